# Optimizing an MI355X kernel written in HIP

```python
import math
import jax, jax.numpy as jnp
from jax import lax
import numpy as np

D_MODEL = 1024
BATCH = 4
SEQ = 8192
DEPTH = 2
DEC_BATCH = 4
DEC_SEQ = 4096
PAST_LEN = 128

GRID_W = 64
N_MIXERS = 2
N_A_LAYERS = (DEPTH + 1) // 2
N_B_LAYERS = DEPTH // 2
S5_GROUP = 16
S5_GROUPS = D_MODEL // S5_GROUP
S5_STATE = 64
DT_MIN = 0.001
DT_MAX = 0.1
NA_HEADS = 16
NA_HEAD_DIM = D_MODEL // NA_HEADS
NA_WIN_ROWS = 8
NA_WIN_COLS = 16
NA_QCOLS = 16
NA_KCOLS = 32
MEM_HEADS = 4
MEM_HEAD_DIM = D_MODEL // MEM_HEADS
MEM_LEN = 256
N_EXPERTS = 16
EXPERT_FF = 2048
EC_CAPACITY_FACTOR = 2
DN_ALPHA = (2.0 * DEPTH) ** 0.25
DN_BETA = (8.0 * DEPTH) ** -0.25
LN_EPS = 1e-5

kernel_name = "hybrid_s5_natten_ec_moe_encoder"


def layer_norm(x, g, b):
    xf = x.astype(jnp.float32)
    mu = jnp.mean(xf, axis=-1, keepdims=True)
    var = jnp.mean(jnp.square(xf - mu), axis=-1, keepdims=True)
    y = (xf - mu) * lax.rsqrt(var + LN_EPS) * g.astype(jnp.float32) + b.astype(jnp.float32)
    return y.astype(x.dtype)


def _ssm_combine(left, right):
    a_l, b_l = left
    a_r, b_r = right
    return a_r * a_l, a_r * b_l + b_r


def s5_mixer(x, w_in, lam_re, lam_im, log_dt, b_re, b_im, c_re, c_im, d_skip, w_glu):
    bsz, L, _ = x.shape
    f32 = jnp.float32
    u = (x @ w_in).astype(f32)
    ug = u.reshape(bsz, L, S5_GROUPS, S5_GROUP)
    y = d_skip.astype(f32) * u
    for direction, reverse in ((0, False), (1, True)):
        dt = jnp.exp(log_dt[direction].astype(f32))[:, None]
        lam = lax.complex(lam_re[direction].astype(f32), lam_im[direction].astype(f32))
        lam_bar = jnp.exp(lam * dt)
        b_bar = ((lam_bar - 1.0) / lam)[..., None] * lax.complex(
            b_re[direction].astype(f32), b_im[direction].astype(f32))
        bu = lax.complex(jnp.einsum('blgh,gph->blgp', ug, jnp.real(b_bar)),
                         jnp.einsum('blgh,gph->blgp', ug, jnp.imag(b_bar)))
        a = jnp.broadcast_to(lam_bar, (1, L) + lam_bar.shape)
        _, h = lax.associative_scan(_ssm_combine, (a, bu), axis=1, reverse=reverse)
        y_dir = (jnp.einsum('gcp,blgp->blgc', c_re[direction].astype(f32), jnp.real(h))
                 - jnp.einsum('gcp,blgp->blgc', c_im[direction].astype(f32), jnp.imag(h)))
        y = y + y_dir.reshape(bsz, L, D_MODEL)
    g = jax.nn.gelu(y).astype(x.dtype)
    z = g @ w_glu
    return z[..., :D_MODEL] * jax.nn.sigmoid(z[..., D_MODEL:])


def na_mixer(x, w_qkv, rpb, w_o):
    bsz, L, _ = x.shape
    rows = L // GRID_W
    kr = min(NA_WIN_ROWS, rows)
    n_cb = GRID_W // NA_QCOLS
    qkv = (x @ w_qkv).reshape(bsz, rows, GRID_W, 3, NA_HEADS, NA_HEAD_DIM)
    q = qkv[:, :, :, 0] * (NA_HEAD_DIM ** -0.5)
    k = qkv[:, :, :, 1]
    v = qkv[:, :, :, 2]
    q_cols = jnp.arange(GRID_W).reshape(n_cb, NA_QCOLS)
    win_start = jnp.clip(q_cols - NA_WIN_COLS // 2, 0, GRID_W - NA_WIN_COLS)
    blk_start = jnp.clip(jnp.arange(n_cb) * NA_QCOLS - NA_WIN_COLS // 2, 0, GRID_W - NA_KCOLS)
    key_cols = blk_start[:, None] + jnp.arange(NA_KCOLS)[None, :]
    kc = key_cols[:, None, :]
    col_mask = (kc >= win_start[:, :, None]) & (kc < win_start[:, :, None] + NA_WIN_COLS)
    dc_idx = jnp.clip(kc - q_cols[:, :, None] + NA_WIN_COLS - 1, 0, 2 * NA_WIN_COLS - 2)
    mask = col_mask[:, :, None, :]

    def row_step(args):
        r, q_row = args
        rs = jnp.clip(r - kr // 2, 0, rows - kr)
        k_rows = lax.dynamic_slice_in_dim(k, rs, kr, axis=1)
        v_rows = lax.dynamic_slice_in_dim(v, rs, kr, axis=1)
        k_blk = k_rows[:, :, key_cols]
        v_blk = v_rows[:, :, key_cols]
        qb = q_row.reshape(bsz, n_cb, NA_QCOLS, NA_HEADS, NA_HEAD_DIM)
        s = jnp.einsum('bnqhd,brnkhd->bhnqrk', qb, k_blk).astype(jnp.float32)
        dr_idx = (rs + jnp.arange(kr) - r + NA_WIN_ROWS - 1).reshape(kr, 1, 1, 1)
        bias = rpb[:, dr_idx, dc_idx[None]].transpose(0, 2, 3, 1, 4).astype(jnp.float32)
        s = jnp.where(mask, s + bias[None], -jnp.inf)
        p = jax.nn.softmax(s.reshape(bsz, NA_HEADS, n_cb, NA_QCOLS, kr * NA_KCOLS), axis=-1)
        p = p.reshape(bsz, NA_HEADS, n_cb, NA_QCOLS, kr, NA_KCOLS).astype(x.dtype)
        o = jnp.einsum('bhnqrk,brnkhd->bnqhd', p, v_blk)
        return o.reshape(bsz, GRID_W, D_MODEL)

    q_rows = jnp.moveaxis(q, 1, 0)
    out = lax.map(row_step, (jnp.arange(rows), q_rows))
    out = jnp.moveaxis(out, 0, 1).reshape(bsz, L, D_MODEL)
    return out @ w_o


def mem_xattn(x, mem, w_q, w_kv, w_o):
    bsz, L, _ = x.shape
    m = mem.shape[1]
    q = (x @ w_q).reshape(bsz, L, MEM_HEADS, MEM_HEAD_DIM)
    kv = (mem @ w_kv).reshape(bsz, m, 2, MEM_HEADS, MEM_HEAD_DIM)
    s = jnp.einsum('blhd,bmhd->bhlm', q, kv[:, :, 0]).astype(jnp.float32) * (MEM_HEAD_DIM ** -0.5)
    p = jax.nn.softmax(s, axis=-1).astype(x.dtype)
    o = jnp.einsum('bhlm,bmhd->blhd', p, kv[:, :, 1]).reshape(bsz, L, D_MODEL)
    return o @ w_o


def ec_moe(x, w_router, w1, w3, w2):
    bsz, L, d = x.shape
    n = bsz * L
    cap = EC_CAPACITY_FACTOR * n // N_EXPERTS
    xt = x.reshape(n, d)
    aff = jax.nn.softmax((xt @ w_router).astype(jnp.float32), axis=-1)
    gate, idx = lax.top_k(aff.T, cap)
    xs = xt[idx]
    h = jax.nn.silu(jnp.einsum('ecd,edf->ecf', xs, w1)) * jnp.einsum('ecd,edf->ecf', xs, w3)
    ye = jnp.einsum('ecf,efd->ecd', h, w2) * gate[..., None].astype(x.dtype)
    out = jnp.zeros_like(xt).at[idx.reshape(-1)].add(ye.reshape(-1, d))
    return out.reshape(bsz, L, d)


def trunk(x, mem, a_w_in, a_lam_re, a_lam_im, a_log_dt, a_b_re, a_b_im, a_c_re, a_c_im, a_d, a_w_glu,
          b_w_qkv, b_rpb, b_w_o, m_w_q, m_w_kv, m_w_o, e_w_router, e_w1, e_w3, e_w2, ln_g, ln_b):
    for i in range(DEPTH):
        j = i // N_MIXERS
        if i % N_MIXERS == 0:
            h = s5_mixer(x, a_w_in[j], a_lam_re[j], a_lam_im[j], a_log_dt[j], a_b_re[j], a_b_im[j],
                         a_c_re[j], a_c_im[j], a_d[j], a_w_glu[j])
        else:
            h = na_mixer(x, b_w_qkv[j], b_rpb[j], b_w_o[j])
        x = layer_norm(DN_ALPHA * x + h, ln_g[i, 0], ln_b[i, 0])
        x = layer_norm(DN_ALPHA * x + mem_xattn(x, mem, m_w_q[i], m_w_kv[i], m_w_o[i]), ln_g[i, 1], ln_b[i, 1])
        x = layer_norm(DN_ALPHA * x + ec_moe(x, e_w_router[i], e_w1[i], e_w3[i], e_w2[i]), ln_g[i, 2], ln_b[i, 2])
    return x


def setup_inputs(seed: int = 0) -> dict:
    key = jax.random.key(seed)
    ks = jax.random.split(key, 32)
    f32 = jnp.float32
    D, G, P, CG = D_MODEL, S5_GROUPS, S5_STATE, S5_GROUP

    def nrm(k, shape, scale):
        return jax.random.normal(k, shape, f32) * scale

    n_vec = jnp.arange(P, dtype=f32)
    return {
        "x_prompt": nrm(ks[0], (BATCH, SEQ, D), 1.0),
        "x_sample": nrm(ks[1], (DEC_BATCH, DEC_SEQ, D), 1.0),
        "mem_prompt": nrm(ks[2], (BATCH, MEM_LEN, D), 1.0),
        "mem_sample": nrm(ks[3], (DEC_BATCH, MEM_LEN, D), 1.0),
        "a_w_in": nrm(ks[4], (N_A_LAYERS, D, D), D ** -0.5),
        "a_lam_re": -0.5 + nrm(ks[5], (N_A_LAYERS, 2, G, P), 0.01),
        "a_lam_im": math.pi * n_vec + nrm(ks[6], (N_A_LAYERS, 2, G, P), 0.01),
        "a_log_dt": jax.random.uniform(ks[7], (N_A_LAYERS, 2, G), f32, math.log(DT_MIN), math.log(DT_MAX)),
        "a_b_re": nrm(ks[8], (N_A_LAYERS, 2, G, P, CG), (2.0 * CG) ** -0.5),
        "a_b_im": nrm(ks[9], (N_A_LAYERS, 2, G, P, CG), (2.0 * CG) ** -0.5),
        "a_c_re": nrm(ks[10], (N_A_LAYERS, 2, G, CG, P), (2.0 * P) ** -0.5),
        "a_c_im": nrm(ks[11], (N_A_LAYERS, 2, G, CG, P), (2.0 * P) ** -0.5),
        "a_d": nrm(ks[12], (N_A_LAYERS, D), 1.0),
        "a_w_glu": nrm(ks[13], (N_A_LAYERS, D, 2 * D), D ** -0.5 * DN_BETA),
        "b_w_qkv": nrm(ks[14], (N_B_LAYERS, D, 3 * D), D ** -0.5),
        "b_rpb": nrm(ks[15], (N_B_LAYERS, NA_HEADS, 2 * NA_WIN_ROWS - 1, 2 * NA_WIN_COLS - 1), 0.1),
        "b_w_o": nrm(ks[16], (N_B_LAYERS, D, D), D ** -0.5 * DN_BETA),
        "m_w_q": nrm(ks[17], (DEPTH, D, D), D ** -0.5),
        "m_w_kv": nrm(ks[18], (DEPTH, D, 2 * D), D ** -0.5),
        "m_w_o": nrm(ks[19], (DEPTH, D, D), D ** -0.5 * DN_BETA),
        "e_w_router": nrm(ks[20], (DEPTH, D, N_EXPERTS), D ** -0.5),
        "e_w1": nrm(ks[21], (DEPTH, N_EXPERTS, D, EXPERT_FF), D ** -0.5),
        "e_w3": nrm(ks[22], (DEPTH, N_EXPERTS, D, EXPERT_FF), D ** -0.5),
        "e_w2": nrm(ks[23], (DEPTH, N_EXPERTS, EXPERT_FF, D), EXPERT_FF ** -0.5 * DN_BETA),
        "ln_g": 1.0 + nrm(ks[24], (DEPTH, 3, D), 0.02),
        "ln_b": nrm(ks[25], (DEPTH, 3, D), 0.02),
    }


def reference(x_prompt, x_sample, mem_prompt, mem_sample, a_w_in, a_lam_re, a_lam_im, a_log_dt,
              a_b_re, a_b_im, a_c_re, a_c_im, a_d, a_w_glu, b_w_qkv, b_rpb, b_w_o,
              m_w_q, m_w_kv, m_w_o, e_w_router, e_w1, e_w3, e_w2, ln_g, ln_b):
    y_prompt = trunk(x_prompt, mem_prompt, a_w_in, a_lam_re, a_lam_im, a_log_dt, a_b_re, a_b_im,
                     a_c_re, a_c_im, a_d, a_w_glu, b_w_qkv, b_rpb, b_w_o, m_w_q, m_w_kv, m_w_o,
                     e_w_router, e_w1, e_w3, e_w2, ln_g, ln_b)
    y_sample = trunk(x_sample, mem_sample, a_w_in, a_lam_re, a_lam_im, a_log_dt, a_b_re, a_b_im,
                     a_c_re, a_c_im, a_d, a_w_glu, b_w_qkv, b_rpb, b_w_o, m_w_q, m_w_kv, m_w_o,
                     e_w_router, e_w1, e_w3, e_w2, ln_g, ln_b)
    return (y_prompt, y_sample)
```

```cpp
#include <hip/hip_runtime.h>
#include <cstdio>
#include <cstdint>
#include <cmath>

namespace nv {
constexpr int D = 1024, NTP = 32768, NTS = 16384, NT = NTP + NTS, NGB = 8, MEM = 256;
constexpr int GRID_W = 64;
constexpr float ALPHA = 1.41421356237309515f;
constexpr float LN_EPS = 1e-5f;

__host__ __device__ inline int gb_tok0(int gb) { return gb < 4 ? gb * 8192 : NTP + (gb - 4) * 4096; }
__host__ __device__ inline int gb_len(int gb) { return gb < 4 ? 8192 : 4096; }

__device__ __forceinline__ float wave_sum(float v) {
#pragma unroll
    for (int o = 1; o < 64; o <<= 1) v += __shfl_xor(v, o);
    return v;
}
__device__ __forceinline__ float wave_max(float v) {
#pragma unroll
    for (int o = 1; o < 64; o <<= 1) v = fmaxf(v, __shfl_xor(v, o));
    return v;
}

struct SG { const float* A; const float* B; float* C; const int* gidx; int M, N, K, zdiv; long sam, sak, sbk, sbn, ldc; long zA0, zA1, zB0, zB1, zC0, zC1; };
__global__ __launch_bounds__(256) void k_sgemm(SG a) {
    __shared__ float As[8][132];
    __shared__ float Bs[8][132];
    const int z = blockIdx.z, z0 = z / a.zdiv, z1 = z % a.zdiv;
    const float* A = a.A + z0 * a.zA0 + z1 * a.zA1;
    const float* B = a.B + z0 * a.zB0 + z1 * a.zB1;
    float* C = a.C + z0 * a.zC0 + z1 * a.zC1;
    const int bm = blockIdx.y * 128, bn = blockIdx.x * 128, tid = threadIdx.x, tx = tid & 15, ty = tid >> 4;
    float acc[8][8];
#pragma unroll
    for (int i = 0; i < 8; ++i)
#pragma unroll
        for (int j = 0; j < 8; ++j) acc[i][j] = 0.f;
    const int arow_l = tid >> 1, akk = (tid & 1) * 4;
    const long arow = a.gidx ? (long)a.gidx[bm + arow_l] : (long)(bm + arow_l);
    const float* Ap = A + arow * a.sam;
    const int bkk = tid >> 5, bnn = (tid & 31) * 4;
    for (int k0 = 0; k0 < a.K; k0 += 8) {
        float av[4], bv[4];
#pragma unroll
        for (int i = 0; i < 4; ++i) av[i] = Ap[(long)(k0 + akk + i) * a.sak];
#pragma unroll
        for (int i = 0; i < 4; ++i) bv[i] = B[(long)(k0 + bkk) * a.sbk + (long)(bn + bnn + i) * a.sbn];
        __syncthreads();
#pragma unroll
        for (int i = 0; i < 4; ++i) As[akk + i][arow_l] = av[i];
#pragma unroll
        for (int i = 0; i < 4; ++i) Bs[bkk][bnn + i] = bv[i];
        __syncthreads();
#pragma unroll
        for (int kk = 0; kk < 8; ++kk) {
            float x[8], y[8];
#pragma unroll
            for (int i = 0; i < 8; ++i) x[i] = As[kk][ty * 8 + i];
#pragma unroll
            for (int j = 0; j < 8; ++j) y[j] = Bs[kk][tx * 8 + j];
#pragma unroll
            for (int i = 0; i < 8; ++i)
#pragma unroll
                for (int j = 0; j < 8; ++j) acc[i][j] += x[i] * y[j];
        }
    }
#pragma unroll
    for (int i = 0; i < 8; ++i)
#pragma unroll
        for (int j = 0; j < 8; ++j) C[(long)(bm + ty * 8 + i) * a.ldc + bn + tx * 8 + j] = acc[i][j];
}

__global__ __launch_bounds__(64) void k_s5_scan(const float* __restrict__ u, float* __restrict__ ydir, const float* lam_re, const float* lam_im, const float* log_dt,
                                                const float* b_re, const float* b_im, const float* c_re, const float* c_im) {
    const int wid = blockIdx.x;
    const int dir = wid & 1, g = (wid >> 1) & 63, gb = wid >> 7;
    const int p = threadIdx.x;
    const int L = gb_len(gb), t0 = gb_tok0(gb);
    const double dt = exp((double)log_dt[dir * 64 + g]);
    const double lr = lam_re[(dir * 64 + g) * 64 + p], li = lam_im[(dir * 64 + g) * 64 + p];
    const double er = exp(lr * dt), lbr = er * cos(li * dt), lbi = er * sin(li * dt);
    const double nr = lbr - 1.0, ni = lbi, den = lr * lr + li * li;
    const double fr = (nr * lr + ni * li) / den, fi = (ni * lr - nr * li) / den;
    float Br[16], Bi[16], Cr[16], Ci[16];
#pragma unroll
    for (int h = 0; h < 16; ++h) {
        const double br = b_re[((dir * 64 + g) * 64 + p) * 16 + h], bi = b_im[((dir * 64 + g) * 64 + p) * 16 + h];
        Br[h] = (float)(fr * br - fi * bi); Bi[h] = (float)(fr * bi + fi * br);
        Cr[h] = c_re[((dir * 64 + g) * 16 + h) * 64 + p]; Ci[h] = c_im[((dir * 64 + g) * 16 + h) * 64 + p];
    }
    const float ar = (float)lbr, ai = (float)lbi;
    float hr = 0.f, hi = 0.f;
    float* yo = ydir + (size_t)dir * NT * D;
    for (int s = 0; s < L; ++s) {
        const int t = dir ? (L - 1 - s) : s;
        const float* ur = u + (size_t)(t0 + t) * D + g * 16;
        float bur = 0.f, bui = 0.f;
#pragma unroll
        for (int h = 0; h < 16; ++h) { const float uv = ur[h]; bur += uv * Br[h]; bui += uv * Bi[h]; }
        const float nhr = ar * hr - ai * hi + bur, nhi = ar * hi + ai * hr + bui;
        hr = nhr; hi = nhi;
        float mine = 0.f;
#pragma unroll
        for (int c = 0; c < 16; ++c) { const float v = wave_sum(Cr[c] * hr - Ci[c] * hi); if (p == c) mine = v; }
        if (p < 16) yo[(size_t)(t0 + t) * D + g * 16 + p] = mine;
    }
}
__global__ void k_s5_gelu(const float* u, const float* ydir, const float* dskip, float* gout) {
    const size_t i = (size_t)blockIdx.x * blockDim.x + threadIdx.x;
    if (i >= (size_t)NT * D) return;
    const float y = dskip[i & (D - 1)] * u[i] + ydir[i] + ydir[(size_t)NT * D + i];
    const float c = 0.7978845608028654f * (y + 0.044715f * y * y * y);
    gout[i] = 0.5f * y * (1.f + tanhf(c));
}
__global__ void k_glu(const float* z1, const float* z2, float* out) {
    const size_t i = (size_t)blockIdx.x * blockDim.x + threadIdx.x;
    if (i >= (size_t)NT * D) return;
    out[i] = z1[i] / (1.f + expf(-z2[i]));
}
__global__ __launch_bounds__(256) void k_res_ln(const float* x, const float* h, const float* g, const float* b, float* xo, int rows) {
    const int row = blockIdx.x * 4 + (threadIdx.x >> 6), lane = threadIdx.x & 63;
    if (row >= rows) return;
    float v[16]; float s = 0.f;
#pragma unroll
    for (int j = 0; j < 16; ++j) { const size_t i = (size_t)row * D + lane + 64 * j; v[j] = ALPHA * x[i] + h[i]; s += v[j]; }
    const float mean = wave_sum(s) * (1.f / D); float q = 0.f;
#pragma unroll
    for (int j = 0; j < 16; ++j) { v[j] -= mean; q += v[j] * v[j]; }
    const float rstd = 1.f / sqrtf(wave_sum(q) * (1.f / D) + LN_EPS);
#pragma unroll
    for (int j = 0; j < 16; ++j) { const int c = lane + 64 * j; xo[(size_t)row * D + c] = v[j] * rstd * g[c] + b[c]; }
}
__global__ __launch_bounds__(256) void k_softmax256(float* s, float scale, int rows) {
    const int row = blockIdx.x * 4 + (threadIdx.x >> 6), lane = threadIdx.x & 63;
    if (row >= rows) return;
    float v[4]; float m = -INFINITY;
#pragma unroll
    for (int j = 0; j < 4; ++j) { v[j] = s[(size_t)row * 256 + lane + 64 * j] * scale; m = fmaxf(m, v[j]); }
    m = wave_max(m); float l = 0.f;
#pragma unroll
    for (int j = 0; j < 4; ++j) { v[j] = expf(v[j] - m); l += v[j]; }
    l = wave_sum(l);
#pragma unroll
    for (int j = 0; j < 4; ++j) s[(size_t)row * 256 + lane + 64 * j] = v[j] / l;
}
__global__ __launch_bounds__(256) void k_router(const float* x, const float* wr, float* aff, int rows) {
    const int row = blockIdx.x * 4 + (threadIdx.x >> 6), lane = threadIdx.x & 63;
    if (row >= rows) return;
    float acc[16];
#pragma unroll
    for (int e = 0; e < 16; ++e) acc[e] = 0.f;
    for (int j = 0; j < 16; ++j) { const int k = lane + 64 * j; const float xv = x[(size_t)row * D + k];
#pragma unroll
        for (int e = 0; e < 16; ++e) acc[e] += xv * wr[k * 16 + e]; }
    float m = -INFINITY;
#pragma unroll
    for (int e = 0; e < 16; ++e) { acc[e] = wave_sum(acc[e]); m = fmaxf(m, acc[e]); }
    float l = 0.f;
#pragma unroll
    for (int e = 0; e < 16; ++e) { acc[e] = expf(acc[e] - m); l += acc[e]; }
    float mine = 0.f;
#pragma unroll
    for (int e = 0; e < 16; ++e) if (lane == e) mine = acc[e] / l;
    if (lane < 16) aff[(size_t)row * 16 + lane] = mine;
}

__device__ void select_expert(const float* aff, int n, int e, int cap, int* idx_out, float* gate_out, int* slot_of  , unsigned* hist  , unsigned* wsum  , unsigned* bc  ) {
    const int tid = threadIdx.x, nth = blockDim.x, lane = tid & 63, wv = tid >> 6, nw = nth >> 6;
    unsigned prefix = 0u, mask = 0u; unsigned remaining = (unsigned)cap;
    for (int pass = 0; pass < 4; ++pass) {
        const int shift = 24 - 8 * pass;
        for (int i = tid; i < 256; i += nth) hist[i] = 0u;
        __syncthreads();
        for (int t = tid; t < n; t += nth) { const unsigned key = __float_as_uint(aff[(size_t)t * 16 + e]); if ((key & mask) == prefix) atomicAdd(&hist[(key >> shift) & 255u], 1u); }
        __syncthreads();
        if (tid == 0) { unsigned cum = 0u; int b = 255; for (; b > 0; --b) { if (cum + hist[b] >= remaining) break; cum += hist[b]; } bc[0] = (unsigned)b; bc[1] = remaining - cum; }
        __syncthreads();
        prefix |= bc[0] << shift; mask |= 0xffu << shift; remaining = bc[1];
        __syncthreads();
    }
    const unsigned T = prefix; const unsigned need_eq = remaining;
    unsigned base = 0u, eqbase = 0u;
    for (int s0 = 0; s0 < n; s0 += nth) {
        const int t = s0 + tid; const bool in = t < n;
        const float a = in ? aff[(size_t)t * 16 + e] : 0.f; const unsigned key = __float_as_uint(a);
        const bool gt = in && key > T, eq = in && key == T;
        const unsigned long long meq = __ballot(eq); const unsigned eqr_w = __popcll(meq & ((1ull << lane) - 1ull));
        if (lane == 0) wsum[wv] = __popcll(meq);
        __syncthreads();
        unsigned eqoff = 0u, eqtot = 0u; for (int w = 0; w < nw; ++w) { const unsigned c = wsum[w]; if (w < wv) eqoff += c; eqtot += c; }
        __syncthreads();
        const bool sel = gt || (eq && (eqbase + eqoff + eqr_w) < need_eq);
        const unsigned long long ms = __ballot(sel); const unsigned sr_w = __popcll(ms & ((1ull << lane) - 1ull));
        if (lane == 0) wsum[wv] = __popcll(ms);
        __syncthreads();
        unsigned soff = 0u, stot = 0u; for (int w = 0; w < nw; ++w) { const unsigned c = wsum[w]; if (w < wv) soff += c; stot += c; }
        __syncthreads();
        if (sel) { const unsigned slot = base + soff + sr_w; if (slot < (unsigned)cap) { idx_out[slot] = t; gate_out[slot] = a; } }
        if (slot_of && in) slot_of[(size_t)t * 16 + e] = sel ? (int)(base + soff + sr_w) : -1;
        base += stot; eqbase += eqtot;
    }
}
__global__ __launch_bounds__(512) void k_select(const float* aff_all, int* idx_all, float* gate_all) {
    __shared__ unsigned hist[256]; __shared__ unsigned wsum[32]; __shared__ unsigned bc[4];
    const int grp = blockIdx.x >> 4, e = blockIdx.x & 15;
    const int n = grp ? NTS : NTP, cap = n / 8;
    const float* aff = aff_all + (size_t)(grp ? NTP : 0) * 16;
    int* idx = idx_all + (grp ? 16 * 4096 : 0) + e * cap; float* gate = gate_all + (grp ? 16 * 4096 : 0) + e * cap;
    select_expert(aff, n, e, cap, idx, gate, nullptr, hist, wsum, bc);
}
__global__ void k_silu_mul(float* h1, const float* h3, size_t n) {
    const size_t i = (size_t)blockIdx.x * blockDim.x + threadIdx.x; if (i >= n) return;
    const float a = h1[i]; h1[i] = a / (1.f + expf(-a)) * h3[i];
}
__global__ void k_scatter_add(const float* ye, const int* idx, const float* gate, float* out, int cap) {
    const size_t i = (size_t)blockIdx.x * blockDim.x + threadIdx.x; if (i >= (size_t)cap * D) return;
    const int slot = (int)(i >> 10), c = (int)(i & 1023);
    atomicAdd(&out[(size_t)idx[slot] * D + c], gate[slot] * ye[i]);
}

__global__ __launch_bounds__(256) void k_natten(float* q, const float* k, const float* v, const float* rpb) {
    const int wg = blockIdx.x * 4 + (threadIdx.x >> 6), lane = threadIdx.x & 63;
    const int tok = wg >> 4, h = wg & 15;
    if (tok >= NT) return;
    int gb, l; if (tok < NTP) { gb = tok >> 13; l = tok & 8191; } else { gb = 4 + ((tok - NTP) >> 12); l = (tok - NTP) & 4095; }
    const int rows = gb_len(gb) / GRID_W, t0 = gb_tok0(gb);
    const int r = l >> 6, qc = l & 63;
    int rs = r - 4; rs = rs < 0 ? 0 : (rs > rows - 8 ? rows - 8 : rs);
    int ws = qc - 8; ws = ws < 0 ? 0 : (ws > 48 ? 48 : ws);
    const float qv = q[(size_t)tok * D + h * 64 + lane] * 0.125f;
    float m = -INFINITY, lsum = 0.f, o = 0.f;
    for (int rr = 0; rr < 8; ++rr) {
        const int kr = rs + rr, dr = kr - r + 7;
        for (int cc = 0; cc < 16; ++cc) {
            const int kc = ws + cc; int dc = kc - qc + 15; dc = dc < 0 ? 0 : (dc > 30 ? 30 : dc);
            const size_t kt = (size_t)(t0 + kr * 64 + kc) * D + h * 64 + lane;
            const float s = wave_sum(qv * k[kt]) + rpb[(h * 15 + dr) * 31 + dc];
            const float mn = fmaxf(m, s), al = expf(m - mn), pp = expf(s - mn);
            lsum = lsum * al + pp; o = o * al + pp * v[kt]; m = mn;
        }
    }
    q[(size_t)tok * D + h * 64 + lane] = o / lsum;
}
}

extern "C" void kernel_launch(void* const* d_in, const int* in_sizes, int n_in, void* d_out, int out_size, void* d_ws, size_t ws_size, hipStream_t stream) {
    using namespace nv;
    const float* x_prompt = (const float*)d_in[0]; const float* x_sample = (const float*)d_in[1];
    const float* mem_prompt = (const float*)d_in[2]; const float* mem_sample = (const float*)d_in[3];
    const float* a_w_in = (const float*)d_in[4]; const float* a_lam_re = (const float*)d_in[5]; const float* a_lam_im = (const float*)d_in[6]; const float* a_log_dt = (const float*)d_in[7];
    const float* a_b_re = (const float*)d_in[8]; const float* a_b_im = (const float*)d_in[9]; const float* a_c_re = (const float*)d_in[10]; const float* a_c_im = (const float*)d_in[11];
    const float* a_d = (const float*)d_in[12]; const float* a_w_glu = (const float*)d_in[13];
    const float* b_w_qkv = (const float*)d_in[14]; const float* b_rpb = (const float*)d_in[15]; const float* b_w_o = (const float*)d_in[16];
    const float* m_w_q = (const float*)d_in[17]; const float* m_w_kv = (const float*)d_in[18]; const float* m_w_o = (const float*)d_in[19];
    const float* e_w_router = (const float*)d_in[20]; const float* e_w1 = (const float*)d_in[21]; const float* e_w3 = (const float*)d_in[22]; const float* e_w2 = (const float*)d_in[23];
    const float* ln_g = (const float*)d_in[24]; const float* ln_b = (const float*)d_in[25];
    float* out = (float*)d_out;
    const size_t BIG = (size_t)NT * D;
    if (ws_size < (4 * BIG + 16u * 1024 * 1024) * sizeof(float)) { fprintf(stderr, "kernel_launch: workspace too small (%zu)\n", ws_size); return; }
    float* W = (float*)d_ws;
    float* X = W; float* T1 = W + BIG; float* T2 = W + 2 * BIG; float* T3 = W + 3 * BIG;
    float* misc = W + 4 * BIG;
    float* KV = misc;
    float* AFF = misc + 4u * 1024 * 1024;
    float* GATE = AFF + 1024 * 1024;
    int* IDX = (int*)(GATE + 128 * 1024);
    float* MEMC = (float*)(IDX + 128 * 1024);

    hipMemcpyAsync(X, x_prompt, (size_t)NTP * D * 4, hipMemcpyDeviceToDevice, stream);
    hipMemcpyAsync(X + (size_t)NTP * D, x_sample, (size_t)NTS * D * 4, hipMemcpyDeviceToDevice, stream);
    hipMemcpyAsync(MEMC, mem_prompt, (size_t)4 * MEM * D * 4, hipMemcpyDeviceToDevice, stream);
    hipMemcpyAsync(MEMC + (size_t)4 * MEM * D, mem_sample, (size_t)4 * MEM * D * 4, hipMemcpyDeviceToDevice, stream);

    auto sgemm = [&](const float* A, const float* B, float* C, const int* gidx, int M, int N, int K, long sam, long sak, long sbk, long sbn, long ldc,
                     int nz = 1, int zdiv = 1, long zA0 = 0, long zA1 = 0, long zB0 = 0, long zB1 = 0, long zC0 = 0, long zC1 = 0) {
        SG a{A, B, C, gidx, M, N, K, zdiv, sam, sak, sbk, sbn, ldc, zA0, zA1, zB0, zB1, zC0, zC1};
        hipLaunchKernelGGL(k_sgemm, dim3(N / 128, M / 128, nz), dim3(256), 0, stream, a);
    };
    const int EW = (int)((BIG + 255) / 256);

    for (int layer = 0; layer < 2; ++layer) {
        if (layer == 0) {
            sgemm(X, a_w_in, T1, nullptr, NT, D, D, D, 1, D, 1, D);
            hipLaunchKernelGGL(k_s5_scan, dim3(NGB * 64 * 2), dim3(64), 0, stream, T1, T2, a_lam_re, a_lam_im, a_log_dt, a_b_re, a_b_im, a_c_re, a_c_im);
            hipLaunchKernelGGL(k_s5_gelu, dim3(EW), dim3(256), 0, stream, T1, T2, a_d, T2);
            sgemm(T2, a_w_glu, T1, nullptr, NT, D, D, D, 1, 2 * D, 1, D);
            sgemm(T2, a_w_glu + D, T3, nullptr, NT, D, D, D, 1, 2 * D, 1, D);
            hipLaunchKernelGGL(k_glu, dim3(EW), dim3(256), 0, stream, T1, T3, T1);
        } else {
            sgemm(X, b_w_qkv, T1, nullptr, NT, D, D, D, 1, 3 * D, 1, D);
            sgemm(X, b_w_qkv + D, T2, nullptr, NT, D, D, D, 1, 3 * D, 1, D);
            sgemm(X, b_w_qkv + 2 * D, T3, nullptr, NT, D, D, D, 1, 3 * D, 1, D);
            hipLaunchKernelGGL(k_natten, dim3(NT * 16 / 4), dim3(256), 0, stream, T1, T2, T3, b_rpb);
            sgemm(T1, b_w_o, T2, nullptr, NT, D, D, D, 1, D, 1, D);
        }
        hipLaunchKernelGGL(k_res_ln, dim3(NT / 4), dim3(256), 0, stream, X, (layer == 0 ? T1 : T2), ln_g + (layer * 3 + 0) * D, ln_b + (layer * 3 + 0) * D, X, NT);

        const float* wq = m_w_q + (size_t)layer * D * D; const float* wkv = m_w_kv + (size_t)layer * D * 2 * D; const float* wo = m_w_o + (size_t)layer * D * D;
        sgemm(MEMC, wkv, KV, nullptr, NGB * MEM, 2 * D, D, D, 1, 2 * D, 1, 2 * D);
        sgemm(X, wq, T1, nullptr, NT, D, D, D, 1, D, 1, D);
        for (int grp = 0; grp < 2; ++grp) {
            const int L = grp ? 4096 : 8192; const size_t tb = grp ? (size_t)NTP : 0; const int gb0 = grp * 4;
            sgemm(T1 + tb * D, KV + (size_t)gb0 * MEM * 2 * D, T2 + tb * D, nullptr, L, 256, 256, D, 1, 1, 2 * D, D,
                  16, 4, (long)L * D, 256, (long)MEM * 2 * D, 256, (long)L * D, 256);
        }
        hipLaunchKernelGGL(k_softmax256, dim3(NT * 4 / 4), dim3(256), 0, stream, T2, 0.0625f, NT * 4);
        for (int grp = 0; grp < 2; ++grp) {
            const int L = grp ? 4096 : 8192; const size_t tb = grp ? (size_t)NTP : 0; const int gb0 = grp * 4;
            sgemm(T2 + tb * D, KV + (size_t)gb0 * MEM * 2 * D + D, T3 + tb * D, nullptr, L, 256, 256, D, 1, 2 * D, 1, D,
                  16, 4, (long)L * D, 256, (long)MEM * 2 * D, 256, (long)L * D, 256);
        }
        sgemm(T3, wo, T1, nullptr, NT, D, D, D, 1, D, 1, D);
        hipLaunchKernelGGL(k_res_ln, dim3(NT / 4), dim3(256), 0, stream, X, T1, ln_g + (layer * 3 + 1) * D, ln_b + (layer * 3 + 1) * D, X, NT);

        hipLaunchKernelGGL(k_router, dim3(NT / 4), dim3(256), 0, stream, X, e_w_router + (size_t)layer * D * 16, AFF, NT);
        hipLaunchKernelGGL(k_select, dim3(32), dim3(512), 0, stream, AFF, IDX, GATE);
        hipMemsetAsync(T1, 0, BIG * 4, stream);
        for (int grp = 0; grp < 2; ++grp) {
            const int n = grp ? NTS : NTP, cap = n / 8; const size_t tb = grp ? (size_t)NTP : 0;
            for (int e = 0; e < 16; ++e) {
                const int* idx = IDX + (grp ? 16 * 4096 : 0) + e * cap; const float* gate = GATE + (grp ? 16 * 4096 : 0) + e * cap;
                const float* w1 = e_w1 + ((size_t)layer * 16 + e) * D * 2048; const float* w3 = e_w3 + ((size_t)layer * 16 + e) * D * 2048; const float* w2 = e_w2 + ((size_t)layer * 16 + e) * 2048 * D;
                float* H1 = T2; float* H3 = T2 + (size_t)4096 * 2048; float* YE = T3;
                sgemm(X + tb * D, w1, H1, idx, cap, 2048, D, D, 1, 2048, 1, 2048);
                sgemm(X + tb * D, w3, H3, idx, cap, 2048, D, D, 1, 2048, 1, 2048);
                hipLaunchKernelGGL(k_silu_mul, dim3((unsigned)(((size_t)cap * 2048 + 255) / 256)), dim3(256), 0, stream, H1, H3, (size_t)cap * 2048);
                sgemm(H1, w2, YE, nullptr, cap, D, 2048, 2048, 1, D, 1, D);
                hipLaunchKernelGGL(k_scatter_add, dim3((unsigned)(((size_t)cap * D + 255) / 256)), dim3(256), 0, stream, YE, idx, gate, T1 + tb * D, cap);
            }
        }
        float* xo = (layer == 1) ? out : X;
        hipLaunchKernelGGL(k_res_ln, dim3(NT / 4), dim3(256), 0, stream, X, T1, ln_g + (layer * 3 + 2) * D, ln_b + (layer * 3 + 2) * D, xo, NT);
    }
}
```

```cpp
#define FZ_PER_PHASE 1
#include <hip/hip_runtime.h>
#include <cstdio>
#include <cstdint>
#include <cmath>
namespace nv {
constexpr int D = 1024, NTP = 32768, NTS = 16384, NT = NTP + NTS, NGB = 8, MEM = 256;
constexpr int GRID_W = 64;
constexpr float ALPHA = 1.41421356237309515f;
constexpr float LN_EPS = 1e-5f;

__host__ __device__ inline int gb_tok0(int gb) { return gb < 4 ? gb * 8192 : NTP + (gb - 4) * 4096; }
__host__ __device__ inline int gb_len(int gb) { return gb < 4 ? 8192 : 4096; }

__device__ __forceinline__ float wave_sum(float v) {
#pragma unroll
    for (int o = 1; o < 64; o <<= 1) v += __shfl_xor(v, o);
    return v;
}
__device__ __forceinline__ float wave_max(float v) {
#pragma unroll
    for (int o = 1; o < 64; o <<= 1) v = fmaxf(v, __shfl_xor(v, o));
    return v;
}

struct SG { const float* A; const float* B; float* C; const int* gidx; int M, N, K, zdiv; long sam, sak, sbk, sbn, ldc; long zA0, zA1, zB0, zB1, zC0, zC1; };
__global__ __launch_bounds__(256) void k_sgemm(SG a) {
    __shared__ float As[8][132];
    __shared__ float Bs[8][132];
    const int z = blockIdx.z, z0 = z / a.zdiv, z1 = z % a.zdiv;
    const float* A = a.A + z0 * a.zA0 + z1 * a.zA1;
    const float* B = a.B + z0 * a.zB0 + z1 * a.zB1;
    float* C = a.C + z0 * a.zC0 + z1 * a.zC1;
    const int bm = blockIdx.y * 128, bn = blockIdx.x * 128, tid = threadIdx.x, tx = tid & 15, ty = tid >> 4;
    float acc[8][8];
#pragma unroll
    for (int i = 0; i < 8; ++i)
#pragma unroll
        for (int j = 0; j < 8; ++j) acc[i][j] = 0.f;
    const int arow_l = tid >> 1, akk = (tid & 1) * 4;
    const long arow = a.gidx ? (long)a.gidx[bm + arow_l] : (long)(bm + arow_l);
    const float* Ap = A + arow * a.sam;
    const int bkk = tid >> 5, bnn = (tid & 31) * 4;
    for (int k0 = 0; k0 < a.K; k0 += 8) {
        float av[4], bv[4];
#pragma unroll
        for (int i = 0; i < 4; ++i) av[i] = Ap[(long)(k0 + akk + i) * a.sak];
#pragma unroll
        for (int i = 0; i < 4; ++i) bv[i] = B[(long)(k0 + bkk) * a.sbk + (long)(bn + bnn + i) * a.sbn];
        __syncthreads();
#pragma unroll
        for (int i = 0; i < 4; ++i) As[akk + i][arow_l] = av[i];
#pragma unroll
        for (int i = 0; i < 4; ++i) Bs[bkk][bnn + i] = bv[i];
        __syncthreads();
#pragma unroll
        for (int kk = 0; kk < 8; ++kk) {
            float x[8], y[8];
#pragma unroll
            for (int i = 0; i < 8; ++i) x[i] = As[kk][ty * 8 + i];
#pragma unroll
            for (int j = 0; j < 8; ++j) y[j] = Bs[kk][tx * 8 + j];
#pragma unroll
            for (int i = 0; i < 8; ++i)
#pragma unroll
                for (int j = 0; j < 8; ++j) acc[i][j] += x[i] * y[j];
        }
    }
#pragma unroll
    for (int i = 0; i < 8; ++i)
#pragma unroll
        for (int j = 0; j < 8; ++j) C[(long)(bm + ty * 8 + i) * a.ldc + bn + tx * 8 + j] = acc[i][j];
}

__global__ __launch_bounds__(64) void k_s5_scan(const float* __restrict__ u, float* __restrict__ ydir, const float* lam_re, const float* lam_im, const float* log_dt,
                                                const float* b_re, const float* b_im, const float* c_re, const float* c_im) {
    const int wid = blockIdx.x;
    const int dir = wid & 1, g = (wid >> 1) & 63, gb = wid >> 7;
    const int p = threadIdx.x;
    const int L = gb_len(gb), t0 = gb_tok0(gb);
    const double dt = exp((double)log_dt[dir * 64 + g]);
    const double lr = lam_re[(dir * 64 + g) * 64 + p], li = lam_im[(dir * 64 + g) * 64 + p];
    const double er = exp(lr * dt), lbr = er * cos(li * dt), lbi = er * sin(li * dt);
    const double nr = lbr - 1.0, ni = lbi, den = lr * lr + li * li;
    const double fr = (nr * lr + ni * li) / den, fi = (ni * lr - nr * li) / den;
    float Br[16], Bi[16], Cr[16], Ci[16];
#pragma unroll
    for (int h = 0; h < 16; ++h) {
        const double br = b_re[((dir * 64 + g) * 64 + p) * 16 + h], bi = b_im[((dir * 64 + g) * 64 + p) * 16 + h];
        Br[h] = (float)(fr * br - fi * bi); Bi[h] = (float)(fr * bi + fi * br);
        Cr[h] = c_re[((dir * 64 + g) * 16 + h) * 64 + p]; Ci[h] = c_im[((dir * 64 + g) * 16 + h) * 64 + p];
    }
    const float ar = (float)lbr, ai = (float)lbi;
    float hr = 0.f, hi = 0.f;
    float* yo = ydir + (size_t)dir * NT * D;
    for (int s = 0; s < L; ++s) {
        const int t = dir ? (L - 1 - s) : s;
        const float* ur = u + (size_t)(t0 + t) * D + g * 16;
        float bur = 0.f, bui = 0.f;
#pragma unroll
        for (int h = 0; h < 16; ++h) { const float uv = ur[h]; bur += uv * Br[h]; bui += uv * Bi[h]; }
        const float nhr = ar * hr - ai * hi + bur, nhi = ar * hi + ai * hr + bui;
        hr = nhr; hi = nhi;
        float mine = 0.f;
#pragma unroll
        for (int c = 0; c < 16; ++c) { const float v = wave_sum(Cr[c] * hr - Ci[c] * hi); if (p == c) mine = v; }
        if (p < 16) yo[(size_t)(t0 + t) * D + g * 16 + p] = mine;
    }
}
__global__ void k_s5_gelu(const float* u, const float* ydir, const float* dskip, float* gout) {
    const size_t i = (size_t)blockIdx.x * blockDim.x + threadIdx.x;
    if (i >= (size_t)NT * D) return;
    const float y = dskip[i & (D - 1)] * u[i] + ydir[i] + ydir[(size_t)NT * D + i];
    const float c = 0.7978845608028654f * (y + 0.044715f * y * y * y);
    gout[i] = 0.5f * y * (1.f + tanhf(c));
}
__global__ void k_glu(const float* z1, const float* z2, float* out) {
    const size_t i = (size_t)blockIdx.x * blockDim.x + threadIdx.x;
    if (i >= (size_t)NT * D) return;
    out[i] = z1[i] / (1.f + expf(-z2[i]));
}
__global__ __launch_bounds__(256) void k_res_ln(const float* x, const float* h, const float* g, const float* b, float* xo, int rows) {
    const int row = blockIdx.x * 4 + (threadIdx.x >> 6), lane = threadIdx.x & 63;
    if (row >= rows) return;
    float v[16]; float s = 0.f;
#pragma unroll
    for (int j = 0; j < 16; ++j) { const size_t i = (size_t)row * D + lane + 64 * j; v[j] = ALPHA * x[i] + h[i]; s += v[j]; }
    const float mean = wave_sum(s) * (1.f / D); float q = 0.f;
#pragma unroll
    for (int j = 0; j < 16; ++j) { v[j] -= mean; q += v[j] * v[j]; }
    const float rstd = 1.f / sqrtf(wave_sum(q) * (1.f / D) + LN_EPS);
#pragma unroll
    for (int j = 0; j < 16; ++j) { const int c = lane + 64 * j; xo[(size_t)row * D + c] = v[j] * rstd * g[c] + b[c]; }
}
__global__ __launch_bounds__(256) void k_softmax256(float* s, float scale, int rows) {
    const int row = blockIdx.x * 4 + (threadIdx.x >> 6), lane = threadIdx.x & 63;
    if (row >= rows) return;
    float v[4]; float m = -INFINITY;
#pragma unroll
    for (int j = 0; j < 4; ++j) { v[j] = s[(size_t)row * 256 + lane + 64 * j] * scale; m = fmaxf(m, v[j]); }
    m = wave_max(m); float l = 0.f;
#pragma unroll
    for (int j = 0; j < 4; ++j) { v[j] = expf(v[j] - m); l += v[j]; }
    l = wave_sum(l);
#pragma unroll
    for (int j = 0; j < 4; ++j) s[(size_t)row * 256 + lane + 64 * j] = v[j] / l;
}
__global__ __launch_bounds__(256) void k_router(const float* x, const float* wr, float* aff, int rows) {
    const int row = blockIdx.x * 4 + (threadIdx.x >> 6), lane = threadIdx.x & 63;
    if (row >= rows) return;
    float acc[16];
#pragma unroll
    for (int e = 0; e < 16; ++e) acc[e] = 0.f;
    for (int j = 0; j < 16; ++j) { const int k = lane + 64 * j; const float xv = x[(size_t)row * D + k];
#pragma unroll
        for (int e = 0; e < 16; ++e) acc[e] += xv * wr[k * 16 + e]; }
    float m = -INFINITY;
#pragma unroll
    for (int e = 0; e < 16; ++e) { acc[e] = wave_sum(acc[e]); m = fmaxf(m, acc[e]); }
    float l = 0.f;
#pragma unroll
    for (int e = 0; e < 16; ++e) { acc[e] = expf(acc[e] - m); l += acc[e]; }
    float mine = 0.f;
#pragma unroll
    for (int e = 0; e < 16; ++e) if (lane == e) mine = acc[e] / l;
    if (lane < 16) aff[(size_t)row * 16 + lane] = mine;
}

__device__ __forceinline__ void select_expert(const float* aff, int n, int e, int cap, int* idx_out, float* gate_out, int* slot_of  , unsigned* hist  , unsigned* wsum  , unsigned* bc  ) {
    const int tid = threadIdx.x, nth = blockDim.x, lane = tid & 63, wv = tid >> 6, nw = nth >> 6;
    unsigned prefix = 0u, mask = 0u; unsigned remaining = (unsigned)cap;
    for (int pass = 0; pass < 4; ++pass) {
        const int shift = 24 - 8 * pass;
        for (int i = tid; i < 256; i += nth) hist[i] = 0u;
        __syncthreads();
        for (int t = tid; t < n; t += nth) { const unsigned key = __float_as_uint(aff[(size_t)t * 16 + e]); if ((key & mask) == prefix) atomicAdd(&hist[(key >> shift) & 255u], 1u); }
        __syncthreads();
        if (tid == 0) { unsigned cum = 0u; int b = 255; for (; b > 0; --b) { if (cum + hist[b] >= remaining) break; cum += hist[b]; } bc[0] = (unsigned)b; bc[1] = remaining - cum; }
        __syncthreads();
        prefix |= bc[0] << shift; mask |= 0xffu << shift; remaining = bc[1];
        __syncthreads();
    }
    const unsigned T = prefix; const unsigned need_eq = remaining;
    unsigned base = 0u, eqbase = 0u;
    for (int s0 = 0; s0 < n; s0 += nth) {
        const int t = s0 + tid; const bool in = t < n;
        const float a = in ? aff[(size_t)t * 16 + e] : 0.f; const unsigned key = __float_as_uint(a);
        const bool gt = in && key > T, eq = in && key == T;
        const unsigned long long meq = __ballot(eq); const unsigned eqr_w = __popcll(meq & ((1ull << lane) - 1ull));
        if (lane == 0) wsum[wv] = __popcll(meq);
        __syncthreads();
        unsigned eqoff = 0u, eqtot = 0u; for (int w = 0; w < nw; ++w) { const unsigned c = wsum[w]; if (w < wv) eqoff += c; eqtot += c; }
        __syncthreads();
        const bool sel = gt || (eq && (eqbase + eqoff + eqr_w) < need_eq);
        const unsigned long long ms = __ballot(sel); const unsigned sr_w = __popcll(ms & ((1ull << lane) - 1ull));
        if (lane == 0) wsum[wv] = __popcll(ms);
        __syncthreads();
        unsigned soff = 0u, stot = 0u; for (int w = 0; w < nw; ++w) { const unsigned c = wsum[w]; if (w < wv) soff += c; stot += c; }
        __syncthreads();
        if (sel) { const unsigned slot = base + soff + sr_w; if (slot < (unsigned)cap) { idx_out[slot] = t; gate_out[slot] = a; } }
        if (slot_of && in) slot_of[(size_t)t * 16 + e] = sel ? (int)(base + soff + sr_w) : -1;
        base += stot; eqbase += eqtot;
    }
}
__global__ __launch_bounds__(512) void k_select(const float* aff_all, int* idx_all, float* gate_all) {
    __shared__ unsigned hist[256]; __shared__ unsigned wsum[32]; __shared__ unsigned bc[4];
    const int grp = blockIdx.x >> 4, e = blockIdx.x & 15;
    const int n = grp ? NTS : NTP, cap = n / 8;
    const float* aff = aff_all + (size_t)(grp ? NTP : 0) * 16;
    int* idx = idx_all + (grp ? 16 * 4096 : 0) + e * cap; float* gate = gate_all + (grp ? 16 * 4096 : 0) + e * cap;
    select_expert(aff, n, e, cap, idx, gate, nullptr, hist, wsum, bc);
}
__global__ void k_silu_mul(float* h1, const float* h3, size_t n) {
    const size_t i = (size_t)blockIdx.x * blockDim.x + threadIdx.x; if (i >= n) return;
    const float a = h1[i]; h1[i] = a / (1.f + expf(-a)) * h3[i];
}
__global__ void k_scatter_add(const float* ye, const int* idx, const float* gate, float* out, int cap) {
    const size_t i = (size_t)blockIdx.x * blockDim.x + threadIdx.x; if (i >= (size_t)cap * D) return;
    const int slot = (int)(i >> 10), c = (int)(i & 1023);
    atomicAdd(&out[(size_t)idx[slot] * D + c], gate[slot] * ye[i]);
}

__global__ __launch_bounds__(256) void k_natten(float* q, const float* k, const float* v, const float* rpb) {
    const int wg = blockIdx.x * 4 + (threadIdx.x >> 6), lane = threadIdx.x & 63;
    const int tok = wg >> 4, h = wg & 15;
    if (tok >= NT) return;
    int gb, l; if (tok < NTP) { gb = tok >> 13; l = tok & 8191; } else { gb = 4 + ((tok - NTP) >> 12); l = (tok - NTP) & 4095; }
    const int rows = gb_len(gb) / GRID_W, t0 = gb_tok0(gb);
    const int r = l >> 6, qc = l & 63;
    int rs = r - 4; rs = rs < 0 ? 0 : (rs > rows - 8 ? rows - 8 : rs);
    int ws = qc - 8; ws = ws < 0 ? 0 : (ws > 48 ? 48 : ws);
    const float qv = q[(size_t)tok * D + h * 64 + lane] * 0.125f;
    float m = -INFINITY, lsum = 0.f, o = 0.f;
    for (int rr = 0; rr < 8; ++rr) {
        const int kr = rs + rr, dr = kr - r + 7;
        for (int cc = 0; cc < 16; ++cc) {
            const int kc = ws + cc; int dc = kc - qc + 15; dc = dc < 0 ? 0 : (dc > 30 ? 30 : dc);
            const size_t kt = (size_t)(t0 + kr * 64 + kc) * D + h * 64 + lane;
            const float s = wave_sum(qv * k[kt]) + rpb[(h * 15 + dr) * 31 + dc];
            const float mn = fmaxf(m, s), al = expf(m - mn), pp = expf(s - mn);
            lsum = lsum * al + pp; o = o * al + pp * v[kt]; m = mn;
        }
    }
    q[(size_t)tok * D + h * 64 + lane] = o / lsum;
}
}
#define LAS __attribute__((address_space(3)))
#define GAS __attribute__((address_space(1)))
namespace fz {
typedef unsigned short bf16_t;
typedef short bf16x8 __attribute__((ext_vector_type(8)));
typedef float f32x4 __attribute__((ext_vector_type(4)));
typedef float f32x2 __attribute__((ext_vector_type(2)));
typedef unsigned u32x4 __attribute__((ext_vector_type(4)));
typedef unsigned u32x2 __attribute__((ext_vector_type(2)));

constexpr int D = 1024, NTP = 32768, NTS = 16384, NT = NTP + NTS;
constexpr int TCH = 32, NCHUNK = NT / TCH;
constexpr int UAK = TCH * 16 + 256;
constexpr float ALPHA = 1.41421356237309515f, LN_EPS = 1e-5f;
constexpr size_t MiB = 1u << 20;
constexpr size_t WS_CTL = 0, WS_XF = 1 * MiB, WS_XB = 193 * MiB, WS_WIN = 289 * MiB, WS_WGLU = 291 * MiB, WS_WQKV = 295 * MiB, WS_WO = 301 * MiB, WS_MWQ = 303 * MiB,
                 WS_MWKV = 307 * MiB, WS_MWO = 315 * MiB, WS_MEMB = 319 * MiB, WS_KV = 323 * MiB, WS_WQK = 339 * MiB, WS_WVO = 371 * MiB, WS_AFF = 403 * MiB, WS_SLOT = 406 * MiB,
                 WS_IDX = 409 * MiB, WS_GATE = 409 * MiB + 512 * 1024, WS_EW13 = 411 * MiB, WS_EW2 = 539 * MiB, WS_POOL = 603 * MiB, WS_END = 1024 * MiB;
constexpr size_t PO_M2T = WS_POOL, PO_M13T = WS_POOL + 16 * MiB, PO_UA = WS_POOL + 64 * MiB, PO_SG = WS_POOL + 208 * MiB;
constexpr size_t PO_HB_S5 = PO_UA;
constexpr size_t PO_SB = WS_POOL, PO_HB_MEM = WS_POOL + 96 * MiB;
constexpr size_t PO_Q = WS_POOL, PO_K = WS_POOL + 96 * MiB, PO_VT = WS_POOL + 192 * MiB, PO_HB_NA = WS_POOL + 288 * MiB;
constexpr size_t PO_HM = WS_POOL, PO_YE = WS_POOL + 192 * MiB;
static_assert(PO_YE + 192 * MiB <= WS_END && PO_SG + 96 * MiB <= WS_END && PO_HB_NA + 96 * MiB <= WS_END, "pool");
constexpr int CW_TMO = 0, CW_BAR = 4096;
constexpr size_t CTL_ZERO_BYTES = 64 * 1024;
constexpr int RING_BYTES = 131072, MISC_OFF = RING_BYTES + 320, LDS_BYTES = 147456;

__host__ __device__ inline int gb_tok0(int gb) { return gb < 4 ? gb * 8192 : NTP + (gb - 4) * 4096; }
__host__ __device__ inline int gb_len(int gb) { return gb < 4 ? 8192 : 4096; }
__host__ __device__ inline int panel_gb(int pm) { return pm < 128 ? (pm >> 5) : 4 + ((pm - 128) >> 4); }

__device__ __forceinline__ unsigned cvt_pk_bf16(float lo, float hi) { unsigned r; asm volatile("v_cvt_pk_bf16_f32 %0, %1, %2" : "=v"(r) : "v"(lo), "v"(hi)); return r; }
__device__ __forceinline__ float bf2f(unsigned short b) { return __uint_as_float(((unsigned)b) << 16); }
__device__ __forceinline__ float wave_sum(float v) {
#pragma unroll
    for (int o = 1; o < 64; o <<= 1) v += __shfl_xor(v, o);
    return v;
}
__device__ __forceinline__ float wave_max(float v) {
#pragma unroll
    for (int o = 1; o < 64; o <<= 1) v = fmaxf(v, __shfl_xor(v, o));
    return v;
}
#define LDS_WAIT() asm volatile("s_waitcnt lgkmcnt(0)" ::: "memory")
#define VM_WAIT() asm volatile("s_waitcnt vmcnt(0)" ::: "memory")

#define XB_TMO      128
#define XB_XCNT(j)  (256  + 64 * (j))
#define XB_XSUB(j)  (1280 + 64 * (j))
#define XB_XGEN(j)  (2304 + 64 * (j))
#define XB_TOP      3328
#define XB_TOPGEN   3392
#define XCD_BAR_WORDS 3456
#define XB_SPIN_CAP (1u << 18)
__device__ __forceinline__ unsigned xb_ld(unsigned* p)              { return __hip_atomic_load(p, __ATOMIC_RELAXED, __HIP_MEMORY_SCOPE_AGENT); }
__device__ __forceinline__ unsigned xb_add(unsigned* p, unsigned v) { return __hip_atomic_fetch_add(p, v, __ATOMIC_RELAXED, __HIP_MEMORY_SCOPE_AGENT); }
__device__ __forceinline__ unsigned xb_xcc_id() { return (unsigned)__builtin_amdgcn_s_getreg((3 << 11) | 20) & 0xFu; }
#define XB_SPIN(cond, bar) do { unsigned _sp = 0; while (cond) { __builtin_amdgcn_s_sleep(1); \
    if ((++_sp & 255u) == 0u) { if (xb_ld(&(bar)[XB_TMO])) break; if (_sp > XB_SPIN_CAP) { atomicAdd(&(bar)[XB_TMO], 1u); break; } } } } while (0)
struct XcdBarrier { unsigned* bar; unsigned x; volatile LAS unsigned* st; };
__device__ __forceinline__ XcdBarrier xcd_barrier_post(unsigned* bar, volatile LAS unsigned* st) {
    XcdBarrier b; b.bar = bar; b.x = xb_xcc_id(); b.st = st;
    if (threadIdx.x == 0) (void)xb_add(&bar[XB_XCNT(b.x)], 1u);
    return b;
}
__device__ __forceinline__ void xcd_barrier_complete(unsigned* bar, unsigned x, unsigned& nloc, unsigned& nx) {
    const unsigned G = gridDim.x * gridDim.y * gridDim.z;
    unsigned sum, cnt, mine, sp = 0u;
    for (;;) {
        sum = 0u; cnt = 0u; mine = 0u;
#pragma unroll
        for (unsigned j = 0; j < 16; ++j) { const unsigned c = xb_ld(&bar[XB_XCNT(j)]); sum += c; cnt += (c > 0u) ? 1u : 0u; mine = (j == x) ? c : mine; }
        if (sum == G) break;
        __builtin_amdgcn_s_sleep(1);
        if ((++sp & 255u) == 0u) { if (xb_ld(&bar[XB_TMO])) break; if (sp > XB_SPIN_CAP) { atomicAdd(&bar[XB_TMO], 1u); break; } }
    }
    nloc = mine > 0u ? mine : 1u; nx = cnt > 0u ? cnt : 1u;
}
__device__ __forceinline__ void xcd_barrier(const XcdBarrier& b) {
    asm volatile("s_waitcnt vmcnt(0)" ::: "memory");
    __syncthreads();
    if (threadIdx.x == 0) {
        unsigned* bar = b.bar;
        __builtin_amdgcn_s_waitcnt(0);
        unsigned nloc = b.st[0], nx = b.st[1];
        if (nloc == 0u) { xcd_barrier_complete(bar, b.x, nloc, nx); b.st[0] = nloc; b.st[1] = nx; }
        const unsigned old = xb_add(&bar[XB_XSUB(b.x)], 1u);
        const unsigned gen = old / nloc;
        if (old + 1u == (gen + 1u) * nloc) {
            __builtin_amdgcn_fence(__ATOMIC_RELEASE, "agent");
            asm volatile("s_waitcnt vmcnt(0)" ::: "memory");
            const unsigned og = xb_add(&bar[XB_TOP], 1u);
            const unsigned tg = og / nx;
            if (og + 1u == (tg + 1u) * nx) xb_add(&bar[XB_TOPGEN], 1u);
            else XB_SPIN(xb_ld(&bar[XB_TOPGEN]) == tg, bar);
            __builtin_amdgcn_fence(__ATOMIC_ACQUIRE, "agent");
            xb_add(&bar[XB_XGEN(b.x)], 1u);
            asm volatile("s_waitcnt vmcnt(0)" ::: "memory");
        } else {
            XB_SPIN(xb_ld(&bar[XB_XGEN(b.x)]) == gen, bar);
            __builtin_amdgcn_fence(__ATOMIC_ACQUIRE, "agent");
            asm volatile("s_waitcnt vmcnt(0)" ::: "memory");
        }
    }
    __syncthreads();
}

constexpr int BM = 256, BK = 64, HALF = 128, HTB = HALF * BK * 2, STAGE_BYTES = 8 * HTB;
__host__ __device__ __forceinline__ int lds_byte(int r, int c) { const int st = (r >> 4) * 2 + (c >> 5), rr = r & 15, cc = c & 31, ob = rr * 64 + cc * 2; return st * 1024 + (ob ^ (((ob >> 9) & 1) << 5)); }
__host__ __device__ __forceinline__ void stage_rc(int b, int& R, int& C) { const int st = b / 1024, sb = b % 1024, swz = sb ^ (((sb >> 9) & 1) << 5); R = (st >> 1) * 16 + swz / 64; C = (st & 1) * 32 + (swz % 64) / 2; }
__host__ __device__ __forceinline__ int perm32(int rho) { const int n = rho >> 4, i = rho & 15; return 8 * (i >> 2) + 4 * n + (i & 3); }

struct GUnit { const char* A; const char* B; char* C; const void* X; int pm, pn; };
__device__ __forceinline__ bool static_unit(int i, int G, int c, int nM, int nN, int& pm, int& pn) {
    const long L = (long)i * G + c; const int nwg = nM * nN; if (L >= nwg) return false;
    int wgid = (int)L; { const int q = nwg / 8, r = nwg % 8, xcd = wgid % 8, off = wgid / 8; wgid = (xcd < r ? xcd * (q + 1) : r * (q + 1) + (xcd - r) * q) + off; }
    const int nig = 8 * nN, gid = wgid / nig, fm = gid * 8, gsz = (nM - fm) < 8 ? (nM - fm) : 8;
    pm = fm + ((wgid % nig) % gsz); pn = (wgid % nig) / gsz; return true;
}
template <class Epi, class Sched, bool GATHER>
__device__ __forceinline__ void gemm_phase(LAS unsigned char* lds, const int K, const unsigned lda, const unsigned ldb, const Sched& S, const Epi& E) {
    int tid_ = threadIdx.x; asm volatile("" : "+v"(tid_));
    const int tid = tid_, wid = __builtin_amdgcn_readfirstlane(tid >> 6), lane = tid & 63, wr = wid >> 2, wc = wid & 3, fr = lane & 15, fq = lane >> 4;
    int nt_ = K / BK; asm volatile("" : "+s"(nt_)); const int nt = nt_;
    unsigned voffA[2], voffB[2]; int gR[2], gC[2];
#pragma unroll
    for (int i = 0; i < 2; ++i) { int R, C; stage_rc(tid * 16 + i * 8192, R, C); const int Rb = Epi::PERM ? ((R & ~31) + perm32(R & 31)) : R;
        voffA[i] = (unsigned)R * lda + (unsigned)C * 2u; voffB[i] = (unsigned)Rb * ldb + (unsigned)C * 2u; gR[i] = R; gC[i] = C * 2; }
    const size_t kstep = (size_t)(BK * 2);
    const size_t hstepA = (size_t)HALF * lda, hstepB = (size_t)HALF * ldb;
    const unsigned ldsw = (unsigned)wid * 1024u;
    const int aoff = lds_byte(wr * 64 + fr, fq * 8), boff = lds_byte(wc * 32 + fr, fq * 8);
    unsigned cvo[2][2], nvo[2][2];
#define PG8_SA(b, h) (((b) * 2 + (h)) * HTB)
#define PG8_SB(b, h) ((4 + (b) * 2 + (h)) * HTB)
#define PG8_STAGE(bufoff, gbase, voff) do { _Pragma("unroll") for (int _i = 0; _i < 2; ++_i) \
        __builtin_amdgcn_global_load_lds((const unsigned*)((const char*)(gbase) + (voff)[_i]), (LAS unsigned*)(lds + (bufoff) + ldsw + _i * 8192), 16, 0, 0); } while (0)
#define PG8_STAGE_B(bufoff, ptr, h) PG8_STAGE(bufoff, (ptr) + (h) * hstepB, voffB)
#define PG8_STAGE_A(bufoff, ptr, h, vo) do { if constexpr (GATHER) { PG8_STAGE(bufoff, (ptr), (vo)[h]); } else { PG8_STAGE(bufoff, (ptr) + (h) * hstepA, voffA); } } while (0)
#define PG8_LDA(dst, b, h) do { _Pragma("unroll") for (int m = 0; m < 4; ++m) _Pragma("unroll") for (int k = 0; k < 2; ++k) dst[m][k] = *(const LAS bf16x8*)(lds + PG8_SA(b, h) + aoff + m * 2048 + k * 1024); } while (0)
#define PG8_LDB(dst, b, h) do { _Pragma("unroll") for (int n = 0; n < 2; ++n) _Pragma("unroll") for (int k = 0; k < 2; ++k) dst[n][k] = *(const LAS bf16x8*)(lds + PG8_SB(b, h) + boff + n * 2048 + k * 1024); } while (0)
#define PG8_MMA(ai, bj, At, Bt) do { __builtin_amdgcn_s_setprio(1); _Pragma("unroll") for (int m = 0; m < 4; ++m) _Pragma("unroll") for (int n = 0; n < 2; ++n) _Pragma("unroll") for (int k = 0; k < 2; ++k) \
        acc[ai][bj][m][n] = __builtin_amdgcn_mfma_f32_16x16x32_bf16(Bt[n][k], At[m][k], acc[ai][bj][m][n], 0, 0, 0); __builtin_amdgcn_s_setprio(0); } while (0)
#define PG8_WAIT_V(n) asm volatile("s_waitcnt vmcnt(" #n ")" ::: "memory")
#define PG8_WAIT_L(n) asm volatile("s_waitcnt lgkmcnt(" #n ")" ::: "memory")
#define PG8_BAR __builtin_amdgcn_s_barrier()
#define PG8_SCHED __builtin_amdgcn_sched_barrier(0)
#define PG8_GLOAD(vo, u) do { if constexpr (GATHER) { const int* _gi = (const int*)(u).X; _Pragma("unroll") for (int _h = 0; _h < 2; ++_h) _Pragma("unroll") for (int _i = 0; _i < 2; ++_i) \
        (vo)[_h][_i] = (unsigned)_gi[_h * HALF + gR[_i]] * lda + (unsigned)gC[_i]; } } while (0)
    GUnit cur, nxt; int ui = 0;
    if (!S.next(0, cur)) return;
    f32x4 acc[2][2][4][2];
#pragma unroll
    for (int a = 0; a < 2; ++a)
#pragma unroll
        for (int b = 0; b < 2; ++b)
#pragma unroll
            for (int m = 0; m < 4; ++m)
#pragma unroll
                for (int n = 0; n < 2; ++n) acc[a][b][m][n] = (f32x4){0.f, 0.f, 0.f, 0.f};
    bf16x8 At[4][2], B0[2][2], B1[2][2];
    const char* cA = cur.A; const char* cB = cur.B;
    PG8_GLOAD(cvo, cur);
    if constexpr (GATHER) { PG8_WAIT_V(0); }
    PG8_STAGE_B(PG8_SB(0, 0), cB, 0); PG8_STAGE_B(PG8_SB(0, 1), cB, 1); PG8_STAGE_A(PG8_SA(0, 0), cA, 0, cvo); PG8_STAGE_A(PG8_SA(0, 1), cA, 1, cvo);
    if (wr == 1) PG8_BAR;
    PG8_WAIT_V(2); PG8_BAR;
    PG8_STAGE_B(PG8_SB(1, 0), cB + kstep, 0); PG8_STAGE_A(PG8_SA(1, 0), cA + kstep, 0, cvo); PG8_STAGE_B(PG8_SB(1, 1), cB + kstep, 1);
    PG8_WAIT_V(6); PG8_BAR;
    for (;;) {
        const bool has_next = S.next(ui + 1, nxt);
        const char* nA = has_next ? nxt.A : cA; const char* nB = has_next ? nxt.B : cB;
        if constexpr (GATHER) { if (has_next) { PG8_GLOAD(nvo, nxt); } else {
#pragma unroll
            for (int h = 0; h < 2; ++h)
#pragma unroll
                for (int i = 0; i < 2; ++i) nvo[h][i] = cvo[h][i]; } }
        for (int t = 0; t < nt; t += 2) {
            const bool last = (t == nt - 2);
            const char* a1 = cA + (size_t)(t + 1) * kstep;
            const char* a2 = last ? nA : cA + (size_t)(t + 2) * kstep; const char* b2 = last ? nB : cB + (size_t)(t + 2) * kstep;
            const char* a3 = a2 + kstep; const char* b3 = b2 + kstep;
            unsigned vo2[2][2];
            if constexpr (GATHER) {
#pragma unroll
                for (int h = 0; h < 2; ++h)
#pragma unroll
                    for (int i = 0; i < 2; ++i) vo2[h][i] = last ? nvo[h][i] : cvo[h][i]; }
            PG8_LDB(B0, 0, 0); PG8_LDB(B1, 0, 1); PG8_SCHED; PG8_LDA(At, 0, 0); PG8_STAGE_A(PG8_SA(1, 1), a1, 1, cvo);
            PG8_WAIT_V(8); PG8_WAIT_L(0); PG8_BAR; PG8_MMA(0, 0, At, B0); PG8_MMA(0, 1, At, B1); PG8_BAR; PG8_SCHED;
            PG8_LDA(At, 0, 1); PG8_STAGE_B(PG8_SB(0, 0), b2, 0); PG8_STAGE_B(PG8_SB(0, 1), b2, 1); PG8_STAGE_A(PG8_SA(0, 0), a2, 0, vo2);
            PG8_WAIT_V(8); PG8_WAIT_L(0); PG8_BAR; PG8_MMA(1, 0, At, B0); PG8_MMA(1, 1, At, B1); PG8_BAR; PG8_SCHED;
            PG8_LDB(B0, 1, 0); PG8_LDB(B1, 1, 1); PG8_SCHED; PG8_LDA(At, 1, 0); PG8_STAGE_A(PG8_SA(0, 1), a2, 1, vo2);
            PG8_WAIT_V(8); PG8_WAIT_L(0); PG8_BAR; PG8_MMA(0, 0, At, B0); PG8_MMA(0, 1, At, B1); PG8_BAR; PG8_SCHED;
            PG8_LDA(At, 1, 1); PG8_STAGE_B(PG8_SB(1, 0), b3, 0); PG8_STAGE_B(PG8_SB(1, 1), b3, 1); PG8_STAGE_A(PG8_SA(1, 0), a3, 0, vo2);
            PG8_WAIT_V(8); PG8_WAIT_L(0); PG8_BAR; PG8_MMA(1, 0, At, B0); PG8_MMA(1, 1, At, B1); PG8_BAR; PG8_SCHED;
        }
        if (wr == 0) PG8_BAR;
        E(acc, cur, wr, wc, fr, fq);
        if (!has_next) break;
#pragma unroll
        for (int a = 0; a < 2; ++a)
#pragma unroll
            for (int b = 0; b < 2; ++b)
#pragma unroll
                for (int m = 0; m < 4; ++m)
#pragma unroll
                    for (int n = 0; n < 2; ++n) acc[a][b][m][n] = (f32x4){0.f, 0.f, 0.f, 0.f};
        cur = nxt; cA = nA; cB = nB; ++ui;
        if constexpr (GATHER) {
#pragma unroll
            for (int h = 0; h < 2; ++h)
#pragma unroll
                for (int i = 0; i < 2; ++i) cvo[h][i] = nvo[h][i]; }
        if (wr == 1) PG8_BAR;
    }
    PG8_WAIT_V(0);
    PG8_BAR;
#undef PG8_SA
#undef PG8_SB
#undef PG8_STAGE
#undef PG8_STAGE_A
#undef PG8_STAGE_B
#undef PG8_LDA
#undef PG8_LDB
#undef PG8_MMA
#undef PG8_WAIT_V
#undef PG8_WAIT_L
#undef PG8_BAR
#undef PG8_SCHED
#undef PG8_GLOAD
}
typedef f32x4 Acc[2][2][4][2];
__device__ __forceinline__ float sigmoidf_fast(float x) { return __builtin_amdgcn_rcpf(1.f + __builtin_amdgcn_exp2f(-1.4426950408889634f * x)); }
__device__ __forceinline__ float gelu_tanh_fast(float y) {
    const float inner = 1.5957691216057308f * (y + 0.044715f * y * y * y);
    return y * sigmoidf_fast(inner);
}
template <bool ROWSCALE> struct EpiBf {
    static constexpr bool PERM = true;
    unsigned ldc; float scale;
    __device__ __forceinline__ void operator()(const Acc& acc, const GUnit& u, int wr, int wc, int fr, int fq) const {
        bf16_t* base = (bf16_t*)u.C; const float* rs = (const float*)u.X;
#pragma unroll
        for (int ai = 0; ai < 2; ++ai)
#pragma unroll
            for (int m = 0; m < 4; ++m) { const int r = ai * HALF + wr * 64 + m * 16 + fr; float s = scale; if (ROWSCALE) s *= rs[r];
                bf16_t* rowp = base + (size_t)r * ldc + wc * 32 + 8 * fq;
#pragma unroll
                for (int bj = 0; bj < 2; ++bj) { const f32x4 v0 = acc[ai][bj][m][0] * s, v1 = acc[ai][bj][m][1] * s;
                    u32x4 w; w.x = cvt_pk_bf16(v0[0], v0[1]); w.y = cvt_pk_bf16(v0[2], v0[3]); w.z = cvt_pk_bf16(v1[0], v1[1]); w.w = cvt_pk_bf16(v1[2], v1[3]);
                    *(u32x4*)(rowp + bj * HALF) = w; } }
    }
};
template <int MODE> struct EpiGated {
    static constexpr bool PERM = true;
    unsigned ldc;
    __device__ __forceinline__ void operator()(const Acc& acc, const GUnit& u, int wr, int wc, int fr, int fq) const {
        bf16_t* base = (bf16_t*)u.C;
#pragma unroll
        for (int ai = 0; ai < 2; ++ai)
#pragma unroll
            for (int m = 0; m < 4; ++m) { const int r = ai * HALF + wr * 64 + m * 16 + fr;
                float o[8];
#pragma unroll
                for (int n = 0; n < 2; ++n)
#pragma unroll
                    for (int j = 0; j < 4; ++j) { const float a = acc[ai][0][m][n][j], b = acc[ai][1][m][n][j];
                        o[n * 4 + j] = (MODE == 0) ? a * sigmoidf_fast(b) : a * sigmoidf_fast(a) * b; }
                u32x4 w; w.x = cvt_pk_bf16(o[0], o[1]); w.y = cvt_pk_bf16(o[2], o[3]); w.z = cvt_pk_bf16(o[4], o[5]); w.w = cvt_pk_bf16(o[6], o[7]);
                *(u32x4*)(base + (size_t)r * ldc + wc * 32 + 8 * fq) = w; }
    }
};
struct EpiUA {
    static constexpr bool PERM = true;
    __device__ __forceinline__ void operator()(const Acc& acc, const GUnit& u, int wr, int wc, int fr, int fq) const {
        bf16_t* UA = (bf16_t*)u.C;
#pragma unroll
        for (int ai = 0; ai < 2; ++ai)
#pragma unroll
            for (int m = 0; m < 4; ++m) { const int tok = u.pm * BM + ai * HALF + wr * 64 + m * 16 + fr; const int chunk = tok >> 5, j = tok & 31;
#pragma unroll
                for (int bj = 0; bj < 2; ++bj) { const int ch = u.pn * BM + bj * HALF + wc * 32 + 8 * fq, g = ch >> 4, h0 = ch & 15;
                    const f32x4 v0 = acc[ai][bj][m][0], v1 = acc[ai][bj][m][1];
                    u32x4 w; w.x = cvt_pk_bf16(v0[0], v0[1]); w.y = cvt_pk_bf16(v0[2], v0[3]); w.z = cvt_pk_bf16(v1[0], v1[1]); w.w = cvt_pk_bf16(v1[2], v1[3]);
                    *(u32x4*)(UA + ((size_t)chunk * 64 + g) * UAK + j * 16 + h0) = w; } }
    }
};
struct EpiS {
    static constexpr bool PERM = false;
    __device__ __forceinline__ void operator()(const Acc& acc, const GUnit& u, int wr, int wc, int fr, int fq) const {
        float* Sg = (float*)u.C;
#pragma unroll
        for (int ai = 0; ai < 2; ++ai)
#pragma unroll
            for (int m = 0; m < 4; ++m) { const int chunk = u.pm * BM + ai * HALF + wr * 64 + m * 16 + fr; float* rowp = Sg + (size_t)chunk * (64 * 256) + wc * 32 + 4 * fq;
#pragma unroll
                for (int bj = 0; bj < 2; ++bj)
#pragma unroll
                    for (int n = 0; n < 2; ++n) *(f32x4*)(rowp + bj * HALF + n * 16) = acc[ai][bj][m][n]; }
    }
};
struct EpiGelu {
    static constexpr bool PERM = true;
    __device__ __forceinline__ void operator()(const Acc& acc, const GUnit& u, int wr, int wc, int fr, int fq) const {
        bf16_t* Gg = (bf16_t*)u.C;
#pragma unroll
        for (int ai = 0; ai < 2; ++ai)
#pragma unroll
            for (int m = 0; m < 4; ++m) { const int chunk = u.pm * BM + ai * HALF + wr * 64 + m * 16 + fr;
#pragma unroll
                for (int bj = 0; bj < 2; ++bj) { const int n0 = u.pn * BM + bj * HALF + wc * 32 + 8 * fq, i = n0 >> 4, c0 = n0 & 15;
                    const f32x4 v0 = acc[ai][bj][m][0], v1 = acc[ai][bj][m][1];
                    u32x4 w; w.x = cvt_pk_bf16(gelu_tanh_fast(v0[0]), gelu_tanh_fast(v0[1])); w.y = cvt_pk_bf16(gelu_tanh_fast(v0[2]), gelu_tanh_fast(v0[3]));
                    w.z = cvt_pk_bf16(gelu_tanh_fast(v1[0]), gelu_tanh_fast(v1[1])); w.w = cvt_pk_bf16(gelu_tanh_fast(v1[2]), gelu_tanh_fast(v1[3]));
                    *(u32x4*)(Gg + ((size_t)chunk * TCH + i) * D + c0) = w; } }
    }
};

struct Ctx { unsigned char* ws; int G, c; };
struct SchedPlain { const char* A; const char* B; char* C; size_t lda, ldb, ldc; int nM, nN, G, c;
    __device__ __forceinline__ bool next(int i, GUnit& u) const { int pm, pn; if (!static_unit(i, G, c, nM, nN, pm, pn)) return false;
        u.A = A + (size_t)pm * BM * lda; u.B = B + (size_t)pn * BM * ldb; u.C = C + ((size_t)pm * BM * ldc + (size_t)pn * BM) * 2; u.X = nullptr; u.pm = pm; u.pn = pn; return true; } };
struct SchedGated { const char* A; const char* B; char* C; size_t lda, ldb, ldc; int nM, nN, G, c;
    __device__ __forceinline__ bool next(int i, GUnit& u) const { int pm, pn; if (!static_unit(i, G, c, nM, nN, pm, pn)) return false;
        u.A = A + (size_t)pm * BM * lda; u.B = B + (size_t)pn * BM * ldb; u.C = C + ((size_t)pm * BM * ldc + (size_t)pn * HALF) * 2; u.X = nullptr; u.pm = pm; u.pn = pn; return true; } };
struct SchedUA { const char* A; const char* B; char* UA; int G, c;
    __device__ __forceinline__ bool next(int i, GUnit& u) const { int pm, pn; if (!static_unit(i, G, c, NT / BM, D / BM, pm, pn)) return false;
        u.A = A + (size_t)pm * BM * (D * 2); u.B = B + (size_t)pn * BM * (D * 2); u.C = UA; u.X = nullptr; u.pm = pm; u.pn = pn; return true; } };
struct SchedKV { unsigned char* ws; int G, c;
    __device__ __forceinline__ bool next(int i, GUnit& u) const { const int L = i * G + c; if (L >= 128) return false; const int layer = L >> 6, r = L & 63, pm = r >> 3, pn = r & 7;
        u.A = (const char*)ws + WS_MEMB + (size_t)pm * BM * 2048; u.B = (const char*)ws + WS_MWKV + (size_t)layer * 4 * MiB + (size_t)pn * BM * 2048;
        u.C = (char*)ws + WS_KV + (size_t)layer * 8 * MiB + ((size_t)pm * BM * 2048 + pn * BM) * 2; u.X = nullptr; u.pm = pm; u.pn = pn; return true; } };
struct SchedSA { unsigned char* ws; int G, c;
    __device__ __forceinline__ bool next(int i, GUnit& u) const { const int L = i * G + c; if (L >= 64 * 6) return false; const int g = L / 6, pm = L % 6;
        u.A = (const char*)ws + PO_UA + (size_t)pm * BM * (64 * UAK * 2) + (size_t)g * UAK * 2; u.B = (const char*)ws + PO_M2T + (size_t)g * 256 * 512 * 2;
        u.C = (char*)ws + PO_SG + (size_t)g * 256 * 4; u.X = nullptr; u.pm = pm; u.pn = 0; return true; } };
struct SchedSC { unsigned char* ws; int G, c;
    __device__ __forceinline__ bool next(int i, GUnit& u) const { const int L = i * G + c; if (L >= 64 * 12) return false; const int g = L / 12, r = L % 12, pm = r >> 1, pn = r & 1;
        u.A = (const char*)ws + PO_UA + (size_t)pm * BM * (64 * UAK * 2) + (size_t)g * UAK * 2; u.B = (const char*)ws + PO_M13T + ((size_t)g * 512 + pn * BM) * UAK * 2;
        u.C = (char*)ws + PO_SG + (size_t)g * 16 * 2; u.X = nullptr; u.pm = pm; u.pn = pn; return true; } };
struct SchedWqk { unsigned char* ws; int G, c;
    __device__ __forceinline__ bool next(int i, GUnit& u) const { const int L = i * G + c; if (L >= 256) return false; const int pn = L & 3, h = (L >> 2) & 3, gb = (L >> 4) & 7, layer = L >> 7;
        u.A = (const char*)ws + WS_KV + (size_t)layer * 8 * MiB + ((size_t)gb * 256 * 2048 + h * 256) * 2; u.B = (const char*)ws + WS_MWQ + (size_t)layer * 2 * MiB + ((size_t)pn * BM * 1024 + h * 256) * 2;
        u.C = (char*)ws + WS_WQK + ((size_t)(layer * 8 + gb) * 1024 * 1024 + (size_t)h * 256 * 1024 + pn * BM) * 2; u.X = nullptr; u.pm = 0; u.pn = pn; return true; } };
struct SchedWvo { unsigned char* ws; int G, c;
    __device__ __forceinline__ bool next(int i, GUnit& u) const { const int L = i * G + c; if (L >= 256) return false; const int pm = L & 3, h = (L >> 2) & 3, gb = (L >> 4) & 7, layer = L >> 7;
        u.A = (const char*)ws + WS_MWO + (size_t)layer * 2 * MiB + ((size_t)pm * BM * 1024 + h * 256) * 2; u.B = (const char*)ws + WS_KV + (size_t)layer * 8 * MiB + ((size_t)gb * 256 * 2048 + 1024 + h * 256) * 2;
        u.C = (char*)ws + WS_WVO + ((size_t)(layer * 8 + gb) * 1024 * 1024 + (size_t)pm * BM * 1024 + h * 256) * 2; u.X = nullptr; u.pm = pm; u.pn = 0; return true; } };
struct SchedBatchW { const char* A; const char* Bl; char* C; int G, c;
    __device__ __forceinline__ bool next(int i, GUnit& u) const { int pm, pn; if (!static_unit(i, G, c, NT / BM, 4, pm, pn)) return false; const int gb = panel_gb(pm);
        u.A = A + (size_t)pm * BM * 2048; u.B = Bl + ((size_t)gb * 1024 + pn * BM) * 2048; u.C = C + ((size_t)pm * BM * 1024 + pn * BM) * 2; u.X = nullptr; u.pm = pm; u.pn = pn; return true; } };
struct Args { const float* in[26]; float* out; unsigned char* ws; int ph_lo, ph_hi, flags, pad; };
struct Frame {
    LAS unsigned char* lds; unsigned char* ws; const float* const* in; float* out;
    int tid, lane, wave, G, c;
};
enum { I_XP = 0, I_XS, I_MEMP, I_MEMS, I_AWIN, I_ALRE, I_ALIM, I_ALDT, I_ABRE, I_ABIM, I_ACRE, I_ACIM, I_AD, I_AWGLU, I_BWQKV, I_BRPB, I_BWO, I_MWQ, I_MWKV, I_MWO, I_EWR, I_EW1, I_EW3, I_EW2, I_LNG, I_LNB };

__device__ __forceinline__ int rowmap(int mode, int n) {
    if (mode == 0) return n;
    if (mode == 1) { const int z = n >> 10, nn = n & 1023; return ((nn >> 7) << 8) + (z << 7) + (nn & 127); }
    return ((n >> 7) << 8) + ((mode == 3) ? 128 : 0) + (n & 127);
}
__device__ __forceinline__ void transpose_item(const float* W, int K, int N, bf16_t* WT, int mode, LAS float* scr, int item, int lane) {
    const int nblk = N / 32, kb = item / nblk, nb = item % nblk, k0 = 64 * kb, n0 = 32 * nb;
#pragma unroll 8
    for (int i = 0; i < 32; ++i) { const int kk = 2 * i + (lane >> 5); scr[kk * 33 + (lane & 31)] = W[(size_t)(k0 + kk) * N + n0 + (lane & 31)]; }
    LDS_WAIT(); asm volatile("" ::: "memory");
    const int c = lane & 7;
#pragma unroll
    for (int j = 0; j < 4; ++j) { const int n = (lane >> 3) + 8 * j; const LAS float* s = scr + (8 * c) * 33 + n;
        u32x4 o; o.x = cvt_pk_bf16(s[0 * 33], s[1 * 33]); o.y = cvt_pk_bf16(s[2 * 33], s[3 * 33]); o.z = cvt_pk_bf16(s[4 * 33], s[5 * 33]); o.w = cvt_pk_bf16(s[6 * 33], s[7 * 33]);
        *(u32x4*)(WT + (size_t)rowmap(mode, n0 + n) * K + k0 + 8 * c) = o; }
    LDS_WAIT(); asm volatile("" ::: "memory");
}
__device__ __forceinline__ void convert_small_weights(Frame& F) {
    LAS float* scr = (LAS float*)(F.lds + F.wave * 16384);
    const int gw = F.c * 8 + F.wave, NGW = F.G * 8;
    for (int it = gw; it < 6656; it += NGW) {
        int r = it;
        if (r < 512) { transpose_item(F.in[I_AWIN], 1024, 1024, (bf16_t*)(F.ws + WS_WIN), 0, scr, r, F.lane); continue; } r -= 512;
        if (r < 1024) { transpose_item(F.in[I_AWGLU], 1024, 2048, (bf16_t*)(F.ws + WS_WGLU), 1, scr, r, F.lane); continue; } r -= 1024;
        if (r < 1536) { transpose_item(F.in[I_BWQKV], 1024, 3072, (bf16_t*)(F.ws + WS_WQKV), 0, scr, r, F.lane); continue; } r -= 1536;
        if (r < 512) { transpose_item(F.in[I_BWO], 1024, 1024, (bf16_t*)(F.ws + WS_WO), 0, scr, r, F.lane); continue; } r -= 512;
        if (r < 2048) { const int l = r >> 10; transpose_item(F.in[I_MWKV] + (size_t)l * 1024 * 2048, 1024, 2048, (bf16_t*)(F.ws + WS_MWKV + (size_t)l * 4 * MiB), 0, scr, r & 1023, F.lane); continue; } r -= 2048;
        { const int l = r >> 9; transpose_item(F.in[I_MWO] + (size_t)l * 1024 * 1024, 1024, 1024, (bf16_t*)(F.ws + WS_MWO + (size_t)l * 2 * MiB), 0, scr, r & 511, F.lane); }
    }
}
__device__ __forceinline__ void convert_expert_weights(Frame& F, int layer) {
    LAS float* scr = (LAS float*)(F.lds + F.wave * 16384);
    const int gw = F.c * 8 + F.wave, NGW = F.G * 8;
    for (int it = gw; it < 16 * 3072; it += NGW) {
        const int e = it / 3072; int r = it % 3072;
        const size_t wofs = ((size_t)layer * 16 + e) * 1024 * 2048;
        if (r < 1024) { transpose_item(F.in[I_EW1] + wofs, 1024, 2048, (bf16_t*)(F.ws + WS_EW13 + (size_t)e * 8 * MiB), 2, scr, r, F.lane); continue; } r -= 1024;
        if (r < 1024) { transpose_item(F.in[I_EW3] + wofs, 1024, 2048, (bf16_t*)(F.ws + WS_EW13 + (size_t)e * 8 * MiB), 3, scr, r, F.lane); continue; } r -= 1024;
        transpose_item(F.in[I_EW2] + wofs, 2048, 1024, (bf16_t*)(F.ws + WS_EW2 + (size_t)e * 4 * MiB), 0, scr, r, F.lane);
    }
}
__device__ __forceinline__ void convert_plain(Frame& F, const float* src, bf16_t* dst, size_t n) {
    const size_t n4 = n / 4;
    for (size_t i = (size_t)F.c * 512 + F.tid; i < n4; i += (size_t)F.G * 512) { const f32x4 v = ((const f32x4*)src)[i]; u32x2 w; w.x = cvt_pk_bf16(v[0], v[1]); w.y = cvt_pk_bf16(v[2], v[3]); ((u32x2*)dst)[i] = w; }
}
__device__ __forceinline__ void import_x(Frame& F, bool copy_f32) {
    const size_t n4 = (size_t)NT * D / 4, np4 = (size_t)NTP * D / 4;
    f32x4* XF = (f32x4*)(F.ws + WS_XF); u32x2* XB = (u32x2*)(F.ws + WS_XB);
    for (size_t i = (size_t)F.c * 512 + F.tid; i < n4; i += (size_t)F.G * 512) {
        f32x4 v;
        if (copy_f32) { v = (i < np4) ? ((const f32x4*)F.in[I_XP])[i] : ((const f32x4*)F.in[I_XS])[i - np4]; XF[i] = v; } else v = XF[i];
        u32x2 w; w.x = cvt_pk_bf16(v[0], v[1]); w.y = cvt_pk_bf16(v[2], v[3]); XB[i] = w; }
}

__device__ __forceinline__ void s5_lam(const float* lre, const float* lim, const float* ldt, int dir, int g, int p, double& dt, double& lr, double& li) {
    dt = exp((double)ldt[dir * 64 + g]); lr = (double)lre[(dir * 64 + g) * 64 + p]; li = (double)lim[(dir * 64 + g) * 64 + p];
}
__device__ __forceinline__ void s5_fill_bc(Frame& F, int g, int dir, LAS float* Bbr, LAS float* Bbi, LAS float* Cr, LAS float* Ci) {
    for (int idx = F.tid; idx < 1024; idx += 512) {
        const int p = idx >> 4, h = idx & 15; double dt, lr, li; s5_lam(F.in[I_ALRE], F.in[I_ALIM], F.in[I_ALDT], dir, g, p, dt, lr, li);
        const double er = exp(lr * dt), lbr = er * cos(li * dt), lbi = er * sin(li * dt), nr = lbr - 1.0, ni = lbi, den = lr * lr + li * li;
        const double fr = (nr * lr + ni * li) / den, fi = (ni * lr - nr * li) / den;
        const double br = F.in[I_ABRE][((dir * 64 + g) * 64 + p) * 16 + h], bi = F.in[I_ABIM][((dir * 64 + g) * 64 + p) * 16 + h];
        Bbr[idx] = (float)(fr * br - fi * bi); Bbi[idx] = (float)(fr * bi + fi * br);
        Cr[idx] = F.in[I_ACRE][(dir * 64 + g) * 1024 + idx]; Ci[idx] = F.in[I_ACIM][(dir * 64 + g) * 1024 + idx];
    }
}
__device__ __forceinline__ void s5_build_item(Frame& F, int g, int dir) {
    LAS float* LPr = (LAS float*)F.lds; LAS float* LPi = LPr + 33 * 64;
    LAS float* Bbr = LPi + 33 * 64; LAS float* Bbi = Bbr + 1024; LAS float* Cr = Bbi + 1024; LAS float* Ci = Cr + 1024;
    LAS float* B2r = Ci + 1024; LAS float* B2i = B2r + 1024; LAS float* C2r = B2i + 1024; LAS float* C2i = C2r + 1024;
    bf16_t* M2T = (bf16_t*)(F.ws + PO_M2T) + (size_t)g * 256 * 512; bf16_t* M13T = (bf16_t*)(F.ws + PO_M13T) + (size_t)g * 512 * UAK;
    __syncthreads();
    for (int idx = F.tid; idx < 33 * 64; idx += 512) { const int e = idx >> 6, p = idx & 63; double dt, lr, li; s5_lam(F.in[I_ALRE], F.in[I_ALIM], F.in[I_ALDT], dir, g, p, dt, lr, li);
        const double er = exp(lr * dt * e); LPr[idx] = (float)(er * cos(li * dt * e)); LPi[idx] = (float)(er * sin(li * dt * e)); }
    s5_fill_bc(F, g, dir, Bbr, Bbi, Cr, Ci);
    if (dir == 0) s5_fill_bc(F, g, 1, B2r, B2i, C2r, C2i);
    __syncthreads();
    {
        const int k = F.tid, j = k >> 4, h = k & 15, e = dir == 0 ? (TCH - 1 - j) : j;
        for (int p = 0; p < 64; ++p) { const float lr = LPr[e * 64 + p], li = LPi[e * 64 + p], br = Bbr[p * 16 + h], bi = Bbi[p * 16 + h];
            const float xr = lr * br - li * bi, xi = lr * bi + li * br;
            M2T[(size_t)(dir * 128 + p) * 512 + k] = (bf16_t)(cvt_pk_bf16(xr, 0.f) & 0xffffu); M2T[(size_t)(dir * 128 + 64 + p) * 512 + k] = (bf16_t)(cvt_pk_bf16(xi, 0.f) & 0xffffu); }
    }
    {
        const int p = F.tid & 63, q8 = F.tid >> 6;
        for (int ic = q8; ic < 512; ic += 8) { const int i = ic >> 4, c = ic & 15, e = dir == 0 ? (i + 1) : (TCH - i);
            const float cr = Cr[c * 64 + p], ci = Ci[c * 64 + p], lr = LPr[e * 64 + p], li = LPi[e * 64 + p];
            const float vr = cr * lr - ci * li, vi = cr * li + ci * lr;
            M13T[(size_t)ic * UAK + 512 + dir * 128 + p] = (bf16_t)(cvt_pk_bf16(vr, 0.f) & 0xffffu); M13T[(size_t)ic * UAK + 512 + dir * 128 + 64 + p] = (bf16_t)(cvt_pk_bf16(-vi, 0.f) & 0xffffu); }
    }
    {
        const int ch = F.tid & 255, c = ch >> 4, h = ch & 15, par = F.tid >> 8;
        for (int d = 1 + par; d < TCH; d += 2) {
            float s = 0.f;
            for (int p = 0; p < 64; ++p) { const float lr = LPr[d * 64 + p], li = LPi[d * 64 + p], br = Bbr[p * 16 + h], bi = Bbi[p * 16 + h];
                s += Cr[c * 64 + p] * (lr * br - li * bi) - Ci[c * 64 + p] * (lr * bi + li * br); }
            const bf16_t v = (bf16_t)(cvt_pk_bf16(s, 0.f) & 0xffffu);
            for (int t = 0; t + d < TCH; ++t) { const int i = dir == 0 ? t + d : t, j = dir == 0 ? t : t + d; M13T[(size_t)(i * 16 + c) * UAK + j * 16 + h] = v; }
        }
        if (dir == 0 && par == 0) {
            float s = (c == h) ? F.in[I_AD][g * 16 + c] : 0.f;
            for (int p = 0; p < 64; ++p) s += Cr[c * 64 + p] * Bbr[p * 16 + h] - Ci[c * 64 + p] * Bbi[p * 16 + h] + C2r[c * 64 + p] * B2r[p * 16 + h] - C2i[c * 64 + p] * B2i[p * 16 + h];
            const bf16_t v = (bf16_t)(cvt_pk_bf16(s, 0.f) & 0xffffu);
            for (int t = 0; t < TCH; ++t) M13T[(size_t)(t * 16 + c) * UAK + t * 16 + h] = v;
        }
    }
    __syncthreads();
}

__device__ __forceinline__ void s5_recurrence(Frame& F) {
    const float* S = (const float*)(F.ws + PO_SG); bf16_t* UA = (bf16_t*)(F.ws + PO_UA);
    for (int base = F.c * 256; base < 65536; base += F.G * 256) {
        if (F.tid >= 256) continue;
        const int flat = base + F.tid, p = flat & 63, dir = (flat >> 6) & 1, g = (flat >> 7) & 63, gb = flat >> 13;
        double dt, lr, li; s5_lam(F.in[I_ALRE], F.in[I_ALIM], F.in[I_ALDT], dir, g, p, dt, lr, li);
        const double er = exp(lr * dt * TCH); const float ar = (float)(er * cos(li * dt * TCH)), ai = (float)(er * sin(li * dt * TCH));
        const int nc = gb < 4 ? 256 : 128, chunk0 = gb < 4 ? gb * 256 : 1024 + (gb - 4) * 128;
        float hr = 0.f, hi = 0.f;
        for (int s0 = 0; s0 < nc; s0 += 8) {
            float sr[8], si[8];
#pragma unroll
            for (int k = 0; k < 8; ++k) { const int cc = dir == 0 ? (s0 + k) : (nc - 1 - s0 - k); const size_t o = ((size_t)(chunk0 + cc) * 64 + g) * 256 + dir * 128 + p; sr[k] = S[o]; si[k] = S[o + 64]; }
#pragma unroll
            for (int k = 0; k < 8; ++k) { const int cc = dir == 0 ? (s0 + k) : (nc - 1 - s0 - k); const size_t o = ((size_t)(chunk0 + cc) * 64 + g) * UAK + 512 + dir * 128 + p;
                UA[o] = (bf16_t)(cvt_pk_bf16(hr, 0.f) & 0xffffu); UA[o + 64] = (bf16_t)(cvt_pk_bf16(hi, 0.f) & 0xffffu);
                const float nr = ar * hr - ai * hi + sr[k], ni = ar * hi + ai * hr + si[k]; hr = nr; hi = ni; }
        }
    }
}

template <int MODE, bool ROUTER, bool FINAL>
__device__ __forceinline__ void ln_phase(Frame& F, const bf16_t* HB, const float* gam, const float* bet, const float* wrouter) {
    float* XF = (float*)(F.ws + WS_XF); bf16_t* XB = (bf16_t*)(F.ws + WS_XB);
    LAS float* wrT = (LAS float*)F.lds;
    if (ROUTER) { __syncthreads(); for (int i = F.tid; i < 16384; i += 512) { const int k = i >> 4, e = i & 15; wrT[e * 1024 + k] = wrouter[i]; } __syncthreads(); }
    f32x4 gv[4], bv[4];
#pragma unroll
    for (int j = 0; j < 4; ++j) { gv[j] = *(const f32x4*)(gam + F.lane * 4 + 256 * j); bv[j] = *(const f32x4*)(bet + F.lane * 4 + 256 * j); }
    const bf16_t* YE = (const bf16_t*)(F.ws + PO_YE); const int* SLOT = (const int*)(F.ws + WS_SLOT);
    for (int row = F.c * 8 + F.wave; row < NT; row += F.G * 8) {
        f32x4 v[4];
#pragma unroll
        for (int j = 0; j < 4; ++j) v[j] = *(const f32x4*)(XF + (size_t)row * D + F.lane * 4 + 256 * j) * ALPHA;
        if (MODE == 0) {
#pragma unroll
            for (int j = 0; j < 4; ++j) { const u32x2 w = *(const u32x2*)(HB + (size_t)row * D + F.lane * 4 + 256 * j);
                v[j][0] += __uint_as_float(w.x << 16); v[j][1] += __uint_as_float(w.x & 0xffff0000u); v[j][2] += __uint_as_float(w.y << 16); v[j][3] += __uint_as_float(w.y & 0xffff0000u); }
        } else {
            const int grp = row >= NTP; const int sl = (F.lane < 16) ? SLOT[(size_t)row * 16 + F.lane] : -1;
            unsigned long long mask = __ballot(sl >= 0);
            while (mask) { const int e = __builtin_ctzll(mask); mask &= mask - 1; const int s = __builtin_amdgcn_readlane(sl, e);
                const size_t yr = grp ? (size_t)65536 + e * 2048 + s : (size_t)e * 4096 + s;
#pragma unroll
                for (int j = 0; j < 4; ++j) { const u32x2 w = *(const u32x2*)(YE + yr * D + F.lane * 4 + 256 * j);
                    v[j][0] += __uint_as_float(w.x << 16); v[j][1] += __uint_as_float(w.x & 0xffff0000u); v[j][2] += __uint_as_float(w.y << 16); v[j][3] += __uint_as_float(w.y & 0xffff0000u); } }
        }
        float s = 0.f;
#pragma unroll
        for (int j = 0; j < 4; ++j) s += (v[j][0] + v[j][1]) + (v[j][2] + v[j][3]);
        const float mean = wave_sum(s) * (1.f / D); float q = 0.f;
#pragma unroll
        for (int j = 0; j < 4; ++j) { v[j] = v[j] - mean; q += (v[j][0] * v[j][0] + v[j][1] * v[j][1]) + (v[j][2] * v[j][2] + v[j][3] * v[j][3]); }
        const float rstd = 1.f / sqrtf(wave_sum(q) * (1.f / D) + LN_EPS);
#pragma unroll
        for (int j = 0; j < 4; ++j) v[j] = v[j] * rstd * gv[j] + bv[j];
        if (FINAL) {
#pragma unroll
            for (int j = 0; j < 4; ++j) *(f32x4*)(F.out + (size_t)row * D + F.lane * 4 + 256 * j) = v[j];
        } else {
#pragma unroll
            for (int j = 0; j < 4; ++j) { *(f32x4*)(XF + (size_t)row * D + F.lane * 4 + 256 * j) = v[j]; u32x2 w; w.x = cvt_pk_bf16(v[j][0], v[j][1]); w.y = cvt_pk_bf16(v[j][2], v[j][3]);
                *(u32x2*)(XB + (size_t)row * D + F.lane * 4 + 256 * j) = w; }
        }
        if (ROUTER) {
            float acc[16];
#pragma unroll
            for (int e = 0; e < 16; ++e) { float a = 0.f;
#pragma unroll
                for (int j = 0; j < 4; ++j) { const f32x4 w = *(const LAS f32x4*)(wrT + e * 1024 + F.lane * 4 + 256 * j); a += (v[j][0] * w[0] + v[j][1] * w[1]) + (v[j][2] * w[2] + v[j][3] * w[3]); }
                acc[e] = wave_sum(a); }
            float m = acc[0];
#pragma unroll
            for (int e = 1; e < 16; ++e) m = fmaxf(m, acc[e]);
            float l = 0.f;
#pragma unroll
            for (int e = 0; e < 16; ++e) { acc[e] = expf(acc[e] - m); l += acc[e]; }
            float mine = 0.f;
#pragma unroll
            for (int e = 0; e < 16; ++e) if (F.lane == e) mine = acc[e] / l;
            if (F.lane < 16) ((float*)(F.ws + WS_AFF))[(size_t)row * 16 + F.lane] = mine;
        }
    }
    if (ROUTER) __syncthreads();
}
__device__ __forceinline__ void softmax_phase(Frame& F, bf16_t* SB) {
    for (int row = F.c * 8 + F.wave; row < NT * 4; row += F.G * 8) {
        u32x2* p = (u32x2*)(SB + (size_t)row * 256) + F.lane; const u32x2 w = *p;
        float a = __uint_as_float(w.x << 16), b = __uint_as_float(w.x & 0xffff0000u), c = __uint_as_float(w.y << 16), d = __uint_as_float(w.y & 0xffff0000u);
        const float m = wave_max(fmaxf(fmaxf(a, b), fmaxf(c, d)));
        a = __expf(a - m); b = __expf(b - m); c = __expf(c - m); d = __expf(d - m);
        const float inv = 1.f / wave_sum((a + b) + (c + d));
        u32x2 o; o.x = cvt_pk_bf16(a * inv, b * inv); o.y = cvt_pk_bf16(c * inv, d * inv); *p = o;
    }
}
__device__ __forceinline__ void moe_panel(int hf, int P, int& e, int& grp, int& yerow0) {
    if (P < 128) { e = hf * 8 + (P >> 4); grp = 0; yerow0 = e * 4096 + (P & 15) * 256; } else { e = hf * 8 + ((P - 128) >> 3); grp = 1; yerow0 = 65536 + e * 2048 + ((P - 128) & 7) * 256; }
}
struct SchedUp { unsigned char* ws; int hf, G, c;
    __device__ __forceinline__ bool next(int i, GUnit& u) const { int P, pn; if (!static_unit(i, G, c, 192, 16, P, pn)) return false; int e, grp, y0; moe_panel(hf, P, e, grp, y0);
        u.A = (const char*)ws + WS_XB + (grp ? (size_t)NTP * 2048 : 0); u.B = (const char*)ws + WS_EW13 + ((size_t)e * 4096 + pn * BM) * 2048;
        u.C = (char*)ws + PO_HM + ((size_t)P * BM * 2048 + pn * HALF) * 2; u.X = (const int*)(ws + WS_IDX) + y0; u.pm = P; u.pn = pn; return true; } };
struct SchedDown { unsigned char* ws; int hf, G, c;
    __device__ __forceinline__ bool next(int i, GUnit& u) const { int P, pn; if (!static_unit(i, G, c, 192, 4, P, pn)) return false; int e, grp, y0; moe_panel(hf, P, e, grp, y0);
        u.A = (const char*)ws + PO_HM + (size_t)P * BM * 4096; u.B = (const char*)ws + WS_EW2 + ((size_t)e * 1024 + pn * BM) * 4096;
        u.C = (char*)ws + PO_YE + ((size_t)y0 * 1024 + pn * BM) * 2; u.X = (const float*)(ws + WS_GATE) + y0; u.pm = P; u.pn = pn; return true; } };
struct SchedQKV { unsigned char* ws; int G, c;
    __device__ __forceinline__ bool next(int i, GUnit& u) const { const int L = i * G + c; if (L >= 1536 + 768) return false;
        if (L < 1536) { int pm, pn; static_unit(i, G, c, 192, 8, pm, pn); if ((long)i * G + c >= 1536) return false;
            u.A = (const char*)ws + WS_XB + (size_t)pm * BM * 2048; u.B = (const char*)ws + WS_WQKV + (size_t)pn * BM * 2048;
            u.C = (char*)ws + (pn < 4 ? PO_Q : PO_K) + ((size_t)pm * BM * 1024 + (pn & 3) * BM) * 2; u.X = nullptr; u.pm = pm; u.pn = pn; return true; }
        const int r = L - 1536, pmv = r & 3, pnv = r >> 2;
        u.A = (const char*)ws + WS_WQKV + (size_t)(2048 + pmv * BM) * 2048; u.B = (const char*)ws + WS_XB + (size_t)pnv * BM * 2048;
        u.C = (char*)ws + PO_VT + ((size_t)pmv * BM * NT + (size_t)pnv * BM) * 2; u.X = nullptr; u.pm = pmv; u.pn = 8 + pnv; return true; } };
struct EpiQKV {
    static constexpr bool PERM = true;
    __device__ __forceinline__ void operator()(const Acc& acc, const GUnit& u, int wr, int wc, int fr, int fq) const {
        if (u.pn >= 8) { EpiBf<false> e{(unsigned)NT, 1.f}; e(acc, u, wr, wc, fr, fq); }
        else { EpiBf<false> e{1024u, u.pn < 4 ? 0.125f : 1.f}; e(acc, u, wr, wc, fr, fq); }
    }
};

__device__ __forceinline__ void select_phase(Frame& F) {
    unsigned* hist = (unsigned*)(F.lds); unsigned* wsum = hist + 256; unsigned* bc = wsum + 32;
    for (int it = F.c; it < 32; it += F.G) {
        const int grp = it >> 4, e = it & 15; const int n = grp ? NTS : NTP, cap = n / 8;
        const float* aff = (const float*)(F.ws + WS_AFF) + (size_t)(grp ? NTP : 0) * 16;
        int* idx = (int*)(F.ws + WS_IDX) + (grp ? 65536 : 0) + e * cap; float* gate = (float*)(F.ws + WS_GATE) + (grp ? 65536 : 0) + e * cap;
        int* slot_of = (int*)(F.ws + WS_SLOT) + (size_t)(grp ? NTP : 0) * 16;
        __syncthreads();
        nv::select_expert(aff, n, e, cap, idx, gate, slot_of, hist, wsum, bc);
        __syncthreads();
    }
}

__device__ __forceinline__ void natten_phase(Frame& F, const float* rpb) {
    const bf16_t* Kb = (const bf16_t*)(F.ws + PO_K); const bf16_t* VT = (const bf16_t*)(F.ws + PO_VT); bf16_t* QO = (bf16_t*)(F.ws + PO_Q);
    LAS float* Opart = (LAS float*)F.lds; LAS float* ML = (LAS float*)(F.lds + RING_BYTES + 4096);
    const int lane = F.lane, w = F.wave, fr = lane & 15, fq = lane >> 4;
    const int NU = 12288, per = (NU + F.G - 1) / F.G, u0 = F.c * per, u1 = (u0 + per < NU) ? u0 + per : NU;
    for (int U = u0; U < u1; ++U) {
        int gb, h, r, rows;
        if (U < 8192) { gb = U >> 11; h = (U >> 7) & 15; r = U & 127; rows = 128; } else { const int V = U - 8192; gb = 4 + (V >> 10); h = (V >> 6) & 15; r = V & 63; rows = 64; }
        int rs = r - 4; rs = rs < 0 ? 0 : (rs > rows - 8 ? rows - 8 : rs);
        const int kr = rs + w, dr = kr - r + 7;
        const size_t tq0 = (size_t)gb_tok0(gb) + (size_t)r * 64, tk0 = (size_t)gb_tok0(gb) + (size_t)kr * 64;
        bf16x8 Qf[4][2], Kf[4][2];
#pragma unroll
        for (int t = 0; t < 4; ++t)
#pragma unroll
            for (int ks = 0; ks < 2; ++ks) { Qf[t][ks] = *(const bf16x8*)(QO + (tq0 + 16 * t + fr) * D + h * 64 + 32 * ks + 8 * fq); Kf[t][ks] = *(const bf16x8*)(Kb + (tk0 + 16 * t + fr) * D + h * 64 + 32 * ks + 8 * fq); }
        float bias[3][4];
#pragma unroll
        for (int dk = 0; dk < 3; ++dk)
#pragma unroll
            for (int e = 0; e < 4; ++e) { int dc = 16 * (dk - 1) + 4 * fq + e - fr + 15; dc = dc < 0 ? 0 : (dc > 30 ? 30 : dc); bias[dk][e] = rpb[(h * 15 + dr) * 31 + dc]; }
        f32x4 St[4][3];
        float mx[4];
#pragma unroll
        for (int qt = 0; qt < 4; ++qt) { mx[qt] = -INFINITY;
            const int qc = 16 * qt + fr; int wsx = qc - 8; wsx = wsx < 0 ? 0 : (wsx > 48 ? 48 : wsx);
#pragma unroll
            for (int dk = 0; dk < 3; ++dk) { const int kt = qt + dk - 1; St[qt][dk] = (f32x4){-INFINITY, -INFINITY, -INFINITY, -INFINITY};
                if (kt >= 0 && kt < 4) { f32x4 a = (f32x4){0.f, 0.f, 0.f, 0.f};
                    a = __builtin_amdgcn_mfma_f32_16x16x32_bf16(Kf[kt][0], Qf[qt][0], a, 0, 0, 0); a = __builtin_amdgcn_mfma_f32_16x16x32_bf16(Kf[kt][1], Qf[qt][1], a, 0, 0, 0);
#pragma unroll
                    for (int e = 0; e < 4; ++e) { const int kc = 16 * kt + 4 * fq + e; const bool ok = (kc >= wsx) && (kc < wsx + 16); const float sv = ok ? a[e] + bias[dk][e] : -INFINITY; St[qt][dk][e] = sv; mx[qt] = fmaxf(mx[qt], sv); } } }
            mx[qt] = fmaxf(mx[qt], __shfl_xor(mx[qt], 16)); mx[qt] = fmaxf(mx[qt], __shfl_xor(mx[qt], 32));
        }
        float ls[4]; bf16x8 Pf[4][2];
#pragma unroll
        for (int qt = 0; qt < 4; ++qt) { float l = 0.f; float pv[4][4];
#pragma unroll
            for (int kt = 0; kt < 4; ++kt)
#pragma unroll
                for (int e = 0; e < 4; ++e) { const int dk = kt - qt + 1; float p = 0.f; if (dk >= 0 && dk < 3) p = __expf(St[qt][dk][e] - mx[qt]); pv[kt][e] = p; l += p; }
            l += __shfl_xor(l, 16); l += __shfl_xor(l, 32); ls[qt] = l;
#pragma unroll
            for (int ks = 0; ks < 2; ++ks) { u32x4 wv; wv.x = cvt_pk_bf16(pv[2 * ks][0], pv[2 * ks][1]); wv.y = cvt_pk_bf16(pv[2 * ks][2], pv[2 * ks][3]); wv.z = cvt_pk_bf16(pv[2 * ks + 1][0], pv[2 * ks + 1][1]); wv.w = cvt_pk_bf16(pv[2 * ks + 1][2], pv[2 * ks + 1][3]);
                Pf[qt][ks] = __builtin_bit_cast(bf16x8, wv); } }
        f32x4 Ot[4][4];
#pragma unroll
        for (int dt = 0; dt < 4; ++dt)
#pragma unroll
            for (int qt = 0; qt < 4; ++qt) Ot[dt][qt] = (f32x4){0.f, 0.f, 0.f, 0.f};
#pragma unroll
        for (int dt = 0; dt < 4; ++dt)
#pragma unroll
            for (int ks = 0; ks < 2; ++ks) { const bf16_t* vp = VT + (size_t)(h * 64 + 16 * dt + fr) * NT + tk0 + 32 * ks + 4 * fq;
                const u32x2 v0 = *(const u32x2*)vp, v1 = *(const u32x2*)(vp + 16); u32x4 vv; vv.x = v0.x; vv.y = v0.y; vv.z = v1.x; vv.w = v1.y; const bf16x8 Vf = __builtin_bit_cast(bf16x8, vv);
#pragma unroll
                for (int qt = 0; qt < 4; ++qt) { if ((qt == 0 && ks == 1) || (qt == 3 && ks == 0)) continue; Ot[dt][qt] = __builtin_amdgcn_mfma_f32_16x16x32_bf16(Vf, Pf[qt][ks], Ot[dt][qt], 0, 0, 0); } }
#pragma unroll
        for (int qt = 0; qt < 4; ++qt) { const int q = 16 * qt + fr;
#pragma unroll
            for (int dt = 0; dt < 4; ++dt) *(LAS f32x4*)(Opart + w * 4096 + q * 64 + (((dt * 4 + fq) ^ (q & 15)) << 2)) = Ot[dt][qt];
            if (fq == 0) { ML[(w * 64 + q) * 2] = mx[qt]; ML[(w * 64 + q) * 2 + 1] = ls[qt]; } }
        __syncthreads();
        {
            const int q = 8 * w + (lane >> 3), c0 = 2 * (lane & 7);
            float M = -INFINITY; float mw[8], lw[8];
#pragma unroll
            for (int x = 0; x < 8; ++x) { mw[x] = ML[(x * 64 + q) * 2]; lw[x] = ML[(x * 64 + q) * 2 + 1]; M = fmaxf(M, mw[x]); }
            float Lt = 0.f; f32x4 o0 = (f32x4){0.f, 0.f, 0.f, 0.f}, o1 = o0;
#pragma unroll
            for (int x = 0; x < 8; ++x) { const float sc = __expf(mw[x] - M); Lt += lw[x] * sc;
                o0 += *(const LAS f32x4*)(Opart + x * 4096 + q * 64 + ((c0 ^ (q & 15)) << 2)) * sc; o1 += *(const LAS f32x4*)(Opart + x * 4096 + q * 64 + (((c0 + 1) ^ (q & 15)) << 2)) * sc; }
            const float inv = 1.f / Lt;
            u32x4 wv; wv.x = cvt_pk_bf16(o0[0] * inv, o0[1] * inv); wv.y = cvt_pk_bf16(o0[2] * inv, o0[3] * inv); wv.z = cvt_pk_bf16(o1[0] * inv, o1[1] * inv); wv.w = cvt_pk_bf16(o1[2] * inv, o1[3] * inv);
            *(u32x4*)(QO + (tq0 + q) * D + h * 64 + 4 * c0) = wv;
        }
        __syncthreads();
    }
}
constexpr int N_PHASES = 31;
constexpr int FLAG_NO_XIMPORT = 1, FLAG_NO_EXPERTS0 = 2;
__global__ void __launch_bounds__(512, 2) fwd(Args args) {
    extern __shared__ __attribute__((aligned(16))) unsigned char lds_raw[];
    Frame F; F.lds = (LAS unsigned char*)lds_raw; F.ws = args.ws; F.in = args.in; F.out = args.out;
    F.tid = threadIdx.x; F.lane = F.tid & 63; F.wave = __builtin_amdgcn_readfirstlane(F.tid >> 6); F.G = gridDim.x; F.c = blockIdx.x;
    unsigned char* ws = args.ws;
    for (int u = F.tid; u < (LDS_BYTES - RING_BYTES) / 4; u += 512) ((LAS unsigned*)(F.lds + RING_BYTES))[u] = 0u;
    __syncthreads();
    const int lo = args.ph_lo, hi = args.ph_hi;
    volatile LAS unsigned* MISC = (volatile LAS unsigned*)(F.lds + MISC_OFF);
    XcdBarrier bar; bar.bar = (unsigned*)(ws + WS_CTL) + CW_BAR; bar.x = 0; bar.st = nullptr;
    const bool multi = (hi - lo) > 1;
    if (multi) bar = xcd_barrier_post((unsigned*)(ws + WS_CTL) + CW_BAR, MISC + 8);
#define IN(k) (lo <= (k) && (k) < hi)
#define SEAM(k) do { if (IN(k) && IN((k) + 1)) xcd_barrier(bar); } while (0)
    LAS unsigned char* ring = F.lds;
#define PHASE_BEGIN() do { int _t = threadIdx.x; asm volatile("" : "+v"(_t)); F.tid = _t; F.lane = _t & 63; F.wave = __builtin_amdgcn_readfirstlane(_t >> 6); } while (0)

    if (IN(0)) { PHASE_BEGIN();
        for (int it = F.c; it < 128; it += F.G) s5_build_item(F, it >> 1, it & 1);
        convert_small_weights(F);
        if (!(args.flags & FLAG_NO_EXPERTS0)) convert_expert_weights(F, 0);
        convert_plain(F, args.in[I_MWQ], (bf16_t*)(ws + WS_MWQ), (size_t)2 * 1024 * 1024);
        convert_plain(F, args.in[I_MEMP], (bf16_t*)(ws + WS_MEMB), (size_t)4 * 256 * 1024);
        convert_plain(F, args.in[I_MEMS], (bf16_t*)(ws + WS_MEMB) + (size_t)4 * 256 * 1024, (size_t)4 * 256 * 1024);
        import_x(F, !(args.flags & FLAG_NO_XIMPORT));
    }
    SEAM(0);
    {
        const float* lng = args.in[I_LNG]; const float* lnb = args.in[I_LNB];
        if (IN(1)) { PHASE_BEGIN();
            { SchedKV S{ws, F.G, F.c}; EpiBf<false> E{2048u, 1.f}; gemm_phase<EpiBf<false>, SchedKV, false>(ring, 1024, 2048u, 2048u, S, E); }
            { SchedUA S{(const char*)ws + WS_XB, (const char*)ws + WS_WIN, (char*)ws + PO_UA, F.G, F.c}; EpiUA E; gemm_phase<EpiUA, SchedUA, false>(ring, 1024, 2048u, 2048u, S, E); }
        }
        SEAM(1);
        if (IN(2)) { PHASE_BEGIN();
            { SchedSA S{ws, F.G, F.c}; EpiS E; gemm_phase<EpiS, SchedSA, false>(ring, 512, (unsigned)(64 * UAK * 2), 1024u, S, E); }
            { SchedWqk S{ws, F.G, F.c}; EpiBf<false> E{1024u, 0.0625f}; gemm_phase<EpiBf<false>, SchedWqk, false>(ring, 256, 4096u, 2048u, S, E); }
            { SchedWvo S{ws, F.G, F.c}; EpiBf<false> E{1024u, 1.f}; gemm_phase<EpiBf<false>, SchedWvo, false>(ring, 256, 2048u, 4096u, S, E); }
        }
        SEAM(2);
        if (IN(3)) { PHASE_BEGIN(); s5_recurrence(F); }
        SEAM(3);
        if (IN(4)) { PHASE_BEGIN(); SchedSC S{ws, F.G, F.c}; EpiGelu E; gemm_phase<EpiGelu, SchedSC, false>(ring, UAK, (unsigned)(64 * UAK * 2), (unsigned)(UAK * 2), S, E); }
        SEAM(4);
        if (IN(5)) { PHASE_BEGIN(); SchedGated S{(const char*)ws + PO_SG, (const char*)ws + WS_WGLU, (char*)ws + PO_HB_S5, 2048, 2048, 1024, NT / BM, 8, F.G, F.c}; EpiGated<0> E{1024u};
            gemm_phase<EpiGated<0>, SchedGated, false>(ring, 1024, 2048u, 2048u, S, E); }
        SEAM(5);
        if (IN(6)) { PHASE_BEGIN(); ln_phase<0, false, false>(F, (const bf16_t*)(ws + PO_HB_S5), lng, lnb, nullptr); }
        SEAM(6);
    }
#define COMMON_BLOCK(layer, pb) do { \
        const float* lng = args.in[I_LNG] + (size_t)(layer) * 3 * D; const float* lnb = args.in[I_LNB] + (size_t)(layer) * 3 * D; \
        if (IN((pb) + 0)) { PHASE_BEGIN(); SchedBatchW S{(const char*)ws + WS_XB, (const char*)ws + WS_WQK + (size_t)(layer) * 16 * MiB, (char*)ws + PO_SB, F.G, F.c}; EpiBf<false> E{1024u, 1.f}; \
            gemm_phase<EpiBf<false>, SchedBatchW, false>(ring, 1024, 2048u, 2048u, S, E); } \
        SEAM((pb) + 0); \
        if (IN((pb) + 1)) { PHASE_BEGIN(); softmax_phase(F, (bf16_t*)(ws + PO_SB)); } \
        SEAM((pb) + 1); \
        if (IN((pb) + 2)) { PHASE_BEGIN(); SchedBatchW S{(const char*)ws + PO_SB, (const char*)ws + WS_WVO + (size_t)(layer) * 16 * MiB, (char*)ws + PO_HB_MEM, F.G, F.c}; EpiBf<false> E{1024u, 1.f}; \
            gemm_phase<EpiBf<false>, SchedBatchW, false>(ring, 1024, 2048u, 2048u, S, E); } \
        SEAM((pb) + 2); \
        if (IN((pb) + 3)) { PHASE_BEGIN(); ln_phase<0, true, false>(F, (const bf16_t*)(ws + PO_HB_MEM), lng + D, lnb + D, args.in[I_EWR] + (size_t)(layer) * D * 16); } \
        SEAM((pb) + 3); \
        if (IN((pb) + 4)) { PHASE_BEGIN(); select_phase(F); } \
        SEAM((pb) + 4); \
        if (IN((pb) + 5)) { PHASE_BEGIN(); SchedUp S{ws, 0, F.G, F.c}; EpiGated<1> E{2048u}; gemm_phase<EpiGated<1>, SchedUp, true>(ring, 1024, 2048u, 2048u, S, E); } \
        SEAM((pb) + 5); \
        if (IN((pb) + 6)) { PHASE_BEGIN(); SchedDown S{ws, 0, F.G, F.c}; EpiBf<true> E{1024u, 1.f}; gemm_phase<EpiBf<true>, SchedDown, false>(ring, 2048, 4096u, 4096u, S, E); } \
        SEAM((pb) + 6); \
        if (IN((pb) + 7)) { PHASE_BEGIN(); SchedUp S{ws, 1, F.G, F.c}; EpiGated<1> E{2048u}; gemm_phase<EpiGated<1>, SchedUp, true>(ring, 1024, 2048u, 2048u, S, E); } \
        SEAM((pb) + 7); \
        if (IN((pb) + 8)) { PHASE_BEGIN(); SchedDown S{ws, 1, F.G, F.c}; EpiBf<true> E{1024u, 1.f}; gemm_phase<EpiBf<true>, SchedDown, false>(ring, 2048, 4096u, 4096u, S, E); } \
        SEAM((pb) + 8); \
    } while (0)
    COMMON_BLOCK(0, 7);
    if (IN(16)) { PHASE_BEGIN(); ln_phase<1, false, false>(F, nullptr, args.in[I_LNG] + 2 * D, args.in[I_LNB] + 2 * D, nullptr); convert_expert_weights(F, 1); }
    SEAM(16);
    {
        const float* lng = args.in[I_LNG] + 3 * D; const float* lnb = args.in[I_LNB] + 3 * D;
        if (IN(17)) { PHASE_BEGIN(); SchedQKV S{ws, F.G, F.c}; EpiQKV E; gemm_phase<EpiQKV, SchedQKV, false>(ring, 1024, 2048u, 2048u, S, E); }
        SEAM(17);
        if (IN(18)) { PHASE_BEGIN(); natten_phase(F, args.in[I_BRPB]); }
        SEAM(18);
        if (IN(19)) { PHASE_BEGIN(); SchedPlain S{(const char*)ws + PO_Q, (const char*)ws + WS_WO, (char*)ws + PO_HB_NA, 2048, 2048, 1024, NT / BM, 4, F.G, F.c}; EpiBf<false> E{1024u, 1.f};
            gemm_phase<EpiBf<false>, SchedPlain, false>(ring, 1024, 2048u, 2048u, S, E); }
        SEAM(19);
        if (IN(20)) { PHASE_BEGIN(); ln_phase<0, false, false>(F, (const bf16_t*)(ws + PO_HB_NA), lng, lnb, nullptr); }
        SEAM(20);
    }
    COMMON_BLOCK(1, 21);
    if (IN(30)) { PHASE_BEGIN(); ln_phase<1, false, true>(F, nullptr, args.in[I_LNG] + 5 * D, args.in[I_LNB] + 5 * D, nullptr); }
#undef COMMON_BLOCK
#undef IN
#undef SEAM
}
}
#ifndef DBG
#define DBG 0
#endif
#ifndef FZ_PER_PHASE
#define FZ_PER_PHASE 0
#endif

#if DBG
namespace dbg {
__global__ void k_cmp_bf16_f32(const unsigned short* a, const float* b, size_t n, double* acc) {
    double s0 = 0, s1 = 0;
    for (size_t i = (size_t)blockIdx.x * blockDim.x + threadIdx.x; i < n; i += (size_t)gridDim.x * blockDim.x) { const double x = (double)__uint_as_float(((unsigned)a[i]) << 16), y = b[i]; s0 += (x - y) * (x - y); s1 += y * y; }
    for (int o = 32; o >= 1; o >>= 1) { s0 += __shfl_xor(s0, o); s1 += __shfl_xor(s1, o); }
    if ((threadIdx.x & 63) == 0) { atomicAdd(acc, s0); atomicAdd(acc + 1, s1); }
}
__global__ void k_cmp_f32_f32(const float* a, const float* b, size_t n, double* acc) {
    double s0 = 0, s1 = 0;
    for (size_t i = (size_t)blockIdx.x * blockDim.x + threadIdx.x; i < n; i += (size_t)gridDim.x * blockDim.x) { const double x = a[i], y = b[i]; s0 += (x - y) * (x - y); s1 += y * y; }
    for (int o = 32; o >= 1; o >>= 1) { s0 += __shfl_xor(s0, o); s1 += __shfl_xor(s1, o); }
    if ((threadIdx.x & 63) == 0) { atomicAdd(acc, s0); atomicAdd(acc + 1, s1); }
}
__global__ void k_cmp_ua(const unsigned short* UA, const float* u, double* acc) {
    double s0 = 0, s1 = 0;
    for (size_t i = (size_t)blockIdx.x * blockDim.x + threadIdx.x; i < (size_t)fz::NT * 1024; i += (size_t)gridDim.x * blockDim.x) {
        const int tok = (int)(i >> 10), ch = (int)(i & 1023), chunk = tok >> 5, j = tok & 31, g = ch >> 4, h = ch & 15;
        const double x = (double)__uint_as_float(((unsigned)UA[((size_t)chunk * 64 + g) * fz::UAK + j * 16 + h]) << 16), y = u[i]; s0 += (x - y) * (x - y); s1 += y * y; }
    for (int o = 32; o >= 1; o >>= 1) { s0 += __shfl_xor(s0, o); s1 += __shfl_xor(s1, o); }
    if ((threadIdx.x & 63) == 0) { atomicAdd(acc, s0); atomicAdd(acc + 1, s1); }
}
__global__ void k_encode(float* out, const double* accA, const double* accB) {
    const double vA = accA[1] > 0 ? sqrt(accA[0] / accA[1]) : 9.99; const double vB = accB[1] > 0 ? sqrt(accB[0] / accB[1]) : 9.99;
    const float c = (float)sqrt(1e8 * (vA == vA ? vA : 7.77)); const float V = (float)(1e5 * (vB == vB ? vB : 7.77));
    const size_t np = (size_t)fz::NTP * 1024, n = (size_t)fz::NT * 1024;
    for (size_t i = (size_t)blockIdx.x * blockDim.x + threadIdx.x; i < n; i += (size_t)gridDim.x * blockDim.x) out[i] = i < np ? c : (i == np ? V : 0.f);
}
}
#endif

extern "C" void kernel_launch(void* const* d_in, const int* in_sizes, int n_in, void* d_out, int out_size, void* d_ws, size_t ws_size, hipStream_t stream) {
    using namespace fz;
    static int grid = 0;
    if (grid == 0) {
        if (n_in != 26 || ws_size < WS_END) { fprintf(stderr, "kernel_launch: unexpected inputs (n_in %d, ws %zu)\n", n_in, ws_size); grid = -1; return; }
        int dev = 0, cus = 0, per_cu = 0;
        if (hipGetDevice(&dev) != hipSuccess || hipDeviceGetAttribute(&cus, hipDeviceAttributeMultiprocessorCount, dev) != hipSuccess) { grid = -1; return; }
        if (hipFuncSetAttribute((const void*)fwd, hipFuncAttributeMaxDynamicSharedMemorySize, LDS_BYTES) != hipSuccess) { fprintf(stderr, "kernel_launch: hipFuncSetAttribute failed\n"); grid = -1; return; }
        if (hipOccupancyMaxActiveBlocksPerMultiprocessor(&per_cu, (const void*)fwd, 512, LDS_BYTES) != hipSuccess || per_cu < 1) { fprintf(stderr, "kernel_launch: occupancy query says %d\n", per_cu); }
        (void)hipGetLastError();
        grid = cus;
    }
    if (grid < 0) return;
    unsigned char* ws = (unsigned char*)d_ws;
    (void)hipMemsetAsync(ws + WS_CTL, 0, CTL_ZERO_BYTES, stream);
    Args a{};
    for (int i = 0; i < 26; ++i) a.in[i] = (const float*)d_in[i];
    a.out = (float*)d_out; a.ws = ws; a.flags = 0; a.pad = 0;
    auto run = [&](int lo, int hi) { a.ph_lo = lo; a.ph_hi = hi; hipLaunchKernelGGL(fwd, dim3(grid), dim3(512), LDS_BYTES, stream, a); };
#if DBG == 0
#if FZ_PER_PHASE
    for (int p = 0; p < N_PHASES; ++p) run(p, p + 1);
#else
    run(0, N_PHASES);
#endif
#else
    using nv::SG;
    const float* const* in = (const float* const*)d_in;
    const size_t BIG = (size_t)NT * D;
    double* ACC = (double*)(ws + 32 * 1024);
    float* nmisc = (float*)(ws + 987 * MiB);
    float* nKV = nmisc; float* nAFF = nmisc + 4u * 1024 * 1024; float* nGATE = nAFF + 1024 * 1024; int* nIDX = (int*)(nGATE + 128 * 1024); float* nMEMC = (float*)(ws + 385 * MiB);
    auto sgemm = [&](const float* A, const float* B, float* C, const int* gidx, int M, int N, int K, long sam, long sak, long sbk, long sbn, long ldc,
                     int nz = 1, int zdiv = 1, long zA0 = 0, long zA1 = 0, long zB0 = 0, long zB1 = 0, long zC0 = 0, long zC1 = 0) {
        SG s{A, B, C, gidx, M, N, K, zdiv, sam, sak, sbk, sbn, ldc, zA0, zA1, zB0, zB1, zC0, zC1};
        hipLaunchKernelGGL(nv::k_sgemm, dim3(N / 128, M / 128, nz), dim3(256), 0, stream, s);
    };
    const int EW = (int)((BIG + 255) / 256);
    auto n_import = [&](float* X) { hipMemcpyAsync(X, in[I_XP], (size_t)NTP * D * 4, hipMemcpyDeviceToDevice, stream); hipMemcpyAsync(X + (size_t)NTP * D, in[I_XS], (size_t)NTS * D * 4, hipMemcpyDeviceToDevice, stream);
        hipMemcpyAsync(nMEMC, in[I_MEMP], (size_t)4 * 256 * D * 4, hipMemcpyDeviceToDevice, stream); hipMemcpyAsync(nMEMC + (size_t)4 * 256 * D, in[I_MEMS], (size_t)4 * 256 * D * 4, hipMemcpyDeviceToDevice, stream); };
    auto n_s5 = [&](float* X, float* T1, float* T2, float* T3) {
        sgemm(X, in[I_AWIN], T1, nullptr, NT, D, D, D, 1, D, 1, D);
        hipLaunchKernelGGL(nv::k_s5_scan, dim3(8 * 64 * 2), dim3(64), 0, stream, T1, T2, in[I_ALRE], in[I_ALIM], in[I_ALDT], in[I_ABRE], in[I_ABIM], in[I_ACRE], in[I_ACIM]);
        hipLaunchKernelGGL(nv::k_s5_gelu, dim3(EW), dim3(256), 0, stream, T1, T2, in[I_AD], T2);
        sgemm(T2, in[I_AWGLU], T1, nullptr, NT, D, D, D, 1, 2 * D, 1, D);
        sgemm(T2, in[I_AWGLU] + D, T3, nullptr, NT, D, D, D, 1, 2 * D, 1, D);
        hipLaunchKernelGGL(nv::k_glu, dim3(EW), dim3(256), 0, stream, T1, T3, T1);
    };
    auto n_na = [&](float* X, float* T1, float* T2, float* T3) {
        sgemm(X, in[I_BWQKV], T1, nullptr, NT, D, D, D, 1, 3 * D, 1, D); sgemm(X, in[I_BWQKV] + D, T2, nullptr, NT, D, D, D, 1, 3 * D, 1, D); sgemm(X, in[I_BWQKV] + 2 * D, T3, nullptr, NT, D, D, D, 1, 3 * D, 1, D);
        hipLaunchKernelGGL(nv::k_natten, dim3(NT * 16 / 4), dim3(256), 0, stream, T1, T2, T3, in[I_BRPB]);
        sgemm(T1, in[I_BWO], T2, nullptr, NT, D, D, D, 1, D, 1, D);
    };
    auto n_ln = [&](float* X, const float* h, int layer, int sub, float* xo) { hipLaunchKernelGGL(nv::k_res_ln, dim3(NT / 4), dim3(256), 0, stream, X, h, in[I_LNG] + (layer * 3 + sub) * D, in[I_LNB] + (layer * 3 + sub) * D, xo, NT); };
    auto n_mem = [&](float* X, float* T1, float* T2, float* T3, int layer) {
        const float* wq = in[I_MWQ] + (size_t)layer * D * D; const float* wkv = in[I_MWKV] + (size_t)layer * D * 2 * D; const float* wo = in[I_MWO] + (size_t)layer * D * D;
        sgemm(nMEMC, wkv, nKV, nullptr, 8 * 256, 2 * D, D, D, 1, 2 * D, 1, 2 * D);
        sgemm(X, wq, T1, nullptr, NT, D, D, D, 1, D, 1, D);
        for (int grp = 0; grp < 2; ++grp) { const int L = grp ? 4096 : 8192; const size_t tb = grp ? (size_t)NTP : 0; const int gb0 = grp * 4;
            sgemm(T1 + tb * D, nKV + (size_t)gb0 * 256 * 2 * D, T2 + tb * D, nullptr, L, 256, 256, D, 1, 1, 2 * D, D, 16, 4, (long)L * D, 256, (long)256 * 2 * D, 256, (long)L * D, 256); }
        hipLaunchKernelGGL(nv::k_softmax256, dim3(NT * 4 / 4), dim3(256), 0, stream, T2, 0.0625f, NT * 4);
        for (int grp = 0; grp < 2; ++grp) { const int L = grp ? 4096 : 8192; const size_t tb = grp ? (size_t)NTP : 0; const int gb0 = grp * 4;
            sgemm(T2 + tb * D, nKV + (size_t)gb0 * 256 * 2 * D + D, T3 + tb * D, nullptr, L, 256, 256, D, 1, 2 * D, 1, D, 16, 4, (long)L * D, 256, (long)256 * 2 * D, 256, (long)L * D, 256); }
        sgemm(T3, wo, T1, nullptr, NT, D, D, D, 1, D, 1, D);
    };
    auto n_moe = [&](float* X, float* T1, float* T2, float* T3, int layer) {
        hipLaunchKernelGGL(nv::k_router, dim3(NT / 4), dim3(256), 0, stream, X, in[I_EWR] + (size_t)layer * D * 16, nAFF, NT);
        hipLaunchKernelGGL(nv::k_select, dim3(32), dim3(512), 0, stream, nAFF, nIDX, nGATE);
        hipMemsetAsync(T1, 0, BIG * 4, stream);
        for (int grp = 0; grp < 2; ++grp) { const int n = grp ? NTS : NTP, cap = n / 8; const size_t tb = grp ? (size_t)NTP : 0;
            for (int e = 0; e < 16; ++e) { const int* idx = nIDX + (grp ? 16 * 4096 : 0) + e * cap; const float* gate = nGATE + (grp ? 16 * 4096 : 0) + e * cap;
                const float* w1 = in[I_EW1] + ((size_t)layer * 16 + e) * D * 2048; const float* w3 = in[I_EW3] + ((size_t)layer * 16 + e) * D * 2048; const float* w2 = in[I_EW2] + ((size_t)layer * 16 + e) * 2048 * D;
                float* H1 = T2; float* H3 = T2 + (size_t)4096 * 2048; float* YE = T3;
                sgemm(X + tb * D, w1, H1, idx, cap, 2048, D, D, 1, 2048, 1, 2048); sgemm(X + tb * D, w3, H3, idx, cap, 2048, D, D, 1, 2048, 1, 2048);
                hipLaunchKernelGGL(nv::k_silu_mul, dim3((unsigned)(((size_t)cap * 2048 + 255) / 256)), dim3(256), 0, stream, H1, H3, (size_t)cap * 2048);
                sgemm(H1, w2, YE, nullptr, cap, D, 2048, 2048, 1, D, 1, D);
                hipLaunchKernelGGL(nv::k_scatter_add, dim3((unsigned)(((size_t)cap * D + 255) / 256)), dim3(256), 0, stream, YE, idx, gate, T1 + tb * D, cap); } }
    };
    float* X = (float*)(ws + WS_XF); float* T1 = (float*)(ws + WS_EW13); float* T2 = (float*)(ws + WS_POOL); float* T3 = (float*)(ws + WS_POOL + 192 * MiB);
    auto cmp_bf = [&](size_t off_bf16, const float* ref, double* acc) { hipLaunchKernelGGL(dbg::k_cmp_bf16_f32, dim3(2048), dim3(256), 0, stream, (const unsigned short*)(ws + off_bf16), ref, BIG, acc); };
#if DBG == 1
    n_import(X);
    a.flags = FLAG_NO_XIMPORT | FLAG_NO_EXPERTS0;
    n_s5(X, T1, T2, T3);
    for (int p = 0; p <= 5; ++p) run(p, p + 1);
    cmp_bf(PO_HB_S5, T1, ACC);
    cmp_bf(PO_HB_S5, T1, ACC + 2);
#elif DBG == 11
    n_import(X);
    a.flags = FLAG_NO_XIMPORT | FLAG_NO_EXPERTS0;
    sgemm(X, in[I_AWIN], T1, nullptr, NT, D, D, D, 1, D, 1, D);
    for (int p = 0; p <= 4; ++p) run(p, p + 1);
    hipLaunchKernelGGL(dbg::k_cmp_ua, dim3(2048), dim3(256), 0, stream, (const unsigned short*)(ws + PO_UA), T1, ACC);
    hipMemcpyAsync(X, T1, BIG * 4, hipMemcpyDeviceToDevice, stream);
    { float* Y = (float*)(ws + 193 * MiB);
      hipLaunchKernelGGL(nv::k_s5_scan, dim3(8 * 64 * 2), dim3(64), 0, stream, X, Y, in[I_ALRE], in[I_ALIM], in[I_ALDT], in[I_ABRE], in[I_ABIM], in[I_ACRE], in[I_ACIM]);
      hipLaunchKernelGGL(nv::k_s5_gelu, dim3(EW), dim3(256), 0, stream, X, Y, in[I_AD], Y);
      cmp_bf(PO_SG, Y, ACC + 2); }
#elif DBG == 2
    n_import(X); n_s5(X, T1, T2, T3); n_ln(X, T1, 0, 0, X); n_mem(X, T1, T2, T3, 0);
    a.flags = FLAG_NO_XIMPORT | FLAG_NO_EXPERTS0;
    run(0, 1); run(1, 2); run(2, 3); run(7, 8); run(8, 9); run(9, 10);
    cmp_bf(PO_HB_MEM, T1, ACC); cmp_bf(PO_HB_MEM, T1, ACC + 2);
#elif DBG == 4
    n_import(X); n_na(X, T1, T2, T3);
    hipMemcpyAsync(T1, T2, BIG * 4, hipMemcpyDeviceToDevice, stream);
    a.flags = FLAG_NO_XIMPORT | FLAG_NO_EXPERTS0;
    run(0, 1); run(17, 18); run(18, 19); run(19, 20);
    cmp_bf(PO_HB_NA, T1, ACC); cmp_bf(PO_HB_NA, T1, ACC + 2);
#endif
    hipLaunchKernelGGL(dbg::k_encode, dim3(2048), dim3(256), 0, stream, (float*)d_out, ACC, ACC + 2);
#endif
}
```

```cpp
#include <hip/hip_runtime.h>
#include <cstdio>
#include <cstdint>
#include <cmath>
namespace nv {
constexpr int D = 1024, NTP = 32768, NTS = 16384, NT = NTP + NTS, NGB = 8, MEM = 256;
constexpr int GRID_W = 64;
constexpr float ALPHA = 1.41421356237309515f;
constexpr float LN_EPS = 1e-5f;

__host__ __device__ inline int gb_tok0(int gb) { return gb < 4 ? gb * 8192 : NTP + (gb - 4) * 4096; }
__host__ __device__ inline int gb_len(int gb) { return gb < 4 ? 8192 : 4096; }

__device__ __forceinline__ float wave_sum(float v) {
#pragma unroll
    for (int o = 1; o < 64; o <<= 1) v += __shfl_xor(v, o);
    return v;
}
__device__ __forceinline__ float wave_max(float v) {
#pragma unroll
    for (int o = 1; o < 64; o <<= 1) v = fmaxf(v, __shfl_xor(v, o));
    return v;
}

struct SG { const float* A; const float* B; float* C; const int* gidx; int M, N, K, zdiv; long sam, sak, sbk, sbn, ldc; long zA0, zA1, zB0, zB1, zC0, zC1; };
__global__ __launch_bounds__(256) void k_sgemm(SG a) {
    __shared__ float As[8][132];
    __shared__ float Bs[8][132];
    const int z = blockIdx.z, z0 = z / a.zdiv, z1 = z % a.zdiv;
    const float* A = a.A + z0 * a.zA0 + z1 * a.zA1;
    const float* B = a.B + z0 * a.zB0 + z1 * a.zB1;
    float* C = a.C + z0 * a.zC0 + z1 * a.zC1;
    const int bm = blockIdx.y * 128, bn = blockIdx.x * 128, tid = threadIdx.x, tx = tid & 15, ty = tid >> 4;
    float acc[8][8];
#pragma unroll
    for (int i = 0; i < 8; ++i)
#pragma unroll
        for (int j = 0; j < 8; ++j) acc[i][j] = 0.f;
    const int arow_l = tid >> 1, akk = (tid & 1) * 4;
    const long arow = a.gidx ? (long)a.gidx[bm + arow_l] : (long)(bm + arow_l);
    const float* Ap = A + arow * a.sam;
    const int bkk = tid >> 5, bnn = (tid & 31) * 4;
    for (int k0 = 0; k0 < a.K; k0 += 8) {
        float av[4], bv[4];
#pragma unroll
        for (int i = 0; i < 4; ++i) av[i] = Ap[(long)(k0 + akk + i) * a.sak];
#pragma unroll
        for (int i = 0; i < 4; ++i) bv[i] = B[(long)(k0 + bkk) * a.sbk + (long)(bn + bnn + i) * a.sbn];
        __syncthreads();
#pragma unroll
        for (int i = 0; i < 4; ++i) As[akk + i][arow_l] = av[i];
#pragma unroll
        for (int i = 0; i < 4; ++i) Bs[bkk][bnn + i] = bv[i];
        __syncthreads();
#pragma unroll
        for (int kk = 0; kk < 8; ++kk) {
            float x[8], y[8];
#pragma unroll
            for (int i = 0; i < 8; ++i) x[i] = As[kk][ty * 8 + i];
#pragma unroll
            for (int j = 0; j < 8; ++j) y[j] = Bs[kk][tx * 8 + j];
#pragma unroll
            for (int i = 0; i < 8; ++i)
#pragma unroll
                for (int j = 0; j < 8; ++j) acc[i][j] += x[i] * y[j];
        }
    }
#pragma unroll
    for (int i = 0; i < 8; ++i)
#pragma unroll
        for (int j = 0; j < 8; ++j) C[(long)(bm + ty * 8 + i) * a.ldc + bn + tx * 8 + j] = acc[i][j];
}

__global__ __launch_bounds__(64) void k_s5_scan(const float* __restrict__ u, float* __restrict__ ydir, const float* lam_re, const float* lam_im, const float* log_dt,
                                                const float* b_re, const float* b_im, const float* c_re, const float* c_im) {
    const int wid = blockIdx.x;
    const int dir = wid & 1, g = (wid >> 1) & 63, gb = wid >> 7;
    const int p = threadIdx.x;
    const int L = gb_len(gb), t0 = gb_tok0(gb);
    const double dt = exp((double)log_dt[dir * 64 + g]);
    const double lr = lam_re[(dir * 64 + g) * 64 + p], li = lam_im[(dir * 64 + g) * 64 + p];
    const double er = exp(lr * dt), lbr = er * cos(li * dt), lbi = er * sin(li * dt);
    const double nr = lbr - 1.0, ni = lbi, den = lr * lr + li * li;
    const double fr = (nr * lr + ni * li) / den, fi = (ni * lr - nr * li) / den;
    float Br[16], Bi[16], Cr[16], Ci[16];
#pragma unroll
    for (int h = 0; h < 16; ++h) {
        const double br = b_re[((dir * 64 + g) * 64 + p) * 16 + h], bi = b_im[((dir * 64 + g) * 64 + p) * 16 + h];
        Br[h] = (float)(fr * br - fi * bi); Bi[h] = (float)(fr * bi + fi * br);
        Cr[h] = c_re[((dir * 64 + g) * 16 + h) * 64 + p]; Ci[h] = c_im[((dir * 64 + g) * 16 + h) * 64 + p];
    }
    const float ar = (float)lbr, ai = (float)lbi;
    float hr = 0.f, hi = 0.f;
    float* yo = ydir + (size_t)dir * NT * D;
    for (int s = 0; s < L; ++s) {
        const int t = dir ? (L - 1 - s) : s;
        const float* ur = u + (size_t)(t0 + t) * D + g * 16;
        float bur = 0.f, bui = 0.f;
#pragma unroll
        for (int h = 0; h < 16; ++h) { const float uv = ur[h]; bur += uv * Br[h]; bui += uv * Bi[h]; }
        const float nhr = ar * hr - ai * hi + bur, nhi = ar * hi + ai * hr + bui;
        hr = nhr; hi = nhi;
        float mine = 0.f;
#pragma unroll
        for (int c = 0; c < 16; ++c) { const float v = wave_sum(Cr[c] * hr - Ci[c] * hi); if (p == c) mine = v; }
        if (p < 16) yo[(size_t)(t0 + t) * D + g * 16 + p] = mine;
    }
}
__global__ void k_s5_gelu(const float* u, const float* ydir, const float* dskip, float* gout) {
    const size_t i = (size_t)blockIdx.x * blockDim.x + threadIdx.x;
    if (i >= (size_t)NT * D) return;
    const float y = dskip[i & (D - 1)] * u[i] + ydir[i] + ydir[(size_t)NT * D + i];
    const float c = 0.7978845608028654f * (y + 0.044715f * y * y * y);
    gout[i] = 0.5f * y * (1.f + tanhf(c));
}
__global__ void k_glu(const float* z1, const float* z2, float* out) {
    const size_t i = (size_t)blockIdx.x * blockDim.x + threadIdx.x;
    if (i >= (size_t)NT * D) return;
    out[i] = z1[i] / (1.f + expf(-z2[i]));
}
__global__ __launch_bounds__(256) void k_res_ln(const float* x, const float* h, const float* g, const float* b, float* xo, int rows) {
    const int row = blockIdx.x * 4 + (threadIdx.x >> 6), lane = threadIdx.x & 63;
    if (row >= rows) return;
    float v[16]; float s = 0.f;
#pragma unroll
    for (int j = 0; j < 16; ++j) { const size_t i = (size_t)row * D + lane + 64 * j; v[j] = ALPHA * x[i] + h[i]; s += v[j]; }
    const float mean = wave_sum(s) * (1.f / D); float q = 0.f;
#pragma unroll
    for (int j = 0; j < 16; ++j) { v[j] -= mean; q += v[j] * v[j]; }
    const float rstd = 1.f / sqrtf(wave_sum(q) * (1.f / D) + LN_EPS);
#pragma unroll
    for (int j = 0; j < 16; ++j) { const int c = lane + 64 * j; xo[(size_t)row * D + c] = v[j] * rstd * g[c] + b[c]; }
}
__global__ __launch_bounds__(256) void k_softmax256(float* s, float scale, int rows) {
    const int row = blockIdx.x * 4 + (threadIdx.x >> 6), lane = threadIdx.x & 63;
    if (row >= rows) return;
    float v[4]; float m = -INFINITY;
#pragma unroll
    for (int j = 0; j < 4; ++j) { v[j] = s[(size_t)row * 256 + lane + 64 * j] * scale; m = fmaxf(m, v[j]); }
    m = wave_max(m); float l = 0.f;
#pragma unroll
    for (int j = 0; j < 4; ++j) { v[j] = expf(v[j] - m); l += v[j]; }
    l = wave_sum(l);
#pragma unroll
    for (int j = 0; j < 4; ++j) s[(size_t)row * 256 + lane + 64 * j] = v[j] / l;
}
__global__ __launch_bounds__(256) void k_router(const float* x, const float* wr, float* aff, int rows) {
    const int row = blockIdx.x * 4 + (threadIdx.x >> 6), lane = threadIdx.x & 63;
    if (row >= rows) return;
    float acc[16];
#pragma unroll
    for (int e = 0; e < 16; ++e) acc[e] = 0.f;
    for (int j = 0; j < 16; ++j) { const int k = lane + 64 * j; const float xv = x[(size_t)row * D + k];
#pragma unroll
        for (int e = 0; e < 16; ++e) acc[e] += xv * wr[k * 16 + e]; }
    float m = -INFINITY;
#pragma unroll
    for (int e = 0; e < 16; ++e) { acc[e] = wave_sum(acc[e]); m = fmaxf(m, acc[e]); }
    float l = 0.f;
#pragma unroll
    for (int e = 0; e < 16; ++e) { acc[e] = expf(acc[e] - m); l += acc[e]; }
    float mine = 0.f;
#pragma unroll
    for (int e = 0; e < 16; ++e) if (lane == e) mine = acc[e] / l;
    if (lane < 16) aff[(size_t)row * 16 + lane] = mine;
}

__device__ __forceinline__ void select_expert(const float* aff, int n, int e, int cap, int* idx_out, float* gate_out, int* slot_of  , unsigned* hist  , unsigned* wsum  , unsigned* bc  ) {
    const int tid = threadIdx.x, nth = blockDim.x, lane = tid & 63, wv = tid >> 6, nw = nth >> 6;
    unsigned prefix = 0u, mask = 0u; unsigned remaining = (unsigned)cap;
    for (int pass = 0; pass < 4; ++pass) {
        const int shift = 24 - 8 * pass;
        for (int i = tid; i < 256; i += nth) hist[i] = 0u;
        __syncthreads();
        for (int t = tid; t < n; t += nth) { const unsigned key = __float_as_uint(aff[(size_t)t * 16 + e]); if ((key & mask) == prefix) atomicAdd(&hist[(key >> shift) & 255u], 1u); }
        __syncthreads();
        if (tid == 0) { unsigned cum = 0u; int b = 255; for (; b > 0; --b) { if (cum + hist[b] >= remaining) break; cum += hist[b]; } bc[0] = (unsigned)b; bc[1] = remaining - cum; }
        __syncthreads();
        prefix |= bc[0] << shift; mask |= 0xffu << shift; remaining = bc[1];
        __syncthreads();
    }
    const unsigned T = prefix; const unsigned need_eq = remaining;
    unsigned base = 0u, eqbase = 0u;
    for (int s0 = 0; s0 < n; s0 += nth) {
        const int t = s0 + tid; const bool in = t < n;
        const float a = in ? aff[(size_t)t * 16 + e] : 0.f; const unsigned key = __float_as_uint(a);
        const bool gt = in && key > T, eq = in && key == T;
        const unsigned long long meq = __ballot(eq); const unsigned eqr_w = __popcll(meq & ((1ull << lane) - 1ull));
        if (lane == 0) wsum[wv] = __popcll(meq);
        __syncthreads();
        unsigned eqoff = 0u, eqtot = 0u; for (int w = 0; w < nw; ++w) { const unsigned c = wsum[w]; if (w < wv) eqoff += c; eqtot += c; }
        __syncthreads();
        const bool sel = gt || (eq && (eqbase + eqoff + eqr_w) < need_eq);
        const unsigned long long ms = __ballot(sel); const unsigned sr_w = __popcll(ms & ((1ull << lane) - 1ull));
        if (lane == 0) wsum[wv] = __popcll(ms);
        __syncthreads();
        unsigned soff = 0u, stot = 0u; for (int w = 0; w < nw; ++w) { const unsigned c = wsum[w]; if (w < wv) soff += c; stot += c; }
        __syncthreads();
        if (sel) { const unsigned slot = base + soff + sr_w; if (slot < (unsigned)cap) { idx_out[slot] = t; gate_out[slot] = a; } }
        if (slot_of && in) slot_of[(size_t)t * 16 + e] = sel ? (int)(base + soff + sr_w) : -1;
        base += stot; eqbase += eqtot;
    }
}
__global__ __launch_bounds__(512) void k_select(const float* aff_all, int* idx_all, float* gate_all) {
    __shared__ unsigned hist[256]; __shared__ unsigned wsum[32]; __shared__ unsigned bc[4];
    const int grp = blockIdx.x >> 4, e = blockIdx.x & 15;
    const int n = grp ? NTS : NTP, cap = n / 8;
    const float* aff = aff_all + (size_t)(grp ? NTP : 0) * 16;
    int* idx = idx_all + (grp ? 16 * 4096 : 0) + e * cap; float* gate = gate_all + (grp ? 16 * 4096 : 0) + e * cap;
    select_expert(aff, n, e, cap, idx, gate, nullptr, hist, wsum, bc);
}
__global__ void k_silu_mul(float* h1, const float* h3, size_t n) {
    const size_t i = (size_t)blockIdx.x * blockDim.x + threadIdx.x; if (i >= n) return;
    const float a = h1[i]; h1[i] = a / (1.f + expf(-a)) * h3[i];
}
__global__ void k_scatter_add(const float* ye, const int* idx, const float* gate, float* out, int cap) {
    const size_t i = (size_t)blockIdx.x * blockDim.x + threadIdx.x; if (i >= (size_t)cap * D) return;
    const int slot = (int)(i >> 10), c = (int)(i & 1023);
    atomicAdd(&out[(size_t)idx[slot] * D + c], gate[slot] * ye[i]);
}

__global__ __launch_bounds__(256) void k_natten(float* q, const float* k, const float* v, const float* rpb) {
    const int wg = blockIdx.x * 4 + (threadIdx.x >> 6), lane = threadIdx.x & 63;
    const int tok = wg >> 4, h = wg & 15;
    if (tok >= NT) return;
    int gb, l; if (tok < NTP) { gb = tok >> 13; l = tok & 8191; } else { gb = 4 + ((tok - NTP) >> 12); l = (tok - NTP) & 4095; }
    const int rows = gb_len(gb) / GRID_W, t0 = gb_tok0(gb);
    const int r = l >> 6, qc = l & 63;
    int rs = r - 4; rs = rs < 0 ? 0 : (rs > rows - 8 ? rows - 8 : rs);
    int ws = qc - 8; ws = ws < 0 ? 0 : (ws > 48 ? 48 : ws);
    const float qv = q[(size_t)tok * D + h * 64 + lane] * 0.125f;
    float m = -INFINITY, lsum = 0.f, o = 0.f;
    for (int rr = 0; rr < 8; ++rr) {
        const int kr = rs + rr, dr = kr - r + 7;
        for (int cc = 0; cc < 16; ++cc) {
            const int kc = ws + cc; int dc = kc - qc + 15; dc = dc < 0 ? 0 : (dc > 30 ? 30 : dc);
            const size_t kt = (size_t)(t0 + kr * 64 + kc) * D + h * 64 + lane;
            const float s = wave_sum(qv * k[kt]) + rpb[(h * 15 + dr) * 31 + dc];
            const float mn = fmaxf(m, s), al = expf(m - mn), pp = expf(s - mn);
            lsum = lsum * al + pp; o = o * al + pp * v[kt]; m = mn;
        }
    }
    q[(size_t)tok * D + h * 64 + lane] = o / lsum;
}
}
#define LAS __attribute__((address_space(3)))
#define GAS __attribute__((address_space(1)))
namespace fz {
typedef unsigned short bf16_t;
typedef short bf16x8 __attribute__((ext_vector_type(8)));
typedef float f32x4 __attribute__((ext_vector_type(4)));
typedef float f32x2 __attribute__((ext_vector_type(2)));
typedef unsigned u32x4 __attribute__((ext_vector_type(4)));
typedef unsigned u32x2 __attribute__((ext_vector_type(2)));

constexpr int D = 1024, NTP = 32768, NTS = 16384, NT = NTP + NTS;
constexpr int TCH = 32, NCHUNK = NT / TCH;
constexpr int UAK = TCH * 16 + 256;
constexpr float ALPHA = 1.41421356237309515f, LN_EPS = 1e-5f;
constexpr size_t MiB = 1u << 20;
constexpr size_t WS_CTL = 0, WS_XF = 1 * MiB, WS_XB = 193 * MiB, WS_WIN = 289 * MiB, WS_WGLU = 291 * MiB, WS_WQKV = 295 * MiB, WS_WO = 301 * MiB, WS_MWQ = 303 * MiB,
                 WS_MWKV = 307 * MiB, WS_MWO = 315 * MiB, WS_MEMB = 319 * MiB, WS_KV = 323 * MiB, WS_WQK = 339 * MiB, WS_WVO = 371 * MiB, WS_AFF = 403 * MiB, WS_SLOT = 406 * MiB,
                 WS_IDX = 409 * MiB, WS_GATE = 409 * MiB + 512 * 1024, WS_EW13 = 411 * MiB, WS_EW2 = 539 * MiB, WS_POOL = 603 * MiB, WS_END = 1024 * MiB;
constexpr size_t PO_M2T = WS_POOL, PO_M13T = WS_POOL + 16 * MiB, PO_UA = WS_POOL + 64 * MiB, PO_SG = WS_POOL + 208 * MiB;
constexpr size_t PO_HB_S5 = PO_UA;
constexpr size_t PO_SB = WS_POOL, PO_HB_MEM = WS_POOL + 96 * MiB;
constexpr size_t PO_Q = WS_POOL, PO_K = WS_POOL + 96 * MiB, PO_VT = WS_POOL + 192 * MiB, PO_HB_NA = WS_POOL + 288 * MiB;
constexpr size_t PO_HM = WS_POOL, PO_YE = WS_POOL + 192 * MiB;
static_assert(PO_YE + 192 * MiB <= WS_END && PO_SG + 96 * MiB <= WS_END && PO_HB_NA + 96 * MiB <= WS_END, "pool");
constexpr int CW_TMO = 0, CW_BAR = 4096;
constexpr size_t CTL_ZERO_BYTES = 64 * 1024;
constexpr int RING_BYTES = 131072, MISC_OFF = RING_BYTES + 320, LDS_BYTES = 147456;

__host__ __device__ inline int gb_tok0(int gb) { return gb < 4 ? gb * 8192 : NTP + (gb - 4) * 4096; }
__host__ __device__ inline int gb_len(int gb) { return gb < 4 ? 8192 : 4096; }
__host__ __device__ inline int panel_gb(int pm) { return pm < 128 ? (pm >> 5) : 4 + ((pm - 128) >> 4); }

__device__ __forceinline__ unsigned cvt_pk_bf16(float lo, float hi) { unsigned r; asm volatile("v_cvt_pk_bf16_f32 %0, %1, %2" : "=v"(r) : "v"(lo), "v"(hi)); return r; }
__device__ __forceinline__ float bf2f(unsigned short b) { return __uint_as_float(((unsigned)b) << 16); }
__device__ __forceinline__ float wave_sum(float v) {
#pragma unroll
    for (int o = 1; o < 64; o <<= 1) v += __shfl_xor(v, o);
    return v;
}
__device__ __forceinline__ float wave_max(float v) {
#pragma unroll
    for (int o = 1; o < 64; o <<= 1) v = fmaxf(v, __shfl_xor(v, o));
    return v;
}
#define LDS_WAIT() asm volatile("s_waitcnt lgkmcnt(0)" ::: "memory")
#define VM_WAIT() asm volatile("s_waitcnt vmcnt(0)" ::: "memory")

#define XB_TMO      128
#define XB_XCNT(j)  (256  + 64 * (j))
#define XB_XSUB(j)  (1280 + 64 * (j))
#define XB_XGEN(j)  (2304 + 64 * (j))
#define XB_TOP      3328
#define XB_TOPGEN   3392
#define XCD_BAR_WORDS 3456
#define XB_SPIN_CAP (1u << 18)
__device__ __forceinline__ unsigned xb_ld(unsigned* p)              { return __hip_atomic_load(p, __ATOMIC_RELAXED, __HIP_MEMORY_SCOPE_AGENT); }
__device__ __forceinline__ unsigned xb_add(unsigned* p, unsigned v) { return __hip_atomic_fetch_add(p, v, __ATOMIC_RELAXED, __HIP_MEMORY_SCOPE_AGENT); }
__device__ __forceinline__ unsigned xb_xcc_id() { return (unsigned)__builtin_amdgcn_s_getreg((3 << 11) | 20) & 0xFu; }
#define XB_SPIN(cond, bar) do { unsigned _sp = 0; while (cond) { __builtin_amdgcn_s_sleep(1); \
    if ((++_sp & 255u) == 0u) { if (xb_ld(&(bar)[XB_TMO])) break; if (_sp > XB_SPIN_CAP) { atomicAdd(&(bar)[XB_TMO], 1u); break; } } } } while (0)
struct XcdBarrier { unsigned* bar; unsigned x; volatile LAS unsigned* st; };
__device__ __forceinline__ XcdBarrier xcd_barrier_post(unsigned* bar, volatile LAS unsigned* st) {
    XcdBarrier b; b.bar = bar; b.x = xb_xcc_id(); b.st = st;
    if (threadIdx.x == 0) (void)xb_add(&bar[XB_XCNT(b.x)], 1u);
    return b;
}
__device__ __forceinline__ void xcd_barrier_complete(unsigned* bar, unsigned x, unsigned& nloc, unsigned& nx) {
    const unsigned G = gridDim.x * gridDim.y * gridDim.z;
    unsigned sum, cnt, mine, sp = 0u;
    for (;;) {
        sum = 0u; cnt = 0u; mine = 0u;
#pragma unroll
        for (unsigned j = 0; j < 16; ++j) { const unsigned c = xb_ld(&bar[XB_XCNT(j)]); sum += c; cnt += (c > 0u) ? 1u : 0u; mine = (j == x) ? c : mine; }
        if (sum == G) break;
        __builtin_amdgcn_s_sleep(1);
        if ((++sp & 255u) == 0u) { if (xb_ld(&bar[XB_TMO])) break; if (sp > XB_SPIN_CAP) { atomicAdd(&bar[XB_TMO], 1u); break; } }
    }
    nloc = mine > 0u ? mine : 1u; nx = cnt > 0u ? cnt : 1u;
}
__device__ __forceinline__ void xcd_barrier(const XcdBarrier& b) {
    asm volatile("s_waitcnt vmcnt(0)" ::: "memory");
    __syncthreads();
    if (threadIdx.x == 0) {
        unsigned* bar = b.bar;
        __builtin_amdgcn_s_waitcnt(0);
        unsigned nloc = b.st[0], nx = b.st[1];
        if (nloc == 0u) { xcd_barrier_complete(bar, b.x, nloc, nx); b.st[0] = nloc; b.st[1] = nx; }
        const unsigned old = xb_add(&bar[XB_XSUB(b.x)], 1u);
        const unsigned gen = old / nloc;
        if (old + 1u == (gen + 1u) * nloc) {
            __builtin_amdgcn_fence(__ATOMIC_RELEASE, "agent");
            asm volatile("s_waitcnt vmcnt(0)" ::: "memory");
            const unsigned og = xb_add(&bar[XB_TOP], 1u);
            const unsigned tg = og / nx;
            if (og + 1u == (tg + 1u) * nx) xb_add(&bar[XB_TOPGEN], 1u);
            else XB_SPIN(xb_ld(&bar[XB_TOPGEN]) == tg, bar);
            __builtin_amdgcn_fence(__ATOMIC_ACQUIRE, "agent");
            xb_add(&bar[XB_XGEN(b.x)], 1u);
            asm volatile("s_waitcnt vmcnt(0)" ::: "memory");
        } else {
            XB_SPIN(xb_ld(&bar[XB_XGEN(b.x)]) == gen, bar);
            __builtin_amdgcn_fence(__ATOMIC_ACQUIRE, "agent");
            asm volatile("s_waitcnt vmcnt(0)" ::: "memory");
        }
    }
    __syncthreads();
}

constexpr int BM = 256, BK = 64, HALF = 128, HTB = HALF * BK * 2, STAGE_BYTES = 8 * HTB;
__host__ __device__ __forceinline__ int lds_byte(int r, int c) { const int st = (r >> 4) * 2 + (c >> 5), rr = r & 15, cc = c & 31, ob = rr * 64 + cc * 2; return st * 1024 + (ob ^ (((ob >> 9) & 1) << 5)); }
__host__ __device__ __forceinline__ void stage_rc(int b, int& R, int& C) { const int st = b / 1024, sb = b % 1024, swz = sb ^ (((sb >> 9) & 1) << 5); R = (st >> 1) * 16 + swz / 64; C = (st & 1) * 32 + (swz % 64) / 2; }
__host__ __device__ __forceinline__ int perm32(int rho) { const int n = rho >> 4, i = rho & 15; return 8 * (i >> 2) + 4 * n + (i & 3); }

struct GUnit { const char* A; const char* B; char* C; const void* X; int pm, pn; };
__device__ __forceinline__ bool static_unit(int i, int G, int c, int nM, int nN, int& pm, int& pn) {
    const long L = (long)i * G + c; const int nwg = nM * nN; if (L >= nwg) return false;
    int wgid = (int)L; { const int q = nwg / 8, r = nwg % 8, xcd = wgid % 8, off = wgid / 8; wgid = (xcd < r ? xcd * (q + 1) : r * (q + 1) + (xcd - r) * q) + off; }
    const int nig = 8 * nN, gid = wgid / nig, fm = gid * 8, gsz = (nM - fm) < 8 ? (nM - fm) : 8;
    pm = fm + ((wgid % nig) % gsz); pn = (wgid % nig) / gsz; return true;
}
template <class Epi, class Sched, bool GATHER>
__device__ __forceinline__ void gemm_phase(LAS unsigned char* lds, const int K, const unsigned lda, const unsigned ldb, const Sched& S, const Epi& E) {
    int tid_ = threadIdx.x; asm volatile("" : "+v"(tid_));
    const int tid = tid_, wid = __builtin_amdgcn_readfirstlane(tid >> 6), lane = tid & 63, wr = wid >> 2, wc = wid & 3, fr = lane & 15, fq = lane >> 4;
    int nt_ = K / BK; asm volatile("" : "+s"(nt_)); const int nt = nt_;
    unsigned voffA[2], voffB[2]; int gR[2], gC[2];
#pragma unroll
    for (int i = 0; i < 2; ++i) { int R, C; stage_rc(tid * 16 + i * 8192, R, C); const int Rb = Epi::PERM ? ((R & ~31) + perm32(R & 31)) : R;
        voffA[i] = (unsigned)R * lda + (unsigned)C * 2u; voffB[i] = (unsigned)Rb * ldb + (unsigned)C * 2u; gR[i] = R; gC[i] = C * 2; }
    const size_t kstep = (size_t)(BK * 2);
    const size_t hstepA = (size_t)HALF * lda, hstepB = (size_t)HALF * ldb;
    const unsigned ldsw = (unsigned)wid * 1024u;
    const int aoff = lds_byte(wr * 64 + fr, fq * 8), boff = lds_byte(wc * 32 + fr, fq * 8);
    unsigned cvo[2][2], nvo[2][2];
#define PG8_SA(b, h) (((b) * 2 + (h)) * HTB)
#define PG8_SB(b, h) ((4 + (b) * 2 + (h)) * HTB)
#define PG8_STAGE(bufoff, gbase, voff) do { _Pragma("unroll") for (int _i = 0; _i < 2; ++_i) \
        __builtin_amdgcn_global_load_lds((const unsigned*)((const char*)(gbase) + (voff)[_i]), (LAS unsigned*)(lds + (bufoff) + ldsw + _i * 8192), 16, 0, 0); } while (0)
#define PG8_STAGE_B(bufoff, ptr, h) PG8_STAGE(bufoff, (ptr) + (h) * hstepB, voffB)
#define PG8_STAGE_A(bufoff, ptr, h, vo) do { if constexpr (GATHER) { PG8_STAGE(bufoff, (ptr), (vo)[h]); } else { PG8_STAGE(bufoff, (ptr) + (h) * hstepA, voffA); } } while (0)
#define PG8_LDA(dst, b, h) do { _Pragma("unroll") for (int m = 0; m < 4; ++m) _Pragma("unroll") for (int k = 0; k < 2; ++k) dst[m][k] = *(const LAS bf16x8*)(lds + PG8_SA(b, h) + aoff + m * 2048 + k * 1024); } while (0)
#define PG8_LDB(dst, b, h) do { _Pragma("unroll") for (int n = 0; n < 2; ++n) _Pragma("unroll") for (int k = 0; k < 2; ++k) dst[n][k] = *(const LAS bf16x8*)(lds + PG8_SB(b, h) + boff + n * 2048 + k * 1024); } while (0)
#define PG8_MMA(ai, bj, At, Bt) do { __builtin_amdgcn_s_setprio(1); _Pragma("unroll") for (int m = 0; m < 4; ++m) _Pragma("unroll") for (int n = 0; n < 2; ++n) _Pragma("unroll") for (int k = 0; k < 2; ++k) \
        acc[ai][bj][m][n] = __builtin_amdgcn_mfma_f32_16x16x32_bf16(Bt[n][k], At[m][k], acc[ai][bj][m][n], 0, 0, 0); __builtin_amdgcn_s_setprio(0); } while (0)
#define PG8_WAIT_V(n) asm volatile("s_waitcnt vmcnt(" #n ")" ::: "memory")
#define PG8_WAIT_L(n) asm volatile("s_waitcnt lgkmcnt(" #n ")" ::: "memory")
#define PG8_BAR __builtin_amdgcn_s_barrier()
#define PG8_SCHED __builtin_amdgcn_sched_barrier(0)
#define PG8_GLOAD(vo, u) do { if constexpr (GATHER) { const int* _gi = (const int*)(u).X; _Pragma("unroll") for (int _h = 0; _h < 2; ++_h) _Pragma("unroll") for (int _i = 0; _i < 2; ++_i) \
        (vo)[_h][_i] = (unsigned)_gi[_h * HALF + gR[_i]] * lda + (unsigned)gC[_i]; } } while (0)
    GUnit cur, nxt; int ui = 0;
    if (!S.next(0, cur)) return;
    f32x4 acc[2][2][4][2];
#pragma unroll
    for (int a = 0; a < 2; ++a)
#pragma unroll
        for (int b = 0; b < 2; ++b)
#pragma unroll
            for (int m = 0; m < 4; ++m)
#pragma unroll
                for (int n = 0; n < 2; ++n) acc[a][b][m][n] = (f32x4){0.f, 0.f, 0.f, 0.f};
    bf16x8 At[4][2], B0[2][2], B1[2][2];
    const char* cA = cur.A; const char* cB = cur.B;
    PG8_GLOAD(cvo, cur);
    if constexpr (GATHER) { PG8_WAIT_V(0); }
    PG8_STAGE_B(PG8_SB(0, 0), cB, 0); PG8_STAGE_B(PG8_SB(0, 1), cB, 1); PG8_STAGE_A(PG8_SA(0, 0), cA, 0, cvo); PG8_STAGE_A(PG8_SA(0, 1), cA, 1, cvo);
    if (wr == 1) PG8_BAR;
    PG8_WAIT_V(2); PG8_BAR;
    PG8_STAGE_B(PG8_SB(1, 0), cB + kstep, 0); PG8_STAGE_A(PG8_SA(1, 0), cA + kstep, 0, cvo); PG8_STAGE_B(PG8_SB(1, 1), cB + kstep, 1);
    PG8_WAIT_V(6); PG8_BAR;
    for (;;) {
        const bool has_next = S.next(ui + 1, nxt);
        const char* nA = has_next ? nxt.A : cA; const char* nB = has_next ? nxt.B : cB;
        if constexpr (GATHER) { if (has_next) { PG8_GLOAD(nvo, nxt); } else {
#pragma unroll
            for (int h = 0; h < 2; ++h)
#pragma unroll
                for (int i = 0; i < 2; ++i) nvo[h][i] = cvo[h][i]; } }
        for (int t = 0; t < nt; t += 2) {
            const bool last = (t == nt - 2);
            const char* a1 = cA + (size_t)(t + 1) * kstep;
            const char* a2 = last ? nA : cA + (size_t)(t + 2) * kstep; const char* b2 = last ? nB : cB + (size_t)(t + 2) * kstep;
            const char* a3 = a2 + kstep; const char* b3 = b2 + kstep;
            unsigned vo2[2][2];
            if constexpr (GATHER) {
#pragma unroll
                for (int h = 0; h < 2; ++h)
#pragma unroll
                    for (int i = 0; i < 2; ++i) vo2[h][i] = last ? nvo[h][i] : cvo[h][i]; }
            PG8_LDB(B0, 0, 0); PG8_LDB(B1, 0, 1); PG8_SCHED; PG8_LDA(At, 0, 0); PG8_STAGE_A(PG8_SA(1, 1), a1, 1, cvo);
            PG8_WAIT_V(8); PG8_WAIT_L(0); PG8_BAR; PG8_MMA(0, 0, At, B0); PG8_MMA(0, 1, At, B1); PG8_BAR; PG8_SCHED;
            PG8_LDA(At, 0, 1); PG8_STAGE_B(PG8_SB(0, 0), b2, 0); PG8_STAGE_B(PG8_SB(0, 1), b2, 1); PG8_STAGE_A(PG8_SA(0, 0), a2, 0, vo2);
            PG8_WAIT_V(8); PG8_WAIT_L(0); PG8_BAR; PG8_MMA(1, 0, At, B0); PG8_MMA(1, 1, At, B1); PG8_BAR; PG8_SCHED;
            PG8_LDB(B0, 1, 0); PG8_LDB(B1, 1, 1); PG8_SCHED; PG8_LDA(At, 1, 0); PG8_STAGE_A(PG8_SA(0, 1), a2, 1, vo2);
            PG8_WAIT_V(8); PG8_WAIT_L(0); PG8_BAR; PG8_MMA(0, 0, At, B0); PG8_MMA(0, 1, At, B1); PG8_BAR; PG8_SCHED;
            PG8_LDA(At, 1, 1); PG8_STAGE_B(PG8_SB(1, 0), b3, 0); PG8_STAGE_B(PG8_SB(1, 1), b3, 1); PG8_STAGE_A(PG8_SA(1, 0), a3, 0, vo2);
            PG8_WAIT_V(8); PG8_WAIT_L(0); PG8_BAR; PG8_MMA(1, 0, At, B0); PG8_MMA(1, 1, At, B1); PG8_BAR; PG8_SCHED;
        }
        if (wr == 0) PG8_BAR;
        E(acc, cur, wr, wc, fr, fq);
        if (!has_next) break;
#pragma unroll
        for (int a = 0; a < 2; ++a)
#pragma unroll
            for (int b = 0; b < 2; ++b)
#pragma unroll
                for (int m = 0; m < 4; ++m)
#pragma unroll
                    for (int n = 0; n < 2; ++n) acc[a][b][m][n] = (f32x4){0.f, 0.f, 0.f, 0.f};
        cur = nxt; cA = nA; cB = nB; ++ui;
        if constexpr (GATHER) {
#pragma unroll
            for (int h = 0; h < 2; ++h)
#pragma unroll
                for (int i = 0; i < 2; ++i) cvo[h][i] = nvo[h][i]; }
        if (wr == 1) PG8_BAR;
    }
    PG8_WAIT_V(0);
    PG8_BAR;
#undef PG8_SA
#undef PG8_SB
#undef PG8_STAGE
#undef PG8_STAGE_A
#undef PG8_STAGE_B
#undef PG8_LDA
#undef PG8_LDB
#undef PG8_MMA
#undef PG8_WAIT_V
#undef PG8_WAIT_L
#undef PG8_BAR
#undef PG8_SCHED
#undef PG8_GLOAD
}
typedef f32x4 Acc[2][2][4][2];
__device__ __forceinline__ float sigmoidf_fast(float x) { return __builtin_amdgcn_rcpf(1.f + __builtin_amdgcn_exp2f(-1.4426950408889634f * x)); }
__device__ __forceinline__ float gelu_tanh_fast(float y) {
    const float inner = 1.5957691216057308f * (y + 0.044715f * y * y * y);
    return y * sigmoidf_fast(inner);
}
template <bool ROWSCALE> struct EpiBf {
    static constexpr bool PERM = true;
    unsigned ldc; float scale;
    __device__ __forceinline__ void operator()(const Acc& acc, const GUnit& u, int wr, int wc, int fr, int fq) const {
        bf16_t* base = (bf16_t*)u.C; const float* rs = (const float*)u.X;
#pragma unroll
        for (int ai = 0; ai < 2; ++ai)
#pragma unroll
            for (int m = 0; m < 4; ++m) { const int r = ai * HALF + wr * 64 + m * 16 + fr; float s = scale; if (ROWSCALE) s *= rs[r];
                bf16_t* rowp = base + (size_t)r * ldc + wc * 32 + 8 * fq;
#pragma unroll
                for (int bj = 0; bj < 2; ++bj) { const f32x4 v0 = acc[ai][bj][m][0] * s, v1 = acc[ai][bj][m][1] * s;
                    u32x4 w; w.x = cvt_pk_bf16(v0[0], v0[1]); w.y = cvt_pk_bf16(v0[2], v0[3]); w.z = cvt_pk_bf16(v1[0], v1[1]); w.w = cvt_pk_bf16(v1[2], v1[3]);
                    *(u32x4*)(rowp + bj * HALF) = w; } }
    }
};
template <int MODE> struct EpiGated {
    static constexpr bool PERM = true;
    unsigned ldc;
    __device__ __forceinline__ void operator()(const Acc& acc, const GUnit& u, int wr, int wc, int fr, int fq) const {
        bf16_t* base = (bf16_t*)u.C;
#pragma unroll
        for (int ai = 0; ai < 2; ++ai)
#pragma unroll
            for (int m = 0; m < 4; ++m) { const int r = ai * HALF + wr * 64 + m * 16 + fr;
                float o[8];
#pragma unroll
                for (int n = 0; n < 2; ++n)
#pragma unroll
                    for (int j = 0; j < 4; ++j) { const float a = acc[ai][0][m][n][j], b = acc[ai][1][m][n][j];
                        o[n * 4 + j] = (MODE == 0) ? a * sigmoidf_fast(b) : a * sigmoidf_fast(a) * b; }
                u32x4 w; w.x = cvt_pk_bf16(o[0], o[1]); w.y = cvt_pk_bf16(o[2], o[3]); w.z = cvt_pk_bf16(o[4], o[5]); w.w = cvt_pk_bf16(o[6], o[7]);
                *(u32x4*)(base + (size_t)r * ldc + wc * 32 + 8 * fq) = w; }
    }
};
struct EpiUA {
    static constexpr bool PERM = true;
    __device__ __forceinline__ void operator()(const Acc& acc, const GUnit& u, int wr, int wc, int fr, int fq) const {
        bf16_t* UA = (bf16_t*)u.C;
#pragma unroll
        for (int ai = 0; ai < 2; ++ai)
#pragma unroll
            for (int m = 0; m < 4; ++m) { const int tok = u.pm * BM + ai * HALF + wr * 64 + m * 16 + fr; const int chunk = tok >> 5, j = tok & 31;
#pragma unroll
                for (int bj = 0; bj < 2; ++bj) { const int ch = u.pn * BM + bj * HALF + wc * 32 + 8 * fq, g = ch >> 4, h0 = ch & 15;
                    const f32x4 v0 = acc[ai][bj][m][0], v1 = acc[ai][bj][m][1];
                    u32x4 w; w.x = cvt_pk_bf16(v0[0], v0[1]); w.y = cvt_pk_bf16(v0[2], v0[3]); w.z = cvt_pk_bf16(v1[0], v1[1]); w.w = cvt_pk_bf16(v1[2], v1[3]);
                    *(u32x4*)(UA + ((size_t)chunk * 64 + g) * UAK + j * 16 + h0) = w; } }
    }
};
struct EpiS {
    static constexpr bool PERM = false;
    __device__ __forceinline__ void operator()(const Acc& acc, const GUnit& u, int wr, int wc, int fr, int fq) const {
        float* Sg = (float*)u.C;
#pragma unroll
        for (int ai = 0; ai < 2; ++ai)
#pragma unroll
            for (int m = 0; m < 4; ++m) { const int chunk = u.pm * BM + ai * HALF + wr * 64 + m * 16 + fr; float* rowp = Sg + (size_t)chunk * (64 * 256) + wc * 32 + 4 * fq;
#pragma unroll
                for (int bj = 0; bj < 2; ++bj)
#pragma unroll
                    for (int n = 0; n < 2; ++n) *(f32x4*)(rowp + bj * HALF + n * 16) = acc[ai][bj][m][n]; }
    }
};
struct EpiGelu {
    static constexpr bool PERM = true;
    __device__ __forceinline__ void operator()(const Acc& acc, const GUnit& u, int wr, int wc, int fr, int fq) const {
        bf16_t* Gg = (bf16_t*)u.C;
#pragma unroll
        for (int ai = 0; ai < 2; ++ai)
#pragma unroll
            for (int m = 0; m < 4; ++m) { const int chunk = u.pm * BM + ai * HALF + wr * 64 + m * 16 + fr;
#pragma unroll
                for (int bj = 0; bj < 2; ++bj) { const int n0 = u.pn * BM + bj * HALF + wc * 32 + 8 * fq, i = n0 >> 4, c0 = n0 & 15;
                    const f32x4 v0 = acc[ai][bj][m][0], v1 = acc[ai][bj][m][1];
                    u32x4 w; w.x = cvt_pk_bf16(gelu_tanh_fast(v0[0]), gelu_tanh_fast(v0[1])); w.y = cvt_pk_bf16(gelu_tanh_fast(v0[2]), gelu_tanh_fast(v0[3]));
                    w.z = cvt_pk_bf16(gelu_tanh_fast(v1[0]), gelu_tanh_fast(v1[1])); w.w = cvt_pk_bf16(gelu_tanh_fast(v1[2]), gelu_tanh_fast(v1[3]));
                    *(u32x4*)(Gg + ((size_t)chunk * TCH + i) * D + c0) = w; } }
    }
};

struct Ctx { unsigned char* ws; int G, c; };
struct SchedPlain { const char* A; const char* B; char* C; size_t lda, ldb, ldc; int nM, nN, G, c;
    __device__ __forceinline__ bool next(int i, GUnit& u) const { int pm, pn; if (!static_unit(i, G, c, nM, nN, pm, pn)) return false;
        u.A = A + (size_t)pm * BM * lda; u.B = B + (size_t)pn * BM * ldb; u.C = C + ((size_t)pm * BM * ldc + (size_t)pn * BM) * 2; u.X = nullptr; u.pm = pm; u.pn = pn; return true; } };
struct SchedGated { const char* A; const char* B; char* C; size_t lda, ldb, ldc; int nM, nN, G, c;
    __device__ __forceinline__ bool next(int i, GUnit& u) const { int pm, pn; if (!static_unit(i, G, c, nM, nN, pm, pn)) return false;
        u.A = A + (size_t)pm * BM * lda; u.B = B + (size_t)pn * BM * ldb; u.C = C + ((size_t)pm * BM * ldc + (size_t)pn * HALF) * 2; u.X = nullptr; u.pm = pm; u.pn = pn; return true; } };
struct SchedUA { const char* A; const char* B; char* UA; int G, c;
    __device__ __forceinline__ bool next(int i, GUnit& u) const { int pm, pn; if (!static_unit(i, G, c, NT / BM, D / BM, pm, pn)) return false;
        u.A = A + (size_t)pm * BM * (D * 2); u.B = B + (size_t)pn * BM * (D * 2); u.C = UA; u.X = nullptr; u.pm = pm; u.pn = pn; return true; } };
struct SchedKV { unsigned char* ws; int G, c;
    __device__ __forceinline__ bool next(int i, GUnit& u) const { const int L = i * G + c; if (L >= 128) return false; const int layer = L >> 6, r = L & 63, pm = r >> 3, pn = r & 7;
        u.A = (const char*)ws + WS_MEMB + (size_t)pm * BM * 2048; u.B = (const char*)ws + WS_MWKV + (size_t)layer * 4 * MiB + (size_t)pn * BM * 2048;
        u.C = (char*)ws + WS_KV + (size_t)layer * 8 * MiB + ((size_t)pm * BM * 2048 + pn * BM) * 2; u.X = nullptr; u.pm = pm; u.pn = pn; return true; } };
struct SchedSA { unsigned char* ws; int G, c;
    __device__ __forceinline__ bool next(int i, GUnit& u) const { const int L = i * G + c; if (L >= 64 * 6) return false; const int g = L / 6, pm = L % 6;
        u.A = (const char*)ws + PO_UA + (size_t)pm * BM * (64 * UAK * 2) + (size_t)g * UAK * 2; u.B = (const char*)ws + PO_M2T + (size_t)g * 256 * 512 * 2;
        u.C = (char*)ws + PO_SG + (size_t)g * 256 * 4; u.X = nullptr; u.pm = pm; u.pn = 0; return true; } };
struct SchedSC { unsigned char* ws; int G, c;
    __device__ __forceinline__ bool next(int i, GUnit& u) const { const int L = i * G + c; if (L >= 64 * 12) return false; const int g = L / 12, r = L % 12, pm = r >> 1, pn = r & 1;
        u.A = (const char*)ws + PO_UA + (size_t)pm * BM * (64 * UAK * 2) + (size_t)g * UAK * 2; u.B = (const char*)ws + PO_M13T + ((size_t)g * 512 + pn * BM) * UAK * 2;
        u.C = (char*)ws + PO_SG + (size_t)g * 16 * 2; u.X = nullptr; u.pm = pm; u.pn = pn; return true; } };
struct SchedWqk { unsigned char* ws; int G, c;
    __device__ __forceinline__ bool next(int i, GUnit& u) const { const int L = i * G + c; if (L >= 256) return false; const int pn = L & 3, h = (L >> 2) & 3, gb = (L >> 4) & 7, layer = L >> 7;
        u.A = (const char*)ws + WS_KV + (size_t)layer * 8 * MiB + ((size_t)gb * 256 * 2048 + h * 256) * 2; u.B = (const char*)ws + WS_MWQ + (size_t)layer * 2 * MiB + ((size_t)pn * BM * 1024 + h * 256) * 2;
        u.C = (char*)ws + WS_WQK + ((size_t)(layer * 8 + gb) * 1024 * 1024 + (size_t)h * 256 * 1024 + pn * BM) * 2; u.X = nullptr; u.pm = 0; u.pn = pn; return true; } };
struct SchedWvo { unsigned char* ws; int G, c;
    __device__ __forceinline__ bool next(int i, GUnit& u) const { const int L = i * G + c; if (L >= 256) return false; const int pm = L & 3, h = (L >> 2) & 3, gb = (L >> 4) & 7, layer = L >> 7;
        u.A = (const char*)ws + WS_MWO + (size_t)layer * 2 * MiB + ((size_t)pm * BM * 1024 + h * 256) * 2; u.B = (const char*)ws + WS_KV + (size_t)layer * 8 * MiB + ((size_t)gb * 256 * 2048 + 1024 + h * 256) * 2;
        u.C = (char*)ws + WS_WVO + ((size_t)(layer * 8 + gb) * 1024 * 1024 + (size_t)pm * BM * 1024 + h * 256) * 2; u.X = nullptr; u.pm = pm; u.pn = 0; return true; } };
struct SchedBatchW { const char* A; const char* Bl; char* C; int G, c;
    __device__ __forceinline__ bool next(int i, GUnit& u) const { int pm, pn; if (!static_unit(i, G, c, NT / BM, 4, pm, pn)) return false; const int gb = panel_gb(pm);
        u.A = A + (size_t)pm * BM * 2048; u.B = Bl + ((size_t)gb * 1024 + pn * BM) * 2048; u.C = C + ((size_t)pm * BM * 1024 + pn * BM) * 2; u.X = nullptr; u.pm = pm; u.pn = pn; return true; } };
struct Args { const float* in[26]; float* out; unsigned char* ws; int ph_lo, ph_hi, flags, pad; };
struct Frame {
    LAS unsigned char* lds; unsigned char* ws; const float* const* in; float* out;
    int tid, lane, wave, G, c;
};
enum { I_XP = 0, I_XS, I_MEMP, I_MEMS, I_AWIN, I_ALRE, I_ALIM, I_ALDT, I_ABRE, I_ABIM, I_ACRE, I_ACIM, I_AD, I_AWGLU, I_BWQKV, I_BRPB, I_BWO, I_MWQ, I_MWKV, I_MWO, I_EWR, I_EW1, I_EW3, I_EW2, I_LNG, I_LNB };

__device__ __forceinline__ int rowmap(int mode, int n) {
    if (mode == 0) return n;
    if (mode == 1) { const int z = n >> 10, nn = n & 1023; return ((nn >> 7) << 8) + (z << 7) + (nn & 127); }
    return ((n >> 7) << 8) + ((mode == 3) ? 128 : 0) + (n & 127);
}
__device__ __forceinline__ void transpose_item(const float* W, int K, int N, bf16_t* WT, int mode, LAS float* scr, int item, int lane) {
    const int nblk = N / 32, kb = item / nblk, nb = item % nblk, k0 = 64 * kb, n0 = 32 * nb;
#pragma unroll 8
    for (int i = 0; i < 32; ++i) { const int kk = 2 * i + (lane >> 5); scr[kk * 33 + (lane & 31)] = W[(size_t)(k0 + kk) * N + n0 + (lane & 31)]; }
    LDS_WAIT(); asm volatile("" ::: "memory");
    const int c = lane & 7;
#pragma unroll
    for (int j = 0; j < 4; ++j) { const int n = (lane >> 3) + 8 * j; const LAS float* s = scr + (8 * c) * 33 + n;
        u32x4 o; o.x = cvt_pk_bf16(s[0 * 33], s[1 * 33]); o.y = cvt_pk_bf16(s[2 * 33], s[3 * 33]); o.z = cvt_pk_bf16(s[4 * 33], s[5 * 33]); o.w = cvt_pk_bf16(s[6 * 33], s[7 * 33]);
        *(u32x4*)(WT + (size_t)rowmap(mode, n0 + n) * K + k0 + 8 * c) = o; }
    LDS_WAIT(); asm volatile("" ::: "memory");
}
__device__ __forceinline__ void convert_small_weights(Frame& F) {
    LAS float* scr = (LAS float*)(F.lds + F.wave * 16384);
    const int gw = F.c * 8 + F.wave, NGW = F.G * 8;
    for (int it = gw; it < 6656; it += NGW) {
        int r = it;
        if (r < 512) { transpose_item(F.in[I_AWIN], 1024, 1024, (bf16_t*)(F.ws + WS_WIN), 0, scr, r, F.lane); continue; } r -= 512;
        if (r < 1024) { transpose_item(F.in[I_AWGLU], 1024, 2048, (bf16_t*)(F.ws + WS_WGLU), 1, scr, r, F.lane); continue; } r -= 1024;
        if (r < 1536) { transpose_item(F.in[I_BWQKV], 1024, 3072, (bf16_t*)(F.ws + WS_WQKV), 0, scr, r, F.lane); continue; } r -= 1536;
        if (r < 512) { transpose_item(F.in[I_BWO], 1024, 1024, (bf16_t*)(F.ws + WS_WO), 0, scr, r, F.lane); continue; } r -= 512;
        if (r < 2048) { const int l = r >> 10; transpose_item(F.in[I_MWKV] + (size_t)l * 1024 * 2048, 1024, 2048, (bf16_t*)(F.ws + WS_MWKV + (size_t)l * 4 * MiB), 0, scr, r & 1023, F.lane); continue; } r -= 2048;
        { const int l = r >> 9; transpose_item(F.in[I_MWO] + (size_t)l * 1024 * 1024, 1024, 1024, (bf16_t*)(F.ws + WS_MWO + (size_t)l * 2 * MiB), 0, scr, r & 511, F.lane); }
    }
}
__device__ __forceinline__ void convert_expert_weights(Frame& F, int layer) {
    LAS float* scr = (LAS float*)(F.lds + F.wave * 16384);
    const int gw = F.c * 8 + F.wave, NGW = F.G * 8;
    for (int it = gw; it < 16 * 3072; it += NGW) {
        const int e = it / 3072; int r = it % 3072;
        const size_t wofs = ((size_t)layer * 16 + e) * 1024 * 2048;
        if (r < 1024) { transpose_item(F.in[I_EW1] + wofs, 1024, 2048, (bf16_t*)(F.ws + WS_EW13 + (size_t)e * 8 * MiB), 2, scr, r, F.lane); continue; } r -= 1024;
        if (r < 1024) { transpose_item(F.in[I_EW3] + wofs, 1024, 2048, (bf16_t*)(F.ws + WS_EW13 + (size_t)e * 8 * MiB), 3, scr, r, F.lane); continue; } r -= 1024;
        transpose_item(F.in[I_EW2] + wofs, 2048, 1024, (bf16_t*)(F.ws + WS_EW2 + (size_t)e * 4 * MiB), 0, scr, r, F.lane);
    }
}
__device__ __forceinline__ void convert_plain(Frame& F, const float* src, bf16_t* dst, size_t n) {
    const size_t n4 = n / 4;
    for (size_t i = (size_t)F.c * 512 + F.tid; i < n4; i += (size_t)F.G * 512) { const f32x4 v = ((const f32x4*)src)[i]; u32x2 w; w.x = cvt_pk_bf16(v[0], v[1]); w.y = cvt_pk_bf16(v[2], v[3]); ((u32x2*)dst)[i] = w; }
}
__device__ __forceinline__ void import_x(Frame& F, bool copy_f32) {
    const size_t n4 = (size_t)NT * D / 4, np4 = (size_t)NTP * D / 4;
    f32x4* XF = (f32x4*)(F.ws + WS_XF); u32x2* XB = (u32x2*)(F.ws + WS_XB);
    for (size_t i = (size_t)F.c * 512 + F.tid; i < n4; i += (size_t)F.G * 512) {
        f32x4 v;
        if (copy_f32) { v = (i < np4) ? ((const f32x4*)F.in[I_XP])[i] : ((const f32x4*)F.in[I_XS])[i - np4]; XF[i] = v; } else v = XF[i];
        u32x2 w; w.x = cvt_pk_bf16(v[0], v[1]); w.y = cvt_pk_bf16(v[2], v[3]); XB[i] = w; }
}

__device__ __forceinline__ void s5_lam(const float* lre, const float* lim, const float* ldt, int dir, int g, int p, double& dt, double& lr, double& li) {
    dt = exp((double)ldt[dir * 64 + g]); lr = (double)lre[(dir * 64 + g) * 64 + p]; li = (double)lim[(dir * 64 + g) * 64 + p];
}
__device__ __forceinline__ void s5_fill_bc(Frame& F, int g, int dir, LAS float* Bbr, LAS float* Bbi, LAS float* Cr, LAS float* Ci) {
    for (int idx = F.tid; idx < 1024; idx += 512) {
        const int p = idx >> 4, h = idx & 15; double dt, lr, li; s5_lam(F.in[I_ALRE], F.in[I_ALIM], F.in[I_ALDT], dir, g, p, dt, lr, li);
        const double er = exp(lr * dt), lbr = er * cos(li * dt), lbi = er * sin(li * dt), nr = lbr - 1.0, ni = lbi, den = lr * lr + li * li;
        const double fr = (nr * lr + ni * li) / den, fi = (ni * lr - nr * li) / den;
        const double br = F.in[I_ABRE][((dir * 64 + g) * 64 + p) * 16 + h], bi = F.in[I_ABIM][((dir * 64 + g) * 64 + p) * 16 + h];
        Bbr[idx] = (float)(fr * br - fi * bi); Bbi[idx] = (float)(fr * bi + fi * br);
        Cr[idx] = F.in[I_ACRE][(dir * 64 + g) * 1024 + idx]; Ci[idx] = F.in[I_ACIM][(dir * 64 + g) * 1024 + idx];
    }
}
__device__ __forceinline__ void s5_build_item(Frame& F, int g, int dir) {
    LAS float* LPr = (LAS float*)F.lds; LAS float* LPi = LPr + 33 * 64;
    LAS float* Bbr = LPi + 33 * 64; LAS float* Bbi = Bbr + 1024; LAS float* Cr = Bbi + 1024; LAS float* Ci = Cr + 1024;
    LAS float* B2r = Ci + 1024; LAS float* B2i = B2r + 1024; LAS float* C2r = B2i + 1024; LAS float* C2i = C2r + 1024;
    bf16_t* M2T = (bf16_t*)(F.ws + PO_M2T) + (size_t)g * 256 * 512; bf16_t* M13T = (bf16_t*)(F.ws + PO_M13T) + (size_t)g * 512 * UAK;
    __syncthreads();
    for (int idx = F.tid; idx < 33 * 64; idx += 512) { const int e = idx >> 6, p = idx & 63; double dt, lr, li; s5_lam(F.in[I_ALRE], F.in[I_ALIM], F.in[I_ALDT], dir, g, p, dt, lr, li);
        const double er = exp(lr * dt * e); LPr[idx] = (float)(er * cos(li * dt * e)); LPi[idx] = (float)(er * sin(li * dt * e)); }
    s5_fill_bc(F, g, dir, Bbr, Bbi, Cr, Ci);
    if (dir == 0) s5_fill_bc(F, g, 1, B2r, B2i, C2r, C2i);
    __syncthreads();
    {
        const int k = F.tid, j = k >> 4, h = k & 15, e = dir == 0 ? (TCH - 1 - j) : j;
        for (int p = 0; p < 64; ++p) { const float lr = LPr[e * 64 + p], li = LPi[e * 64 + p], br = Bbr[p * 16 + h], bi = Bbi[p * 16 + h];
            const float xr = lr * br - li * bi, xi = lr * bi + li * br;
            M2T[(size_t)(dir * 128 + p) * 512 + k] = (bf16_t)(cvt_pk_bf16(xr, 0.f) & 0xffffu); M2T[(size_t)(dir * 128 + 64 + p) * 512 + k] = (bf16_t)(cvt_pk_bf16(xi, 0.f) & 0xffffu); }
    }
    {
        const int p = F.tid & 63, q8 = F.tid >> 6;
        for (int ic = q8; ic < 512; ic += 8) { const int i = ic >> 4, c = ic & 15, e = dir == 0 ? (i + 1) : (TCH - i);
            const float cr = Cr[c * 64 + p], ci = Ci[c * 64 + p], lr = LPr[e * 64 + p], li = LPi[e * 64 + p];
            const float vr = cr * lr - ci * li, vi = cr * li + ci * lr;
            M13T[(size_t)ic * UAK + 512 + dir * 128 + p] = (bf16_t)(cvt_pk_bf16(vr, 0.f) & 0xffffu); M13T[(size_t)ic * UAK + 512 + dir * 128 + 64 + p] = (bf16_t)(cvt_pk_bf16(-vi, 0.f) & 0xffffu); }
    }
    {
        const int ch = F.tid & 255, c = ch >> 4, h = ch & 15, par = F.tid >> 8;
        for (int d = 1 + par; d < TCH; d += 2) {
            float s = 0.f;
            for (int p = 0; p < 64; ++p) { const float lr = LPr[d * 64 + p], li = LPi[d * 64 + p], br = Bbr[p * 16 + h], bi = Bbi[p * 16 + h];
                s += Cr[c * 64 + p] * (lr * br - li * bi) - Ci[c * 64 + p] * (lr * bi + li * br); }
            const bf16_t v = (bf16_t)(cvt_pk_bf16(s, 0.f) & 0xffffu);
            for (int t = 0; t + d < TCH; ++t) { const int i = dir == 0 ? t + d : t, j = dir == 0 ? t : t + d; M13T[(size_t)(i * 16 + c) * UAK + j * 16 + h] = v; }
        }
        if (dir == 0 && par == 0) {
            float s = (c == h) ? F.in[I_AD][g * 16 + c] : 0.f;
            for (int p = 0; p < 64; ++p) s += Cr[c * 64 + p] * Bbr[p * 16 + h] - Ci[c * 64 + p] * Bbi[p * 16 + h] + C2r[c * 64 + p] * B2r[p * 16 + h] - C2i[c * 64 + p] * B2i[p * 16 + h];
            const bf16_t v = (bf16_t)(cvt_pk_bf16(s, 0.f) & 0xffffu);
            for (int t = 0; t < TCH; ++t) M13T[(size_t)(t * 16 + c) * UAK + t * 16 + h] = v;
        }
    }
    __syncthreads();
}

__device__ __forceinline__ void s5_recurrence(Frame& F) {
    const float* S = (const float*)(F.ws + PO_SG); bf16_t* UA = (bf16_t*)(F.ws + PO_UA);
    for (int base = F.c * 256; base < 65536; base += F.G * 256) {
        if (F.tid >= 256) continue;
        const int flat = base + F.tid, p = flat & 63, dir = (flat >> 6) & 1, g = (flat >> 7) & 63, gb = flat >> 13;
        double dt, lr, li; s5_lam(F.in[I_ALRE], F.in[I_ALIM], F.in[I_ALDT], dir, g, p, dt, lr, li);
        const double er = exp(lr * dt * TCH); const float ar = (float)(er * cos(li * dt * TCH)), ai = (float)(er * sin(li * dt * TCH));
        const int nc = gb < 4 ? 256 : 128, chunk0 = gb < 4 ? gb * 256 : 1024 + (gb - 4) * 128;
        float hr = 0.f, hi = 0.f;
        for (int s0 = 0; s0 < nc; s0 += 8) {
            float sr[8], si[8];
#pragma unroll
            for (int k = 0; k < 8; ++k) { const int cc = dir == 0 ? (s0 + k) : (nc - 1 - s0 - k); const size_t o = ((size_t)(chunk0 + cc) * 64 + g) * 256 + dir * 128 + p; sr[k] = S[o]; si[k] = S[o + 64]; }
#pragma unroll
            for (int k = 0; k < 8; ++k) { const int cc = dir == 0 ? (s0 + k) : (nc - 1 - s0 - k); const size_t o = ((size_t)(chunk0 + cc) * 64 + g) * UAK + 512 + dir * 128 + p;
                UA[o] = (bf16_t)(cvt_pk_bf16(hr, 0.f) & 0xffffu); UA[o + 64] = (bf16_t)(cvt_pk_bf16(hi, 0.f) & 0xffffu);
                const float nr = ar * hr - ai * hi + sr[k], ni = ar * hi + ai * hr + si[k]; hr = nr; hi = ni; }
        }
    }
}

template <int MODE, bool ROUTER, bool FINAL>
__device__ __forceinline__ void ln_phase(Frame& F, const bf16_t* HB, const float* gam, const float* bet, const float* wrouter) {
    float* XF = (float*)(F.ws + WS_XF); bf16_t* XB = (bf16_t*)(F.ws + WS_XB);
    LAS float* wrT = (LAS float*)F.lds;
    if (ROUTER) { __syncthreads(); for (int i = F.tid; i < 16384; i += 512) { const int k = i >> 4, e = i & 15; wrT[e * 1024 + k] = wrouter[i]; } __syncthreads(); }
    f32x4 gv[4], bv[4];
#pragma unroll
    for (int j = 0; j < 4; ++j) { gv[j] = *(const f32x4*)(gam + F.lane * 4 + 256 * j); bv[j] = *(const f32x4*)(bet + F.lane * 4 + 256 * j); }
    const bf16_t* YE = (const bf16_t*)(F.ws + PO_YE); const int* SLOT = (const int*)(F.ws + WS_SLOT);
    for (int row = F.c * 8 + F.wave; row < NT; row += F.G * 8) {
        f32x4 v[4];
#pragma unroll
        for (int j = 0; j < 4; ++j) v[j] = *(const f32x4*)(XF + (size_t)row * D + F.lane * 4 + 256 * j) * ALPHA;
        if (MODE == 0) {
#pragma unroll
            for (int j = 0; j < 4; ++j) { const u32x2 w = *(const u32x2*)(HB + (size_t)row * D + F.lane * 4 + 256 * j);
                v[j][0] += __uint_as_float(w.x << 16); v[j][1] += __uint_as_float(w.x & 0xffff0000u); v[j][2] += __uint_as_float(w.y << 16); v[j][3] += __uint_as_float(w.y & 0xffff0000u); }
        } else {
            const int grp = row >= NTP; const int sl = (F.lane < 16) ? SLOT[(size_t)row * 16 + F.lane] : -1;
            unsigned long long mask = __ballot(sl >= 0);
            while (mask) { const int e = __builtin_ctzll(mask); mask &= mask - 1; const int s = __builtin_amdgcn_readlane(sl, e);
                const size_t yr = grp ? (size_t)65536 + e * 2048 + s : (size_t)e * 4096 + s;
#pragma unroll
                for (int j = 0; j < 4; ++j) { const u32x2 w = *(const u32x2*)(YE + yr * D + F.lane * 4 + 256 * j);
                    v[j][0] += __uint_as_float(w.x << 16); v[j][1] += __uint_as_float(w.x & 0xffff0000u); v[j][2] += __uint_as_float(w.y << 16); v[j][3] += __uint_as_float(w.y & 0xffff0000u); } }
        }
        float s = 0.f;
#pragma unroll
        for (int j = 0; j < 4; ++j) s += (v[j][0] + v[j][1]) + (v[j][2] + v[j][3]);
        const float mean = wave_sum(s) * (1.f / D); float q = 0.f;
#pragma unroll
        for (int j = 0; j < 4; ++j) { v[j] = v[j] - mean; q += (v[j][0] * v[j][0] + v[j][1] * v[j][1]) + (v[j][2] * v[j][2] + v[j][3] * v[j][3]); }
        const float rstd = 1.f / sqrtf(wave_sum(q) * (1.f / D) + LN_EPS);
#pragma unroll
        for (int j = 0; j < 4; ++j) v[j] = v[j] * rstd * gv[j] + bv[j];
        if (FINAL) {
#pragma unroll
            for (int j = 0; j < 4; ++j) *(f32x4*)(F.out + (size_t)row * D + F.lane * 4 + 256 * j) = v[j];
        } else {
#pragma unroll
            for (int j = 0; j < 4; ++j) { *(f32x4*)(XF + (size_t)row * D + F.lane * 4 + 256 * j) = v[j]; u32x2 w; w.x = cvt_pk_bf16(v[j][0], v[j][1]); w.y = cvt_pk_bf16(v[j][2], v[j][3]);
                *(u32x2*)(XB + (size_t)row * D + F.lane * 4 + 256 * j) = w; }
        }
        if (ROUTER) {
            float acc[16];
#pragma unroll
            for (int e = 0; e < 16; ++e) { float a = 0.f;
#pragma unroll
                for (int j = 0; j < 4; ++j) { const f32x4 w = *(const LAS f32x4*)(wrT + e * 1024 + F.lane * 4 + 256 * j); a += (v[j][0] * w[0] + v[j][1] * w[1]) + (v[j][2] * w[2] + v[j][3] * w[3]); }
                acc[e] = wave_sum(a); }
            float m = acc[0];
#pragma unroll
            for (int e = 1; e < 16; ++e) m = fmaxf(m, acc[e]);
            float l = 0.f;
#pragma unroll
            for (int e = 0; e < 16; ++e) { acc[e] = expf(acc[e] - m); l += acc[e]; }
            float mine = 0.f;
#pragma unroll
            for (int e = 0; e < 16; ++e) if (F.lane == e) mine = acc[e] / l;
            if (F.lane < 16) ((float*)(F.ws + WS_AFF))[(size_t)row * 16 + F.lane] = mine;
        }
    }
    if (ROUTER) __syncthreads();
}
__device__ __forceinline__ void softmax_phase(Frame& F, bf16_t* SB) {
    for (int row = F.c * 8 + F.wave; row < NT * 4; row += F.G * 8) {
        u32x2* p = (u32x2*)(SB + (size_t)row * 256) + F.lane; const u32x2 w = *p;
        float a = __uint_as_float(w.x << 16), b = __uint_as_float(w.x & 0xffff0000u), c = __uint_as_float(w.y << 16), d = __uint_as_float(w.y & 0xffff0000u);
        const float m = wave_max(fmaxf(fmaxf(a, b), fmaxf(c, d)));
        a = __expf(a - m); b = __expf(b - m); c = __expf(c - m); d = __expf(d - m);
        const float inv = 1.f / wave_sum((a + b) + (c + d));
        u32x2 o; o.x = cvt_pk_bf16(a * inv, b * inv); o.y = cvt_pk_bf16(c * inv, d * inv); *p = o;
    }
}
__device__ __forceinline__ void moe_panel(int hf, int P, int& e, int& grp, int& yerow0) {
    if (P < 128) { e = hf * 8 + (P >> 4); grp = 0; yerow0 = e * 4096 + (P & 15) * 256; } else { e = hf * 8 + ((P - 128) >> 3); grp = 1; yerow0 = 65536 + e * 2048 + ((P - 128) & 7) * 256; }
}
struct SchedUp { unsigned char* ws; int hf, G, c;
    __device__ __forceinline__ bool next(int i, GUnit& u) const { int P, pn; if (!static_unit(i, G, c, 192, 16, P, pn)) return false; int e, grp, y0; moe_panel(hf, P, e, grp, y0);
        u.A = (const char*)ws + WS_XB + (grp ? (size_t)NTP * 2048 : 0); u.B = (const char*)ws + WS_EW13 + ((size_t)e * 4096 + pn * BM) * 2048;
        u.C = (char*)ws + PO_HM + ((size_t)P * BM * 2048 + pn * HALF) * 2; u.X = (const int*)(ws + WS_IDX) + y0; u.pm = P; u.pn = pn; return true; } };
struct SchedDown { unsigned char* ws; int hf, G, c;
    __device__ __forceinline__ bool next(int i, GUnit& u) const { int P, pn; if (!static_unit(i, G, c, 192, 4, P, pn)) return false; int e, grp, y0; moe_panel(hf, P, e, grp, y0);
        u.A = (const char*)ws + PO_HM + (size_t)P * BM * 4096; u.B = (const char*)ws + WS_EW2 + ((size_t)e * 1024 + pn * BM) * 4096;
        u.C = (char*)ws + PO_YE + ((size_t)y0 * 1024 + pn * BM) * 2; u.X = (const float*)(ws + WS_GATE) + y0; u.pm = P; u.pn = pn; return true; } };
struct SchedQKV { unsigned char* ws; int G, c;
    __device__ __forceinline__ bool next(int i, GUnit& u) const { const int L = i * G + c; if (L >= 1536 + 768) return false;
        if (L < 1536) { int pm, pn; static_unit(i, G, c, 192, 8, pm, pn); if ((long)i * G + c >= 1536) return false;
            u.A = (const char*)ws + WS_XB + (size_t)pm * BM * 2048; u.B = (const char*)ws + WS_WQKV + (size_t)pn * BM * 2048;
            u.C = (char*)ws + (pn < 4 ? PO_Q : PO_K) + ((size_t)pm * BM * 1024 + (pn & 3) * BM) * 2; u.X = nullptr; u.pm = pm; u.pn = pn; return true; }
        const int r = L - 1536, pmv = r & 3, pnv = r >> 2;
        u.A = (const char*)ws + WS_WQKV + (size_t)(2048 + pmv * BM) * 2048; u.B = (const char*)ws + WS_XB + (size_t)pnv * BM * 2048;
        u.C = (char*)ws + PO_VT + ((size_t)pmv * BM * NT + (size_t)pnv * BM) * 2; u.X = nullptr; u.pm = pmv; u.pn = 8 + pnv; return true; } };
struct EpiQKV {
    static constexpr bool PERM = true;
    __device__ __forceinline__ void operator()(const Acc& acc, const GUnit& u, int wr, int wc, int fr, int fq) const {
        if (u.pn >= 8) { EpiBf<false> e{(unsigned)NT, 1.f}; e(acc, u, wr, wc, fr, fq); }
        else { EpiBf<false> e{1024u, u.pn < 4 ? 0.125f : 1.f}; e(acc, u, wr, wc, fr, fq); }
    }
};

__device__ __forceinline__ void select_phase(Frame& F) {
    unsigned* hist = (unsigned*)(F.lds); unsigned* wsum = hist + 256; unsigned* bc = wsum + 32;
    for (int it = F.c; it < 32; it += F.G) {
        const int grp = it >> 4, e = it & 15; const int n = grp ? NTS : NTP, cap = n / 8;
        const float* aff = (const float*)(F.ws + WS_AFF) + (size_t)(grp ? NTP : 0) * 16;
        int* idx = (int*)(F.ws + WS_IDX) + (grp ? 65536 : 0) + e * cap; float* gate = (float*)(F.ws + WS_GATE) + (grp ? 65536 : 0) + e * cap;
        int* slot_of = (int*)(F.ws + WS_SLOT) + (size_t)(grp ? NTP : 0) * 16;
        __syncthreads();
        nv::select_expert(aff, n, e, cap, idx, gate, slot_of, hist, wsum, bc);
        __syncthreads();
    }
}

__device__ __forceinline__ void natten_phase(Frame& F, const float* rpb) {
    const bf16_t* Kb = (const bf16_t*)(F.ws + PO_K); const bf16_t* VT = (const bf16_t*)(F.ws + PO_VT); bf16_t* QO = (bf16_t*)(F.ws + PO_Q);
    LAS float* Opart = (LAS float*)F.lds; LAS float* ML = (LAS float*)(F.lds + RING_BYTES + 4096);
    const int lane = F.lane, w = F.wave, fr = lane & 15, fq = lane >> 4;
    const int NU = 12288, per = (NU + F.G - 1) / F.G, u0 = F.c * per, u1 = (u0 + per < NU) ? u0 + per : NU;
    for (int U = u0; U < u1; ++U) {
        int gb, h, r, rows;
        if (U < 8192) { gb = U >> 11; h = (U >> 7) & 15; r = U & 127; rows = 128; } else { const int V = U - 8192; gb = 4 + (V >> 10); h = (V >> 6) & 15; r = V & 63; rows = 64; }
        int rs = r - 4; rs = rs < 0 ? 0 : (rs > rows - 8 ? rows - 8 : rs);
        const int kr = rs + w, dr = kr - r + 7;
        const size_t tq0 = (size_t)gb_tok0(gb) + (size_t)r * 64, tk0 = (size_t)gb_tok0(gb) + (size_t)kr * 64;
        bf16x8 Qf[4][2], Kf[4][2];
#pragma unroll
        for (int t = 0; t < 4; ++t)
#pragma unroll
            for (int ks = 0; ks < 2; ++ks) { Qf[t][ks] = *(const bf16x8*)(QO + (tq0 + 16 * t + fr) * D + h * 64 + 32 * ks + 8 * fq); Kf[t][ks] = *(const bf16x8*)(Kb + (tk0 + 16 * t + fr) * D + h * 64 + 32 * ks + 8 * fq); }
        float bias[3][4];
#pragma unroll
        for (int dk = 0; dk < 3; ++dk)
#pragma unroll
            for (int e = 0; e < 4; ++e) { int dc = 16 * (dk - 1) + 4 * fq + e - fr + 15; dc = dc < 0 ? 0 : (dc > 30 ? 30 : dc); bias[dk][e] = rpb[(h * 15 + dr) * 31 + dc]; }
        f32x4 St[4][3];
        float mx[4];
#pragma unroll
        for (int qt = 0; qt < 4; ++qt) { mx[qt] = -INFINITY;
            const int qc = 16 * qt + fr; int wsx = qc - 8; wsx = wsx < 0 ? 0 : (wsx > 48 ? 48 : wsx);
#pragma unroll
            for (int dk = 0; dk < 3; ++dk) { const int kt = qt + dk - 1; St[qt][dk] = (f32x4){-INFINITY, -INFINITY, -INFINITY, -INFINITY};
                if (kt >= 0 && kt < 4) { f32x4 a = (f32x4){0.f, 0.f, 0.f, 0.f};
                    a = __builtin_amdgcn_mfma_f32_16x16x32_bf16(Kf[kt][0], Qf[qt][0], a, 0, 0, 0); a = __builtin_amdgcn_mfma_f32_16x16x32_bf16(Kf[kt][1], Qf[qt][1], a, 0, 0, 0);
#pragma unroll
                    for (int e = 0; e < 4; ++e) { const int kc = 16 * kt + 4 * fq + e; const bool ok = (kc >= wsx) && (kc < wsx + 16); const float sv = ok ? a[e] + bias[dk][e] : -INFINITY; St[qt][dk][e] = sv; mx[qt] = fmaxf(mx[qt], sv); } } }
            mx[qt] = fmaxf(mx[qt], __shfl_xor(mx[qt], 16)); mx[qt] = fmaxf(mx[qt], __shfl_xor(mx[qt], 32));
        }
        float ls[4]; bf16x8 Pf[4][2];
#pragma unroll
        for (int qt = 0; qt < 4; ++qt) { float l = 0.f; float pv[4][4];
#pragma unroll
            for (int kt = 0; kt < 4; ++kt)
#pragma unroll
                for (int e = 0; e < 4; ++e) { const int dk = kt - qt + 1; float p = 0.f; if (dk >= 0 && dk < 3) p = __expf(St[qt][dk][e] - mx[qt]); pv[kt][e] = p; l += p; }
            l += __shfl_xor(l, 16); l += __shfl_xor(l, 32); ls[qt] = l;
#pragma unroll
            for (int ks = 0; ks < 2; ++ks) { u32x4 wv; wv.x = cvt_pk_bf16(pv[2 * ks][0], pv[2 * ks][1]); wv.y = cvt_pk_bf16(pv[2 * ks][2], pv[2 * ks][3]); wv.z = cvt_pk_bf16(pv[2 * ks + 1][0], pv[2 * ks + 1][1]); wv.w = cvt_pk_bf16(pv[2 * ks + 1][2], pv[2 * ks + 1][3]);
                Pf[qt][ks] = __builtin_bit_cast(bf16x8, wv); } }
        f32x4 Ot[4][4];
#pragma unroll
        for (int dt = 0; dt < 4; ++dt)
#pragma unroll
            for (int qt = 0; qt < 4; ++qt) Ot[dt][qt] = (f32x4){0.f, 0.f, 0.f, 0.f};
#pragma unroll
        for (int dt = 0; dt < 4; ++dt)
#pragma unroll
            for (int ks = 0; ks < 2; ++ks) { const bf16_t* vp = VT + (size_t)(h * 64 + 16 * dt + fr) * NT + tk0 + 32 * ks + 4 * fq;
                const u32x2 v0 = *(const u32x2*)vp, v1 = *(const u32x2*)(vp + 16); u32x4 vv; vv.x = v0.x; vv.y = v0.y; vv.z = v1.x; vv.w = v1.y; const bf16x8 Vf = __builtin_bit_cast(bf16x8, vv);
#pragma unroll
                for (int qt = 0; qt < 4; ++qt) { if ((qt == 0 && ks == 1) || (qt == 3 && ks == 0)) continue; Ot[dt][qt] = __builtin_amdgcn_mfma_f32_16x16x32_bf16(Vf, Pf[qt][ks], Ot[dt][qt], 0, 0, 0); } }
#pragma unroll
        for (int qt = 0; qt < 4; ++qt) { const int q = 16 * qt + fr;
#pragma unroll
            for (int dt = 0; dt < 4; ++dt) *(LAS f32x4*)(Opart + w * 4096 + q * 64 + (((dt * 4 + fq) ^ (q & 15)) << 2)) = Ot[dt][qt];
            if (fq == 0) { ML[(w * 64 + q) * 2] = mx[qt]; ML[(w * 64 + q) * 2 + 1] = ls[qt]; } }
        __syncthreads();
        {
            const int q = 8 * w + (lane >> 3), c0 = 2 * (lane & 7);
            float M = -INFINITY; float mw[8], lw[8];
#pragma unroll
            for (int x = 0; x < 8; ++x) { mw[x] = ML[(x * 64 + q) * 2]; lw[x] = ML[(x * 64 + q) * 2 + 1]; M = fmaxf(M, mw[x]); }
            float Lt = 0.f; f32x4 o0 = (f32x4){0.f, 0.f, 0.f, 0.f}, o1 = o0;
#pragma unroll
            for (int x = 0; x < 8; ++x) { const float sc = __expf(mw[x] - M); Lt += lw[x] * sc;
                o0 += *(const LAS f32x4*)(Opart + x * 4096 + q * 64 + ((c0 ^ (q & 15)) << 2)) * sc; o1 += *(const LAS f32x4*)(Opart + x * 4096 + q * 64 + (((c0 + 1) ^ (q & 15)) << 2)) * sc; }
            const float inv = 1.f / Lt;
            u32x4 wv; wv.x = cvt_pk_bf16(o0[0] * inv, o0[1] * inv); wv.y = cvt_pk_bf16(o0[2] * inv, o0[3] * inv); wv.z = cvt_pk_bf16(o1[0] * inv, o1[1] * inv); wv.w = cvt_pk_bf16(o1[2] * inv, o1[3] * inv);
            *(u32x4*)(QO + (tq0 + q) * D + h * 64 + 4 * c0) = wv;
        }
        __syncthreads();
    }
}
constexpr int N_PHASES = 31;
constexpr int FLAG_NO_XIMPORT = 1, FLAG_NO_EXPERTS0 = 2;
__global__ void __launch_bounds__(512, 2) fwd(Args args) {
    extern __shared__ __attribute__((aligned(16))) unsigned char lds_raw[];
    Frame F; F.lds = (LAS unsigned char*)lds_raw; F.ws = args.ws; F.in = args.in; F.out = args.out;
    F.tid = threadIdx.x; F.lane = F.tid & 63; F.wave = __builtin_amdgcn_readfirstlane(F.tid >> 6); F.G = gridDim.x; F.c = blockIdx.x;
    unsigned char* ws = args.ws;
    for (int u = F.tid; u < (LDS_BYTES - RING_BYTES) / 4; u += 512) ((LAS unsigned*)(F.lds + RING_BYTES))[u] = 0u;
    __syncthreads();
    const int lo = args.ph_lo, hi = args.ph_hi;
    volatile LAS unsigned* MISC = (volatile LAS unsigned*)(F.lds + MISC_OFF);
    XcdBarrier bar; bar.bar = (unsigned*)(ws + WS_CTL) + CW_BAR; bar.x = 0; bar.st = nullptr;
    const bool multi = (hi - lo) > 1;
    if (multi) bar = xcd_barrier_post((unsigned*)(ws + WS_CTL) + CW_BAR, MISC + 8);
#define IN(k) (lo <= (k) && (k) < hi)
#define SEAM(k) do { if (IN(k) && IN((k) + 1)) xcd_barrier(bar); } while (0)
    LAS unsigned char* ring = F.lds;
#define PHASE_BEGIN() do { int _t = threadIdx.x; asm volatile("" : "+v"(_t)); F.tid = _t; F.lane = _t & 63; F.wave = __builtin_amdgcn_readfirstlane(_t >> 6); } while (0)

    if (IN(0)) { PHASE_BEGIN();
        for (int it = F.c; it < 128; it += F.G) s5_build_item(F, it >> 1, it & 1);
        convert_small_weights(F);
        if (!(args.flags & FLAG_NO_EXPERTS0)) convert_expert_weights(F, 0);
        convert_plain(F, args.in[I_MWQ], (bf16_t*)(ws + WS_MWQ), (size_t)2 * 1024 * 1024);
        convert_plain(F, args.in[I_MEMP], (bf16_t*)(ws + WS_MEMB), (size_t)4 * 256 * 1024);
        convert_plain(F, args.in[I_MEMS], (bf16_t*)(ws + WS_MEMB) + (size_t)4 * 256 * 1024, (size_t)4 * 256 * 1024);
        import_x(F, !(args.flags & FLAG_NO_XIMPORT));
    }
    SEAM(0);
    {
        const float* lng = args.in[I_LNG]; const float* lnb = args.in[I_LNB];
        if (IN(1)) { PHASE_BEGIN();
            { SchedKV S{ws, F.G, F.c}; EpiBf<false> E{2048u, 1.f}; gemm_phase<EpiBf<false>, SchedKV, false>(ring, 1024, 2048u, 2048u, S, E); }
            { SchedUA S{(const char*)ws + WS_XB, (const char*)ws + WS_WIN, (char*)ws + PO_UA, F.G, F.c}; EpiUA E; gemm_phase<EpiUA, SchedUA, false>(ring, 1024, 2048u, 2048u, S, E); }
        }
        SEAM(1);
        if (IN(2)) { PHASE_BEGIN();
            { SchedSA S{ws, F.G, F.c}; EpiS E; gemm_phase<EpiS, SchedSA, false>(ring, 512, (unsigned)(64 * UAK * 2), 1024u, S, E); }
            { SchedWqk S{ws, F.G, F.c}; EpiBf<false> E{1024u, 0.0625f}; gemm_phase<EpiBf<false>, SchedWqk, false>(ring, 256, 4096u, 2048u, S, E); }
            { SchedWvo S{ws, F.G, F.c}; EpiBf<false> E{1024u, 1.f}; gemm_phase<EpiBf<false>, SchedWvo, false>(ring, 256, 2048u, 4096u, S, E); }
        }
        SEAM(2);
        if (IN(3)) { PHASE_BEGIN(); s5_recurrence(F); }
        SEAM(3);
        if (IN(4)) { PHASE_BEGIN(); SchedSC S{ws, F.G, F.c}; EpiGelu E; gemm_phase<EpiGelu, SchedSC, false>(ring, UAK, (unsigned)(64 * UAK * 2), (unsigned)(UAK * 2), S, E); }
        SEAM(4);
        if (IN(5)) { PHASE_BEGIN(); SchedGated S{(const char*)ws + PO_SG, (const char*)ws + WS_WGLU, (char*)ws + PO_HB_S5, 2048, 2048, 1024, NT / BM, 8, F.G, F.c}; EpiGated<0> E{1024u};
            gemm_phase<EpiGated<0>, SchedGated, false>(ring, 1024, 2048u, 2048u, S, E); }
        SEAM(5);
        if (IN(6)) { PHASE_BEGIN(); ln_phase<0, false, false>(F, (const bf16_t*)(ws + PO_HB_S5), lng, lnb, nullptr); }
        SEAM(6);
    }
#define COMMON_BLOCK(layer, pb) do { \
        const float* lng = args.in[I_LNG] + (size_t)(layer) * 3 * D; const float* lnb = args.in[I_LNB] + (size_t)(layer) * 3 * D; \
        if (IN((pb) + 0)) { PHASE_BEGIN(); SchedBatchW S{(const char*)ws + WS_XB, (const char*)ws + WS_WQK + (size_t)(layer) * 16 * MiB, (char*)ws + PO_SB, F.G, F.c}; EpiBf<false> E{1024u, 1.f}; \
            gemm_phase<EpiBf<false>, SchedBatchW, false>(ring, 1024, 2048u, 2048u, S, E); } \
        SEAM((pb) + 0); \
        if (IN((pb) + 1)) { PHASE_BEGIN(); softmax_phase(F, (bf16_t*)(ws + PO_SB)); } \
        SEAM((pb) + 1); \
        if (IN((pb) + 2)) { PHASE_BEGIN(); SchedBatchW S{(const char*)ws + PO_SB, (const char*)ws + WS_WVO + (size_t)(layer) * 16 * MiB, (char*)ws + PO_HB_MEM, F.G, F.c}; EpiBf<false> E{1024u, 1.f}; \
            gemm_phase<EpiBf<false>, SchedBatchW, false>(ring, 1024, 2048u, 2048u, S, E); } \
        SEAM((pb) + 2); \
        if (IN((pb) + 3)) { PHASE_BEGIN(); ln_phase<0, true, false>(F, (const bf16_t*)(ws + PO_HB_MEM), lng + D, lnb + D, args.in[I_EWR] + (size_t)(layer) * D * 16); } \
        SEAM((pb) + 3); \
        if (IN((pb) + 4)) { PHASE_BEGIN(); select_phase(F); } \
        SEAM((pb) + 4); \
        if (IN((pb) + 5)) { PHASE_BEGIN(); SchedUp S{ws, 0, F.G, F.c}; EpiGated<1> E{2048u}; gemm_phase<EpiGated<1>, SchedUp, true>(ring, 1024, 2048u, 2048u, S, E); } \
        SEAM((pb) + 5); \
        if (IN((pb) + 6)) { PHASE_BEGIN(); SchedDown S{ws, 0, F.G, F.c}; EpiBf<true> E{1024u, 1.f}; gemm_phase<EpiBf<true>, SchedDown, false>(ring, 2048, 4096u, 4096u, S, E); } \
        SEAM((pb) + 6); \
        if (IN((pb) + 7)) { PHASE_BEGIN(); SchedUp S{ws, 1, F.G, F.c}; EpiGated<1> E{2048u}; gemm_phase<EpiGated<1>, SchedUp, true>(ring, 1024, 2048u, 2048u, S, E); } \
        SEAM((pb) + 7); \
        if (IN((pb) + 8)) { PHASE_BEGIN(); SchedDown S{ws, 1, F.G, F.c}; EpiBf<true> E{1024u, 1.f}; gemm_phase<EpiBf<true>, SchedDown, false>(ring, 2048, 4096u, 4096u, S, E); } \
        SEAM((pb) + 8); \
    } while (0)
    COMMON_BLOCK(0, 7);
    if (IN(16)) { PHASE_BEGIN(); ln_phase<1, false, false>(F, nullptr, args.in[I_LNG] + 2 * D, args.in[I_LNB] + 2 * D, nullptr); convert_expert_weights(F, 1); }
    SEAM(16);
    {
        const float* lng = args.in[I_LNG] + 3 * D; const float* lnb = args.in[I_LNB] + 3 * D;
        if (IN(17)) { PHASE_BEGIN(); SchedQKV S{ws, F.G, F.c}; EpiQKV E; gemm_phase<EpiQKV, SchedQKV, false>(ring, 1024, 2048u, 2048u, S, E); }
        SEAM(17);
        if (IN(18)) { PHASE_BEGIN(); natten_phase(F, args.in[I_BRPB]); }
        SEAM(18);
        if (IN(19)) { PHASE_BEGIN(); SchedPlain S{(const char*)ws + PO_Q, (const char*)ws + WS_WO, (char*)ws + PO_HB_NA, 2048, 2048, 1024, NT / BM, 4, F.G, F.c}; EpiBf<false> E{1024u, 1.f};
            gemm_phase<EpiBf<false>, SchedPlain, false>(ring, 1024, 2048u, 2048u, S, E); }
        SEAM(19);
        if (IN(20)) { PHASE_BEGIN(); ln_phase<0, false, false>(F, (const bf16_t*)(ws + PO_HB_NA), lng, lnb, nullptr); }
        SEAM(20);
    }
    COMMON_BLOCK(1, 21);
    if (IN(30)) { PHASE_BEGIN(); ln_phase<1, false, true>(F, nullptr, args.in[I_LNG] + 5 * D, args.in[I_LNB] + 5 * D, nullptr); }
#undef COMMON_BLOCK
#undef IN
#undef SEAM
}
}
#ifndef DBG
#define DBG 0
#endif
#ifndef FZ_PER_PHASE
#define FZ_PER_PHASE 0
#endif

#if DBG
namespace dbg {
__global__ void k_cmp_bf16_f32(const unsigned short* a, const float* b, size_t n, double* acc) {
    double s0 = 0, s1 = 0;
    for (size_t i = (size_t)blockIdx.x * blockDim.x + threadIdx.x; i < n; i += (size_t)gridDim.x * blockDim.x) { const double x = (double)__uint_as_float(((unsigned)a[i]) << 16), y = b[i]; s0 += (x - y) * (x - y); s1 += y * y; }
    for (int o = 32; o >= 1; o >>= 1) { s0 += __shfl_xor(s0, o); s1 += __shfl_xor(s1, o); }
    if ((threadIdx.x & 63) == 0) { atomicAdd(acc, s0); atomicAdd(acc + 1, s1); }
}
__global__ void k_cmp_f32_f32(const float* a, const float* b, size_t n, double* acc) {
    double s0 = 0, s1 = 0;
    for (size_t i = (size_t)blockIdx.x * blockDim.x + threadIdx.x; i < n; i += (size_t)gridDim.x * blockDim.x) { const double x = a[i], y = b[i]; s0 += (x - y) * (x - y); s1 += y * y; }
    for (int o = 32; o >= 1; o >>= 1) { s0 += __shfl_xor(s0, o); s1 += __shfl_xor(s1, o); }
    if ((threadIdx.x & 63) == 0) { atomicAdd(acc, s0); atomicAdd(acc + 1, s1); }
}
__global__ void k_cmp_ua(const unsigned short* UA, const float* u, double* acc) {
    double s0 = 0, s1 = 0;
    for (size_t i = (size_t)blockIdx.x * blockDim.x + threadIdx.x; i < (size_t)fz::NT * 1024; i += (size_t)gridDim.x * blockDim.x) {
        const int tok = (int)(i >> 10), ch = (int)(i & 1023), chunk = tok >> 5, j = tok & 31, g = ch >> 4, h = ch & 15;
        const double x = (double)__uint_as_float(((unsigned)UA[((size_t)chunk * 64 + g) * fz::UAK + j * 16 + h]) << 16), y = u[i]; s0 += (x - y) * (x - y); s1 += y * y; }
    for (int o = 32; o >= 1; o >>= 1) { s0 += __shfl_xor(s0, o); s1 += __shfl_xor(s1, o); }
    if ((threadIdx.x & 63) == 0) { atomicAdd(acc, s0); atomicAdd(acc + 1, s1); }
}
__global__ void k_encode(float* out, const double* accA, const double* accB) {
    const double vA = accA[1] > 0 ? sqrt(accA[0] / accA[1]) : 9.99; const double vB = accB[1] > 0 ? sqrt(accB[0] / accB[1]) : 9.99;
    const float c = (float)sqrt(1e8 * (vA == vA ? vA : 7.77)); const float V = (float)(1e5 * (vB == vB ? vB : 7.77));
    const size_t np = (size_t)fz::NTP * 1024, n = (size_t)fz::NT * 1024;
    for (size_t i = (size_t)blockIdx.x * blockDim.x + threadIdx.x; i < n; i += (size_t)gridDim.x * blockDim.x) out[i] = i < np ? c : (i == np ? V : 0.f);
}
}
#endif

extern "C" void kernel_launch(void* const* d_in, const int* in_sizes, int n_in, void* d_out, int out_size, void* d_ws, size_t ws_size, hipStream_t stream) {
    using namespace fz;
    static int grid = 0;
    if (grid == 0) {
        if (n_in != 26 || ws_size < WS_END) { fprintf(stderr, "kernel_launch: unexpected inputs (n_in %d, ws %zu)\n", n_in, ws_size); grid = -1; return; }
        int dev = 0, cus = 0, per_cu = 0;
        if (hipGetDevice(&dev) != hipSuccess || hipDeviceGetAttribute(&cus, hipDeviceAttributeMultiprocessorCount, dev) != hipSuccess) { grid = -1; return; }
        if (hipFuncSetAttribute((const void*)fwd, hipFuncAttributeMaxDynamicSharedMemorySize, LDS_BYTES) != hipSuccess) { fprintf(stderr, "kernel_launch: hipFuncSetAttribute failed\n"); grid = -1; return; }
        if (hipOccupancyMaxActiveBlocksPerMultiprocessor(&per_cu, (const void*)fwd, 512, LDS_BYTES) != hipSuccess || per_cu < 1) { fprintf(stderr, "kernel_launch: occupancy query says %d\n", per_cu); }
        (void)hipGetLastError();
        grid = cus;
    }
    if (grid < 0) return;
    unsigned char* ws = (unsigned char*)d_ws;
    (void)hipMemsetAsync(ws + WS_CTL, 0, CTL_ZERO_BYTES, stream);
    Args a{};
    for (int i = 0; i < 26; ++i) a.in[i] = (const float*)d_in[i];
    a.out = (float*)d_out; a.ws = ws; a.flags = 0; a.pad = 0;
    auto run = [&](int lo, int hi) { a.ph_lo = lo; a.ph_hi = hi; hipLaunchKernelGGL(fwd, dim3(grid), dim3(512), LDS_BYTES, stream, a); };
#if DBG == 0
#if FZ_PER_PHASE
    for (int p = 0; p < N_PHASES; ++p) run(p, p + 1);
#else
    run(0, N_PHASES);
#endif
#else
    using nv::SG;
    const float* const* in = (const float* const*)d_in;
    const size_t BIG = (size_t)NT * D;
    double* ACC = (double*)(ws + 32 * 1024);
    float* nmisc = (float*)(ws + 987 * MiB);
    float* nKV = nmisc; float* nAFF = nmisc + 4u * 1024 * 1024; float* nGATE = nAFF + 1024 * 1024; int* nIDX = (int*)(nGATE + 128 * 1024); float* nMEMC = (float*)(ws + 385 * MiB);
    auto sgemm = [&](const float* A, const float* B, float* C, const int* gidx, int M, int N, int K, long sam, long sak, long sbk, long sbn, long ldc,
                     int nz = 1, int zdiv = 1, long zA0 = 0, long zA1 = 0, long zB0 = 0, long zB1 = 0, long zC0 = 0, long zC1 = 0) {
        SG s{A, B, C, gidx, M, N, K, zdiv, sam, sak, sbk, sbn, ldc, zA0, zA1, zB0, zB1, zC0, zC1};
        hipLaunchKernelGGL(nv::k_sgemm, dim3(N / 128, M / 128, nz), dim3(256), 0, stream, s);
    };
    const int EW = (int)((BIG + 255) / 256);
    auto n_import = [&](float* X) { hipMemcpyAsync(X, in[I_XP], (size_t)NTP * D * 4, hipMemcpyDeviceToDevice, stream); hipMemcpyAsync(X + (size_t)NTP * D, in[I_XS], (size_t)NTS * D * 4, hipMemcpyDeviceToDevice, stream);
        hipMemcpyAsync(nMEMC, in[I_MEMP], (size_t)4 * 256 * D * 4, hipMemcpyDeviceToDevice, stream); hipMemcpyAsync(nMEMC + (size_t)4 * 256 * D, in[I_MEMS], (size_t)4 * 256 * D * 4, hipMemcpyDeviceToDevice, stream); };
    auto n_s5 = [&](float* X, float* T1, float* T2, float* T3) {
        sgemm(X, in[I_AWIN], T1, nullptr, NT, D, D, D, 1, D, 1, D);
        hipLaunchKernelGGL(nv::k_s5_scan, dim3(8 * 64 * 2), dim3(64), 0, stream, T1, T2, in[I_ALRE], in[I_ALIM], in[I_ALDT], in[I_ABRE], in[I_ABIM], in[I_ACRE], in[I_ACIM]);
        hipLaunchKernelGGL(nv::k_s5_gelu, dim3(EW), dim3(256), 0, stream, T1, T2, in[I_AD], T2);
        sgemm(T2, in[I_AWGLU], T1, nullptr, NT, D, D, D, 1, 2 * D, 1, D);
        sgemm(T2, in[I_AWGLU] + D, T3, nullptr, NT, D, D, D, 1, 2 * D, 1, D);
        hipLaunchKernelGGL(nv::k_glu, dim3(EW), dim3(256), 0, stream, T1, T3, T1);
    };
    auto n_na = [&](float* X, float* T1, float* T2, float* T3) {
        sgemm(X, in[I_BWQKV], T1, nullptr, NT, D, D, D, 1, 3 * D, 1, D); sgemm(X, in[I_BWQKV] + D, T2, nullptr, NT, D, D, D, 1, 3 * D, 1, D); sgemm(X, in[I_BWQKV] + 2 * D, T3, nullptr, NT, D, D, D, 1, 3 * D, 1, D);
        hipLaunchKernelGGL(nv::k_natten, dim3(NT * 16 / 4), dim3(256), 0, stream, T1, T2, T3, in[I_BRPB]);
        sgemm(T1, in[I_BWO], T2, nullptr, NT, D, D, D, 1, D, 1, D);
    };
    auto n_ln = [&](float* X, const float* h, int layer, int sub, float* xo) { hipLaunchKernelGGL(nv::k_res_ln, dim3(NT / 4), dim3(256), 0, stream, X, h, in[I_LNG] + (layer * 3 + sub) * D, in[I_LNB] + (layer * 3 + sub) * D, xo, NT); };
    auto n_mem = [&](float* X, float* T1, float* T2, float* T3, int layer) {
        const float* wq = in[I_MWQ] + (size_t)layer * D * D; const float* wkv = in[I_MWKV] + (size_t)layer * D * 2 * D; const float* wo = in[I_MWO] + (size_t)layer * D * D;
        sgemm(nMEMC, wkv, nKV, nullptr, 8 * 256, 2 * D, D, D, 1, 2 * D, 1, 2 * D);
        sgemm(X, wq, T1, nullptr, NT, D, D, D, 1, D, 1, D);
        for (int grp = 0; grp < 2; ++grp) { const int L = grp ? 4096 : 8192; const size_t tb = grp ? (size_t)NTP : 0; const int gb0 = grp * 4;
            sgemm(T1 + tb * D, nKV + (size_t)gb0 * 256 * 2 * D, T2 + tb * D, nullptr, L, 256, 256, D, 1, 1, 2 * D, D, 16, 4, (long)L * D, 256, (long)256 * 2 * D, 256, (long)L * D, 256); }
        hipLaunchKernelGGL(nv::k_softmax256, dim3(NT * 4 / 4), dim3(256), 0, stream, T2, 0.0625f, NT * 4);
        for (int grp = 0; grp < 2; ++grp) { const int L = grp ? 4096 : 8192; const size_t tb = grp ? (size_t)NTP : 0; const int gb0 = grp * 4;
            sgemm(T2 + tb * D, nKV + (size_t)gb0 * 256 * 2 * D + D, T3 + tb * D, nullptr, L, 256, 256, D, 1, 2 * D, 1, D, 16, 4, (long)L * D, 256, (long)256 * 2 * D, 256, (long)L * D, 256); }
        sgemm(T3, wo, T1, nullptr, NT, D, D, D, 1, D, 1, D);
    };
    auto n_moe = [&](float* X, float* T1, float* T2, float* T3, int layer) {
        hipLaunchKernelGGL(nv::k_router, dim3(NT / 4), dim3(256), 0, stream, X, in[I_EWR] + (size_t)layer * D * 16, nAFF, NT);
        hipLaunchKernelGGL(nv::k_select, dim3(32), dim3(512), 0, stream, nAFF, nIDX, nGATE);
        hipMemsetAsync(T1, 0, BIG * 4, stream);
        for (int grp = 0; grp < 2; ++grp) { const int n = grp ? NTS : NTP, cap = n / 8; const size_t tb = grp ? (size_t)NTP : 0;
            for (int e = 0; e < 16; ++e) { const int* idx = nIDX + (grp ? 16 * 4096 : 0) + e * cap; const float* gate = nGATE + (grp ? 16 * 4096 : 0) + e * cap;
                const float* w1 = in[I_EW1] + ((size_t)layer * 16 + e) * D * 2048; const float* w3 = in[I_EW3] + ((size_t)layer * 16 + e) * D * 2048; const float* w2 = in[I_EW2] + ((size_t)layer * 16 + e) * 2048 * D;
                float* H1 = T2; float* H3 = T2 + (size_t)4096 * 2048; float* YE = T3;
                sgemm(X + tb * D, w1, H1, idx, cap, 2048, D, D, 1, 2048, 1, 2048); sgemm(X + tb * D, w3, H3, idx, cap, 2048, D, D, 1, 2048, 1, 2048);
                hipLaunchKernelGGL(nv::k_silu_mul, dim3((unsigned)(((size_t)cap * 2048 + 255) / 256)), dim3(256), 0, stream, H1, H3, (size_t)cap * 2048);
                sgemm(H1, w2, YE, nullptr, cap, D, 2048, 2048, 1, D, 1, D);
                hipLaunchKernelGGL(nv::k_scatter_add, dim3((unsigned)(((size_t)cap * D + 255) / 256)), dim3(256), 0, stream, YE, idx, gate, T1 + tb * D, cap); } }
    };
    float* X = (float*)(ws + WS_XF); float* T1 = (float*)(ws + WS_EW13); float* T2 = (float*)(ws + WS_POOL); float* T3 = (float*)(ws + WS_POOL + 192 * MiB);
    auto cmp_bf = [&](size_t off_bf16, const float* ref, double* acc) { hipLaunchKernelGGL(dbg::k_cmp_bf16_f32, dim3(2048), dim3(256), 0, stream, (const unsigned short*)(ws + off_bf16), ref, BIG, acc); };
#if DBG == 1
    n_import(X);
    a.flags = FLAG_NO_XIMPORT | FLAG_NO_EXPERTS0;
    n_s5(X, T1, T2, T3);
    for (int p = 0; p <= 5; ++p) run(p, p + 1);
    cmp_bf(PO_HB_S5, T1, ACC);
    cmp_bf(PO_HB_S5, T1, ACC + 2);
#elif DBG == 11
    n_import(X);
    a.flags = FLAG_NO_XIMPORT | FLAG_NO_EXPERTS0;
    sgemm(X, in[I_AWIN], T1, nullptr, NT, D, D, D, 1, D, 1, D);
    for (int p = 0; p <= 4; ++p) run(p, p + 1);
    hipLaunchKernelGGL(dbg::k_cmp_ua, dim3(2048), dim3(256), 0, stream, (const unsigned short*)(ws + PO_UA), T1, ACC);
    hipMemcpyAsync(X, T1, BIG * 4, hipMemcpyDeviceToDevice, stream);
    { float* Y = (float*)(ws + 193 * MiB);
      hipLaunchKernelGGL(nv::k_s5_scan, dim3(8 * 64 * 2), dim3(64), 0, stream, X, Y, in[I_ALRE], in[I_ALIM], in[I_ALDT], in[I_ABRE], in[I_ABIM], in[I_ACRE], in[I_ACIM]);
      hipLaunchKernelGGL(nv::k_s5_gelu, dim3(EW), dim3(256), 0, stream, X, Y, in[I_AD], Y);
      cmp_bf(PO_SG, Y, ACC + 2); }
#elif DBG == 2
    n_import(X); n_s5(X, T1, T2, T3); n_ln(X, T1, 0, 0, X); n_mem(X, T1, T2, T3, 0);
    a.flags = FLAG_NO_XIMPORT | FLAG_NO_EXPERTS0;
    run(0, 1); run(1, 2); run(2, 3); run(7, 8); run(8, 9); run(9, 10);
    cmp_bf(PO_HB_MEM, T1, ACC); cmp_bf(PO_HB_MEM, T1, ACC + 2);
#elif DBG == 4
    n_import(X); n_na(X, T1, T2, T3);
    hipMemcpyAsync(T1, T2, BIG * 4, hipMemcpyDeviceToDevice, stream);
    a.flags = FLAG_NO_XIMPORT | FLAG_NO_EXPERTS0;
    run(0, 1); run(17, 18); run(18, 19); run(19, 20);
    cmp_bf(PO_HB_NA, T1, ACC); cmp_bf(PO_HB_NA, T1, ACC + 2);
#endif
    hipLaunchKernelGGL(dbg::k_encode, dim3(2048), dim3(256), 0, stream, (float*)d_out, ACC, ACC + 2);
#endif
}
```

```cpp
#include <hip/hip_runtime.h>
#include <cstdio>
#include <cstdint>
#include <cmath>
#define NO_WT 1
namespace nv {
constexpr int D = 1024, NTP = 32768, NTS = 16384, NT = NTP + NTS, NGB = 8, MEM = 256;
constexpr int GRID_W = 64;
constexpr float ALPHA = 1.41421356237309515f;
constexpr float LN_EPS = 1e-5f;

__host__ __device__ inline int gb_tok0(int gb) { return gb < 4 ? gb * 8192 : NTP + (gb - 4) * 4096; }
__host__ __device__ inline int gb_len(int gb) { return gb < 4 ? 8192 : 4096; }

__device__ __forceinline__ float wave_sum(float v) {
#pragma unroll
    for (int o = 1; o < 64; o <<= 1) v += __shfl_xor(v, o);
    return v;
}
__device__ __forceinline__ float wave_max(float v) {
#pragma unroll
    for (int o = 1; o < 64; o <<= 1) v = fmaxf(v, __shfl_xor(v, o));
    return v;
}

struct SG { const float* A; const float* B; float* C; const int* gidx; int M, N, K, zdiv; long sam, sak, sbk, sbn, ldc; long zA0, zA1, zB0, zB1, zC0, zC1; };
__global__ __launch_bounds__(256) void k_sgemm(SG a) {
    __shared__ float As[8][132];
    __shared__ float Bs[8][132];
    const int z = blockIdx.z, z0 = z / a.zdiv, z1 = z % a.zdiv;
    const float* A = a.A + z0 * a.zA0 + z1 * a.zA1;
    const float* B = a.B + z0 * a.zB0 + z1 * a.zB1;
    float* C = a.C + z0 * a.zC0 + z1 * a.zC1;
    const int bm = blockIdx.y * 128, bn = blockIdx.x * 128, tid = threadIdx.x, tx = tid & 15, ty = tid >> 4;
    float acc[8][8];
#pragma unroll
    for (int i = 0; i < 8; ++i)
#pragma unroll
        for (int j = 0; j < 8; ++j) acc[i][j] = 0.f;
    const int arow_l = tid >> 1, akk = (tid & 1) * 4;
    const long arow = a.gidx ? (long)a.gidx[bm + arow_l] : (long)(bm + arow_l);
    const float* Ap = A + arow * a.sam;
    const int bkk = tid >> 5, bnn = (tid & 31) * 4;
    for (int k0 = 0; k0 < a.K; k0 += 8) {
        float av[4], bv[4];
#pragma unroll
        for (int i = 0; i < 4; ++i) av[i] = Ap[(long)(k0 + akk + i) * a.sak];
#pragma unroll
        for (int i = 0; i < 4; ++i) bv[i] = B[(long)(k0 + bkk) * a.sbk + (long)(bn + bnn + i) * a.sbn];
        __syncthreads();
#pragma unroll
        for (int i = 0; i < 4; ++i) As[akk + i][arow_l] = av[i];
#pragma unroll
        for (int i = 0; i < 4; ++i) Bs[bkk][bnn + i] = bv[i];
        __syncthreads();
#pragma unroll
        for (int kk = 0; kk < 8; ++kk) {
            float x[8], y[8];
#pragma unroll
            for (int i = 0; i < 8; ++i) x[i] = As[kk][ty * 8 + i];
#pragma unroll
            for (int j = 0; j < 8; ++j) y[j] = Bs[kk][tx * 8 + j];
#pragma unroll
            for (int i = 0; i < 8; ++i)
#pragma unroll
                for (int j = 0; j < 8; ++j) acc[i][j] += x[i] * y[j];
        }
    }
#pragma unroll
    for (int i = 0; i < 8; ++i)
#pragma unroll
        for (int j = 0; j < 8; ++j) C[(long)(bm + ty * 8 + i) * a.ldc + bn + tx * 8 + j] = acc[i][j];
}

__global__ __launch_bounds__(64) void k_s5_scan(const float* __restrict__ u, float* __restrict__ ydir, const float* lam_re, const float* lam_im, const float* log_dt,
                                                const float* b_re, const float* b_im, const float* c_re, const float* c_im) {
    const int wid = blockIdx.x;
    const int dir = wid & 1, g = (wid >> 1) & 63, gb = wid >> 7;
    const int p = threadIdx.x;
    const int L = gb_len(gb), t0 = gb_tok0(gb);
    const double dt = exp((double)log_dt[dir * 64 + g]);
    const double lr = lam_re[(dir * 64 + g) * 64 + p], li = lam_im[(dir * 64 + g) * 64 + p];
    const double er = exp(lr * dt), lbr = er * cos(li * dt), lbi = er * sin(li * dt);
    const double nr = lbr - 1.0, ni = lbi, den = lr * lr + li * li;
    const double fr = (nr * lr + ni * li) / den, fi = (ni * lr - nr * li) / den;
    float Br[16], Bi[16], Cr[16], Ci[16];
#pragma unroll
    for (int h = 0; h < 16; ++h) {
        const double br = b_re[((dir * 64 + g) * 64 + p) * 16 + h], bi = b_im[((dir * 64 + g) * 64 + p) * 16 + h];
        Br[h] = (float)(fr * br - fi * bi); Bi[h] = (float)(fr * bi + fi * br);
        Cr[h] = c_re[((dir * 64 + g) * 16 + h) * 64 + p]; Ci[h] = c_im[((dir * 64 + g) * 16 + h) * 64 + p];
    }
    const float ar = (float)lbr, ai = (float)lbi;
    float hr = 0.f, hi = 0.f;
    float* yo = ydir + (size_t)dir * NT * D;
    for (int s = 0; s < L; ++s) {
        const int t = dir ? (L - 1 - s) : s;
        const float* ur = u + (size_t)(t0 + t) * D + g * 16;
        float bur = 0.f, bui = 0.f;
#pragma unroll
        for (int h = 0; h < 16; ++h) { const float uv = ur[h]; bur += uv * Br[h]; bui += uv * Bi[h]; }
        const float nhr = ar * hr - ai * hi + bur, nhi = ar * hi + ai * hr + bui;
        hr = nhr; hi = nhi;
        float mine = 0.f;
#pragma unroll
        for (int c = 0; c < 16; ++c) { const float v = wave_sum(Cr[c] * hr - Ci[c] * hi); if (p == c) mine = v; }
        if (p < 16) yo[(size_t)(t0 + t) * D + g * 16 + p] = mine;
    }
}
__global__ void k_s5_gelu(const float* u, const float* ydir, const float* dskip, float* gout) {
    const size_t i = (size_t)blockIdx.x * blockDim.x + threadIdx.x;
    if (i >= (size_t)NT * D) return;
    const float y = dskip[i & (D - 1)] * u[i] + ydir[i] + ydir[(size_t)NT * D + i];
    const float c = 0.7978845608028654f * (y + 0.044715f * y * y * y);
    gout[i] = 0.5f * y * (1.f + tanhf(c));
}
__global__ void k_glu(const float* z1, const float* z2, float* out) {
    const size_t i = (size_t)blockIdx.x * blockDim.x + threadIdx.x;
    if (i >= (size_t)NT * D) return;
    out[i] = z1[i] / (1.f + expf(-z2[i]));
}
__global__ __launch_bounds__(256) void k_res_ln(const float* x, const float* h, const float* g, const float* b, float* xo, int rows) {
    const int row = blockIdx.x * 4 + (threadIdx.x >> 6), lane = threadIdx.x & 63;
    if (row >= rows) return;
    float v[16]; float s = 0.f;
#pragma unroll
    for (int j = 0; j < 16; ++j) { const size_t i = (size_t)row * D + lane + 64 * j; v[j] = ALPHA * x[i] + h[i]; s += v[j]; }
    const float mean = wave_sum(s) * (1.f / D); float q = 0.f;
#pragma unroll
    for (int j = 0; j < 16; ++j) { v[j] -= mean; q += v[j] * v[j]; }
    const float rstd = 1.f / sqrtf(wave_sum(q) * (1.f / D) + LN_EPS);
#pragma unroll
    for (int j = 0; j < 16; ++j) { const int c = lane + 64 * j; xo[(size_t)row * D + c] = v[j] * rstd * g[c] + b[c]; }
}
__global__ __launch_bounds__(256) void k_softmax256(float* s, float scale, int rows) {
    const int row = blockIdx.x * 4 + (threadIdx.x >> 6), lane = threadIdx.x & 63;
    if (row >= rows) return;
    float v[4]; float m = -INFINITY;
#pragma unroll
    for (int j = 0; j < 4; ++j) { v[j] = s[(size_t)row * 256 + lane + 64 * j] * scale; m = fmaxf(m, v[j]); }
    m = wave_max(m); float l = 0.f;
#pragma unroll
    for (int j = 0; j < 4; ++j) { v[j] = expf(v[j] - m); l += v[j]; }
    l = wave_sum(l);
#pragma unroll
    for (int j = 0; j < 4; ++j) s[(size_t)row * 256 + lane + 64 * j] = v[j] / l;
}
__global__ __launch_bounds__(256) void k_router(const float* x, const float* wr, float* aff, int rows) {
    const int row = blockIdx.x * 4 + (threadIdx.x >> 6), lane = threadIdx.x & 63;
    if (row >= rows) return;
    float acc[16];
#pragma unroll
    for (int e = 0; e < 16; ++e) acc[e] = 0.f;
    for (int j = 0; j < 16; ++j) { const int k = lane + 64 * j; const float xv = x[(size_t)row * D + k];
#pragma unroll
        for (int e = 0; e < 16; ++e) acc[e] += xv * wr[k * 16 + e]; }
    float m = -INFINITY;
#pragma unroll
    for (int e = 0; e < 16; ++e) { acc[e] = wave_sum(acc[e]); m = fmaxf(m, acc[e]); }
    float l = 0.f;
#pragma unroll
    for (int e = 0; e < 16; ++e) { acc[e] = expf(acc[e] - m); l += acc[e]; }
    float mine = 0.f;
#pragma unroll
    for (int e = 0; e < 16; ++e) if (lane == e) mine = acc[e] / l;
    if (lane < 16) aff[(size_t)row * 16 + lane] = mine;
}

__device__ __forceinline__ void select_expert(const float* aff, int n, int e, int cap, int* idx_out, float* gate_out, int* slot_of  , unsigned* hist  , unsigned* wsum  , unsigned* bc  ) {
    const int tid = threadIdx.x, nth = blockDim.x, lane = tid & 63, wv = tid >> 6, nw = nth >> 6;
    unsigned prefix = 0u, mask = 0u; unsigned remaining = (unsigned)cap;
    for (int pass = 0; pass < 4; ++pass) {
        const int shift = 24 - 8 * pass;
        for (int i = tid; i < 256; i += nth) hist[i] = 0u;
        __syncthreads();
        for (int t = tid; t < n; t += nth) { const unsigned key = __float_as_uint(aff[(size_t)t * 16 + e]); if ((key & mask) == prefix) atomicAdd(&hist[(key >> shift) & 255u], 1u); }
        __syncthreads();
        if (tid == 0) { unsigned cum = 0u; int b = 255; for (; b > 0; --b) { if (cum + hist[b] >= remaining) break; cum += hist[b]; } bc[0] = (unsigned)b; bc[1] = remaining - cum; }
        __syncthreads();
        prefix |= bc[0] << shift; mask |= 0xffu << shift; remaining = bc[1];
        __syncthreads();
    }
    const unsigned T = prefix; const unsigned need_eq = remaining;
    unsigned base = 0u, eqbase = 0u;
    for (int s0 = 0; s0 < n; s0 += nth) {
        const int t = s0 + tid; const bool in = t < n;
        const float a = in ? aff[(size_t)t * 16 + e] : 0.f; const unsigned key = __float_as_uint(a);
        const bool gt = in && key > T, eq = in && key == T;
        const unsigned long long meq = __ballot(eq); const unsigned eqr_w = __popcll(meq & ((1ull << lane) - 1ull));
        if (lane == 0) wsum[wv] = __popcll(meq);
        __syncthreads();
        unsigned eqoff = 0u, eqtot = 0u; for (int w = 0; w < nw; ++w) { const unsigned c = wsum[w]; if (w < wv) eqoff += c; eqtot += c; }
        __syncthreads();
        const bool sel = gt || (eq && (eqbase + eqoff + eqr_w) < need_eq);
        const unsigned long long ms = __ballot(sel); const unsigned sr_w = __popcll(ms & ((1ull << lane) - 1ull));
        if (lane == 0) wsum[wv] = __popcll(ms);
        __syncthreads();
        unsigned soff = 0u, stot = 0u; for (int w = 0; w < nw; ++w) { const unsigned c = wsum[w]; if (w < wv) soff += c; stot += c; }
        __syncthreads();
        if (sel) { const unsigned slot = base + soff + sr_w; if (slot < (unsigned)cap) { idx_out[slot] = t; gate_out[slot] = a; } }
        if (slot_of && in) slot_of[(size_t)t * 16 + e] = sel ? (int)(base + soff + sr_w) : -1;
        base += stot; eqbase += eqtot;
    }
}
__global__ __launch_bounds__(512) void k_select(const float* aff_all, int* idx_all, float* gate_all) {
    __shared__ unsigned hist[256]; __shared__ unsigned wsum[32]; __shared__ unsigned bc[4];
    const int grp = blockIdx.x >> 4, e = blockIdx.x & 15;
    const int n = grp ? NTS : NTP, cap = n / 8;
    const float* aff = aff_all + (size_t)(grp ? NTP : 0) * 16;
    int* idx = idx_all + (grp ? 16 * 4096 : 0) + e * cap; float* gate = gate_all + (grp ? 16 * 4096 : 0) + e * cap;
    select_expert(aff, n, e, cap, idx, gate, nullptr, hist, wsum, bc);
}
__global__ void k_silu_mul(float* h1, const float* h3, size_t n) {
    const size_t i = (size_t)blockIdx.x * blockDim.x + threadIdx.x; if (i >= n) return;
    const float a = h1[i]; h1[i] = a / (1.f + expf(-a)) * h3[i];
}
__global__ void k_scatter_add(const float* ye, const int* idx, const float* gate, float* out, int cap) {
    const size_t i = (size_t)blockIdx.x * blockDim.x + threadIdx.x; if (i >= (size_t)cap * D) return;
    const int slot = (int)(i >> 10), c = (int)(i & 1023);
    atomicAdd(&out[(size_t)idx[slot] * D + c], gate[slot] * ye[i]);
}

__global__ __launch_bounds__(256) void k_natten(float* q, const float* k, const float* v, const float* rpb) {
    const int wg = blockIdx.x * 4 + (threadIdx.x >> 6), lane = threadIdx.x & 63;
    const int tok = wg >> 4, h = wg & 15;
    if (tok >= NT) return;
    int gb, l; if (tok < NTP) { gb = tok >> 13; l = tok & 8191; } else { gb = 4 + ((tok - NTP) >> 12); l = (tok - NTP) & 4095; }
    const int rows = gb_len(gb) / GRID_W, t0 = gb_tok0(gb);
    const int r = l >> 6, qc = l & 63;
    int rs = r - 4; rs = rs < 0 ? 0 : (rs > rows - 8 ? rows - 8 : rs);
    int ws = qc - 8; ws = ws < 0 ? 0 : (ws > 48 ? 48 : ws);
    const float qv = q[(size_t)tok * D + h * 64 + lane] * 0.125f;
    float m = -INFINITY, lsum = 0.f, o = 0.f;
    for (int rr = 0; rr < 8; ++rr) {
        const int kr = rs + rr, dr = kr - r + 7;
        for (int cc = 0; cc < 16; ++cc) {
            const int kc = ws + cc; int dc = kc - qc + 15; dc = dc < 0 ? 0 : (dc > 30 ? 30 : dc);
            const size_t kt = (size_t)(t0 + kr * 64 + kc) * D + h * 64 + lane;
            const float s = wave_sum(qv * k[kt]) + rpb[(h * 15 + dr) * 31 + dc];
            const float mn = fmaxf(m, s), al = expf(m - mn), pp = expf(s - mn);
            lsum = lsum * al + pp; o = o * al + pp * v[kt]; m = mn;
        }
    }
    q[(size_t)tok * D + h * 64 + lane] = o / lsum;
}
}
#define LAS __attribute__((address_space(3)))
#define GAS __attribute__((address_space(1)))
namespace fz {
typedef unsigned short bf16_t;
typedef short bf16x8 __attribute__((ext_vector_type(8)));
typedef float f32x4 __attribute__((ext_vector_type(4)));
typedef float f32x2 __attribute__((ext_vector_type(2)));
typedef unsigned u32x4 __attribute__((ext_vector_type(4)));
typedef unsigned u32x2 __attribute__((ext_vector_type(2)));
typedef int v8i __attribute__((ext_vector_type(8)));
typedef int v4i __attribute__((ext_vector_type(4)));

constexpr int D = 1024, NTP = 32768, NTS = 16384, NT = NTP + NTS;
constexpr int TCH = 32, NCHUNK = NT / TCH;
constexpr int UAK = TCH * 16 + 256;
constexpr float ALPHA = 1.41421356237309515f, LN_EPS = 1e-5f;
constexpr size_t MiB = 1u << 20;
constexpr size_t WS_CTL = 0, WS_XF = 1 * MiB, WS_XB = 193 * MiB, WS_WIN = 289 * MiB, WS_WGLU = 291 * MiB, WS_WQKV = 295 * MiB, WS_WO = 301 * MiB, WS_MWQ = 303 * MiB,
                 WS_MWKV = 307 * MiB, WS_MWO = 315 * MiB, WS_MEMB = 319 * MiB, WS_KV = 323 * MiB, WS_WQK = 339 * MiB, WS_WVO = 371 * MiB, WS_AFF = 403 * MiB, WS_SLOT = 406 * MiB,
                 WS_IDX = 409 * MiB, WS_GATE = 409 * MiB + 512 * 1024, WS_EW13 = 411 * MiB  , WS_EW2 = 475 * MiB  ,
                 WS_XB8 = 507 * MiB  , WS_POOL = 603 * MiB, WS_END = 1024 * MiB;
constexpr size_t PO_M2T = WS_POOL, PO_M13T = WS_POOL + 16 * MiB, PO_UA = WS_POOL + 64 * MiB, PO_SG = WS_POOL + 208 * MiB;
constexpr size_t PO_HB_S5 = WS_POOL;
constexpr size_t PO_SB = WS_POOL + 96 * MiB, PO_HB_MEM = WS_POOL + 304 * MiB;
constexpr size_t PO_Q = WS_POOL, PO_K = WS_POOL + 96 * MiB, PO_VT = WS_POOL + 192 * MiB, PO_HB_NA = WS_POOL + 96 * MiB;
constexpr size_t PO_HM = WS_POOL, PO_YE = WS_POOL + 192 * MiB;
static_assert(PO_YE + 192 * MiB <= WS_END && PO_SG + 96 * MiB <= WS_END && PO_HB_NA + 96 * MiB <= WS_END && PO_HB_MEM + 96 * MiB <= WS_END, "pool");
constexpr int CW_TMO = 0, CW_BAR = 4096;
constexpr size_t CTL_ZERO_BYTES = 64 * 1024;
constexpr int RING_BYTES = 131072, MISC_OFF = RING_BYTES + 320, LDS_BYTES = 147456, ZERO16_OFF = RING_BYTES + 64;

__host__ __device__ inline int gb_tok0(int gb) { return gb < 4 ? gb * 8192 : NTP + (gb - 4) * 4096; }
__host__ __device__ inline int gb_len(int gb) { return gb < 4 ? 8192 : 4096; }
__host__ __device__ inline int panel_gb(int pm) { return pm < 128 ? (pm >> 5) : 4 + ((pm - 128) >> 4); }

__device__ __forceinline__ unsigned cvt_pk_bf16(float lo, float hi) { unsigned r; asm volatile("v_cvt_pk_bf16_f32 %0, %1, %2" : "=v"(r) : "v"(lo), "v"(hi)); return r; }
typedef __bf16 bf16x2_t __attribute__((ext_vector_type(2)));
__device__ __forceinline__ unsigned cvt_pk_bf16_c(float lo, float hi) { const f32x2 v = {lo, hi}; const bf16x2_t b = __builtin_convertvector(v, bf16x2_t); return __builtin_bit_cast(unsigned, b); }
__device__ __forceinline__ float bf2f(unsigned short b) { return __uint_as_float(((unsigned)b) << 16); }
template <int CTRL> __device__ __forceinline__ float dpp_f(float v) { return __uint_as_float((unsigned)__builtin_amdgcn_update_dpp(0, (int)__float_as_uint(v), CTRL, 0xF, 0xF, true)); }
__device__ __forceinline__ float x16_sum(float v) { const auto r = __builtin_amdgcn_permlane16_swap(__float_as_uint(v), __float_as_uint(v), false, false); return __uint_as_float(r[0]) + __uint_as_float(r[1]); }
__device__ __forceinline__ float x32_sum(float v) { const auto r = __builtin_amdgcn_permlane32_swap(__float_as_uint(v), __float_as_uint(v), false, false); return __uint_as_float(r[0]) + __uint_as_float(r[1]); }
__device__ __forceinline__ float x16_max(float v) { const auto r = __builtin_amdgcn_permlane16_swap(__float_as_uint(v), __float_as_uint(v), false, false); return fmaxf(__uint_as_float(r[0]), __uint_as_float(r[1])); }
__device__ __forceinline__ float x32_max(float v) { const auto r = __builtin_amdgcn_permlane32_swap(__float_as_uint(v), __float_as_uint(v), false, false); return fmaxf(__uint_as_float(r[0]), __uint_as_float(r[1])); }
__device__ __forceinline__ float row_sum(float v) { v += dpp_f<0xB1>(v); v += dpp_f<0x4E>(v); v += dpp_f<0x141>(v); v += dpp_f<0x140>(v); return v; }
__device__ __forceinline__ float row_max(float v) { v = fmaxf(v, dpp_f<0xB1>(v)); v = fmaxf(v, dpp_f<0x4E>(v)); v = fmaxf(v, dpp_f<0x141>(v)); v = fmaxf(v, dpp_f<0x140>(v)); return v; }
__device__ __forceinline__ float wave_sum(float v) { return x32_sum(x16_sum(row_sum(v))); }
__device__ __forceinline__ float wave_max(float v) { return x32_max(x16_max(row_max(v))); }
#ifndef NO_WT
__device__ __forceinline__ void st16(void* p, u32x4 v) { asm volatile("global_store_dwordx4 %0, %1, off sc1\n\ts_nop 1" :: "v"(p), "v"(v)); }
__device__ __forceinline__ void st8(void* p, u32x2 v) { asm volatile("global_store_dwordx2 %0, %1, off sc1\n\ts_nop 1" :: "v"(p), "v"(v)); }
__device__ __forceinline__ void st4(void* p, unsigned v) { asm volatile("global_store_dword %0, %1, off sc1\n\ts_nop 1" :: "v"(p), "v"(v)); }
#else
__device__ __forceinline__ void st16(void* p, u32x4 v) { *(u32x4*)p = v; }
__device__ __forceinline__ void st8(void* p, u32x2 v) { *(u32x2*)p = v; }
__device__ __forceinline__ void st4(void* p, unsigned v) { *(unsigned*)p = v; }
#endif
__device__ __forceinline__ void st16f(void* p, f32x4 v) { st16(p, __builtin_bit_cast(u32x4, v)); }
__device__ __forceinline__ void pst16(void* p, u32x4 v) { *(u32x4*)p = v; }
__device__ __forceinline__ void pst8(void* p, u32x2 v) { *(u32x2*)p = v; }
#ifndef NO_WT
__device__ __forceinline__ void st16_so(const void* base, unsigned off, f32x4 v) { asm volatile("global_store_dwordx4 %0, %1, %2 sc1\n\ts_nop 1" :: "v"(off), "v"(v), "s"(base)); }
__device__ __forceinline__ void st4_so(const void* base, unsigned off, unsigned v) { asm volatile("global_store_dword %0, %1, %2 sc1\n\ts_nop 1" :: "v"(off), "v"(v), "s"(base)); }
#else
__device__ __forceinline__ void st16_so(const void* base, unsigned off, f32x4 v) { *(f32x4*)((unsigned char*)base + off) = v; }
__device__ __forceinline__ void st4_so(const void* base, unsigned off, unsigned v) { *(unsigned*)((unsigned char*)base + off) = v; }
#endif
#define LDS_WAIT() asm volatile("s_waitcnt lgkmcnt(0)" ::: "memory")
#define VM_WAIT() asm volatile("s_waitcnt vmcnt(0)" ::: "memory")

#define XB_TMO      128
#define XB_XCNT(j)  (256  + 64 * (j))
#define XB_XSUB(j)  (1280 + 64 * (j))
#define XB_XGEN(j)  (2304 + 64 * (j))
#define XB_TOP      3328
#define XB_TOPGEN   3392
#define XCD_BAR_WORDS 3456
#define XB_SPIN_CAP (1u << 18)
__device__ __forceinline__ unsigned xb_ld(unsigned* p)              { return __hip_atomic_load(p, __ATOMIC_RELAXED, __HIP_MEMORY_SCOPE_AGENT); }
__device__ __forceinline__ unsigned xb_add(unsigned* p, unsigned v) { return __hip_atomic_fetch_add(p, v, __ATOMIC_RELAXED, __HIP_MEMORY_SCOPE_AGENT); }
__device__ __forceinline__ unsigned xb_xcc_id() { return (unsigned)__builtin_amdgcn_s_getreg((3 << 11) | 20) & 0xFu; }
#define XB_SPIN(cond, bar) do { unsigned _sp = 0; while (cond) { __builtin_amdgcn_s_sleep(1); \
    if ((++_sp & 255u) == 0u) { if (xb_ld(&(bar)[XB_TMO])) break; if (_sp > XB_SPIN_CAP) { atomicAdd(&(bar)[XB_TMO], 1u); break; } } } } while (0)
struct XcdBarrier { unsigned* bar; unsigned x; volatile LAS unsigned* st; };
__device__ __forceinline__ int xb_tid();
__device__ __forceinline__ XcdBarrier xcd_barrier_post(unsigned* bar, volatile LAS unsigned* st) {
    XcdBarrier b; b.bar = bar; b.x = xb_xcc_id(); b.st = st;
    if (threadIdx.x == 0) st[4] = xb_add(&bar[XB_XCNT(b.x)], 1u);
    return b;
}
#define XB_LCNT(j)  (3520 + 64 * (j))
#define XB_LGEN(j)  (4544 + 64 * (j))
#define XCD_BAR_WORDS_EXT 5568
__device__ __forceinline__ void xcd_local_barrier(const XcdBarrier& b, const int wave_s, const unsigned nloc) {
    asm volatile("s_waitcnt vmcnt(0)" ::: "memory");
    __syncthreads();
    if (wave_s == 0 && xb_tid() == 0) {
        unsigned* bar = b.bar;
        const unsigned old = xb_add(&bar[XB_LCNT(b.x)], 1u);
        const unsigned gen = old / nloc;
        if (old + 1u == (gen + 1u) * nloc) xb_add(&bar[XB_LGEN(b.x)], 1u);
        else XB_SPIN(xb_ld(&bar[XB_LGEN(b.x)]) == gen, bar);
#ifndef LB_NOACQ
        __builtin_amdgcn_fence(__ATOMIC_ACQUIRE, "agent");
        asm volatile("s_waitcnt vmcnt(0)" ::: "memory");
#endif
    }
    __syncthreads();
}
__device__ __forceinline__ void xcd_barrier_complete(unsigned* bar, unsigned x, unsigned& nloc, unsigned& nx) {
    const unsigned G = gridDim.x * gridDim.y * gridDim.z;
    unsigned sum, cnt, mine, sp = 0u;
    for (;;) {
        sum = 0u; cnt = 0u; mine = 0u;
#pragma unroll
        for (unsigned j = 0; j < 16; ++j) { const unsigned c = xb_ld(&bar[XB_XCNT(j)]); sum += c; cnt += (c > 0u) ? 1u : 0u; mine = (j == x) ? c : mine; }
        if (sum == G) break;
        __builtin_amdgcn_s_sleep(1);
        if ((++sp & 255u) == 0u) { if (xb_ld(&bar[XB_TMO])) break; if (sp > XB_SPIN_CAP) { atomicAdd(&bar[XB_TMO], 1u); break; } }
    }
    nloc = mine > 0u ? mine : 1u; nx = cnt > 0u ? cnt : 1u;
}
__device__ __forceinline__ int xb_tid() { int t; asm volatile("v_mbcnt_lo_u32_b32 %0, -1, 0\n\tv_mbcnt_hi_u32_b32 %0, -1, %0" : "=v"(t)); return t; }
__device__ __forceinline__ void xcd_barrier(const XcdBarrier& b, const int wave_s) {
    asm volatile("s_waitcnt vmcnt(0)" ::: "memory");
    __syncthreads();
    if (wave_s == 0 && xb_tid() == 0) {
        unsigned* bar = b.bar;
        __builtin_amdgcn_s_waitcnt(0);
        unsigned nloc = b.st[0], nx = b.st[1];
        if (nloc == 0u) { xcd_barrier_complete(bar, b.x, nloc, nx); b.st[0] = nloc; b.st[1] = nx; }
        const unsigned old = xb_add(&bar[XB_XSUB(b.x)], 1u);
        const unsigned gen = old / nloc;
        if (old + 1u == (gen + 1u) * nloc) {
            __builtin_amdgcn_fence(__ATOMIC_RELEASE, "agent");
            asm volatile("s_waitcnt vmcnt(0)" ::: "memory");
            const unsigned og = xb_add(&bar[XB_TOP], 1u);
            const unsigned tg = og / nx;
            if (og + 1u == (tg + 1u) * nx) xb_add(&bar[XB_TOPGEN], 1u);
            else XB_SPIN(xb_ld(&bar[XB_TOPGEN]) == tg, bar);
            __builtin_amdgcn_fence(__ATOMIC_ACQUIRE, "agent");
            xb_add(&bar[XB_XGEN(b.x)], 1u);
            asm volatile("s_waitcnt vmcnt(0)" ::: "memory");
        } else {
            XB_SPIN(xb_ld(&bar[XB_XGEN(b.x)]) == gen, bar);
            __builtin_amdgcn_fence(__ATOMIC_ACQUIRE, "agent");
            asm volatile("s_waitcnt vmcnt(0)" ::: "memory");
        }
    }
    __syncthreads();
}

constexpr int BM = 256, BK = 64, HALF = 128, HTB = HALF * BK * 2, STAGE_BYTES = 8 * HTB;
__host__ __device__ __forceinline__ int lds_byte(int r, int c) { const int st = (r >> 4) * 2 + (c >> 5), rr = r & 15, cc = c & 31, ob = rr * 64 + cc * 2; return st * 1024 + (ob ^ (((ob >> 9) & 1) << 5)); }
__host__ __device__ __forceinline__ void stage_rc(int b, int& R, int& C) { const int st = b / 1024, sb = b % 1024, swz = sb ^ (((sb >> 9) & 1) << 5); R = (st >> 1) * 16 + swz / 64; C = (st & 1) * 32 + (swz % 64) / 2; }
__host__ __device__ __forceinline__ int perm32(int rho) { const int n = rho >> 4, i = rho & 15; return 8 * (i >> 2) + 4 * n + (i & 3); }

struct GUnit { const char* A; const char* B; char* C; const void* X; int pm, pn; };
template <int WGM = 8>
__device__ __forceinline__ bool static_unit(int i, int G, int c, int nM, int nN, int& pm, int& pn) {
    const long L = (long)i * G + c; const int nwg = nM * nN; if (L >= nwg) return false;
    int wgid = (int)L; { const int q = nwg / 8, r = nwg % 8, xcd = wgid % 8, off = wgid / 8; wgid = (xcd < r ? xcd * (q + 1) : r * (q + 1) + (xcd - r) * q) + off; }
    const int nig = WGM * nN, gid = wgid / nig, fm = gid * WGM, gsz = (nM - fm) < WGM ? (nM - fm) : WGM;
    pm = fm + ((wgid % nig) % gsz); pn = (wgid % nig) / gsz; return true;
}
template <class Epi, class Sched, bool GATHER, bool FP8 = false>
__device__ __forceinline__ void gemm_phase(LAS unsigned char* lds, const int tid_in, const int K, const unsigned lda, const unsigned ldb, const Sched& S, const Epi& E) {
    int tid_ = tid_in; asm volatile("" : "+v"(tid_));
    const int tid = tid_, wid = __builtin_amdgcn_readfirstlane(tid >> 6), lane = tid & 63, wr = wid >> 2, wc = wid & 3, fr = lane & 15, fq = lane >> 4;
    int nt_ = K / BK; asm volatile("" : "+s"(nt_)); const int nt = nt_;
    unsigned voffA[2], voffB[2]; int gR[2], gC[2];
#pragma unroll
    for (int i = 0; i < 2; ++i) { int R, C; stage_rc(tid * 16 + i * 8192, R, C); const int Rb = Epi::PERM ? ((R & ~31) + perm32(R & 31)) : R;
        voffA[i] = (unsigned)R * lda + (unsigned)C * 2u; voffB[i] = (unsigned)Rb * ldb + (unsigned)C * 2u; gR[i] = R; gC[i] = C * 2; }
    const size_t kstep = (size_t)(BK * 2);
    const size_t hstepA = (size_t)HALF * lda, hstepB = (size_t)HALF * ldb;
    const unsigned ldsw = (unsigned)wid * 1024u;
    const int aoff = lds_byte(wr * 64 + fr, fq * 8), boff = lds_byte(wc * 32 + fr, fq * 8);
    const int sc8 = 0x7F7F7F7F;
    unsigned cvo[2][2], nvo[2][2];
#define PG8_SA(b, h) (((b) * 2 + (h)) * HTB)
#define PG8_SB(b, h) ((4 + (b) * 2 + (h)) * HTB)
#define PG8_STAGE(bufoff, gbase, voff) do { _Pragma("unroll") for (int _i = 0; _i < 2; ++_i) \
        __builtin_amdgcn_global_load_lds((const unsigned*)((const char*)(gbase) + (voff)[_i]), (LAS unsigned*)(lds + (bufoff) + ldsw + _i * 8192), 16, 0, 0); } while (0)
#define PG8_STAGE_B(bufoff, ptr, h) PG8_STAGE(bufoff, (ptr) + (h) * hstepB, voffB)
#define PG8_STAGE_A(bufoff, ptr, h, vo) do { if constexpr (GATHER) { PG8_STAGE(bufoff, (ptr), (vo)[h]); } else { PG8_STAGE(bufoff, (ptr) + (h) * hstepA, voffA); } } while (0)
#define PG8_LDA(dst, b, h) do { _Pragma("unroll") for (int m = 0; m < 4; ++m) _Pragma("unroll") for (int k = 0; k < 2; ++k) dst[m][k] = *(const LAS bf16x8*)(lds + PG8_SA(b, h) + aoff + m * 2048 + k * 1024); } while (0)
#define PG8_LDB(dst, b, h) do { _Pragma("unroll") for (int n = 0; n < 2; ++n) _Pragma("unroll") for (int k = 0; k < 2; ++k) dst[n][k] = *(const LAS bf16x8*)(lds + PG8_SB(b, h) + boff + n * 2048 + k * 1024); } while (0)
#define PG8_MMA(ai, bj, At, Bt) do { __builtin_amdgcn_s_setprio(1); _Pragma("unroll") for (int m = 0; m < 4; ++m) _Pragma("unroll") for (int n = 0; n < 2; ++n) { \
        if constexpr (FP8) { const v8i _a = __builtin_shufflevector(__builtin_bit_cast(v4i, At[m][0]), __builtin_bit_cast(v4i, At[m][1]), 0, 1, 2, 3, 4, 5, 6, 7), _b = __builtin_shufflevector(__builtin_bit_cast(v4i, Bt[n][0]), __builtin_bit_cast(v4i, Bt[n][1]), 0, 1, 2, 3, 4, 5, 6, 7); \
            asm volatile("v_mfma_scale_f32_16x16x128_f8f6f4 %0, %1, %2, %0, %3, %3 op_sel_hi:[0,0,0]" : "+v"(acc[ai][bj][m][n]) : "v"(_b), "v"(_a), "v"(sc8)); } \
        else { _Pragma("unroll") for (int k = 0; k < 2; ++k) acc[ai][bj][m][n] = __builtin_amdgcn_mfma_f32_16x16x32_bf16(Bt[n][k], At[m][k], acc[ai][bj][m][n], 0, 0, 0); } } __builtin_amdgcn_s_setprio(0); } while (0)
#define PG8_WAIT_V(n) asm volatile("s_waitcnt vmcnt(" #n ")" ::: "memory")
#define PG8_WAIT_L(n) asm volatile("s_waitcnt lgkmcnt(" #n ")" ::: "memory")
#define PG8_BAR __builtin_amdgcn_s_barrier()
#define PG8_SCHED __builtin_amdgcn_sched_barrier(0)
#define PG8_GLOAD(vo, u) do { if constexpr (GATHER) { const int* _gi = (const int*)(u).X; _Pragma("unroll") for (int _h = 0; _h < 2; ++_h) _Pragma("unroll") for (int _i = 0; _i < 2; ++_i) \
        (vo)[_h][_i] = (unsigned)_gi[_h * HALF + gR[_i]] * lda + (unsigned)gC[_i]; } } while (0)
    GUnit cur, nxt; int ui = 0;
    if (!S.next(0, cur)) return;
    f32x4 acc[2][2][4][2];
    const volatile LAS f32x4* zero16 = (const volatile LAS f32x4*)(lds + ZERO16_OFF);
#pragma unroll
    for (int a = 0; a < 2; ++a)
#pragma unroll
        for (int b = 0; b < 2; ++b)
#pragma unroll
            for (int m = 0; m < 4; ++m)
#pragma unroll
                for (int n = 0; n < 2; ++n) acc[a][b][m][n] = *zero16;
    bf16x8 At[4][2], B0[2][2], B1[2][2];
    const char* cA = cur.A; const char* cB = cur.B;
    PG8_GLOAD(cvo, cur);
    if constexpr (GATHER) { PG8_WAIT_V(0); }
    PG8_STAGE_B(PG8_SB(0, 0), cB, 0); PG8_STAGE_B(PG8_SB(0, 1), cB, 1); PG8_STAGE_A(PG8_SA(0, 0), cA, 0, cvo); PG8_STAGE_A(PG8_SA(0, 1), cA, 1, cvo);
    if (wr == 1) PG8_BAR;
    PG8_WAIT_V(2); PG8_BAR;
    PG8_STAGE_B(PG8_SB(1, 0), cB + kstep, 0); PG8_STAGE_A(PG8_SA(1, 0), cA + kstep, 0, cvo); PG8_STAGE_B(PG8_SB(1, 1), cB + kstep, 1);
    PG8_WAIT_V(6); PG8_BAR;
    for (;;) {
        const bool has_next = S.next(ui + 1, nxt);
        const char* nA = has_next ? nxt.A : cA; const char* nB = has_next ? nxt.B : cB;
        if constexpr (GATHER) { if (has_next) { PG8_GLOAD(nvo, nxt); } else {
#pragma unroll
            for (int h = 0; h < 2; ++h)
#pragma unroll
                for (int i = 0; i < 2; ++i) nvo[h][i] = cvo[h][i]; } }
        for (int t = 0; t < nt; t += 2) {
            const bool last = (t == nt - 2);
            const char* a1 = cA + (size_t)(t + 1) * kstep;
            const char* a2 = last ? nA : cA + (size_t)(t + 2) * kstep; const char* b2 = last ? nB : cB + (size_t)(t + 2) * kstep;
            const char* a3 = a2 + kstep; const char* b3 = b2 + kstep;
            unsigned vo2[2][2];
            if constexpr (GATHER) {
#pragma unroll
                for (int h = 0; h < 2; ++h)
#pragma unroll
                    for (int i = 0; i < 2; ++i) vo2[h][i] = last ? nvo[h][i] : cvo[h][i]; }
            PG8_LDB(B0, 0, 0); PG8_LDB(B1, 0, 1); PG8_SCHED; PG8_LDA(At, 0, 0); PG8_STAGE_A(PG8_SA(1, 1), a1, 1, cvo);
            PG8_WAIT_V(8); PG8_WAIT_L(0); PG8_BAR; PG8_MMA(0, 0, At, B0); PG8_MMA(0, 1, At, B1); PG8_BAR; PG8_SCHED;
            PG8_LDA(At, 0, 1); PG8_STAGE_B(PG8_SB(0, 0), b2, 0); PG8_STAGE_B(PG8_SB(0, 1), b2, 1); PG8_STAGE_A(PG8_SA(0, 0), a2, 0, vo2);
            PG8_WAIT_V(8); PG8_WAIT_L(0); PG8_BAR; PG8_MMA(1, 0, At, B0); PG8_MMA(1, 1, At, B1); PG8_BAR; PG8_SCHED;
            PG8_LDB(B0, 1, 0); PG8_LDB(B1, 1, 1); PG8_SCHED; PG8_LDA(At, 1, 0); PG8_STAGE_A(PG8_SA(0, 1), a2, 1, vo2);
            PG8_WAIT_V(8); PG8_WAIT_L(0); PG8_BAR; PG8_MMA(0, 0, At, B0); PG8_MMA(0, 1, At, B1); PG8_BAR; PG8_SCHED;
            PG8_LDA(At, 1, 1); PG8_STAGE_B(PG8_SB(1, 0), b3, 0); PG8_STAGE_B(PG8_SB(1, 1), b3, 1); PG8_STAGE_A(PG8_SA(1, 0), a3, 0, vo2);
            PG8_WAIT_V(8); PG8_WAIT_L(0); PG8_BAR; PG8_MMA(1, 0, At, B0); PG8_MMA(1, 1, At, B1); PG8_BAR; PG8_SCHED;
        }
        if constexpr (FP8) { asm volatile("s_nop 15\n\ts_nop 15" ::: "memory"); }
        if (wr == 0) PG8_BAR;
        E(acc, cur, wr, wc, fr, fq);
        if (!has_next) break;
#pragma unroll
        for (int a = 0; a < 2; ++a)
#pragma unroll
            for (int b = 0; b < 2; ++b)
#pragma unroll
                for (int m = 0; m < 4; ++m)
#pragma unroll
                    for (int n = 0; n < 2; ++n) acc[a][b][m][n] = *zero16;
        cur = nxt; cA = nA; cB = nB; ++ui;
        if constexpr (GATHER) {
#pragma unroll
            for (int h = 0; h < 2; ++h)
#pragma unroll
                for (int i = 0; i < 2; ++i) cvo[h][i] = nvo[h][i]; }
        if (wr == 1) PG8_BAR;
    }
    PG8_WAIT_V(0);
    PG8_BAR;
#undef PG8_SA
#undef PG8_SB
#undef PG8_STAGE
#undef PG8_STAGE_A
#undef PG8_STAGE_B
#undef PG8_LDA
#undef PG8_LDB
#undef PG8_MMA
#undef PG8_WAIT_V
#undef PG8_WAIT_L
#undef PG8_BAR
#undef PG8_SCHED
#undef PG8_GLOAD
}
typedef f32x4 Acc[2][2][4][2];
__device__ __forceinline__ float sigmoidf_fast(float x) { return __builtin_amdgcn_rcpf(1.f + __builtin_amdgcn_exp2f(-1.4426950408889634f * x)); }
__device__ __forceinline__ float gelu_tanh_fast(float y) {
    const float inner = 1.5957691216057308f * (y + 0.044715f * y * y * y);
    return y * sigmoidf_fast(inner);
}
__device__ __forceinline__ unsigned cvt4_fp8(float a, float b, float c, float d) {
    a = fminf(fmaxf(a, -448.f), 448.f); b = fminf(fmaxf(b, -448.f), 448.f); c = fminf(fmaxf(c, -448.f), 448.f); d = fminf(fmaxf(d, -448.f), 448.f);
    int w = 0; w = __builtin_amdgcn_cvt_pk_fp8_f32(a, b, w, false); w = __builtin_amdgcn_cvt_pk_fp8_f32(c, d, w, true); return (unsigned)w;
}
constexpr float FP8_SX = 8.f, FP8_SW13 = 32.f, FP8_SH = 8.f, FP8_SW2 = 64.f, FP8_SWQK = 32.f, FP8_SWQKV = 32.f;
struct EpiGated8 {
    static constexpr bool PERM = true;
    unsigned ldc;
    __device__ __forceinline__ void operator()(const Acc& acc, const GUnit& u, int wr, int wc, int fr, int fq) const {
        unsigned char* base = (unsigned char*)u.C;
        constexpr float kx = -1.4426950408889634f / (FP8_SX * FP8_SW13), ic = (FP8_SX * FP8_SW13) * (FP8_SX * FP8_SW13) / FP8_SH;
#pragma unroll
        for (int ai = 0; ai < 2; ++ai)
#pragma unroll
            for (int m = 0; m < 4; ++m) { const int r = ai * HALF + wr * 64 + m * 16 + fr;
                float o[8];
#pragma unroll
                for (int n = 0; n < 2; ++n)
#pragma unroll
                    for (int j = 0; j < 4; j += 2) {
                        const f32x2 a = {acc[ai][0][m][n][j], acc[ai][0][m][n][j + 1]}, b = {acc[ai][1][m][n][j], acc[ai][1][m][n][j + 1]};
                        const f32x2 t = a * f32x2{kx, kx};
                        const f32x2 e = {__builtin_amdgcn_exp2f(t[0]), __builtin_amdgcn_exp2f(t[1])};
                        const f32x2 d = e * f32x2{ic, ic} + f32x2{ic, ic};
                        const f32x2 s = {__builtin_amdgcn_rcpf(d[0]), __builtin_amdgcn_rcpf(d[1])};
                        const f32x2 q = (a * b) * s;
                        o[n * 4 + j] = __builtin_amdgcn_fmed3f(q[0], -448.f, 448.f); o[n * 4 + j + 1] = __builtin_amdgcn_fmed3f(q[1], -448.f, 448.f); }
                int w0 = 0, w1 = 0;
                w0 = __builtin_amdgcn_cvt_pk_fp8_f32(o[0], o[1], w0, false); w0 = __builtin_amdgcn_cvt_pk_fp8_f32(o[2], o[3], w0, true);
                w1 = __builtin_amdgcn_cvt_pk_fp8_f32(o[4], o[5], w1, false); w1 = __builtin_amdgcn_cvt_pk_fp8_f32(o[6], o[7], w1, true);
                u32x2 w; w.x = (unsigned)w0; w.y = (unsigned)w1;
                st8(base + (size_t)r * ldc + wc * 32 + 8 * fq, w); }
    }
};
struct EpiBf8 {
    static constexpr bool PERM = true;
    unsigned ldc; float scale;
    __device__ __forceinline__ void operator()(const Acc& acc, const GUnit& u, int wr, int wc, int fr, int fq) const {
        unsigned char* base = (unsigned char*)u.C;
#pragma unroll
        for (int ai = 0; ai < 2; ++ai)
#pragma unroll
            for (int m = 0; m < 4; ++m) { const int r = ai * HALF + wr * 64 + m * 16 + fr; unsigned char* rowp = base + (size_t)r * ldc + wc * 32 + 8 * fq;
#pragma unroll
                for (int bj = 0; bj < 2; ++bj) { const f32x4 v0 = acc[ai][bj][m][0] * scale, v1 = acc[ai][bj][m][1] * scale;
                    u32x2 w; w.x = cvt4_fp8(v0[0], v0[1], v0[2], v0[3]); w.y = cvt4_fp8(v1[0], v1[1], v1[2], v1[3]); st8(rowp + bj * HALF, w); } }
    }
};
template <bool ROWSCALE> struct EpiBf {
    static constexpr bool PERM = true;
    unsigned ldc; float scale;
    __device__ __forceinline__ void operator()(const Acc& acc, const GUnit& u, int wr, int wc, int fr, int fq) const {
        bf16_t* base = (bf16_t*)u.C; const float* rs = (const float*)u.X;
#pragma unroll
        for (int ai = 0; ai < 2; ++ai)
#pragma unroll
            for (int m = 0; m < 4; ++m) { const int r = ai * HALF + wr * 64 + m * 16 + fr; float s = scale; if (ROWSCALE) s *= rs[r];
                bf16_t* rowp = base + (size_t)r * ldc + wc * 32 + 8 * fq;
#pragma unroll
                for (int bj = 0; bj < 2; ++bj) { const f32x4 v0 = acc[ai][bj][m][0] * s, v1 = acc[ai][bj][m][1] * s;
                    u32x4 w; w.x = cvt_pk_bf16(v0[0], v0[1]); w.y = cvt_pk_bf16(v0[2], v0[3]); w.z = cvt_pk_bf16(v1[0], v1[1]); w.w = cvt_pk_bf16(v1[2], v1[3]);
                    st16(rowp + bj * HALF, w); } }
    }
};
template <int MODE> struct EpiGated {
    static constexpr bool PERM = true;
    unsigned ldc;
    __device__ __forceinline__ void operator()(const Acc& acc, const GUnit& u, int wr, int wc, int fr, int fq) const {
        bf16_t* base = (bf16_t*)u.C;
#pragma unroll
        for (int ai = 0; ai < 2; ++ai)
#pragma unroll
            for (int m = 0; m < 4; ++m) { const int r = ai * HALF + wr * 64 + m * 16 + fr;
                float o[8];
#pragma unroll
                for (int n = 0; n < 2; ++n)
#pragma unroll
                    for (int j = 0; j < 4; ++j) { const float a = acc[ai][0][m][n][j], b = acc[ai][1][m][n][j];
                        o[n * 4 + j] = (MODE == 0) ? a * sigmoidf_fast(b) : a * sigmoidf_fast(a) * b; }
                u32x4 w; w.x = cvt_pk_bf16(o[0], o[1]); w.y = cvt_pk_bf16(o[2], o[3]); w.z = cvt_pk_bf16(o[4], o[5]); w.w = cvt_pk_bf16(o[6], o[7]);
                st16(base + (size_t)r * ldc + wc * 32 + 8 * fq, w); }
    }
};
struct EpiUA {
    static constexpr bool PERM = true;
    __device__ __forceinline__ void operator()(const Acc& acc, const GUnit& u, int wr, int wc, int fr, int fq) const {
        bf16_t* UA = (bf16_t*)u.C;
#pragma unroll
        for (int ai = 0; ai < 2; ++ai)
#pragma unroll
            for (int m = 0; m < 4; ++m) { const int tok = u.pm * BM + ai * HALF + wr * 64 + m * 16 + fr; const int chunk = tok >> 5, j = tok & 31;
#pragma unroll
                for (int bj = 0; bj < 2; ++bj) { const int ch = u.pn * BM + bj * HALF + wc * 32 + 8 * fq, g = ch >> 4, h0 = ch & 15;
                    const f32x4 v0 = acc[ai][bj][m][0], v1 = acc[ai][bj][m][1];
                    u32x4 w; w.x = cvt_pk_bf16(v0[0], v0[1]); w.y = cvt_pk_bf16(v0[2], v0[3]); w.z = cvt_pk_bf16(v1[0], v1[1]); w.w = cvt_pk_bf16(v1[2], v1[3]);
                    st16(UA + ((size_t)g * NCHUNK + chunk) * UAK + j * 16 + h0, w); } }
    }
};
struct EpiS {
    static constexpr bool PERM = false;
    __device__ __forceinline__ void operator()(const Acc& acc, const GUnit& u, int wr, int wc, int fr, int fq) const {
        float* Sg = (float*)u.C;
#pragma unroll
        for (int ai = 0; ai < 2; ++ai)
#pragma unroll
            for (int m = 0; m < 4; ++m) { const int chunk = u.pm * BM + ai * HALF + wr * 64 + m * 16 + fr; float* rowp = Sg + (size_t)chunk * 256 + wc * 32 + 4 * fq;
#pragma unroll
                for (int bj = 0; bj < 2; ++bj)
#pragma unroll
                    for (int n = 0; n < 2; ++n) st16f(rowp + bj * HALF + n * 16, acc[ai][bj][m][n]); }
    }
};
struct EpiGelu {
    static constexpr bool PERM = true;
    __device__ __forceinline__ void operator()(const Acc& acc, const GUnit& u, int wr, int wc, int fr, int fq) const {
        bf16_t* Gg = (bf16_t*)u.C;
#pragma unroll
        for (int ai = 0; ai < 2; ++ai)
#pragma unroll
            for (int m = 0; m < 4; ++m) { const int chunk = u.pm * BM + ai * HALF + wr * 64 + m * 16 + fr;
#pragma unroll
                for (int bj = 0; bj < 2; ++bj) { const int n0 = u.pn * BM + bj * HALF + wc * 32 + 8 * fq, i = n0 >> 4, c0 = n0 & 15;
                    const f32x4 v0 = acc[ai][bj][m][0], v1 = acc[ai][bj][m][1];
                    u32x4 w; w.x = cvt_pk_bf16(gelu_tanh_fast(v0[0]), gelu_tanh_fast(v0[1])); w.y = cvt_pk_bf16(gelu_tanh_fast(v0[2]), gelu_tanh_fast(v0[3]));
                    w.z = cvt_pk_bf16(gelu_tanh_fast(v1[0]), gelu_tanh_fast(v1[1])); w.w = cvt_pk_bf16(gelu_tanh_fast(v1[2]), gelu_tanh_fast(v1[3]));
                    st16(Gg + ((size_t)chunk * TCH + i) * D + c0, w); } }
    }
};

struct EpiSoftmax {
    static constexpr bool PERM = true;
    LAS float* red; unsigned ldc; float scale;
    __device__ __forceinline__ void operator()(Acc& acc, const GUnit& u, int wr, int wc, int fr, int fq) const {
        bf16_t* base = (bf16_t*)u.C;
#pragma unroll
        for (int ai = 0; ai < 2; ++ai)
#pragma unroll
            for (int m = 0; m < 4; ++m) { float mx = -INFINITY;
#pragma unroll
                for (int bj = 0; bj < 2; ++bj)
#pragma unroll
                    for (int n = 0; n < 2; ++n) { const f32x4 v = acc[ai][bj][m][n]; mx = fmaxf(mx, fmaxf(fmaxf(v[0], v[1]), fmaxf(v[2], v[3]))); }
                mx *= scale; mx = x32_max(x16_max(mx));
                if (fq == 0) red[(ai * HALF + wr * 64 + m * 16 + fr) * 4 + wc] = mx; }
        asm volatile("s_waitcnt lgkmcnt(0)" ::: "memory"); __builtin_amdgcn_s_barrier(); asm volatile("" ::: "memory");
#pragma unroll
        for (int ai = 0; ai < 2; ++ai)
#pragma unroll
            for (int m = 0; m < 4; ++m) { const int r = ai * HALF + wr * 64 + m * 16 + fr; const f32x4 mm = *(const LAS f32x4*)(red + r * 4); const float M = fmaxf(fmaxf(mm[0], mm[1]), fmaxf(mm[2], mm[3]));
                float s = 0.f;
#pragma unroll
                for (int bj = 0; bj < 2; ++bj)
#pragma unroll
                    for (int n = 0; n < 2; ++n) { f32x4 v = acc[ai][bj][m][n];
#pragma unroll
                        for (int j = 0; j < 4; ++j) { v[j] = __builtin_amdgcn_exp2f(__builtin_fmaf(v[j], scale, -M)); s += v[j]; }
                        acc[ai][bj][m][n] = v; }
                s = x32_sum(x16_sum(s));
                if (fq == 0) red[1024 + r * 4 + wc] = s; }
        asm volatile("s_waitcnt lgkmcnt(0)" ::: "memory"); __builtin_amdgcn_s_barrier(); asm volatile("" ::: "memory");
#pragma unroll
        for (int ai = 0; ai < 2; ++ai)
#pragma unroll
            for (int m = 0; m < 4; ++m) { const int r = ai * HALF + wr * 64 + m * 16 + fr; const f32x4 ss = *(const LAS f32x4*)(red + 1024 + r * 4); const float inv = __builtin_amdgcn_rcpf((ss[0] + ss[1]) + (ss[2] + ss[3]));
                bf16_t* rowp = base + (size_t)r * ldc + wc * 32 + 8 * fq;
#pragma unroll
                for (int bj = 0; bj < 2; ++bj) { const f32x4 v0 = acc[ai][bj][m][0] * inv, v1 = acc[ai][bj][m][1] * inv;
                    u32x4 w; w.x = cvt_pk_bf16(v0[0], v0[1]); w.y = cvt_pk_bf16(v0[2], v0[3]); w.z = cvt_pk_bf16(v1[0], v1[1]); w.w = cvt_pk_bf16(v1[2], v1[3]);
                    st16(rowp + bj * HALF, w); } }
    }
};

struct Ctx { unsigned char* ws; int G, c; };
struct SchedPlain { const char* A; const char* B; char* C; size_t lda, ldb, ldc; int nM, nN, G, c;
    __device__ __forceinline__ bool next(int i, GUnit& u) const { int pm, pn; if (!static_unit(i, G, c, nM, nN, pm, pn)) return false;
        u.A = A + (size_t)pm * BM * lda; u.B = B + (size_t)pn * BM * ldb; u.C = C + ((size_t)pm * BM * ldc + (size_t)pn * BM) * 2; u.X = nullptr; u.pm = pm; u.pn = pn; return true; } };
struct SchedGated { const char* A; const char* B; char* C; size_t lda, ldb, ldc; int nM, nN, G, c;
    __device__ __forceinline__ bool next(int i, GUnit& u) const { int pm, pn; if (!static_unit(i, G, c, nM, nN, pm, pn)) return false;
        u.A = A + (size_t)pm * BM * lda; u.B = B + (size_t)pn * BM * ldb; u.C = C + ((size_t)pm * BM * ldc + (size_t)pn * HALF) * 2; u.X = nullptr; u.pm = pm; u.pn = pn; return true; } };
struct SchedUA { const char* A; const char* B; char* UA; int G, c;
    __device__ __forceinline__ bool next(int i, GUnit& u) const { int pm, pn; if (!static_unit(i, G, c, NT / BM, D / BM, pm, pn)) return false;
        u.A = A + (size_t)pm * BM * (D * 2); u.B = B + (size_t)pn * BM * (D * 2); u.C = UA; u.X = nullptr; u.pm = pm; u.pn = pn; return true; } };
struct SchedKV { unsigned char* ws; int G, c;
    __device__ __forceinline__ bool next(int i, GUnit& u) const { const int L = i * G + c; if (L >= 128) return false; const int layer = L >> 6, r = L & 63, pm = r >> 3, pn = r & 7;
        u.A = (const char*)ws + WS_MEMB + (size_t)pm * BM * 2048; u.B = (const char*)ws + WS_MWKV + (size_t)layer * 4 * MiB + (size_t)pn * BM * 2048;
        u.C = (char*)ws + WS_KV + (size_t)layer * 8 * MiB + ((size_t)pm * BM * 2048 + pn * BM) * 2; u.X = nullptr; u.pm = pm; u.pn = pn; return true; } };
struct SchedSA { unsigned char* ws; int G, c;
    __device__ __forceinline__ bool next(int i, GUnit& u) const { const int L = i * G + c; if (L >= 64 * 6) return false; const int g = L / 6, pm = L % 6;
        u.A = (const char*)ws + PO_UA + ((size_t)g * NCHUNK + (size_t)pm * BM) * (UAK * 2); u.B = (const char*)ws + PO_M2T + (size_t)g * 256 * 512 * 2;
        u.C = (char*)ws + PO_SG + (size_t)g * NCHUNK * 256 * 4; u.X = nullptr; u.pm = pm; u.pn = 0; return true; } };
struct SchedSC { unsigned char* ws; int G, c;
    __device__ __forceinline__ bool next(int i, GUnit& u) const { const int L = i * G + c; if (L >= 64 * 12) return false; const int g = L / 12, r = L % 12, pm = r >> 1, pn = r & 1;
        u.A = (const char*)ws + PO_UA + ((size_t)g * NCHUNK + (size_t)pm * BM) * (UAK * 2); u.B = (const char*)ws + PO_M13T + ((size_t)g * 512 + pn * BM) * UAK * 2;
        u.C = (char*)ws + PO_SG + (size_t)g * 16 * 2; u.X = nullptr; u.pm = pm; u.pn = pn; return true; } };
struct SchedWqk { unsigned char* ws; int G, c;
    __device__ __forceinline__ bool next(int i, GUnit& u) const { const int L = i * G + c; if (L >= 256) return false; const int pn = L & 3, h = (L >> 2) & 3, gb = (L >> 4) & 7, layer = L >> 7;
        u.A = (const char*)ws + WS_KV + (size_t)layer * 8 * MiB + ((size_t)gb * 256 * 2048 + h * 256) * 2; u.B = (const char*)ws + WS_MWQ + (size_t)layer * 2 * MiB + ((size_t)pn * BM * 1024 + h * 256) * 2;
        u.C = (char*)ws + WS_WQK + ((size_t)(layer * 8 + gb) * 1024 * 1024 + (size_t)h * 256 * 1024 + pn * BM); u.X = nullptr; u.pm = 0; u.pn = pn; return true; } };
struct SchedWvo { unsigned char* ws; int G, c;
    __device__ __forceinline__ bool next(int i, GUnit& u) const { const int L = i * G + c; if (L >= 256) return false; const int pm = L & 3, h = (L >> 2) & 3, gb = (L >> 4) & 7, layer = L >> 7;
        u.A = (const char*)ws + WS_MWO + (size_t)layer * 2 * MiB + ((size_t)pm * BM * 1024 + h * 256) * 2; u.B = (const char*)ws + WS_KV + (size_t)layer * 8 * MiB + ((size_t)gb * 256 * 2048 + 1024 + h * 256) * 2;
        u.C = (char*)ws + WS_WVO + ((size_t)(layer * 8 + gb) * 1024 * 1024 + (size_t)pm * BM * 1024 + h * 256) * 2; u.X = nullptr; u.pm = pm; u.pn = 0; return true; } };
struct SchedScores8 { const char* A; const char* Bl; char* C; int G, c;
    __device__ __forceinline__ bool next(int i, GUnit& u) const { int pm, pn; if (!static_unit(i, G, c, NT / BM, 4, pm, pn)) return false; const int gb = panel_gb(pm);
        u.A = A + (size_t)pm * BM * 1024; u.B = Bl + ((size_t)gb * 1024 + pn * BM) * 1024; u.C = C + ((size_t)pm * BM * 1024 + pn * BM) * 2; u.X = nullptr; u.pm = pm; u.pn = pn; return true; } };
struct SchedBatchW { const char* A; const char* Bl; char* C; int G, c;
    __device__ __forceinline__ bool next(int i, GUnit& u) const { int pm, pn; if (!static_unit(i, G, c, NT / BM, 4, pm, pn)) return false; const int gb = panel_gb(pm);
        u.A = A + (size_t)pm * BM * 2048; u.B = Bl + ((size_t)gb * 1024 + pn * BM) * 2048; u.C = C + ((size_t)pm * BM * 1024 + pn * BM) * 2; u.X = nullptr; u.pm = pm; u.pn = pn; return true; } };
struct Args { const float* in[26]; float* out; unsigned char* ws; int ph_lo, ph_hi, flags, pad; };
struct Frame {
    LAS unsigned char* lds; unsigned char* ws; const float* const* in; float* out;
    int tid, lane, wave, G, c;
    bool xok;
};
enum { I_XP = 0, I_XS, I_MEMP, I_MEMS, I_AWIN, I_ALRE, I_ALIM, I_ALDT, I_ABRE, I_ABIM, I_ACRE, I_ACIM, I_AD, I_AWGLU, I_BWQKV, I_BRPB, I_BWO, I_MWQ, I_MWKV, I_MWO, I_EWR, I_EW1, I_EW3, I_EW2, I_LNG, I_LNB };

__device__ __forceinline__ int rowmap(int mode, int n) {
    if (mode == 0) return n;
    if (mode == 1) { const int z = n >> 10, nn = n & 1023; return ((nn >> 7) << 8) + (z << 7) + (nn & 127); }
    return ((n >> 7) << 8) + ((mode == 3) ? 128 : 0) + (n & 127);
}
__device__ __forceinline__ void transpose_item(const float* W, int K, int N, bf16_t* WT, int mode, LAS float* scr, int item, int lane) {
    const int nblk = N / 32, kb = item / nblk, nb = item % nblk, k0 = 64 * kb, n0 = 32 * nb;
#pragma unroll 8
    for (int i = 0; i < 32; ++i) { const int kk = 2 * i + (lane >> 5); scr[kk * 33 + (lane & 31)] = W[(size_t)(k0 + kk) * N + n0 + (lane & 31)]; }
    LDS_WAIT(); asm volatile("" ::: "memory");
    const int c = lane & 7;
#pragma unroll
    for (int j = 0; j < 4; ++j) { const int n = (lane >> 3) + 8 * j; const LAS float* s = scr + (8 * c) * 33 + n;
        u32x4 o; o.x = cvt_pk_bf16(s[0 * 33], s[1 * 33]); o.y = cvt_pk_bf16(s[2 * 33], s[3 * 33]); o.z = cvt_pk_bf16(s[4 * 33], s[5 * 33]); o.w = cvt_pk_bf16(s[6 * 33], s[7 * 33]);
        *(u32x4*)(WT + (size_t)rowmap(mode, n0 + n) * K + k0 + 8 * c) = o; }
    LDS_WAIT(); asm volatile("" ::: "memory");
}
__device__ __forceinline__ void t8_load(f32x4 (&v)[16], const float* W, int N, int item, int lane) {
    const int nblk = N / 32, kb = item / nblk, nb = item % nblk, k0 = 128 * kb, n0 = 32 * nb, q = lane >> 3, c = lane & 7;
#pragma unroll
    for (int i = 0; i < 16; ++i) v[i] = *(const f32x4*)(W + (size_t)(k0 + 16 * q + i) * N + n0 + 4 * c);
}
__device__ __forceinline__ void t8_finish(const f32x4 (&v)[16], int K, int N, unsigned char* WT, int mode, float scale, LAS unsigned char* scr, int item, int lane) {
    const int nblk = N / 32, kb = item / nblk, nb = item % nblk, k0 = 128 * kb, n0 = 32 * nb, q = lane >> 3, c = lane & 7;
#pragma unroll
    for (int j = 0; j < 4; ++j) { u32x4 o;
        o.x = cvt4_fp8(v[0][j] * scale, v[1][j] * scale, v[2][j] * scale, v[3][j] * scale); o.y = cvt4_fp8(v[4][j] * scale, v[5][j] * scale, v[6][j] * scale, v[7][j] * scale);
        o.z = cvt4_fp8(v[8][j] * scale, v[9][j] * scale, v[10][j] * scale, v[11][j] * scale); o.w = cvt4_fp8(v[12][j] * scale, v[13][j] * scale, v[14][j] * scale, v[15][j] * scale);
        *(LAS u32x4*)(scr + (4 * c + j) * 144 + 16 * q) = o; }
    LDS_WAIT(); asm volatile("" ::: "memory");
#pragma unroll
    for (int j = 0; j < 4; ++j) { const int n = (lane >> 3) + 8 * j; const u32x4 o = *(const LAS u32x4*)(scr + n * 144 + 16 * c);
        pst16(WT + (size_t)rowmap(mode, n0 + n) * K + k0 + 16 * c, o); }
    LDS_WAIT(); asm volatile("" ::: "memory");
}
__device__ __forceinline__ void transpose_item8(const float* W, int K, int N, unsigned char* WT, int mode, float scale, LAS unsigned char* scr, int item, int lane) {
    f32x4 v[16]; t8_load(v, W, N, item, lane); t8_finish(v, K, N, WT, mode, scale, scr, item, lane);
}
__device__ __forceinline__ void transpose_item16(const float* W, int K, int N, bf16_t* WT, int mode, LAS unsigned char* scr, int item, int lane) {
    const int nblk = N / 32, kb = item / nblk, nb = item % nblk, k0 = 128 * kb, n0 = 32 * nb, q = lane >> 3, c = lane & 7;
    f32x4 v[16];
#pragma unroll
    for (int i = 0; i < 16; ++i) v[i] = *(const f32x4*)(W + (size_t)(k0 + 16 * q + i) * N + n0 + 4 * c);
#pragma unroll
    for (int j = 0; j < 4; ++j) { u32x4 o0, o1;
        o0.x = cvt_pk_bf16(v[0][j], v[1][j]); o0.y = cvt_pk_bf16(v[2][j], v[3][j]); o0.z = cvt_pk_bf16(v[4][j], v[5][j]); o0.w = cvt_pk_bf16(v[6][j], v[7][j]);
        o1.x = cvt_pk_bf16(v[8][j], v[9][j]); o1.y = cvt_pk_bf16(v[10][j], v[11][j]); o1.z = cvt_pk_bf16(v[12][j], v[13][j]); o1.w = cvt_pk_bf16(v[14][j], v[15][j]);
        *(LAS u32x4*)(scr + (4 * c + j) * 272 + 32 * q) = o0; *(LAS u32x4*)(scr + (4 * c + j) * 272 + 32 * q + 16) = o1; }
    LDS_WAIT(); asm volatile("" ::: "memory");
#pragma unroll
    for (int j = 0; j < 8; ++j) { const int n = (lane >> 4) + 4 * j, ch = lane & 15; const u32x4 o = *(const LAS u32x4*)(scr + n * 272 + 16 * ch);
        *(u32x4*)(WT + (size_t)rowmap(mode, n0 + n) * K + k0 + 8 * ch) = o; }
    LDS_WAIT(); asm volatile("" ::: "memory");
}
__device__ __forceinline__ void convert_small_weights(Frame& F) {
    LAS unsigned char* scr = F.lds + F.wave * 16384;
    const int gw = F.c * 8 + F.wave, NGW = F.G * 8;
    for (int it = gw; it < 3328; it += NGW) {
        int r = it;
        if (r < 256) { transpose_item16(F.in[I_AWIN], 1024, 1024, (bf16_t*)(F.ws + WS_WIN), 0, scr, r, F.lane); continue; } r -= 256;
        if (r < 512) { transpose_item16(F.in[I_AWGLU], 1024, 2048, (bf16_t*)(F.ws + WS_WGLU), 1, scr, r, F.lane); continue; } r -= 512;
        if (r < 768) { transpose_item8(F.in[I_BWQKV], 1024, 3072, F.ws + WS_WQKV, 0, FP8_SWQKV, scr, r, F.lane); continue; } r -= 768;
        if (r < 256) { transpose_item16(F.in[I_BWO], 1024, 1024, (bf16_t*)(F.ws + WS_WO), 0, scr, r, F.lane); continue; } r -= 256;
        if (r < 1024) { const int l = r >> 9; transpose_item16(F.in[I_MWKV] + (size_t)l * 1024 * 2048, 1024, 2048, (bf16_t*)(F.ws + WS_MWKV + (size_t)l * 4 * MiB), 0, scr, r & 511, F.lane); continue; } r -= 1024;
        { const int l = r >> 8; transpose_item16(F.in[I_MWO] + (size_t)l * 1024 * 1024, 1024, 1024, (bf16_t*)(F.ws + WS_MWO + (size_t)l * 2 * MiB), 0, scr, r & 255, F.lane); }
    }
}
__device__ __forceinline__ void convert_expert_weights(Frame& F, int layer, int lo = 0, int hi = 16 * 1536, int wg0 = 0) {
    if (F.G <= wg0) wg0 = 0;
    if (F.c < wg0) return;
    LAS unsigned char* scr = F.lds + F.wave * 16384;
    const int gw = (F.c - wg0) * 8 + F.wave, NGW = (F.G - wg0) * 8;
#define CVX_DECODE(it_) const int _e = (it_) / 1536; int _r = (it_) % 1536; const size_t _wofs = ((size_t)layer * 16 + _e) * 1024 * 2048; \
        const int _w = _r >> 9; _r &= 511; const float* _W = (_w == 0 ? F.in[I_EW1] : (_w == 1 ? F.in[I_EW3] : F.in[I_EW2])) + _wofs; const int _N = _w == 2 ? 1024 : 2048, _K = _w == 2 ? 2048 : 1024;
#define CVX_LOAD(v_, it_) do { CVX_DECODE(it_); (void)_K; t8_load(v_, _W, _N, _r, F.lane); } while (0)
#define CVX_FINISH(v_, it_) do { CVX_DECODE(it_); unsigned char* _WT = _w == 2 ? F.ws + WS_EW2 + (size_t)_e * 2 * MiB : F.ws + WS_EW13 + (size_t)_e * 4 * MiB; \
        t8_finish(v_, _K, _N, _WT, _w == 0 ? 2 : (_w == 1 ? 3 : 0), _w == 2 ? FP8_SW2 : FP8_SW13, scr, _r, F.lane); } while (0)
    f32x4 va[16], vb[16];
    int it = lo + gw;
    if (it < hi) CVX_LOAD(va, it);
    while (it < hi) {
        const int it1 = it + NGW, it2 = it1 + NGW;
        if (it1 < hi) CVX_LOAD(vb, it1);
        CVX_FINISH(va, it);
        if (it1 < hi) { if (it2 < hi) CVX_LOAD(va, it2); CVX_FINISH(vb, it1); }
        it = it2;
    }
#undef CVX_DECODE
#undef CVX_LOAD
#undef CVX_FINISH
}
__device__ __forceinline__ void convert_plain(Frame& F, const float* src, bf16_t* dst, size_t n) {
    const size_t n4 = n / 4;
    for (size_t i = (size_t)F.c * 512 + F.tid; i < n4; i += (size_t)F.G * 512) { const f32x4 v = ((const f32x4*)src)[i]; u32x2 w; w.x = cvt_pk_bf16(v[0], v[1]); w.y = cvt_pk_bf16(v[2], v[3]); ((u32x2*)dst)[i] = w; }
}
__device__ __forceinline__ void import_x(Frame& F, bool copy_f32) {
    const size_t n4 = (size_t)NT * D / 4, np4 = (size_t)NTP * D / 4, st = (size_t)F.G * 512;
    f32x4* XF = (f32x4*)(F.ws + WS_XF); u32x2* XB = (u32x2*)(F.ws + WS_XB);
    for (size_t i0 = (size_t)F.c * 512 + F.tid; i0 < n4; i0 += st * 8) {
        f32x4 v[8];
#pragma unroll
        for (int u = 0; u < 8; ++u) { const size_t i = i0 + st * u;
            if (i < n4) { if (copy_f32) { v[u] = (i < np4) ? ((const f32x4*)F.in[I_XP])[i] : ((const f32x4*)F.in[I_XS])[i - np4]; } else v[u] = XF[i]; } }
#pragma unroll
        for (int u = 0; u < 8; ++u) { const size_t i = i0 + st * u;
            if (i < n4) { u32x2 w; w.x = cvt_pk_bf16(v[u][0], v[u][1]); w.y = cvt_pk_bf16(v[u][2], v[u][3]); XB[i] = w; } }
    }
}

__device__ __forceinline__ void s5_lam(const float* lre, const float* lim, const float* ldt, int dir, int g, int p, double& dt, double& lr, double& li) {
    dt = exp((double)ldt[dir * 64 + g]); lr = (double)lre[(dir * 64 + g) * 64 + p]; li = (double)lim[(dir * 64 + g) * 64 + p];
}
__device__ __forceinline__ void s5_fill_bc(Frame& F, int g, int dir, LAS float* Bbr, LAS float* Bbi, LAS float* Cr, LAS float* Ci) {
    for (int idx = F.tid; idx < 1024; idx += 512) {
        const int p = idx >> 4, h = idx & 15; double dt, lr, li; s5_lam(F.in[I_ALRE], F.in[I_ALIM], F.in[I_ALDT], dir, g, p, dt, lr, li);
        const double er = exp(lr * dt), lbr = er * cos(li * dt), lbi = er * sin(li * dt), nr = lbr - 1.0, ni = lbi, den = lr * lr + li * li;
        const double fr = (nr * lr + ni * li) / den, fi = (ni * lr - nr * li) / den;
        const double br = F.in[I_ABRE][((dir * 64 + g) * 64 + p) * 16 + h], bi = F.in[I_ABIM][((dir * 64 + g) * 64 + p) * 16 + h];
        Bbr[idx] = (float)(fr * br - fi * bi); Bbi[idx] = (float)(fr * bi + fi * br);
        Cr[idx] = F.in[I_ACRE][(dir * 64 + g) * 1024 + idx]; Ci[idx] = F.in[I_ACIM][(dir * 64 + g) * 1024 + idx];
    }
}
__device__ __forceinline__ void s5_build_item(Frame& F, int g, int dir) {
    LAS float* LPr = (LAS float*)F.lds; LAS float* LPi = LPr + 33 * 64;
    LAS float* Bbr = LPi + 33 * 64; LAS float* Bbi = Bbr + 1024; LAS float* Cr = Bbi + 1024; LAS float* Ci = Cr + 1024;
    LAS float* B2r = Ci + 1024; LAS float* B2i = B2r + 1024; LAS float* C2r = B2i + 1024; LAS float* C2i = C2r + 1024;
    bf16_t* M2T = (bf16_t*)(F.ws + PO_M2T) + (size_t)g * 256 * 512; bf16_t* M13T = (bf16_t*)(F.ws + PO_M13T) + (size_t)g * 512 * UAK;
    __syncthreads();
    for (int idx = F.tid; idx < 33 * 64; idx += 512) { const int e = idx >> 6, p = idx & 63; double dt, lr, li; s5_lam(F.in[I_ALRE], F.in[I_ALIM], F.in[I_ALDT], dir, g, p, dt, lr, li);
        const double er = exp(lr * dt * e); LPr[idx] = (float)(er * cos(li * dt * e)); LPi[idx] = (float)(er * sin(li * dt * e)); }
    s5_fill_bc(F, g, dir, Bbr, Bbi, Cr, Ci);
    if (dir == 0) s5_fill_bc(F, g, 1, B2r, B2i, C2r, C2i);
    __syncthreads();
    {
        const int k = F.tid, j = k >> 4, h = k & 15, e = dir == 0 ? (TCH - 1 - j) : j;
        for (int p = 0; p < 64; ++p) { const float lr = LPr[e * 64 + p], li = LPi[e * 64 + p], br = Bbr[p * 16 + h], bi = Bbi[p * 16 + h];
            const float xr = lr * br - li * bi, xi = lr * bi + li * br;
            M2T[(size_t)(dir * 128 + p) * 512 + k] = (bf16_t)(cvt_pk_bf16(xr, 0.f) & 0xffffu); M2T[(size_t)(dir * 128 + 64 + p) * 512 + k] = (bf16_t)(cvt_pk_bf16(xi, 0.f) & 0xffffu); }
    }
    {
        const int p = F.tid & 63, q8 = F.tid >> 6;
        for (int ic = q8; ic < 512; ic += 8) { const int i = ic >> 4, c = ic & 15, e = dir == 0 ? (i + 1) : (TCH - i);
            const float cr = Cr[c * 64 + p], ci = Ci[c * 64 + p], lr = LPr[e * 64 + p], li = LPi[e * 64 + p];
            const float vr = cr * lr - ci * li, vi = cr * li + ci * lr;
            M13T[(size_t)ic * UAK + 512 + dir * 128 + p] = (bf16_t)(cvt_pk_bf16(vr, 0.f) & 0xffffu); M13T[(size_t)ic * UAK + 512 + dir * 128 + 64 + p] = (bf16_t)(cvt_pk_bf16(-vi, 0.f) & 0xffffu); }
    }
    {
        const int ch = F.tid & 255, c = ch >> 4, h = ch & 15, par = F.tid >> 8;
        for (int d = 1 + par; d < TCH; d += 2) {
            float s = 0.f;
            for (int p = 0; p < 64; ++p) { const float lr = LPr[d * 64 + p], li = LPi[d * 64 + p], br = Bbr[p * 16 + h], bi = Bbi[p * 16 + h];
                s += Cr[c * 64 + p] * (lr * br - li * bi) - Ci[c * 64 + p] * (lr * bi + li * br); }
            const bf16_t v = (bf16_t)(cvt_pk_bf16(s, 0.f) & 0xffffu);
            for (int t = 0; t + d < TCH; ++t) { const int i = dir == 0 ? t + d : t, j = dir == 0 ? t : t + d; M13T[(size_t)(i * 16 + c) * UAK + j * 16 + h] = v; }
        }
        if (dir == 0 && par == 0) {
            float s = (c == h) ? F.in[I_AD][g * 16 + c] : 0.f;
            for (int p = 0; p < 64; ++p) s += Cr[c * 64 + p] * Bbr[p * 16 + h] - Ci[c * 64 + p] * Bbi[p * 16 + h] + C2r[c * 64 + p] * B2r[p * 16 + h] - C2i[c * 64 + p] * B2i[p * 16 + h];
            const bf16_t v = (bf16_t)(cvt_pk_bf16(s, 0.f) & 0xffffu);
            for (int t = 0; t < TCH; ++t) M13T[(size_t)(t * 16 + c) * UAK + t * 16 + h] = v;
        }
    }
    __syncthreads();
}

__device__ __forceinline__ void s5_recurrence(Frame& F) {
    const float* S = (const float*)(F.ws + PO_SG); bf16_t* UA = (bf16_t*)(F.ws + PO_UA);
    for (int base = F.c * 256; base < 65536; base += F.G * 256) {
        if (F.tid >= 256) continue;
        const int flat = base + F.tid, p = flat & 63, dir = (flat >> 6) & 1, g = (flat >> 7) & 63, gb = flat >> 13;
        double dt, lr, li; s5_lam(F.in[I_ALRE], F.in[I_ALIM], F.in[I_ALDT], dir, g, p, dt, lr, li);
        const double er = exp(lr * dt * TCH); const float ar = (float)(er * cos(li * dt * TCH)), ai = (float)(er * sin(li * dt * TCH));
        const int nc = gb < 4 ? 256 : 128, chunk0 = gb < 4 ? gb * 256 : 1024 + (gb - 4) * 128;
        float hr = 0.f, hi = 0.f;
        for (int s0 = 0; s0 < nc; s0 += 8) {
            float sr[8], si[8];
#pragma unroll
            for (int k = 0; k < 8; ++k) { const int cc = dir == 0 ? (s0 + k) : (nc - 1 - s0 - k); const size_t o = ((size_t)g * NCHUNK + (chunk0 + cc)) * 256 + dir * 128 + p; sr[k] = S[o]; si[k] = S[o + 64]; }
#pragma unroll
            for (int k = 0; k < 8; ++k) { const int cc = dir == 0 ? (s0 + k) : (nc - 1 - s0 - k); const size_t o = ((size_t)g * NCHUNK + (chunk0 + cc)) * UAK + 512 + dir * 128 + p;
                UA[o] = (bf16_t)(cvt_pk_bf16(hr, 0.f) & 0xffffu); UA[o + 64] = (bf16_t)(cvt_pk_bf16(hi, 0.f) & 0xffffu);
                const float nr = ar * hr - ai * hi + sr[k], ni = ar * hi + ai * hr + si[k]; hr = nr; hi = ni; }
        }
    }
}

__device__ __forceinline__ void add_bf16x4(f32x4& v, const u32x2 w) { v[0] += __uint_as_float(w.x << 16); v[1] += __uint_as_float(w.x & 0xffff0000u); v[2] += __uint_as_float(w.y << 16); v[3] += __uint_as_float(w.y & 0xffff0000u); }
constexpr int WRS = 1028;
__device__ __forceinline__ void ln_router_fill(Frame& F, const float* gam, const float* bet, const float* wrouter) {
    LAS float* wrT = (LAS float*)F.lds; LAS float* gsh = wrT + 16 * WRS; LAS float* bsh = gsh + 1024;
    __syncthreads();
    for (int i = F.tid; i < 16384; i += 512) { const int k = i >> 4, e = i & 15; wrT[e * WRS + k] = wrouter[i]; }
    for (int i = F.tid; i < 1024; i += 512) { gsh[i] = gam[i]; bsh[i] = bet[i]; }
    __syncthreads();
}
#ifndef RES_BF16
#define RES_BF16 1
#endif
template <int MODE, bool ROUTER, bool FINAL, bool SRCIN = false>
__device__ __forceinline__ void ln_phase(Frame& F, const bf16_t* HB, const float* gam, const float* bet, const float* wrouter) {
    float* XF = (float*)(F.ws + WS_XF);
    LAS float* wrT = (LAS float*)F.lds;
    LAS float* gsh = wrT + 16 * WRS; LAS float* bsh = gsh + 1024;
    f32x4 gv[4], bv[4];
    if (!ROUTER) {
#pragma unroll
        for (int j = 0; j < 4; ++j) { gv[j] = *(const f32x4*)(gam + F.lane * 4 + 256 * j); bv[j] = *(const f32x4*)(bet + F.lane * 4 + 256 * j); } }
    const unsigned char* wsb = F.ws; int ln = F.lane; unsigned lb4 = (unsigned)ln * 16u, lb2 = (unsigned)ln * 8u, lb1 = (unsigned)ln * 4u;
    const unsigned hb_off = (unsigned)((const unsigned char*)HB - wsb);
    const int nq = F.xok ? 6 : (NT / 4 + F.G * 8 - 1) / (F.G * 8);
    constexpr bool X32 = SRCIN || !RES_BF16;
    f32x4 xr32[4][4]; u32x2 xr16[4][4], hwr[4][4];
#define LN_ISSUE(row0_) do { const int _r0 = (row0_); \
        const unsigned char* xbase = SRCIN ? (_r0 < NTP ? (const unsigned char*)F.in[I_XP] : (const unsigned char*)F.in[I_XS] - (size_t)NTP * 4096) : wsb + WS_XF;      \
        if (X32) { _Pragma("unroll") for (int r = 0; r < 4; ++r) { const unsigned ro = (unsigned)(_r0 + r) * 4096u + lb4; _Pragma("unroll") for (int j = 0; j < 4; ++j) xr32[r][j] = *(const f32x4*)(xbase + ro + 1024u * j); } } \
        else { _Pragma("unroll") for (int r = 0; r < 4; ++r) { const unsigned ro = (unsigned)(_r0 + r) * 2048u + lb2; _Pragma("unroll") for (int j = 0; j < 4; ++j) xr16[r][j] = *(const u32x2*)(xbase + ro + 512u * j); } } \
        if (MODE == 0) { _Pragma("unroll") for (int r = 0; r < 4; ++r) { const unsigned ro = hb_off + (unsigned)(_r0 + r) * 2048u + lb2; _Pragma("unroll") for (int j = 0; j < 4; ++j) hwr[r][j] = *(const u32x2*)(wsb + ro + 512u * j); } } \
    } while (0)
#define LN_Q(qi_) (F.xok ? ((F.c & 7) * 1536 + (F.c >> 3) * 48 + F.wave * 6 + (qi_)) : (F.c * 8 + F.wave + (qi_) * F.G * 8))
    u32x4 sln = {~0u, ~0u, ~0u, ~0u};
    if (MODE == 1) { const int q0 = LN_Q(0); if (nq > 0 && q0 < NT / 4 && F.lane < 16) sln = *(const u32x4*)(wsb + (unsigned)(WS_SLOT + ((size_t)F.lane * NT + (size_t)q0 * 4) * 4)); }
    { const int q0 = LN_Q(0); if (nq > 0 && q0 < NT / 4) { LN_ISSUE(q0 * 4); } }
    for (int qi = 0; qi < nq; ++qi) {
        const int q = LN_Q(qi);
        if (q >= NT / 4) break;
        const int row0 = q * 4;
        const u32x4 slc = sln;
        if (MODE == 1) { const int qn = LN_Q(qi + 1); if (qi + 1 < nq && qn < NT / 4 && ln < 16) sln = *(const u32x4*)(wsb + (unsigned)(WS_SLOT + ((size_t)ln * NT + (size_t)qn * 4) * 4)); }
        asm volatile("v_mbcnt_lo_u32_b32 %0, -1, 0\n\tv_mbcnt_hi_u32_b32 %0, -1, %0" : "=v"(ln));
        lb4 = (unsigned)ln * 16u; lb2 = (unsigned)ln * 8u; lb1 = (unsigned)ln * 4u; const int lw = ln * 4;
        f32x4 v[4][4];
#pragma unroll
        for (int r = 0; r < 4; ++r)
#pragma unroll
            for (int j = 0; j < 4; ++j) {
                if (X32) v[r][j] = xr32[r][j];
                else { v[r][j][0] = __uint_as_float(xr16[r][j].x << 16); v[r][j][1] = __uint_as_float(xr16[r][j].x & 0xffff0000u); v[r][j][2] = __uint_as_float(xr16[r][j].y << 16); v[r][j][3] = __uint_as_float(xr16[r][j].y & 0xffff0000u); } }
        if (MODE == 0) {
#pragma unroll
            for (int r = 0; r < 4; ++r)
#pragma unroll
                for (int j = 0; j < 4; ++j) { v[r][j] = v[r][j] * ALPHA; add_bf16x4(v[r][j], hwr[r][j]); }
        }
        if (!ROUTER) { const int qn = LN_Q(qi + 1); if (qi + 1 < nq && qn < NT / 4) { LN_ISSUE(qn * 4); } }
        if (MODE == 0) {
        } else {
            const int grp = row0 >= NTP; int sl[4];
#pragma unroll
            for (int r = 0; r < 4; ++r) sl[r] = (ln < 16) ? (int)slc[r] : -1;
            unsigned long long mask[4]; bool any[4], two[4]; u32x2 wa[4][4], wb[4][4];
#pragma unroll
            for (int r = 0; r < 4; ++r) {
                unsigned long long mk = __ballot(sl[r] >= 0); any[r] = mk != 0ull;
                int e0 = 0, s0 = 0; if (any[r]) { e0 = __builtin_ctzll(mk); mk &= mk - 1; s0 = __builtin_amdgcn_readlane(sl[r], e0); }
                const unsigned y0 = any[r] ? (grp ? 65536u + e0 * 2048u + s0 : e0 * 4096u + s0) : 0u;
                two[r] = mk != 0ull; int e1 = 0, s1 = 0; if (two[r]) { e1 = __builtin_ctzll(mk); mk &= mk - 1; s1 = __builtin_amdgcn_readlane(sl[r], e1); }
                const unsigned y1 = two[r] ? (grp ? 65536u + e1 * 2048u + s1 : e1 * 4096u + s1) : y0;
                mask[r] = mk;
                const unsigned char* ya = wsb + PO_YE + (size_t)y0 * 2048; const unsigned char* yb = wsb + PO_YE + (size_t)y1 * 2048;
#pragma unroll
                for (int j = 0; j < 4; ++j) { wa[r][j] = *(const u32x2*)(ya + lb2 + 512u * j); wb[r][j] = *(const u32x2*)(yb + lb2 + 512u * j); }
            }
#pragma unroll
            for (int r = 0; r < 4; ++r) {
#pragma unroll
                for (int j = 0; j < 4; ++j) { v[r][j] = v[r][j] * ALPHA; if (any[r]) add_bf16x4(v[r][j], wa[r][j]); if (two[r]) add_bf16x4(v[r][j], wb[r][j]); }
                unsigned long long mk = mask[r];
                while (mk) {
                    const int e0 = __builtin_ctzll(mk); mk &= mk - 1; const int s0 = __builtin_amdgcn_readlane(sl[r], e0);
                    const unsigned y0 = grp ? 65536u + e0 * 2048u + s0 : e0 * 4096u + s0;
                    const bool tw = mk != 0ull; int e1 = 0, s1 = 0; if (tw) { e1 = __builtin_ctzll(mk); mk &= mk - 1; s1 = __builtin_amdgcn_readlane(sl[r], e1); }
                    const unsigned y1 = tw ? (grp ? 65536u + e1 * 2048u + s1 : e1 * 4096u + s1) : y0;
                    const unsigned char* ya = wsb + PO_YE + (size_t)y0 * 2048; const unsigned char* yb = wsb + PO_YE + (size_t)y1 * 2048;
                    u32x2 xa[4], xb[4];
#pragma unroll
                    for (int j = 0; j < 4; ++j) { xa[j] = *(const u32x2*)(ya + lb2 + 512u * j); xb[j] = *(const u32x2*)(yb + lb2 + 512u * j); }
#pragma unroll
                    for (int j = 0; j < 4; ++j) { add_bf16x4(v[r][j], xa[j]); if (tw) add_bf16x4(v[r][j], xb[j]); }
                }
            }
        }
#pragma unroll
        for (int r = 0; r < 4; ++r) {
            float s = 0.f;
#pragma unroll
            for (int j = 0; j < 4; ++j) s += (v[r][j][0] + v[r][j][1]) + (v[r][j][2] + v[r][j][3]);
            const float mean = wave_sum(s) * (1.f / D); float qq = 0.f;
#pragma unroll
            for (int j = 0; j < 4; ++j) { v[r][j] = v[r][j] - mean; qq += (v[r][j][0] * v[r][j][0] + v[r][j][1] * v[r][j][1]) + (v[r][j][2] * v[r][j][2] + v[r][j][3] * v[r][j][3]); }
            const float rstd = 1.f / sqrtf(wave_sum(qq) * (1.f / D) + LN_EPS);
#pragma unroll
            for (int j = 0; j < 4; ++j) { if (ROUTER) { gv[j] = *(const LAS f32x4*)(gsh + lw + 256 * j); bv[j] = *(const LAS f32x4*)(bsh + lw + 256 * j); } v[r][j] = v[r][j] * rstd * gv[j] + bv[j]; }
            const unsigned row = (unsigned)(row0 + r);
            if (FINAL) {
                unsigned char* ob = (unsigned char*)F.out;
#pragma unroll
                for (int j = 0; j < 4; ++j) *(f32x4*)(ob + (size_t)(row * 4096u + lb4 + 1024u * j)) = v[r][j];
            } else {
                unsigned char* wsw = F.ws;
#pragma unroll
                for (int j = 0; j < 4; ++j) {
                    if (RES_BF16) { u32x2 xo; xo.x = cvt_pk_bf16_c(v[r][j][0], v[r][j][1]); xo.y = cvt_pk_bf16_c(v[r][j][2], v[r][j][3]); *(u32x2*)(wsw + (unsigned)(WS_XF + row * 2048u + lb2 + 512u * j)) = xo; }
                    else *(f32x4*)(wsw + (unsigned)(WS_XF + row * 4096u + lb4 + 1024u * j)) = v[r][j];
                    *(unsigned*)(wsw + (unsigned)(WS_XB8 + row * 1024u + lb1 + 256u * j)) = cvt4_fp8(v[r][j][0] * FP8_SX, v[r][j][1] * FP8_SX, v[r][j][2] * FP8_SX, v[r][j][3] * FP8_SX); }
            }
        }
        if (ROUTER) {
            { const int qn = LN_Q(qi + 1); if (qi + 1 < nq && qn < NT / 4) { LN_ISSUE(qn * 4); } }
            float val[64];
#pragma unroll
            for (int hf = 0; hf < 4; ++hf) {
                f32x2 a2[4][4];
#pragma unroll
                for (int r = 0; r < 4; ++r)
#pragma unroll
                    for (int e4 = 0; e4 < 4; ++e4) a2[r][e4] = f32x2{0.f, 0.f};
#pragma unroll
                for (int e4 = 0; e4 < 4; ++e4)
#pragma unroll
                    for (int j = 0; j < 4; ++j) { const f32x4 w = *(const LAS f32x4*)(wrT + (hf * 4 + e4) * WRS + lw + 256 * j);
                        const f32x2 wl = f32x2{w[0], w[1]}, wh = f32x2{w[2], w[3]};
#pragma unroll
                        for (int r = 0; r < 4; ++r) { a2[r][e4] = f32x2{v[r][j][0], v[r][j][1]} * wl + a2[r][e4]; a2[r][e4] = f32x2{v[r][j][2], v[r][j][3]} * wh + a2[r][e4]; } }
#pragma unroll
                for (int r = 0; r < 4; ++r)
#pragma unroll
                    for (int e4 = 0; e4 < 4; ++e4) val[r * 16 + hf * 4 + e4] = a2[r][e4][0] + a2[r][e4][1];
            }
#pragma unroll
            for (int sft = 5; sft >= 0; --sft) { const int n2 = 1 << sft; const bool up = (ln >> sft) & 1;
#pragma unroll
                for (int i = 0; i < n2; ++i) { const float lo = val[i], hi = val[i + n2]; const float mine = up ? hi : lo, other = up ? lo : hi; val[i] = mine + __shfl_xor(other, n2); } }
            const float lg = val[0], m = row_max(lg);
            const float ex = expf(lg - m); const float l = row_sum(ex);
            *(float*)(F.ws + (unsigned)(WS_AFF + ((size_t)(ln & 15) * NT + row0 + (ln >> 4)) * 4)) = ex / l;
        }
    }
#undef LN_Q
#undef LN_ISSUE
    if (ROUTER) __syncthreads();
}
__device__ __forceinline__ void softmax_phase(Frame& F, bf16_t* SB) {
    for (int row = F.c * 8 + F.wave; row < NT * 4; row += F.G * 8) {
        u32x2* p = (u32x2*)(SB + (size_t)row * 256) + F.lane; const u32x2 w = *p;
        float a = __uint_as_float(w.x << 16), b = __uint_as_float(w.x & 0xffff0000u), c = __uint_as_float(w.y << 16), d = __uint_as_float(w.y & 0xffff0000u);
        const float m = wave_max(fmaxf(fmaxf(a, b), fmaxf(c, d)));
        a = __expf(a - m); b = __expf(b - m); c = __expf(c - m); d = __expf(d - m);
        const float inv = 1.f / wave_sum((a + b) + (c + d));
        u32x2 o; o.x = cvt_pk_bf16(a * inv, b * inv); o.y = cvt_pk_bf16(c * inv, d * inv); *p = o;
    }
}
__device__ __forceinline__ void moe_panel(int P, int& e, int& grp, int& yerow0) {
    if (P < 256) { e = P >> 4; grp = 0; } else { e = (P - 256) >> 3; grp = 1; }
    yerow0 = P * 256;
}
#ifndef UPWGM
#define UPWGM 8
#endif
struct SchedUp { unsigned char* ws; int G, c;
    __device__ __forceinline__ bool next(int i, GUnit& u) const { int P, pn; if (!static_unit<UPWGM>(i, G, c, 384, 16, P, pn)) return false; int e, grp, y0; moe_panel(P, e, grp, y0);
        u.A = (const char*)ws + WS_XB8 + (grp ? (size_t)NTP * 1024 : 0); u.B = (const char*)ws + WS_EW13 + ((size_t)e * 4096 + pn * BM) * 1024;
        u.C = (char*)ws + PO_HM + ((size_t)P * BM * 2048 + pn * HALF); u.X = (const int*)(ws + WS_IDX) + y0; u.pm = P; u.pn = pn; return true; } };
struct SchedDown { unsigned char* ws; int G, c;
    __device__ __forceinline__ bool next(int i, GUnit& u) const { int P, pn; if (!static_unit(i, G, c, 384, 4, P, pn)) return false; int e, grp, y0; moe_panel(P, e, grp, y0);
        u.A = (const char*)ws + PO_HM + (size_t)P * BM * 2048; u.B = (const char*)ws + WS_EW2 + ((size_t)e * 1024 + pn * BM) * 2048;
        u.C = (char*)ws + PO_YE + ((size_t)y0 * 1024 + pn * BM) * 2; u.X = (const float*)(ws + WS_GATE) + y0; u.pm = P; u.pn = pn; return true; } };
struct SchedQKV { unsigned char* ws; int G, c;
    __device__ __forceinline__ bool next(int i, GUnit& u) const { const int L = i * G + c; if (L >= 1536 + 768) return false;
        if (L < 1536) { int pm, pn; static_unit(i, G, c, 192, 8, pm, pn);
            u.A = (const char*)ws + WS_XB8 + (size_t)pm * BM * 1024; u.B = (const char*)ws + WS_WQKV + (size_t)pn * BM * 1024;
            u.C = (char*)ws + (pn < 4 ? PO_Q : PO_K) + ((size_t)pm * BM * 1024 + (pn & 3) * BM) * 2; u.X = nullptr; u.pm = pm; u.pn = pn; return true; }
        const int r = L - 1536, pmv = r & 3, pnv = r >> 2;
        u.A = (const char*)ws + WS_WQKV + (size_t)(2048 + pmv * BM) * 1024; u.B = (const char*)ws + WS_XB8 + (size_t)pnv * BM * 1024;
        u.C = (char*)ws + PO_VT + ((size_t)pmv * BM * NT + (size_t)pnv * BM) * 2; u.X = nullptr; u.pm = pmv; u.pn = 8 + pnv; return true; } };
struct EpiQKV {
    static constexpr bool PERM = true;
    __device__ __forceinline__ void operator()(const Acc& acc, const GUnit& u, int wr, int wc, int fr, int fq) const {
        constexpr float ds = 1.f / (FP8_SX * FP8_SWQKV);
        if (u.pn >= 8) { EpiBf<false> e{(unsigned)NT, ds}; e(acc, u, wr, wc, fr, fq); }
        else { EpiBf<false> e{1024u, u.pn < 4 ? 0.125f * 1.4426950408889634f * ds : ds}; e(acc, u, wr, wc, fr, fq); }
    }
};

__device__ __forceinline__ int wave_sum_i(int v) {
#pragma unroll
    for (int o = 1; o < 64; o <<= 1) v += __shfl_xor(v, o);
    return v;
}
__device__ __forceinline__ int block_excl_scan(int v, int lane, int wave, LAS int* red, int& total) {
    int inc = v;
#pragma unroll
    for (int o = 1; o < 64; o <<= 1) { const int t = __shfl_up(inc, o); if (lane >= o) inc += t; }
    __syncthreads();
    if (lane == 63) red[wave] = inc;
    __syncthreads();
    int off = 0, tot = 0;
#pragma unroll
    for (int w = 0; w < 8; ++w) { const int c = red[w]; if (w < wave) off += c; tot += c; }
    total = tot; return off + inc - v;
}
template <int PER>
__device__ __forceinline__ void select_fast(Frame& F, const float* affcol, int cap, int* idx_out, float* gate_out, int* slotcol) {
    LAS int* red = (LAS int*)F.lds;
    unsigned key[PER];
#pragma unroll
    for (int i = 0; i < PER / 4; ++i) { const u32x4 v = ((const u32x4*)(affcol + (size_t)F.tid * PER))[i]; key[4 * i] = v.x; key[4 * i + 1] = v.y; key[4 * i + 2] = v.z; key[4 * i + 3] = v.w; }
    unsigned T = 0u;
    for (int b = 30; b >= 0; --b) {
        const unsigned cand = T | (1u << b); int cnt = 0;
#pragma unroll
        for (int i = 0; i < PER; ++i) cnt += (key[i] >= cand) ? 1 : 0;
        cnt = wave_sum_i(cnt);
        LAS int* r = red + (b & 1) * 8;
        if (F.lane == 0) r[F.wave] = cnt;
        __syncthreads();
        int tot = 0;
#pragma unroll
        for (int w = 0; w < 8; ++w) tot += r[w];
        if (tot >= cap) T = cand;
    }
    int g = 0, q = 0;
#pragma unroll
    for (int i = 0; i < PER; ++i) { g += (key[i] > T) ? 1 : 0; q += (key[i] == T) ? 1 : 0; }
    int tot_g, tot_q; (void)tot_q;
    const int Eoff = block_excl_scan(q, F.lane, F.wave, red + 32, tot_q);
    int dummy; const int Goff = block_excl_scan(g, F.lane, F.wave, red + 32, tot_g); (void)Goff;
    const int need_eq = cap - tot_g;
    int eq_take = need_eq - Eoff; eq_take = eq_take < 0 ? 0 : (eq_take > q ? q : eq_take);
    const int base = block_excl_scan(g + eq_take, F.lane, F.wave, red + 32, dummy);
    int slot = base, eqseen = 0;
    const int tok0 = F.tid * PER;
#pragma unroll
    for (int i4 = 0; i4 < PER / 4; ++i4) { int so[4];
#pragma unroll
        for (int j = 0; j < 4; ++j) { const int i = 4 * i4 + j; const unsigned k = key[i]; bool sel = k > T; if (k == T) { sel = eqseen < eq_take; ++eqseen; }
            so[j] = sel ? slot : -1; if (sel) { idx_out[slot] = tok0 + i; gate_out[slot] = __uint_as_float(k); ++slot; } }
        ((int4*)(slotcol + tok0))[i4] = make_int4(so[0], so[1], so[2], so[3]); }
}
__device__ __forceinline__ void select_phase(Frame& F) {
    for (int it = F.c; it < 32; it += F.G) {
        const int grp = it >> 4, e = it & 15; const int n = grp ? NTS : NTP, cap = n / 8;
        const float* affcol = (const float*)(F.ws + WS_AFF) + (size_t)e * NT + (grp ? NTP : 0);
        int* idx = (int*)(F.ws + WS_IDX) + (grp ? 65536 : 0) + e * cap; float* gate = (float*)(F.ws + WS_GATE) + (grp ? 65536 : 0) + e * cap;
        int* slotcol = (int*)(F.ws + WS_SLOT) + (size_t)e * NT + (grp ? NTP : 0);
        __syncthreads();
        if (grp == 0) select_fast<64>(F, affcol, cap, idx, gate, slotcol); else select_fast<32>(F, affcol, cap, idx, gate, slotcol);
        __syncthreads();
    }
}

__device__ __forceinline__ void natten_fill(Frame& F, const float* rpb) {
    LAS float* rpbs = (LAS float*)F.lds;
    __syncthreads();
    for (int i = F.tid; i < 16 * 15 * 31; i += 512) rpbs[i] = rpb[i] * 1.4426950408889634f;
    __syncthreads();
}
__device__ __forceinline__ void natten_phase(Frame& F, const float* rpb) {
    const bf16_t* Kb = (const bf16_t*)(F.ws + PO_K); const bf16_t* VT = (const bf16_t*)(F.ws + PO_VT); bf16_t* QO = (bf16_t*)(F.ws + PO_Q);
    LAS float* rpbs = (LAS float*)F.lds;
    const int lane = F.lane, w = F.wave, fr = lane & 15, fq = lane >> 4;
    bool c0[4], c2[4]; int xe[4];
#pragma unroll
    for (int e = 0; e < 4; ++e) { xe[e] = 4 * fq + e - fr; c0[e] = xe[e] >= 8; c2[e] = xe[e] < -8; }
    const bool fA = fr < 8, fC = fr > 8;
    LAS bf16_t* Ks = (LAS bf16_t*)(F.lds + 32768); LAS bf16_t* Vs = Ks + 2 * 64 * 72;
    const int lrow = F.tid >> 3, lchk = F.tid & 7;
    for (int blk = F.c; blk < 1536; blk += F.G) {
        int gb, h, rb, rows;
        if (blk < 1024) { gb = blk >> 8; h = (blk >> 4) & 15; rb = blk & 15; rows = 128; } else { const int V = blk - 1024; gb = 4 + (V >> 7); h = (V >> 3) & 15; rb = V & 7; rows = 64; }
        const int r = rb * 8 + w;
        int rs = r - 4; rs = rs < 0 ? 0 : (rs > rows - 8 ? rows - 8 : rs);
        int kr_lo = rb * 8 - 4; kr_lo = kr_lo < 0 ? 0 : (kr_lo > rows - 8 ? rows - 8 : kr_lo);
        int kr_hi = rb * 8 + 7 - 4; kr_hi = (kr_hi < 0 ? 0 : (kr_hi > rows - 8 ? rows - 8 : kr_hi)) + 8;
        const size_t tb = (size_t)gb_tok0(gb), tq0 = tb + (size_t)r * 64;
        bf16x8 Qf[4][2];
        float mrun[4], lrun[4]; f32x4 Ot[4][4];
#pragma unroll
        for (int qt = 0; qt < 4; ++qt) { mrun[qt] = -INFINITY; lrun[qt] = 0.f;
#pragma unroll
            for (int dt = 0; dt < 4; ++dt) Ot[dt][qt] = (f32x4){0.f, 0.f, 0.f, 0.f}; }
        const bf16_t* kg = Kb + (tb + (size_t)kr_lo * 64 + lrow) * D + h * 64 + lchk * 8; const bf16_t* vg = VT + (size_t)(h * 64 + lrow) * NT + tb + (size_t)kr_lo * 64 + lchk * 8;
        const int nrows = kr_hi - kr_lo;
#define NA_LOAD(dst, ptr) asm volatile("global_load_dwordx4 %0, %1, off" : "=&v"(dst) : "v"(ptr) : "memory")
        u32x4 kA, vA, kB, vB;
        { const u32x4 k0r = *(const u32x4*)kg, v0r = *(const u32x4*)vg;
#pragma unroll
          for (int t = 0; t < 4; ++t)
#pragma unroll
              for (int ks = 0; ks < 2; ++ks) Qf[t][ks] = *(const bf16x8*)(QO + (tq0 + 16 * t + fr) * D + h * 64 + 32 * ks + 8 * fq);
          { const bf16_t* kp = kg + (size_t)64 * D; const bf16_t* vp = vg + 64; NA_LOAD(kB, kp); NA_LOAD(vB, vp); }
          __syncthreads();
          *(LAS u32x4*)(Ks + lrow * 72 + lchk * 8) = k0r; *(LAS u32x4*)(Vs + lrow * 72 + lchk * 8) = v0r; }
#pragma unroll
        for (int t = 0; t < 4; ++t)
#pragma unroll
            for (int ks = 0; ks < 2; ++ks) asm volatile("" :: "v"(Qf[t][ks]));
        asm volatile("s_waitcnt vmcnt(0)" ::: "memory");
        __syncthreads();
#pragma nounroll
        for (int i2 = 0; i2 < nrows; i2 += 2) {
#pragma unroll
          for (int jj = 0; jj < 2; ++jj) {
            const int i = i2 + jj; if (i >= nrows) break;
            const int kr = kr_lo + i; const int buf = jj; const bool more = i + 1 < nrows, more2 = i + 2 < nrows;
            if (more2) { const bf16_t* kp = kg + (size_t)(i + 2) * 64 * D; const bf16_t* vp = vg + (size_t)(i + 2) * 64;
                if (jj == 1) { NA_LOAD(kB, kp); NA_LOAD(vB, vp); } else { NA_LOAD(kA, kp); NA_LOAD(vA, vp); } }
            if (kr >= rs && kr < rs + 8) {
            const int dr = kr - r + 7;
            const LAS bf16_t* Kt = Ks + buf * (64 * 72); const LAS bf16_t* Vt = Vs + buf * (64 * 72);
            bf16x8 Kf[4][2];
#pragma unroll
            for (int t = 0; t < 4; ++t)
#pragma unroll
                for (int ks = 0; ks < 2; ++ks) Kf[t][ks] = *(const LAS bf16x8*)(Kt + (16 * t + fr) * 72 + 32 * ks + 8 * fq);
            float bsel[3][4];
#pragma unroll
            for (int e = 0; e < 4; ++e) { const int dcB = xe[e] + 15 + (c0[e] ? -16 : (c2[e] ? 16 : 0)), dcA = fA ? xe[e] + 15 : dcB, dcC = fC ? xe[e] + 15 : dcB;
                bsel[0][e] = rpbs[(h * 15 + dr) * 31 + dcA]; bsel[1][e] = rpbs[(h * 15 + dr) * 31 + dcB]; bsel[2][e] = rpbs[(h * 15 + dr) * 31 + dcC]; }
            bf16x8 Pf[4][2]; float alpha[4]; bool moved = false;
#pragma unroll
            for (int qt = 0; qt < 4; ++qt) {
                f32x4 St[3];
#pragma unroll
                for (int dk = 0; dk < 3; ++dk) { const int kt = qt + dk - 1; St[dk] = (f32x4){0.f, 0.f, 0.f, 0.f};
                    if (kt >= 0 && kt < 4) { St[dk] = __builtin_amdgcn_mfma_f32_16x16x32_bf16(Kf[kt][0], Qf[qt][0], St[dk], 0, 0, 0); St[dk] = __builtin_amdgcn_mfma_f32_16x16x32_bf16(Kf[kt][1], Qf[qt][1], St[dk], 0, 0, 0); } }
                constexpr int dummy = 0; (void)dummy;
                const int cls = qt == 0 ? 0 : (qt == 3 ? 2 : 1);
                float sv[4]; bool u0[4], u2[4]; float mx = -INFINITY;
#pragma unroll
                for (int e = 0; e < 4; ++e) { u0[e] = c0[e] && !(cls == 0 && fA) && !(cls == 2 && fC) && (qt > 0); u2[e] = c2[e] && !(cls == 0 && fA) && !(cls == 2 && fC) && (qt < 3);
                    sv[e] = (u0[e] ? St[0][e] : (u2[e] ? St[2][e] : St[1][e])) + bsel[cls][e]; mx = fmaxf(mx, sv[e]); }
                mx = x32_max(x16_max(mx));
                const float mnew = fmaxf(mrun[qt], mx); alpha[qt] = __builtin_amdgcn_exp2f(mrun[qt] - mnew); moved = moved || (mnew != mrun[qt]); mrun[qt] = mnew;
                float l = 0.f, p[4];
#pragma unroll
                for (int e = 0; e < 4; ++e) { p[e] = __builtin_amdgcn_exp2f(sv[e] - mnew); l += p[e]; }
                l = x32_sum(x16_sum(l)); lrun[qt] = lrun[qt] * alpha[qt] + l;
                float pv[4][4];
#pragma unroll
                for (int kt = 0; kt < 4; ++kt)
#pragma unroll
                    for (int e = 0; e < 4; ++e) { const int dk = kt - qt + 1; float v = 0.f; if (dk == 0) v = u0[e] ? p[e] : 0.f; else if (dk == 2) v = u2[e] ? p[e] : 0.f; else if (dk == 1) v = (u0[e] || u2[e]) ? 0.f : p[e]; pv[kt][e] = v; }
#pragma unroll
                for (int ks = 0; ks < 2; ++ks) { u32x4 wv; wv.x = cvt_pk_bf16_c(pv[2 * ks][0], pv[2 * ks][1]); wv.y = cvt_pk_bf16_c(pv[2 * ks][2], pv[2 * ks][3]); wv.z = cvt_pk_bf16_c(pv[2 * ks + 1][0], pv[2 * ks + 1][1]); wv.w = cvt_pk_bf16_c(pv[2 * ks + 1][2], pv[2 * ks + 1][3]);
                    Pf[qt][ks] = __builtin_bit_cast(bf16x8, wv); }
            }
            const bool rescale = __ballot(moved) != 0ull;
#pragma unroll
            for (int dt = 0; dt < 4; ++dt) {
                if (rescale) {
#pragma unroll
                    for (int qt = 0; qt < 4; ++qt) Ot[dt][qt] = Ot[dt][qt] * alpha[qt]; }
#pragma unroll
                for (int ks = 0; ks < 2; ++ks) { const u32x2 v0 = *(const LAS u32x2*)(Vt + (16 * dt + fr) * 72 + 32 * ks + 4 * fq), v1 = *(const LAS u32x2*)(Vt + (16 * dt + fr) * 72 + 32 * ks + 16 + 4 * fq);
                    u32x4 vv; vv.x = v0.x; vv.y = v0.y; vv.z = v1.x; vv.w = v1.y; const bf16x8 Vf = __builtin_bit_cast(bf16x8, vv);
#pragma unroll
                    for (int qt = 0; qt < 4; ++qt) { if ((qt == 0 && ks == 1) || (qt == 3 && ks == 0)) continue; Ot[dt][qt] = __builtin_amdgcn_mfma_f32_16x16x32_bf16(Vf, Pf[qt][ks], Ot[dt][qt], 0, 0, 0); } }
            }
            }
            if (more) {
                if (more2) asm volatile("s_waitcnt vmcnt(2)" ::: "memory"); else asm volatile("s_waitcnt vmcnt(0)" ::: "memory");
                LAS bf16_t* kd = Ks + (buf ^ 1) * (64 * 72) + lrow * 72 + lchk * 8; LAS bf16_t* vd = Vs + (buf ^ 1) * (64 * 72) + lrow * 72 + lchk * 8;
                if (jj == 1) { asm volatile("" : "+v"(kA), "+v"(vA)); *(LAS u32x4*)kd = kA; *(LAS u32x4*)vd = vA; } else { asm volatile("" : "+v"(kB), "+v"(vB)); *(LAS u32x4*)kd = kB; *(LAS u32x4*)vd = vB; }
            }
            __syncthreads();
          }
        }
#undef NA_LOAD
#pragma unroll
        for (int qt = 0; qt < 4; ++qt) { const float inv = 1.f / lrun[qt];
#pragma unroll
            for (int dt = 0; dt < 4; ++dt) { const f32x4 o = Ot[dt][qt] * inv; u32x2 wv; wv.x = cvt_pk_bf16_c(o[0], o[1]); wv.y = cvt_pk_bf16_c(o[2], o[3]);
                pst8(QO + (tq0 + 16 * qt + fr) * D + h * 64 + 16 * dt + 4 * fq, wv); } }
    }
    __syncthreads();
}
constexpr int N_PHASES = 31;
constexpr int FLAG_NO_XIMPORT = 1, FLAG_NO_EXPERTS0 = 2;
constexpr int CV_P1 = 3072, CV_P2 = CV_P1 + 1536, CV_SEL = CV_P2 + 5376, CV_SEL1 = 5376;
__global__ void __launch_bounds__(512, 2) fwd(Args args) {
    extern __shared__ __attribute__((aligned(16))) unsigned char lds_raw[];
    Frame F; F.lds = (LAS unsigned char*)lds_raw; F.ws = args.ws; F.in = args.in; F.out = args.out;
    F.tid = threadIdx.x; F.lane = F.tid & 63; F.wave = __builtin_amdgcn_readfirstlane(F.tid >> 6); F.G = gridDim.x; F.c = blockIdx.x; F.xok = false;
    unsigned char* ws = args.ws;
    const int wave_s = __builtin_amdgcn_readfirstlane(threadIdx.x >> 6);
    for (int u = F.tid; u < (LDS_BYTES - RING_BYTES) / 4; u += 512) ((LAS unsigned*)(F.lds + RING_BYTES))[u] = 0u;
    __syncthreads();
    const int lo = args.ph_lo, hi = args.ph_hi;
    volatile LAS unsigned* MISC = (volatile LAS unsigned*)(F.lds + MISC_OFF);
    XcdBarrier bar; bar.bar = (unsigned*)(ws + WS_CTL) + CW_BAR + args.pad * XCD_BAR_WORDS_EXT; bar.x = 0; bar.st = nullptr;
    const bool multi = (hi - lo) > 1;
    if (multi) bar = xcd_barrier_post((unsigned*)(ws + WS_CTL) + CW_BAR + args.pad * XCD_BAR_WORDS_EXT, MISC + 8);
#define IN(k) (lo <= (k) && (k) < hi)
#ifdef STAMP_PA
    unsigned long long* TS = (unsigned long long*)(ws + WS_CTL + 40 * 1024);
#define STAMP(k) do { if (blockIdx.x == 0 && threadIdx.x == 0) TS[k] = __builtin_amdgcn_s_memrealtime(); } while (0)
#else
#define STAMP(k) do { } while (0)
#endif
#ifdef AMP_PHASE
    unsigned long long t_phase0 = 0ull;
#define AMP_NOW(t) asm volatile("s_memrealtime %0\n\ts_waitcnt lgkmcnt(0)" : "=s"(t) :: "memory")
#define AMP_T0() do { AMP_NOW(t_phase0); } while (0)
#define AMP_WAIT(k) do { if ((k) == AMP_PHASE || AMP_PHASE < 0) { asm volatile("s_waitcnt vmcnt(0) lgkmcnt(0)" ::: "memory"); unsigned long long _t1; AMP_NOW(_t1); const unsigned long long _tw = _t1 + (unsigned long long)AMP_M * (_t1 - t_phase0); unsigned long long _tn; do { __builtin_amdgcn_s_sleep(4); AMP_NOW(_tn); } while (_tn < _tw); } } while (0)
#else
#define AMP_T0() do { } while (0)
#define AMP_WAIT(k) do { } while (0)
#endif
#define SEAM(k) do { AMP_WAIT(k); if (IN(k) && IN((k) + 1)) { xcd_barrier(bar, wave_s); STAMP((k) + 1); } } while (0)
    STAMP(0);
    LAS unsigned char* ring = F.lds;
#define PHASE_BEGIN() do { int _t; asm volatile("v_mbcnt_lo_u32_b32 %0, -1, 0\n\tv_mbcnt_hi_u32_b32 %0, -1, %0" : "=v"(_t)); _t |= (wave_s << 6); F.tid = _t; F.lane = _t & 63; F.wave = wave_s; AMP_T0(); } while (0)

    if (IN(0)) { PHASE_BEGIN();
        for (int it = F.c; it < 128; it += F.G) s5_build_item(F, it >> 1, it & 1);
        convert_small_weights(F);
        if (!(args.flags & FLAG_NO_EXPERTS0)) convert_expert_weights(F, 0, CV_SEL, 16 * 1536, 0);
        convert_plain(F, args.in[I_MWQ], (bf16_t*)(ws + WS_MWQ), (size_t)2 * 1024 * 1024);
        convert_plain(F, args.in[I_MEMP], (bf16_t*)(ws + WS_MEMB), (size_t)4 * 256 * 1024);
        convert_plain(F, args.in[I_MEMS], (bf16_t*)(ws + WS_MEMB) + (size_t)4 * 256 * 1024, (size_t)4 * 256 * 1024);
        import_x(F, !(args.flags & FLAG_NO_XIMPORT));
    }
    SEAM(0);
    unsigned nloc_s = 32u;
    if (multi && IN(0) && IN(1)) {
        if (F.tid == 0) { unsigned ok = (F.G == 256) ? 1u : 0u; unsigned* bw = bar.bar;
            for (unsigned j = 0; j < 16; ++j) { const unsigned cnt = xb_ld(&bw[XB_XCNT(j)]); if (j < 8 ? cnt != 32u : cnt != 0u) ok = 0u; }
            MISC[13] = ok; }
        __syncthreads();
        if (MISC[13]) { F.xok = true; F.c = (int)(MISC[12] * 8u + bar.x); }
    }
#define LSEAM(k) do { AMP_WAIT(k); if (IN(k) && IN((k) + 1)) { if (F.xok) xcd_local_barrier(bar, wave_s, nloc_s); else xcd_barrier(bar, wave_s); STAMP((k) + 1); } } while (0)
    {
        const float* lng = args.in[I_LNG]; const float* lnb = args.in[I_LNB];
        if (IN(1)) { PHASE_BEGIN();
            { SchedKV S{ws, F.G, F.c}; EpiBf<false> E{2048u, 1.f}; gemm_phase<EpiBf<false>, SchedKV, false>(ring, F.tid, 1024, 2048u, 2048u, S, E); }
            { SchedUA S{(const char*)ws + WS_XB, (const char*)ws + WS_WIN, (char*)ws + PO_UA, F.G, F.c}; EpiUA E; gemm_phase<EpiUA, SchedUA, false>(ring, F.tid, 1024, 2048u, 2048u, S, E); }
            if (!(args.flags & FLAG_NO_EXPERTS0)) convert_expert_weights(F, 0, 0, CV_P1, 128);
        }
        SEAM(1);
        if (IN(2)) { PHASE_BEGIN();
            { SchedSA S{ws, F.G, F.c}; EpiS E; gemm_phase<EpiS, SchedSA, false>(ring, F.tid, 512, (unsigned)(UAK * 2), 1024u, S, E); }
            { SchedWqk S{ws, F.G, F.c}; EpiBf8 E{1024u, 0.0625f * 1.4426950408889634f * FP8_SWQK}; gemm_phase<EpiBf8, SchedWqk, false>(ring, F.tid, 256, 4096u, 2048u, S, E); }
            { SchedWvo S{ws, F.G, F.c}; EpiBf<false> E{1024u, 1.f}; gemm_phase<EpiBf<false>, SchedWvo, false>(ring, F.tid, 256, 2048u, 4096u, S, E); }
            if (!(args.flags & FLAG_NO_EXPERTS0)) convert_expert_weights(F, 0, CV_P1, CV_P2, 128);
        }
        SEAM(2);
        if (IN(3)) { PHASE_BEGIN(); s5_recurrence(F); }
        SEAM(3);
        if (IN(4)) { PHASE_BEGIN(); SchedSC S{ws, F.G, F.c}; EpiGelu E; gemm_phase<EpiGelu, SchedSC, false>(ring, F.tid, UAK, (unsigned)(UAK * 2), (unsigned)(UAK * 2), S, E); }
        SEAM(4);
        if (IN(5)) { PHASE_BEGIN(); SchedGated S{(const char*)ws + PO_SG, (const char*)ws + WS_WGLU, (char*)ws + PO_HB_S5, 2048, 2048, 1024, NT / BM, 8, F.G, F.c}; EpiGated<0> E{1024u};
            gemm_phase<EpiGated<0>, SchedGated, false>(ring, F.tid, 1024, 2048u, 2048u, S, E); }
        LSEAM(5);
        if (IN(6)) { PHASE_BEGIN(); if (args.flags & FLAG_NO_XIMPORT) ln_phase<0, false, false, false>(F, (const bf16_t*)(ws + PO_HB_S5), lng, lnb, nullptr); else ln_phase<0, false, false, true>(F, (const bf16_t*)(ws + PO_HB_S5), lng, lnb, nullptr); }
        LSEAM(6);
    }
#define COMMON_BLOCK(layer, pb) do { \
        const float* lng = args.in[I_LNG] + (size_t)(layer) * 3 * D; const float* lnb = args.in[I_LNB] + (size_t)(layer) * 3 * D; \
        if (IN((pb) + 0)) { PHASE_BEGIN(); SchedScores8 S{(const char*)ws + WS_XB8, (const char*)ws + WS_WQK + (size_t)(layer) * 8 * MiB, (char*)ws + PO_SB, F.G, F.c}; EpiSoftmax E{(LAS float*)(F.lds + RING_BYTES + 4096), 1024u, 1.f / (FP8_SX * FP8_SWQK)}; \
            gemm_phase<EpiSoftmax, SchedScores8, false, true>(ring, F.tid, 512, 1024u, 1024u, S, E); } \
        AMP_WAIT((pb) + 0); if (IN((pb) + 0) && IN((pb) + 2)) { if (F.xok) xcd_local_barrier(bar, wave_s, nloc_s); else xcd_barrier(bar, wave_s); STAMP((pb) + 1); }     \
        if (IN((pb) + 2)) { PHASE_BEGIN(); SchedBatchW S{(const char*)ws + PO_SB, (const char*)ws + WS_WVO + (size_t)(layer) * 16 * MiB, (char*)ws + PO_HB_MEM, F.G, F.c}; EpiBf<false> E{1024u, 1.f}; \
            gemm_phase<EpiBf<false>, SchedBatchW, false>(ring, F.tid, 1024, 2048u, 2048u, S, E); } \
        if (IN((pb) + 3)) { PHASE_BEGIN(); ln_router_fill(F, lng + D, lnb + D, args.in[I_EWR] + (size_t)(layer) * D * 16); }     \
        LSEAM((pb) + 2); \
        if (IN((pb) + 3)) { PHASE_BEGIN(); ln_phase<0, true, false>(F, (const bf16_t*)(ws + PO_HB_MEM), lng + D, lnb + D, args.in[I_EWR] + (size_t)(layer) * D * 16); } \
        SEAM((pb) + 3); \
        if (IN((pb) + 4)) { PHASE_BEGIN(); select_phase(F); if ((layer) == 0) { if (!(args.flags & FLAG_NO_EXPERTS0)) convert_expert_weights(F, 0, CV_P2, CV_SEL, 32); } else convert_expert_weights(F, 1, 0, CV_SEL1, 32); } \
        SEAM((pb) + 4); \
        if (IN((pb) + 5)) { PHASE_BEGIN(); SchedUp S{ws, F.G, F.c}; EpiGated8 E{2048u}; gemm_phase<EpiGated8, SchedUp, true, true>(ring, F.tid, 512, 1024u, 1024u, S, E); } \
        SEAM((pb) + 5); \
        if (IN((pb) + 6)) { PHASE_BEGIN(); SchedDown S{ws, F.G, F.c}; EpiBf<true> E{1024u, 1.f / (FP8_SH * FP8_SW2)}; gemm_phase<EpiBf<true>, SchedDown, false, true>(ring, F.tid, 1024, 2048u, 2048u, S, E); } \
        AMP_WAIT((pb) + 6); if (IN((pb) + 6) && IN((pb) + 9)) { xcd_barrier(bar, wave_s); STAMP((pb) + 9); }     \
    } while (0)
    COMMON_BLOCK(0, 7);
    if (IN(16)) { PHASE_BEGIN(); ln_phase<1, false, false>(F, nullptr, args.in[I_LNG] + 2 * D, args.in[I_LNB] + 2 * D, nullptr); convert_expert_weights(F, 1, CV_SEL1, 16 * 1536, 0); }
    SEAM(16);
    {
        const float* lng = args.in[I_LNG] + 3 * D; const float* lnb = args.in[I_LNB] + 3 * D;
        if (IN(17)) { PHASE_BEGIN(); SchedQKV S{ws, F.G, F.c}; EpiQKV E; gemm_phase<EpiQKV, SchedQKV, false, true>(ring, F.tid, 512, 1024u, 1024u, S, E); }
        if (IN(18)) { PHASE_BEGIN(); natten_fill(F, args.in[I_BRPB]); }
        SEAM(17);
        if (IN(18)) { PHASE_BEGIN(); natten_phase(F, args.in[I_BRPB]); }
        SEAM(18);
        if (IN(19)) { PHASE_BEGIN(); SchedPlain S{(const char*)ws + PO_Q, (const char*)ws + WS_WO, (char*)ws + PO_HB_NA, 2048, 2048, 1024, NT / BM, 4, F.G, F.c}; EpiBf<false> E{1024u, 1.f};
            gemm_phase<EpiBf<false>, SchedPlain, false>(ring, F.tid, 1024, 2048u, 2048u, S, E); }
        LSEAM(19);
        if (IN(20)) { PHASE_BEGIN(); ln_phase<0, false, false>(F, (const bf16_t*)(ws + PO_HB_NA), lng, lnb, nullptr); }
        LSEAM(20);
    }
    COMMON_BLOCK(1, 21);
    if (IN(30)) { PHASE_BEGIN(); ln_phase<1, false, true>(F, nullptr, args.in[I_LNG] + 5 * D, args.in[I_LNB] + 5 * D, nullptr); }
    AMP_WAIT(30);
#undef COMMON_BLOCK
#ifdef STAMP_PA
    xcd_barrier(bar, wave_s); STAMP(31); xcd_barrier(bar, wave_s);
    {
        const volatile unsigned long long* T = TS; const float dA = (float)(T[STAMP_PA + STAMP_NA] - T[STAMP_PA]) * 0.01f, dB = (float)(T[STAMP_PB + STAMP_NB] - T[STAMP_PB]) * 0.01f;
        const float c = sqrtf(100.f * dA), V = 100.f * dB; const size_t np = (size_t)NTP * 1024, n = (size_t)NT * 1024;
        for (size_t i = (size_t)blockIdx.x * 512 + threadIdx.x; i < n; i += (size_t)gridDim.x * 512) args.out[i] = i < np ? c : (i == np ? V : 0.f);
    }
#endif
#undef IN
#undef SEAM
}
}
#ifndef DBG
#define DBG 0
#endif
#ifndef FZ_PER_PHASE
#define FZ_PER_PHASE 0
#endif

#if DBG
namespace dbg {
__global__ void k_cmp_bf16_f32(const unsigned short* a, const float* b, size_t n, double* acc) {
    double s0 = 0, s1 = 0;
    for (size_t i = (size_t)blockIdx.x * blockDim.x + threadIdx.x; i < n; i += (size_t)gridDim.x * blockDim.x) { const double x = (double)__uint_as_float(((unsigned)a[i]) << 16), y = b[i]; s0 += (x - y) * (x - y); s1 += y * y; }
    for (int o = 32; o >= 1; o >>= 1) { s0 += __shfl_xor(s0, o); s1 += __shfl_xor(s1, o); }
    if ((threadIdx.x & 63) == 0) { atomicAdd(acc, s0); atomicAdd(acc + 1, s1); }
}
__global__ void k_cmp_f32_f32(const float* a, const float* b, size_t n, double* acc) {
    double s0 = 0, s1 = 0;
    for (size_t i = (size_t)blockIdx.x * blockDim.x + threadIdx.x; i < n; i += (size_t)gridDim.x * blockDim.x) { const double x = a[i], y = b[i]; s0 += (x - y) * (x - y); s1 += y * y; }
    for (int o = 32; o >= 1; o >>= 1) { s0 += __shfl_xor(s0, o); s1 += __shfl_xor(s1, o); }
    if ((threadIdx.x & 63) == 0) { atomicAdd(acc, s0); atomicAdd(acc + 1, s1); }
}
__global__ void k_cmp_ua(const unsigned short* UA, const float* u, double* acc) {
    double s0 = 0, s1 = 0;
    for (size_t i = (size_t)blockIdx.x * blockDim.x + threadIdx.x; i < (size_t)fz::NT * 1024; i += (size_t)gridDim.x * blockDim.x) {
        const int tok = (int)(i >> 10), ch = (int)(i & 1023), chunk = tok >> 5, j = tok & 31, g = ch >> 4, h = ch & 15;
        const double x = (double)__uint_as_float(((unsigned)UA[((size_t)g * fz::NCHUNK + chunk) * fz::UAK + j * 16 + h]) << 16), y = u[i]; s0 += (x - y) * (x - y); s1 += y * y; }
    for (int o = 32; o >= 1; o >>= 1) { s0 += __shfl_xor(s0, o); s1 += __shfl_xor(s1, o); }
    if ((threadIdx.x & 63) == 0) { atomicAdd(acc, s0); atomicAdd(acc + 1, s1); }
}
__global__ void k_encode(float* out, const double* accA, const double* accB) {
    const double vA = accA[1] > 0 ? sqrt(accA[0] / accA[1]) : 9.99; const double vB = accB[1] > 0 ? sqrt(accB[0] / accB[1]) : 9.99;
    const float c = (float)sqrt(1e8 * (vA == vA ? vA : 7.77)); const float V = (float)(1e5 * (vB == vB ? vB : 7.77));
    const size_t np = (size_t)fz::NTP * 1024, n = (size_t)fz::NT * 1024;
    for (size_t i = (size_t)blockIdx.x * blockDim.x + threadIdx.x; i < n; i += (size_t)gridDim.x * blockDim.x) out[i] = i < np ? c : (i == np ? V : 0.f);
}
}
#endif

extern "C" void kernel_launch(void* const* d_in, const int* in_sizes, int n_in, void* d_out, int out_size, void* d_ws, size_t ws_size, hipStream_t stream) {
    using namespace fz;
    static int grid = 0;
    if (grid == 0) {
        if (n_in != 26 || ws_size < WS_END) { fprintf(stderr, "kernel_launch: unexpected inputs (n_in %d, ws %zu)\n", n_in, ws_size); grid = -1; return; }
        int dev = 0, cus = 0, per_cu = 0;
        if (hipGetDevice(&dev) != hipSuccess || hipDeviceGetAttribute(&cus, hipDeviceAttributeMultiprocessorCount, dev) != hipSuccess) { grid = -1; return; }
        if (hipFuncSetAttribute((const void*)fwd, hipFuncAttributeMaxDynamicSharedMemorySize, LDS_BYTES) != hipSuccess) { fprintf(stderr, "kernel_launch: hipFuncSetAttribute failed\n"); grid = -1; return; }
        if (hipOccupancyMaxActiveBlocksPerMultiprocessor(&per_cu, (const void*)fwd, 512, LDS_BYTES) != hipSuccess || per_cu < 1) { fprintf(stderr, "kernel_launch: occupancy query says %d\n", per_cu); }
        (void)hipGetLastError();
        grid = cus;
    }
    if (grid < 0) return;
    unsigned char* ws = (unsigned char*)d_ws;
    (void)hipMemsetAsync(ws + WS_CTL, 0, CTL_ZERO_BYTES, stream);
    Args a{};
    for (int i = 0; i < 26; ++i) a.in[i] = (const float*)d_in[i];
    a.out = (float*)d_out; a.ws = ws; a.flags = 0; a.pad = 0;
    auto run = [&](int lo, int hi) { a.ph_lo = lo; a.ph_hi = hi; hipLaunchKernelGGL(fwd, dim3(grid), dim3(512), LDS_BYTES, stream, a); };
#if DBG == 0
#ifdef PRE_LO
    a.pad = 1; run(PRE_LO, PRE_HI); a.pad = 0;
#endif
#if FZ_PER_PHASE
    for (int p = 0; p < N_PHASES; ++p) run(p, p + 1);
#else
    run(0, N_PHASES);
#endif
#else
    using nv::SG;
    const float* const* in = (const float* const*)d_in;
    const size_t BIG = (size_t)NT * D;
    double* ACC = (double*)(ws + 32 * 1024);
    float* nmisc = (float*)(ws + 987 * MiB);
    float* nKV = nmisc; float* nAFF = nmisc + 4u * 1024 * 1024; float* nGATE = nAFF + 1024 * 1024; int* nIDX = (int*)(nGATE + 128 * 1024); float* nMEMC = (float*)(ws + 385 * MiB);
    auto sgemm = [&](const float* A, const float* B, float* C, const int* gidx, int M, int N, int K, long sam, long sak, long sbk, long sbn, long ldc,
                     int nz = 1, int zdiv = 1, long zA0 = 0, long zA1 = 0, long zB0 = 0, long zB1 = 0, long zC0 = 0, long zC1 = 0) {
        SG s{A, B, C, gidx, M, N, K, zdiv, sam, sak, sbk, sbn, ldc, zA0, zA1, zB0, zB1, zC0, zC1};
        hipLaunchKernelGGL(nv::k_sgemm, dim3(N / 128, M / 128, nz), dim3(256), 0, stream, s);
    };
    const int EW = (int)((BIG + 255) / 256);
    auto n_import = [&](float* X) { hipMemcpyAsync(X, in[I_XP], (size_t)NTP * D * 4, hipMemcpyDeviceToDevice, stream); hipMemcpyAsync(X + (size_t)NTP * D, in[I_XS], (size_t)NTS * D * 4, hipMemcpyDeviceToDevice, stream);
        hipMemcpyAsync(nMEMC, in[I_MEMP], (size_t)4 * 256 * D * 4, hipMemcpyDeviceToDevice, stream); hipMemcpyAsync(nMEMC + (size_t)4 * 256 * D, in[I_MEMS], (size_t)4 * 256 * D * 4, hipMemcpyDeviceToDevice, stream); };
    auto n_s5 = [&](float* X, float* T1, float* T2, float* T3) {
        sgemm(X, in[I_AWIN], T1, nullptr, NT, D, D, D, 1, D, 1, D);
        hipLaunchKernelGGL(nv::k_s5_scan, dim3(8 * 64 * 2), dim3(64), 0, stream, T1, T2, in[I_ALRE], in[I_ALIM], in[I_ALDT], in[I_ABRE], in[I_ABIM], in[I_ACRE], in[I_ACIM]);
        hipLaunchKernelGGL(nv::k_s5_gelu, dim3(EW), dim3(256), 0, stream, T1, T2, in[I_AD], T2);
        sgemm(T2, in[I_AWGLU], T1, nullptr, NT, D, D, D, 1, 2 * D, 1, D);
        sgemm(T2, in[I_AWGLU] + D, T3, nullptr, NT, D, D, D, 1, 2 * D, 1, D);
        hipLaunchKernelGGL(nv::k_glu, dim3(EW), dim3(256), 0, stream, T1, T3, T1);
    };
    auto n_na = [&](float* X, float* T1, float* T2, float* T3) {
        sgemm(X, in[I_BWQKV], T1, nullptr, NT, D, D, D, 1, 3 * D, 1, D); sgemm(X, in[I_BWQKV] + D, T2, nullptr, NT, D, D, D, 1, 3 * D, 1, D); sgemm(X, in[I_BWQKV] + 2 * D, T3, nullptr, NT, D, D, D, 1, 3 * D, 1, D);
        hipLaunchKernelGGL(nv::k_natten, dim3(NT * 16 / 4), dim3(256), 0, stream, T1, T2, T3, in[I_BRPB]);
        sgemm(T1, in[I_BWO], T2, nullptr, NT, D, D, D, 1, D, 1, D);
    };
    auto n_ln = [&](float* X, const float* h, int layer, int sub, float* xo) { hipLaunchKernelGGL(nv::k_res_ln, dim3(NT / 4), dim3(256), 0, stream, X, h, in[I_LNG] + (layer * 3 + sub) * D, in[I_LNB] + (layer * 3 + sub) * D, xo, NT); };
    auto n_mem = [&](float* X, float* T1, float* T2, float* T3, int layer) {
        const float* wq = in[I_MWQ] + (size_t)layer * D * D; const float* wkv = in[I_MWKV] + (size_t)layer * D * 2 * D; const float* wo = in[I_MWO] + (size_t)layer * D * D;
        sgemm(nMEMC, wkv, nKV, nullptr, 8 * 256, 2 * D, D, D, 1, 2 * D, 1, 2 * D);
        sgemm(X, wq, T1, nullptr, NT, D, D, D, 1, D, 1, D);
        for (int grp = 0; grp < 2; ++grp) { const int L = grp ? 4096 : 8192; const size_t tb = grp ? (size_t)NTP : 0; const int gb0 = grp * 4;
            sgemm(T1 + tb * D, nKV + (size_t)gb0 * 256 * 2 * D, T2 + tb * D, nullptr, L, 256, 256, D, 1, 1, 2 * D, D, 16, 4, (long)L * D, 256, (long)256 * 2 * D, 256, (long)L * D, 256); }
        hipLaunchKernelGGL(nv::k_softmax256, dim3(NT * 4 / 4), dim3(256), 0, stream, T2, 0.0625f, NT * 4);
        for (int grp = 0; grp < 2; ++grp) { const int L = grp ? 4096 : 8192; const size_t tb = grp ? (size_t)NTP : 0; const int gb0 = grp * 4;
            sgemm(T2 + tb * D, nKV + (size_t)gb0 * 256 * 2 * D + D, T3 + tb * D, nullptr, L, 256, 256, D, 1, 2 * D, 1, D, 16, 4, (long)L * D, 256, (long)256 * 2 * D, 256, (long)L * D, 256); }
        sgemm(T3, wo, T1, nullptr, NT, D, D, D, 1, D, 1, D);
    };
    auto n_moe = [&](float* X, float* T1, float* T2, float* T3, int layer) {
        hipLaunchKernelGGL(nv::k_router, dim3(NT / 4), dim3(256), 0, stream, X, in[I_EWR] + (size_t)layer * D * 16, nAFF, NT);
        hipLaunchKernelGGL(nv::k_select, dim3(32), dim3(512), 0, stream, nAFF, nIDX, nGATE);
        hipMemsetAsync(T1, 0, BIG * 4, stream);
        for (int grp = 0; grp < 2; ++grp) { const int n = grp ? NTS : NTP, cap = n / 8; const size_t tb = grp ? (size_t)NTP : 0;
            for (int e = 0; e < 16; ++e) { const int* idx = nIDX + (grp ? 16 * 4096 : 0) + e * cap; const float* gate = nGATE + (grp ? 16 * 4096 : 0) + e * cap;
                const float* w1 = in[I_EW1] + ((size_t)layer * 16 + e) * D * 2048; const float* w3 = in[I_EW3] + ((size_t)layer * 16 + e) * D * 2048; const float* w2 = in[I_EW2] + ((size_t)layer * 16 + e) * 2048 * D;
                float* H1 = T2; float* H3 = T2 + (size_t)4096 * 2048; float* YE = T3;
                sgemm(X + tb * D, w1, H1, idx, cap, 2048, D, D, 1, 2048, 1, 2048); sgemm(X + tb * D, w3, H3, idx, cap, 2048, D, D, 1, 2048, 1, 2048);
                hipLaunchKernelGGL(nv::k_silu_mul, dim3((unsigned)(((size_t)cap * 2048 + 255) / 256)), dim3(256), 0, stream, H1, H3, (size_t)cap * 2048);
                sgemm(H1, w2, YE, nullptr, cap, D, 2048, 2048, 1, D, 1, D);
                hipLaunchKernelGGL(nv::k_scatter_add, dim3((unsigned)(((size_t)cap * D + 255) / 256)), dim3(256), 0, stream, YE, idx, gate, T1 + tb * D, cap); } }
    };
    float* X = (float*)(ws + WS_XF); float* T1 = (float*)(ws + WS_EW13); float* T2 = (float*)(ws + WS_POOL); float* T3 = (float*)(ws + WS_POOL + 192 * MiB);
    auto cmp_bf = [&](size_t off_bf16, const float* ref, double* acc) { hipLaunchKernelGGL(dbg::k_cmp_bf16_f32, dim3(2048), dim3(256), 0, stream, (const unsigned short*)(ws + off_bf16), ref, BIG, acc); };
#if DBG == 1
    n_import(X);
    a.flags = FLAG_NO_XIMPORT | FLAG_NO_EXPERTS0;
    n_s5(X, T1, T2, T3);
    for (int p = 0; p <= 5; ++p) run(p, p + 1);
    cmp_bf(PO_HB_S5, T1, ACC);
    cmp_bf(PO_HB_S5, T1, ACC + 2);
#elif DBG == 11
    n_import(X);
    a.flags = FLAG_NO_XIMPORT | FLAG_NO_EXPERTS0;
    sgemm(X, in[I_AWIN], T1, nullptr, NT, D, D, D, 1, D, 1, D);
    for (int p = 0; p <= 4; ++p) run(p, p + 1);
    hipLaunchKernelGGL(dbg::k_cmp_ua, dim3(2048), dim3(256), 0, stream, (const unsigned short*)(ws + PO_UA), T1, ACC);
    hipMemcpyAsync(X, T1, BIG * 4, hipMemcpyDeviceToDevice, stream);
    { float* Y = (float*)(ws + 193 * MiB);
      hipLaunchKernelGGL(nv::k_s5_scan, dim3(8 * 64 * 2), dim3(64), 0, stream, X, Y, in[I_ALRE], in[I_ALIM], in[I_ALDT], in[I_ABRE], in[I_ABIM], in[I_ACRE], in[I_ACIM]);
      hipLaunchKernelGGL(nv::k_s5_gelu, dim3(EW), dim3(256), 0, stream, X, Y, in[I_AD], Y);
      cmp_bf(PO_SG, Y, ACC + 2); }
#elif DBG == 2
    n_import(X); n_s5(X, T1, T2, T3); n_ln(X, T1, 0, 0, X); n_mem(X, T1, T2, T3, 0);
    a.flags = FLAG_NO_XIMPORT | FLAG_NO_EXPERTS0;
    run(0, 1); run(1, 2); run(2, 3); run(7, 8); run(9, 10);
    cmp_bf(PO_HB_MEM, T1, ACC); cmp_bf(PO_HB_MEM, T1, ACC + 2);
#elif DBG == 4
    n_import(X); n_na(X, T1, T2, T3);
    hipMemcpyAsync(T1, T2, BIG * 4, hipMemcpyDeviceToDevice, stream);
    a.flags = FLAG_NO_XIMPORT | FLAG_NO_EXPERTS0;
    run(0, 1); run(17, 18); run(18, 19); run(19, 20);
    cmp_bf(PO_HB_NA, T1, ACC); cmp_bf(PO_HB_NA, T1, ACC + 2);
#endif
    hipLaunchKernelGGL(dbg::k_encode, dim3(2048), dim3(256), 0, stream, (float*)d_out, ACC, ACC + 2);
#endif
}
```

```cpp
#include <hip/hip_runtime.h>
#include <cstdio>
#include <cstdint>
#include <cmath>
#define NO_WT 1
namespace nv {
constexpr int D = 1024, NTP = 32768, NTS = 16384, NT = NTP + NTS, NGB = 8, MEM = 256;
constexpr int GRID_W = 64;
constexpr float ALPHA = 1.41421356237309515f;
constexpr float LN_EPS = 1e-5f;

__host__ __device__ inline int gb_tok0(int gb) { return gb < 4 ? gb * 8192 : NTP + (gb - 4) * 4096; }
__host__ __device__ inline int gb_len(int gb) { return gb < 4 ? 8192 : 4096; }

__device__ __forceinline__ float wave_sum(float v) {
#pragma unroll
    for (int o = 1; o < 64; o <<= 1) v += __shfl_xor(v, o);
    return v;
}
__device__ __forceinline__ float wave_max(float v) {
#pragma unroll
    for (int o = 1; o < 64; o <<= 1) v = fmaxf(v, __shfl_xor(v, o));
    return v;
}

struct SG { const float* A; const float* B; float* C; const int* gidx; int M, N, K, zdiv; long sam, sak, sbk, sbn, ldc; long zA0, zA1, zB0, zB1, zC0, zC1; };
__global__ __launch_bounds__(256) void k_sgemm(SG a) {
    __shared__ float As[8][132];
    __shared__ float Bs[8][132];
    const int z = blockIdx.z, z0 = z / a.zdiv, z1 = z % a.zdiv;
    const float* A = a.A + z0 * a.zA0 + z1 * a.zA1;
    const float* B = a.B + z0 * a.zB0 + z1 * a.zB1;
    float* C = a.C + z0 * a.zC0 + z1 * a.zC1;
    const int bm = blockIdx.y * 128, bn = blockIdx.x * 128, tid = threadIdx.x, tx = tid & 15, ty = tid >> 4;
    float acc[8][8];
#pragma unroll
    for (int i = 0; i < 8; ++i)
#pragma unroll
        for (int j = 0; j < 8; ++j) acc[i][j] = 0.f;
    const int arow_l = tid >> 1, akk = (tid & 1) * 4;
    const long arow = a.gidx ? (long)a.gidx[bm + arow_l] : (long)(bm + arow_l);
    const float* Ap = A + arow * a.sam;
    const int bkk = tid >> 5, bnn = (tid & 31) * 4;
    for (int k0 = 0; k0 < a.K; k0 += 8) {
        float av[4], bv[4];
#pragma unroll
        for (int i = 0; i < 4; ++i) av[i] = Ap[(long)(k0 + akk + i) * a.sak];
#pragma unroll
        for (int i = 0; i < 4; ++i) bv[i] = B[(long)(k0 + bkk) * a.sbk + (long)(bn + bnn + i) * a.sbn];
        __syncthreads();
#pragma unroll
        for (int i = 0; i < 4; ++i) As[akk + i][arow_l] = av[i];
#pragma unroll
        for (int i = 0; i < 4; ++i) Bs[bkk][bnn + i] = bv[i];
        __syncthreads();
#pragma unroll
        for (int kk = 0; kk < 8; ++kk) {
            float x[8], y[8];
#pragma unroll
            for (int i = 0; i < 8; ++i) x[i] = As[kk][ty * 8 + i];
#pragma unroll
            for (int j = 0; j < 8; ++j) y[j] = Bs[kk][tx * 8 + j];
#pragma unroll
            for (int i = 0; i < 8; ++i)
#pragma unroll
                for (int j = 0; j < 8; ++j) acc[i][j] += x[i] * y[j];
        }
    }
#pragma unroll
    for (int i = 0; i < 8; ++i)
#pragma unroll
        for (int j = 0; j < 8; ++j) C[(long)(bm + ty * 8 + i) * a.ldc + bn + tx * 8 + j] = acc[i][j];
}

__global__ __launch_bounds__(64) void k_s5_scan(const float* __restrict__ u, float* __restrict__ ydir, const float* lam_re, const float* lam_im, const float* log_dt,
                                                const float* b_re, const float* b_im, const float* c_re, const float* c_im) {
    const int wid = blockIdx.x;
    const int dir = wid & 1, g = (wid >> 1) & 63, gb = wid >> 7;
    const int p = threadIdx.x;
    const int L = gb_len(gb), t0 = gb_tok0(gb);
    const double dt = exp((double)log_dt[dir * 64 + g]);
    const double lr = lam_re[(dir * 64 + g) * 64 + p], li = lam_im[(dir * 64 + g) * 64 + p];
    const double er = exp(lr * dt), lbr = er * cos(li * dt), lbi = er * sin(li * dt);
    const double nr = lbr - 1.0, ni = lbi, den = lr * lr + li * li;
    const double fr = (nr * lr + ni * li) / den, fi = (ni * lr - nr * li) / den;
    float Br[16], Bi[16], Cr[16], Ci[16];
#pragma unroll
    for (int h = 0; h < 16; ++h) {
        const double br = b_re[((dir * 64 + g) * 64 + p) * 16 + h], bi = b_im[((dir * 64 + g) * 64 + p) * 16 + h];
        Br[h] = (float)(fr * br - fi * bi); Bi[h] = (float)(fr * bi + fi * br);
        Cr[h] = c_re[((dir * 64 + g) * 16 + h) * 64 + p]; Ci[h] = c_im[((dir * 64 + g) * 16 + h) * 64 + p];
    }
    const float ar = (float)lbr, ai = (float)lbi;
    float hr = 0.f, hi = 0.f;
    float* yo = ydir + (size_t)dir * NT * D;
    for (int s = 0; s < L; ++s) {
        const int t = dir ? (L - 1 - s) : s;
        const float* ur = u + (size_t)(t0 + t) * D + g * 16;
        float bur = 0.f, bui = 0.f;
#pragma unroll
        for (int h = 0; h < 16; ++h) { const float uv = ur[h]; bur += uv * Br[h]; bui += uv * Bi[h]; }
        const float nhr = ar * hr - ai * hi + bur, nhi = ar * hi + ai * hr + bui;
        hr = nhr; hi = nhi;
        float mine = 0.f;
#pragma unroll
        for (int c = 0; c < 16; ++c) { const float v = wave_sum(Cr[c] * hr - Ci[c] * hi); if (p == c) mine = v; }
        if (p < 16) yo[(size_t)(t0 + t) * D + g * 16 + p] = mine;
    }
}
__global__ void k_s5_gelu(const float* u, const float* ydir, const float* dskip, float* gout) {
    const size_t i = (size_t)blockIdx.x * blockDim.x + threadIdx.x;
    if (i >= (size_t)NT * D) return;
    const float y = dskip[i & (D - 1)] * u[i] + ydir[i] + ydir[(size_t)NT * D + i];
    const float c = 0.7978845608028654f * (y + 0.044715f * y * y * y);
    gout[i] = 0.5f * y * (1.f + tanhf(c));
}
__global__ void k_glu(const float* z1, const float* z2, float* out) {
    const size_t i = (size_t)blockIdx.x * blockDim.x + threadIdx.x;
    if (i >= (size_t)NT * D) return;
    out[i] = z1[i] / (1.f + expf(-z2[i]));
}
__global__ __launch_bounds__(256) void k_res_ln(const float* x, const float* h, const float* g, const float* b, float* xo, int rows) {
    const int row = blockIdx.x * 4 + (threadIdx.x >> 6), lane = threadIdx.x & 63;
    if (row >= rows) return;
    float v[16]; float s = 0.f;
#pragma unroll
    for (int j = 0; j < 16; ++j) { const size_t i = (size_t)row * D + lane + 64 * j; v[j] = ALPHA * x[i] + h[i]; s += v[j]; }
    const float mean = wave_sum(s) * (1.f / D); float q = 0.f;
#pragma unroll
    for (int j = 0; j < 16; ++j) { v[j] -= mean; q += v[j] * v[j]; }
    const float rstd = 1.f / sqrtf(wave_sum(q) * (1.f / D) + LN_EPS);
#pragma unroll
    for (int j = 0; j < 16; ++j) { const int c = lane + 64 * j; xo[(size_t)row * D + c] = v[j] * rstd * g[c] + b[c]; }
}
__global__ __launch_bounds__(256) void k_softmax256(float* s, float scale, int rows) {
    const int row = blockIdx.x * 4 + (threadIdx.x >> 6), lane = threadIdx.x & 63;
    if (row >= rows) return;
    float v[4]; float m = -INFINITY;
#pragma unroll
    for (int j = 0; j < 4; ++j) { v[j] = s[(size_t)row * 256 + lane + 64 * j] * scale; m = fmaxf(m, v[j]); }
    m = wave_max(m); float l = 0.f;
#pragma unroll
    for (int j = 0; j < 4; ++j) { v[j] = expf(v[j] - m); l += v[j]; }
    l = wave_sum(l);
#pragma unroll
    for (int j = 0; j < 4; ++j) s[(size_t)row * 256 + lane + 64 * j] = v[j] / l;
}
__global__ __launch_bounds__(256) void k_router(const float* x, const float* wr, float* aff, int rows) {
    const int row = blockIdx.x * 4 + (threadIdx.x >> 6), lane = threadIdx.x & 63;
    if (row >= rows) return;
    float acc[16];
#pragma unroll
    for (int e = 0; e < 16; ++e) acc[e] = 0.f;
    for (int j = 0; j < 16; ++j) { const int k = lane + 64 * j; const float xv = x[(size_t)row * D + k];
#pragma unroll
        for (int e = 0; e < 16; ++e) acc[e] += xv * wr[k * 16 + e]; }
    float m = -INFINITY;
#pragma unroll
    for (int e = 0; e < 16; ++e) { acc[e] = wave_sum(acc[e]); m = fmaxf(m, acc[e]); }
    float l = 0.f;
#pragma unroll
    for (int e = 0; e < 16; ++e) { acc[e] = expf(acc[e] - m); l += acc[e]; }
    float mine = 0.f;
#pragma unroll
    for (int e = 0; e < 16; ++e) if (lane == e) mine = acc[e] / l;
    if (lane < 16) aff[(size_t)row * 16 + lane] = mine;
}

__device__ __forceinline__ void select_expert(const float* aff, int n, int e, int cap, int* idx_out, float* gate_out, int* slot_of  , unsigned* hist  , unsigned* wsum  , unsigned* bc  ) {
    const int tid = threadIdx.x, nth = blockDim.x, lane = tid & 63, wv = tid >> 6, nw = nth >> 6;
    unsigned prefix = 0u, mask = 0u; unsigned remaining = (unsigned)cap;
    for (int pass = 0; pass < 4; ++pass) {
        const int shift = 24 - 8 * pass;
        for (int i = tid; i < 256; i += nth) hist[i] = 0u;
        __syncthreads();
        for (int t = tid; t < n; t += nth) { const unsigned key = __float_as_uint(aff[(size_t)t * 16 + e]); if ((key & mask) == prefix) atomicAdd(&hist[(key >> shift) & 255u], 1u); }
        __syncthreads();
        if (tid == 0) { unsigned cum = 0u; int b = 255; for (; b > 0; --b) { if (cum + hist[b] >= remaining) break; cum += hist[b]; } bc[0] = (unsigned)b; bc[1] = remaining - cum; }
        __syncthreads();
        prefix |= bc[0] << shift; mask |= 0xffu << shift; remaining = bc[1];
        __syncthreads();
    }
    const unsigned T = prefix; const unsigned need_eq = remaining;
    unsigned base = 0u, eqbase = 0u;
    for (int s0 = 0; s0 < n; s0 += nth) {
        const int t = s0 + tid; const bool in = t < n;
        const float a = in ? aff[(size_t)t * 16 + e] : 0.f; const unsigned key = __float_as_uint(a);
        const bool gt = in && key > T, eq = in && key == T;
        const unsigned long long meq = __ballot(eq); const unsigned eqr_w = __popcll(meq & ((1ull << lane) - 1ull));
        if (lane == 0) wsum[wv] = __popcll(meq);
        __syncthreads();
        unsigned eqoff = 0u, eqtot = 0u; for (int w = 0; w < nw; ++w) { const unsigned c = wsum[w]; if (w < wv) eqoff += c; eqtot += c; }
        __syncthreads();
        const bool sel = gt || (eq && (eqbase + eqoff + eqr_w) < need_eq);
        const unsigned long long ms = __ballot(sel); const unsigned sr_w = __popcll(ms & ((1ull << lane) - 1ull));
        if (lane == 0) wsum[wv] = __popcll(ms);
        __syncthreads();
        unsigned soff = 0u, stot = 0u; for (int w = 0; w < nw; ++w) { const unsigned c = wsum[w]; if (w < wv) soff += c; stot += c; }
        __syncthreads();
        if (sel) { const unsigned slot = base + soff + sr_w; if (slot < (unsigned)cap) { idx_out[slot] = t; gate_out[slot] = a; } }
        if (slot_of && in) slot_of[(size_t)t * 16 + e] = sel ? (int)(base + soff + sr_w) : -1;
        base += stot; eqbase += eqtot;
    }
}
__global__ __launch_bounds__(512) void k_select(const float* aff_all, int* idx_all, float* gate_all) {
    __shared__ unsigned hist[256]; __shared__ unsigned wsum[32]; __shared__ unsigned bc[4];
    const int grp = blockIdx.x >> 4, e = blockIdx.x & 15;
    const int n = grp ? NTS : NTP, cap = n / 8;
    const float* aff = aff_all + (size_t)(grp ? NTP : 0) * 16;
    int* idx = idx_all + (grp ? 16 * 4096 : 0) + e * cap; float* gate = gate_all + (grp ? 16 * 4096 : 0) + e * cap;
    select_expert(aff, n, e, cap, idx, gate, nullptr, hist, wsum, bc);
}
__global__ void k_silu_mul(float* h1, const float* h3, size_t n) {
    const size_t i = (size_t)blockIdx.x * blockDim.x + threadIdx.x; if (i >= n) return;
    const float a = h1[i]; h1[i] = a / (1.f + expf(-a)) * h3[i];
}
__global__ void k_scatter_add(const float* ye, const int* idx, const float* gate, float* out, int cap) {
    const size_t i = (size_t)blockIdx.x * blockDim.x + threadIdx.x; if (i >= (size_t)cap * D) return;
    const int slot = (int)(i >> 10), c = (int)(i & 1023);
    atomicAdd(&out[(size_t)idx[slot] * D + c], gate[slot] * ye[i]);
}

__global__ __launch_bounds__(256) void k_natten(float* q, const float* k, const float* v, const float* rpb) {
    const int wg = blockIdx.x * 4 + (threadIdx.x >> 6), lane = threadIdx.x & 63;
    const int tok = wg >> 4, h = wg & 15;
    if (tok >= NT) return;
    int gb, l; if (tok < NTP) { gb = tok >> 13; l = tok & 8191; } else { gb = 4 + ((tok - NTP) >> 12); l = (tok - NTP) & 4095; }
    const int rows = gb_len(gb) / GRID_W, t0 = gb_tok0(gb);
    const int r = l >> 6, qc = l & 63;
    int rs = r - 4; rs = rs < 0 ? 0 : (rs > rows - 8 ? rows - 8 : rs);
    int ws = qc - 8; ws = ws < 0 ? 0 : (ws > 48 ? 48 : ws);
    const float qv = q[(size_t)tok * D + h * 64 + lane] * 0.125f;
    float m = -INFINITY, lsum = 0.f, o = 0.f;
    for (int rr = 0; rr < 8; ++rr) {
        const int kr = rs + rr, dr = kr - r + 7;
        for (int cc = 0; cc < 16; ++cc) {
            const int kc = ws + cc; int dc = kc - qc + 15; dc = dc < 0 ? 0 : (dc > 30 ? 30 : dc);
            const size_t kt = (size_t)(t0 + kr * 64 + kc) * D + h * 64 + lane;
            const float s = wave_sum(qv * k[kt]) + rpb[(h * 15 + dr) * 31 + dc];
            const float mn = fmaxf(m, s), al = expf(m - mn), pp = expf(s - mn);
            lsum = lsum * al + pp; o = o * al + pp * v[kt]; m = mn;
        }
    }
    q[(size_t)tok * D + h * 64 + lane] = o / lsum;
}
}
#define LAS __attribute__((address_space(3)))
#define GAS __attribute__((address_space(1)))
namespace fz {
typedef unsigned short bf16_t;
typedef short bf16x8 __attribute__((ext_vector_type(8)));
typedef float f32x4 __attribute__((ext_vector_type(4)));
typedef float f32x2 __attribute__((ext_vector_type(2)));
typedef unsigned u32x4 __attribute__((ext_vector_type(4)));
typedef unsigned u32x2 __attribute__((ext_vector_type(2)));
typedef int v8i __attribute__((ext_vector_type(8)));
typedef int v4i __attribute__((ext_vector_type(4)));

constexpr int D = 1024, NTP = 32768, NTS = 16384, NT = NTP + NTS;
constexpr int TCH = 32, NCHUNK = NT / TCH;
constexpr int UAK = TCH * 16 + 256;
constexpr float ALPHA = 1.41421356237309515f, LN_EPS = 1e-5f;
constexpr size_t MiB = 1u << 20;
constexpr size_t WS_CTL = 0, WS_XF = 1 * MiB, WS_XB = 193 * MiB, WS_WIN = 289 * MiB, WS_WGLU = 291 * MiB, WS_WQKV = 295 * MiB, WS_WO = 301 * MiB, WS_MWQ = 303 * MiB,
                 WS_MWKV = 307 * MiB, WS_MWO = 315 * MiB, WS_MEMB = 319 * MiB, WS_KV = 323 * MiB, WS_WQK = 339 * MiB, WS_WVO = 371 * MiB, WS_AFF = 403 * MiB, WS_SLOT = 406 * MiB,
                 WS_IDX = 409 * MiB, WS_GATE = 409 * MiB + 512 * 1024, WS_EW13 = 411 * MiB  , WS_EW2 = 475 * MiB  ,
                 WS_XB8 = 507 * MiB  , WS_POOL = 603 * MiB, WS_END = 1024 * MiB;
constexpr size_t PO_M2T = WS_POOL, PO_M13T = WS_POOL + 16 * MiB, PO_UA = WS_POOL + 64 * MiB, PO_SG = WS_POOL + 208 * MiB;
constexpr size_t PO_HB_S5 = WS_POOL;
constexpr size_t PO_SB = WS_POOL + 96 * MiB, PO_HB_MEM = WS_POOL + 304 * MiB;
constexpr size_t PO_Q = WS_POOL, PO_K = WS_POOL + 96 * MiB, PO_VT = WS_POOL + 192 * MiB, PO_HB_NA = WS_POOL + 96 * MiB;
constexpr size_t PO_HM = WS_POOL, PO_YE = WS_POOL + 192 * MiB;
static_assert(PO_YE + 192 * MiB <= WS_END && PO_SG + 96 * MiB <= WS_END && PO_HB_NA + 96 * MiB <= WS_END && PO_HB_MEM + 96 * MiB <= WS_END, "pool");
constexpr int CW_TMO = 0, CW_BAR = 4096;
constexpr size_t CTL_ZERO_BYTES = 64 * 1024;
constexpr int RING_BYTES = 131072, MISC_OFF = RING_BYTES + 320, LDS_BYTES = 147456, ZERO16_OFF = RING_BYTES + 64;

__host__ __device__ inline int gb_tok0(int gb) { return gb < 4 ? gb * 8192 : NTP + (gb - 4) * 4096; }
__host__ __device__ inline int gb_len(int gb) { return gb < 4 ? 8192 : 4096; }
__host__ __device__ inline int panel_gb(int pm) { return pm < 128 ? (pm >> 5) : 4 + ((pm - 128) >> 4); }

__device__ __forceinline__ unsigned cvt_pk_bf16(float lo, float hi) { unsigned r; asm volatile("v_cvt_pk_bf16_f32 %0, %1, %2" : "=v"(r) : "v"(lo), "v"(hi)); return r; }
typedef __bf16 bf16x2_t __attribute__((ext_vector_type(2)));
__device__ __forceinline__ unsigned cvt_pk_bf16_c(float lo, float hi) { const f32x2 v = {lo, hi}; const bf16x2_t b = __builtin_convertvector(v, bf16x2_t); return __builtin_bit_cast(unsigned, b); }
__device__ __forceinline__ float bf2f(unsigned short b) { return __uint_as_float(((unsigned)b) << 16); }
template <int CTRL> __device__ __forceinline__ float dpp_f(float v) { return __uint_as_float((unsigned)__builtin_amdgcn_update_dpp(0, (int)__float_as_uint(v), CTRL, 0xF, 0xF, true)); }
__device__ __forceinline__ float x16_sum(float v) { const auto r = __builtin_amdgcn_permlane16_swap(__float_as_uint(v), __float_as_uint(v), false, false); return __uint_as_float(r[0]) + __uint_as_float(r[1]); }
__device__ __forceinline__ float x32_sum(float v) { const auto r = __builtin_amdgcn_permlane32_swap(__float_as_uint(v), __float_as_uint(v), false, false); return __uint_as_float(r[0]) + __uint_as_float(r[1]); }
__device__ __forceinline__ float x16_max(float v) { const auto r = __builtin_amdgcn_permlane16_swap(__float_as_uint(v), __float_as_uint(v), false, false); return fmaxf(__uint_as_float(r[0]), __uint_as_float(r[1])); }
__device__ __forceinline__ float x32_max(float v) { const auto r = __builtin_amdgcn_permlane32_swap(__float_as_uint(v), __float_as_uint(v), false, false); return fmaxf(__uint_as_float(r[0]), __uint_as_float(r[1])); }
__device__ __forceinline__ float row_sum(float v) { v += dpp_f<0xB1>(v); v += dpp_f<0x4E>(v); v += dpp_f<0x141>(v); v += dpp_f<0x140>(v); return v; }
__device__ __forceinline__ float row_max(float v) { v = fmaxf(v, dpp_f<0xB1>(v)); v = fmaxf(v, dpp_f<0x4E>(v)); v = fmaxf(v, dpp_f<0x141>(v)); v = fmaxf(v, dpp_f<0x140>(v)); return v; }
__device__ __forceinline__ float wave_sum(float v) { return x32_sum(x16_sum(row_sum(v))); }
__device__ __forceinline__ float wave_max(float v) { return x32_max(x16_max(row_max(v))); }
#ifndef NO_WT
__device__ __forceinline__ void st16(void* p, u32x4 v) { asm volatile("global_store_dwordx4 %0, %1, off sc1\n\ts_nop 1" :: "v"(p), "v"(v)); }
__device__ __forceinline__ void st8(void* p, u32x2 v) { asm volatile("global_store_dwordx2 %0, %1, off sc1\n\ts_nop 1" :: "v"(p), "v"(v)); }
__device__ __forceinline__ void st4(void* p, unsigned v) { asm volatile("global_store_dword %0, %1, off sc1\n\ts_nop 1" :: "v"(p), "v"(v)); }
#else
__device__ __forceinline__ void st16(void* p, u32x4 v) { *(u32x4*)p = v; }
__device__ __forceinline__ void st8(void* p, u32x2 v) { *(u32x2*)p = v; }
__device__ __forceinline__ void st4(void* p, unsigned v) { *(unsigned*)p = v; }
#endif
__device__ __forceinline__ void st16f(void* p, f32x4 v) { st16(p, __builtin_bit_cast(u32x4, v)); }
__device__ __forceinline__ void pst16(void* p, u32x4 v) { *(u32x4*)p = v; }
__device__ __forceinline__ void pst8(void* p, u32x2 v) { *(u32x2*)p = v; }
#ifndef NO_WT
__device__ __forceinline__ void st16_so(const void* base, unsigned off, f32x4 v) { asm volatile("global_store_dwordx4 %0, %1, %2 sc1\n\ts_nop 1" :: "v"(off), "v"(v), "s"(base)); }
__device__ __forceinline__ void st4_so(const void* base, unsigned off, unsigned v) { asm volatile("global_store_dword %0, %1, %2 sc1\n\ts_nop 1" :: "v"(off), "v"(v), "s"(base)); }
#else
__device__ __forceinline__ void st16_so(const void* base, unsigned off, f32x4 v) { *(f32x4*)((unsigned char*)base + off) = v; }
__device__ __forceinline__ void st4_so(const void* base, unsigned off, unsigned v) { *(unsigned*)((unsigned char*)base + off) = v; }
#endif
#define LDS_WAIT() asm volatile("s_waitcnt lgkmcnt(0)" ::: "memory")
#define VM_WAIT() asm volatile("s_waitcnt vmcnt(0)" ::: "memory")

#define XB_TMO      128
#define XB_XCNT(j)  (256  + 64 * (j))
#define XB_XSUB(j)  (1280 + 64 * (j))
#define XB_XGEN(j)  (2304 + 64 * (j))
#define XB_TOP      3328
#define XB_TOPGEN   3392
#define XCD_BAR_WORDS 3456
#define XB_SPIN_CAP (1u << 18)
__device__ __forceinline__ unsigned xb_ld(unsigned* p)              { return __hip_atomic_load(p, __ATOMIC_RELAXED, __HIP_MEMORY_SCOPE_AGENT); }
__device__ __forceinline__ unsigned xb_add(unsigned* p, unsigned v) { return __hip_atomic_fetch_add(p, v, __ATOMIC_RELAXED, __HIP_MEMORY_SCOPE_AGENT); }
__device__ __forceinline__ unsigned xb_xcc_id() { return (unsigned)__builtin_amdgcn_s_getreg((3 << 11) | 20) & 0xFu; }
#define XB_SPIN(cond, bar) do { unsigned _sp = 0; while (cond) { __builtin_amdgcn_s_sleep(1); \
    if ((++_sp & 255u) == 0u) { if (xb_ld(&(bar)[XB_TMO])) break; if (_sp > XB_SPIN_CAP) { atomicAdd(&(bar)[XB_TMO], 1u); break; } } } } while (0)
struct XcdBarrier { unsigned* bar; unsigned x; volatile LAS unsigned* st; };
__device__ __forceinline__ int xb_tid();
__device__ __forceinline__ XcdBarrier xcd_barrier_post(unsigned* bar, volatile LAS unsigned* st) {
    XcdBarrier b; b.bar = bar; b.x = xb_xcc_id(); b.st = st;
    if (threadIdx.x == 0) st[4] = xb_add(&bar[XB_XCNT(b.x)], 1u);
    return b;
}
#define XB_LCNT(j)  (3520 + 64 * (j))
#define XB_LGEN(j)  (4544 + 64 * (j))
#define XCD_BAR_WORDS_EXT 5568
__device__ __forceinline__ void xcd_local_barrier(const XcdBarrier& b, const int wave_s, const unsigned nloc) {
    asm volatile("s_waitcnt vmcnt(0)" ::: "memory");
    __syncthreads();
    if (wave_s == 0 && xb_tid() == 0) {
        unsigned* bar = b.bar;
        const unsigned old = xb_add(&bar[XB_LCNT(b.x)], 1u);
        const unsigned gen = old / nloc;
        if (old + 1u == (gen + 1u) * nloc) xb_add(&bar[XB_LGEN(b.x)], 1u);
        else XB_SPIN(xb_ld(&bar[XB_LGEN(b.x)]) == gen, bar);
#ifndef LB_NOACQ
        __builtin_amdgcn_fence(__ATOMIC_ACQUIRE, "agent");
        asm volatile("s_waitcnt vmcnt(0)" ::: "memory");
#endif
    }
    __syncthreads();
}
__device__ __forceinline__ void xcd_barrier_complete(unsigned* bar, unsigned x, unsigned& nloc, unsigned& nx) {
    const unsigned G = gridDim.x * gridDim.y * gridDim.z;
    unsigned sum, cnt, mine, sp = 0u;
    for (;;) {
        sum = 0u; cnt = 0u; mine = 0u;
#pragma unroll
        for (unsigned j = 0; j < 16; ++j) { const unsigned c = xb_ld(&bar[XB_XCNT(j)]); sum += c; cnt += (c > 0u) ? 1u : 0u; mine = (j == x) ? c : mine; }
        if (sum == G) break;
        __builtin_amdgcn_s_sleep(1);
        if ((++sp & 255u) == 0u) { if (xb_ld(&bar[XB_TMO])) break; if (sp > XB_SPIN_CAP) { atomicAdd(&bar[XB_TMO], 1u); break; } }
    }
    nloc = mine > 0u ? mine : 1u; nx = cnt > 0u ? cnt : 1u;
}
__device__ __forceinline__ int xb_tid() { int t; asm volatile("v_mbcnt_lo_u32_b32 %0, -1, 0\n\tv_mbcnt_hi_u32_b32 %0, -1, %0" : "=v"(t)); return t; }
__device__ __forceinline__ void xcd_barrier(const XcdBarrier& b, const int wave_s) {
    asm volatile("s_waitcnt vmcnt(0)" ::: "memory");
    __syncthreads();
    if (wave_s == 0 && xb_tid() == 0) {
        unsigned* bar = b.bar;
        __builtin_amdgcn_s_waitcnt(0);
        unsigned nloc = b.st[0], nx = b.st[1];
        if (nloc == 0u) { xcd_barrier_complete(bar, b.x, nloc, nx); b.st[0] = nloc; b.st[1] = nx; }
        const unsigned old = xb_add(&bar[XB_XSUB(b.x)], 1u);
        const unsigned gen = old / nloc;
        if (old + 1u == (gen + 1u) * nloc) {
            __builtin_amdgcn_fence(__ATOMIC_RELEASE, "agent");
            asm volatile("s_waitcnt vmcnt(0)" ::: "memory");
            const unsigned og = xb_add(&bar[XB_TOP], 1u);
            const unsigned tg = og / nx;
            if (og + 1u == (tg + 1u) * nx) xb_add(&bar[XB_TOPGEN], 1u);
            else XB_SPIN(xb_ld(&bar[XB_TOPGEN]) == tg, bar);
            __builtin_amdgcn_fence(__ATOMIC_ACQUIRE, "agent");
            xb_add(&bar[XB_XGEN(b.x)], 1u);
            asm volatile("s_waitcnt vmcnt(0)" ::: "memory");
        } else {
            XB_SPIN(xb_ld(&bar[XB_XGEN(b.x)]) == gen, bar);
            __builtin_amdgcn_fence(__ATOMIC_ACQUIRE, "agent");
            asm volatile("s_waitcnt vmcnt(0)" ::: "memory");
        }
    }
    __syncthreads();
}

constexpr int BM = 256, BK = 64, HALF = 128, HTB = HALF * BK * 2, STAGE_BYTES = 8 * HTB;
__host__ __device__ __forceinline__ int lds_byte(int r, int c) { const int st = (r >> 4) * 2 + (c >> 5), rr = r & 15, cc = c & 31, ob = rr * 64 + cc * 2; return st * 1024 + (ob ^ (((ob >> 9) & 1) << 5)); }
__host__ __device__ __forceinline__ void stage_rc(int b, int& R, int& C) { const int st = b / 1024, sb = b % 1024, swz = sb ^ (((sb >> 9) & 1) << 5); R = (st >> 1) * 16 + swz / 64; C = (st & 1) * 32 + (swz % 64) / 2; }
__host__ __device__ __forceinline__ int perm32(int rho) { const int n = rho >> 4, i = rho & 15; return 8 * (i >> 2) + 4 * n + (i & 3); }

struct GUnit { const char* A; const char* B; char* C; const void* X; int pm, pn; };
template <int WGM = 8>
__device__ __forceinline__ bool static_unit(int i, int G, int c, int nM, int nN, int& pm, int& pn) {
    const long L = (long)i * G + c; const int nwg = nM * nN; if (L >= nwg) return false;
    int wgid = (int)L; { const int q = nwg / 8, r = nwg % 8, xcd = wgid % 8, off = wgid / 8; wgid = (xcd < r ? xcd * (q + 1) : r * (q + 1) + (xcd - r) * q) + off; }
    const int nig = WGM * nN, gid = wgid / nig, fm = gid * WGM, gsz = (nM - fm) < WGM ? (nM - fm) : WGM;
    pm = fm + ((wgid % nig) % gsz); pn = (wgid % nig) / gsz; return true;
}
template <class Epi, class Sched, bool GATHER, bool FP8 = false>
__device__ __forceinline__ void gemm_phase(LAS unsigned char* lds, const int tid_in, const int K, const unsigned lda, const unsigned ldb, const Sched& S, const Epi& E) {
    int tid_ = tid_in; asm volatile("" : "+v"(tid_));
    const int tid = tid_, wid = __builtin_amdgcn_readfirstlane(tid >> 6), lane = tid & 63, wr = wid >> 2, wc = wid & 3, fr = lane & 15, fq = lane >> 4;
    int nt_ = K / BK; asm volatile("" : "+s"(nt_)); const int nt = nt_;
    unsigned voffA[2], voffB[2]; int gR[2], gC[2];
#pragma unroll
    for (int i = 0; i < 2; ++i) { int R, C; stage_rc(tid * 16 + i * 8192, R, C); const int Rb = Epi::PERM ? ((R & ~31) + perm32(R & 31)) : R;
        voffA[i] = (unsigned)R * lda + (unsigned)C * 2u; voffB[i] = (unsigned)Rb * ldb + (unsigned)C * 2u; gR[i] = R; gC[i] = C * 2; }
    const size_t kstep = (size_t)(BK * 2);
    const size_t hstepA = (size_t)HALF * lda, hstepB = (size_t)HALF * ldb;
    const unsigned ldsw = (unsigned)wid * 1024u;
    const int aoff = lds_byte(wr * 64 + fr, fq * 8), boff = lds_byte(wc * 32 + fr, fq * 8);
    const int sc8 = 0x7F7F7F7F;
    unsigned cvo[2][2], nvo[2][2];
#define PG8_SA(b, h) (((b) * 2 + (h)) * HTB)
#define PG8_SB(b, h) ((4 + (b) * 2 + (h)) * HTB)
#define PG8_STAGE(bufoff, gbase, voff) do { _Pragma("unroll") for (int _i = 0; _i < 2; ++_i) \
        __builtin_amdgcn_global_load_lds((const unsigned*)((const char*)(gbase) + (voff)[_i]), (LAS unsigned*)(lds + (bufoff) + ldsw + _i * 8192), 16, 0, 0); } while (0)
#define PG8_STAGE_B(bufoff, ptr, h) PG8_STAGE(bufoff, (ptr) + (h) * hstepB, voffB)
#define PG8_STAGE_A(bufoff, ptr, h, vo) do { if constexpr (GATHER) { PG8_STAGE(bufoff, (ptr), (vo)[h]); } else { PG8_STAGE(bufoff, (ptr) + (h) * hstepA, voffA); } } while (0)
#define PG8_LDA(dst, b, h) do { _Pragma("unroll") for (int m = 0; m < 4; ++m) _Pragma("unroll") for (int k = 0; k < 2; ++k) dst[m][k] = *(const LAS bf16x8*)(lds + PG8_SA(b, h) + aoff + m * 2048 + k * 1024); } while (0)
#define PG8_LDB(dst, b, h) do { _Pragma("unroll") for (int n = 0; n < 2; ++n) _Pragma("unroll") for (int k = 0; k < 2; ++k) dst[n][k] = *(const LAS bf16x8*)(lds + PG8_SB(b, h) + boff + n * 2048 + k * 1024); } while (0)
#define PG8_MMA(ai, bj, At, Bt) do { __builtin_amdgcn_s_setprio(1); _Pragma("unroll") for (int m = 0; m < 4; ++m) _Pragma("unroll") for (int n = 0; n < 2; ++n) { \
        if constexpr (FP8) { const v8i _a = __builtin_shufflevector(__builtin_bit_cast(v4i, At[m][0]), __builtin_bit_cast(v4i, At[m][1]), 0, 1, 2, 3, 4, 5, 6, 7), _b = __builtin_shufflevector(__builtin_bit_cast(v4i, Bt[n][0]), __builtin_bit_cast(v4i, Bt[n][1]), 0, 1, 2, 3, 4, 5, 6, 7); \
            asm volatile("v_mfma_scale_f32_16x16x128_f8f6f4 %0, %1, %2, %0, %3, %3 op_sel_hi:[0,0,0]" : "+v"(acc[ai][bj][m][n]) : "v"(_b), "v"(_a), "v"(sc8)); } \
        else { _Pragma("unroll") for (int k = 0; k < 2; ++k) acc[ai][bj][m][n] = __builtin_amdgcn_mfma_f32_16x16x32_bf16(Bt[n][k], At[m][k], acc[ai][bj][m][n], 0, 0, 0); } } __builtin_amdgcn_s_setprio(0); } while (0)
#define PG8_WAIT_V(n) asm volatile("s_waitcnt vmcnt(" #n ")" ::: "memory")
#define PG8_WAIT_L(n) asm volatile("s_waitcnt lgkmcnt(" #n ")" ::: "memory")
#define PG8_BAR __builtin_amdgcn_s_barrier()
#define PG8_SCHED __builtin_amdgcn_sched_barrier(0)
#define PG8_GLOAD(vo, u) do { if constexpr (GATHER) { const int* _gi = (const int*)(u).X; _Pragma("unroll") for (int _h = 0; _h < 2; ++_h) _Pragma("unroll") for (int _i = 0; _i < 2; ++_i) \
        (vo)[_h][_i] = (unsigned)_gi[_h * HALF + gR[_i]] * lda + (unsigned)gC[_i]; } } while (0)
    GUnit cur, nxt; int ui = 0;
    if (!S.next(0, cur)) return;
    f32x4 acc[2][2][4][2];
    const volatile LAS f32x4* zero16 = (const volatile LAS f32x4*)(lds + ZERO16_OFF);
#pragma unroll
    for (int a = 0; a < 2; ++a)
#pragma unroll
        for (int b = 0; b < 2; ++b)
#pragma unroll
            for (int m = 0; m < 4; ++m)
#pragma unroll
                for (int n = 0; n < 2; ++n) acc[a][b][m][n] = *zero16;
    bf16x8 At[4][2], B0[2][2], B1[2][2];
    const char* cA = cur.A; const char* cB = cur.B;
    PG8_GLOAD(cvo, cur);
    if constexpr (GATHER) { PG8_WAIT_V(0); }
    PG8_STAGE_B(PG8_SB(0, 0), cB, 0); PG8_STAGE_B(PG8_SB(0, 1), cB, 1); PG8_STAGE_A(PG8_SA(0, 0), cA, 0, cvo); PG8_STAGE_A(PG8_SA(0, 1), cA, 1, cvo);
    if (wr == 1) PG8_BAR;
    PG8_WAIT_V(2); PG8_BAR;
    PG8_STAGE_B(PG8_SB(1, 0), cB + kstep, 0); PG8_STAGE_A(PG8_SA(1, 0), cA + kstep, 0, cvo); PG8_STAGE_B(PG8_SB(1, 1), cB + kstep, 1);
    PG8_WAIT_V(6); PG8_BAR;
    for (;;) {
        const bool has_next = S.next(ui + 1, nxt);
        const char* nA = has_next ? nxt.A : cA; const char* nB = has_next ? nxt.B : cB;
        if constexpr (GATHER) { if (has_next) { PG8_GLOAD(nvo, nxt); } else {
#pragma unroll
            for (int h = 0; h < 2; ++h)
#pragma unroll
                for (int i = 0; i < 2; ++i) nvo[h][i] = cvo[h][i]; } }
        for (int t = 0; t < nt; t += 2) {
            const bool last = (t == nt - 2);
            const char* a1 = cA + (size_t)(t + 1) * kstep;
            const char* a2 = last ? nA : cA + (size_t)(t + 2) * kstep; const char* b2 = last ? nB : cB + (size_t)(t + 2) * kstep;
            const char* a3 = a2 + kstep; const char* b3 = b2 + kstep;
            unsigned vo2[2][2];
            if constexpr (GATHER) {
#pragma unroll
                for (int h = 0; h < 2; ++h)
#pragma unroll
                    for (int i = 0; i < 2; ++i) vo2[h][i] = last ? nvo[h][i] : cvo[h][i]; }
            PG8_LDB(B0, 0, 0); PG8_LDB(B1, 0, 1); PG8_SCHED; PG8_LDA(At, 0, 0); PG8_STAGE_A(PG8_SA(1, 1), a1, 1, cvo);
            PG8_WAIT_V(8); PG8_WAIT_L(0); PG8_BAR; PG8_MMA(0, 0, At, B0); PG8_MMA(0, 1, At, B1); PG8_BAR; PG8_SCHED;
            PG8_LDA(At, 0, 1); PG8_STAGE_B(PG8_SB(0, 0), b2, 0); PG8_STAGE_B(PG8_SB(0, 1), b2, 1); PG8_STAGE_A(PG8_SA(0, 0), a2, 0, vo2);
            PG8_WAIT_V(8); PG8_WAIT_L(0); PG8_BAR; PG8_MMA(1, 0, At, B0); PG8_MMA(1, 1, At, B1); PG8_BAR; PG8_SCHED;
            PG8_LDB(B0, 1, 0); PG8_LDB(B1, 1, 1); PG8_SCHED; PG8_LDA(At, 1, 0); PG8_STAGE_A(PG8_SA(0, 1), a2, 1, vo2);
            PG8_WAIT_V(8); PG8_WAIT_L(0); PG8_BAR; PG8_MMA(0, 0, At, B0); PG8_MMA(0, 1, At, B1); PG8_BAR; PG8_SCHED;
            PG8_LDA(At, 1, 1); PG8_STAGE_B(PG8_SB(1, 0), b3, 0); PG8_STAGE_B(PG8_SB(1, 1), b3, 1); PG8_STAGE_A(PG8_SA(1, 0), a3, 0, vo2);
            PG8_WAIT_V(8); PG8_WAIT_L(0); PG8_BAR; PG8_MMA(1, 0, At, B0); PG8_MMA(1, 1, At, B1); PG8_BAR; PG8_SCHED;
        }
        if constexpr (FP8) { asm volatile("s_nop 15\n\ts_nop 15" ::: "memory"); }
        if (wr == 0) PG8_BAR;
        E(acc, cur, wr, wc, fr, fq);
        if (!has_next) break;
#pragma unroll
        for (int a = 0; a < 2; ++a)
#pragma unroll
            for (int b = 0; b < 2; ++b)
#pragma unroll
                for (int m = 0; m < 4; ++m)
#pragma unroll
                    for (int n = 0; n < 2; ++n) acc[a][b][m][n] = *zero16;
        cur = nxt; cA = nA; cB = nB; ++ui;
        if constexpr (GATHER) {
#pragma unroll
            for (int h = 0; h < 2; ++h)
#pragma unroll
                for (int i = 0; i < 2; ++i) cvo[h][i] = nvo[h][i]; }
        if (wr == 1) PG8_BAR;
    }
    PG8_WAIT_V(0);
    PG8_BAR;
#undef PG8_SA
#undef PG8_SB
#undef PG8_STAGE
#undef PG8_STAGE_A
#undef PG8_STAGE_B
#undef PG8_LDA
#undef PG8_LDB
#undef PG8_MMA
#undef PG8_WAIT_V
#undef PG8_WAIT_L
#undef PG8_BAR
#undef PG8_SCHED
#undef PG8_GLOAD
}
typedef f32x4 Acc[2][2][4][2];
__device__ __forceinline__ float sigmoidf_fast(float x) { return __builtin_amdgcn_rcpf(1.f + __builtin_amdgcn_exp2f(-1.4426950408889634f * x)); }
__device__ __forceinline__ float gelu_tanh_fast(float y) {
    const float inner = 1.5957691216057308f * (y + 0.044715f * y * y * y);
    return y * sigmoidf_fast(inner);
}
__device__ __forceinline__ unsigned cvt4_fp8(float a, float b, float c, float d) {
    a = fminf(fmaxf(a, -448.f), 448.f); b = fminf(fmaxf(b, -448.f), 448.f); c = fminf(fmaxf(c, -448.f), 448.f); d = fminf(fmaxf(d, -448.f), 448.f);
    int w = 0; w = __builtin_amdgcn_cvt_pk_fp8_f32(a, b, w, false); w = __builtin_amdgcn_cvt_pk_fp8_f32(c, d, w, true); return (unsigned)w;
}
constexpr float FP8_SX = 8.f, FP8_SW13 = 32.f, FP8_SH = 8.f, FP8_SW2 = 64.f, FP8_SWQK = 32.f, FP8_SWQKV = 32.f;
struct EpiGated8 {
    static constexpr bool PERM = true;
    unsigned ldc;
    __device__ __forceinline__ void operator()(const Acc& acc, const GUnit& u, int wr, int wc, int fr, int fq) const {
        unsigned char* base = (unsigned char*)u.C;
        constexpr float kx = -1.4426950408889634f / (FP8_SX * FP8_SW13), ic = (FP8_SX * FP8_SW13) * (FP8_SX * FP8_SW13) / FP8_SH;
#pragma unroll
        for (int ai = 0; ai < 2; ++ai)
#pragma unroll
            for (int m = 0; m < 4; ++m) { const int r = ai * HALF + wr * 64 + m * 16 + fr;
                float o[8];
#pragma unroll
                for (int n = 0; n < 2; ++n)
#pragma unroll
                    for (int j = 0; j < 4; j += 2) {
                        const f32x2 a = {acc[ai][0][m][n][j], acc[ai][0][m][n][j + 1]}, b = {acc[ai][1][m][n][j], acc[ai][1][m][n][j + 1]};
                        const f32x2 t = a * f32x2{kx, kx};
                        const f32x2 e = {__builtin_amdgcn_exp2f(t[0]), __builtin_amdgcn_exp2f(t[1])};
                        const f32x2 d = e * f32x2{ic, ic} + f32x2{ic, ic};
                        const f32x2 s = {__builtin_amdgcn_rcpf(d[0]), __builtin_amdgcn_rcpf(d[1])};
                        const f32x2 q = (a * b) * s;
                        o[n * 4 + j] = __builtin_amdgcn_fmed3f(q[0], -448.f, 448.f); o[n * 4 + j + 1] = __builtin_amdgcn_fmed3f(q[1], -448.f, 448.f); }
                int w0 = 0, w1 = 0;
                w0 = __builtin_amdgcn_cvt_pk_fp8_f32(o[0], o[1], w0, false); w0 = __builtin_amdgcn_cvt_pk_fp8_f32(o[2], o[3], w0, true);
                w1 = __builtin_amdgcn_cvt_pk_fp8_f32(o[4], o[5], w1, false); w1 = __builtin_amdgcn_cvt_pk_fp8_f32(o[6], o[7], w1, true);
                u32x2 w; w.x = (unsigned)w0; w.y = (unsigned)w1;
                st8(base + (size_t)r * ldc + wc * 32 + 8 * fq, w); }
    }
};
struct EpiBf8 {
    static constexpr bool PERM = true;
    unsigned ldc; float scale;
    __device__ __forceinline__ void operator()(const Acc& acc, const GUnit& u, int wr, int wc, int fr, int fq) const {
        unsigned char* base = (unsigned char*)u.C;
#pragma unroll
        for (int ai = 0; ai < 2; ++ai)
#pragma unroll
            for (int m = 0; m < 4; ++m) { const int r = ai * HALF + wr * 64 + m * 16 + fr; unsigned char* rowp = base + (size_t)r * ldc + wc * 32 + 8 * fq;
#pragma unroll
                for (int bj = 0; bj < 2; ++bj) { const f32x4 v0 = acc[ai][bj][m][0] * scale, v1 = acc[ai][bj][m][1] * scale;
                    u32x2 w; w.x = cvt4_fp8(v0[0], v0[1], v0[2], v0[3]); w.y = cvt4_fp8(v1[0], v1[1], v1[2], v1[3]); st8(rowp + bj * HALF, w); } }
    }
};
template <bool ROWSCALE> struct EpiBf {
    static constexpr bool PERM = true;
    unsigned ldc; float scale;
    __device__ __forceinline__ void operator()(const Acc& acc, const GUnit& u, int wr, int wc, int fr, int fq) const {
        bf16_t* base = (bf16_t*)u.C; const float* rs = (const float*)u.X;
#pragma unroll
        for (int ai = 0; ai < 2; ++ai)
#pragma unroll
            for (int m = 0; m < 4; ++m) { const int r = ai * HALF + wr * 64 + m * 16 + fr; float s = scale; if (ROWSCALE) s *= rs[r];
                bf16_t* rowp = base + (size_t)r * ldc + wc * 32 + 8 * fq;
#pragma unroll
                for (int bj = 0; bj < 2; ++bj) { const f32x4 v0 = acc[ai][bj][m][0] * s, v1 = acc[ai][bj][m][1] * s;
                    u32x4 w; w.x = cvt_pk_bf16(v0[0], v0[1]); w.y = cvt_pk_bf16(v0[2], v0[3]); w.z = cvt_pk_bf16(v1[0], v1[1]); w.w = cvt_pk_bf16(v1[2], v1[3]);
                    st16(rowp + bj * HALF, w); } }
    }
};
template <int MODE> struct EpiGated {
    static constexpr bool PERM = true;
    unsigned ldc;
    __device__ __forceinline__ void operator()(const Acc& acc, const GUnit& u, int wr, int wc, int fr, int fq) const {
        bf16_t* base = (bf16_t*)u.C;
#pragma unroll
        for (int ai = 0; ai < 2; ++ai)
#pragma unroll
            for (int m = 0; m < 4; ++m) { const int r = ai * HALF + wr * 64 + m * 16 + fr;
                float o[8];
#pragma unroll
                for (int n = 0; n < 2; ++n)
#pragma unroll
                    for (int j = 0; j < 4; ++j) { const float a = acc[ai][0][m][n][j], b = acc[ai][1][m][n][j];
                        o[n * 4 + j] = (MODE == 0) ? a * sigmoidf_fast(b) : a * sigmoidf_fast(a) * b; }
                u32x4 w; w.x = cvt_pk_bf16(o[0], o[1]); w.y = cvt_pk_bf16(o[2], o[3]); w.z = cvt_pk_bf16(o[4], o[5]); w.w = cvt_pk_bf16(o[6], o[7]);
                st16(base + (size_t)r * ldc + wc * 32 + 8 * fq, w); }
    }
};
struct EpiUA {
    static constexpr bool PERM = true;
    __device__ __forceinline__ void operator()(const Acc& acc, const GUnit& u, int wr, int wc, int fr, int fq) const {
        bf16_t* UA = (bf16_t*)u.C;
#pragma unroll
        for (int ai = 0; ai < 2; ++ai)
#pragma unroll
            for (int m = 0; m < 4; ++m) { const int tok = u.pm * BM + ai * HALF + wr * 64 + m * 16 + fr; const int chunk = tok >> 5, j = tok & 31;
#pragma unroll
                for (int bj = 0; bj < 2; ++bj) { const int ch = u.pn * BM + bj * HALF + wc * 32 + 8 * fq, g = ch >> 4, h0 = ch & 15;
                    const f32x4 v0 = acc[ai][bj][m][0], v1 = acc[ai][bj][m][1];
                    u32x4 w; w.x = cvt_pk_bf16(v0[0], v0[1]); w.y = cvt_pk_bf16(v0[2], v0[3]); w.z = cvt_pk_bf16(v1[0], v1[1]); w.w = cvt_pk_bf16(v1[2], v1[3]);
                    st16(UA + ((size_t)g * NCHUNK + chunk) * UAK + j * 16 + h0, w); } }
    }
};
struct EpiS {
    static constexpr bool PERM = false;
    __device__ __forceinline__ void operator()(const Acc& acc, const GUnit& u, int wr, int wc, int fr, int fq) const {
        float* Sg = (float*)u.C;
#pragma unroll
        for (int ai = 0; ai < 2; ++ai)
#pragma unroll
            for (int m = 0; m < 4; ++m) { const int chunk = u.pm * BM + ai * HALF + wr * 64 + m * 16 + fr; float* rowp = Sg + (size_t)chunk * 256 + wc * 32 + 4 * fq;
#pragma unroll
                for (int bj = 0; bj < 2; ++bj)
#pragma unroll
                    for (int n = 0; n < 2; ++n) st16f(rowp + bj * HALF + n * 16, acc[ai][bj][m][n]); }
    }
};
struct EpiGelu {
    static constexpr bool PERM = true;
    __device__ __forceinline__ void operator()(const Acc& acc, const GUnit& u, int wr, int wc, int fr, int fq) const {
        bf16_t* Gg = (bf16_t*)u.C;
#pragma unroll
        for (int ai = 0; ai < 2; ++ai)
#pragma unroll
            for (int m = 0; m < 4; ++m) { const int chunk = u.pm * BM + ai * HALF + wr * 64 + m * 16 + fr;
#pragma unroll
                for (int bj = 0; bj < 2; ++bj) { const int n0 = u.pn * BM + bj * HALF + wc * 32 + 8 * fq, i = n0 >> 4, c0 = n0 & 15;
                    const f32x4 v0 = acc[ai][bj][m][0], v1 = acc[ai][bj][m][1];
                    u32x4 w; w.x = cvt_pk_bf16(gelu_tanh_fast(v0[0]), gelu_tanh_fast(v0[1])); w.y = cvt_pk_bf16(gelu_tanh_fast(v0[2]), gelu_tanh_fast(v0[3]));
                    w.z = cvt_pk_bf16(gelu_tanh_fast(v1[0]), gelu_tanh_fast(v1[1])); w.w = cvt_pk_bf16(gelu_tanh_fast(v1[2]), gelu_tanh_fast(v1[3]));
                    st16(Gg + ((size_t)chunk * TCH + i) * D + c0, w); } }
    }
};

struct EpiSoftmax {
    static constexpr bool PERM = true;
    LAS float* red; unsigned ldc; float scale;
    __device__ __forceinline__ void operator()(Acc& acc, const GUnit& u, int wr, int wc, int fr, int fq) const {
        bf16_t* base = (bf16_t*)u.C;
#pragma unroll
        for (int ai = 0; ai < 2; ++ai)
#pragma unroll
            for (int m = 0; m < 4; ++m) { float mx = -INFINITY;
#pragma unroll
                for (int bj = 0; bj < 2; ++bj)
#pragma unroll
                    for (int n = 0; n < 2; ++n) { const f32x4 v = acc[ai][bj][m][n]; mx = fmaxf(mx, fmaxf(fmaxf(v[0], v[1]), fmaxf(v[2], v[3]))); }
                mx *= scale; mx = x32_max(x16_max(mx));
                if (fq == 0) red[(ai * HALF + wr * 64 + m * 16 + fr) * 4 + wc] = mx; }
        asm volatile("s_waitcnt lgkmcnt(0)" ::: "memory"); __builtin_amdgcn_s_barrier(); asm volatile("" ::: "memory");
#pragma unroll
        for (int ai = 0; ai < 2; ++ai)
#pragma unroll
            for (int m = 0; m < 4; ++m) { const int r = ai * HALF + wr * 64 + m * 16 + fr; const f32x4 mm = *(const LAS f32x4*)(red + r * 4); const float M = fmaxf(fmaxf(mm[0], mm[1]), fmaxf(mm[2], mm[3]));
                float s = 0.f;
#pragma unroll
                for (int bj = 0; bj < 2; ++bj)
#pragma unroll
                    for (int n = 0; n < 2; ++n) { f32x4 v = acc[ai][bj][m][n];
#pragma unroll
                        for (int j = 0; j < 4; ++j) { v[j] = __builtin_amdgcn_exp2f(__builtin_fmaf(v[j], scale, -M)); s += v[j]; }
                        acc[ai][bj][m][n] = v; }
                s = x32_sum(x16_sum(s));
                if (fq == 0) red[1024 + r * 4 + wc] = s; }
        asm volatile("s_waitcnt lgkmcnt(0)" ::: "memory"); __builtin_amdgcn_s_barrier(); asm volatile("" ::: "memory");
#pragma unroll
        for (int ai = 0; ai < 2; ++ai)
#pragma unroll
            for (int m = 0; m < 4; ++m) { const int r = ai * HALF + wr * 64 + m * 16 + fr; const f32x4 ss = *(const LAS f32x4*)(red + 1024 + r * 4); const float inv = __builtin_amdgcn_rcpf((ss[0] + ss[1]) + (ss[2] + ss[3]));
                bf16_t* rowp = base + (size_t)r * ldc + wc * 32 + 8 * fq;
#pragma unroll
                for (int bj = 0; bj < 2; ++bj) { const f32x4 v0 = acc[ai][bj][m][0] * inv, v1 = acc[ai][bj][m][1] * inv;
                    u32x4 w; w.x = cvt_pk_bf16(v0[0], v0[1]); w.y = cvt_pk_bf16(v0[2], v0[3]); w.z = cvt_pk_bf16(v1[0], v1[1]); w.w = cvt_pk_bf16(v1[2], v1[3]);
                    st16(rowp + bj * HALF, w); } }
    }
};

struct Ctx { unsigned char* ws; int G, c; };
struct SchedPlain { const char* A; const char* B; char* C; size_t lda, ldb, ldc; int nM, nN, G, c;
    __device__ __forceinline__ bool next(int i, GUnit& u) const { int pm, pn; if (!static_unit(i, G, c, nM, nN, pm, pn)) return false;
        u.A = A + (size_t)pm * BM * lda; u.B = B + (size_t)pn * BM * ldb; u.C = C + ((size_t)pm * BM * ldc + (size_t)pn * BM) * 2; u.X = nullptr; u.pm = pm; u.pn = pn; return true; } };
struct SchedGated { const char* A; const char* B; char* C; size_t lda, ldb, ldc; int nM, nN, G, c;
    __device__ __forceinline__ bool next(int i, GUnit& u) const { int pm, pn; if (!static_unit(i, G, c, nM, nN, pm, pn)) return false;
        u.A = A + (size_t)pm * BM * lda; u.B = B + (size_t)pn * BM * ldb; u.C = C + ((size_t)pm * BM * ldc + (size_t)pn * HALF) * 2; u.X = nullptr; u.pm = pm; u.pn = pn; return true; } };
struct SchedUA { const char* A; const char* B; char* UA; int G, c;
    __device__ __forceinline__ bool next(int i, GUnit& u) const { int pm, pn; if (!static_unit(i, G, c, NT / BM, D / BM, pm, pn)) return false;
        u.A = A + (size_t)pm * BM * (D * 2); u.B = B + (size_t)pn * BM * (D * 2); u.C = UA; u.X = nullptr; u.pm = pm; u.pn = pn; return true; } };
struct SchedKV { unsigned char* ws; int G, c;
    __device__ __forceinline__ bool next(int i, GUnit& u) const { const int L = i * G + c; if (L >= 128) return false; const int layer = L >> 6, r = L & 63, pm = r >> 3, pn = r & 7;
        u.A = (const char*)ws + WS_MEMB + (size_t)pm * BM * 2048; u.B = (const char*)ws + WS_MWKV + (size_t)layer * 4 * MiB + (size_t)pn * BM * 2048;
        u.C = (char*)ws + WS_KV + (size_t)layer * 8 * MiB + ((size_t)pm * BM * 2048 + pn * BM) * 2; u.X = nullptr; u.pm = pm; u.pn = pn; return true; } };
struct SchedSA { unsigned char* ws; int G, c;
    __device__ __forceinline__ bool next(int i, GUnit& u) const { const int L = i * G + c; if (L >= 64 * 6) return false; const int g = L / 6, pm = L % 6;
        u.A = (const char*)ws + PO_UA + ((size_t)g * NCHUNK + (size_t)pm * BM) * (UAK * 2); u.B = (const char*)ws + PO_M2T + (size_t)g * 256 * 512 * 2;
        u.C = (char*)ws + PO_SG + (size_t)g * NCHUNK * 256 * 4; u.X = nullptr; u.pm = pm; u.pn = 0; return true; } };
struct SchedSC { unsigned char* ws; int G, c;
    __device__ __forceinline__ bool next(int i, GUnit& u) const { const int L = i * G + c; if (L >= 64 * 12) return false; const int g = L / 12, r = L % 12, pm = r >> 1, pn = r & 1;
        u.A = (const char*)ws + PO_UA + ((size_t)g * NCHUNK + (size_t)pm * BM) * (UAK * 2); u.B = (const char*)ws + PO_M13T + ((size_t)g * 512 + pn * BM) * UAK * 2;
        u.C = (char*)ws + PO_SG + (size_t)g * 16 * 2; u.X = nullptr; u.pm = pm; u.pn = pn; return true; } };
struct SchedWqk { unsigned char* ws; int G, c;
    __device__ __forceinline__ bool next(int i, GUnit& u) const { const int L = i * G + c; if (L >= 256) return false; const int pn = L & 3, h = (L >> 2) & 3, gb = (L >> 4) & 7, layer = L >> 7;
        u.A = (const char*)ws + WS_KV + (size_t)layer * 8 * MiB + ((size_t)gb * 256 * 2048 + h * 256) * 2; u.B = (const char*)ws + WS_MWQ + (size_t)layer * 2 * MiB + ((size_t)pn * BM * 1024 + h * 256) * 2;
        u.C = (char*)ws + WS_WQK + ((size_t)(layer * 8 + gb) * 1024 * 1024 + (size_t)h * 256 * 1024 + pn * BM); u.X = nullptr; u.pm = 0; u.pn = pn; return true; } };
struct SchedWvo { unsigned char* ws; int G, c;
    __device__ __forceinline__ bool next(int i, GUnit& u) const { const int L = i * G + c; if (L >= 256) return false; const int pm = L & 3, h = (L >> 2) & 3, gb = (L >> 4) & 7, layer = L >> 7;
        u.A = (const char*)ws + WS_MWO + (size_t)layer * 2 * MiB + ((size_t)pm * BM * 1024 + h * 256) * 2; u.B = (const char*)ws + WS_KV + (size_t)layer * 8 * MiB + ((size_t)gb * 256 * 2048 + 1024 + h * 256) * 2;
        u.C = (char*)ws + WS_WVO + ((size_t)(layer * 8 + gb) * 1024 * 1024 + (size_t)pm * BM * 1024 + h * 256) * 2; u.X = nullptr; u.pm = pm; u.pn = 0; return true; } };
struct SchedScores8 { const char* A; const char* Bl; char* C; int G, c;
    __device__ __forceinline__ bool next(int i, GUnit& u) const { int pm, pn; if (!static_unit(i, G, c, NT / BM, 4, pm, pn)) return false; const int gb = panel_gb(pm);
        u.A = A + (size_t)pm * BM * 1024; u.B = Bl + ((size_t)gb * 1024 + pn * BM) * 1024; u.C = C + ((size_t)pm * BM * 1024 + pn * BM) * 2; u.X = nullptr; u.pm = pm; u.pn = pn; return true; } };
struct SchedBatchW { const char* A; const char* Bl; char* C; int G, c;
    __device__ __forceinline__ bool next(int i, GUnit& u) const { int pm, pn; if (!static_unit(i, G, c, NT / BM, 4, pm, pn)) return false; const int gb = panel_gb(pm);
        u.A = A + (size_t)pm * BM * 2048; u.B = Bl + ((size_t)gb * 1024 + pn * BM) * 2048; u.C = C + ((size_t)pm * BM * 1024 + pn * BM) * 2; u.X = nullptr; u.pm = pm; u.pn = pn; return true; } };
struct Args { const float* in[26]; float* out; unsigned char* ws; int ph_lo, ph_hi, flags, pad; };
struct Frame {
    LAS unsigned char* lds; unsigned char* ws; const float* const* in; float* out;
    int tid, lane, wave, G, c;
    bool xok;
};
enum { I_XP = 0, I_XS, I_MEMP, I_MEMS, I_AWIN, I_ALRE, I_ALIM, I_ALDT, I_ABRE, I_ABIM, I_ACRE, I_ACIM, I_AD, I_AWGLU, I_BWQKV, I_BRPB, I_BWO, I_MWQ, I_MWKV, I_MWO, I_EWR, I_EW1, I_EW3, I_EW2, I_LNG, I_LNB };

__device__ __forceinline__ int rowmap(int mode, int n) {
    if (mode == 0) return n;
    if (mode == 1) { const int z = n >> 10, nn = n & 1023; return ((nn >> 7) << 8) + (z << 7) + (nn & 127); }
    return ((n >> 7) << 8) + ((mode == 3) ? 128 : 0) + (n & 127);
}
__device__ __forceinline__ void transpose_item(const float* W, int K, int N, bf16_t* WT, int mode, LAS float* scr, int item, int lane) {
    const int nblk = N / 32, kb = item / nblk, nb = item % nblk, k0 = 64 * kb, n0 = 32 * nb;
#pragma unroll 8
    for (int i = 0; i < 32; ++i) { const int kk = 2 * i + (lane >> 5); scr[kk * 33 + (lane & 31)] = W[(size_t)(k0 + kk) * N + n0 + (lane & 31)]; }
    LDS_WAIT(); asm volatile("" ::: "memory");
    const int c = lane & 7;
#pragma unroll
    for (int j = 0; j < 4; ++j) { const int n = (lane >> 3) + 8 * j; const LAS float* s = scr + (8 * c) * 33 + n;
        u32x4 o; o.x = cvt_pk_bf16(s[0 * 33], s[1 * 33]); o.y = cvt_pk_bf16(s[2 * 33], s[3 * 33]); o.z = cvt_pk_bf16(s[4 * 33], s[5 * 33]); o.w = cvt_pk_bf16(s[6 * 33], s[7 * 33]);
        *(u32x4*)(WT + (size_t)rowmap(mode, n0 + n) * K + k0 + 8 * c) = o; }
    LDS_WAIT(); asm volatile("" ::: "memory");
}
__device__ __forceinline__ void t8_load(f32x4 (&v)[16], const float* W, int N, int item, int lane) {
    const int nblk = N / 32, kb = item / nblk, nb = item % nblk, k0 = 128 * kb, n0 = 32 * nb, q = lane >> 3, c = lane & 7;
#pragma unroll
    for (int i = 0; i < 16; ++i) v[i] = *(const f32x4*)(W + (size_t)(k0 + 16 * q + i) * N + n0 + 4 * c);
}
__device__ __forceinline__ void t8_finish(const f32x4 (&v)[16], int K, int N, unsigned char* WT, int mode, float scale, LAS unsigned char* scr, int item, int lane) {
    const int nblk = N / 32, kb = item / nblk, nb = item % nblk, k0 = 128 * kb, n0 = 32 * nb, q = lane >> 3, c = lane & 7;
#pragma unroll
    for (int j = 0; j < 4; ++j) { u32x4 o;
        o.x = cvt4_fp8(v[0][j] * scale, v[1][j] * scale, v[2][j] * scale, v[3][j] * scale); o.y = cvt4_fp8(v[4][j] * scale, v[5][j] * scale, v[6][j] * scale, v[7][j] * scale);
        o.z = cvt4_fp8(v[8][j] * scale, v[9][j] * scale, v[10][j] * scale, v[11][j] * scale); o.w = cvt4_fp8(v[12][j] * scale, v[13][j] * scale, v[14][j] * scale, v[15][j] * scale);
        *(LAS u32x4*)(scr + (4 * c + j) * 144 + 16 * q) = o; }
    LDS_WAIT(); asm volatile("" ::: "memory");
#pragma unroll
    for (int j = 0; j < 4; ++j) { const int n = (lane >> 3) + 8 * j; const u32x4 o = *(const LAS u32x4*)(scr + n * 144 + 16 * c);
        pst16(WT + (size_t)rowmap(mode, n0 + n) * K + k0 + 16 * c, o); }
    LDS_WAIT(); asm volatile("" ::: "memory");
}
__device__ __forceinline__ void transpose_item8(const float* W, int K, int N, unsigned char* WT, int mode, float scale, LAS unsigned char* scr, int item, int lane) {
    f32x4 v[16]; t8_load(v, W, N, item, lane); t8_finish(v, K, N, WT, mode, scale, scr, item, lane);
}
__device__ __forceinline__ void transpose_item16(const float* W, int K, int N, bf16_t* WT, int mode, LAS unsigned char* scr, int item, int lane) {
    const int nblk = N / 32, kb = item / nblk, nb = item % nblk, k0 = 128 * kb, n0 = 32 * nb, q = lane >> 3, c = lane & 7;
    f32x4 v[16];
#pragma unroll
    for (int i = 0; i < 16; ++i) v[i] = *(const f32x4*)(W + (size_t)(k0 + 16 * q + i) * N + n0 + 4 * c);
#pragma unroll
    for (int j = 0; j < 4; ++j) { u32x4 o0, o1;
        o0.x = cvt_pk_bf16(v[0][j], v[1][j]); o0.y = cvt_pk_bf16(v[2][j], v[3][j]); o0.z = cvt_pk_bf16(v[4][j], v[5][j]); o0.w = cvt_pk_bf16(v[6][j], v[7][j]);
        o1.x = cvt_pk_bf16(v[8][j], v[9][j]); o1.y = cvt_pk_bf16(v[10][j], v[11][j]); o1.z = cvt_pk_bf16(v[12][j], v[13][j]); o1.w = cvt_pk_bf16(v[14][j], v[15][j]);
        *(LAS u32x4*)(scr + (4 * c + j) * 272 + 32 * q) = o0; *(LAS u32x4*)(scr + (4 * c + j) * 272 + 32 * q + 16) = o1; }
    LDS_WAIT(); asm volatile("" ::: "memory");
#pragma unroll
    for (int j = 0; j < 8; ++j) { const int n = (lane >> 4) + 4 * j, ch = lane & 15; const u32x4 o = *(const LAS u32x4*)(scr + n * 272 + 16 * ch);
        *(u32x4*)(WT + (size_t)rowmap(mode, n0 + n) * K + k0 + 8 * ch) = o; }
    LDS_WAIT(); asm volatile("" ::: "memory");
}
__device__ __forceinline__ void convert_small_weights(Frame& F) {
    LAS unsigned char* scr = F.lds + F.wave * 16384;
    const int gw = F.c * 8 + F.wave, NGW = F.G * 8;
    for (int it = gw; it < 3328; it += NGW) {
        int r = it;
        if (r < 256) { transpose_item16(F.in[I_AWIN], 1024, 1024, (bf16_t*)(F.ws + WS_WIN), 0, scr, r, F.lane); continue; } r -= 256;
        if (r < 512) { transpose_item16(F.in[I_AWGLU], 1024, 2048, (bf16_t*)(F.ws + WS_WGLU), 1, scr, r, F.lane); continue; } r -= 512;
        if (r < 768) { transpose_item8(F.in[I_BWQKV], 1024, 3072, F.ws + WS_WQKV, 0, FP8_SWQKV, scr, r, F.lane); continue; } r -= 768;
        if (r < 256) { transpose_item16(F.in[I_BWO], 1024, 1024, (bf16_t*)(F.ws + WS_WO), 0, scr, r, F.lane); continue; } r -= 256;
        if (r < 1024) { const int l = r >> 9; transpose_item16(F.in[I_MWKV] + (size_t)l * 1024 * 2048, 1024, 2048, (bf16_t*)(F.ws + WS_MWKV + (size_t)l * 4 * MiB), 0, scr, r & 511, F.lane); continue; } r -= 1024;
        { const int l = r >> 8; transpose_item16(F.in[I_MWO] + (size_t)l * 1024 * 1024, 1024, 1024, (bf16_t*)(F.ws + WS_MWO + (size_t)l * 2 * MiB), 0, scr, r & 255, F.lane); }
    }
}
__device__ __forceinline__ void convert_expert_weights(Frame& F, int layer, int lo = 0, int hi = 16 * 1536, int wg0 = 0) {
    if (F.G <= wg0) wg0 = 0;
    if (F.c < wg0) return;
    LAS unsigned char* scr = F.lds + F.wave * 16384;
    const int gw = (F.c - wg0) * 8 + F.wave, NGW = (F.G - wg0) * 8;
#define CVX_DECODE(it_) const int _e = (it_) / 1536; int _r = (it_) % 1536; const size_t _wofs = ((size_t)layer * 16 + _e) * 1024 * 2048; \
        const int _w = _r >> 9; _r &= 511; const float* _W = (_w == 0 ? F.in[I_EW1] : (_w == 1 ? F.in[I_EW3] : F.in[I_EW2])) + _wofs; const int _N = _w == 2 ? 1024 : 2048, _K = _w == 2 ? 2048 : 1024;
#define CVX_LOAD(v_, it_) do { CVX_DECODE(it_); (void)_K; t8_load(v_, _W, _N, _r, F.lane); } while (0)
#define CVX_FINISH(v_, it_) do { CVX_DECODE(it_); unsigned char* _WT = _w == 2 ? F.ws + WS_EW2 + (size_t)_e * 2 * MiB : F.ws + WS_EW13 + (size_t)_e * 4 * MiB; \
        t8_finish(v_, _K, _N, _WT, _w == 0 ? 2 : (_w == 1 ? 3 : 0), _w == 2 ? FP8_SW2 : FP8_SW13, scr, _r, F.lane); } while (0)
    f32x4 va[16], vb[16];
    int it = lo + gw;
    if (it < hi) CVX_LOAD(va, it);
    while (it < hi) {
        const int it1 = it + NGW, it2 = it1 + NGW;
        if (it1 < hi) CVX_LOAD(vb, it1);
        CVX_FINISH(va, it);
        if (it1 < hi) { if (it2 < hi) CVX_LOAD(va, it2); CVX_FINISH(vb, it1); }
        it = it2;
    }
#undef CVX_DECODE
#undef CVX_LOAD
#undef CVX_FINISH
}
__device__ __forceinline__ void convert_plain(Frame& F, const float* src, bf16_t* dst, size_t n) {
    const size_t n4 = n / 4;
    for (size_t i = (size_t)F.c * 512 + F.tid; i < n4; i += (size_t)F.G * 512) { const f32x4 v = ((const f32x4*)src)[i]; u32x2 w; w.x = cvt_pk_bf16(v[0], v[1]); w.y = cvt_pk_bf16(v[2], v[3]); ((u32x2*)dst)[i] = w; }
}
__device__ __forceinline__ void import_x(Frame& F, bool copy_f32) {
    const size_t n4 = (size_t)NT * D / 4, np4 = (size_t)NTP * D / 4, st = (size_t)F.G * 512;
    f32x4* XF = (f32x4*)(F.ws + WS_XF); u32x2* XB = (u32x2*)(F.ws + WS_XB);
    for (size_t i0 = (size_t)F.c * 512 + F.tid; i0 < n4; i0 += st * 8) {
        f32x4 v[8];
#pragma unroll
        for (int u = 0; u < 8; ++u) { const size_t i = i0 + st * u;
            if (i < n4) { if (copy_f32) { v[u] = (i < np4) ? ((const f32x4*)F.in[I_XP])[i] : ((const f32x4*)F.in[I_XS])[i - np4]; } else v[u] = XF[i]; } }
#pragma unroll
        for (int u = 0; u < 8; ++u) { const size_t i = i0 + st * u;
            if (i < n4) { u32x2 w; w.x = cvt_pk_bf16(v[u][0], v[u][1]); w.y = cvt_pk_bf16(v[u][2], v[u][3]); XB[i] = w; } }
    }
}

__device__ __forceinline__ void s5_lam(const float* lre, const float* lim, const float* ldt, int dir, int g, int p, double& dt, double& lr, double& li) {
    dt = exp((double)ldt[dir * 64 + g]); lr = (double)lre[(dir * 64 + g) * 64 + p]; li = (double)lim[(dir * 64 + g) * 64 + p];
}
__device__ __forceinline__ void s5_fill_bc(Frame& F, int g, int dir, LAS float* Bbr, LAS float* Bbi, LAS float* Cr, LAS float* Ci) {
    for (int idx = F.tid; idx < 1024; idx += 512) {
        const int p = idx >> 4, h = idx & 15; double dt, lr, li; s5_lam(F.in[I_ALRE], F.in[I_ALIM], F.in[I_ALDT], dir, g, p, dt, lr, li);
        const double er = exp(lr * dt), lbr = er * cos(li * dt), lbi = er * sin(li * dt), nr = lbr - 1.0, ni = lbi, den = lr * lr + li * li;
        const double fr = (nr * lr + ni * li) / den, fi = (ni * lr - nr * li) / den;
        const double br = F.in[I_ABRE][((dir * 64 + g) * 64 + p) * 16 + h], bi = F.in[I_ABIM][((dir * 64 + g) * 64 + p) * 16 + h];
        Bbr[idx] = (float)(fr * br - fi * bi); Bbi[idx] = (float)(fr * bi + fi * br);
        Cr[idx] = F.in[I_ACRE][(dir * 64 + g) * 1024 + idx]; Ci[idx] = F.in[I_ACIM][(dir * 64 + g) * 1024 + idx];
    }
}
__device__ __forceinline__ void s5_build_item(Frame& F, int g, int dir) {
    LAS float* LPr = (LAS float*)F.lds; LAS float* LPi = LPr + 33 * 64;
    LAS float* Bbr = LPi + 33 * 64; LAS float* Bbi = Bbr + 1024; LAS float* Cr = Bbi + 1024; LAS float* Ci = Cr + 1024;
    LAS float* B2r = Ci + 1024; LAS float* B2i = B2r + 1024; LAS float* C2r = B2i + 1024; LAS float* C2i = C2r + 1024;
    bf16_t* M2T = (bf16_t*)(F.ws + PO_M2T) + (size_t)g * 256 * 512; bf16_t* M13T = (bf16_t*)(F.ws + PO_M13T) + (size_t)g * 512 * UAK;
    __syncthreads();
    for (int idx = F.tid; idx < 33 * 64; idx += 512) { const int e = idx >> 6, p = idx & 63; double dt, lr, li; s5_lam(F.in[I_ALRE], F.in[I_ALIM], F.in[I_ALDT], dir, g, p, dt, lr, li);
        const double er = exp(lr * dt * e); LPr[idx] = (float)(er * cos(li * dt * e)); LPi[idx] = (float)(er * sin(li * dt * e)); }
    s5_fill_bc(F, g, dir, Bbr, Bbi, Cr, Ci);
    if (dir == 0) s5_fill_bc(F, g, 1, B2r, B2i, C2r, C2i);
    __syncthreads();
    {
        const int k = F.tid, j = k >> 4, h = k & 15, e = dir == 0 ? (TCH - 1 - j) : j;
        for (int p = 0; p < 64; ++p) { const float lr = LPr[e * 64 + p], li = LPi[e * 64 + p], br = Bbr[p * 16 + h], bi = Bbi[p * 16 + h];
            const float xr = lr * br - li * bi, xi = lr * bi + li * br;
            M2T[(size_t)(dir * 128 + p) * 512 + k] = (bf16_t)(cvt_pk_bf16(xr, 0.f) & 0xffffu); M2T[(size_t)(dir * 128 + 64 + p) * 512 + k] = (bf16_t)(cvt_pk_bf16(xi, 0.f) & 0xffffu); }
    }
    {
        const int p = F.tid & 63, q8 = F.tid >> 6;
        for (int ic = q8; ic < 512; ic += 8) { const int i = ic >> 4, c = ic & 15, e = dir == 0 ? (i + 1) : (TCH - i);
            const float cr = Cr[c * 64 + p], ci = Ci[c * 64 + p], lr = LPr[e * 64 + p], li = LPi[e * 64 + p];
            const float vr = cr * lr - ci * li, vi = cr * li + ci * lr;
            M13T[(size_t)ic * UAK + 512 + dir * 128 + p] = (bf16_t)(cvt_pk_bf16(vr, 0.f) & 0xffffu); M13T[(size_t)ic * UAK + 512 + dir * 128 + 64 + p] = (bf16_t)(cvt_pk_bf16(-vi, 0.f) & 0xffffu); }
    }
    {
        const int ch = F.tid & 255, c = ch >> 4, h = ch & 15, par = F.tid >> 8;
        for (int d = 1 + par; d < TCH; d += 2) {
            float s = 0.f;
            for (int p = 0; p < 64; ++p) { const float lr = LPr[d * 64 + p], li = LPi[d * 64 + p], br = Bbr[p * 16 + h], bi = Bbi[p * 16 + h];
                s += Cr[c * 64 + p] * (lr * br - li * bi) - Ci[c * 64 + p] * (lr * bi + li * br); }
            const bf16_t v = (bf16_t)(cvt_pk_bf16(s, 0.f) & 0xffffu);
            for (int t = 0; t + d < TCH; ++t) { const int i = dir == 0 ? t + d : t, j = dir == 0 ? t : t + d; M13T[(size_t)(i * 16 + c) * UAK + j * 16 + h] = v; }
        }
        if (dir == 0 && par == 0) {
            float s = (c == h) ? F.in[I_AD][g * 16 + c] : 0.f;
            for (int p = 0; p < 64; ++p) s += Cr[c * 64 + p] * Bbr[p * 16 + h] - Ci[c * 64 + p] * Bbi[p * 16 + h] + C2r[c * 64 + p] * B2r[p * 16 + h] - C2i[c * 64 + p] * B2i[p * 16 + h];
            const bf16_t v = (bf16_t)(cvt_pk_bf16(s, 0.f) & 0xffffu);
            for (int t = 0; t < TCH; ++t) M13T[(size_t)(t * 16 + c) * UAK + t * 16 + h] = v;
        }
    }
    __syncthreads();
}

__device__ __forceinline__ void s5_recurrence(Frame& F) {
    const float* S = (const float*)(F.ws + PO_SG); bf16_t* UA = (bf16_t*)(F.ws + PO_UA);
    for (int base = F.c * 256; base < 65536; base += F.G * 256) {
        if (F.tid >= 256) continue;
        const int flat = base + F.tid, p = flat & 63, dir = (flat >> 6) & 1, g = (flat >> 7) & 63, gb = flat >> 13;
        double dt, lr, li; s5_lam(F.in[I_ALRE], F.in[I_ALIM], F.in[I_ALDT], dir, g, p, dt, lr, li);
        const double er = exp(lr * dt * TCH); const float ar = (float)(er * cos(li * dt * TCH)), ai = (float)(er * sin(li * dt * TCH));
        const int nc = gb < 4 ? 256 : 128, chunk0 = gb < 4 ? gb * 256 : 1024 + (gb - 4) * 128;
        float hr = 0.f, hi = 0.f;
        for (int s0 = 0; s0 < nc; s0 += 8) {
            float sr[8], si[8];
#pragma unroll
            for (int k = 0; k < 8; ++k) { const int cc = dir == 0 ? (s0 + k) : (nc - 1 - s0 - k); const size_t o = ((size_t)g * NCHUNK + (chunk0 + cc)) * 256 + dir * 128 + p; sr[k] = S[o]; si[k] = S[o + 64]; }
#pragma unroll
            for (int k = 0; k < 8; ++k) { const int cc = dir == 0 ? (s0 + k) : (nc - 1 - s0 - k); const size_t o = ((size_t)g * NCHUNK + (chunk0 + cc)) * UAK + 512 + dir * 128 + p;
                UA[o] = (bf16_t)(cvt_pk_bf16(hr, 0.f) & 0xffffu); UA[o + 64] = (bf16_t)(cvt_pk_bf16(hi, 0.f) & 0xffffu);
                const float nr = ar * hr - ai * hi + sr[k], ni = ar * hi + ai * hr + si[k]; hr = nr; hi = ni; }
        }
    }
}

__device__ __forceinline__ void add_bf16x4(f32x4& v, const u32x2 w) { v[0] += __uint_as_float(w.x << 16); v[1] += __uint_as_float(w.x & 0xffff0000u); v[2] += __uint_as_float(w.y << 16); v[3] += __uint_as_float(w.y & 0xffff0000u); }
constexpr int WRS = 1028;
__device__ __forceinline__ void ln_router_fill(Frame& F, const float* gam, const float* bet, const float* wrouter) {
    LAS float* wrT = (LAS float*)F.lds; LAS float* gsh = wrT + 16 * WRS; LAS float* bsh = gsh + 1024;
    __syncthreads();
    for (int i = F.tid; i < 16384; i += 512) { const int k = i >> 4, e = i & 15; wrT[e * WRS + k] = wrouter[i]; }
    for (int i = F.tid; i < 1024; i += 512) { gsh[i] = gam[i]; bsh[i] = bet[i]; }
    __syncthreads();
}
#ifndef RES_BF16
#define RES_BF16 1
#endif
template <int MODE, bool ROUTER, bool FINAL, bool SRCIN = false>
__device__ __forceinline__ void ln_phase(Frame& F, const bf16_t* HB, const float* gam, const float* bet, const float* wrouter) {
    float* XF = (float*)(F.ws + WS_XF);
    LAS float* wrT = (LAS float*)F.lds;
    LAS float* gsh = wrT + 16 * WRS; LAS float* bsh = gsh + 1024;
    f32x4 gv[4], bv[4];
    if (!ROUTER) {
#pragma unroll
        for (int j = 0; j < 4; ++j) { gv[j] = *(const f32x4*)(gam + F.lane * 4 + 256 * j); bv[j] = *(const f32x4*)(bet + F.lane * 4 + 256 * j); } }
    const unsigned char* wsb = F.ws; int ln = F.lane; unsigned lb4 = (unsigned)ln * 16u, lb2 = (unsigned)ln * 8u, lb1 = (unsigned)ln * 4u;
    const unsigned hb_off = (unsigned)((const unsigned char*)HB - wsb);
    const int nq = F.xok ? 6 : (NT / 4 + F.G * 8 - 1) / (F.G * 8);
    constexpr bool X32 = SRCIN || !RES_BF16;
    f32x4 xr32[4][4]; u32x2 xr16[4][4], hwr[4][4];
#define LN_ISSUE(row0_) do { const int _r0 = (row0_); \
        const unsigned char* xbase = SRCIN ? (_r0 < NTP ? (const unsigned char*)F.in[I_XP] : (const unsigned char*)F.in[I_XS] - (size_t)NTP * 4096) : wsb + WS_XF;      \
        if (X32) { _Pragma("unroll") for (int r = 0; r < 4; ++r) { const unsigned ro = (unsigned)(_r0 + r) * 4096u + lb4; _Pragma("unroll") for (int j = 0; j < 4; ++j) xr32[r][j] = *(const f32x4*)(xbase + ro + 1024u * j); } } \
        else { _Pragma("unroll") for (int r = 0; r < 4; ++r) { const unsigned ro = (unsigned)(_r0 + r) * 2048u + lb2; _Pragma("unroll") for (int j = 0; j < 4; ++j) xr16[r][j] = *(const u32x2*)(xbase + ro + 512u * j); } } \
        if (MODE == 0) { _Pragma("unroll") for (int r = 0; r < 4; ++r) { const unsigned ro = hb_off + (unsigned)(_r0 + r) * 2048u + lb2; _Pragma("unroll") for (int j = 0; j < 4; ++j) hwr[r][j] = *(const u32x2*)(wsb + ro + 512u * j); } } \
    } while (0)
#define LN_Q(qi_) (F.xok ? ((F.c & 7) * 1536 + (F.c >> 3) * 48 + F.wave * 6 + (qi_)) : (F.c * 8 + F.wave + (qi_) * F.G * 8))
    u32x4 sln = {~0u, ~0u, ~0u, ~0u};
    if (MODE == 1) { const int q0 = LN_Q(0); if (nq > 0 && q0 < NT / 4 && F.lane < 16) sln = *(const u32x4*)(wsb + (unsigned)(WS_SLOT + ((size_t)F.lane * NT + (size_t)q0 * 4) * 4)); }
    { const int q0 = LN_Q(0); if (nq > 0 && q0 < NT / 4) { LN_ISSUE(q0 * 4); } }
    for (int qi = 0; qi < nq; ++qi) {
        const int q = LN_Q(qi);
        if (q >= NT / 4) break;
        const int row0 = q * 4;
        const u32x4 slc = sln;
        if (MODE == 1) { const int qn = LN_Q(qi + 1); if (qi + 1 < nq && qn < NT / 4 && ln < 16) sln = *(const u32x4*)(wsb + (unsigned)(WS_SLOT + ((size_t)ln * NT + (size_t)qn * 4) * 4)); }
        asm volatile("v_mbcnt_lo_u32_b32 %0, -1, 0\n\tv_mbcnt_hi_u32_b32 %0, -1, %0" : "=v"(ln));
        lb4 = (unsigned)ln * 16u; lb2 = (unsigned)ln * 8u; lb1 = (unsigned)ln * 4u; const int lw = ln * 4;
        f32x4 v[4][4];
#pragma unroll
        for (int r = 0; r < 4; ++r)
#pragma unroll
            for (int j = 0; j < 4; ++j) {
                if (X32) v[r][j] = xr32[r][j];
                else { v[r][j][0] = __uint_as_float(xr16[r][j].x << 16); v[r][j][1] = __uint_as_float(xr16[r][j].x & 0xffff0000u); v[r][j][2] = __uint_as_float(xr16[r][j].y << 16); v[r][j][3] = __uint_as_float(xr16[r][j].y & 0xffff0000u); } }
        if (MODE == 0) {
#pragma unroll
            for (int r = 0; r < 4; ++r)
#pragma unroll
                for (int j = 0; j < 4; ++j) { v[r][j] = v[r][j] * ALPHA; add_bf16x4(v[r][j], hwr[r][j]); }
        }
        if (!ROUTER) { const int qn = LN_Q(qi + 1); if (qi + 1 < nq && qn < NT / 4) { LN_ISSUE(qn * 4); } }
        if (MODE == 0) {
        } else {
            const int grp = row0 >= NTP; int sl[4];
#pragma unroll
            for (int r = 0; r < 4; ++r) sl[r] = (ln < 16) ? (int)slc[r] : -1;
            unsigned long long mask[4]; bool any[4], two[4]; u32x2 wa[4][4], wb[4][4];
#pragma unroll
            for (int r = 0; r < 4; ++r) {
                unsigned long long mk = __ballot(sl[r] >= 0); any[r] = mk != 0ull;
                int e0 = 0, s0 = 0; if (any[r]) { e0 = __builtin_ctzll(mk); mk &= mk - 1; s0 = __builtin_amdgcn_readlane(sl[r], e0); }
                const unsigned y0 = any[r] ? (grp ? 65536u + e0 * 2048u + s0 : e0 * 4096u + s0) : 0u;
                two[r] = mk != 0ull; int e1 = 0, s1 = 0; if (two[r]) { e1 = __builtin_ctzll(mk); mk &= mk - 1; s1 = __builtin_amdgcn_readlane(sl[r], e1); }
                const unsigned y1 = two[r] ? (grp ? 65536u + e1 * 2048u + s1 : e1 * 4096u + s1) : y0;
                mask[r] = mk;
                const unsigned char* ya = wsb + PO_YE + (size_t)y0 * 2048; const unsigned char* yb = wsb + PO_YE + (size_t)y1 * 2048;
#pragma unroll
                for (int j = 0; j < 4; ++j) { wa[r][j] = *(const u32x2*)(ya + lb2 + 512u * j); wb[r][j] = *(const u32x2*)(yb + lb2 + 512u * j); }
            }
#pragma unroll
            for (int r = 0; r < 4; ++r) {
#pragma unroll
                for (int j = 0; j < 4; ++j) { v[r][j] = v[r][j] * ALPHA; if (any[r]) add_bf16x4(v[r][j], wa[r][j]); if (two[r]) add_bf16x4(v[r][j], wb[r][j]); }
                unsigned long long mk = mask[r];
                while (mk) {
                    const int e0 = __builtin_ctzll(mk); mk &= mk - 1; const int s0 = __builtin_amdgcn_readlane(sl[r], e0);
                    const unsigned y0 = grp ? 65536u + e0 * 2048u + s0 : e0 * 4096u + s0;
                    const bool tw = mk != 0ull; int e1 = 0, s1 = 0; if (tw) { e1 = __builtin_ctzll(mk); mk &= mk - 1; s1 = __builtin_amdgcn_readlane(sl[r], e1); }
                    const unsigned y1 = tw ? (grp ? 65536u + e1 * 2048u + s1 : e1 * 4096u + s1) : y0;
                    const unsigned char* ya = wsb + PO_YE + (size_t)y0 * 2048; const unsigned char* yb = wsb + PO_YE + (size_t)y1 * 2048;
                    u32x2 xa[4], xb[4];
#pragma unroll
                    for (int j = 0; j < 4; ++j) { xa[j] = *(const u32x2*)(ya + lb2 + 512u * j); xb[j] = *(const u32x2*)(yb + lb2 + 512u * j); }
#pragma unroll
                    for (int j = 0; j < 4; ++j) { add_bf16x4(v[r][j], xa[j]); if (tw) add_bf16x4(v[r][j], xb[j]); }
                }
            }
        }
#pragma unroll
        for (int r = 0; r < 4; ++r) {
            float s = 0.f;
#pragma unroll
            for (int j = 0; j < 4; ++j) s += (v[r][j][0] + v[r][j][1]) + (v[r][j][2] + v[r][j][3]);
            const float mean = wave_sum(s) * (1.f / D); float qq = 0.f;
#pragma unroll
            for (int j = 0; j < 4; ++j) { v[r][j] = v[r][j] - mean; qq += (v[r][j][0] * v[r][j][0] + v[r][j][1] * v[r][j][1]) + (v[r][j][2] * v[r][j][2] + v[r][j][3] * v[r][j][3]); }
            const float rstd = 1.f / sqrtf(wave_sum(qq) * (1.f / D) + LN_EPS);
#pragma unroll
            for (int j = 0; j < 4; ++j) { if (ROUTER) { gv[j] = *(const LAS f32x4*)(gsh + lw + 256 * j); bv[j] = *(const LAS f32x4*)(bsh + lw + 256 * j); } v[r][j] = v[r][j] * rstd * gv[j] + bv[j]; }
            const unsigned row = (unsigned)(row0 + r);
            if (FINAL) {
                unsigned char* ob = (unsigned char*)F.out;
#pragma unroll
                for (int j = 0; j < 4; ++j) *(f32x4*)(ob + (size_t)(row * 4096u + lb4 + 1024u * j)) = v[r][j];
            } else {
                unsigned char* wsw = F.ws;
#pragma unroll
                for (int j = 0; j < 4; ++j) {
                    if (RES_BF16) { u32x2 xo; xo.x = cvt_pk_bf16_c(v[r][j][0], v[r][j][1]); xo.y = cvt_pk_bf16_c(v[r][j][2], v[r][j][3]); *(u32x2*)(wsw + (unsigned)(WS_XF + row * 2048u + lb2 + 512u * j)) = xo; }
                    else *(f32x4*)(wsw + (unsigned)(WS_XF + row * 4096u + lb4 + 1024u * j)) = v[r][j];
                    *(unsigned*)(wsw + (unsigned)(WS_XB8 + row * 1024u + lb1 + 256u * j)) = cvt4_fp8(v[r][j][0] * FP8_SX, v[r][j][1] * FP8_SX, v[r][j][2] * FP8_SX, v[r][j][3] * FP8_SX); }
            }
        }
        if (ROUTER) {
            { const int qn = LN_Q(qi + 1); if (qi + 1 < nq && qn < NT / 4) { LN_ISSUE(qn * 4); } }
            float val[64];
#pragma unroll
            for (int hf = 0; hf < 4; ++hf) {
                f32x2 a2[4][4];
#pragma unroll
                for (int r = 0; r < 4; ++r)
#pragma unroll
                    for (int e4 = 0; e4 < 4; ++e4) a2[r][e4] = f32x2{0.f, 0.f};
#pragma unroll
                for (int e4 = 0; e4 < 4; ++e4)
#pragma unroll
                    for (int j = 0; j < 4; ++j) { const f32x4 w = *(const LAS f32x4*)(wrT + (hf * 4 + e4) * WRS + lw + 256 * j);
                        const f32x2 wl = f32x2{w[0], w[1]}, wh = f32x2{w[2], w[3]};
#pragma unroll
                        for (int r = 0; r < 4; ++r) { a2[r][e4] = f32x2{v[r][j][0], v[r][j][1]} * wl + a2[r][e4]; a2[r][e4] = f32x2{v[r][j][2], v[r][j][3]} * wh + a2[r][e4]; } }
#pragma unroll
                for (int r = 0; r < 4; ++r)
#pragma unroll
                    for (int e4 = 0; e4 < 4; ++e4) val[r * 16 + hf * 4 + e4] = a2[r][e4][0] + a2[r][e4][1];
            }
#pragma unroll
            for (int sft = 5; sft >= 0; --sft) { const int n2 = 1 << sft; const bool up = (ln >> sft) & 1;
#pragma unroll
                for (int i = 0; i < n2; ++i) { const float lo = val[i], hi = val[i + n2]; const float mine = up ? hi : lo, other = up ? lo : hi; val[i] = mine + __shfl_xor(other, n2); } }
            const float lg = val[0], m = row_max(lg);
            const float ex = expf(lg - m); const float l = row_sum(ex);
            *(float*)(F.ws + (unsigned)(WS_AFF + ((size_t)(ln & 15) * NT + row0 + (ln >> 4)) * 4)) = ex / l;
        }
    }
#undef LN_Q
#undef LN_ISSUE
    if (ROUTER) __syncthreads();
}
__device__ __forceinline__ void softmax_phase(Frame& F, bf16_t* SB) {
    for (int row = F.c * 8 + F.wave; row < NT * 4; row += F.G * 8) {
        u32x2* p = (u32x2*)(SB + (size_t)row * 256) + F.lane; const u32x2 w = *p;
        float a = __uint_as_float(w.x << 16), b = __uint_as_float(w.x & 0xffff0000u), c = __uint_as_float(w.y << 16), d = __uint_as_float(w.y & 0xffff0000u);
        const float m = wave_max(fmaxf(fmaxf(a, b), fmaxf(c, d)));
        a = __expf(a - m); b = __expf(b - m); c = __expf(c - m); d = __expf(d - m);
        const float inv = 1.f / wave_sum((a + b) + (c + d));
        u32x2 o; o.x = cvt_pk_bf16(a * inv, b * inv); o.y = cvt_pk_bf16(c * inv, d * inv); *p = o;
    }
}
__device__ __forceinline__ void moe_panel(int P, int& e, int& grp, int& yerow0) {
    if (P < 256) { e = P >> 4; grp = 0; } else { e = (P - 256) >> 3; grp = 1; }
    yerow0 = P * 256;
}
#ifndef UPWGM
#define UPWGM 8
#endif
struct SchedUp { unsigned char* ws; int G, c;
    __device__ __forceinline__ bool next(int i, GUnit& u) const { int P, pn; if (!static_unit<UPWGM>(i, G, c, 384, 16, P, pn)) return false; int e, grp, y0; moe_panel(P, e, grp, y0);
        u.A = (const char*)ws + WS_XB8 + (grp ? (size_t)NTP * 1024 : 0); u.B = (const char*)ws + WS_EW13 + ((size_t)e * 4096 + pn * BM) * 1024;
        u.C = (char*)ws + PO_HM + ((size_t)P * BM * 2048 + pn * HALF); u.X = (const int*)(ws + WS_IDX) + y0; u.pm = P; u.pn = pn; return true; } };
struct SchedDown { unsigned char* ws; int G, c;
    __device__ __forceinline__ bool next(int i, GUnit& u) const { int P, pn; if (!static_unit(i, G, c, 384, 4, P, pn)) return false; int e, grp, y0; moe_panel(P, e, grp, y0);
        u.A = (const char*)ws + PO_HM + (size_t)P * BM * 2048; u.B = (const char*)ws + WS_EW2 + ((size_t)e * 1024 + pn * BM) * 2048;
        u.C = (char*)ws + PO_YE + ((size_t)y0 * 1024 + pn * BM) * 2; u.X = (const float*)(ws + WS_GATE) + y0; u.pm = P; u.pn = pn; return true; } };
struct SchedQKV { unsigned char* ws; int G, c;
    __device__ __forceinline__ bool next(int i, GUnit& u) const { const int L = i * G + c; if (L >= 1536 + 768) return false;
        if (L < 1536) { int pm, pn; static_unit(i, G, c, 192, 8, pm, pn);
            u.A = (const char*)ws + WS_XB8 + (size_t)pm * BM * 1024; u.B = (const char*)ws + WS_WQKV + (size_t)pn * BM * 1024;
            u.C = (char*)ws + (pn < 4 ? PO_Q : PO_K) + ((size_t)pm * BM * 1024 + (pn & 3) * BM) * 2; u.X = nullptr; u.pm = pm; u.pn = pn; return true; }
        const int r = L - 1536, pmv = r & 3, pnv = r >> 2;
        u.A = (const char*)ws + WS_WQKV + (size_t)(2048 + pmv * BM) * 1024; u.B = (const char*)ws + WS_XB8 + (size_t)pnv * BM * 1024;
        u.C = (char*)ws + PO_VT + ((size_t)pmv * BM * NT + (size_t)pnv * BM) * 2; u.X = nullptr; u.pm = pmv; u.pn = 8 + pnv; return true; } };
struct EpiQKV {
    static constexpr bool PERM = true;
    __device__ __forceinline__ void operator()(const Acc& acc, const GUnit& u, int wr, int wc, int fr, int fq) const {
        constexpr float ds = 1.f / (FP8_SX * FP8_SWQKV);
        if (u.pn >= 8) { EpiBf<false> e{(unsigned)NT, ds}; e(acc, u, wr, wc, fr, fq); }
        else { EpiBf<false> e{1024u, u.pn < 4 ? 0.125f * 1.4426950408889634f * ds : ds}; e(acc, u, wr, wc, fr, fq); }
    }
};

__device__ __forceinline__ int wave_sum_i(int v) {
#pragma unroll
    for (int o = 1; o < 64; o <<= 1) v += __shfl_xor(v, o);
    return v;
}
__device__ __forceinline__ int block_excl_scan(int v, int lane, int wave, LAS int* red, int& total) {
    int inc = v;
#pragma unroll
    for (int o = 1; o < 64; o <<= 1) { const int t = __shfl_up(inc, o); if (lane >= o) inc += t; }
    __syncthreads();
    if (lane == 63) red[wave] = inc;
    __syncthreads();
    int off = 0, tot = 0;
#pragma unroll
    for (int w = 0; w < 8; ++w) { const int c = red[w]; if (w < wave) off += c; tot += c; }
    total = tot; return off + inc - v;
}
template <int PER>
__device__ __forceinline__ void select_fast(Frame& F, const float* affcol, int cap, int* idx_out, float* gate_out, int* slotcol) {
    LAS int* red = (LAS int*)F.lds;
    unsigned key[PER];
#pragma unroll
    for (int i = 0; i < PER / 4; ++i) { const u32x4 v = ((const u32x4*)(affcol + (size_t)F.tid * PER))[i]; key[4 * i] = v.x; key[4 * i + 1] = v.y; key[4 * i + 2] = v.z; key[4 * i + 3] = v.w; }
    unsigned T = 0u;
    for (int b = 30; b >= 0; --b) {
        const unsigned cand = T | (1u << b); int cnt = 0;
#pragma unroll
        for (int i = 0; i < PER; ++i) cnt += (key[i] >= cand) ? 1 : 0;
        cnt = wave_sum_i(cnt);
        LAS int* r = red + (b & 1) * 8;
        if (F.lane == 0) r[F.wave] = cnt;
        __syncthreads();
        int tot = 0;
#pragma unroll
        for (int w = 0; w < 8; ++w) tot += r[w];
        if (tot >= cap) T = cand;
    }
    int g = 0, q = 0;
#pragma unroll
    for (int i = 0; i < PER; ++i) { g += (key[i] > T) ? 1 : 0; q += (key[i] == T) ? 1 : 0; }
    int tot_g, tot_q; (void)tot_q;
    const int Eoff = block_excl_scan(q, F.lane, F.wave, red + 32, tot_q);
    int dummy; const int Goff = block_excl_scan(g, F.lane, F.wave, red + 32, tot_g); (void)Goff;
    const int need_eq = cap - tot_g;
    int eq_take = need_eq - Eoff; eq_take = eq_take < 0 ? 0 : (eq_take > q ? q : eq_take);
    const int base = block_excl_scan(g + eq_take, F.lane, F.wave, red + 32, dummy);
    int slot = base, eqseen = 0;
    const int tok0 = F.tid * PER;
#pragma unroll
    for (int i4 = 0; i4 < PER / 4; ++i4) { int so[4];
#pragma unroll
        for (int j = 0; j < 4; ++j) { const int i = 4 * i4 + j; const unsigned k = key[i]; bool sel = k > T; if (k == T) { sel = eqseen < eq_take; ++eqseen; }
            so[j] = sel ? slot : -1; if (sel) { idx_out[slot] = tok0 + i; gate_out[slot] = __uint_as_float(k); ++slot; } }
        ((int4*)(slotcol + tok0))[i4] = make_int4(so[0], so[1], so[2], so[3]); }
}
__device__ __forceinline__ void select_phase(Frame& F) {
    for (int it = F.c; it < 32; it += F.G) {
        const int grp = it >> 4, e = it & 15; const int n = grp ? NTS : NTP, cap = n / 8;
        const float* affcol = (const float*)(F.ws + WS_AFF) + (size_t)e * NT + (grp ? NTP : 0);
        int* idx = (int*)(F.ws + WS_IDX) + (grp ? 65536 : 0) + e * cap; float* gate = (float*)(F.ws + WS_GATE) + (grp ? 65536 : 0) + e * cap;
        int* slotcol = (int*)(F.ws + WS_SLOT) + (size_t)e * NT + (grp ? NTP : 0);
        __syncthreads();
        if (grp == 0) select_fast<64>(F, affcol, cap, idx, gate, slotcol); else select_fast<32>(F, affcol, cap, idx, gate, slotcol);
        __syncthreads();
    }
}

__device__ __forceinline__ void natten_fill(Frame& F, const float* rpb) {
    LAS float* rpbs = (LAS float*)F.lds;
    __syncthreads();
    for (int i = F.tid; i < 16 * 15 * 31; i += 512) rpbs[i] = rpb[i] * 1.4426950408889634f;
    __syncthreads();
}
__device__ __forceinline__ void natten_phase(Frame& F, const float* rpb) {
    const bf16_t* Kb = (const bf16_t*)(F.ws + PO_K); const bf16_t* VT = (const bf16_t*)(F.ws + PO_VT); bf16_t* QO = (bf16_t*)(F.ws + PO_Q);
    LAS float* rpbs = (LAS float*)F.lds;
    const int lane = F.lane, w = F.wave, fr = lane & 15, fq = lane >> 4;
    bool c0[4], c2[4]; int xe[4];
#pragma unroll
    for (int e = 0; e < 4; ++e) { xe[e] = 4 * fq + e - fr; c0[e] = xe[e] >= 8; c2[e] = xe[e] < -8; }
    const bool fA = fr < 8, fC = fr > 8;
    LAS bf16_t* Ks = (LAS bf16_t*)(F.lds + 32768); LAS bf16_t* Vs = Ks + 2 * 64 * 72;
    const int lrow = F.tid >> 3, lchk = F.tid & 7;
    for (int blk = F.c; blk < 1536; blk += F.G) {
        int gb, h, rb, rows;
        if (blk < 1024) { gb = blk >> 8; h = (blk >> 4) & 15; rb = blk & 15; rows = 128; } else { const int V = blk - 1024; gb = 4 + (V >> 7); h = (V >> 3) & 15; rb = V & 7; rows = 64; }
        const int r = rb * 8 + w;
        int rs = r - 4; rs = rs < 0 ? 0 : (rs > rows - 8 ? rows - 8 : rs);
        int kr_lo = rb * 8 - 4; kr_lo = kr_lo < 0 ? 0 : (kr_lo > rows - 8 ? rows - 8 : kr_lo);
        int kr_hi = rb * 8 + 7 - 4; kr_hi = (kr_hi < 0 ? 0 : (kr_hi > rows - 8 ? rows - 8 : kr_hi)) + 8;
        const size_t tb = (size_t)gb_tok0(gb), tq0 = tb + (size_t)r * 64;
        bf16x8 Qf[4][2];
        float mrun[4], lrun[4]; f32x4 Ot[4][4];
#pragma unroll
        for (int qt = 0; qt < 4; ++qt) { mrun[qt] = -INFINITY; lrun[qt] = 0.f;
#pragma unroll
            for (int dt = 0; dt < 4; ++dt) Ot[dt][qt] = (f32x4){0.f, 0.f, 0.f, 0.f}; }
        const bf16_t* kg = Kb + (tb + (size_t)kr_lo * 64 + lrow) * D + h * 64 + lchk * 8; const bf16_t* vg = VT + (size_t)(h * 64 + lrow) * NT + tb + (size_t)kr_lo * 64 + lchk * 8;
        const int nrows = kr_hi - kr_lo;
#define NA_LOAD(dst, ptr) asm volatile("global_load_dwordx4 %0, %1, off" : "=&v"(dst) : "v"(ptr) : "memory")
        u32x4 kA, vA, kB, vB;
        { const u32x4 k0r = *(const u32x4*)kg, v0r = *(const u32x4*)vg;
#pragma unroll
          for (int t = 0; t < 4; ++t)
#pragma unroll
              for (int ks = 0; ks < 2; ++ks) Qf[t][ks] = *(const bf16x8*)(QO + (tq0 + 16 * t + fr) * D + h * 64 + 32 * ks + 8 * fq);
          { const bf16_t* kp = kg + (size_t)64 * D; const bf16_t* vp = vg + 64; NA_LOAD(kB, kp); NA_LOAD(vB, vp); }
          __syncthreads();
          *(LAS u32x4*)(Ks + lrow * 72 + lchk * 8) = k0r; *(LAS u32x4*)(Vs + lrow * 72 + lchk * 8) = v0r; }
#pragma unroll
        for (int t = 0; t < 4; ++t)
#pragma unroll
            for (int ks = 0; ks < 2; ++ks) asm volatile("" :: "v"(Qf[t][ks]));
        asm volatile("s_waitcnt vmcnt(0)" ::: "memory");
        __syncthreads();
#pragma nounroll
        for (int i2 = 0; i2 < nrows; i2 += 2) {
#pragma unroll
          for (int jj = 0; jj < 2; ++jj) {
            const int i = i2 + jj; if (i >= nrows) break;
            const int kr = kr_lo + i; const int buf = jj; const bool more = i + 1 < nrows, more2 = i + 2 < nrows;
            if (more2) { const bf16_t* kp = kg + (size_t)(i + 2) * 64 * D; const bf16_t* vp = vg + (size_t)(i + 2) * 64;
                if (jj == 1) { NA_LOAD(kB, kp); NA_LOAD(vB, vp); } else { NA_LOAD(kA, kp); NA_LOAD(vA, vp); } }
            if (kr >= rs && kr < rs + 8) {
            const int dr = kr - r + 7;
            const LAS bf16_t* Kt = Ks + buf * (64 * 72); const LAS bf16_t* Vt = Vs + buf * (64 * 72);
            bf16x8 Kf[4][2];
#pragma unroll
            for (int t = 0; t < 4; ++t)
#pragma unroll
                for (int ks = 0; ks < 2; ++ks) Kf[t][ks] = *(const LAS bf16x8*)(Kt + (16 * t + fr) * 72 + 32 * ks + 8 * fq);
            float bsel[3][4];
#pragma unroll
            for (int e = 0; e < 4; ++e) { const int dcB = xe[e] + 15 + (c0[e] ? -16 : (c2[e] ? 16 : 0)), dcA = fA ? xe[e] + 15 : dcB, dcC = fC ? xe[e] + 15 : dcB;
                bsel[0][e] = rpbs[(h * 15 + dr) * 31 + dcA]; bsel[1][e] = rpbs[(h * 15 + dr) * 31 + dcB]; bsel[2][e] = rpbs[(h * 15 + dr) * 31 + dcC]; }
            bf16x8 Pf[4][2]; float alpha[4]; bool moved = false;
#pragma unroll
            for (int qt = 0; qt < 4; ++qt) {
                f32x4 St[3];
#pragma unroll
                for (int dk = 0; dk < 3; ++dk) { const int kt = qt + dk - 1; St[dk] = (f32x4){0.f, 0.f, 0.f, 0.f};
                    if (kt >= 0 && kt < 4) { St[dk] = __builtin_amdgcn_mfma_f32_16x16x32_bf16(Kf[kt][0], Qf[qt][0], St[dk], 0, 0, 0); St[dk] = __builtin_amdgcn_mfma_f32_16x16x32_bf16(Kf[kt][1], Qf[qt][1], St[dk], 0, 0, 0); } }
                constexpr int dummy = 0; (void)dummy;
                const int cls = qt == 0 ? 0 : (qt == 3 ? 2 : 1);
                float sv[4]; bool u0[4], u2[4]; float mx = -INFINITY;
#pragma unroll
                for (int e = 0; e < 4; ++e) { u0[e] = c0[e] && !(cls == 0 && fA) && !(cls == 2 && fC) && (qt > 0); u2[e] = c2[e] && !(cls == 0 && fA) && !(cls == 2 && fC) && (qt < 3);
                    sv[e] = (u0[e] ? St[0][e] : (u2[e] ? St[2][e] : St[1][e])) + bsel[cls][e]; mx = fmaxf(mx, sv[e]); }
                mx = x32_max(x16_max(mx));
                const float mnew = fmaxf(mrun[qt], mx); alpha[qt] = __builtin_amdgcn_exp2f(mrun[qt] - mnew); moved = moved || (mnew != mrun[qt]); mrun[qt] = mnew;
                float l = 0.f, p[4];
#pragma unroll
                for (int e = 0; e < 4; ++e) { p[e] = __builtin_amdgcn_exp2f(sv[e] - mnew); l += p[e]; }
                l = x32_sum(x16_sum(l)); lrun[qt] = lrun[qt] * alpha[qt] + l;
                float pv[4][4];
#pragma unroll
                for (int kt = 0; kt < 4; ++kt)
#pragma unroll
                    for (int e = 0; e < 4; ++e) { const int dk = kt - qt + 1; float v = 0.f; if (dk == 0) v = u0[e] ? p[e] : 0.f; else if (dk == 2) v = u2[e] ? p[e] : 0.f; else if (dk == 1) v = (u0[e] || u2[e]) ? 0.f : p[e]; pv[kt][e] = v; }
#pragma unroll
                for (int ks = 0; ks < 2; ++ks) { u32x4 wv; wv.x = cvt_pk_bf16_c(pv[2 * ks][0], pv[2 * ks][1]); wv.y = cvt_pk_bf16_c(pv[2 * ks][2], pv[2 * ks][3]); wv.z = cvt_pk_bf16_c(pv[2 * ks + 1][0], pv[2 * ks + 1][1]); wv.w = cvt_pk_bf16_c(pv[2 * ks + 1][2], pv[2 * ks + 1][3]);
                    Pf[qt][ks] = __builtin_bit_cast(bf16x8, wv); }
            }
            const bool rescale = __ballot(moved) != 0ull;
#pragma unroll
            for (int dt = 0; dt < 4; ++dt) {
                if (rescale) {
#pragma unroll
                    for (int qt = 0; qt < 4; ++qt) Ot[dt][qt] = Ot[dt][qt] * alpha[qt]; }
#pragma unroll
                for (int ks = 0; ks < 2; ++ks) { const u32x2 v0 = *(const LAS u32x2*)(Vt + (16 * dt + fr) * 72 + 32 * ks + 4 * fq), v1 = *(const LAS u32x2*)(Vt + (16 * dt + fr) * 72 + 32 * ks + 16 + 4 * fq);
                    u32x4 vv; vv.x = v0.x; vv.y = v0.y; vv.z = v1.x; vv.w = v1.y; const bf16x8 Vf = __builtin_bit_cast(bf16x8, vv);
#pragma unroll
                    for (int qt = 0; qt < 4; ++qt) { if ((qt == 0 && ks == 1) || (qt == 3 && ks == 0)) continue; Ot[dt][qt] = __builtin_amdgcn_mfma_f32_16x16x32_bf16(Vf, Pf[qt][ks], Ot[dt][qt], 0, 0, 0); } }
            }
            }
            if (more) {
                if (more2) asm volatile("s_waitcnt vmcnt(2)" ::: "memory"); else asm volatile("s_waitcnt vmcnt(0)" ::: "memory");
                LAS bf16_t* kd = Ks + (buf ^ 1) * (64 * 72) + lrow * 72 + lchk * 8; LAS bf16_t* vd = Vs + (buf ^ 1) * (64 * 72) + lrow * 72 + lchk * 8;
                if (jj == 1) { asm volatile("" : "+v"(kA), "+v"(vA)); *(LAS u32x4*)kd = kA; *(LAS u32x4*)vd = vA; } else { asm volatile("" : "+v"(kB), "+v"(vB)); *(LAS u32x4*)kd = kB; *(LAS u32x4*)vd = vB; }
            }
            __syncthreads();
          }
        }
#undef NA_LOAD
#pragma unroll
        for (int qt = 0; qt < 4; ++qt) { const float inv = 1.f / lrun[qt];
#pragma unroll
            for (int dt = 0; dt < 4; ++dt) { const f32x4 o = Ot[dt][qt] * inv; u32x2 wv; wv.x = cvt_pk_bf16_c(o[0], o[1]); wv.y = cvt_pk_bf16_c(o[2], o[3]);
                pst8(QO + (tq0 + 16 * qt + fr) * D + h * 64 + 16 * dt + 4 * fq, wv); } }
    }
    __syncthreads();
}
constexpr int N_PHASES = 31;
constexpr int FLAG_NO_XIMPORT = 1, FLAG_NO_EXPERTS0 = 2;
constexpr int CV_P1 = 3072, CV_P2 = CV_P1 + 1536, CV_SEL = CV_P2 + 5376, CV_SEL1 = 5376, CV_P0B = CV_SEL + 5632;
__global__ void __launch_bounds__(512, 2) fwd(Args args) {
    extern __shared__ __attribute__((aligned(16))) unsigned char lds_raw[];
    Frame F; F.lds = (LAS unsigned char*)lds_raw; F.ws = args.ws; F.in = args.in; F.out = args.out;
    F.tid = threadIdx.x; F.lane = F.tid & 63; F.wave = __builtin_amdgcn_readfirstlane(F.tid >> 6); F.G = gridDim.x; F.c = blockIdx.x; F.xok = false;
    unsigned char* ws = args.ws;
    const int wave_s = __builtin_amdgcn_readfirstlane(threadIdx.x >> 6);
    for (int u = F.tid; u < (LDS_BYTES - RING_BYTES) / 4; u += 512) ((LAS unsigned*)(F.lds + RING_BYTES))[u] = 0u;
    __syncthreads();
    const int lo = args.ph_lo, hi = args.ph_hi;
    volatile LAS unsigned* MISC = (volatile LAS unsigned*)(F.lds + MISC_OFF);
    XcdBarrier bar; bar.bar = (unsigned*)(ws + WS_CTL) + CW_BAR + args.pad * XCD_BAR_WORDS_EXT; bar.x = 0; bar.st = nullptr;
    const bool multi = (hi - lo) > 1;
    if (multi) bar = xcd_barrier_post((unsigned*)(ws + WS_CTL) + CW_BAR + args.pad * XCD_BAR_WORDS_EXT, MISC + 8);
#define IN(k) (lo <= (k) && (k) < hi)
#ifdef STAMP_PA
    unsigned long long* TS = (unsigned long long*)(ws + WS_CTL + 40 * 1024);
#define STAMP(k) do { if (blockIdx.x == 0 && threadIdx.x == 0) TS[k] = __builtin_amdgcn_s_memrealtime(); } while (0)
#else
#define STAMP(k) do { } while (0)
#endif
#ifdef AMP_PHASE
    unsigned long long t_phase0 = 0ull;
#define AMP_NOW(t) asm volatile("s_memrealtime %0\n\ts_waitcnt lgkmcnt(0)" : "=s"(t) :: "memory")
#define AMP_T0() do { AMP_NOW(t_phase0); } while (0)
#define AMP_WAIT(k) do { if ((k) == AMP_PHASE || AMP_PHASE < 0) { asm volatile("s_waitcnt vmcnt(0) lgkmcnt(0)" ::: "memory"); unsigned long long _t1; AMP_NOW(_t1); const unsigned long long _tw = _t1 + (unsigned long long)AMP_M * (_t1 - t_phase0); unsigned long long _tn; do { __builtin_amdgcn_s_sleep(4); AMP_NOW(_tn); } while (_tn < _tw); } } while (0)
#else
#define AMP_T0() do { } while (0)
#define AMP_WAIT(k) do { } while (0)
#endif
#define SEAM(k) do { AMP_WAIT(k); if (IN(k) && IN((k) + 1)) { xcd_barrier(bar, wave_s); STAMP((k) + 1); } } while (0)
    STAMP(0);
    LAS unsigned char* ring = F.lds;
#define PHASE_BEGIN() do { int _t; asm volatile("v_mbcnt_lo_u32_b32 %0, -1, 0\n\tv_mbcnt_hi_u32_b32 %0, -1, %0" : "=v"(_t)); _t |= (wave_s << 6); F.tid = _t; F.lane = _t & 63; F.wave = wave_s; AMP_T0(); } while (0)

#ifndef P0_SKIP
#define P0_SKIP 0
#endif
    if (IN(0)) { PHASE_BEGIN(); const int p0s = (args.pad == 1) ? P0_SKIP : 0;
        if (!(p0s & 1)) for (int it = F.c; it < 128; it += F.G) s5_build_item(F, it >> 1, it & 1);
        if (!(p0s & 2)) convert_small_weights(F);
        if (!(p0s & 4)) if (!(args.flags & FLAG_NO_EXPERTS0)) { convert_expert_weights(F, 0, CV_SEL, CV_P0B, 128);
            convert_expert_weights(F, 0, CV_P0B, 16 * 1536, 0); }
        if (!(p0s & 8)) { convert_plain(F, args.in[I_MWQ], (bf16_t*)(ws + WS_MWQ), (size_t)2 * 1024 * 1024);
        convert_plain(F, args.in[I_MEMP], (bf16_t*)(ws + WS_MEMB), (size_t)4 * 256 * 1024);
        convert_plain(F, args.in[I_MEMS], (bf16_t*)(ws + WS_MEMB) + (size_t)4 * 256 * 1024, (size_t)4 * 256 * 1024); }
        if (!(p0s & 16)) import_x(F, !(args.flags & FLAG_NO_XIMPORT));
    }
    SEAM(0);
    unsigned nloc_s = 32u;
    if (multi && IN(0) && IN(1)) {
        if (F.tid == 0) { unsigned ok = (F.G == 256) ? 1u : 0u; unsigned* bw = bar.bar;
            for (unsigned j = 0; j < 16; ++j) { const unsigned cnt = xb_ld(&bw[XB_XCNT(j)]); if (j < 8 ? cnt != 32u : cnt != 0u) ok = 0u; }
            MISC[13] = ok; }
        __syncthreads();
        if (MISC[13]) { F.xok = true; F.c = (int)(MISC[12] * 8u + bar.x); }
    }
#define LSEAM(k) do { AMP_WAIT(k); if (IN(k) && IN((k) + 1)) { if (F.xok) xcd_local_barrier(bar, wave_s, nloc_s); else xcd_barrier(bar, wave_s); STAMP((k) + 1); } } while (0)
    {
        const float* lng = args.in[I_LNG]; const float* lnb = args.in[I_LNB];
        if (IN(1)) { PHASE_BEGIN();
            { SchedKV S{ws, F.G, F.c}; EpiBf<false> E{2048u, 1.f}; gemm_phase<EpiBf<false>, SchedKV, false>(ring, F.tid, 1024, 2048u, 2048u, S, E); }
            { SchedUA S{(const char*)ws + WS_XB, (const char*)ws + WS_WIN, (char*)ws + PO_UA, F.G, F.c}; EpiUA E; gemm_phase<EpiUA, SchedUA, false>(ring, F.tid, 1024, 2048u, 2048u, S, E); }
            if (!(args.flags & FLAG_NO_EXPERTS0)) convert_expert_weights(F, 0, 0, CV_P1, 128);
        }
        SEAM(1);
        if (IN(2)) { PHASE_BEGIN();
            { SchedSA S{ws, F.G, F.c}; EpiS E; gemm_phase<EpiS, SchedSA, false>(ring, F.tid, 512, (unsigned)(UAK * 2), 1024u, S, E); }
            { SchedWqk S{ws, F.G, F.c}; EpiBf8 E{1024u, 0.0625f * 1.4426950408889634f * FP8_SWQK}; gemm_phase<EpiBf8, SchedWqk, false>(ring, F.tid, 256, 4096u, 2048u, S, E); }
            { SchedWvo S{ws, F.G, F.c}; EpiBf<false> E{1024u, 1.f}; gemm_phase<EpiBf<false>, SchedWvo, false>(ring, F.tid, 256, 2048u, 4096u, S, E); }
            if (!(args.flags & FLAG_NO_EXPERTS0)) convert_expert_weights(F, 0, CV_P1, CV_P2, 128);
        }
        SEAM(2);
        if (IN(3)) { PHASE_BEGIN(); s5_recurrence(F); }
        SEAM(3);
        if (IN(4)) { PHASE_BEGIN(); SchedSC S{ws, F.G, F.c}; EpiGelu E; gemm_phase<EpiGelu, SchedSC, false>(ring, F.tid, UAK, (unsigned)(UAK * 2), (unsigned)(UAK * 2), S, E); }
        SEAM(4);
        if (IN(5)) { PHASE_BEGIN(); SchedGated S{(const char*)ws + PO_SG, (const char*)ws + WS_WGLU, (char*)ws + PO_HB_S5, 2048, 2048, 1024, NT / BM, 8, F.G, F.c}; EpiGated<0> E{1024u};
            gemm_phase<EpiGated<0>, SchedGated, false>(ring, F.tid, 1024, 2048u, 2048u, S, E); }
        LSEAM(5);
        if (IN(6)) { PHASE_BEGIN(); if (args.flags & FLAG_NO_XIMPORT) ln_phase<0, false, false, false>(F, (const bf16_t*)(ws + PO_HB_S5), lng, lnb, nullptr); else ln_phase<0, false, false, true>(F, (const bf16_t*)(ws + PO_HB_S5), lng, lnb, nullptr); }
        LSEAM(6);
    }
#define COMMON_BLOCK(layer, pb) do { \
        const float* lng = args.in[I_LNG] + (size_t)(layer) * 3 * D; const float* lnb = args.in[I_LNB] + (size_t)(layer) * 3 * D; \
        if (IN((pb) + 0)) { PHASE_BEGIN(); SchedScores8 S{(const char*)ws + WS_XB8, (const char*)ws + WS_WQK + (size_t)(layer) * 8 * MiB, (char*)ws + PO_SB, F.G, F.c}; EpiSoftmax E{(LAS float*)(F.lds + RING_BYTES + 4096), 1024u, 1.f / (FP8_SX * FP8_SWQK)}; \
            gemm_phase<EpiSoftmax, SchedScores8, false, true>(ring, F.tid, 512, 1024u, 1024u, S, E); } \
        AMP_WAIT((pb) + 0); if (IN((pb) + 0) && IN((pb) + 2)) { if (F.xok) xcd_local_barrier(bar, wave_s, nloc_s); else xcd_barrier(bar, wave_s); STAMP((pb) + 1); }     \
        if (IN((pb) + 2)) { PHASE_BEGIN(); SchedBatchW S{(const char*)ws + PO_SB, (const char*)ws + WS_WVO + (size_t)(layer) * 16 * MiB, (char*)ws + PO_HB_MEM, F.G, F.c}; EpiBf<false> E{1024u, 1.f}; \
            gemm_phase<EpiBf<false>, SchedBatchW, false>(ring, F.tid, 1024, 2048u, 2048u, S, E); } \
        if (IN((pb) + 3)) { PHASE_BEGIN(); ln_router_fill(F, lng + D, lnb + D, args.in[I_EWR] + (size_t)(layer) * D * 16); }     \
        LSEAM((pb) + 2); \
        if (IN((pb) + 3)) { PHASE_BEGIN(); ln_phase<0, true, false>(F, (const bf16_t*)(ws + PO_HB_MEM), lng + D, lnb + D, args.in[I_EWR] + (size_t)(layer) * D * 16); } \
        SEAM((pb) + 3); \
        if (IN((pb) + 4)) { PHASE_BEGIN(); select_phase(F); if ((layer) == 0) { if (!(args.flags & FLAG_NO_EXPERTS0)) convert_expert_weights(F, 0, CV_P2, CV_SEL, 32); } else convert_expert_weights(F, 1, 0, CV_SEL1, 32); } \
        SEAM((pb) + 4); \
        if (IN((pb) + 5)) { PHASE_BEGIN(); SchedUp S{ws, F.G, F.c}; EpiGated8 E{2048u}; gemm_phase<EpiGated8, SchedUp, true, true>(ring, F.tid, 512, 1024u, 1024u, S, E); } \
        SEAM((pb) + 5); \
        if (IN((pb) + 6)) { PHASE_BEGIN(); SchedDown S{ws, F.G, F.c}; EpiBf<true> E{1024u, 1.f / (FP8_SH * FP8_SW2)}; gemm_phase<EpiBf<true>, SchedDown, false, true>(ring, F.tid, 1024, 2048u, 2048u, S, E); } \
        AMP_WAIT((pb) + 6); if (IN((pb) + 6) && IN((pb) + 9)) { xcd_barrier(bar, wave_s); STAMP((pb) + 9); }     \
    } while (0)
    COMMON_BLOCK(0, 7);
    if (IN(16)) { PHASE_BEGIN(); ln_phase<1, false, false>(F, nullptr, args.in[I_LNG] + 2 * D, args.in[I_LNB] + 2 * D, nullptr); convert_expert_weights(F, 1, CV_SEL1, 16 * 1536, 0); }
    SEAM(16);
    {
        const float* lng = args.in[I_LNG] + 3 * D; const float* lnb = args.in[I_LNB] + 3 * D;
        if (IN(17)) { PHASE_BEGIN(); SchedQKV S{ws, F.G, F.c}; EpiQKV E; gemm_phase<EpiQKV, SchedQKV, false, true>(ring, F.tid, 512, 1024u, 1024u, S, E); }
        if (IN(18)) { PHASE_BEGIN(); natten_fill(F, args.in[I_BRPB]); }
        SEAM(17);
        if (IN(18)) { PHASE_BEGIN(); natten_phase(F, args.in[I_BRPB]); }
        SEAM(18);
        if (IN(19)) { PHASE_BEGIN(); SchedPlain S{(const char*)ws + PO_Q, (const char*)ws + WS_WO, (char*)ws + PO_HB_NA, 2048, 2048, 1024, NT / BM, 4, F.G, F.c}; EpiBf<false> E{1024u, 1.f};
            gemm_phase<EpiBf<false>, SchedPlain, false>(ring, F.tid, 1024, 2048u, 2048u, S, E); }
        LSEAM(19);
        if (IN(20)) { PHASE_BEGIN(); ln_phase<0, false, false>(F, (const bf16_t*)(ws + PO_HB_NA), lng, lnb, nullptr); }
        LSEAM(20);
    }
    COMMON_BLOCK(1, 21);
    if (IN(30)) { PHASE_BEGIN(); ln_phase<1, false, true>(F, nullptr, args.in[I_LNG] + 5 * D, args.in[I_LNB] + 5 * D, nullptr); }
    AMP_WAIT(30);
#undef COMMON_BLOCK
#ifdef STAMP_PA
    xcd_barrier(bar, wave_s); STAMP(31); xcd_barrier(bar, wave_s);
    {
        const volatile unsigned long long* T = TS; const float dA = (float)(T[STAMP_PA + STAMP_NA] - T[STAMP_PA]) * 0.01f, dB = (float)(T[STAMP_PB + STAMP_NB] - T[STAMP_PB]) * 0.01f;
        const float c = sqrtf(100.f * dA), V = 100.f * dB; const size_t np = (size_t)NTP * 1024, n = (size_t)NT * 1024;
        for (size_t i = (size_t)blockIdx.x * 512 + threadIdx.x; i < n; i += (size_t)gridDim.x * 512) args.out[i] = i < np ? c : (i == np ? V : 0.f);
    }
#endif
#undef IN
#undef SEAM
}
}
#ifndef DBG
#define DBG 0
#endif
#ifndef FZ_PER_PHASE
#define FZ_PER_PHASE 0
#endif

#if DBG
namespace dbg {
__global__ void k_cmp_bf16_f32(const unsigned short* a, const float* b, size_t n, double* acc) {
    double s0 = 0, s1 = 0;
    for (size_t i = (size_t)blockIdx.x * blockDim.x + threadIdx.x; i < n; i += (size_t)gridDim.x * blockDim.x) { const double x = (double)__uint_as_float(((unsigned)a[i]) << 16), y = b[i]; s0 += (x - y) * (x - y); s1 += y * y; }
    for (int o = 32; o >= 1; o >>= 1) { s0 += __shfl_xor(s0, o); s1 += __shfl_xor(s1, o); }
    if ((threadIdx.x & 63) == 0) { atomicAdd(acc, s0); atomicAdd(acc + 1, s1); }
}
__global__ void k_cmp_f32_f32(const float* a, const float* b, size_t n, double* acc) {
    double s0 = 0, s1 = 0;
    for (size_t i = (size_t)blockIdx.x * blockDim.x + threadIdx.x; i < n; i += (size_t)gridDim.x * blockDim.x) { const double x = a[i], y = b[i]; s0 += (x - y) * (x - y); s1 += y * y; }
    for (int o = 32; o >= 1; o >>= 1) { s0 += __shfl_xor(s0, o); s1 += __shfl_xor(s1, o); }
    if ((threadIdx.x & 63) == 0) { atomicAdd(acc, s0); atomicAdd(acc + 1, s1); }
}
__global__ void k_cmp_ua(const unsigned short* UA, const float* u, double* acc) {
    double s0 = 0, s1 = 0;
    for (size_t i = (size_t)blockIdx.x * blockDim.x + threadIdx.x; i < (size_t)fz::NT * 1024; i += (size_t)gridDim.x * blockDim.x) {
        const int tok = (int)(i >> 10), ch = (int)(i & 1023), chunk = tok >> 5, j = tok & 31, g = ch >> 4, h = ch & 15;
        const double x = (double)__uint_as_float(((unsigned)UA[((size_t)g * fz::NCHUNK + chunk) * fz::UAK + j * 16 + h]) << 16), y = u[i]; s0 += (x - y) * (x - y); s1 += y * y; }
    for (int o = 32; o >= 1; o >>= 1) { s0 += __shfl_xor(s0, o); s1 += __shfl_xor(s1, o); }
    if ((threadIdx.x & 63) == 0) { atomicAdd(acc, s0); atomicAdd(acc + 1, s1); }
}
__global__ void k_encode(float* out, const double* accA, const double* accB) {
    const double vA = accA[1] > 0 ? sqrt(accA[0] / accA[1]) : 9.99; const double vB = accB[1] > 0 ? sqrt(accB[0] / accB[1]) : 9.99;
    const float c = (float)sqrt(1e8 * (vA == vA ? vA : 7.77)); const float V = (float)(1e5 * (vB == vB ? vB : 7.77));
    const size_t np = (size_t)fz::NTP * 1024, n = (size_t)fz::NT * 1024;
    for (size_t i = (size_t)blockIdx.x * blockDim.x + threadIdx.x; i < n; i += (size_t)gridDim.x * blockDim.x) out[i] = i < np ? c : (i == np ? V : 0.f);
}
}
#endif

extern "C" void kernel_launch(void* const* d_in, const int* in_sizes, int n_in, void* d_out, int out_size, void* d_ws, size_t ws_size, hipStream_t stream) {
    using namespace fz;
    static int grid = 0;
    if (grid == 0) {
        if (n_in != 26 || ws_size < WS_END) { fprintf(stderr, "kernel_launch: unexpected inputs (n_in %d, ws %zu)\n", n_in, ws_size); grid = -1; return; }
        int dev = 0, cus = 0, per_cu = 0;
        if (hipGetDevice(&dev) != hipSuccess || hipDeviceGetAttribute(&cus, hipDeviceAttributeMultiprocessorCount, dev) != hipSuccess) { grid = -1; return; }
        if (hipFuncSetAttribute((const void*)fwd, hipFuncAttributeMaxDynamicSharedMemorySize, LDS_BYTES) != hipSuccess) { fprintf(stderr, "kernel_launch: hipFuncSetAttribute failed\n"); grid = -1; return; }
        if (hipOccupancyMaxActiveBlocksPerMultiprocessor(&per_cu, (const void*)fwd, 512, LDS_BYTES) != hipSuccess || per_cu < 1) { fprintf(stderr, "kernel_launch: occupancy query says %d\n", per_cu); }
        (void)hipGetLastError();
        grid = cus;
    }
    if (grid < 0) return;
    unsigned char* ws = (unsigned char*)d_ws;
    (void)hipMemsetAsync(ws + WS_CTL, 0, CTL_ZERO_BYTES, stream);
    Args a{};
    for (int i = 0; i < 26; ++i) a.in[i] = (const float*)d_in[i];
    a.out = (float*)d_out; a.ws = ws; a.flags = 0; a.pad = 0;
    auto run = [&](int lo, int hi) { a.ph_lo = lo; a.ph_hi = hi; hipLaunchKernelGGL(fwd, dim3(grid), dim3(512), LDS_BYTES, stream, a); };
#if DBG == 0
#ifdef PRE_LO
    a.pad = 1; run(PRE_LO, PRE_HI); a.pad = 0;
#endif
#if FZ_PER_PHASE
    for (int p = 0; p < N_PHASES; ++p) run(p, p + 1);
#else
    run(0, N_PHASES);
#endif
#else
    using nv::SG;
    const float* const* in = (const float* const*)d_in;
    const size_t BIG = (size_t)NT * D;
    double* ACC = (double*)(ws + 32 * 1024);
    float* nmisc = (float*)(ws + 987 * MiB);
    float* nKV = nmisc; float* nAFF = nmisc + 4u * 1024 * 1024; float* nGATE = nAFF + 1024 * 1024; int* nIDX = (int*)(nGATE + 128 * 1024); float* nMEMC = (float*)(ws + 385 * MiB);
    auto sgemm = [&](const float* A, const float* B, float* C, const int* gidx, int M, int N, int K, long sam, long sak, long sbk, long sbn, long ldc,
                     int nz = 1, int zdiv = 1, long zA0 = 0, long zA1 = 0, long zB0 = 0, long zB1 = 0, long zC0 = 0, long zC1 = 0) {
        SG s{A, B, C, gidx, M, N, K, zdiv, sam, sak, sbk, sbn, ldc, zA0, zA1, zB0, zB1, zC0, zC1};
        hipLaunchKernelGGL(nv::k_sgemm, dim3(N / 128, M / 128, nz), dim3(256), 0, stream, s);
    };
    const int EW = (int)((BIG + 255) / 256);
    auto n_import = [&](float* X) { hipMemcpyAsync(X, in[I_XP], (size_t)NTP * D * 4, hipMemcpyDeviceToDevice, stream); hipMemcpyAsync(X + (size_t)NTP * D, in[I_XS], (size_t)NTS * D * 4, hipMemcpyDeviceToDevice, stream);
        hipMemcpyAsync(nMEMC, in[I_MEMP], (size_t)4 * 256 * D * 4, hipMemcpyDeviceToDevice, stream); hipMemcpyAsync(nMEMC + (size_t)4 * 256 * D, in[I_MEMS], (size_t)4 * 256 * D * 4, hipMemcpyDeviceToDevice, stream); };
    auto n_s5 = [&](float* X, float* T1, float* T2, float* T3) {
        sgemm(X, in[I_AWIN], T1, nullptr, NT, D, D, D, 1, D, 1, D);
        hipLaunchKernelGGL(nv::k_s5_scan, dim3(8 * 64 * 2), dim3(64), 0, stream, T1, T2, in[I_ALRE], in[I_ALIM], in[I_ALDT], in[I_ABRE], in[I_ABIM], in[I_ACRE], in[I_ACIM]);
        hipLaunchKernelGGL(nv::k_s5_gelu, dim3(EW), dim3(256), 0, stream, T1, T2, in[I_AD], T2);
        sgemm(T2, in[I_AWGLU], T1, nullptr, NT, D, D, D, 1, 2 * D, 1, D);
        sgemm(T2, in[I_AWGLU] + D, T3, nullptr, NT, D, D, D, 1, 2 * D, 1, D);
        hipLaunchKernelGGL(nv::k_glu, dim3(EW), dim3(256), 0, stream, T1, T3, T1);
    };
    auto n_na = [&](float* X, float* T1, float* T2, float* T3) {
        sgemm(X, in[I_BWQKV], T1, nullptr, NT, D, D, D, 1, 3 * D, 1, D); sgemm(X, in[I_BWQKV] + D, T2, nullptr, NT, D, D, D, 1, 3 * D, 1, D); sgemm(X, in[I_BWQKV] + 2 * D, T3, nullptr, NT, D, D, D, 1, 3 * D, 1, D);
        hipLaunchKernelGGL(nv::k_natten, dim3(NT * 16 / 4), dim3(256), 0, stream, T1, T2, T3, in[I_BRPB]);
        sgemm(T1, in[I_BWO], T2, nullptr, NT, D, D, D, 1, D, 1, D);
    };
    auto n_ln = [&](float* X, const float* h, int layer, int sub, float* xo) { hipLaunchKernelGGL(nv::k_res_ln, dim3(NT / 4), dim3(256), 0, stream, X, h, in[I_LNG] + (layer * 3 + sub) * D, in[I_LNB] + (layer * 3 + sub) * D, xo, NT); };
    auto n_mem = [&](float* X, float* T1, float* T2, float* T3, int layer) {
        const float* wq = in[I_MWQ] + (size_t)layer * D * D; const float* wkv = in[I_MWKV] + (size_t)layer * D * 2 * D; const float* wo = in[I_MWO] + (size_t)layer * D * D;
        sgemm(nMEMC, wkv, nKV, nullptr, 8 * 256, 2 * D, D, D, 1, 2 * D, 1, 2 * D);
        sgemm(X, wq, T1, nullptr, NT, D, D, D, 1, D, 1, D);
        for (int grp = 0; grp < 2; ++grp) { const int L = grp ? 4096 : 8192; const size_t tb = grp ? (size_t)NTP : 0; const int gb0 = grp * 4;
            sgemm(T1 + tb * D, nKV + (size_t)gb0 * 256 * 2 * D, T2 + tb * D, nullptr, L, 256, 256, D, 1, 1, 2 * D, D, 16, 4, (long)L * D, 256, (long)256 * 2 * D, 256, (long)L * D, 256); }
        hipLaunchKernelGGL(nv::k_softmax256, dim3(NT * 4 / 4), dim3(256), 0, stream, T2, 0.0625f, NT * 4);
        for (int grp = 0; grp < 2; ++grp) { const int L = grp ? 4096 : 8192; const size_t tb = grp ? (size_t)NTP : 0; const int gb0 = grp * 4;
            sgemm(T2 + tb * D, nKV + (size_t)gb0 * 256 * 2 * D + D, T3 + tb * D, nullptr, L, 256, 256, D, 1, 2 * D, 1, D, 16, 4, (long)L * D, 256, (long)256 * 2 * D, 256, (long)L * D, 256); }
        sgemm(T3, wo, T1, nullptr, NT, D, D, D, 1, D, 1, D);
    };
    auto n_moe = [&](float* X, float* T1, float* T2, float* T3, int layer) {
        hipLaunchKernelGGL(nv::k_router, dim3(NT / 4), dim3(256), 0, stream, X, in[I_EWR] + (size_t)layer * D * 16, nAFF, NT);
        hipLaunchKernelGGL(nv::k_select, dim3(32), dim3(512), 0, stream, nAFF, nIDX, nGATE);
        hipMemsetAsync(T1, 0, BIG * 4, stream);
        for (int grp = 0; grp < 2; ++grp) { const int n = grp ? NTS : NTP, cap = n / 8; const size_t tb = grp ? (size_t)NTP : 0;
            for (int e = 0; e < 16; ++e) { const int* idx = nIDX + (grp ? 16 * 4096 : 0) + e * cap; const float* gate = nGATE + (grp ? 16 * 4096 : 0) + e * cap;
                const float* w1 = in[I_EW1] + ((size_t)layer * 16 + e) * D * 2048; const float* w3 = in[I_EW3] + ((size_t)layer * 16 + e) * D * 2048; const float* w2 = in[I_EW2] + ((size_t)layer * 16 + e) * 2048 * D;
                float* H1 = T2; float* H3 = T2 + (size_t)4096 * 2048; float* YE = T3;
                sgemm(X + tb * D, w1, H1, idx, cap, 2048, D, D, 1, 2048, 1, 2048); sgemm(X + tb * D, w3, H3, idx, cap, 2048, D, D, 1, 2048, 1, 2048);
                hipLaunchKernelGGL(nv::k_silu_mul, dim3((unsigned)(((size_t)cap * 2048 + 255) / 256)), dim3(256), 0, stream, H1, H3, (size_t)cap * 2048);
                sgemm(H1, w2, YE, nullptr, cap, D, 2048, 2048, 1, D, 1, D);
                hipLaunchKernelGGL(nv::k_scatter_add, dim3((unsigned)(((size_t)cap * D + 255) / 256)), dim3(256), 0, stream, YE, idx, gate, T1 + tb * D, cap); } }
    };
    float* X = (float*)(ws + WS_XF); float* T1 = (float*)(ws + WS_EW13); float* T2 = (float*)(ws + WS_POOL); float* T3 = (float*)(ws + WS_POOL + 192 * MiB);
    auto cmp_bf = [&](size_t off_bf16, const float* ref, double* acc) { hipLaunchKernelGGL(dbg::k_cmp_bf16_f32, dim3(2048), dim3(256), 0, stream, (const unsigned short*)(ws + off_bf16), ref, BIG, acc); };
#if DBG == 1
    n_import(X);
    a.flags = FLAG_NO_XIMPORT | FLAG_NO_EXPERTS0;
    n_s5(X, T1, T2, T3);
    for (int p = 0; p <= 5; ++p) run(p, p + 1);
    cmp_bf(PO_HB_S5, T1, ACC);
    cmp_bf(PO_HB_S5, T1, ACC + 2);
#elif DBG == 11
    n_import(X);
    a.flags = FLAG_NO_XIMPORT | FLAG_NO_EXPERTS0;
    sgemm(X, in[I_AWIN], T1, nullptr, NT, D, D, D, 1, D, 1, D);
    for (int p = 0; p <= 4; ++p) run(p, p + 1);
    hipLaunchKernelGGL(dbg::k_cmp_ua, dim3(2048), dim3(256), 0, stream, (const unsigned short*)(ws + PO_UA), T1, ACC);
    hipMemcpyAsync(X, T1, BIG * 4, hipMemcpyDeviceToDevice, stream);
    { float* Y = (float*)(ws + 193 * MiB);
      hipLaunchKernelGGL(nv::k_s5_scan, dim3(8 * 64 * 2), dim3(64), 0, stream, X, Y, in[I_ALRE], in[I_ALIM], in[I_ALDT], in[I_ABRE], in[I_ABIM], in[I_ACRE], in[I_ACIM]);
      hipLaunchKernelGGL(nv::k_s5_gelu, dim3(EW), dim3(256), 0, stream, X, Y, in[I_AD], Y);
      cmp_bf(PO_SG, Y, ACC + 2); }
#elif DBG == 2
    n_import(X); n_s5(X, T1, T2, T3); n_ln(X, T1, 0, 0, X); n_mem(X, T1, T2, T3, 0);
    a.flags = FLAG_NO_XIMPORT | FLAG_NO_EXPERTS0;
    run(0, 1); run(1, 2); run(2, 3); run(7, 8); run(9, 10);
    cmp_bf(PO_HB_MEM, T1, ACC); cmp_bf(PO_HB_MEM, T1, ACC + 2);
#elif DBG == 4
    n_import(X); n_na(X, T1, T2, T3);
    hipMemcpyAsync(T1, T2, BIG * 4, hipMemcpyDeviceToDevice, stream);
    a.flags = FLAG_NO_XIMPORT | FLAG_NO_EXPERTS0;
    run(0, 1); run(17, 18); run(18, 19); run(19, 20);
    cmp_bf(PO_HB_NA, T1, ACC); cmp_bf(PO_HB_NA, T1, ACC + 2);
#endif
    hipLaunchKernelGGL(dbg::k_encode, dim3(2048), dim3(256), 0, stream, (float*)d_out, ACC, ACC + 2);
#endif
}
```

```cpp
#include <hip/hip_runtime.h>
#include <cstdio>
#include <cstdint>
#include <cmath>
#define NO_WT 1
namespace nv {
constexpr int D = 1024, NTP = 32768, NTS = 16384, NT = NTP + NTS, NGB = 8, MEM = 256;
constexpr int GRID_W = 64;
constexpr float ALPHA = 1.41421356237309515f;
constexpr float LN_EPS = 1e-5f;

__host__ __device__ inline int gb_tok0(int gb) { return gb < 4 ? gb * 8192 : NTP + (gb - 4) * 4096; }
__host__ __device__ inline int gb_len(int gb) { return gb < 4 ? 8192 : 4096; }

__device__ __forceinline__ float wave_sum(float v) {
#pragma unroll
    for (int o = 1; o < 64; o <<= 1) v += __shfl_xor(v, o);
    return v;
}
__device__ __forceinline__ float wave_max(float v) {
#pragma unroll
    for (int o = 1; o < 64; o <<= 1) v = fmaxf(v, __shfl_xor(v, o));
    return v;
}

struct SG { const float* A; const float* B; float* C; const int* gidx; int M, N, K, zdiv; long sam, sak, sbk, sbn, ldc; long zA0, zA1, zB0, zB1, zC0, zC1; };
__global__ __launch_bounds__(256) void k_sgemm(SG a) {
    __shared__ float As[8][132];
    __shared__ float Bs[8][132];
    const int z = blockIdx.z, z0 = z / a.zdiv, z1 = z % a.zdiv;
    const float* A = a.A + z0 * a.zA0 + z1 * a.zA1;
    const float* B = a.B + z0 * a.zB0 + z1 * a.zB1;
    float* C = a.C + z0 * a.zC0 + z1 * a.zC1;
    const int bm = blockIdx.y * 128, bn = blockIdx.x * 128, tid = threadIdx.x, tx = tid & 15, ty = tid >> 4;
    float acc[8][8];
#pragma unroll
    for (int i = 0; i < 8; ++i)
#pragma unroll
        for (int j = 0; j < 8; ++j) acc[i][j] = 0.f;
    const int arow_l = tid >> 1, akk = (tid & 1) * 4;
    const long arow = a.gidx ? (long)a.gidx[bm + arow_l] : (long)(bm + arow_l);
    const float* Ap = A + arow * a.sam;
    const int bkk = tid >> 5, bnn = (tid & 31) * 4;
    for (int k0 = 0; k0 < a.K; k0 += 8) {
        float av[4], bv[4];
#pragma unroll
        for (int i = 0; i < 4; ++i) av[i] = Ap[(long)(k0 + akk + i) * a.sak];
#pragma unroll
        for (int i = 0; i < 4; ++i) bv[i] = B[(long)(k0 + bkk) * a.sbk + (long)(bn + bnn + i) * a.sbn];
        __syncthreads();
#pragma unroll
        for (int i = 0; i < 4; ++i) As[akk + i][arow_l] = av[i];
#pragma unroll
        for (int i = 0; i < 4; ++i) Bs[bkk][bnn + i] = bv[i];
        __syncthreads();
#pragma unroll
        for (int kk = 0; kk < 8; ++kk) {
            float x[8], y[8];
#pragma unroll
            for (int i = 0; i < 8; ++i) x[i] = As[kk][ty * 8 + i];
#pragma unroll
            for (int j = 0; j < 8; ++j) y[j] = Bs[kk][tx * 8 + j];
#pragma unroll
            for (int i = 0; i < 8; ++i)
#pragma unroll
                for (int j = 0; j < 8; ++j) acc[i][j] += x[i] * y[j];
        }
    }
#pragma unroll
    for (int i = 0; i < 8; ++i)
#pragma unroll
        for (int j = 0; j < 8; ++j) C[(long)(bm + ty * 8 + i) * a.ldc + bn + tx * 8 + j] = acc[i][j];
}

__global__ __launch_bounds__(64) void k_s5_scan(const float* __restrict__ u, float* __restrict__ ydir, const float* lam_re, const float* lam_im, const float* log_dt,
                                                const float* b_re, const float* b_im, const float* c_re, const float* c_im) {
    const int wid = blockIdx.x;
    const int dir = wid & 1, g = (wid >> 1) & 63, gb = wid >> 7;
    const int p = threadIdx.x;
    const int L = gb_len(gb), t0 = gb_tok0(gb);
    const double dt = exp((double)log_dt[dir * 64 + g]);
    const double lr = lam_re[(dir * 64 + g) * 64 + p], li = lam_im[(dir * 64 + g) * 64 + p];
    const double er = exp(lr * dt), lbr = er * cos(li * dt), lbi = er * sin(li * dt);
    const double nr = lbr - 1.0, ni = lbi, den = lr * lr + li * li;
    const double fr = (nr * lr + ni * li) / den, fi = (ni * lr - nr * li) / den;
    float Br[16], Bi[16], Cr[16], Ci[16];
#pragma unroll
    for (int h = 0; h < 16; ++h) {
        const double br = b_re[((dir * 64 + g) * 64 + p) * 16 + h], bi = b_im[((dir * 64 + g) * 64 + p) * 16 + h];
        Br[h] = (float)(fr * br - fi * bi); Bi[h] = (float)(fr * bi + fi * br);
        Cr[h] = c_re[((dir * 64 + g) * 16 + h) * 64 + p]; Ci[h] = c_im[((dir * 64 + g) * 16 + h) * 64 + p];
    }
    const float ar = (float)lbr, ai = (float)lbi;
    float hr = 0.f, hi = 0.f;
    float* yo = ydir + (size_t)dir * NT * D;
    for (int s = 0; s < L; ++s) {
        const int t = dir ? (L - 1 - s) : s;
        const float* ur = u + (size_t)(t0 + t) * D + g * 16;
        float bur = 0.f, bui = 0.f;
#pragma unroll
        for (int h = 0; h < 16; ++h) { const float uv = ur[h]; bur += uv * Br[h]; bui += uv * Bi[h]; }
        const float nhr = ar * hr - ai * hi + bur, nhi = ar * hi + ai * hr + bui;
        hr = nhr; hi = nhi;
        float mine = 0.f;
#pragma unroll
        for (int c = 0; c < 16; ++c) { const float v = wave_sum(Cr[c] * hr - Ci[c] * hi); if (p == c) mine = v; }
        if (p < 16) yo[(size_t)(t0 + t) * D + g * 16 + p] = mine;
    }
}
__global__ void k_s5_gelu(const float* u, const float* ydir, const float* dskip, float* gout) {
    const size_t i = (size_t)blockIdx.x * blockDim.x + threadIdx.x;
    if (i >= (size_t)NT * D) return;
    const float y = dskip[i & (D - 1)] * u[i] + ydir[i] + ydir[(size_t)NT * D + i];
    const float c = 0.7978845608028654f * (y + 0.044715f * y * y * y);
    gout[i] = 0.5f * y * (1.f + tanhf(c));
}
__global__ void k_glu(const float* z1, const float* z2, float* out) {
    const size_t i = (size_t)blockIdx.x * blockDim.x + threadIdx.x;
    if (i >= (size_t)NT * D) return;
    out[i] = z1[i] / (1.f + expf(-z2[i]));
}
__global__ __launch_bounds__(256) void k_res_ln(const float* x, const float* h, const float* g, const float* b, float* xo, int rows) {
    const int row = blockIdx.x * 4 + (threadIdx.x >> 6), lane = threadIdx.x & 63;
    if (row >= rows) return;
    float v[16]; float s = 0.f;
#pragma unroll
    for (int j = 0; j < 16; ++j) { const size_t i = (size_t)row * D + lane + 64 * j; v[j] = ALPHA * x[i] + h[i]; s += v[j]; }
    const float mean = wave_sum(s) * (1.f / D); float q = 0.f;
#pragma unroll
    for (int j = 0; j < 16; ++j) { v[j] -= mean; q += v[j] * v[j]; }
    const float rstd = 1.f / sqrtf(wave_sum(q) * (1.f / D) + LN_EPS);
#pragma unroll
    for (int j = 0; j < 16; ++j) { const int c = lane + 64 * j; xo[(size_t)row * D + c] = v[j] * rstd * g[c] + b[c]; }
}
__global__ __launch_bounds__(256) void k_softmax256(float* s, float scale, int rows) {
    const int row = blockIdx.x * 4 + (threadIdx.x >> 6), lane = threadIdx.x & 63;
    if (row >= rows) return;
    float v[4]; float m = -INFINITY;
#pragma unroll
    for (int j = 0; j < 4; ++j) { v[j] = s[(size_t)row * 256 + lane + 64 * j] * scale; m = fmaxf(m, v[j]); }
    m = wave_max(m); float l = 0.f;
#pragma unroll
    for (int j = 0; j < 4; ++j) { v[j] = expf(v[j] - m); l += v[j]; }
    l = wave_sum(l);
#pragma unroll
    for (int j = 0; j < 4; ++j) s[(size_t)row * 256 + lane + 64 * j] = v[j] / l;
}
__global__ __launch_bounds__(256) void k_router(const float* x, const float* wr, float* aff, int rows) {
    const int row = blockIdx.x * 4 + (threadIdx.x >> 6), lane = threadIdx.x & 63;
    if (row >= rows) return;
    float acc[16];
#pragma unroll
    for (int e = 0; e < 16; ++e) acc[e] = 0.f;
    for (int j = 0; j < 16; ++j) { const int k = lane + 64 * j; const float xv = x[(size_t)row * D + k];
#pragma unroll
        for (int e = 0; e < 16; ++e) acc[e] += xv * wr[k * 16 + e]; }
    float m = -INFINITY;
#pragma unroll
    for (int e = 0; e < 16; ++e) { acc[e] = wave_sum(acc[e]); m = fmaxf(m, acc[e]); }
    float l = 0.f;
#pragma unroll
    for (int e = 0; e < 16; ++e) { acc[e] = expf(acc[e] - m); l += acc[e]; }
    float mine = 0.f;
#pragma unroll
    for (int e = 0; e < 16; ++e) if (lane == e) mine = acc[e] / l;
    if (lane < 16) aff[(size_t)row * 16 + lane] = mine;
}

__device__ __forceinline__ void select_expert(const float* aff, int n, int e, int cap, int* idx_out, float* gate_out, int* slot_of  , unsigned* hist  , unsigned* wsum  , unsigned* bc  ) {
    const int tid = threadIdx.x, nth = blockDim.x, lane = tid & 63, wv = tid >> 6, nw = nth >> 6;
    unsigned prefix = 0u, mask = 0u; unsigned remaining = (unsigned)cap;
    for (int pass = 0; pass < 4; ++pass) {
        const int shift = 24 - 8 * pass;
        for (int i = tid; i < 256; i += nth) hist[i] = 0u;
        __syncthreads();
        for (int t = tid; t < n; t += nth) { const unsigned key = __float_as_uint(aff[(size_t)t * 16 + e]); if ((key & mask) == prefix) atomicAdd(&hist[(key >> shift) & 255u], 1u); }
        __syncthreads();
        if (tid == 0) { unsigned cum = 0u; int b = 255; for (; b > 0; --b) { if (cum + hist[b] >= remaining) break; cum += hist[b]; } bc[0] = (unsigned)b; bc[1] = remaining - cum; }
        __syncthreads();
        prefix |= bc[0] << shift; mask |= 0xffu << shift; remaining = bc[1];
        __syncthreads();
    }
    const unsigned T = prefix; const unsigned need_eq = remaining;
    unsigned base = 0u, eqbase = 0u;
    for (int s0 = 0; s0 < n; s0 += nth) {
        const int t = s0 + tid; const bool in = t < n;
        const float a = in ? aff[(size_t)t * 16 + e] : 0.f; const unsigned key = __float_as_uint(a);
        const bool gt = in && key > T, eq = in && key == T;
        const unsigned long long meq = __ballot(eq); const unsigned eqr_w = __popcll(meq & ((1ull << lane) - 1ull));
        if (lane == 0) wsum[wv] = __popcll(meq);
        __syncthreads();
        unsigned eqoff = 0u, eqtot = 0u; for (int w = 0; w < nw; ++w) { const unsigned c = wsum[w]; if (w < wv) eqoff += c; eqtot += c; }
        __syncthreads();
        const bool sel = gt || (eq && (eqbase + eqoff + eqr_w) < need_eq);
        const unsigned long long ms = __ballot(sel); const unsigned sr_w = __popcll(ms & ((1ull << lane) - 1ull));
        if (lane == 0) wsum[wv] = __popcll(ms);
        __syncthreads();
        unsigned soff = 0u, stot = 0u; for (int w = 0; w < nw; ++w) { const unsigned c = wsum[w]; if (w < wv) soff += c; stot += c; }
        __syncthreads();
        if (sel) { const unsigned slot = base + soff + sr_w; if (slot < (unsigned)cap) { idx_out[slot] = t; gate_out[slot] = a; } }
        if (slot_of && in) slot_of[(size_t)t * 16 + e] = sel ? (int)(base + soff + sr_w) : -1;
        base += stot; eqbase += eqtot;
    }
}
__global__ __launch_bounds__(512) void k_select(const float* aff_all, int* idx_all, float* gate_all) {
    __shared__ unsigned hist[256]; __shared__ unsigned wsum[32]; __shared__ unsigned bc[4];
    const int grp = blockIdx.x >> 4, e = blockIdx.x & 15;
    const int n = grp ? NTS : NTP, cap = n / 8;
    const float* aff = aff_all + (size_t)(grp ? NTP : 0) * 16;
    int* idx = idx_all + (grp ? 16 * 4096 : 0) + e * cap; float* gate = gate_all + (grp ? 16 * 4096 : 0) + e * cap;
    select_expert(aff, n, e, cap, idx, gate, nullptr, hist, wsum, bc);
}
__global__ void k_silu_mul(float* h1, const float* h3, size_t n) {
    const size_t i = (size_t)blockIdx.x * blockDim.x + threadIdx.x; if (i >= n) return;
    const float a = h1[i]; h1[i] = a / (1.f + expf(-a)) * h3[i];
}
__global__ void k_scatter_add(const float* ye, const int* idx, const float* gate, float* out, int cap) {
    const size_t i = (size_t)blockIdx.x * blockDim.x + threadIdx.x; if (i >= (size_t)cap * D) return;
    const int slot = (int)(i >> 10), c = (int)(i & 1023);
    atomicAdd(&out[(size_t)idx[slot] * D + c], gate[slot] * ye[i]);
}

__global__ __launch_bounds__(256) void k_natten(float* q, const float* k, const float* v, const float* rpb) {
    const int wg = blockIdx.x * 4 + (threadIdx.x >> 6), lane = threadIdx.x & 63;
    const int tok = wg >> 4, h = wg & 15;
    if (tok >= NT) return;
    int gb, l; if (tok < NTP) { gb = tok >> 13; l = tok & 8191; } else { gb = 4 + ((tok - NTP) >> 12); l = (tok - NTP) & 4095; }
    const int rows = gb_len(gb) / GRID_W, t0 = gb_tok0(gb);
    const int r = l >> 6, qc = l & 63;
    int rs = r - 4; rs = rs < 0 ? 0 : (rs > rows - 8 ? rows - 8 : rs);
    int ws = qc - 8; ws = ws < 0 ? 0 : (ws > 48 ? 48 : ws);
    const float qv = q[(size_t)tok * D + h * 64 + lane] * 0.125f;
    float m = -INFINITY, lsum = 0.f, o = 0.f;
    for (int rr = 0; rr < 8; ++rr) {
        const int kr = rs + rr, dr = kr - r + 7;
        for (int cc = 0; cc < 16; ++cc) {
            const int kc = ws + cc; int dc = kc - qc + 15; dc = dc < 0 ? 0 : (dc > 30 ? 30 : dc);
            const size_t kt = (size_t)(t0 + kr * 64 + kc) * D + h * 64 + lane;
            const float s = wave_sum(qv * k[kt]) + rpb[(h * 15 + dr) * 31 + dc];
            const float mn = fmaxf(m, s), al = expf(m - mn), pp = expf(s - mn);
            lsum = lsum * al + pp; o = o * al + pp * v[kt]; m = mn;
        }
    }
    q[(size_t)tok * D + h * 64 + lane] = o / lsum;
}
}
#define LAS __attribute__((address_space(3)))
#define GAS __attribute__((address_space(1)))
namespace fz {
typedef unsigned short bf16_t;
typedef short bf16x8 __attribute__((ext_vector_type(8)));
typedef float f32x4 __attribute__((ext_vector_type(4)));
typedef float f32x2 __attribute__((ext_vector_type(2)));
typedef unsigned u32x4 __attribute__((ext_vector_type(4)));
typedef unsigned u32x2 __attribute__((ext_vector_type(2)));
typedef int v8i __attribute__((ext_vector_type(8)));
typedef int v4i __attribute__((ext_vector_type(4)));

constexpr int D = 1024, NTP = 32768, NTS = 16384, NT = NTP + NTS;
constexpr int TCH = 32, NCHUNK = NT / TCH;
constexpr int UAK = TCH * 16 + 256;
constexpr float ALPHA = 1.41421356237309515f, LN_EPS = 1e-5f;
constexpr size_t MiB = 1u << 20;
constexpr size_t WS_CTL = 0, WS_XF = 1 * MiB, WS_XB = 193 * MiB, WS_WIN = 289 * MiB, WS_WGLU = 291 * MiB, WS_WQKV = 295 * MiB, WS_WO = 301 * MiB, WS_MWQ = 303 * MiB,
                 WS_MWKV = 307 * MiB, WS_MWO = 315 * MiB, WS_MEMB = 319 * MiB, WS_KV = 323 * MiB, WS_WQK = 339 * MiB, WS_WVO = 371 * MiB, WS_AFF = 403 * MiB, WS_SLOT = 406 * MiB,
                 WS_IDX = 409 * MiB, WS_GATE = 409 * MiB + 512 * 1024, WS_EW13 = 411 * MiB  , WS_EW2 = 475 * MiB  ,
                 WS_XB8 = 507 * MiB  , WS_POOL = 603 * MiB, WS_END = 1024 * MiB;
constexpr size_t PO_M2T = WS_POOL, PO_M13T = WS_POOL + 16 * MiB, PO_UA = WS_POOL + 64 * MiB, PO_SG = WS_POOL + 208 * MiB;
constexpr size_t PO_HB_S5 = WS_POOL;
constexpr size_t PO_SB = WS_POOL + 96 * MiB, PO_HB_MEM = WS_POOL + 304 * MiB;
constexpr size_t PO_Q = WS_POOL, PO_K = WS_POOL + 96 * MiB, PO_VT = WS_POOL + 192 * MiB, PO_HB_NA = WS_POOL + 96 * MiB;
constexpr size_t PO_HM = WS_POOL, PO_YE = WS_POOL + 192 * MiB;
static_assert(PO_YE + 192 * MiB <= WS_END && PO_SG + 96 * MiB <= WS_END && PO_HB_NA + 96 * MiB <= WS_END && PO_HB_MEM + 96 * MiB <= WS_END, "pool");
constexpr int CW_TMO = 0, CW_BAR = 4096;
constexpr size_t CTL_ZERO_BYTES = 64 * 1024;
constexpr int RING_BYTES = 131072, MISC_OFF = RING_BYTES + 320, LDS_BYTES = 147456, ZERO16_OFF = RING_BYTES + 64;

__host__ __device__ inline int gb_tok0(int gb) { return gb < 4 ? gb * 8192 : NTP + (gb - 4) * 4096; }
__host__ __device__ inline int gb_len(int gb) { return gb < 4 ? 8192 : 4096; }
__host__ __device__ inline int panel_gb(int pm) { return pm < 128 ? (pm >> 5) : 4 + ((pm - 128) >> 4); }

__device__ __forceinline__ unsigned cvt_pk_bf16(float lo, float hi) { unsigned r; asm volatile("v_cvt_pk_bf16_f32 %0, %1, %2" : "=v"(r) : "v"(lo), "v"(hi)); return r; }
typedef __bf16 bf16x2_t __attribute__((ext_vector_type(2)));
__device__ __forceinline__ unsigned cvt_pk_bf16_c(float lo, float hi) { const f32x2 v = {lo, hi}; const bf16x2_t b = __builtin_convertvector(v, bf16x2_t); return __builtin_bit_cast(unsigned, b); }
__device__ __forceinline__ float bf2f(unsigned short b) { return __uint_as_float(((unsigned)b) << 16); }
template <int CTRL> __device__ __forceinline__ float dpp_f(float v) { return __uint_as_float((unsigned)__builtin_amdgcn_update_dpp(0, (int)__float_as_uint(v), CTRL, 0xF, 0xF, true)); }
__device__ __forceinline__ float x16_sum(float v) { const auto r = __builtin_amdgcn_permlane16_swap(__float_as_uint(v), __float_as_uint(v), false, false); return __uint_as_float(r[0]) + __uint_as_float(r[1]); }
__device__ __forceinline__ float x32_sum(float v) { const auto r = __builtin_amdgcn_permlane32_swap(__float_as_uint(v), __float_as_uint(v), false, false); return __uint_as_float(r[0]) + __uint_as_float(r[1]); }
__device__ __forceinline__ float x16_max(float v) { const auto r = __builtin_amdgcn_permlane16_swap(__float_as_uint(v), __float_as_uint(v), false, false); return fmaxf(__uint_as_float(r[0]), __uint_as_float(r[1])); }
__device__ __forceinline__ float x32_max(float v) { const auto r = __builtin_amdgcn_permlane32_swap(__float_as_uint(v), __float_as_uint(v), false, false); return fmaxf(__uint_as_float(r[0]), __uint_as_float(r[1])); }
__device__ __forceinline__ float row_sum(float v) { v += dpp_f<0xB1>(v); v += dpp_f<0x4E>(v); v += dpp_f<0x141>(v); v += dpp_f<0x140>(v); return v; }
__device__ __forceinline__ float row_max(float v) { v = fmaxf(v, dpp_f<0xB1>(v)); v = fmaxf(v, dpp_f<0x4E>(v)); v = fmaxf(v, dpp_f<0x141>(v)); v = fmaxf(v, dpp_f<0x140>(v)); return v; }
__device__ __forceinline__ float wave_sum(float v) { return x32_sum(x16_sum(row_sum(v))); }
__device__ __forceinline__ float wave_max(float v) { return x32_max(x16_max(row_max(v))); }
#ifndef NO_WT
__device__ __forceinline__ void st16(void* p, u32x4 v) { asm volatile("global_store_dwordx4 %0, %1, off sc1\n\ts_nop 1" :: "v"(p), "v"(v)); }
__device__ __forceinline__ void st8(void* p, u32x2 v) { asm volatile("global_store_dwordx2 %0, %1, off sc1\n\ts_nop 1" :: "v"(p), "v"(v)); }
__device__ __forceinline__ void st4(void* p, unsigned v) { asm volatile("global_store_dword %0, %1, off sc1\n\ts_nop 1" :: "v"(p), "v"(v)); }
#else
__device__ __forceinline__ void st16(void* p, u32x4 v) { *(u32x4*)p = v; }
__device__ __forceinline__ void st8(void* p, u32x2 v) { *(u32x2*)p = v; }
__device__ __forceinline__ void st4(void* p, unsigned v) { *(unsigned*)p = v; }
#endif
__device__ __forceinline__ void st16f(void* p, f32x4 v) { st16(p, __builtin_bit_cast(u32x4, v)); }
__device__ __forceinline__ void pst16(void* p, u32x4 v) { *(u32x4*)p = v; }
__device__ __forceinline__ void pst8(void* p, u32x2 v) { *(u32x2*)p = v; }
#ifndef NO_WT
__device__ __forceinline__ void st16_so(const void* base, unsigned off, f32x4 v) { asm volatile("global_store_dwordx4 %0, %1, %2 sc1\n\ts_nop 1" :: "v"(off), "v"(v), "s"(base)); }
__device__ __forceinline__ void st4_so(const void* base, unsigned off, unsigned v) { asm volatile("global_store_dword %0, %1, %2 sc1\n\ts_nop 1" :: "v"(off), "v"(v), "s"(base)); }
#else
__device__ __forceinline__ void st16_so(const void* base, unsigned off, f32x4 v) { *(f32x4*)((unsigned char*)base + off) = v; }
__device__ __forceinline__ void st4_so(const void* base, unsigned off, unsigned v) { *(unsigned*)((unsigned char*)base + off) = v; }
#endif
#define LDS_WAIT() asm volatile("s_waitcnt lgkmcnt(0)" ::: "memory")
#define VM_WAIT() asm volatile("s_waitcnt vmcnt(0)" ::: "memory")

#define XB_TMO      128
#define XB_XCNT(j)  (256  + 64 * (j))
#define XB_XSUB(j)  (1280 + 64 * (j))
#define XB_XGEN(j)  (2304 + 64 * (j))
#define XB_TOP      3328
#define XB_TOPGEN   3392
#define XCD_BAR_WORDS 3456
#define XB_SPIN_CAP (1u << 18)
__device__ __forceinline__ unsigned xb_ld(unsigned* p)              { return __hip_atomic_load(p, __ATOMIC_RELAXED, __HIP_MEMORY_SCOPE_AGENT); }
__device__ __forceinline__ unsigned xb_add(unsigned* p, unsigned v) { return __hip_atomic_fetch_add(p, v, __ATOMIC_RELAXED, __HIP_MEMORY_SCOPE_AGENT); }
__device__ __forceinline__ unsigned xb_xcc_id() { return (unsigned)__builtin_amdgcn_s_getreg((3 << 11) | 20) & 0xFu; }
#define XB_SPIN(cond, bar) do { unsigned _sp = 0; while (cond) { __builtin_amdgcn_s_sleep(1); \
    if ((++_sp & 255u) == 0u) { if (xb_ld(&(bar)[XB_TMO])) break; if (_sp > XB_SPIN_CAP) { atomicAdd(&(bar)[XB_TMO], 1u); break; } } } } while (0)
struct XcdBarrier { unsigned* bar; unsigned x; volatile LAS unsigned* st; };
__device__ __forceinline__ int xb_tid();
__device__ __forceinline__ XcdBarrier xcd_barrier_post(unsigned* bar, volatile LAS unsigned* st) {
    XcdBarrier b; b.bar = bar; b.x = xb_xcc_id(); b.st = st;
    if (threadIdx.x == 0) st[4] = xb_add(&bar[XB_XCNT(b.x)], 1u);
    return b;
}
#define XB_LCNT(j)  (3520 + 64 * (j))
#define XB_LGEN(j)  (4544 + 64 * (j))
#define XCD_BAR_WORDS_EXT 5568
__device__ __forceinline__ void xcd_local_barrier(const XcdBarrier& b, const int wave_s, const unsigned nloc) {
    asm volatile("s_waitcnt vmcnt(0)" ::: "memory");
    __syncthreads();
    if (wave_s == 0 && xb_tid() == 0) {
        unsigned* bar = b.bar;
        const unsigned old = xb_add(&bar[XB_LCNT(b.x)], 1u);
        const unsigned gen = old / nloc;
        if (old + 1u == (gen + 1u) * nloc) xb_add(&bar[XB_LGEN(b.x)], 1u);
        else XB_SPIN(xb_ld(&bar[XB_LGEN(b.x)]) == gen, bar);
#ifndef LB_NOACQ
        __builtin_amdgcn_fence(__ATOMIC_ACQUIRE, "agent");
        asm volatile("s_waitcnt vmcnt(0)" ::: "memory");
#endif
    }
    __syncthreads();
}
__device__ __forceinline__ void xcd_barrier_complete(unsigned* bar, unsigned x, unsigned& nloc, unsigned& nx) {
    const unsigned G = gridDim.x * gridDim.y * gridDim.z;
    unsigned sum, cnt, mine, sp = 0u;
    for (;;) {
        sum = 0u; cnt = 0u; mine = 0u;
#pragma unroll
        for (unsigned j = 0; j < 16; ++j) { const unsigned c = xb_ld(&bar[XB_XCNT(j)]); sum += c; cnt += (c > 0u) ? 1u : 0u; mine = (j == x) ? c : mine; }
        if (sum == G) break;
        __builtin_amdgcn_s_sleep(1);
        if ((++sp & 255u) == 0u) { if (xb_ld(&bar[XB_TMO])) break; if (sp > XB_SPIN_CAP) { atomicAdd(&bar[XB_TMO], 1u); break; } }
    }
    nloc = mine > 0u ? mine : 1u; nx = cnt > 0u ? cnt : 1u;
}
__device__ __forceinline__ int xb_tid() { int t; asm volatile("v_mbcnt_lo_u32_b32 %0, -1, 0\n\tv_mbcnt_hi_u32_b32 %0, -1, %0" : "=v"(t)); return t; }
__device__ __forceinline__ void xcd_barrier(const XcdBarrier& b, const int wave_s) {
    asm volatile("s_waitcnt vmcnt(0)" ::: "memory");
    __syncthreads();
    if (wave_s == 0 && xb_tid() == 0) {
        unsigned* bar = b.bar;
        __builtin_amdgcn_s_waitcnt(0);
        unsigned nloc = b.st[0], nx = b.st[1];
        if (nloc == 0u) { xcd_barrier_complete(bar, b.x, nloc, nx); b.st[0] = nloc; b.st[1] = nx; }
        const unsigned old = xb_add(&bar[XB_XSUB(b.x)], 1u);
        const unsigned gen = old / nloc;
        if (old + 1u == (gen + 1u) * nloc) {
            __builtin_amdgcn_fence(__ATOMIC_RELEASE, "agent");
            asm volatile("s_waitcnt vmcnt(0)" ::: "memory");
            const unsigned og = xb_add(&bar[XB_TOP], 1u);
            const unsigned tg = og / nx;
            if (og + 1u == (tg + 1u) * nx) xb_add(&bar[XB_TOPGEN], 1u);
            else XB_SPIN(xb_ld(&bar[XB_TOPGEN]) == tg, bar);
            __builtin_amdgcn_fence(__ATOMIC_ACQUIRE, "agent");
            xb_add(&bar[XB_XGEN(b.x)], 1u);
            asm volatile("s_waitcnt vmcnt(0)" ::: "memory");
        } else {
            XB_SPIN(xb_ld(&bar[XB_XGEN(b.x)]) == gen, bar);
            __builtin_amdgcn_fence(__ATOMIC_ACQUIRE, "agent");
            asm volatile("s_waitcnt vmcnt(0)" ::: "memory");
        }
    }
    __syncthreads();
}

constexpr int BM = 256, BK = 64, HALF = 128, HTB = HALF * BK * 2, STAGE_BYTES = 8 * HTB;
__host__ __device__ __forceinline__ int lds_byte(int r, int c) { const int st = (r >> 4) * 2 + (c >> 5), rr = r & 15, cc = c & 31, ob = rr * 64 + cc * 2; return st * 1024 + (ob ^ (((ob >> 9) & 1) << 5)); }
__host__ __device__ __forceinline__ void stage_rc(int b, int& R, int& C) { const int st = b / 1024, sb = b % 1024, swz = sb ^ (((sb >> 9) & 1) << 5); R = (st >> 1) * 16 + swz / 64; C = (st & 1) * 32 + (swz % 64) / 2; }
__host__ __device__ __forceinline__ int perm32(int rho) { const int n = rho >> 4, i = rho & 15; return 8 * (i >> 2) + 4 * n + (i & 3); }

struct GUnit { const char* A; const char* B; char* C; const void* X; int pm, pn; };
template <int WGM = 8>
__device__ __forceinline__ bool static_unit(int i, int G, int c, int nM, int nN, int& pm, int& pn) {
    const long L = (long)i * G + c; const int nwg = nM * nN; if (L >= nwg) return false;
    int wgid = (int)L; { const int q = nwg / 8, r = nwg % 8, xcd = wgid % 8, off = wgid / 8; wgid = (xcd < r ? xcd * (q + 1) : r * (q + 1) + (xcd - r) * q) + off; }
    const int nig = WGM * nN, gid = wgid / nig, fm = gid * WGM, gsz = (nM - fm) < WGM ? (nM - fm) : WGM;
    pm = fm + ((wgid % nig) % gsz); pn = (wgid % nig) / gsz; return true;
}
template <class Epi, class Sched, bool GATHER, bool FP8 = false>
__device__ __forceinline__ void gemm_phase(LAS unsigned char* lds, const int tid_in, const int K, const unsigned lda, const unsigned ldb, const Sched& S, const Epi& E) {
    int tid_ = tid_in; asm volatile("" : "+v"(tid_));
    const int tid = tid_, wid = __builtin_amdgcn_readfirstlane(tid >> 6), lane = tid & 63, wr = wid >> 2, wc = wid & 3, fr = lane & 15, fq = lane >> 4;
    int nt_ = K / BK; asm volatile("" : "+s"(nt_)); const int nt = nt_;
    unsigned voffA[2], voffB[2]; int gR[2], gC[2];
#pragma unroll
    for (int i = 0; i < 2; ++i) { int R, C; stage_rc(tid * 16 + i * 8192, R, C); const int Rb = Epi::PERM ? ((R & ~31) + perm32(R & 31)) : R;
        voffA[i] = (unsigned)R * lda + (unsigned)C * 2u; voffB[i] = (unsigned)Rb * ldb + (unsigned)C * 2u; gR[i] = R; gC[i] = C * 2; }
    const size_t kstep = (size_t)(BK * 2);
    const size_t hstepA = (size_t)HALF * lda, hstepB = (size_t)HALF * ldb;
    const unsigned ldsw = (unsigned)wid * 1024u;
    const int aoff = lds_byte(wr * 64 + fr, fq * 8), boff = lds_byte(wc * 32 + fr, fq * 8);
    const int sc8 = 0x7F7F7F7F;
    unsigned cvo[2][2], nvo[2][2];
#define PG8_SA(b, h) (((b) * 2 + (h)) * HTB)
#define PG8_SB(b, h) ((4 + (b) * 2 + (h)) * HTB)
#define PG8_STAGE(bufoff, gbase, voff) do { _Pragma("unroll") for (int _i = 0; _i < 2; ++_i) \
        __builtin_amdgcn_global_load_lds((const unsigned*)((const char*)(gbase) + (voff)[_i]), (LAS unsigned*)(lds + (bufoff) + ldsw + _i * 8192), 16, 0, 0); } while (0)
#define PG8_STAGE_B(bufoff, ptr, h) PG8_STAGE(bufoff, (ptr) + (h) * hstepB, voffB)
#define PG8_STAGE_A(bufoff, ptr, h, vo) do { if constexpr (GATHER) { PG8_STAGE(bufoff, (ptr), (vo)[h]); } else { PG8_STAGE(bufoff, (ptr) + (h) * hstepA, voffA); } } while (0)
#define PG8_LDA(dst, b, h) do { _Pragma("unroll") for (int m = 0; m < 4; ++m) _Pragma("unroll") for (int k = 0; k < 2; ++k) dst[m][k] = *(const LAS bf16x8*)(lds + PG8_SA(b, h) + aoff + m * 2048 + k * 1024); } while (0)
#define PG8_LDB(dst, b, h) do { _Pragma("unroll") for (int n = 0; n < 2; ++n) _Pragma("unroll") for (int k = 0; k < 2; ++k) dst[n][k] = *(const LAS bf16x8*)(lds + PG8_SB(b, h) + boff + n * 2048 + k * 1024); } while (0)
#define PG8_MMA(ai, bj, At, Bt) do { __builtin_amdgcn_s_setprio(1); _Pragma("unroll") for (int m = 0; m < 4; ++m) _Pragma("unroll") for (int n = 0; n < 2; ++n) { \
        if constexpr (FP8) { const v8i _a = __builtin_shufflevector(__builtin_bit_cast(v4i, At[m][0]), __builtin_bit_cast(v4i, At[m][1]), 0, 1, 2, 3, 4, 5, 6, 7), _b = __builtin_shufflevector(__builtin_bit_cast(v4i, Bt[n][0]), __builtin_bit_cast(v4i, Bt[n][1]), 0, 1, 2, 3, 4, 5, 6, 7); \
            asm volatile("v_mfma_scale_f32_16x16x128_f8f6f4 %0, %1, %2, %0, %3, %3 op_sel_hi:[0,0,0]" : "+v"(acc[ai][bj][m][n]) : "v"(_b), "v"(_a), "v"(sc8)); } \
        else { _Pragma("unroll") for (int k = 0; k < 2; ++k) acc[ai][bj][m][n] = __builtin_amdgcn_mfma_f32_16x16x32_bf16(Bt[n][k], At[m][k], acc[ai][bj][m][n], 0, 0, 0); } } __builtin_amdgcn_s_setprio(0); } while (0)
#define PG8_WAIT_V(n) asm volatile("s_waitcnt vmcnt(" #n ")" ::: "memory")
#define PG8_WAIT_L(n) asm volatile("s_waitcnt lgkmcnt(" #n ")" ::: "memory")
#define PG8_BAR __builtin_amdgcn_s_barrier()
#define PG8_SCHED __builtin_amdgcn_sched_barrier(0)
#define PG8_GLOAD(vo, u) do { if constexpr (GATHER) { const int* _gi = (const int*)(u).X; _Pragma("unroll") for (int _h = 0; _h < 2; ++_h) _Pragma("unroll") for (int _i = 0; _i < 2; ++_i) \
        (vo)[_h][_i] = (unsigned)_gi[_h * HALF + gR[_i]] * lda + (unsigned)gC[_i]; } } while (0)
    GUnit cur, nxt; int ui = 0;
    if (!S.next(0, cur)) return;
    f32x4 acc[2][2][4][2];
    const volatile LAS f32x4* zero16 = (const volatile LAS f32x4*)(lds + ZERO16_OFF);
#pragma unroll
    for (int a = 0; a < 2; ++a)
#pragma unroll
        for (int b = 0; b < 2; ++b)
#pragma unroll
            for (int m = 0; m < 4; ++m)
#pragma unroll
                for (int n = 0; n < 2; ++n) acc[a][b][m][n] = *zero16;
    bf16x8 At[4][2], B0[2][2], B1[2][2];
    const char* cA = cur.A; const char* cB = cur.B;
    PG8_GLOAD(cvo, cur);
    if constexpr (GATHER) { PG8_WAIT_V(0); }
    PG8_STAGE_B(PG8_SB(0, 0), cB, 0); PG8_STAGE_B(PG8_SB(0, 1), cB, 1); PG8_STAGE_A(PG8_SA(0, 0), cA, 0, cvo); PG8_STAGE_A(PG8_SA(0, 1), cA, 1, cvo);
    if (wr == 1) PG8_BAR;
    PG8_WAIT_V(2); PG8_BAR;
    PG8_STAGE_B(PG8_SB(1, 0), cB + kstep, 0); PG8_STAGE_A(PG8_SA(1, 0), cA + kstep, 0, cvo); PG8_STAGE_B(PG8_SB(1, 1), cB + kstep, 1);
    PG8_WAIT_V(6); PG8_BAR;
    for (;;) {
        const bool has_next = S.next(ui + 1, nxt);
        const char* nA = has_next ? nxt.A : cA; const char* nB = has_next ? nxt.B : cB;
        if constexpr (GATHER) { if (has_next) { PG8_GLOAD(nvo, nxt); } else {
#pragma unroll
            for (int h = 0; h < 2; ++h)
#pragma unroll
                for (int i = 0; i < 2; ++i) nvo[h][i] = cvo[h][i]; } }
        for (int t = 0; t < nt; t += 2) {
            const bool last = (t == nt - 2);
            const char* a1 = cA + (size_t)(t + 1) * kstep;
            const char* a2 = last ? nA : cA + (size_t)(t + 2) * kstep; const char* b2 = last ? nB : cB + (size_t)(t + 2) * kstep;
            const char* a3 = a2 + kstep; const char* b3 = b2 + kstep;
            unsigned vo2[2][2];
            if constexpr (GATHER) {
#pragma unroll
                for (int h = 0; h < 2; ++h)
#pragma unroll
                    for (int i = 0; i < 2; ++i) vo2[h][i] = last ? nvo[h][i] : cvo[h][i]; }
            PG8_LDB(B0, 0, 0); PG8_LDB(B1, 0, 1); PG8_SCHED; PG8_LDA(At, 0, 0); PG8_STAGE_A(PG8_SA(1, 1), a1, 1, cvo);
            PG8_WAIT_V(8); PG8_WAIT_L(0); PG8_BAR; PG8_MMA(0, 0, At, B0); PG8_MMA(0, 1, At, B1); PG8_BAR; PG8_SCHED;
            PG8_LDA(At, 0, 1); PG8_STAGE_B(PG8_SB(0, 0), b2, 0); PG8_STAGE_B(PG8_SB(0, 1), b2, 1); PG8_STAGE_A(PG8_SA(0, 0), a2, 0, vo2);
            PG8_WAIT_V(8); PG8_WAIT_L(0); PG8_BAR; PG8_MMA(1, 0, At, B0); PG8_MMA(1, 1, At, B1); PG8_BAR; PG8_SCHED;
            PG8_LDB(B0, 1, 0); PG8_LDB(B1, 1, 1); PG8_SCHED; PG8_LDA(At, 1, 0); PG8_STAGE_A(PG8_SA(0, 1), a2, 1, vo2);
            PG8_WAIT_V(8); PG8_WAIT_L(0); PG8_BAR; PG8_MMA(0, 0, At, B0); PG8_MMA(0, 1, At, B1); PG8_BAR; PG8_SCHED;
            PG8_LDA(At, 1, 1); PG8_STAGE_B(PG8_SB(1, 0), b3, 0); PG8_STAGE_B(PG8_SB(1, 1), b3, 1); PG8_STAGE_A(PG8_SA(1, 0), a3, 0, vo2);
            PG8_WAIT_V(8); PG8_WAIT_L(0); PG8_BAR; PG8_MMA(1, 0, At, B0); PG8_MMA(1, 1, At, B1); PG8_BAR; PG8_SCHED;
        }
        if constexpr (FP8) { asm volatile("s_nop 15\n\ts_nop 15" ::: "memory"); }
        if (wr == 0) PG8_BAR;
        E(acc, cur, wr, wc, fr, fq);
        if (!has_next) break;
#pragma unroll
        for (int a = 0; a < 2; ++a)
#pragma unroll
            for (int b = 0; b < 2; ++b)
#pragma unroll
                for (int m = 0; m < 4; ++m)
#pragma unroll
                    for (int n = 0; n < 2; ++n) acc[a][b][m][n] = *zero16;
        cur = nxt; cA = nA; cB = nB; ++ui;
        if constexpr (GATHER) {
#pragma unroll
            for (int h = 0; h < 2; ++h)
#pragma unroll
                for (int i = 0; i < 2; ++i) cvo[h][i] = nvo[h][i]; }
        if (wr == 1) PG8_BAR;
    }
    PG8_WAIT_V(0);
    PG8_BAR;
#undef PG8_SA
#undef PG8_SB
#undef PG8_STAGE
#undef PG8_STAGE_A
#undef PG8_STAGE_B
#undef PG8_LDA
#undef PG8_LDB
#undef PG8_MMA
#undef PG8_WAIT_V
#undef PG8_WAIT_L
#undef PG8_BAR
#undef PG8_SCHED
#undef PG8_GLOAD
}
typedef f32x4 Acc[2][2][4][2];
__device__ __forceinline__ float sigmoidf_fast(float x) { return __builtin_amdgcn_rcpf(1.f + __builtin_amdgcn_exp2f(-1.4426950408889634f * x)); }
__device__ __forceinline__ float gelu_tanh_fast(float y) {
    const float inner = 1.5957691216057308f * (y + 0.044715f * y * y * y);
    return y * sigmoidf_fast(inner);
}
__device__ __forceinline__ unsigned cvt4_fp8(float a, float b, float c, float d) {
    a = fminf(fmaxf(a, -448.f), 448.f); b = fminf(fmaxf(b, -448.f), 448.f); c = fminf(fmaxf(c, -448.f), 448.f); d = fminf(fmaxf(d, -448.f), 448.f);
    int w = 0; w = __builtin_amdgcn_cvt_pk_fp8_f32(a, b, w, false); w = __builtin_amdgcn_cvt_pk_fp8_f32(c, d, w, true); return (unsigned)w;
}
constexpr float FP8_SX = 8.f, FP8_SW13 = 32.f, FP8_SH = 8.f, FP8_SW2 = 64.f, FP8_SWQK = 32.f, FP8_SWQKV = 32.f;
struct EpiGated8 {
    static constexpr bool PERM = true;
    unsigned ldc;
    __device__ __forceinline__ void operator()(const Acc& acc, const GUnit& u, int wr, int wc, int fr, int fq) const {
        unsigned char* base = (unsigned char*)u.C;
        constexpr float kx = -1.4426950408889634f / (FP8_SX * FP8_SW13), ic = (FP8_SX * FP8_SW13) * (FP8_SX * FP8_SW13) / FP8_SH;
#pragma unroll
        for (int ai = 0; ai < 2; ++ai)
#pragma unroll
            for (int m = 0; m < 4; ++m) { const int r = ai * HALF + wr * 64 + m * 16 + fr;
                float o[8];
#pragma unroll
                for (int n = 0; n < 2; ++n)
#pragma unroll
                    for (int j = 0; j < 4; j += 2) {
                        const f32x2 a = {acc[ai][0][m][n][j], acc[ai][0][m][n][j + 1]}, b = {acc[ai][1][m][n][j], acc[ai][1][m][n][j + 1]};
                        const f32x2 t = a * f32x2{kx, kx};
                        const f32x2 e = {__builtin_amdgcn_exp2f(t[0]), __builtin_amdgcn_exp2f(t[1])};
                        const f32x2 d = e * f32x2{ic, ic} + f32x2{ic, ic};
                        const f32x2 s = {__builtin_amdgcn_rcpf(d[0]), __builtin_amdgcn_rcpf(d[1])};
                        const f32x2 q = (a * b) * s;
                        o[n * 4 + j] = __builtin_amdgcn_fmed3f(q[0], -448.f, 448.f); o[n * 4 + j + 1] = __builtin_amdgcn_fmed3f(q[1], -448.f, 448.f); }
                int w0 = 0, w1 = 0;
                w0 = __builtin_amdgcn_cvt_pk_fp8_f32(o[0], o[1], w0, false); w0 = __builtin_amdgcn_cvt_pk_fp8_f32(o[2], o[3], w0, true);
                w1 = __builtin_amdgcn_cvt_pk_fp8_f32(o[4], o[5], w1, false); w1 = __builtin_amdgcn_cvt_pk_fp8_f32(o[6], o[7], w1, true);
                u32x2 w; w.x = (unsigned)w0; w.y = (unsigned)w1;
                st8(base + (size_t)r * ldc + wc * 32 + 8 * fq, w); }
    }
};
struct EpiBf8 {
    static constexpr bool PERM = true;
    unsigned ldc; float scale;
    __device__ __forceinline__ void operator()(const Acc& acc, const GUnit& u, int wr, int wc, int fr, int fq) const {
        unsigned char* base = (unsigned char*)u.C;
#pragma unroll
        for (int ai = 0; ai < 2; ++ai)
#pragma unroll
            for (int m = 0; m < 4; ++m) { const int r = ai * HALF + wr * 64 + m * 16 + fr; unsigned char* rowp = base + (size_t)r * ldc + wc * 32 + 8 * fq;
#pragma unroll
                for (int bj = 0; bj < 2; ++bj) { const f32x4 v0 = acc[ai][bj][m][0] * scale, v1 = acc[ai][bj][m][1] * scale;
                    u32x2 w; w.x = cvt4_fp8(v0[0], v0[1], v0[2], v0[3]); w.y = cvt4_fp8(v1[0], v1[1], v1[2], v1[3]); st8(rowp + bj * HALF, w); } }
    }
};
template <bool ROWSCALE> struct EpiBf {
    static constexpr bool PERM = true;
    unsigned ldc; float scale;
    __device__ __forceinline__ void operator()(const Acc& acc, const GUnit& u, int wr, int wc, int fr, int fq) const {
        bf16_t* base = (bf16_t*)u.C; const float* rs = (const float*)u.X;
#pragma unroll
        for (int ai = 0; ai < 2; ++ai)
#pragma unroll
            for (int m = 0; m < 4; ++m) { const int r = ai * HALF + wr * 64 + m * 16 + fr; float s = scale; if (ROWSCALE) s *= rs[r];
                bf16_t* rowp = base + (size_t)r * ldc + wc * 32 + 8 * fq;
#pragma unroll
                for (int bj = 0; bj < 2; ++bj) { const f32x4 v0 = acc[ai][bj][m][0] * s, v1 = acc[ai][bj][m][1] * s;
                    u32x4 w; w.x = cvt_pk_bf16(v0[0], v0[1]); w.y = cvt_pk_bf16(v0[2], v0[3]); w.z = cvt_pk_bf16(v1[0], v1[1]); w.w = cvt_pk_bf16(v1[2], v1[3]);
                    st16(rowp + bj * HALF, w); } }
    }
};
template <int MODE> struct EpiGated {
    static constexpr bool PERM = true;
    unsigned ldc;
    __device__ __forceinline__ void operator()(const Acc& acc, const GUnit& u, int wr, int wc, int fr, int fq) const {
        bf16_t* base = (bf16_t*)u.C;
#pragma unroll
        for (int ai = 0; ai < 2; ++ai)
#pragma unroll
            for (int m = 0; m < 4; ++m) { const int r = ai * HALF + wr * 64 + m * 16 + fr;
                float o[8];
#pragma unroll
                for (int n = 0; n < 2; ++n)
#pragma unroll
                    for (int j = 0; j < 4; ++j) { const float a = acc[ai][0][m][n][j], b = acc[ai][1][m][n][j];
                        o[n * 4 + j] = (MODE == 0) ? a * sigmoidf_fast(b) : a * sigmoidf_fast(a) * b; }
                u32x4 w; w.x = cvt_pk_bf16(o[0], o[1]); w.y = cvt_pk_bf16(o[2], o[3]); w.z = cvt_pk_bf16(o[4], o[5]); w.w = cvt_pk_bf16(o[6], o[7]);
                st16(base + (size_t)r * ldc + wc * 32 + 8 * fq, w); }
    }
};
struct EpiUA {
    static constexpr bool PERM = true;
    __device__ __forceinline__ void operator()(const Acc& acc, const GUnit& u, int wr, int wc, int fr, int fq) const {
        bf16_t* UA = (bf16_t*)u.C;
#pragma unroll
        for (int ai = 0; ai < 2; ++ai)
#pragma unroll
            for (int m = 0; m < 4; ++m) { const int tok = u.pm * BM + ai * HALF + wr * 64 + m * 16 + fr; const int chunk = tok >> 5, j = tok & 31;
#pragma unroll
                for (int bj = 0; bj < 2; ++bj) { const int ch = u.pn * BM + bj * HALF + wc * 32 + 8 * fq, g = ch >> 4, h0 = ch & 15;
                    const f32x4 v0 = acc[ai][bj][m][0], v1 = acc[ai][bj][m][1];
                    u32x4 w; w.x = cvt_pk_bf16(v0[0], v0[1]); w.y = cvt_pk_bf16(v0[2], v0[3]); w.z = cvt_pk_bf16(v1[0], v1[1]); w.w = cvt_pk_bf16(v1[2], v1[3]);
                    st16(UA + ((size_t)g * NCHUNK + chunk) * UAK + j * 16 + h0, w); } }
    }
};
struct EpiS {
    static constexpr bool PERM = false;
    __device__ __forceinline__ void operator()(const Acc& acc, const GUnit& u, int wr, int wc, int fr, int fq) const {
        float* Sg = (float*)u.C;
#pragma unroll
        for (int ai = 0; ai < 2; ++ai)
#pragma unroll
            for (int m = 0; m < 4; ++m) { const int chunk = u.pm * BM + ai * HALF + wr * 64 + m * 16 + fr; float* rowp = Sg + (size_t)chunk * 256 + wc * 32 + 4 * fq;
#pragma unroll
                for (int bj = 0; bj < 2; ++bj)
#pragma unroll
                    for (int n = 0; n < 2; ++n) st16f(rowp + bj * HALF + n * 16, acc[ai][bj][m][n]); }
    }
};
struct EpiGelu {
    static constexpr bool PERM = true;
    __device__ __forceinline__ void operator()(const Acc& acc, const GUnit& u, int wr, int wc, int fr, int fq) const {
        bf16_t* Gg = (bf16_t*)u.C;
#pragma unroll
        for (int ai = 0; ai < 2; ++ai)
#pragma unroll
            for (int m = 0; m < 4; ++m) { const int chunk = u.pm * BM + ai * HALF + wr * 64 + m * 16 + fr;
#pragma unroll
                for (int bj = 0; bj < 2; ++bj) { const int n0 = u.pn * BM + bj * HALF + wc * 32 + 8 * fq, i = n0 >> 4, c0 = n0 & 15;
                    const f32x4 v0 = acc[ai][bj][m][0], v1 = acc[ai][bj][m][1];
                    u32x4 w; w.x = cvt_pk_bf16(gelu_tanh_fast(v0[0]), gelu_tanh_fast(v0[1])); w.y = cvt_pk_bf16(gelu_tanh_fast(v0[2]), gelu_tanh_fast(v0[3]));
                    w.z = cvt_pk_bf16(gelu_tanh_fast(v1[0]), gelu_tanh_fast(v1[1])); w.w = cvt_pk_bf16(gelu_tanh_fast(v1[2]), gelu_tanh_fast(v1[3]));
                    st16(Gg + ((size_t)chunk * TCH + i) * D + c0, w); } }
    }
};

struct EpiSoftmax {
    static constexpr bool PERM = true;
    LAS float* red; unsigned ldc; float scale;
    __device__ __forceinline__ void operator()(Acc& acc, const GUnit& u, int wr, int wc, int fr, int fq) const {
        bf16_t* base = (bf16_t*)u.C;
#pragma unroll
        for (int ai = 0; ai < 2; ++ai)
#pragma unroll
            for (int m = 0; m < 4; ++m) { float mx = -INFINITY;
#pragma unroll
                for (int bj = 0; bj < 2; ++bj)
#pragma unroll
                    for (int n = 0; n < 2; ++n) { const f32x4 v = acc[ai][bj][m][n]; mx = fmaxf(mx, fmaxf(fmaxf(v[0], v[1]), fmaxf(v[2], v[3]))); }
                mx *= scale; mx = x32_max(x16_max(mx));
                if (fq == 0) red[(ai * HALF + wr * 64 + m * 16 + fr) * 4 + wc] = mx; }
        asm volatile("s_waitcnt lgkmcnt(0)" ::: "memory"); __builtin_amdgcn_s_barrier(); asm volatile("" ::: "memory");
#pragma unroll
        for (int ai = 0; ai < 2; ++ai)
#pragma unroll
            for (int m = 0; m < 4; ++m) { const int r = ai * HALF + wr * 64 + m * 16 + fr; const f32x4 mm = *(const LAS f32x4*)(red + r * 4); const float M = fmaxf(fmaxf(mm[0], mm[1]), fmaxf(mm[2], mm[3]));
                float s = 0.f;
#pragma unroll
                for (int bj = 0; bj < 2; ++bj)
#pragma unroll
                    for (int n = 0; n < 2; ++n) { f32x4 v = acc[ai][bj][m][n];
#pragma unroll
                        for (int j = 0; j < 4; ++j) { v[j] = __builtin_amdgcn_exp2f(__builtin_fmaf(v[j], scale, -M)); s += v[j]; }
                        acc[ai][bj][m][n] = v; }
                s = x32_sum(x16_sum(s));
                if (fq == 0) red[1024 + r * 4 + wc] = s; }
        asm volatile("s_waitcnt lgkmcnt(0)" ::: "memory"); __builtin_amdgcn_s_barrier(); asm volatile("" ::: "memory");
#pragma unroll
        for (int ai = 0; ai < 2; ++ai)
#pragma unroll
            for (int m = 0; m < 4; ++m) { const int r = ai * HALF + wr * 64 + m * 16 + fr; const f32x4 ss = *(const LAS f32x4*)(red + 1024 + r * 4); const float inv = __builtin_amdgcn_rcpf((ss[0] + ss[1]) + (ss[2] + ss[3]));
                bf16_t* rowp = base + (size_t)r * ldc + wc * 32 + 8 * fq;
#pragma unroll
                for (int bj = 0; bj < 2; ++bj) { const f32x4 v0 = acc[ai][bj][m][0] * inv, v1 = acc[ai][bj][m][1] * inv;
                    u32x4 w; w.x = cvt_pk_bf16(v0[0], v0[1]); w.y = cvt_pk_bf16(v0[2], v0[3]); w.z = cvt_pk_bf16(v1[0], v1[1]); w.w = cvt_pk_bf16(v1[2], v1[3]);
                    st16(rowp + bj * HALF, w); } }
    }
};

struct Ctx { unsigned char* ws; int G, c; };
struct SchedPlain { const char* A; const char* B; char* C; size_t lda, ldb, ldc; int nM, nN, G, c;
    __device__ __forceinline__ bool next(int i, GUnit& u) const { int pm, pn; if (!static_unit(i, G, c, nM, nN, pm, pn)) return false;
        u.A = A + (size_t)pm * BM * lda; u.B = B + (size_t)pn * BM * ldb; u.C = C + ((size_t)pm * BM * ldc + (size_t)pn * BM) * 2; u.X = nullptr; u.pm = pm; u.pn = pn; return true; } };
struct SchedGated { const char* A; const char* B; char* C; size_t lda, ldb, ldc; int nM, nN, G, c;
    __device__ __forceinline__ bool next(int i, GUnit& u) const { int pm, pn; if (!static_unit(i, G, c, nM, nN, pm, pn)) return false;
        u.A = A + (size_t)pm * BM * lda; u.B = B + (size_t)pn * BM * ldb; u.C = C + ((size_t)pm * BM * ldc + (size_t)pn * HALF) * 2; u.X = nullptr; u.pm = pm; u.pn = pn; return true; } };
struct SchedUA { const char* A; const char* B; char* UA; int G, c;
    __device__ __forceinline__ bool next(int i, GUnit& u) const { int pm, pn; if (!static_unit(i, G, c, NT / BM, D / BM, pm, pn)) return false;
        u.A = A + (size_t)pm * BM * (D * 2); u.B = B + (size_t)pn * BM * (D * 2); u.C = UA; u.X = nullptr; u.pm = pm; u.pn = pn; return true; } };
struct SchedKV { unsigned char* ws; int G, c;
    __device__ __forceinline__ bool next(int i, GUnit& u) const { const int L = i * G + c; if (L >= 128) return false; const int layer = L >> 6, r = L & 63, pm = r >> 3, pn = r & 7;
        u.A = (const char*)ws + WS_MEMB + (size_t)pm * BM * 2048; u.B = (const char*)ws + WS_MWKV + (size_t)layer * 4 * MiB + (size_t)pn * BM * 2048;
        u.C = (char*)ws + WS_KV + (size_t)layer * 8 * MiB + ((size_t)pm * BM * 2048 + pn * BM) * 2; u.X = nullptr; u.pm = pm; u.pn = pn; return true; } };
struct SchedSA { unsigned char* ws; int G, c;
    __device__ __forceinline__ bool next(int i, GUnit& u) const { const int L = i * G + c; if (L >= 64 * 6) return false; const int g = L / 6, pm = L % 6;
        u.A = (const char*)ws + PO_UA + ((size_t)g * NCHUNK + (size_t)pm * BM) * (UAK * 2); u.B = (const char*)ws + PO_M2T + (size_t)g * 256 * 512 * 2;
        u.C = (char*)ws + PO_SG + (size_t)g * NCHUNK * 256 * 4; u.X = nullptr; u.pm = pm; u.pn = 0; return true; } };
struct SchedSC { unsigned char* ws; int G, c;
    __device__ __forceinline__ bool next(int i, GUnit& u) const { const int L = i * G + c; if (L >= 64 * 12) return false; const int g = L / 12, r = L % 12, pm = r >> 1, pn = r & 1;
        u.A = (const char*)ws + PO_UA + ((size_t)g * NCHUNK + (size_t)pm * BM) * (UAK * 2); u.B = (const char*)ws + PO_M13T + ((size_t)g * 512 + pn * BM) * UAK * 2;
        u.C = (char*)ws + PO_SG + (size_t)g * 16 * 2; u.X = nullptr; u.pm = pm; u.pn = pn; return true; } };
struct SchedWqk { unsigned char* ws; int G, c;
    __device__ __forceinline__ bool next(int i, GUnit& u) const { const int L = i * G + c; if (L >= 256) return false; const int pn = L & 3, h = (L >> 2) & 3, gb = (L >> 4) & 7, layer = L >> 7;
        u.A = (const char*)ws + WS_KV + (size_t)layer * 8 * MiB + ((size_t)gb * 256 * 2048 + h * 256) * 2; u.B = (const char*)ws + WS_MWQ + (size_t)layer * 2 * MiB + ((size_t)pn * BM * 1024 + h * 256) * 2;
        u.C = (char*)ws + WS_WQK + ((size_t)(layer * 8 + gb) * 1024 * 1024 + (size_t)h * 256 * 1024 + pn * BM); u.X = nullptr; u.pm = 0; u.pn = pn; return true; } };
struct SchedWvo { unsigned char* ws; int G, c;
    __device__ __forceinline__ bool next(int i, GUnit& u) const { const int L = i * G + c; if (L >= 256) return false; const int pm = L & 3, h = (L >> 2) & 3, gb = (L >> 4) & 7, layer = L >> 7;
        u.A = (const char*)ws + WS_MWO + (size_t)layer * 2 * MiB + ((size_t)pm * BM * 1024 + h * 256) * 2; u.B = (const char*)ws + WS_KV + (size_t)layer * 8 * MiB + ((size_t)gb * 256 * 2048 + 1024 + h * 256) * 2;
        u.C = (char*)ws + WS_WVO + ((size_t)(layer * 8 + gb) * 1024 * 1024 + (size_t)pm * BM * 1024 + h * 256) * 2; u.X = nullptr; u.pm = pm; u.pn = 0; return true; } };
struct SchedScores8 { const char* A; const char* Bl; char* C; int G, c;
    __device__ __forceinline__ bool next(int i, GUnit& u) const { int pm, pn; if (!static_unit(i, G, c, NT / BM, 4, pm, pn)) return false; const int gb = panel_gb(pm);
        u.A = A + (size_t)pm * BM * 1024; u.B = Bl + ((size_t)gb * 1024 + pn * BM) * 1024; u.C = C + ((size_t)pm * BM * 1024 + pn * BM) * 2; u.X = nullptr; u.pm = pm; u.pn = pn; return true; } };
struct SchedBatchW { const char* A; const char* Bl; char* C; int G, c;
    __device__ __forceinline__ bool next(int i, GUnit& u) const { int pm, pn; if (!static_unit(i, G, c, NT / BM, 4, pm, pn)) return false; const int gb = panel_gb(pm);
        u.A = A + (size_t)pm * BM * 2048; u.B = Bl + ((size_t)gb * 1024 + pn * BM) * 2048; u.C = C + ((size_t)pm * BM * 1024 + pn * BM) * 2; u.X = nullptr; u.pm = pm; u.pn = pn; return true; } };
struct Args { const float* in[26]; float* out; unsigned char* ws; int ph_lo, ph_hi, flags, pad; };
struct Frame {
    LAS unsigned char* lds; unsigned char* ws; const float* const* in; float* out;
    int tid, lane, wave, G, c;
    bool xok;
};
enum { I_XP = 0, I_XS, I_MEMP, I_MEMS, I_AWIN, I_ALRE, I_ALIM, I_ALDT, I_ABRE, I_ABIM, I_ACRE, I_ACIM, I_AD, I_AWGLU, I_BWQKV, I_BRPB, I_BWO, I_MWQ, I_MWKV, I_MWO, I_EWR, I_EW1, I_EW3, I_EW2, I_LNG, I_LNB };

__device__ __forceinline__ int rowmap(int mode, int n) {
    if (mode == 0) return n;
    if (mode == 1) { const int z = n >> 10, nn = n & 1023; return ((nn >> 7) << 8) + (z << 7) + (nn & 127); }
    return ((n >> 7) << 8) + ((mode == 3) ? 128 : 0) + (n & 127);
}
__device__ __forceinline__ void transpose_item(const float* W, int K, int N, bf16_t* WT, int mode, LAS float* scr, int item, int lane) {
    const int nblk = N / 32, kb = item / nblk, nb = item % nblk, k0 = 64 * kb, n0 = 32 * nb;
#pragma unroll 8
    for (int i = 0; i < 32; ++i) { const int kk = 2 * i + (lane >> 5); scr[kk * 33 + (lane & 31)] = W[(size_t)(k0 + kk) * N + n0 + (lane & 31)]; }
    LDS_WAIT(); asm volatile("" ::: "memory");
    const int c = lane & 7;
#pragma unroll
    for (int j = 0; j < 4; ++j) { const int n = (lane >> 3) + 8 * j; const LAS float* s = scr + (8 * c) * 33 + n;
        u32x4 o; o.x = cvt_pk_bf16(s[0 * 33], s[1 * 33]); o.y = cvt_pk_bf16(s[2 * 33], s[3 * 33]); o.z = cvt_pk_bf16(s[4 * 33], s[5 * 33]); o.w = cvt_pk_bf16(s[6 * 33], s[7 * 33]);
        *(u32x4*)(WT + (size_t)rowmap(mode, n0 + n) * K + k0 + 8 * c) = o; }
    LDS_WAIT(); asm volatile("" ::: "memory");
}
__device__ __forceinline__ void t8_load(f32x4 (&v)[16], const float* W, int N, int item, int lane) {
    const int nblk = N / 32, kb = item / nblk, nb = item % nblk, k0 = 128 * kb, n0 = 32 * nb, q = lane >> 3, c = lane & 7;
#pragma unroll
    for (int i = 0; i < 16; ++i) v[i] = *(const f32x4*)(W + (size_t)(k0 + 16 * q + i) * N + n0 + 4 * c);
}
__device__ __forceinline__ void t8_finish(const f32x4 (&v)[16], int K, int N, unsigned char* WT, int mode, float scale, LAS unsigned char* scr, int item, int lane) {
    const int nblk = N / 32, kb = item / nblk, nb = item % nblk, k0 = 128 * kb, n0 = 32 * nb, q = lane >> 3, c = lane & 7;
#pragma unroll
    for (int j = 0; j < 4; ++j) { u32x4 o;
        o.x = cvt4_fp8(v[0][j] * scale, v[1][j] * scale, v[2][j] * scale, v[3][j] * scale); o.y = cvt4_fp8(v[4][j] * scale, v[5][j] * scale, v[6][j] * scale, v[7][j] * scale);
        o.z = cvt4_fp8(v[8][j] * scale, v[9][j] * scale, v[10][j] * scale, v[11][j] * scale); o.w = cvt4_fp8(v[12][j] * scale, v[13][j] * scale, v[14][j] * scale, v[15][j] * scale);
        *(LAS u32x4*)(scr + (4 * c + j) * 144 + 16 * q) = o; }
    LDS_WAIT(); asm volatile("" ::: "memory");
#pragma unroll
    for (int j = 0; j < 4; ++j) { const int n = (lane >> 3) + 8 * j; const u32x4 o = *(const LAS u32x4*)(scr + n * 144 + 16 * c);
        pst16(WT + (size_t)rowmap(mode, n0 + n) * K + k0 + 16 * c, o); }
    LDS_WAIT(); asm volatile("" ::: "memory");
}
__device__ __forceinline__ void transpose_item8(const float* W, int K, int N, unsigned char* WT, int mode, float scale, LAS unsigned char* scr, int item, int lane) {
    f32x4 v[16]; t8_load(v, W, N, item, lane); t8_finish(v, K, N, WT, mode, scale, scr, item, lane);
}
__device__ __forceinline__ void transpose_item16(const float* W, int K, int N, bf16_t* WT, int mode, LAS unsigned char* scr, int item, int lane) {
    const int nblk = N / 32, kb = item / nblk, nb = item % nblk, k0 = 128 * kb, n0 = 32 * nb, q = lane >> 3, c = lane & 7;
    f32x4 v[16];
#pragma unroll
    for (int i = 0; i < 16; ++i) v[i] = *(const f32x4*)(W + (size_t)(k0 + 16 * q + i) * N + n0 + 4 * c);
#pragma unroll
    for (int j = 0; j < 4; ++j) { u32x4 o0, o1;
        o0.x = cvt_pk_bf16(v[0][j], v[1][j]); o0.y = cvt_pk_bf16(v[2][j], v[3][j]); o0.z = cvt_pk_bf16(v[4][j], v[5][j]); o0.w = cvt_pk_bf16(v[6][j], v[7][j]);
        o1.x = cvt_pk_bf16(v[8][j], v[9][j]); o1.y = cvt_pk_bf16(v[10][j], v[11][j]); o1.z = cvt_pk_bf16(v[12][j], v[13][j]); o1.w = cvt_pk_bf16(v[14][j], v[15][j]);
        *(LAS u32x4*)(scr + (4 * c + j) * 272 + 32 * q) = o0; *(LAS u32x4*)(scr + (4 * c + j) * 272 + 32 * q + 16) = o1; }
    LDS_WAIT(); asm volatile("" ::: "memory");
#pragma unroll
    for (int j = 0; j < 8; ++j) { const int n = (lane >> 4) + 4 * j, ch = lane & 15; const u32x4 o = *(const LAS u32x4*)(scr + n * 272 + 16 * ch);
        *(u32x4*)(WT + (size_t)rowmap(mode, n0 + n) * K + k0 + 8 * ch) = o; }
    LDS_WAIT(); asm volatile("" ::: "memory");
}
__device__ __forceinline__ void convert_small_weights(Frame& F) {
    LAS unsigned char* scr = F.lds + F.wave * 16384;
    const int gw = F.c * 8 + F.wave, NGW = F.G * 8;
    for (int it = gw; it < 3328; it += NGW) {
        int r = it;
        if (r < 256) { transpose_item16(F.in[I_AWIN], 1024, 1024, (bf16_t*)(F.ws + WS_WIN), 0, scr, r, F.lane); continue; } r -= 256;
        if (r < 512) { transpose_item16(F.in[I_AWGLU], 1024, 2048, (bf16_t*)(F.ws + WS_WGLU), 1, scr, r, F.lane); continue; } r -= 512;
        if (r < 768) { transpose_item8(F.in[I_BWQKV], 1024, 3072, F.ws + WS_WQKV, 0, FP8_SWQKV, scr, r, F.lane); continue; } r -= 768;
        if (r < 256) { transpose_item16(F.in[I_BWO], 1024, 1024, (bf16_t*)(F.ws + WS_WO), 0, scr, r, F.lane); continue; } r -= 256;
        if (r < 1024) { const int l = r >> 9; transpose_item16(F.in[I_MWKV] + (size_t)l * 1024 * 2048, 1024, 2048, (bf16_t*)(F.ws + WS_MWKV + (size_t)l * 4 * MiB), 0, scr, r & 511, F.lane); continue; } r -= 1024;
        { const int l = r >> 8; transpose_item16(F.in[I_MWO] + (size_t)l * 1024 * 1024, 1024, 1024, (bf16_t*)(F.ws + WS_MWO + (size_t)l * 2 * MiB), 0, scr, r & 255, F.lane); }
    }
}
__device__ __forceinline__ void convert_expert_weights(Frame& F, int layer, int lo = 0, int hi = 16 * 1536, int wg0 = 0) {
    if (F.G <= wg0) wg0 = 0;
    if (F.c < wg0) return;
    LAS unsigned char* scr = F.lds + F.wave * 16384;
    const int gw = (F.c - wg0) * 8 + F.wave, NGW = (F.G - wg0) * 8;
#define CVX_DECODE(it_) const int _e = (it_) / 1536; int _r = (it_) % 1536; const size_t _wofs = ((size_t)layer * 16 + _e) * 1024 * 2048; \
        const int _w = _r >> 9; _r &= 511; const float* _W = (_w == 0 ? F.in[I_EW1] : (_w == 1 ? F.in[I_EW3] : F.in[I_EW2])) + _wofs; const int _N = _w == 2 ? 1024 : 2048, _K = _w == 2 ? 2048 : 1024;
#define CVX_LOAD(v_, it_) do { CVX_DECODE(it_); (void)_K; t8_load(v_, _W, _N, _r, F.lane); } while (0)
#define CVX_FINISH(v_, it_) do { CVX_DECODE(it_); unsigned char* _WT = _w == 2 ? F.ws + WS_EW2 + (size_t)_e * 2 * MiB : F.ws + WS_EW13 + (size_t)_e * 4 * MiB; \
        t8_finish(v_, _K, _N, _WT, _w == 0 ? 2 : (_w == 1 ? 3 : 0), _w == 2 ? FP8_SW2 : FP8_SW13, scr, _r, F.lane); } while (0)
    f32x4 va[16], vb[16];
    int it = lo + gw;
    if (it < hi) CVX_LOAD(va, it);
    while (it < hi) {
        const int it1 = it + NGW, it2 = it1 + NGW;
        if (it1 < hi) CVX_LOAD(vb, it1);
        CVX_FINISH(va, it);
        if (it1 < hi) { if (it2 < hi) CVX_LOAD(va, it2); CVX_FINISH(vb, it1); }
        it = it2;
    }
#undef CVX_DECODE
#undef CVX_LOAD
#undef CVX_FINISH
}
__device__ __forceinline__ void convert_plain(Frame& F, const float* src, bf16_t* dst, size_t n) {
    const size_t n4 = n / 4;
    for (size_t i = (size_t)F.c * 512 + F.tid; i < n4; i += (size_t)F.G * 512) { const f32x4 v = ((const f32x4*)src)[i]; u32x2 w; w.x = cvt_pk_bf16(v[0], v[1]); w.y = cvt_pk_bf16(v[2], v[3]); ((u32x2*)dst)[i] = w; }
}
__device__ __forceinline__ void import_x(Frame& F, bool copy_f32) {
    const size_t n4 = (size_t)NT * D / 4, np4 = (size_t)NTP * D / 4, st = (size_t)F.G * 512;
    f32x4* XF = (f32x4*)(F.ws + WS_XF); u32x2* XB = (u32x2*)(F.ws + WS_XB);
    for (size_t i0 = (size_t)F.c * 512 + F.tid; i0 < n4; i0 += st * 8) {
        f32x4 v[8];
#pragma unroll
        for (int u = 0; u < 8; ++u) { const size_t i = i0 + st * u;
            if (i < n4) { if (copy_f32) { v[u] = (i < np4) ? ((const f32x4*)F.in[I_XP])[i] : ((const f32x4*)F.in[I_XS])[i - np4]; } else v[u] = XF[i]; } }
#pragma unroll
        for (int u = 0; u < 8; ++u) { const size_t i = i0 + st * u;
            if (i < n4) { u32x2 w; w.x = cvt_pk_bf16(v[u][0], v[u][1]); w.y = cvt_pk_bf16(v[u][2], v[u][3]); XB[i] = w; } }
    }
}

__device__ __forceinline__ void s5_lam(const float* lre, const float* lim, const float* ldt, int dir, int g, int p, double& dt, double& lr, double& li) {
    dt = exp((double)ldt[dir * 64 + g]); lr = (double)lre[(dir * 64 + g) * 64 + p]; li = (double)lim[(dir * 64 + g) * 64 + p];
}
__device__ __forceinline__ void s5_fill_bc(Frame& F, int g, int dir, LAS float* Bbr, LAS float* Bbi, LAS float* Cr, LAS float* Ci) {
    for (int idx = F.tid; idx < 1024; idx += 512) {
        const int p = idx >> 4, h = idx & 15; double dt, lr, li; s5_lam(F.in[I_ALRE], F.in[I_ALIM], F.in[I_ALDT], dir, g, p, dt, lr, li);
        const double er = exp(lr * dt), lbr = er * cos(li * dt), lbi = er * sin(li * dt), nr = lbr - 1.0, ni = lbi, den = lr * lr + li * li;
        const double fr = (nr * lr + ni * li) / den, fi = (ni * lr - nr * li) / den;
        const double br = F.in[I_ABRE][((dir * 64 + g) * 64 + p) * 16 + h], bi = F.in[I_ABIM][((dir * 64 + g) * 64 + p) * 16 + h];
        Bbr[idx] = (float)(fr * br - fi * bi); Bbi[idx] = (float)(fr * bi + fi * br);
        Cr[idx] = F.in[I_ACRE][(dir * 64 + g) * 1024 + idx]; Ci[idx] = F.in[I_ACIM][(dir * 64 + g) * 1024 + idx];
    }
}
__device__ __forceinline__ void s5_build_item(Frame& F, int g, int dir) {
    LAS float* LPr = (LAS float*)F.lds; LAS float* LPi = LPr + 33 * 64;
    LAS float* Bbr = LPi + 33 * 64; LAS float* Bbi = Bbr + 1024; LAS float* Cr = Bbi + 1024; LAS float* Ci = Cr + 1024;
    LAS float* B2r = Ci + 1024; LAS float* B2i = B2r + 1024; LAS float* C2r = B2i + 1024; LAS float* C2i = C2r + 1024;
    LAS float* KD = C2i + 1024;
    bf16_t* M2T = (bf16_t*)(F.ws + PO_M2T) + (size_t)g * 256 * 512; bf16_t* M13T = (bf16_t*)(F.ws + PO_M13T) + (size_t)g * 512 * UAK;
    __syncthreads();
    for (int idx = F.tid; idx < 33 * 64; idx += 512) { const int e = idx >> 6, p = idx & 63; double dt, lr, li; s5_lam(F.in[I_ALRE], F.in[I_ALIM], F.in[I_ALDT], dir, g, p, dt, lr, li);
        const double er = exp(lr * dt * e); LPr[idx] = (float)(er * cos(li * dt * e)); LPi[idx] = (float)(er * sin(li * dt * e)); }
    s5_fill_bc(F, g, dir, Bbr, Bbi, Cr, Ci);
    if (dir == 0) s5_fill_bc(F, g, 1, B2r, B2i, C2r, C2i);
    __syncthreads();
    {
        const int k = F.tid, j = k >> 4, h = k & 15, e = dir == 0 ? (TCH - 1 - j) : j;
        for (int p = 0; p < 64; ++p) { const float lr = LPr[e * 64 + p], li = LPi[e * 64 + p], br = Bbr[p * 16 + h], bi = Bbi[p * 16 + h];
            const float xr = lr * br - li * bi, xi = lr * bi + li * br;
            M2T[(size_t)(dir * 128 + p) * 512 + k] = (bf16_t)(cvt_pk_bf16(xr, 0.f) & 0xffffu); M2T[(size_t)(dir * 128 + 64 + p) * 512 + k] = (bf16_t)(cvt_pk_bf16(xi, 0.f) & 0xffffu); }
    }
    {
        const int p = F.tid & 63, q8 = F.tid >> 6;
        for (int ic = q8; ic < 512; ic += 8) { const int i = ic >> 4, c = ic & 15, e = dir == 0 ? (i + 1) : (TCH - i);
            const float cr = Cr[c * 64 + p], ci = Ci[c * 64 + p], lr = LPr[e * 64 + p], li = LPi[e * 64 + p];
            const float vr = cr * lr - ci * li, vi = cr * li + ci * lr;
            M13T[(size_t)ic * UAK + 512 + dir * 128 + p] = (bf16_t)(cvt_pk_bf16(vr, 0.f) & 0xffffu); M13T[(size_t)ic * UAK + 512 + dir * 128 + 64 + p] = (bf16_t)(cvt_pk_bf16(-vi, 0.f) & 0xffffu); }
    }
    {
        const int ch = F.tid & 255, c = ch >> 4, h = ch & 15, par = F.tid >> 8;
        if (dir == 0 && par == 0) {
            float s = (c == h) ? F.in[I_AD][g * 16 + c] : 0.f;
            for (int p = 0; p < 64; ++p) s += Cr[c * 64 + p] * Bbr[p * 16 + h] - Ci[c * 64 + p] * Bbi[p * 16 + h] + C2r[c * 64 + p] * B2r[p * 16 + h] - C2i[c * 64 + p] * B2i[p * 16 + h];
            KD[ch] = s;
        }
#pragma nounroll
        for (int hp = 0; hp < 64; hp += 32) {
            float cbr[32], cbi[32];
#pragma unroll
            for (int p = 0; p < 32; ++p) { const float cr = Cr[c * 64 + hp + p], ci = Ci[c * 64 + hp + p], br = Bbr[(hp + p) * 16 + h], bi = Bbi[(hp + p) * 16 + h]; cbr[p] = cr * br - ci * bi; cbi[p] = cr * bi + ci * br; }
#pragma nounroll
            for (int d = 1 + par; d < TCH; d += 2) {
                float s0 = 0.f, s1 = 0.f;
#pragma unroll
                for (int p = 0; p < 32; p += 4) { const f32x4 lr = *(const LAS f32x4*)(LPr + d * 64 + hp + p), li = *(const LAS f32x4*)(LPi + d * 64 + hp + p);
                    s0 += cbr[p] * lr[0]; s1 -= cbi[p] * li[0]; s0 += cbr[p + 1] * lr[1]; s1 -= cbi[p + 1] * li[1]; s0 += cbr[p + 2] * lr[2]; s1 -= cbi[p + 2] * li[2]; s0 += cbr[p + 3] * lr[3]; s1 -= cbi[p + 3] * li[3]; }
                if (hp == 0) KD[d * 256 + ch] = s0 + s1; else KD[d * 256 + ch] += s0 + s1;
            }
        }
        __syncthreads();
        for (int idx = F.tid; idx < 512 * 64; idx += 512) { const int hf = idx & 1, j = (idx >> 1) & 31, ic = idx >> 6, i = ic >> 4, cc = ic & 15;
            const bool mine = dir == 0 ? (j <= i) : (j > i);
            if (mine) { const int d = dir == 0 ? (i - j) : (j - i); const f32x4 v0 = *(const LAS f32x4*)(KD + d * 256 + cc * 16 + hf * 8), v1 = *(const LAS f32x4*)(KD + d * 256 + cc * 16 + hf * 8 + 4);
                u32x4 v; v.x = cvt_pk_bf16(v0[0], v0[1]); v.y = cvt_pk_bf16(v0[2], v0[3]); v.z = cvt_pk_bf16(v1[0], v1[1]); v.w = cvt_pk_bf16(v1[2], v1[3]); *(u32x4*)(M13T + (size_t)ic * UAK + j * 16 + hf * 8) = v; } }
    }
    __syncthreads();
}

__device__ __forceinline__ void s5_recurrence(Frame& F) {
    const float* S = (const float*)(F.ws + PO_SG); bf16_t* UA = (bf16_t*)(F.ws + PO_UA);
    for (int base = F.c * 256; base < 65536; base += F.G * 256) {
        if (F.tid >= 256) continue;
        const int flat = base + F.tid, p = flat & 63, dir = (flat >> 6) & 1, g = (flat >> 7) & 63, gb = flat >> 13;
        double dt, lr, li; s5_lam(F.in[I_ALRE], F.in[I_ALIM], F.in[I_ALDT], dir, g, p, dt, lr, li);
        const double er = exp(lr * dt * TCH); const float ar = (float)(er * cos(li * dt * TCH)), ai = (float)(er * sin(li * dt * TCH));
        const int nc = gb < 4 ? 256 : 128, chunk0 = gb < 4 ? gb * 256 : 1024 + (gb - 4) * 128;
        float hr = 0.f, hi = 0.f;
        for (int s0 = 0; s0 < nc; s0 += 8) {
            float sr[8], si[8];
#pragma unroll
            for (int k = 0; k < 8; ++k) { const int cc = dir == 0 ? (s0 + k) : (nc - 1 - s0 - k); const size_t o = ((size_t)g * NCHUNK + (chunk0 + cc)) * 256 + dir * 128 + p; sr[k] = S[o]; si[k] = S[o + 64]; }
#pragma unroll
            for (int k = 0; k < 8; ++k) { const int cc = dir == 0 ? (s0 + k) : (nc - 1 - s0 - k); const size_t o = ((size_t)g * NCHUNK + (chunk0 + cc)) * UAK + 512 + dir * 128 + p;
                UA[o] = (bf16_t)(cvt_pk_bf16(hr, 0.f) & 0xffffu); UA[o + 64] = (bf16_t)(cvt_pk_bf16(hi, 0.f) & 0xffffu);
                const float nr = ar * hr - ai * hi + sr[k], ni = ar * hi + ai * hr + si[k]; hr = nr; hi = ni; }
        }
    }
}

__device__ __forceinline__ void add_bf16x4(f32x4& v, const u32x2 w) { v[0] += __uint_as_float(w.x << 16); v[1] += __uint_as_float(w.x & 0xffff0000u); v[2] += __uint_as_float(w.y << 16); v[3] += __uint_as_float(w.y & 0xffff0000u); }
constexpr int WRS = 1028;
__device__ __forceinline__ void ln_router_fill(Frame& F, const float* gam, const float* bet, const float* wrouter) {
    LAS float* wrT = (LAS float*)F.lds; LAS float* gsh = wrT + 16 * WRS; LAS float* bsh = gsh + 1024;
    __syncthreads();
    for (int i = F.tid; i < 16384; i += 512) { const int k = i >> 4, e = i & 15; wrT[e * WRS + k] = wrouter[i]; }
    for (int i = F.tid; i < 1024; i += 512) { gsh[i] = gam[i]; bsh[i] = bet[i]; }
    __syncthreads();
}
#ifndef RES_BF16
#define RES_BF16 1
#endif
template <int MODE, bool ROUTER, bool FINAL, bool SRCIN = false>
__device__ __forceinline__ void ln_phase(Frame& F, const bf16_t* HB, const float* gam, const float* bet, const float* wrouter) {
    float* XF = (float*)(F.ws + WS_XF);
    LAS float* wrT = (LAS float*)F.lds;
    LAS float* gsh = wrT + 16 * WRS; LAS float* bsh = gsh + 1024;
    f32x4 gv[4], bv[4];
    if (!ROUTER) {
#pragma unroll
        for (int j = 0; j < 4; ++j) { gv[j] = *(const f32x4*)(gam + F.lane * 4 + 256 * j); bv[j] = *(const f32x4*)(bet + F.lane * 4 + 256 * j); } }
    const unsigned char* wsb = F.ws; int ln = F.lane; unsigned lb4 = (unsigned)ln * 16u, lb2 = (unsigned)ln * 8u, lb1 = (unsigned)ln * 4u;
    const unsigned hb_off = (unsigned)((const unsigned char*)HB - wsb);
    const int nq = F.xok ? 6 : (NT / 4 + F.G * 8 - 1) / (F.G * 8);
    constexpr bool X32 = SRCIN || !RES_BF16;
    f32x4 xr32[4][4]; u32x2 xr16[4][4], hwr[4][4];
#define LN_ISSUE(row0_) do { const int _r0 = (row0_); \
        const unsigned char* xbase = SRCIN ? (_r0 < NTP ? (const unsigned char*)F.in[I_XP] : (const unsigned char*)F.in[I_XS] - (size_t)NTP * 4096) : wsb + WS_XF;      \
        if (X32) { _Pragma("unroll") for (int r = 0; r < 4; ++r) { const unsigned ro = (unsigned)(_r0 + r) * 4096u + lb4; _Pragma("unroll") for (int j = 0; j < 4; ++j) xr32[r][j] = *(const f32x4*)(xbase + ro + 1024u * j); } } \
        else { _Pragma("unroll") for (int r = 0; r < 4; ++r) { const unsigned ro = (unsigned)(_r0 + r) * 2048u + lb2; _Pragma("unroll") for (int j = 0; j < 4; ++j) xr16[r][j] = *(const u32x2*)(xbase + ro + 512u * j); } } \
        if (MODE == 0) { _Pragma("unroll") for (int r = 0; r < 4; ++r) { const unsigned ro = hb_off + (unsigned)(_r0 + r) * 2048u + lb2; _Pragma("unroll") for (int j = 0; j < 4; ++j) hwr[r][j] = *(const u32x2*)(wsb + ro + 512u * j); } } \
    } while (0)
#define LN_Q(qi_) (F.xok ? ((F.c & 7) * 1536 + (F.c >> 3) * 48 + F.wave * 6 + (qi_)) : (F.c * 8 + F.wave + (qi_) * F.G * 8))
    u32x4 sln = {~0u, ~0u, ~0u, ~0u};
    if (MODE == 1) { const int q0 = LN_Q(0); if (nq > 0 && q0 < NT / 4 && F.lane < 16) sln = *(const u32x4*)(wsb + (unsigned)(WS_SLOT + ((size_t)F.lane * NT + (size_t)q0 * 4) * 4)); }
    { const int q0 = LN_Q(0); if (nq > 0 && q0 < NT / 4) { LN_ISSUE(q0 * 4); } }
    for (int qi = 0; qi < nq; ++qi) {
        const int q = LN_Q(qi);
        if (q >= NT / 4) break;
        const int row0 = q * 4;
        const u32x4 slc = sln;
        if (MODE == 1) { const int qn = LN_Q(qi + 1); if (qi + 1 < nq && qn < NT / 4 && ln < 16) sln = *(const u32x4*)(wsb + (unsigned)(WS_SLOT + ((size_t)ln * NT + (size_t)qn * 4) * 4)); }
        asm volatile("v_mbcnt_lo_u32_b32 %0, -1, 0\n\tv_mbcnt_hi_u32_b32 %0, -1, %0" : "=v"(ln));
        lb4 = (unsigned)ln * 16u; lb2 = (unsigned)ln * 8u; lb1 = (unsigned)ln * 4u; const int lw = ln * 4;
        f32x4 v[4][4];
#pragma unroll
        for (int r = 0; r < 4; ++r)
#pragma unroll
            for (int j = 0; j < 4; ++j) {
                if (X32) v[r][j] = xr32[r][j];
                else { v[r][j][0] = __uint_as_float(xr16[r][j].x << 16); v[r][j][1] = __uint_as_float(xr16[r][j].x & 0xffff0000u); v[r][j][2] = __uint_as_float(xr16[r][j].y << 16); v[r][j][3] = __uint_as_float(xr16[r][j].y & 0xffff0000u); } }
        if (MODE == 0) {
#pragma unroll
            for (int r = 0; r < 4; ++r)
#pragma unroll
                for (int j = 0; j < 4; ++j) { v[r][j] = v[r][j] * ALPHA; add_bf16x4(v[r][j], hwr[r][j]); }
        }
        if (!ROUTER) { const int qn = LN_Q(qi + 1); if (qi + 1 < nq && qn < NT / 4) { LN_ISSUE(qn * 4); } }
        if (MODE == 0) {
        } else {
            const int grp = row0 >= NTP; int sl[4];
#pragma unroll
            for (int r = 0; r < 4; ++r) sl[r] = (ln < 16) ? (int)slc[r] : -1;
            unsigned long long mask[4]; bool any[4], two[4]; u32x2 wa[4][4], wb[4][4];
#pragma unroll
            for (int r = 0; r < 4; ++r) {
                unsigned long long mk = __ballot(sl[r] >= 0); any[r] = mk != 0ull;
                int e0 = 0, s0 = 0; if (any[r]) { e0 = __builtin_ctzll(mk); mk &= mk - 1; s0 = __builtin_amdgcn_readlane(sl[r], e0); }
                const unsigned y0 = any[r] ? (grp ? 65536u + e0 * 2048u + s0 : e0 * 4096u + s0) : 0u;
                two[r] = mk != 0ull; int e1 = 0, s1 = 0; if (two[r]) { e1 = __builtin_ctzll(mk); mk &= mk - 1; s1 = __builtin_amdgcn_readlane(sl[r], e1); }
                const unsigned y1 = two[r] ? (grp ? 65536u + e1 * 2048u + s1 : e1 * 4096u + s1) : y0;
                mask[r] = mk;
                const unsigned char* ya = wsb + PO_YE + (size_t)y0 * 2048; const unsigned char* yb = wsb + PO_YE + (size_t)y1 * 2048;
#pragma unroll
                for (int j = 0; j < 4; ++j) { wa[r][j] = *(const u32x2*)(ya + lb2 + 512u * j); wb[r][j] = *(const u32x2*)(yb + lb2 + 512u * j); }
            }
#pragma unroll
            for (int r = 0; r < 4; ++r) {
#pragma unroll
                for (int j = 0; j < 4; ++j) { v[r][j] = v[r][j] * ALPHA; if (any[r]) add_bf16x4(v[r][j], wa[r][j]); if (two[r]) add_bf16x4(v[r][j], wb[r][j]); }
                unsigned long long mk = mask[r];
                while (mk) {
                    const int e0 = __builtin_ctzll(mk); mk &= mk - 1; const int s0 = __builtin_amdgcn_readlane(sl[r], e0);
                    const unsigned y0 = grp ? 65536u + e0 * 2048u + s0 : e0 * 4096u + s0;
                    const bool tw = mk != 0ull; int e1 = 0, s1 = 0; if (tw) { e1 = __builtin_ctzll(mk); mk &= mk - 1; s1 = __builtin_amdgcn_readlane(sl[r], e1); }
                    const unsigned y1 = tw ? (grp ? 65536u + e1 * 2048u + s1 : e1 * 4096u + s1) : y0;
                    const unsigned char* ya = wsb + PO_YE + (size_t)y0 * 2048; const unsigned char* yb = wsb + PO_YE + (size_t)y1 * 2048;
                    u32x2 xa[4], xb[4];
#pragma unroll
                    for (int j = 0; j < 4; ++j) { xa[j] = *(const u32x2*)(ya + lb2 + 512u * j); xb[j] = *(const u32x2*)(yb + lb2 + 512u * j); }
#pragma unroll
                    for (int j = 0; j < 4; ++j) { add_bf16x4(v[r][j], xa[j]); if (tw) add_bf16x4(v[r][j], xb[j]); }
                }
            }
        }
#pragma unroll
        for (int r = 0; r < 4; ++r) {
            float s = 0.f;
#pragma unroll
            for (int j = 0; j < 4; ++j) s += (v[r][j][0] + v[r][j][1]) + (v[r][j][2] + v[r][j][3]);
            const float mean = wave_sum(s) * (1.f / D); float qq = 0.f;
#pragma unroll
            for (int j = 0; j < 4; ++j) { v[r][j] = v[r][j] - mean; qq += (v[r][j][0] * v[r][j][0] + v[r][j][1] * v[r][j][1]) + (v[r][j][2] * v[r][j][2] + v[r][j][3] * v[r][j][3]); }
            const float rstd = 1.f / sqrtf(wave_sum(qq) * (1.f / D) + LN_EPS);
#pragma unroll
            for (int j = 0; j < 4; ++j) { if (ROUTER) { gv[j] = *(const LAS f32x4*)(gsh + lw + 256 * j); bv[j] = *(const LAS f32x4*)(bsh + lw + 256 * j); } v[r][j] = v[r][j] * rstd * gv[j] + bv[j]; }
            const unsigned row = (unsigned)(row0 + r);
            if (FINAL) {
                unsigned char* ob = (unsigned char*)F.out;
#pragma unroll
                for (int j = 0; j < 4; ++j) *(f32x4*)(ob + (size_t)(row * 4096u + lb4 + 1024u * j)) = v[r][j];
            } else {
                unsigned char* wsw = F.ws;
#pragma unroll
                for (int j = 0; j < 4; ++j) {
                    if (RES_BF16) { u32x2 xo; xo.x = cvt_pk_bf16_c(v[r][j][0], v[r][j][1]); xo.y = cvt_pk_bf16_c(v[r][j][2], v[r][j][3]); *(u32x2*)(wsw + (unsigned)(WS_XF + row * 2048u + lb2 + 512u * j)) = xo; }
                    else *(f32x4*)(wsw + (unsigned)(WS_XF + row * 4096u + lb4 + 1024u * j)) = v[r][j];
                    *(unsigned*)(wsw + (unsigned)(WS_XB8 + row * 1024u + lb1 + 256u * j)) = cvt4_fp8(v[r][j][0] * FP8_SX, v[r][j][1] * FP8_SX, v[r][j][2] * FP8_SX, v[r][j][3] * FP8_SX); }
            }
        }
        if (ROUTER) {
            { const int qn = LN_Q(qi + 1); if (qi + 1 < nq && qn < NT / 4) { LN_ISSUE(qn * 4); } }
            float val[64];
#pragma unroll
            for (int hf = 0; hf < 4; ++hf) {
                f32x2 a2[4][4];
#pragma unroll
                for (int r = 0; r < 4; ++r)
#pragma unroll
                    for (int e4 = 0; e4 < 4; ++e4) a2[r][e4] = f32x2{0.f, 0.f};
#pragma unroll
                for (int e4 = 0; e4 < 4; ++e4)
#pragma unroll
                    for (int j = 0; j < 4; ++j) { const f32x4 w = *(const LAS f32x4*)(wrT + (hf * 4 + e4) * WRS + lw + 256 * j);
                        const f32x2 wl = f32x2{w[0], w[1]}, wh = f32x2{w[2], w[3]};
#pragma unroll
                        for (int r = 0; r < 4; ++r) { a2[r][e4] = f32x2{v[r][j][0], v[r][j][1]} * wl + a2[r][e4]; a2[r][e4] = f32x2{v[r][j][2], v[r][j][3]} * wh + a2[r][e4]; } }
#pragma unroll
                for (int r = 0; r < 4; ++r)
#pragma unroll
                    for (int e4 = 0; e4 < 4; ++e4) val[r * 16 + hf * 4 + e4] = a2[r][e4][0] + a2[r][e4][1];
            }
#pragma unroll
            for (int sft = 5; sft >= 0; --sft) { const int n2 = 1 << sft; const bool up = (ln >> sft) & 1;
#pragma unroll
                for (int i = 0; i < n2; ++i) { const float lo = val[i], hi = val[i + n2]; const float mine = up ? hi : lo, other = up ? lo : hi; val[i] = mine + __shfl_xor(other, n2); } }
            const float lg = val[0], m = row_max(lg);
            const float ex = expf(lg - m); const float l = row_sum(ex);
            *(float*)(F.ws + (unsigned)(WS_AFF + ((size_t)(ln & 15) * NT + row0 + (ln >> 4)) * 4)) = ex / l;
        }
    }
#undef LN_Q
#undef LN_ISSUE
    if (ROUTER) __syncthreads();
}
__device__ __forceinline__ void softmax_phase(Frame& F, bf16_t* SB) {
    for (int row = F.c * 8 + F.wave; row < NT * 4; row += F.G * 8) {
        u32x2* p = (u32x2*)(SB + (size_t)row * 256) + F.lane; const u32x2 w = *p;
        float a = __uint_as_float(w.x << 16), b = __uint_as_float(w.x & 0xffff0000u), c = __uint_as_float(w.y << 16), d = __uint_as_float(w.y & 0xffff0000u);
        const float m = wave_max(fmaxf(fmaxf(a, b), fmaxf(c, d)));
        a = __expf(a - m); b = __expf(b - m); c = __expf(c - m); d = __expf(d - m);
        const float inv = 1.f / wave_sum((a + b) + (c + d));
        u32x2 o; o.x = cvt_pk_bf16(a * inv, b * inv); o.y = cvt_pk_bf16(c * inv, d * inv); *p = o;
    }
}
__device__ __forceinline__ void moe_panel(int P, int& e, int& grp, int& yerow0) {
    if (P < 256) { e = P >> 4; grp = 0; } else { e = (P - 256) >> 3; grp = 1; }
    yerow0 = P * 256;
}
#ifndef UPWGM
#define UPWGM 8
#endif
struct SchedUp { unsigned char* ws; int G, c;
    __device__ __forceinline__ bool next(int i, GUnit& u) const { int P, pn; if (!static_unit<UPWGM>(i, G, c, 384, 16, P, pn)) return false; int e, grp, y0; moe_panel(P, e, grp, y0);
        u.A = (const char*)ws + WS_XB8 + (grp ? (size_t)NTP * 1024 : 0); u.B = (const char*)ws + WS_EW13 + ((size_t)e * 4096 + pn * BM) * 1024;
        u.C = (char*)ws + PO_HM + ((size_t)P * BM * 2048 + pn * HALF); u.X = (const int*)(ws + WS_IDX) + y0; u.pm = P; u.pn = pn; return true; } };
struct SchedDown { unsigned char* ws; int G, c;
    __device__ __forceinline__ bool next(int i, GUnit& u) const { int P, pn; if (!static_unit(i, G, c, 384, 4, P, pn)) return false; int e, grp, y0; moe_panel(P, e, grp, y0);
        u.A = (const char*)ws + PO_HM + (size_t)P * BM * 2048; u.B = (const char*)ws + WS_EW2 + ((size_t)e * 1024 + pn * BM) * 2048;
        u.C = (char*)ws + PO_YE + ((size_t)y0 * 1024 + pn * BM) * 2; u.X = (const float*)(ws + WS_GATE) + y0; u.pm = P; u.pn = pn; return true; } };
struct SchedQKV { unsigned char* ws; int G, c;
    __device__ __forceinline__ bool next(int i, GUnit& u) const { const int L = i * G + c; if (L >= 1536 + 768) return false;
        if (L < 1536) { int pm, pn; static_unit(i, G, c, 192, 8, pm, pn);
            u.A = (const char*)ws + WS_XB8 + (size_t)pm * BM * 1024; u.B = (const char*)ws + WS_WQKV + (size_t)pn * BM * 1024;
            u.C = (char*)ws + (pn < 4 ? PO_Q : PO_K) + ((size_t)pm * BM * 1024 + (pn & 3) * BM) * 2; u.X = nullptr; u.pm = pm; u.pn = pn; return true; }
        const int r = L - 1536, pmv = r & 3, pnv = r >> 2;
        u.A = (const char*)ws + WS_WQKV + (size_t)(2048 + pmv * BM) * 1024; u.B = (const char*)ws + WS_XB8 + (size_t)pnv * BM * 1024;
        u.C = (char*)ws + PO_VT + ((size_t)pmv * BM * NT + (size_t)pnv * BM) * 2; u.X = nullptr; u.pm = pmv; u.pn = 8 + pnv; return true; } };
struct EpiQKV {
    static constexpr bool PERM = true;
    __device__ __forceinline__ void operator()(const Acc& acc, const GUnit& u, int wr, int wc, int fr, int fq) const {
        constexpr float ds = 1.f / (FP8_SX * FP8_SWQKV);
        if (u.pn >= 8) { EpiBf<false> e{(unsigned)NT, ds}; e(acc, u, wr, wc, fr, fq); }
        else { EpiBf<false> e{1024u, u.pn < 4 ? 0.125f * 1.4426950408889634f * ds : ds}; e(acc, u, wr, wc, fr, fq); }
    }
};

__device__ __forceinline__ int wave_sum_i(int v) {
#pragma unroll
    for (int o = 1; o < 64; o <<= 1) v += __shfl_xor(v, o);
    return v;
}
__device__ __forceinline__ int block_excl_scan(int v, int lane, int wave, LAS int* red, int& total) {
    int inc = v;
#pragma unroll
    for (int o = 1; o < 64; o <<= 1) { const int t = __shfl_up(inc, o); if (lane >= o) inc += t; }
    __syncthreads();
    if (lane == 63) red[wave] = inc;
    __syncthreads();
    int off = 0, tot = 0;
#pragma unroll
    for (int w = 0; w < 8; ++w) { const int c = red[w]; if (w < wave) off += c; tot += c; }
    total = tot; return off + inc - v;
}
template <int PER>
__device__ __forceinline__ void select_fast(Frame& F, const float* affcol, int cap, int* idx_out, float* gate_out, int* slotcol) {
    LAS int* red = (LAS int*)F.lds;
    unsigned key[PER];
#pragma unroll
    for (int i = 0; i < PER / 4; ++i) { const u32x4 v = ((const u32x4*)(affcol + (size_t)F.tid * PER))[i]; key[4 * i] = v.x; key[4 * i + 1] = v.y; key[4 * i + 2] = v.z; key[4 * i + 3] = v.w; }
    unsigned T = 0u;
    for (int b = 30; b >= 0; --b) {
        const unsigned cand = T | (1u << b); int cnt = 0;
#pragma unroll
        for (int i = 0; i < PER; ++i) cnt += (key[i] >= cand) ? 1 : 0;
        cnt = wave_sum_i(cnt);
        LAS int* r = red + (b & 1) * 8;
        if (F.lane == 0) r[F.wave] = cnt;
        __syncthreads();
        int tot = 0;
#pragma unroll
        for (int w = 0; w < 8; ++w) tot += r[w];
        if (tot >= cap) T = cand;
    }
    int g = 0, q = 0;
#pragma unroll
    for (int i = 0; i < PER; ++i) { g += (key[i] > T) ? 1 : 0; q += (key[i] == T) ? 1 : 0; }
    int tot_g, tot_q; (void)tot_q;
    const int Eoff = block_excl_scan(q, F.lane, F.wave, red + 32, tot_q);
    int dummy; const int Goff = block_excl_scan(g, F.lane, F.wave, red + 32, tot_g); (void)Goff;
    const int need_eq = cap - tot_g;
    int eq_take = need_eq - Eoff; eq_take = eq_take < 0 ? 0 : (eq_take > q ? q : eq_take);
    const int base = block_excl_scan(g + eq_take, F.lane, F.wave, red + 32, dummy);
    int slot = base, eqseen = 0;
    const int tok0 = F.tid * PER;
#pragma unroll
    for (int i4 = 0; i4 < PER / 4; ++i4) { int so[4];
#pragma unroll
        for (int j = 0; j < 4; ++j) { const int i = 4 * i4 + j; const unsigned k = key[i]; bool sel = k > T; if (k == T) { sel = eqseen < eq_take; ++eqseen; }
            so[j] = sel ? slot : -1; if (sel) { idx_out[slot] = tok0 + i; gate_out[slot] = __uint_as_float(k); ++slot; } }
        ((int4*)(slotcol + tok0))[i4] = make_int4(so[0], so[1], so[2], so[3]); }
}
__device__ __forceinline__ void select_phase(Frame& F) {
    for (int it = F.c; it < 32; it += F.G) {
        const int grp = it >> 4, e = it & 15; const int n = grp ? NTS : NTP, cap = n / 8;
        const float* affcol = (const float*)(F.ws + WS_AFF) + (size_t)e * NT + (grp ? NTP : 0);
        int* idx = (int*)(F.ws + WS_IDX) + (grp ? 65536 : 0) + e * cap; float* gate = (float*)(F.ws + WS_GATE) + (grp ? 65536 : 0) + e * cap;
        int* slotcol = (int*)(F.ws + WS_SLOT) + (size_t)e * NT + (grp ? NTP : 0);
        __syncthreads();
        if (grp == 0) select_fast<64>(F, affcol, cap, idx, gate, slotcol); else select_fast<32>(F, affcol, cap, idx, gate, slotcol);
        __syncthreads();
    }
}

__device__ __forceinline__ void natten_fill(Frame& F, const float* rpb) {
    LAS float* rpbs = (LAS float*)F.lds;
    __syncthreads();
    for (int i = F.tid; i < 16 * 15 * 31; i += 512) rpbs[i] = rpb[i] * 1.4426950408889634f;
    __syncthreads();
}
__device__ __forceinline__ void natten_phase(Frame& F, const float* rpb) {
    const bf16_t* Kb = (const bf16_t*)(F.ws + PO_K); const bf16_t* VT = (const bf16_t*)(F.ws + PO_VT); bf16_t* QO = (bf16_t*)(F.ws + PO_Q);
    LAS float* rpbs = (LAS float*)F.lds;
    const int lane = F.lane, w = F.wave, fr = lane & 15, fq = lane >> 4;
    bool c0[4], c2[4]; int xe[4];
#pragma unroll
    for (int e = 0; e < 4; ++e) { xe[e] = 4 * fq + e - fr; c0[e] = xe[e] >= 8; c2[e] = xe[e] < -8; }
    const bool fA = fr < 8, fC = fr > 8;
    LAS bf16_t* Ks = (LAS bf16_t*)(F.lds + 32768); LAS bf16_t* Vs = Ks + 2 * 64 * 72;
    const int lrow = F.tid >> 3, lchk = F.tid & 7;
    for (int blk = F.c; blk < 1536; blk += F.G) {
        int gb, h, rb, rows;
        if (blk < 1024) { gb = blk >> 8; h = (blk >> 4) & 15; rb = blk & 15; rows = 128; } else { const int V = blk - 1024; gb = 4 + (V >> 7); h = (V >> 3) & 15; rb = V & 7; rows = 64; }
        const int r = rb * 8 + w;
        int rs = r - 4; rs = rs < 0 ? 0 : (rs > rows - 8 ? rows - 8 : rs);
        int kr_lo = rb * 8 - 4; kr_lo = kr_lo < 0 ? 0 : (kr_lo > rows - 8 ? rows - 8 : kr_lo);
        int kr_hi = rb * 8 + 7 - 4; kr_hi = (kr_hi < 0 ? 0 : (kr_hi > rows - 8 ? rows - 8 : kr_hi)) + 8;
        const size_t tb = (size_t)gb_tok0(gb), tq0 = tb + (size_t)r * 64;
        bf16x8 Qf[4][2];
        float mrun[4], lrun[4]; f32x4 Ot[4][4];
#pragma unroll
        for (int qt = 0; qt < 4; ++qt) { mrun[qt] = -INFINITY; lrun[qt] = 0.f;
#pragma unroll
            for (int dt = 0; dt < 4; ++dt) Ot[dt][qt] = (f32x4){0.f, 0.f, 0.f, 0.f}; }
        const bf16_t* kg = Kb + (tb + (size_t)kr_lo * 64 + lrow) * D + h * 64 + lchk * 8; const bf16_t* vg = VT + (size_t)(h * 64 + lrow) * NT + tb + (size_t)kr_lo * 64 + lchk * 8;
        const int nrows = kr_hi - kr_lo;
#define NA_LOAD(dst, ptr) asm volatile("global_load_dwordx4 %0, %1, off" : "=&v"(dst) : "v"(ptr) : "memory")
        u32x4 kA, vA, kB, vB;
        { const u32x4 k0r = *(const u32x4*)kg, v0r = *(const u32x4*)vg;
#pragma unroll
          for (int t = 0; t < 4; ++t)
#pragma unroll
              for (int ks = 0; ks < 2; ++ks) Qf[t][ks] = *(const bf16x8*)(QO + (tq0 + 16 * t + fr) * D + h * 64 + 32 * ks + 8 * fq);
          { const bf16_t* kp = kg + (size_t)64 * D; const bf16_t* vp = vg + 64; NA_LOAD(kB, kp); NA_LOAD(vB, vp); }
          __syncthreads();
          *(LAS u32x4*)(Ks + lrow * 72 + lchk * 8) = k0r; *(LAS u32x4*)(Vs + lrow * 72 + lchk * 8) = v0r; }
#pragma unroll
        for (int t = 0; t < 4; ++t)
#pragma unroll
            for (int ks = 0; ks < 2; ++ks) asm volatile("" :: "v"(Qf[t][ks]));
        asm volatile("s_waitcnt vmcnt(0)" ::: "memory");
        __syncthreads();
#pragma nounroll
        for (int i2 = 0; i2 < nrows; i2 += 2) {
#pragma unroll
          for (int jj = 0; jj < 2; ++jj) {
            const int i = i2 + jj; if (i >= nrows) break;
            const int kr = kr_lo + i; const int buf = jj; const bool more = i + 1 < nrows, more2 = i + 2 < nrows;
            if (more2) { const bf16_t* kp = kg + (size_t)(i + 2) * 64 * D; const bf16_t* vp = vg + (size_t)(i + 2) * 64;
                if (jj == 1) { NA_LOAD(kB, kp); NA_LOAD(vB, vp); } else { NA_LOAD(kA, kp); NA_LOAD(vA, vp); } }
            if (kr >= rs && kr < rs + 8) {
            const int dr = kr - r + 7;
            const LAS bf16_t* Kt = Ks + buf * (64 * 72); const LAS bf16_t* Vt = Vs + buf * (64 * 72);
            bf16x8 Kf[4][2];
#pragma unroll
            for (int t = 0; t < 4; ++t)
#pragma unroll
                for (int ks = 0; ks < 2; ++ks) Kf[t][ks] = *(const LAS bf16x8*)(Kt + (16 * t + fr) * 72 + 32 * ks + 8 * fq);
            float bsel[3][4];
#pragma unroll
            for (int e = 0; e < 4; ++e) { const int dcB = xe[e] + 15 + (c0[e] ? -16 : (c2[e] ? 16 : 0)), dcA = fA ? xe[e] + 15 : dcB, dcC = fC ? xe[e] + 15 : dcB;
                bsel[0][e] = rpbs[(h * 15 + dr) * 31 + dcA]; bsel[1][e] = rpbs[(h * 15 + dr) * 31 + dcB]; bsel[2][e] = rpbs[(h * 15 + dr) * 31 + dcC]; }
            bf16x8 Pf[4][2]; float alpha[4]; bool moved = false;
#pragma unroll
            for (int qt = 0; qt < 4; ++qt) {
                f32x4 St[3];
#pragma unroll
                for (int dk = 0; dk < 3; ++dk) { const int kt = qt + dk - 1; St[dk] = (f32x4){0.f, 0.f, 0.f, 0.f};
                    if (kt >= 0 && kt < 4) { St[dk] = __builtin_amdgcn_mfma_f32_16x16x32_bf16(Kf[kt][0], Qf[qt][0], St[dk], 0, 0, 0); St[dk] = __builtin_amdgcn_mfma_f32_16x16x32_bf16(Kf[kt][1], Qf[qt][1], St[dk], 0, 0, 0); } }
                constexpr int dummy = 0; (void)dummy;
                const int cls = qt == 0 ? 0 : (qt == 3 ? 2 : 1);
                float sv[4]; bool u0[4], u2[4]; float mx = -INFINITY;
#pragma unroll
                for (int e = 0; e < 4; ++e) { u0[e] = c0[e] && !(cls == 0 && fA) && !(cls == 2 && fC) && (qt > 0); u2[e] = c2[e] && !(cls == 0 && fA) && !(cls == 2 && fC) && (qt < 3);
                    sv[e] = (u0[e] ? St[0][e] : (u2[e] ? St[2][e] : St[1][e])) + bsel[cls][e]; mx = fmaxf(mx, sv[e]); }
                mx = x32_max(x16_max(mx));
                const float mnew = fmaxf(mrun[qt], mx); alpha[qt] = __builtin_amdgcn_exp2f(mrun[qt] - mnew); moved = moved || (mnew != mrun[qt]); mrun[qt] = mnew;
                float l = 0.f, p[4];
#pragma unroll
                for (int e = 0; e < 4; ++e) { p[e] = __builtin_amdgcn_exp2f(sv[e] - mnew); l += p[e]; }
                l = x32_sum(x16_sum(l)); lrun[qt] = lrun[qt] * alpha[qt] + l;
                float pv[4][4];
#pragma unroll
                for (int kt = 0; kt < 4; ++kt)
#pragma unroll
                    for (int e = 0; e < 4; ++e) { const int dk = kt - qt + 1; float v = 0.f; if (dk == 0) v = u0[e] ? p[e] : 0.f; else if (dk == 2) v = u2[e] ? p[e] : 0.f; else if (dk == 1) v = (u0[e] || u2[e]) ? 0.f : p[e]; pv[kt][e] = v; }
#pragma unroll
                for (int ks = 0; ks < 2; ++ks) { u32x4 wv; wv.x = cvt_pk_bf16_c(pv[2 * ks][0], pv[2 * ks][1]); wv.y = cvt_pk_bf16_c(pv[2 * ks][2], pv[2 * ks][3]); wv.z = cvt_pk_bf16_c(pv[2 * ks + 1][0], pv[2 * ks + 1][1]); wv.w = cvt_pk_bf16_c(pv[2 * ks + 1][2], pv[2 * ks + 1][3]);
                    Pf[qt][ks] = __builtin_bit_cast(bf16x8, wv); }
            }
            const bool rescale = __ballot(moved) != 0ull;
#pragma unroll
            for (int dt = 0; dt < 4; ++dt) {
                if (rescale) {
#pragma unroll
                    for (int qt = 0; qt < 4; ++qt) Ot[dt][qt] = Ot[dt][qt] * alpha[qt]; }
#pragma unroll
                for (int ks = 0; ks < 2; ++ks) { const u32x2 v0 = *(const LAS u32x2*)(Vt + (16 * dt + fr) * 72 + 32 * ks + 4 * fq), v1 = *(const LAS u32x2*)(Vt + (16 * dt + fr) * 72 + 32 * ks + 16 + 4 * fq);
                    u32x4 vv; vv.x = v0.x; vv.y = v0.y; vv.z = v1.x; vv.w = v1.y; const bf16x8 Vf = __builtin_bit_cast(bf16x8, vv);
#pragma unroll
                    for (int qt = 0; qt < 4; ++qt) { if ((qt == 0 && ks == 1) || (qt == 3 && ks == 0)) continue; Ot[dt][qt] = __builtin_amdgcn_mfma_f32_16x16x32_bf16(Vf, Pf[qt][ks], Ot[dt][qt], 0, 0, 0); } }
            }
            }
            if (more) {
                if (more2) asm volatile("s_waitcnt vmcnt(2)" ::: "memory"); else asm volatile("s_waitcnt vmcnt(0)" ::: "memory");
                LAS bf16_t* kd = Ks + (buf ^ 1) * (64 * 72) + lrow * 72 + lchk * 8; LAS bf16_t* vd = Vs + (buf ^ 1) * (64 * 72) + lrow * 72 + lchk * 8;
                if (jj == 1) { asm volatile("" : "+v"(kA), "+v"(vA)); *(LAS u32x4*)kd = kA; *(LAS u32x4*)vd = vA; } else { asm volatile("" : "+v"(kB), "+v"(vB)); *(LAS u32x4*)kd = kB; *(LAS u32x4*)vd = vB; }
            }
            __syncthreads();
          }
        }
#undef NA_LOAD
#pragma unroll
        for (int qt = 0; qt < 4; ++qt) { const float inv = 1.f / lrun[qt];
#pragma unroll
            for (int dt = 0; dt < 4; ++dt) { const f32x4 o = Ot[dt][qt] * inv; u32x2 wv; wv.x = cvt_pk_bf16_c(o[0], o[1]); wv.y = cvt_pk_bf16_c(o[2], o[3]);
                pst8(QO + (tq0 + 16 * qt + fr) * D + h * 64 + 16 * dt + 4 * fq, wv); } }
    }
    __syncthreads();
}
constexpr int N_PHASES = 31;
constexpr int FLAG_NO_XIMPORT = 1, FLAG_NO_EXPERTS0 = 2;
constexpr int CV_P1 = 3072, CV_P2 = CV_P1 + 1536, CV_SEL = CV_P2 + 5376, CV_SEL1 = 5376, CV_P0B = CV_SEL + 1536;
__global__ void __launch_bounds__(512, 2) fwd(Args args) {
    extern __shared__ __attribute__((aligned(16))) unsigned char lds_raw[];
    Frame F; F.lds = (LAS unsigned char*)lds_raw; F.ws = args.ws; F.in = args.in; F.out = args.out;
    F.tid = threadIdx.x; F.lane = F.tid & 63; F.wave = __builtin_amdgcn_readfirstlane(F.tid >> 6); F.G = gridDim.x; F.c = blockIdx.x; F.xok = false;
    unsigned char* ws = args.ws;
    const int wave_s = __builtin_amdgcn_readfirstlane(threadIdx.x >> 6);
    for (int u = F.tid; u < (LDS_BYTES - RING_BYTES) / 4; u += 512) ((LAS unsigned*)(F.lds + RING_BYTES))[u] = 0u;
    __syncthreads();
    const int lo = args.ph_lo, hi = args.ph_hi;
    volatile LAS unsigned* MISC = (volatile LAS unsigned*)(F.lds + MISC_OFF);
    XcdBarrier bar; bar.bar = (unsigned*)(ws + WS_CTL) + CW_BAR + args.pad * XCD_BAR_WORDS_EXT; bar.x = 0; bar.st = nullptr;
    const bool multi = (hi - lo) > 1;
    if (multi) bar = xcd_barrier_post((unsigned*)(ws + WS_CTL) + CW_BAR + args.pad * XCD_BAR_WORDS_EXT, MISC + 8);
#define IN(k) (lo <= (k) && (k) < hi)
#ifdef STAMP_PA
    unsigned long long* TS = (unsigned long long*)(ws + WS_CTL + 40 * 1024);
#define STAMP(k) do { if (blockIdx.x == 0 && threadIdx.x == 0) TS[k] = __builtin_amdgcn_s_memrealtime(); } while (0)
#else
#define STAMP(k) do { } while (0)
#endif
#ifdef AMP_PHASE
    unsigned long long t_phase0 = 0ull;
#define AMP_NOW(t) asm volatile("s_memrealtime %0\n\ts_waitcnt lgkmcnt(0)" : "=s"(t) :: "memory")
#define AMP_T0() do { AMP_NOW(t_phase0); } while (0)
#define AMP_WAIT(k) do { if ((k) == AMP_PHASE || AMP_PHASE < 0) { asm volatile("s_waitcnt vmcnt(0) lgkmcnt(0)" ::: "memory"); unsigned long long _t1; AMP_NOW(_t1); const unsigned long long _tw = _t1 + (unsigned long long)AMP_M * (_t1 - t_phase0); unsigned long long _tn; do { __builtin_amdgcn_s_sleep(4); AMP_NOW(_tn); } while (_tn < _tw); } } while (0)
#else
#define AMP_T0() do { } while (0)
#define AMP_WAIT(k) do { } while (0)
#endif
#define SEAM(k) do { AMP_WAIT(k); if (IN(k) && IN((k) + 1)) { xcd_barrier(bar, wave_s); STAMP((k) + 1); } } while (0)
    STAMP(0);
    LAS unsigned char* ring = F.lds;
#define PHASE_BEGIN() do { int _t; asm volatile("v_mbcnt_lo_u32_b32 %0, -1, 0\n\tv_mbcnt_hi_u32_b32 %0, -1, %0" : "=v"(_t)); _t |= (wave_s << 6); F.tid = _t; F.lane = _t & 63; F.wave = wave_s; AMP_T0(); } while (0)

#ifndef P0_SKIP
#define P0_SKIP 0
#endif
    if (IN(0)) { PHASE_BEGIN(); const int p0s = (args.pad == 1) ? P0_SKIP : 0;
        if (!(p0s & 1)) for (int it = F.c; it < 128; it += F.G) s5_build_item(F, it >> 1, it & 1);
        if (!(p0s & 2)) convert_small_weights(F);
        if (!(p0s & 4)) if (!(args.flags & FLAG_NO_EXPERTS0)) { convert_expert_weights(F, 0, CV_SEL, CV_P0B, 128);
            convert_expert_weights(F, 0, CV_P0B, 16 * 1536, 0); }
        if (!(p0s & 8)) { convert_plain(F, args.in[I_MWQ], (bf16_t*)(ws + WS_MWQ), (size_t)2 * 1024 * 1024);
        convert_plain(F, args.in[I_MEMP], (bf16_t*)(ws + WS_MEMB), (size_t)4 * 256 * 1024);
        convert_plain(F, args.in[I_MEMS], (bf16_t*)(ws + WS_MEMB) + (size_t)4 * 256 * 1024, (size_t)4 * 256 * 1024); }
        if (!(p0s & 16)) import_x(F, !(args.flags & FLAG_NO_XIMPORT));
    }
    SEAM(0);
    unsigned nloc_s = 32u;
    if (multi && IN(0) && IN(1)) {
        if (F.tid == 0) { unsigned ok = (F.G == 256) ? 1u : 0u; unsigned* bw = bar.bar;
            for (unsigned j = 0; j < 16; ++j) { const unsigned cnt = xb_ld(&bw[XB_XCNT(j)]); if (j < 8 ? cnt != 32u : cnt != 0u) ok = 0u; }
            MISC[13] = ok; }
        __syncthreads();
        if (MISC[13]) { F.xok = true; F.c = (int)(MISC[12] * 8u + bar.x); }
    }
#define LSEAM(k) do { AMP_WAIT(k); if (IN(k) && IN((k) + 1)) { if (F.xok) xcd_local_barrier(bar, wave_s, nloc_s); else xcd_barrier(bar, wave_s); STAMP((k) + 1); } } while (0)
    {
        const float* lng = args.in[I_LNG]; const float* lnb = args.in[I_LNB];
        if (IN(1)) { PHASE_BEGIN();
            { SchedKV S{ws, F.G, F.c}; EpiBf<false> E{2048u, 1.f}; gemm_phase<EpiBf<false>, SchedKV, false>(ring, F.tid, 1024, 2048u, 2048u, S, E); }
            { SchedUA S{(const char*)ws + WS_XB, (const char*)ws + WS_WIN, (char*)ws + PO_UA, F.G, F.c}; EpiUA E; gemm_phase<EpiUA, SchedUA, false>(ring, F.tid, 1024, 2048u, 2048u, S, E); }
            if (!(args.flags & FLAG_NO_EXPERTS0)) convert_expert_weights(F, 0, 0, CV_P1, 128);
        }
        SEAM(1);
        if (IN(2)) { PHASE_BEGIN();
            { SchedSA S{ws, F.G, F.c}; EpiS E; gemm_phase<EpiS, SchedSA, false>(ring, F.tid, 512, (unsigned)(UAK * 2), 1024u, S, E); }
            { SchedWqk S{ws, F.G, F.c}; EpiBf8 E{1024u, 0.0625f * 1.4426950408889634f * FP8_SWQK}; gemm_phase<EpiBf8, SchedWqk, false>(ring, F.tid, 256, 4096u, 2048u, S, E); }
            { SchedWvo S{ws, F.G, F.c}; EpiBf<false> E{1024u, 1.f}; gemm_phase<EpiBf<false>, SchedWvo, false>(ring, F.tid, 256, 2048u, 4096u, S, E); }
            if (!(args.flags & FLAG_NO_EXPERTS0)) convert_expert_weights(F, 0, CV_P1, CV_P2, 128);
        }
        SEAM(2);
        if (IN(3)) { PHASE_BEGIN(); s5_recurrence(F); }
        SEAM(3);
        if (IN(4)) { PHASE_BEGIN(); SchedSC S{ws, F.G, F.c}; EpiGelu E; gemm_phase<EpiGelu, SchedSC, false>(ring, F.tid, UAK, (unsigned)(UAK * 2), (unsigned)(UAK * 2), S, E); }
        SEAM(4);
        if (IN(5)) { PHASE_BEGIN(); SchedGated S{(const char*)ws + PO_SG, (const char*)ws + WS_WGLU, (char*)ws + PO_HB_S5, 2048, 2048, 1024, NT / BM, 8, F.G, F.c}; EpiGated<0> E{1024u};
            gemm_phase<EpiGated<0>, SchedGated, false>(ring, F.tid, 1024, 2048u, 2048u, S, E); }
        LSEAM(5);
        if (IN(6)) { PHASE_BEGIN(); if (args.flags & FLAG_NO_XIMPORT) ln_phase<0, false, false, false>(F, (const bf16_t*)(ws + PO_HB_S5), lng, lnb, nullptr); else ln_phase<0, false, false, true>(F, (const bf16_t*)(ws + PO_HB_S5), lng, lnb, nullptr); }
        LSEAM(6);
    }
#define COMMON_BLOCK(layer, pb) do { \
        const float* lng = args.in[I_LNG] + (size_t)(layer) * 3 * D; const float* lnb = args.in[I_LNB] + (size_t)(layer) * 3 * D; \
        if (IN((pb) + 0)) { PHASE_BEGIN(); SchedScores8 S{(const char*)ws + WS_XB8, (const char*)ws + WS_WQK + (size_t)(layer) * 8 * MiB, (char*)ws + PO_SB, F.G, F.c}; EpiSoftmax E{(LAS float*)(F.lds + RING_BYTES + 4096), 1024u, 1.f / (FP8_SX * FP8_SWQK)}; \
            gemm_phase<EpiSoftmax, SchedScores8, false, true>(ring, F.tid, 512, 1024u, 1024u, S, E); } \
        AMP_WAIT((pb) + 0); if (IN((pb) + 0) && IN((pb) + 2)) { if (F.xok) xcd_local_barrier(bar, wave_s, nloc_s); else xcd_barrier(bar, wave_s); STAMP((pb) + 1); }     \
        if (IN((pb) + 2)) { PHASE_BEGIN(); SchedBatchW S{(const char*)ws + PO_SB, (const char*)ws + WS_WVO + (size_t)(layer) * 16 * MiB, (char*)ws + PO_HB_MEM, F.G, F.c}; EpiBf<false> E{1024u, 1.f}; \
            gemm_phase<EpiBf<false>, SchedBatchW, false>(ring, F.tid, 1024, 2048u, 2048u, S, E); } \
        if (IN((pb) + 3)) { PHASE_BEGIN(); ln_router_fill(F, lng + D, lnb + D, args.in[I_EWR] + (size_t)(layer) * D * 16); }     \
        LSEAM((pb) + 2); \
        if (IN((pb) + 3)) { PHASE_BEGIN(); ln_phase<0, true, false>(F, (const bf16_t*)(ws + PO_HB_MEM), lng + D, lnb + D, args.in[I_EWR] + (size_t)(layer) * D * 16); } \
        SEAM((pb) + 3); \
        if (IN((pb) + 4)) { PHASE_BEGIN(); select_phase(F); if ((layer) == 0) { if (!(args.flags & FLAG_NO_EXPERTS0)) convert_expert_weights(F, 0, CV_P2, CV_SEL, 32); } else convert_expert_weights(F, 1, 0, CV_SEL1, 32); } \
        SEAM((pb) + 4); \
        if (IN((pb) + 5)) { PHASE_BEGIN(); SchedUp S{ws, F.G, F.c}; EpiGated8 E{2048u}; gemm_phase<EpiGated8, SchedUp, true, true>(ring, F.tid, 512, 1024u, 1024u, S, E); } \
        SEAM((pb) + 5); \
        if (IN((pb) + 6)) { PHASE_BEGIN(); SchedDown S{ws, F.G, F.c}; EpiBf<true> E{1024u, 1.f / (FP8_SH * FP8_SW2)}; gemm_phase<EpiBf<true>, SchedDown, false, true>(ring, F.tid, 1024, 2048u, 2048u, S, E); } \
        AMP_WAIT((pb) + 6); if (IN((pb) + 6) && IN((pb) + 9)) { xcd_barrier(bar, wave_s); STAMP((pb) + 9); }     \
    } while (0)
    COMMON_BLOCK(0, 7);
    if (IN(16)) { PHASE_BEGIN(); ln_phase<1, false, false>(F, nullptr, args.in[I_LNG] + 2 * D, args.in[I_LNB] + 2 * D, nullptr); convert_expert_weights(F, 1, CV_SEL1, 16 * 1536, 0); }
    SEAM(16);
    {
        const float* lng = args.in[I_LNG] + 3 * D; const float* lnb = args.in[I_LNB] + 3 * D;
        if (IN(17)) { PHASE_BEGIN(); SchedQKV S{ws, F.G, F.c}; EpiQKV E; gemm_phase<EpiQKV, SchedQKV, false, true>(ring, F.tid, 512, 1024u, 1024u, S, E); }
        if (IN(18)) { PHASE_BEGIN(); natten_fill(F, args.in[I_BRPB]); }
        SEAM(17);
        if (IN(18)) { PHASE_BEGIN(); natten_phase(F, args.in[I_BRPB]); }
        SEAM(18);
        if (IN(19)) { PHASE_BEGIN(); SchedPlain S{(const char*)ws + PO_Q, (const char*)ws + WS_WO, (char*)ws + PO_HB_NA, 2048, 2048, 1024, NT / BM, 4, F.G, F.c}; EpiBf<false> E{1024u, 1.f};
            gemm_phase<EpiBf<false>, SchedPlain, false>(ring, F.tid, 1024, 2048u, 2048u, S, E); }
        LSEAM(19);
        if (IN(20)) { PHASE_BEGIN(); ln_phase<0, false, false>(F, (const bf16_t*)(ws + PO_HB_NA), lng, lnb, nullptr); }
        LSEAM(20);
    }
    COMMON_BLOCK(1, 21);
    if (IN(30)) { PHASE_BEGIN(); ln_phase<1, false, true>(F, nullptr, args.in[I_LNG] + 5 * D, args.in[I_LNB] + 5 * D, nullptr); }
    AMP_WAIT(30);
#undef COMMON_BLOCK
#ifdef STAMP_PA
    xcd_barrier(bar, wave_s); STAMP(31); xcd_barrier(bar, wave_s);
    {
        const volatile unsigned long long* T = TS; const float dA = (float)(T[STAMP_PA + STAMP_NA] - T[STAMP_PA]) * 0.01f, dB = (float)(T[STAMP_PB + STAMP_NB] - T[STAMP_PB]) * 0.01f;
        const float c = sqrtf(100.f * dA), V = 100.f * dB; const size_t np = (size_t)NTP * 1024, n = (size_t)NT * 1024;
        for (size_t i = (size_t)blockIdx.x * 512 + threadIdx.x; i < n; i += (size_t)gridDim.x * 512) args.out[i] = i < np ? c : (i == np ? V : 0.f);
    }
#endif
#undef IN
#undef SEAM
}
}
#ifndef DBG
#define DBG 0
#endif
#ifndef FZ_PER_PHASE
#define FZ_PER_PHASE 0
#endif

#if DBG
namespace dbg {
__global__ void k_cmp_bf16_f32(const unsigned short* a, const float* b, size_t n, double* acc) {
    double s0 = 0, s1 = 0;
    for (size_t i = (size_t)blockIdx.x * blockDim.x + threadIdx.x; i < n; i += (size_t)gridDim.x * blockDim.x) { const double x = (double)__uint_as_float(((unsigned)a[i]) << 16), y = b[i]; s0 += (x - y) * (x - y); s1 += y * y; }
    for (int o = 32; o >= 1; o >>= 1) { s0 += __shfl_xor(s0, o); s1 += __shfl_xor(s1, o); }
    if ((threadIdx.x & 63) == 0) { atomicAdd(acc, s0); atomicAdd(acc + 1, s1); }
}
__global__ void k_cmp_f32_f32(const float* a, const float* b, size_t n, double* acc) {
    double s0 = 0, s1 = 0;
    for (size_t i = (size_t)blockIdx.x * blockDim.x + threadIdx.x; i < n; i += (size_t)gridDim.x * blockDim.x) { const double x = a[i], y = b[i]; s0 += (x - y) * (x - y); s1 += y * y; }
    for (int o = 32; o >= 1; o >>= 1) { s0 += __shfl_xor(s0, o); s1 += __shfl_xor(s1, o); }
    if ((threadIdx.x & 63) == 0) { atomicAdd(acc, s0); atomicAdd(acc + 1, s1); }
}
__global__ void k_cmp_ua(const unsigned short* UA, const float* u, double* acc) {
    double s0 = 0, s1 = 0;
    for (size_t i = (size_t)blockIdx.x * blockDim.x + threadIdx.x; i < (size_t)fz::NT * 1024; i += (size_t)gridDim.x * blockDim.x) {
        const int tok = (int)(i >> 10), ch = (int)(i & 1023), chunk = tok >> 5, j = tok & 31, g = ch >> 4, h = ch & 15;
        const double x = (double)__uint_as_float(((unsigned)UA[((size_t)g * fz::NCHUNK + chunk) * fz::UAK + j * 16 + h]) << 16), y = u[i]; s0 += (x - y) * (x - y); s1 += y * y; }
    for (int o = 32; o >= 1; o >>= 1) { s0 += __shfl_xor(s0, o); s1 += __shfl_xor(s1, o); }
    if ((threadIdx.x & 63) == 0) { atomicAdd(acc, s0); atomicAdd(acc + 1, s1); }
}
__global__ void k_encode(float* out, const double* accA, const double* accB) {
    const double vA = accA[1] > 0 ? sqrt(accA[0] / accA[1]) : 9.99; const double vB = accB[1] > 0 ? sqrt(accB[0] / accB[1]) : 9.99;
    const float c = (float)sqrt(1e8 * (vA == vA ? vA : 7.77)); const float V = (float)(1e5 * (vB == vB ? vB : 7.77));
    const size_t np = (size_t)fz::NTP * 1024, n = (size_t)fz::NT * 1024;
    for (size_t i = (size_t)blockIdx.x * blockDim.x + threadIdx.x; i < n; i += (size_t)gridDim.x * blockDim.x) out[i] = i < np ? c : (i == np ? V : 0.f);
}
}
#endif

extern "C" void kernel_launch(void* const* d_in, const int* in_sizes, int n_in, void* d_out, int out_size, void* d_ws, size_t ws_size, hipStream_t stream) {
    using namespace fz;
    static int grid = 0;
    if (grid == 0) {
        if (n_in != 26 || ws_size < WS_END) { fprintf(stderr, "kernel_launch: unexpected inputs (n_in %d, ws %zu)\n", n_in, ws_size); grid = -1; return; }
        int dev = 0, cus = 0, per_cu = 0;
        if (hipGetDevice(&dev) != hipSuccess || hipDeviceGetAttribute(&cus, hipDeviceAttributeMultiprocessorCount, dev) != hipSuccess) { grid = -1; return; }
        if (hipFuncSetAttribute((const void*)fwd, hipFuncAttributeMaxDynamicSharedMemorySize, LDS_BYTES) != hipSuccess) { fprintf(stderr, "kernel_launch: hipFuncSetAttribute failed\n"); grid = -1; return; }
        if (hipOccupancyMaxActiveBlocksPerMultiprocessor(&per_cu, (const void*)fwd, 512, LDS_BYTES) != hipSuccess || per_cu < 1) { fprintf(stderr, "kernel_launch: occupancy query says %d\n", per_cu); }
        (void)hipGetLastError();
        grid = cus;
    }
    if (grid < 0) return;
    unsigned char* ws = (unsigned char*)d_ws;
    (void)hipMemsetAsync(ws + WS_CTL, 0, CTL_ZERO_BYTES, stream);
    Args a{};
    for (int i = 0; i < 26; ++i) a.in[i] = (const float*)d_in[i];
    a.out = (float*)d_out; a.ws = ws; a.flags = 0; a.pad = 0;
    auto run = [&](int lo, int hi) { a.ph_lo = lo; a.ph_hi = hi; hipLaunchKernelGGL(fwd, dim3(grid), dim3(512), LDS_BYTES, stream, a); };
#if DBG == 0
#ifdef PRE_LO
    a.pad = 1; run(PRE_LO, PRE_HI); a.pad = 0;
#endif
#if FZ_PER_PHASE
    for (int p = 0; p < N_PHASES; ++p) run(p, p + 1);
#else
    run(0, N_PHASES);
#endif
#else
    using nv::SG;
    const float* const* in = (const float* const*)d_in;
    const size_t BIG = (size_t)NT * D;
    double* ACC = (double*)(ws + 32 * 1024);
    float* nmisc = (float*)(ws + 987 * MiB);
    float* nKV = nmisc; float* nAFF = nmisc + 4u * 1024 * 1024; float* nGATE = nAFF + 1024 * 1024; int* nIDX = (int*)(nGATE + 128 * 1024); float* nMEMC = (float*)(ws + 385 * MiB);
    auto sgemm = [&](const float* A, const float* B, float* C, const int* gidx, int M, int N, int K, long sam, long sak, long sbk, long sbn, long ldc,
                     int nz = 1, int zdiv = 1, long zA0 = 0, long zA1 = 0, long zB0 = 0, long zB1 = 0, long zC0 = 0, long zC1 = 0) {
        SG s{A, B, C, gidx, M, N, K, zdiv, sam, sak, sbk, sbn, ldc, zA0, zA1, zB0, zB1, zC0, zC1};
        hipLaunchKernelGGL(nv::k_sgemm, dim3(N / 128, M / 128, nz), dim3(256), 0, stream, s);
    };
    const int EW = (int)((BIG + 255) / 256);
    auto n_import = [&](float* X) { hipMemcpyAsync(X, in[I_XP], (size_t)NTP * D * 4, hipMemcpyDeviceToDevice, stream); hipMemcpyAsync(X + (size_t)NTP * D, in[I_XS], (size_t)NTS * D * 4, hipMemcpyDeviceToDevice, stream);
        hipMemcpyAsync(nMEMC, in[I_MEMP], (size_t)4 * 256 * D * 4, hipMemcpyDeviceToDevice, stream); hipMemcpyAsync(nMEMC + (size_t)4 * 256 * D, in[I_MEMS], (size_t)4 * 256 * D * 4, hipMemcpyDeviceToDevice, stream); };
    auto n_s5 = [&](float* X, float* T1, float* T2, float* T3) {
        sgemm(X, in[I_AWIN], T1, nullptr, NT, D, D, D, 1, D, 1, D);
        hipLaunchKernelGGL(nv::k_s5_scan, dim3(8 * 64 * 2), dim3(64), 0, stream, T1, T2, in[I_ALRE], in[I_ALIM], in[I_ALDT], in[I_ABRE], in[I_ABIM], in[I_ACRE], in[I_ACIM]);
        hipLaunchKernelGGL(nv::k_s5_gelu, dim3(EW), dim3(256), 0, stream, T1, T2, in[I_AD], T2);
        sgemm(T2, in[I_AWGLU], T1, nullptr, NT, D, D, D, 1, 2 * D, 1, D);
        sgemm(T2, in[I_AWGLU] + D, T3, nullptr, NT, D, D, D, 1, 2 * D, 1, D);
        hipLaunchKernelGGL(nv::k_glu, dim3(EW), dim3(256), 0, stream, T1, T3, T1);
    };
    auto n_na = [&](float* X, float* T1, float* T2, float* T3) {
        sgemm(X, in[I_BWQKV], T1, nullptr, NT, D, D, D, 1, 3 * D, 1, D); sgemm(X, in[I_BWQKV] + D, T2, nullptr, NT, D, D, D, 1, 3 * D, 1, D); sgemm(X, in[I_BWQKV] + 2 * D, T3, nullptr, NT, D, D, D, 1, 3 * D, 1, D);
        hipLaunchKernelGGL(nv::k_natten, dim3(NT * 16 / 4), dim3(256), 0, stream, T1, T2, T3, in[I_BRPB]);
        sgemm(T1, in[I_BWO], T2, nullptr, NT, D, D, D, 1, D, 1, D);
    };
    auto n_ln = [&](float* X, const float* h, int layer, int sub, float* xo) { hipLaunchKernelGGL(nv::k_res_ln, dim3(NT / 4), dim3(256), 0, stream, X, h, in[I_LNG] + (layer * 3 + sub) * D, in[I_LNB] + (layer * 3 + sub) * D, xo, NT); };
    auto n_mem = [&](float* X, float* T1, float* T2, float* T3, int layer) {
        const float* wq = in[I_MWQ] + (size_t)layer * D * D; const float* wkv = in[I_MWKV] + (size_t)layer * D * 2 * D; const float* wo = in[I_MWO] + (size_t)layer * D * D;
        sgemm(nMEMC, wkv, nKV, nullptr, 8 * 256, 2 * D, D, D, 1, 2 * D, 1, 2 * D);
        sgemm(X, wq, T1, nullptr, NT, D, D, D, 1, D, 1, D);
        for (int grp = 0; grp < 2; ++grp) { const int L = grp ? 4096 : 8192; const size_t tb = grp ? (size_t)NTP : 0; const int gb0 = grp * 4;
            sgemm(T1 + tb * D, nKV + (size_t)gb0 * 256 * 2 * D, T2 + tb * D, nullptr, L, 256, 256, D, 1, 1, 2 * D, D, 16, 4, (long)L * D, 256, (long)256 * 2 * D, 256, (long)L * D, 256); }
        hipLaunchKernelGGL(nv::k_softmax256, dim3(NT * 4 / 4), dim3(256), 0, stream, T2, 0.0625f, NT * 4);
        for (int grp = 0; grp < 2; ++grp) { const int L = grp ? 4096 : 8192; const size_t tb = grp ? (size_t)NTP : 0; const int gb0 = grp * 4;
            sgemm(T2 + tb * D, nKV + (size_t)gb0 * 256 * 2 * D + D, T3 + tb * D, nullptr, L, 256, 256, D, 1, 2 * D, 1, D, 16, 4, (long)L * D, 256, (long)256 * 2 * D, 256, (long)L * D, 256); }
        sgemm(T3, wo, T1, nullptr, NT, D, D, D, 1, D, 1, D);
    };
    auto n_moe = [&](float* X, float* T1, float* T2, float* T3, int layer) {
        hipLaunchKernelGGL(nv::k_router, dim3(NT / 4), dim3(256), 0, stream, X, in[I_EWR] + (size_t)layer * D * 16, nAFF, NT);
        hipLaunchKernelGGL(nv::k_select, dim3(32), dim3(512), 0, stream, nAFF, nIDX, nGATE);
        hipMemsetAsync(T1, 0, BIG * 4, stream);
        for (int grp = 0; grp < 2; ++grp) { const int n = grp ? NTS : NTP, cap = n / 8; const size_t tb = grp ? (size_t)NTP : 0;
            for (int e = 0; e < 16; ++e) { const int* idx = nIDX + (grp ? 16 * 4096 : 0) + e * cap; const float* gate = nGATE + (grp ? 16 * 4096 : 0) + e * cap;
                const float* w1 = in[I_EW1] + ((size_t)layer * 16 + e) * D * 2048; const float* w3 = in[I_EW3] + ((size_t)layer * 16 + e) * D * 2048; const float* w2 = in[I_EW2] + ((size_t)layer * 16 + e) * 2048 * D;
                float* H1 = T2; float* H3 = T2 + (size_t)4096 * 2048; float* YE = T3;
                sgemm(X + tb * D, w1, H1, idx, cap, 2048, D, D, 1, 2048, 1, 2048); sgemm(X + tb * D, w3, H3, idx, cap, 2048, D, D, 1, 2048, 1, 2048);
                hipLaunchKernelGGL(nv::k_silu_mul, dim3((unsigned)(((size_t)cap * 2048 + 255) / 256)), dim3(256), 0, stream, H1, H3, (size_t)cap * 2048);
                sgemm(H1, w2, YE, nullptr, cap, D, 2048, 2048, 1, D, 1, D);
                hipLaunchKernelGGL(nv::k_scatter_add, dim3((unsigned)(((size_t)cap * D + 255) / 256)), dim3(256), 0, stream, YE, idx, gate, T1 + tb * D, cap); } }
    };
    float* X = (float*)(ws + WS_XF); float* T1 = (float*)(ws + WS_EW13); float* T2 = (float*)(ws + WS_POOL); float* T3 = (float*)(ws + WS_POOL + 192 * MiB);
    auto cmp_bf = [&](size_t off_bf16, const float* ref, double* acc) { hipLaunchKernelGGL(dbg::k_cmp_bf16_f32, dim3(2048), dim3(256), 0, stream, (const unsigned short*)(ws + off_bf16), ref, BIG, acc); };
#if DBG == 1
    n_import(X);
    a.flags = FLAG_NO_XIMPORT | FLAG_NO_EXPERTS0;
    n_s5(X, T1, T2, T3);
    for (int p = 0; p <= 5; ++p) run(p, p + 1);
    cmp_bf(PO_HB_S5, T1, ACC);
    cmp_bf(PO_HB_S5, T1, ACC + 2);
#elif DBG == 11
    n_import(X);
    a.flags = FLAG_NO_XIMPORT | FLAG_NO_EXPERTS0;
    sgemm(X, in[I_AWIN], T1, nullptr, NT, D, D, D, 1, D, 1, D);
    for (int p = 0; p <= 4; ++p) run(p, p + 1);
    hipLaunchKernelGGL(dbg::k_cmp_ua, dim3(2048), dim3(256), 0, stream, (const unsigned short*)(ws + PO_UA), T1, ACC);
    hipMemcpyAsync(X, T1, BIG * 4, hipMemcpyDeviceToDevice, stream);
    { float* Y = (float*)(ws + 193 * MiB);
      hipLaunchKernelGGL(nv::k_s5_scan, dim3(8 * 64 * 2), dim3(64), 0, stream, X, Y, in[I_ALRE], in[I_ALIM], in[I_ALDT], in[I_ABRE], in[I_ABIM], in[I_ACRE], in[I_ACIM]);
      hipLaunchKernelGGL(nv::k_s5_gelu, dim3(EW), dim3(256), 0, stream, X, Y, in[I_AD], Y);
      cmp_bf(PO_SG, Y, ACC + 2); }
#elif DBG == 2
    n_import(X); n_s5(X, T1, T2, T3); n_ln(X, T1, 0, 0, X); n_mem(X, T1, T2, T3, 0);
    a.flags = FLAG_NO_XIMPORT | FLAG_NO_EXPERTS0;
    run(0, 1); run(1, 2); run(2, 3); run(7, 8); run(9, 10);
    cmp_bf(PO_HB_MEM, T1, ACC); cmp_bf(PO_HB_MEM, T1, ACC + 2);
#elif DBG == 4
    n_import(X); n_na(X, T1, T2, T3);
    hipMemcpyAsync(T1, T2, BIG * 4, hipMemcpyDeviceToDevice, stream);
    a.flags = FLAG_NO_XIMPORT | FLAG_NO_EXPERTS0;
    run(0, 1); run(17, 18); run(18, 19); run(19, 20);
    cmp_bf(PO_HB_NA, T1, ACC); cmp_bf(PO_HB_NA, T1, ACC + 2);
#endif
    hipLaunchKernelGGL(dbg::k_encode, dim3(2048), dim3(256), 0, stream, (float*)d_out, ACC, ACC + 2);
#endif
}
```

```cpp
#include <hip/hip_runtime.h>
#include <cstdio>
#include <cstdint>
#include <cmath>
#define NO_WT 1
namespace nv {
constexpr int D = 1024, NTP = 32768, NTS = 16384, NT = NTP + NTS, NGB = 8, MEM = 256;
constexpr int GRID_W = 64;
constexpr float ALPHA = 1.41421356237309515f;
constexpr float LN_EPS = 1e-5f;

__host__ __device__ inline int gb_tok0(int gb) { return gb < 4 ? gb * 8192 : NTP + (gb - 4) * 4096; }
__host__ __device__ inline int gb_len(int gb) { return gb < 4 ? 8192 : 4096; }

__device__ __forceinline__ float wave_sum(float v) {
#pragma unroll
    for (int o = 1; o < 64; o <<= 1) v += __shfl_xor(v, o);
    return v;
}
__device__ __forceinline__ float wave_max(float v) {
#pragma unroll
    for (int o = 1; o < 64; o <<= 1) v = fmaxf(v, __shfl_xor(v, o));
    return v;
}

struct SG { const float* A; const float* B; float* C; const int* gidx; int M, N, K, zdiv; long sam, sak, sbk, sbn, ldc; long zA0, zA1, zB0, zB1, zC0, zC1; };
__global__ __launch_bounds__(256) void k_sgemm(SG a) {
    __shared__ float As[8][132];
    __shared__ float Bs[8][132];
    const int z = blockIdx.z, z0 = z / a.zdiv, z1 = z % a.zdiv;
    const float* A = a.A + z0 * a.zA0 + z1 * a.zA1;
    const float* B = a.B + z0 * a.zB0 + z1 * a.zB1;
    float* C = a.C + z0 * a.zC0 + z1 * a.zC1;
    const int bm = blockIdx.y * 128, bn = blockIdx.x * 128, tid = threadIdx.x, tx = tid & 15, ty = tid >> 4;
    float acc[8][8];
#pragma unroll
    for (int i = 0; i < 8; ++i)
#pragma unroll
        for (int j = 0; j < 8; ++j) acc[i][j] = 0.f;
    const int arow_l = tid >> 1, akk = (tid & 1) * 4;
    const long arow = a.gidx ? (long)a.gidx[bm + arow_l] : (long)(bm + arow_l);
    const float* Ap = A + arow * a.sam;
    const int bkk = tid >> 5, bnn = (tid & 31) * 4;
    for (int k0 = 0; k0 < a.K; k0 += 8) {
        float av[4], bv[4];
#pragma unroll
        for (int i = 0; i < 4; ++i) av[i] = Ap[(long)(k0 + akk + i) * a.sak];
#pragma unroll
        for (int i = 0; i < 4; ++i) bv[i] = B[(long)(k0 + bkk) * a.sbk + (long)(bn + bnn + i) * a.sbn];
        __syncthreads();
#pragma unroll
        for (int i = 0; i < 4; ++i) As[akk + i][arow_l] = av[i];
#pragma unroll
        for (int i = 0; i < 4; ++i) Bs[bkk][bnn + i] = bv[i];
        __syncthreads();
#pragma unroll
        for (int kk = 0; kk < 8; ++kk) {
            float x[8], y[8];
#pragma unroll
            for (int i = 0; i < 8; ++i) x[i] = As[kk][ty * 8 + i];
#pragma unroll
            for (int j = 0; j < 8; ++j) y[j] = Bs[kk][tx * 8 + j];
#pragma unroll
            for (int i = 0; i < 8; ++i)
#pragma unroll
                for (int j = 0; j < 8; ++j) acc[i][j] += x[i] * y[j];
        }
    }
#pragma unroll
    for (int i = 0; i < 8; ++i)
#pragma unroll
        for (int j = 0; j < 8; ++j) C[(long)(bm + ty * 8 + i) * a.ldc + bn + tx * 8 + j] = acc[i][j];
}

__global__ __launch_bounds__(64) void k_s5_scan(const float* __restrict__ u, float* __restrict__ ydir, const float* lam_re, const float* lam_im, const float* log_dt,
                                                const float* b_re, const float* b_im, const float* c_re, const float* c_im) {
    const int wid = blockIdx.x;
    const int dir = wid & 1, g = (wid >> 1) & 63, gb = wid >> 7;
    const int p = threadIdx.x;
    const int L = gb_len(gb), t0 = gb_tok0(gb);
    const double dt = exp((double)log_dt[dir * 64 + g]);
    const double lr = lam_re[(dir * 64 + g) * 64 + p], li = lam_im[(dir * 64 + g) * 64 + p];
    const double er = exp(lr * dt), lbr = er * cos(li * dt), lbi = er * sin(li * dt);
    const double nr = lbr - 1.0, ni = lbi, den = lr * lr + li * li;
    const double fr = (nr * lr + ni * li) / den, fi = (ni * lr - nr * li) / den;
    float Br[16], Bi[16], Cr[16], Ci[16];
#pragma unroll
    for (int h = 0; h < 16; ++h) {
        const double br = b_re[((dir * 64 + g) * 64 + p) * 16 + h], bi = b_im[((dir * 64 + g) * 64 + p) * 16 + h];
        Br[h] = (float)(fr * br - fi * bi); Bi[h] = (float)(fr * bi + fi * br);
        Cr[h] = c_re[((dir * 64 + g) * 16 + h) * 64 + p]; Ci[h] = c_im[((dir * 64 + g) * 16 + h) * 64 + p];
    }
    const float ar = (float)lbr, ai = (float)lbi;
    float hr = 0.f, hi = 0.f;
    float* yo = ydir + (size_t)dir * NT * D;
    for (int s = 0; s < L; ++s) {
        const int t = dir ? (L - 1 - s) : s;
        const float* ur = u + (size_t)(t0 + t) * D + g * 16;
        float bur = 0.f, bui = 0.f;
#pragma unroll
        for (int h = 0; h < 16; ++h) { const float uv = ur[h]; bur += uv * Br[h]; bui += uv * Bi[h]; }
        const float nhr = ar * hr - ai * hi + bur, nhi = ar * hi + ai * hr + bui;
        hr = nhr; hi = nhi;
        float mine = 0.f;
#pragma unroll
        for (int c = 0; c < 16; ++c) { const float v = wave_sum(Cr[c] * hr - Ci[c] * hi); if (p == c) mine = v; }
        if (p < 16) yo[(size_t)(t0 + t) * D + g * 16 + p] = mine;
    }
}
__global__ void k_s5_gelu(const float* u, const float* ydir, const float* dskip, float* gout) {
    const size_t i = (size_t)blockIdx.x * blockDim.x + threadIdx.x;
    if (i >= (size_t)NT * D) return;
    const float y = dskip[i & (D - 1)] * u[i] + ydir[i] + ydir[(size_t)NT * D + i];
    const float c = 0.7978845608028654f * (y + 0.044715f * y * y * y);
    gout[i] = 0.5f * y * (1.f + tanhf(c));
}
__global__ void k_glu(const float* z1, const float* z2, float* out) {
    const size_t i = (size_t)blockIdx.x * blockDim.x + threadIdx.x;
    if (i >= (size_t)NT * D) return;
    out[i] = z1[i] / (1.f + expf(-z2[i]));
}
__global__ __launch_bounds__(256) void k_res_ln(const float* x, const float* h, const float* g, const float* b, float* xo, int rows) {
    const int row = blockIdx.x * 4 + (threadIdx.x >> 6), lane = threadIdx.x & 63;
    if (row >= rows) return;
    float v[16]; float s = 0.f;
#pragma unroll
    for (int j = 0; j < 16; ++j) { const size_t i = (size_t)row * D + lane + 64 * j; v[j] = ALPHA * x[i] + h[i]; s += v[j]; }
    const float mean = wave_sum(s) * (1.f / D); float q = 0.f;
#pragma unroll
    for (int j = 0; j < 16; ++j) { v[j] -= mean; q += v[j] * v[j]; }
    const float rstd = 1.f / sqrtf(wave_sum(q) * (1.f / D) + LN_EPS);
#pragma unroll
    for (int j = 0; j < 16; ++j) { const int c = lane + 64 * j; xo[(size_t)row * D + c] = v[j] * rstd * g[c] + b[c]; }
}
__global__ __launch_bounds__(256) void k_softmax256(float* s, float scale, int rows) {
    const int row = blockIdx.x * 4 + (threadIdx.x >> 6), lane = threadIdx.x & 63;
    if (row >= rows) return;
    float v[4]; float m = -INFINITY;
#pragma unroll
    for (int j = 0; j < 4; ++j) { v[j] = s[(size_t)row * 256 + lane + 64 * j] * scale; m = fmaxf(m, v[j]); }
    m = wave_max(m); float l = 0.f;
#pragma unroll
    for (int j = 0; j < 4; ++j) { v[j] = expf(v[j] - m); l += v[j]; }
    l = wave_sum(l);
#pragma unroll
    for (int j = 0; j < 4; ++j) s[(size_t)row * 256 + lane + 64 * j] = v[j] / l;
}
__global__ __launch_bounds__(256) void k_router(const float* x, const float* wr, float* aff, int rows) {
    const int row = blockIdx.x * 4 + (threadIdx.x >> 6), lane = threadIdx.x & 63;
    if (row >= rows) return;
    float acc[16];
#pragma unroll
    for (int e = 0; e < 16; ++e) acc[e] = 0.f;
    for (int j = 0; j < 16; ++j) { const int k = lane + 64 * j; const float xv = x[(size_t)row * D + k];
#pragma unroll
        for (int e = 0; e < 16; ++e) acc[e] += xv * wr[k * 16 + e]; }
    float m = -INFINITY;
#pragma unroll
    for (int e = 0; e < 16; ++e) { acc[e] = wave_sum(acc[e]); m = fmaxf(m, acc[e]); }
    float l = 0.f;
#pragma unroll
    for (int e = 0; e < 16; ++e) { acc[e] = expf(acc[e] - m); l += acc[e]; }
    float mine = 0.f;
#pragma unroll
    for (int e = 0; e < 16; ++e) if (lane == e) mine = acc[e] / l;
    if (lane < 16) aff[(size_t)row * 16 + lane] = mine;
}

__device__ __forceinline__ void select_expert(const float* aff, int n, int e, int cap, int* idx_out, float* gate_out, int* slot_of  , unsigned* hist  , unsigned* wsum  , unsigned* bc  ) {
    const int tid = threadIdx.x, nth = blockDim.x, lane = tid & 63, wv = tid >> 6, nw = nth >> 6;
    unsigned prefix = 0u, mask = 0u; unsigned remaining = (unsigned)cap;
    for (int pass = 0; pass < 4; ++pass) {
        const int shift = 24 - 8 * pass;
        for (int i = tid; i < 256; i += nth) hist[i] = 0u;
        __syncthreads();
        for (int t = tid; t < n; t += nth) { const unsigned key = __float_as_uint(aff[(size_t)t * 16 + e]); if ((key & mask) == prefix) atomicAdd(&hist[(key >> shift) & 255u], 1u); }
        __syncthreads();
        if (tid == 0) { unsigned cum = 0u; int b = 255; for (; b > 0; --b) { if (cum + hist[b] >= remaining) break; cum += hist[b]; } bc[0] = (unsigned)b; bc[1] = remaining - cum; }
        __syncthreads();
        prefix |= bc[0] << shift; mask |= 0xffu << shift; remaining = bc[1];
        __syncthreads();
    }
    const unsigned T = prefix; const unsigned need_eq = remaining;
    unsigned base = 0u, eqbase = 0u;
    for (int s0 = 0; s0 < n; s0 += nth) {
        const int t = s0 + tid; const bool in = t < n;
        const float a = in ? aff[(size_t)t * 16 + e] : 0.f; const unsigned key = __float_as_uint(a);
        const bool gt = in && key > T, eq = in && key == T;
        const unsigned long long meq = __ballot(eq); const unsigned eqr_w = __popcll(meq & ((1ull << lane) - 1ull));
        if (lane == 0) wsum[wv] = __popcll(meq);
        __syncthreads();
        unsigned eqoff = 0u, eqtot = 0u; for (int w = 0; w < nw; ++w) { const unsigned c = wsum[w]; if (w < wv) eqoff += c; eqtot += c; }
        __syncthreads();
        const bool sel = gt || (eq && (eqbase + eqoff + eqr_w) < need_eq);
        const unsigned long long ms = __ballot(sel); const unsigned sr_w = __popcll(ms & ((1ull << lane) - 1ull));
        if (lane == 0) wsum[wv] = __popcll(ms);
        __syncthreads();
        unsigned soff = 0u, stot = 0u; for (int w = 0; w < nw; ++w) { const unsigned c = wsum[w]; if (w < wv) soff += c; stot += c; }
        __syncthreads();
        if (sel) { const unsigned slot = base + soff + sr_w; if (slot < (unsigned)cap) { idx_out[slot] = t; gate_out[slot] = a; } }
        if (slot_of && in) slot_of[(size_t)t * 16 + e] = sel ? (int)(base + soff + sr_w) : -1;
        base += stot; eqbase += eqtot;
    }
}
__global__ __launch_bounds__(512) void k_select(const float* aff_all, int* idx_all, float* gate_all) {
    __shared__ unsigned hist[256]; __shared__ unsigned wsum[32]; __shared__ unsigned bc[4];
    const int grp = blockIdx.x >> 4, e = blockIdx.x & 15;
    const int n = grp ? NTS : NTP, cap = n / 8;
    const float* aff = aff_all + (size_t)(grp ? NTP : 0) * 16;
    int* idx = idx_all + (grp ? 16 * 4096 : 0) + e * cap; float* gate = gate_all + (grp ? 16 * 4096 : 0) + e * cap;
    select_expert(aff, n, e, cap, idx, gate, nullptr, hist, wsum, bc);
}
__global__ void k_silu_mul(float* h1, const float* h3, size_t n) {
    const size_t i = (size_t)blockIdx.x * blockDim.x + threadIdx.x; if (i >= n) return;
    const float a = h1[i]; h1[i] = a / (1.f + expf(-a)) * h3[i];
}
__global__ void k_scatter_add(const float* ye, const int* idx, const float* gate, float* out, int cap) {
    const size_t i = (size_t)blockIdx.x * blockDim.x + threadIdx.x; if (i >= (size_t)cap * D) return;
    const int slot = (int)(i >> 10), c = (int)(i & 1023);
    atomicAdd(&out[(size_t)idx[slot] * D + c], gate[slot] * ye[i]);
}

__global__ __launch_bounds__(256) void k_natten(float* q, const float* k, const float* v, const float* rpb) {
    const int wg = blockIdx.x * 4 + (threadIdx.x >> 6), lane = threadIdx.x & 63;
    const int tok = wg >> 4, h = wg & 15;
    if (tok >= NT) return;
    int gb, l; if (tok < NTP) { gb = tok >> 13; l = tok & 8191; } else { gb = 4 + ((tok - NTP) >> 12); l = (tok - NTP) & 4095; }
    const int rows = gb_len(gb) / GRID_W, t0 = gb_tok0(gb);
    const int r = l >> 6, qc = l & 63;
    int rs = r - 4; rs = rs < 0 ? 0 : (rs > rows - 8 ? rows - 8 : rs);
    int ws = qc - 8; ws = ws < 0 ? 0 : (ws > 48 ? 48 : ws);
    const float qv = q[(size_t)tok * D + h * 64 + lane] * 0.125f;
    float m = -INFINITY, lsum = 0.f, o = 0.f;
    for (int rr = 0; rr < 8; ++rr) {
        const int kr = rs + rr, dr = kr - r + 7;
        for (int cc = 0; cc < 16; ++cc) {
            const int kc = ws + cc; int dc = kc - qc + 15; dc = dc < 0 ? 0 : (dc > 30 ? 30 : dc);
            const size_t kt = (size_t)(t0 + kr * 64 + kc) * D + h * 64 + lane;
            const float s = wave_sum(qv * k[kt]) + rpb[(h * 15 + dr) * 31 + dc];
            const float mn = fmaxf(m, s), al = expf(m - mn), pp = expf(s - mn);
            lsum = lsum * al + pp; o = o * al + pp * v[kt]; m = mn;
        }
    }
    q[(size_t)tok * D + h * 64 + lane] = o / lsum;
}
}
#define LAS __attribute__((address_space(3)))
#define GAS __attribute__((address_space(1)))
namespace fz {
typedef unsigned short bf16_t;
typedef short bf16x8 __attribute__((ext_vector_type(8)));
typedef float f32x4 __attribute__((ext_vector_type(4)));
typedef float f32x2 __attribute__((ext_vector_type(2)));
typedef unsigned u32x4 __attribute__((ext_vector_type(4)));
typedef unsigned u32x2 __attribute__((ext_vector_type(2)));
typedef int v8i __attribute__((ext_vector_type(8)));
typedef int v4i __attribute__((ext_vector_type(4)));

constexpr int D = 1024, NTP = 32768, NTS = 16384, NT = NTP + NTS;
constexpr int TCH = 32, NCHUNK = NT / TCH;
constexpr int UAK = TCH * 16 + 256;
constexpr float ALPHA = 1.41421356237309515f, LN_EPS = 1e-5f;
constexpr size_t MiB = 1u << 20;
constexpr size_t WS_CTL = 0, WS_XF = 1 * MiB, WS_XB = 193 * MiB, WS_WIN = 289 * MiB, WS_WGLU = 291 * MiB, WS_WQKV = 295 * MiB, WS_WO = 301 * MiB, WS_MWQ = 303 * MiB,
                 WS_MWKV = 307 * MiB, WS_MWO = 315 * MiB, WS_MEMB = 319 * MiB, WS_KV = 323 * MiB, WS_WQK = 339 * MiB, WS_WVO = 371 * MiB, WS_AFF = 403 * MiB, WS_SLOT = 406 * MiB,
                 WS_IDX = 409 * MiB, WS_GATE = 409 * MiB + 512 * 1024, WS_EW13 = 411 * MiB  , WS_EW2 = 475 * MiB  ,
                 WS_XB8 = 507 * MiB  , WS_POOL = 603 * MiB, WS_END = 1024 * MiB;
constexpr size_t PO_M2T = WS_POOL, PO_M13T = WS_POOL + 16 * MiB, PO_UA = WS_POOL + 64 * MiB, PO_SG = WS_POOL + 208 * MiB;
constexpr size_t PO_HB_S5 = WS_POOL;
constexpr size_t PO_SB = WS_POOL + 96 * MiB, PO_HB_MEM = WS_POOL + 304 * MiB;
constexpr size_t PO_Q = WS_POOL, PO_K = WS_POOL + 96 * MiB, PO_VT = WS_POOL + 192 * MiB, PO_HB_NA = WS_POOL + 96 * MiB;
constexpr size_t PO_HM = WS_POOL, PO_YE = WS_POOL + 192 * MiB;
static_assert(PO_YE + 192 * MiB <= WS_END && PO_SG + 96 * MiB <= WS_END && PO_HB_NA + 96 * MiB <= WS_END && PO_HB_MEM + 96 * MiB <= WS_END, "pool");
constexpr int CW_TMO = 0, CW_BAR = 4096;
constexpr size_t CTL_ZERO_BYTES = 64 * 1024;
constexpr int RING_BYTES = 131072, MISC_OFF = RING_BYTES + 320, LDS_BYTES = 147456, ZERO16_OFF = RING_BYTES + 64;

__host__ __device__ inline int gb_tok0(int gb) { return gb < 4 ? gb * 8192 : NTP + (gb - 4) * 4096; }
__host__ __device__ inline int gb_len(int gb) { return gb < 4 ? 8192 : 4096; }
__host__ __device__ inline int panel_gb(int pm) { return pm < 128 ? (pm >> 5) : 4 + ((pm - 128) >> 4); }

__device__ __forceinline__ unsigned cvt_pk_bf16(float lo, float hi) { unsigned r; asm volatile("v_cvt_pk_bf16_f32 %0, %1, %2" : "=v"(r) : "v"(lo), "v"(hi)); return r; }
typedef __bf16 bf16x2_t __attribute__((ext_vector_type(2)));
__device__ __forceinline__ unsigned cvt_pk_bf16_c(float lo, float hi) { const f32x2 v = {lo, hi}; const bf16x2_t b = __builtin_convertvector(v, bf16x2_t); return __builtin_bit_cast(unsigned, b); }
__device__ __forceinline__ float bf2f(unsigned short b) { return __uint_as_float(((unsigned)b) << 16); }
template <int CTRL> __device__ __forceinline__ float dpp_f(float v) { return __uint_as_float((unsigned)__builtin_amdgcn_update_dpp(0, (int)__float_as_uint(v), CTRL, 0xF, 0xF, true)); }
__device__ __forceinline__ float x16_sum(float v) { const auto r = __builtin_amdgcn_permlane16_swap(__float_as_uint(v), __float_as_uint(v), false, false); return __uint_as_float(r[0]) + __uint_as_float(r[1]); }
__device__ __forceinline__ float x32_sum(float v) { const auto r = __builtin_amdgcn_permlane32_swap(__float_as_uint(v), __float_as_uint(v), false, false); return __uint_as_float(r[0]) + __uint_as_float(r[1]); }
__device__ __forceinline__ float x16_max(float v) { const auto r = __builtin_amdgcn_permlane16_swap(__float_as_uint(v), __float_as_uint(v), false, false); return fmaxf(__uint_as_float(r[0]), __uint_as_float(r[1])); }
__device__ __forceinline__ float x32_max(float v) { const auto r = __builtin_amdgcn_permlane32_swap(__float_as_uint(v), __float_as_uint(v), false, false); return fmaxf(__uint_as_float(r[0]), __uint_as_float(r[1])); }
__device__ __forceinline__ float row_sum(float v) { v += dpp_f<0xB1>(v); v += dpp_f<0x4E>(v); v += dpp_f<0x141>(v); v += dpp_f<0x140>(v); return v; }
__device__ __forceinline__ float row_max(float v) { v = fmaxf(v, dpp_f<0xB1>(v)); v = fmaxf(v, dpp_f<0x4E>(v)); v = fmaxf(v, dpp_f<0x141>(v)); v = fmaxf(v, dpp_f<0x140>(v)); return v; }
__device__ __forceinline__ float wave_sum(float v) { return x32_sum(x16_sum(row_sum(v))); }
__device__ __forceinline__ float wave_max(float v) { return x32_max(x16_max(row_max(v))); }
#ifndef NO_WT
__device__ __forceinline__ void st16(void* p, u32x4 v) { asm volatile("global_store_dwordx4 %0, %1, off sc1\n\ts_nop 1" :: "v"(p), "v"(v)); }
__device__ __forceinline__ void st8(void* p, u32x2 v) { asm volatile("global_store_dwordx2 %0, %1, off sc1\n\ts_nop 1" :: "v"(p), "v"(v)); }
__device__ __forceinline__ void st4(void* p, unsigned v) { asm volatile("global_store_dword %0, %1, off sc1\n\ts_nop 1" :: "v"(p), "v"(v)); }
#else
__device__ __forceinline__ void st16(void* p, u32x4 v) { *(u32x4*)p = v; }
__device__ __forceinline__ void st8(void* p, u32x2 v) { *(u32x2*)p = v; }
__device__ __forceinline__ void st4(void* p, unsigned v) { *(unsigned*)p = v; }
#endif
__device__ __forceinline__ void st16f(void* p, f32x4 v) { st16(p, __builtin_bit_cast(u32x4, v)); }
__device__ __forceinline__ void pst16(void* p, u32x4 v) { *(u32x4*)p = v; }
__device__ __forceinline__ void pst8(void* p, u32x2 v) { *(u32x2*)p = v; }
#ifndef NO_WT
__device__ __forceinline__ void st16_so(const void* base, unsigned off, f32x4 v) { asm volatile("global_store_dwordx4 %0, %1, %2 sc1\n\ts_nop 1" :: "v"(off), "v"(v), "s"(base)); }
__device__ __forceinline__ void st4_so(const void* base, unsigned off, unsigned v) { asm volatile("global_store_dword %0, %1, %2 sc1\n\ts_nop 1" :: "v"(off), "v"(v), "s"(base)); }
#else
__device__ __forceinline__ void st16_so(const void* base, unsigned off, f32x4 v) { *(f32x4*)((unsigned char*)base + off) = v; }
__device__ __forceinline__ void st4_so(const void* base, unsigned off, unsigned v) { *(unsigned*)((unsigned char*)base + off) = v; }
#endif
#define LDS_WAIT() asm volatile("s_waitcnt lgkmcnt(0)" ::: "memory")
#define VM_WAIT() asm volatile("s_waitcnt vmcnt(0)" ::: "memory")

#define XB_TMO      128
#define XB_XCNT(j)  (256  + 64 * (j))
#define XB_XSUB(j)  (1280 + 64 * (j))
#define XB_XGEN(j)  (2304 + 64 * (j))
#define XB_TOP      3328
#define XB_TOPGEN   3392
#define XCD_BAR_WORDS 3456
#define XB_SPIN_CAP (1u << 18)
__device__ __forceinline__ unsigned xb_ld(unsigned* p)              { return __hip_atomic_load(p, __ATOMIC_RELAXED, __HIP_MEMORY_SCOPE_AGENT); }
__device__ __forceinline__ unsigned xb_add(unsigned* p, unsigned v) { return __hip_atomic_fetch_add(p, v, __ATOMIC_RELAXED, __HIP_MEMORY_SCOPE_AGENT); }
__device__ __forceinline__ unsigned xb_xcc_id() { return (unsigned)__builtin_amdgcn_s_getreg((3 << 11) | 20) & 0xFu; }
#define XB_SPIN(cond, bar) do { unsigned _sp = 0; while (cond) { __builtin_amdgcn_s_sleep(1); \
    if ((++_sp & 255u) == 0u) { if (xb_ld(&(bar)[XB_TMO])) break; if (_sp > XB_SPIN_CAP) { atomicAdd(&(bar)[XB_TMO], 1u); break; } } } } while (0)
struct XcdBarrier { unsigned* bar; unsigned x; volatile LAS unsigned* st; };
__device__ __forceinline__ int xb_tid();
__device__ __forceinline__ XcdBarrier xcd_barrier_post(unsigned* bar, volatile LAS unsigned* st) {
    XcdBarrier b; b.bar = bar; b.x = xb_xcc_id(); b.st = st;
    if (threadIdx.x == 0) st[4] = xb_add(&bar[XB_XCNT(b.x)], 1u);
    return b;
}
#define XB_LCNT(j)  (3520 + 64 * (j))
#define XB_LGEN(j)  (4544 + 64 * (j))
#define XCD_BAR_WORDS_EXT 5568
__device__ __forceinline__ void xcd_local_barrier(const XcdBarrier& b, const int wave_s, const unsigned nloc) {
    asm volatile("s_waitcnt vmcnt(0)" ::: "memory");
    __syncthreads();
    if (wave_s == 0 && xb_tid() == 0) {
        unsigned* bar = b.bar;
        const unsigned old = xb_add(&bar[XB_LCNT(b.x)], 1u);
        const unsigned gen = old / nloc;
        if (old + 1u == (gen + 1u) * nloc) xb_add(&bar[XB_LGEN(b.x)], 1u);
        else XB_SPIN(xb_ld(&bar[XB_LGEN(b.x)]) == gen, bar);
#ifndef LB_NOACQ
        __builtin_amdgcn_fence(__ATOMIC_ACQUIRE, "agent");
        asm volatile("s_waitcnt vmcnt(0)" ::: "memory");
#endif
    }
    __syncthreads();
}
__device__ __forceinline__ void xcd_barrier_complete(unsigned* bar, unsigned x, unsigned& nloc, unsigned& nx) {
    const unsigned G = gridDim.x * gridDim.y * gridDim.z;
    unsigned sum, cnt, mine, sp = 0u;
    for (;;) {
        sum = 0u; cnt = 0u; mine = 0u;
#pragma unroll
        for (unsigned j = 0; j < 16; ++j) { const unsigned c = xb_ld(&bar[XB_XCNT(j)]); sum += c; cnt += (c > 0u) ? 1u : 0u; mine = (j == x) ? c : mine; }
        if (sum == G) break;
        __builtin_amdgcn_s_sleep(1);
        if ((++sp & 255u) == 0u) { if (xb_ld(&bar[XB_TMO])) break; if (sp > XB_SPIN_CAP) { atomicAdd(&bar[XB_TMO], 1u); break; } }
    }
    nloc = mine > 0u ? mine : 1u; nx = cnt > 0u ? cnt : 1u;
}
__device__ __forceinline__ int xb_tid() { int t; asm volatile("v_mbcnt_lo_u32_b32 %0, -1, 0\n\tv_mbcnt_hi_u32_b32 %0, -1, %0" : "=v"(t)); return t; }
__device__ __forceinline__ void xcd_barrier(const XcdBarrier& b, const int wave_s) {
    asm volatile("s_waitcnt vmcnt(0)" ::: "memory");
    __syncthreads();
    if (wave_s == 0 && xb_tid() == 0) {
        unsigned* bar = b.bar;
        __builtin_amdgcn_s_waitcnt(0);
        unsigned nloc = b.st[0], nx = b.st[1];
        if (nloc == 0u) { xcd_barrier_complete(bar, b.x, nloc, nx); b.st[0] = nloc; b.st[1] = nx; }
        const unsigned old = xb_add(&bar[XB_XSUB(b.x)], 1u);
        const unsigned gen = old / nloc;
        if (old + 1u == (gen + 1u) * nloc) {
            __builtin_amdgcn_fence(__ATOMIC_RELEASE, "agent");
            asm volatile("s_waitcnt vmcnt(0)" ::: "memory");
            const unsigned og = xb_add(&bar[XB_TOP], 1u);
            const unsigned tg = og / nx;
            if (og + 1u == (tg + 1u) * nx) xb_add(&bar[XB_TOPGEN], 1u);
            else XB_SPIN(xb_ld(&bar[XB_TOPGEN]) == tg, bar);
            __builtin_amdgcn_fence(__ATOMIC_ACQUIRE, "agent");
            xb_add(&bar[XB_XGEN(b.x)], 1u);
            asm volatile("s_waitcnt vmcnt(0)" ::: "memory");
        } else {
            XB_SPIN(xb_ld(&bar[XB_XGEN(b.x)]) == gen, bar);
            __builtin_amdgcn_fence(__ATOMIC_ACQUIRE, "agent");
            asm volatile("s_waitcnt vmcnt(0)" ::: "memory");
        }
    }
    __syncthreads();
}

constexpr int BM = 256, BK = 64, HALF = 128, HTB = HALF * BK * 2, STAGE_BYTES = 8 * HTB;
__host__ __device__ __forceinline__ int lds_byte(int r, int c) { const int st = (r >> 4) * 2 + (c >> 5), rr = r & 15, cc = c & 31, ob = rr * 64 + cc * 2; return st * 1024 + (ob ^ (((ob >> 9) & 1) << 5)); }
__host__ __device__ __forceinline__ void stage_rc(int b, int& R, int& C) { const int st = b / 1024, sb = b % 1024, swz = sb ^ (((sb >> 9) & 1) << 5); R = (st >> 1) * 16 + swz / 64; C = (st & 1) * 32 + (swz % 64) / 2; }
__host__ __device__ __forceinline__ int perm32(int rho) { const int n = rho >> 4, i = rho & 15; return 8 * (i >> 2) + 4 * n + (i & 3); }

struct GUnit { const char* A; const char* B; char* C; const void* X; int pm, pn; };
template <int WGM = 8>
__device__ __forceinline__ bool static_unit(int i, int G, int c, int nM, int nN, int& pm, int& pn) {
    const long L = (long)i * G + c; const int nwg = nM * nN; if (L >= nwg) return false;
    int wgid = (int)L; { const int q = nwg / 8, r = nwg % 8, xcd = wgid % 8, off = wgid / 8; wgid = (xcd < r ? xcd * (q + 1) : r * (q + 1) + (xcd - r) * q) + off; }
    const int nig = WGM * nN, gid = wgid / nig, fm = gid * WGM, gsz = (nM - fm) < WGM ? (nM - fm) : WGM;
    pm = fm + ((wgid % nig) % gsz); pn = (wgid % nig) / gsz; return true;
}
template <class Epi, class Sched, bool GATHER, bool FP8 = false>
__device__ __forceinline__ void gemm_phase(LAS unsigned char* lds, const int tid_in, const int K, const unsigned lda, const unsigned ldb, const Sched& S, const Epi& E) {
    int tid_ = tid_in; asm volatile("" : "+v"(tid_));
    const int tid = tid_, wid = __builtin_amdgcn_readfirstlane(tid >> 6), lane = tid & 63, wr = wid >> 2, wc = wid & 3, fr = lane & 15, fq = lane >> 4;
    int nt_ = K / BK; asm volatile("" : "+s"(nt_)); const int nt = nt_;
    unsigned voffA[2], voffB[2]; int gR[2], gC[2];
#pragma unroll
    for (int i = 0; i < 2; ++i) { int R, C; stage_rc(tid * 16 + i * 8192, R, C); const int Rb = Epi::PERM ? ((R & ~31) + perm32(R & 31)) : R;
        voffA[i] = (unsigned)R * lda + (unsigned)C * 2u; voffB[i] = (unsigned)Rb * ldb + (unsigned)C * 2u; gR[i] = R; gC[i] = C * 2; }
    const size_t kstep = (size_t)(BK * 2);
    const size_t hstepA = (size_t)HALF * lda, hstepB = (size_t)HALF * ldb;
    const unsigned ldsw = (unsigned)wid * 1024u;
    const int aoff = lds_byte(wr * 64 + fr, fq * 8), boff = lds_byte(wc * 32 + fr, fq * 8);
    const int sc8 = 0x7F7F7F7F;
    unsigned cvo[2][2], nvo[2][2];
#define PG8_SA(b, h) (((b) * 2 + (h)) * HTB)
#define PG8_SB(b, h) ((4 + (b) * 2 + (h)) * HTB)
#define PG8_STAGE(bufoff, gbase, voff) do { _Pragma("unroll") for (int _i = 0; _i < 2; ++_i) \
        __builtin_amdgcn_global_load_lds((const unsigned*)((const char*)(gbase) + (voff)[_i]), (LAS unsigned*)(lds + (bufoff) + ldsw + _i * 8192), 16, 0, 0); } while (0)
#define PG8_STAGE_B(bufoff, ptr, h) PG8_STAGE(bufoff, (ptr) + (h) * hstepB, voffB)
#define PG8_STAGE_A(bufoff, ptr, h, vo) do { if constexpr (GATHER) { PG8_STAGE(bufoff, (ptr), (vo)[h]); } else { PG8_STAGE(bufoff, (ptr) + (h) * hstepA, voffA); } } while (0)
#define PG8_LDA(dst, b, h) do { _Pragma("unroll") for (int m = 0; m < 4; ++m) _Pragma("unroll") for (int k = 0; k < 2; ++k) dst[m][k] = *(const LAS bf16x8*)(lds + PG8_SA(b, h) + aoff + m * 2048 + k * 1024); } while (0)
#define PG8_LDB(dst, b, h) do { _Pragma("unroll") for (int n = 0; n < 2; ++n) _Pragma("unroll") for (int k = 0; k < 2; ++k) dst[n][k] = *(const LAS bf16x8*)(lds + PG8_SB(b, h) + boff + n * 2048 + k * 1024); } while (0)
#define PG8_MMA(ai, bj, At, Bt) do { __builtin_amdgcn_s_setprio(1); _Pragma("unroll") for (int m = 0; m < 4; ++m) _Pragma("unroll") for (int n = 0; n < 2; ++n) { \
        if constexpr (FP8) { const v8i _a = __builtin_shufflevector(__builtin_bit_cast(v4i, At[m][0]), __builtin_bit_cast(v4i, At[m][1]), 0, 1, 2, 3, 4, 5, 6, 7), _b = __builtin_shufflevector(__builtin_bit_cast(v4i, Bt[n][0]), __builtin_bit_cast(v4i, Bt[n][1]), 0, 1, 2, 3, 4, 5, 6, 7); \
            asm volatile("v_mfma_scale_f32_16x16x128_f8f6f4 %0, %1, %2, %0, %3, %3 op_sel_hi:[0,0,0]" : "+v"(acc[ai][bj][m][n]) : "v"(_b), "v"(_a), "v"(sc8)); } \
        else { _Pragma("unroll") for (int k = 0; k < 2; ++k) acc[ai][bj][m][n] = __builtin_amdgcn_mfma_f32_16x16x32_bf16(Bt[n][k], At[m][k], acc[ai][bj][m][n], 0, 0, 0); } } __builtin_amdgcn_s_setprio(0); } while (0)
#define PG8_WAIT_V(n) asm volatile("s_waitcnt vmcnt(" #n ")" ::: "memory")
#define PG8_WAIT_L(n) asm volatile("s_waitcnt lgkmcnt(" #n ")" ::: "memory")
#define PG8_BAR __builtin_amdgcn_s_barrier()
#define PG8_SCHED __builtin_amdgcn_sched_barrier(0)
#define PG8_GLOAD(vo, u) do { if constexpr (GATHER) { const int* _gi = (const int*)(u).X; _Pragma("unroll") for (int _h = 0; _h < 2; ++_h) _Pragma("unroll") for (int _i = 0; _i < 2; ++_i) \
        (vo)[_h][_i] = (unsigned)_gi[_h * HALF + gR[_i]] * lda + (unsigned)gC[_i]; } } while (0)
    GUnit cur, nxt; int ui = 0;
    if (!S.next(0, cur)) return;
    f32x4 acc[2][2][4][2];
    const volatile LAS f32x4* zero16 = (const volatile LAS f32x4*)(lds + ZERO16_OFF);
#pragma unroll
    for (int a = 0; a < 2; ++a)
#pragma unroll
        for (int b = 0; b < 2; ++b)
#pragma unroll
            for (int m = 0; m < 4; ++m)
#pragma unroll
                for (int n = 0; n < 2; ++n) acc[a][b][m][n] = *zero16;
    bf16x8 At[4][2], B0[2][2], B1[2][2];
    const char* cA = cur.A; const char* cB = cur.B;
    PG8_GLOAD(cvo, cur);
    if constexpr (GATHER) { PG8_WAIT_V(0); }
    PG8_STAGE_B(PG8_SB(0, 0), cB, 0); PG8_STAGE_B(PG8_SB(0, 1), cB, 1); PG8_STAGE_A(PG8_SA(0, 0), cA, 0, cvo); PG8_STAGE_A(PG8_SA(0, 1), cA, 1, cvo);
    if (wr == 1) PG8_BAR;
    PG8_WAIT_V(2); PG8_BAR;
    PG8_STAGE_B(PG8_SB(1, 0), cB + kstep, 0); PG8_STAGE_A(PG8_SA(1, 0), cA + kstep, 0, cvo); PG8_STAGE_B(PG8_SB(1, 1), cB + kstep, 1);
    PG8_WAIT_V(6); PG8_BAR;
    for (;;) {
        const bool has_next = S.next(ui + 1, nxt);
        const char* nA = has_next ? nxt.A : cA; const char* nB = has_next ? nxt.B : cB;
        if constexpr (GATHER) { if (has_next) { PG8_GLOAD(nvo, nxt); } else {
#pragma unroll
            for (int h = 0; h < 2; ++h)
#pragma unroll
                for (int i = 0; i < 2; ++i) nvo[h][i] = cvo[h][i]; } }
        for (int t = 0; t < nt; t += 2) {
            const bool last = (t == nt - 2);
            const char* a1 = cA + (size_t)(t + 1) * kstep;
            const char* a2 = last ? nA : cA + (size_t)(t + 2) * kstep; const char* b2 = last ? nB : cB + (size_t)(t + 2) * kstep;
            const char* a3 = a2 + kstep; const char* b3 = b2 + kstep;
            unsigned vo2[2][2];
            if constexpr (GATHER) {
#pragma unroll
                for (int h = 0; h < 2; ++h)
#pragma unroll
                    for (int i = 0; i < 2; ++i) vo2[h][i] = last ? nvo[h][i] : cvo[h][i]; }
            PG8_LDB(B0, 0, 0); PG8_LDB(B1, 0, 1); PG8_SCHED; PG8_LDA(At, 0, 0); PG8_STAGE_A(PG8_SA(1, 1), a1, 1, cvo);
            PG8_WAIT_V(8); PG8_WAIT_L(0); PG8_BAR; PG8_MMA(0, 0, At, B0); PG8_MMA(0, 1, At, B1); PG8_BAR; PG8_SCHED;
            PG8_LDA(At, 0, 1); PG8_STAGE_B(PG8_SB(0, 0), b2, 0); PG8_STAGE_B(PG8_SB(0, 1), b2, 1); PG8_STAGE_A(PG8_SA(0, 0), a2, 0, vo2);
            PG8_WAIT_V(8); PG8_WAIT_L(0); PG8_BAR; PG8_MMA(1, 0, At, B0); PG8_MMA(1, 1, At, B1); PG8_BAR; PG8_SCHED;
            PG8_LDB(B0, 1, 0); PG8_LDB(B1, 1, 1); PG8_SCHED; PG8_LDA(At, 1, 0); PG8_STAGE_A(PG8_SA(0, 1), a2, 1, vo2);
            PG8_WAIT_V(8); PG8_WAIT_L(0); PG8_BAR; PG8_MMA(0, 0, At, B0); PG8_MMA(0, 1, At, B1); PG8_BAR; PG8_SCHED;
            PG8_LDA(At, 1, 1); PG8_STAGE_B(PG8_SB(1, 0), b3, 0); PG8_STAGE_B(PG8_SB(1, 1), b3, 1); PG8_STAGE_A(PG8_SA(1, 0), a3, 0, vo2);
            PG8_WAIT_V(8); PG8_WAIT_L(0); PG8_BAR; PG8_MMA(1, 0, At, B0); PG8_MMA(1, 1, At, B1); PG8_BAR; PG8_SCHED;
        }
        if constexpr (FP8) { asm volatile("s_nop 15\n\ts_nop 15" ::: "memory"); }
        if (wr == 0) PG8_BAR;
        E(acc, cur, wr, wc, fr, fq);
        if (!has_next) break;
#pragma unroll
        for (int a = 0; a < 2; ++a)
#pragma unroll
            for (int b = 0; b < 2; ++b)
#pragma unroll
                for (int m = 0; m < 4; ++m)
#pragma unroll
                    for (int n = 0; n < 2; ++n) acc[a][b][m][n] = *zero16;
        cur = nxt; cA = nA; cB = nB; ++ui;
        if constexpr (GATHER) {
#pragma unroll
            for (int h = 0; h < 2; ++h)
#pragma unroll
                for (int i = 0; i < 2; ++i) cvo[h][i] = nvo[h][i]; }
        if (wr == 1) PG8_BAR;
    }
    PG8_WAIT_V(0);
    PG8_BAR;
#undef PG8_SA
#undef PG8_SB
#undef PG8_STAGE
#undef PG8_STAGE_A
#undef PG8_STAGE_B
#undef PG8_LDA
#undef PG8_LDB
#undef PG8_MMA
#undef PG8_WAIT_V
#undef PG8_WAIT_L
#undef PG8_BAR
#undef PG8_SCHED
#undef PG8_GLOAD
}
typedef f32x4 Acc[2][2][4][2];
__device__ __forceinline__ float sigmoidf_fast(float x) { return __builtin_amdgcn_rcpf(1.f + __builtin_amdgcn_exp2f(-1.4426950408889634f * x)); }
__device__ __forceinline__ float gelu_tanh_fast(float y) {
    const float inner = 1.5957691216057308f * (y + 0.044715f * y * y * y);
    return y * sigmoidf_fast(inner);
}
__device__ __forceinline__ unsigned cvt4_fp8(float a, float b, float c, float d) {
    a = fminf(fmaxf(a, -448.f), 448.f); b = fminf(fmaxf(b, -448.f), 448.f); c = fminf(fmaxf(c, -448.f), 448.f); d = fminf(fmaxf(d, -448.f), 448.f);
    int w = 0; w = __builtin_amdgcn_cvt_pk_fp8_f32(a, b, w, false); w = __builtin_amdgcn_cvt_pk_fp8_f32(c, d, w, true); return (unsigned)w;
}
constexpr float FP8_SX = 8.f, FP8_SW13 = 32.f, FP8_SH = 8.f, FP8_SW2 = 64.f, FP8_SWQK = 32.f, FP8_SWQKV = 32.f;
struct EpiGated8 {
    static constexpr bool PERM = true;
    unsigned ldc;
    __device__ __forceinline__ void operator()(const Acc& acc, const GUnit& u, int wr, int wc, int fr, int fq) const {
        unsigned char* base = (unsigned char*)u.C;
        constexpr float kx = -1.4426950408889634f / (FP8_SX * FP8_SW13), ic = (FP8_SX * FP8_SW13) * (FP8_SX * FP8_SW13) / FP8_SH;
#pragma unroll
        for (int ai = 0; ai < 2; ++ai)
#pragma unroll
            for (int m = 0; m < 4; ++m) { const int r = ai * HALF + wr * 64 + m * 16 + fr;
                float o[8];
#pragma unroll
                for (int n = 0; n < 2; ++n)
#pragma unroll
                    for (int j = 0; j < 4; j += 2) {
                        const f32x2 a = {acc[ai][0][m][n][j], acc[ai][0][m][n][j + 1]}, b = {acc[ai][1][m][n][j], acc[ai][1][m][n][j + 1]};
                        const f32x2 t = a * f32x2{kx, kx};
                        const f32x2 e = {__builtin_amdgcn_exp2f(t[0]), __builtin_amdgcn_exp2f(t[1])};
                        const f32x2 d = e * f32x2{ic, ic} + f32x2{ic, ic};
                        const f32x2 s = {__builtin_amdgcn_rcpf(d[0]), __builtin_amdgcn_rcpf(d[1])};
                        const f32x2 q = (a * b) * s;
                        o[n * 4 + j] = __builtin_amdgcn_fmed3f(q[0], -448.f, 448.f); o[n * 4 + j + 1] = __builtin_amdgcn_fmed3f(q[1], -448.f, 448.f); }
                int w0 = 0, w1 = 0;
                w0 = __builtin_amdgcn_cvt_pk_fp8_f32(o[0], o[1], w0, false); w0 = __builtin_amdgcn_cvt_pk_fp8_f32(o[2], o[3], w0, true);
                w1 = __builtin_amdgcn_cvt_pk_fp8_f32(o[4], o[5], w1, false); w1 = __builtin_amdgcn_cvt_pk_fp8_f32(o[6], o[7], w1, true);
                u32x2 w; w.x = (unsigned)w0; w.y = (unsigned)w1;
                st8(base + (size_t)r * ldc + wc * 32 + 8 * fq, w); }
    }
};
struct EpiBf8 {
    static constexpr bool PERM = true;
    unsigned ldc; float scale;
    __device__ __forceinline__ void operator()(const Acc& acc, const GUnit& u, int wr, int wc, int fr, int fq) const {
        unsigned char* base = (unsigned char*)u.C;
#pragma unroll
        for (int ai = 0; ai < 2; ++ai)
#pragma unroll
            for (int m = 0; m < 4; ++m) { const int r = ai * HALF + wr * 64 + m * 16 + fr; unsigned char* rowp = base + (size_t)r * ldc + wc * 32 + 8 * fq;
#pragma unroll
                for (int bj = 0; bj < 2; ++bj) { const f32x4 v0 = acc[ai][bj][m][0] * scale, v1 = acc[ai][bj][m][1] * scale;
                    u32x2 w; w.x = cvt4_fp8(v0[0], v0[1], v0[2], v0[3]); w.y = cvt4_fp8(v1[0], v1[1], v1[2], v1[3]); st8(rowp + bj * HALF, w); } }
    }
};
template <bool ROWSCALE> struct EpiBf {
    static constexpr bool PERM = true;
    unsigned ldc; float scale;
    __device__ __forceinline__ void operator()(const Acc& acc, const GUnit& u, int wr, int wc, int fr, int fq) const {
        bf16_t* base = (bf16_t*)u.C; const float* rs = (const float*)u.X;
#pragma unroll
        for (int ai = 0; ai < 2; ++ai)
#pragma unroll
            for (int m = 0; m < 4; ++m) { const int r = ai * HALF + wr * 64 + m * 16 + fr; float s = scale; if (ROWSCALE) s *= rs[r];
                bf16_t* rowp = base + (size_t)r * ldc + wc * 32 + 8 * fq;
#pragma unroll
                for (int bj = 0; bj < 2; ++bj) { const f32x4 v0 = acc[ai][bj][m][0] * s, v1 = acc[ai][bj][m][1] * s;
                    u32x4 w; w.x = cvt_pk_bf16(v0[0], v0[1]); w.y = cvt_pk_bf16(v0[2], v0[3]); w.z = cvt_pk_bf16(v1[0], v1[1]); w.w = cvt_pk_bf16(v1[2], v1[3]);
                    st16(rowp + bj * HALF, w); } }
    }
};
template <int MODE> struct EpiGated {
    static constexpr bool PERM = true;
    unsigned ldc;
    __device__ __forceinline__ void operator()(const Acc& acc, const GUnit& u, int wr, int wc, int fr, int fq) const {
        bf16_t* base = (bf16_t*)u.C;
#pragma unroll
        for (int ai = 0; ai < 2; ++ai)
#pragma unroll
            for (int m = 0; m < 4; ++m) { const int r = ai * HALF + wr * 64 + m * 16 + fr;
                float o[8];
#pragma unroll
                for (int n = 0; n < 2; ++n)
#pragma unroll
                    for (int j = 0; j < 4; ++j) { const float a = acc[ai][0][m][n][j], b = acc[ai][1][m][n][j];
                        o[n * 4 + j] = (MODE == 0) ? a * sigmoidf_fast(b) : a * sigmoidf_fast(a) * b; }
                u32x4 w; w.x = cvt_pk_bf16(o[0], o[1]); w.y = cvt_pk_bf16(o[2], o[3]); w.z = cvt_pk_bf16(o[4], o[5]); w.w = cvt_pk_bf16(o[6], o[7]);
                st16(base + (size_t)r * ldc + wc * 32 + 8 * fq, w); }
    }
};
struct EpiUA {
    static constexpr bool PERM = true;
    __device__ __forceinline__ void operator()(const Acc& acc, const GUnit& u, int wr, int wc, int fr, int fq) const {
        bf16_t* UA = (bf16_t*)u.C;
#pragma unroll
        for (int ai = 0; ai < 2; ++ai)
#pragma unroll
            for (int m = 0; m < 4; ++m) { const int tok = u.pm * BM + ai * HALF + wr * 64 + m * 16 + fr; const int chunk = tok >> 5, j = tok & 31;
#pragma unroll
                for (int bj = 0; bj < 2; ++bj) { const int ch = u.pn * BM + bj * HALF + wc * 32 + 8 * fq, g = ch >> 4, h0 = ch & 15;
                    const f32x4 v0 = acc[ai][bj][m][0], v1 = acc[ai][bj][m][1];
                    u32x4 w; w.x = cvt_pk_bf16(v0[0], v0[1]); w.y = cvt_pk_bf16(v0[2], v0[3]); w.z = cvt_pk_bf16(v1[0], v1[1]); w.w = cvt_pk_bf16(v1[2], v1[3]);
                    st16(UA + ((size_t)g * NCHUNK + chunk) * UAK + j * 16 + h0, w); } }
    }
};
struct EpiS {
    static constexpr bool PERM = false;
    __device__ __forceinline__ void operator()(const Acc& acc, const GUnit& u, int wr, int wc, int fr, int fq) const {
        float* Sg = (float*)u.C;
#pragma unroll
        for (int ai = 0; ai < 2; ++ai)
#pragma unroll
            for (int m = 0; m < 4; ++m) { const int chunk = u.pm * BM + ai * HALF + wr * 64 + m * 16 + fr; float* rowp = Sg + (size_t)chunk * 256 + wc * 32 + 4 * fq;
#pragma unroll
                for (int bj = 0; bj < 2; ++bj)
#pragma unroll
                    for (int n = 0; n < 2; ++n) st16f(rowp + bj * HALF + n * 16, acc[ai][bj][m][n]); }
    }
};
struct EpiGelu {
    static constexpr bool PERM = true;
    __device__ __forceinline__ void operator()(const Acc& acc, const GUnit& u, int wr, int wc, int fr, int fq) const {
        bf16_t* Gg = (bf16_t*)u.C;
#pragma unroll
        for (int ai = 0; ai < 2; ++ai)
#pragma unroll
            for (int m = 0; m < 4; ++m) { const int chunk = u.pm * BM + ai * HALF + wr * 64 + m * 16 + fr;
#pragma unroll
                for (int bj = 0; bj < 2; ++bj) { const int n0 = u.pn * BM + bj * HALF + wc * 32 + 8 * fq, i = n0 >> 4, c0 = n0 & 15;
                    const f32x4 v0 = acc[ai][bj][m][0], v1 = acc[ai][bj][m][1];
                    u32x4 w; w.x = cvt_pk_bf16(gelu_tanh_fast(v0[0]), gelu_tanh_fast(v0[1])); w.y = cvt_pk_bf16(gelu_tanh_fast(v0[2]), gelu_tanh_fast(v0[3]));
                    w.z = cvt_pk_bf16(gelu_tanh_fast(v1[0]), gelu_tanh_fast(v1[1])); w.w = cvt_pk_bf16(gelu_tanh_fast(v1[2]), gelu_tanh_fast(v1[3]));
                    st16(Gg + ((size_t)chunk * TCH + i) * D + c0, w); } }
    }
};

struct EpiSoftmax {
    static constexpr bool PERM = true;
    LAS float* red; unsigned ldc; float scale;
    __device__ __forceinline__ void operator()(Acc& acc, const GUnit& u, int wr, int wc, int fr, int fq) const {
        bf16_t* base = (bf16_t*)u.C;
#pragma unroll
        for (int ai = 0; ai < 2; ++ai)
#pragma unroll
            for (int m = 0; m < 4; ++m) { float mx = -INFINITY;
#pragma unroll
                for (int bj = 0; bj < 2; ++bj)
#pragma unroll
                    for (int n = 0; n < 2; ++n) { const f32x4 v = acc[ai][bj][m][n]; mx = fmaxf(mx, fmaxf(fmaxf(v[0], v[1]), fmaxf(v[2], v[3]))); }
                mx *= scale; mx = x32_max(x16_max(mx));
                if (fq == 0) red[(ai * HALF + wr * 64 + m * 16 + fr) * 4 + wc] = mx; }
        asm volatile("s_waitcnt lgkmcnt(0)" ::: "memory"); __builtin_amdgcn_s_barrier(); asm volatile("" ::: "memory");
#pragma unroll
        for (int ai = 0; ai < 2; ++ai)
#pragma unroll
            for (int m = 0; m < 4; ++m) { const int r = ai * HALF + wr * 64 + m * 16 + fr; const f32x4 mm = *(const LAS f32x4*)(red + r * 4); const float M = fmaxf(fmaxf(mm[0], mm[1]), fmaxf(mm[2], mm[3]));
                float s = 0.f;
#pragma unroll
                for (int bj = 0; bj < 2; ++bj)
#pragma unroll
                    for (int n = 0; n < 2; ++n) { f32x4 v = acc[ai][bj][m][n];
#pragma unroll
                        for (int j = 0; j < 4; ++j) { v[j] = __builtin_amdgcn_exp2f(__builtin_fmaf(v[j], scale, -M)); s += v[j]; }
                        acc[ai][bj][m][n] = v; }
                s = x32_sum(x16_sum(s));
                if (fq == 0) red[1024 + r * 4 + wc] = s; }
        asm volatile("s_waitcnt lgkmcnt(0)" ::: "memory"); __builtin_amdgcn_s_barrier(); asm volatile("" ::: "memory");
#pragma unroll
        for (int ai = 0; ai < 2; ++ai)
#pragma unroll
            for (int m = 0; m < 4; ++m) { const int r = ai * HALF + wr * 64 + m * 16 + fr; const f32x4 ss = *(const LAS f32x4*)(red + 1024 + r * 4); const float inv = __builtin_amdgcn_rcpf((ss[0] + ss[1]) + (ss[2] + ss[3]));
                bf16_t* rowp = base + (size_t)r * ldc + wc * 32 + 8 * fq;
#pragma unroll
                for (int bj = 0; bj < 2; ++bj) { const f32x4 v0 = acc[ai][bj][m][0] * inv, v1 = acc[ai][bj][m][1] * inv;
                    u32x4 w; w.x = cvt_pk_bf16(v0[0], v0[1]); w.y = cvt_pk_bf16(v0[2], v0[3]); w.z = cvt_pk_bf16(v1[0], v1[1]); w.w = cvt_pk_bf16(v1[2], v1[3]);
                    st16(rowp + bj * HALF, w); } }
    }
};

struct Ctx { unsigned char* ws; int G, c; };
struct SchedPlain { const char* A; const char* B; char* C; size_t lda, ldb, ldc; int nM, nN, G, c;
    __device__ __forceinline__ bool next(int i, GUnit& u) const { int pm, pn; if (!static_unit(i, G, c, nM, nN, pm, pn)) return false;
        u.A = A + (size_t)pm * BM * lda; u.B = B + (size_t)pn * BM * ldb; u.C = C + ((size_t)pm * BM * ldc + (size_t)pn * BM) * 2; u.X = nullptr; u.pm = pm; u.pn = pn; return true; } };
struct SchedGated { const char* A; const char* B; char* C; size_t lda, ldb, ldc; int nM, nN, G, c;
    __device__ __forceinline__ bool next(int i, GUnit& u) const { int pm, pn; if (!static_unit(i, G, c, nM, nN, pm, pn)) return false;
        u.A = A + (size_t)pm * BM * lda; u.B = B + (size_t)pn * BM * ldb; u.C = C + ((size_t)pm * BM * ldc + (size_t)pn * HALF) * 2; u.X = nullptr; u.pm = pm; u.pn = pn; return true; } };
struct SchedUA { const char* A; const char* B; char* UA; int G, c;
    __device__ __forceinline__ bool next(int i, GUnit& u) const { int pm, pn; if (!static_unit(i, G, c, NT / BM, D / BM, pm, pn)) return false;
        u.A = A + (size_t)pm * BM * (D * 2); u.B = B + (size_t)pn * BM * (D * 2); u.C = UA; u.X = nullptr; u.pm = pm; u.pn = pn; return true; } };
struct SchedKV { unsigned char* ws; int G, c;
    __device__ __forceinline__ bool next(int i, GUnit& u) const { const int L = i * G + c; if (L >= 128) return false; const int layer = L >> 6, r = L & 63, pm = r >> 3, pn = r & 7;
        u.A = (const char*)ws + WS_MEMB + (size_t)pm * BM * 2048; u.B = (const char*)ws + WS_MWKV + (size_t)layer * 4 * MiB + (size_t)pn * BM * 2048;
        u.C = (char*)ws + WS_KV + (size_t)layer * 8 * MiB + ((size_t)pm * BM * 2048 + pn * BM) * 2; u.X = nullptr; u.pm = pm; u.pn = pn; return true; } };
struct SchedSA { unsigned char* ws; int G, c;
    __device__ __forceinline__ bool next(int i, GUnit& u) const { const int L = i * G + c; if (L >= 64 * 6) return false; const int g = L / 6, pm = L % 6;
        u.A = (const char*)ws + PO_UA + ((size_t)g * NCHUNK + (size_t)pm * BM) * (UAK * 2); u.B = (const char*)ws + PO_M2T + (size_t)g * 256 * 512 * 2;
        u.C = (char*)ws + PO_SG + (size_t)g * NCHUNK * 256 * 4; u.X = nullptr; u.pm = pm; u.pn = 0; return true; } };
struct SchedSC { unsigned char* ws; int G, c;
    __device__ __forceinline__ bool next(int i, GUnit& u) const { const int L = i * G + c; if (L >= 64 * 12) return false; const int g = L / 12, r = L % 12, pm = r >> 1, pn = r & 1;
        u.A = (const char*)ws + PO_UA + ((size_t)g * NCHUNK + (size_t)pm * BM) * (UAK * 2); u.B = (const char*)ws + PO_M13T + ((size_t)g * 512 + pn * BM) * UAK * 2;
        u.C = (char*)ws + PO_SG + (size_t)g * 16 * 2; u.X = nullptr; u.pm = pm; u.pn = pn; return true; } };
struct SchedWqk { unsigned char* ws; int G, c;
    __device__ __forceinline__ bool next(int i, GUnit& u) const { const int L = i * G + c; if (L >= 256) return false; const int pn = L & 3, h = (L >> 2) & 3, gb = (L >> 4) & 7, layer = L >> 7;
        u.A = (const char*)ws + WS_KV + (size_t)layer * 8 * MiB + ((size_t)gb * 256 * 2048 + h * 256) * 2; u.B = (const char*)ws + WS_MWQ + (size_t)layer * 2 * MiB + ((size_t)pn * BM * 1024 + h * 256) * 2;
        u.C = (char*)ws + WS_WQK + ((size_t)(layer * 8 + gb) * 1024 * 1024 + (size_t)h * 256 * 1024 + pn * BM); u.X = nullptr; u.pm = 0; u.pn = pn; return true; } };
struct SchedWvo { unsigned char* ws; int G, c;
    __device__ __forceinline__ bool next(int i, GUnit& u) const { const int L = i * G + c; if (L >= 256) return false; const int pm = L & 3, h = (L >> 2) & 3, gb = (L >> 4) & 7, layer = L >> 7;
        u.A = (const char*)ws + WS_MWO + (size_t)layer * 2 * MiB + ((size_t)pm * BM * 1024 + h * 256) * 2; u.B = (const char*)ws + WS_KV + (size_t)layer * 8 * MiB + ((size_t)gb * 256 * 2048 + 1024 + h * 256) * 2;
        u.C = (char*)ws + WS_WVO + ((size_t)(layer * 8 + gb) * 1024 * 1024 + (size_t)pm * BM * 1024 + h * 256) * 2; u.X = nullptr; u.pm = pm; u.pn = 0; return true; } };
struct SchedScores8 { const char* A; const char* Bl; char* C; int G, c;
    __device__ __forceinline__ bool next(int i, GUnit& u) const { int pm, pn; if (!static_unit(i, G, c, NT / BM, 4, pm, pn)) return false; const int gb = panel_gb(pm);
        u.A = A + (size_t)pm * BM * 1024; u.B = Bl + ((size_t)gb * 1024 + pn * BM) * 1024; u.C = C + ((size_t)pm * BM * 1024 + pn * BM) * 2; u.X = nullptr; u.pm = pm; u.pn = pn; return true; } };
struct SchedBatchW { const char* A; const char* Bl; char* C; int G, c;
    __device__ __forceinline__ bool next(int i, GUnit& u) const { int pm, pn; if (!static_unit(i, G, c, NT / BM, 4, pm, pn)) return false; const int gb = panel_gb(pm);
        u.A = A + (size_t)pm * BM * 2048; u.B = Bl + ((size_t)gb * 1024 + pn * BM) * 2048; u.C = C + ((size_t)pm * BM * 1024 + pn * BM) * 2; u.X = nullptr; u.pm = pm; u.pn = pn; return true; } };
struct Args { const float* in[26]; float* out; unsigned char* ws; int ph_lo, ph_hi, flags, pad; };
struct Frame {
    LAS unsigned char* lds; unsigned char* ws; const float* const* in; float* out;
    int tid, lane, wave, G, c;
    bool xok;
};
enum { I_XP = 0, I_XS, I_MEMP, I_MEMS, I_AWIN, I_ALRE, I_ALIM, I_ALDT, I_ABRE, I_ABIM, I_ACRE, I_ACIM, I_AD, I_AWGLU, I_BWQKV, I_BRPB, I_BWO, I_MWQ, I_MWKV, I_MWO, I_EWR, I_EW1, I_EW3, I_EW2, I_LNG, I_LNB };

__device__ __forceinline__ int rowmap(int mode, int n) {
    if (mode == 0) return n;
    if (mode == 1) { const int z = n >> 10, nn = n & 1023; return ((nn >> 7) << 8) + (z << 7) + (nn & 127); }
    return ((n >> 7) << 8) + ((mode == 3) ? 128 : 0) + (n & 127);
}
__device__ __forceinline__ void transpose_item(const float* W, int K, int N, bf16_t* WT, int mode, LAS float* scr, int item, int lane) {
    const int nblk = N / 32, kb = item / nblk, nb = item % nblk, k0 = 64 * kb, n0 = 32 * nb;
#pragma unroll 8
    for (int i = 0; i < 32; ++i) { const int kk = 2 * i + (lane >> 5); scr[kk * 33 + (lane & 31)] = W[(size_t)(k0 + kk) * N + n0 + (lane & 31)]; }
    LDS_WAIT(); asm volatile("" ::: "memory");
    const int c = lane & 7;
#pragma unroll
    for (int j = 0; j < 4; ++j) { const int n = (lane >> 3) + 8 * j; const LAS float* s = scr + (8 * c) * 33 + n;
        u32x4 o; o.x = cvt_pk_bf16(s[0 * 33], s[1 * 33]); o.y = cvt_pk_bf16(s[2 * 33], s[3 * 33]); o.z = cvt_pk_bf16(s[4 * 33], s[5 * 33]); o.w = cvt_pk_bf16(s[6 * 33], s[7 * 33]);
        *(u32x4*)(WT + (size_t)rowmap(mode, n0 + n) * K + k0 + 8 * c) = o; }
    LDS_WAIT(); asm volatile("" ::: "memory");
}
__device__ __forceinline__ void t8_load(f32x4 (&v)[16], const float* W, int N, int item, int lane) {
    const int nblk = N / 32, kb = item / nblk, nb = item % nblk, k0 = 128 * kb, n0 = 32 * nb, q = lane >> 3, c = lane & 7;
#pragma unroll
    for (int i = 0; i < 16; ++i) v[i] = *(const f32x4*)(W + (size_t)(k0 + 16 * q + i) * N + n0 + 4 * c);
}
__device__ __forceinline__ void t8_finish(const f32x4 (&v)[16], int K, int N, unsigned char* WT, int mode, float scale, LAS unsigned char* scr, int item, int lane) {
    const int nblk = N / 32, kb = item / nblk, nb = item % nblk, k0 = 128 * kb, n0 = 32 * nb, q = lane >> 3, c = lane & 7;
#pragma unroll
    for (int j = 0; j < 4; ++j) { u32x4 o;
        o.x = cvt4_fp8(v[0][j] * scale, v[1][j] * scale, v[2][j] * scale, v[3][j] * scale); o.y = cvt4_fp8(v[4][j] * scale, v[5][j] * scale, v[6][j] * scale, v[7][j] * scale);
        o.z = cvt4_fp8(v[8][j] * scale, v[9][j] * scale, v[10][j] * scale, v[11][j] * scale); o.w = cvt4_fp8(v[12][j] * scale, v[13][j] * scale, v[14][j] * scale, v[15][j] * scale);
        *(LAS u32x4*)(scr + (4 * c + j) * 144 + 16 * q) = o; }
    LDS_WAIT(); asm volatile("" ::: "memory");
#pragma unroll
    for (int j = 0; j < 4; ++j) { const int n = (lane >> 3) + 8 * j; const u32x4 o = *(const LAS u32x4*)(scr + n * 144 + 16 * c);
        pst16(WT + (size_t)rowmap(mode, n0 + n) * K + k0 + 16 * c, o); }
    LDS_WAIT(); asm volatile("" ::: "memory");
}
__device__ __forceinline__ void transpose_item8(const float* W, int K, int N, unsigned char* WT, int mode, float scale, LAS unsigned char* scr, int item, int lane) {
    f32x4 v[16]; t8_load(v, W, N, item, lane); t8_finish(v, K, N, WT, mode, scale, scr, item, lane);
}
__device__ __forceinline__ void transpose_item16(const float* W, int K, int N, bf16_t* WT, int mode, LAS unsigned char* scr, int item, int lane) {
    const int nblk = N / 32, kb = item / nblk, nb = item % nblk, k0 = 128 * kb, n0 = 32 * nb, q = lane >> 3, c = lane & 7;
    f32x4 v[16];
#pragma unroll
    for (int i = 0; i < 16; ++i) v[i] = *(const f32x4*)(W + (size_t)(k0 + 16 * q + i) * N + n0 + 4 * c);
#pragma unroll
    for (int j = 0; j < 4; ++j) { u32x4 o0, o1;
        o0.x = cvt_pk_bf16(v[0][j], v[1][j]); o0.y = cvt_pk_bf16(v[2][j], v[3][j]); o0.z = cvt_pk_bf16(v[4][j], v[5][j]); o0.w = cvt_pk_bf16(v[6][j], v[7][j]);
        o1.x = cvt_pk_bf16(v[8][j], v[9][j]); o1.y = cvt_pk_bf16(v[10][j], v[11][j]); o1.z = cvt_pk_bf16(v[12][j], v[13][j]); o1.w = cvt_pk_bf16(v[14][j], v[15][j]);
        *(LAS u32x4*)(scr + (4 * c + j) * 272 + 32 * q) = o0; *(LAS u32x4*)(scr + (4 * c + j) * 272 + 32 * q + 16) = o1; }
    LDS_WAIT(); asm volatile("" ::: "memory");
#pragma unroll
    for (int j = 0; j < 8; ++j) { const int n = (lane >> 4) + 4 * j, ch = lane & 15; const u32x4 o = *(const LAS u32x4*)(scr + n * 272 + 16 * ch);
        *(u32x4*)(WT + (size_t)rowmap(mode, n0 + n) * K + k0 + 8 * ch) = o; }
    LDS_WAIT(); asm volatile("" ::: "memory");
}
__device__ __forceinline__ void convert_small_weights(Frame& F) {
    LAS unsigned char* scr = F.lds + F.wave * 16384;
    const int gw = F.c * 8 + F.wave, NGW = F.G * 8;
    for (int it = gw; it < 3328; it += NGW) {
        int r = it;
        if (r < 256) { transpose_item16(F.in[I_AWIN], 1024, 1024, (bf16_t*)(F.ws + WS_WIN), 0, scr, r, F.lane); continue; } r -= 256;
        if (r < 512) { transpose_item16(F.in[I_AWGLU], 1024, 2048, (bf16_t*)(F.ws + WS_WGLU), 1, scr, r, F.lane); continue; } r -= 512;
        if (r < 768) { transpose_item8(F.in[I_BWQKV], 1024, 3072, F.ws + WS_WQKV, 0, FP8_SWQKV, scr, r, F.lane); continue; } r -= 768;
        if (r < 256) { transpose_item16(F.in[I_BWO], 1024, 1024, (bf16_t*)(F.ws + WS_WO), 0, scr, r, F.lane); continue; } r -= 256;
        if (r < 1024) { const int l = r >> 9; transpose_item16(F.in[I_MWKV] + (size_t)l * 1024 * 2048, 1024, 2048, (bf16_t*)(F.ws + WS_MWKV + (size_t)l * 4 * MiB), 0, scr, r & 511, F.lane); continue; } r -= 1024;
        { const int l = r >> 8; transpose_item16(F.in[I_MWO] + (size_t)l * 1024 * 1024, 1024, 1024, (bf16_t*)(F.ws + WS_MWO + (size_t)l * 2 * MiB), 0, scr, r & 255, F.lane); }
    }
}
__device__ __forceinline__ void convert_expert_weights(Frame& F, int layer, int lo = 0, int hi = 16 * 1536, int wg0 = 0) {
    if (F.G <= wg0) wg0 = 0;
    if (F.c < wg0) return;
    LAS unsigned char* scr = F.lds + F.wave * 16384;
    const int gw = (F.c - wg0) * 8 + F.wave, NGW = (F.G - wg0) * 8;
#define CVX_DECODE(it_) const int _e = (it_) / 1536; int _r = (it_) % 1536; const size_t _wofs = ((size_t)layer * 16 + _e) * 1024 * 2048; \
        const int _w = _r >> 9; _r &= 511; const float* _W = (_w == 0 ? F.in[I_EW1] : (_w == 1 ? F.in[I_EW3] : F.in[I_EW2])) + _wofs; const int _N = _w == 2 ? 1024 : 2048, _K = _w == 2 ? 2048 : 1024;
#define CVX_LOAD(v_, it_) do { CVX_DECODE(it_); (void)_K; t8_load(v_, _W, _N, _r, F.lane); } while (0)
#define CVX_FINISH(v_, it_) do { CVX_DECODE(it_); unsigned char* _WT = _w == 2 ? F.ws + WS_EW2 + (size_t)_e * 2 * MiB : F.ws + WS_EW13 + (size_t)_e * 4 * MiB; \
        t8_finish(v_, _K, _N, _WT, _w == 0 ? 2 : (_w == 1 ? 3 : 0), _w == 2 ? FP8_SW2 : FP8_SW13, scr, _r, F.lane); } while (0)
    f32x4 va[16], vb[16];
    int it = lo + gw;
    if (it < hi) CVX_LOAD(va, it);
    while (it < hi) {
        const int it1 = it + NGW, it2 = it1 + NGW;
        if (it1 < hi) CVX_LOAD(vb, it1);
        CVX_FINISH(va, it);
        if (it1 < hi) { if (it2 < hi) CVX_LOAD(va, it2); CVX_FINISH(vb, it1); }
        it = it2;
    }
#undef CVX_DECODE
#undef CVX_LOAD
#undef CVX_FINISH
}
__device__ __forceinline__ void convert_plain(Frame& F, const float* src, bf16_t* dst, size_t n) {
    const size_t n4 = n / 4;
    for (size_t i = (size_t)F.c * 512 + F.tid; i < n4; i += (size_t)F.G * 512) { const f32x4 v = ((const f32x4*)src)[i]; u32x2 w; w.x = cvt_pk_bf16(v[0], v[1]); w.y = cvt_pk_bf16(v[2], v[3]); ((u32x2*)dst)[i] = w; }
}
__device__ __forceinline__ void import_x(Frame& F, bool copy_f32) {
    const size_t n4 = (size_t)NT * D / 4, np4 = (size_t)NTP * D / 4, st = (size_t)F.G * 512;
    f32x4* XF = (f32x4*)(F.ws + WS_XF); u32x2* XB = (u32x2*)(F.ws + WS_XB);
    for (size_t i0 = (size_t)F.c * 512 + F.tid; i0 < n4; i0 += st * 8) {
        f32x4 v[8];
#pragma unroll
        for (int u = 0; u < 8; ++u) { const size_t i = i0 + st * u;
            if (i < n4) { if (copy_f32) { v[u] = (i < np4) ? ((const f32x4*)F.in[I_XP])[i] : ((const f32x4*)F.in[I_XS])[i - np4]; } else v[u] = XF[i]; } }
#pragma unroll
        for (int u = 0; u < 8; ++u) { const size_t i = i0 + st * u;
            if (i < n4) { u32x2 w; w.x = cvt_pk_bf16(v[u][0], v[u][1]); w.y = cvt_pk_bf16(v[u][2], v[u][3]); XB[i] = w; } }
    }
}

__device__ __forceinline__ void s5_lam(const float* lre, const float* lim, const float* ldt, int dir, int g, int p, double& dt, double& lr, double& li) {
    dt = exp((double)ldt[dir * 64 + g]); lr = (double)lre[(dir * 64 + g) * 64 + p]; li = (double)lim[(dir * 64 + g) * 64 + p];
}
__device__ __forceinline__ void s5_fill_bc(Frame& F, int g, int dir, const LAS double* LBd, LAS float* Bbr, LAS float* Bbi, LAS float* Cr, LAS float* Ci) {
    for (int idx = F.tid; idx < 1024; idx += 512) {
        const int p = idx >> 4, h = idx & 15; const double fr = LBd[p * 4 + 2], fi = LBd[p * 4 + 3];
        const double br = F.in[I_ABRE][((dir * 64 + g) * 64 + p) * 16 + h], bi = F.in[I_ABIM][((dir * 64 + g) * 64 + p) * 16 + h];
        Bbr[idx] = (float)(fr * br - fi * bi); Bbi[idx] = (float)(fr * bi + fi * br);
        Cr[idx] = F.in[I_ACRE][(dir * 64 + g) * 1024 + idx]; Ci[idx] = F.in[I_ACIM][(dir * 64 + g) * 1024 + idx];
    }
}
__device__ __forceinline__ void s5_build_item(Frame& F, int g, int dir) {
    LAS float* LPr = (LAS float*)F.lds; LAS float* LPi = LPr + 33 * 64;
    LAS float* Bbr = LPi + 33 * 64; LAS float* Bbi = Bbr + 1024; LAS float* Cr = Bbi + 1024; LAS float* Ci = Cr + 1024;
    LAS float* B2r = Ci + 1024; LAS float* B2i = B2r + 1024; LAS float* C2r = B2i + 1024; LAS float* C2i = C2r + 1024;
    LAS float* KD = C2i + 1024;
    bf16_t* M2T = (bf16_t*)(F.ws + PO_M2T) + (size_t)g * 256 * 512; bf16_t* M13T = (bf16_t*)(F.ws + PO_M13T) + (size_t)g * 512 * UAK;
    LAS double* LB = (LAS double*)(KD + 32 * 256);
    __syncthreads();
    if (F.tid < 128) { const int dd = F.tid >> 6, p = F.tid & 63;
        if (dd == 0 || dir == 0) { double dt, lr, li; s5_lam(F.in[I_ALRE], F.in[I_ALIM], F.in[I_ALDT], dd == 0 ? dir : 1, g, p, dt, lr, li);
            const double er = exp(lr * dt), lbr = er * cos(li * dt), lbi = er * sin(li * dt), nr = lbr - 1.0, ni = lbi, den = lr * lr + li * li;
            LB[(dd * 64 + p) * 4 + 0] = lbr; LB[(dd * 64 + p) * 4 + 1] = lbi; LB[(dd * 64 + p) * 4 + 2] = (nr * lr + ni * li) / den; LB[(dd * 64 + p) * 4 + 3] = (ni * lr - nr * li) / den; } }
    __syncthreads();
    for (int idx = F.tid; idx < 33 * 64; idx += 512) { const int e = idx >> 6, p = idx & 63; double br = LB[p * 4], bi = LB[p * 4 + 1], rr = 1.0, ri = 0.0;
        for (int b = e; b != 0; b >>= 1) { if (b & 1) { const double t = rr * br - ri * bi; ri = rr * bi + ri * br; rr = t; } const double t2 = br * br - bi * bi; bi = 2.0 * br * bi; br = t2; }
        LPr[idx] = (float)rr; LPi[idx] = (float)ri; }
    s5_fill_bc(F, g, dir, LB, Bbr, Bbi, Cr, Ci);
    if (dir == 0) s5_fill_bc(F, g, 1, LB + 256, B2r, B2i, C2r, C2i);
    __syncthreads();
    {
        const int k = F.tid, j = k >> 4, h = k & 15, e = dir == 0 ? (TCH - 1 - j) : j;
        for (int p = 0; p < 64; ++p) { const float lr = LPr[e * 64 + p], li = LPi[e * 64 + p], br = Bbr[p * 16 + h], bi = Bbi[p * 16 + h];
            const float xr = lr * br - li * bi, xi = lr * bi + li * br;
            M2T[(size_t)(dir * 128 + p) * 512 + k] = (bf16_t)(cvt_pk_bf16(xr, 0.f) & 0xffffu); M2T[(size_t)(dir * 128 + 64 + p) * 512 + k] = (bf16_t)(cvt_pk_bf16(xi, 0.f) & 0xffffu); }
    }
    {
        const int p = F.tid & 63, q8 = F.tid >> 6;
        for (int ic = q8; ic < 512; ic += 8) { const int i = ic >> 4, c = ic & 15, e = dir == 0 ? (i + 1) : (TCH - i);
            const float cr = Cr[c * 64 + p], ci = Ci[c * 64 + p], lr = LPr[e * 64 + p], li = LPi[e * 64 + p];
            const float vr = cr * lr - ci * li, vi = cr * li + ci * lr;
            M13T[(size_t)ic * UAK + 512 + dir * 128 + p] = (bf16_t)(cvt_pk_bf16(vr, 0.f) & 0xffffu); M13T[(size_t)ic * UAK + 512 + dir * 128 + 64 + p] = (bf16_t)(cvt_pk_bf16(-vi, 0.f) & 0xffffu); }
    }
    {
        const int ch = F.tid & 255, c = ch >> 4, h = ch & 15, par = F.tid >> 8;
        if (dir == 0 && par == 0) {
            float s = (c == h) ? F.in[I_AD][g * 16 + c] : 0.f;
            for (int p = 0; p < 64; ++p) s += Cr[c * 64 + p] * Bbr[p * 16 + h] - Ci[c * 64 + p] * Bbi[p * 16 + h] + C2r[c * 64 + p] * B2r[p * 16 + h] - C2i[c * 64 + p] * B2i[p * 16 + h];
            KD[ch] = s;
        }
#pragma nounroll
        for (int hp = 0; hp < 64; hp += 32) {
            float cbr[32], cbi[32];
#pragma unroll
            for (int p = 0; p < 32; ++p) { const float cr = Cr[c * 64 + hp + p], ci = Ci[c * 64 + hp + p], br = Bbr[(hp + p) * 16 + h], bi = Bbi[(hp + p) * 16 + h]; cbr[p] = cr * br - ci * bi; cbi[p] = cr * bi + ci * br; }
#pragma nounroll
            for (int d = 1 + par; d < TCH; d += 2) {
                float s0 = 0.f, s1 = 0.f;
#pragma unroll
                for (int p = 0; p < 32; p += 4) { const f32x4 lr = *(const LAS f32x4*)(LPr + d * 64 + hp + p), li = *(const LAS f32x4*)(LPi + d * 64 + hp + p);
                    s0 += cbr[p] * lr[0]; s1 -= cbi[p] * li[0]; s0 += cbr[p + 1] * lr[1]; s1 -= cbi[p + 1] * li[1]; s0 += cbr[p + 2] * lr[2]; s1 -= cbi[p + 2] * li[2]; s0 += cbr[p + 3] * lr[3]; s1 -= cbi[p + 3] * li[3]; }
                if (hp == 0) KD[d * 256 + ch] = s0 + s1; else KD[d * 256 + ch] += s0 + s1;
            }
        }
        __syncthreads();
        for (int idx = F.tid; idx < 512 * 64; idx += 512) { const int hf = idx & 1, j = (idx >> 1) & 31, ic = idx >> 6, i = ic >> 4, cc = ic & 15;
            const bool mine = dir == 0 ? (j <= i) : (j > i);
            if (mine) { const int d = dir == 0 ? (i - j) : (j - i); const f32x4 v0 = *(const LAS f32x4*)(KD + d * 256 + cc * 16 + hf * 8), v1 = *(const LAS f32x4*)(KD + d * 256 + cc * 16 + hf * 8 + 4);
                u32x4 v; v.x = cvt_pk_bf16(v0[0], v0[1]); v.y = cvt_pk_bf16(v0[2], v0[3]); v.z = cvt_pk_bf16(v1[0], v1[1]); v.w = cvt_pk_bf16(v1[2], v1[3]); *(u32x4*)(M13T + (size_t)ic * UAK + j * 16 + hf * 8) = v; } }
    }
    __syncthreads();
}

__device__ __forceinline__ void s5_recurrence(Frame& F) {
    const float* S = (const float*)(F.ws + PO_SG); bf16_t* UA = (bf16_t*)(F.ws + PO_UA);
    for (int base = F.c * 256; base < 65536; base += F.G * 256) {
        if (F.tid >= 256) continue;
        const int flat = base + F.tid, p = flat & 63, dir = (flat >> 6) & 1, g = (flat >> 7) & 63, gb = flat >> 13;
        double dt, lr, li; s5_lam(F.in[I_ALRE], F.in[I_ALIM], F.in[I_ALDT], dir, g, p, dt, lr, li);
        const double er = exp(lr * dt * TCH); const float ar = (float)(er * cos(li * dt * TCH)), ai = (float)(er * sin(li * dt * TCH));
        const int nc = gb < 4 ? 256 : 128, chunk0 = gb < 4 ? gb * 256 : 1024 + (gb - 4) * 128;
        float hr = 0.f, hi = 0.f;
        for (int s0 = 0; s0 < nc; s0 += 8) {
            float sr[8], si[8];
#pragma unroll
            for (int k = 0; k < 8; ++k) { const int cc = dir == 0 ? (s0 + k) : (nc - 1 - s0 - k); const size_t o = ((size_t)g * NCHUNK + (chunk0 + cc)) * 256 + dir * 128 + p; sr[k] = S[o]; si[k] = S[o + 64]; }
#pragma unroll
            for (int k = 0; k < 8; ++k) { const int cc = dir == 0 ? (s0 + k) : (nc - 1 - s0 - k); const size_t o = ((size_t)g * NCHUNK + (chunk0 + cc)) * UAK + 512 + dir * 128 + p;
                UA[o] = (bf16_t)(cvt_pk_bf16(hr, 0.f) & 0xffffu); UA[o + 64] = (bf16_t)(cvt_pk_bf16(hi, 0.f) & 0xffffu);
                const float nr = ar * hr - ai * hi + sr[k], ni = ar * hi + ai * hr + si[k]; hr = nr; hi = ni; }
        }
    }
}

__device__ __forceinline__ void add_bf16x4(f32x4& v, const u32x2 w) { v[0] += __uint_as_float(w.x << 16); v[1] += __uint_as_float(w.x & 0xffff0000u); v[2] += __uint_as_float(w.y << 16); v[3] += __uint_as_float(w.y & 0xffff0000u); }
constexpr int WRS = 1028;
__device__ __forceinline__ void ln_router_fill(Frame& F, const float* gam, const float* bet, const float* wrouter) {
    LAS float* wrT = (LAS float*)F.lds; LAS float* gsh = wrT + 16 * WRS; LAS float* bsh = gsh + 1024;
    __syncthreads();
    for (int i = F.tid; i < 16384; i += 512) { const int k = i >> 4, e = i & 15; wrT[e * WRS + k] = wrouter[i]; }
    for (int i = F.tid; i < 1024; i += 512) { gsh[i] = gam[i]; bsh[i] = bet[i]; }
    __syncthreads();
}
#ifndef RES_BF16
#define RES_BF16 1
#endif
template <int MODE, bool ROUTER, bool FINAL, bool SRCIN = false>
__device__ __forceinline__ void ln_phase(Frame& F, const bf16_t* HB, const float* gam, const float* bet, const float* wrouter) {
    float* XF = (float*)(F.ws + WS_XF);
    LAS float* wrT = (LAS float*)F.lds;
    LAS float* gsh = wrT + 16 * WRS; LAS float* bsh = gsh + 1024;
    f32x4 gv[4], bv[4];
    if (!ROUTER) {
#pragma unroll
        for (int j = 0; j < 4; ++j) { gv[j] = *(const f32x4*)(gam + F.lane * 4 + 256 * j); bv[j] = *(const f32x4*)(bet + F.lane * 4 + 256 * j); } }
    const unsigned char* wsb = F.ws; int ln = F.lane; unsigned lb4 = (unsigned)ln * 16u, lb2 = (unsigned)ln * 8u, lb1 = (unsigned)ln * 4u;
    const unsigned hb_off = (unsigned)((const unsigned char*)HB - wsb);
    const int nq = F.xok ? 6 : (NT / 4 + F.G * 8 - 1) / (F.G * 8);
    constexpr bool X32 = SRCIN || !RES_BF16;
    f32x4 xr32[4][4]; u32x2 xr16[4][4], hwr[4][4];
#define LN_ISSUE(row0_) do { const int _r0 = (row0_); \
        const unsigned char* xbase = SRCIN ? (_r0 < NTP ? (const unsigned char*)F.in[I_XP] : (const unsigned char*)F.in[I_XS] - (size_t)NTP * 4096) : wsb + WS_XF;      \
        if (X32) { _Pragma("unroll") for (int r = 0; r < 4; ++r) { const unsigned ro = (unsigned)(_r0 + r) * 4096u + lb4; _Pragma("unroll") for (int j = 0; j < 4; ++j) xr32[r][j] = *(const f32x4*)(xbase + ro + 1024u * j); } } \
        else { _Pragma("unroll") for (int r = 0; r < 4; ++r) { const unsigned ro = (unsigned)(_r0 + r) * 2048u + lb2; _Pragma("unroll") for (int j = 0; j < 4; ++j) xr16[r][j] = *(const u32x2*)(xbase + ro + 512u * j); } } \
        if (MODE == 0) { _Pragma("unroll") for (int r = 0; r < 4; ++r) { const unsigned ro = hb_off + (unsigned)(_r0 + r) * 2048u + lb2; _Pragma("unroll") for (int j = 0; j < 4; ++j) hwr[r][j] = *(const u32x2*)(wsb + ro + 512u * j); } } \
    } while (0)
#define LN_Q(qi_) (F.xok ? ((F.c & 7) * 1536 + (F.c >> 3) * 48 + F.wave * 6 + (qi_)) : (F.c * 8 + F.wave + (qi_) * F.G * 8))
    u32x4 sln = {~0u, ~0u, ~0u, ~0u};
    if (MODE == 1) { const int q0 = LN_Q(0); if (nq > 0 && q0 < NT / 4 && F.lane < 16) sln = *(const u32x4*)(wsb + (unsigned)(WS_SLOT + ((size_t)F.lane * NT + (size_t)q0 * 4) * 4)); }
    { const int q0 = LN_Q(0); if (nq > 0 && q0 < NT / 4) { LN_ISSUE(q0 * 4); } }
    for (int qi = 0; qi < nq; ++qi) {
        const int q = LN_Q(qi);
        if (q >= NT / 4) break;
        const int row0 = q * 4;
        const u32x4 slc = sln;
        if (MODE == 1) { const int qn = LN_Q(qi + 1); if (qi + 1 < nq && qn < NT / 4 && ln < 16) sln = *(const u32x4*)(wsb + (unsigned)(WS_SLOT + ((size_t)ln * NT + (size_t)qn * 4) * 4)); }
        asm volatile("v_mbcnt_lo_u32_b32 %0, -1, 0\n\tv_mbcnt_hi_u32_b32 %0, -1, %0" : "=v"(ln));
        lb4 = (unsigned)ln * 16u; lb2 = (unsigned)ln * 8u; lb1 = (unsigned)ln * 4u; const int lw = ln * 4;
        f32x4 v[4][4];
#pragma unroll
        for (int r = 0; r < 4; ++r)
#pragma unroll
            for (int j = 0; j < 4; ++j) {
                if (X32) v[r][j] = xr32[r][j];
                else { v[r][j][0] = __uint_as_float(xr16[r][j].x << 16); v[r][j][1] = __uint_as_float(xr16[r][j].x & 0xffff0000u); v[r][j][2] = __uint_as_float(xr16[r][j].y << 16); v[r][j][3] = __uint_as_float(xr16[r][j].y & 0xffff0000u); } }
        if (MODE == 0) {
#pragma unroll
            for (int r = 0; r < 4; ++r)
#pragma unroll
                for (int j = 0; j < 4; ++j) { v[r][j] = v[r][j] * ALPHA; add_bf16x4(v[r][j], hwr[r][j]); }
        }
        if (!ROUTER) { const int qn = LN_Q(qi + 1); if (qi + 1 < nq && qn < NT / 4) { LN_ISSUE(qn * 4); } }
        if (MODE == 0) {
        } else {
            const int grp = row0 >= NTP; int sl[4];
#pragma unroll
            for (int r = 0; r < 4; ++r) sl[r] = (ln < 16) ? (int)slc[r] : -1;
            unsigned long long mask[4]; bool any[4], two[4]; u32x2 wa[4][4], wb[4][4];
#pragma unroll
            for (int r = 0; r < 4; ++r) {
                unsigned long long mk = __ballot(sl[r] >= 0); any[r] = mk != 0ull;
                int e0 = 0, s0 = 0; if (any[r]) { e0 = __builtin_ctzll(mk); mk &= mk - 1; s0 = __builtin_amdgcn_readlane(sl[r], e0); }
                const unsigned y0 = any[r] ? (grp ? 65536u + e0 * 2048u + s0 : e0 * 4096u + s0) : 0u;
                two[r] = mk != 0ull; int e1 = 0, s1 = 0; if (two[r]) { e1 = __builtin_ctzll(mk); mk &= mk - 1; s1 = __builtin_amdgcn_readlane(sl[r], e1); }
                const unsigned y1 = two[r] ? (grp ? 65536u + e1 * 2048u + s1 : e1 * 4096u + s1) : y0;
                mask[r] = mk;
                const unsigned char* ya = wsb + PO_YE + (size_t)y0 * 2048; const unsigned char* yb = wsb + PO_YE + (size_t)y1 * 2048;
#pragma unroll
                for (int j = 0; j < 4; ++j) { wa[r][j] = *(const u32x2*)(ya + lb2 + 512u * j); wb[r][j] = *(const u32x2*)(yb + lb2 + 512u * j); }
            }
#pragma unroll
            for (int r = 0; r < 4; ++r) {
#pragma unroll
                for (int j = 0; j < 4; ++j) { v[r][j] = v[r][j] * ALPHA; if (any[r]) add_bf16x4(v[r][j], wa[r][j]); if (two[r]) add_bf16x4(v[r][j], wb[r][j]); }
                unsigned long long mk = mask[r];
                while (mk) {
                    const int e0 = __builtin_ctzll(mk); mk &= mk - 1; const int s0 = __builtin_amdgcn_readlane(sl[r], e0);
                    const unsigned y0 = grp ? 65536u + e0 * 2048u + s0 : e0 * 4096u + s0;
                    const bool tw = mk != 0ull; int e1 = 0, s1 = 0; if (tw) { e1 = __builtin_ctzll(mk); mk &= mk - 1; s1 = __builtin_amdgcn_readlane(sl[r], e1); }
                    const unsigned y1 = tw ? (grp ? 65536u + e1 * 2048u + s1 : e1 * 4096u + s1) : y0;
                    const unsigned char* ya = wsb + PO_YE + (size_t)y0 * 2048; const unsigned char* yb = wsb + PO_YE + (size_t)y1 * 2048;
                    u32x2 xa[4], xb[4];
#pragma unroll
                    for (int j = 0; j < 4; ++j) { xa[j] = *(const u32x2*)(ya + lb2 + 512u * j); xb[j] = *(const u32x2*)(yb + lb2 + 512u * j); }
#pragma unroll
                    for (int j = 0; j < 4; ++j) { add_bf16x4(v[r][j], xa[j]); if (tw) add_bf16x4(v[r][j], xb[j]); }
                }
            }
        }
#pragma unroll
        for (int r = 0; r < 4; ++r) {
            float s = 0.f;
#pragma unroll
            for (int j = 0; j < 4; ++j) s += (v[r][j][0] + v[r][j][1]) + (v[r][j][2] + v[r][j][3]);
            const float mean = wave_sum(s) * (1.f / D); float qq = 0.f;
#pragma unroll
            for (int j = 0; j < 4; ++j) { v[r][j] = v[r][j] - mean; qq += (v[r][j][0] * v[r][j][0] + v[r][j][1] * v[r][j][1]) + (v[r][j][2] * v[r][j][2] + v[r][j][3] * v[r][j][3]); }
            const float rstd = 1.f / sqrtf(wave_sum(qq) * (1.f / D) + LN_EPS);
#pragma unroll
            for (int j = 0; j < 4; ++j) { if (ROUTER) { gv[j] = *(const LAS f32x4*)(gsh + lw + 256 * j); bv[j] = *(const LAS f32x4*)(bsh + lw + 256 * j); } v[r][j] = v[r][j] * rstd * gv[j] + bv[j]; }
            const unsigned row = (unsigned)(row0 + r);
            if (FINAL) {
                unsigned char* ob = (unsigned char*)F.out;
#pragma unroll
                for (int j = 0; j < 4; ++j) *(f32x4*)(ob + (size_t)(row * 4096u + lb4 + 1024u * j)) = v[r][j];
            } else {
                unsigned char* wsw = F.ws;
#pragma unroll
                for (int j = 0; j < 4; ++j) {
                    if (RES_BF16) { u32x2 xo; xo.x = cvt_pk_bf16_c(v[r][j][0], v[r][j][1]); xo.y = cvt_pk_bf16_c(v[r][j][2], v[r][j][3]); *(u32x2*)(wsw + (unsigned)(WS_XF + row * 2048u + lb2 + 512u * j)) = xo; }
                    else *(f32x4*)(wsw + (unsigned)(WS_XF + row * 4096u + lb4 + 1024u * j)) = v[r][j];
                    *(unsigned*)(wsw + (unsigned)(WS_XB8 + row * 1024u + lb1 + 256u * j)) = cvt4_fp8(v[r][j][0] * FP8_SX, v[r][j][1] * FP8_SX, v[r][j][2] * FP8_SX, v[r][j][3] * FP8_SX); }
            }
        }
        if (ROUTER) {
            { const int qn = LN_Q(qi + 1); if (qi + 1 < nq && qn < NT / 4) { LN_ISSUE(qn * 4); } }
            float val[64];
#pragma unroll
            for (int hf = 0; hf < 4; ++hf) {
                f32x2 a2[4][4];
#pragma unroll
                for (int r = 0; r < 4; ++r)
#pragma unroll
                    for (int e4 = 0; e4 < 4; ++e4) a2[r][e4] = f32x2{0.f, 0.f};
#pragma unroll
                for (int e4 = 0; e4 < 4; ++e4)
#pragma unroll
                    for (int j = 0; j < 4; ++j) { const f32x4 w = *(const LAS f32x4*)(wrT + (hf * 4 + e4) * WRS + lw + 256 * j);
                        const f32x2 wl = f32x2{w[0], w[1]}, wh = f32x2{w[2], w[3]};
#pragma unroll
                        for (int r = 0; r < 4; ++r) { a2[r][e4] = f32x2{v[r][j][0], v[r][j][1]} * wl + a2[r][e4]; a2[r][e4] = f32x2{v[r][j][2], v[r][j][3]} * wh + a2[r][e4]; } }
#pragma unroll
                for (int r = 0; r < 4; ++r)
#pragma unroll
                    for (int e4 = 0; e4 < 4; ++e4) val[r * 16 + hf * 4 + e4] = a2[r][e4][0] + a2[r][e4][1];
            }
#pragma unroll
            for (int sft = 5; sft >= 0; --sft) { const int n2 = 1 << sft; const bool up = (ln >> sft) & 1;
#pragma unroll
                for (int i = 0; i < n2; ++i) { const float lo = val[i], hi = val[i + n2]; const float mine = up ? hi : lo, other = up ? lo : hi; val[i] = mine + __shfl_xor(other, n2); } }
            const float lg = val[0], m = row_max(lg);
            const float ex = expf(lg - m); const float l = row_sum(ex);
            *(float*)(F.ws + (unsigned)(WS_AFF + ((size_t)(ln & 15) * NT + row0 + (ln >> 4)) * 4)) = ex / l;
        }
    }
#undef LN_Q
#undef LN_ISSUE
    if (ROUTER) __syncthreads();
}
__device__ __forceinline__ void softmax_phase(Frame& F, bf16_t* SB) {
    for (int row = F.c * 8 + F.wave; row < NT * 4; row += F.G * 8) {
        u32x2* p = (u32x2*)(SB + (size_t)row * 256) + F.lane; const u32x2 w = *p;
        float a = __uint_as_float(w.x << 16), b = __uint_as_float(w.x & 0xffff0000u), c = __uint_as_float(w.y << 16), d = __uint_as_float(w.y & 0xffff0000u);
        const float m = wave_max(fmaxf(fmaxf(a, b), fmaxf(c, d)));
        a = __expf(a - m); b = __expf(b - m); c = __expf(c - m); d = __expf(d - m);
        const float inv = 1.f / wave_sum((a + b) + (c + d));
        u32x2 o; o.x = cvt_pk_bf16(a * inv, b * inv); o.y = cvt_pk_bf16(c * inv, d * inv); *p = o;
    }
}
__device__ __forceinline__ void moe_panel(int P, int& e, int& grp, int& yerow0) {
    if (P < 256) { e = P >> 4; grp = 0; } else { e = (P - 256) >> 3; grp = 1; }
    yerow0 = P * 256;
}
#ifndef UPWGM
#define UPWGM 8
#endif
struct SchedUp { unsigned char* ws; int G, c;
    __device__ __forceinline__ bool next(int i, GUnit& u) const { int P, pn; if (!static_unit<UPWGM>(i, G, c, 384, 16, P, pn)) return false; int e, grp, y0; moe_panel(P, e, grp, y0);
        u.A = (const char*)ws + WS_XB8 + (grp ? (size_t)NTP * 1024 : 0); u.B = (const char*)ws + WS_EW13 + ((size_t)e * 4096 + pn * BM) * 1024;
        u.C = (char*)ws + PO_HM + ((size_t)P * BM * 2048 + pn * HALF); u.X = (const int*)(ws + WS_IDX) + y0; u.pm = P; u.pn = pn; return true; } };
struct SchedDown { unsigned char* ws; int G, c;
    __device__ __forceinline__ bool next(int i, GUnit& u) const { int P, pn; if (!static_unit(i, G, c, 384, 4, P, pn)) return false; int e, grp, y0; moe_panel(P, e, grp, y0);
        u.A = (const char*)ws + PO_HM + (size_t)P * BM * 2048; u.B = (const char*)ws + WS_EW2 + ((size_t)e * 1024 + pn * BM) * 2048;
        u.C = (char*)ws + PO_YE + ((size_t)y0 * 1024 + pn * BM) * 2; u.X = (const float*)(ws + WS_GATE) + y0; u.pm = P; u.pn = pn; return true; } };
struct SchedQKV { unsigned char* ws; int G, c;
    __device__ __forceinline__ bool next(int i, GUnit& u) const { const int L = i * G + c; if (L >= 1536 + 768) return false;
        if (L < 1536) { int pm, pn; static_unit(i, G, c, 192, 8, pm, pn);
            u.A = (const char*)ws + WS_XB8 + (size_t)pm * BM * 1024; u.B = (const char*)ws + WS_WQKV + (size_t)pn * BM * 1024;
            u.C = (char*)ws + (pn < 4 ? PO_Q : PO_K) + ((size_t)pm * BM * 1024 + (pn & 3) * BM) * 2; u.X = nullptr; u.pm = pm; u.pn = pn; return true; }
        const int r = L - 1536, pmv = r & 3, pnv = r >> 2;
        u.A = (const char*)ws + WS_WQKV + (size_t)(2048 + pmv * BM) * 1024; u.B = (const char*)ws + WS_XB8 + (size_t)pnv * BM * 1024;
        u.C = (char*)ws + PO_VT + ((size_t)pmv * BM * NT + (size_t)pnv * BM) * 2; u.X = nullptr; u.pm = pmv; u.pn = 8 + pnv; return true; } };
struct EpiQKV {
    static constexpr bool PERM = true;
    __device__ __forceinline__ void operator()(const Acc& acc, const GUnit& u, int wr, int wc, int fr, int fq) const {
        constexpr float ds = 1.f / (FP8_SX * FP8_SWQKV);
        if (u.pn >= 8) { EpiBf<false> e{(unsigned)NT, ds}; e(acc, u, wr, wc, fr, fq); }
        else { EpiBf<false> e{1024u, u.pn < 4 ? 0.125f * 1.4426950408889634f * ds : ds}; e(acc, u, wr, wc, fr, fq); }
    }
};

__device__ __forceinline__ int wave_sum_i(int v) {
#pragma unroll
    for (int o = 1; o < 64; o <<= 1) v += __shfl_xor(v, o);
    return v;
}
__device__ __forceinline__ int block_excl_scan(int v, int lane, int wave, LAS int* red, int& total) {
    int inc = v;
#pragma unroll
    for (int o = 1; o < 64; o <<= 1) { const int t = __shfl_up(inc, o); if (lane >= o) inc += t; }
    __syncthreads();
    if (lane == 63) red[wave] = inc;
    __syncthreads();
    int off = 0, tot = 0;
#pragma unroll
    for (int w = 0; w < 8; ++w) { const int c = red[w]; if (w < wave) off += c; tot += c; }
    total = tot; return off + inc - v;
}
template <int PER>
__device__ __forceinline__ void select_fast(Frame& F, const float* affcol, int cap, int* idx_out, float* gate_out, int* slotcol) {
    LAS int* red = (LAS int*)F.lds;
    unsigned key[PER];
#pragma unroll
    for (int i = 0; i < PER / 4; ++i) { const u32x4 v = ((const u32x4*)(affcol + (size_t)F.tid * PER))[i]; key[4 * i] = v.x; key[4 * i + 1] = v.y; key[4 * i + 2] = v.z; key[4 * i + 3] = v.w; }
    unsigned T = 0u;
    for (int b = 30; b >= 0; --b) {
        const unsigned cand = T | (1u << b); int cnt = 0;
#pragma unroll
        for (int i = 0; i < PER; ++i) cnt += (key[i] >= cand) ? 1 : 0;
        cnt = wave_sum_i(cnt);
        LAS int* r = red + (b & 1) * 8;
        if (F.lane == 0) r[F.wave] = cnt;
        __syncthreads();
        int tot = 0;
#pragma unroll
        for (int w = 0; w < 8; ++w) tot += r[w];
        if (tot >= cap) T = cand;
    }
    int g = 0, q = 0;
#pragma unroll
    for (int i = 0; i < PER; ++i) { g += (key[i] > T) ? 1 : 0; q += (key[i] == T) ? 1 : 0; }
    int tot_g, tot_q; (void)tot_q;
    const int Eoff = block_excl_scan(q, F.lane, F.wave, red + 32, tot_q);
    int dummy; const int Goff = block_excl_scan(g, F.lane, F.wave, red + 32, tot_g); (void)Goff;
    const int need_eq = cap - tot_g;
    int eq_take = need_eq - Eoff; eq_take = eq_take < 0 ? 0 : (eq_take > q ? q : eq_take);
    const int base = block_excl_scan(g + eq_take, F.lane, F.wave, red + 32, dummy);
    int slot = base, eqseen = 0;
    const int tok0 = F.tid * PER;
#pragma unroll
    for (int i4 = 0; i4 < PER / 4; ++i4) { int so[4];
#pragma unroll
        for (int j = 0; j < 4; ++j) { const int i = 4 * i4 + j; const unsigned k = key[i]; bool sel = k > T; if (k == T) { sel = eqseen < eq_take; ++eqseen; }
            so[j] = sel ? slot : -1; if (sel) { idx_out[slot] = tok0 + i; gate_out[slot] = __uint_as_float(k); ++slot; } }
        ((int4*)(slotcol + tok0))[i4] = make_int4(so[0], so[1], so[2], so[3]); }
}
__device__ __forceinline__ void select_phase(Frame& F) {
    for (int it = F.c; it < 32; it += F.G) {
        const int grp = it >> 4, e = it & 15; const int n = grp ? NTS : NTP, cap = n / 8;
        const float* affcol = (const float*)(F.ws + WS_AFF) + (size_t)e * NT + (grp ? NTP : 0);
        int* idx = (int*)(F.ws + WS_IDX) + (grp ? 65536 : 0) + e * cap; float* gate = (float*)(F.ws + WS_GATE) + (grp ? 65536 : 0) + e * cap;
        int* slotcol = (int*)(F.ws + WS_SLOT) + (size_t)e * NT + (grp ? NTP : 0);
        __syncthreads();
        if (grp == 0) select_fast<64>(F, affcol, cap, idx, gate, slotcol); else select_fast<32>(F, affcol, cap, idx, gate, slotcol);
        __syncthreads();
    }
}

__device__ __forceinline__ void natten_fill(Frame& F, const float* rpb) {
    LAS float* rpbs = (LAS float*)F.lds;
    __syncthreads();
    for (int i = F.tid; i < 16 * 15 * 31; i += 512) rpbs[i] = rpb[i] * 1.4426950408889634f;
    __syncthreads();
}
__device__ __forceinline__ void natten_phase(Frame& F, const float* rpb) {
    const bf16_t* Kb = (const bf16_t*)(F.ws + PO_K); const bf16_t* VT = (const bf16_t*)(F.ws + PO_VT); bf16_t* QO = (bf16_t*)(F.ws + PO_Q);
    LAS float* rpbs = (LAS float*)F.lds;
    const int lane = F.lane, w = F.wave, fr = lane & 15, fq = lane >> 4;
    bool c0[4], c2[4]; int xe[4];
#pragma unroll
    for (int e = 0; e < 4; ++e) { xe[e] = 4 * fq + e - fr; c0[e] = xe[e] >= 8; c2[e] = xe[e] < -8; }
    const bool fA = fr < 8, fC = fr > 8;
    LAS bf16_t* Ks = (LAS bf16_t*)(F.lds + 32768); LAS bf16_t* Vs = Ks + 2 * 64 * 72;
    const int lrow = F.tid >> 3, lchk = F.tid & 7;
    for (int blk = F.c; blk < 1536; blk += F.G) {
        int gb, h, rb, rows;
        if (blk < 1024) { gb = blk >> 8; h = (blk >> 4) & 15; rb = blk & 15; rows = 128; } else { const int V = blk - 1024; gb = 4 + (V >> 7); h = (V >> 3) & 15; rb = V & 7; rows = 64; }
        const int r = rb * 8 + w;
        int rs = r - 4; rs = rs < 0 ? 0 : (rs > rows - 8 ? rows - 8 : rs);
        int kr_lo = rb * 8 - 4; kr_lo = kr_lo < 0 ? 0 : (kr_lo > rows - 8 ? rows - 8 : kr_lo);
        int kr_hi = rb * 8 + 7 - 4; kr_hi = (kr_hi < 0 ? 0 : (kr_hi > rows - 8 ? rows - 8 : kr_hi)) + 8;
        const size_t tb = (size_t)gb_tok0(gb), tq0 = tb + (size_t)r * 64;
        bf16x8 Qf[4][2];
        float mrun[4], lrun[4]; f32x4 Ot[4][4];
#pragma unroll
        for (int qt = 0; qt < 4; ++qt) { mrun[qt] = -INFINITY; lrun[qt] = 0.f;
#pragma unroll
            for (int dt = 0; dt < 4; ++dt) Ot[dt][qt] = (f32x4){0.f, 0.f, 0.f, 0.f}; }
        const bf16_t* kg = Kb + (tb + (size_t)kr_lo * 64 + lrow) * D + h * 64 + lchk * 8; const bf16_t* vg = VT + (size_t)(h * 64 + lrow) * NT + tb + (size_t)kr_lo * 64 + lchk * 8;
        const int nrows = kr_hi - kr_lo;
#define NA_LOAD(dst, ptr) asm volatile("global_load_dwordx4 %0, %1, off" : "=&v"(dst) : "v"(ptr) : "memory")
        u32x4 kA, vA, kB, vB;
        { const u32x4 k0r = *(const u32x4*)kg, v0r = *(const u32x4*)vg;
#pragma unroll
          for (int t = 0; t < 4; ++t)
#pragma unroll
              for (int ks = 0; ks < 2; ++ks) Qf[t][ks] = *(const bf16x8*)(QO + (tq0 + 16 * t + fr) * D + h * 64 + 32 * ks + 8 * fq);
          { const bf16_t* kp = kg + (size_t)64 * D; const bf16_t* vp = vg + 64; NA_LOAD(kB, kp); NA_LOAD(vB, vp); }
          __syncthreads();
          *(LAS u32x4*)(Ks + lrow * 72 + lchk * 8) = k0r; *(LAS u32x4*)(Vs + lrow * 72 + lchk * 8) = v0r; }
#pragma unroll
        for (int t = 0; t < 4; ++t)
#pragma unroll
            for (int ks = 0; ks < 2; ++ks) asm volatile("" :: "v"(Qf[t][ks]));
        asm volatile("s_waitcnt vmcnt(0)" ::: "memory");
        __syncthreads();
#pragma nounroll
        for (int i2 = 0; i2 < nrows; i2 += 2) {
#pragma unroll
          for (int jj = 0; jj < 2; ++jj) {
            const int i = i2 + jj; if (i >= nrows) break;
            const int kr = kr_lo + i; const int buf = jj; const bool more = i + 1 < nrows, more2 = i + 2 < nrows;
            if (more2) { const bf16_t* kp = kg + (size_t)(i + 2) * 64 * D; const bf16_t* vp = vg + (size_t)(i + 2) * 64;
                if (jj == 1) { NA_LOAD(kB, kp); NA_LOAD(vB, vp); } else { NA_LOAD(kA, kp); NA_LOAD(vA, vp); } }
            if (kr >= rs && kr < rs + 8) {
            const int dr = kr - r + 7;
            const LAS bf16_t* Kt = Ks + buf * (64 * 72); const LAS bf16_t* Vt = Vs + buf * (64 * 72);
            bf16x8 Kf[4][2];
#pragma unroll
            for (int t = 0; t < 4; ++t)
#pragma unroll
                for (int ks = 0; ks < 2; ++ks) Kf[t][ks] = *(const LAS bf16x8*)(Kt + (16 * t + fr) * 72 + 32 * ks + 8 * fq);
            float bsel[3][4];
#pragma unroll
            for (int e = 0; e < 4; ++e) { const int dcB = xe[e] + 15 + (c0[e] ? -16 : (c2[e] ? 16 : 0)), dcA = fA ? xe[e] + 15 : dcB, dcC = fC ? xe[e] + 15 : dcB;
                bsel[0][e] = rpbs[(h * 15 + dr) * 31 + dcA]; bsel[1][e] = rpbs[(h * 15 + dr) * 31 + dcB]; bsel[2][e] = rpbs[(h * 15 + dr) * 31 + dcC]; }
            bf16x8 Pf[4][2]; float alpha[4]; bool moved = false;
#pragma unroll
            for (int qt = 0; qt < 4; ++qt) {
                f32x4 St[3];
#pragma unroll
                for (int dk = 0; dk < 3; ++dk) { const int kt = qt + dk - 1; St[dk] = (f32x4){0.f, 0.f, 0.f, 0.f};
                    if (kt >= 0 && kt < 4) { St[dk] = __builtin_amdgcn_mfma_f32_16x16x32_bf16(Kf[kt][0], Qf[qt][0], St[dk], 0, 0, 0); St[dk] = __builtin_amdgcn_mfma_f32_16x16x32_bf16(Kf[kt][1], Qf[qt][1], St[dk], 0, 0, 0); } }
                constexpr int dummy = 0; (void)dummy;
                const int cls = qt == 0 ? 0 : (qt == 3 ? 2 : 1);
                float sv[4]; bool u0[4], u2[4]; float mx = -INFINITY;
#pragma unroll
                for (int e = 0; e < 4; ++e) { u0[e] = c0[e] && !(cls == 0 && fA) && !(cls == 2 && fC) && (qt > 0); u2[e] = c2[e] && !(cls == 0 && fA) && !(cls == 2 && fC) && (qt < 3);
                    sv[e] = (u0[e] ? St[0][e] : (u2[e] ? St[2][e] : St[1][e])) + bsel[cls][e]; mx = fmaxf(mx, sv[e]); }
                mx = x32_max(x16_max(mx));
                const float mnew = fmaxf(mrun[qt], mx); alpha[qt] = __builtin_amdgcn_exp2f(mrun[qt] - mnew); moved = moved || (mnew != mrun[qt]); mrun[qt] = mnew;
                float l = 0.f, p[4];
#pragma unroll
                for (int e = 0; e < 4; ++e) { p[e] = __builtin_amdgcn_exp2f(sv[e] - mnew); l += p[e]; }
                l = x32_sum(x16_sum(l)); lrun[qt] = lrun[qt] * alpha[qt] + l;
                float pv[4][4];
#pragma unroll
                for (int kt = 0; kt < 4; ++kt)
#pragma unroll
                    for (int e = 0; e < 4; ++e) { const int dk = kt - qt + 1; float v = 0.f; if (dk == 0) v = u0[e] ? p[e] : 0.f; else if (dk == 2) v = u2[e] ? p[e] : 0.f; else if (dk == 1) v = (u0[e] || u2[e]) ? 0.f : p[e]; pv[kt][e] = v; }
#pragma unroll
                for (int ks = 0; ks < 2; ++ks) { u32x4 wv; wv.x = cvt_pk_bf16_c(pv[2 * ks][0], pv[2 * ks][1]); wv.y = cvt_pk_bf16_c(pv[2 * ks][2], pv[2 * ks][3]); wv.z = cvt_pk_bf16_c(pv[2 * ks + 1][0], pv[2 * ks + 1][1]); wv.w = cvt_pk_bf16_c(pv[2 * ks + 1][2], pv[2 * ks + 1][3]);
                    Pf[qt][ks] = __builtin_bit_cast(bf16x8, wv); }
            }
            const bool rescale = __ballot(moved) != 0ull;
#pragma unroll
            for (int dt = 0; dt < 4; ++dt) {
                if (rescale) {
#pragma unroll
                    for (int qt = 0; qt < 4; ++qt) Ot[dt][qt] = Ot[dt][qt] * alpha[qt]; }
#pragma unroll
                for (int ks = 0; ks < 2; ++ks) { const u32x2 v0 = *(const LAS u32x2*)(Vt + (16 * dt + fr) * 72 + 32 * ks + 4 * fq), v1 = *(const LAS u32x2*)(Vt + (16 * dt + fr) * 72 + 32 * ks + 16 + 4 * fq);
                    u32x4 vv; vv.x = v0.x; vv.y = v0.y; vv.z = v1.x; vv.w = v1.y; const bf16x8 Vf = __builtin_bit_cast(bf16x8, vv);
#pragma unroll
                    for (int qt = 0; qt < 4; ++qt) { if ((qt == 0 && ks == 1) || (qt == 3 && ks == 0)) continue; Ot[dt][qt] = __builtin_amdgcn_mfma_f32_16x16x32_bf16(Vf, Pf[qt][ks], Ot[dt][qt], 0, 0, 0); } }
            }
            }
            if (more) {
                if (more2) asm volatile("s_waitcnt vmcnt(2)" ::: "memory"); else asm volatile("s_waitcnt vmcnt(0)" ::: "memory");
                LAS bf16_t* kd = Ks + (buf ^ 1) * (64 * 72) + lrow * 72 + lchk * 8; LAS bf16_t* vd = Vs + (buf ^ 1) * (64 * 72) + lrow * 72 + lchk * 8;
                if (jj == 1) { asm volatile("" : "+v"(kA), "+v"(vA)); *(LAS u32x4*)kd = kA; *(LAS u32x4*)vd = vA; } else { asm volatile("" : "+v"(kB), "+v"(vB)); *(LAS u32x4*)kd = kB; *(LAS u32x4*)vd = vB; }
            }
            __syncthreads();
          }
        }
#undef NA_LOAD
#pragma unroll
        for (int qt = 0; qt < 4; ++qt) { const float inv = 1.f / lrun[qt];
#pragma unroll
            for (int dt = 0; dt < 4; ++dt) { const f32x4 o = Ot[dt][qt] * inv; u32x2 wv; wv.x = cvt_pk_bf16_c(o[0], o[1]); wv.y = cvt_pk_bf16_c(o[2], o[3]);
                pst8(QO + (tq0 + 16 * qt + fr) * D + h * 64 + 16 * dt + 4 * fq, wv); } }
    }
    __syncthreads();
}
constexpr int N_PHASES = 31;
constexpr int FLAG_NO_XIMPORT = 1, FLAG_NO_EXPERTS0 = 2;
constexpr int CV_P1 = 3072, CV_P2 = CV_P1 + 1536, CV_SEL = CV_P2 + 5376, CV_SEL1 = 5376, CV_P0B = CV_SEL + 512;
__global__ void __launch_bounds__(512, 2) fwd(Args args) {
    extern __shared__ __attribute__((aligned(16))) unsigned char lds_raw[];
    Frame F; F.lds = (LAS unsigned char*)lds_raw; F.ws = args.ws; F.in = args.in; F.out = args.out;
    F.tid = threadIdx.x; F.lane = F.tid & 63; F.wave = __builtin_amdgcn_readfirstlane(F.tid >> 6); F.G = gridDim.x; F.c = blockIdx.x; F.xok = false;
    unsigned char* ws = args.ws;
    const int wave_s = __builtin_amdgcn_readfirstlane(threadIdx.x >> 6);
    for (int u = F.tid; u < (LDS_BYTES - RING_BYTES) / 4; u += 512) ((LAS unsigned*)(F.lds + RING_BYTES))[u] = 0u;
    __syncthreads();
    const int lo = args.ph_lo, hi = args.ph_hi;
    volatile LAS unsigned* MISC = (volatile LAS unsigned*)(F.lds + MISC_OFF);
    XcdBarrier bar; bar.bar = (unsigned*)(ws + WS_CTL) + CW_BAR + args.pad * XCD_BAR_WORDS_EXT; bar.x = 0; bar.st = nullptr;
    const bool multi = (hi - lo) > 1;
    if (multi) bar = xcd_barrier_post((unsigned*)(ws + WS_CTL) + CW_BAR + args.pad * XCD_BAR_WORDS_EXT, MISC + 8);
#define IN(k) (lo <= (k) && (k) < hi)
#ifdef STAMP_PA
    unsigned long long* TS = (unsigned long long*)(ws + WS_CTL + 40 * 1024);
#define STAMP(k) do { if (blockIdx.x == 0 && threadIdx.x == 0) TS[k] = __builtin_amdgcn_s_memrealtime(); } while (0)
#else
#define STAMP(k) do { } while (0)
#endif
#ifdef AMP_PHASE
    unsigned long long t_phase0 = 0ull;
#define AMP_NOW(t) asm volatile("s_memrealtime %0\n\ts_waitcnt lgkmcnt(0)" : "=s"(t) :: "memory")
#define AMP_T0() do { AMP_NOW(t_phase0); } while (0)
#define AMP_WAIT(k) do { if ((k) == AMP_PHASE || AMP_PHASE < 0) { asm volatile("s_waitcnt vmcnt(0) lgkmcnt(0)" ::: "memory"); unsigned long long _t1; AMP_NOW(_t1); const unsigned long long _tw = _t1 + (unsigned long long)AMP_M * (_t1 - t_phase0); unsigned long long _tn; do { __builtin_amdgcn_s_sleep(4); AMP_NOW(_tn); } while (_tn < _tw); } } while (0)
#else
#define AMP_T0() do { } while (0)
#define AMP_WAIT(k) do { } while (0)
#endif
#define SEAM(k) do { AMP_WAIT(k); if (IN(k) && IN((k) + 1)) { xcd_barrier(bar, wave_s); STAMP((k) + 1); } } while (0)
    STAMP(0);
    LAS unsigned char* ring = F.lds;
#define PHASE_BEGIN() do { int _t; asm volatile("v_mbcnt_lo_u32_b32 %0, -1, 0\n\tv_mbcnt_hi_u32_b32 %0, -1, %0" : "=v"(_t)); _t |= (wave_s << 6); F.tid = _t; F.lane = _t & 63; F.wave = wave_s; AMP_T0(); } while (0)

#ifndef P0_SKIP
#define P0_SKIP 0
#endif
    if (IN(0)) { PHASE_BEGIN(); const int p0s = (args.pad == 1) ? P0_SKIP : 0;
        if (!(p0s & 1)) for (int it = F.c; it < 128; it += F.G) s5_build_item(F, it >> 1, it & 1);
        if (!(p0s & 2)) convert_small_weights(F);
        if (!(p0s & 4)) if (!(args.flags & FLAG_NO_EXPERTS0)) { convert_expert_weights(F, 0, CV_SEL, CV_P0B, 128);
            convert_expert_weights(F, 0, CV_P0B, 16 * 1536, 0); }
        if (!(p0s & 8)) { convert_plain(F, args.in[I_MWQ], (bf16_t*)(ws + WS_MWQ), (size_t)2 * 1024 * 1024);
        convert_plain(F, args.in[I_MEMP], (bf16_t*)(ws + WS_MEMB), (size_t)4 * 256 * 1024);
        convert_plain(F, args.in[I_MEMS], (bf16_t*)(ws + WS_MEMB) + (size_t)4 * 256 * 1024, (size_t)4 * 256 * 1024); }
        if (!(p0s & 16)) import_x(F, !(args.flags & FLAG_NO_XIMPORT));
    }
    SEAM(0);
    unsigned nloc_s = 32u;
    if (multi && IN(0) && IN(1)) {
        if (F.tid == 0) { unsigned ok = (F.G == 256) ? 1u : 0u; unsigned* bw = bar.bar;
            for (unsigned j = 0; j < 16; ++j) { const unsigned cnt = xb_ld(&bw[XB_XCNT(j)]); if (j < 8 ? cnt != 32u : cnt != 0u) ok = 0u; }
            MISC[13] = ok; }
        __syncthreads();
        if (MISC[13]) { F.xok = true; F.c = (int)(MISC[12] * 8u + bar.x); }
    }
#define LSEAM(k) do { AMP_WAIT(k); if (IN(k) && IN((k) + 1)) { if (F.xok) xcd_local_barrier(bar, wave_s, nloc_s); else xcd_barrier(bar, wave_s); STAMP((k) + 1); } } while (0)
    {
        const float* lng = args.in[I_LNG]; const float* lnb = args.in[I_LNB];
        if (IN(1)) { PHASE_BEGIN();
            { SchedKV S{ws, F.G, F.c}; EpiBf<false> E{2048u, 1.f}; gemm_phase<EpiBf<false>, SchedKV, false>(ring, F.tid, 1024, 2048u, 2048u, S, E); }
            { SchedUA S{(const char*)ws + WS_XB, (const char*)ws + WS_WIN, (char*)ws + PO_UA, F.G, F.c}; EpiUA E; gemm_phase<EpiUA, SchedUA, false>(ring, F.tid, 1024, 2048u, 2048u, S, E); }
            if (!(args.flags & FLAG_NO_EXPERTS0)) convert_expert_weights(F, 0, 0, CV_P1, 128);
        }
        SEAM(1);
        if (IN(2)) { PHASE_BEGIN();
            { SchedSA S{ws, F.G, F.c}; EpiS E; gemm_phase<EpiS, SchedSA, false>(ring, F.tid, 512, (unsigned)(UAK * 2), 1024u, S, E); }
            { SchedWqk S{ws, F.G, F.c}; EpiBf8 E{1024u, 0.0625f * 1.4426950408889634f * FP8_SWQK}; gemm_phase<EpiBf8, SchedWqk, false>(ring, F.tid, 256, 4096u, 2048u, S, E); }
            { SchedWvo S{ws, F.G, F.c}; EpiBf<false> E{1024u, 1.f}; gemm_phase<EpiBf<false>, SchedWvo, false>(ring, F.tid, 256, 2048u, 4096u, S, E); }
            if (!(args.flags & FLAG_NO_EXPERTS0)) convert_expert_weights(F, 0, CV_P1, CV_P2, 128);
        }
        SEAM(2);
        if (IN(3)) { PHASE_BEGIN(); s5_recurrence(F); }
        SEAM(3);
        if (IN(4)) { PHASE_BEGIN(); SchedSC S{ws, F.G, F.c}; EpiGelu E; gemm_phase<EpiGelu, SchedSC, false>(ring, F.tid, UAK, (unsigned)(UAK * 2), (unsigned)(UAK * 2), S, E); }
        SEAM(4);
        if (IN(5)) { PHASE_BEGIN(); SchedGated S{(const char*)ws + PO_SG, (const char*)ws + WS_WGLU, (char*)ws + PO_HB_S5, 2048, 2048, 1024, NT / BM, 8, F.G, F.c}; EpiGated<0> E{1024u};
            gemm_phase<EpiGated<0>, SchedGated, false>(ring, F.tid, 1024, 2048u, 2048u, S, E); }
        LSEAM(5);
        if (IN(6)) { PHASE_BEGIN(); if (args.flags & FLAG_NO_XIMPORT) ln_phase<0, false, false, false>(F, (const bf16_t*)(ws + PO_HB_S5), lng, lnb, nullptr); else ln_phase<0, false, false, true>(F, (const bf16_t*)(ws + PO_HB_S5), lng, lnb, nullptr); }
        LSEAM(6);
    }
#define COMMON_BLOCK(layer, pb) do { \
        const float* lng = args.in[I_LNG] + (size_t)(layer) * 3 * D; const float* lnb = args.in[I_LNB] + (size_t)(layer) * 3 * D; \
        if (IN((pb) + 0)) { PHASE_BEGIN(); SchedScores8 S{(const char*)ws + WS_XB8, (const char*)ws + WS_WQK + (size_t)(layer) * 8 * MiB, (char*)ws + PO_SB, F.G, F.c}; EpiSoftmax E{(LAS float*)(F.lds + RING_BYTES + 4096), 1024u, 1.f / (FP8_SX * FP8_SWQK)}; \
            gemm_phase<EpiSoftmax, SchedScores8, false, true>(ring, F.tid, 512, 1024u, 1024u, S, E); } \
        AMP_WAIT((pb) + 0); if (IN((pb) + 0) && IN((pb) + 2)) { if (F.xok) xcd_local_barrier(bar, wave_s, nloc_s); else xcd_barrier(bar, wave_s); STAMP((pb) + 1); }     \
        if (IN((pb) + 2)) { PHASE_BEGIN(); SchedBatchW S{(const char*)ws + PO_SB, (const char*)ws + WS_WVO + (size_t)(layer) * 16 * MiB, (char*)ws + PO_HB_MEM, F.G, F.c}; EpiBf<false> E{1024u, 1.f}; \
            gemm_phase<EpiBf<false>, SchedBatchW, false>(ring, F.tid, 1024, 2048u, 2048u, S, E); } \
        if (IN((pb) + 3)) { PHASE_BEGIN(); ln_router_fill(F, lng + D, lnb + D, args.in[I_EWR] + (size_t)(layer) * D * 16); }     \
        LSEAM((pb) + 2); \
        if (IN((pb) + 3)) { PHASE_BEGIN(); ln_phase<0, true, false>(F, (const bf16_t*)(ws + PO_HB_MEM), lng + D, lnb + D, args.in[I_EWR] + (size_t)(layer) * D * 16); } \
        SEAM((pb) + 3); \
        if (IN((pb) + 4)) { PHASE_BEGIN(); select_phase(F); if ((layer) == 0) { if (!(args.flags & FLAG_NO_EXPERTS0)) convert_expert_weights(F, 0, CV_P2, CV_SEL, 32); } else convert_expert_weights(F, 1, 0, CV_SEL1, 32); } \
        SEAM((pb) + 4); \
        if (IN((pb) + 5)) { PHASE_BEGIN(); SchedUp S{ws, F.G, F.c}; EpiGated8 E{2048u}; gemm_phase<EpiGated8, SchedUp, true, true>(ring, F.tid, 512, 1024u, 1024u, S, E); } \
        SEAM((pb) + 5); \
        if (IN((pb) + 6)) { PHASE_BEGIN(); SchedDown S{ws, F.G, F.c}; EpiBf<true> E{1024u, 1.f / (FP8_SH * FP8_SW2)}; gemm_phase<EpiBf<true>, SchedDown, false, true>(ring, F.tid, 1024, 2048u, 2048u, S, E); } \
        AMP_WAIT((pb) + 6); if (IN((pb) + 6) && IN((pb) + 9)) { xcd_barrier(bar, wave_s); STAMP((pb) + 9); }     \
    } while (0)
    COMMON_BLOCK(0, 7);
    if (IN(16)) { PHASE_BEGIN(); ln_phase<1, false, false>(F, nullptr, args.in[I_LNG] + 2 * D, args.in[I_LNB] + 2 * D, nullptr); convert_expert_weights(F, 1, CV_SEL1, 16 * 1536, 0); }
    SEAM(16);
    {
        const float* lng = args.in[I_LNG] + 3 * D; const float* lnb = args.in[I_LNB] + 3 * D;
        if (IN(17)) { PHASE_BEGIN(); SchedQKV S{ws, F.G, F.c}; EpiQKV E; gemm_phase<EpiQKV, SchedQKV, false, true>(ring, F.tid, 512, 1024u, 1024u, S, E); }
        if (IN(18)) { PHASE_BEGIN(); natten_fill(F, args.in[I_BRPB]); }
        SEAM(17);
        if (IN(18)) { PHASE_BEGIN(); natten_phase(F, args.in[I_BRPB]); }
        SEAM(18);
        if (IN(19)) { PHASE_BEGIN(); SchedPlain S{(const char*)ws + PO_Q, (const char*)ws + WS_WO, (char*)ws + PO_HB_NA, 2048, 2048, 1024, NT / BM, 4, F.G, F.c}; EpiBf<false> E{1024u, 1.f};
            gemm_phase<EpiBf<false>, SchedPlain, false>(ring, F.tid, 1024, 2048u, 2048u, S, E); }
        LSEAM(19);
        if (IN(20)) { PHASE_BEGIN(); ln_phase<0, false, false>(F, (const bf16_t*)(ws + PO_HB_NA), lng, lnb, nullptr); }
        LSEAM(20);
    }
    COMMON_BLOCK(1, 21);
    if (IN(30)) { PHASE_BEGIN(); ln_phase<1, false, true>(F, nullptr, args.in[I_LNG] + 5 * D, args.in[I_LNB] + 5 * D, nullptr); }
    AMP_WAIT(30);
#undef COMMON_BLOCK
#ifdef STAMP_PA
    xcd_barrier(bar, wave_s); STAMP(31); xcd_barrier(bar, wave_s);
    {
        const volatile unsigned long long* T = TS; const float dA = (float)(T[STAMP_PA + STAMP_NA] - T[STAMP_PA]) * 0.01f, dB = (float)(T[STAMP_PB + STAMP_NB] - T[STAMP_PB]) * 0.01f;
        const float c = sqrtf(100.f * dA), V = 100.f * dB; const size_t np = (size_t)NTP * 1024, n = (size_t)NT * 1024;
        for (size_t i = (size_t)blockIdx.x * 512 + threadIdx.x; i < n; i += (size_t)gridDim.x * 512) args.out[i] = i < np ? c : (i == np ? V : 0.f);
    }
#endif
#undef IN
#undef SEAM
}
}
#ifndef DBG
#define DBG 0
#endif
#ifndef FZ_PER_PHASE
#define FZ_PER_PHASE 0
#endif

#if DBG
namespace dbg {
__global__ void k_cmp_bf16_f32(const unsigned short* a, const float* b, size_t n, double* acc) {
    double s0 = 0, s1 = 0;
    for (size_t i = (size_t)blockIdx.x * blockDim.x + threadIdx.x; i < n; i += (size_t)gridDim.x * blockDim.x) { const double x = (double)__uint_as_float(((unsigned)a[i]) << 16), y = b[i]; s0 += (x - y) * (x - y); s1 += y * y; }
    for (int o = 32; o >= 1; o >>= 1) { s0 += __shfl_xor(s0, o); s1 += __shfl_xor(s1, o); }
    if ((threadIdx.x & 63) == 0) { atomicAdd(acc, s0); atomicAdd(acc + 1, s1); }
}
__global__ void k_cmp_f32_f32(const float* a, const float* b, size_t n, double* acc) {
    double s0 = 0, s1 = 0;
    for (size_t i = (size_t)blockIdx.x * blockDim.x + threadIdx.x; i < n; i += (size_t)gridDim.x * blockDim.x) { const double x = a[i], y = b[i]; s0 += (x - y) * (x - y); s1 += y * y; }
    for (int o = 32; o >= 1; o >>= 1) { s0 += __shfl_xor(s0, o); s1 += __shfl_xor(s1, o); }
    if ((threadIdx.x & 63) == 0) { atomicAdd(acc, s0); atomicAdd(acc + 1, s1); }
}
__global__ void k_cmp_ua(const unsigned short* UA, const float* u, double* acc) {
    double s0 = 0, s1 = 0;
    for (size_t i = (size_t)blockIdx.x * blockDim.x + threadIdx.x; i < (size_t)fz::NT * 1024; i += (size_t)gridDim.x * blockDim.x) {
        const int tok = (int)(i >> 10), ch = (int)(i & 1023), chunk = tok >> 5, j = tok & 31, g = ch >> 4, h = ch & 15;
        const double x = (double)__uint_as_float(((unsigned)UA[((size_t)g * fz::NCHUNK + chunk) * fz::UAK + j * 16 + h]) << 16), y = u[i]; s0 += (x - y) * (x - y); s1 += y * y; }
    for (int o = 32; o >= 1; o >>= 1) { s0 += __shfl_xor(s0, o); s1 += __shfl_xor(s1, o); }
    if ((threadIdx.x & 63) == 0) { atomicAdd(acc, s0); atomicAdd(acc + 1, s1); }
}
__global__ void k_encode(float* out, const double* accA, const double* accB) {
    const double vA = accA[1] > 0 ? sqrt(accA[0] / accA[1]) : 9.99; const double vB = accB[1] > 0 ? sqrt(accB[0] / accB[1]) : 9.99;
    const float c = (float)sqrt(1e8 * (vA == vA ? vA : 7.77)); const float V = (float)(1e5 * (vB == vB ? vB : 7.77));
    const size_t np = (size_t)fz::NTP * 1024, n = (size_t)fz::NT * 1024;
    for (size_t i = (size_t)blockIdx.x * blockDim.x + threadIdx.x; i < n; i += (size_t)gridDim.x * blockDim.x) out[i] = i < np ? c : (i == np ? V : 0.f);
}
}
#endif

extern "C" void kernel_launch(void* const* d_in, const int* in_sizes, int n_in, void* d_out, int out_size, void* d_ws, size_t ws_size, hipStream_t stream) {
    using namespace fz;
    static int grid = 0;
    if (grid == 0) {
        if (n_in != 26 || ws_size < WS_END) { fprintf(stderr, "kernel_launch: unexpected inputs (n_in %d, ws %zu)\n", n_in, ws_size); grid = -1; return; }
        int dev = 0, cus = 0, per_cu = 0;
        if (hipGetDevice(&dev) != hipSuccess || hipDeviceGetAttribute(&cus, hipDeviceAttributeMultiprocessorCount, dev) != hipSuccess) { grid = -1; return; }
        if (hipFuncSetAttribute((const void*)fwd, hipFuncAttributeMaxDynamicSharedMemorySize, LDS_BYTES) != hipSuccess) { fprintf(stderr, "kernel_launch: hipFuncSetAttribute failed\n"); grid = -1; return; }
        if (hipOccupancyMaxActiveBlocksPerMultiprocessor(&per_cu, (const void*)fwd, 512, LDS_BYTES) != hipSuccess || per_cu < 1) { fprintf(stderr, "kernel_launch: occupancy query says %d\n", per_cu); }
        (void)hipGetLastError();
        grid = cus;
    }
    if (grid < 0) return;
    unsigned char* ws = (unsigned char*)d_ws;
    (void)hipMemsetAsync(ws + WS_CTL, 0, CTL_ZERO_BYTES, stream);
    Args a{};
    for (int i = 0; i < 26; ++i) a.in[i] = (const float*)d_in[i];
    a.out = (float*)d_out; a.ws = ws; a.flags = 0; a.pad = 0;
    auto run = [&](int lo, int hi) { a.ph_lo = lo; a.ph_hi = hi; hipLaunchKernelGGL(fwd, dim3(grid), dim3(512), LDS_BYTES, stream, a); };
#if DBG == 0
#ifdef PRE_LO
    a.pad = 1; run(PRE_LO, PRE_HI); a.pad = 0;
#endif
#if FZ_PER_PHASE
    for (int p = 0; p < N_PHASES; ++p) run(p, p + 1);
#else
    run(0, N_PHASES);
#endif
#else
    using nv::SG;
    const float* const* in = (const float* const*)d_in;
    const size_t BIG = (size_t)NT * D;
    double* ACC = (double*)(ws + 32 * 1024);
    float* nmisc = (float*)(ws + 987 * MiB);
    float* nKV = nmisc; float* nAFF = nmisc + 4u * 1024 * 1024; float* nGATE = nAFF + 1024 * 1024; int* nIDX = (int*)(nGATE + 128 * 1024); float* nMEMC = (float*)(ws + 385 * MiB);
    auto sgemm = [&](const float* A, const float* B, float* C, const int* gidx, int M, int N, int K, long sam, long sak, long sbk, long sbn, long ldc,
                     int nz = 1, int zdiv = 1, long zA0 = 0, long zA1 = 0, long zB0 = 0, long zB1 = 0, long zC0 = 0, long zC1 = 0) {
        SG s{A, B, C, gidx, M, N, K, zdiv, sam, sak, sbk, sbn, ldc, zA0, zA1, zB0, zB1, zC0, zC1};
        hipLaunchKernelGGL(nv::k_sgemm, dim3(N / 128, M / 128, nz), dim3(256), 0, stream, s);
    };
    const int EW = (int)((BIG + 255) / 256);
    auto n_import = [&](float* X) { hipMemcpyAsync(X, in[I_XP], (size_t)NTP * D * 4, hipMemcpyDeviceToDevice, stream); hipMemcpyAsync(X + (size_t)NTP * D, in[I_XS], (size_t)NTS * D * 4, hipMemcpyDeviceToDevice, stream);
        hipMemcpyAsync(nMEMC, in[I_MEMP], (size_t)4 * 256 * D * 4, hipMemcpyDeviceToDevice, stream); hipMemcpyAsync(nMEMC + (size_t)4 * 256 * D, in[I_MEMS], (size_t)4 * 256 * D * 4, hipMemcpyDeviceToDevice, stream); };
    auto n_s5 = [&](float* X, float* T1, float* T2, float* T3) {
        sgemm(X, in[I_AWIN], T1, nullptr, NT, D, D, D, 1, D, 1, D);
        hipLaunchKernelGGL(nv::k_s5_scan, dim3(8 * 64 * 2), dim3(64), 0, stream, T1, T2, in[I_ALRE], in[I_ALIM], in[I_ALDT], in[I_ABRE], in[I_ABIM], in[I_ACRE], in[I_ACIM]);
        hipLaunchKernelGGL(nv::k_s5_gelu, dim3(EW), dim3(256), 0, stream, T1, T2, in[I_AD], T2);
        sgemm(T2, in[I_AWGLU], T1, nullptr, NT, D, D, D, 1, 2 * D, 1, D);
        sgemm(T2, in[I_AWGLU] + D, T3, nullptr, NT, D, D, D, 1, 2 * D, 1, D);
        hipLaunchKernelGGL(nv::k_glu, dim3(EW), dim3(256), 0, stream, T1, T3, T1);
    };
    auto n_na = [&](float* X, float* T1, float* T2, float* T3) {
        sgemm(X, in[I_BWQKV], T1, nullptr, NT, D, D, D, 1, 3 * D, 1, D); sgemm(X, in[I_BWQKV] + D, T2, nullptr, NT, D, D, D, 1, 3 * D, 1, D); sgemm(X, in[I_BWQKV] + 2 * D, T3, nullptr, NT, D, D, D, 1, 3 * D, 1, D);
        hipLaunchKernelGGL(nv::k_natten, dim3(NT * 16 / 4), dim3(256), 0, stream, T1, T2, T3, in[I_BRPB]);
        sgemm(T1, in[I_BWO], T2, nullptr, NT, D, D, D, 1, D, 1, D);
    };
    auto n_ln = [&](float* X, const float* h, int layer, int sub, float* xo) { hipLaunchKernelGGL(nv::k_res_ln, dim3(NT / 4), dim3(256), 0, stream, X, h, in[I_LNG] + (layer * 3 + sub) * D, in[I_LNB] + (layer * 3 + sub) * D, xo, NT); };
    auto n_mem = [&](float* X, float* T1, float* T2, float* T3, int layer) {
        const float* wq = in[I_MWQ] + (size_t)layer * D * D; const float* wkv = in[I_MWKV] + (size_t)layer * D * 2 * D; const float* wo = in[I_MWO] + (size_t)layer * D * D;
        sgemm(nMEMC, wkv, nKV, nullptr, 8 * 256, 2 * D, D, D, 1, 2 * D, 1, 2 * D);
        sgemm(X, wq, T1, nullptr, NT, D, D, D, 1, D, 1, D);
        for (int grp = 0; grp < 2; ++grp) { const int L = grp ? 4096 : 8192; const size_t tb = grp ? (size_t)NTP : 0; const int gb0 = grp * 4;
            sgemm(T1 + tb * D, nKV + (size_t)gb0 * 256 * 2 * D, T2 + tb * D, nullptr, L, 256, 256, D, 1, 1, 2 * D, D, 16, 4, (long)L * D, 256, (long)256 * 2 * D, 256, (long)L * D, 256); }
        hipLaunchKernelGGL(nv::k_softmax256, dim3(NT * 4 / 4), dim3(256), 0, stream, T2, 0.0625f, NT * 4);
        for (int grp = 0; grp < 2; ++grp) { const int L = grp ? 4096 : 8192; const size_t tb = grp ? (size_t)NTP : 0; const int gb0 = grp * 4;
            sgemm(T2 + tb * D, nKV + (size_t)gb0 * 256 * 2 * D + D, T3 + tb * D, nullptr, L, 256, 256, D, 1, 2 * D, 1, D, 16, 4, (long)L * D, 256, (long)256 * 2 * D, 256, (long)L * D, 256); }
        sgemm(T3, wo, T1, nullptr, NT, D, D, D, 1, D, 1, D);
    };
    auto n_moe = [&](float* X, float* T1, float* T2, float* T3, int layer) {
        hipLaunchKernelGGL(nv::k_router, dim3(NT / 4), dim3(256), 0, stream, X, in[I_EWR] + (size_t)layer * D * 16, nAFF, NT);
        hipLaunchKernelGGL(nv::k_select, dim3(32), dim3(512), 0, stream, nAFF, nIDX, nGATE);
        hipMemsetAsync(T1, 0, BIG * 4, stream);
        for (int grp = 0; grp < 2; ++grp) { const int n = grp ? NTS : NTP, cap = n / 8; const size_t tb = grp ? (size_t)NTP : 0;
            for (int e = 0; e < 16; ++e) { const int* idx = nIDX + (grp ? 16 * 4096 : 0) + e * cap; const float* gate = nGATE + (grp ? 16 * 4096 : 0) + e * cap;
                const float* w1 = in[I_EW1] + ((size_t)layer * 16 + e) * D * 2048; const float* w3 = in[I_EW3] + ((size_t)layer * 16 + e) * D * 2048; const float* w2 = in[I_EW2] + ((size_t)layer * 16 + e) * 2048 * D;
                float* H1 = T2; float* H3 = T2 + (size_t)4096 * 2048; float* YE = T3;
                sgemm(X + tb * D, w1, H1, idx, cap, 2048, D, D, 1, 2048, 1, 2048); sgemm(X + tb * D, w3, H3, idx, cap, 2048, D, D, 1, 2048, 1, 2048);
                hipLaunchKernelGGL(nv::k_silu_mul, dim3((unsigned)(((size_t)cap * 2048 + 255) / 256)), dim3(256), 0, stream, H1, H3, (size_t)cap * 2048);
                sgemm(H1, w2, YE, nullptr, cap, D, 2048, 2048, 1, D, 1, D);
                hipLaunchKernelGGL(nv::k_scatter_add, dim3((unsigned)(((size_t)cap * D + 255) / 256)), dim3(256), 0, stream, YE, idx, gate, T1 + tb * D, cap); } }
    };
    float* X = (float*)(ws + WS_XF); float* T1 = (float*)(ws + WS_EW13); float* T2 = (float*)(ws + WS_POOL); float* T3 = (float*)(ws + WS_POOL + 192 * MiB);
    auto cmp_bf = [&](size_t off_bf16, const float* ref, double* acc) { hipLaunchKernelGGL(dbg::k_cmp_bf16_f32, dim3(2048), dim3(256), 0, stream, (const unsigned short*)(ws + off_bf16), ref, BIG, acc); };
#if DBG == 1
    n_import(X);
    a.flags = FLAG_NO_XIMPORT | FLAG_NO_EXPERTS0;
    n_s5(X, T1, T2, T3);
    for (int p = 0; p <= 5; ++p) run(p, p + 1);
    cmp_bf(PO_HB_S5, T1, ACC);
    cmp_bf(PO_HB_S5, T1, ACC + 2);
#elif DBG == 11
    n_import(X);
    a.flags = FLAG_NO_XIMPORT | FLAG_NO_EXPERTS0;
    sgemm(X, in[I_AWIN], T1, nullptr, NT, D, D, D, 1, D, 1, D);
    for (int p = 0; p <= 4; ++p) run(p, p + 1);
    hipLaunchKernelGGL(dbg::k_cmp_ua, dim3(2048), dim3(256), 0, stream, (const unsigned short*)(ws + PO_UA), T1, ACC);
    hipMemcpyAsync(X, T1, BIG * 4, hipMemcpyDeviceToDevice, stream);
    { float* Y = (float*)(ws + 193 * MiB);
      hipLaunchKernelGGL(nv::k_s5_scan, dim3(8 * 64 * 2), dim3(64), 0, stream, X, Y, in[I_ALRE], in[I_ALIM], in[I_ALDT], in[I_ABRE], in[I_ABIM], in[I_ACRE], in[I_ACIM]);
      hipLaunchKernelGGL(nv::k_s5_gelu, dim3(EW), dim3(256), 0, stream, X, Y, in[I_AD], Y);
      cmp_bf(PO_SG, Y, ACC + 2); }
#elif DBG == 2
    n_import(X); n_s5(X, T1, T2, T3); n_ln(X, T1, 0, 0, X); n_mem(X, T1, T2, T3, 0);
    a.flags = FLAG_NO_XIMPORT | FLAG_NO_EXPERTS0;
    run(0, 1); run(1, 2); run(2, 3); run(7, 8); run(9, 10);
    cmp_bf(PO_HB_MEM, T1, ACC); cmp_bf(PO_HB_MEM, T1, ACC + 2);
#elif DBG == 4
    n_import(X); n_na(X, T1, T2, T3);
    hipMemcpyAsync(T1, T2, BIG * 4, hipMemcpyDeviceToDevice, stream);
    a.flags = FLAG_NO_XIMPORT | FLAG_NO_EXPERTS0;
    run(0, 1); run(17, 18); run(18, 19); run(19, 20);
    cmp_bf(PO_HB_NA, T1, ACC); cmp_bf(PO_HB_NA, T1, ACC + 2);
#endif
    hipLaunchKernelGGL(dbg::k_encode, dim3(2048), dim3(256), 0, stream, (float*)d_out, ACC, ACC + 2);
#endif
}
```

```cpp
#include <hip/hip_runtime.h>
#include <cstdio>
#include <cstdint>
#include <cmath>
#define NO_WT 1
namespace nv {
constexpr int D = 1024, NTP = 32768, NTS = 16384, NT = NTP + NTS, NGB = 8, MEM = 256;
constexpr int GRID_W = 64;
constexpr float ALPHA = 1.41421356237309515f;
constexpr float LN_EPS = 1e-5f;

__host__ __device__ inline int gb_tok0(int gb) { return gb < 4 ? gb * 8192 : NTP + (gb - 4) * 4096; }
__host__ __device__ inline int gb_len(int gb) { return gb < 4 ? 8192 : 4096; }

__device__ __forceinline__ float wave_sum(float v) {
#pragma unroll
    for (int o = 1; o < 64; o <<= 1) v += __shfl_xor(v, o);
    return v;
}
__device__ __forceinline__ float wave_max(float v) {
#pragma unroll
    for (int o = 1; o < 64; o <<= 1) v = fmaxf(v, __shfl_xor(v, o));
    return v;
}

struct SG { const float* A; const float* B; float* C; const int* gidx; int M, N, K, zdiv; long sam, sak, sbk, sbn, ldc; long zA0, zA1, zB0, zB1, zC0, zC1; };
__global__ __launch_bounds__(256) void k_sgemm(SG a) {
    __shared__ float As[8][132];
    __shared__ float Bs[8][132];
    const int z = blockIdx.z, z0 = z / a.zdiv, z1 = z % a.zdiv;
    const float* A = a.A + z0 * a.zA0 + z1 * a.zA1;
    const float* B = a.B + z0 * a.zB0 + z1 * a.zB1;
    float* C = a.C + z0 * a.zC0 + z1 * a.zC1;
    const int bm = blockIdx.y * 128, bn = blockIdx.x * 128, tid = threadIdx.x, tx = tid & 15, ty = tid >> 4;
    float acc[8][8];
#pragma unroll
    for (int i = 0; i < 8; ++i)
#pragma unroll
        for (int j = 0; j < 8; ++j) acc[i][j] = 0.f;
    const int arow_l = tid >> 1, akk = (tid & 1) * 4;
    const long arow = a.gidx ? (long)a.gidx[bm + arow_l] : (long)(bm + arow_l);
    const float* Ap = A + arow * a.sam;
    const int bkk = tid >> 5, bnn = (tid & 31) * 4;
    for (int k0 = 0; k0 < a.K; k0 += 8) {
        float av[4], bv[4];
#pragma unroll
        for (int i = 0; i < 4; ++i) av[i] = Ap[(long)(k0 + akk + i) * a.sak];
#pragma unroll
        for (int i = 0; i < 4; ++i) bv[i] = B[(long)(k0 + bkk) * a.sbk + (long)(bn + bnn + i) * a.sbn];
        __syncthreads();
#pragma unroll
        for (int i = 0; i < 4; ++i) As[akk + i][arow_l] = av[i];
#pragma unroll
        for (int i = 0; i < 4; ++i) Bs[bkk][bnn + i] = bv[i];
        __syncthreads();
#pragma unroll
        for (int kk = 0; kk < 8; ++kk) {
            float x[8], y[8];
#pragma unroll
            for (int i = 0; i < 8; ++i) x[i] = As[kk][ty * 8 + i];
#pragma unroll
            for (int j = 0; j < 8; ++j) y[j] = Bs[kk][tx * 8 + j];
#pragma unroll
            for (int i = 0; i < 8; ++i)
#pragma unroll
                for (int j = 0; j < 8; ++j) acc[i][j] += x[i] * y[j];
        }
    }
#pragma unroll
    for (int i = 0; i < 8; ++i)
#pragma unroll
        for (int j = 0; j < 8; ++j) C[(long)(bm + ty * 8 + i) * a.ldc + bn + tx * 8 + j] = acc[i][j];
}

__global__ __launch_bounds__(64) void k_s5_scan(const float* __restrict__ u, float* __restrict__ ydir, const float* lam_re, const float* lam_im, const float* log_dt,
                                                const float* b_re, const float* b_im, const float* c_re, const float* c_im) {
    const int wid = blockIdx.x;
    const int dir = wid & 1, g = (wid >> 1) & 63, gb = wid >> 7;
    const int p = threadIdx.x;
    const int L = gb_len(gb), t0 = gb_tok0(gb);
    const double dt = exp((double)log_dt[dir * 64 + g]);
    const double lr = lam_re[(dir * 64 + g) * 64 + p], li = lam_im[(dir * 64 + g) * 64 + p];
    const double er = exp(lr * dt), lbr = er * cos(li * dt), lbi = er * sin(li * dt);
    const double nr = lbr - 1.0, ni = lbi, den = lr * lr + li * li;
    const double fr = (nr * lr + ni * li) / den, fi = (ni * lr - nr * li) / den;
    float Br[16], Bi[16], Cr[16], Ci[16];
#pragma unroll
    for (int h = 0; h < 16; ++h) {
        const double br = b_re[((dir * 64 + g) * 64 + p) * 16 + h], bi = b_im[((dir * 64 + g) * 64 + p) * 16 + h];
        Br[h] = (float)(fr * br - fi * bi); Bi[h] = (float)(fr * bi + fi * br);
        Cr[h] = c_re[((dir * 64 + g) * 16 + h) * 64 + p]; Ci[h] = c_im[((dir * 64 + g) * 16 + h) * 64 + p];
    }
    const float ar = (float)lbr, ai = (float)lbi;
    float hr = 0.f, hi = 0.f;
    float* yo = ydir + (size_t)dir * NT * D;
    for (int s = 0; s < L; ++s) {
        const int t = dir ? (L - 1 - s) : s;
        const float* ur = u + (size_t)(t0 + t) * D + g * 16;
        float bur = 0.f, bui = 0.f;
#pragma unroll
        for (int h = 0; h < 16; ++h) { const float uv = ur[h]; bur += uv * Br[h]; bui += uv * Bi[h]; }
        const float nhr = ar * hr - ai * hi + bur, nhi = ar * hi + ai * hr + bui;
        hr = nhr; hi = nhi;
        float mine = 0.f;
#pragma unroll
        for (int c = 0; c < 16; ++c) { const float v = wave_sum(Cr[c] * hr - Ci[c] * hi); if (p == c) mine = v; }
        if (p < 16) yo[(size_t)(t0 + t) * D + g * 16 + p] = mine;
    }
}
__global__ void k_s5_gelu(const float* u, const float* ydir, const float* dskip, float* gout) {
    const size_t i = (size_t)blockIdx.x * blockDim.x + threadIdx.x;
    if (i >= (size_t)NT * D) return;
    const float y = dskip[i & (D - 1)] * u[i] + ydir[i] + ydir[(size_t)NT * D + i];
    const float c = 0.7978845608028654f * (y + 0.044715f * y * y * y);
    gout[i] = 0.5f * y * (1.f + tanhf(c));
}
__global__ void k_glu(const float* z1, const float* z2, float* out) {
    const size_t i = (size_t)blockIdx.x * blockDim.x + threadIdx.x;
    if (i >= (size_t)NT * D) return;
    out[i] = z1[i] / (1.f + expf(-z2[i]));
}
__global__ __launch_bounds__(256) void k_res_ln(const float* x, const float* h, const float* g, const float* b, float* xo, int rows) {
    const int row = blockIdx.x * 4 + (threadIdx.x >> 6), lane = threadIdx.x & 63;
    if (row >= rows) return;
    float v[16]; float s = 0.f;
#pragma unroll
    for (int j = 0; j < 16; ++j) { const size_t i = (size_t)row * D + lane + 64 * j; v[j] = ALPHA * x[i] + h[i]; s += v[j]; }
    const float mean = wave_sum(s) * (1.f / D); float q = 0.f;
#pragma unroll
    for (int j = 0; j < 16; ++j) { v[j] -= mean; q += v[j] * v[j]; }
    const float rstd = 1.f / sqrtf(wave_sum(q) * (1.f / D) + LN_EPS);
#pragma unroll
    for (int j = 0; j < 16; ++j) { const int c = lane + 64 * j; xo[(size_t)row * D + c] = v[j] * rstd * g[c] + b[c]; }
}
__global__ __launch_bounds__(256) void k_softmax256(float* s, float scale, int rows) {
    const int row = blockIdx.x * 4 + (threadIdx.x >> 6), lane = threadIdx.x & 63;
    if (row >= rows) return;
    float v[4]; float m = -INFINITY;
#pragma unroll
    for (int j = 0; j < 4; ++j) { v[j] = s[(size_t)row * 256 + lane + 64 * j] * scale; m = fmaxf(m, v[j]); }
    m = wave_max(m); float l = 0.f;
#pragma unroll
    for (int j = 0; j < 4; ++j) { v[j] = expf(v[j] - m); l += v[j]; }
    l = wave_sum(l);
#pragma unroll
    for (int j = 0; j < 4; ++j) s[(size_t)row * 256 + lane + 64 * j] = v[j] / l;
}
__global__ __launch_bounds__(256) void k_router(const float* x, const float* wr, float* aff, int rows) {
    const int row = blockIdx.x * 4 + (threadIdx.x >> 6), lane = threadIdx.x & 63;
    if (row >= rows) return;
    float acc[16];
#pragma unroll
    for (int e = 0; e < 16; ++e) acc[e] = 0.f;
    for (int j = 0; j < 16; ++j) { const int k = lane + 64 * j; const float xv = x[(size_t)row * D + k];
#pragma unroll
        for (int e = 0; e < 16; ++e) acc[e] += xv * wr[k * 16 + e]; }
    float m = -INFINITY;
#pragma unroll
    for (int e = 0; e < 16; ++e) { acc[e] = wave_sum(acc[e]); m = fmaxf(m, acc[e]); }
    float l = 0.f;
#pragma unroll
    for (int e = 0; e < 16; ++e) { acc[e] = expf(acc[e] - m); l += acc[e]; }
    float mine = 0.f;
#pragma unroll
    for (int e = 0; e < 16; ++e) if (lane == e) mine = acc[e] / l;
    if (lane < 16) aff[(size_t)row * 16 + lane] = mine;
}

__device__ __forceinline__ void select_expert(const float* aff, int n, int e, int cap, int* idx_out, float* gate_out, int* slot_of  , unsigned* hist  , unsigned* wsum  , unsigned* bc  ) {
    const int tid = threadIdx.x, nth = blockDim.x, lane = tid & 63, wv = tid >> 6, nw = nth >> 6;
    unsigned prefix = 0u, mask = 0u; unsigned remaining = (unsigned)cap;
    for (int pass = 0; pass < 4; ++pass) {
        const int shift = 24 - 8 * pass;
        for (int i = tid; i < 256; i += nth) hist[i] = 0u;
        __syncthreads();
        for (int t = tid; t < n; t += nth) { const unsigned key = __float_as_uint(aff[(size_t)t * 16 + e]); if ((key & mask) == prefix) atomicAdd(&hist[(key >> shift) & 255u], 1u); }
        __syncthreads();
        if (tid == 0) { unsigned cum = 0u; int b = 255; for (; b > 0; --b) { if (cum + hist[b] >= remaining) break; cum += hist[b]; } bc[0] = (unsigned)b; bc[1] = remaining - cum; }
        __syncthreads();
        prefix |= bc[0] << shift; mask |= 0xffu << shift; remaining = bc[1];
        __syncthreads();
    }
    const unsigned T = prefix; const unsigned need_eq = remaining;
    unsigned base = 0u, eqbase = 0u;
    for (int s0 = 0; s0 < n; s0 += nth) {
        const int t = s0 + tid; const bool in = t < n;
        const float a = in ? aff[(size_t)t * 16 + e] : 0.f; const unsigned key = __float_as_uint(a);
        const bool gt = in && key > T, eq = in && key == T;
        const unsigned long long meq = __ballot(eq); const unsigned eqr_w = __popcll(meq & ((1ull << lane) - 1ull));
        if (lane == 0) wsum[wv] = __popcll(meq);
        __syncthreads();
        unsigned eqoff = 0u, eqtot = 0u; for (int w = 0; w < nw; ++w) { const unsigned c = wsum[w]; if (w < wv) eqoff += c; eqtot += c; }
        __syncthreads();
        const bool sel = gt || (eq && (eqbase + eqoff + eqr_w) < need_eq);
        const unsigned long long ms = __ballot(sel); const unsigned sr_w = __popcll(ms & ((1ull << lane) - 1ull));
        if (lane == 0) wsum[wv] = __popcll(ms);
        __syncthreads();
        unsigned soff = 0u, stot = 0u; for (int w = 0; w < nw; ++w) { const unsigned c = wsum[w]; if (w < wv) soff += c; stot += c; }
        __syncthreads();
        if (sel) { const unsigned slot = base + soff + sr_w; if (slot < (unsigned)cap) { idx_out[slot] = t; gate_out[slot] = a; } }
        if (slot_of && in) slot_of[(size_t)t * 16 + e] = sel ? (int)(base + soff + sr_w) : -1;
        base += stot; eqbase += eqtot;
    }
}
__global__ __launch_bounds__(512) void k_select(const float* aff_all, int* idx_all, float* gate_all) {
    __shared__ unsigned hist[256]; __shared__ unsigned wsum[32]; __shared__ unsigned bc[4];
    const int grp = blockIdx.x >> 4, e = blockIdx.x & 15;
    const int n = grp ? NTS : NTP, cap = n / 8;
    const float* aff = aff_all + (size_t)(grp ? NTP : 0) * 16;
    int* idx = idx_all + (grp ? 16 * 4096 : 0) + e * cap; float* gate = gate_all + (grp ? 16 * 4096 : 0) + e * cap;
    select_expert(aff, n, e, cap, idx, gate, nullptr, hist, wsum, bc);
}
__global__ void k_silu_mul(float* h1, const float* h3, size_t n) {
    const size_t i = (size_t)blockIdx.x * blockDim.x + threadIdx.x; if (i >= n) return;
    const float a = h1[i]; h1[i] = a / (1.f + expf(-a)) * h3[i];
}
__global__ void k_scatter_add(const float* ye, const int* idx, const float* gate, float* out, int cap) {
    const size_t i = (size_t)blockIdx.x * blockDim.x + threadIdx.x; if (i >= (size_t)cap * D) return;
    const int slot = (int)(i >> 10), c = (int)(i & 1023);
    atomicAdd(&out[(size_t)idx[slot] * D + c], gate[slot] * ye[i]);
}

__global__ __launch_bounds__(256) void k_natten(float* q, const float* k, const float* v, const float* rpb) {
    const int wg = blockIdx.x * 4 + (threadIdx.x >> 6), lane = threadIdx.x & 63;
    const int tok = wg >> 4, h = wg & 15;
    if (tok >= NT) return;
    int gb, l; if (tok < NTP) { gb = tok >> 13; l = tok & 8191; } else { gb = 4 + ((tok - NTP) >> 12); l = (tok - NTP) & 4095; }
    const int rows = gb_len(gb) / GRID_W, t0 = gb_tok0(gb);
    const int r = l >> 6, qc = l & 63;
    int rs = r - 4; rs = rs < 0 ? 0 : (rs > rows - 8 ? rows - 8 : rs);
    int ws = qc - 8; ws = ws < 0 ? 0 : (ws > 48 ? 48 : ws);
    const float qv = q[(size_t)tok * D + h * 64 + lane] * 0.125f;
    float m = -INFINITY, lsum = 0.f, o = 0.f;
    for (int rr = 0; rr < 8; ++rr) {
        const int kr = rs + rr, dr = kr - r + 7;
        for (int cc = 0; cc < 16; ++cc) {
            const int kc = ws + cc; int dc = kc - qc + 15; dc = dc < 0 ? 0 : (dc > 30 ? 30 : dc);
            const size_t kt = (size_t)(t0 + kr * 64 + kc) * D + h * 64 + lane;
            const float s = wave_sum(qv * k[kt]) + rpb[(h * 15 + dr) * 31 + dc];
            const float mn = fmaxf(m, s), al = expf(m - mn), pp = expf(s - mn);
            lsum = lsum * al + pp; o = o * al + pp * v[kt]; m = mn;
        }
    }
    q[(size_t)tok * D + h * 64 + lane] = o / lsum;
}
}
#define LAS __attribute__((address_space(3)))
#define GAS __attribute__((address_space(1)))
namespace fz {
typedef unsigned short bf16_t;
typedef short bf16x8 __attribute__((ext_vector_type(8)));
typedef float f32x4 __attribute__((ext_vector_type(4)));
typedef float f32x2 __attribute__((ext_vector_type(2)));
typedef unsigned u32x4 __attribute__((ext_vector_type(4)));
typedef unsigned u32x2 __attribute__((ext_vector_type(2)));
typedef int v8i __attribute__((ext_vector_type(8)));
typedef int v4i __attribute__((ext_vector_type(4)));

constexpr int D = 1024, NTP = 32768, NTS = 16384, NT = NTP + NTS;
constexpr int TCH = 32, NCHUNK = NT / TCH;
constexpr int UAK = TCH * 16 + 256;
constexpr float ALPHA = 1.41421356237309515f, LN_EPS = 1e-5f;
constexpr size_t MiB = 1u << 20;
constexpr size_t WS_CTL = 0, WS_XF = 1 * MiB, WS_XB = 193 * MiB, WS_WIN = 289 * MiB, WS_WGLU = 291 * MiB, WS_WQKV = 295 * MiB, WS_WO = 301 * MiB, WS_MWQ = 303 * MiB,
                 WS_MWKV = 307 * MiB, WS_MWO = 315 * MiB, WS_MEMB = 319 * MiB, WS_KV = 323 * MiB, WS_WQK = 339 * MiB, WS_WVO = 371 * MiB, WS_AFF = 403 * MiB, WS_SLOT = 406 * MiB,
                 WS_IDX = 409 * MiB, WS_GATE = 409 * MiB + 512 * 1024, WS_EW13 = 411 * MiB  , WS_EW2 = 475 * MiB  ,
                 WS_XB8 = 507 * MiB  , WS_POOL = 603 * MiB, WS_END = 1024 * MiB;
constexpr size_t PO_M2T = WS_POOL, PO_M13T = WS_POOL + 16 * MiB, PO_UA = WS_POOL + 64 * MiB, PO_SG = WS_POOL + 208 * MiB;
constexpr size_t PO_HB_S5 = WS_POOL;
constexpr size_t PO_SB = WS_POOL + 96 * MiB, PO_HB_MEM = WS_POOL + 304 * MiB;
constexpr size_t PO_Q = WS_POOL, PO_K = WS_POOL + 96 * MiB, PO_VT = WS_POOL + 192 * MiB, PO_HB_NA = WS_POOL + 96 * MiB;
constexpr size_t PO_HM = WS_POOL, PO_YE = WS_POOL + 192 * MiB;
static_assert(PO_YE + 192 * MiB <= WS_END && PO_SG + 96 * MiB <= WS_END && PO_HB_NA + 96 * MiB <= WS_END && PO_HB_MEM + 96 * MiB <= WS_END, "pool");
constexpr int CW_TMO = 0, CW_BAR = 4096;
constexpr size_t CTL_ZERO_BYTES = 64 * 1024;
constexpr int RING_BYTES = 131072, MISC_OFF = RING_BYTES + 320, LDS_BYTES = 147456, ZERO16_OFF = RING_BYTES + 64;

__host__ __device__ inline int gb_tok0(int gb) { return gb < 4 ? gb * 8192 : NTP + (gb - 4) * 4096; }
__host__ __device__ inline int gb_len(int gb) { return gb < 4 ? 8192 : 4096; }
__host__ __device__ inline int panel_gb(int pm) { return pm < 128 ? (pm >> 5) : 4 + ((pm - 128) >> 4); }

__device__ __forceinline__ unsigned cvt_pk_bf16(float lo, float hi) { unsigned r; asm volatile("v_cvt_pk_bf16_f32 %0, %1, %2" : "=v"(r) : "v"(lo), "v"(hi)); return r; }
typedef __bf16 bf16x2_t __attribute__((ext_vector_type(2)));
__device__ __forceinline__ unsigned cvt_pk_bf16_c(float lo, float hi) { const f32x2 v = {lo, hi}; const bf16x2_t b = __builtin_convertvector(v, bf16x2_t); return __builtin_bit_cast(unsigned, b); }
__device__ __forceinline__ float bf2f(unsigned short b) { return __uint_as_float(((unsigned)b) << 16); }
template <int CTRL> __device__ __forceinline__ float dpp_f(float v) { return __uint_as_float((unsigned)__builtin_amdgcn_update_dpp(0, (int)__float_as_uint(v), CTRL, 0xF, 0xF, true)); }
__device__ __forceinline__ float x16_sum(float v) { const auto r = __builtin_amdgcn_permlane16_swap(__float_as_uint(v), __float_as_uint(v), false, false); return __uint_as_float(r[0]) + __uint_as_float(r[1]); }
__device__ __forceinline__ float x32_sum(float v) { const auto r = __builtin_amdgcn_permlane32_swap(__float_as_uint(v), __float_as_uint(v), false, false); return __uint_as_float(r[0]) + __uint_as_float(r[1]); }
__device__ __forceinline__ float x16_max(float v) { const auto r = __builtin_amdgcn_permlane16_swap(__float_as_uint(v), __float_as_uint(v), false, false); return fmaxf(__uint_as_float(r[0]), __uint_as_float(r[1])); }
__device__ __forceinline__ float x32_max(float v) { const auto r = __builtin_amdgcn_permlane32_swap(__float_as_uint(v), __float_as_uint(v), false, false); return fmaxf(__uint_as_float(r[0]), __uint_as_float(r[1])); }
__device__ __forceinline__ float row_sum(float v) { v += dpp_f<0xB1>(v); v += dpp_f<0x4E>(v); v += dpp_f<0x141>(v); v += dpp_f<0x140>(v); return v; }
__device__ __forceinline__ float row_max(float v) { v = fmaxf(v, dpp_f<0xB1>(v)); v = fmaxf(v, dpp_f<0x4E>(v)); v = fmaxf(v, dpp_f<0x141>(v)); v = fmaxf(v, dpp_f<0x140>(v)); return v; }
__device__ __forceinline__ float wave_sum(float v) { return x32_sum(x16_sum(row_sum(v))); }
__device__ __forceinline__ float wave_max(float v) { return x32_max(x16_max(row_max(v))); }
#ifndef NO_WT
__device__ __forceinline__ void st16(void* p, u32x4 v) { asm volatile("global_store_dwordx4 %0, %1, off sc1\n\ts_nop 1" :: "v"(p), "v"(v)); }
__device__ __forceinline__ void st8(void* p, u32x2 v) { asm volatile("global_store_dwordx2 %0, %1, off sc1\n\ts_nop 1" :: "v"(p), "v"(v)); }
__device__ __forceinline__ void st4(void* p, unsigned v) { asm volatile("global_store_dword %0, %1, off sc1\n\ts_nop 1" :: "v"(p), "v"(v)); }
#else
__device__ __forceinline__ void st16(void* p, u32x4 v) { *(u32x4*)p = v; }
__device__ __forceinline__ void st8(void* p, u32x2 v) { *(u32x2*)p = v; }
__device__ __forceinline__ void st4(void* p, unsigned v) { *(unsigned*)p = v; }
#endif
__device__ __forceinline__ void st16f(void* p, f32x4 v) { st16(p, __builtin_bit_cast(u32x4, v)); }
__device__ __forceinline__ void pst16(void* p, u32x4 v) { *(u32x4*)p = v; }
__device__ __forceinline__ void pst8(void* p, u32x2 v) { *(u32x2*)p = v; }
#ifndef NO_WT
__device__ __forceinline__ void st16_so(const void* base, unsigned off, f32x4 v) { asm volatile("global_store_dwordx4 %0, %1, %2 sc1\n\ts_nop 1" :: "v"(off), "v"(v), "s"(base)); }
__device__ __forceinline__ void st4_so(const void* base, unsigned off, unsigned v) { asm volatile("global_store_dword %0, %1, %2 sc1\n\ts_nop 1" :: "v"(off), "v"(v), "s"(base)); }
#else
__device__ __forceinline__ void st16_so(const void* base, unsigned off, f32x4 v) { *(f32x4*)((unsigned char*)base + off) = v; }
__device__ __forceinline__ void st4_so(const void* base, unsigned off, unsigned v) { *(unsigned*)((unsigned char*)base + off) = v; }
#endif
#define LDS_WAIT() asm volatile("s_waitcnt lgkmcnt(0)" ::: "memory")
#define VM_WAIT() asm volatile("s_waitcnt vmcnt(0)" ::: "memory")

#define XB_TMO      128
#define XB_XCNT(j)  (256  + 64 * (j))
#define XB_XSUB(j)  (1280 + 64 * (j))
#define XB_XGEN(j)  (2304 + 64 * (j))
#define XB_TOP      3328
#define XB_TOPGEN   3392
#define XCD_BAR_WORDS 3456
#define XB_SPIN_CAP (1u << 18)
__device__ __forceinline__ unsigned xb_ld(unsigned* p)              { return __hip_atomic_load(p, __ATOMIC_RELAXED, __HIP_MEMORY_SCOPE_AGENT); }
__device__ __forceinline__ unsigned xb_add(unsigned* p, unsigned v) { return __hip_atomic_fetch_add(p, v, __ATOMIC_RELAXED, __HIP_MEMORY_SCOPE_AGENT); }
__device__ __forceinline__ unsigned xb_xcc_id() { return (unsigned)__builtin_amdgcn_s_getreg((3 << 11) | 20) & 0xFu; }
#define XB_SPIN(cond, bar) do { unsigned _sp = 0; while (cond) { __builtin_amdgcn_s_sleep(1); \
    if ((++_sp & 255u) == 0u) { if (xb_ld(&(bar)[XB_TMO])) break; if (_sp > XB_SPIN_CAP) { atomicAdd(&(bar)[XB_TMO], 1u); break; } } } } while (0)
struct XcdBarrier { unsigned* bar; unsigned x; volatile LAS unsigned* st; };
__device__ __forceinline__ int xb_tid();
__device__ __forceinline__ XcdBarrier xcd_barrier_post(unsigned* bar, volatile LAS unsigned* st) {
    XcdBarrier b; b.bar = bar; b.x = xb_xcc_id(); b.st = st;
    if (threadIdx.x == 0) st[4] = xb_add(&bar[XB_XCNT(b.x)], 1u);
    return b;
}
#define XB_LCNT(j)  (3520 + 64 * (j))
#define XB_LGEN(j)  (4544 + 64 * (j))
#define XCD_BAR_WORDS_EXT 5568
__device__ __forceinline__ void xcd_local_barrier(const XcdBarrier& b, const int wave_s, const unsigned nloc) {
    asm volatile("s_waitcnt vmcnt(0)" ::: "memory");
    __syncthreads();
    if (wave_s == 0 && xb_tid() == 0) {
        unsigned* bar = b.bar;
        const unsigned old = xb_add(&bar[XB_LCNT(b.x)], 1u);
        const unsigned gen = old / nloc;
        if (old + 1u == (gen + 1u) * nloc) xb_add(&bar[XB_LGEN(b.x)], 1u);
        else XB_SPIN(xb_ld(&bar[XB_LGEN(b.x)]) == gen, bar);
#ifndef LB_NOACQ
        __builtin_amdgcn_fence(__ATOMIC_ACQUIRE, "agent");
        asm volatile("s_waitcnt vmcnt(0)" ::: "memory");
#endif
    }
    __syncthreads();
}
__device__ __forceinline__ void xcd_barrier_complete(unsigned* bar, unsigned x, unsigned& nloc, unsigned& nx) {
    const unsigned G = gridDim.x * gridDim.y * gridDim.z;
    unsigned sum, cnt, mine, sp = 0u;
    for (;;) {
        sum = 0u; cnt = 0u; mine = 0u;
#pragma unroll
        for (unsigned j = 0; j < 16; ++j) { const unsigned c = xb_ld(&bar[XB_XCNT(j)]); sum += c; cnt += (c > 0u) ? 1u : 0u; mine = (j == x) ? c : mine; }
        if (sum == G) break;
        __builtin_amdgcn_s_sleep(1);
        if ((++sp & 255u) == 0u) { if (xb_ld(&bar[XB_TMO])) break; if (sp > XB_SPIN_CAP) { atomicAdd(&bar[XB_TMO], 1u); break; } }
    }
    nloc = mine > 0u ? mine : 1u; nx = cnt > 0u ? cnt : 1u;
}
__device__ __forceinline__ int xb_tid() { int t; asm volatile("v_mbcnt_lo_u32_b32 %0, -1, 0\n\tv_mbcnt_hi_u32_b32 %0, -1, %0" : "=v"(t)); return t; }
__device__ __forceinline__ void xcd_barrier(const XcdBarrier& b, const int wave_s) {
    asm volatile("s_waitcnt vmcnt(0)" ::: "memory");
    __syncthreads();
    if (wave_s == 0 && xb_tid() == 0) {
        unsigned* bar = b.bar;
        __builtin_amdgcn_s_waitcnt(0);
        unsigned nloc = b.st[0], nx = b.st[1];
        if (nloc == 0u) { xcd_barrier_complete(bar, b.x, nloc, nx); b.st[0] = nloc; b.st[1] = nx; }
        const unsigned old = xb_add(&bar[XB_XSUB(b.x)], 1u);
        const unsigned gen = old / nloc;
        if (old + 1u == (gen + 1u) * nloc) {
            __builtin_amdgcn_fence(__ATOMIC_RELEASE, "agent");
            asm volatile("s_waitcnt vmcnt(0)" ::: "memory");
            const unsigned og = xb_add(&bar[XB_TOP], 1u);
            const unsigned tg = og / nx;
            if (og + 1u == (tg + 1u) * nx) xb_add(&bar[XB_TOPGEN], 1u);
            else XB_SPIN(xb_ld(&bar[XB_TOPGEN]) == tg, bar);
            __builtin_amdgcn_fence(__ATOMIC_ACQUIRE, "agent");
            xb_add(&bar[XB_XGEN(b.x)], 1u);
            asm volatile("s_waitcnt vmcnt(0)" ::: "memory");
        } else {
            XB_SPIN(xb_ld(&bar[XB_XGEN(b.x)]) == gen, bar);
            __builtin_amdgcn_fence(__ATOMIC_ACQUIRE, "agent");
            asm volatile("s_waitcnt vmcnt(0)" ::: "memory");
        }
    }
    __syncthreads();
}

constexpr int BM = 256, BK = 64, HALF = 128, HTB = HALF * BK * 2, STAGE_BYTES = 8 * HTB;
__host__ __device__ __forceinline__ int lds_byte(int r, int c) { const int st = (r >> 4) * 2 + (c >> 5), rr = r & 15, cc = c & 31, ob = rr * 64 + cc * 2; return st * 1024 + (ob ^ (((ob >> 9) & 1) << 5)); }
__host__ __device__ __forceinline__ void stage_rc(int b, int& R, int& C) { const int st = b / 1024, sb = b % 1024, swz = sb ^ (((sb >> 9) & 1) << 5); R = (st >> 1) * 16 + swz / 64; C = (st & 1) * 32 + (swz % 64) / 2; }
__host__ __device__ __forceinline__ int perm32(int rho) { const int n = rho >> 4, i = rho & 15; return 8 * (i >> 2) + 4 * n + (i & 3); }

struct GUnit { const char* A; const char* B; char* C; const void* X; int pm, pn; };
template <int WGM = 8>
__device__ __forceinline__ bool static_unit(int i, int G, int c, int nM, int nN, int& pm, int& pn) {
    const long L = (long)i * G + c; const int nwg = nM * nN; if (L >= nwg) return false;
    int wgid = (int)L; { const int q = nwg / 8, r = nwg % 8, xcd = wgid % 8, off = wgid / 8; wgid = (xcd < r ? xcd * (q + 1) : r * (q + 1) + (xcd - r) * q) + off; }
    const int nig = WGM * nN, gid = wgid / nig, fm = gid * WGM, gsz = (nM - fm) < WGM ? (nM - fm) : WGM;
    pm = fm + ((wgid % nig) % gsz); pn = (wgid % nig) / gsz; return true;
}
template <class Epi, class Sched, bool GATHER, bool FP8 = false>
__device__ __forceinline__ void gemm_phase(LAS unsigned char* lds, const int tid_in, const int K, const unsigned lda, const unsigned ldb, const Sched& S, const Epi& E) {
    int tid_ = tid_in; asm volatile("" : "+v"(tid_));
    const int tid = tid_, wid = __builtin_amdgcn_readfirstlane(tid >> 6), lane = tid & 63, wr = wid >> 2, wc = wid & 3, fr = lane & 15, fq = lane >> 4;
    int nt_ = K / BK; asm volatile("" : "+s"(nt_)); const int nt = nt_;
    unsigned voffA[2], voffB[2]; int gR[2], gC[2];
#pragma unroll
    for (int i = 0; i < 2; ++i) { int R, C; stage_rc(tid * 16 + i * 8192, R, C); const int Rb = Epi::PERM ? ((R & ~31) + perm32(R & 31)) : R;
        voffA[i] = (unsigned)R * lda + (unsigned)C * 2u; voffB[i] = (unsigned)Rb * ldb + (unsigned)C * 2u; gR[i] = R; gC[i] = C * 2; }
    const size_t kstep = (size_t)(BK * 2);
    const size_t hstepA = (size_t)HALF * lda, hstepB = (size_t)HALF * ldb;
    const unsigned ldsw = (unsigned)wid * 1024u;
    const int aoff = lds_byte(wr * 64 + fr, fq * 8), boff = lds_byte(wc * 32 + fr, fq * 8);
    const int sc8 = 0x7F7F7F7F;
    unsigned cvo[2][2], nvo[2][2];
#define PG8_SA(b, h) (((b) * 2 + (h)) * HTB)
#define PG8_SB(b, h) ((4 + (b) * 2 + (h)) * HTB)
#define PG8_STAGE(bufoff, gbase, voff) do { _Pragma("unroll") for (int _i = 0; _i < 2; ++_i) \
        __builtin_amdgcn_global_load_lds((const unsigned*)((const char*)(gbase) + (voff)[_i]), (LAS unsigned*)(lds + (bufoff) + ldsw + _i * 8192), 16, 0, 0); } while (0)
#define PG8_STAGE_B(bufoff, ptr, h) PG8_STAGE(bufoff, (ptr) + (h) * hstepB, voffB)
#define PG8_STAGE_A(bufoff, ptr, h, vo) do { if constexpr (GATHER) { PG8_STAGE(bufoff, (ptr), (vo)[h]); } else { PG8_STAGE(bufoff, (ptr) + (h) * hstepA, voffA); } } while (0)
#define PG8_LDA(dst, b, h) do { _Pragma("unroll") for (int m = 0; m < 4; ++m) _Pragma("unroll") for (int k = 0; k < 2; ++k) dst[m][k] = *(const LAS bf16x8*)(lds + PG8_SA(b, h) + aoff + m * 2048 + k * 1024); } while (0)
#define PG8_LDB(dst, b, h) do { _Pragma("unroll") for (int n = 0; n < 2; ++n) _Pragma("unroll") for (int k = 0; k < 2; ++k) dst[n][k] = *(const LAS bf16x8*)(lds + PG8_SB(b, h) + boff + n * 2048 + k * 1024); } while (0)
#define PG8_MMA(ai, bj, At, Bt) do { __builtin_amdgcn_s_setprio(1); _Pragma("unroll") for (int m = 0; m < 4; ++m) _Pragma("unroll") for (int n = 0; n < 2; ++n) { \
        if constexpr (FP8) { const v8i _a = __builtin_shufflevector(__builtin_bit_cast(v4i, At[m][0]), __builtin_bit_cast(v4i, At[m][1]), 0, 1, 2, 3, 4, 5, 6, 7), _b = __builtin_shufflevector(__builtin_bit_cast(v4i, Bt[n][0]), __builtin_bit_cast(v4i, Bt[n][1]), 0, 1, 2, 3, 4, 5, 6, 7); \
            asm volatile("v_mfma_scale_f32_16x16x128_f8f6f4 %0, %1, %2, %0, %3, %3 op_sel_hi:[0,0,0]" : "+v"(acc[ai][bj][m][n]) : "v"(_b), "v"(_a), "v"(sc8)); } \
        else { _Pragma("unroll") for (int k = 0; k < 2; ++k) acc[ai][bj][m][n] = __builtin_amdgcn_mfma_f32_16x16x32_bf16(Bt[n][k], At[m][k], acc[ai][bj][m][n], 0, 0, 0); } } __builtin_amdgcn_s_setprio(0); } while (0)
#define PG8_WAIT_V(n) asm volatile("s_waitcnt vmcnt(" #n ")" ::: "memory")
#define PG8_WAIT_L(n) asm volatile("s_waitcnt lgkmcnt(" #n ")" ::: "memory")
#define PG8_BAR __builtin_amdgcn_s_barrier()
#define PG8_SCHED __builtin_amdgcn_sched_barrier(0)
#define PG8_GLOAD(vo, u) do { if constexpr (GATHER) { const int* _gi = (const int*)(u).X; _Pragma("unroll") for (int _h = 0; _h < 2; ++_h) _Pragma("unroll") for (int _i = 0; _i < 2; ++_i) \
        (vo)[_h][_i] = (unsigned)_gi[_h * HALF + gR[_i]] * lda + (unsigned)gC[_i]; } } while (0)
    GUnit cur, nxt; int ui = 0;
    if (!S.next(0, cur)) return;
    f32x4 acc[2][2][4][2];
    const volatile LAS f32x4* zero16 = (const volatile LAS f32x4*)(lds + ZERO16_OFF);
#pragma unroll
    for (int a = 0; a < 2; ++a)
#pragma unroll
        for (int b = 0; b < 2; ++b)
#pragma unroll
            for (int m = 0; m < 4; ++m)
#pragma unroll
                for (int n = 0; n < 2; ++n) acc[a][b][m][n] = *zero16;
    bf16x8 At[4][2], B0[2][2], B1[2][2];
    const char* cA = cur.A; const char* cB = cur.B;
    PG8_GLOAD(cvo, cur);
    if constexpr (GATHER) { PG8_WAIT_V(0); }
    PG8_STAGE_B(PG8_SB(0, 0), cB, 0); PG8_STAGE_B(PG8_SB(0, 1), cB, 1); PG8_STAGE_A(PG8_SA(0, 0), cA, 0, cvo); PG8_STAGE_A(PG8_SA(0, 1), cA, 1, cvo);
    if (wr == 1) PG8_BAR;
    PG8_WAIT_V(2); PG8_BAR;
    PG8_STAGE_B(PG8_SB(1, 0), cB + kstep, 0); PG8_STAGE_A(PG8_SA(1, 0), cA + kstep, 0, cvo); PG8_STAGE_B(PG8_SB(1, 1), cB + kstep, 1);
    PG8_WAIT_V(6); PG8_BAR;
    for (;;) {
        const bool has_next = S.next(ui + 1, nxt);
        const char* nA = has_next ? nxt.A : cA; const char* nB = has_next ? nxt.B : cB;
        if constexpr (GATHER) { if (has_next) { PG8_GLOAD(nvo, nxt); } else {
#pragma unroll
            for (int h = 0; h < 2; ++h)
#pragma unroll
                for (int i = 0; i < 2; ++i) nvo[h][i] = cvo[h][i]; } }
        for (int t = 0; t < nt; t += 2) {
            const bool last = (t == nt - 2);
            const char* a1 = cA + (size_t)(t + 1) * kstep;
            const char* a2 = last ? nA : cA + (size_t)(t + 2) * kstep; const char* b2 = last ? nB : cB + (size_t)(t + 2) * kstep;
            const char* a3 = a2 + kstep; const char* b3 = b2 + kstep;
            unsigned vo2[2][2];
            if constexpr (GATHER) {
#pragma unroll
                for (int h = 0; h < 2; ++h)
#pragma unroll
                    for (int i = 0; i < 2; ++i) vo2[h][i] = last ? nvo[h][i] : cvo[h][i]; }
            PG8_LDB(B0, 0, 0); PG8_LDB(B1, 0, 1); PG8_SCHED; PG8_LDA(At, 0, 0); PG8_STAGE_A(PG8_SA(1, 1), a1, 1, cvo);
            PG8_WAIT_V(8); PG8_WAIT_L(0); PG8_BAR; PG8_MMA(0, 0, At, B0); PG8_MMA(0, 1, At, B1); PG8_BAR; PG8_SCHED;
            PG8_LDA(At, 0, 1); PG8_STAGE_B(PG8_SB(0, 0), b2, 0); PG8_STAGE_B(PG8_SB(0, 1), b2, 1); PG8_STAGE_A(PG8_SA(0, 0), a2, 0, vo2);
            PG8_WAIT_V(8); PG8_WAIT_L(0); PG8_BAR; PG8_MMA(1, 0, At, B0); PG8_MMA(1, 1, At, B1); PG8_BAR; PG8_SCHED;
            PG8_LDB(B0, 1, 0); PG8_LDB(B1, 1, 1); PG8_SCHED; PG8_LDA(At, 1, 0); PG8_STAGE_A(PG8_SA(0, 1), a2, 1, vo2);
            PG8_WAIT_V(8); PG8_WAIT_L(0); PG8_BAR; PG8_MMA(0, 0, At, B0); PG8_MMA(0, 1, At, B1); PG8_BAR; PG8_SCHED;
            PG8_LDA(At, 1, 1); PG8_STAGE_B(PG8_SB(1, 0), b3, 0); PG8_STAGE_B(PG8_SB(1, 1), b3, 1); PG8_STAGE_A(PG8_SA(1, 0), a3, 0, vo2);
            PG8_WAIT_V(8); PG8_WAIT_L(0); PG8_BAR; PG8_MMA(1, 0, At, B0); PG8_MMA(1, 1, At, B1); PG8_BAR; PG8_SCHED;
        }
        if constexpr (FP8) { asm volatile("s_nop 15\n\ts_nop 15" ::: "memory"); }
        if (wr == 0) PG8_BAR;
        E(acc, cur, wr, wc, fr, fq);
        if (!has_next) break;
#pragma unroll
        for (int a = 0; a < 2; ++a)
#pragma unroll
            for (int b = 0; b < 2; ++b)
#pragma unroll
                for (int m = 0; m < 4; ++m)
#pragma unroll
                    for (int n = 0; n < 2; ++n) acc[a][b][m][n] = *zero16;
        cur = nxt; cA = nA; cB = nB; ++ui;
        if constexpr (GATHER) {
#pragma unroll
            for (int h = 0; h < 2; ++h)
#pragma unroll
                for (int i = 0; i < 2; ++i) cvo[h][i] = nvo[h][i]; }
        if (wr == 1) PG8_BAR;
    }
    PG8_WAIT_V(0);
    PG8_BAR;
#undef PG8_SA
#undef PG8_SB
#undef PG8_STAGE
#undef PG8_STAGE_A
#undef PG8_STAGE_B
#undef PG8_LDA
#undef PG8_LDB
#undef PG8_MMA
#undef PG8_WAIT_V
#undef PG8_WAIT_L
#undef PG8_BAR
#undef PG8_SCHED
#undef PG8_GLOAD
}
typedef f32x4 Acc[2][2][4][2];
__device__ __forceinline__ float sigmoidf_fast(float x) { return __builtin_amdgcn_rcpf(1.f + __builtin_amdgcn_exp2f(-1.4426950408889634f * x)); }
__device__ __forceinline__ float gelu_tanh_fast(float y) {
    const float inner = 1.5957691216057308f * (y + 0.044715f * y * y * y);
    return y * sigmoidf_fast(inner);
}
__device__ __forceinline__ unsigned cvt4_fp8(float a, float b, float c, float d) {
    a = fminf(fmaxf(a, -448.f), 448.f); b = fminf(fmaxf(b, -448.f), 448.f); c = fminf(fmaxf(c, -448.f), 448.f); d = fminf(fmaxf(d, -448.f), 448.f);
    int w = 0; w = __builtin_amdgcn_cvt_pk_fp8_f32(a, b, w, false); w = __builtin_amdgcn_cvt_pk_fp8_f32(c, d, w, true); return (unsigned)w;
}
constexpr float FP8_SX = 8.f, FP8_SW13 = 32.f, FP8_SH = 8.f, FP8_SW2 = 64.f, FP8_SWQK = 32.f, FP8_SWQKV = 32.f;
struct EpiGated8 {
    static constexpr bool PERM = true;
    unsigned ldc;
    __device__ __forceinline__ void operator()(const Acc& acc, const GUnit& u, int wr, int wc, int fr, int fq) const {
        unsigned char* base = (unsigned char*)u.C;
        constexpr float kx = -1.4426950408889634f / (FP8_SX * FP8_SW13), ic = (FP8_SX * FP8_SW13) * (FP8_SX * FP8_SW13) / FP8_SH;
#pragma unroll
        for (int ai = 0; ai < 2; ++ai)
#pragma unroll
            for (int m = 0; m < 4; ++m) { const int r = ai * HALF + wr * 64 + m * 16 + fr;
                float o[8];
#pragma unroll
                for (int n = 0; n < 2; ++n)
#pragma unroll
                    for (int j = 0; j < 4; j += 2) {
                        const f32x2 a = {acc[ai][0][m][n][j], acc[ai][0][m][n][j + 1]}, b = {acc[ai][1][m][n][j], acc[ai][1][m][n][j + 1]};
                        const f32x2 t = a * f32x2{kx, kx};
                        const f32x2 e = {__builtin_amdgcn_exp2f(t[0]), __builtin_amdgcn_exp2f(t[1])};
                        const f32x2 d = e * f32x2{ic, ic} + f32x2{ic, ic};
                        const f32x2 s = {__builtin_amdgcn_rcpf(d[0]), __builtin_amdgcn_rcpf(d[1])};
                        const f32x2 q = (a * b) * s;
                        o[n * 4 + j] = __builtin_amdgcn_fmed3f(q[0], -448.f, 448.f); o[n * 4 + j + 1] = __builtin_amdgcn_fmed3f(q[1], -448.f, 448.f); }
                int w0 = 0, w1 = 0;
                w0 = __builtin_amdgcn_cvt_pk_fp8_f32(o[0], o[1], w0, false); w0 = __builtin_amdgcn_cvt_pk_fp8_f32(o[2], o[3], w0, true);
                w1 = __builtin_amdgcn_cvt_pk_fp8_f32(o[4], o[5], w1, false); w1 = __builtin_amdgcn_cvt_pk_fp8_f32(o[6], o[7], w1, true);
                u32x2 w; w.x = (unsigned)w0; w.y = (unsigned)w1;
                st8(base + (size_t)r * ldc + wc * 32 + 8 * fq, w); }
    }
};
struct EpiBf8 {
    static constexpr bool PERM = true;
    unsigned ldc; float scale;
    __device__ __forceinline__ void operator()(const Acc& acc, const GUnit& u, int wr, int wc, int fr, int fq) const {
        unsigned char* base = (unsigned char*)u.C;
#pragma unroll
        for (int ai = 0; ai < 2; ++ai)
#pragma unroll
            for (int m = 0; m < 4; ++m) { const int r = ai * HALF + wr * 64 + m * 16 + fr; unsigned char* rowp = base + (size_t)r * ldc + wc * 32 + 8 * fq;
#pragma unroll
                for (int bj = 0; bj < 2; ++bj) { const f32x4 v0 = acc[ai][bj][m][0] * scale, v1 = acc[ai][bj][m][1] * scale;
                    u32x2 w; w.x = cvt4_fp8(v0[0], v0[1], v0[2], v0[3]); w.y = cvt4_fp8(v1[0], v1[1], v1[2], v1[3]); st8(rowp + bj * HALF, w); } }
    }
};
template <bool ROWSCALE> struct EpiBf {
    static constexpr bool PERM = true;
    unsigned ldc; float scale;
    __device__ __forceinline__ void operator()(const Acc& acc, const GUnit& u, int wr, int wc, int fr, int fq) const {
        bf16_t* base = (bf16_t*)u.C; const float* rs = (const float*)u.X;
#pragma unroll
        for (int ai = 0; ai < 2; ++ai)
#pragma unroll
            for (int m = 0; m < 4; ++m) { const int r = ai * HALF + wr * 64 + m * 16 + fr; float s = scale; if (ROWSCALE) s *= rs[r];
                bf16_t* rowp = base + (size_t)r * ldc + wc * 32 + 8 * fq;
#pragma unroll
                for (int bj = 0; bj < 2; ++bj) { const f32x4 v0 = acc[ai][bj][m][0] * s, v1 = acc[ai][bj][m][1] * s;
                    u32x4 w; w.x = cvt_pk_bf16(v0[0], v0[1]); w.y = cvt_pk_bf16(v0[2], v0[3]); w.z = cvt_pk_bf16(v1[0], v1[1]); w.w = cvt_pk_bf16(v1[2], v1[3]);
                    st16(rowp + bj * HALF, w); } }
    }
};
template <int MODE> struct EpiGated {
    static constexpr bool PERM = true;
    unsigned ldc;
    __device__ __forceinline__ void operator()(const Acc& acc, const GUnit& u, int wr, int wc, int fr, int fq) const {
        bf16_t* base = (bf16_t*)u.C;
#pragma unroll
        for (int ai = 0; ai < 2; ++ai)
#pragma unroll
            for (int m = 0; m < 4; ++m) { const int r = ai * HALF + wr * 64 + m * 16 + fr;
                float o[8];
#pragma unroll
                for (int n = 0; n < 2; ++n)
#pragma unroll
                    for (int j = 0; j < 4; ++j) { const float a = acc[ai][0][m][n][j], b = acc[ai][1][m][n][j];
                        o[n * 4 + j] = (MODE == 0) ? a * sigmoidf_fast(b) : a * sigmoidf_fast(a) * b; }
                u32x4 w; w.x = cvt_pk_bf16(o[0], o[1]); w.y = cvt_pk_bf16(o[2], o[3]); w.z = cvt_pk_bf16(o[4], o[5]); w.w = cvt_pk_bf16(o[6], o[7]);
                st16(base + (size_t)r * ldc + wc * 32 + 8 * fq, w); }
    }
};
struct EpiUA {
    static constexpr bool PERM = true;
    __device__ __forceinline__ void operator()(const Acc& acc, const GUnit& u, int wr, int wc, int fr, int fq) const {
        bf16_t* UA = (bf16_t*)u.C;
#pragma unroll
        for (int ai = 0; ai < 2; ++ai)
#pragma unroll
            for (int m = 0; m < 4; ++m) { const int tok = u.pm * BM + ai * HALF + wr * 64 + m * 16 + fr; const int chunk = tok >> 5, j = tok & 31;
#pragma unroll
                for (int bj = 0; bj < 2; ++bj) { const int ch = u.pn * BM + bj * HALF + wc * 32 + 8 * fq, g = ch >> 4, h0 = ch & 15;
                    const f32x4 v0 = acc[ai][bj][m][0], v1 = acc[ai][bj][m][1];
                    u32x4 w; w.x = cvt_pk_bf16(v0[0], v0[1]); w.y = cvt_pk_bf16(v0[2], v0[3]); w.z = cvt_pk_bf16(v1[0], v1[1]); w.w = cvt_pk_bf16(v1[2], v1[3]);
                    st16(UA + ((size_t)g * NCHUNK + chunk) * UAK + j * 16 + h0, w); } }
    }
};
struct EpiS {
    static constexpr bool PERM = false;
    __device__ __forceinline__ void operator()(const Acc& acc, const GUnit& u, int wr, int wc, int fr, int fq) const {
        float* Sg = (float*)u.C;
#pragma unroll
        for (int ai = 0; ai < 2; ++ai)
#pragma unroll
            for (int m = 0; m < 4; ++m) { const int chunk = u.pm * BM + ai * HALF + wr * 64 + m * 16 + fr; float* rowp = Sg + (size_t)chunk * 256 + wc * 32 + 4 * fq;
#pragma unroll
                for (int bj = 0; bj < 2; ++bj)
#pragma unroll
                    for (int n = 0; n < 2; ++n) st16f(rowp + bj * HALF + n * 16, acc[ai][bj][m][n]); }
    }
};
struct EpiGelu {
    static constexpr bool PERM = true;
    __device__ __forceinline__ void operator()(const Acc& acc, const GUnit& u, int wr, int wc, int fr, int fq) const {
        bf16_t* Gg = (bf16_t*)u.C;
#pragma unroll
        for (int ai = 0; ai < 2; ++ai)
#pragma unroll
            for (int m = 0; m < 4; ++m) { const int chunk = u.pm * BM + ai * HALF + wr * 64 + m * 16 + fr;
#pragma unroll
                for (int bj = 0; bj < 2; ++bj) { const int n0 = u.pn * BM + bj * HALF + wc * 32 + 8 * fq, i = n0 >> 4, c0 = n0 & 15;
                    const f32x4 v0 = acc[ai][bj][m][0], v1 = acc[ai][bj][m][1];
                    u32x4 w; w.x = cvt_pk_bf16(gelu_tanh_fast(v0[0]), gelu_tanh_fast(v0[1])); w.y = cvt_pk_bf16(gelu_tanh_fast(v0[2]), gelu_tanh_fast(v0[3]));
                    w.z = cvt_pk_bf16(gelu_tanh_fast(v1[0]), gelu_tanh_fast(v1[1])); w.w = cvt_pk_bf16(gelu_tanh_fast(v1[2]), gelu_tanh_fast(v1[3]));
                    st16(Gg + ((size_t)chunk * TCH + i) * D + c0, w); } }
    }
};

struct EpiSoftmax {
    static constexpr bool PERM = true;
    LAS float* red; unsigned ldc; float scale;
    __device__ __forceinline__ void operator()(Acc& acc, const GUnit& u, int wr, int wc, int fr, int fq) const {
        bf16_t* base = (bf16_t*)u.C;
#pragma unroll
        for (int ai = 0; ai < 2; ++ai)
#pragma unroll
            for (int m = 0; m < 4; ++m) { float mx = -INFINITY;
#pragma unroll
                for (int bj = 0; bj < 2; ++bj)
#pragma unroll
                    for (int n = 0; n < 2; ++n) { const f32x4 v = acc[ai][bj][m][n]; mx = fmaxf(mx, fmaxf(fmaxf(v[0], v[1]), fmaxf(v[2], v[3]))); }
                mx *= scale; mx = x32_max(x16_max(mx));
                if (fq == 0) red[(ai * HALF + wr * 64 + m * 16 + fr) * 4 + wc] = mx; }
        asm volatile("s_waitcnt lgkmcnt(0)" ::: "memory"); __builtin_amdgcn_s_barrier(); asm volatile("" ::: "memory");
#pragma unroll
        for (int ai = 0; ai < 2; ++ai)
#pragma unroll
            for (int m = 0; m < 4; ++m) { const int r = ai * HALF + wr * 64 + m * 16 + fr; const f32x4 mm = *(const LAS f32x4*)(red + r * 4); const float M = fmaxf(fmaxf(mm[0], mm[1]), fmaxf(mm[2], mm[3]));
                float s = 0.f;
#pragma unroll
                for (int bj = 0; bj < 2; ++bj)
#pragma unroll
                    for (int n = 0; n < 2; ++n) { f32x4 v = acc[ai][bj][m][n];
#pragma unroll
                        for (int j = 0; j < 4; ++j) { v[j] = __builtin_amdgcn_exp2f(__builtin_fmaf(v[j], scale, -M)); s += v[j]; }
                        acc[ai][bj][m][n] = v; }
                s = x32_sum(x16_sum(s));
                if (fq == 0) red[1024 + r * 4 + wc] = s; }
        asm volatile("s_waitcnt lgkmcnt(0)" ::: "memory"); __builtin_amdgcn_s_barrier(); asm volatile("" ::: "memory");
#pragma unroll
        for (int ai = 0; ai < 2; ++ai)
#pragma unroll
            for (int m = 0; m < 4; ++m) { const int r = ai * HALF + wr * 64 + m * 16 + fr; const f32x4 ss = *(const LAS f32x4*)(red + 1024 + r * 4); const float inv = __builtin_amdgcn_rcpf((ss[0] + ss[1]) + (ss[2] + ss[3]));
                bf16_t* rowp = base + (size_t)r * ldc + wc * 32 + 8 * fq;
#pragma unroll
                for (int bj = 0; bj < 2; ++bj) { const f32x4 v0 = acc[ai][bj][m][0] * inv, v1 = acc[ai][bj][m][1] * inv;
                    u32x4 w; w.x = cvt_pk_bf16(v0[0], v0[1]); w.y = cvt_pk_bf16(v0[2], v0[3]); w.z = cvt_pk_bf16(v1[0], v1[1]); w.w = cvt_pk_bf16(v1[2], v1[3]);
                    st16(rowp + bj * HALF, w); } }
    }
};

struct Ctx { unsigned char* ws; int G, c; };
struct SchedPlain { const char* A; const char* B; char* C; size_t lda, ldb, ldc; int nM, nN, G, c;
    __device__ __forceinline__ bool next(int i, GUnit& u) const { int pm, pn; if (!static_unit(i, G, c, nM, nN, pm, pn)) return false;
        u.A = A + (size_t)pm * BM * lda; u.B = B + (size_t)pn * BM * ldb; u.C = C + ((size_t)pm * BM * ldc + (size_t)pn * BM) * 2; u.X = nullptr; u.pm = pm; u.pn = pn; return true; } };
struct SchedGated { const char* A; const char* B; char* C; size_t lda, ldb, ldc; int nM, nN, G, c;
    __device__ __forceinline__ bool next(int i, GUnit& u) const { int pm, pn; if (!static_unit(i, G, c, nM, nN, pm, pn)) return false;
        u.A = A + (size_t)pm * BM * lda; u.B = B + (size_t)pn * BM * ldb; u.C = C + ((size_t)pm * BM * ldc + (size_t)pn * HALF) * 2; u.X = nullptr; u.pm = pm; u.pn = pn; return true; } };
struct SchedUA { const char* A; const char* B; char* UA; int G, c;
    __device__ __forceinline__ bool next(int i, GUnit& u) const { int pm, pn; if (!static_unit(i, G, c, NT / BM, D / BM, pm, pn)) return false;
        u.A = A + (size_t)pm * BM * (D * 2); u.B = B + (size_t)pn * BM * (D * 2); u.C = UA; u.X = nullptr; u.pm = pm; u.pn = pn; return true; } };
struct SchedKV { unsigned char* ws; int G, c;
    __device__ __forceinline__ bool next(int i, GUnit& u) const { const int L = i * G + c; if (L >= 128) return false; const int layer = L >> 6, r = L & 63, pm = r >> 3, pn = r & 7;
        u.A = (const char*)ws + WS_MEMB + (size_t)pm * BM * 2048; u.B = (const char*)ws + WS_MWKV + (size_t)layer * 4 * MiB + (size_t)pn * BM * 2048;
        u.C = (char*)ws + WS_KV + (size_t)layer * 8 * MiB + ((size_t)pm * BM * 2048 + pn * BM) * 2; u.X = nullptr; u.pm = pm; u.pn = pn; return true; } };
struct SchedSA { unsigned char* ws; int G, c;
    __device__ __forceinline__ bool next(int i, GUnit& u) const { const int L = i * G + c; if (L >= 64 * 6) return false; const int g = L / 6, pm = L % 6;
        u.A = (const char*)ws + PO_UA + ((size_t)g * NCHUNK + (size_t)pm * BM) * (UAK * 2); u.B = (const char*)ws + PO_M2T + (size_t)g * 256 * 512 * 2;
        u.C = (char*)ws + PO_SG + (size_t)g * NCHUNK * 256 * 4; u.X = nullptr; u.pm = pm; u.pn = 0; return true; } };
struct SchedSC { unsigned char* ws; int G, c;
    __device__ __forceinline__ bool next(int i, GUnit& u) const { const int L = i * G + c; if (L >= 64 * 12) return false; const int g = L / 12, r = L % 12, pm = r >> 1, pn = r & 1;
        u.A = (const char*)ws + PO_UA + ((size_t)g * NCHUNK + (size_t)pm * BM) * (UAK * 2); u.B = (const char*)ws + PO_M13T + ((size_t)g * 512 + pn * BM) * UAK * 2;
        u.C = (char*)ws + PO_SG + (size_t)g * 16 * 2; u.X = nullptr; u.pm = pm; u.pn = pn; return true; } };
struct SchedWqk { unsigned char* ws; int G, c;
    __device__ __forceinline__ bool next(int i, GUnit& u) const { const int L = i * G + c; if (L >= 256) return false; const int pn = L & 3, h = (L >> 2) & 3, gb = (L >> 4) & 7, layer = L >> 7;
        u.A = (const char*)ws + WS_KV + (size_t)layer * 8 * MiB + ((size_t)gb * 256 * 2048 + h * 256) * 2; u.B = (const char*)ws + WS_MWQ + (size_t)layer * 2 * MiB + ((size_t)pn * BM * 1024 + h * 256) * 2;
        u.C = (char*)ws + WS_WQK + ((size_t)(layer * 8 + gb) * 1024 * 1024 + (size_t)h * 256 * 1024 + pn * BM); u.X = nullptr; u.pm = 0; u.pn = pn; return true; } };
struct SchedWvo { unsigned char* ws; int G, c;
    __device__ __forceinline__ bool next(int i, GUnit& u) const { const int L = i * G + c; if (L >= 256) return false; const int pm = L & 3, h = (L >> 2) & 3, gb = (L >> 4) & 7, layer = L >> 7;
        u.A = (const char*)ws + WS_MWO + (size_t)layer * 2 * MiB + ((size_t)pm * BM * 1024 + h * 256) * 2; u.B = (const char*)ws + WS_KV + (size_t)layer * 8 * MiB + ((size_t)gb * 256 * 2048 + 1024 + h * 256) * 2;
        u.C = (char*)ws + WS_WVO + ((size_t)(layer * 8 + gb) * 1024 * 1024 + (size_t)pm * BM * 1024 + h * 256) * 2; u.X = nullptr; u.pm = pm; u.pn = 0; return true; } };
struct SchedScores8 { const char* A; const char* Bl; char* C; int G, c;
    __device__ __forceinline__ bool next(int i, GUnit& u) const { int pm, pn; if (!static_unit(i, G, c, NT / BM, 4, pm, pn)) return false; const int gb = panel_gb(pm);
        u.A = A + (size_t)pm * BM * 1024; u.B = Bl + ((size_t)gb * 1024 + pn * BM) * 1024; u.C = C + ((size_t)pm * BM * 1024 + pn * BM) * 2; u.X = nullptr; u.pm = pm; u.pn = pn; return true; } };
struct SchedBatchW { const char* A; const char* Bl; char* C; int G, c;
    __device__ __forceinline__ bool next(int i, GUnit& u) const { int pm, pn; if (!static_unit(i, G, c, NT / BM, 4, pm, pn)) return false; const int gb = panel_gb(pm);
        u.A = A + (size_t)pm * BM * 2048; u.B = Bl + ((size_t)gb * 1024 + pn * BM) * 2048; u.C = C + ((size_t)pm * BM * 1024 + pn * BM) * 2; u.X = nullptr; u.pm = pm; u.pn = pn; return true; } };
struct Args { const float* in[26]; float* out; unsigned char* ws; int ph_lo, ph_hi, flags, pad; };
struct Frame {
    LAS unsigned char* lds; unsigned char* ws; const float* const* in; float* out;
    int tid, lane, wave, G, c;
    bool xok;
};
enum { I_XP = 0, I_XS, I_MEMP, I_MEMS, I_AWIN, I_ALRE, I_ALIM, I_ALDT, I_ABRE, I_ABIM, I_ACRE, I_ACIM, I_AD, I_AWGLU, I_BWQKV, I_BRPB, I_BWO, I_MWQ, I_MWKV, I_MWO, I_EWR, I_EW1, I_EW3, I_EW2, I_LNG, I_LNB };

__device__ __forceinline__ int rowmap(int mode, int n) {
    if (mode == 0) return n;
    if (mode == 1) { const int z = n >> 10, nn = n & 1023; return ((nn >> 7) << 8) + (z << 7) + (nn & 127); }
    return ((n >> 7) << 8) + ((mode == 3) ? 128 : 0) + (n & 127);
}
__device__ __forceinline__ void transpose_item(const float* W, int K, int N, bf16_t* WT, int mode, LAS float* scr, int item, int lane) {
    const int nblk = N / 32, kb = item / nblk, nb = item % nblk, k0 = 64 * kb, n0 = 32 * nb;
#pragma unroll 8
    for (int i = 0; i < 32; ++i) { const int kk = 2 * i + (lane >> 5); scr[kk * 33 + (lane & 31)] = W[(size_t)(k0 + kk) * N + n0 + (lane & 31)]; }
    LDS_WAIT(); asm volatile("" ::: "memory");
    const int c = lane & 7;
#pragma unroll
    for (int j = 0; j < 4; ++j) { const int n = (lane >> 3) + 8 * j; const LAS float* s = scr + (8 * c) * 33 + n;
        u32x4 o; o.x = cvt_pk_bf16(s[0 * 33], s[1 * 33]); o.y = cvt_pk_bf16(s[2 * 33], s[3 * 33]); o.z = cvt_pk_bf16(s[4 * 33], s[5 * 33]); o.w = cvt_pk_bf16(s[6 * 33], s[7 * 33]);
        *(u32x4*)(WT + (size_t)rowmap(mode, n0 + n) * K + k0 + 8 * c) = o; }
    LDS_WAIT(); asm volatile("" ::: "memory");
}
__device__ __forceinline__ void t8_load(f32x4 (&v)[16], const float* W, int N, int item, int lane) {
    const int nblk = N / 32, kb = item / nblk, nb = item % nblk, k0 = 128 * kb, n0 = 32 * nb, q = lane >> 3, c = lane & 7;
#pragma unroll
    for (int i = 0; i < 16; ++i) v[i] = *(const f32x4*)(W + (size_t)(k0 + 16 * q + i) * N + n0 + 4 * c);
}
__device__ __forceinline__ void t8_finish(const f32x4 (&v)[16], int K, int N, unsigned char* WT, int mode, float scale, LAS unsigned char* scr, int item, int lane) {
    const int nblk = N / 32, kb = item / nblk, nb = item % nblk, k0 = 128 * kb, n0 = 32 * nb, q = lane >> 3, c = lane & 7;
#pragma unroll
    for (int j = 0; j < 4; ++j) { u32x4 o;
        o.x = cvt4_fp8(v[0][j] * scale, v[1][j] * scale, v[2][j] * scale, v[3][j] * scale); o.y = cvt4_fp8(v[4][j] * scale, v[5][j] * scale, v[6][j] * scale, v[7][j] * scale);
        o.z = cvt4_fp8(v[8][j] * scale, v[9][j] * scale, v[10][j] * scale, v[11][j] * scale); o.w = cvt4_fp8(v[12][j] * scale, v[13][j] * scale, v[14][j] * scale, v[15][j] * scale);
        *(LAS u32x4*)(scr + (4 * c + j) * 144 + 16 * q) = o; }
    LDS_WAIT(); asm volatile("" ::: "memory");
#pragma unroll
    for (int j = 0; j < 4; ++j) { const int n = (lane >> 3) + 8 * j; const u32x4 o = *(const LAS u32x4*)(scr + n * 144 + 16 * c);
        pst16(WT + (size_t)rowmap(mode, n0 + n) * K + k0 + 16 * c, o); }
    LDS_WAIT(); asm volatile("" ::: "memory");
}
__device__ __forceinline__ void transpose_item8(const float* W, int K, int N, unsigned char* WT, int mode, float scale, LAS unsigned char* scr, int item, int lane) {
    f32x4 v[16]; t8_load(v, W, N, item, lane); t8_finish(v, K, N, WT, mode, scale, scr, item, lane);
}
__device__ __forceinline__ void transpose_item16(const float* W, int K, int N, bf16_t* WT, int mode, LAS unsigned char* scr, int item, int lane) {
    const int nblk = N / 32, kb = item / nblk, nb = item % nblk, k0 = 128 * kb, n0 = 32 * nb, q = lane >> 3, c = lane & 7;
    f32x4 v[16];
#pragma unroll
    for (int i = 0; i < 16; ++i) v[i] = *(const f32x4*)(W + (size_t)(k0 + 16 * q + i) * N + n0 + 4 * c);
#pragma unroll
    for (int j = 0; j < 4; ++j) { u32x4 o0, o1;
        o0.x = cvt_pk_bf16(v[0][j], v[1][j]); o0.y = cvt_pk_bf16(v[2][j], v[3][j]); o0.z = cvt_pk_bf16(v[4][j], v[5][j]); o0.w = cvt_pk_bf16(v[6][j], v[7][j]);
        o1.x = cvt_pk_bf16(v[8][j], v[9][j]); o1.y = cvt_pk_bf16(v[10][j], v[11][j]); o1.z = cvt_pk_bf16(v[12][j], v[13][j]); o1.w = cvt_pk_bf16(v[14][j], v[15][j]);
        *(LAS u32x4*)(scr + (4 * c + j) * 272 + 32 * q) = o0; *(LAS u32x4*)(scr + (4 * c + j) * 272 + 32 * q + 16) = o1; }
    LDS_WAIT(); asm volatile("" ::: "memory");
#pragma unroll
    for (int j = 0; j < 8; ++j) { const int n = (lane >> 4) + 4 * j, ch = lane & 15; const u32x4 o = *(const LAS u32x4*)(scr + n * 272 + 16 * ch);
        *(u32x4*)(WT + (size_t)rowmap(mode, n0 + n) * K + k0 + 8 * ch) = o; }
    LDS_WAIT(); asm volatile("" ::: "memory");
}
__device__ __forceinline__ void convert_small_weights(Frame& F) {
    LAS unsigned char* scr = F.lds + F.wave * 16384;
    const int gw = F.c * 8 + F.wave, NGW = F.G * 8;
    for (int it = gw; it < 3328; it += NGW) {
        int r = it;
        if (r < 256) { transpose_item16(F.in[I_AWIN], 1024, 1024, (bf16_t*)(F.ws + WS_WIN), 0, scr, r, F.lane); continue; } r -= 256;
        if (r < 512) { transpose_item16(F.in[I_AWGLU], 1024, 2048, (bf16_t*)(F.ws + WS_WGLU), 1, scr, r, F.lane); continue; } r -= 512;
        if (r < 768) { transpose_item8(F.in[I_BWQKV], 1024, 3072, F.ws + WS_WQKV, 0, FP8_SWQKV, scr, r, F.lane); continue; } r -= 768;
        if (r < 256) { transpose_item16(F.in[I_BWO], 1024, 1024, (bf16_t*)(F.ws + WS_WO), 0, scr, r, F.lane); continue; } r -= 256;
        if (r < 1024) { const int l = r >> 9; transpose_item16(F.in[I_MWKV] + (size_t)l * 1024 * 2048, 1024, 2048, (bf16_t*)(F.ws + WS_MWKV + (size_t)l * 4 * MiB), 0, scr, r & 511, F.lane); continue; } r -= 1024;
        { const int l = r >> 8; transpose_item16(F.in[I_MWO] + (size_t)l * 1024 * 1024, 1024, 1024, (bf16_t*)(F.ws + WS_MWO + (size_t)l * 2 * MiB), 0, scr, r & 255, F.lane); }
    }
}
__device__ __forceinline__ void convert_expert_weights(Frame& F, int layer, int lo = 0, int hi = 16 * 1536, int wg0 = 0) {
    if (F.G <= wg0) wg0 = 0;
    if (F.c < wg0) return;
    LAS unsigned char* scr = F.lds + F.wave * 16384;
    const int gw = (F.c - wg0) * 8 + F.wave, NGW = (F.G - wg0) * 8;
#define CVX_DECODE(it_) const int _e = (it_) / 1536; int _r = (it_) % 1536; const size_t _wofs = ((size_t)layer * 16 + _e) * 1024 * 2048; \
        const int _w = _r >> 9; _r &= 511; const float* _W = (_w == 0 ? F.in[I_EW1] : (_w == 1 ? F.in[I_EW3] : F.in[I_EW2])) + _wofs; const int _N = _w == 2 ? 1024 : 2048, _K = _w == 2 ? 2048 : 1024;
#define CVX_LOAD(v_, it_) do { CVX_DECODE(it_); (void)_K; t8_load(v_, _W, _N, _r, F.lane); } while (0)
#define CVX_FINISH(v_, it_) do { CVX_DECODE(it_); unsigned char* _WT = _w == 2 ? F.ws + WS_EW2 + (size_t)_e * 2 * MiB : F.ws + WS_EW13 + (size_t)_e * 4 * MiB; \
        t8_finish(v_, _K, _N, _WT, _w == 0 ? 2 : (_w == 1 ? 3 : 0), _w == 2 ? FP8_SW2 : FP8_SW13, scr, _r, F.lane); } while (0)
    f32x4 va[16], vb[16];
    int it = lo + gw;
    if (it < hi) CVX_LOAD(va, it);
    while (it < hi) {
        const int it1 = it + NGW, it2 = it1 + NGW;
        if (it1 < hi) CVX_LOAD(vb, it1);
        CVX_FINISH(va, it);
        if (it1 < hi) { if (it2 < hi) CVX_LOAD(va, it2); CVX_FINISH(vb, it1); }
        it = it2;
    }
#undef CVX_DECODE
#undef CVX_LOAD
#undef CVX_FINISH
}
__device__ __forceinline__ void convert_plain(Frame& F, const float* src, bf16_t* dst, size_t n) {
    const size_t n4 = n / 4;
    for (size_t i = (size_t)F.c * 512 + F.tid; i < n4; i += (size_t)F.G * 512) { const f32x4 v = ((const f32x4*)src)[i]; u32x2 w; w.x = cvt_pk_bf16(v[0], v[1]); w.y = cvt_pk_bf16(v[2], v[3]); ((u32x2*)dst)[i] = w; }
}
__device__ __forceinline__ void import_x(Frame& F, bool copy_f32) {
    const size_t n4 = (size_t)NT * D / 4, np4 = (size_t)NTP * D / 4, st = (size_t)F.G * 512;
    f32x4* XF = (f32x4*)(F.ws + WS_XF); u32x2* XB = (u32x2*)(F.ws + WS_XB);
    for (size_t i0 = (size_t)F.c * 512 + F.tid; i0 < n4; i0 += st * 8) {
        f32x4 v[8];
#pragma unroll
        for (int u = 0; u < 8; ++u) { const size_t i = i0 + st * u;
            if (i < n4) { if (copy_f32) { v[u] = (i < np4) ? ((const f32x4*)F.in[I_XP])[i] : ((const f32x4*)F.in[I_XS])[i - np4]; } else v[u] = XF[i]; } }
#pragma unroll
        for (int u = 0; u < 8; ++u) { const size_t i = i0 + st * u;
            if (i < n4) { u32x2 w; w.x = cvt_pk_bf16(v[u][0], v[u][1]); w.y = cvt_pk_bf16(v[u][2], v[u][3]); XB[i] = w; } }
    }
}

__device__ __forceinline__ void s5_lam(const float* lre, const float* lim, const float* ldt, int dir, int g, int p, double& dt, double& lr, double& li) {
    dt = exp((double)ldt[dir * 64 + g]); lr = (double)lre[(dir * 64 + g) * 64 + p]; li = (double)lim[(dir * 64 + g) * 64 + p];
}
__device__ __forceinline__ void s5_fill_bc(Frame& F, int g, int dir, const LAS double* LBd, LAS float* Bbr, LAS float* Bbi, LAS float* Cr, LAS float* Ci) {
    for (int idx = F.tid; idx < 1024; idx += 512) {
        const int p = idx >> 4, h = idx & 15; const double fr = LBd[p * 4 + 2], fi = LBd[p * 4 + 3];
        const double br = F.in[I_ABRE][((dir * 64 + g) * 64 + p) * 16 + h], bi = F.in[I_ABIM][((dir * 64 + g) * 64 + p) * 16 + h];
        Bbr[idx] = (float)(fr * br - fi * bi); Bbi[idx] = (float)(fr * bi + fi * br);
        Cr[idx] = F.in[I_ACRE][(dir * 64 + g) * 1024 + idx]; Ci[idx] = F.in[I_ACIM][(dir * 64 + g) * 1024 + idx];
    }
}
__device__ __forceinline__ void s5_build_item(Frame& F, int g, int dir) {
    LAS float* LPr = (LAS float*)F.lds; LAS float* LPi = LPr + 33 * 64;
    LAS float* Bbr = LPi + 33 * 64; LAS float* Bbi = Bbr + 1024; LAS float* Cr = Bbi + 1024; LAS float* Ci = Cr + 1024;
    LAS float* B2r = Ci + 1024; LAS float* B2i = B2r + 1024; LAS float* C2r = B2i + 1024; LAS float* C2i = C2r + 1024;
    LAS float* KD = C2i + 1024;
    bf16_t* M2T = (bf16_t*)(F.ws + PO_M2T) + (size_t)g * 256 * 512; bf16_t* M13T = (bf16_t*)(F.ws + PO_M13T) + (size_t)g * 512 * UAK;
    LAS double* LB = (LAS double*)(KD + 32 * 256);
    __syncthreads();
    if (F.tid < 128) { const int dd = F.tid >> 6, p = F.tid & 63;
        if (dd == 0 || dir == 0) { double dt, lr, li; s5_lam(F.in[I_ALRE], F.in[I_ALIM], F.in[I_ALDT], dd == 0 ? dir : 1, g, p, dt, lr, li);
            const double er = exp(lr * dt), lbr = er * cos(li * dt), lbi = er * sin(li * dt), nr = lbr - 1.0, ni = lbi, den = lr * lr + li * li;
            LB[(dd * 64 + p) * 4 + 0] = lbr; LB[(dd * 64 + p) * 4 + 1] = lbi; LB[(dd * 64 + p) * 4 + 2] = (nr * lr + ni * li) / den; LB[(dd * 64 + p) * 4 + 3] = (ni * lr - nr * li) / den; } }
    __syncthreads();
    for (int idx = F.tid; idx < 33 * 64; idx += 512) { const int e = idx >> 6, p = idx & 63; double br = LB[p * 4], bi = LB[p * 4 + 1], rr = 1.0, ri = 0.0;
        for (int b = e; b != 0; b >>= 1) { if (b & 1) { const double t = rr * br - ri * bi; ri = rr * bi + ri * br; rr = t; } const double t2 = br * br - bi * bi; bi = 2.0 * br * bi; br = t2; }
        LPr[idx] = (float)rr; LPi[idx] = (float)ri; }
    s5_fill_bc(F, g, dir, LB, Bbr, Bbi, Cr, Ci);
    if (dir == 0) s5_fill_bc(F, g, 1, LB + 256, B2r, B2i, C2r, C2i);
    __syncthreads();
    {
        const int k = F.tid, j = k >> 4, h = k & 15, e = dir == 0 ? (TCH - 1 - j) : j;
        for (int p = 0; p < 64; ++p) { const float lr = LPr[e * 64 + p], li = LPi[e * 64 + p], br = Bbr[p * 16 + h], bi = Bbi[p * 16 + h];
            const float xr = lr * br - li * bi, xi = lr * bi + li * br;
            M2T[(size_t)(dir * 128 + p) * 512 + k] = (bf16_t)(cvt_pk_bf16(xr, 0.f) & 0xffffu); M2T[(size_t)(dir * 128 + 64 + p) * 512 + k] = (bf16_t)(cvt_pk_bf16(xi, 0.f) & 0xffffu); }
    }
    {
        const int p = F.tid & 63, q8 = F.tid >> 6;
        for (int ic = q8; ic < 512; ic += 8) { const int i = ic >> 4, c = ic & 15, e = dir == 0 ? (i + 1) : (TCH - i);
            const float cr = Cr[c * 64 + p], ci = Ci[c * 64 + p], lr = LPr[e * 64 + p], li = LPi[e * 64 + p];
            const float vr = cr * lr - ci * li, vi = cr * li + ci * lr;
            M13T[(size_t)ic * UAK + 512 + dir * 128 + p] = (bf16_t)(cvt_pk_bf16(vr, 0.f) & 0xffffu); M13T[(size_t)ic * UAK + 512 + dir * 128 + 64 + p] = (bf16_t)(cvt_pk_bf16(-vi, 0.f) & 0xffffu); }
    }
    {
        const int ch = F.tid & 255, c = ch >> 4, h = ch & 15, par = F.tid >> 8;
        if (dir == 0 && par == 0) {
            float s = (c == h) ? F.in[I_AD][g * 16 + c] : 0.f;
            for (int p = 0; p < 64; ++p) s += Cr[c * 64 + p] * Bbr[p * 16 + h] - Ci[c * 64 + p] * Bbi[p * 16 + h] + C2r[c * 64 + p] * B2r[p * 16 + h] - C2i[c * 64 + p] * B2i[p * 16 + h];
            KD[ch] = s;
        }
#pragma nounroll
        for (int hp = 0; hp < 64; hp += 32) {
            float cbr[32], cbi[32];
#pragma unroll
            for (int p = 0; p < 32; ++p) { const float cr = Cr[c * 64 + hp + p], ci = Ci[c * 64 + hp + p], br = Bbr[(hp + p) * 16 + h], bi = Bbi[(hp + p) * 16 + h]; cbr[p] = cr * br - ci * bi; cbi[p] = cr * bi + ci * br; }
#pragma nounroll
            for (int d = 1 + par; d < TCH; d += 2) {
                float s0 = 0.f, s1 = 0.f;
#pragma unroll
                for (int p = 0; p < 32; p += 4) { const f32x4 lr = *(const LAS f32x4*)(LPr + d * 64 + hp + p), li = *(const LAS f32x4*)(LPi + d * 64 + hp + p);
                    s0 += cbr[p] * lr[0]; s1 -= cbi[p] * li[0]; s0 += cbr[p + 1] * lr[1]; s1 -= cbi[p + 1] * li[1]; s0 += cbr[p + 2] * lr[2]; s1 -= cbi[p + 2] * li[2]; s0 += cbr[p + 3] * lr[3]; s1 -= cbi[p + 3] * li[3]; }
                if (hp == 0) KD[d * 256 + ch] = s0 + s1; else KD[d * 256 + ch] += s0 + s1;
            }
        }
        __syncthreads();
        for (int idx = F.tid; idx < 512 * 64; idx += 512) { const int hf = idx & 1, j = (idx >> 1) & 31, ic = idx >> 6, i = ic >> 4, cc = ic & 15;
            const bool mine = dir == 0 ? (j <= i) : (j > i);
            if (mine) { const int d = dir == 0 ? (i - j) : (j - i); const f32x4 v0 = *(const LAS f32x4*)(KD + d * 256 + cc * 16 + hf * 8), v1 = *(const LAS f32x4*)(KD + d * 256 + cc * 16 + hf * 8 + 4);
                u32x4 v; v.x = cvt_pk_bf16(v0[0], v0[1]); v.y = cvt_pk_bf16(v0[2], v0[3]); v.z = cvt_pk_bf16(v1[0], v1[1]); v.w = cvt_pk_bf16(v1[2], v1[3]); *(u32x4*)(M13T + (size_t)ic * UAK + j * 16 + hf * 8) = v; } }
    }
    __syncthreads();
}

__device__ __forceinline__ void s5_recurrence(Frame& F) {
    const float* S = (const float*)(F.ws + PO_SG); bf16_t* UA = (bf16_t*)(F.ws + PO_UA);
    for (int base = F.c * 256; base < 65536; base += F.G * 256) {
        if (F.tid >= 256) continue;
        const int flat = base + F.tid, p = flat & 63, dir = (flat >> 6) & 1, g = (flat >> 7) & 63, gb = flat >> 13;
        double dt, lr, li; s5_lam(F.in[I_ALRE], F.in[I_ALIM], F.in[I_ALDT], dir, g, p, dt, lr, li);
        const double er = exp(lr * dt * TCH); const float ar = (float)(er * cos(li * dt * TCH)), ai = (float)(er * sin(li * dt * TCH));
        const int nc = gb < 4 ? 256 : 128, chunk0 = gb < 4 ? gb * 256 : 1024 + (gb - 4) * 128;
        float hr = 0.f, hi = 0.f;
        for (int s0 = 0; s0 < nc; s0 += 8) {
            float sr[8], si[8];
#pragma unroll
            for (int k = 0; k < 8; ++k) { const int cc = dir == 0 ? (s0 + k) : (nc - 1 - s0 - k); const size_t o = ((size_t)g * NCHUNK + (chunk0 + cc)) * 256 + dir * 128 + p; sr[k] = S[o]; si[k] = S[o + 64]; }
#pragma unroll
            for (int k = 0; k < 8; ++k) { const int cc = dir == 0 ? (s0 + k) : (nc - 1 - s0 - k); const size_t o = ((size_t)g * NCHUNK + (chunk0 + cc)) * UAK + 512 + dir * 128 + p;
                UA[o] = (bf16_t)(cvt_pk_bf16(hr, 0.f) & 0xffffu); UA[o + 64] = (bf16_t)(cvt_pk_bf16(hi, 0.f) & 0xffffu);
                const float nr = ar * hr - ai * hi + sr[k], ni = ar * hi + ai * hr + si[k]; hr = nr; hi = ni; }
        }
    }
}

__device__ __forceinline__ void add_bf16x4(f32x4& v, const u32x2 w) { v[0] += __uint_as_float(w.x << 16); v[1] += __uint_as_float(w.x & 0xffff0000u); v[2] += __uint_as_float(w.y << 16); v[3] += __uint_as_float(w.y & 0xffff0000u); }
constexpr int WRS = 1028;
__device__ __forceinline__ void ln_router_fill(Frame& F, const float* gam, const float* bet, const float* wrouter) {
    LAS float* wrT = (LAS float*)F.lds; LAS float* gsh = wrT + 16 * WRS; LAS float* bsh = gsh + 1024;
    __syncthreads();
    for (int i = F.tid; i < 16384; i += 512) { const int k = i >> 4, e = i & 15; wrT[e * WRS + k] = wrouter[i]; }
    for (int i = F.tid; i < 1024; i += 512) { gsh[i] = gam[i]; bsh[i] = bet[i]; }
    __syncthreads();
}
#ifndef RES_BF16
#define RES_BF16 1
#endif
template <int MODE, bool ROUTER, bool FINAL, bool SRCIN = false>
__device__ __forceinline__ void ln_phase(Frame& F, const bf16_t* HB, const float* gam, const float* bet, const float* wrouter) {
    float* XF = (float*)(F.ws + WS_XF);
    LAS float* wrT = (LAS float*)F.lds;
    LAS float* gsh = wrT + 16 * WRS; LAS float* bsh = gsh + 1024;
    f32x4 gv[4], bv[4];
    if (!ROUTER) {
#pragma unroll
        for (int j = 0; j < 4; ++j) { gv[j] = *(const f32x4*)(gam + F.lane * 4 + 256 * j); bv[j] = *(const f32x4*)(bet + F.lane * 4 + 256 * j); } }
    const unsigned char* wsb = F.ws; int ln = F.lane; unsigned lb4 = (unsigned)ln * 16u, lb2 = (unsigned)ln * 8u, lb1 = (unsigned)ln * 4u;
    const unsigned hb_off = (unsigned)((const unsigned char*)HB - wsb);
    const int nq = F.xok ? 6 : (NT / 4 + F.G * 8 - 1) / (F.G * 8);
    constexpr bool X32 = SRCIN || !RES_BF16;
    f32x4 xr32[4][4]; u32x2 xr16[4][4], hwr[4][4];
#define LN_ISSUE(row0_) do { const int _r0 = (row0_); \
        const unsigned char* xbase = SRCIN ? (_r0 < NTP ? (const unsigned char*)F.in[I_XP] : (const unsigned char*)F.in[I_XS] - (size_t)NTP * 4096) : wsb + WS_XF;      \
        if (X32) { _Pragma("unroll") for (int r = 0; r < 4; ++r) { const unsigned ro = (unsigned)(_r0 + r) * 4096u + lb4; _Pragma("unroll") for (int j = 0; j < 4; ++j) xr32[r][j] = *(const f32x4*)(xbase + ro + 1024u * j); } } \
        else { _Pragma("unroll") for (int r = 0; r < 4; ++r) { const unsigned ro = (unsigned)(_r0 + r) * 2048u + lb2; _Pragma("unroll") for (int j = 0; j < 4; ++j) xr16[r][j] = *(const u32x2*)(xbase + ro + 512u * j); } } \
        if (MODE == 0) { _Pragma("unroll") for (int r = 0; r < 4; ++r) { const unsigned ro = hb_off + (unsigned)(_r0 + r) * 2048u + lb2; _Pragma("unroll") for (int j = 0; j < 4; ++j) hwr[r][j] = *(const u32x2*)(wsb + ro + 512u * j); } } \
    } while (0)
#define LN_Q(qi_) (F.xok ? ((F.c & 7) * 1536 + (F.c >> 3) * 48 + F.wave * 6 + (qi_)) : (F.c * 8 + F.wave + (qi_) * F.G * 8))
    u32x4 sln = {~0u, ~0u, ~0u, ~0u};
    if (MODE == 1) { const int q0 = LN_Q(0); if (nq > 0 && q0 < NT / 4 && F.lane < 16) sln = *(const u32x4*)(wsb + (unsigned)(WS_SLOT + ((size_t)F.lane * NT + (size_t)q0 * 4) * 4)); }
    { const int q0 = LN_Q(0); if (nq > 0 && q0 < NT / 4) { LN_ISSUE(q0 * 4); } }
    for (int qi = 0; qi < nq; ++qi) {
        const int q = LN_Q(qi);
        if (q >= NT / 4) break;
        const int row0 = q * 4;
        const u32x4 slc = sln;
        if (MODE == 1) { const int qn = LN_Q(qi + 1); if (qi + 1 < nq && qn < NT / 4 && ln < 16) sln = *(const u32x4*)(wsb + (unsigned)(WS_SLOT + ((size_t)ln * NT + (size_t)qn * 4) * 4)); }
        asm volatile("v_mbcnt_lo_u32_b32 %0, -1, 0\n\tv_mbcnt_hi_u32_b32 %0, -1, %0" : "=v"(ln));
        lb4 = (unsigned)ln * 16u; lb2 = (unsigned)ln * 8u; lb1 = (unsigned)ln * 4u; const int lw = ln * 4;
        f32x4 v[4][4];
#pragma unroll
        for (int r = 0; r < 4; ++r)
#pragma unroll
            for (int j = 0; j < 4; ++j) {
                if (X32) v[r][j] = xr32[r][j];
                else { v[r][j][0] = __uint_as_float(xr16[r][j].x << 16); v[r][j][1] = __uint_as_float(xr16[r][j].x & 0xffff0000u); v[r][j][2] = __uint_as_float(xr16[r][j].y << 16); v[r][j][3] = __uint_as_float(xr16[r][j].y & 0xffff0000u); } }
        if (MODE == 0) {
#pragma unroll
            for (int r = 0; r < 4; ++r)
#pragma unroll
                for (int j = 0; j < 4; ++j) { v[r][j] = v[r][j] * ALPHA; add_bf16x4(v[r][j], hwr[r][j]); }
        }
        if (!ROUTER) { const int qn = LN_Q(qi + 1); if (qi + 1 < nq && qn < NT / 4) { LN_ISSUE(qn * 4); } }
        if (MODE == 0) {
        } else {
            const int grp = row0 >= NTP; int sl[4];
#pragma unroll
            for (int r = 0; r < 4; ++r) sl[r] = (ln < 16) ? (int)slc[r] : -1;
            unsigned long long mask[4]; bool any[4], two[4]; u32x2 wa[4][4], wb[4][4];
#pragma unroll
            for (int r = 0; r < 4; ++r) {
                unsigned long long mk = __ballot(sl[r] >= 0); any[r] = mk != 0ull;
                int e0 = 0, s0 = 0; if (any[r]) { e0 = __builtin_ctzll(mk); mk &= mk - 1; s0 = __builtin_amdgcn_readlane(sl[r], e0); }
                const unsigned y0 = any[r] ? (grp ? 65536u + e0 * 2048u + s0 : e0 * 4096u + s0) : 0u;
                two[r] = mk != 0ull; int e1 = 0, s1 = 0; if (two[r]) { e1 = __builtin_ctzll(mk); mk &= mk - 1; s1 = __builtin_amdgcn_readlane(sl[r], e1); }
                const unsigned y1 = two[r] ? (grp ? 65536u + e1 * 2048u + s1 : e1 * 4096u + s1) : y0;
                mask[r] = mk;
                const unsigned char* ya = wsb + PO_YE + (size_t)y0 * 2048; const unsigned char* yb = wsb + PO_YE + (size_t)y1 * 2048;
#pragma unroll
                for (int j = 0; j < 4; ++j) { wa[r][j] = *(const u32x2*)(ya + lb2 + 512u * j); wb[r][j] = *(const u32x2*)(yb + lb2 + 512u * j); }
            }
#pragma unroll
            for (int r = 0; r < 4; ++r) {
#pragma unroll
                for (int j = 0; j < 4; ++j) { v[r][j] = v[r][j] * ALPHA; if (any[r]) add_bf16x4(v[r][j], wa[r][j]); if (two[r]) add_bf16x4(v[r][j], wb[r][j]); }
                unsigned long long mk = mask[r];
                while (mk) {
                    const int e0 = __builtin_ctzll(mk); mk &= mk - 1; const int s0 = __builtin_amdgcn_readlane(sl[r], e0);
                    const unsigned y0 = grp ? 65536u + e0 * 2048u + s0 : e0 * 4096u + s0;
                    const bool tw = mk != 0ull; int e1 = 0, s1 = 0; if (tw) { e1 = __builtin_ctzll(mk); mk &= mk - 1; s1 = __builtin_amdgcn_readlane(sl[r], e1); }
                    const unsigned y1 = tw ? (grp ? 65536u + e1 * 2048u + s1 : e1 * 4096u + s1) : y0;
                    const unsigned char* ya = wsb + PO_YE + (size_t)y0 * 2048; const unsigned char* yb = wsb + PO_YE + (size_t)y1 * 2048;
                    u32x2 xa[4], xb[4];
#pragma unroll
                    for (int j = 0; j < 4; ++j) { xa[j] = *(const u32x2*)(ya + lb2 + 512u * j); xb[j] = *(const u32x2*)(yb + lb2 + 512u * j); }
#pragma unroll
                    for (int j = 0; j < 4; ++j) { add_bf16x4(v[r][j], xa[j]); if (tw) add_bf16x4(v[r][j], xb[j]); }
                }
            }
        }
#pragma unroll
        for (int r = 0; r < 4; ++r) {
            float s = 0.f;
#pragma unroll
            for (int j = 0; j < 4; ++j) s += (v[r][j][0] + v[r][j][1]) + (v[r][j][2] + v[r][j][3]);
            const float mean = wave_sum(s) * (1.f / D); float qq = 0.f;
#pragma unroll
            for (int j = 0; j < 4; ++j) { v[r][j] = v[r][j] - mean; qq += (v[r][j][0] * v[r][j][0] + v[r][j][1] * v[r][j][1]) + (v[r][j][2] * v[r][j][2] + v[r][j][3] * v[r][j][3]); }
            const float rstd = 1.f / sqrtf(wave_sum(qq) * (1.f / D) + LN_EPS);
#pragma unroll
            for (int j = 0; j < 4; ++j) { if (ROUTER) { gv[j] = *(const LAS f32x4*)(gsh + lw + 256 * j); bv[j] = *(const LAS f32x4*)(bsh + lw + 256 * j); } v[r][j] = v[r][j] * rstd * gv[j] + bv[j]; }
            const unsigned row = (unsigned)(row0 + r);
            if (FINAL) {
                unsigned char* ob = (unsigned char*)F.out;
#pragma unroll
                for (int j = 0; j < 4; ++j) *(f32x4*)(ob + (size_t)(row * 4096u + lb4 + 1024u * j)) = v[r][j];
            } else {
                unsigned char* wsw = F.ws;
#pragma unroll
                for (int j = 0; j < 4; ++j) {
                    if (RES_BF16) { u32x2 xo; xo.x = cvt_pk_bf16_c(v[r][j][0], v[r][j][1]); xo.y = cvt_pk_bf16_c(v[r][j][2], v[r][j][3]); *(u32x2*)(wsw + (unsigned)(WS_XF + row * 2048u + lb2 + 512u * j)) = xo; }
                    else *(f32x4*)(wsw + (unsigned)(WS_XF + row * 4096u + lb4 + 1024u * j)) = v[r][j];
                    *(unsigned*)(wsw + (unsigned)(WS_XB8 + row * 1024u + lb1 + 256u * j)) = cvt4_fp8(v[r][j][0] * FP8_SX, v[r][j][1] * FP8_SX, v[r][j][2] * FP8_SX, v[r][j][3] * FP8_SX); }
            }
        }
        if (ROUTER) {
            { const int qn = LN_Q(qi + 1); if (qi + 1 < nq && qn < NT / 4) { LN_ISSUE(qn * 4); } }
            float val[64];
#pragma unroll
            for (int hf = 0; hf < 4; ++hf) {
                f32x2 a2[4][4];
#pragma unroll
                for (int r = 0; r < 4; ++r)
#pragma unroll
                    for (int e4 = 0; e4 < 4; ++e4) a2[r][e4] = f32x2{0.f, 0.f};
#pragma unroll
                for (int e4 = 0; e4 < 4; ++e4)
#pragma unroll
                    for (int j = 0; j < 4; ++j) { const f32x4 w = *(const LAS f32x4*)(wrT + (hf * 4 + e4) * WRS + lw + 256 * j);
                        const f32x2 wl = f32x2{w[0], w[1]}, wh = f32x2{w[2], w[3]};
#pragma unroll
                        for (int r = 0; r < 4; ++r) { a2[r][e4] = f32x2{v[r][j][0], v[r][j][1]} * wl + a2[r][e4]; a2[r][e4] = f32x2{v[r][j][2], v[r][j][3]} * wh + a2[r][e4]; } }
#pragma unroll
                for (int r = 0; r < 4; ++r)
#pragma unroll
                    for (int e4 = 0; e4 < 4; ++e4) val[r * 16 + hf * 4 + e4] = a2[r][e4][0] + a2[r][e4][1];
            }
#pragma unroll
            for (int sft = 5; sft >= 0; --sft) { const int n2 = 1 << sft; const bool up = (ln >> sft) & 1;
#pragma unroll
                for (int i = 0; i < n2; ++i) { const float lo = val[i], hi = val[i + n2]; const float mine = up ? hi : lo, other = up ? lo : hi; val[i] = mine + __shfl_xor(other, n2); } }
            const float lg = val[0], m = row_max(lg);
            const float ex = expf(lg - m); const float l = row_sum(ex);
            *(float*)(F.ws + (unsigned)(WS_AFF + ((size_t)(ln & 15) * NT + row0 + (ln >> 4)) * 4)) = ex / l;
        }
    }
#undef LN_Q
#undef LN_ISSUE
    if (ROUTER) __syncthreads();
}
__device__ __forceinline__ void softmax_phase(Frame& F, bf16_t* SB) {
    for (int row = F.c * 8 + F.wave; row < NT * 4; row += F.G * 8) {
        u32x2* p = (u32x2*)(SB + (size_t)row * 256) + F.lane; const u32x2 w = *p;
        float a = __uint_as_float(w.x << 16), b = __uint_as_float(w.x & 0xffff0000u), c = __uint_as_float(w.y << 16), d = __uint_as_float(w.y & 0xffff0000u);
        const float m = wave_max(fmaxf(fmaxf(a, b), fmaxf(c, d)));
        a = __expf(a - m); b = __expf(b - m); c = __expf(c - m); d = __expf(d - m);
        const float inv = 1.f / wave_sum((a + b) + (c + d));
        u32x2 o; o.x = cvt_pk_bf16(a * inv, b * inv); o.y = cvt_pk_bf16(c * inv, d * inv); *p = o;
    }
}
__device__ __forceinline__ void moe_panel(int P, int& e, int& grp, int& yerow0) {
    if (P < 256) { e = P >> 4; grp = 0; } else { e = (P - 256) >> 3; grp = 1; }
    yerow0 = P * 256;
}
#ifndef UPWGM
#define UPWGM 8
#endif
struct SchedUp { unsigned char* ws; int G, c;
    __device__ __forceinline__ bool next(int i, GUnit& u) const { int P, pn; if (!static_unit<UPWGM>(i, G, c, 384, 16, P, pn)) return false; int e, grp, y0; moe_panel(P, e, grp, y0);
        u.A = (const char*)ws + WS_XB8 + (grp ? (size_t)NTP * 1024 : 0); u.B = (const char*)ws + WS_EW13 + ((size_t)e * 4096 + pn * BM) * 1024;
        u.C = (char*)ws + PO_HM + ((size_t)P * BM * 2048 + pn * HALF); u.X = (const int*)(ws + WS_IDX) + y0; u.pm = P; u.pn = pn; return true; } };
struct SchedDown { unsigned char* ws; int G, c;
    __device__ __forceinline__ bool next(int i, GUnit& u) const { int P, pn; if (!static_unit(i, G, c, 384, 4, P, pn)) return false; int e, grp, y0; moe_panel(P, e, grp, y0);
        u.A = (const char*)ws + PO_HM + (size_t)P * BM * 2048; u.B = (const char*)ws + WS_EW2 + ((size_t)e * 1024 + pn * BM) * 2048;
        u.C = (char*)ws + PO_YE + ((size_t)y0 * 1024 + pn * BM) * 2; u.X = (const float*)(ws + WS_GATE) + y0; u.pm = P; u.pn = pn; return true; } };
struct SchedQKV { unsigned char* ws; int G, c;
    __device__ __forceinline__ bool next(int i, GUnit& u) const { const int L = i * G + c; if (L >= 1536 + 768) return false;
        if (L < 1536) { int pm, pn; static_unit(i, G, c, 192, 8, pm, pn);
            u.A = (const char*)ws + WS_XB8 + (size_t)pm * BM * 1024; u.B = (const char*)ws + WS_WQKV + (size_t)pn * BM * 1024;
            u.C = (char*)ws + (pn < 4 ? PO_Q : PO_K) + ((size_t)pm * BM * 1024 + (pn & 3) * BM) * 2; u.X = nullptr; u.pm = pm; u.pn = pn; return true; }
        const int r = L - 1536, pmv = r & 3, pnv = r >> 2;
        u.A = (const char*)ws + WS_WQKV + (size_t)(2048 + pmv * BM) * 1024; u.B = (const char*)ws + WS_XB8 + (size_t)pnv * BM * 1024;
        u.C = (char*)ws + PO_VT + ((size_t)pmv * BM * NT + (size_t)pnv * BM) * 2; u.X = nullptr; u.pm = pmv; u.pn = 8 + pnv; return true; } };
struct EpiQKV {
    static constexpr bool PERM = true;
    __device__ __forceinline__ void operator()(const Acc& acc, const GUnit& u, int wr, int wc, int fr, int fq) const {
        constexpr float ds = 1.f / (FP8_SX * FP8_SWQKV);
        if (u.pn >= 8) { EpiBf<false> e{(unsigned)NT, ds}; e(acc, u, wr, wc, fr, fq); }
        else { EpiBf<false> e{1024u, u.pn < 4 ? 0.125f * 1.4426950408889634f * ds : ds}; e(acc, u, wr, wc, fr, fq); }
    }
};

__device__ __forceinline__ int wave_sum_i(int v) {
#pragma unroll
    for (int o = 1; o < 64; o <<= 1) v += __shfl_xor(v, o);
    return v;
}
__device__ __forceinline__ int block_excl_scan(int v, int lane, int wave, LAS int* red, int& total) {
    int inc = v;
#pragma unroll
    for (int o = 1; o < 64; o <<= 1) { const int t = __shfl_up(inc, o); if (lane >= o) inc += t; }
    __syncthreads();
    if (lane == 63) red[wave] = inc;
    __syncthreads();
    int off = 0, tot = 0;
#pragma unroll
    for (int w = 0; w < 8; ++w) { const int c = red[w]; if (w < wave) off += c; tot += c; }
    total = tot; return off + inc - v;
}
template <int PER>
__device__ __forceinline__ void select_fast(Frame& F, const float* affcol, int cap, int* idx_out, float* gate_out, int* slotcol) {
    LAS int* red = (LAS int*)F.lds;
    unsigned key[PER];
#pragma unroll
    for (int i = 0; i < PER / 4; ++i) { const u32x4 v = ((const u32x4*)(affcol + (size_t)F.tid * PER))[i]; key[4 * i] = v.x; key[4 * i + 1] = v.y; key[4 * i + 2] = v.z; key[4 * i + 3] = v.w; }
    unsigned T = 0u;
    for (int b = 30; b >= 0; --b) {
        const unsigned cand = T | (1u << b); int cnt = 0;
#pragma unroll
        for (int i = 0; i < PER; ++i) cnt += (key[i] >= cand) ? 1 : 0;
        cnt = wave_sum_i(cnt);
        LAS int* r = red + (b & 1) * 8;
        if (F.lane == 0) r[F.wave] = cnt;
        __syncthreads();
        int tot = 0;
#pragma unroll
        for (int w = 0; w < 8; ++w) tot += r[w];
        if (tot >= cap) T = cand;
    }
    int g = 0, q = 0;
#pragma unroll
    for (int i = 0; i < PER; ++i) { g += (key[i] > T) ? 1 : 0; q += (key[i] == T) ? 1 : 0; }
    int tot_g, tot_q; (void)tot_q;
    const int Eoff = block_excl_scan(q, F.lane, F.wave, red + 32, tot_q);
    int dummy; const int Goff = block_excl_scan(g, F.lane, F.wave, red + 32, tot_g); (void)Goff;
    const int need_eq = cap - tot_g;
    int eq_take = need_eq - Eoff; eq_take = eq_take < 0 ? 0 : (eq_take > q ? q : eq_take);
    const int base = block_excl_scan(g + eq_take, F.lane, F.wave, red + 32, dummy);
    int slot = base, eqseen = 0;
    const int tok0 = F.tid * PER;
#pragma unroll
    for (int i4 = 0; i4 < PER / 4; ++i4) { int so[4];
#pragma unroll
        for (int j = 0; j < 4; ++j) { const int i = 4 * i4 + j; const unsigned k = key[i]; bool sel = k > T; if (k == T) { sel = eqseen < eq_take; ++eqseen; }
            so[j] = sel ? slot : -1; if (sel) { idx_out[slot] = tok0 + i; gate_out[slot] = __uint_as_float(k); ++slot; } }
        ((int4*)(slotcol + tok0))[i4] = make_int4(so[0], so[1], so[2], so[3]); }
}
__device__ __forceinline__ void select_phase(Frame& F) {
    for (int it = F.c; it < 32; it += F.G) {
        const int grp = it >> 4, e = it & 15; const int n = grp ? NTS : NTP, cap = n / 8;
        const float* affcol = (const float*)(F.ws + WS_AFF) + (size_t)e * NT + (grp ? NTP : 0);
        int* idx = (int*)(F.ws + WS_IDX) + (grp ? 65536 : 0) + e * cap; float* gate = (float*)(F.ws + WS_GATE) + (grp ? 65536 : 0) + e * cap;
        int* slotcol = (int*)(F.ws + WS_SLOT) + (size_t)e * NT + (grp ? NTP : 0);
        __syncthreads();
        if (grp == 0) select_fast<64>(F, affcol, cap, idx, gate, slotcol); else select_fast<32>(F, affcol, cap, idx, gate, slotcol);
        __syncthreads();
    }
}

__device__ __forceinline__ void natten_fill(Frame& F, const float* rpb) {
    LAS float* rpbs = (LAS float*)F.lds;
    __syncthreads();
    for (int i = F.tid; i < 16 * 15 * 31; i += 512) rpbs[i] = rpb[i] * 1.4426950408889634f;
    __syncthreads();
}
__device__ __forceinline__ void natten_phase(Frame& F, const float* rpb) {
    const bf16_t* Kb = (const bf16_t*)(F.ws + PO_K); const bf16_t* VT = (const bf16_t*)(F.ws + PO_VT); bf16_t* QO = (bf16_t*)(F.ws + PO_Q);
    LAS float* rpbs = (LAS float*)F.lds;
    const int lane = F.lane, w = F.wave, fr = lane & 15, fq = lane >> 4;
    bool c0[4], c2[4]; int xe[4];
#pragma unroll
    for (int e = 0; e < 4; ++e) { xe[e] = 4 * fq + e - fr; c0[e] = xe[e] >= 8; c2[e] = xe[e] < -8; }
    const bool fA = fr < 8, fC = fr > 8;
    LAS bf16_t* Ks = (LAS bf16_t*)(F.lds + 32768); LAS bf16_t* Vs = Ks + 2 * 64 * 72;
    const int lrow = F.tid >> 3, lchk = F.tid & 7;
    for (int blk = F.c; blk < 1536; blk += F.G) {
        int gb, h, rb, rows;
        if (blk < 1024) { gb = blk >> 8; h = (blk >> 4) & 15; rb = blk & 15; rows = 128; } else { const int V = blk - 1024; gb = 4 + (V >> 7); h = (V >> 3) & 15; rb = V & 7; rows = 64; }
        const int r = rb * 8 + w;
        int rs = r - 4; rs = rs < 0 ? 0 : (rs > rows - 8 ? rows - 8 : rs);
        int kr_lo = rb * 8 - 4; kr_lo = kr_lo < 0 ? 0 : (kr_lo > rows - 8 ? rows - 8 : kr_lo);
        int kr_hi = rb * 8 + 7 - 4; kr_hi = (kr_hi < 0 ? 0 : (kr_hi > rows - 8 ? rows - 8 : kr_hi)) + 8;
        const size_t tb = (size_t)gb_tok0(gb), tq0 = tb + (size_t)r * 64;
        bf16x8 Qf[4][2];
        float mrun[4], lrun[4]; f32x4 Ot[4][4];
#pragma unroll
        for (int qt = 0; qt < 4; ++qt) { mrun[qt] = -INFINITY; lrun[qt] = 0.f;
#pragma unroll
            for (int dt = 0; dt < 4; ++dt) Ot[dt][qt] = (f32x4){0.f, 0.f, 0.f, 0.f}; }
        const bf16_t* kg = Kb + (tb + (size_t)kr_lo * 64 + lrow) * D + h * 64 + lchk * 8; const bf16_t* vg = VT + (size_t)(h * 64 + lrow) * NT + tb + (size_t)kr_lo * 64 + lchk * 8;
        const int nrows = kr_hi - kr_lo;
#define NA_LOAD(dst, ptr) asm volatile("global_load_dwordx4 %0, %1, off" : "=&v"(dst) : "v"(ptr) : "memory")
        u32x4 kA, vA, kB, vB;
        { const u32x4 k0r = *(const u32x4*)kg, v0r = *(const u32x4*)vg;
#pragma unroll
          for (int t = 0; t < 4; ++t)
#pragma unroll
              for (int ks = 0; ks < 2; ++ks) Qf[t][ks] = *(const bf16x8*)(QO + (tq0 + 16 * t + fr) * D + h * 64 + 32 * ks + 8 * fq);
          { const bf16_t* kp = kg + (size_t)64 * D; const bf16_t* vp = vg + 64; NA_LOAD(kB, kp); NA_LOAD(vB, vp); }
          __syncthreads();
          *(LAS u32x4*)(Ks + lrow * 72 + lchk * 8) = k0r; *(LAS u32x4*)(Vs + lrow * 72 + lchk * 8) = v0r; }
#pragma unroll
        for (int t = 0; t < 4; ++t)
#pragma unroll
            for (int ks = 0; ks < 2; ++ks) asm volatile("" :: "v"(Qf[t][ks]));
        asm volatile("s_waitcnt vmcnt(0)" ::: "memory");
        __syncthreads();
#pragma nounroll
        for (int i2 = 0; i2 < nrows; i2 += 2) {
#pragma unroll
          for (int jj = 0; jj < 2; ++jj) {
            const int i = i2 + jj; if (i >= nrows) break;
            const int kr = kr_lo + i; const int buf = jj; const bool more = i + 1 < nrows, more2 = i + 2 < nrows;
            if (more2) { const bf16_t* kp = kg + (size_t)(i + 2) * 64 * D; const bf16_t* vp = vg + (size_t)(i + 2) * 64;
                if (jj == 1) { NA_LOAD(kB, kp); NA_LOAD(vB, vp); } else { NA_LOAD(kA, kp); NA_LOAD(vA, vp); } }
            if (kr >= rs && kr < rs + 8) {
            const int dr = kr - r + 7;
            const LAS bf16_t* Kt = Ks + buf * (64 * 72); const LAS bf16_t* Vt = Vs + buf * (64 * 72);
            bf16x8 Kf[4][2];
#pragma unroll
            for (int t = 0; t < 4; ++t)
#pragma unroll
                for (int ks = 0; ks < 2; ++ks) Kf[t][ks] = *(const LAS bf16x8*)(Kt + (16 * t + fr) * 72 + 32 * ks + 8 * fq);
            float bsel[3][4];
#pragma unroll
            for (int e = 0; e < 4; ++e) { const int dcB = xe[e] + 15 + (c0[e] ? -16 : (c2[e] ? 16 : 0)), dcA = fA ? xe[e] + 15 : dcB, dcC = fC ? xe[e] + 15 : dcB;
                bsel[0][e] = rpbs[(h * 15 + dr) * 31 + dcA]; bsel[1][e] = rpbs[(h * 15 + dr) * 31 + dcB]; bsel[2][e] = rpbs[(h * 15 + dr) * 31 + dcC]; }
            bf16x8 Pf[4][2]; float alpha[4]; bool moved = false;
#pragma unroll
            for (int qt = 0; qt < 4; ++qt) {
                f32x4 St[3];
#pragma unroll
                for (int dk = 0; dk < 3; ++dk) { const int kt = qt + dk - 1; St[dk] = (f32x4){0.f, 0.f, 0.f, 0.f};
                    if (kt >= 0 && kt < 4) { St[dk] = __builtin_amdgcn_mfma_f32_16x16x32_bf16(Kf[kt][0], Qf[qt][0], St[dk], 0, 0, 0); St[dk] = __builtin_amdgcn_mfma_f32_16x16x32_bf16(Kf[kt][1], Qf[qt][1], St[dk], 0, 0, 0); } }
                constexpr int dummy = 0; (void)dummy;
                const int cls = qt == 0 ? 0 : (qt == 3 ? 2 : 1);
                float sv[4]; bool u0[4], u2[4]; float mx = -INFINITY;
#pragma unroll
                for (int e = 0; e < 4; ++e) { u0[e] = c0[e] && !(cls == 0 && fA) && !(cls == 2 && fC) && (qt > 0); u2[e] = c2[e] && !(cls == 0 && fA) && !(cls == 2 && fC) && (qt < 3);
                    sv[e] = (u0[e] ? St[0][e] : (u2[e] ? St[2][e] : St[1][e])) + bsel[cls][e]; mx = fmaxf(mx, sv[e]); }
                mx = x32_max(x16_max(mx));
                const float mnew = fmaxf(mrun[qt], mx); alpha[qt] = __builtin_amdgcn_exp2f(mrun[qt] - mnew); moved = moved || (mnew != mrun[qt]); mrun[qt] = mnew;
                float l = 0.f, p[4];
#pragma unroll
                for (int e = 0; e < 4; ++e) { p[e] = __builtin_amdgcn_exp2f(sv[e] - mnew); l += p[e]; }
                l = x32_sum(x16_sum(l)); lrun[qt] = lrun[qt] * alpha[qt] + l;
                float pv[4][4];
#pragma unroll
                for (int kt = 0; kt < 4; ++kt)
#pragma unroll
                    for (int e = 0; e < 4; ++e) { const int dk = kt - qt + 1; float v = 0.f; if (dk == 0) v = u0[e] ? p[e] : 0.f; else if (dk == 2) v = u2[e] ? p[e] : 0.f; else if (dk == 1) v = (u0[e] || u2[e]) ? 0.f : p[e]; pv[kt][e] = v; }
#pragma unroll
                for (int ks = 0; ks < 2; ++ks) { u32x4 wv; wv.x = cvt_pk_bf16_c(pv[2 * ks][0], pv[2 * ks][1]); wv.y = cvt_pk_bf16_c(pv[2 * ks][2], pv[2 * ks][3]); wv.z = cvt_pk_bf16_c(pv[2 * ks + 1][0], pv[2 * ks + 1][1]); wv.w = cvt_pk_bf16_c(pv[2 * ks + 1][2], pv[2 * ks + 1][3]);
                    Pf[qt][ks] = __builtin_bit_cast(bf16x8, wv); }
            }
            const bool rescale = __ballot(moved) != 0ull;
#pragma unroll
            for (int dt = 0; dt < 4; ++dt) {
                if (rescale) {
#pragma unroll
                    for (int qt = 0; qt < 4; ++qt) Ot[dt][qt] = Ot[dt][qt] * alpha[qt]; }
#pragma unroll
                for (int ks = 0; ks < 2; ++ks) { const u32x2 v0 = *(const LAS u32x2*)(Vt + (16 * dt + fr) * 72 + 32 * ks + 4 * fq), v1 = *(const LAS u32x2*)(Vt + (16 * dt + fr) * 72 + 32 * ks + 16 + 4 * fq);
                    u32x4 vv; vv.x = v0.x; vv.y = v0.y; vv.z = v1.x; vv.w = v1.y; const bf16x8 Vf = __builtin_bit_cast(bf16x8, vv);
#pragma unroll
                    for (int qt = 0; qt < 4; ++qt) { if ((qt == 0 && ks == 1) || (qt == 3 && ks == 0)) continue; Ot[dt][qt] = __builtin_amdgcn_mfma_f32_16x16x32_bf16(Vf, Pf[qt][ks], Ot[dt][qt], 0, 0, 0); } }
            }
            }
            if (more) {
                if (more2) asm volatile("s_waitcnt vmcnt(2)" ::: "memory"); else asm volatile("s_waitcnt vmcnt(0)" ::: "memory");
                LAS bf16_t* kd = Ks + (buf ^ 1) * (64 * 72) + lrow * 72 + lchk * 8; LAS bf16_t* vd = Vs + (buf ^ 1) * (64 * 72) + lrow * 72 + lchk * 8;
                if (jj == 1) { asm volatile("" : "+v"(kA), "+v"(vA)); *(LAS u32x4*)kd = kA; *(LAS u32x4*)vd = vA; } else { asm volatile("" : "+v"(kB), "+v"(vB)); *(LAS u32x4*)kd = kB; *(LAS u32x4*)vd = vB; }
            }
            __syncthreads();
          }
        }
#undef NA_LOAD
#pragma unroll
        for (int qt = 0; qt < 4; ++qt) { const float inv = 1.f / lrun[qt];
#pragma unroll
            for (int dt = 0; dt < 4; ++dt) { const f32x4 o = Ot[dt][qt] * inv; u32x2 wv; wv.x = cvt_pk_bf16_c(o[0], o[1]); wv.y = cvt_pk_bf16_c(o[2], o[3]);
                pst8(QO + (tq0 + 16 * qt + fr) * D + h * 64 + 16 * dt + 4 * fq, wv); } }
    }
    __syncthreads();
}
constexpr int N_PHASES = 31;
constexpr int FLAG_NO_XIMPORT = 1, FLAG_NO_EXPERTS0 = 2;
constexpr int CV_P1 = 3072, CV_P2 = CV_P1 + 1536, CV_SEL = CV_P2 + 5376, CV_SEL1 = 5376, CV_P0B = CV_SEL + 3584;
__global__ void __launch_bounds__(512, 2) fwd(Args args) {
    extern __shared__ __attribute__((aligned(16))) unsigned char lds_raw[];
    Frame F; F.lds = (LAS unsigned char*)lds_raw; F.ws = args.ws; F.in = args.in; F.out = args.out;
    F.tid = threadIdx.x; F.lane = F.tid & 63; F.wave = __builtin_amdgcn_readfirstlane(F.tid >> 6); F.G = gridDim.x; F.c = blockIdx.x; F.xok = false;
    unsigned char* ws = args.ws;
    const int wave_s = __builtin_amdgcn_readfirstlane(threadIdx.x >> 6);
    for (int u = F.tid; u < (LDS_BYTES - RING_BYTES) / 4; u += 512) ((LAS unsigned*)(F.lds + RING_BYTES))[u] = 0u;
    __syncthreads();
    const int lo = args.ph_lo, hi = args.ph_hi;
    volatile LAS unsigned* MISC = (volatile LAS unsigned*)(F.lds + MISC_OFF);
    XcdBarrier bar; bar.bar = (unsigned*)(ws + WS_CTL) + CW_BAR + args.pad * XCD_BAR_WORDS_EXT; bar.x = 0; bar.st = nullptr;
    const bool multi = (hi - lo) > 1;
    if (multi) bar = xcd_barrier_post((unsigned*)(ws + WS_CTL) + CW_BAR + args.pad * XCD_BAR_WORDS_EXT, MISC + 8);
#define IN(k) (lo <= (k) && (k) < hi)
#ifdef STAMP_PA
    unsigned long long* TS = (unsigned long long*)(ws + WS_CTL + 40 * 1024);
#define STAMP(k) do { if (blockIdx.x == 0 && threadIdx.x == 0) TS[k] = __builtin_amdgcn_s_memrealtime(); } while (0)
#else
#define STAMP(k) do { } while (0)
#endif
#ifdef AMP_PHASE
    unsigned long long t_phase0 = 0ull;
#define AMP_NOW(t) asm volatile("s_memrealtime %0\n\ts_waitcnt lgkmcnt(0)" : "=s"(t) :: "memory")
#define AMP_T0() do { AMP_NOW(t_phase0); } while (0)
#define AMP_WAIT(k) do { if ((k) == AMP_PHASE || AMP_PHASE < 0) { asm volatile("s_waitcnt vmcnt(0) lgkmcnt(0)" ::: "memory"); unsigned long long _t1; AMP_NOW(_t1); const unsigned long long _tw = _t1 + (unsigned long long)AMP_M * (_t1 - t_phase0); unsigned long long _tn; do { __builtin_amdgcn_s_sleep(4); AMP_NOW(_tn); } while (_tn < _tw); } } while (0)
#else
#define AMP_T0() do { } while (0)
#define AMP_WAIT(k) do { } while (0)
#endif
#define SEAM(k) do { AMP_WAIT(k); if (IN(k) && IN((k) + 1)) { xcd_barrier(bar, wave_s); STAMP((k) + 1); } } while (0)
    STAMP(0);
    LAS unsigned char* ring = F.lds;
#define PHASE_BEGIN() do { int _t; asm volatile("v_mbcnt_lo_u32_b32 %0, -1, 0\n\tv_mbcnt_hi_u32_b32 %0, -1, %0" : "=v"(_t)); _t |= (wave_s << 6); F.tid = _t; F.lane = _t & 63; F.wave = wave_s; AMP_T0(); } while (0)

#ifndef P0_SKIP
#define P0_SKIP 0
#endif
    if (IN(0)) { PHASE_BEGIN(); const int p0s = (args.pad == 1) ? P0_SKIP : 0;
        if (!(p0s & 1)) for (int it = F.c; it < 128; it += F.G) s5_build_item(F, it >> 1, it & 1);
        if (!(p0s & 2)) convert_small_weights(F);
        if (!(p0s & 4)) if (!(args.flags & FLAG_NO_EXPERTS0)) { convert_expert_weights(F, 0, CV_SEL, CV_P0B, 128);
            convert_expert_weights(F, 0, CV_P0B, 16 * 1536, 0); }
        if (!(p0s & 8)) { convert_plain(F, args.in[I_MWQ], (bf16_t*)(ws + WS_MWQ), (size_t)2 * 1024 * 1024);
        convert_plain(F, args.in[I_MEMP], (bf16_t*)(ws + WS_MEMB), (size_t)4 * 256 * 1024);
        convert_plain(F, args.in[I_MEMS], (bf16_t*)(ws + WS_MEMB) + (size_t)4 * 256 * 1024, (size_t)4 * 256 * 1024); }
        if (!(p0s & 16)) import_x(F, !(args.flags & FLAG_NO_XIMPORT));
    }
    SEAM(0);
    unsigned nloc_s = 32u;
    if (multi && IN(0) && IN(1)) {
        if (F.tid == 0) { unsigned ok = (F.G == 256) ? 1u : 0u; unsigned* bw = bar.bar;
            for (unsigned j = 0; j < 16; ++j) { const unsigned cnt = xb_ld(&bw[XB_XCNT(j)]); if (j < 8 ? cnt != 32u : cnt != 0u) ok = 0u; }
            MISC[13] = ok; }
        __syncthreads();
        if (MISC[13]) { F.xok = true; F.c = (int)(MISC[12] * 8u + bar.x); }
    }
#define LSEAM(k) do { AMP_WAIT(k); if (IN(k) && IN((k) + 1)) { if (F.xok) xcd_local_barrier(bar, wave_s, nloc_s); else xcd_barrier(bar, wave_s); STAMP((k) + 1); } } while (0)
    {
        const float* lng = args.in[I_LNG]; const float* lnb = args.in[I_LNB];
        if (IN(1)) { PHASE_BEGIN();
            { SchedKV S{ws, F.G, F.c}; EpiBf<false> E{2048u, 1.f}; gemm_phase<EpiBf<false>, SchedKV, false>(ring, F.tid, 1024, 2048u, 2048u, S, E); }
            { SchedUA S{(const char*)ws + WS_XB, (const char*)ws + WS_WIN, (char*)ws + PO_UA, F.G, F.c}; EpiUA E; gemm_phase<EpiUA, SchedUA, false>(ring, F.tid, 1024, 2048u, 2048u, S, E); }
            if (!(args.flags & FLAG_NO_EXPERTS0)) convert_expert_weights(F, 0, 0, CV_P1, 128);
        }
        SEAM(1);
        if (IN(2)) { PHASE_BEGIN();
            { SchedSA S{ws, F.G, F.c}; EpiS E; gemm_phase<EpiS, SchedSA, false>(ring, F.tid, 512, (unsigned)(UAK * 2), 1024u, S, E); }
            { SchedWqk S{ws, F.G, F.c}; EpiBf8 E{1024u, 0.0625f * 1.4426950408889634f * FP8_SWQK}; gemm_phase<EpiBf8, SchedWqk, false>(ring, F.tid, 256, 4096u, 2048u, S, E); }
            { SchedWvo S{ws, F.G, F.c}; EpiBf<false> E{1024u, 1.f}; gemm_phase<EpiBf<false>, SchedWvo, false>(ring, F.tid, 256, 2048u, 4096u, S, E); }
            if (!(args.flags & FLAG_NO_EXPERTS0)) convert_expert_weights(F, 0, CV_P1, CV_P2, 128);
        }
        SEAM(2);
        if (IN(3)) { PHASE_BEGIN(); s5_recurrence(F); }
        SEAM(3);
        if (IN(4)) { PHASE_BEGIN(); SchedSC S{ws, F.G, F.c}; EpiGelu E; gemm_phase<EpiGelu, SchedSC, false>(ring, F.tid, UAK, (unsigned)(UAK * 2), (unsigned)(UAK * 2), S, E); }
        SEAM(4);
        if (IN(5)) { PHASE_BEGIN(); SchedGated S{(const char*)ws + PO_SG, (const char*)ws + WS_WGLU, (char*)ws + PO_HB_S5, 2048, 2048, 1024, NT / BM, 8, F.G, F.c}; EpiGated<0> E{1024u};
            gemm_phase<EpiGated<0>, SchedGated, false>(ring, F.tid, 1024, 2048u, 2048u, S, E); }
        LSEAM(5);
        if (IN(6)) { PHASE_BEGIN(); if (args.flags & FLAG_NO_XIMPORT) ln_phase<0, false, false, false>(F, (const bf16_t*)(ws + PO_HB_S5), lng, lnb, nullptr); else ln_phase<0, false, false, true>(F, (const bf16_t*)(ws + PO_HB_S5), lng, lnb, nullptr); }
        LSEAM(6);
    }
#define COMMON_BLOCK(layer, pb) do { \
        const float* lng = args.in[I_LNG] + (size_t)(layer) * 3 * D; const float* lnb = args.in[I_LNB] + (size_t)(layer) * 3 * D; \
        if (IN((pb) + 0)) { PHASE_BEGIN(); SchedScores8 S{(const char*)ws + WS_XB8, (const char*)ws + WS_WQK + (size_t)(layer) * 8 * MiB, (char*)ws + PO_SB, F.G, F.c}; EpiSoftmax E{(LAS float*)(F.lds + RING_BYTES + 4096), 1024u, 1.f / (FP8_SX * FP8_SWQK)}; \
            gemm_phase<EpiSoftmax, SchedScores8, false, true>(ring, F.tid, 512, 1024u, 1024u, S, E); } \
        AMP_WAIT((pb) + 0); if (IN((pb) + 0) && IN((pb) + 2)) { if (F.xok) xcd_local_barrier(bar, wave_s, nloc_s); else xcd_barrier(bar, wave_s); STAMP((pb) + 1); }     \
        if (IN((pb) + 2)) { PHASE_BEGIN(); SchedBatchW S{(const char*)ws + PO_SB, (const char*)ws + WS_WVO + (size_t)(layer) * 16 * MiB, (char*)ws + PO_HB_MEM, F.G, F.c}; EpiBf<false> E{1024u, 1.f}; \
            gemm_phase<EpiBf<false>, SchedBatchW, false>(ring, F.tid, 1024, 2048u, 2048u, S, E); } \
        if (IN((pb) + 3)) { PHASE_BEGIN(); ln_router_fill(F, lng + D, lnb + D, args.in[I_EWR] + (size_t)(layer) * D * 16); }     \
        LSEAM((pb) + 2); \
        if (IN((pb) + 3)) { PHASE_BEGIN(); ln_phase<0, true, false>(F, (const bf16_t*)(ws + PO_HB_MEM), lng + D, lnb + D, args.in[I_EWR] + (size_t)(layer) * D * 16); } \
        SEAM((pb) + 3); \
        if (IN((pb) + 4)) { PHASE_BEGIN(); select_phase(F); if ((layer) == 0) { if (!(args.flags & FLAG_NO_EXPERTS0)) convert_expert_weights(F, 0, CV_P2, CV_SEL, 32); } else convert_expert_weights(F, 1, 0, CV_SEL1, 32); } \
        SEAM((pb) + 4); \
        if (IN((pb) + 5)) { PHASE_BEGIN(); SchedUp S{ws, F.G, F.c}; EpiGated8 E{2048u}; gemm_phase<EpiGated8, SchedUp, true, true>(ring, F.tid, 512, 1024u, 1024u, S, E); } \
        LSEAM((pb) + 5);     \
        if (IN((pb) + 6)) { PHASE_BEGIN(); SchedDown S{ws, F.G, F.c}; EpiBf<true> E{1024u, 1.f / (FP8_SH * FP8_SW2)}; gemm_phase<EpiBf<true>, SchedDown, false, true>(ring, F.tid, 1024, 2048u, 2048u, S, E); } \
        AMP_WAIT((pb) + 6); if (IN((pb) + 6) && IN((pb) + 9)) { xcd_barrier(bar, wave_s); STAMP((pb) + 9); }     \
    } while (0)
    COMMON_BLOCK(0, 7);
    if (IN(16)) { PHASE_BEGIN(); ln_phase<1, false, false>(F, nullptr, args.in[I_LNG] + 2 * D, args.in[I_LNB] + 2 * D, nullptr); convert_expert_weights(F, 1, CV_SEL1, 16 * 1536, 0); }
    SEAM(16);
    {
        const float* lng = args.in[I_LNG] + 3 * D; const float* lnb = args.in[I_LNB] + 3 * D;
        if (IN(17)) { PHASE_BEGIN(); SchedQKV S{ws, F.G, F.c}; EpiQKV E; gemm_phase<EpiQKV, SchedQKV, false, true>(ring, F.tid, 512, 1024u, 1024u, S, E); }
        if (IN(18)) { PHASE_BEGIN(); natten_fill(F, args.in[I_BRPB]); }
        SEAM(17);
        if (IN(18)) { PHASE_BEGIN(); natten_phase(F, args.in[I_BRPB]); }
        SEAM(18);
        if (IN(19)) { PHASE_BEGIN(); SchedPlain S{(const char*)ws + PO_Q, (const char*)ws + WS_WO, (char*)ws + PO_HB_NA, 2048, 2048, 1024, NT / BM, 4, F.G, F.c}; EpiBf<false> E{1024u, 1.f};
            gemm_phase<EpiBf<false>, SchedPlain, false>(ring, F.tid, 1024, 2048u, 2048u, S, E); }
        LSEAM(19);
        if (IN(20)) { PHASE_BEGIN(); ln_phase<0, false, false>(F, (const bf16_t*)(ws + PO_HB_NA), lng, lnb, nullptr); }
        LSEAM(20);
    }
    COMMON_BLOCK(1, 21);
    if (IN(30)) { PHASE_BEGIN(); ln_phase<1, false, true>(F, nullptr, args.in[I_LNG] + 5 * D, args.in[I_LNB] + 5 * D, nullptr); }
    AMP_WAIT(30);
#undef COMMON_BLOCK
#ifdef STAMP_PA
    xcd_barrier(bar, wave_s); STAMP(31); xcd_barrier(bar, wave_s);
    {
        const volatile unsigned long long* T = TS; const float dA = (float)(T[STAMP_PA + STAMP_NA] - T[STAMP_PA]) * 0.01f, dB = (float)(T[STAMP_PB + STAMP_NB] - T[STAMP_PB]) * 0.01f;
        const float c = sqrtf(100.f * dA), V = 100.f * dB; const size_t np = (size_t)NTP * 1024, n = (size_t)NT * 1024;
        for (size_t i = (size_t)blockIdx.x * 512 + threadIdx.x; i < n; i += (size_t)gridDim.x * 512) args.out[i] = i < np ? c : (i == np ? V : 0.f);
    }
#endif
#undef IN
#undef SEAM
}
}
#ifndef DBG
#define DBG 0
#endif
#ifndef FZ_PER_PHASE
#define FZ_PER_PHASE 0
#endif

#if DBG
namespace dbg {
__global__ void k_cmp_bf16_f32(const unsigned short* a, const float* b, size_t n, double* acc) {
    double s0 = 0, s1 = 0;
    for (size_t i = (size_t)blockIdx.x * blockDim.x + threadIdx.x; i < n; i += (size_t)gridDim.x * blockDim.x) { const double x = (double)__uint_as_float(((unsigned)a[i]) << 16), y = b[i]; s0 += (x - y) * (x - y); s1 += y * y; }
    for (int o = 32; o >= 1; o >>= 1) { s0 += __shfl_xor(s0, o); s1 += __shfl_xor(s1, o); }
    if ((threadIdx.x & 63) == 0) { atomicAdd(acc, s0); atomicAdd(acc + 1, s1); }
}
__global__ void k_cmp_f32_f32(const float* a, const float* b, size_t n, double* acc) {
    double s0 = 0, s1 = 0;
    for (size_t i = (size_t)blockIdx.x * blockDim.x + threadIdx.x; i < n; i += (size_t)gridDim.x * blockDim.x) { const double x = a[i], y = b[i]; s0 += (x - y) * (x - y); s1 += y * y; }
    for (int o = 32; o >= 1; o >>= 1) { s0 += __shfl_xor(s0, o); s1 += __shfl_xor(s1, o); }
    if ((threadIdx.x & 63) == 0) { atomicAdd(acc, s0); atomicAdd(acc + 1, s1); }
}
__global__ void k_cmp_ua(const unsigned short* UA, const float* u, double* acc) {
    double s0 = 0, s1 = 0;
    for (size_t i = (size_t)blockIdx.x * blockDim.x + threadIdx.x; i < (size_t)fz::NT * 1024; i += (size_t)gridDim.x * blockDim.x) {
        const int tok = (int)(i >> 10), ch = (int)(i & 1023), chunk = tok >> 5, j = tok & 31, g = ch >> 4, h = ch & 15;
        const double x = (double)__uint_as_float(((unsigned)UA[((size_t)g * fz::NCHUNK + chunk) * fz::UAK + j * 16 + h]) << 16), y = u[i]; s0 += (x - y) * (x - y); s1 += y * y; }
    for (int o = 32; o >= 1; o >>= 1) { s0 += __shfl_xor(s0, o); s1 += __shfl_xor(s1, o); }
    if ((threadIdx.x & 63) == 0) { atomicAdd(acc, s0); atomicAdd(acc + 1, s1); }
}
__global__ void k_encode(float* out, const double* accA, const double* accB) {
    const double vA = accA[1] > 0 ? sqrt(accA[0] / accA[1]) : 9.99; const double vB = accB[1] > 0 ? sqrt(accB[0] / accB[1]) : 9.99;
    const float c = (float)sqrt(1e8 * (vA == vA ? vA : 7.77)); const float V = (float)(1e5 * (vB == vB ? vB : 7.77));
    const size_t np = (size_t)fz::NTP * 1024, n = (size_t)fz::NT * 1024;
    for (size_t i = (size_t)blockIdx.x * blockDim.x + threadIdx.x; i < n; i += (size_t)gridDim.x * blockDim.x) out[i] = i < np ? c : (i == np ? V : 0.f);
}
}
#endif

extern "C" void kernel_launch(void* const* d_in, const int* in_sizes, int n_in, void* d_out, int out_size, void* d_ws, size_t ws_size, hipStream_t stream) {
    using namespace fz;
    static int grid = 0;
    if (grid == 0) {
        if (n_in != 26 || ws_size < WS_END) { fprintf(stderr, "kernel_launch: unexpected inputs (n_in %d, ws %zu)\n", n_in, ws_size); grid = -1; return; }
        int dev = 0, cus = 0, per_cu = 0;
        if (hipGetDevice(&dev) != hipSuccess || hipDeviceGetAttribute(&cus, hipDeviceAttributeMultiprocessorCount, dev) != hipSuccess) { grid = -1; return; }
        if (hipFuncSetAttribute((const void*)fwd, hipFuncAttributeMaxDynamicSharedMemorySize, LDS_BYTES) != hipSuccess) { fprintf(stderr, "kernel_launch: hipFuncSetAttribute failed\n"); grid = -1; return; }
        if (hipOccupancyMaxActiveBlocksPerMultiprocessor(&per_cu, (const void*)fwd, 512, LDS_BYTES) != hipSuccess || per_cu < 1) { fprintf(stderr, "kernel_launch: occupancy query says %d\n", per_cu); }
        (void)hipGetLastError();
        grid = cus;
    }
    if (grid < 0) return;
    unsigned char* ws = (unsigned char*)d_ws;
    (void)hipMemsetAsync(ws + WS_CTL, 0, CTL_ZERO_BYTES, stream);
    Args a{};
    for (int i = 0; i < 26; ++i) a.in[i] = (const float*)d_in[i];
    a.out = (float*)d_out; a.ws = ws; a.flags = 0; a.pad = 0;
    auto run = [&](int lo, int hi) { a.ph_lo = lo; a.ph_hi = hi; hipLaunchKernelGGL(fwd, dim3(grid), dim3(512), LDS_BYTES, stream, a); };
#if DBG == 0
#ifdef PRE_LO
    a.pad = 1; run(PRE_LO, PRE_HI); a.pad = 0;
#endif
#if FZ_PER_PHASE
    for (int p = 0; p < N_PHASES; ++p) run(p, p + 1);
#else
    run(0, N_PHASES);
#endif
#else
    using nv::SG;
    const float* const* in = (const float* const*)d_in;
    const size_t BIG = (size_t)NT * D;
    double* ACC = (double*)(ws + 32 * 1024);
    float* nmisc = (float*)(ws + 987 * MiB);
    float* nKV = nmisc; float* nAFF = nmisc + 4u * 1024 * 1024; float* nGATE = nAFF + 1024 * 1024; int* nIDX = (int*)(nGATE + 128 * 1024); float* nMEMC = (float*)(ws + 385 * MiB);
    auto sgemm = [&](const float* A, const float* B, float* C, const int* gidx, int M, int N, int K, long sam, long sak, long sbk, long sbn, long ldc,
                     int nz = 1, int zdiv = 1, long zA0 = 0, long zA1 = 0, long zB0 = 0, long zB1 = 0, long zC0 = 0, long zC1 = 0) {
        SG s{A, B, C, gidx, M, N, K, zdiv, sam, sak, sbk, sbn, ldc, zA0, zA1, zB0, zB1, zC0, zC1};
        hipLaunchKernelGGL(nv::k_sgemm, dim3(N / 128, M / 128, nz), dim3(256), 0, stream, s);
    };
    const int EW = (int)((BIG + 255) / 256);
    auto n_import = [&](float* X) { hipMemcpyAsync(X, in[I_XP], (size_t)NTP * D * 4, hipMemcpyDeviceToDevice, stream); hipMemcpyAsync(X + (size_t)NTP * D, in[I_XS], (size_t)NTS * D * 4, hipMemcpyDeviceToDevice, stream);
        hipMemcpyAsync(nMEMC, in[I_MEMP], (size_t)4 * 256 * D * 4, hipMemcpyDeviceToDevice, stream); hipMemcpyAsync(nMEMC + (size_t)4 * 256 * D, in[I_MEMS], (size_t)4 * 256 * D * 4, hipMemcpyDeviceToDevice, stream); };
    auto n_s5 = [&](float* X, float* T1, float* T2, float* T3) {
        sgemm(X, in[I_AWIN], T1, nullptr, NT, D, D, D, 1, D, 1, D);
        hipLaunchKernelGGL(nv::k_s5_scan, dim3(8 * 64 * 2), dim3(64), 0, stream, T1, T2, in[I_ALRE], in[I_ALIM], in[I_ALDT], in[I_ABRE], in[I_ABIM], in[I_ACRE], in[I_ACIM]);
        hipLaunchKernelGGL(nv::k_s5_gelu, dim3(EW), dim3(256), 0, stream, T1, T2, in[I_AD], T2);
        sgemm(T2, in[I_AWGLU], T1, nullptr, NT, D, D, D, 1, 2 * D, 1, D);
        sgemm(T2, in[I_AWGLU] + D, T3, nullptr, NT, D, D, D, 1, 2 * D, 1, D);
        hipLaunchKernelGGL(nv::k_glu, dim3(EW), dim3(256), 0, stream, T1, T3, T1);
    };
    auto n_na = [&](float* X, float* T1, float* T2, float* T3) {
        sgemm(X, in[I_BWQKV], T1, nullptr, NT, D, D, D, 1, 3 * D, 1, D); sgemm(X, in[I_BWQKV] + D, T2, nullptr, NT, D, D, D, 1, 3 * D, 1, D); sgemm(X, in[I_BWQKV] + 2 * D, T3, nullptr, NT, D, D, D, 1, 3 * D, 1, D);
        hipLaunchKernelGGL(nv::k_natten, dim3(NT * 16 / 4), dim3(256), 0, stream, T1, T2, T3, in[I_BRPB]);
        sgemm(T1, in[I_BWO], T2, nullptr, NT, D, D, D, 1, D, 1, D);
    };
    auto n_ln = [&](float* X, const float* h, int layer, int sub, float* xo) { hipLaunchKernelGGL(nv::k_res_ln, dim3(NT / 4), dim3(256), 0, stream, X, h, in[I_LNG] + (layer * 3 + sub) * D, in[I_LNB] + (layer * 3 + sub) * D, xo, NT); };
    auto n_mem = [&](float* X, float* T1, float* T2, float* T3, int layer) {
        const float* wq = in[I_MWQ] + (size_t)layer * D * D; const float* wkv = in[I_MWKV] + (size_t)layer * D * 2 * D; const float* wo = in[I_MWO] + (size_t)layer * D * D;
        sgemm(nMEMC, wkv, nKV, nullptr, 8 * 256, 2 * D, D, D, 1, 2 * D, 1, 2 * D);
        sgemm(X, wq, T1, nullptr, NT, D, D, D, 1, D, 1, D);
        for (int grp = 0; grp < 2; ++grp) { const int L = grp ? 4096 : 8192; const size_t tb = grp ? (size_t)NTP : 0; const int gb0 = grp * 4;
            sgemm(T1 + tb * D, nKV + (size_t)gb0 * 256 * 2 * D, T2 + tb * D, nullptr, L, 256, 256, D, 1, 1, 2 * D, D, 16, 4, (long)L * D, 256, (long)256 * 2 * D, 256, (long)L * D, 256); }
        hipLaunchKernelGGL(nv::k_softmax256, dim3(NT * 4 / 4), dim3(256), 0, stream, T2, 0.0625f, NT * 4);
        for (int grp = 0; grp < 2; ++grp) { const int L = grp ? 4096 : 8192; const size_t tb = grp ? (size_t)NTP : 0; const int gb0 = grp * 4;
            sgemm(T2 + tb * D, nKV + (size_t)gb0 * 256 * 2 * D + D, T3 + tb * D, nullptr, L, 256, 256, D, 1, 2 * D, 1, D, 16, 4, (long)L * D, 256, (long)256 * 2 * D, 256, (long)L * D, 256); }
        sgemm(T3, wo, T1, nullptr, NT, D, D, D, 1, D, 1, D);
    };
    auto n_moe = [&](float* X, float* T1, float* T2, float* T3, int layer) {
        hipLaunchKernelGGL(nv::k_router, dim3(NT / 4), dim3(256), 0, stream, X, in[I_EWR] + (size_t)layer * D * 16, nAFF, NT);
        hipLaunchKernelGGL(nv::k_select, dim3(32), dim3(512), 0, stream, nAFF, nIDX, nGATE);
        hipMemsetAsync(T1, 0, BIG * 4, stream);
        for (int grp = 0; grp < 2; ++grp) { const int n = grp ? NTS : NTP, cap = n / 8; const size_t tb = grp ? (size_t)NTP : 0;
            for (int e = 0; e < 16; ++e) { const int* idx = nIDX + (grp ? 16 * 4096 : 0) + e * cap; const float* gate = nGATE + (grp ? 16 * 4096 : 0) + e * cap;
                const float* w1 = in[I_EW1] + ((size_t)layer * 16 + e) * D * 2048; const float* w3 = in[I_EW3] + ((size_t)layer * 16 + e) * D * 2048; const float* w2 = in[I_EW2] + ((size_t)layer * 16 + e) * 2048 * D;
                float* H1 = T2; float* H3 = T2 + (size_t)4096 * 2048; float* YE = T3;
                sgemm(X + tb * D, w1, H1, idx, cap, 2048, D, D, 1, 2048, 1, 2048); sgemm(X + tb * D, w3, H3, idx, cap, 2048, D, D, 1, 2048, 1, 2048);
                hipLaunchKernelGGL(nv::k_silu_mul, dim3((unsigned)(((size_t)cap * 2048 + 255) / 256)), dim3(256), 0, stream, H1, H3, (size_t)cap * 2048);
                sgemm(H1, w2, YE, nullptr, cap, D, 2048, 2048, 1, D, 1, D);
                hipLaunchKernelGGL(nv::k_scatter_add, dim3((unsigned)(((size_t)cap * D + 255) / 256)), dim3(256), 0, stream, YE, idx, gate, T1 + tb * D, cap); } }
    };
    float* X = (float*)(ws + WS_XF); float* T1 = (float*)(ws + WS_EW13); float* T2 = (float*)(ws + WS_POOL); float* T3 = (float*)(ws + WS_POOL + 192 * MiB);
    auto cmp_bf = [&](size_t off_bf16, const float* ref, double* acc) { hipLaunchKernelGGL(dbg::k_cmp_bf16_f32, dim3(2048), dim3(256), 0, stream, (const unsigned short*)(ws + off_bf16), ref, BIG, acc); };
#if DBG == 1
    n_import(X);
    a.flags = FLAG_NO_XIMPORT | FLAG_NO_EXPERTS0;
    n_s5(X, T1, T2, T3);
    for (int p = 0; p <= 5; ++p) run(p, p + 1);
    cmp_bf(PO_HB_S5, T1, ACC);
    cmp_bf(PO_HB_S5, T1, ACC + 2);
#elif DBG == 11
    n_import(X);
    a.flags = FLAG_NO_XIMPORT | FLAG_NO_EXPERTS0;
    sgemm(X, in[I_AWIN], T1, nullptr, NT, D, D, D, 1, D, 1, D);
    for (int p = 0; p <= 4; ++p) run(p, p + 1);
    hipLaunchKernelGGL(dbg::k_cmp_ua, dim3(2048), dim3(256), 0, stream, (const unsigned short*)(ws + PO_UA), T1, ACC);
    hipMemcpyAsync(X, T1, BIG * 4, hipMemcpyDeviceToDevice, stream);
    { float* Y = (float*)(ws + 193 * MiB);
      hipLaunchKernelGGL(nv::k_s5_scan, dim3(8 * 64 * 2), dim3(64), 0, stream, X, Y, in[I_ALRE], in[I_ALIM], in[I_ALDT], in[I_ABRE], in[I_ABIM], in[I_ACRE], in[I_ACIM]);
      hipLaunchKernelGGL(nv::k_s5_gelu, dim3(EW), dim3(256), 0, stream, X, Y, in[I_AD], Y);
      cmp_bf(PO_SG, Y, ACC + 2); }
#elif DBG == 2
    n_import(X); n_s5(X, T1, T2, T3); n_ln(X, T1, 0, 0, X); n_mem(X, T1, T2, T3, 0);
    a.flags = FLAG_NO_XIMPORT | FLAG_NO_EXPERTS0;
    run(0, 1); run(1, 2); run(2, 3); run(7, 8); run(9, 10);
    cmp_bf(PO_HB_MEM, T1, ACC); cmp_bf(PO_HB_MEM, T1, ACC + 2);
#elif DBG == 4
    n_import(X); n_na(X, T1, T2, T3);
    hipMemcpyAsync(T1, T2, BIG * 4, hipMemcpyDeviceToDevice, stream);
    a.flags = FLAG_NO_XIMPORT | FLAG_NO_EXPERTS0;
    run(0, 1); run(17, 18); run(18, 19); run(19, 20);
    cmp_bf(PO_HB_NA, T1, ACC); cmp_bf(PO_HB_NA, T1, ACC + 2);
#endif
    hipLaunchKernelGGL(dbg::k_encode, dim3(2048), dim3(256), 0, stream, (float*)d_out, ACC, ACC + 2);
#endif
}
```

```cpp
#include <hip/hip_runtime.h>
#include <cstdio>
#include <cstdint>
#include <cmath>
#define NO_WT 1
namespace nv {
constexpr int D = 1024, NTP = 32768, NTS = 16384, NT = NTP + NTS, NGB = 8, MEM = 256;
constexpr int GRID_W = 64;
constexpr float ALPHA = 1.41421356237309515f;
constexpr float LN_EPS = 1e-5f;

__host__ __device__ inline int gb_tok0(int gb) { return gb < 4 ? gb * 8192 : NTP + (gb - 4) * 4096; }
__host__ __device__ inline int gb_len(int gb) { return gb < 4 ? 8192 : 4096; }

__device__ __forceinline__ float wave_sum(float v) {
#pragma unroll
    for (int o = 1; o < 64; o <<= 1) v += __shfl_xor(v, o);
    return v;
}
__device__ __forceinline__ float wave_max(float v) {
#pragma unroll
    for (int o = 1; o < 64; o <<= 1) v = fmaxf(v, __shfl_xor(v, o));
    return v;
}

struct SG { const float* A; const float* B; float* C; const int* gidx; int M, N, K, zdiv; long sam, sak, sbk, sbn, ldc; long zA0, zA1, zB0, zB1, zC0, zC1; };
__global__ __launch_bounds__(256) void k_sgemm(SG a) {
    __shared__ float As[8][132];
    __shared__ float Bs[8][132];
    const int z = blockIdx.z, z0 = z / a.zdiv, z1 = z % a.zdiv;
    const float* A = a.A + z0 * a.zA0 + z1 * a.zA1;
    const float* B = a.B + z0 * a.zB0 + z1 * a.zB1;
    float* C = a.C + z0 * a.zC0 + z1 * a.zC1;
    const int bm = blockIdx.y * 128, bn = blockIdx.x * 128, tid = threadIdx.x, tx = tid & 15, ty = tid >> 4;
    float acc[8][8];
#pragma unroll
    for (int i = 0; i < 8; ++i)
#pragma unroll
        for (int j = 0; j < 8; ++j) acc[i][j] = 0.f;
    const int arow_l = tid >> 1, akk = (tid & 1) * 4;
    const long arow = a.gidx ? (long)a.gidx[bm + arow_l] : (long)(bm + arow_l);
    const float* Ap = A + arow * a.sam;
    const int bkk = tid >> 5, bnn = (tid & 31) * 4;
    for (int k0 = 0; k0 < a.K; k0 += 8) {
        float av[4], bv[4];
#pragma unroll
        for (int i = 0; i < 4; ++i) av[i] = Ap[(long)(k0 + akk + i) * a.sak];
#pragma unroll
        for (int i = 0; i < 4; ++i) bv[i] = B[(long)(k0 + bkk) * a.sbk + (long)(bn + bnn + i) * a.sbn];
        __syncthreads();
#pragma unroll
        for (int i = 0; i < 4; ++i) As[akk + i][arow_l] = av[i];
#pragma unroll
        for (int i = 0; i < 4; ++i) Bs[bkk][bnn + i] = bv[i];
        __syncthreads();
#pragma unroll
        for (int kk = 0; kk < 8; ++kk) {
            float x[8], y[8];
#pragma unroll
            for (int i = 0; i < 8; ++i) x[i] = As[kk][ty * 8 + i];
#pragma unroll
            for (int j = 0; j < 8; ++j) y[j] = Bs[kk][tx * 8 + j];
#pragma unroll
            for (int i = 0; i < 8; ++i)
#pragma unroll
                for (int j = 0; j < 8; ++j) acc[i][j] += x[i] * y[j];
        }
    }
#pragma unroll
    for (int i = 0; i < 8; ++i)
#pragma unroll
        for (int j = 0; j < 8; ++j) C[(long)(bm + ty * 8 + i) * a.ldc + bn + tx * 8 + j] = acc[i][j];
}

__global__ __launch_bounds__(64) void k_s5_scan(const float* __restrict__ u, float* __restrict__ ydir, const float* lam_re, const float* lam_im, const float* log_dt,
                                                const float* b_re, const float* b_im, const float* c_re, const float* c_im) {
    const int wid = blockIdx.x;
    const int dir = wid & 1, g = (wid >> 1) & 63, gb = wid >> 7;
    const int p = threadIdx.x;
    const int L = gb_len(gb), t0 = gb_tok0(gb);
    const double dt = exp((double)log_dt[dir * 64 + g]);
    const double lr = lam_re[(dir * 64 + g) * 64 + p], li = lam_im[(dir * 64 + g) * 64 + p];
    const double er = exp(lr * dt), lbr = er * cos(li * dt), lbi = er * sin(li * dt);
    const double nr = lbr - 1.0, ni = lbi, den = lr * lr + li * li;
    const double fr = (nr * lr + ni * li) / den, fi = (ni * lr - nr * li) / den;
    float Br[16], Bi[16], Cr[16], Ci[16];
#pragma unroll
    for (int h = 0; h < 16; ++h) {
        const double br = b_re[((dir * 64 + g) * 64 + p) * 16 + h], bi = b_im[((dir * 64 + g) * 64 + p) * 16 + h];
        Br[h] = (float)(fr * br - fi * bi); Bi[h] = (float)(fr * bi + fi * br);
        Cr[h] = c_re[((dir * 64 + g) * 16 + h) * 64 + p]; Ci[h] = c_im[((dir * 64 + g) * 16 + h) * 64 + p];
    }
    const float ar = (float)lbr, ai = (float)lbi;
    float hr = 0.f, hi = 0.f;
    float* yo = ydir + (size_t)dir * NT * D;
    for (int s = 0; s < L; ++s) {
        const int t = dir ? (L - 1 - s) : s;
        const float* ur = u + (size_t)(t0 + t) * D + g * 16;
        float bur = 0.f, bui = 0.f;
#pragma unroll
        for (int h = 0; h < 16; ++h) { const float uv = ur[h]; bur += uv * Br[h]; bui += uv * Bi[h]; }
        const float nhr = ar * hr - ai * hi + bur, nhi = ar * hi + ai * hr + bui;
        hr = nhr; hi = nhi;
        float mine = 0.f;
#pragma unroll
        for (int c = 0; c < 16; ++c) { const float v = wave_sum(Cr[c] * hr - Ci[c] * hi); if (p == c) mine = v; }
        if (p < 16) yo[(size_t)(t0 + t) * D + g * 16 + p] = mine;
    }
}
__global__ void k_s5_gelu(const float* u, const float* ydir, const float* dskip, float* gout) {
    const size_t i = (size_t)blockIdx.x * blockDim.x + threadIdx.x;
    if (i >= (size_t)NT * D) return;
    const float y = dskip[i & (D - 1)] * u[i] + ydir[i] + ydir[(size_t)NT * D + i];
    const float c = 0.7978845608028654f * (y + 0.044715f * y * y * y);
    gout[i] = 0.5f * y * (1.f + tanhf(c));
}
__global__ void k_glu(const float* z1, const float* z2, float* out) {
    const size_t i = (size_t)blockIdx.x * blockDim.x + threadIdx.x;
    if (i >= (size_t)NT * D) return;
    out[i] = z1[i] / (1.f + expf(-z2[i]));
}
__global__ __launch_bounds__(256) void k_res_ln(const float* x, const float* h, const float* g, const float* b, float* xo, int rows) {
    const int row = blockIdx.x * 4 + (threadIdx.x >> 6), lane = threadIdx.x & 63;
    if (row >= rows) return;
    float v[16]; float s = 0.f;
#pragma unroll
    for (int j = 0; j < 16; ++j) { const size_t i = (size_t)row * D + lane + 64 * j; v[j] = ALPHA * x[i] + h[i]; s += v[j]; }
    const float mean = wave_sum(s) * (1.f / D); float q = 0.f;
#pragma unroll
    for (int j = 0; j < 16; ++j) { v[j] -= mean; q += v[j] * v[j]; }
    const float rstd = 1.f / sqrtf(wave_sum(q) * (1.f / D) + LN_EPS);
#pragma unroll
    for (int j = 0; j < 16; ++j) { const int c = lane + 64 * j; xo[(size_t)row * D + c] = v[j] * rstd * g[c] + b[c]; }
}
__global__ __launch_bounds__(256) void k_softmax256(float* s, float scale, int rows) {
    const int row = blockIdx.x * 4 + (threadIdx.x >> 6), lane = threadIdx.x & 63;
    if (row >= rows) return;
    float v[4]; float m = -INFINITY;
#pragma unroll
    for (int j = 0; j < 4; ++j) { v[j] = s[(size_t)row * 256 + lane + 64 * j] * scale; m = fmaxf(m, v[j]); }
    m = wave_max(m); float l = 0.f;
#pragma unroll
    for (int j = 0; j < 4; ++j) { v[j] = expf(v[j] - m); l += v[j]; }
    l = wave_sum(l);
#pragma unroll
    for (int j = 0; j < 4; ++j) s[(size_t)row * 256 + lane + 64 * j] = v[j] / l;
}
__global__ __launch_bounds__(256) void k_router(const float* x, const float* wr, float* aff, int rows) {
    const int row = blockIdx.x * 4 + (threadIdx.x >> 6), lane = threadIdx.x & 63;
    if (row >= rows) return;
    float acc[16];
#pragma unroll
    for (int e = 0; e < 16; ++e) acc[e] = 0.f;
    for (int j = 0; j < 16; ++j) { const int k = lane + 64 * j; const float xv = x[(size_t)row * D + k];
#pragma unroll
        for (int e = 0; e < 16; ++e) acc[e] += xv * wr[k * 16 + e]; }
    float m = -INFINITY;
#pragma unroll
    for (int e = 0; e < 16; ++e) { acc[e] = wave_sum(acc[e]); m = fmaxf(m, acc[e]); }
    float l = 0.f;
#pragma unroll
    for (int e = 0; e < 16; ++e) { acc[e] = expf(acc[e] - m); l += acc[e]; }
    float mine = 0.f;
#pragma unroll
    for (int e = 0; e < 16; ++e) if (lane == e) mine = acc[e] / l;
    if (lane < 16) aff[(size_t)row * 16 + lane] = mine;
}

__device__ __forceinline__ void select_expert(const float* aff, int n, int e, int cap, int* idx_out, float* gate_out, int* slot_of  , unsigned* hist  , unsigned* wsum  , unsigned* bc  ) {
    const int tid = threadIdx.x, nth = blockDim.x, lane = tid & 63, wv = tid >> 6, nw = nth >> 6;
    unsigned prefix = 0u, mask = 0u; unsigned remaining = (unsigned)cap;
    for (int pass = 0; pass < 4; ++pass) {
        const int shift = 24 - 8 * pass;
        for (int i = tid; i < 256; i += nth) hist[i] = 0u;
        __syncthreads();
        for (int t = tid; t < n; t += nth) { const unsigned key = __float_as_uint(aff[(size_t)t * 16 + e]); if ((key & mask) == prefix) atomicAdd(&hist[(key >> shift) & 255u], 1u); }
        __syncthreads();
        if (tid == 0) { unsigned cum = 0u; int b = 255; for (; b > 0; --b) { if (cum + hist[b] >= remaining) break; cum += hist[b]; } bc[0] = (unsigned)b; bc[1] = remaining - cum; }
        __syncthreads();
        prefix |= bc[0] << shift; mask |= 0xffu << shift; remaining = bc[1];
        __syncthreads();
    }
    const unsigned T = prefix; const unsigned need_eq = remaining;
    unsigned base = 0u, eqbase = 0u;
    for (int s0 = 0; s0 < n; s0 += nth) {
        const int t = s0 + tid; const bool in = t < n;
        const float a = in ? aff[(size_t)t * 16 + e] : 0.f; const unsigned key = __float_as_uint(a);
        const bool gt = in && key > T, eq = in && key == T;
        const unsigned long long meq = __ballot(eq); const unsigned eqr_w = __popcll(meq & ((1ull << lane) - 1ull));
        if (lane == 0) wsum[wv] = __popcll(meq);
        __syncthreads();
        unsigned eqoff = 0u, eqtot = 0u; for (int w = 0; w < nw; ++w) { const unsigned c = wsum[w]; if (w < wv) eqoff += c; eqtot += c; }
        __syncthreads();
        const bool sel = gt || (eq && (eqbase + eqoff + eqr_w) < need_eq);
        const unsigned long long ms = __ballot(sel); const unsigned sr_w = __popcll(ms & ((1ull << lane) - 1ull));
        if (lane == 0) wsum[wv] = __popcll(ms);
        __syncthreads();
        unsigned soff = 0u, stot = 0u; for (int w = 0; w < nw; ++w) { const unsigned c = wsum[w]; if (w < wv) soff += c; stot += c; }
        __syncthreads();
        if (sel) { const unsigned slot = base + soff + sr_w; if (slot < (unsigned)cap) { idx_out[slot] = t; gate_out[slot] = a; } }
        if (slot_of && in) slot_of[(size_t)t * 16 + e] = sel ? (int)(base + soff + sr_w) : -1;
        base += stot; eqbase += eqtot;
    }
}
__global__ __launch_bounds__(512) void k_select(const float* aff_all, int* idx_all, float* gate_all) {
    __shared__ unsigned hist[256]; __shared__ unsigned wsum[32]; __shared__ unsigned bc[4];
    const int grp = blockIdx.x >> 4, e = blockIdx.x & 15;
    const int n = grp ? NTS : NTP, cap = n / 8;
    const float* aff = aff_all + (size_t)(grp ? NTP : 0) * 16;
    int* idx = idx_all + (grp ? 16 * 4096 : 0) + e * cap; float* gate = gate_all + (grp ? 16 * 4096 : 0) + e * cap;
    select_expert(aff, n, e, cap, idx, gate, nullptr, hist, wsum, bc);
}
__global__ void k_silu_mul(float* h1, const float* h3, size_t n) {
    const size_t i = (size_t)blockIdx.x * blockDim.x + threadIdx.x; if (i >= n) return;
    const float a = h1[i]; h1[i] = a / (1.f + expf(-a)) * h3[i];
}
__global__ void k_scatter_add(const float* ye, const int* idx, const float* gate, float* out, int cap) {
    const size_t i = (size_t)blockIdx.x * blockDim.x + threadIdx.x; if (i >= (size_t)cap * D) return;
    const int slot = (int)(i >> 10), c = (int)(i & 1023);
    atomicAdd(&out[(size_t)idx[slot] * D + c], gate[slot] * ye[i]);
}

__global__ __launch_bounds__(256) void k_natten(float* q, const float* k, const float* v, const float* rpb) {
    const int wg = blockIdx.x * 4 + (threadIdx.x >> 6), lane = threadIdx.x & 63;
    const int tok = wg >> 4, h = wg & 15;
    if (tok >= NT) return;
    int gb, l; if (tok < NTP) { gb = tok >> 13; l = tok & 8191; } else { gb = 4 + ((tok - NTP) >> 12); l = (tok - NTP) & 4095; }
    const int rows = gb_len(gb) / GRID_W, t0 = gb_tok0(gb);
    const int r = l >> 6, qc = l & 63;
    int rs = r - 4; rs = rs < 0 ? 0 : (rs > rows - 8 ? rows - 8 : rs);
    int ws = qc - 8; ws = ws < 0 ? 0 : (ws > 48 ? 48 : ws);
    const float qv = q[(size_t)tok * D + h * 64 + lane] * 0.125f;
    float m = -INFINITY, lsum = 0.f, o = 0.f;
    for (int rr = 0; rr < 8; ++rr) {
        const int kr = rs + rr, dr = kr - r + 7;
        for (int cc = 0; cc < 16; ++cc) {
            const int kc = ws + cc; int dc = kc - qc + 15; dc = dc < 0 ? 0 : (dc > 30 ? 30 : dc);
            const size_t kt = (size_t)(t0 + kr * 64 + kc) * D + h * 64 + lane;
            const float s = wave_sum(qv * k[kt]) + rpb[(h * 15 + dr) * 31 + dc];
            const float mn = fmaxf(m, s), al = expf(m - mn), pp = expf(s - mn);
            lsum = lsum * al + pp; o = o * al + pp * v[kt]; m = mn;
        }
    }
    q[(size_t)tok * D + h * 64 + lane] = o / lsum;
}
}
#define LAS __attribute__((address_space(3)))
#define GAS __attribute__((address_space(1)))
namespace fz {
typedef unsigned short bf16_t;
typedef short bf16x8 __attribute__((ext_vector_type(8)));
typedef float f32x4 __attribute__((ext_vector_type(4)));
typedef float f32x2 __attribute__((ext_vector_type(2)));
typedef unsigned u32x4 __attribute__((ext_vector_type(4)));
typedef unsigned u32x2 __attribute__((ext_vector_type(2)));
typedef int v8i __attribute__((ext_vector_type(8)));
typedef int v4i __attribute__((ext_vector_type(4)));

constexpr int D = 1024, NTP = 32768, NTS = 16384, NT = NTP + NTS;
constexpr int TCH = 32, NCHUNK = NT / TCH;
constexpr int UAK = TCH * 16 + 256;
constexpr float ALPHA = 1.41421356237309515f, LN_EPS = 1e-5f;
constexpr size_t MiB = 1u << 20;
constexpr size_t WS_CTL = 0, WS_XF = 1 * MiB, WS_XB = 193 * MiB, WS_WIN = 289 * MiB, WS_WGLU = 291 * MiB, WS_WQKV = 295 * MiB, WS_WO = 301 * MiB, WS_MWQ = 303 * MiB,
                 WS_MWKV = 307 * MiB, WS_MWO = 315 * MiB, WS_MEMB = 319 * MiB, WS_KV = 323 * MiB, WS_WQK = 339 * MiB, WS_WVO = 371 * MiB, WS_AFF = 403 * MiB, WS_SLOT = 406 * MiB,
                 WS_IDX = 409 * MiB, WS_GATE = 409 * MiB + 512 * 1024, WS_EW13 = 411 * MiB  , WS_EW2 = 475 * MiB  ,
                 WS_XB8 = 507 * MiB  , WS_POOL = 603 * MiB, WS_END = 1024 * MiB;
constexpr size_t PO_M2T = WS_POOL, PO_M13T = WS_POOL + 16 * MiB, PO_UA = WS_POOL + 64 * MiB, PO_SG = WS_POOL + 208 * MiB;
constexpr size_t PO_HB_S5 = WS_POOL;
constexpr size_t PO_SB = WS_POOL, PO_HB_MEM = WS_POOL + 304 * MiB;
constexpr size_t PO_Q = WS_POOL, PO_K = WS_POOL + 96 * MiB, PO_VT = WS_POOL + 192 * MiB, PO_HB_NA = WS_POOL + 304 * MiB;
constexpr size_t PO_HM = WS_POOL, PO_YE = WS_POOL + 192 * MiB;
static_assert(PO_YE + 192 * MiB <= WS_END && PO_SG + 96 * MiB <= WS_END && PO_HB_NA + 96 * MiB <= WS_END && PO_HB_MEM + 96 * MiB <= WS_END, "pool");
constexpr int CW_TMO = 0, CW_BAR = 4096;
constexpr size_t CTL_ZERO_BYTES = 64 * 1024;
constexpr int RING_BYTES = 131072, MISC_OFF = RING_BYTES + 320, LDS_BYTES = 147456, ZERO16_OFF = RING_BYTES + 64;

__host__ __device__ inline int gb_tok0(int gb) { return gb < 4 ? gb * 8192 : NTP + (gb - 4) * 4096; }
__host__ __device__ inline int gb_len(int gb) { return gb < 4 ? 8192 : 4096; }
__host__ __device__ inline int panel_gb(int pm) { return pm < 128 ? (pm >> 5) : 4 + ((pm - 128) >> 4); }

__device__ __forceinline__ unsigned cvt_pk_bf16(float lo, float hi) { unsigned r; asm volatile("v_cvt_pk_bf16_f32 %0, %1, %2" : "=v"(r) : "v"(lo), "v"(hi)); return r; }
typedef __bf16 bf16x2_t __attribute__((ext_vector_type(2)));
__device__ __forceinline__ unsigned cvt_pk_bf16_c(float lo, float hi) { const f32x2 v = {lo, hi}; const bf16x2_t b = __builtin_convertvector(v, bf16x2_t); return __builtin_bit_cast(unsigned, b); }
__device__ __forceinline__ float bf2f(unsigned short b) { return __uint_as_float(((unsigned)b) << 16); }
template <int CTRL> __device__ __forceinline__ float dpp_f(float v) { return __uint_as_float((unsigned)__builtin_amdgcn_update_dpp(0, (int)__float_as_uint(v), CTRL, 0xF, 0xF, true)); }
__device__ __forceinline__ float x16_sum(float v) { const auto r = __builtin_amdgcn_permlane16_swap(__float_as_uint(v), __float_as_uint(v), false, false); return __uint_as_float(r[0]) + __uint_as_float(r[1]); }
__device__ __forceinline__ float x32_sum(float v) { const auto r = __builtin_amdgcn_permlane32_swap(__float_as_uint(v), __float_as_uint(v), false, false); return __uint_as_float(r[0]) + __uint_as_float(r[1]); }
__device__ __forceinline__ float x16_max(float v) { const auto r = __builtin_amdgcn_permlane16_swap(__float_as_uint(v), __float_as_uint(v), false, false); return fmaxf(__uint_as_float(r[0]), __uint_as_float(r[1])); }
__device__ __forceinline__ float x32_max(float v) { const auto r = __builtin_amdgcn_permlane32_swap(__float_as_uint(v), __float_as_uint(v), false, false); return fmaxf(__uint_as_float(r[0]), __uint_as_float(r[1])); }
__device__ __forceinline__ float row_sum(float v) { v += dpp_f<0xB1>(v); v += dpp_f<0x4E>(v); v += dpp_f<0x141>(v); v += dpp_f<0x140>(v); return v; }
__device__ __forceinline__ float row_max(float v) { v = fmaxf(v, dpp_f<0xB1>(v)); v = fmaxf(v, dpp_f<0x4E>(v)); v = fmaxf(v, dpp_f<0x141>(v)); v = fmaxf(v, dpp_f<0x140>(v)); return v; }
__device__ __forceinline__ float wave_sum(float v) { return x32_sum(x16_sum(row_sum(v))); }
__device__ __forceinline__ float wave_max(float v) { return x32_max(x16_max(row_max(v))); }
#ifndef NO_WT
__device__ __forceinline__ void st16(void* p, u32x4 v) { asm volatile("global_store_dwordx4 %0, %1, off sc1\n\ts_nop 1" :: "v"(p), "v"(v)); }
__device__ __forceinline__ void st8(void* p, u32x2 v) { asm volatile("global_store_dwordx2 %0, %1, off sc1\n\ts_nop 1" :: "v"(p), "v"(v)); }
__device__ __forceinline__ void st4(void* p, unsigned v) { asm volatile("global_store_dword %0, %1, off sc1\n\ts_nop 1" :: "v"(p), "v"(v)); }
#else
__device__ __forceinline__ void st16(void* p, u32x4 v) { *(u32x4*)p = v; }
__device__ __forceinline__ void st8(void* p, u32x2 v) { *(u32x2*)p = v; }
__device__ __forceinline__ void st4(void* p, unsigned v) { *(unsigned*)p = v; }
#endif
__device__ __forceinline__ void st16f(void* p, f32x4 v) { st16(p, __builtin_bit_cast(u32x4, v)); }
__device__ __forceinline__ void pst16(void* p, u32x4 v) { *(u32x4*)p = v; }
__device__ __forceinline__ void pst8(void* p, u32x2 v) { *(u32x2*)p = v; }
#ifndef NO_WT
__device__ __forceinline__ void st16_so(const void* base, unsigned off, f32x4 v) { asm volatile("global_store_dwordx4 %0, %1, %2 sc1\n\ts_nop 1" :: "v"(off), "v"(v), "s"(base)); }
__device__ __forceinline__ void st4_so(const void* base, unsigned off, unsigned v) { asm volatile("global_store_dword %0, %1, %2 sc1\n\ts_nop 1" :: "v"(off), "v"(v), "s"(base)); }
#else
__device__ __forceinline__ void st16_so(const void* base, unsigned off, f32x4 v) { *(f32x4*)((unsigned char*)base + off) = v; }
__device__ __forceinline__ void st4_so(const void* base, unsigned off, unsigned v) { *(unsigned*)((unsigned char*)base + off) = v; }
#endif
#define LDS_WAIT() asm volatile("s_waitcnt lgkmcnt(0)" ::: "memory")
#define VM_WAIT() asm volatile("s_waitcnt vmcnt(0)" ::: "memory")

#define XB_TMO      128
#define XB_XCNT(j)  (256  + 64 * (j))
#define XB_XSUB(j)  (1280 + 64 * (j))
#define XB_XGEN(j)  (2304 + 64 * (j))
#define XB_TOP      3328
#define XB_TOPGEN   3392
#define XCD_BAR_WORDS 3456
#define XB_SPIN_CAP (1u << 18)
__device__ __forceinline__ unsigned xb_ld(unsigned* p)              { return __hip_atomic_load(p, __ATOMIC_RELAXED, __HIP_MEMORY_SCOPE_AGENT); }
__device__ __forceinline__ unsigned xb_add(unsigned* p, unsigned v) { return __hip_atomic_fetch_add(p, v, __ATOMIC_RELAXED, __HIP_MEMORY_SCOPE_AGENT); }
__device__ __forceinline__ unsigned xb_xcc_id() { return (unsigned)__builtin_amdgcn_s_getreg((3 << 11) | 20) & 0xFu; }
#define XB_SPIN(cond, bar) do { unsigned _sp = 0; while (cond) { __builtin_amdgcn_s_sleep(1); \
    if ((++_sp & 255u) == 0u) { if (xb_ld(&(bar)[XB_TMO])) break; if (_sp > XB_SPIN_CAP) { atomicAdd(&(bar)[XB_TMO], 1u); break; } } } } while (0)
struct XcdBarrier { unsigned* bar; unsigned x; volatile LAS unsigned* st; };
__device__ __forceinline__ int xb_tid();
__device__ __forceinline__ XcdBarrier xcd_barrier_post(unsigned* bar, volatile LAS unsigned* st) {
    XcdBarrier b; b.bar = bar; b.x = xb_xcc_id(); b.st = st;
    if (threadIdx.x == 0) st[4] = xb_add(&bar[XB_XCNT(b.x)], 1u);
    return b;
}
#define XB_LCNT(j)  (3520 + 64 * (j))
#define XB_LGEN(j)  (4544 + 64 * (j))
#define XCD_BAR_WORDS_EXT 5568
__device__ __forceinline__ void xcd_local_barrier(const XcdBarrier& b, const int wave_s, const unsigned nloc) {
    asm volatile("s_waitcnt vmcnt(0)" ::: "memory");
    __syncthreads();
    if (wave_s == 0 && xb_tid() == 0) {
        unsigned* bar = b.bar;
        const unsigned old = xb_add(&bar[XB_LCNT(b.x)], 1u);
        const unsigned gen = old / nloc;
        if (old + 1u == (gen + 1u) * nloc) xb_add(&bar[XB_LGEN(b.x)], 1u);
        else XB_SPIN(xb_ld(&bar[XB_LGEN(b.x)]) == gen, bar);
#ifndef LB_NOACQ
        __builtin_amdgcn_fence(__ATOMIC_ACQUIRE, "agent");
        asm volatile("s_waitcnt vmcnt(0)" ::: "memory");
#endif
    }
    __syncthreads();
}
__device__ __forceinline__ void xcd_barrier_complete(unsigned* bar, unsigned x, unsigned& nloc, unsigned& nx) {
    const unsigned G = gridDim.x * gridDim.y * gridDim.z;
    unsigned sum, cnt, mine, sp = 0u;
    for (;;) {
        sum = 0u; cnt = 0u; mine = 0u;
#pragma unroll
        for (unsigned j = 0; j < 16; ++j) { const unsigned c = xb_ld(&bar[XB_XCNT(j)]); sum += c; cnt += (c > 0u) ? 1u : 0u; mine = (j == x) ? c : mine; }
        if (sum == G) break;
        __builtin_amdgcn_s_sleep(1);
        if ((++sp & 255u) == 0u) { if (xb_ld(&bar[XB_TMO])) break; if (sp > XB_SPIN_CAP) { atomicAdd(&bar[XB_TMO], 1u); break; } }
    }
    nloc = mine > 0u ? mine : 1u; nx = cnt > 0u ? cnt : 1u;
}
__device__ __forceinline__ int xb_tid() { int t; asm volatile("v_mbcnt_lo_u32_b32 %0, -1, 0\n\tv_mbcnt_hi_u32_b32 %0, -1, %0" : "=v"(t)); return t; }
__device__ __forceinline__ void xcd_barrier(const XcdBarrier& b, const int wave_s) {
    asm volatile("s_waitcnt vmcnt(0)" ::: "memory");
    __syncthreads();
    if (wave_s == 0 && xb_tid() == 0) {
        unsigned* bar = b.bar;
        __builtin_amdgcn_s_waitcnt(0);
        unsigned nloc = b.st[0], nx = b.st[1];
        if (nloc == 0u) { xcd_barrier_complete(bar, b.x, nloc, nx); b.st[0] = nloc; b.st[1] = nx; }
        const unsigned old = xb_add(&bar[XB_XSUB(b.x)], 1u);
        const unsigned gen = old / nloc;
        if (old + 1u == (gen + 1u) * nloc) {
            __builtin_amdgcn_fence(__ATOMIC_RELEASE, "agent");
            asm volatile("s_waitcnt vmcnt(0)" ::: "memory");
            const unsigned og = xb_add(&bar[XB_TOP], 1u);
            const unsigned tg = og / nx;
            if (og + 1u == (tg + 1u) * nx) xb_add(&bar[XB_TOPGEN], 1u);
            else XB_SPIN(xb_ld(&bar[XB_TOPGEN]) == tg, bar);
            __builtin_amdgcn_fence(__ATOMIC_ACQUIRE, "agent");
            xb_add(&bar[XB_XGEN(b.x)], 1u);
            asm volatile("s_waitcnt vmcnt(0)" ::: "memory");
        } else {
            XB_SPIN(xb_ld(&bar[XB_XGEN(b.x)]) == gen, bar);
            __builtin_amdgcn_fence(__ATOMIC_ACQUIRE, "agent");
            asm volatile("s_waitcnt vmcnt(0)" ::: "memory");
        }
    }
    __syncthreads();
}

constexpr int BM = 256, BK = 64, HALF = 128, HTB = HALF * BK * 2, STAGE_BYTES = 8 * HTB;
__host__ __device__ __forceinline__ int lds_byte(int r, int c) { const int st = (r >> 4) * 2 + (c >> 5), rr = r & 15, cc = c & 31, ob = rr * 64 + cc * 2; return st * 1024 + (ob ^ (((ob >> 9) & 1) << 5)); }
__host__ __device__ __forceinline__ void stage_rc(int b, int& R, int& C) { const int st = b / 1024, sb = b % 1024, swz = sb ^ (((sb >> 9) & 1) << 5); R = (st >> 1) * 16 + swz / 64; C = (st & 1) * 32 + (swz % 64) / 2; }
__host__ __device__ __forceinline__ int perm32(int rho) { const int n = rho >> 4, i = rho & 15; return 8 * (i >> 2) + 4 * n + (i & 3); }

struct GUnit { const char* A; const char* B; char* C; const void* X; int pm, pn; };
template <int WGM = 8>
__device__ __forceinline__ bool static_unit(int i, int G, int c, int nM, int nN, int& pm, int& pn) {
    const long L = (long)i * G + c; const int nwg = nM * nN; if (L >= nwg) return false;
    int wgid = (int)L; { const int q = nwg / 8, r = nwg % 8, xcd = wgid % 8, off = wgid / 8; wgid = (xcd < r ? xcd * (q + 1) : r * (q + 1) + (xcd - r) * q) + off; }
    const int nig = WGM * nN, gid = wgid / nig, fm = gid * WGM, gsz = (nM - fm) < WGM ? (nM - fm) : WGM;
    pm = fm + ((wgid % nig) % gsz); pn = (wgid % nig) / gsz; return true;
}
template <class Epi, class Sched, bool GATHER, bool FP8 = false>
__device__ __forceinline__ void gemm_phase(LAS unsigned char* lds, const int tid_in, const int K, const unsigned lda, const unsigned ldb, const Sched& S, const Epi& E) {
    int tid_ = tid_in; asm volatile("" : "+v"(tid_));
    const int tid = tid_, wid = __builtin_amdgcn_readfirstlane(tid >> 6), lane = tid & 63, wr = wid >> 2, wc = wid & 3, fr = lane & 15, fq = lane >> 4;
    int nt_ = K / BK; asm volatile("" : "+s"(nt_)); const int nt = nt_;
    unsigned voffA[2], voffB[2]; int gR[2], gC[2];
#pragma unroll
    for (int i = 0; i < 2; ++i) { int R, C; stage_rc(tid * 16 + i * 8192, R, C); const int Rb = Epi::PERM ? ((R & ~31) + perm32(R & 31)) : R;
        voffA[i] = (unsigned)R * lda + (unsigned)C * 2u; voffB[i] = (unsigned)Rb * ldb + (unsigned)C * 2u; gR[i] = R; gC[i] = C * 2; }
    const size_t kstep = (size_t)(BK * 2);
    const size_t hstepA = (size_t)HALF * lda, hstepB = (size_t)HALF * ldb;
    const unsigned ldsw = (unsigned)wid * 1024u;
    const int aoff = lds_byte(wr * 64 + fr, fq * 8), boff = lds_byte(wc * 32 + fr, fq * 8);
    const int sc8 = 0x7F7F7F7F;
    unsigned cvo[2][2], nvo[2][2];
#define PG8_SA(b, h) (((b) * 2 + (h)) * HTB)
#define PG8_SB(b, h) ((4 + (b) * 2 + (h)) * HTB)
#define PG8_STAGE(bufoff, gbase, voff) do { _Pragma("unroll") for (int _i = 0; _i < 2; ++_i) \
        __builtin_amdgcn_global_load_lds((const unsigned*)((const char*)(gbase) + (voff)[_i]), (LAS unsigned*)(lds + (bufoff) + ldsw + _i * 8192), 16, 0, 0); } while (0)
#define PG8_STAGE_B(bufoff, ptr, h) PG8_STAGE(bufoff, (ptr) + (h) * hstepB, voffB)
#define PG8_STAGE_A(bufoff, ptr, h, vo) do { if constexpr (GATHER) { PG8_STAGE(bufoff, (ptr), (vo)[h]); } else { PG8_STAGE(bufoff, (ptr) + (h) * hstepA, voffA); } } while (0)
#define PG8_LDA(dst, b, h) do { _Pragma("unroll") for (int m = 0; m < 4; ++m) _Pragma("unroll") for (int k = 0; k < 2; ++k) dst[m][k] = *(const LAS bf16x8*)(lds + PG8_SA(b, h) + aoff + m * 2048 + k * 1024); } while (0)
#define PG8_LDB(dst, b, h) do { _Pragma("unroll") for (int n = 0; n < 2; ++n) _Pragma("unroll") for (int k = 0; k < 2; ++k) dst[n][k] = *(const LAS bf16x8*)(lds + PG8_SB(b, h) + boff + n * 2048 + k * 1024); } while (0)
#define PG8_MMA(ai, bj, At, Bt) do { __builtin_amdgcn_s_setprio(1); _Pragma("unroll") for (int m = 0; m < 4; ++m) _Pragma("unroll") for (int n = 0; n < 2; ++n) { \
        if constexpr (FP8) { const v8i _a = __builtin_shufflevector(__builtin_bit_cast(v4i, At[m][0]), __builtin_bit_cast(v4i, At[m][1]), 0, 1, 2, 3, 4, 5, 6, 7), _b = __builtin_shufflevector(__builtin_bit_cast(v4i, Bt[n][0]), __builtin_bit_cast(v4i, Bt[n][1]), 0, 1, 2, 3, 4, 5, 6, 7); \
            asm volatile("v_mfma_scale_f32_16x16x128_f8f6f4 %0, %1, %2, %0, %3, %3 op_sel_hi:[0,0,0]" : "+v"(acc[ai][bj][m][n]) : "v"(_b), "v"(_a), "v"(sc8)); } \
        else { _Pragma("unroll") for (int k = 0; k < 2; ++k) acc[ai][bj][m][n] = __builtin_amdgcn_mfma_f32_16x16x32_bf16(Bt[n][k], At[m][k], acc[ai][bj][m][n], 0, 0, 0); } } __builtin_amdgcn_s_setprio(0); } while (0)
#define PG8_WAIT_V(n) asm volatile("s_waitcnt vmcnt(" #n ")" ::: "memory")
#define PG8_WAIT_L(n) asm volatile("s_waitcnt lgkmcnt(" #n ")" ::: "memory")
#define PG8_BAR __builtin_amdgcn_s_barrier()
#define PG8_SCHED __builtin_amdgcn_sched_barrier(0)
#define PG8_GLOAD(vo, u) do { if constexpr (GATHER) { const int* _gi = (const int*)(u).X; _Pragma("unroll") for (int _h = 0; _h < 2; ++_h) _Pragma("unroll") for (int _i = 0; _i < 2; ++_i) \
        (vo)[_h][_i] = (unsigned)_gi[_h * HALF + gR[_i]] * lda + (unsigned)gC[_i]; } } while (0)
    GUnit cur, nxt; int ui = 0;
    if (!S.next(0, cur)) return;
    f32x4 acc[2][2][4][2];
    const volatile LAS f32x4* zero16 = (const volatile LAS f32x4*)(lds + ZERO16_OFF);
#pragma unroll
    for (int a = 0; a < 2; ++a)
#pragma unroll
        for (int b = 0; b < 2; ++b)
#pragma unroll
            for (int m = 0; m < 4; ++m)
#pragma unroll
                for (int n = 0; n < 2; ++n) acc[a][b][m][n] = *zero16;
    bf16x8 At[4][2], B0[2][2], B1[2][2];
    const char* cA = cur.A; const char* cB = cur.B;
    PG8_GLOAD(cvo, cur);
    if constexpr (GATHER) { PG8_WAIT_V(0); }
    PG8_STAGE_B(PG8_SB(0, 0), cB, 0); PG8_STAGE_B(PG8_SB(0, 1), cB, 1); PG8_STAGE_A(PG8_SA(0, 0), cA, 0, cvo); PG8_STAGE_A(PG8_SA(0, 1), cA, 1, cvo);
    if (wr == 1) PG8_BAR;
    PG8_WAIT_V(2); PG8_BAR;
    PG8_STAGE_B(PG8_SB(1, 0), cB + kstep, 0); PG8_STAGE_A(PG8_SA(1, 0), cA + kstep, 0, cvo); PG8_STAGE_B(PG8_SB(1, 1), cB + kstep, 1);
    PG8_WAIT_V(6); PG8_BAR;
    for (;;) {
        const bool has_next = S.next(ui + 1, nxt);
        const char* nA = has_next ? nxt.A : cA; const char* nB = has_next ? nxt.B : cB;
        if constexpr (GATHER) { if (has_next) { PG8_GLOAD(nvo, nxt); } else {
#pragma unroll
            for (int h = 0; h < 2; ++h)
#pragma unroll
                for (int i = 0; i < 2; ++i) nvo[h][i] = cvo[h][i]; } }
        for (int t = 0; t < nt; t += 2) {
            const bool last = (t == nt - 2);
            const char* a1 = cA + (size_t)(t + 1) * kstep;
            const char* a2 = last ? nA : cA + (size_t)(t + 2) * kstep; const char* b2 = last ? nB : cB + (size_t)(t + 2) * kstep;
            const char* a3 = a2 + kstep; const char* b3 = b2 + kstep;
            unsigned vo2[2][2];
            if constexpr (GATHER) {
#pragma unroll
                for (int h = 0; h < 2; ++h)
#pragma unroll
                    for (int i = 0; i < 2; ++i) vo2[h][i] = last ? nvo[h][i] : cvo[h][i]; }
            PG8_LDB(B0, 0, 0); PG8_LDB(B1, 0, 1); PG8_SCHED; PG8_LDA(At, 0, 0); PG8_STAGE_A(PG8_SA(1, 1), a1, 1, cvo);
            PG8_WAIT_V(8); PG8_WAIT_L(0); PG8_BAR; PG8_MMA(0, 0, At, B0); PG8_MMA(0, 1, At, B1); PG8_BAR; PG8_SCHED;
            PG8_LDA(At, 0, 1); PG8_STAGE_B(PG8_SB(0, 0), b2, 0); PG8_STAGE_B(PG8_SB(0, 1), b2, 1); PG8_STAGE_A(PG8_SA(0, 0), a2, 0, vo2);
            PG8_WAIT_V(8); PG8_WAIT_L(0); PG8_BAR; PG8_MMA(1, 0, At, B0); PG8_MMA(1, 1, At, B1); PG8_BAR; PG8_SCHED;
            PG8_LDB(B0, 1, 0); PG8_LDB(B1, 1, 1); PG8_SCHED; PG8_LDA(At, 1, 0); PG8_STAGE_A(PG8_SA(0, 1), a2, 1, vo2);
            PG8_WAIT_V(8); PG8_WAIT_L(0); PG8_BAR; PG8_MMA(0, 0, At, B0); PG8_MMA(0, 1, At, B1); PG8_BAR; PG8_SCHED;
            PG8_LDA(At, 1, 1); PG8_STAGE_B(PG8_SB(1, 0), b3, 0); PG8_STAGE_B(PG8_SB(1, 1), b3, 1); PG8_STAGE_A(PG8_SA(1, 0), a3, 0, vo2);
            PG8_WAIT_V(8); PG8_WAIT_L(0); PG8_BAR; PG8_MMA(1, 0, At, B0); PG8_MMA(1, 1, At, B1); PG8_BAR; PG8_SCHED;
        }
        if constexpr (FP8) { asm volatile("s_nop 15\n\ts_nop 15" ::: "memory"); }
        if (wr == 0) PG8_BAR;
        E(acc, cur, wr, wc, fr, fq);
        if (!has_next) break;
#pragma unroll
        for (int a = 0; a < 2; ++a)
#pragma unroll
            for (int b = 0; b < 2; ++b)
#pragma unroll
                for (int m = 0; m < 4; ++m)
#pragma unroll
                    for (int n = 0; n < 2; ++n) acc[a][b][m][n] = *zero16;
        cur = nxt; cA = nA; cB = nB; ++ui;
        if constexpr (GATHER) {
#pragma unroll
            for (int h = 0; h < 2; ++h)
#pragma unroll
                for (int i = 0; i < 2; ++i) cvo[h][i] = nvo[h][i]; }
        if (wr == 1) PG8_BAR;
    }
    PG8_WAIT_V(0);
    PG8_BAR;
#undef PG8_SA
#undef PG8_SB
#undef PG8_STAGE
#undef PG8_STAGE_A
#undef PG8_STAGE_B
#undef PG8_LDA
#undef PG8_LDB
#undef PG8_MMA
#undef PG8_WAIT_V
#undef PG8_WAIT_L
#undef PG8_BAR
#undef PG8_SCHED
#undef PG8_GLOAD
}
typedef f32x4 Acc[2][2][4][2];
__device__ __forceinline__ float sigmoidf_fast(float x) { return __builtin_amdgcn_rcpf(1.f + __builtin_amdgcn_exp2f(-1.4426950408889634f * x)); }
__device__ __forceinline__ float gelu_tanh_fast(float y) {
    const float inner = 1.5957691216057308f * (y + 0.044715f * y * y * y);
    return y * sigmoidf_fast(inner);
}
__device__ __forceinline__ unsigned cvt4_fp8(float a, float b, float c, float d) {
    a = fminf(fmaxf(a, -448.f), 448.f); b = fminf(fmaxf(b, -448.f), 448.f); c = fminf(fmaxf(c, -448.f), 448.f); d = fminf(fmaxf(d, -448.f), 448.f);
    int w = 0; w = __builtin_amdgcn_cvt_pk_fp8_f32(a, b, w, false); w = __builtin_amdgcn_cvt_pk_fp8_f32(c, d, w, true); return (unsigned)w;
}
constexpr float FP8_SX = 8.f, FP8_SW13 = 32.f, FP8_SH = 8.f, FP8_SW2 = 64.f, FP8_SWQK = 32.f, FP8_SWQKV = 32.f;
struct EpiGated8 {
    static constexpr bool PERM = true;
    unsigned ldc;
    __device__ __forceinline__ void operator()(const Acc& acc, const GUnit& u, int wr, int wc, int fr, int fq) const {
        unsigned char* base = (unsigned char*)u.C;
        constexpr float kx = -1.4426950408889634f / (FP8_SX * FP8_SW13), ic = (FP8_SX * FP8_SW13) * (FP8_SX * FP8_SW13) / FP8_SH;
#pragma unroll
        for (int ai = 0; ai < 2; ++ai)
#pragma unroll
            for (int m = 0; m < 4; ++m) { const int r = ai * HALF + wr * 64 + m * 16 + fr;
                float o[8];
#pragma unroll
                for (int n = 0; n < 2; ++n)
#pragma unroll
                    for (int j = 0; j < 4; j += 2) {
                        const f32x2 a = {acc[ai][0][m][n][j], acc[ai][0][m][n][j + 1]}, b = {acc[ai][1][m][n][j], acc[ai][1][m][n][j + 1]};
                        const f32x2 t = a * f32x2{kx, kx};
                        const f32x2 e = {__builtin_amdgcn_exp2f(t[0]), __builtin_amdgcn_exp2f(t[1])};
                        const f32x2 d = e * f32x2{ic, ic} + f32x2{ic, ic};
                        const f32x2 s = {__builtin_amdgcn_rcpf(d[0]), __builtin_amdgcn_rcpf(d[1])};
                        const f32x2 q = (a * b) * s;
                        o[n * 4 + j] = __builtin_amdgcn_fmed3f(q[0], -448.f, 448.f); o[n * 4 + j + 1] = __builtin_amdgcn_fmed3f(q[1], -448.f, 448.f); }
                int w0 = 0, w1 = 0;
                w0 = __builtin_amdgcn_cvt_pk_fp8_f32(o[0], o[1], w0, false); w0 = __builtin_amdgcn_cvt_pk_fp8_f32(o[2], o[3], w0, true);
                w1 = __builtin_amdgcn_cvt_pk_fp8_f32(o[4], o[5], w1, false); w1 = __builtin_amdgcn_cvt_pk_fp8_f32(o[6], o[7], w1, true);
                u32x2 w; w.x = (unsigned)w0; w.y = (unsigned)w1;
                st8(base + (size_t)r * ldc + wc * 32 + 8 * fq, w); }
    }
};
struct EpiBf8 {
    static constexpr bool PERM = true;
    unsigned ldc; float scale;
    __device__ __forceinline__ void operator()(const Acc& acc, const GUnit& u, int wr, int wc, int fr, int fq) const {
        unsigned char* base = (unsigned char*)u.C;
#pragma unroll
        for (int ai = 0; ai < 2; ++ai)
#pragma unroll
            for (int m = 0; m < 4; ++m) { const int r = ai * HALF + wr * 64 + m * 16 + fr; unsigned char* rowp = base + (size_t)r * ldc + wc * 32 + 8 * fq;
#pragma unroll
                for (int bj = 0; bj < 2; ++bj) { const f32x4 v0 = acc[ai][bj][m][0] * scale, v1 = acc[ai][bj][m][1] * scale;
                    u32x2 w; w.x = cvt4_fp8(v0[0], v0[1], v0[2], v0[3]); w.y = cvt4_fp8(v1[0], v1[1], v1[2], v1[3]); st8(rowp + bj * HALF, w); } }
    }
};
template <bool ROWSCALE> struct EpiBf {
    static constexpr bool PERM = true;
    unsigned ldc; float scale;
    __device__ __forceinline__ void operator()(const Acc& acc, const GUnit& u, int wr, int wc, int fr, int fq) const {
        bf16_t* base = (bf16_t*)u.C; const float* rs = (const float*)u.X;
#pragma unroll
        for (int ai = 0; ai < 2; ++ai)
#pragma unroll
            for (int m = 0; m < 4; ++m) { const int r = ai * HALF + wr * 64 + m * 16 + fr; float s = scale; if (ROWSCALE) s *= rs[r];
                bf16_t* rowp = base + (size_t)r * ldc + wc * 32 + 8 * fq;
#pragma unroll
                for (int bj = 0; bj < 2; ++bj) { const f32x4 v0 = acc[ai][bj][m][0] * s, v1 = acc[ai][bj][m][1] * s;
                    u32x4 w; w.x = cvt_pk_bf16(v0[0], v0[1]); w.y = cvt_pk_bf16(v0[2], v0[3]); w.z = cvt_pk_bf16(v1[0], v1[1]); w.w = cvt_pk_bf16(v1[2], v1[3]);
                    st16(rowp + bj * HALF, w); } }
    }
};
template <int MODE> struct EpiGated {
    static constexpr bool PERM = true;
    unsigned ldc;
    __device__ __forceinline__ void operator()(const Acc& acc, const GUnit& u, int wr, int wc, int fr, int fq) const {
        bf16_t* base = (bf16_t*)u.C;
#pragma unroll
        for (int ai = 0; ai < 2; ++ai)
#pragma unroll
            for (int m = 0; m < 4; ++m) { const int r = ai * HALF + wr * 64 + m * 16 + fr;
                float o[8];
#pragma unroll
                for (int n = 0; n < 2; ++n)
#pragma unroll
                    for (int j = 0; j < 4; ++j) { const float a = acc[ai][0][m][n][j], b = acc[ai][1][m][n][j];
                        o[n * 4 + j] = (MODE == 0) ? a * sigmoidf_fast(b) : a * sigmoidf_fast(a) * b; }
                u32x4 w; w.x = cvt_pk_bf16(o[0], o[1]); w.y = cvt_pk_bf16(o[2], o[3]); w.z = cvt_pk_bf16(o[4], o[5]); w.w = cvt_pk_bf16(o[6], o[7]);
                st16(base + (size_t)r * ldc + wc * 32 + 8 * fq, w); }
    }
};
struct EpiUA {
    static constexpr bool PERM = true;
    __device__ __forceinline__ void operator()(const Acc& acc, const GUnit& u, int wr, int wc, int fr, int fq) const {
        bf16_t* UA = (bf16_t*)u.C;
#pragma unroll
        for (int ai = 0; ai < 2; ++ai)
#pragma unroll
            for (int m = 0; m < 4; ++m) { const int tok = u.pm * BM + ai * HALF + wr * 64 + m * 16 + fr; const int chunk = tok >> 5, j = tok & 31;
#pragma unroll
                for (int bj = 0; bj < 2; ++bj) { const int ch = u.pn * BM + bj * HALF + wc * 32 + 8 * fq, g = ch >> 4, h0 = ch & 15;
                    const f32x4 v0 = acc[ai][bj][m][0], v1 = acc[ai][bj][m][1];
                    u32x4 w; w.x = cvt_pk_bf16(v0[0], v0[1]); w.y = cvt_pk_bf16(v0[2], v0[3]); w.z = cvt_pk_bf16(v1[0], v1[1]); w.w = cvt_pk_bf16(v1[2], v1[3]);
                    st16(UA + ((size_t)g * NCHUNK + chunk) * UAK + j * 16 + h0, w); } }
    }
};
struct EpiS {
    static constexpr bool PERM = false;
    __device__ __forceinline__ void operator()(const Acc& acc, const GUnit& u, int wr, int wc, int fr, int fq) const {
        float* Sg = (float*)u.C;
#pragma unroll
        for (int ai = 0; ai < 2; ++ai)
#pragma unroll
            for (int m = 0; m < 4; ++m) { const int chunk = u.pm * BM + ai * HALF + wr * 64 + m * 16 + fr; float* rowp = Sg + (size_t)chunk * 256 + wc * 32 + 4 * fq;
#pragma unroll
                for (int bj = 0; bj < 2; ++bj)
#pragma unroll
                    for (int n = 0; n < 2; ++n) st16f(rowp + bj * HALF + n * 16, acc[ai][bj][m][n]); }
    }
};
struct EpiGelu {
    static constexpr bool PERM = true;
    __device__ __forceinline__ void operator()(const Acc& acc, const GUnit& u, int wr, int wc, int fr, int fq) const {
        bf16_t* Gg = (bf16_t*)u.C;
#pragma unroll
        for (int ai = 0; ai < 2; ++ai)
#pragma unroll
            for (int m = 0; m < 4; ++m) { const int chunk = u.pm * BM + ai * HALF + wr * 64 + m * 16 + fr;
#pragma unroll
                for (int bj = 0; bj < 2; ++bj) { const int n0 = u.pn * BM + bj * HALF + wc * 32 + 8 * fq, i = n0 >> 4, c0 = n0 & 15;
                    const f32x4 v0 = acc[ai][bj][m][0], v1 = acc[ai][bj][m][1];
                    u32x4 w; w.x = cvt_pk_bf16(gelu_tanh_fast(v0[0]), gelu_tanh_fast(v0[1])); w.y = cvt_pk_bf16(gelu_tanh_fast(v0[2]), gelu_tanh_fast(v0[3]));
                    w.z = cvt_pk_bf16(gelu_tanh_fast(v1[0]), gelu_tanh_fast(v1[1])); w.w = cvt_pk_bf16(gelu_tanh_fast(v1[2]), gelu_tanh_fast(v1[3]));
                    st16(Gg + ((size_t)chunk * TCH + i) * D + c0, w); } }
    }
};

struct EpiSoftmax {
    static constexpr bool PERM = true;
    LAS float* red; unsigned ldc; float scale;
    __device__ __forceinline__ void operator()(Acc& acc, const GUnit& u, int wr, int wc, int fr, int fq) const {
        bf16_t* base = (bf16_t*)u.C;
#pragma unroll
        for (int ai = 0; ai < 2; ++ai)
#pragma unroll
            for (int m = 0; m < 4; ++m) { float mx = -INFINITY;
#pragma unroll
                for (int bj = 0; bj < 2; ++bj)
#pragma unroll
                    for (int n = 0; n < 2; ++n) { const f32x4 v = acc[ai][bj][m][n]; mx = fmaxf(mx, fmaxf(fmaxf(v[0], v[1]), fmaxf(v[2], v[3]))); }
                mx *= scale; mx = x32_max(x16_max(mx));
                if (fq == 0) red[(ai * HALF + wr * 64 + m * 16 + fr) * 4 + wc] = mx; }
        asm volatile("s_waitcnt lgkmcnt(0)" ::: "memory"); __builtin_amdgcn_s_barrier(); asm volatile("" ::: "memory");
#pragma unroll
        for (int ai = 0; ai < 2; ++ai)
#pragma unroll
            for (int m = 0; m < 4; ++m) { const int r = ai * HALF + wr * 64 + m * 16 + fr; const f32x4 mm = *(const LAS f32x4*)(red + r * 4); const float M = fmaxf(fmaxf(mm[0], mm[1]), fmaxf(mm[2], mm[3]));
                float s = 0.f;
#pragma unroll
                for (int bj = 0; bj < 2; ++bj)
#pragma unroll
                    for (int n = 0; n < 2; ++n) { f32x4 v = acc[ai][bj][m][n];
#pragma unroll
                        for (int j = 0; j < 4; ++j) { v[j] = __builtin_amdgcn_exp2f(__builtin_fmaf(v[j], scale, -M)); s += v[j]; }
                        acc[ai][bj][m][n] = v; }
                s = x32_sum(x16_sum(s));
                if (fq == 0) red[1024 + r * 4 + wc] = s; }
        asm volatile("s_waitcnt lgkmcnt(0)" ::: "memory"); __builtin_amdgcn_s_barrier(); asm volatile("" ::: "memory");
#pragma unroll
        for (int ai = 0; ai < 2; ++ai)
#pragma unroll
            for (int m = 0; m < 4; ++m) { const int r = ai * HALF + wr * 64 + m * 16 + fr; const f32x4 ss = *(const LAS f32x4*)(red + 1024 + r * 4); const float inv = __builtin_amdgcn_rcpf((ss[0] + ss[1]) + (ss[2] + ss[3]));
                bf16_t* rowp = base + (size_t)r * ldc + wc * 32 + 8 * fq;
#pragma unroll
                for (int bj = 0; bj < 2; ++bj) { const f32x4 v0 = acc[ai][bj][m][0] * inv, v1 = acc[ai][bj][m][1] * inv;
                    u32x4 w; w.x = cvt_pk_bf16(v0[0], v0[1]); w.y = cvt_pk_bf16(v0[2], v0[3]); w.z = cvt_pk_bf16(v1[0], v1[1]); w.w = cvt_pk_bf16(v1[2], v1[3]);
                    st16(rowp + bj * HALF, w); } }
    }
};

struct Ctx { unsigned char* ws; int G, c; };
struct SchedPlain { const char* A; const char* B; char* C; size_t lda, ldb, ldc; int nM, nN, G, c;
    __device__ __forceinline__ bool next(int i, GUnit& u) const { int pm, pn; if (!static_unit(i, G, c, nM, nN, pm, pn)) return false;
        u.A = A + (size_t)pm * BM * lda; u.B = B + (size_t)pn * BM * ldb; u.C = C + ((size_t)pm * BM * ldc + (size_t)pn * BM) * 2; u.X = nullptr; u.pm = pm; u.pn = pn; return true; } };
struct SchedGated { const char* A; const char* B; char* C; size_t lda, ldb, ldc; int nM, nN, G, c;
    __device__ __forceinline__ bool next(int i, GUnit& u) const { int pm, pn; if (!static_unit(i, G, c, nM, nN, pm, pn)) return false;
        u.A = A + (size_t)pm * BM * lda; u.B = B + (size_t)pn * BM * ldb; u.C = C + ((size_t)pm * BM * ldc + (size_t)pn * HALF) * 2; u.X = nullptr; u.pm = pm; u.pn = pn; return true; } };
struct SchedUA { const char* A; const char* B; char* UA; int G, c;
    __device__ __forceinline__ bool next(int i, GUnit& u) const { int pm, pn; if (!static_unit(i, G, c, NT / BM, D / BM, pm, pn)) return false;
        u.A = A + (size_t)pm * BM * (D * 2); u.B = B + (size_t)pn * BM * (D * 2); u.C = UA; u.X = nullptr; u.pm = pm; u.pn = pn; return true; } };
struct SchedKV { unsigned char* ws; int G, c;
    __device__ __forceinline__ bool next(int i, GUnit& u) const { const int L = i * G + c; if (L >= 128) return false; const int layer = L >> 6, r = L & 63, pm = r >> 3, pn = r & 7;
        u.A = (const char*)ws + WS_MEMB + (size_t)pm * BM * 2048; u.B = (const char*)ws + WS_MWKV + (size_t)layer * 4 * MiB + (size_t)pn * BM * 2048;
        u.C = (char*)ws + WS_KV + (size_t)layer * 8 * MiB + ((size_t)pm * BM * 2048 + pn * BM) * 2; u.X = nullptr; u.pm = pm; u.pn = pn; return true; } };
struct SchedSA { unsigned char* ws; int G, c;
    __device__ __forceinline__ bool next(int i, GUnit& u) const { const int L = i * G + c; if (L >= 64 * 6) return false; const int g = L / 6, pm = L % 6;
        u.A = (const char*)ws + PO_UA + ((size_t)g * NCHUNK + (size_t)pm * BM) * (UAK * 2); u.B = (const char*)ws + PO_M2T + (size_t)g * 256 * 512 * 2;
        u.C = (char*)ws + PO_SG + (size_t)g * NCHUNK * 256 * 4; u.X = nullptr; u.pm = pm; u.pn = 0; return true; } };
struct SchedSC { unsigned char* ws; int G, c;
    __device__ __forceinline__ bool next(int i, GUnit& u) const { const int L = i * G + c; if (L >= 64 * 12) return false; const int g = L / 12, r = L % 12, pm = r >> 1, pn = r & 1;
        u.A = (const char*)ws + PO_UA + ((size_t)g * NCHUNK + (size_t)pm * BM) * (UAK * 2); u.B = (const char*)ws + PO_M13T + ((size_t)g * 512 + pn * BM) * UAK * 2;
        u.C = (char*)ws + PO_SG + (size_t)g * 16 * 2; u.X = nullptr; u.pm = pm; u.pn = pn; return true; } };
struct SchedWqk { unsigned char* ws; int G, c;
    __device__ __forceinline__ bool next(int i, GUnit& u) const { const int L = i * G + c; if (L >= 256) return false; const int pn = L & 3, h = (L >> 2) & 3, gb = (L >> 4) & 7, layer = L >> 7;
        u.A = (const char*)ws + WS_KV + (size_t)layer * 8 * MiB + ((size_t)gb * 256 * 2048 + h * 256) * 2; u.B = (const char*)ws + WS_MWQ + (size_t)layer * 2 * MiB + ((size_t)pn * BM * 1024 + h * 256) * 2;
        u.C = (char*)ws + WS_WQK + ((size_t)(layer * 8 + gb) * 1024 * 1024 + (size_t)h * 256 * 1024 + pn * BM); u.X = nullptr; u.pm = 0; u.pn = pn; return true; } };
struct SchedWvo { unsigned char* ws; int G, c;
    __device__ __forceinline__ bool next(int i, GUnit& u) const { const int L = i * G + c; if (L >= 256) return false; const int pm = L & 3, h = (L >> 2) & 3, gb = (L >> 4) & 7, layer = L >> 7;
        u.A = (const char*)ws + WS_MWO + (size_t)layer * 2 * MiB + ((size_t)pm * BM * 1024 + h * 256) * 2; u.B = (const char*)ws + WS_KV + (size_t)layer * 8 * MiB + ((size_t)gb * 256 * 2048 + 1024 + h * 256) * 2;
        u.C = (char*)ws + WS_WVO + ((size_t)(layer * 8 + gb) * 1024 * 1024 + (size_t)pm * BM * 1024 + h * 256) * 2; u.X = nullptr; u.pm = pm; u.pn = 0; return true; } };
struct SchedScores8 { const char* A; const char* Bl; char* C; int G, c;
    __device__ __forceinline__ bool next(int i, GUnit& u) const { int pm, pn; if (!static_unit(i, G, c, NT / BM, 4, pm, pn)) return false; const int gb = panel_gb(pm);
        u.A = A + (size_t)pm * BM * 1024; u.B = Bl + ((size_t)gb * 1024 + pn * BM) * 1024; u.C = C + ((size_t)pm * BM * 1024 + pn * BM) * 2; u.X = nullptr; u.pm = pm; u.pn = pn; return true; } };
struct SchedBatchW { const char* A; const char* Bl; char* C; int G, c;
    __device__ __forceinline__ bool next(int i, GUnit& u) const { int pm, pn; if (!static_unit(i, G, c, NT / BM, 4, pm, pn)) return false; const int gb = panel_gb(pm);
        u.A = A + (size_t)pm * BM * 2048; u.B = Bl + ((size_t)gb * 1024 + pn * BM) * 2048; u.C = C + ((size_t)pm * BM * 1024 + pn * BM) * 2; u.X = nullptr; u.pm = pm; u.pn = pn; return true; } };
struct Args { const float* in[26]; float* out; unsigned char* ws; int ph_lo, ph_hi, flags, pad; };
struct Frame {
    LAS unsigned char* lds; unsigned char* ws; const float* const* in; float* out;
    int tid, lane, wave, G, c;
    bool xok;
};
enum { I_XP = 0, I_XS, I_MEMP, I_MEMS, I_AWIN, I_ALRE, I_ALIM, I_ALDT, I_ABRE, I_ABIM, I_ACRE, I_ACIM, I_AD, I_AWGLU, I_BWQKV, I_BRPB, I_BWO, I_MWQ, I_MWKV, I_MWO, I_EWR, I_EW1, I_EW3, I_EW2, I_LNG, I_LNB };

__device__ __forceinline__ int rowmap(int mode, int n) {
    if (mode == 0) return n;
    if (mode == 1) { const int z = n >> 10, nn = n & 1023; return ((nn >> 7) << 8) + (z << 7) + (nn & 127); }
    return ((n >> 7) << 8) + ((mode == 3) ? 128 : 0) + (n & 127);
}
__device__ __forceinline__ void transpose_item(const float* W, int K, int N, bf16_t* WT, int mode, LAS float* scr, int item, int lane) {
    const int nblk = N / 32, kb = item / nblk, nb = item % nblk, k0 = 64 * kb, n0 = 32 * nb;
#pragma unroll 8
    for (int i = 0; i < 32; ++i) { const int kk = 2 * i + (lane >> 5); scr[kk * 33 + (lane & 31)] = W[(size_t)(k0 + kk) * N + n0 + (lane & 31)]; }
    LDS_WAIT(); asm volatile("" ::: "memory");
    const int c = lane & 7;
#pragma unroll
    for (int j = 0; j < 4; ++j) { const int n = (lane >> 3) + 8 * j; const LAS float* s = scr + (8 * c) * 33 + n;
        u32x4 o; o.x = cvt_pk_bf16(s[0 * 33], s[1 * 33]); o.y = cvt_pk_bf16(s[2 * 33], s[3 * 33]); o.z = cvt_pk_bf16(s[4 * 33], s[5 * 33]); o.w = cvt_pk_bf16(s[6 * 33], s[7 * 33]);
        *(u32x4*)(WT + (size_t)rowmap(mode, n0 + n) * K + k0 + 8 * c) = o; }
    LDS_WAIT(); asm volatile("" ::: "memory");
}
__device__ __forceinline__ void t8_load(f32x4 (&v)[16], const float* W, int N, int item, int lane) {
    const int nblk = N / 32, kb = item / nblk, nb = item % nblk, k0 = 128 * kb, n0 = 32 * nb, q = lane >> 3, c = lane & 7;
#pragma unroll
    for (int i = 0; i < 16; ++i) v[i] = *(const f32x4*)(W + (size_t)(k0 + 16 * q + i) * N + n0 + 4 * c);
}
__device__ __forceinline__ void t8_finish(const f32x4 (&v)[16], int K, int N, unsigned char* WT, int mode, float scale, LAS unsigned char* scr, int item, int lane) {
    const int nblk = N / 32, kb = item / nblk, nb = item % nblk, k0 = 128 * kb, n0 = 32 * nb, q = lane >> 3, c = lane & 7;
#pragma unroll
    for (int j = 0; j < 4; ++j) { u32x4 o;
        o.x = cvt4_fp8(v[0][j] * scale, v[1][j] * scale, v[2][j] * scale, v[3][j] * scale); o.y = cvt4_fp8(v[4][j] * scale, v[5][j] * scale, v[6][j] * scale, v[7][j] * scale);
        o.z = cvt4_fp8(v[8][j] * scale, v[9][j] * scale, v[10][j] * scale, v[11][j] * scale); o.w = cvt4_fp8(v[12][j] * scale, v[13][j] * scale, v[14][j] * scale, v[15][j] * scale);
        *(LAS u32x4*)(scr + (4 * c + j) * 144 + 16 * q) = o; }
    LDS_WAIT(); asm volatile("" ::: "memory");
#pragma unroll
    for (int j = 0; j < 4; ++j) { const int n = (lane >> 3) + 8 * j; const u32x4 o = *(const LAS u32x4*)(scr + n * 144 + 16 * c);
        pst16(WT + (size_t)rowmap(mode, n0 + n) * K + k0 + 16 * c, o); }
    LDS_WAIT(); asm volatile("" ::: "memory");
}
__device__ __forceinline__ void transpose_item8(const float* W, int K, int N, unsigned char* WT, int mode, float scale, LAS unsigned char* scr, int item, int lane) {
    f32x4 v[16]; t8_load(v, W, N, item, lane); t8_finish(v, K, N, WT, mode, scale, scr, item, lane);
}
__device__ __forceinline__ void transpose_item16(const float* W, int K, int N, bf16_t* WT, int mode, LAS unsigned char* scr, int item, int lane) {
    const int nblk = N / 32, kb = item / nblk, nb = item % nblk, k0 = 128 * kb, n0 = 32 * nb, q = lane >> 3, c = lane & 7;
    f32x4 v[16];
#pragma unroll
    for (int i = 0; i < 16; ++i) v[i] = *(const f32x4*)(W + (size_t)(k0 + 16 * q + i) * N + n0 + 4 * c);
#pragma unroll
    for (int j = 0; j < 4; ++j) { u32x4 o0, o1;
        o0.x = cvt_pk_bf16(v[0][j], v[1][j]); o0.y = cvt_pk_bf16(v[2][j], v[3][j]); o0.z = cvt_pk_bf16(v[4][j], v[5][j]); o0.w = cvt_pk_bf16(v[6][j], v[7][j]);
        o1.x = cvt_pk_bf16(v[8][j], v[9][j]); o1.y = cvt_pk_bf16(v[10][j], v[11][j]); o1.z = cvt_pk_bf16(v[12][j], v[13][j]); o1.w = cvt_pk_bf16(v[14][j], v[15][j]);
        *(LAS u32x4*)(scr + (4 * c + j) * 272 + 32 * q) = o0; *(LAS u32x4*)(scr + (4 * c + j) * 272 + 32 * q + 16) = o1; }
    LDS_WAIT(); asm volatile("" ::: "memory");
#pragma unroll
    for (int j = 0; j < 8; ++j) { const int n = (lane >> 4) + 4 * j, ch = lane & 15; const u32x4 o = *(const LAS u32x4*)(scr + n * 272 + 16 * ch);
        *(u32x4*)(WT + (size_t)rowmap(mode, n0 + n) * K + k0 + 8 * ch) = o; }
    LDS_WAIT(); asm volatile("" ::: "memory");
}
__device__ __forceinline__ void convert_small_weights(Frame& F) {
    LAS unsigned char* scr = F.lds + F.wave * 16384;
    const int gw = F.c * 8 + F.wave, NGW = F.G * 8;
    for (int it = gw; it < 3328; it += NGW) {
        int r = it;
        if (r < 256) { transpose_item16(F.in[I_AWIN], 1024, 1024, (bf16_t*)(F.ws + WS_WIN), 0, scr, r, F.lane); continue; } r -= 256;
        if (r < 512) { transpose_item16(F.in[I_AWGLU], 1024, 2048, (bf16_t*)(F.ws + WS_WGLU), 1, scr, r, F.lane); continue; } r -= 512;
        if (r < 768) { transpose_item8(F.in[I_BWQKV], 1024, 3072, F.ws + WS_WQKV, 0, FP8_SWQKV, scr, r, F.lane); continue; } r -= 768;
        if (r < 256) { transpose_item16(F.in[I_BWO], 1024, 1024, (bf16_t*)(F.ws + WS_WO), 0, scr, r, F.lane); continue; } r -= 256;
        if (r < 1024) { const int l = r >> 9; transpose_item16(F.in[I_MWKV] + (size_t)l * 1024 * 2048, 1024, 2048, (bf16_t*)(F.ws + WS_MWKV + (size_t)l * 4 * MiB), 0, scr, r & 511, F.lane); continue; } r -= 1024;
        { const int l = r >> 8; transpose_item16(F.in[I_MWO] + (size_t)l * 1024 * 1024, 1024, 1024, (bf16_t*)(F.ws + WS_MWO + (size_t)l * 2 * MiB), 0, scr, r & 255, F.lane); }
    }
}
__device__ __forceinline__ void convert_expert_weights(Frame& F, int layer, int lo = 0, int hi = 16 * 1536, int wg0 = 0) {
    if (F.G <= wg0) wg0 = 0;
    if (F.c < wg0) return;
    LAS unsigned char* scr = F.lds + F.wave * 16384;
    const int gw = (F.c - wg0) * 8 + F.wave, NGW = (F.G - wg0) * 8;
#define CVX_DECODE(it_) const int _e = (it_) / 1536; int _r = (it_) % 1536; const size_t _wofs = ((size_t)layer * 16 + _e) * 1024 * 2048; \
        const int _w = _r >> 9; _r &= 511; const float* _W = (_w == 0 ? F.in[I_EW1] : (_w == 1 ? F.in[I_EW3] : F.in[I_EW2])) + _wofs; const int _N = _w == 2 ? 1024 : 2048, _K = _w == 2 ? 2048 : 1024;
#define CVX_LOAD(v_, it_) do { CVX_DECODE(it_); (void)_K; t8_load(v_, _W, _N, _r, F.lane); } while (0)
#define CVX_FINISH(v_, it_) do { CVX_DECODE(it_); unsigned char* _WT = _w == 2 ? F.ws + WS_EW2 + (size_t)_e * 2 * MiB : F.ws + WS_EW13 + (size_t)_e * 4 * MiB; \
        t8_finish(v_, _K, _N, _WT, _w == 0 ? 2 : (_w == 1 ? 3 : 0), _w == 2 ? FP8_SW2 : FP8_SW13, scr, _r, F.lane); } while (0)
    f32x4 va[16], vb[16];
    int it = lo + gw;
    if (it < hi) CVX_LOAD(va, it);
    while (it < hi) {
        const int it1 = it + NGW, it2 = it1 + NGW;
        if (it1 < hi) CVX_LOAD(vb, it1);
        CVX_FINISH(va, it);
        if (it1 < hi) { if (it2 < hi) CVX_LOAD(va, it2); CVX_FINISH(vb, it1); }
        it = it2;
    }
#undef CVX_DECODE
#undef CVX_LOAD
#undef CVX_FINISH
}
__device__ __forceinline__ void convert_plain(Frame& F, const float* src, bf16_t* dst, size_t n) {
    const size_t n4 = n / 4;
    for (size_t i = (size_t)F.c * 512 + F.tid; i < n4; i += (size_t)F.G * 512) { const f32x4 v = ((const f32x4*)src)[i]; u32x2 w; w.x = cvt_pk_bf16(v[0], v[1]); w.y = cvt_pk_bf16(v[2], v[3]); ((u32x2*)dst)[i] = w; }
}
__device__ __forceinline__ void import_x(Frame& F, bool copy_f32) {
    const size_t n4 = (size_t)NT * D / 4, np4 = (size_t)NTP * D / 4, st = (size_t)F.G * 512;
    f32x4* XF = (f32x4*)(F.ws + WS_XF); u32x2* XB = (u32x2*)(F.ws + WS_XB);
    for (size_t i0 = (size_t)F.c * 512 + F.tid; i0 < n4; i0 += st * 8) {
        f32x4 v[8];
#pragma unroll
        for (int u = 0; u < 8; ++u) { const size_t i = i0 + st * u;
            if (i < n4) { if (copy_f32) { v[u] = (i < np4) ? ((const f32x4*)F.in[I_XP])[i] : ((const f32x4*)F.in[I_XS])[i - np4]; } else v[u] = XF[i]; } }
#pragma unroll
        for (int u = 0; u < 8; ++u) { const size_t i = i0 + st * u;
            if (i < n4) { u32x2 w; w.x = cvt_pk_bf16(v[u][0], v[u][1]); w.y = cvt_pk_bf16(v[u][2], v[u][3]); XB[i] = w; } }
    }
}

__device__ __forceinline__ void s5_lam(const float* lre, const float* lim, const float* ldt, int dir, int g, int p, double& dt, double& lr, double& li) {
    dt = exp((double)ldt[dir * 64 + g]); lr = (double)lre[(dir * 64 + g) * 64 + p]; li = (double)lim[(dir * 64 + g) * 64 + p];
}
__device__ __forceinline__ void s5_fill_bc(Frame& F, int g, int dir, const LAS double* LBd, LAS float* Bbr, LAS float* Bbi, LAS float* Cr, LAS float* Ci) {
    for (int idx = F.tid; idx < 1024; idx += 512) {
        const int p = idx >> 4, h = idx & 15; const double fr = LBd[p * 4 + 2], fi = LBd[p * 4 + 3];
        const double br = F.in[I_ABRE][((dir * 64 + g) * 64 + p) * 16 + h], bi = F.in[I_ABIM][((dir * 64 + g) * 64 + p) * 16 + h];
        Bbr[idx] = (float)(fr * br - fi * bi); Bbi[idx] = (float)(fr * bi + fi * br);
        Cr[idx] = F.in[I_ACRE][(dir * 64 + g) * 1024 + idx]; Ci[idx] = F.in[I_ACIM][(dir * 64 + g) * 1024 + idx];
    }
}
__device__ __forceinline__ void s5_build_item(Frame& F, int g, int dir) {
    LAS float* LPr = (LAS float*)F.lds; LAS float* LPi = LPr + 33 * 64;
    LAS float* Bbr = LPi + 33 * 64; LAS float* Bbi = Bbr + 1024; LAS float* Cr = Bbi + 1024; LAS float* Ci = Cr + 1024;
    LAS float* B2r = Ci + 1024; LAS float* B2i = B2r + 1024; LAS float* C2r = B2i + 1024; LAS float* C2i = C2r + 1024;
    LAS float* KD = C2i + 1024;
    bf16_t* M2T = (bf16_t*)(F.ws + PO_M2T) + (size_t)g * 256 * 512; bf16_t* M13T = (bf16_t*)(F.ws + PO_M13T) + (size_t)g * 512 * UAK;
    LAS double* LB = (LAS double*)(KD + 32 * 256);
    __syncthreads();
    if (F.tid < 128) { const int dd = F.tid >> 6, p = F.tid & 63;
        if (dd == 0 || dir == 0) { double dt, lr, li; s5_lam(F.in[I_ALRE], F.in[I_ALIM], F.in[I_ALDT], dd == 0 ? dir : 1, g, p, dt, lr, li);
            const double er = exp(lr * dt), lbr = er * cos(li * dt), lbi = er * sin(li * dt), nr = lbr - 1.0, ni = lbi, den = lr * lr + li * li;
            LB[(dd * 64 + p) * 4 + 0] = lbr; LB[(dd * 64 + p) * 4 + 1] = lbi; LB[(dd * 64 + p) * 4 + 2] = (nr * lr + ni * li) / den; LB[(dd * 64 + p) * 4 + 3] = (ni * lr - nr * li) / den; } }
    __syncthreads();
    for (int idx = F.tid; idx < 33 * 64; idx += 512) { const int e = idx >> 6, p = idx & 63; double br = LB[p * 4], bi = LB[p * 4 + 1], rr = 1.0, ri = 0.0;
        for (int b = e; b != 0; b >>= 1) { if (b & 1) { const double t = rr * br - ri * bi; ri = rr * bi + ri * br; rr = t; } const double t2 = br * br - bi * bi; bi = 2.0 * br * bi; br = t2; }
        LPr[idx] = (float)rr; LPi[idx] = (float)ri; }
    s5_fill_bc(F, g, dir, LB, Bbr, Bbi, Cr, Ci);
    if (dir == 0) s5_fill_bc(F, g, 1, LB + 256, B2r, B2i, C2r, C2i);
    __syncthreads();
    {
        const int k = F.tid, j = k >> 4, h = k & 15, e = dir == 0 ? (TCH - 1 - j) : j;
        for (int p = 0; p < 64; ++p) { const float lr = LPr[e * 64 + p], li = LPi[e * 64 + p], br = Bbr[p * 16 + h], bi = Bbi[p * 16 + h];
            const float xr = lr * br - li * bi, xi = lr * bi + li * br;
            M2T[(size_t)(dir * 128 + p) * 512 + k] = (bf16_t)(cvt_pk_bf16(xr, 0.f) & 0xffffu); M2T[(size_t)(dir * 128 + 64 + p) * 512 + k] = (bf16_t)(cvt_pk_bf16(xi, 0.f) & 0xffffu); }
    }
    {
        const int p = F.tid & 63, q8 = F.tid >> 6;
        for (int ic = q8; ic < 512; ic += 8) { const int i = ic >> 4, c = ic & 15, e = dir == 0 ? (i + 1) : (TCH - i);
            const float cr = Cr[c * 64 + p], ci = Ci[c * 64 + p], lr = LPr[e * 64 + p], li = LPi[e * 64 + p];
            const float vr = cr * lr - ci * li, vi = cr * li + ci * lr;
            M13T[(size_t)ic * UAK + 512 + dir * 128 + p] = (bf16_t)(cvt_pk_bf16(vr, 0.f) & 0xffffu); M13T[(size_t)ic * UAK + 512 + dir * 128 + 64 + p] = (bf16_t)(cvt_pk_bf16(-vi, 0.f) & 0xffffu); }
    }
    {
        const int ch = F.tid & 255, c = ch >> 4, h = ch & 15, par = F.tid >> 8;
        if (dir == 0 && par == 0) {
            float s = (c == h) ? F.in[I_AD][g * 16 + c] : 0.f;
            for (int p = 0; p < 64; ++p) s += Cr[c * 64 + p] * Bbr[p * 16 + h] - Ci[c * 64 + p] * Bbi[p * 16 + h] + C2r[c * 64 + p] * B2r[p * 16 + h] - C2i[c * 64 + p] * B2i[p * 16 + h];
            KD[ch] = s;
        }
#pragma nounroll
        for (int hp = 0; hp < 64; hp += 32) {
            float cbr[32], cbi[32];
#pragma unroll
            for (int p = 0; p < 32; ++p) { const float cr = Cr[c * 64 + hp + p], ci = Ci[c * 64 + hp + p], br = Bbr[(hp + p) * 16 + h], bi = Bbi[(hp + p) * 16 + h]; cbr[p] = cr * br - ci * bi; cbi[p] = cr * bi + ci * br; }
#pragma nounroll
            for (int d = 1 + par; d < TCH; d += 2) {
                float s0 = 0.f, s1 = 0.f;
#pragma unroll
                for (int p = 0; p < 32; p += 4) { const f32x4 lr = *(const LAS f32x4*)(LPr + d * 64 + hp + p), li = *(const LAS f32x4*)(LPi + d * 64 + hp + p);
                    s0 += cbr[p] * lr[0]; s1 -= cbi[p] * li[0]; s0 += cbr[p + 1] * lr[1]; s1 -= cbi[p + 1] * li[1]; s0 += cbr[p + 2] * lr[2]; s1 -= cbi[p + 2] * li[2]; s0 += cbr[p + 3] * lr[3]; s1 -= cbi[p + 3] * li[3]; }
                if (hp == 0) KD[d * 256 + ch] = s0 + s1; else KD[d * 256 + ch] += s0 + s1;
            }
        }
        __syncthreads();
        for (int idx = F.tid; idx < 512 * 64; idx += 512) { const int hf = idx & 1, j = (idx >> 1) & 31, ic = idx >> 6, i = ic >> 4, cc = ic & 15;
            const bool mine = dir == 0 ? (j <= i) : (j > i);
            if (mine) { const int d = dir == 0 ? (i - j) : (j - i); const f32x4 v0 = *(const LAS f32x4*)(KD + d * 256 + cc * 16 + hf * 8), v1 = *(const LAS f32x4*)(KD + d * 256 + cc * 16 + hf * 8 + 4);
                u32x4 v; v.x = cvt_pk_bf16(v0[0], v0[1]); v.y = cvt_pk_bf16(v0[2], v0[3]); v.z = cvt_pk_bf16(v1[0], v1[1]); v.w = cvt_pk_bf16(v1[2], v1[3]); *(u32x4*)(M13T + (size_t)ic * UAK + j * 16 + hf * 8) = v; } }
    }
    __syncthreads();
}

__device__ __forceinline__ void s5_recurrence(Frame& F) {
    const float* S = (const float*)(F.ws + PO_SG); bf16_t* UA = (bf16_t*)(F.ws + PO_UA);
    for (int base = F.c * 256; base < 65536; base += F.G * 256) {
        if (F.tid >= 256) continue;
        const int flat = base + F.tid, p = flat & 63, dir = (flat >> 6) & 1, g = (flat >> 7) & 63, gb = flat >> 13;
        double dt, lr, li; s5_lam(F.in[I_ALRE], F.in[I_ALIM], F.in[I_ALDT], dir, g, p, dt, lr, li);
        const double er = exp(lr * dt * TCH); const float ar = (float)(er * cos(li * dt * TCH)), ai = (float)(er * sin(li * dt * TCH));
        const int nc = gb < 4 ? 256 : 128, chunk0 = gb < 4 ? gb * 256 : 1024 + (gb - 4) * 128;
        float hr = 0.f, hi = 0.f;
        for (int s0 = 0; s0 < nc; s0 += 8) {
            float sr[8], si[8];
#pragma unroll
            for (int k = 0; k < 8; ++k) { const int cc = dir == 0 ? (s0 + k) : (nc - 1 - s0 - k); const size_t o = ((size_t)g * NCHUNK + (chunk0 + cc)) * 256 + dir * 128 + p; sr[k] = S[o]; si[k] = S[o + 64]; }
#pragma unroll
            for (int k = 0; k < 8; ++k) { const int cc = dir == 0 ? (s0 + k) : (nc - 1 - s0 - k); const size_t o = ((size_t)g * NCHUNK + (chunk0 + cc)) * UAK + 512 + dir * 128 + p;
                UA[o] = (bf16_t)(cvt_pk_bf16(hr, 0.f) & 0xffffu); UA[o + 64] = (bf16_t)(cvt_pk_bf16(hi, 0.f) & 0xffffu);
                const float nr = ar * hr - ai * hi + sr[k], ni = ar * hi + ai * hr + si[k]; hr = nr; hi = ni; }
        }
    }
}

__device__ __forceinline__ void add_bf16x4(f32x4& v, const u32x2 w) { v[0] += __uint_as_float(w.x << 16); v[1] += __uint_as_float(w.x & 0xffff0000u); v[2] += __uint_as_float(w.y << 16); v[3] += __uint_as_float(w.y & 0xffff0000u); }
constexpr int WRS = 1028;
__device__ __forceinline__ void ln_router_fill(Frame& F, const float* gam, const float* bet, const float* wrouter) {
    LAS float* wrT = (LAS float*)F.lds; LAS float* gsh = wrT + 16 * WRS; LAS float* bsh = gsh + 1024;
    __syncthreads();
    for (int i = F.tid; i < 16384; i += 512) { const int k = i >> 4, e = i & 15; wrT[e * WRS + k] = wrouter[i]; }
    for (int i = F.tid; i < 1024; i += 512) { gsh[i] = gam[i]; bsh[i] = bet[i]; }
    __syncthreads();
}
#ifndef RES_BF16
#define RES_BF16 1
#endif
template <int MODE, bool ROUTER, bool FINAL, bool SRCIN = false>
__device__ __forceinline__ void ln_phase(Frame& F, const bf16_t* HB, const float* gam, const float* bet, const float* wrouter) {
    float* XF = (float*)(F.ws + WS_XF);
    LAS float* wrT = (LAS float*)F.lds;
    LAS float* gsh = wrT + 16 * WRS; LAS float* bsh = gsh + 1024;
    f32x4 gv[4], bv[4];
    if (!ROUTER) {
#pragma unroll
        for (int j = 0; j < 4; ++j) { gv[j] = *(const f32x4*)(gam + F.lane * 4 + 256 * j); bv[j] = *(const f32x4*)(bet + F.lane * 4 + 256 * j); } }
    const unsigned char* wsb = F.ws; int ln = F.lane; unsigned lb4 = (unsigned)ln * 16u, lb2 = (unsigned)ln * 8u, lb1 = (unsigned)ln * 4u;
    const unsigned hb_off = (unsigned)((const unsigned char*)HB - wsb);
    const int nq = F.xok ? 6 : (NT / 4 + F.G * 8 - 1) / (F.G * 8);
    constexpr bool X32 = SRCIN || !RES_BF16;
    f32x4 xr32[4][4]; u32x2 xr16[4][4], hwr[4][4];
#define LN_ISSUE(row0_) do { const int _r0 = (row0_); \
        const unsigned char* xbase = SRCIN ? (_r0 < NTP ? (const unsigned char*)F.in[I_XP] : (const unsigned char*)F.in[I_XS] - (size_t)NTP * 4096) : wsb + WS_XF;      \
        if (X32) { _Pragma("unroll") for (int r = 0; r < 4; ++r) { const unsigned ro = (unsigned)(_r0 + r) * 4096u + lb4; _Pragma("unroll") for (int j = 0; j < 4; ++j) xr32[r][j] = *(const f32x4*)(xbase + ro + 1024u * j); } } \
        else { _Pragma("unroll") for (int r = 0; r < 4; ++r) { const unsigned ro = (unsigned)(_r0 + r) * 2048u + lb2; _Pragma("unroll") for (int j = 0; j < 4; ++j) xr16[r][j] = *(const u32x2*)(xbase + ro + 512u * j); } } \
        if (MODE == 0) { _Pragma("unroll") for (int r = 0; r < 4; ++r) { const unsigned ro = hb_off + (unsigned)(_r0 + r) * 2048u + lb2; _Pragma("unroll") for (int j = 0; j < 4; ++j) hwr[r][j] = *(const u32x2*)(wsb + ro + 512u * j); } } \
    } while (0)
#define LN_Q(qi_) (F.xok ? ((F.c & 7) * 1536 + (F.c >> 3) * 48 + F.wave * 6 + (qi_)) : (F.c * 8 + F.wave + (qi_) * F.G * 8))
    u32x4 sln = {~0u, ~0u, ~0u, ~0u};
    if (MODE == 1) { const int q0 = LN_Q(0); if (nq > 0 && q0 < NT / 4 && F.lane < 16) sln = *(const u32x4*)(wsb + (unsigned)(WS_SLOT + ((size_t)F.lane * NT + (size_t)q0 * 4) * 4)); }
    { const int q0 = LN_Q(0); if (nq > 0 && q0 < NT / 4) { LN_ISSUE(q0 * 4); } }
    for (int qi = 0; qi < nq; ++qi) {
        const int q = LN_Q(qi);
        if (q >= NT / 4) break;
        const int row0 = q * 4;
        const u32x4 slc = sln;
        if (MODE == 1) { const int qn = LN_Q(qi + 1); if (qi + 1 < nq && qn < NT / 4 && ln < 16) sln = *(const u32x4*)(wsb + (unsigned)(WS_SLOT + ((size_t)ln * NT + (size_t)qn * 4) * 4)); }
        asm volatile("v_mbcnt_lo_u32_b32 %0, -1, 0\n\tv_mbcnt_hi_u32_b32 %0, -1, %0" : "=v"(ln));
        lb4 = (unsigned)ln * 16u; lb2 = (unsigned)ln * 8u; lb1 = (unsigned)ln * 4u; const int lw = ln * 4;
        f32x4 v[4][4];
#pragma unroll
        for (int r = 0; r < 4; ++r)
#pragma unroll
            for (int j = 0; j < 4; ++j) {
                if (X32) v[r][j] = xr32[r][j];
                else { v[r][j][0] = __uint_as_float(xr16[r][j].x << 16); v[r][j][1] = __uint_as_float(xr16[r][j].x & 0xffff0000u); v[r][j][2] = __uint_as_float(xr16[r][j].y << 16); v[r][j][3] = __uint_as_float(xr16[r][j].y & 0xffff0000u); } }
        if (MODE == 0) {
#pragma unroll
            for (int r = 0; r < 4; ++r)
#pragma unroll
                for (int j = 0; j < 4; ++j) { v[r][j] = v[r][j] * ALPHA; add_bf16x4(v[r][j], hwr[r][j]); }
        }
        if (!ROUTER) { const int qn = LN_Q(qi + 1); if (qi + 1 < nq && qn < NT / 4) { LN_ISSUE(qn * 4); } }
        if (MODE == 0) {
        } else {
            const int grp = row0 >= NTP; int sl[4];
#pragma unroll
            for (int r = 0; r < 4; ++r) sl[r] = (ln < 16) ? (int)slc[r] : -1;
            unsigned long long mask[4]; bool any[4], two[4]; u32x2 wa[4][4], wb[4][4];
#pragma unroll
            for (int r = 0; r < 4; ++r) {
                unsigned long long mk = __ballot(sl[r] >= 0); any[r] = mk != 0ull;
                int e0 = 0, s0 = 0; if (any[r]) { e0 = __builtin_ctzll(mk); mk &= mk - 1; s0 = __builtin_amdgcn_readlane(sl[r], e0); }
                const unsigned y0 = any[r] ? (grp ? 65536u + e0 * 2048u + s0 : e0 * 4096u + s0) : 0u;
                two[r] = mk != 0ull; int e1 = 0, s1 = 0; if (two[r]) { e1 = __builtin_ctzll(mk); mk &= mk - 1; s1 = __builtin_amdgcn_readlane(sl[r], e1); }
                const unsigned y1 = two[r] ? (grp ? 65536u + e1 * 2048u + s1 : e1 * 4096u + s1) : y0;
                mask[r] = mk;
                const unsigned char* ya = wsb + PO_YE + (size_t)y0 * 2048; const unsigned char* yb = wsb + PO_YE + (size_t)y1 * 2048;
#pragma unroll
                for (int j = 0; j < 4; ++j) { wa[r][j] = *(const u32x2*)(ya + lb2 + 512u * j); wb[r][j] = *(const u32x2*)(yb + lb2 + 512u * j); }
            }
#pragma unroll
            for (int r = 0; r < 4; ++r) {
#pragma unroll
                for (int j = 0; j < 4; ++j) { v[r][j] = v[r][j] * ALPHA; if (any[r]) add_bf16x4(v[r][j], wa[r][j]); if (two[r]) add_bf16x4(v[r][j], wb[r][j]); }
                unsigned long long mk = mask[r];
                while (mk) {
                    const int e0 = __builtin_ctzll(mk); mk &= mk - 1; const int s0 = __builtin_amdgcn_readlane(sl[r], e0);
                    const unsigned y0 = grp ? 65536u + e0 * 2048u + s0 : e0 * 4096u + s0;
                    const bool tw = mk != 0ull; int e1 = 0, s1 = 0; if (tw) { e1 = __builtin_ctzll(mk); mk &= mk - 1; s1 = __builtin_amdgcn_readlane(sl[r], e1); }
                    const unsigned y1 = tw ? (grp ? 65536u + e1 * 2048u + s1 : e1 * 4096u + s1) : y0;
                    const unsigned char* ya = wsb + PO_YE + (size_t)y0 * 2048; const unsigned char* yb = wsb + PO_YE + (size_t)y1 * 2048;
                    u32x2 xa[4], xb[4];
#pragma unroll
                    for (int j = 0; j < 4; ++j) { xa[j] = *(const u32x2*)(ya + lb2 + 512u * j); xb[j] = *(const u32x2*)(yb + lb2 + 512u * j); }
#pragma unroll
                    for (int j = 0; j < 4; ++j) { add_bf16x4(v[r][j], xa[j]); if (tw) add_bf16x4(v[r][j], xb[j]); }
                }
            }
        }
#pragma unroll
        for (int r = 0; r < 4; ++r) {
            float s = 0.f;
#pragma unroll
            for (int j = 0; j < 4; ++j) s += (v[r][j][0] + v[r][j][1]) + (v[r][j][2] + v[r][j][3]);
            const float mean = wave_sum(s) * (1.f / D); float qq = 0.f;
#pragma unroll
            for (int j = 0; j < 4; ++j) { v[r][j] = v[r][j] - mean; qq += (v[r][j][0] * v[r][j][0] + v[r][j][1] * v[r][j][1]) + (v[r][j][2] * v[r][j][2] + v[r][j][3] * v[r][j][3]); }
            const float rstd = 1.f / sqrtf(wave_sum(qq) * (1.f / D) + LN_EPS);
#pragma unroll
            for (int j = 0; j < 4; ++j) { if (ROUTER) { gv[j] = *(const LAS f32x4*)(gsh + lw + 256 * j); bv[j] = *(const LAS f32x4*)(bsh + lw + 256 * j); } v[r][j] = v[r][j] * rstd * gv[j] + bv[j]; }
            const unsigned row = (unsigned)(row0 + r);
            if (FINAL) {
                unsigned char* ob = (unsigned char*)F.out;
#pragma unroll
                for (int j = 0; j < 4; ++j) *(f32x4*)(ob + (size_t)(row * 4096u + lb4 + 1024u * j)) = v[r][j];
            } else {
                unsigned char* wsw = F.ws;
#pragma unroll
                for (int j = 0; j < 4; ++j) {
                    if (RES_BF16) { u32x2 xo; xo.x = cvt_pk_bf16_c(v[r][j][0], v[r][j][1]); xo.y = cvt_pk_bf16_c(v[r][j][2], v[r][j][3]); *(u32x2*)(wsw + (unsigned)(WS_XF + row * 2048u + lb2 + 512u * j)) = xo; }
                    else *(f32x4*)(wsw + (unsigned)(WS_XF + row * 4096u + lb4 + 1024u * j)) = v[r][j];
                    *(unsigned*)(wsw + (unsigned)(WS_XB8 + row * 1024u + lb1 + 256u * j)) = cvt4_fp8(v[r][j][0] * FP8_SX, v[r][j][1] * FP8_SX, v[r][j][2] * FP8_SX, v[r][j][3] * FP8_SX); }
            }
        }
        if (ROUTER) {
            { const int qn = LN_Q(qi + 1); if (qi + 1 < nq && qn < NT / 4) { LN_ISSUE(qn * 4); } }
            float val[64];
#pragma unroll
            for (int hf = 0; hf < 4; ++hf) {
                f32x2 a2[4][4];
#pragma unroll
                for (int r = 0; r < 4; ++r)
#pragma unroll
                    for (int e4 = 0; e4 < 4; ++e4) a2[r][e4] = f32x2{0.f, 0.f};
#pragma unroll
                for (int e4 = 0; e4 < 4; ++e4)
#pragma unroll
                    for (int j = 0; j < 4; ++j) { const f32x4 w = *(const LAS f32x4*)(wrT + (hf * 4 + e4) * WRS + lw + 256 * j);
                        const f32x2 wl = f32x2{w[0], w[1]}, wh = f32x2{w[2], w[3]};
#pragma unroll
                        for (int r = 0; r < 4; ++r) { a2[r][e4] = f32x2{v[r][j][0], v[r][j][1]} * wl + a2[r][e4]; a2[r][e4] = f32x2{v[r][j][2], v[r][j][3]} * wh + a2[r][e4]; } }
#pragma unroll
                for (int r = 0; r < 4; ++r)
#pragma unroll
                    for (int e4 = 0; e4 < 4; ++e4) val[r * 16 + hf * 4 + e4] = a2[r][e4][0] + a2[r][e4][1];
            }
#pragma unroll
            for (int sft = 5; sft >= 0; --sft) { const int n2 = 1 << sft; const bool up = (ln >> sft) & 1;
#pragma unroll
                for (int i = 0; i < n2; ++i) { const float lo = val[i], hi = val[i + n2]; const float mine = up ? hi : lo, other = up ? lo : hi; val[i] = mine + __shfl_xor(other, n2); } }
            const float lg = val[0], m = row_max(lg);
            const float ex = expf(lg - m); const float l = row_sum(ex);
            *(float*)(F.ws + (unsigned)(WS_AFF + ((size_t)(ln & 15) * NT + row0 + (ln >> 4)) * 4)) = ex / l;
        }
    }
#undef LN_Q
#undef LN_ISSUE
    if (ROUTER) __syncthreads();
}
__device__ __forceinline__ void softmax_phase(Frame& F, bf16_t* SB) {
    for (int row = F.c * 8 + F.wave; row < NT * 4; row += F.G * 8) {
        u32x2* p = (u32x2*)(SB + (size_t)row * 256) + F.lane; const u32x2 w = *p;
        float a = __uint_as_float(w.x << 16), b = __uint_as_float(w.x & 0xffff0000u), c = __uint_as_float(w.y << 16), d = __uint_as_float(w.y & 0xffff0000u);
        const float m = wave_max(fmaxf(fmaxf(a, b), fmaxf(c, d)));
        a = __expf(a - m); b = __expf(b - m); c = __expf(c - m); d = __expf(d - m);
        const float inv = 1.f / wave_sum((a + b) + (c + d));
        u32x2 o; o.x = cvt_pk_bf16(a * inv, b * inv); o.y = cvt_pk_bf16(c * inv, d * inv); *p = o;
    }
}
__device__ __forceinline__ void moe_panel(int P, int& e, int& grp, int& yerow0) {
    if (P < 256) { e = P >> 4; grp = 0; } else { e = (P - 256) >> 3; grp = 1; }
    yerow0 = P * 256;
}
#ifndef UPWGM
#define UPWGM 8
#endif
struct SchedUp { unsigned char* ws; int G, c;
    __device__ __forceinline__ bool next(int i, GUnit& u) const { int P, pn; if (!static_unit<UPWGM>(i, G, c, 384, 16, P, pn)) return false; int e, grp, y0; moe_panel(P, e, grp, y0);
        u.A = (const char*)ws + WS_XB8 + (grp ? (size_t)NTP * 1024 : 0); u.B = (const char*)ws + WS_EW13 + ((size_t)e * 4096 + pn * BM) * 1024;
        u.C = (char*)ws + PO_HM + ((size_t)P * BM * 2048 + pn * HALF); u.X = (const int*)(ws + WS_IDX) + y0; u.pm = P; u.pn = pn; return true; } };
struct SchedDown { unsigned char* ws; int G, c;
    __device__ __forceinline__ bool next(int i, GUnit& u) const { int P, pn; if (!static_unit(i, G, c, 384, 4, P, pn)) return false; int e, grp, y0; moe_panel(P, e, grp, y0);
        u.A = (const char*)ws + PO_HM + (size_t)P * BM * 2048; u.B = (const char*)ws + WS_EW2 + ((size_t)e * 1024 + pn * BM) * 2048;
        u.C = (char*)ws + PO_YE + ((size_t)y0 * 1024 + pn * BM) * 2; u.X = (const float*)(ws + WS_GATE) + y0; u.pm = P; u.pn = pn; return true; } };
struct SchedQKV { unsigned char* ws; int G, c;
    __device__ __forceinline__ bool next(int i, GUnit& u) const { const int L = i * G + c; if (L >= 1536 + 768) return false;
        if (L < 1536) { int pm, pn; static_unit(i, G, c, 192, 8, pm, pn);
            u.A = (const char*)ws + WS_XB8 + (size_t)pm * BM * 1024; u.B = (const char*)ws + WS_WQKV + (size_t)pn * BM * 1024;
            u.C = (char*)ws + (pn < 4 ? PO_Q : PO_K) + ((size_t)pm * BM * 1024 + (pn & 3) * BM) * 2; u.X = nullptr; u.pm = pm; u.pn = pn; return true; }
        const int r = L - 1536, pmv = r & 3, pnv = r >> 2;
        u.A = (const char*)ws + WS_WQKV + (size_t)(2048 + pmv * BM) * 1024; u.B = (const char*)ws + WS_XB8 + (size_t)pnv * BM * 1024;
        u.C = (char*)ws + PO_VT + ((size_t)pmv * BM * NT + (size_t)pnv * BM) * 2; u.X = nullptr; u.pm = pmv; u.pn = 8 + pnv; return true; } };
struct EpiQKV {
    static constexpr bool PERM = true;
    __device__ __forceinline__ void operator()(const Acc& acc, const GUnit& u, int wr, int wc, int fr, int fq) const {
        constexpr float ds = 1.f / (FP8_SX * FP8_SWQKV);
        if (u.pn >= 8) { EpiBf<false> e{(unsigned)NT, ds}; e(acc, u, wr, wc, fr, fq); }
        else { EpiBf<false> e{1024u, u.pn < 4 ? 0.125f * 1.4426950408889634f * ds : ds}; e(acc, u, wr, wc, fr, fq); }
    }
};

__device__ __forceinline__ int wave_sum_i(int v) {
#pragma unroll
    for (int o = 1; o < 64; o <<= 1) v += __shfl_xor(v, o);
    return v;
}
__device__ __forceinline__ int block_excl_scan(int v, int lane, int wave, LAS int* red, int& total) {
    int inc = v;
#pragma unroll
    for (int o = 1; o < 64; o <<= 1) { const int t = __shfl_up(inc, o); if (lane >= o) inc += t; }
    __syncthreads();
    if (lane == 63) red[wave] = inc;
    __syncthreads();
    int off = 0, tot = 0;
#pragma unroll
    for (int w = 0; w < 8; ++w) { const int c = red[w]; if (w < wave) off += c; tot += c; }
    total = tot; return off + inc - v;
}
template <int PER>
__device__ __forceinline__ void select_fast(Frame& F, const float* affcol, int cap, int* idx_out, float* gate_out, int* slotcol) {
    LAS int* red = (LAS int*)F.lds;
    unsigned key[PER];
#pragma unroll
    for (int i = 0; i < PER / 4; ++i) { const u32x4 v = ((const u32x4*)(affcol + (size_t)F.tid * PER))[i]; key[4 * i] = v.x; key[4 * i + 1] = v.y; key[4 * i + 2] = v.z; key[4 * i + 3] = v.w; }
    unsigned T = 0u;
    for (int b = 30; b >= 0; --b) {
        const unsigned cand = T | (1u << b); int cnt = 0;
#pragma unroll
        for (int i = 0; i < PER; ++i) cnt += (key[i] >= cand) ? 1 : 0;
        cnt = wave_sum_i(cnt);
        LAS int* r = red + (b & 1) * 8;
        if (F.lane == 0) r[F.wave] = cnt;
        __syncthreads();
        int tot = 0;
#pragma unroll
        for (int w = 0; w < 8; ++w) tot += r[w];
        if (tot >= cap) T = cand;
    }
    int g = 0, q = 0;
#pragma unroll
    for (int i = 0; i < PER; ++i) { g += (key[i] > T) ? 1 : 0; q += (key[i] == T) ? 1 : 0; }
    int tot_g, tot_q; (void)tot_q;
    const int Eoff = block_excl_scan(q, F.lane, F.wave, red + 32, tot_q);
    int dummy; const int Goff = block_excl_scan(g, F.lane, F.wave, red + 32, tot_g); (void)Goff;
    const int need_eq = cap - tot_g;
    int eq_take = need_eq - Eoff; eq_take = eq_take < 0 ? 0 : (eq_take > q ? q : eq_take);
    const int base = block_excl_scan(g + eq_take, F.lane, F.wave, red + 32, dummy);
    int slot = base, eqseen = 0;
    const int tok0 = F.tid * PER;
#pragma unroll
    for (int i4 = 0; i4 < PER / 4; ++i4) { int so[4];
#pragma unroll
        for (int j = 0; j < 4; ++j) { const int i = 4 * i4 + j; const unsigned k = key[i]; bool sel = k > T; if (k == T) { sel = eqseen < eq_take; ++eqseen; }
            so[j] = sel ? slot : -1; if (sel) { idx_out[slot] = tok0 + i; gate_out[slot] = __uint_as_float(k); ++slot; } }
        ((int4*)(slotcol + tok0))[i4] = make_int4(so[0], so[1], so[2], so[3]); }
}
__device__ __forceinline__ void select_phase(Frame& F) {
    for (int it = F.c; it < 32; it += F.G) {
        const int grp = it >> 4, e = it & 15; const int n = grp ? NTS : NTP, cap = n / 8;
        const float* affcol = (const float*)(F.ws + WS_AFF) + (size_t)e * NT + (grp ? NTP : 0);
        int* idx = (int*)(F.ws + WS_IDX) + (grp ? 65536 : 0) + e * cap; float* gate = (float*)(F.ws + WS_GATE) + (grp ? 65536 : 0) + e * cap;
        int* slotcol = (int*)(F.ws + WS_SLOT) + (size_t)e * NT + (grp ? NTP : 0);
        __syncthreads();
        if (grp == 0) select_fast<64>(F, affcol, cap, idx, gate, slotcol); else select_fast<32>(F, affcol, cap, idx, gate, slotcol);
        __syncthreads();
    }
}

__device__ __forceinline__ void natten_fill(Frame& F, const float* rpb) {
    LAS float* rpbs = (LAS float*)F.lds;
    __syncthreads();
    for (int i = F.tid; i < 16 * 15 * 31; i += 512) rpbs[i] = rpb[i] * 1.4426950408889634f;
    __syncthreads();
}
__device__ __forceinline__ void natten_phase(Frame& F, const float* rpb) {
    const bf16_t* Kb = (const bf16_t*)(F.ws + PO_K); const bf16_t* VT = (const bf16_t*)(F.ws + PO_VT); bf16_t* QO = (bf16_t*)(F.ws + PO_Q);
    LAS float* rpbs = (LAS float*)F.lds;
    const int lane = F.lane, w = F.wave, fr = lane & 15, fq = lane >> 4;
    bool c0[4], c2[4]; int xe[4];
#pragma unroll
    for (int e = 0; e < 4; ++e) { xe[e] = 4 * fq + e - fr; c0[e] = xe[e] >= 8; c2[e] = xe[e] < -8; }
    const bool fA = fr < 8, fC = fr > 8;
    LAS bf16_t* Ks = (LAS bf16_t*)(F.lds + 32768); LAS bf16_t* Vs = Ks + 2 * 64 * 72;
    const int lrow = F.tid >> 3, lchk = F.tid & 7;
    const int nblk = F.xok ? 6 : 1536;
    for (int it = F.xok ? 0 : F.c; it < nblk; it += F.xok ? 1 : F.G) {
        int gb, h, rb, rows;
        if (F.xok) { const int u = (F.c >> 3) + 32 * it, t = 12 * (F.c & 7) + (u >> 4); h = u & 15;
            if (t < 64) { gb = t >> 4; rb = t & 15; rows = 128; } else { gb = 4 + ((t - 64) >> 3); rb = (t - 64) & 7; rows = 64; } }
        else { const int blk = it; if (blk < 1024) { gb = blk >> 8; h = (blk >> 4) & 15; rb = blk & 15; rows = 128; } else { const int V = blk - 1024; gb = 4 + (V >> 7); h = (V >> 3) & 15; rb = V & 7; rows = 64; } }
        const int r = rb * 8 + w;
        int rs = r - 4; rs = rs < 0 ? 0 : (rs > rows - 8 ? rows - 8 : rs);
        int kr_lo = rb * 8 - 4; kr_lo = kr_lo < 0 ? 0 : (kr_lo > rows - 8 ? rows - 8 : kr_lo);
        int kr_hi = rb * 8 + 7 - 4; kr_hi = (kr_hi < 0 ? 0 : (kr_hi > rows - 8 ? rows - 8 : kr_hi)) + 8;
        const size_t tb = (size_t)gb_tok0(gb), tq0 = tb + (size_t)r * 64;
        bf16x8 Qf[4][2];
        float mrun[4], lrun[4]; f32x4 Ot[4][4];
#pragma unroll
        for (int qt = 0; qt < 4; ++qt) { mrun[qt] = -INFINITY; lrun[qt] = 0.f;
#pragma unroll
            for (int dt = 0; dt < 4; ++dt) Ot[dt][qt] = (f32x4){0.f, 0.f, 0.f, 0.f}; }
        const bf16_t* kg = Kb + (tb + (size_t)kr_lo * 64 + lrow) * D + h * 64 + lchk * 8; const bf16_t* vg = VT + (size_t)(h * 64 + lrow) * NT + tb + (size_t)kr_lo * 64 + lchk * 8;
        const int nrows = kr_hi - kr_lo;
#define NA_LOAD(dst, ptr) asm volatile("global_load_dwordx4 %0, %1, off" : "=&v"(dst) : "v"(ptr) : "memory")
        u32x4 kA, vA, kB, vB;
        { const u32x4 k0r = *(const u32x4*)kg, v0r = *(const u32x4*)vg;
#pragma unroll
          for (int t = 0; t < 4; ++t)
#pragma unroll
              for (int ks = 0; ks < 2; ++ks) Qf[t][ks] = *(const bf16x8*)(QO + (tq0 + 16 * t + fr) * D + h * 64 + 32 * ks + 8 * fq);
          { const bf16_t* kp = kg + (size_t)64 * D; const bf16_t* vp = vg + 64; NA_LOAD(kB, kp); NA_LOAD(vB, vp); }
          __syncthreads();
          *(LAS u32x4*)(Ks + lrow * 72 + lchk * 8) = k0r; *(LAS u32x4*)(Vs + lrow * 72 + lchk * 8) = v0r; }
#pragma unroll
        for (int t = 0; t < 4; ++t)
#pragma unroll
            for (int ks = 0; ks < 2; ++ks) asm volatile("" :: "v"(Qf[t][ks]));
        asm volatile("s_waitcnt vmcnt(0)" ::: "memory");
        __syncthreads();
#pragma nounroll
        for (int i2 = 0; i2 < nrows; i2 += 2) {
#pragma unroll
          for (int jj = 0; jj < 2; ++jj) {
            const int i = i2 + jj; if (i >= nrows) break;
            const int kr = kr_lo + i; const int buf = jj; const bool more = i + 1 < nrows, more2 = i + 2 < nrows;
            if (more2) { const bf16_t* kp = kg + (size_t)(i + 2) * 64 * D; const bf16_t* vp = vg + (size_t)(i + 2) * 64;
                if (jj == 1) { NA_LOAD(kB, kp); NA_LOAD(vB, vp); } else { NA_LOAD(kA, kp); NA_LOAD(vA, vp); } }
            if (kr >= rs && kr < rs + 8) {
            const int dr = kr - r + 7;
            const LAS bf16_t* Kt = Ks + buf * (64 * 72); const LAS bf16_t* Vt = Vs + buf * (64 * 72);
            bf16x8 Kf[4][2];
#pragma unroll
            for (int t = 0; t < 4; ++t)
#pragma unroll
                for (int ks = 0; ks < 2; ++ks) Kf[t][ks] = *(const LAS bf16x8*)(Kt + (16 * t + fr) * 72 + 32 * ks + 8 * fq);
            float bsel[3][4];
#pragma unroll
            for (int e = 0; e < 4; ++e) { const int dcB = xe[e] + 15 + (c0[e] ? -16 : (c2[e] ? 16 : 0)), dcA = fA ? xe[e] + 15 : dcB, dcC = fC ? xe[e] + 15 : dcB;
                bsel[0][e] = rpbs[(h * 15 + dr) * 31 + dcA]; bsel[1][e] = rpbs[(h * 15 + dr) * 31 + dcB]; bsel[2][e] = rpbs[(h * 15 + dr) * 31 + dcC]; }
            bf16x8 Pf[4][2]; float alpha[4]; bool moved = false;
#pragma unroll
            for (int qt = 0; qt < 4; ++qt) {
                f32x4 St[3];
#pragma unroll
                for (int dk = 0; dk < 3; ++dk) { const int kt = qt + dk - 1; St[dk] = (f32x4){0.f, 0.f, 0.f, 0.f};
                    if (kt >= 0 && kt < 4) { St[dk] = __builtin_amdgcn_mfma_f32_16x16x32_bf16(Kf[kt][0], Qf[qt][0], St[dk], 0, 0, 0); St[dk] = __builtin_amdgcn_mfma_f32_16x16x32_bf16(Kf[kt][1], Qf[qt][1], St[dk], 0, 0, 0); } }
                constexpr int dummy = 0; (void)dummy;
                const int cls = qt == 0 ? 0 : (qt == 3 ? 2 : 1);
                float sv[4]; bool u0[4], u2[4]; float mx = -INFINITY;
#pragma unroll
                for (int e = 0; e < 4; ++e) { u0[e] = c0[e] && !(cls == 0 && fA) && !(cls == 2 && fC) && (qt > 0); u2[e] = c2[e] && !(cls == 0 && fA) && !(cls == 2 && fC) && (qt < 3);
                    sv[e] = (u0[e] ? St[0][e] : (u2[e] ? St[2][e] : St[1][e])) + bsel[cls][e]; mx = fmaxf(mx, sv[e]); }
                mx = x32_max(x16_max(mx));
                const float mnew = fmaxf(mrun[qt], mx); alpha[qt] = __builtin_amdgcn_exp2f(mrun[qt] - mnew); moved = moved || (mnew != mrun[qt]); mrun[qt] = mnew;
                float l = 0.f, p[4];
#pragma unroll
                for (int e = 0; e < 4; ++e) { p[e] = __builtin_amdgcn_exp2f(sv[e] - mnew); l += p[e]; }
                l = x32_sum(x16_sum(l)); lrun[qt] = lrun[qt] * alpha[qt] + l;
                float pv[4][4];
#pragma unroll
                for (int kt = 0; kt < 4; ++kt)
#pragma unroll
                    for (int e = 0; e < 4; ++e) { const int dk = kt - qt + 1; float v = 0.f; if (dk == 0) v = u0[e] ? p[e] : 0.f; else if (dk == 2) v = u2[e] ? p[e] : 0.f; else if (dk == 1) v = (u0[e] || u2[e]) ? 0.f : p[e]; pv[kt][e] = v; }
#pragma unroll
                for (int ks = 0; ks < 2; ++ks) { u32x4 wv; wv.x = cvt_pk_bf16_c(pv[2 * ks][0], pv[2 * ks][1]); wv.y = cvt_pk_bf16_c(pv[2 * ks][2], pv[2 * ks][3]); wv.z = cvt_pk_bf16_c(pv[2 * ks + 1][0], pv[2 * ks + 1][1]); wv.w = cvt_pk_bf16_c(pv[2 * ks + 1][2], pv[2 * ks + 1][3]);
                    Pf[qt][ks] = __builtin_bit_cast(bf16x8, wv); }
            }
            const bool rescale = __ballot(moved) != 0ull;
#pragma unroll
            for (int dt = 0; dt < 4; ++dt) {
                if (rescale) {
#pragma unroll
                    for (int qt = 0; qt < 4; ++qt) Ot[dt][qt] = Ot[dt][qt] * alpha[qt]; }
#pragma unroll
                for (int ks = 0; ks < 2; ++ks) { const u32x2 v0 = *(const LAS u32x2*)(Vt + (16 * dt + fr) * 72 + 32 * ks + 4 * fq), v1 = *(const LAS u32x2*)(Vt + (16 * dt + fr) * 72 + 32 * ks + 16 + 4 * fq);
                    u32x4 vv; vv.x = v0.x; vv.y = v0.y; vv.z = v1.x; vv.w = v1.y; const bf16x8 Vf = __builtin_bit_cast(bf16x8, vv);
#pragma unroll
                    for (int qt = 0; qt < 4; ++qt) { if ((qt == 0 && ks == 1) || (qt == 3 && ks == 0)) continue; Ot[dt][qt] = __builtin_amdgcn_mfma_f32_16x16x32_bf16(Vf, Pf[qt][ks], Ot[dt][qt], 0, 0, 0); } }
            }
            }
            if (more) {
                if (more2) asm volatile("s_waitcnt vmcnt(2)" ::: "memory"); else asm volatile("s_waitcnt vmcnt(0)" ::: "memory");
                LAS bf16_t* kd = Ks + (buf ^ 1) * (64 * 72) + lrow * 72 + lchk * 8; LAS bf16_t* vd = Vs + (buf ^ 1) * (64 * 72) + lrow * 72 + lchk * 8;
                if (jj == 1) { asm volatile("" : "+v"(kA), "+v"(vA)); *(LAS u32x4*)kd = kA; *(LAS u32x4*)vd = vA; } else { asm volatile("" : "+v"(kB), "+v"(vB)); *(LAS u32x4*)kd = kB; *(LAS u32x4*)vd = vB; }
            }
            __syncthreads();
          }
        }
#undef NA_LOAD
#pragma unroll
        for (int qt = 0; qt < 4; ++qt) { const float inv = 1.f / lrun[qt];
#pragma unroll
            for (int dt = 0; dt < 4; ++dt) { const f32x4 o = Ot[dt][qt] * inv; u32x2 wv; wv.x = cvt_pk_bf16_c(o[0], o[1]); wv.y = cvt_pk_bf16_c(o[2], o[3]);
                pst8(QO + (tq0 + 16 * qt + fr) * D + h * 64 + 16 * dt + 4 * fq, wv); } }
    }
    __syncthreads();
}
constexpr int N_PHASES = 31;
constexpr int FLAG_NO_XIMPORT = 1, FLAG_NO_EXPERTS0 = 2;
constexpr int CV_P1 = 3072, CV_P2 = CV_P1 + 1536, CV_SEL = CV_P2 + 5376, CV_SEL1 = 5376, CV_P0B = CV_SEL + 3584;
__global__ void __launch_bounds__(512, 2) fwd(Args args) {
    extern __shared__ __attribute__((aligned(16))) unsigned char lds_raw[];
    Frame F; F.lds = (LAS unsigned char*)lds_raw; F.ws = args.ws; F.in = args.in; F.out = args.out;
    F.tid = threadIdx.x; F.lane = F.tid & 63; F.wave = __builtin_amdgcn_readfirstlane(F.tid >> 6); F.G = gridDim.x; F.c = blockIdx.x; F.xok = false;
    unsigned char* ws = args.ws;
    const int wave_s = __builtin_amdgcn_readfirstlane(threadIdx.x >> 6);
    for (int u = F.tid; u < (LDS_BYTES - RING_BYTES) / 4; u += 512) ((LAS unsigned*)(F.lds + RING_BYTES))[u] = 0u;
    __syncthreads();
    const int lo = args.ph_lo, hi = args.ph_hi;
    volatile LAS unsigned* MISC = (volatile LAS unsigned*)(F.lds + MISC_OFF);
    XcdBarrier bar; bar.bar = (unsigned*)(ws + WS_CTL) + CW_BAR + args.pad * XCD_BAR_WORDS_EXT; bar.x = 0; bar.st = nullptr;
    const bool multi = (hi - lo) > 1;
    if (multi) bar = xcd_barrier_post((unsigned*)(ws + WS_CTL) + CW_BAR + args.pad * XCD_BAR_WORDS_EXT, MISC + 8);
#define IN(k) (lo <= (k) && (k) < hi)
#ifdef STAMP_PA
    unsigned long long* TS = (unsigned long long*)(ws + WS_CTL + 40 * 1024);
#define STAMP(k) do { if (blockIdx.x == 0 && threadIdx.x == 0) TS[k] = __builtin_amdgcn_s_memrealtime(); } while (0)
#else
#define STAMP(k) do { } while (0)
#endif
#ifdef AMP_PHASE
    unsigned long long t_phase0 = 0ull;
#define AMP_NOW(t) asm volatile("s_memrealtime %0\n\ts_waitcnt lgkmcnt(0)" : "=s"(t) :: "memory")
#define AMP_T0() do { AMP_NOW(t_phase0); } while (0)
#define AMP_WAIT(k) do { if ((k) == AMP_PHASE || AMP_PHASE < 0) { asm volatile("s_waitcnt vmcnt(0) lgkmcnt(0)" ::: "memory"); unsigned long long _t1; AMP_NOW(_t1); const unsigned long long _tw = _t1 + (unsigned long long)AMP_M * (_t1 - t_phase0); unsigned long long _tn; do { __builtin_amdgcn_s_sleep(4); AMP_NOW(_tn); } while (_tn < _tw); } } while (0)
#else
#define AMP_T0() do { } while (0)
#define AMP_WAIT(k) do { } while (0)
#endif
#define SEAM(k) do { AMP_WAIT(k); if (IN(k) && IN((k) + 1)) { xcd_barrier(bar, wave_s); STAMP((k) + 1); } } while (0)
    STAMP(0);
    LAS unsigned char* ring = F.lds;
#define PHASE_BEGIN() do { int _t; asm volatile("v_mbcnt_lo_u32_b32 %0, -1, 0\n\tv_mbcnt_hi_u32_b32 %0, -1, %0" : "=v"(_t)); _t |= (wave_s << 6); F.tid = _t; F.lane = _t & 63; F.wave = wave_s; AMP_T0(); } while (0)

#ifndef P0_SKIP
#define P0_SKIP 0
#endif
    if (IN(0)) { PHASE_BEGIN(); const int p0s = (args.pad == 1) ? P0_SKIP : 0;
        if (!(p0s & 1)) for (int it = F.c; it < 128; it += F.G) s5_build_item(F, it >> 1, it & 1);
        if (!(p0s & 2)) convert_small_weights(F);
        if (!(p0s & 4)) if (!(args.flags & FLAG_NO_EXPERTS0)) { convert_expert_weights(F, 0, CV_SEL, CV_P0B, 128);
            convert_expert_weights(F, 0, CV_P0B, 16 * 1536, 0); }
        if (!(p0s & 8)) { convert_plain(F, args.in[I_MWQ], (bf16_t*)(ws + WS_MWQ), (size_t)2 * 1024 * 1024);
        convert_plain(F, args.in[I_MEMP], (bf16_t*)(ws + WS_MEMB), (size_t)4 * 256 * 1024);
        convert_plain(F, args.in[I_MEMS], (bf16_t*)(ws + WS_MEMB) + (size_t)4 * 256 * 1024, (size_t)4 * 256 * 1024); }
        if (!(p0s & 16)) import_x(F, !(args.flags & FLAG_NO_XIMPORT));
    }
    SEAM(0);
    unsigned nloc_s = 32u;
    if (multi && IN(0) && IN(1)) {
        if (F.tid == 0) { unsigned ok = (F.G == 256) ? 1u : 0u; unsigned* bw = bar.bar;
            for (unsigned j = 0; j < 16; ++j) { const unsigned cnt = xb_ld(&bw[XB_XCNT(j)]); if (j < 8 ? cnt != 32u : cnt != 0u) ok = 0u; }
            MISC[13] = ok; }
        __syncthreads();
        if (MISC[13]) { F.xok = true; F.c = (int)(MISC[12] * 8u + bar.x); }
    }
#define LSEAM(k) do { AMP_WAIT(k); if (IN(k) && IN((k) + 1)) { if (F.xok) xcd_local_barrier(bar, wave_s, nloc_s); else xcd_barrier(bar, wave_s); STAMP((k) + 1); } } while (0)
    {
        const float* lng = args.in[I_LNG]; const float* lnb = args.in[I_LNB];
        if (IN(1)) { PHASE_BEGIN();
            { SchedKV S{ws, F.G, F.c}; EpiBf<false> E{2048u, 1.f}; gemm_phase<EpiBf<false>, SchedKV, false>(ring, F.tid, 1024, 2048u, 2048u, S, E); }
            { SchedUA S{(const char*)ws + WS_XB, (const char*)ws + WS_WIN, (char*)ws + PO_UA, F.G, F.c}; EpiUA E; gemm_phase<EpiUA, SchedUA, false>(ring, F.tid, 1024, 2048u, 2048u, S, E); }
            if (!(args.flags & FLAG_NO_EXPERTS0)) convert_expert_weights(F, 0, 0, CV_P1, 128);
        }
        SEAM(1);
        if (IN(2)) { PHASE_BEGIN();
            { SchedSA S{ws, F.G, F.c}; EpiS E; gemm_phase<EpiS, SchedSA, false>(ring, F.tid, 512, (unsigned)(UAK * 2), 1024u, S, E); }
            { SchedWqk S{ws, F.G, F.c}; EpiBf8 E{1024u, 0.0625f * 1.4426950408889634f * FP8_SWQK}; gemm_phase<EpiBf8, SchedWqk, false>(ring, F.tid, 256, 4096u, 2048u, S, E); }
            { SchedWvo S{ws, F.G, F.c}; EpiBf<false> E{1024u, 1.f}; gemm_phase<EpiBf<false>, SchedWvo, false>(ring, F.tid, 256, 2048u, 4096u, S, E); }
            if (!(args.flags & FLAG_NO_EXPERTS0)) convert_expert_weights(F, 0, CV_P1, CV_P2, 128);
        }
        SEAM(2);
        if (IN(3)) { PHASE_BEGIN(); s5_recurrence(F); }
        SEAM(3);
        if (IN(4)) { PHASE_BEGIN(); SchedSC S{ws, F.G, F.c}; EpiGelu E; gemm_phase<EpiGelu, SchedSC, false>(ring, F.tid, UAK, (unsigned)(UAK * 2), (unsigned)(UAK * 2), S, E); }
        SEAM(4);
        if (IN(5)) { PHASE_BEGIN(); SchedGated S{(const char*)ws + PO_SG, (const char*)ws + WS_WGLU, (char*)ws + PO_HB_S5, 2048, 2048, 1024, NT / BM, 8, F.G, F.c}; EpiGated<0> E{1024u};
            gemm_phase<EpiGated<0>, SchedGated, false>(ring, F.tid, 1024, 2048u, 2048u, S, E); }
        LSEAM(5);
        if (IN(6)) { PHASE_BEGIN(); if (args.flags & FLAG_NO_XIMPORT) ln_phase<0, false, false, false>(F, (const bf16_t*)(ws + PO_HB_S5), lng, lnb, nullptr); else ln_phase<0, false, false, true>(F, (const bf16_t*)(ws + PO_HB_S5), lng, lnb, nullptr); }
        LSEAM(6);
    }
#define COMMON_BLOCK(layer, pb) do { \
        const float* lng = args.in[I_LNG] + (size_t)(layer) * 3 * D; const float* lnb = args.in[I_LNB] + (size_t)(layer) * 3 * D; \
        if (IN((pb) + 0)) { PHASE_BEGIN(); SchedScores8 S{(const char*)ws + WS_XB8, (const char*)ws + WS_WQK + (size_t)(layer) * 8 * MiB, (char*)ws + PO_SB, F.G, F.c}; EpiSoftmax E{(LAS float*)(F.lds + RING_BYTES + 4096), 1024u, 1.f / (FP8_SX * FP8_SWQK)}; \
            gemm_phase<EpiSoftmax, SchedScores8, false, true>(ring, F.tid, 512, 1024u, 1024u, S, E); } \
        AMP_WAIT((pb) + 0); if (IN((pb) + 0) && IN((pb) + 2)) { if (F.xok) xcd_local_barrier(bar, wave_s, nloc_s); else xcd_barrier(bar, wave_s); STAMP((pb) + 1); }     \
        if (IN((pb) + 2)) { PHASE_BEGIN(); SchedBatchW S{(const char*)ws + PO_SB, (const char*)ws + WS_WVO + (size_t)(layer) * 16 * MiB, (char*)ws + PO_HB_MEM, F.G, F.c}; EpiBf<false> E{1024u, 1.f}; \
            gemm_phase<EpiBf<false>, SchedBatchW, false>(ring, F.tid, 1024, 2048u, 2048u, S, E); } \
        if (IN((pb) + 3)) { PHASE_BEGIN(); ln_router_fill(F, lng + D, lnb + D, args.in[I_EWR] + (size_t)(layer) * D * 16); }     \
        LSEAM((pb) + 2); \
        if (IN((pb) + 3)) { PHASE_BEGIN(); ln_phase<0, true, false>(F, (const bf16_t*)(ws + PO_HB_MEM), lng + D, lnb + D, args.in[I_EWR] + (size_t)(layer) * D * 16); } \
        SEAM((pb) + 3); \
        if (IN((pb) + 4)) { PHASE_BEGIN(); select_phase(F); if ((layer) == 0) { if (!(args.flags & FLAG_NO_EXPERTS0)) convert_expert_weights(F, 0, CV_P2, CV_SEL, 32); } else convert_expert_weights(F, 1, 0, CV_SEL1, 32); } \
        SEAM((pb) + 4); \
        if (IN((pb) + 5)) { PHASE_BEGIN(); SchedUp S{ws, F.G, F.c}; EpiGated8 E{2048u}; gemm_phase<EpiGated8, SchedUp, true, true>(ring, F.tid, 512, 1024u, 1024u, S, E); } \
        LSEAM((pb) + 5);     \
        if (IN((pb) + 6)) { PHASE_BEGIN(); SchedDown S{ws, F.G, F.c}; EpiBf<true> E{1024u, 1.f / (FP8_SH * FP8_SW2)}; gemm_phase<EpiBf<true>, SchedDown, false, true>(ring, F.tid, 1024, 2048u, 2048u, S, E); } \
        AMP_WAIT((pb) + 6); if (IN((pb) + 6) && IN((pb) + 9)) { xcd_barrier(bar, wave_s); STAMP((pb) + 9); }     \
    } while (0)
    COMMON_BLOCK(0, 7);
    if (IN(16)) { PHASE_BEGIN(); ln_phase<1, false, false>(F, nullptr, args.in[I_LNG] + 2 * D, args.in[I_LNB] + 2 * D, nullptr); convert_expert_weights(F, 1, CV_SEL1, 16 * 1536, 0); }
    SEAM(16);
    {
        const float* lng = args.in[I_LNG] + 3 * D; const float* lnb = args.in[I_LNB] + 3 * D;
        if (IN(17)) { PHASE_BEGIN(); SchedQKV S{ws, F.G, F.c}; EpiQKV E; gemm_phase<EpiQKV, SchedQKV, false, true>(ring, F.tid, 512, 1024u, 1024u, S, E); }
        if (IN(18)) { PHASE_BEGIN(); natten_fill(F, args.in[I_BRPB]); }
        SEAM(17);
        if (IN(18)) { PHASE_BEGIN(); natten_phase(F, args.in[I_BRPB]); }
        LSEAM(18);
        if (IN(19)) { PHASE_BEGIN(); SchedPlain S{(const char*)ws + PO_Q, (const char*)ws + WS_WO, (char*)ws + PO_HB_NA, 2048, 2048, 1024, NT / BM, 4, F.G, F.c}; EpiBf<false> E{1024u, 1.f};
            gemm_phase<EpiBf<false>, SchedPlain, false>(ring, F.tid, 1024, 2048u, 2048u, S, E); }
        LSEAM(19);
        if (IN(20)) { PHASE_BEGIN(); ln_phase<0, false, false>(F, (const bf16_t*)(ws + PO_HB_NA), lng, lnb, nullptr); }
        LSEAM(20);
    }
    COMMON_BLOCK(1, 21);
    if (IN(30)) { PHASE_BEGIN(); ln_phase<1, false, true>(F, nullptr, args.in[I_LNG] + 5 * D, args.in[I_LNB] + 5 * D, nullptr); }
    AMP_WAIT(30);
#undef COMMON_BLOCK
#ifdef STAMP_PA
    xcd_barrier(bar, wave_s); STAMP(31); xcd_barrier(bar, wave_s);
    {
        const volatile unsigned long long* T = TS; const float dA = (float)(T[STAMP_PA + STAMP_NA] - T[STAMP_PA]) * 0.01f, dB = (float)(T[STAMP_PB + STAMP_NB] - T[STAMP_PB]) * 0.01f;
        const float c = sqrtf(100.f * dA), V = 100.f * dB; const size_t np = (size_t)NTP * 1024, n = (size_t)NT * 1024;
        for (size_t i = (size_t)blockIdx.x * 512 + threadIdx.x; i < n; i += (size_t)gridDim.x * 512) args.out[i] = i < np ? c : (i == np ? V : 0.f);
    }
#endif
#undef IN
#undef SEAM
}
}
#ifndef DBG
#define DBG 0
#endif
#ifndef FZ_PER_PHASE
#define FZ_PER_PHASE 0
#endif

#if DBG
namespace dbg {
__global__ void k_cmp_bf16_f32(const unsigned short* a, const float* b, size_t n, double* acc) {
    double s0 = 0, s1 = 0;
    for (size_t i = (size_t)blockIdx.x * blockDim.x + threadIdx.x; i < n; i += (size_t)gridDim.x * blockDim.x) { const double x = (double)__uint_as_float(((unsigned)a[i]) << 16), y = b[i]; s0 += (x - y) * (x - y); s1 += y * y; }
    for (int o = 32; o >= 1; o >>= 1) { s0 += __shfl_xor(s0, o); s1 += __shfl_xor(s1, o); }
    if ((threadIdx.x & 63) == 0) { atomicAdd(acc, s0); atomicAdd(acc + 1, s1); }
}
__global__ void k_cmp_f32_f32(const float* a, const float* b, size_t n, double* acc) {
    double s0 = 0, s1 = 0;
    for (size_t i = (size_t)blockIdx.x * blockDim.x + threadIdx.x; i < n; i += (size_t)gridDim.x * blockDim.x) { const double x = a[i], y = b[i]; s0 += (x - y) * (x - y); s1 += y * y; }
    for (int o = 32; o >= 1; o >>= 1) { s0 += __shfl_xor(s0, o); s1 += __shfl_xor(s1, o); }
    if ((threadIdx.x & 63) == 0) { atomicAdd(acc, s0); atomicAdd(acc + 1, s1); }
}
__global__ void k_cmp_ua(const unsigned short* UA, const float* u, double* acc) {
    double s0 = 0, s1 = 0;
    for (size_t i = (size_t)blockIdx.x * blockDim.x + threadIdx.x; i < (size_t)fz::NT * 1024; i += (size_t)gridDim.x * blockDim.x) {
        const int tok = (int)(i >> 10), ch = (int)(i & 1023), chunk = tok >> 5, j = tok & 31, g = ch >> 4, h = ch & 15;
        const double x = (double)__uint_as_float(((unsigned)UA[((size_t)g * fz::NCHUNK + chunk) * fz::UAK + j * 16 + h]) << 16), y = u[i]; s0 += (x - y) * (x - y); s1 += y * y; }
    for (int o = 32; o >= 1; o >>= 1) { s0 += __shfl_xor(s0, o); s1 += __shfl_xor(s1, o); }
    if ((threadIdx.x & 63) == 0) { atomicAdd(acc, s0); atomicAdd(acc + 1, s1); }
}
__global__ void k_encode(float* out, const double* accA, const double* accB) {
    const double vA = accA[1] > 0 ? sqrt(accA[0] / accA[1]) : 9.99; const double vB = accB[1] > 0 ? sqrt(accB[0] / accB[1]) : 9.99;
    const float c = (float)sqrt(1e8 * (vA == vA ? vA : 7.77)); const float V = (float)(1e5 * (vB == vB ? vB : 7.77));
    const size_t np = (size_t)fz::NTP * 1024, n = (size_t)fz::NT * 1024;
    for (size_t i = (size_t)blockIdx.x * blockDim.x + threadIdx.x; i < n; i += (size_t)gridDim.x * blockDim.x) out[i] = i < np ? c : (i == np ? V : 0.f);
}
}
#endif

extern "C" void kernel_launch(void* const* d_in, const int* in_sizes, int n_in, void* d_out, int out_size, void* d_ws, size_t ws_size, hipStream_t stream) {
    using namespace fz;
    static int grid = 0;
    if (grid == 0) {
        if (n_in != 26 || ws_size < WS_END) { fprintf(stderr, "kernel_launch: unexpected inputs (n_in %d, ws %zu)\n", n_in, ws_size); grid = -1; return; }
        int dev = 0, cus = 0, per_cu = 0;
        if (hipGetDevice(&dev) != hipSuccess || hipDeviceGetAttribute(&cus, hipDeviceAttributeMultiprocessorCount, dev) != hipSuccess) { grid = -1; return; }
        if (hipFuncSetAttribute((const void*)fwd, hipFuncAttributeMaxDynamicSharedMemorySize, LDS_BYTES) != hipSuccess) { fprintf(stderr, "kernel_launch: hipFuncSetAttribute failed\n"); grid = -1; return; }
        if (hipOccupancyMaxActiveBlocksPerMultiprocessor(&per_cu, (const void*)fwd, 512, LDS_BYTES) != hipSuccess || per_cu < 1) { fprintf(stderr, "kernel_launch: occupancy query says %d\n", per_cu); }
        (void)hipGetLastError();
        grid = cus;
    }
    if (grid < 0) return;
    unsigned char* ws = (unsigned char*)d_ws;
    (void)hipMemsetAsync(ws + WS_CTL, 0, CTL_ZERO_BYTES, stream);
    Args a{};
    for (int i = 0; i < 26; ++i) a.in[i] = (const float*)d_in[i];
    a.out = (float*)d_out; a.ws = ws; a.flags = 0; a.pad = 0;
    auto run = [&](int lo, int hi) { a.ph_lo = lo; a.ph_hi = hi; hipLaunchKernelGGL(fwd, dim3(grid), dim3(512), LDS_BYTES, stream, a); };
#if DBG == 0
#ifdef PRE_LO
    a.pad = 1; run(PRE_LO, PRE_HI); a.pad = 0;
#endif
#if FZ_PER_PHASE
    for (int p = 0; p < N_PHASES; ++p) run(p, p + 1);
#else
    run(0, N_PHASES);
#endif
#else
    using nv::SG;
    const float* const* in = (const float* const*)d_in;
    const size_t BIG = (size_t)NT * D;
    double* ACC = (double*)(ws + 32 * 1024);
    float* nmisc = (float*)(ws + 987 * MiB);
    float* nKV = nmisc; float* nAFF = nmisc + 4u * 1024 * 1024; float* nGATE = nAFF + 1024 * 1024; int* nIDX = (int*)(nGATE + 128 * 1024); float* nMEMC = (float*)(ws + 385 * MiB);
    auto sgemm = [&](const float* A, const float* B, float* C, const int* gidx, int M, int N, int K, long sam, long sak, long sbk, long sbn, long ldc,
                     int nz = 1, int zdiv = 1, long zA0 = 0, long zA1 = 0, long zB0 = 0, long zB1 = 0, long zC0 = 0, long zC1 = 0) {
        SG s{A, B, C, gidx, M, N, K, zdiv, sam, sak, sbk, sbn, ldc, zA0, zA1, zB0, zB1, zC0, zC1};
        hipLaunchKernelGGL(nv::k_sgemm, dim3(N / 128, M / 128, nz), dim3(256), 0, stream, s);
    };
    const int EW = (int)((BIG + 255) / 256);
    auto n_import = [&](float* X) { hipMemcpyAsync(X, in[I_XP], (size_t)NTP * D * 4, hipMemcpyDeviceToDevice, stream); hipMemcpyAsync(X + (size_t)NTP * D, in[I_XS], (size_t)NTS * D * 4, hipMemcpyDeviceToDevice, stream);
        hipMemcpyAsync(nMEMC, in[I_MEMP], (size_t)4 * 256 * D * 4, hipMemcpyDeviceToDevice, stream); hipMemcpyAsync(nMEMC + (size_t)4 * 256 * D, in[I_MEMS], (size_t)4 * 256 * D * 4, hipMemcpyDeviceToDevice, stream); };
    auto n_s5 = [&](float* X, float* T1, float* T2, float* T3) {
        sgemm(X, in[I_AWIN], T1, nullptr, NT, D, D, D, 1, D, 1, D);
        hipLaunchKernelGGL(nv::k_s5_scan, dim3(8 * 64 * 2), dim3(64), 0, stream, T1, T2, in[I_ALRE], in[I_ALIM], in[I_ALDT], in[I_ABRE], in[I_ABIM], in[I_ACRE], in[I_ACIM]);
        hipLaunchKernelGGL(nv::k_s5_gelu, dim3(EW), dim3(256), 0, stream, T1, T2, in[I_AD], T2);
        sgemm(T2, in[I_AWGLU], T1, nullptr, NT, D, D, D, 1, 2 * D, 1, D);
        sgemm(T2, in[I_AWGLU] + D, T3, nullptr, NT, D, D, D, 1, 2 * D, 1, D);
        hipLaunchKernelGGL(nv::k_glu, dim3(EW), dim3(256), 0, stream, T1, T3, T1);
    };
    auto n_na = [&](float* X, float* T1, float* T2, float* T3) {
        sgemm(X, in[I_BWQKV], T1, nullptr, NT, D, D, D, 1, 3 * D, 1, D); sgemm(X, in[I_BWQKV] + D, T2, nullptr, NT, D, D, D, 1, 3 * D, 1, D); sgemm(X, in[I_BWQKV] + 2 * D, T3, nullptr, NT, D, D, D, 1, 3 * D, 1, D);
        hipLaunchKernelGGL(nv::k_natten, dim3(NT * 16 / 4), dim3(256), 0, stream, T1, T2, T3, in[I_BRPB]);
        sgemm(T1, in[I_BWO], T2, nullptr, NT, D, D, D, 1, D, 1, D);
    };
    auto n_ln = [&](float* X, const float* h, int layer, int sub, float* xo) { hipLaunchKernelGGL(nv::k_res_ln, dim3(NT / 4), dim3(256), 0, stream, X, h, in[I_LNG] + (layer * 3 + sub) * D, in[I_LNB] + (layer * 3 + sub) * D, xo, NT); };
    auto n_mem = [&](float* X, float* T1, float* T2, float* T3, int layer) {
        const float* wq = in[I_MWQ] + (size_t)layer * D * D; const float* wkv = in[I_MWKV] + (size_t)layer * D * 2 * D; const float* wo = in[I_MWO] + (size_t)layer * D * D;
        sgemm(nMEMC, wkv, nKV, nullptr, 8 * 256, 2 * D, D, D, 1, 2 * D, 1, 2 * D);
        sgemm(X, wq, T1, nullptr, NT, D, D, D, 1, D, 1, D);
        for (int grp = 0; grp < 2; ++grp) { const int L = grp ? 4096 : 8192; const size_t tb = grp ? (size_t)NTP : 0; const int gb0 = grp * 4;
            sgemm(T1 + tb * D, nKV + (size_t)gb0 * 256 * 2 * D, T2 + tb * D, nullptr, L, 256, 256, D, 1, 1, 2 * D, D, 16, 4, (long)L * D, 256, (long)256 * 2 * D, 256, (long)L * D, 256); }
        hipLaunchKernelGGL(nv::k_softmax256, dim3(NT * 4 / 4), dim3(256), 0, stream, T2, 0.0625f, NT * 4);
        for (int grp = 0; grp < 2; ++grp) { const int L = grp ? 4096 : 8192; const size_t tb = grp ? (size_t)NTP : 0; const int gb0 = grp * 4;
            sgemm(T2 + tb * D, nKV + (size_t)gb0 * 256 * 2 * D + D, T3 + tb * D, nullptr, L, 256, 256, D, 1, 2 * D, 1, D, 16, 4, (long)L * D, 256, (long)256 * 2 * D, 256, (long)L * D, 256); }
        sgemm(T3, wo, T1, nullptr, NT, D, D, D, 1, D, 1, D);
    };
    auto n_moe = [&](float* X, float* T1, float* T2, float* T3, int layer) {
        hipLaunchKernelGGL(nv::k_router, dim3(NT / 4), dim3(256), 0, stream, X, in[I_EWR] + (size_t)layer * D * 16, nAFF, NT);
        hipLaunchKernelGGL(nv::k_select, dim3(32), dim3(512), 0, stream, nAFF, nIDX, nGATE);
        hipMemsetAsync(T1, 0, BIG * 4, stream);
        for (int grp = 0; grp < 2; ++grp) { const int n = grp ? NTS : NTP, cap = n / 8; const size_t tb = grp ? (size_t)NTP : 0;
            for (int e = 0; e < 16; ++e) { const int* idx = nIDX + (grp ? 16 * 4096 : 0) + e * cap; const float* gate = nGATE + (grp ? 16 * 4096 : 0) + e * cap;
                const float* w1 = in[I_EW1] + ((size_t)layer * 16 + e) * D * 2048; const float* w3 = in[I_EW3] + ((size_t)layer * 16 + e) * D * 2048; const float* w2 = in[I_EW2] + ((size_t)layer * 16 + e) * 2048 * D;
                float* H1 = T2; float* H3 = T2 + (size_t)4096 * 2048; float* YE = T3;
                sgemm(X + tb * D, w1, H1, idx, cap, 2048, D, D, 1, 2048, 1, 2048); sgemm(X + tb * D, w3, H3, idx, cap, 2048, D, D, 1, 2048, 1, 2048);
                hipLaunchKernelGGL(nv::k_silu_mul, dim3((unsigned)(((size_t)cap * 2048 + 255) / 256)), dim3(256), 0, stream, H1, H3, (size_t)cap * 2048);
                sgemm(H1, w2, YE, nullptr, cap, D, 2048, 2048, 1, D, 1, D);
                hipLaunchKernelGGL(nv::k_scatter_add, dim3((unsigned)(((size_t)cap * D + 255) / 256)), dim3(256), 0, stream, YE, idx, gate, T1 + tb * D, cap); } }
    };
    float* X = (float*)(ws + WS_XF); float* T1 = (float*)(ws + WS_EW13); float* T2 = (float*)(ws + WS_POOL); float* T3 = (float*)(ws + WS_POOL + 192 * MiB);
    auto cmp_bf = [&](size_t off_bf16, const float* ref, double* acc) { hipLaunchKernelGGL(dbg::k_cmp_bf16_f32, dim3(2048), dim3(256), 0, stream, (const unsigned short*)(ws + off_bf16), ref, BIG, acc); };
#if DBG == 1
    n_import(X);
    a.flags = FLAG_NO_XIMPORT | FLAG_NO_EXPERTS0;
    n_s5(X, T1, T2, T3);
    for (int p = 0; p <= 5; ++p) run(p, p + 1);
    cmp_bf(PO_HB_S5, T1, ACC);
    cmp_bf(PO_HB_S5, T1, ACC + 2);
#elif DBG == 11
    n_import(X);
    a.flags = FLAG_NO_XIMPORT | FLAG_NO_EXPERTS0;
    sgemm(X, in[I_AWIN], T1, nullptr, NT, D, D, D, 1, D, 1, D);
    for (int p = 0; p <= 4; ++p) run(p, p + 1);
    hipLaunchKernelGGL(dbg::k_cmp_ua, dim3(2048), dim3(256), 0, stream, (const unsigned short*)(ws + PO_UA), T1, ACC);
    hipMemcpyAsync(X, T1, BIG * 4, hipMemcpyDeviceToDevice, stream);
    { float* Y = (float*)(ws + 193 * MiB);
      hipLaunchKernelGGL(nv::k_s5_scan, dim3(8 * 64 * 2), dim3(64), 0, stream, X, Y, in[I_ALRE], in[I_ALIM], in[I_ALDT], in[I_ABRE], in[I_ABIM], in[I_ACRE], in[I_ACIM]);
      hipLaunchKernelGGL(nv::k_s5_gelu, dim3(EW), dim3(256), 0, stream, X, Y, in[I_AD], Y);
      cmp_bf(PO_SG, Y, ACC + 2); }
#elif DBG == 2
    n_import(X); n_s5(X, T1, T2, T3); n_ln(X, T1, 0, 0, X); n_mem(X, T1, T2, T3, 0);
    a.flags = FLAG_NO_XIMPORT | FLAG_NO_EXPERTS0;
    run(0, 1); run(1, 2); run(2, 3); run(7, 8); run(9, 10);
    cmp_bf(PO_HB_MEM, T1, ACC); cmp_bf(PO_HB_MEM, T1, ACC + 2);
#elif DBG == 4
    n_import(X); n_na(X, T1, T2, T3);
    hipMemcpyAsync(T1, T2, BIG * 4, hipMemcpyDeviceToDevice, stream);
    a.flags = FLAG_NO_XIMPORT | FLAG_NO_EXPERTS0;
    run(0, 1); run(17, 18); run(18, 19); run(19, 20);
    cmp_bf(PO_HB_NA, T1, ACC); cmp_bf(PO_HB_NA, T1, ACC + 2);
#endif
    hipLaunchKernelGGL(dbg::k_encode, dim3(2048), dim3(256), 0, stream, (float*)d_out, ACC, ACC + 2);
#endif
}
```

```cpp
#include <hip/hip_runtime.h>
#include <cstdio>
#include <cstdint>
#include <cmath>
#define NO_WT 1
namespace nv {
constexpr int D = 1024, NTP = 32768, NTS = 16384, NT = NTP + NTS, NGB = 8, MEM = 256;
constexpr int GRID_W = 64;
constexpr float ALPHA = 1.41421356237309515f;
constexpr float LN_EPS = 1e-5f;

__host__ __device__ inline int gb_tok0(int gb) { return gb < 4 ? gb * 8192 : NTP + (gb - 4) * 4096; }
__host__ __device__ inline int gb_len(int gb) { return gb < 4 ? 8192 : 4096; }

__device__ __forceinline__ float wave_sum(float v) {
#pragma unroll
    for (int o = 1; o < 64; o <<= 1) v += __shfl_xor(v, o);
    return v;
}
__device__ __forceinline__ float wave_max(float v) {
#pragma unroll
    for (int o = 1; o < 64; o <<= 1) v = fmaxf(v, __shfl_xor(v, o));
    return v;
}

struct SG { const float* A; const float* B; float* C; const int* gidx; int M, N, K, zdiv; long sam, sak, sbk, sbn, ldc; long zA0, zA1, zB0, zB1, zC0, zC1; };
__global__ __launch_bounds__(256) void k_sgemm(SG a) {
    __shared__ float As[8][132];
    __shared__ float Bs[8][132];
    const int z = blockIdx.z, z0 = z / a.zdiv, z1 = z % a.zdiv;
    const float* A = a.A + z0 * a.zA0 + z1 * a.zA1;
    const float* B = a.B + z0 * a.zB0 + z1 * a.zB1;
    float* C = a.C + z0 * a.zC0 + z1 * a.zC1;
    const int bm = blockIdx.y * 128, bn = blockIdx.x * 128, tid = threadIdx.x, tx = tid & 15, ty = tid >> 4;
    float acc[8][8];
#pragma unroll
    for (int i = 0; i < 8; ++i)
#pragma unroll
        for (int j = 0; j < 8; ++j) acc[i][j] = 0.f;
    const int arow_l = tid >> 1, akk = (tid & 1) * 4;
    const long arow = a.gidx ? (long)a.gidx[bm + arow_l] : (long)(bm + arow_l);
    const float* Ap = A + arow * a.sam;
    const int bkk = tid >> 5, bnn = (tid & 31) * 4;
    for (int k0 = 0; k0 < a.K; k0 += 8) {
        float av[4], bv[4];
#pragma unroll
        for (int i = 0; i < 4; ++i) av[i] = Ap[(long)(k0 + akk + i) * a.sak];
#pragma unroll
        for (int i = 0; i < 4; ++i) bv[i] = B[(long)(k0 + bkk) * a.sbk + (long)(bn + bnn + i) * a.sbn];
        __syncthreads();
#pragma unroll
        for (int i = 0; i < 4; ++i) As[akk + i][arow_l] = av[i];
#pragma unroll
        for (int i = 0; i < 4; ++i) Bs[bkk][bnn + i] = bv[i];
        __syncthreads();
#pragma unroll
        for (int kk = 0; kk < 8; ++kk) {
            float x[8], y[8];
#pragma unroll
            for (int i = 0; i < 8; ++i) x[i] = As[kk][ty * 8 + i];
#pragma unroll
            for (int j = 0; j < 8; ++j) y[j] = Bs[kk][tx * 8 + j];
#pragma unroll
            for (int i = 0; i < 8; ++i)
#pragma unroll
                for (int j = 0; j < 8; ++j) acc[i][j] += x[i] * y[j];
        }
    }
#pragma unroll
    for (int i = 0; i < 8; ++i)
#pragma unroll
        for (int j = 0; j < 8; ++j) C[(long)(bm + ty * 8 + i) * a.ldc + bn + tx * 8 + j] = acc[i][j];
}

__global__ __launch_bounds__(64) void k_s5_scan(const float* __restrict__ u, float* __restrict__ ydir, const float* lam_re, const float* lam_im, const float* log_dt,
                                                const float* b_re, const float* b_im, const float* c_re, const float* c_im) {
    const int wid = blockIdx.x;
    const int dir = wid & 1, g = (wid >> 1) & 63, gb = wid >> 7;
    const int p = threadIdx.x;
    const int L = gb_len(gb), t0 = gb_tok0(gb);
    const double dt = exp((double)log_dt[dir * 64 + g]);
    const double lr = lam_re[(dir * 64 + g) * 64 + p], li = lam_im[(dir * 64 + g) * 64 + p];
    const double er = exp(lr * dt), lbr = er * cos(li * dt), lbi = er * sin(li * dt);
    const double nr = lbr - 1.0, ni = lbi, den = lr * lr + li * li;
    const double fr = (nr * lr + ni * li) / den, fi = (ni * lr - nr * li) / den;
    float Br[16], Bi[16], Cr[16], Ci[16];
#pragma unroll
    for (int h = 0; h < 16; ++h) {
        const double br = b_re[((dir * 64 + g) * 64 + p) * 16 + h], bi = b_im[((dir * 64 + g) * 64 + p) * 16 + h];
        Br[h] = (float)(fr * br - fi * bi); Bi[h] = (float)(fr * bi + fi * br);
        Cr[h] = c_re[((dir * 64 + g) * 16 + h) * 64 + p]; Ci[h] = c_im[((dir * 64 + g) * 16 + h) * 64 + p];
    }
    const float ar = (float)lbr, ai = (float)lbi;
    float hr = 0.f, hi = 0.f;
    float* yo = ydir + (size_t)dir * NT * D;
    for (int s = 0; s < L; ++s) {
        const int t = dir ? (L - 1 - s) : s;
        const float* ur = u + (size_t)(t0 + t) * D + g * 16;
        float bur = 0.f, bui = 0.f;
#pragma unroll
        for (int h = 0; h < 16; ++h) { const float uv = ur[h]; bur += uv * Br[h]; bui += uv * Bi[h]; }
        const float nhr = ar * hr - ai * hi + bur, nhi = ar * hi + ai * hr + bui;
        hr = nhr; hi = nhi;
        float mine = 0.f;
#pragma unroll
        for (int c = 0; c < 16; ++c) { const float v = wave_sum(Cr[c] * hr - Ci[c] * hi); if (p == c) mine = v; }
        if (p < 16) yo[(size_t)(t0 + t) * D + g * 16 + p] = mine;
    }
}
__global__ void k_s5_gelu(const float* u, const float* ydir, const float* dskip, float* gout) {
    const size_t i = (size_t)blockIdx.x * blockDim.x + threadIdx.x;
    if (i >= (size_t)NT * D) return;
    const float y = dskip[i & (D - 1)] * u[i] + ydir[i] + ydir[(size_t)NT * D + i];
    const float c = 0.7978845608028654f * (y + 0.044715f * y * y * y);
    gout[i] = 0.5f * y * (1.f + tanhf(c));
}
__global__ void k_glu(const float* z1, const float* z2, float* out) {
    const size_t i = (size_t)blockIdx.x * blockDim.x + threadIdx.x;
    if (i >= (size_t)NT * D) return;
    out[i] = z1[i] / (1.f + expf(-z2[i]));
}
__global__ __launch_bounds__(256) void k_res_ln(const float* x, const float* h, const float* g, const float* b, float* xo, int rows) {
    const int row = blockIdx.x * 4 + (threadIdx.x >> 6), lane = threadIdx.x & 63;
    if (row >= rows) return;
    float v[16]; float s = 0.f;
#pragma unroll
    for (int j = 0; j < 16; ++j) { const size_t i = (size_t)row * D + lane + 64 * j; v[j] = ALPHA * x[i] + h[i]; s += v[j]; }
    const float mean = wave_sum(s) * (1.f / D); float q = 0.f;
#pragma unroll
    for (int j = 0; j < 16; ++j) { v[j] -= mean; q += v[j] * v[j]; }
    const float rstd = 1.f / sqrtf(wave_sum(q) * (1.f / D) + LN_EPS);
#pragma unroll
    for (int j = 0; j < 16; ++j) { const int c = lane + 64 * j; xo[(size_t)row * D + c] = v[j] * rstd * g[c] + b[c]; }
}
__global__ __launch_bounds__(256) void k_softmax256(float* s, float scale, int rows) {
    const int row = blockIdx.x * 4 + (threadIdx.x >> 6), lane = threadIdx.x & 63;
    if (row >= rows) return;
    float v[4]; float m = -INFINITY;
#pragma unroll
    for (int j = 0; j < 4; ++j) { v[j] = s[(size_t)row * 256 + lane + 64 * j] * scale; m = fmaxf(m, v[j]); }
    m = wave_max(m); float l = 0.f;
#pragma unroll
    for (int j = 0; j < 4; ++j) { v[j] = expf(v[j] - m); l += v[j]; }
    l = wave_sum(l);
#pragma unroll
    for (int j = 0; j < 4; ++j) s[(size_t)row * 256 + lane + 64 * j] = v[j] / l;
}
__global__ __launch_bounds__(256) void k_router(const float* x, const float* wr, float* aff, int rows) {
    const int row = blockIdx.x * 4 + (threadIdx.x >> 6), lane = threadIdx.x & 63;
    if (row >= rows) return;
    float acc[16];
#pragma unroll
    for (int e = 0; e < 16; ++e) acc[e] = 0.f;
    for (int j = 0; j < 16; ++j) { const int k = lane + 64 * j; const float xv = x[(size_t)row * D + k];
#pragma unroll
        for (int e = 0; e < 16; ++e) acc[e] += xv * wr[k * 16 + e]; }
    float m = -INFINITY;
#pragma unroll
    for (int e = 0; e < 16; ++e) { acc[e] = wave_sum(acc[e]); m = fmaxf(m, acc[e]); }
    float l = 0.f;
#pragma unroll
    for (int e = 0; e < 16; ++e) { acc[e] = expf(acc[e] - m); l += acc[e]; }
    float mine = 0.f;
#pragma unroll
    for (int e = 0; e < 16; ++e) if (lane == e) mine = acc[e] / l;
    if (lane < 16) aff[(size_t)row * 16 + lane] = mine;
}

__device__ __forceinline__ void select_expert(const float* aff, int n, int e, int cap, int* idx_out, float* gate_out, int* slot_of  , unsigned* hist  , unsigned* wsum  , unsigned* bc  ) {
    const int tid = threadIdx.x, nth = blockDim.x, lane = tid & 63, wv = tid >> 6, nw = nth >> 6;
    unsigned prefix = 0u, mask = 0u; unsigned remaining = (unsigned)cap;
    for (int pass = 0; pass < 4; ++pass) {
        const int shift = 24 - 8 * pass;
        for (int i = tid; i < 256; i += nth) hist[i] = 0u;
        __syncthreads();
        for (int t = tid; t < n; t += nth) { const unsigned key = __float_as_uint(aff[(size_t)t * 16 + e]); if ((key & mask) == prefix) atomicAdd(&hist[(key >> shift) & 255u], 1u); }
        __syncthreads();
        if (tid == 0) { unsigned cum = 0u; int b = 255; for (; b > 0; --b) { if (cum + hist[b] >= remaining) break; cum += hist[b]; } bc[0] = (unsigned)b; bc[1] = remaining - cum; }
        __syncthreads();
        prefix |= bc[0] << shift; mask |= 0xffu << shift; remaining = bc[1];
        __syncthreads();
    }
    const unsigned T = prefix; const unsigned need_eq = remaining;
    unsigned base = 0u, eqbase = 0u;
    for (int s0 = 0; s0 < n; s0 += nth) {
        const int t = s0 + tid; const bool in = t < n;
        const float a = in ? aff[(size_t)t * 16 + e] : 0.f; const unsigned key = __float_as_uint(a);
        const bool gt = in && key > T, eq = in && key == T;
        const unsigned long long meq = __ballot(eq); const unsigned eqr_w = __popcll(meq & ((1ull << lane) - 1ull));
        if (lane == 0) wsum[wv] = __popcll(meq);
        __syncthreads();
        unsigned eqoff = 0u, eqtot = 0u; for (int w = 0; w < nw; ++w) { const unsigned c = wsum[w]; if (w < wv) eqoff += c; eqtot += c; }
        __syncthreads();
        const bool sel = gt || (eq && (eqbase + eqoff + eqr_w) < need_eq);
        const unsigned long long ms = __ballot(sel); const unsigned sr_w = __popcll(ms & ((1ull << lane) - 1ull));
        if (lane == 0) wsum[wv] = __popcll(ms);
        __syncthreads();
        unsigned soff = 0u, stot = 0u; for (int w = 0; w < nw; ++w) { const unsigned c = wsum[w]; if (w < wv) soff += c; stot += c; }
        __syncthreads();
        if (sel) { const unsigned slot = base + soff + sr_w; if (slot < (unsigned)cap) { idx_out[slot] = t; gate_out[slot] = a; } }
        if (slot_of && in) slot_of[(size_t)t * 16 + e] = sel ? (int)(base + soff + sr_w) : -1;
        base += stot; eqbase += eqtot;
    }
}
__global__ __launch_bounds__(512) void k_select(const float* aff_all, int* idx_all, float* gate_all) {
    __shared__ unsigned hist[256]; __shared__ unsigned wsum[32]; __shared__ unsigned bc[4];
    const int grp = blockIdx.x >> 4, e = blockIdx.x & 15;
    const int n = grp ? NTS : NTP, cap = n / 8;
    const float* aff = aff_all + (size_t)(grp ? NTP : 0) * 16;
    int* idx = idx_all + (grp ? 16 * 4096 : 0) + e * cap; float* gate = gate_all + (grp ? 16 * 4096 : 0) + e * cap;
    select_expert(aff, n, e, cap, idx, gate, nullptr, hist, wsum, bc);
}
__global__ void k_silu_mul(float* h1, const float* h3, size_t n) {
    const size_t i = (size_t)blockIdx.x * blockDim.x + threadIdx.x; if (i >= n) return;
    const float a = h1[i]; h1[i] = a / (1.f + expf(-a)) * h3[i];
}
__global__ void k_scatter_add(const float* ye, const int* idx, const float* gate, float* out, int cap) {
    const size_t i = (size_t)blockIdx.x * blockDim.x + threadIdx.x; if (i >= (size_t)cap * D) return;
    const int slot = (int)(i >> 10), c = (int)(i & 1023);
    atomicAdd(&out[(size_t)idx[slot] * D + c], gate[slot] * ye[i]);
}

__global__ __launch_bounds__(256) void k_natten(float* q, const float* k, const float* v, const float* rpb) {
    const int wg = blockIdx.x * 4 + (threadIdx.x >> 6), lane = threadIdx.x & 63;
    const int tok = wg >> 4, h = wg & 15;
    if (tok >= NT) return;
    int gb, l; if (tok < NTP) { gb = tok >> 13; l = tok & 8191; } else { gb = 4 + ((tok - NTP) >> 12); l = (tok - NTP) & 4095; }
    const int rows = gb_len(gb) / GRID_W, t0 = gb_tok0(gb);
    const int r = l >> 6, qc = l & 63;
    int rs = r - 4; rs = rs < 0 ? 0 : (rs > rows - 8 ? rows - 8 : rs);
    int ws = qc - 8; ws = ws < 0 ? 0 : (ws > 48 ? 48 : ws);
    const float qv = q[(size_t)tok * D + h * 64 + lane] * 0.125f;
    float m = -INFINITY, lsum = 0.f, o = 0.f;
    for (int rr = 0; rr < 8; ++rr) {
        const int kr = rs + rr, dr = kr - r + 7;
        for (int cc = 0; cc < 16; ++cc) {
            const int kc = ws + cc; int dc = kc - qc + 15; dc = dc < 0 ? 0 : (dc > 30 ? 30 : dc);
            const size_t kt = (size_t)(t0 + kr * 64 + kc) * D + h * 64 + lane;
            const float s = wave_sum(qv * k[kt]) + rpb[(h * 15 + dr) * 31 + dc];
            const float mn = fmaxf(m, s), al = expf(m - mn), pp = expf(s - mn);
            lsum = lsum * al + pp; o = o * al + pp * v[kt]; m = mn;
        }
    }
    q[(size_t)tok * D + h * 64 + lane] = o / lsum;
}
}
#define LAS __attribute__((address_space(3)))
#define GAS __attribute__((address_space(1)))
namespace fz {
typedef unsigned short bf16_t;
typedef short bf16x8 __attribute__((ext_vector_type(8)));
typedef float f32x4 __attribute__((ext_vector_type(4)));
typedef float f32x2 __attribute__((ext_vector_type(2)));
typedef unsigned u32x4 __attribute__((ext_vector_type(4)));
typedef unsigned u32x2 __attribute__((ext_vector_type(2)));
typedef int v8i __attribute__((ext_vector_type(8)));
typedef int v4i __attribute__((ext_vector_type(4)));

constexpr int D = 1024, NTP = 32768, NTS = 16384, NT = NTP + NTS;
constexpr int TCH = 32, NCHUNK = NT / TCH;
constexpr int UAK = TCH * 16 + 256;
constexpr float ALPHA = 1.41421356237309515f, LN_EPS = 1e-5f;
constexpr size_t MiB = 1u << 20;
constexpr size_t WS_CTL = 0, WS_XF = 1 * MiB, WS_XB = 193 * MiB, WS_WIN = 289 * MiB, WS_WGLU = 291 * MiB, WS_WQKV = 295 * MiB, WS_WO = 301 * MiB, WS_MWQ = 303 * MiB,
                 WS_MWKV = 307 * MiB, WS_MWO = 315 * MiB, WS_MEMB = 319 * MiB, WS_KV = 323 * MiB, WS_WQK = 339 * MiB, WS_WVO = 371 * MiB, WS_AFF = 403 * MiB, WS_SLOT = 406 * MiB,
                 WS_IDX = 409 * MiB, WS_GATE = 409 * MiB + 512 * 1024, WS_EW13 = 411 * MiB  , WS_EW2 = 475 * MiB  ,
                 WS_XB8 = 507 * MiB  , WS_POOL = 603 * MiB, WS_END = 1024 * MiB;
constexpr size_t PO_M2T = WS_POOL, PO_M13T = WS_POOL + 16 * MiB, PO_UA = WS_POOL + 64 * MiB, PO_SG = WS_POOL + 208 * MiB;
constexpr size_t PO_HB_S5 = WS_POOL;
constexpr size_t PO_SB = WS_POOL, PO_HB_MEM = WS_POOL + 304 * MiB;
constexpr size_t PO_Q = WS_POOL, PO_K = WS_POOL + 96 * MiB, PO_VT = WS_POOL + 192 * MiB, PO_HB_NA = WS_POOL + 304 * MiB;
constexpr size_t PO_HM = WS_POOL, PO_YE = WS_POOL + 192 * MiB;
static_assert(PO_YE + 192 * MiB <= WS_END && PO_SG + 96 * MiB <= WS_END && PO_HB_NA + 96 * MiB <= WS_END && PO_HB_MEM + 96 * MiB <= WS_END, "pool");
constexpr int CW_TMO = 0, CW_BAR = 4096;
constexpr size_t CTL_ZERO_BYTES = 64 * 1024;
constexpr int RING_BYTES = 131072, MISC_OFF = RING_BYTES + 320, LDS_BYTES = 147456, ZERO16_OFF = RING_BYTES + 64;

__host__ __device__ inline int gb_tok0(int gb) { return gb < 4 ? gb * 8192 : NTP + (gb - 4) * 4096; }
__host__ __device__ inline int gb_len(int gb) { return gb < 4 ? 8192 : 4096; }
__host__ __device__ inline int panel_gb(int pm) { return pm < 128 ? (pm >> 5) : 4 + ((pm - 128) >> 4); }

__device__ __forceinline__ unsigned cvt_pk_bf16(float lo, float hi) { unsigned r; asm volatile("v_cvt_pk_bf16_f32 %0, %1, %2" : "=v"(r) : "v"(lo), "v"(hi)); return r; }
typedef __bf16 bf16x2_t __attribute__((ext_vector_type(2)));
__device__ __forceinline__ unsigned cvt_pk_bf16_c(float lo, float hi) { const f32x2 v = {lo, hi}; const bf16x2_t b = __builtin_convertvector(v, bf16x2_t); return __builtin_bit_cast(unsigned, b); }
__device__ __forceinline__ float bf2f(unsigned short b) { return __uint_as_float(((unsigned)b) << 16); }
template <int CTRL> __device__ __forceinline__ float dpp_f(float v) { return __uint_as_float((unsigned)__builtin_amdgcn_update_dpp(0, (int)__float_as_uint(v), CTRL, 0xF, 0xF, true)); }
__device__ __forceinline__ float x16_sum(float v) { const auto r = __builtin_amdgcn_permlane16_swap(__float_as_uint(v), __float_as_uint(v), false, false); return __uint_as_float(r[0]) + __uint_as_float(r[1]); }
__device__ __forceinline__ float x32_sum(float v) { const auto r = __builtin_amdgcn_permlane32_swap(__float_as_uint(v), __float_as_uint(v), false, false); return __uint_as_float(r[0]) + __uint_as_float(r[1]); }
__device__ __forceinline__ float x16_max(float v) { const auto r = __builtin_amdgcn_permlane16_swap(__float_as_uint(v), __float_as_uint(v), false, false); return fmaxf(__uint_as_float(r[0]), __uint_as_float(r[1])); }
__device__ __forceinline__ float x32_max(float v) { const auto r = __builtin_amdgcn_permlane32_swap(__float_as_uint(v), __float_as_uint(v), false, false); return fmaxf(__uint_as_float(r[0]), __uint_as_float(r[1])); }
__device__ __forceinline__ float row_sum(float v) { v += dpp_f<0xB1>(v); v += dpp_f<0x4E>(v); v += dpp_f<0x141>(v); v += dpp_f<0x140>(v); return v; }
__device__ __forceinline__ float row_max(float v) { v = fmaxf(v, dpp_f<0xB1>(v)); v = fmaxf(v, dpp_f<0x4E>(v)); v = fmaxf(v, dpp_f<0x141>(v)); v = fmaxf(v, dpp_f<0x140>(v)); return v; }
__device__ __forceinline__ float wave_sum(float v) { return x32_sum(x16_sum(row_sum(v))); }
__device__ __forceinline__ float wave_max(float v) { return x32_max(x16_max(row_max(v))); }
#ifndef NO_WT
__device__ __forceinline__ void st16(void* p, u32x4 v) { asm volatile("global_store_dwordx4 %0, %1, off sc1\n\ts_nop 1" :: "v"(p), "v"(v)); }
__device__ __forceinline__ void st8(void* p, u32x2 v) { asm volatile("global_store_dwordx2 %0, %1, off sc1\n\ts_nop 1" :: "v"(p), "v"(v)); }
__device__ __forceinline__ void st4(void* p, unsigned v) { asm volatile("global_store_dword %0, %1, off sc1\n\ts_nop 1" :: "v"(p), "v"(v)); }
#else
__device__ __forceinline__ void st16(void* p, u32x4 v) { *(u32x4*)p = v; }
__device__ __forceinline__ void st8(void* p, u32x2 v) { *(u32x2*)p = v; }
__device__ __forceinline__ void st4(void* p, unsigned v) { *(unsigned*)p = v; }
#endif
__device__ __forceinline__ void st16f(void* p, f32x4 v) { st16(p, __builtin_bit_cast(u32x4, v)); }
__device__ __forceinline__ void pst16(void* p, u32x4 v) { *(u32x4*)p = v; }
__device__ __forceinline__ void pst8(void* p, u32x2 v) { *(u32x2*)p = v; }
#ifndef NO_WT
__device__ __forceinline__ void st16_so(const void* base, unsigned off, f32x4 v) { asm volatile("global_store_dwordx4 %0, %1, %2 sc1\n\ts_nop 1" :: "v"(off), "v"(v), "s"(base)); }
__device__ __forceinline__ void st4_so(const void* base, unsigned off, unsigned v) { asm volatile("global_store_dword %0, %1, %2 sc1\n\ts_nop 1" :: "v"(off), "v"(v), "s"(base)); }
#else
__device__ __forceinline__ void st16_so(const void* base, unsigned off, f32x4 v) { *(f32x4*)((unsigned char*)base + off) = v; }
__device__ __forceinline__ void st4_so(const void* base, unsigned off, unsigned v) { *(unsigned*)((unsigned char*)base + off) = v; }
#endif
#define LDS_WAIT() asm volatile("s_waitcnt lgkmcnt(0)" ::: "memory")
#define VM_WAIT() asm volatile("s_waitcnt vmcnt(0)" ::: "memory")

#define XB_TMO      128
#define XB_XCNT(j)  (256  + 64 * (j))
#define XB_XSUB(j)  (1280 + 64 * (j))
#define XB_XGEN(j)  (2304 + 64 * (j))
#define XB_TOP      3328
#define XB_TOPGEN   3392
#define XCD_BAR_WORDS 3456
#define XB_SPIN_CAP (1u << 18)
__device__ __forceinline__ unsigned xb_ld(unsigned* p)              { return __hip_atomic_load(p, __ATOMIC_RELAXED, __HIP_MEMORY_SCOPE_AGENT); }
__device__ __forceinline__ unsigned xb_add(unsigned* p, unsigned v) { return __hip_atomic_fetch_add(p, v, __ATOMIC_RELAXED, __HIP_MEMORY_SCOPE_AGENT); }
__device__ __forceinline__ unsigned xb_xcc_id() { return (unsigned)__builtin_amdgcn_s_getreg((3 << 11) | 20) & 0xFu; }
#define XB_SPIN(cond, bar) do { unsigned _sp = 0; while (cond) { __builtin_amdgcn_s_sleep(1); \
    if ((++_sp & 255u) == 0u) { if (xb_ld(&(bar)[XB_TMO])) break; if (_sp > XB_SPIN_CAP) { atomicAdd(&(bar)[XB_TMO], 1u); break; } } } } while (0)
struct XcdBarrier { unsigned* bar; unsigned x; volatile LAS unsigned* st; };
__device__ __forceinline__ int xb_tid();
__device__ __forceinline__ XcdBarrier xcd_barrier_post(unsigned* bar, volatile LAS unsigned* st) {
    XcdBarrier b; b.bar = bar; b.x = xb_xcc_id(); b.st = st;
    if (threadIdx.x == 0) st[4] = xb_add(&bar[XB_XCNT(b.x)], 1u);
    return b;
}
#define XB_LCNT(j)  (3520 + 64 * (j))
#define XB_LGEN(j)  (4544 + 64 * (j))
#define XCD_BAR_WORDS_EXT 5568
__device__ __forceinline__ void xcd_local_barrier(const XcdBarrier& b, const int wave_s, const unsigned nloc) {
    asm volatile("s_waitcnt vmcnt(0)" ::: "memory");
    __syncthreads();
    if (wave_s == 0 && xb_tid() == 0) {
        unsigned* bar = b.bar;
        const unsigned old = xb_add(&bar[XB_LCNT(b.x)], 1u);
        const unsigned gen = old / nloc;
        if (old + 1u == (gen + 1u) * nloc) xb_add(&bar[XB_LGEN(b.x)], 1u);
        else XB_SPIN(xb_ld(&bar[XB_LGEN(b.x)]) == gen, bar);
#ifndef LB_NOACQ
        __builtin_amdgcn_fence(__ATOMIC_ACQUIRE, "agent");
        asm volatile("s_waitcnt vmcnt(0)" ::: "memory");
#endif
    }
    __syncthreads();
}
__device__ __forceinline__ void xcd_barrier_complete(unsigned* bar, unsigned x, unsigned& nloc, unsigned& nx) {
    const unsigned G = gridDim.x * gridDim.y * gridDim.z;
    unsigned sum, cnt, mine, sp = 0u;
    for (;;) {
        sum = 0u; cnt = 0u; mine = 0u;
#pragma unroll
        for (unsigned j = 0; j < 16; ++j) { const unsigned c = xb_ld(&bar[XB_XCNT(j)]); sum += c; cnt += (c > 0u) ? 1u : 0u; mine = (j == x) ? c : mine; }
        if (sum == G) break;
        __builtin_amdgcn_s_sleep(1);
        if ((++sp & 255u) == 0u) { if (xb_ld(&bar[XB_TMO])) break; if (sp > XB_SPIN_CAP) { atomicAdd(&bar[XB_TMO], 1u); break; } }
    }
    nloc = mine > 0u ? mine : 1u; nx = cnt > 0u ? cnt : 1u;
}
__device__ __forceinline__ int xb_tid() { int t; asm volatile("v_mbcnt_lo_u32_b32 %0, -1, 0\n\tv_mbcnt_hi_u32_b32 %0, -1, %0" : "=v"(t)); return t; }
__device__ __forceinline__ void xcd_barrier(const XcdBarrier& b, const int wave_s) {
    asm volatile("s_waitcnt vmcnt(0)" ::: "memory");
    __syncthreads();
    if (wave_s == 0 && xb_tid() == 0) {
        unsigned* bar = b.bar;
        __builtin_amdgcn_s_waitcnt(0);
        unsigned nloc = b.st[0], nx = b.st[1];
        if (nloc == 0u) { xcd_barrier_complete(bar, b.x, nloc, nx); b.st[0] = nloc; b.st[1] = nx; }
        const unsigned old = xb_add(&bar[XB_XSUB(b.x)], 1u);
        const unsigned gen = old / nloc;
        if (old + 1u == (gen + 1u) * nloc) {
            __builtin_amdgcn_fence(__ATOMIC_RELEASE, "agent");
            asm volatile("s_waitcnt vmcnt(0)" ::: "memory");
            const unsigned og = xb_add(&bar[XB_TOP], 1u);
            const unsigned tg = og / nx;
            if (og + 1u == (tg + 1u) * nx) xb_add(&bar[XB_TOPGEN], 1u);
            else XB_SPIN(xb_ld(&bar[XB_TOPGEN]) == tg, bar);
            __builtin_amdgcn_fence(__ATOMIC_ACQUIRE, "agent");
            xb_add(&bar[XB_XGEN(b.x)], 1u);
            asm volatile("s_waitcnt vmcnt(0)" ::: "memory");
        } else {
            XB_SPIN(xb_ld(&bar[XB_XGEN(b.x)]) == gen, bar);
            __builtin_amdgcn_fence(__ATOMIC_ACQUIRE, "agent");
            asm volatile("s_waitcnt vmcnt(0)" ::: "memory");
        }
    }
    __syncthreads();
}

constexpr int BM = 256, BK = 64, HALF = 128, HTB = HALF * BK * 2, STAGE_BYTES = 8 * HTB;
__host__ __device__ __forceinline__ int lds_byte(int r, int c) { const int st = (r >> 4) * 2 + (c >> 5), rr = r & 15, cc = c & 31, ob = rr * 64 + cc * 2; return st * 1024 + (ob ^ (((ob >> 9) & 1) << 5)); }
__host__ __device__ __forceinline__ void stage_rc(int b, int& R, int& C) { const int st = b / 1024, sb = b % 1024, swz = sb ^ (((sb >> 9) & 1) << 5); R = (st >> 1) * 16 + swz / 64; C = (st & 1) * 32 + (swz % 64) / 2; }
__host__ __device__ __forceinline__ int perm32(int rho) { const int n = rho >> 4, i = rho & 15; return 8 * (i >> 2) + 4 * n + (i & 3); }

struct GUnit { const char* A; const char* B; char* C; const void* X; int pm, pn; };
template <int WGM = 8>
__device__ __forceinline__ bool static_unit(int i, int G, int c, int nM, int nN, int& pm, int& pn) {
    const long L = (long)i * G + c; const int nwg = nM * nN; if (L >= nwg) return false;
    int wgid = (int)L; { const int q = nwg / 8, r = nwg % 8, xcd = wgid % 8, off = wgid / 8; wgid = (xcd < r ? xcd * (q + 1) : r * (q + 1) + (xcd - r) * q) + off; }
    const int nig = WGM * nN, gid = wgid / nig, fm = gid * WGM, gsz = (nM - fm) < WGM ? (nM - fm) : WGM;
    pm = fm + ((wgid % nig) % gsz); pn = (wgid % nig) / gsz; return true;
}
template <class Epi, class Sched, bool GATHER, bool FP8 = false>
__device__ __forceinline__ void gemm_phase(LAS unsigned char* lds, const int tid_in, const int K, const unsigned lda, const unsigned ldb, const Sched& S, const Epi& E) {
    int tid_ = tid_in; asm volatile("" : "+v"(tid_));
    const int tid = tid_, wid = __builtin_amdgcn_readfirstlane(tid >> 6), lane = tid & 63, wr = wid >> 2, wc = wid & 3, fr = lane & 15, fq = lane >> 4;
    int nt_ = K / BK; asm volatile("" : "+s"(nt_)); const int nt = nt_;
    unsigned voffA[2], voffB[2]; int gR[2], gC[2];
#pragma unroll
    for (int i = 0; i < 2; ++i) { int R, C; stage_rc(tid * 16 + i * 8192, R, C); const int Rb = Epi::PERM ? ((R & ~31) + perm32(R & 31)) : R;
        voffA[i] = (unsigned)R * lda + (unsigned)C * 2u; voffB[i] = (unsigned)Rb * ldb + (unsigned)C * 2u; gR[i] = R; gC[i] = C * 2; }
    const size_t kstep = (size_t)(BK * 2);
    const size_t hstepA = (size_t)HALF * lda, hstepB = (size_t)HALF * ldb;
    const unsigned ldsw = (unsigned)wid * 1024u;
    const int aoff = lds_byte(wr * 64 + fr, fq * 8), boff = lds_byte(wc * 32 + fr, fq * 8);
    unsigned cvo[2][2], nvo[2][2];
#define PG8_SA(b, h) (((b) * 2 + (h)) * HTB)
#define PG8_SB(b, h) ((4 + (b) * 2 + (h)) * HTB)
#define PG8_STAGE(bufoff, gbase, voff) do { _Pragma("unroll") for (int _i = 0; _i < 2; ++_i) \
        __builtin_amdgcn_global_load_lds((const unsigned*)((const char*)(gbase) + (voff)[_i]), (LAS unsigned*)(lds + (bufoff) + ldsw + _i * 8192), 16, 0, 0); } while (0)
#define PG8_STAGE_B(bufoff, ptr, h) PG8_STAGE(bufoff, (ptr) + (h) * hstepB, voffB)
#define PG8_STAGE_A(bufoff, ptr, h, vo) do { if constexpr (GATHER) { PG8_STAGE(bufoff, (ptr), (vo)[h]); } else { PG8_STAGE(bufoff, (ptr) + (h) * hstepA, voffA); } } while (0)
#define PG8_LDA(dst, b, h) do { _Pragma("unroll") for (int m = 0; m < 4; ++m) _Pragma("unroll") for (int k = 0; k < 2; ++k) dst[m][k] = *(const LAS bf16x8*)(lds + PG8_SA(b, h) + aoff + m * 2048 + k * 1024); } while (0)
#define PG8_LDB(dst, b, h) do { _Pragma("unroll") for (int n = 0; n < 2; ++n) _Pragma("unroll") for (int k = 0; k < 2; ++k) dst[n][k] = *(const LAS bf16x8*)(lds + PG8_SB(b, h) + boff + n * 2048 + k * 1024); } while (0)
#define PG8_MMA(ai, bj, At, Bt) do { __builtin_amdgcn_s_setprio(1); _Pragma("unroll") for (int m = 0; m < 4; ++m) _Pragma("unroll") for (int n = 0; n < 2; ++n) { \
        if constexpr (FP8) { const v8i _a = __builtin_shufflevector(__builtin_bit_cast(v4i, At[m][0]), __builtin_bit_cast(v4i, At[m][1]), 0, 1, 2, 3, 4, 5, 6, 7), _b = __builtin_shufflevector(__builtin_bit_cast(v4i, Bt[n][0]), __builtin_bit_cast(v4i, Bt[n][1]), 0, 1, 2, 3, 4, 5, 6, 7); \
            asm volatile("v_mfma_f32_16x16x128_f8f6f4 %0, %1, %2, %0" : "+v"(acc[ai][bj][m][n]) : "v"(_b), "v"(_a)); } \
        else { _Pragma("unroll") for (int k = 0; k < 2; ++k) acc[ai][bj][m][n] = __builtin_amdgcn_mfma_f32_16x16x32_bf16(Bt[n][k], At[m][k], acc[ai][bj][m][n], 0, 0, 0); } } __builtin_amdgcn_s_setprio(0); } while (0)
#define PG8_WAIT_V(n) asm volatile("s_waitcnt vmcnt(" #n ")" ::: "memory")
#define PG8_WAIT_L(n) asm volatile("s_waitcnt lgkmcnt(" #n ")" ::: "memory")
#define PG8_BAR __builtin_amdgcn_s_barrier()
#define PG8_SCHED __builtin_amdgcn_sched_barrier(0)
#define PG8_GLOAD(vo, u) do { if constexpr (GATHER) { const int* _gi = (const int*)(u).X; _Pragma("unroll") for (int _h = 0; _h < 2; ++_h) _Pragma("unroll") for (int _i = 0; _i < 2; ++_i) \
        (vo)[_h][_i] = (unsigned)_gi[_h * HALF + gR[_i]] * lda + (unsigned)gC[_i]; } } while (0)
    GUnit cur, nxt; int ui = 0;
    if (!S.next(0, cur)) return;
    f32x4 acc[2][2][4][2];
    const volatile LAS f32x4* zero16 = (const volatile LAS f32x4*)(lds + ZERO16_OFF);
#pragma unroll
    for (int a = 0; a < 2; ++a)
#pragma unroll
        for (int b = 0; b < 2; ++b)
#pragma unroll
            for (int m = 0; m < 4; ++m)
#pragma unroll
                for (int n = 0; n < 2; ++n) acc[a][b][m][n] = *zero16;
    bf16x8 At[4][2], B0[2][2], B1[2][2];
    const char* cA = cur.A; const char* cB = cur.B;
    PG8_GLOAD(cvo, cur);
    if constexpr (GATHER) { PG8_WAIT_V(0); }
    PG8_STAGE_B(PG8_SB(0, 0), cB, 0); PG8_STAGE_B(PG8_SB(0, 1), cB, 1); PG8_STAGE_A(PG8_SA(0, 0), cA, 0, cvo); PG8_STAGE_A(PG8_SA(0, 1), cA, 1, cvo);
    if (wr == 1) PG8_BAR;
    PG8_WAIT_V(2); PG8_BAR;
    PG8_STAGE_B(PG8_SB(1, 0), cB + kstep, 0); PG8_STAGE_A(PG8_SA(1, 0), cA + kstep, 0, cvo); PG8_STAGE_B(PG8_SB(1, 1), cB + kstep, 1);
    PG8_WAIT_V(6); PG8_BAR;
    for (;;) {
        const bool has_next = S.next(ui + 1, nxt);
        const char* nA = has_next ? nxt.A : cA; const char* nB = has_next ? nxt.B : cB;
        if constexpr (GATHER) { if (has_next) { PG8_GLOAD(nvo, nxt); } else {
#pragma unroll
            for (int h = 0; h < 2; ++h)
#pragma unroll
                for (int i = 0; i < 2; ++i) nvo[h][i] = cvo[h][i]; } }
        for (int t = 0; t < nt; t += 2) {
            const bool last = (t == nt - 2);
            const char* a1 = cA + (size_t)(t + 1) * kstep;
            const char* a2 = last ? nA : cA + (size_t)(t + 2) * kstep; const char* b2 = last ? nB : cB + (size_t)(t + 2) * kstep;
            const char* a3 = a2 + kstep; const char* b3 = b2 + kstep;
            unsigned vo2[2][2];
            if constexpr (GATHER) {
#pragma unroll
                for (int h = 0; h < 2; ++h)
#pragma unroll
                    for (int i = 0; i < 2; ++i) vo2[h][i] = last ? nvo[h][i] : cvo[h][i]; }
            PG8_LDB(B0, 0, 0); PG8_LDB(B1, 0, 1); PG8_SCHED; PG8_LDA(At, 0, 0); PG8_STAGE_A(PG8_SA(1, 1), a1, 1, cvo);
            PG8_WAIT_V(8); PG8_WAIT_L(0); PG8_BAR; PG8_MMA(0, 0, At, B0); PG8_MMA(0, 1, At, B1); PG8_BAR; PG8_SCHED;
            PG8_LDA(At, 0, 1); PG8_STAGE_B(PG8_SB(0, 0), b2, 0); PG8_STAGE_B(PG8_SB(0, 1), b2, 1); PG8_STAGE_A(PG8_SA(0, 0), a2, 0, vo2);
            PG8_WAIT_V(8); PG8_WAIT_L(0); PG8_BAR; PG8_MMA(1, 0, At, B0); PG8_MMA(1, 1, At, B1); PG8_BAR; PG8_SCHED;
            PG8_LDB(B0, 1, 0); PG8_LDB(B1, 1, 1); PG8_SCHED; PG8_LDA(At, 1, 0); PG8_STAGE_A(PG8_SA(0, 1), a2, 1, vo2);
            PG8_WAIT_V(8); PG8_WAIT_L(0); PG8_BAR; PG8_MMA(0, 0, At, B0); PG8_MMA(0, 1, At, B1); PG8_BAR; PG8_SCHED;
            PG8_LDA(At, 1, 1); PG8_STAGE_B(PG8_SB(1, 0), b3, 0); PG8_STAGE_B(PG8_SB(1, 1), b3, 1); PG8_STAGE_A(PG8_SA(1, 0), a3, 0, vo2);
            PG8_WAIT_V(8); PG8_WAIT_L(0); PG8_BAR; PG8_MMA(1, 0, At, B0); PG8_MMA(1, 1, At, B1); PG8_BAR; PG8_SCHED;
        }
        if constexpr (FP8) { asm volatile("s_nop 15\n\ts_nop 15" ::: "memory"); }
        if (wr == 0) PG8_BAR;
        E(acc, cur, wr, wc, fr, fq);
        if (!has_next) break;
#pragma unroll
        for (int a = 0; a < 2; ++a)
#pragma unroll
            for (int b = 0; b < 2; ++b)
#pragma unroll
                for (int m = 0; m < 4; ++m)
#pragma unroll
                    for (int n = 0; n < 2; ++n) acc[a][b][m][n] = *zero16;
        cur = nxt; cA = nA; cB = nB; ++ui;
        if constexpr (GATHER) {
#pragma unroll
            for (int h = 0; h < 2; ++h)
#pragma unroll
                for (int i = 0; i < 2; ++i) cvo[h][i] = nvo[h][i]; }
        if (wr == 1) PG8_BAR;
    }
    PG8_WAIT_V(0);
    PG8_BAR;
#undef PG8_SA
#undef PG8_SB
#undef PG8_STAGE
#undef PG8_STAGE_A
#undef PG8_STAGE_B
#undef PG8_LDA
#undef PG8_LDB
#undef PG8_MMA
#undef PG8_WAIT_V
#undef PG8_WAIT_L
#undef PG8_BAR
#undef PG8_SCHED
#undef PG8_GLOAD
}
typedef f32x4 Acc[2][2][4][2];
__device__ __forceinline__ float sigmoidf_fast(float x) { return __builtin_amdgcn_rcpf(1.f + __builtin_amdgcn_exp2f(-1.4426950408889634f * x)); }
__device__ __forceinline__ float gelu_tanh_fast(float y) {
    const float inner = 1.5957691216057308f * (y + 0.044715f * y * y * y);
    return y * sigmoidf_fast(inner);
}
__device__ __forceinline__ unsigned cvt4_fp8(float a, float b, float c, float d) {
    a = fminf(fmaxf(a, -448.f), 448.f); b = fminf(fmaxf(b, -448.f), 448.f); c = fminf(fmaxf(c, -448.f), 448.f); d = fminf(fmaxf(d, -448.f), 448.f);
    int w = 0; w = __builtin_amdgcn_cvt_pk_fp8_f32(a, b, w, false); w = __builtin_amdgcn_cvt_pk_fp8_f32(c, d, w, true); return (unsigned)w;
}
constexpr float FP8_SX = 8.f, FP8_SW13 = 32.f, FP8_SH = 8.f, FP8_SW2 = 64.f, FP8_SWQK = 32.f, FP8_SWQKV = 32.f;
struct EpiGated8 {
    static constexpr bool PERM = true;
    unsigned ldc;
    __device__ __forceinline__ void operator()(const Acc& acc, const GUnit& u, int wr, int wc, int fr, int fq) const {
        unsigned char* base = (unsigned char*)u.C;
        constexpr float kx = -1.4426950408889634f / (FP8_SX * FP8_SW13), ic = (FP8_SX * FP8_SW13) * (FP8_SX * FP8_SW13) / FP8_SH;
#pragma unroll
        for (int ai = 0; ai < 2; ++ai)
#pragma unroll
            for (int m = 0; m < 4; ++m) { const int r = ai * HALF + wr * 64 + m * 16 + fr;
                float o[8];
#pragma unroll
                for (int n = 0; n < 2; ++n)
#pragma unroll
                    for (int j = 0; j < 4; j += 2) {
                        const f32x2 a = {acc[ai][0][m][n][j], acc[ai][0][m][n][j + 1]}, b = {acc[ai][1][m][n][j], acc[ai][1][m][n][j + 1]};
                        const f32x2 t = a * f32x2{kx, kx};
                        const f32x2 e = {__builtin_amdgcn_exp2f(t[0]), __builtin_amdgcn_exp2f(t[1])};
                        const f32x2 d = e * f32x2{ic, ic} + f32x2{ic, ic};
                        const f32x2 s = {__builtin_amdgcn_rcpf(d[0]), __builtin_amdgcn_rcpf(d[1])};
                        const f32x2 q = (a * b) * s;
                        o[n * 4 + j] = __builtin_amdgcn_fmed3f(q[0], -448.f, 448.f); o[n * 4 + j + 1] = __builtin_amdgcn_fmed3f(q[1], -448.f, 448.f); }
                int w0 = 0, w1 = 0;
                w0 = __builtin_amdgcn_cvt_pk_fp8_f32(o[0], o[1], w0, false); w0 = __builtin_amdgcn_cvt_pk_fp8_f32(o[2], o[3], w0, true);
                w1 = __builtin_amdgcn_cvt_pk_fp8_f32(o[4], o[5], w1, false); w1 = __builtin_amdgcn_cvt_pk_fp8_f32(o[6], o[7], w1, true);
                u32x2 w; w.x = (unsigned)w0; w.y = (unsigned)w1;
                st8(base + (size_t)r * ldc + wc * 32 + 8 * fq, w); }
    }
};
struct EpiBf8 {
    static constexpr bool PERM = true;
    unsigned ldc; float scale;
    __device__ __forceinline__ void operator()(const Acc& acc, const GUnit& u, int wr, int wc, int fr, int fq) const {
        unsigned char* base = (unsigned char*)u.C;
#pragma unroll
        for (int ai = 0; ai < 2; ++ai)
#pragma unroll
            for (int m = 0; m < 4; ++m) { const int r = ai * HALF + wr * 64 + m * 16 + fr; unsigned char* rowp = base + (size_t)r * ldc + wc * 32 + 8 * fq;
#pragma unroll
                for (int bj = 0; bj < 2; ++bj) { const f32x4 v0 = acc[ai][bj][m][0] * scale, v1 = acc[ai][bj][m][1] * scale;
                    u32x2 w; w.x = cvt4_fp8(v0[0], v0[1], v0[2], v0[3]); w.y = cvt4_fp8(v1[0], v1[1], v1[2], v1[3]); st8(rowp + bj * HALF, w); } }
    }
};
template <bool ROWSCALE> struct EpiBf {
    static constexpr bool PERM = true;
    unsigned ldc; float scale;
    __device__ __forceinline__ void operator()(const Acc& acc, const GUnit& u, int wr, int wc, int fr, int fq) const {
        bf16_t* base = (bf16_t*)u.C; const float* rs = (const float*)u.X;
#pragma unroll
        for (int ai = 0; ai < 2; ++ai)
#pragma unroll
            for (int m = 0; m < 4; ++m) { const int r = ai * HALF + wr * 64 + m * 16 + fr; float s = scale; if (ROWSCALE) s *= rs[r];
                bf16_t* rowp = base + (size_t)r * ldc + wc * 32 + 8 * fq;
#pragma unroll
                for (int bj = 0; bj < 2; ++bj) { const f32x4 v0 = acc[ai][bj][m][0] * s, v1 = acc[ai][bj][m][1] * s;
                    u32x4 w; w.x = cvt_pk_bf16(v0[0], v0[1]); w.y = cvt_pk_bf16(v0[2], v0[3]); w.z = cvt_pk_bf16(v1[0], v1[1]); w.w = cvt_pk_bf16(v1[2], v1[3]);
                    st16(rowp + bj * HALF, w); } }
    }
};
template <int MODE> struct EpiGated {
    static constexpr bool PERM = true;
    unsigned ldc;
    __device__ __forceinline__ void operator()(const Acc& acc, const GUnit& u, int wr, int wc, int fr, int fq) const {
        bf16_t* base = (bf16_t*)u.C;
#pragma unroll
        for (int ai = 0; ai < 2; ++ai)
#pragma unroll
            for (int m = 0; m < 4; ++m) { const int r = ai * HALF + wr * 64 + m * 16 + fr;
                float o[8];
#pragma unroll
                for (int n = 0; n < 2; ++n)
#pragma unroll
                    for (int j = 0; j < 4; ++j) { const float a = acc[ai][0][m][n][j], b = acc[ai][1][m][n][j];
                        o[n * 4 + j] = (MODE == 0) ? a * sigmoidf_fast(b) : a * sigmoidf_fast(a) * b; }
                u32x4 w; w.x = cvt_pk_bf16(o[0], o[1]); w.y = cvt_pk_bf16(o[2], o[3]); w.z = cvt_pk_bf16(o[4], o[5]); w.w = cvt_pk_bf16(o[6], o[7]);
                st16(base + (size_t)r * ldc + wc * 32 + 8 * fq, w); }
    }
};
struct EpiUA {
    static constexpr bool PERM = true;
    __device__ __forceinline__ void operator()(const Acc& acc, const GUnit& u, int wr, int wc, int fr, int fq) const {
        bf16_t* UA = (bf16_t*)u.C;
#pragma unroll
        for (int ai = 0; ai < 2; ++ai)
#pragma unroll
            for (int m = 0; m < 4; ++m) { const int tok = u.pm * BM + ai * HALF + wr * 64 + m * 16 + fr; const int chunk = tok >> 5, j = tok & 31;
#pragma unroll
                for (int bj = 0; bj < 2; ++bj) { const int ch = u.pn * BM + bj * HALF + wc * 32 + 8 * fq, g = ch >> 4, h0 = ch & 15;
                    const f32x4 v0 = acc[ai][bj][m][0], v1 = acc[ai][bj][m][1];
                    u32x4 w; w.x = cvt_pk_bf16(v0[0], v0[1]); w.y = cvt_pk_bf16(v0[2], v0[3]); w.z = cvt_pk_bf16(v1[0], v1[1]); w.w = cvt_pk_bf16(v1[2], v1[3]);
                    st16(UA + ((size_t)g * NCHUNK + chunk) * UAK + j * 16 + h0, w); } }
    }
};
struct EpiS {
    static constexpr bool PERM = false;
    __device__ __forceinline__ void operator()(const Acc& acc, const GUnit& u, int wr, int wc, int fr, int fq) const {
        float* Sg = (float*)u.C;
#pragma unroll
        for (int ai = 0; ai < 2; ++ai)
#pragma unroll
            for (int m = 0; m < 4; ++m) { const int chunk = u.pm * BM + ai * HALF + wr * 64 + m * 16 + fr; float* rowp = Sg + (size_t)chunk * 256 + wc * 32 + 4 * fq;
#pragma unroll
                for (int bj = 0; bj < 2; ++bj)
#pragma unroll
                    for (int n = 0; n < 2; ++n) st16f(rowp + bj * HALF + n * 16, acc[ai][bj][m][n]); }
    }
};
struct EpiGelu {
    static constexpr bool PERM = true;
    __device__ __forceinline__ void operator()(const Acc& acc, const GUnit& u, int wr, int wc, int fr, int fq) const {
        bf16_t* Gg = (bf16_t*)u.C;
#pragma unroll
        for (int ai = 0; ai < 2; ++ai)
#pragma unroll
            for (int m = 0; m < 4; ++m) { const int chunk = u.pm * BM + ai * HALF + wr * 64 + m * 16 + fr;
#pragma unroll
                for (int bj = 0; bj < 2; ++bj) { const int n0 = u.pn * BM + bj * HALF + wc * 32 + 8 * fq, i = n0 >> 4, c0 = n0 & 15;
                    const f32x4 v0 = acc[ai][bj][m][0], v1 = acc[ai][bj][m][1];
                    u32x4 w; w.x = cvt_pk_bf16(gelu_tanh_fast(v0[0]), gelu_tanh_fast(v0[1])); w.y = cvt_pk_bf16(gelu_tanh_fast(v0[2]), gelu_tanh_fast(v0[3]));
                    w.z = cvt_pk_bf16(gelu_tanh_fast(v1[0]), gelu_tanh_fast(v1[1])); w.w = cvt_pk_bf16(gelu_tanh_fast(v1[2]), gelu_tanh_fast(v1[3]));
                    st16(Gg + ((size_t)chunk * TCH + i) * D + c0, w); } }
    }
};

struct EpiSoftmax {
    static constexpr bool PERM = true;
    LAS float* red; unsigned ldc; float scale;
    __device__ __forceinline__ void operator()(Acc& acc, const GUnit& u, int wr, int wc, int fr, int fq) const {
        bf16_t* base = (bf16_t*)u.C;
#pragma unroll
        for (int ai = 0; ai < 2; ++ai)
#pragma unroll
            for (int m = 0; m < 4; ++m) { float mx = -INFINITY;
#pragma unroll
                for (int bj = 0; bj < 2; ++bj)
#pragma unroll
                    for (int n = 0; n < 2; ++n) { const f32x4 v = acc[ai][bj][m][n]; mx = fmaxf(mx, fmaxf(fmaxf(v[0], v[1]), fmaxf(v[2], v[3]))); }
                mx *= scale; mx = x32_max(x16_max(mx));
                if (fq == 0) red[(ai * HALF + wr * 64 + m * 16 + fr) * 4 + wc] = mx; }
        asm volatile("s_waitcnt lgkmcnt(0)" ::: "memory"); __builtin_amdgcn_s_barrier(); asm volatile("" ::: "memory");
#pragma unroll
        for (int ai = 0; ai < 2; ++ai)
#pragma unroll
            for (int m = 0; m < 4; ++m) { const int r = ai * HALF + wr * 64 + m * 16 + fr; const f32x4 mm = *(const LAS f32x4*)(red + r * 4); const float M = fmaxf(fmaxf(mm[0], mm[1]), fmaxf(mm[2], mm[3]));
                float s = 0.f;
#pragma unroll
                for (int bj = 0; bj < 2; ++bj)
#pragma unroll
                    for (int n = 0; n < 2; ++n) { f32x4 v = acc[ai][bj][m][n];
#pragma unroll
                        for (int j = 0; j < 4; ++j) { v[j] = __builtin_amdgcn_exp2f(__builtin_fmaf(v[j], scale, -M)); s += v[j]; }
                        acc[ai][bj][m][n] = v; }
                s = x32_sum(x16_sum(s));
                if (fq == 0) red[1024 + r * 4 + wc] = s; }
        asm volatile("s_waitcnt lgkmcnt(0)" ::: "memory"); __builtin_amdgcn_s_barrier(); asm volatile("" ::: "memory");
#pragma unroll
        for (int ai = 0; ai < 2; ++ai)
#pragma unroll
            for (int m = 0; m < 4; ++m) { const int r = ai * HALF + wr * 64 + m * 16 + fr; const f32x4 ss = *(const LAS f32x4*)(red + 1024 + r * 4); const float inv = __builtin_amdgcn_rcpf((ss[0] + ss[1]) + (ss[2] + ss[3]));
                bf16_t* rowp = base + (size_t)r * ldc + wc * 32 + 8 * fq;
#pragma unroll
                for (int bj = 0; bj < 2; ++bj) { const f32x4 v0 = acc[ai][bj][m][0] * inv, v1 = acc[ai][bj][m][1] * inv;
                    u32x4 w; w.x = cvt_pk_bf16(v0[0], v0[1]); w.y = cvt_pk_bf16(v0[2], v0[3]); w.z = cvt_pk_bf16(v1[0], v1[1]); w.w = cvt_pk_bf16(v1[2], v1[3]);
                    st16(rowp + bj * HALF, w); } }
    }
};

struct Ctx { unsigned char* ws; int G, c; };
struct SchedPlain { const char* A; const char* B; char* C; size_t lda, ldb, ldc; int nM, nN, G, c;
    __device__ __forceinline__ bool next(int i, GUnit& u) const { int pm, pn; if (!static_unit(i, G, c, nM, nN, pm, pn)) return false;
        u.A = A + (size_t)pm * BM * lda; u.B = B + (size_t)pn * BM * ldb; u.C = C + ((size_t)pm * BM * ldc + (size_t)pn * BM) * 2; u.X = nullptr; u.pm = pm; u.pn = pn; return true; } };
struct SchedGated { const char* A; const char* B; char* C; size_t lda, ldb, ldc; int nM, nN, G, c;
    __device__ __forceinline__ bool next(int i, GUnit& u) const { int pm, pn; if (!static_unit(i, G, c, nM, nN, pm, pn)) return false;
        u.A = A + (size_t)pm * BM * lda; u.B = B + (size_t)pn * BM * ldb; u.C = C + ((size_t)pm * BM * ldc + (size_t)pn * HALF) * 2; u.X = nullptr; u.pm = pm; u.pn = pn; return true; } };
struct SchedUA { const char* A; const char* B; char* UA; int G, c;
    __device__ __forceinline__ bool next(int i, GUnit& u) const { int pm, pn; if (!static_unit(i, G, c, NT / BM, D / BM, pm, pn)) return false;
        u.A = A + (size_t)pm * BM * (D * 2); u.B = B + (size_t)pn * BM * (D * 2); u.C = UA; u.X = nullptr; u.pm = pm; u.pn = pn; return true; } };
struct SchedKV { unsigned char* ws; int G, c;
    __device__ __forceinline__ bool next(int i, GUnit& u) const { const int L = i * G + c; if (L >= 128) return false; const int layer = L >> 6, r = L & 63, pm = r >> 3, pn = r & 7;
        u.A = (const char*)ws + WS_MEMB + (size_t)pm * BM * 2048; u.B = (const char*)ws + WS_MWKV + (size_t)layer * 4 * MiB + (size_t)pn * BM * 2048;
        u.C = (char*)ws + WS_KV + (size_t)layer * 8 * MiB + ((size_t)pm * BM * 2048 + pn * BM) * 2; u.X = nullptr; u.pm = pm; u.pn = pn; return true; } };
struct SchedSA { unsigned char* ws; int G, c;
    __device__ __forceinline__ bool next(int i, GUnit& u) const { const int L = i * G + c; if (L >= 64 * 6) return false; const int g = L / 6, pm = L % 6;
        u.A = (const char*)ws + PO_UA + ((size_t)g * NCHUNK + (size_t)pm * BM) * (UAK * 2); u.B = (const char*)ws + PO_M2T + (size_t)g * 256 * 512 * 2;
        u.C = (char*)ws + PO_SG + (size_t)g * NCHUNK * 256 * 4; u.X = nullptr; u.pm = pm; u.pn = 0; return true; } };
struct SchedSC { unsigned char* ws; int G, c;
    __device__ __forceinline__ bool next(int i, GUnit& u) const { const int L = i * G + c; if (L >= 64 * 12) return false; const int g = L / 12, r = L % 12, pm = r >> 1, pn = r & 1;
        u.A = (const char*)ws + PO_UA + ((size_t)g * NCHUNK + (size_t)pm * BM) * (UAK * 2); u.B = (const char*)ws + PO_M13T + ((size_t)g * 512 + pn * BM) * UAK * 2;
        u.C = (char*)ws + PO_SG + (size_t)g * 16 * 2; u.X = nullptr; u.pm = pm; u.pn = pn; return true; } };
struct SchedWqk { unsigned char* ws; int G, c;
    __device__ __forceinline__ bool next(int i, GUnit& u) const { const int L = i * G + c; if (L >= 256) return false; const int pn = L & 3, h = (L >> 2) & 3, gb = (L >> 4) & 7, layer = L >> 7;
        u.A = (const char*)ws + WS_KV + (size_t)layer * 8 * MiB + ((size_t)gb * 256 * 2048 + h * 256) * 2; u.B = (const char*)ws + WS_MWQ + (size_t)layer * 2 * MiB + ((size_t)pn * BM * 1024 + h * 256) * 2;
        u.C = (char*)ws + WS_WQK + ((size_t)(layer * 8 + gb) * 1024 * 1024 + (size_t)h * 256 * 1024 + pn * BM); u.X = nullptr; u.pm = 0; u.pn = pn; return true; } };
struct SchedWvo { unsigned char* ws; int G, c;
    __device__ __forceinline__ bool next(int i, GUnit& u) const { const int L = i * G + c; if (L >= 256) return false; const int pm = L & 3, h = (L >> 2) & 3, gb = (L >> 4) & 7, layer = L >> 7;
        u.A = (const char*)ws + WS_MWO + (size_t)layer * 2 * MiB + ((size_t)pm * BM * 1024 + h * 256) * 2; u.B = (const char*)ws + WS_KV + (size_t)layer * 8 * MiB + ((size_t)gb * 256 * 2048 + 1024 + h * 256) * 2;
        u.C = (char*)ws + WS_WVO + ((size_t)(layer * 8 + gb) * 1024 * 1024 + (size_t)pm * BM * 1024 + h * 256) * 2; u.X = nullptr; u.pm = pm; u.pn = 0; return true; } };
struct SchedScores8 { const char* A; const char* Bl; char* C; int G, c;
    __device__ __forceinline__ bool next(int i, GUnit& u) const { int pm, pn; if (!static_unit(i, G, c, NT / BM, 4, pm, pn)) return false; const int gb = panel_gb(pm);
        u.A = A + (size_t)pm * BM * 1024; u.B = Bl + ((size_t)gb * 1024 + pn * BM) * 1024; u.C = C + ((size_t)pm * BM * 1024 + pn * BM) * 2; u.X = nullptr; u.pm = pm; u.pn = pn; return true; } };
struct SchedBatchW { const char* A; const char* Bl; char* C; int G, c;
    __device__ __forceinline__ bool next(int i, GUnit& u) const { int pm, pn; if (!static_unit(i, G, c, NT / BM, 4, pm, pn)) return false; const int gb = panel_gb(pm);
        u.A = A + (size_t)pm * BM * 2048; u.B = Bl + ((size_t)gb * 1024 + pn * BM) * 2048; u.C = C + ((size_t)pm * BM * 1024 + pn * BM) * 2; u.X = nullptr; u.pm = pm; u.pn = pn; return true; } };
struct Args { const float* in[26]; float* out; unsigned char* ws; int ph_lo, ph_hi, flags, pad; };
struct Frame {
    LAS unsigned char* lds; unsigned char* ws; const float* const* in; float* out;
    int tid, lane, wave, G, c;
    bool xok;
};
enum { I_XP = 0, I_XS, I_MEMP, I_MEMS, I_AWIN, I_ALRE, I_ALIM, I_ALDT, I_ABRE, I_ABIM, I_ACRE, I_ACIM, I_AD, I_AWGLU, I_BWQKV, I_BRPB, I_BWO, I_MWQ, I_MWKV, I_MWO, I_EWR, I_EW1, I_EW3, I_EW2, I_LNG, I_LNB };

__device__ __forceinline__ int rowmap(int mode, int n) {
    if (mode == 0) return n;
    if (mode == 1) { const int z = n >> 10, nn = n & 1023; return ((nn >> 7) << 8) + (z << 7) + (nn & 127); }
    return ((n >> 7) << 8) + ((mode == 3) ? 128 : 0) + (n & 127);
}
__device__ __forceinline__ void transpose_item(const float* W, int K, int N, bf16_t* WT, int mode, LAS float* scr, int item, int lane) {
    const int nblk = N / 32, kb = item / nblk, nb = item % nblk, k0 = 64 * kb, n0 = 32 * nb;
#pragma unroll 8
    for (int i = 0; i < 32; ++i) { const int kk = 2 * i + (lane >> 5); scr[kk * 33 + (lane & 31)] = W[(size_t)(k0 + kk) * N + n0 + (lane & 31)]; }
    LDS_WAIT(); asm volatile("" ::: "memory");
    const int c = lane & 7;
#pragma unroll
    for (int j = 0; j < 4; ++j) { const int n = (lane >> 3) + 8 * j; const LAS float* s = scr + (8 * c) * 33 + n;
        u32x4 o; o.x = cvt_pk_bf16(s[0 * 33], s[1 * 33]); o.y = cvt_pk_bf16(s[2 * 33], s[3 * 33]); o.z = cvt_pk_bf16(s[4 * 33], s[5 * 33]); o.w = cvt_pk_bf16(s[6 * 33], s[7 * 33]);
        *(u32x4*)(WT + (size_t)rowmap(mode, n0 + n) * K + k0 + 8 * c) = o; }
    LDS_WAIT(); asm volatile("" ::: "memory");
}
__device__ __forceinline__ void t8_load(f32x4 (&v)[16], const float* W, int N, int item, int lane) {
    const int nblk = N / 32, kb = item / nblk, nb = item % nblk, k0 = 128 * kb, n0 = 32 * nb, q = lane >> 3, c = lane & 7;
#pragma unroll
    for (int i = 0; i < 16; ++i) v[i] = *(const f32x4*)(W + (size_t)(k0 + 16 * q + i) * N + n0 + 4 * c);
}
__device__ __forceinline__ void t8_finish(const f32x4 (&v)[16], int K, int N, unsigned char* WT, int mode, float scale, LAS unsigned char* scr, int item, int lane) {
    const int nblk = N / 32, kb = item / nblk, nb = item % nblk, k0 = 128 * kb, n0 = 32 * nb, q = lane >> 3, c = lane & 7;
#pragma unroll
    for (int j = 0; j < 4; ++j) { u32x4 o;
        o.x = cvt4_fp8(v[0][j] * scale, v[1][j] * scale, v[2][j] * scale, v[3][j] * scale); o.y = cvt4_fp8(v[4][j] * scale, v[5][j] * scale, v[6][j] * scale, v[7][j] * scale);
        o.z = cvt4_fp8(v[8][j] * scale, v[9][j] * scale, v[10][j] * scale, v[11][j] * scale); o.w = cvt4_fp8(v[12][j] * scale, v[13][j] * scale, v[14][j] * scale, v[15][j] * scale);
        *(LAS u32x4*)(scr + (4 * c + j) * 144 + 16 * q) = o; }
    LDS_WAIT(); asm volatile("" ::: "memory");
#pragma unroll
    for (int j = 0; j < 4; ++j) { const int n = (lane >> 3) + 8 * j; const u32x4 o = *(const LAS u32x4*)(scr + n * 144 + 16 * c);
        pst16(WT + (size_t)rowmap(mode, n0 + n) * K + k0 + 16 * c, o); }
    LDS_WAIT(); asm volatile("" ::: "memory");
}
__device__ __forceinline__ void transpose_item8(const float* W, int K, int N, unsigned char* WT, int mode, float scale, LAS unsigned char* scr, int item, int lane) {
    f32x4 v[16]; t8_load(v, W, N, item, lane); t8_finish(v, K, N, WT, mode, scale, scr, item, lane);
}
__device__ __forceinline__ void transpose_item16(const float* W, int K, int N, bf16_t* WT, int mode, LAS unsigned char* scr, int item, int lane) {
    const int nblk = N / 32, kb = item / nblk, nb = item % nblk, k0 = 128 * kb, n0 = 32 * nb, q = lane >> 3, c = lane & 7;
    f32x4 v[16];
#pragma unroll
    for (int i = 0; i < 16; ++i) v[i] = *(const f32x4*)(W + (size_t)(k0 + 16 * q + i) * N + n0 + 4 * c);
#pragma unroll
    for (int j = 0; j < 4; ++j) { u32x4 o0, o1;
        o0.x = cvt_pk_bf16(v[0][j], v[1][j]); o0.y = cvt_pk_bf16(v[2][j], v[3][j]); o0.z = cvt_pk_bf16(v[4][j], v[5][j]); o0.w = cvt_pk_bf16(v[6][j], v[7][j]);
        o1.x = cvt_pk_bf16(v[8][j], v[9][j]); o1.y = cvt_pk_bf16(v[10][j], v[11][j]); o1.z = cvt_pk_bf16(v[12][j], v[13][j]); o1.w = cvt_pk_bf16(v[14][j], v[15][j]);
        *(LAS u32x4*)(scr + (4 * c + j) * 272 + 32 * q) = o0; *(LAS u32x4*)(scr + (4 * c + j) * 272 + 32 * q + 16) = o1; }
    LDS_WAIT(); asm volatile("" ::: "memory");
#pragma unroll
    for (int j = 0; j < 8; ++j) { const int n = (lane >> 4) + 4 * j, ch = lane & 15; const u32x4 o = *(const LAS u32x4*)(scr + n * 272 + 16 * ch);
        *(u32x4*)(WT + (size_t)rowmap(mode, n0 + n) * K + k0 + 8 * ch) = o; }
    LDS_WAIT(); asm volatile("" ::: "memory");
}
__device__ __forceinline__ void convert_small_weights(Frame& F) {
    LAS unsigned char* scr = F.lds + F.wave * 16384;
    const int gw = F.c * 8 + F.wave, NGW = F.G * 8;
    for (int it = gw; it < 3328; it += NGW) {
        int r = it;
        if (r < 256) { transpose_item16(F.in[I_AWIN], 1024, 1024, (bf16_t*)(F.ws + WS_WIN), 0, scr, r, F.lane); continue; } r -= 256;
        if (r < 512) { transpose_item16(F.in[I_AWGLU], 1024, 2048, (bf16_t*)(F.ws + WS_WGLU), 1, scr, r, F.lane); continue; } r -= 512;
        if (r < 768) { transpose_item8(F.in[I_BWQKV], 1024, 3072, F.ws + WS_WQKV, 0, FP8_SWQKV, scr, r, F.lane); continue; } r -= 768;
        if (r < 256) { transpose_item16(F.in[I_BWO], 1024, 1024, (bf16_t*)(F.ws + WS_WO), 0, scr, r, F.lane); continue; } r -= 256;
        if (r < 1024) { const int l = r >> 9; transpose_item16(F.in[I_MWKV] + (size_t)l * 1024 * 2048, 1024, 2048, (bf16_t*)(F.ws + WS_MWKV + (size_t)l * 4 * MiB), 0, scr, r & 511, F.lane); continue; } r -= 1024;
        { const int l = r >> 8; transpose_item16(F.in[I_MWO] + (size_t)l * 1024 * 1024, 1024, 1024, (bf16_t*)(F.ws + WS_MWO + (size_t)l * 2 * MiB), 0, scr, r & 255, F.lane); }
    }
}
__device__ __forceinline__ void convert_expert_weights(Frame& F, int layer, int lo = 0, int hi = 16 * 1536, int wg0 = 0) {
    if (F.G <= wg0) wg0 = 0;
    if (F.c < wg0) return;
    LAS unsigned char* scr = F.lds + F.wave * 16384;
    const int gw = (F.c - wg0) * 8 + F.wave, NGW = (F.G - wg0) * 8;
#define CVX_DECODE(it_) const int _e = (it_) / 1536; int _r = (it_) % 1536; const size_t _wofs = ((size_t)layer * 16 + _e) * 1024 * 2048; \
        const int _w = _r >> 9; _r &= 511; const float* _W = (_w == 0 ? F.in[I_EW1] : (_w == 1 ? F.in[I_EW3] : F.in[I_EW2])) + _wofs; const int _N = _w == 2 ? 1024 : 2048, _K = _w == 2 ? 2048 : 1024;
#define CVX_LOAD(v_, it_) do { CVX_DECODE(it_); (void)_K; t8_load(v_, _W, _N, _r, F.lane); } while (0)
#define CVX_FINISH(v_, it_) do { CVX_DECODE(it_); unsigned char* _WT = _w == 2 ? F.ws + WS_EW2 + (size_t)_e * 2 * MiB : F.ws + WS_EW13 + (size_t)_e * 4 * MiB; \
        t8_finish(v_, _K, _N, _WT, _w == 0 ? 2 : (_w == 1 ? 3 : 0), _w == 2 ? FP8_SW2 : FP8_SW13, scr, _r, F.lane); } while (0)
    f32x4 va[16], vb[16];
    int it = lo + gw;
    if (it < hi) CVX_LOAD(va, it);
    while (it < hi) {
        const int it1 = it + NGW, it2 = it1 + NGW;
        if (it1 < hi) CVX_LOAD(vb, it1);
        CVX_FINISH(va, it);
        if (it1 < hi) { if (it2 < hi) CVX_LOAD(va, it2); CVX_FINISH(vb, it1); }
        it = it2;
    }
#undef CVX_DECODE
#undef CVX_LOAD
#undef CVX_FINISH
}
__device__ __forceinline__ void convert_plain(Frame& F, const float* src, bf16_t* dst, size_t n) {
    const size_t n4 = n / 4;
    for (size_t i = (size_t)F.c * 512 + F.tid; i < n4; i += (size_t)F.G * 512) { const f32x4 v = ((const f32x4*)src)[i]; u32x2 w; w.x = cvt_pk_bf16(v[0], v[1]); w.y = cvt_pk_bf16(v[2], v[3]); ((u32x2*)dst)[i] = w; }
}
__device__ __forceinline__ void import_x(Frame& F, bool copy_f32) {
    const size_t n4 = (size_t)NT * D / 4, np4 = (size_t)NTP * D / 4, st = (size_t)F.G * 512;
    f32x4* XF = (f32x4*)(F.ws + WS_XF); u32x2* XB = (u32x2*)(F.ws + WS_XB);
    for (size_t i0 = (size_t)F.c * 512 + F.tid; i0 < n4; i0 += st * 8) {
        f32x4 v[8];
#pragma unroll
        for (int u = 0; u < 8; ++u) { const size_t i = i0 + st * u;
            if (i < n4) { if (copy_f32) { v[u] = (i < np4) ? ((const f32x4*)F.in[I_XP])[i] : ((const f32x4*)F.in[I_XS])[i - np4]; } else v[u] = XF[i]; } }
#pragma unroll
        for (int u = 0; u < 8; ++u) { const size_t i = i0 + st * u;
            if (i < n4) { u32x2 w; w.x = cvt_pk_bf16(v[u][0], v[u][1]); w.y = cvt_pk_bf16(v[u][2], v[u][3]); XB[i] = w; } }
    }
}

__device__ __forceinline__ void s5_lam(const float* lre, const float* lim, const float* ldt, int dir, int g, int p, double& dt, double& lr, double& li) {
    dt = exp((double)ldt[dir * 64 + g]); lr = (double)lre[(dir * 64 + g) * 64 + p]; li = (double)lim[(dir * 64 + g) * 64 + p];
}
__device__ __forceinline__ void s5_fill_bc(Frame& F, int g, int dir, const LAS double* LBd, LAS float* Bbr, LAS float* Bbi, LAS float* Cr, LAS float* Ci) {
    for (int idx = F.tid; idx < 1024; idx += 512) {
        const int p = idx >> 4, h = idx & 15; const double fr = LBd[p * 4 + 2], fi = LBd[p * 4 + 3];
        const double br = F.in[I_ABRE][((dir * 64 + g) * 64 + p) * 16 + h], bi = F.in[I_ABIM][((dir * 64 + g) * 64 + p) * 16 + h];
        Bbr[idx] = (float)(fr * br - fi * bi); Bbi[idx] = (float)(fr * bi + fi * br);
        Cr[idx] = F.in[I_ACRE][(dir * 64 + g) * 1024 + idx]; Ci[idx] = F.in[I_ACIM][(dir * 64 + g) * 1024 + idx];
    }
}
__device__ __forceinline__ void s5_build_item(Frame& F, int g, int dir) {
    LAS float* LPr = (LAS float*)F.lds; LAS float* LPi = LPr + 33 * 64;
    LAS float* Bbr = LPi + 33 * 64; LAS float* Bbi = Bbr + 1024; LAS float* Cr = Bbi + 1024; LAS float* Ci = Cr + 1024;
    LAS float* B2r = Ci + 1024; LAS float* B2i = B2r + 1024; LAS float* C2r = B2i + 1024; LAS float* C2i = C2r + 1024;
    LAS float* KD = C2i + 1024;
    bf16_t* M2T = (bf16_t*)(F.ws + PO_M2T) + (size_t)g * 256 * 512; bf16_t* M13T = (bf16_t*)(F.ws + PO_M13T) + (size_t)g * 512 * UAK;
    LAS double* LB = (LAS double*)(KD + 32 * 256);
    __syncthreads();
    if (F.tid < 128) { const int dd = F.tid >> 6, p = F.tid & 63;
        if (dd == 0 || dir == 0) { double dt, lr, li; s5_lam(F.in[I_ALRE], F.in[I_ALIM], F.in[I_ALDT], dd == 0 ? dir : 1, g, p, dt, lr, li);
            const double er = exp(lr * dt), lbr = er * cos(li * dt), lbi = er * sin(li * dt), nr = lbr - 1.0, ni = lbi, den = lr * lr + li * li;
            LB[(dd * 64 + p) * 4 + 0] = lbr; LB[(dd * 64 + p) * 4 + 1] = lbi; LB[(dd * 64 + p) * 4 + 2] = (nr * lr + ni * li) / den; LB[(dd * 64 + p) * 4 + 3] = (ni * lr - nr * li) / den; } }
    __syncthreads();
    for (int idx = F.tid; idx < 33 * 64; idx += 512) { const int e = idx >> 6, p = idx & 63; double br = LB[p * 4], bi = LB[p * 4 + 1], rr = 1.0, ri = 0.0;
        for (int b = e; b != 0; b >>= 1) { if (b & 1) { const double t = rr * br - ri * bi; ri = rr * bi + ri * br; rr = t; } const double t2 = br * br - bi * bi; bi = 2.0 * br * bi; br = t2; }
        LPr[idx] = (float)rr; LPi[idx] = (float)ri; }
    s5_fill_bc(F, g, dir, LB, Bbr, Bbi, Cr, Ci);
    if (dir == 0) s5_fill_bc(F, g, 1, LB + 256, B2r, B2i, C2r, C2i);
    __syncthreads();
    {
        const int k = F.tid, j = k >> 4, h = k & 15, e = dir == 0 ? (TCH - 1 - j) : j;
        for (int p = 0; p < 64; ++p) { const float lr = LPr[e * 64 + p], li = LPi[e * 64 + p], br = Bbr[p * 16 + h], bi = Bbi[p * 16 + h];
            const float xr = lr * br - li * bi, xi = lr * bi + li * br;
            M2T[(size_t)(dir * 128 + p) * 512 + k] = (bf16_t)(cvt_pk_bf16(xr, 0.f) & 0xffffu); M2T[(size_t)(dir * 128 + 64 + p) * 512 + k] = (bf16_t)(cvt_pk_bf16(xi, 0.f) & 0xffffu); }
    }
    {
        const int p = F.tid & 63, q8 = F.tid >> 6;
        for (int ic = q8; ic < 512; ic += 8) { const int i = ic >> 4, c = ic & 15, e = dir == 0 ? (i + 1) : (TCH - i);
            const float cr = Cr[c * 64 + p], ci = Ci[c * 64 + p], lr = LPr[e * 64 + p], li = LPi[e * 64 + p];
            const float vr = cr * lr - ci * li, vi = cr * li + ci * lr;
            M13T[(size_t)ic * UAK + 512 + dir * 128 + p] = (bf16_t)(cvt_pk_bf16(vr, 0.f) & 0xffffu); M13T[(size_t)ic * UAK + 512 + dir * 128 + 64 + p] = (bf16_t)(cvt_pk_bf16(-vi, 0.f) & 0xffffu); }
    }
    {
        const int ch = F.tid & 255, c = ch >> 4, h = ch & 15, par = F.tid >> 8;
        if (dir == 0 && par == 0) {
            float s = (c == h) ? F.in[I_AD][g * 16 + c] : 0.f;
            for (int p = 0; p < 64; ++p) s += Cr[c * 64 + p] * Bbr[p * 16 + h] - Ci[c * 64 + p] * Bbi[p * 16 + h] + C2r[c * 64 + p] * B2r[p * 16 + h] - C2i[c * 64 + p] * B2i[p * 16 + h];
            KD[ch] = s;
        }
#pragma nounroll
        for (int hp = 0; hp < 64; hp += 32) {
            float cbr[32], cbi[32];
#pragma unroll
            for (int p = 0; p < 32; ++p) { const float cr = Cr[c * 64 + hp + p], ci = Ci[c * 64 + hp + p], br = Bbr[(hp + p) * 16 + h], bi = Bbi[(hp + p) * 16 + h]; cbr[p] = cr * br - ci * bi; cbi[p] = cr * bi + ci * br; }
#pragma nounroll
            for (int d = 1 + par; d < TCH; d += 2) {
                float s0 = 0.f, s1 = 0.f;
#pragma unroll
                for (int p = 0; p < 32; p += 4) { const f32x4 lr = *(const LAS f32x4*)(LPr + d * 64 + hp + p), li = *(const LAS f32x4*)(LPi + d * 64 + hp + p);
                    s0 += cbr[p] * lr[0]; s1 -= cbi[p] * li[0]; s0 += cbr[p + 1] * lr[1]; s1 -= cbi[p + 1] * li[1]; s0 += cbr[p + 2] * lr[2]; s1 -= cbi[p + 2] * li[2]; s0 += cbr[p + 3] * lr[3]; s1 -= cbi[p + 3] * li[3]; }
                if (hp == 0) KD[d * 256 + ch] = s0 + s1; else KD[d * 256 + ch] += s0 + s1;
            }
        }
        __syncthreads();
        for (int idx = F.tid; idx < 512 * 64; idx += 512) { const int hf = idx & 1, j = (idx >> 1) & 31, ic = idx >> 6, i = ic >> 4, cc = ic & 15;
            const bool mine = dir == 0 ? (j <= i) : (j > i);
            if (mine) { const int d = dir == 0 ? (i - j) : (j - i); const f32x4 v0 = *(const LAS f32x4*)(KD + d * 256 + cc * 16 + hf * 8), v1 = *(const LAS f32x4*)(KD + d * 256 + cc * 16 + hf * 8 + 4);
                u32x4 v; v.x = cvt_pk_bf16(v0[0], v0[1]); v.y = cvt_pk_bf16(v0[2], v0[3]); v.z = cvt_pk_bf16(v1[0], v1[1]); v.w = cvt_pk_bf16(v1[2], v1[3]); *(u32x4*)(M13T + (size_t)ic * UAK + j * 16 + hf * 8) = v; } }
    }
    __syncthreads();
}

__device__ __forceinline__ void s5_recurrence(Frame& F) {
    const float* S = (const float*)(F.ws + PO_SG); bf16_t* UA = (bf16_t*)(F.ws + PO_UA);
    for (int base = F.c * 256; base < 65536; base += F.G * 256) {
        if (F.tid >= 256) continue;
        const int flat = base + F.tid, p = flat & 63, dir = (flat >> 6) & 1, g = (flat >> 7) & 63, gb = flat >> 13;
        double dt, lr, li; s5_lam(F.in[I_ALRE], F.in[I_ALIM], F.in[I_ALDT], dir, g, p, dt, lr, li);
        const double er = exp(lr * dt * TCH); const float ar = (float)(er * cos(li * dt * TCH)), ai = (float)(er * sin(li * dt * TCH));
        const int nc = gb < 4 ? 256 : 128, chunk0 = gb < 4 ? gb * 256 : 1024 + (gb - 4) * 128;
        float hr = 0.f, hi = 0.f;
        for (int s0 = 0; s0 < nc; s0 += 8) {
            float sr[8], si[8];
#pragma unroll
            for (int k = 0; k < 8; ++k) { const int cc = dir == 0 ? (s0 + k) : (nc - 1 - s0 - k); const size_t o = ((size_t)g * NCHUNK + (chunk0 + cc)) * 256 + dir * 128 + p; sr[k] = S[o]; si[k] = S[o + 64]; }
#pragma unroll
            for (int k = 0; k < 8; ++k) { const int cc = dir == 0 ? (s0 + k) : (nc - 1 - s0 - k); const size_t o = ((size_t)g * NCHUNK + (chunk0 + cc)) * UAK + 512 + dir * 128 + p;
                UA[o] = (bf16_t)(cvt_pk_bf16(hr, 0.f) & 0xffffu); UA[o + 64] = (bf16_t)(cvt_pk_bf16(hi, 0.f) & 0xffffu);
                const float nr = ar * hr - ai * hi + sr[k], ni = ar * hi + ai * hr + si[k]; hr = nr; hi = ni; }
        }
    }
}

__device__ __forceinline__ void add_bf16x4(f32x4& v, const u32x2 w) { v[0] += __uint_as_float(w.x << 16); v[1] += __uint_as_float(w.x & 0xffff0000u); v[2] += __uint_as_float(w.y << 16); v[3] += __uint_as_float(w.y & 0xffff0000u); }
constexpr int WRS = 1028;
__device__ __forceinline__ void ln_router_fill(Frame& F, const float* gam, const float* bet, const float* wrouter) {
    LAS float* wrT = (LAS float*)F.lds; LAS float* gsh = wrT + 16 * WRS; LAS float* bsh = gsh + 1024;
    __syncthreads();
    for (int i = F.tid; i < 16384; i += 512) { const int k = i >> 4, e = i & 15; wrT[e * WRS + k] = wrouter[i]; }
    for (int i = F.tid; i < 1024; i += 512) { gsh[i] = gam[i]; bsh[i] = bet[i]; }
    __syncthreads();
}
#ifndef RES_BF16
#define RES_BF16 1
#endif
template <int MODE, bool ROUTER, bool FINAL, bool SRCIN = false>
__device__ __forceinline__ void ln_phase(Frame& F, const bf16_t* HB, const float* gam, const float* bet, const float* wrouter) {
    float* XF = (float*)(F.ws + WS_XF);
    LAS float* wrT = (LAS float*)F.lds;
    LAS float* gsh = wrT + 16 * WRS; LAS float* bsh = gsh + 1024;
    f32x4 gv[4], bv[4];
    if (!ROUTER) {
#pragma unroll
        for (int j = 0; j < 4; ++j) { gv[j] = *(const f32x4*)(gam + F.lane * 4 + 256 * j); bv[j] = *(const f32x4*)(bet + F.lane * 4 + 256 * j); } }
    const unsigned char* wsb = F.ws; int ln = F.lane; unsigned lb4 = (unsigned)ln * 16u, lb2 = (unsigned)ln * 8u, lb1 = (unsigned)ln * 4u;
    const unsigned hb_off = (unsigned)((const unsigned char*)HB - wsb);
    const int nq = F.xok ? 6 : (NT / 4 + F.G * 8 - 1) / (F.G * 8);
    constexpr bool X32 = SRCIN || !RES_BF16;
    f32x4 xr32[4][4]; u32x2 xr16[4][4], hwr[4][4];
#define LN_ISSUE(row0_) do { const int _r0 = (row0_); \
        const unsigned char* xbase = SRCIN ? (_r0 < NTP ? (const unsigned char*)F.in[I_XP] : (const unsigned char*)F.in[I_XS] - (size_t)NTP * 4096) : wsb + WS_XF;      \
        if (X32) { _Pragma("unroll") for (int r = 0; r < 4; ++r) { const unsigned ro = (unsigned)(_r0 + r) * 4096u + lb4; _Pragma("unroll") for (int j = 0; j < 4; ++j) xr32[r][j] = *(const f32x4*)(xbase + ro + 1024u * j); } } \
        else { _Pragma("unroll") for (int r = 0; r < 4; ++r) { const unsigned ro = (unsigned)(_r0 + r) * 2048u + lb2; _Pragma("unroll") for (int j = 0; j < 4; ++j) xr16[r][j] = *(const u32x2*)(xbase + ro + 512u * j); } } \
        if (MODE == 0) { _Pragma("unroll") for (int r = 0; r < 4; ++r) { const unsigned ro = hb_off + (unsigned)(_r0 + r) * 2048u + lb2; _Pragma("unroll") for (int j = 0; j < 4; ++j) hwr[r][j] = *(const u32x2*)(wsb + ro + 512u * j); } } \
    } while (0)
#define LN_Q(qi_) (F.xok ? ((F.c & 7) * 1536 + (F.c >> 3) * 48 + F.wave * 6 + (qi_)) : (F.c * 8 + F.wave + (qi_) * F.G * 8))
    u32x4 sln = {~0u, ~0u, ~0u, ~0u};
    if (MODE == 1) { const int q0 = LN_Q(0); if (nq > 0 && q0 < NT / 4 && F.lane < 16) sln = *(const u32x4*)(wsb + (unsigned)(WS_SLOT + ((size_t)F.lane * NT + (size_t)q0 * 4) * 4)); }
    { const int q0 = LN_Q(0); if (nq > 0 && q0 < NT / 4) { LN_ISSUE(q0 * 4); } }
    for (int qi = 0; qi < nq; ++qi) {
        const int q = LN_Q(qi);
        if (q >= NT / 4) break;
        const int row0 = q * 4;
        const u32x4 slc = sln;
        if (MODE == 1) { const int qn = LN_Q(qi + 1); if (qi + 1 < nq && qn < NT / 4 && ln < 16) sln = *(const u32x4*)(wsb + (unsigned)(WS_SLOT + ((size_t)ln * NT + (size_t)qn * 4) * 4)); }
        asm volatile("v_mbcnt_lo_u32_b32 %0, -1, 0\n\tv_mbcnt_hi_u32_b32 %0, -1, %0" : "=v"(ln));
        lb4 = (unsigned)ln * 16u; lb2 = (unsigned)ln * 8u; lb1 = (unsigned)ln * 4u; const int lw = ln * 4;
        f32x4 v[4][4];
#pragma unroll
        for (int r = 0; r < 4; ++r)
#pragma unroll
            for (int j = 0; j < 4; ++j) {
                if (X32) v[r][j] = xr32[r][j];
                else { v[r][j][0] = __uint_as_float(xr16[r][j].x << 16); v[r][j][1] = __uint_as_float(xr16[r][j].x & 0xffff0000u); v[r][j][2] = __uint_as_float(xr16[r][j].y << 16); v[r][j][3] = __uint_as_float(xr16[r][j].y & 0xffff0000u); } }
        if (MODE == 0) {
#pragma unroll
            for (int r = 0; r < 4; ++r)
#pragma unroll
                for (int j = 0; j < 4; ++j) { v[r][j] = v[r][j] * ALPHA; add_bf16x4(v[r][j], hwr[r][j]); }
        }
        if (!ROUTER) { const int qn = LN_Q(qi + 1); if (qi + 1 < nq && qn < NT / 4) { LN_ISSUE(qn * 4); } }
        if (MODE == 0) {
        } else {
            const int grp = row0 >= NTP; int sl[4];
#pragma unroll
            for (int r = 0; r < 4; ++r) sl[r] = (ln < 16) ? (int)slc[r] : -1;
            unsigned long long mask[4]; bool any[4], two[4]; u32x2 wa[4][4], wb[4][4];
#pragma unroll
            for (int r = 0; r < 4; ++r) {
                unsigned long long mk = __ballot(sl[r] >= 0); any[r] = mk != 0ull;
                int e0 = 0, s0 = 0; if (any[r]) { e0 = __builtin_ctzll(mk); mk &= mk - 1; s0 = __builtin_amdgcn_readlane(sl[r], e0); }
                const unsigned y0 = any[r] ? (grp ? 65536u + e0 * 2048u + s0 : e0 * 4096u + s0) : 0u;
                two[r] = mk != 0ull; int e1 = 0, s1 = 0; if (two[r]) { e1 = __builtin_ctzll(mk); mk &= mk - 1; s1 = __builtin_amdgcn_readlane(sl[r], e1); }
                const unsigned y1 = two[r] ? (grp ? 65536u + e1 * 2048u + s1 : e1 * 4096u + s1) : y0;
                mask[r] = mk;
                const unsigned char* ya = wsb + PO_YE + (size_t)y0 * 2048; const unsigned char* yb = wsb + PO_YE + (size_t)y1 * 2048;
#pragma unroll
                for (int j = 0; j < 4; ++j) { wa[r][j] = *(const u32x2*)(ya + lb2 + 512u * j); wb[r][j] = *(const u32x2*)(yb + lb2 + 512u * j); }
            }
#pragma unroll
            for (int r = 0; r < 4; ++r) {
#pragma unroll
                for (int j = 0; j < 4; ++j) { v[r][j] = v[r][j] * ALPHA; if (any[r]) add_bf16x4(v[r][j], wa[r][j]); if (two[r]) add_bf16x4(v[r][j], wb[r][j]); }
                unsigned long long mk = mask[r];
                while (mk) {
                    const int e0 = __builtin_ctzll(mk); mk &= mk - 1; const int s0 = __builtin_amdgcn_readlane(sl[r], e0);
                    const unsigned y0 = grp ? 65536u + e0 * 2048u + s0 : e0 * 4096u + s0;
                    const bool tw = mk != 0ull; int e1 = 0, s1 = 0; if (tw) { e1 = __builtin_ctzll(mk); mk &= mk - 1; s1 = __builtin_amdgcn_readlane(sl[r], e1); }
                    const unsigned y1 = tw ? (grp ? 65536u + e1 * 2048u + s1 : e1 * 4096u + s1) : y0;
                    const unsigned char* ya = wsb + PO_YE + (size_t)y0 * 2048; const unsigned char* yb = wsb + PO_YE + (size_t)y1 * 2048;
                    u32x2 xa[4], xb[4];
#pragma unroll
                    for (int j = 0; j < 4; ++j) { xa[j] = *(const u32x2*)(ya + lb2 + 512u * j); xb[j] = *(const u32x2*)(yb + lb2 + 512u * j); }
#pragma unroll
                    for (int j = 0; j < 4; ++j) { add_bf16x4(v[r][j], xa[j]); if (tw) add_bf16x4(v[r][j], xb[j]); }
                }
            }
        }
#pragma unroll
        for (int r = 0; r < 4; ++r) {
            float s = 0.f;
#pragma unroll
            for (int j = 0; j < 4; ++j) s += (v[r][j][0] + v[r][j][1]) + (v[r][j][2] + v[r][j][3]);
            const float mean = wave_sum(s) * (1.f / D); float qq = 0.f;
#pragma unroll
            for (int j = 0; j < 4; ++j) { v[r][j] = v[r][j] - mean; qq += (v[r][j][0] * v[r][j][0] + v[r][j][1] * v[r][j][1]) + (v[r][j][2] * v[r][j][2] + v[r][j][3] * v[r][j][3]); }
            const float rstd = 1.f / sqrtf(wave_sum(qq) * (1.f / D) + LN_EPS);
#pragma unroll
            for (int j = 0; j < 4; ++j) { if (ROUTER) { gv[j] = *(const LAS f32x4*)(gsh + lw + 256 * j); bv[j] = *(const LAS f32x4*)(bsh + lw + 256 * j); } v[r][j] = v[r][j] * rstd * gv[j] + bv[j]; }
            const unsigned row = (unsigned)(row0 + r);
            if (FINAL) {
                unsigned char* ob = (unsigned char*)F.out;
#pragma unroll
                for (int j = 0; j < 4; ++j) *(f32x4*)(ob + (size_t)(row * 4096u + lb4 + 1024u * j)) = v[r][j];
            } else {
                unsigned char* wsw = F.ws;
#pragma unroll
                for (int j = 0; j < 4; ++j) {
                    if (RES_BF16) { u32x2 xo; xo.x = cvt_pk_bf16_c(v[r][j][0], v[r][j][1]); xo.y = cvt_pk_bf16_c(v[r][j][2], v[r][j][3]); *(u32x2*)(wsw + (unsigned)(WS_XF + row * 2048u + lb2 + 512u * j)) = xo; }
                    else *(f32x4*)(wsw + (unsigned)(WS_XF + row * 4096u + lb4 + 1024u * j)) = v[r][j];
                    *(unsigned*)(wsw + (unsigned)(WS_XB8 + row * 1024u + lb1 + 256u * j)) = cvt4_fp8(v[r][j][0] * FP8_SX, v[r][j][1] * FP8_SX, v[r][j][2] * FP8_SX, v[r][j][3] * FP8_SX); }
            }
        }
        if (ROUTER) {
            { const int qn = LN_Q(qi + 1); if (qi + 1 < nq && qn < NT / 4) { LN_ISSUE(qn * 4); } }
            float val[64];
#pragma unroll
            for (int hf = 0; hf < 4; ++hf) {
                f32x2 a2[4][4];
#pragma unroll
                for (int r = 0; r < 4; ++r)
#pragma unroll
                    for (int e4 = 0; e4 < 4; ++e4) a2[r][e4] = f32x2{0.f, 0.f};
#pragma unroll
                for (int e4 = 0; e4 < 4; ++e4)
#pragma unroll
                    for (int j = 0; j < 4; ++j) { const f32x4 w = *(const LAS f32x4*)(wrT + (hf * 4 + e4) * WRS + lw + 256 * j);
                        const f32x2 wl = f32x2{w[0], w[1]}, wh = f32x2{w[2], w[3]};
#pragma unroll
                        for (int r = 0; r < 4; ++r) { a2[r][e4] = f32x2{v[r][j][0], v[r][j][1]} * wl + a2[r][e4]; a2[r][e4] = f32x2{v[r][j][2], v[r][j][3]} * wh + a2[r][e4]; } }
#pragma unroll
                for (int r = 0; r < 4; ++r)
#pragma unroll
                    for (int e4 = 0; e4 < 4; ++e4) val[r * 16 + hf * 4 + e4] = a2[r][e4][0] + a2[r][e4][1];
            }
#pragma unroll
            for (int sft = 5; sft >= 0; --sft) { const int n2 = 1 << sft; const bool up = (ln >> sft) & 1;
#pragma unroll
                for (int i = 0; i < n2; ++i) { const float lo = val[i], hi = val[i + n2]; const float mine = up ? hi : lo, other = up ? lo : hi; val[i] = mine + __shfl_xor(other, n2); } }
            const float lg = val[0], m = row_max(lg);
            const float ex = expf(lg - m); const float l = row_sum(ex);
            *(float*)(F.ws + (unsigned)(WS_AFF + ((size_t)(ln & 15) * NT + row0 + (ln >> 4)) * 4)) = ex / l;
        }
    }
#undef LN_Q
#undef LN_ISSUE
    if (ROUTER) __syncthreads();
}
__device__ __forceinline__ void softmax_phase(Frame& F, bf16_t* SB) {
    for (int row = F.c * 8 + F.wave; row < NT * 4; row += F.G * 8) {
        u32x2* p = (u32x2*)(SB + (size_t)row * 256) + F.lane; const u32x2 w = *p;
        float a = __uint_as_float(w.x << 16), b = __uint_as_float(w.x & 0xffff0000u), c = __uint_as_float(w.y << 16), d = __uint_as_float(w.y & 0xffff0000u);
        const float m = wave_max(fmaxf(fmaxf(a, b), fmaxf(c, d)));
        a = __expf(a - m); b = __expf(b - m); c = __expf(c - m); d = __expf(d - m);
        const float inv = 1.f / wave_sum((a + b) + (c + d));
        u32x2 o; o.x = cvt_pk_bf16(a * inv, b * inv); o.y = cvt_pk_bf16(c * inv, d * inv); *p = o;
    }
}
__device__ __forceinline__ void moe_panel(int P, int& e, int& grp, int& yerow0) {
    if (P < 256) { e = P >> 4; grp = 0; } else { e = (P - 256) >> 3; grp = 1; }
    yerow0 = P * 256;
}
#ifndef UPWGM
#define UPWGM 8
#endif
struct SchedUp { unsigned char* ws; int G, c;
    __device__ __forceinline__ bool next(int i, GUnit& u) const { int P, pn; if (!static_unit<UPWGM>(i, G, c, 384, 16, P, pn)) return false; int e, grp, y0; moe_panel(P, e, grp, y0);
        u.A = (const char*)ws + WS_XB8 + (grp ? (size_t)NTP * 1024 : 0); u.B = (const char*)ws + WS_EW13 + ((size_t)e * 4096 + pn * BM) * 1024;
        u.C = (char*)ws + PO_HM + ((size_t)P * BM * 2048 + pn * HALF); u.X = (const int*)(ws + WS_IDX) + y0; u.pm = P; u.pn = pn; return true; } };
struct SchedDown { unsigned char* ws; int G, c;
    __device__ __forceinline__ bool next(int i, GUnit& u) const { int P, pn; if (!static_unit(i, G, c, 384, 4, P, pn)) return false; int e, grp, y0; moe_panel(P, e, grp, y0);
        u.A = (const char*)ws + PO_HM + (size_t)P * BM * 2048; u.B = (const char*)ws + WS_EW2 + ((size_t)e * 1024 + pn * BM) * 2048;
        u.C = (char*)ws + PO_YE + ((size_t)y0 * 1024 + pn * BM) * 2; u.X = (const float*)(ws + WS_GATE) + y0; u.pm = P; u.pn = pn; return true; } };
struct SchedQKV { unsigned char* ws; int G, c;
    __device__ __forceinline__ bool next(int i, GUnit& u) const { const int L = i * G + c; if (L >= 1536 + 768) return false;
        if (L < 1536) { int pm, pn; static_unit(i, G, c, 192, 8, pm, pn);
            u.A = (const char*)ws + WS_XB8 + (size_t)pm * BM * 1024; u.B = (const char*)ws + WS_WQKV + (size_t)pn * BM * 1024;
            u.C = (char*)ws + (pn < 4 ? PO_Q : PO_K) + ((size_t)pm * BM * 1024 + (pn & 3) * BM) * 2; u.X = nullptr; u.pm = pm; u.pn = pn; return true; }
        const int r = L - 1536, pmv = r & 3, pnv = r >> 2;
        u.A = (const char*)ws + WS_WQKV + (size_t)(2048 + pmv * BM) * 1024; u.B = (const char*)ws + WS_XB8 + (size_t)pnv * BM * 1024;
        u.C = (char*)ws + PO_VT + ((size_t)pmv * BM * NT + (size_t)pnv * BM) * 2; u.X = nullptr; u.pm = pmv; u.pn = 8 + pnv; return true; } };
struct EpiQKV {
    static constexpr bool PERM = true;
    __device__ __forceinline__ void operator()(const Acc& acc, const GUnit& u, int wr, int wc, int fr, int fq) const {
        constexpr float ds = 1.f / (FP8_SX * FP8_SWQKV);
        if (u.pn >= 8) { EpiBf<false> e{(unsigned)NT, ds}; e(acc, u, wr, wc, fr, fq); }
        else { EpiBf<false> e{1024u, u.pn < 4 ? 0.125f * 1.4426950408889634f * ds : ds}; e(acc, u, wr, wc, fr, fq); }
    }
};

__device__ __forceinline__ int wave_sum_i(int v) {
#pragma unroll
    for (int o = 1; o < 64; o <<= 1) v += __shfl_xor(v, o);
    return v;
}
__device__ __forceinline__ int block_excl_scan(int v, int lane, int wave, LAS int* red, int& total) {
    int inc = v;
#pragma unroll
    for (int o = 1; o < 64; o <<= 1) { const int t = __shfl_up(inc, o); if (lane >= o) inc += t; }
    __syncthreads();
    if (lane == 63) red[wave] = inc;
    __syncthreads();
    int off = 0, tot = 0;
#pragma unroll
    for (int w = 0; w < 8; ++w) { const int c = red[w]; if (w < wave) off += c; tot += c; }
    total = tot; return off + inc - v;
}
template <int PER>
__device__ __forceinline__ void select_fast(Frame& F, const float* affcol, int cap, int* idx_out, float* gate_out, int* slotcol) {
    LAS int* red = (LAS int*)F.lds;
    unsigned key[PER];
#pragma unroll
    for (int i = 0; i < PER / 4; ++i) { const u32x4 v = ((const u32x4*)(affcol + (size_t)F.tid * PER))[i]; key[4 * i] = v.x; key[4 * i + 1] = v.y; key[4 * i + 2] = v.z; key[4 * i + 3] = v.w; }
    unsigned T = 0u;
    for (int b = 30; b >= 0; --b) {
        const unsigned cand = T | (1u << b); int cnt = 0;
#pragma unroll
        for (int i = 0; i < PER; ++i) cnt += (key[i] >= cand) ? 1 : 0;
        cnt = wave_sum_i(cnt);
        LAS int* r = red + (b & 1) * 8;
        if (F.lane == 0) r[F.wave] = cnt;
        __syncthreads();
        int tot = 0;
#pragma unroll
        for (int w = 0; w < 8; ++w) tot += r[w];
        if (tot >= cap) T = cand;
    }
    int g = 0, q = 0;
#pragma unroll
    for (int i = 0; i < PER; ++i) { g += (key[i] > T) ? 1 : 0; q += (key[i] == T) ? 1 : 0; }
    int tot_g, tot_q; (void)tot_q;
    const int Eoff = block_excl_scan(q, F.lane, F.wave, red + 32, tot_q);
    int dummy; const int Goff = block_excl_scan(g, F.lane, F.wave, red + 32, tot_g); (void)Goff;
    const int need_eq = cap - tot_g;
    int eq_take = need_eq - Eoff; eq_take = eq_take < 0 ? 0 : (eq_take > q ? q : eq_take);
    const int base = block_excl_scan(g + eq_take, F.lane, F.wave, red + 32, dummy);
    int slot = base, eqseen = 0;
    const int tok0 = F.tid * PER;
#pragma unroll
    for (int i4 = 0; i4 < PER / 4; ++i4) { int so[4];
#pragma unroll
        for (int j = 0; j < 4; ++j) { const int i = 4 * i4 + j; const unsigned k = key[i]; bool sel = k > T; if (k == T) { sel = eqseen < eq_take; ++eqseen; }
            so[j] = sel ? slot : -1; if (sel) { idx_out[slot] = tok0 + i; gate_out[slot] = __uint_as_float(k); ++slot; } }
        ((int4*)(slotcol + tok0))[i4] = make_int4(so[0], so[1], so[2], so[3]); }
}
__device__ __forceinline__ void select_phase(Frame& F) {
    for (int it = F.c; it < 32; it += F.G) {
        const int grp = it >> 4, e = it & 15; const int n = grp ? NTS : NTP, cap = n / 8;
        const float* affcol = (const float*)(F.ws + WS_AFF) + (size_t)e * NT + (grp ? NTP : 0);
        int* idx = (int*)(F.ws + WS_IDX) + (grp ? 65536 : 0) + e * cap; float* gate = (float*)(F.ws + WS_GATE) + (grp ? 65536 : 0) + e * cap;
        int* slotcol = (int*)(F.ws + WS_SLOT) + (size_t)e * NT + (grp ? NTP : 0);
        __syncthreads();
        if (grp == 0) select_fast<64>(F, affcol, cap, idx, gate, slotcol); else select_fast<32>(F, affcol, cap, idx, gate, slotcol);
        __syncthreads();
    }
}

__device__ __forceinline__ void natten_fill(Frame& F, const float* rpb) {
    LAS float* rpbs = (LAS float*)F.lds;
    __syncthreads();
    for (int i = F.tid; i < 16 * 15 * 31; i += 512) rpbs[i] = rpb[i] * 1.4426950408889634f;
    __syncthreads();
}
__device__ __forceinline__ void natten_phase(Frame& F, const float* rpb) {
    const bf16_t* Kb = (const bf16_t*)(F.ws + PO_K); const bf16_t* VT = (const bf16_t*)(F.ws + PO_VT); bf16_t* QO = (bf16_t*)(F.ws + PO_Q);
    LAS float* rpbs = (LAS float*)F.lds;
    const int lane = F.lane, w = F.wave, fr = lane & 15, fq = lane >> 4;
    bool c0[4], c2[4]; int xe[4];
#pragma unroll
    for (int e = 0; e < 4; ++e) { xe[e] = 4 * fq + e - fr; c0[e] = xe[e] >= 8; c2[e] = xe[e] < -8; }
    const bool fA = fr < 8, fC = fr > 8;
    LAS bf16_t* Ks = (LAS bf16_t*)(F.lds + 32768); LAS bf16_t* Vs = Ks + 2 * 64 * 72;
    const int lrow = F.tid >> 3, lchk = F.tid & 7;
    const int nblk = F.xok ? 6 : 1536;
    for (int it = F.xok ? 0 : F.c; it < nblk; it += F.xok ? 1 : F.G) {
        int gb, h, rb, rows;
        if (F.xok) { const int u = (F.c >> 3) + 32 * it, t = 12 * (F.c & 7) + (u >> 4); h = u & 15;
            if (t < 64) { gb = t >> 4; rb = t & 15; rows = 128; } else { gb = 4 + ((t - 64) >> 3); rb = (t - 64) & 7; rows = 64; } }
        else { const int blk = it; if (blk < 1024) { gb = blk >> 8; h = (blk >> 4) & 15; rb = blk & 15; rows = 128; } else { const int V = blk - 1024; gb = 4 + (V >> 7); h = (V >> 3) & 15; rb = V & 7; rows = 64; } }
        const int r = rb * 8 + w;
        int rs = r - 4; rs = rs < 0 ? 0 : (rs > rows - 8 ? rows - 8 : rs);
        int kr_lo = rb * 8 - 4; kr_lo = kr_lo < 0 ? 0 : (kr_lo > rows - 8 ? rows - 8 : kr_lo);
        int kr_hi = rb * 8 + 7 - 4; kr_hi = (kr_hi < 0 ? 0 : (kr_hi > rows - 8 ? rows - 8 : kr_hi)) + 8;
        const size_t tb = (size_t)gb_tok0(gb), tq0 = tb + (size_t)r * 64;
        bf16x8 Qf[4][2];
        float mrun[4], lrun[4]; f32x4 Ot[4][4];
#pragma unroll
        for (int qt = 0; qt < 4; ++qt) { mrun[qt] = -INFINITY; lrun[qt] = 0.f;
#pragma unroll
            for (int dt = 0; dt < 4; ++dt) Ot[dt][qt] = (f32x4){0.f, 0.f, 0.f, 0.f}; }
        const bf16_t* kg = Kb + (tb + (size_t)kr_lo * 64 + lrow) * D + h * 64 + lchk * 8; const bf16_t* vg = VT + (size_t)(h * 64 + lrow) * NT + tb + (size_t)kr_lo * 64 + lchk * 8;
        const int nrows = kr_hi - kr_lo;
#define NA_LOAD(dst, ptr) asm volatile("global_load_dwordx4 %0, %1, off" : "=&v"(dst) : "v"(ptr) : "memory")
        u32x4 kA, vA, kB, vB;
        { const u32x4 k0r = *(const u32x4*)kg, v0r = *(const u32x4*)vg;
#pragma unroll
          for (int t = 0; t < 4; ++t)
#pragma unroll
              for (int ks = 0; ks < 2; ++ks) Qf[t][ks] = *(const bf16x8*)(QO + (tq0 + 16 * t + fr) * D + h * 64 + 32 * ks + 8 * fq);
          { const bf16_t* kp = kg + (size_t)64 * D; const bf16_t* vp = vg + 64; NA_LOAD(kB, kp); NA_LOAD(vB, vp); }
          __syncthreads();
          *(LAS u32x4*)(Ks + lrow * 72 + lchk * 8) = k0r; *(LAS u32x4*)(Vs + lrow * 72 + lchk * 8) = v0r; }
#pragma unroll
        for (int t = 0; t < 4; ++t)
#pragma unroll
            for (int ks = 0; ks < 2; ++ks) asm volatile("" :: "v"(Qf[t][ks]));
        asm volatile("s_waitcnt vmcnt(0)" ::: "memory");
        __syncthreads();
#pragma nounroll
        for (int i2 = 0; i2 < nrows; i2 += 2) {
#pragma unroll
          for (int jj = 0; jj < 2; ++jj) {
            const int i = i2 + jj; if (i >= nrows) break;
            const int kr = kr_lo + i; const int buf = jj; const bool more = i + 1 < nrows, more2 = i + 2 < nrows;
            if (more2) { const bf16_t* kp = kg + (size_t)(i + 2) * 64 * D; const bf16_t* vp = vg + (size_t)(i + 2) * 64;
                if (jj == 1) { NA_LOAD(kB, kp); NA_LOAD(vB, vp); } else { NA_LOAD(kA, kp); NA_LOAD(vA, vp); } }
            if (kr >= rs && kr < rs + 8) {
            const int dr = kr - r + 7;
            const LAS bf16_t* Kt = Ks + buf * (64 * 72); const LAS bf16_t* Vt = Vs + buf * (64 * 72);
            bf16x8 Kf[4][2];
#pragma unroll
            for (int t = 0; t < 4; ++t)
#pragma unroll
                for (int ks = 0; ks < 2; ++ks) Kf[t][ks] = *(const LAS bf16x8*)(Kt + (16 * t + fr) * 72 + 32 * ks + 8 * fq);
            float bsel[3][4];
#pragma unroll
            for (int e = 0; e < 4; ++e) { const int dcB = xe[e] + 15 + (c0[e] ? -16 : (c2[e] ? 16 : 0)), dcA = fA ? xe[e] + 15 : dcB, dcC = fC ? xe[e] + 15 : dcB;
                bsel[0][e] = rpbs[(h * 15 + dr) * 31 + dcA]; bsel[1][e] = rpbs[(h * 15 + dr) * 31 + dcB]; bsel[2][e] = rpbs[(h * 15 + dr) * 31 + dcC]; }
            bf16x8 Pf[4][2]; float alpha[4]; bool moved = false;
#pragma unroll
            for (int qt = 0; qt < 4; ++qt) {
                f32x4 St[3];
#pragma unroll
                for (int dk = 0; dk < 3; ++dk) { const int kt = qt + dk - 1; St[dk] = (f32x4){0.f, 0.f, 0.f, 0.f};
                    if (kt >= 0 && kt < 4) { St[dk] = __builtin_amdgcn_mfma_f32_16x16x32_bf16(Kf[kt][0], Qf[qt][0], St[dk], 0, 0, 0); St[dk] = __builtin_amdgcn_mfma_f32_16x16x32_bf16(Kf[kt][1], Qf[qt][1], St[dk], 0, 0, 0); } }
                constexpr int dummy = 0; (void)dummy;
                const int cls = qt == 0 ? 0 : (qt == 3 ? 2 : 1);
                float sv[4]; bool u0[4], u2[4]; float mx = -INFINITY;
#pragma unroll
                for (int e = 0; e < 4; ++e) { u0[e] = c0[e] && !(cls == 0 && fA) && !(cls == 2 && fC) && (qt > 0); u2[e] = c2[e] && !(cls == 0 && fA) && !(cls == 2 && fC) && (qt < 3);
                    sv[e] = (u0[e] ? St[0][e] : (u2[e] ? St[2][e] : St[1][e])) + bsel[cls][e]; mx = fmaxf(mx, sv[e]); }
                mx = x32_max(x16_max(mx));
                const float mnew = fmaxf(mrun[qt], mx); alpha[qt] = __builtin_amdgcn_exp2f(mrun[qt] - mnew); moved = moved || (mnew != mrun[qt]); mrun[qt] = mnew;
                float l = 0.f, p[4];
#pragma unroll
                for (int e = 0; e < 4; ++e) { p[e] = __builtin_amdgcn_exp2f(sv[e] - mnew); l += p[e]; }
                l = x32_sum(x16_sum(l)); lrun[qt] = lrun[qt] * alpha[qt] + l;
                float pv[4][4];
#pragma unroll
                for (int kt = 0; kt < 4; ++kt)
#pragma unroll
                    for (int e = 0; e < 4; ++e) { const int dk = kt - qt + 1; float v = 0.f; if (dk == 0) v = u0[e] ? p[e] : 0.f; else if (dk == 2) v = u2[e] ? p[e] : 0.f; else if (dk == 1) v = (u0[e] || u2[e]) ? 0.f : p[e]; pv[kt][e] = v; }
#pragma unroll
                for (int ks = 0; ks < 2; ++ks) { u32x4 wv; wv.x = cvt_pk_bf16_c(pv[2 * ks][0], pv[2 * ks][1]); wv.y = cvt_pk_bf16_c(pv[2 * ks][2], pv[2 * ks][3]); wv.z = cvt_pk_bf16_c(pv[2 * ks + 1][0], pv[2 * ks + 1][1]); wv.w = cvt_pk_bf16_c(pv[2 * ks + 1][2], pv[2 * ks + 1][3]);
                    Pf[qt][ks] = __builtin_bit_cast(bf16x8, wv); }
            }
            const bool rescale = __ballot(moved) != 0ull;
#pragma unroll
            for (int dt = 0; dt < 4; ++dt) {
                if (rescale) {
#pragma unroll
                    for (int qt = 0; qt < 4; ++qt) Ot[dt][qt] = Ot[dt][qt] * alpha[qt]; }
#pragma unroll
                for (int ks = 0; ks < 2; ++ks) { const u32x2 v0 = *(const LAS u32x2*)(Vt + (16 * dt + fr) * 72 + 32 * ks + 4 * fq), v1 = *(const LAS u32x2*)(Vt + (16 * dt + fr) * 72 + 32 * ks + 16 + 4 * fq);
                    u32x4 vv; vv.x = v0.x; vv.y = v0.y; vv.z = v1.x; vv.w = v1.y; const bf16x8 Vf = __builtin_bit_cast(bf16x8, vv);
#pragma unroll
                    for (int qt = 0; qt < 4; ++qt) { if ((qt == 0 && ks == 1) || (qt == 3 && ks == 0)) continue; Ot[dt][qt] = __builtin_amdgcn_mfma_f32_16x16x32_bf16(Vf, Pf[qt][ks], Ot[dt][qt], 0, 0, 0); } }
            }
            }
            if (more) {
                if (more2) asm volatile("s_waitcnt vmcnt(2)" ::: "memory"); else asm volatile("s_waitcnt vmcnt(0)" ::: "memory");
                LAS bf16_t* kd = Ks + (buf ^ 1) * (64 * 72) + lrow * 72 + lchk * 8; LAS bf16_t* vd = Vs + (buf ^ 1) * (64 * 72) + lrow * 72 + lchk * 8;
                if (jj == 1) { asm volatile("" : "+v"(kA), "+v"(vA)); *(LAS u32x4*)kd = kA; *(LAS u32x4*)vd = vA; } else { asm volatile("" : "+v"(kB), "+v"(vB)); *(LAS u32x4*)kd = kB; *(LAS u32x4*)vd = vB; }
            }
            __syncthreads();
          }
        }
#undef NA_LOAD
#pragma unroll
        for (int qt = 0; qt < 4; ++qt) { const float inv = 1.f / lrun[qt];
#pragma unroll
            for (int dt = 0; dt < 4; ++dt) { const f32x4 o = Ot[dt][qt] * inv; u32x2 wv; wv.x = cvt_pk_bf16_c(o[0], o[1]); wv.y = cvt_pk_bf16_c(o[2], o[3]);
                pst8(QO + (tq0 + 16 * qt + fr) * D + h * 64 + 16 * dt + 4 * fq, wv); } }
    }
    __syncthreads();
}
constexpr int N_PHASES = 31;
constexpr int FLAG_NO_XIMPORT = 1, FLAG_NO_EXPERTS0 = 2;
constexpr int CV_P1 = 3072, CV_P2 = CV_P1 + 1536, CV_SEL = CV_P2 + 5376, CV_SEL1 = 5376, CV_P0B = CV_SEL + 3584;
__global__ void __launch_bounds__(512, 2) fwd(Args args) {
    extern __shared__ __attribute__((aligned(16))) unsigned char lds_raw[];
    Frame F; F.lds = (LAS unsigned char*)lds_raw; F.ws = args.ws; F.in = args.in; F.out = args.out;
    F.tid = threadIdx.x; F.lane = F.tid & 63; F.wave = __builtin_amdgcn_readfirstlane(F.tid >> 6); F.G = gridDim.x; F.c = blockIdx.x; F.xok = false;
    unsigned char* ws = args.ws;
    const int wave_s = __builtin_amdgcn_readfirstlane(threadIdx.x >> 6);
    for (int u = F.tid; u < (LDS_BYTES - RING_BYTES) / 4; u += 512) ((LAS unsigned*)(F.lds + RING_BYTES))[u] = 0u;
    __syncthreads();
    const int lo = args.ph_lo, hi = args.ph_hi;
    volatile LAS unsigned* MISC = (volatile LAS unsigned*)(F.lds + MISC_OFF);
    XcdBarrier bar; bar.bar = (unsigned*)(ws + WS_CTL) + CW_BAR + args.pad * XCD_BAR_WORDS_EXT; bar.x = 0; bar.st = nullptr;
    const bool multi = (hi - lo) > 1;
    if (multi) bar = xcd_barrier_post((unsigned*)(ws + WS_CTL) + CW_BAR + args.pad * XCD_BAR_WORDS_EXT, MISC + 8);
#define IN(k) (lo <= (k) && (k) < hi)
#ifdef STAMP_PA
    unsigned long long* TS = (unsigned long long*)(ws + WS_CTL + 40 * 1024);
#define STAMP(k) do { if (blockIdx.x == 0 && threadIdx.x == 0) TS[k] = __builtin_amdgcn_s_memrealtime(); } while (0)
#else
#define STAMP(k) do { } while (0)
#endif
#ifdef AMP_PHASE
    unsigned long long t_phase0 = 0ull;
#define AMP_NOW(t) asm volatile("s_memrealtime %0\n\ts_waitcnt lgkmcnt(0)" : "=s"(t) :: "memory")
#define AMP_T0() do { AMP_NOW(t_phase0); } while (0)
#define AMP_WAIT(k) do { if ((k) == AMP_PHASE || AMP_PHASE < 0) { asm volatile("s_waitcnt vmcnt(0) lgkmcnt(0)" ::: "memory"); unsigned long long _t1; AMP_NOW(_t1); const unsigned long long _tw = _t1 + (unsigned long long)AMP_M * (_t1 - t_phase0); unsigned long long _tn; do { __builtin_amdgcn_s_sleep(4); AMP_NOW(_tn); } while (_tn < _tw); } } while (0)
#else
#define AMP_T0() do { } while (0)
#define AMP_WAIT(k) do { } while (0)
#endif
#define SEAM(k) do { AMP_WAIT(k); if (IN(k) && IN((k) + 1)) { xcd_barrier(bar, wave_s); STAMP((k) + 1); } } while (0)
    STAMP(0);
    LAS unsigned char* ring = F.lds;
#define PHASE_BEGIN() do { int _t; asm volatile("v_mbcnt_lo_u32_b32 %0, -1, 0\n\tv_mbcnt_hi_u32_b32 %0, -1, %0" : "=v"(_t)); _t |= (wave_s << 6); F.tid = _t; F.lane = _t & 63; F.wave = wave_s; AMP_T0(); } while (0)

#ifndef P0_SKIP
#define P0_SKIP 0
#endif
    if (IN(0)) { PHASE_BEGIN(); const int p0s = (args.pad == 1) ? P0_SKIP : 0;
        if (!(p0s & 1)) for (int it = F.c; it < 128; it += F.G) s5_build_item(F, it >> 1, it & 1);
        if (!(p0s & 2)) convert_small_weights(F);
        if (!(p0s & 4)) if (!(args.flags & FLAG_NO_EXPERTS0)) { convert_expert_weights(F, 0, CV_SEL, CV_P0B, 128);
            convert_expert_weights(F, 0, CV_P0B, 16 * 1536, 0); }
        if (!(p0s & 8)) { convert_plain(F, args.in[I_MWQ], (bf16_t*)(ws + WS_MWQ), (size_t)2 * 1024 * 1024);
        convert_plain(F, args.in[I_MEMP], (bf16_t*)(ws + WS_MEMB), (size_t)4 * 256 * 1024);
        convert_plain(F, args.in[I_MEMS], (bf16_t*)(ws + WS_MEMB) + (size_t)4 * 256 * 1024, (size_t)4 * 256 * 1024); }
        if (!(p0s & 16)) import_x(F, !(args.flags & FLAG_NO_XIMPORT));
    }
    SEAM(0);
    unsigned nloc_s = 32u;
    if (multi && IN(0) && IN(1)) {
        if (F.tid == 0) { unsigned ok = (F.G == 256) ? 1u : 0u; unsigned* bw = bar.bar;
            for (unsigned j = 0; j < 16; ++j) { const unsigned cnt = xb_ld(&bw[XB_XCNT(j)]); if (j < 8 ? cnt != 32u : cnt != 0u) ok = 0u; }
            MISC[13] = ok; }
        __syncthreads();
        if (MISC[13]) { F.xok = true; F.c = (int)(MISC[12] * 8u + bar.x); }
    }
#define LSEAM(k) do { AMP_WAIT(k); if (IN(k) && IN((k) + 1)) { if (F.xok) xcd_local_barrier(bar, wave_s, nloc_s); else xcd_barrier(bar, wave_s); STAMP((k) + 1); } } while (0)
    {
        const float* lng = args.in[I_LNG]; const float* lnb = args.in[I_LNB];
        if (IN(1)) { PHASE_BEGIN();
            { SchedKV S{ws, F.G, F.c}; EpiBf<false> E{2048u, 1.f}; gemm_phase<EpiBf<false>, SchedKV, false>(ring, F.tid, 1024, 2048u, 2048u, S, E); }
            { SchedUA S{(const char*)ws + WS_XB, (const char*)ws + WS_WIN, (char*)ws + PO_UA, F.G, F.c}; EpiUA E; gemm_phase<EpiUA, SchedUA, false>(ring, F.tid, 1024, 2048u, 2048u, S, E); }
            if (!(args.flags & FLAG_NO_EXPERTS0)) convert_expert_weights(F, 0, 0, CV_P1, 128);
        }
        SEAM(1);
        if (IN(2)) { PHASE_BEGIN();
            { SchedSA S{ws, F.G, F.c}; EpiS E; gemm_phase<EpiS, SchedSA, false>(ring, F.tid, 512, (unsigned)(UAK * 2), 1024u, S, E); }
            { SchedWqk S{ws, F.G, F.c}; EpiBf8 E{1024u, 0.0625f * 1.4426950408889634f * FP8_SWQK}; gemm_phase<EpiBf8, SchedWqk, false>(ring, F.tid, 256, 4096u, 2048u, S, E); }
            { SchedWvo S{ws, F.G, F.c}; EpiBf<false> E{1024u, 1.f}; gemm_phase<EpiBf<false>, SchedWvo, false>(ring, F.tid, 256, 2048u, 4096u, S, E); }
            if (!(args.flags & FLAG_NO_EXPERTS0)) convert_expert_weights(F, 0, CV_P1, CV_P2, 128);
        }
        SEAM(2);
        if (IN(3)) { PHASE_BEGIN(); s5_recurrence(F); }
        SEAM(3);
        if (IN(4)) { PHASE_BEGIN(); SchedSC S{ws, F.G, F.c}; EpiGelu E; gemm_phase<EpiGelu, SchedSC, false>(ring, F.tid, UAK, (unsigned)(UAK * 2), (unsigned)(UAK * 2), S, E); }
        SEAM(4);
        if (IN(5)) { PHASE_BEGIN(); SchedGated S{(const char*)ws + PO_SG, (const char*)ws + WS_WGLU, (char*)ws + PO_HB_S5, 2048, 2048, 1024, NT / BM, 8, F.G, F.c}; EpiGated<0> E{1024u};
            gemm_phase<EpiGated<0>, SchedGated, false>(ring, F.tid, 1024, 2048u, 2048u, S, E); }
        LSEAM(5);
        if (IN(6)) { PHASE_BEGIN(); if (args.flags & FLAG_NO_XIMPORT) ln_phase<0, false, false, false>(F, (const bf16_t*)(ws + PO_HB_S5), lng, lnb, nullptr); else ln_phase<0, false, false, true>(F, (const bf16_t*)(ws + PO_HB_S5), lng, lnb, nullptr); }
        LSEAM(6);
    }
#define COMMON_BLOCK(layer, pb) do { \
        const float* lng = args.in[I_LNG] + (size_t)(layer) * 3 * D; const float* lnb = args.in[I_LNB] + (size_t)(layer) * 3 * D; \
        if (IN((pb) + 0)) { PHASE_BEGIN(); SchedScores8 S{(const char*)ws + WS_XB8, (const char*)ws + WS_WQK + (size_t)(layer) * 8 * MiB, (char*)ws + PO_SB, F.G, F.c}; EpiSoftmax E{(LAS float*)(F.lds + RING_BYTES + 4096), 1024u, 1.f / (FP8_SX * FP8_SWQK)}; \
            gemm_phase<EpiSoftmax, SchedScores8, false, true>(ring, F.tid, 512, 1024u, 1024u, S, E); } \
        AMP_WAIT((pb) + 0); if (IN((pb) + 0) && IN((pb) + 2)) { if (F.xok) xcd_local_barrier(bar, wave_s, nloc_s); else xcd_barrier(bar, wave_s); STAMP((pb) + 1); }     \
        if (IN((pb) + 2)) { PHASE_BEGIN(); SchedBatchW S{(const char*)ws + PO_SB, (const char*)ws + WS_WVO + (size_t)(layer) * 16 * MiB, (char*)ws + PO_HB_MEM, F.G, F.c}; EpiBf<false> E{1024u, 1.f}; \
            gemm_phase<EpiBf<false>, SchedBatchW, false>(ring, F.tid, 1024, 2048u, 2048u, S, E); } \
        if (IN((pb) + 3)) { PHASE_BEGIN(); ln_router_fill(F, lng + D, lnb + D, args.in[I_EWR] + (size_t)(layer) * D * 16); }     \
        LSEAM((pb) + 2); \
        if (IN((pb) + 3)) { PHASE_BEGIN(); ln_phase<0, true, false>(F, (const bf16_t*)(ws + PO_HB_MEM), lng + D, lnb + D, args.in[I_EWR] + (size_t)(layer) * D * 16); } \
        SEAM((pb) + 3); \
        if (IN((pb) + 4)) { PHASE_BEGIN(); select_phase(F); if ((layer) == 0) { if (!(args.flags & FLAG_NO_EXPERTS0)) convert_expert_weights(F, 0, CV_P2, CV_SEL, 32); } else convert_expert_weights(F, 1, 0, CV_SEL1, 32); } \
        SEAM((pb) + 4); \
        if (IN((pb) + 5)) { PHASE_BEGIN(); SchedUp S{ws, F.G, F.c}; EpiGated8 E{2048u}; gemm_phase<EpiGated8, SchedUp, true, true>(ring, F.tid, 512, 1024u, 1024u, S, E); } \
        LSEAM((pb) + 5);     \
        if (IN((pb) + 6)) { PHASE_BEGIN(); SchedDown S{ws, F.G, F.c}; EpiBf<true> E{1024u, 1.f / (FP8_SH * FP8_SW2)}; gemm_phase<EpiBf<true>, SchedDown, false, true>(ring, F.tid, 1024, 2048u, 2048u, S, E); } \
        AMP_WAIT((pb) + 6); if (IN((pb) + 6) && IN((pb) + 9)) { xcd_barrier(bar, wave_s); STAMP((pb) + 9); }     \
    } while (0)
    COMMON_BLOCK(0, 7);
    if (IN(16)) { PHASE_BEGIN(); ln_phase<1, false, false>(F, nullptr, args.in[I_LNG] + 2 * D, args.in[I_LNB] + 2 * D, nullptr); convert_expert_weights(F, 1, CV_SEL1, 16 * 1536, 0); }
    SEAM(16);
    {
        const float* lng = args.in[I_LNG] + 3 * D; const float* lnb = args.in[I_LNB] + 3 * D;
        if (IN(17)) { PHASE_BEGIN(); SchedQKV S{ws, F.G, F.c}; EpiQKV E; gemm_phase<EpiQKV, SchedQKV, false, true>(ring, F.tid, 512, 1024u, 1024u, S, E); }
        if (IN(18)) { PHASE_BEGIN(); natten_fill(F, args.in[I_BRPB]); }
        SEAM(17);
        if (IN(18)) { PHASE_BEGIN(); natten_phase(F, args.in[I_BRPB]); }
        LSEAM(18);
        if (IN(19)) { PHASE_BEGIN(); SchedPlain S{(const char*)ws + PO_Q, (const char*)ws + WS_WO, (char*)ws + PO_HB_NA, 2048, 2048, 1024, NT / BM, 4, F.G, F.c}; EpiBf<false> E{1024u, 1.f};
            gemm_phase<EpiBf<false>, SchedPlain, false>(ring, F.tid, 1024, 2048u, 2048u, S, E); }
        LSEAM(19);
        if (IN(20)) { PHASE_BEGIN(); ln_phase<0, false, false>(F, (const bf16_t*)(ws + PO_HB_NA), lng, lnb, nullptr); }
        LSEAM(20);
    }
    COMMON_BLOCK(1, 21);
    if (IN(30)) { PHASE_BEGIN(); ln_phase<1, false, true>(F, nullptr, args.in[I_LNG] + 5 * D, args.in[I_LNB] + 5 * D, nullptr); }
    AMP_WAIT(30);
#undef COMMON_BLOCK
#ifdef STAMP_PA
    xcd_barrier(bar, wave_s); STAMP(31); xcd_barrier(bar, wave_s);
    {
        const volatile unsigned long long* T = TS; const float dA = (float)(T[STAMP_PA + STAMP_NA] - T[STAMP_PA]) * 0.01f, dB = (float)(T[STAMP_PB + STAMP_NB] - T[STAMP_PB]) * 0.01f;
        const float c = sqrtf(100.f * dA), V = 100.f * dB; const size_t np = (size_t)NTP * 1024, n = (size_t)NT * 1024;
        for (size_t i = (size_t)blockIdx.x * 512 + threadIdx.x; i < n; i += (size_t)gridDim.x * 512) args.out[i] = i < np ? c : (i == np ? V : 0.f);
    }
#endif
#undef IN
#undef SEAM
}
}
#ifndef DBG
#define DBG 0
#endif
#ifndef FZ_PER_PHASE
#define FZ_PER_PHASE 0
#endif

#if DBG
namespace dbg {
__global__ void k_cmp_bf16_f32(const unsigned short* a, const float* b, size_t n, double* acc) {
    double s0 = 0, s1 = 0;
    for (size_t i = (size_t)blockIdx.x * blockDim.x + threadIdx.x; i < n; i += (size_t)gridDim.x * blockDim.x) { const double x = (double)__uint_as_float(((unsigned)a[i]) << 16), y = b[i]; s0 += (x - y) * (x - y); s1 += y * y; }
    for (int o = 32; o >= 1; o >>= 1) { s0 += __shfl_xor(s0, o); s1 += __shfl_xor(s1, o); }
    if ((threadIdx.x & 63) == 0) { atomicAdd(acc, s0); atomicAdd(acc + 1, s1); }
}
__global__ void k_cmp_f32_f32(const float* a, const float* b, size_t n, double* acc) {
    double s0 = 0, s1 = 0;
    for (size_t i = (size_t)blockIdx.x * blockDim.x + threadIdx.x; i < n; i += (size_t)gridDim.x * blockDim.x) { const double x = a[i], y = b[i]; s0 += (x - y) * (x - y); s1 += y * y; }
    for (int o = 32; o >= 1; o >>= 1) { s0 += __shfl_xor(s0, o); s1 += __shfl_xor(s1, o); }
    if ((threadIdx.x & 63) == 0) { atomicAdd(acc, s0); atomicAdd(acc + 1, s1); }
}
__global__ void k_cmp_ua(const unsigned short* UA, const float* u, double* acc) {
    double s0 = 0, s1 = 0;
    for (size_t i = (size_t)blockIdx.x * blockDim.x + threadIdx.x; i < (size_t)fz::NT * 1024; i += (size_t)gridDim.x * blockDim.x) {
        const int tok = (int)(i >> 10), ch = (int)(i & 1023), chunk = tok >> 5, j = tok & 31, g = ch >> 4, h = ch & 15;
        const double x = (double)__uint_as_float(((unsigned)UA[((size_t)g * fz::NCHUNK + chunk) * fz::UAK + j * 16 + h]) << 16), y = u[i]; s0 += (x - y) * (x - y); s1 += y * y; }
    for (int o = 32; o >= 1; o >>= 1) { s0 += __shfl_xor(s0, o); s1 += __shfl_xor(s1, o); }
    if ((threadIdx.x & 63) == 0) { atomicAdd(acc, s0); atomicAdd(acc + 1, s1); }
}
__global__ void k_encode(float* out, const double* accA, const double* accB) {
    const double vA = accA[1] > 0 ? sqrt(accA[0] / accA[1]) : 9.99; const double vB = accB[1] > 0 ? sqrt(accB[0] / accB[1]) : 9.99;
    const float c = (float)sqrt(1e8 * (vA == vA ? vA : 7.77)); const float V = (float)(1e5 * (vB == vB ? vB : 7.77));
    const size_t np = (size_t)fz::NTP * 1024, n = (size_t)fz::NT * 1024;
    for (size_t i = (size_t)blockIdx.x * blockDim.x + threadIdx.x; i < n; i += (size_t)gridDim.x * blockDim.x) out[i] = i < np ? c : (i == np ? V : 0.f);
}
}
#endif

extern "C" void kernel_launch(void* const* d_in, const int* in_sizes, int n_in, void* d_out, int out_size, void* d_ws, size_t ws_size, hipStream_t stream) {
    using namespace fz;
    static int grid = 0;
    if (grid == 0) {
        if (n_in != 26 || ws_size < WS_END) { fprintf(stderr, "kernel_launch: unexpected inputs (n_in %d, ws %zu)\n", n_in, ws_size); grid = -1; return; }
        int dev = 0, cus = 0, per_cu = 0;
        if (hipGetDevice(&dev) != hipSuccess || hipDeviceGetAttribute(&cus, hipDeviceAttributeMultiprocessorCount, dev) != hipSuccess) { grid = -1; return; }
        if (hipFuncSetAttribute((const void*)fwd, hipFuncAttributeMaxDynamicSharedMemorySize, LDS_BYTES) != hipSuccess) { fprintf(stderr, "kernel_launch: hipFuncSetAttribute failed\n"); grid = -1; return; }
        if (hipOccupancyMaxActiveBlocksPerMultiprocessor(&per_cu, (const void*)fwd, 512, LDS_BYTES) != hipSuccess || per_cu < 1) { fprintf(stderr, "kernel_launch: occupancy query says %d\n", per_cu); }
        (void)hipGetLastError();
        grid = cus;
    }
    if (grid < 0) return;
    unsigned char* ws = (unsigned char*)d_ws;
    (void)hipMemsetAsync(ws + WS_CTL, 0, CTL_ZERO_BYTES, stream);
    Args a{};
    for (int i = 0; i < 26; ++i) a.in[i] = (const float*)d_in[i];
    a.out = (float*)d_out; a.ws = ws; a.flags = 0; a.pad = 0;
    auto run = [&](int lo, int hi) { a.ph_lo = lo; a.ph_hi = hi; hipLaunchKernelGGL(fwd, dim3(grid), dim3(512), LDS_BYTES, stream, a); };
#if DBG == 0
#ifdef PRE_LO
    a.pad = 1; run(PRE_LO, PRE_HI); a.pad = 0;
#endif
#if FZ_PER_PHASE
    for (int p = 0; p < N_PHASES; ++p) run(p, p + 1);
#else
    run(0, N_PHASES);
#endif
#else
    using nv::SG;
    const float* const* in = (const float* const*)d_in;
    const size_t BIG = (size_t)NT * D;
    double* ACC = (double*)(ws + 32 * 1024);
    float* nmisc = (float*)(ws + 987 * MiB);
    float* nKV = nmisc; float* nAFF = nmisc + 4u * 1024 * 1024; float* nGATE = nAFF + 1024 * 1024; int* nIDX = (int*)(nGATE + 128 * 1024); float* nMEMC = (float*)(ws + 385 * MiB);
    auto sgemm = [&](const float* A, const float* B, float* C, const int* gidx, int M, int N, int K, long sam, long sak, long sbk, long sbn, long ldc,
                     int nz = 1, int zdiv = 1, long zA0 = 0, long zA1 = 0, long zB0 = 0, long zB1 = 0, long zC0 = 0, long zC1 = 0) {
        SG s{A, B, C, gidx, M, N, K, zdiv, sam, sak, sbk, sbn, ldc, zA0, zA1, zB0, zB1, zC0, zC1};
        hipLaunchKernelGGL(nv::k_sgemm, dim3(N / 128, M / 128, nz), dim3(256), 0, stream, s);
    };
    const int EW = (int)((BIG + 255) / 256);
    auto n_import = [&](float* X) { hipMemcpyAsync(X, in[I_XP], (size_t)NTP * D * 4, hipMemcpyDeviceToDevice, stream); hipMemcpyAsync(X + (size_t)NTP * D, in[I_XS], (size_t)NTS * D * 4, hipMemcpyDeviceToDevice, stream);
        hipMemcpyAsync(nMEMC, in[I_MEMP], (size_t)4 * 256 * D * 4, hipMemcpyDeviceToDevice, stream); hipMemcpyAsync(nMEMC + (size_t)4 * 256 * D, in[I_MEMS], (size_t)4 * 256 * D * 4, hipMemcpyDeviceToDevice, stream); };
    auto n_s5 = [&](float* X, float* T1, float* T2, float* T3) {
        sgemm(X, in[I_AWIN], T1, nullptr, NT, D, D, D, 1, D, 1, D);
        hipLaunchKernelGGL(nv::k_s5_scan, dim3(8 * 64 * 2), dim3(64), 0, stream, T1, T2, in[I_ALRE], in[I_ALIM], in[I_ALDT], in[I_ABRE], in[I_ABIM], in[I_ACRE], in[I_ACIM]);
        hipLaunchKernelGGL(nv::k_s5_gelu, dim3(EW), dim3(256), 0, stream, T1, T2, in[I_AD], T2);
        sgemm(T2, in[I_AWGLU], T1, nullptr, NT, D, D, D, 1, 2 * D, 1, D);
        sgemm(T2, in[I_AWGLU] + D, T3, nullptr, NT, D, D, D, 1, 2 * D, 1, D);
        hipLaunchKernelGGL(nv::k_glu, dim3(EW), dim3(256), 0, stream, T1, T3, T1);
    };
    auto n_na = [&](float* X, float* T1, float* T2, float* T3) {
        sgemm(X, in[I_BWQKV], T1, nullptr, NT, D, D, D, 1, 3 * D, 1, D); sgemm(X, in[I_BWQKV] + D, T2, nullptr, NT, D, D, D, 1, 3 * D, 1, D); sgemm(X, in[I_BWQKV] + 2 * D, T3, nullptr, NT, D, D, D, 1, 3 * D, 1, D);
        hipLaunchKernelGGL(nv::k_natten, dim3(NT * 16 / 4), dim3(256), 0, stream, T1, T2, T3, in[I_BRPB]);
        sgemm(T1, in[I_BWO], T2, nullptr, NT, D, D, D, 1, D, 1, D);
    };
    auto n_ln = [&](float* X, const float* h, int layer, int sub, float* xo) { hipLaunchKernelGGL(nv::k_res_ln, dim3(NT / 4), dim3(256), 0, stream, X, h, in[I_LNG] + (layer * 3 + sub) * D, in[I_LNB] + (layer * 3 + sub) * D, xo, NT); };
    auto n_mem = [&](float* X, float* T1, float* T2, float* T3, int layer) {
        const float* wq = in[I_MWQ] + (size_t)layer * D * D; const float* wkv = in[I_MWKV] + (size_t)layer * D * 2 * D; const float* wo = in[I_MWO] + (size_t)layer * D * D;
        sgemm(nMEMC, wkv, nKV, nullptr, 8 * 256, 2 * D, D, D, 1, 2 * D, 1, 2 * D);
        sgemm(X, wq, T1, nullptr, NT, D, D, D, 1, D, 1, D);
        for (int grp = 0; grp < 2; ++grp) { const int L = grp ? 4096 : 8192; const size_t tb = grp ? (size_t)NTP : 0; const int gb0 = grp * 4;
            sgemm(T1 + tb * D, nKV + (size_t)gb0 * 256 * 2 * D, T2 + tb * D, nullptr, L, 256, 256, D, 1, 1, 2 * D, D, 16, 4, (long)L * D, 256, (long)256 * 2 * D, 256, (long)L * D, 256); }
        hipLaunchKernelGGL(nv::k_softmax256, dim3(NT * 4 / 4), dim3(256), 0, stream, T2, 0.0625f, NT * 4);
        for (int grp = 0; grp < 2; ++grp) { const int L = grp ? 4096 : 8192; const size_t tb = grp ? (size_t)NTP : 0; const int gb0 = grp * 4;
            sgemm(T2 + tb * D, nKV + (size_t)gb0 * 256 * 2 * D + D, T3 + tb * D, nullptr, L, 256, 256, D, 1, 2 * D, 1, D, 16, 4, (long)L * D, 256, (long)256 * 2 * D, 256, (long)L * D, 256); }
        sgemm(T3, wo, T1, nullptr, NT, D, D, D, 1, D, 1, D);
    };
    auto n_moe = [&](float* X, float* T1, float* T2, float* T3, int layer) {
        hipLaunchKernelGGL(nv::k_router, dim3(NT / 4), dim3(256), 0, stream, X, in[I_EWR] + (size_t)layer * D * 16, nAFF, NT);
        hipLaunchKernelGGL(nv::k_select, dim3(32), dim3(512), 0, stream, nAFF, nIDX, nGATE);
        hipMemsetAsync(T1, 0, BIG * 4, stream);
        for (int grp = 0; grp < 2; ++grp) { const int n = grp ? NTS : NTP, cap = n / 8; const size_t tb = grp ? (size_t)NTP : 0;
            for (int e = 0; e < 16; ++e) { const int* idx = nIDX + (grp ? 16 * 4096 : 0) + e * cap; const float* gate = nGATE + (grp ? 16 * 4096 : 0) + e * cap;
                const float* w1 = in[I_EW1] + ((size_t)layer * 16 + e) * D * 2048; const float* w3 = in[I_EW3] + ((size_t)layer * 16 + e) * D * 2048; const float* w2 = in[I_EW2] + ((size_t)layer * 16 + e) * 2048 * D;
                float* H1 = T2; float* H3 = T2 + (size_t)4096 * 2048; float* YE = T3;
                sgemm(X + tb * D, w1, H1, idx, cap, 2048, D, D, 1, 2048, 1, 2048); sgemm(X + tb * D, w3, H3, idx, cap, 2048, D, D, 1, 2048, 1, 2048);
                hipLaunchKernelGGL(nv::k_silu_mul, dim3((unsigned)(((size_t)cap * 2048 + 255) / 256)), dim3(256), 0, stream, H1, H3, (size_t)cap * 2048);
                sgemm(H1, w2, YE, nullptr, cap, D, 2048, 2048, 1, D, 1, D);
                hipLaunchKernelGGL(nv::k_scatter_add, dim3((unsigned)(((size_t)cap * D + 255) / 256)), dim3(256), 0, stream, YE, idx, gate, T1 + tb * D, cap); } }
    };
    float* X = (float*)(ws + WS_XF); float* T1 = (float*)(ws + WS_EW13); float* T2 = (float*)(ws + WS_POOL); float* T3 = (float*)(ws + WS_POOL + 192 * MiB);
    auto cmp_bf = [&](size_t off_bf16, const float* ref, double* acc) { hipLaunchKernelGGL(dbg::k_cmp_bf16_f32, dim3(2048), dim3(256), 0, stream, (const unsigned short*)(ws + off_bf16), ref, BIG, acc); };
#if DBG == 1
    n_import(X);
    a.flags = FLAG_NO_XIMPORT | FLAG_NO_EXPERTS0;
    n_s5(X, T1, T2, T3);
    for (int p = 0; p <= 5; ++p) run(p, p + 1);
    cmp_bf(PO_HB_S5, T1, ACC);
    cmp_bf(PO_HB_S5, T1, ACC + 2);
#elif DBG == 11
    n_import(X);
    a.flags = FLAG_NO_XIMPORT | FLAG_NO_EXPERTS0;
    sgemm(X, in[I_AWIN], T1, nullptr, NT, D, D, D, 1, D, 1, D);
    for (int p = 0; p <= 4; ++p) run(p, p + 1);
    hipLaunchKernelGGL(dbg::k_cmp_ua, dim3(2048), dim3(256), 0, stream, (const unsigned short*)(ws + PO_UA), T1, ACC);
    hipMemcpyAsync(X, T1, BIG * 4, hipMemcpyDeviceToDevice, stream);
    { float* Y = (float*)(ws + 193 * MiB);
      hipLaunchKernelGGL(nv::k_s5_scan, dim3(8 * 64 * 2), dim3(64), 0, stream, X, Y, in[I_ALRE], in[I_ALIM], in[I_ALDT], in[I_ABRE], in[I_ABIM], in[I_ACRE], in[I_ACIM]);
      hipLaunchKernelGGL(nv::k_s5_gelu, dim3(EW), dim3(256), 0, stream, X, Y, in[I_AD], Y);
      cmp_bf(PO_SG, Y, ACC + 2); }
#elif DBG == 2
    n_import(X); n_s5(X, T1, T2, T3); n_ln(X, T1, 0, 0, X); n_mem(X, T1, T2, T3, 0);
    a.flags = FLAG_NO_XIMPORT | FLAG_NO_EXPERTS0;
    run(0, 1); run(1, 2); run(2, 3); run(7, 8); run(9, 10);
    cmp_bf(PO_HB_MEM, T1, ACC); cmp_bf(PO_HB_MEM, T1, ACC + 2);
#elif DBG == 4
    n_import(X); n_na(X, T1, T2, T3);
    hipMemcpyAsync(T1, T2, BIG * 4, hipMemcpyDeviceToDevice, stream);
    a.flags = FLAG_NO_XIMPORT | FLAG_NO_EXPERTS0;
    run(0, 1); run(17, 18); run(18, 19); run(19, 20);
    cmp_bf(PO_HB_NA, T1, ACC); cmp_bf(PO_HB_NA, T1, ACC + 2);
#endif
    hipLaunchKernelGGL(dbg::k_encode, dim3(2048), dim3(256), 0, stream, (float*)d_out, ACC, ACC + 2);
#endif
}
```

```cpp
#include <hip/hip_runtime.h>
#include <cstdio>
#include <cstdint>
#include <cmath>
#define NO_WT 1
namespace nv {
constexpr int D = 1024, NTP = 32768, NTS = 16384, NT = NTP + NTS, NGB = 8, MEM = 256;
constexpr int GRID_W = 64;
constexpr float ALPHA = 1.41421356237309515f;
constexpr float LN_EPS = 1e-5f;

__host__ __device__ inline int gb_tok0(int gb) { return gb < 4 ? gb * 8192 : NTP + (gb - 4) * 4096; }
__host__ __device__ inline int gb_len(int gb) { return gb < 4 ? 8192 : 4096; }

__device__ __forceinline__ float wave_sum(float v) {
#pragma unroll
    for (int o = 1; o < 64; o <<= 1) v += __shfl_xor(v, o);
    return v;
}
__device__ __forceinline__ float wave_max(float v) {
#pragma unroll
    for (int o = 1; o < 64; o <<= 1) v = fmaxf(v, __shfl_xor(v, o));
    return v;
}

struct SG { const float* A; const float* B; float* C; const int* gidx; int M, N, K, zdiv; long sam, sak, sbk, sbn, ldc; long zA0, zA1, zB0, zB1, zC0, zC1; };
__global__ __launch_bounds__(256) void k_sgemm(SG a) {
    __shared__ float As[8][132];
    __shared__ float Bs[8][132];
    const int z = blockIdx.z, z0 = z / a.zdiv, z1 = z % a.zdiv;
    const float* A = a.A + z0 * a.zA0 + z1 * a.zA1;
    const float* B = a.B + z0 * a.zB0 + z1 * a.zB1;
    float* C = a.C + z0 * a.zC0 + z1 * a.zC1;
    const int bm = blockIdx.y * 128, bn = blockIdx.x * 128, tid = threadIdx.x, tx = tid & 15, ty = tid >> 4;
    float acc[8][8];
#pragma unroll
    for (int i = 0; i < 8; ++i)
#pragma unroll
        for (int j = 0; j < 8; ++j) acc[i][j] = 0.f;
    const int arow_l = tid >> 1, akk = (tid & 1) * 4;
    const long arow = a.gidx ? (long)a.gidx[bm + arow_l] : (long)(bm + arow_l);
    const float* Ap = A + arow * a.sam;
    const int bkk = tid >> 5, bnn = (tid & 31) * 4;
    for (int k0 = 0; k0 < a.K; k0 += 8) {
        float av[4], bv[4];
#pragma unroll
        for (int i = 0; i < 4; ++i) av[i] = Ap[(long)(k0 + akk + i) * a.sak];
#pragma unroll
        for (int i = 0; i < 4; ++i) bv[i] = B[(long)(k0 + bkk) * a.sbk + (long)(bn + bnn + i) * a.sbn];
        __syncthreads();
#pragma unroll
        for (int i = 0; i < 4; ++i) As[akk + i][arow_l] = av[i];
#pragma unroll
        for (int i = 0; i < 4; ++i) Bs[bkk][bnn + i] = bv[i];
        __syncthreads();
#pragma unroll
        for (int kk = 0; kk < 8; ++kk) {
            float x[8], y[8];
#pragma unroll
            for (int i = 0; i < 8; ++i) x[i] = As[kk][ty * 8 + i];
#pragma unroll
            for (int j = 0; j < 8; ++j) y[j] = Bs[kk][tx * 8 + j];
#pragma unroll
            for (int i = 0; i < 8; ++i)
#pragma unroll
                for (int j = 0; j < 8; ++j) acc[i][j] += x[i] * y[j];
        }
    }
#pragma unroll
    for (int i = 0; i < 8; ++i)
#pragma unroll
        for (int j = 0; j < 8; ++j) C[(long)(bm + ty * 8 + i) * a.ldc + bn + tx * 8 + j] = acc[i][j];
}

__global__ __launch_bounds__(64) void k_s5_scan(const float* __restrict__ u, float* __restrict__ ydir, const float* lam_re, const float* lam_im, const float* log_dt,
                                                const float* b_re, const float* b_im, const float* c_re, const float* c_im) {
    const int wid = blockIdx.x;
    const int dir = wid & 1, g = (wid >> 1) & 63, gb = wid >> 7;
    const int p = threadIdx.x;
    const int L = gb_len(gb), t0 = gb_tok0(gb);
    const double dt = exp((double)log_dt[dir * 64 + g]);
    const double lr = lam_re[(dir * 64 + g) * 64 + p], li = lam_im[(dir * 64 + g) * 64 + p];
    const double er = exp(lr * dt), lbr = er * cos(li * dt), lbi = er * sin(li * dt);
    const double nr = lbr - 1.0, ni = lbi, den = lr * lr + li * li;
    const double fr = (nr * lr + ni * li) / den, fi = (ni * lr - nr * li) / den;
    float Br[16], Bi[16], Cr[16], Ci[16];
#pragma unroll
    for (int h = 0; h < 16; ++h) {
        const double br = b_re[((dir * 64 + g) * 64 + p) * 16 + h], bi = b_im[((dir * 64 + g) * 64 + p) * 16 + h];
        Br[h] = (float)(fr * br - fi * bi); Bi[h] = (float)(fr * bi + fi * br);
        Cr[h] = c_re[((dir * 64 + g) * 16 + h) * 64 + p]; Ci[h] = c_im[((dir * 64 + g) * 16 + h) * 64 + p];
    }
    const float ar = (float)lbr, ai = (float)lbi;
    float hr = 0.f, hi = 0.f;
    float* yo = ydir + (size_t)dir * NT * D;
    for (int s = 0; s < L; ++s) {
        const int t = dir ? (L - 1 - s) : s;
        const float* ur = u + (size_t)(t0 + t) * D + g * 16;
        float bur = 0.f, bui = 0.f;
#pragma unroll
        for (int h = 0; h < 16; ++h) { const float uv = ur[h]; bur += uv * Br[h]; bui += uv * Bi[h]; }
        const float nhr = ar * hr - ai * hi + bur, nhi = ar * hi + ai * hr + bui;
        hr = nhr; hi = nhi;
        float mine = 0.f;
#pragma unroll
        for (int c = 0; c < 16; ++c) { const float v = wave_sum(Cr[c] * hr - Ci[c] * hi); if (p == c) mine = v; }
        if (p < 16) yo[(size_t)(t0 + t) * D + g * 16 + p] = mine;
    }
}
__global__ void k_s5_gelu(const float* u, const float* ydir, const float* dskip, float* gout) {
    const size_t i = (size_t)blockIdx.x * blockDim.x + threadIdx.x;
    if (i >= (size_t)NT * D) return;
    const float y = dskip[i & (D - 1)] * u[i] + ydir[i] + ydir[(size_t)NT * D + i];
    const float c = 0.7978845608028654f * (y + 0.044715f * y * y * y);
    gout[i] = 0.5f * y * (1.f + tanhf(c));
}
__global__ void k_glu(const float* z1, const float* z2, float* out) {
    const size_t i = (size_t)blockIdx.x * blockDim.x + threadIdx.x;
    if (i >= (size_t)NT * D) return;
    out[i] = z1[i] / (1.f + expf(-z2[i]));
}
__global__ __launch_bounds__(256) void k_res_ln(const float* x, const float* h, const float* g, const float* b, float* xo, int rows) {
    const int row = blockIdx.x * 4 + (threadIdx.x >> 6), lane = threadIdx.x & 63;
    if (row >= rows) return;
    float v[16]; float s = 0.f;
#pragma unroll
    for (int j = 0; j < 16; ++j) { const size_t i = (size_t)row * D + lane + 64 * j; v[j] = ALPHA * x[i] + h[i]; s += v[j]; }
    const float mean = wave_sum(s) * (1.f / D); float q = 0.f;
#pragma unroll
    for (int j = 0; j < 16; ++j) { v[j] -= mean; q += v[j] * v[j]; }
    const float rstd = 1.f / sqrtf(wave_sum(q) * (1.f / D) + LN_EPS);
#pragma unroll
    for (int j = 0; j < 16; ++j) { const int c = lane + 64 * j; xo[(size_t)row * D + c] = v[j] * rstd * g[c] + b[c]; }
}
__global__ __launch_bounds__(256) void k_softmax256(float* s, float scale, int rows) {
    const int row = blockIdx.x * 4 + (threadIdx.x >> 6), lane = threadIdx.x & 63;
    if (row >= rows) return;
    float v[4]; float m = -INFINITY;
#pragma unroll
    for (int j = 0; j < 4; ++j) { v[j] = s[(size_t)row * 256 + lane + 64 * j] * scale; m = fmaxf(m, v[j]); }
    m = wave_max(m); float l = 0.f;
#pragma unroll
    for (int j = 0; j < 4; ++j) { v[j] = expf(v[j] - m); l += v[j]; }
    l = wave_sum(l);
#pragma unroll
    for (int j = 0; j < 4; ++j) s[(size_t)row * 256 + lane + 64 * j] = v[j] / l;
}
__global__ __launch_bounds__(256) void k_router(const float* x, const float* wr, float* aff, int rows) {
    const int row = blockIdx.x * 4 + (threadIdx.x >> 6), lane = threadIdx.x & 63;
    if (row >= rows) return;
    float acc[16];
#pragma unroll
    for (int e = 0; e < 16; ++e) acc[e] = 0.f;
    for (int j = 0; j < 16; ++j) { const int k = lane + 64 * j; const float xv = x[(size_t)row * D + k];
#pragma unroll
        for (int e = 0; e < 16; ++e) acc[e] += xv * wr[k * 16 + e]; }
    float m = -INFINITY;
#pragma unroll
    for (int e = 0; e < 16; ++e) { acc[e] = wave_sum(acc[e]); m = fmaxf(m, acc[e]); }
    float l = 0.f;
#pragma unroll
    for (int e = 0; e < 16; ++e) { acc[e] = expf(acc[e] - m); l += acc[e]; }
    float mine = 0.f;
#pragma unroll
    for (int e = 0; e < 16; ++e) if (lane == e) mine = acc[e] / l;
    if (lane < 16) aff[(size_t)row * 16 + lane] = mine;
}

__device__ __forceinline__ void select_expert(const float* aff, int n, int e, int cap, int* idx_out, float* gate_out, int* slot_of  , unsigned* hist  , unsigned* wsum  , unsigned* bc  ) {
    const int tid = threadIdx.x, nth = blockDim.x, lane = tid & 63, wv = tid >> 6, nw = nth >> 6;
    unsigned prefix = 0u, mask = 0u; unsigned remaining = (unsigned)cap;
    for (int pass = 0; pass < 4; ++pass) {
        const int shift = 24 - 8 * pass;
        for (int i = tid; i < 256; i += nth) hist[i] = 0u;
        __syncthreads();
        for (int t = tid; t < n; t += nth) { const unsigned key = __float_as_uint(aff[(size_t)t * 16 + e]); if ((key & mask) == prefix) atomicAdd(&hist[(key >> shift) & 255u], 1u); }
        __syncthreads();
        if (tid == 0) { unsigned cum = 0u; int b = 255; for (; b > 0; --b) { if (cum + hist[b] >= remaining) break; cum += hist[b]; } bc[0] = (unsigned)b; bc[1] = remaining - cum; }
        __syncthreads();
        prefix |= bc[0] << shift; mask |= 0xffu << shift; remaining = bc[1];
        __syncthreads();
    }
    const unsigned T = prefix; const unsigned need_eq = remaining;
    unsigned base = 0u, eqbase = 0u;
    for (int s0 = 0; s0 < n; s0 += nth) {
        const int t = s0 + tid; const bool in = t < n;
        const float a = in ? aff[(size_t)t * 16 + e] : 0.f; const unsigned key = __float_as_uint(a);
        const bool gt = in && key > T, eq = in && key == T;
        const unsigned long long meq = __ballot(eq); const unsigned eqr_w = __popcll(meq & ((1ull << lane) - 1ull));
        if (lane == 0) wsum[wv] = __popcll(meq);
        __syncthreads();
        unsigned eqoff = 0u, eqtot = 0u; for (int w = 0; w < nw; ++w) { const unsigned c = wsum[w]; if (w < wv) eqoff += c; eqtot += c; }
        __syncthreads();
        const bool sel = gt || (eq && (eqbase + eqoff + eqr_w) < need_eq);
        const unsigned long long ms = __ballot(sel); const unsigned sr_w = __popcll(ms & ((1ull << lane) - 1ull));
        if (lane == 0) wsum[wv] = __popcll(ms);
        __syncthreads();
        unsigned soff = 0u, stot = 0u; for (int w = 0; w < nw; ++w) { const unsigned c = wsum[w]; if (w < wv) soff += c; stot += c; }
        __syncthreads();
        if (sel) { const unsigned slot = base + soff + sr_w; if (slot < (unsigned)cap) { idx_out[slot] = t; gate_out[slot] = a; } }
        if (slot_of && in) slot_of[(size_t)t * 16 + e] = sel ? (int)(base + soff + sr_w) : -1;
        base += stot; eqbase += eqtot;
    }
}
__global__ __launch_bounds__(512) void k_select(const float* aff_all, int* idx_all, float* gate_all) {
    __shared__ unsigned hist[256]; __shared__ unsigned wsum[32]; __shared__ unsigned bc[4];
    const int grp = blockIdx.x >> 4, e = blockIdx.x & 15;
    const int n = grp ? NTS : NTP, cap = n / 8;
    const float* aff = aff_all + (size_t)(grp ? NTP : 0) * 16;
    int* idx = idx_all + (grp ? 16 * 4096 : 0) + e * cap; float* gate = gate_all + (grp ? 16 * 4096 : 0) + e * cap;
    select_expert(aff, n, e, cap, idx, gate, nullptr, hist, wsum, bc);
}
__global__ void k_silu_mul(float* h1, const float* h3, size_t n) {
    const size_t i = (size_t)blockIdx.x * blockDim.x + threadIdx.x; if (i >= n) return;
    const float a = h1[i]; h1[i] = a / (1.f + expf(-a)) * h3[i];
}
__global__ void k_scatter_add(const float* ye, const int* idx, const float* gate, float* out, int cap) {
    const size_t i = (size_t)blockIdx.x * blockDim.x + threadIdx.x; if (i >= (size_t)cap * D) return;
    const int slot = (int)(i >> 10), c = (int)(i & 1023);
    atomicAdd(&out[(size_t)idx[slot] * D + c], gate[slot] * ye[i]);
}

__global__ __launch_bounds__(256) void k_natten(float* q, const float* k, const float* v, const float* rpb) {
    const int wg = blockIdx.x * 4 + (threadIdx.x >> 6), lane = threadIdx.x & 63;
    const int tok = wg >> 4, h = wg & 15;
    if (tok >= NT) return;
    int gb, l; if (tok < NTP) { gb = tok >> 13; l = tok & 8191; } else { gb = 4 + ((tok - NTP) >> 12); l = (tok - NTP) & 4095; }
    const int rows = gb_len(gb) / GRID_W, t0 = gb_tok0(gb);
    const int r = l >> 6, qc = l & 63;
    int rs = r - 4; rs = rs < 0 ? 0 : (rs > rows - 8 ? rows - 8 : rs);
    int ws = qc - 8; ws = ws < 0 ? 0 : (ws > 48 ? 48 : ws);
    const float qv = q[(size_t)tok * D + h * 64 + lane] * 0.125f;
    float m = -INFINITY, lsum = 0.f, o = 0.f;
    for (int rr = 0; rr < 8; ++rr) {
        const int kr = rs + rr, dr = kr - r + 7;
        for (int cc = 0; cc < 16; ++cc) {
            const int kc = ws + cc; int dc = kc - qc + 15; dc = dc < 0 ? 0 : (dc > 30 ? 30 : dc);
            const size_t kt = (size_t)(t0 + kr * 64 + kc) * D + h * 64 + lane;
            const float s = wave_sum(qv * k[kt]) + rpb[(h * 15 + dr) * 31 + dc];
            const float mn = fmaxf(m, s), al = expf(m - mn), pp = expf(s - mn);
            lsum = lsum * al + pp; o = o * al + pp * v[kt]; m = mn;
        }
    }
    q[(size_t)tok * D + h * 64 + lane] = o / lsum;
}
}
#define LAS __attribute__((address_space(3)))
#define GAS __attribute__((address_space(1)))
namespace fz {
typedef unsigned short bf16_t;
typedef short bf16x8 __attribute__((ext_vector_type(8)));
typedef float f32x4 __attribute__((ext_vector_type(4)));
typedef float f32x2 __attribute__((ext_vector_type(2)));
typedef unsigned u32x4 __attribute__((ext_vector_type(4)));
typedef unsigned u32x2 __attribute__((ext_vector_type(2)));
typedef int v8i __attribute__((ext_vector_type(8)));
typedef int v4i __attribute__((ext_vector_type(4)));

constexpr int D = 1024, NTP = 32768, NTS = 16384, NT = NTP + NTS;
constexpr int TCH = 32, NCHUNK = NT / TCH;
constexpr int UAK = TCH * 16 + 256;
constexpr float ALPHA = 1.41421356237309515f, LN_EPS = 1e-5f;
constexpr size_t MiB = 1u << 20;
constexpr size_t WS_CTL = 0, WS_XF = 1 * MiB, WS_XB = 193 * MiB, WS_WIN = 289 * MiB, WS_WGLU = 291 * MiB, WS_WQKV = 295 * MiB, WS_WO = 301 * MiB, WS_MWQ = 303 * MiB,
                 WS_MWKV = 307 * MiB, WS_MWO = 315 * MiB, WS_MEMB = 319 * MiB, WS_KV = 323 * MiB, WS_WQK = 339 * MiB, WS_WVO = 371 * MiB, WS_AFF = 403 * MiB, WS_SLOT = 406 * MiB,
                 WS_IDX = 409 * MiB, WS_GATE = 409 * MiB + 512 * 1024, WS_EW13 = 411 * MiB  , WS_EW2 = 475 * MiB  ,
                 WS_XB8 = 507 * MiB  , WS_POOL = 603 * MiB, WS_END = 1024 * MiB;
constexpr size_t PO_M2T = WS_POOL, PO_M13T = WS_POOL + 16 * MiB, PO_UA = WS_POOL + 64 * MiB, PO_SG = WS_POOL + 208 * MiB;
constexpr size_t PO_HB_S5 = WS_POOL;
constexpr size_t PO_SB = WS_POOL, PO_HB_MEM = WS_POOL + 304 * MiB;
constexpr size_t PO_Q = WS_POOL, PO_K = WS_POOL + 96 * MiB, PO_VT = WS_POOL + 192 * MiB, PO_HB_NA = WS_POOL + 304 * MiB;
constexpr size_t PO_HM = WS_POOL, PO_YE = WS_POOL + 192 * MiB;
static_assert(PO_YE + 192 * MiB <= WS_END && PO_SG + 96 * MiB <= WS_END && PO_HB_NA + 96 * MiB <= WS_END && PO_HB_MEM + 96 * MiB <= WS_END, "pool");
constexpr int CW_TMO = 0, CW_BAR = 4096;
constexpr size_t CTL_ZERO_BYTES = 64 * 1024;
constexpr int RING_BYTES = 131072, MISC_OFF = RING_BYTES + 320, LDS_BYTES = 147456, ZERO16_OFF = RING_BYTES + 64;

__host__ __device__ inline int gb_tok0(int gb) { return gb < 4 ? gb * 8192 : NTP + (gb - 4) * 4096; }
__host__ __device__ inline int gb_len(int gb) { return gb < 4 ? 8192 : 4096; }
__host__ __device__ inline int panel_gb(int pm) { return pm < 128 ? (pm >> 5) : 4 + ((pm - 128) >> 4); }

__device__ __forceinline__ unsigned cvt_pk_bf16(float lo, float hi) { unsigned r; asm volatile("v_cvt_pk_bf16_f32 %0, %1, %2" : "=v"(r) : "v"(lo), "v"(hi)); return r; }
typedef __bf16 bf16x2_t __attribute__((ext_vector_type(2)));
__device__ __forceinline__ unsigned cvt_pk_bf16_c(float lo, float hi) { const f32x2 v = {lo, hi}; const bf16x2_t b = __builtin_convertvector(v, bf16x2_t); return __builtin_bit_cast(unsigned, b); }
__device__ __forceinline__ float bf2f(unsigned short b) { return __uint_as_float(((unsigned)b) << 16); }
template <int CTRL> __device__ __forceinline__ float dpp_f(float v) { return __uint_as_float((unsigned)__builtin_amdgcn_update_dpp(0, (int)__float_as_uint(v), CTRL, 0xF, 0xF, true)); }
__device__ __forceinline__ float x16_sum(float v) { const auto r = __builtin_amdgcn_permlane16_swap(__float_as_uint(v), __float_as_uint(v), false, false); return __uint_as_float(r[0]) + __uint_as_float(r[1]); }
__device__ __forceinline__ float x32_sum(float v) { const auto r = __builtin_amdgcn_permlane32_swap(__float_as_uint(v), __float_as_uint(v), false, false); return __uint_as_float(r[0]) + __uint_as_float(r[1]); }
__device__ __forceinline__ float x16_max(float v) { const auto r = __builtin_amdgcn_permlane16_swap(__float_as_uint(v), __float_as_uint(v), false, false); return fmaxf(__uint_as_float(r[0]), __uint_as_float(r[1])); }
__device__ __forceinline__ float x32_max(float v) { const auto r = __builtin_amdgcn_permlane32_swap(__float_as_uint(v), __float_as_uint(v), false, false); return fmaxf(__uint_as_float(r[0]), __uint_as_float(r[1])); }
__device__ __forceinline__ float row_sum(float v) { v += dpp_f<0xB1>(v); v += dpp_f<0x4E>(v); v += dpp_f<0x141>(v); v += dpp_f<0x140>(v); return v; }
__device__ __forceinline__ float row_max(float v) { v = fmaxf(v, dpp_f<0xB1>(v)); v = fmaxf(v, dpp_f<0x4E>(v)); v = fmaxf(v, dpp_f<0x141>(v)); v = fmaxf(v, dpp_f<0x140>(v)); return v; }
__device__ __forceinline__ float wave_sum(float v) { return x32_sum(x16_sum(row_sum(v))); }
__device__ __forceinline__ float wave_max(float v) { return x32_max(x16_max(row_max(v))); }
#ifndef NO_WT
__device__ __forceinline__ void st16(void* p, u32x4 v) { asm volatile("global_store_dwordx4 %0, %1, off sc1\n\ts_nop 1" :: "v"(p), "v"(v)); }
__device__ __forceinline__ void st8(void* p, u32x2 v) { asm volatile("global_store_dwordx2 %0, %1, off sc1\n\ts_nop 1" :: "v"(p), "v"(v)); }
__device__ __forceinline__ void st4(void* p, unsigned v) { asm volatile("global_store_dword %0, %1, off sc1\n\ts_nop 1" :: "v"(p), "v"(v)); }
#else
__device__ __forceinline__ void st16(void* p, u32x4 v) { *(u32x4*)p = v; }
__device__ __forceinline__ void st8(void* p, u32x2 v) { *(u32x2*)p = v; }
__device__ __forceinline__ void st4(void* p, unsigned v) { *(unsigned*)p = v; }
#endif
__device__ __forceinline__ void st16f(void* p, f32x4 v) { st16(p, __builtin_bit_cast(u32x4, v)); }
__device__ __forceinline__ void pst16(void* p, u32x4 v) { *(u32x4*)p = v; }
__device__ __forceinline__ void pst8(void* p, u32x2 v) { *(u32x2*)p = v; }
#ifndef NO_WT
__device__ __forceinline__ void st16_so(const void* base, unsigned off, f32x4 v) { asm volatile("global_store_dwordx4 %0, %1, %2 sc1\n\ts_nop 1" :: "v"(off), "v"(v), "s"(base)); }
__device__ __forceinline__ void st4_so(const void* base, unsigned off, unsigned v) { asm volatile("global_store_dword %0, %1, %2 sc1\n\ts_nop 1" :: "v"(off), "v"(v), "s"(base)); }
#else
__device__ __forceinline__ void st16_so(const void* base, unsigned off, f32x4 v) { *(f32x4*)((unsigned char*)base + off) = v; }
__device__ __forceinline__ void st4_so(const void* base, unsigned off, unsigned v) { *(unsigned*)((unsigned char*)base + off) = v; }
#endif
#define LDS_WAIT() asm volatile("s_waitcnt lgkmcnt(0)" ::: "memory")
#define VM_WAIT() asm volatile("s_waitcnt vmcnt(0)" ::: "memory")

#define XB_TMO      128
#define XB_XCNT(j)  (256  + 64 * (j))
#define XB_XSUB(j)  (1280 + 64 * (j))
#define XB_XGEN(j)  (2304 + 64 * (j))
#define XB_TOP      3328
#define XB_TOPGEN   3392
#define XCD_BAR_WORDS 3456
#define XB_SPIN_CAP (1u << 18)
__device__ __forceinline__ unsigned xb_ld(unsigned* p)              { return __hip_atomic_load(p, __ATOMIC_RELAXED, __HIP_MEMORY_SCOPE_AGENT); }
__device__ __forceinline__ unsigned xb_add(unsigned* p, unsigned v) { return __hip_atomic_fetch_add(p, v, __ATOMIC_RELAXED, __HIP_MEMORY_SCOPE_AGENT); }
__device__ __forceinline__ unsigned xb_xcc_id() { return (unsigned)__builtin_amdgcn_s_getreg((3 << 11) | 20) & 0xFu; }
#define XB_SPIN(cond, bar) do { unsigned _sp = 0; while (cond) { __builtin_amdgcn_s_sleep(1); \
    if ((++_sp & 255u) == 0u) { if (xb_ld(&(bar)[XB_TMO])) break; if (_sp > XB_SPIN_CAP) { atomicAdd(&(bar)[XB_TMO], 1u); break; } } } } while (0)
struct XcdBarrier { unsigned* bar; unsigned x; volatile LAS unsigned* st; };
__device__ __forceinline__ int xb_tid();
__device__ __forceinline__ XcdBarrier xcd_barrier_post(unsigned* bar, volatile LAS unsigned* st) {
    XcdBarrier b; b.bar = bar; b.x = xb_xcc_id(); b.st = st;
    if (threadIdx.x == 0) st[4] = xb_add(&bar[XB_XCNT(b.x)], 1u);
    return b;
}
#define XB_LCNT(j)  (3520 + 64 * (j))
#define XB_LGEN(j)  (4544 + 64 * (j))
#define XCD_BAR_WORDS_EXT 5568
__device__ __forceinline__ void xcd_local_barrier(const XcdBarrier& b, const int wave_s, const unsigned nloc) {
    asm volatile("s_waitcnt vmcnt(0)" ::: "memory");
    __syncthreads();
    if (wave_s == 0 && xb_tid() == 0) {
        unsigned* bar = b.bar;
        const unsigned old = xb_add(&bar[XB_LCNT(b.x)], 1u);
        const unsigned gen = old / nloc;
        if (old + 1u == (gen + 1u) * nloc) xb_add(&bar[XB_LGEN(b.x)], 1u);
        else XB_SPIN(xb_ld(&bar[XB_LGEN(b.x)]) == gen, bar);
#ifndef LB_NOACQ
        __builtin_amdgcn_fence(__ATOMIC_ACQUIRE, "agent");
        asm volatile("s_waitcnt vmcnt(0)" ::: "memory");
#endif
    }
    __syncthreads();
}
__device__ __forceinline__ void xcd_barrier_complete(unsigned* bar, unsigned x, unsigned& nloc, unsigned& nx) {
    const unsigned G = gridDim.x * gridDim.y * gridDim.z;
    unsigned sum, cnt, mine, sp = 0u;
    for (;;) {
        sum = 0u; cnt = 0u; mine = 0u;
#pragma unroll
        for (unsigned j = 0; j < 16; ++j) { const unsigned c = xb_ld(&bar[XB_XCNT(j)]); sum += c; cnt += (c > 0u) ? 1u : 0u; mine = (j == x) ? c : mine; }
        if (sum == G) break;
        __builtin_amdgcn_s_sleep(1);
        if ((++sp & 255u) == 0u) { if (xb_ld(&bar[XB_TMO])) break; if (sp > XB_SPIN_CAP) { atomicAdd(&bar[XB_TMO], 1u); break; } }
    }
    nloc = mine > 0u ? mine : 1u; nx = cnt > 0u ? cnt : 1u;
}
__device__ __forceinline__ int xb_tid() { int t; asm volatile("v_mbcnt_lo_u32_b32 %0, -1, 0\n\tv_mbcnt_hi_u32_b32 %0, -1, %0" : "=v"(t)); return t; }
__device__ __forceinline__ void xcd_barrier(const XcdBarrier& b, const int wave_s) {
    asm volatile("s_waitcnt vmcnt(0)" ::: "memory");
    __syncthreads();
    if (wave_s == 0 && xb_tid() == 0) {
        unsigned* bar = b.bar;
        __builtin_amdgcn_s_waitcnt(0);
        unsigned nloc = b.st[0], nx = b.st[1];
        if (nloc == 0u) { xcd_barrier_complete(bar, b.x, nloc, nx); b.st[0] = nloc; b.st[1] = nx; }
        const unsigned old = xb_add(&bar[XB_XSUB(b.x)], 1u);
        const unsigned gen = old / nloc;
        if (old + 1u == (gen + 1u) * nloc) {
            __builtin_amdgcn_fence(__ATOMIC_RELEASE, "agent");
            asm volatile("s_waitcnt vmcnt(0)" ::: "memory");
            const unsigned og = xb_add(&bar[XB_TOP], 1u);
            const unsigned tg = og / nx;
            if (og + 1u == (tg + 1u) * nx) xb_add(&bar[XB_TOPGEN], 1u);
            else XB_SPIN(xb_ld(&bar[XB_TOPGEN]) == tg, bar);
            __builtin_amdgcn_fence(__ATOMIC_ACQUIRE, "agent");
            xb_add(&bar[XB_XGEN(b.x)], 1u);
            asm volatile("s_waitcnt vmcnt(0)" ::: "memory");
        } else {
            XB_SPIN(xb_ld(&bar[XB_XGEN(b.x)]) == gen, bar);
            __builtin_amdgcn_fence(__ATOMIC_ACQUIRE, "agent");
            asm volatile("s_waitcnt vmcnt(0)" ::: "memory");
        }
    }
    __syncthreads();
}

constexpr int BM = 256, BK = 64, HALF = 128, HTB = HALF * BK * 2, STAGE_BYTES = 8 * HTB;
__host__ __device__ __forceinline__ int lds_byte(int r, int c) { const int st = (r >> 4) * 2 + (c >> 5), rr = r & 15, cc = c & 31, ob = rr * 64 + cc * 2; return st * 1024 + (ob ^ (((ob >> 9) & 1) << 5)); }
__host__ __device__ __forceinline__ void stage_rc(int b, int& R, int& C) { const int st = b / 1024, sb = b % 1024, swz = sb ^ (((sb >> 9) & 1) << 5); R = (st >> 1) * 16 + swz / 64; C = (st & 1) * 32 + (swz % 64) / 2; }
__host__ __device__ __forceinline__ int perm32(int rho) { const int n = rho >> 4, i = rho & 15; return 8 * (i >> 2) + 4 * n + (i & 3); }

struct GUnit { const char* A; const char* B; char* C; const void* X; int pm, pn; };
template <int WGM = 8>
__device__ __forceinline__ bool static_unit(int i, int G, int c, int nM, int nN, int& pm, int& pn) {
    const long L = (long)i * G + c; const int nwg = nM * nN; if (L >= nwg) return false;
    int wgid = (int)L; { const int q = nwg / 8, r = nwg % 8, xcd = wgid % 8, off = wgid / 8; wgid = (xcd < r ? xcd * (q + 1) : r * (q + 1) + (xcd - r) * q) + off; }
    const int nig = WGM * nN, gid = wgid / nig, fm = gid * WGM, gsz = (nM - fm) < WGM ? (nM - fm) : WGM;
    pm = fm + ((wgid % nig) % gsz); pn = (wgid % nig) / gsz; return true;
}
template <class Epi, class Sched, bool GATHER, bool FP8 = false>
__device__ __forceinline__ void gemm_phase(LAS unsigned char* lds, const int tid_in, const int K, const unsigned lda, const unsigned ldb, const Sched& S, const Epi& E) {
    int tid_ = tid_in; asm volatile("" : "+v"(tid_));
    const int tid = tid_, wid = __builtin_amdgcn_readfirstlane(tid >> 6), lane = tid & 63, wr = wid >> 2, wc = wid & 3, fr = lane & 15, fq = lane >> 4;
    int nt_ = K / BK; asm volatile("" : "+s"(nt_)); const int nt = nt_;
    unsigned voffA[2], voffB[2]; int gR[2], gC[2];
#pragma unroll
    for (int i = 0; i < 2; ++i) { int R, C; stage_rc(tid * 16 + i * 8192, R, C); const int Rb = Epi::PERM ? ((R & ~31) + perm32(R & 31)) : R;
        voffA[i] = (unsigned)R * lda + (unsigned)C * 2u; voffB[i] = (unsigned)Rb * ldb + (unsigned)C * 2u; gR[i] = R; gC[i] = C * 2; }
    const size_t kstep = (size_t)(BK * 2);
    const size_t hstepA = (size_t)HALF * lda, hstepB = (size_t)HALF * ldb;
    const unsigned ldsw = (unsigned)wid * 1024u;
    const int aoff = lds_byte(wr * 64 + fr, fq * 8), boff = lds_byte(wc * 32 + fr, fq * 8);
    unsigned cvo[2][2], nvo[2][2];
#define PG8_SA(b, h) (((b) * 2 + (h)) * HTB)
#define PG8_SB(b, h) ((4 + (b) * 2 + (h)) * HTB)
#define PG8_STAGE(bufoff, gbase, voff) do { _Pragma("unroll") for (int _i = 0; _i < 2; ++_i) \
        __builtin_amdgcn_global_load_lds((const unsigned*)((const char*)(gbase) + (voff)[_i]), (LAS unsigned*)(lds + (bufoff) + ldsw + _i * 8192), 16, 0, 0); } while (0)
#define PG8_STAGE_B(bufoff, ptr, h) PG8_STAGE(bufoff, (ptr) + (h) * hstepB, voffB)
#define PG8_STAGE_A(bufoff, ptr, h, vo) do { if constexpr (GATHER) { PG8_STAGE(bufoff, (ptr), (vo)[h]); } else { PG8_STAGE(bufoff, (ptr) + (h) * hstepA, voffA); } } while (0)
#define PG8_LDA(dst, b, h) do { _Pragma("unroll") for (int m = 0; m < 4; ++m) _Pragma("unroll") for (int k = 0; k < 2; ++k) dst[m][k] = *(const LAS bf16x8*)(lds + PG8_SA(b, h) + aoff + m * 2048 + k * 1024); } while (0)
#define PG8_LDB(dst, b, h) do { _Pragma("unroll") for (int n = 0; n < 2; ++n) _Pragma("unroll") for (int k = 0; k < 2; ++k) dst[n][k] = *(const LAS bf16x8*)(lds + PG8_SB(b, h) + boff + n * 2048 + k * 1024); } while (0)
#define PG8_MMA(ai, bj, At, Bt) do { __builtin_amdgcn_s_setprio(1); _Pragma("unroll") for (int m = 0; m < 4; ++m) _Pragma("unroll") for (int n = 0; n < 2; ++n) { \
        if constexpr (FP8) { const v8i _a = __builtin_shufflevector(__builtin_bit_cast(v4i, At[m][0]), __builtin_bit_cast(v4i, At[m][1]), 0, 1, 2, 3, 4, 5, 6, 7), _b = __builtin_shufflevector(__builtin_bit_cast(v4i, Bt[n][0]), __builtin_bit_cast(v4i, Bt[n][1]), 0, 1, 2, 3, 4, 5, 6, 7); \
            asm volatile("v_mfma_f32_16x16x128_f8f6f4 %0, %1, %2, %0" : "+v"(acc[ai][bj][m][n]) : "v"(_b), "v"(_a)); } \
        else { _Pragma("unroll") for (int k = 0; k < 2; ++k) acc[ai][bj][m][n] = __builtin_amdgcn_mfma_f32_16x16x32_bf16(Bt[n][k], At[m][k], acc[ai][bj][m][n], 0, 0, 0); } } __builtin_amdgcn_s_setprio(0); } while (0)
#define PG8_WAIT_V(n) asm volatile("s_waitcnt vmcnt(" #n ")" ::: "memory")
#define PG8_WAIT_L(n) asm volatile("s_waitcnt lgkmcnt(" #n ")" ::: "memory")
#define PG8_BAR __builtin_amdgcn_s_barrier()
#define PG8_SCHED __builtin_amdgcn_sched_barrier(0)
#define PG8_GLOAD(vo, u) do { if constexpr (GATHER) { const int* _gi = (const int*)(u).X; _Pragma("unroll") for (int _h = 0; _h < 2; ++_h) _Pragma("unroll") for (int _i = 0; _i < 2; ++_i) \
        (vo)[_h][_i] = (unsigned)_gi[_h * HALF + gR[_i]] * lda + (unsigned)gC[_i]; } } while (0)
    GUnit cur, nxt; int ui = 0;
    if (!S.next(0, cur)) return;
    f32x4 acc[2][2][4][2];
    const volatile LAS f32x4* zero16 = (const volatile LAS f32x4*)(lds + ZERO16_OFF);
#pragma unroll
    for (int a = 0; a < 2; ++a)
#pragma unroll
        for (int b = 0; b < 2; ++b)
#pragma unroll
            for (int m = 0; m < 4; ++m)
#pragma unroll
                for (int n = 0; n < 2; ++n) acc[a][b][m][n] = *zero16;
    bf16x8 At[4][2], B0[2][2], B1[2][2];
    const char* cA = cur.A; const char* cB = cur.B;
    PG8_GLOAD(cvo, cur);
    if constexpr (GATHER) { PG8_WAIT_V(0); }
    PG8_STAGE_B(PG8_SB(0, 0), cB, 0); PG8_STAGE_B(PG8_SB(0, 1), cB, 1); PG8_STAGE_A(PG8_SA(0, 0), cA, 0, cvo); PG8_STAGE_A(PG8_SA(0, 1), cA, 1, cvo);
    if (wr == 1) PG8_BAR;
    PG8_WAIT_V(2); PG8_BAR;
    PG8_STAGE_B(PG8_SB(1, 0), cB + kstep, 0); PG8_STAGE_A(PG8_SA(1, 0), cA + kstep, 0, cvo); PG8_STAGE_B(PG8_SB(1, 1), cB + kstep, 1);
    PG8_WAIT_V(6); PG8_BAR;
    for (;;) {
        const bool has_next = S.next(ui + 1, nxt);
        const char* nA = has_next ? nxt.A : cA; const char* nB = has_next ? nxt.B : cB;
        if constexpr (GATHER) { if (has_next) { PG8_GLOAD(nvo, nxt); } else {
#pragma unroll
            for (int h = 0; h < 2; ++h)
#pragma unroll
                for (int i = 0; i < 2; ++i) nvo[h][i] = cvo[h][i]; } }
        for (int t = 0; t < nt; t += 2) {
            const bool last = (t == nt - 2);
            const char* a1 = cA + (size_t)(t + 1) * kstep;
            const char* a2 = last ? nA : cA + (size_t)(t + 2) * kstep; const char* b2 = last ? nB : cB + (size_t)(t + 2) * kstep;
            const char* a3 = a2 + kstep; const char* b3 = b2 + kstep;
            unsigned vo2[2][2];
            if constexpr (GATHER) {
#pragma unroll
                for (int h = 0; h < 2; ++h)
#pragma unroll
                    for (int i = 0; i < 2; ++i) vo2[h][i] = last ? nvo[h][i] : cvo[h][i]; }
            PG8_LDB(B0, 0, 0); PG8_LDB(B1, 0, 1); PG8_SCHED; PG8_LDA(At, 0, 0); PG8_STAGE_A(PG8_SA(1, 1), a1, 1, cvo);
            PG8_WAIT_V(8); PG8_WAIT_L(0); PG8_BAR; PG8_MMA(0, 0, At, B0); PG8_MMA(0, 1, At, B1); PG8_BAR; PG8_SCHED;
            PG8_LDA(At, 0, 1); PG8_STAGE_B(PG8_SB(0, 0), b2, 0); PG8_STAGE_B(PG8_SB(0, 1), b2, 1); PG8_STAGE_A(PG8_SA(0, 0), a2, 0, vo2);
            PG8_WAIT_V(8); PG8_WAIT_L(0); PG8_BAR; PG8_MMA(1, 0, At, B0); PG8_MMA(1, 1, At, B1); PG8_BAR; PG8_SCHED;
            PG8_LDB(B0, 1, 0); PG8_LDB(B1, 1, 1); PG8_SCHED; PG8_LDA(At, 1, 0); PG8_STAGE_A(PG8_SA(0, 1), a2, 1, vo2);
            PG8_WAIT_V(8); PG8_WAIT_L(0); PG8_BAR; PG8_MMA(0, 0, At, B0); PG8_MMA(0, 1, At, B1); PG8_BAR; PG8_SCHED;
            PG8_LDA(At, 1, 1); PG8_STAGE_B(PG8_SB(1, 0), b3, 0); PG8_STAGE_B(PG8_SB(1, 1), b3, 1); PG8_STAGE_A(PG8_SA(1, 0), a3, 0, vo2);
            PG8_WAIT_V(8); PG8_WAIT_L(0); PG8_BAR; PG8_MMA(1, 0, At, B0); PG8_MMA(1, 1, At, B1); PG8_BAR; PG8_SCHED;
        }
        if constexpr (FP8) { asm volatile("s_nop 15\n\ts_nop 15" ::: "memory"); }
        if (wr == 0) PG8_BAR;
        E(acc, cur, wr, wc, fr, fq);
        if (!has_next) break;
#pragma unroll
        for (int a = 0; a < 2; ++a)
#pragma unroll
            for (int b = 0; b < 2; ++b)
#pragma unroll
                for (int m = 0; m < 4; ++m)
#pragma unroll
                    for (int n = 0; n < 2; ++n) acc[a][b][m][n] = *zero16;
        cur = nxt; cA = nA; cB = nB; ++ui;
        if constexpr (GATHER) {
#pragma unroll
            for (int h = 0; h < 2; ++h)
#pragma unroll
                for (int i = 0; i < 2; ++i) cvo[h][i] = nvo[h][i]; }
        if (wr == 1) PG8_BAR;
    }
    PG8_WAIT_V(0);
    PG8_BAR;
#undef PG8_SA
#undef PG8_SB
#undef PG8_STAGE
#undef PG8_STAGE_A
#undef PG8_STAGE_B
#undef PG8_LDA
#undef PG8_LDB
#undef PG8_MMA
#undef PG8_WAIT_V
#undef PG8_WAIT_L
#undef PG8_BAR
#undef PG8_SCHED
#undef PG8_GLOAD
}
typedef f32x4 Acc[2][2][4][2];
__device__ __forceinline__ float sigmoidf_fast(float x) { return __builtin_amdgcn_rcpf(1.f + __builtin_amdgcn_exp2f(-1.4426950408889634f * x)); }
__device__ __forceinline__ float gelu_tanh_fast(float y) {
    const float inner = 1.5957691216057308f * (y + 0.044715f * y * y * y);
    return y * sigmoidf_fast(inner);
}
__device__ __forceinline__ unsigned cvt4_fp8(float a, float b, float c, float d) {
    a = fminf(fmaxf(a, -448.f), 448.f); b = fminf(fmaxf(b, -448.f), 448.f); c = fminf(fmaxf(c, -448.f), 448.f); d = fminf(fmaxf(d, -448.f), 448.f);
    int w = 0; w = __builtin_amdgcn_cvt_pk_fp8_f32(a, b, w, false); w = __builtin_amdgcn_cvt_pk_fp8_f32(c, d, w, true); return (unsigned)w;
}
constexpr float FP8_SX = 8.f, FP8_SW13 = 32.f, FP8_SH = 8.f, FP8_SW2 = 64.f, FP8_SWQK = 32.f, FP8_SWQKV = 32.f;
struct EpiGated8 {
    static constexpr bool PERM = true;
    unsigned ldc;
    __device__ __forceinline__ void operator()(const Acc& acc, const GUnit& u, int wr, int wc, int fr, int fq) const {
        unsigned char* base = (unsigned char*)u.C;
        constexpr float kx = -1.4426950408889634f / (FP8_SX * FP8_SW13), ic = (FP8_SX * FP8_SW13) * (FP8_SX * FP8_SW13) / FP8_SH;
#pragma unroll
        for (int ai = 0; ai < 2; ++ai)
#pragma unroll
            for (int m = 0; m < 4; ++m) { const int r = ai * HALF + wr * 64 + m * 16 + fr;
                float o[8];
#pragma unroll
                for (int n = 0; n < 2; ++n)
#pragma unroll
                    for (int j = 0; j < 4; j += 2) {
                        const f32x2 a = {acc[ai][0][m][n][j], acc[ai][0][m][n][j + 1]}, b = {acc[ai][1][m][n][j], acc[ai][1][m][n][j + 1]};
                        const f32x2 t = a * f32x2{kx, kx};
                        const f32x2 e = {__builtin_amdgcn_exp2f(t[0]), __builtin_amdgcn_exp2f(t[1])};
                        const f32x2 d = e * f32x2{ic, ic} + f32x2{ic, ic};
                        const f32x2 s = {__builtin_amdgcn_rcpf(d[0]), __builtin_amdgcn_rcpf(d[1])};
                        const f32x2 q = (a * b) * s;
                        o[n * 4 + j] = __builtin_amdgcn_fmed3f(q[0], -448.f, 448.f); o[n * 4 + j + 1] = __builtin_amdgcn_fmed3f(q[1], -448.f, 448.f); }
                int w0 = 0, w1 = 0;
                w0 = __builtin_amdgcn_cvt_pk_fp8_f32(o[0], o[1], w0, false); w0 = __builtin_amdgcn_cvt_pk_fp8_f32(o[2], o[3], w0, true);
                w1 = __builtin_amdgcn_cvt_pk_fp8_f32(o[4], o[5], w1, false); w1 = __builtin_amdgcn_cvt_pk_fp8_f32(o[6], o[7], w1, true);
                u32x2 w; w.x = (unsigned)w0; w.y = (unsigned)w1;
                st8(base + (size_t)r * ldc + wc * 32 + 8 * fq, w); }
    }
};
struct EpiBf8 {
    static constexpr bool PERM = true;
    unsigned ldc; float scale;
    __device__ __forceinline__ void operator()(const Acc& acc, const GUnit& u, int wr, int wc, int fr, int fq) const {
        unsigned char* base = (unsigned char*)u.C;
#pragma unroll
        for (int ai = 0; ai < 2; ++ai)
#pragma unroll
            for (int m = 0; m < 4; ++m) { const int r = ai * HALF + wr * 64 + m * 16 + fr; unsigned char* rowp = base + (size_t)r * ldc + wc * 32 + 8 * fq;
#pragma unroll
                for (int bj = 0; bj < 2; ++bj) { const f32x4 v0 = acc[ai][bj][m][0] * scale, v1 = acc[ai][bj][m][1] * scale;
                    u32x2 w; w.x = cvt4_fp8(v0[0], v0[1], v0[2], v0[3]); w.y = cvt4_fp8(v1[0], v1[1], v1[2], v1[3]); st8(rowp + bj * HALF, w); } }
    }
};
template <bool ROWSCALE> struct EpiBf {
    static constexpr bool PERM = true;
    unsigned ldc; float scale;
    __device__ __forceinline__ void operator()(const Acc& acc, const GUnit& u, int wr, int wc, int fr, int fq) const {
        bf16_t* base = (bf16_t*)u.C; const float* rs = (const float*)u.X;
#pragma unroll
        for (int ai = 0; ai < 2; ++ai)
#pragma unroll
            for (int m = 0; m < 4; ++m) { const int r = ai * HALF + wr * 64 + m * 16 + fr; float s = scale; if (ROWSCALE) s *= rs[r];
                bf16_t* rowp = base + (size_t)r * ldc + wc * 32 + 8 * fq;
#pragma unroll
                for (int bj = 0; bj < 2; ++bj) { const f32x4 v0 = acc[ai][bj][m][0] * s, v1 = acc[ai][bj][m][1] * s;
                    u32x4 w; w.x = cvt_pk_bf16(v0[0], v0[1]); w.y = cvt_pk_bf16(v0[2], v0[3]); w.z = cvt_pk_bf16(v1[0], v1[1]); w.w = cvt_pk_bf16(v1[2], v1[3]);
                    st16(rowp + bj * HALF, w); } }
    }
};
template <int MODE> struct EpiGated {
    static constexpr bool PERM = true;
    unsigned ldc;
    __device__ __forceinline__ void operator()(const Acc& acc, const GUnit& u, int wr, int wc, int fr, int fq) const {
        bf16_t* base = (bf16_t*)u.C;
#pragma unroll
        for (int ai = 0; ai < 2; ++ai)
#pragma unroll
            for (int m = 0; m < 4; ++m) { const int r = ai * HALF + wr * 64 + m * 16 + fr;
                float o[8];
#pragma unroll
                for (int n = 0; n < 2; ++n)
#pragma unroll
                    for (int j = 0; j < 4; ++j) { const float a = acc[ai][0][m][n][j], b = acc[ai][1][m][n][j];
                        o[n * 4 + j] = (MODE == 0) ? a * sigmoidf_fast(b) : a * sigmoidf_fast(a) * b; }
                u32x4 w; w.x = cvt_pk_bf16(o[0], o[1]); w.y = cvt_pk_bf16(o[2], o[3]); w.z = cvt_pk_bf16(o[4], o[5]); w.w = cvt_pk_bf16(o[6], o[7]);
                st16(base + (size_t)r * ldc + wc * 32 + 8 * fq, w); }
    }
};
struct EpiUA {
    static constexpr bool PERM = true;
    __device__ __forceinline__ void operator()(const Acc& acc, const GUnit& u, int wr, int wc, int fr, int fq) const {
        bf16_t* UA = (bf16_t*)u.C;
#pragma unroll
        for (int ai = 0; ai < 2; ++ai)
#pragma unroll
            for (int m = 0; m < 4; ++m) { const int tok = u.pm * BM + ai * HALF + wr * 64 + m * 16 + fr; const int chunk = tok >> 5, j = tok & 31;
#pragma unroll
                for (int bj = 0; bj < 2; ++bj) { const int ch = u.pn * BM + bj * HALF + wc * 32 + 8 * fq, g = ch >> 4, h0 = ch & 15;
                    const f32x4 v0 = acc[ai][bj][m][0], v1 = acc[ai][bj][m][1];
                    u32x4 w; w.x = cvt_pk_bf16(v0[0], v0[1]); w.y = cvt_pk_bf16(v0[2], v0[3]); w.z = cvt_pk_bf16(v1[0], v1[1]); w.w = cvt_pk_bf16(v1[2], v1[3]);
                    st16(UA + ((size_t)g * NCHUNK + chunk) * UAK + j * 16 + h0, w); } }
    }
};
struct EpiS {
    static constexpr bool PERM = false;
    __device__ __forceinline__ void operator()(const Acc& acc, const GUnit& u, int wr, int wc, int fr, int fq) const {
        float* Sg = (float*)u.C;
#pragma unroll
        for (int ai = 0; ai < 2; ++ai)
#pragma unroll
            for (int m = 0; m < 4; ++m) { const int chunk = u.pm * BM + ai * HALF + wr * 64 + m * 16 + fr; float* rowp = Sg + (size_t)chunk * 256 + wc * 32 + 4 * fq;
#pragma unroll
                for (int bj = 0; bj < 2; ++bj)
#pragma unroll
                    for (int n = 0; n < 2; ++n) st16f(rowp + bj * HALF + n * 16, acc[ai][bj][m][n]); }
    }
};
struct EpiGelu {
    static constexpr bool PERM = true;
    __device__ __forceinline__ void operator()(const Acc& acc, const GUnit& u, int wr, int wc, int fr, int fq) const {
        bf16_t* Gg = (bf16_t*)u.C;
#pragma unroll
        for (int ai = 0; ai < 2; ++ai)
#pragma unroll
            for (int m = 0; m < 4; ++m) { const int chunk = u.pm * BM + ai * HALF + wr * 64 + m * 16 + fr;
#pragma unroll
                for (int bj = 0; bj < 2; ++bj) { const int n0 = u.pn * BM + bj * HALF + wc * 32 + 8 * fq, i = n0 >> 4, c0 = n0 & 15;
                    const f32x4 v0 = acc[ai][bj][m][0], v1 = acc[ai][bj][m][1];
                    u32x4 w; w.x = cvt_pk_bf16(gelu_tanh_fast(v0[0]), gelu_tanh_fast(v0[1])); w.y = cvt_pk_bf16(gelu_tanh_fast(v0[2]), gelu_tanh_fast(v0[3]));
                    w.z = cvt_pk_bf16(gelu_tanh_fast(v1[0]), gelu_tanh_fast(v1[1])); w.w = cvt_pk_bf16(gelu_tanh_fast(v1[2]), gelu_tanh_fast(v1[3]));
                    st16(Gg + ((size_t)chunk * TCH + i) * D + c0, w); } }
    }
};

struct EpiSoftmax {
    static constexpr bool PERM = true;
    LAS float* red; unsigned ldc; float scale;
    __device__ __forceinline__ void operator()(Acc& acc, const GUnit& u, int wr, int wc, int fr, int fq) const {
        bf16_t* base = (bf16_t*)u.C;
#pragma unroll
        for (int ai = 0; ai < 2; ++ai)
#pragma unroll
            for (int m = 0; m < 4; ++m) { float mx = -INFINITY;
#pragma unroll
                for (int bj = 0; bj < 2; ++bj)
#pragma unroll
                    for (int n = 0; n < 2; ++n) { const f32x4 v = acc[ai][bj][m][n]; mx = fmaxf(mx, fmaxf(fmaxf(v[0], v[1]), fmaxf(v[2], v[3]))); }
                mx *= scale; mx = x32_max(x16_max(mx));
                if (fq == 0) red[(ai * HALF + wr * 64 + m * 16 + fr) * 4 + wc] = mx; }
        asm volatile("s_waitcnt lgkmcnt(0)" ::: "memory"); __builtin_amdgcn_s_barrier(); asm volatile("" ::: "memory");
#pragma unroll
        for (int ai = 0; ai < 2; ++ai)
#pragma unroll
            for (int m = 0; m < 4; ++m) { const int r = ai * HALF + wr * 64 + m * 16 + fr; const f32x4 mm = *(const LAS f32x4*)(red + r * 4); const float M = fmaxf(fmaxf(mm[0], mm[1]), fmaxf(mm[2], mm[3]));
                float s = 0.f;
#pragma unroll
                for (int bj = 0; bj < 2; ++bj)
#pragma unroll
                    for (int n = 0; n < 2; ++n) { f32x4 v = acc[ai][bj][m][n];
#pragma unroll
                        for (int j = 0; j < 4; ++j) { v[j] = __builtin_amdgcn_exp2f(__builtin_fmaf(v[j], scale, -M)); s += v[j]; }
                        acc[ai][bj][m][n] = v; }
                s = x32_sum(x16_sum(s));
                if (fq == 0) red[1024 + r * 4 + wc] = s; }
        asm volatile("s_waitcnt lgkmcnt(0)" ::: "memory"); __builtin_amdgcn_s_barrier(); asm volatile("" ::: "memory");
#pragma unroll
        for (int ai = 0; ai < 2; ++ai)
#pragma unroll
            for (int m = 0; m < 4; ++m) { const int r = ai * HALF + wr * 64 + m * 16 + fr; const f32x4 ss = *(const LAS f32x4*)(red + 1024 + r * 4); const float inv = __builtin_amdgcn_rcpf((ss[0] + ss[1]) + (ss[2] + ss[3]));
                bf16_t* rowp = base + (size_t)r * ldc + wc * 32 + 8 * fq;
#pragma unroll
                for (int bj = 0; bj < 2; ++bj) { const f32x4 v0 = acc[ai][bj][m][0] * inv, v1 = acc[ai][bj][m][1] * inv;
                    u32x4 w; w.x = cvt_pk_bf16(v0[0], v0[1]); w.y = cvt_pk_bf16(v0[2], v0[3]); w.z = cvt_pk_bf16(v1[0], v1[1]); w.w = cvt_pk_bf16(v1[2], v1[3]);
                    st16(rowp + bj * HALF, w); } }
    }
};

struct Ctx { unsigned char* ws; int G, c; };
struct SchedPlain { const char* A; const char* B; char* C; size_t lda, ldb, ldc; int nM, nN, G, c;
    __device__ __forceinline__ bool next(int i, GUnit& u) const { int pm, pn; if (!static_unit(i, G, c, nM, nN, pm, pn)) return false;
        u.A = A + (size_t)pm * BM * lda; u.B = B + (size_t)pn * BM * ldb; u.C = C + ((size_t)pm * BM * ldc + (size_t)pn * BM) * 2; u.X = nullptr; u.pm = pm; u.pn = pn; return true; } };
struct SchedGated { const char* A; const char* B; char* C; size_t lda, ldb, ldc; int nM, nN, G, c;
    __device__ __forceinline__ bool next(int i, GUnit& u) const { int pm, pn; if (!static_unit(i, G, c, nM, nN, pm, pn)) return false;
        u.A = A + (size_t)pm * BM * lda; u.B = B + (size_t)pn * BM * ldb; u.C = C + ((size_t)pm * BM * ldc + (size_t)pn * HALF) * 2; u.X = nullptr; u.pm = pm; u.pn = pn; return true; } };
struct SchedUA { const char* A; const char* B; char* UA; int G, c;
    __device__ __forceinline__ bool next(int i, GUnit& u) const { int pm, pn; if (!static_unit(i, G, c, NT / BM, D / BM, pm, pn)) return false;
        u.A = A + (size_t)pm * BM * (D * 2); u.B = B + (size_t)pn * BM * (D * 2); u.C = UA; u.X = nullptr; u.pm = pm; u.pn = pn; return true; } };
struct SchedKV { unsigned char* ws; int G, c;
    __device__ __forceinline__ bool next(int i, GUnit& u) const { const int L = i * G + c; if (L >= 128) return false; const int layer = L >> 6, r = L & 63, pm = r >> 3, pn = r & 7;
        u.A = (const char*)ws + WS_MEMB + (size_t)pm * BM * 2048; u.B = (const char*)ws + WS_MWKV + (size_t)layer * 4 * MiB + (size_t)pn * BM * 2048;
        u.C = (char*)ws + WS_KV + (size_t)layer * 8 * MiB + ((size_t)pm * BM * 2048 + pn * BM) * 2; u.X = nullptr; u.pm = pm; u.pn = pn; return true; } };
struct SchedSA { unsigned char* ws; int G, c;
    __device__ __forceinline__ bool next(int i, GUnit& u) const { const int L = i * G + c; if (L >= 64 * 6) return false; const int g = L / 6, pm = L % 6;
        u.A = (const char*)ws + PO_UA + ((size_t)g * NCHUNK + (size_t)pm * BM) * (UAK * 2); u.B = (const char*)ws + PO_M2T + (size_t)g * 256 * 512 * 2;
        u.C = (char*)ws + PO_SG + (size_t)g * NCHUNK * 256 * 4; u.X = nullptr; u.pm = pm; u.pn = 0; return true; } };
struct SchedSC { unsigned char* ws; int G, c;
    __device__ __forceinline__ bool next(int i, GUnit& u) const { const int L = i * G + c; if (L >= 64 * 12) return false; const int g = L / 12, r = L % 12, pm = r >> 1, pn = r & 1;
        u.A = (const char*)ws + PO_UA + ((size_t)g * NCHUNK + (size_t)pm * BM) * (UAK * 2); u.B = (const char*)ws + PO_M13T + ((size_t)g * 512 + pn * BM) * UAK * 2;
        u.C = (char*)ws + PO_SG + (size_t)g * 16 * 2; u.X = nullptr; u.pm = pm; u.pn = pn; return true; } };
struct SchedWqk { unsigned char* ws; int G, c;
    __device__ __forceinline__ bool next(int i, GUnit& u) const { const int L = i * G + c; if (L >= 256) return false; const int pn = L & 3, h = (L >> 2) & 3, gb = (L >> 4) & 7, layer = L >> 7;
        u.A = (const char*)ws + WS_KV + (size_t)layer * 8 * MiB + ((size_t)gb * 256 * 2048 + h * 256) * 2; u.B = (const char*)ws + WS_MWQ + (size_t)layer * 2 * MiB + ((size_t)pn * BM * 1024 + h * 256) * 2;
        u.C = (char*)ws + WS_WQK + ((size_t)(layer * 8 + gb) * 1024 * 1024 + (size_t)h * 256 * 1024 + pn * BM); u.X = nullptr; u.pm = 0; u.pn = pn; return true; } };
struct SchedWvo { unsigned char* ws; int G, c;
    __device__ __forceinline__ bool next(int i, GUnit& u) const { const int L = i * G + c; if (L >= 256) return false; const int pm = L & 3, h = (L >> 2) & 3, gb = (L >> 4) & 7, layer = L >> 7;
        u.A = (const char*)ws + WS_MWO + (size_t)layer * 2 * MiB + ((size_t)pm * BM * 1024 + h * 256) * 2; u.B = (const char*)ws + WS_KV + (size_t)layer * 8 * MiB + ((size_t)gb * 256 * 2048 + 1024 + h * 256) * 2;
        u.C = (char*)ws + WS_WVO + ((size_t)(layer * 8 + gb) * 1024 * 1024 + (size_t)pm * BM * 1024 + h * 256) * 2; u.X = nullptr; u.pm = pm; u.pn = 0; return true; } };
struct SchedScores8 { const char* A; const char* Bl; char* C; int G, c;
    __device__ __forceinline__ bool next(int i, GUnit& u) const { int pm, pn; if (!static_unit(i, G, c, NT / BM, 4, pm, pn)) return false; const int gb = panel_gb(pm);
        u.A = A + (size_t)pm * BM * 1024; u.B = Bl + ((size_t)gb * 1024 + pn * BM) * 1024; u.C = C + ((size_t)pm * BM * 1024 + pn * BM) * 2; u.X = nullptr; u.pm = pm; u.pn = pn; return true; } };
struct SchedBatchW { const char* A; const char* Bl; char* C; int G, c;
    __device__ __forceinline__ bool next(int i, GUnit& u) const { int pm, pn; if (!static_unit(i, G, c, NT / BM, 4, pm, pn)) return false; const int gb = panel_gb(pm);
        u.A = A + (size_t)pm * BM * 2048; u.B = Bl + ((size_t)gb * 1024 + pn * BM) * 2048; u.C = C + ((size_t)pm * BM * 1024 + pn * BM) * 2; u.X = nullptr; u.pm = pm; u.pn = pn; return true; } };
struct Args { const float* in[26]; float* out; unsigned char* ws; int ph_lo, ph_hi, flags, pad; };
struct Frame {
    LAS unsigned char* lds; unsigned char* ws; const float* const* in; float* out;
    int tid, lane, wave, G, c;
    bool xok;
};
enum { I_XP = 0, I_XS, I_MEMP, I_MEMS, I_AWIN, I_ALRE, I_ALIM, I_ALDT, I_ABRE, I_ABIM, I_ACRE, I_ACIM, I_AD, I_AWGLU, I_BWQKV, I_BRPB, I_BWO, I_MWQ, I_MWKV, I_MWO, I_EWR, I_EW1, I_EW3, I_EW2, I_LNG, I_LNB };

__device__ __forceinline__ int rowmap(int mode, int n) {
    if (mode == 0) return n;
    if (mode == 1) { const int z = n >> 10, nn = n & 1023; return ((nn >> 7) << 8) + (z << 7) + (nn & 127); }
    return ((n >> 7) << 8) + ((mode == 3) ? 128 : 0) + (n & 127);
}
__device__ __forceinline__ void transpose_item(const float* W, int K, int N, bf16_t* WT, int mode, LAS float* scr, int item, int lane) {
    const int nblk = N / 32, kb = item / nblk, nb = item % nblk, k0 = 64 * kb, n0 = 32 * nb;
#pragma unroll 8
    for (int i = 0; i < 32; ++i) { const int kk = 2 * i + (lane >> 5); scr[kk * 33 + (lane & 31)] = W[(size_t)(k0 + kk) * N + n0 + (lane & 31)]; }
    LDS_WAIT(); asm volatile("" ::: "memory");
    const int c = lane & 7;
#pragma unroll
    for (int j = 0; j < 4; ++j) { const int n = (lane >> 3) + 8 * j; const LAS float* s = scr + (8 * c) * 33 + n;
        u32x4 o; o.x = cvt_pk_bf16(s[0 * 33], s[1 * 33]); o.y = cvt_pk_bf16(s[2 * 33], s[3 * 33]); o.z = cvt_pk_bf16(s[4 * 33], s[5 * 33]); o.w = cvt_pk_bf16(s[6 * 33], s[7 * 33]);
        *(u32x4*)(WT + (size_t)rowmap(mode, n0 + n) * K + k0 + 8 * c) = o; }
    LDS_WAIT(); asm volatile("" ::: "memory");
}
__device__ __forceinline__ void t8_load(f32x4 (&v)[16], const float* W, int N, int item, int lane) {
    const int nblk = N / 32, kb = item / nblk, nb = item % nblk, k0 = 128 * kb, n0 = 32 * nb, q = lane >> 3, c = lane & 7;
#pragma unroll
    for (int i = 0; i < 16; ++i) v[i] = *(const f32x4*)(W + (size_t)(k0 + 16 * q + i) * N + n0 + 4 * c);
}
__device__ __forceinline__ void t8_finish(const f32x4 (&v)[16], int K, int N, unsigned char* WT, int mode, float scale, LAS unsigned char* scr, int item, int lane) {
    const int nblk = N / 32, kb = item / nblk, nb = item % nblk, k0 = 128 * kb, n0 = 32 * nb, q = lane >> 3, c = lane & 7;
#pragma unroll
    for (int j = 0; j < 4; ++j) { u32x4 o;
        o.x = cvt4_fp8(v[0][j] * scale, v[1][j] * scale, v[2][j] * scale, v[3][j] * scale); o.y = cvt4_fp8(v[4][j] * scale, v[5][j] * scale, v[6][j] * scale, v[7][j] * scale);
        o.z = cvt4_fp8(v[8][j] * scale, v[9][j] * scale, v[10][j] * scale, v[11][j] * scale); o.w = cvt4_fp8(v[12][j] * scale, v[13][j] * scale, v[14][j] * scale, v[15][j] * scale);
        *(LAS u32x4*)(scr + (4 * c + j) * 144 + 16 * q) = o; }
    LDS_WAIT(); asm volatile("" ::: "memory");
#pragma unroll
    for (int j = 0; j < 4; ++j) { const int n = (lane >> 3) + 8 * j; const u32x4 o = *(const LAS u32x4*)(scr + n * 144 + 16 * c);
        pst16(WT + (size_t)rowmap(mode, n0 + n) * K + k0 + 16 * c, o); }
    LDS_WAIT(); asm volatile("" ::: "memory");
}
__device__ __forceinline__ void transpose_item8(const float* W, int K, int N, unsigned char* WT, int mode, float scale, LAS unsigned char* scr, int item, int lane) {
    f32x4 v[16]; t8_load(v, W, N, item, lane); t8_finish(v, K, N, WT, mode, scale, scr, item, lane);
}
__device__ __forceinline__ void transpose_item16(const float* W, int K, int N, bf16_t* WT, int mode, LAS unsigned char* scr, int item, int lane) {
    const int nblk = N / 32, kb = item / nblk, nb = item % nblk, k0 = 128 * kb, n0 = 32 * nb, q = lane >> 3, c = lane & 7;
    f32x4 v[16];
#pragma unroll
    for (int i = 0; i < 16; ++i) v[i] = *(const f32x4*)(W + (size_t)(k0 + 16 * q + i) * N + n0 + 4 * c);
#pragma unroll
    for (int j = 0; j < 4; ++j) { u32x4 o0, o1;
        o0.x = cvt_pk_bf16(v[0][j], v[1][j]); o0.y = cvt_pk_bf16(v[2][j], v[3][j]); o0.z = cvt_pk_bf16(v[4][j], v[5][j]); o0.w = cvt_pk_bf16(v[6][j], v[7][j]);
        o1.x = cvt_pk_bf16(v[8][j], v[9][j]); o1.y = cvt_pk_bf16(v[10][j], v[11][j]); o1.z = cvt_pk_bf16(v[12][j], v[13][j]); o1.w = cvt_pk_bf16(v[14][j], v[15][j]);
        *(LAS u32x4*)(scr + (4 * c + j) * 272 + 32 * q) = o0; *(LAS u32x4*)(scr + (4 * c + j) * 272 + 32 * q + 16) = o1; }
    LDS_WAIT(); asm volatile("" ::: "memory");
#pragma unroll
    for (int j = 0; j < 8; ++j) { const int n = (lane >> 4) + 4 * j, ch = lane & 15; const u32x4 o = *(const LAS u32x4*)(scr + n * 272 + 16 * ch);
        *(u32x4*)(WT + (size_t)rowmap(mode, n0 + n) * K + k0 + 8 * ch) = o; }
    LDS_WAIT(); asm volatile("" ::: "memory");
}
__device__ __forceinline__ void convert_small_weights(Frame& F) {
    LAS unsigned char* scr = F.lds + F.wave * 16384;
    const int gw = F.c * 8 + F.wave, NGW = F.G * 8;
    for (int it = gw; it < 3328; it += NGW) {
        int r = it;
        if (r < 256) { transpose_item16(F.in[I_AWIN], 1024, 1024, (bf16_t*)(F.ws + WS_WIN), 0, scr, r, F.lane); continue; } r -= 256;
        if (r < 512) { transpose_item16(F.in[I_AWGLU], 1024, 2048, (bf16_t*)(F.ws + WS_WGLU), 1, scr, r, F.lane); continue; } r -= 512;
        if (r < 768) { transpose_item8(F.in[I_BWQKV], 1024, 3072, F.ws + WS_WQKV, 0, FP8_SWQKV, scr, r, F.lane); continue; } r -= 768;
        if (r < 256) { transpose_item16(F.in[I_BWO], 1024, 1024, (bf16_t*)(F.ws + WS_WO), 0, scr, r, F.lane); continue; } r -= 256;
        if (r < 1024) { const int l = r >> 9; transpose_item16(F.in[I_MWKV] + (size_t)l * 1024 * 2048, 1024, 2048, (bf16_t*)(F.ws + WS_MWKV + (size_t)l * 4 * MiB), 0, scr, r & 511, F.lane); continue; } r -= 1024;
        { const int l = r >> 8; transpose_item16(F.in[I_MWO] + (size_t)l * 1024 * 1024, 1024, 1024, (bf16_t*)(F.ws + WS_MWO + (size_t)l * 2 * MiB), 0, scr, r & 255, F.lane); }
    }
}
__device__ __forceinline__ void convert_expert_weights(Frame& F, int layer, int lo = 0, int hi = 16 * 1536, int wg0 = 0) {
    if (F.G <= wg0) wg0 = 0;
    if (F.c < wg0) return;
    LAS unsigned char* scr = F.lds + F.wave * 16384;
    const int gw = (F.c - wg0) * 8 + F.wave, NGW = (F.G - wg0) * 8;
#define CVX_DECODE(it_) const int _e = (it_) / 1536; int _r = (it_) % 1536; const size_t _wofs = ((size_t)layer * 16 + _e) * 1024 * 2048; \
        const int _w = _r >> 9; _r &= 511; const float* _W = (_w == 0 ? F.in[I_EW1] : (_w == 1 ? F.in[I_EW3] : F.in[I_EW2])) + _wofs; const int _N = _w == 2 ? 1024 : 2048, _K = _w == 2 ? 2048 : 1024;
#define CVX_LOAD(v_, it_) do { CVX_DECODE(it_); (void)_K; t8_load(v_, _W, _N, _r, F.lane); } while (0)
#define CVX_FINISH(v_, it_) do { CVX_DECODE(it_); unsigned char* _WT = _w == 2 ? F.ws + WS_EW2 + (size_t)_e * 2 * MiB : F.ws + WS_EW13 + (size_t)_e * 4 * MiB; \
        t8_finish(v_, _K, _N, _WT, _w == 0 ? 2 : (_w == 1 ? 3 : 0), _w == 2 ? FP8_SW2 : FP8_SW13, scr, _r, F.lane); } while (0)
    f32x4 va[16], vb[16];
    int it = lo + gw;
    if (it < hi) CVX_LOAD(va, it);
    while (it < hi) {
        const int it1 = it + NGW, it2 = it1 + NGW;
        if (it1 < hi) CVX_LOAD(vb, it1);
        CVX_FINISH(va, it);
        if (it1 < hi) { if (it2 < hi) CVX_LOAD(va, it2); CVX_FINISH(vb, it1); }
        it = it2;
    }
#undef CVX_DECODE
#undef CVX_LOAD
#undef CVX_FINISH
}
__device__ __forceinline__ void convert_plain(Frame& F, const float* src, bf16_t* dst, size_t n) {
    const size_t n4 = n / 4;
    for (size_t i = (size_t)F.c * 512 + F.tid; i < n4; i += (size_t)F.G * 512) { const f32x4 v = ((const f32x4*)src)[i]; u32x2 w; w.x = cvt_pk_bf16(v[0], v[1]); w.y = cvt_pk_bf16(v[2], v[3]); ((u32x2*)dst)[i] = w; }
}
__device__ __forceinline__ void import_x(Frame& F, bool copy_f32) {
    const size_t n4 = (size_t)NT * D / 4, np4 = (size_t)NTP * D / 4, st = (size_t)F.G * 512;
    f32x4* XF = (f32x4*)(F.ws + WS_XF); u32x2* XB = (u32x2*)(F.ws + WS_XB);
    for (size_t i0 = (size_t)F.c * 512 + F.tid; i0 < n4; i0 += st * 8) {
        f32x4 v[8];
#pragma unroll
        for (int u = 0; u < 8; ++u) { const size_t i = i0 + st * u;
            if (i < n4) { if (copy_f32) { v[u] = (i < np4) ? ((const f32x4*)F.in[I_XP])[i] : ((const f32x4*)F.in[I_XS])[i - np4]; } else v[u] = XF[i]; } }
#pragma unroll
        for (int u = 0; u < 8; ++u) { const size_t i = i0 + st * u;
            if (i < n4) { u32x2 w; w.x = cvt_pk_bf16(v[u][0], v[u][1]); w.y = cvt_pk_bf16(v[u][2], v[u][3]); XB[i] = w; } }
    }
}

__device__ __forceinline__ void s5_lam(const float* lre, const float* lim, const float* ldt, int dir, int g, int p, double& dt, double& lr, double& li) {
    dt = exp((double)ldt[dir * 64 + g]); lr = (double)lre[(dir * 64 + g) * 64 + p]; li = (double)lim[(dir * 64 + g) * 64 + p];
}
__device__ __forceinline__ void s5_fill_bc(Frame& F, int g, int dir, const LAS double* LBd, LAS float* Bbr, LAS float* Bbi, LAS float* Cr, LAS float* Ci) {
    for (int idx = F.tid; idx < 1024; idx += 512) {
        const int p = idx >> 4, h = idx & 15; const double fr = LBd[p * 4 + 2], fi = LBd[p * 4 + 3];
        const double br = F.in[I_ABRE][((dir * 64 + g) * 64 + p) * 16 + h], bi = F.in[I_ABIM][((dir * 64 + g) * 64 + p) * 16 + h];
        Bbr[idx] = (float)(fr * br - fi * bi); Bbi[idx] = (float)(fr * bi + fi * br);
        Cr[idx] = F.in[I_ACRE][(dir * 64 + g) * 1024 + idx]; Ci[idx] = F.in[I_ACIM][(dir * 64 + g) * 1024 + idx];
    }
}
__device__ __forceinline__ void s5_build_item(Frame& F, int g, int dir) {
    LAS float* LPr = (LAS float*)F.lds; LAS float* LPi = LPr + 33 * 64;
    LAS float* Bbr = LPi + 33 * 64; LAS float* Bbi = Bbr + 1024; LAS float* Cr = Bbi + 1024; LAS float* Ci = Cr + 1024;
    LAS float* B2r = Ci + 1024; LAS float* B2i = B2r + 1024; LAS float* C2r = B2i + 1024; LAS float* C2i = C2r + 1024;
    LAS float* KD = C2i + 1024;
    bf16_t* M2T = (bf16_t*)(F.ws + PO_M2T) + (size_t)g * 256 * 512; bf16_t* M13T = (bf16_t*)(F.ws + PO_M13T) + (size_t)g * 512 * UAK;
    LAS double* LB = (LAS double*)(KD + 32 * 256);
    __syncthreads();
    if (F.tid < 128) { const int dd = F.tid >> 6, p = F.tid & 63;
        if (dd == 0 || dir == 0) { double dt, lr, li; s5_lam(F.in[I_ALRE], F.in[I_ALIM], F.in[I_ALDT], dd == 0 ? dir : 1, g, p, dt, lr, li);
            const double er = exp(lr * dt), lbr = er * cos(li * dt), lbi = er * sin(li * dt), nr = lbr - 1.0, ni = lbi, den = lr * lr + li * li;
            LB[(dd * 64 + p) * 4 + 0] = lbr; LB[(dd * 64 + p) * 4 + 1] = lbi; LB[(dd * 64 + p) * 4 + 2] = (nr * lr + ni * li) / den; LB[(dd * 64 + p) * 4 + 3] = (ni * lr - nr * li) / den; } }
    __syncthreads();
    for (int idx = F.tid; idx < 33 * 64; idx += 512) { const int e = idx >> 6, p = idx & 63; double br = LB[p * 4], bi = LB[p * 4 + 1], rr = 1.0, ri = 0.0;
        for (int b = e; b != 0; b >>= 1) { if (b & 1) { const double t = rr * br - ri * bi; ri = rr * bi + ri * br; rr = t; } const double t2 = br * br - bi * bi; bi = 2.0 * br * bi; br = t2; }
        LPr[idx] = (float)rr; LPi[idx] = (float)ri; }
    s5_fill_bc(F, g, dir, LB, Bbr, Bbi, Cr, Ci);
    if (dir == 0) s5_fill_bc(F, g, 1, LB + 256, B2r, B2i, C2r, C2i);
    __syncthreads();
    {
        const int k = F.tid, j = k >> 4, h = k & 15, e = dir == 0 ? (TCH - 1 - j) : j;
        for (int p = 0; p < 64; ++p) { const float lr = LPr[e * 64 + p], li = LPi[e * 64 + p], br = Bbr[p * 16 + h], bi = Bbi[p * 16 + h];
            const float xr = lr * br - li * bi, xi = lr * bi + li * br;
            M2T[(size_t)(dir * 128 + p) * 512 + k] = (bf16_t)(cvt_pk_bf16(xr, 0.f) & 0xffffu); M2T[(size_t)(dir * 128 + 64 + p) * 512 + k] = (bf16_t)(cvt_pk_bf16(xi, 0.f) & 0xffffu); }
    }
    {
        const int p = F.tid & 63, q8 = F.tid >> 6;
        for (int ic = q8; ic < 512; ic += 8) { const int i = ic >> 4, c = ic & 15, e = dir == 0 ? (i + 1) : (TCH - i);
            const float cr = Cr[c * 64 + p], ci = Ci[c * 64 + p], lr = LPr[e * 64 + p], li = LPi[e * 64 + p];
            const float vr = cr * lr - ci * li, vi = cr * li + ci * lr;
            M13T[(size_t)ic * UAK + 512 + dir * 128 + p] = (bf16_t)(cvt_pk_bf16(vr, 0.f) & 0xffffu); M13T[(size_t)ic * UAK + 512 + dir * 128 + 64 + p] = (bf16_t)(cvt_pk_bf16(-vi, 0.f) & 0xffffu); }
    }
    {
        const int ch = F.tid & 255, c = ch >> 4, h = ch & 15, par = F.tid >> 8;
        if (dir == 0 && par == 0) {
            float s = (c == h) ? F.in[I_AD][g * 16 + c] : 0.f;
            for (int p = 0; p < 64; ++p) s += Cr[c * 64 + p] * Bbr[p * 16 + h] - Ci[c * 64 + p] * Bbi[p * 16 + h] + C2r[c * 64 + p] * B2r[p * 16 + h] - C2i[c * 64 + p] * B2i[p * 16 + h];
            KD[ch] = s;
        }
#pragma nounroll
        for (int hp = 0; hp < 64; hp += 32) {
            float cbr[32], cbi[32];
#pragma unroll
            for (int p = 0; p < 32; ++p) { const float cr = Cr[c * 64 + hp + p], ci = Ci[c * 64 + hp + p], br = Bbr[(hp + p) * 16 + h], bi = Bbi[(hp + p) * 16 + h]; cbr[p] = cr * br - ci * bi; cbi[p] = cr * bi + ci * br; }
#pragma nounroll
            for (int d = 1 + par; d < TCH; d += 2) {
                float s0 = 0.f, s1 = 0.f;
#pragma unroll
                for (int p = 0; p < 32; p += 4) { const f32x4 lr = *(const LAS f32x4*)(LPr + d * 64 + hp + p), li = *(const LAS f32x4*)(LPi + d * 64 + hp + p);
                    s0 += cbr[p] * lr[0]; s1 -= cbi[p] * li[0]; s0 += cbr[p + 1] * lr[1]; s1 -= cbi[p + 1] * li[1]; s0 += cbr[p + 2] * lr[2]; s1 -= cbi[p + 2] * li[2]; s0 += cbr[p + 3] * lr[3]; s1 -= cbi[p + 3] * li[3]; }
                if (hp == 0) KD[d * 256 + ch] = s0 + s1; else KD[d * 256 + ch] += s0 + s1;
            }
        }
        __syncthreads();
        for (int idx = F.tid; idx < 512 * 64; idx += 512) { const int hf = idx & 1, j = (idx >> 1) & 31, ic = idx >> 6, i = ic >> 4, cc = ic & 15;
            const bool mine = dir == 0 ? (j <= i) : (j > i);
            if (mine) { const int d = dir == 0 ? (i - j) : (j - i); const f32x4 v0 = *(const LAS f32x4*)(KD + d * 256 + cc * 16 + hf * 8), v1 = *(const LAS f32x4*)(KD + d * 256 + cc * 16 + hf * 8 + 4);
                u32x4 v; v.x = cvt_pk_bf16(v0[0], v0[1]); v.y = cvt_pk_bf16(v0[2], v0[3]); v.z = cvt_pk_bf16(v1[0], v1[1]); v.w = cvt_pk_bf16(v1[2], v1[3]); *(u32x4*)(M13T + (size_t)ic * UAK + j * 16 + hf * 8) = v; } }
    }
    __syncthreads();
}

__device__ __forceinline__ void s5_recurrence(Frame& F) {
    const float* S = (const float*)(F.ws + PO_SG); bf16_t* UA = (bf16_t*)(F.ws + PO_UA);
    for (int base = F.c * 256; base < 65536; base += F.G * 256) {
        if (F.tid >= 256) continue;
        const int flat = base + F.tid, p = flat & 63, dir = (flat >> 6) & 1, g = (flat >> 7) & 63, gb = flat >> 13;
        double dt, lr, li; s5_lam(F.in[I_ALRE], F.in[I_ALIM], F.in[I_ALDT], dir, g, p, dt, lr, li);
        const double er = exp(lr * dt * TCH); const float ar = (float)(er * cos(li * dt * TCH)), ai = (float)(er * sin(li * dt * TCH));
        const int nc = gb < 4 ? 256 : 128, chunk0 = gb < 4 ? gb * 256 : 1024 + (gb - 4) * 128;
        float hr = 0.f, hi = 0.f;
        for (int s0 = 0; s0 < nc; s0 += 8) {
            float sr[8], si[8];
#pragma unroll
            for (int k = 0; k < 8; ++k) { const int cc = dir == 0 ? (s0 + k) : (nc - 1 - s0 - k); const size_t o = ((size_t)g * NCHUNK + (chunk0 + cc)) * 256 + dir * 128 + p; sr[k] = S[o]; si[k] = S[o + 64]; }
#pragma unroll
            for (int k = 0; k < 8; ++k) { const int cc = dir == 0 ? (s0 + k) : (nc - 1 - s0 - k); const size_t o = ((size_t)g * NCHUNK + (chunk0 + cc)) * UAK + 512 + dir * 128 + p;
                UA[o] = (bf16_t)(cvt_pk_bf16(hr, 0.f) & 0xffffu); UA[o + 64] = (bf16_t)(cvt_pk_bf16(hi, 0.f) & 0xffffu);
                const float nr = ar * hr - ai * hi + sr[k], ni = ar * hi + ai * hr + si[k]; hr = nr; hi = ni; }
        }
    }
}

__device__ __forceinline__ void add_bf16x4(f32x4& v, const u32x2 w) { v[0] += __uint_as_float(w.x << 16); v[1] += __uint_as_float(w.x & 0xffff0000u); v[2] += __uint_as_float(w.y << 16); v[3] += __uint_as_float(w.y & 0xffff0000u); }
constexpr int WRS = 1028;
__device__ __forceinline__ void ln_router_fill(Frame& F, const float* gam, const float* bet, const float* wrouter) {
    LAS float* wrT = (LAS float*)F.lds; LAS float* gsh = wrT + 16 * WRS; LAS float* bsh = gsh + 1024;
    __syncthreads();
    for (int i = F.tid; i < 16384; i += 512) { const int k = i >> 4, e = i & 15; wrT[e * WRS + k] = wrouter[i]; }
    for (int i = F.tid; i < 1024; i += 512) { gsh[i] = gam[i]; bsh[i] = bet[i]; }
    __syncthreads();
}
#ifndef RES_BF16
#define RES_BF16 1
#endif
template <int MODE, bool ROUTER, bool FINAL, bool SRCIN = false>
__device__ __forceinline__ void ln_phase(Frame& F, const bf16_t* HB, const float* gam, const float* bet, const float* wrouter) {
    float* XF = (float*)(F.ws + WS_XF);
    LAS float* wrT = (LAS float*)F.lds;
    LAS float* gsh = wrT + 16 * WRS; LAS float* bsh = gsh + 1024;
    f32x4 gv[4], bv[4];
    if (!ROUTER) {
#pragma unroll
        for (int j = 0; j < 4; ++j) { gv[j] = *(const f32x4*)(gam + F.lane * 4 + 256 * j); bv[j] = *(const f32x4*)(bet + F.lane * 4 + 256 * j); } }
    const unsigned char* wsb = F.ws; int ln = F.lane; unsigned lb4 = (unsigned)ln * 16u, lb2 = (unsigned)ln * 8u, lb1 = (unsigned)ln * 4u;
    const unsigned hb_off = (unsigned)((const unsigned char*)HB - wsb);
    const int nq = F.xok ? 6 : (NT / 4 + F.G * 8 - 1) / (F.G * 8);
    constexpr bool X32 = SRCIN || !RES_BF16;
    f32x4 xr32[4][4]; u32x2 xr16[4][4], hwr[4][4];
#define LN_ISSUE(row0_) do { const int _r0 = (row0_); \
        const unsigned char* xbase = SRCIN ? (_r0 < NTP ? (const unsigned char*)F.in[I_XP] : (const unsigned char*)F.in[I_XS] - (size_t)NTP * 4096) : wsb + WS_XF;      \
        if (X32) { _Pragma("unroll") for (int r = 0; r < 4; ++r) { const unsigned ro = (unsigned)(_r0 + r) * 4096u + lb4; _Pragma("unroll") for (int j = 0; j < 4; ++j) xr32[r][j] = *(const f32x4*)(xbase + ro + 1024u * j); } } \
        else { _Pragma("unroll") for (int r = 0; r < 4; ++r) { const unsigned ro = (unsigned)(_r0 + r) * 2048u + lb2; _Pragma("unroll") for (int j = 0; j < 4; ++j) xr16[r][j] = *(const u32x2*)(xbase + ro + 512u * j); } } \
        if (MODE == 0) { _Pragma("unroll") for (int r = 0; r < 4; ++r) { const unsigned ro = hb_off + (unsigned)(_r0 + r) * 2048u + lb2; _Pragma("unroll") for (int j = 0; j < 4; ++j) hwr[r][j] = *(const u32x2*)(wsb + ro + 512u * j); } } \
    } while (0)
#define LN_Q(qi_) (F.xok ? ((F.c & 7) * 1536 + (F.c >> 3) * 48 + F.wave * 6 + (qi_)) : (F.c * 8 + F.wave + (qi_) * F.G * 8))
    u32x4 sln = {~0u, ~0u, ~0u, ~0u};
    if (MODE == 1) { const int q0 = LN_Q(0); if (nq > 0 && q0 < NT / 4 && F.lane < 16) sln = *(const u32x4*)(wsb + (unsigned)(WS_SLOT + ((size_t)F.lane * NT + (size_t)q0 * 4) * 4)); }
    { const int q0 = LN_Q(0); if (nq > 0 && q0 < NT / 4) { LN_ISSUE(q0 * 4); } }
    for (int qi = 0; qi < nq; ++qi) {
        const int q = LN_Q(qi);
        if (q >= NT / 4) break;
        const int row0 = q * 4;
        const u32x4 slc = sln;
        if (MODE == 1) { const int qn = LN_Q(qi + 1); if (qi + 1 < nq && qn < NT / 4 && ln < 16) sln = *(const u32x4*)(wsb + (unsigned)(WS_SLOT + ((size_t)ln * NT + (size_t)qn * 4) * 4)); }
        asm volatile("v_mbcnt_lo_u32_b32 %0, -1, 0\n\tv_mbcnt_hi_u32_b32 %0, -1, %0" : "=v"(ln));
        lb4 = (unsigned)ln * 16u; lb2 = (unsigned)ln * 8u; lb1 = (unsigned)ln * 4u; const int lw = ln * 4;
        f32x4 v[4][4];
#pragma unroll
        for (int r = 0; r < 4; ++r)
#pragma unroll
            for (int j = 0; j < 4; ++j) {
                if (X32) v[r][j] = xr32[r][j];
                else { v[r][j][0] = __uint_as_float(xr16[r][j].x << 16); v[r][j][1] = __uint_as_float(xr16[r][j].x & 0xffff0000u); v[r][j][2] = __uint_as_float(xr16[r][j].y << 16); v[r][j][3] = __uint_as_float(xr16[r][j].y & 0xffff0000u); } }
        if (MODE == 0) {
#pragma unroll
            for (int r = 0; r < 4; ++r)
#pragma unroll
                for (int j = 0; j < 4; ++j) { v[r][j] = v[r][j] * ALPHA; add_bf16x4(v[r][j], hwr[r][j]); }
        }
        if (!ROUTER) { const int qn = LN_Q(qi + 1); if (qi + 1 < nq && qn < NT / 4) { LN_ISSUE(qn * 4); } }
        if (MODE == 0) {
        } else {
            const int grp = row0 >= NTP; int sl[4];
#pragma unroll
            for (int r = 0; r < 4; ++r) sl[r] = (ln < 16) ? (int)slc[r] : -1;
            unsigned long long mask[4]; bool any[4], two[4]; u32x2 wa[4][4], wb[4][4];
#pragma unroll
            for (int r = 0; r < 4; ++r) {
                unsigned long long mk = __ballot(sl[r] >= 0); any[r] = mk != 0ull;
                int e0 = 0, s0 = 0; if (any[r]) { e0 = __builtin_ctzll(mk); mk &= mk - 1; s0 = __builtin_amdgcn_readlane(sl[r], e0); }
                const unsigned y0 = any[r] ? (grp ? 65536u + e0 * 2048u + s0 : e0 * 4096u + s0) : 0u;
                two[r] = mk != 0ull; int e1 = 0, s1 = 0; if (two[r]) { e1 = __builtin_ctzll(mk); mk &= mk - 1; s1 = __builtin_amdgcn_readlane(sl[r], e1); }
                const unsigned y1 = two[r] ? (grp ? 65536u + e1 * 2048u + s1 : e1 * 4096u + s1) : y0;
                mask[r] = mk;
                const unsigned char* ya = wsb + PO_YE + (size_t)y0 * 2048; const unsigned char* yb = wsb + PO_YE + (size_t)y1 * 2048;
#pragma unroll
                for (int j = 0; j < 4; ++j) { wa[r][j] = *(const u32x2*)(ya + lb2 + 512u * j); wb[r][j] = *(const u32x2*)(yb + lb2 + 512u * j); }
            }
#pragma unroll
            for (int r = 0; r < 4; ++r) {
#pragma unroll
                for (int j = 0; j < 4; ++j) { v[r][j] = v[r][j] * ALPHA; if (any[r]) add_bf16x4(v[r][j], wa[r][j]); if (two[r]) add_bf16x4(v[r][j], wb[r][j]); }
                unsigned long long mk = mask[r];
                while (mk) {
                    const int e0 = __builtin_ctzll(mk); mk &= mk - 1; const int s0 = __builtin_amdgcn_readlane(sl[r], e0);
                    const unsigned y0 = grp ? 65536u + e0 * 2048u + s0 : e0 * 4096u + s0;
                    const bool tw = mk != 0ull; int e1 = 0, s1 = 0; if (tw) { e1 = __builtin_ctzll(mk); mk &= mk - 1; s1 = __builtin_amdgcn_readlane(sl[r], e1); }
                    const unsigned y1 = tw ? (grp ? 65536u + e1 * 2048u + s1 : e1 * 4096u + s1) : y0;
                    const unsigned char* ya = wsb + PO_YE + (size_t)y0 * 2048; const unsigned char* yb = wsb + PO_YE + (size_t)y1 * 2048;
                    u32x2 xa[4], xb[4];
#pragma unroll
                    for (int j = 0; j < 4; ++j) { xa[j] = *(const u32x2*)(ya + lb2 + 512u * j); xb[j] = *(const u32x2*)(yb + lb2 + 512u * j); }
#pragma unroll
                    for (int j = 0; j < 4; ++j) { add_bf16x4(v[r][j], xa[j]); if (tw) add_bf16x4(v[r][j], xb[j]); }
                }
            }
        }
#pragma unroll
        for (int r = 0; r < 4; ++r) {
            float s = 0.f;
#pragma unroll
            for (int j = 0; j < 4; ++j) s += (v[r][j][0] + v[r][j][1]) + (v[r][j][2] + v[r][j][3]);
            const float mean = wave_sum(s) * (1.f / D); float qq = 0.f;
#pragma unroll
            for (int j = 0; j < 4; ++j) { v[r][j] = v[r][j] - mean; qq += (v[r][j][0] * v[r][j][0] + v[r][j][1] * v[r][j][1]) + (v[r][j][2] * v[r][j][2] + v[r][j][3] * v[r][j][3]); }
            const float rstd = 1.f / sqrtf(wave_sum(qq) * (1.f / D) + LN_EPS);
#pragma unroll
            for (int j = 0; j < 4; ++j) { if (ROUTER) { gv[j] = *(const LAS f32x4*)(gsh + lw + 256 * j); bv[j] = *(const LAS f32x4*)(bsh + lw + 256 * j); } v[r][j] = v[r][j] * rstd * gv[j] + bv[j]; }
            const unsigned row = (unsigned)(row0 + r);
            if (FINAL) {
                unsigned char* ob = (unsigned char*)F.out;
#pragma unroll
                for (int j = 0; j < 4; ++j) *(f32x4*)(ob + (size_t)(row * 4096u + lb4 + 1024u * j)) = v[r][j];
            } else {
                unsigned char* wsw = F.ws;
#pragma unroll
                for (int j = 0; j < 4; ++j) {
                    if (RES_BF16) { u32x2 xo; xo.x = cvt_pk_bf16_c(v[r][j][0], v[r][j][1]); xo.y = cvt_pk_bf16_c(v[r][j][2], v[r][j][3]); *(u32x2*)(wsw + (unsigned)(WS_XF + row * 2048u + lb2 + 512u * j)) = xo; }
                    else *(f32x4*)(wsw + (unsigned)(WS_XF + row * 4096u + lb4 + 1024u * j)) = v[r][j];
                    *(unsigned*)(wsw + (unsigned)(WS_XB8 + row * 1024u + lb1 + 256u * j)) = cvt4_fp8(v[r][j][0] * FP8_SX, v[r][j][1] * FP8_SX, v[r][j][2] * FP8_SX, v[r][j][3] * FP8_SX); }
            }
        }
        if (ROUTER) {
            { const int qn = LN_Q(qi + 1); if (qi + 1 < nq && qn < NT / 4) { LN_ISSUE(qn * 4); } }
            float val[64];
#pragma unroll
            for (int hf = 0; hf < 4; ++hf) {
                f32x2 a2[4][4];
#pragma unroll
                for (int r = 0; r < 4; ++r)
#pragma unroll
                    for (int e4 = 0; e4 < 4; ++e4) a2[r][e4] = f32x2{0.f, 0.f};
#pragma unroll
                for (int e4 = 0; e4 < 4; ++e4)
#pragma unroll
                    for (int j = 0; j < 4; ++j) { const f32x4 w = *(const LAS f32x4*)(wrT + (hf * 4 + e4) * WRS + lw + 256 * j);
                        const f32x2 wl = f32x2{w[0], w[1]}, wh = f32x2{w[2], w[3]};
#pragma unroll
                        for (int r = 0; r < 4; ++r) { a2[r][e4] = f32x2{v[r][j][0], v[r][j][1]} * wl + a2[r][e4]; a2[r][e4] = f32x2{v[r][j][2], v[r][j][3]} * wh + a2[r][e4]; } }
#pragma unroll
                for (int r = 0; r < 4; ++r)
#pragma unroll
                    for (int e4 = 0; e4 < 4; ++e4) val[r * 16 + hf * 4 + e4] = a2[r][e4][0] + a2[r][e4][1];
            }
#pragma unroll
            for (int sft = 5; sft >= 0; --sft) { const int n2 = 1 << sft; const bool up = (ln >> sft) & 1;
#pragma unroll
                for (int i = 0; i < n2; ++i) { const float lo = val[i], hi = val[i + n2]; const float mine = up ? hi : lo, other = up ? lo : hi; val[i] = mine + __shfl_xor(other, n2); } }
            const float lg = val[0], m = row_max(lg);
            const float ex = expf(lg - m); const float l = row_sum(ex);
            *(float*)(F.ws + (unsigned)(WS_AFF + ((size_t)(ln & 15) * NT + row0 + (ln >> 4)) * 4)) = ex / l;
        }
    }
#undef LN_Q
#undef LN_ISSUE
    if (ROUTER) __syncthreads();
}
__device__ __forceinline__ void softmax_phase(Frame& F, bf16_t* SB) {
    for (int row = F.c * 8 + F.wave; row < NT * 4; row += F.G * 8) {
        u32x2* p = (u32x2*)(SB + (size_t)row * 256) + F.lane; const u32x2 w = *p;
        float a = __uint_as_float(w.x << 16), b = __uint_as_float(w.x & 0xffff0000u), c = __uint_as_float(w.y << 16), d = __uint_as_float(w.y & 0xffff0000u);
        const float m = wave_max(fmaxf(fmaxf(a, b), fmaxf(c, d)));
        a = __expf(a - m); b = __expf(b - m); c = __expf(c - m); d = __expf(d - m);
        const float inv = 1.f / wave_sum((a + b) + (c + d));
        u32x2 o; o.x = cvt_pk_bf16(a * inv, b * inv); o.y = cvt_pk_bf16(c * inv, d * inv); *p = o;
    }
}
__device__ __forceinline__ void moe_panel(int P, int& e, int& grp, int& yerow0) {
    if (P < 256) { e = P >> 4; grp = 0; } else { e = (P - 256) >> 3; grp = 1; }
    yerow0 = P * 256;
}
#ifndef UPWGM
#define UPWGM 8
#endif
struct SchedUp { unsigned char* ws; int G, c;
    __device__ __forceinline__ bool next(int i, GUnit& u) const { int P, pn; if (!static_unit<UPWGM>(i, G, c, 384, 16, P, pn)) return false; int e, grp, y0; moe_panel(P, e, grp, y0);
        u.A = (const char*)ws + WS_XB8 + (grp ? (size_t)NTP * 1024 : 0); u.B = (const char*)ws + WS_EW13 + ((size_t)e * 4096 + pn * BM) * 1024;
        u.C = (char*)ws + PO_HM + ((size_t)P * BM * 2048 + pn * HALF); u.X = (const int*)(ws + WS_IDX) + y0; u.pm = P; u.pn = pn; return true; } };
struct SchedDown { unsigned char* ws; int G, c;
    __device__ __forceinline__ bool next(int i, GUnit& u) const { int P, pn; if (!static_unit(i, G, c, 384, 4, P, pn)) return false; int e, grp, y0; moe_panel(P, e, grp, y0);
        u.A = (const char*)ws + PO_HM + (size_t)P * BM * 2048; u.B = (const char*)ws + WS_EW2 + ((size_t)e * 1024 + pn * BM) * 2048;
        u.C = (char*)ws + PO_YE + ((size_t)y0 * 1024 + pn * BM) * 2; u.X = (const float*)(ws + WS_GATE) + y0; u.pm = P; u.pn = pn; return true; } };
struct SchedQKV { unsigned char* ws; int G, c;
    __device__ __forceinline__ bool next(int i, GUnit& u) const { const int L = i * G + c; if (L >= 1536 + 768) return false;
        if (L < 1536) { int pm, pn; static_unit(i, G, c, 192, 8, pm, pn);
            u.A = (const char*)ws + WS_XB8 + (size_t)pm * BM * 1024; u.B = (const char*)ws + WS_WQKV + (size_t)pn * BM * 1024;
            u.C = (char*)ws + (pn < 4 ? PO_Q : PO_K) + ((size_t)pm * BM * 1024 + (pn & 3) * BM) * 2; u.X = nullptr; u.pm = pm; u.pn = pn; return true; }
        const int r = L - 1536, pmv = r & 3, pnv = r >> 2;
        u.A = (const char*)ws + WS_WQKV + (size_t)(2048 + pmv * BM) * 1024; u.B = (const char*)ws + WS_XB8 + (size_t)pnv * BM * 1024;
        u.C = (char*)ws + PO_VT + ((size_t)pmv * BM * NT + (size_t)pnv * BM) * 2; u.X = nullptr; u.pm = pmv; u.pn = 8 + pnv; return true; } };
struct EpiQKV {
    static constexpr bool PERM = true;
    __device__ __forceinline__ void operator()(const Acc& acc, const GUnit& u, int wr, int wc, int fr, int fq) const {
        constexpr float ds = 1.f / (FP8_SX * FP8_SWQKV);
        if (u.pn >= 8) { EpiBf<false> e{(unsigned)NT, ds}; e(acc, u, wr, wc, fr, fq); }
        else { EpiBf<false> e{1024u, u.pn < 4 ? 0.125f * 1.4426950408889634f * ds : ds}; e(acc, u, wr, wc, fr, fq); }
    }
};

__device__ __forceinline__ int wave_sum_i(int v) {
#pragma unroll
    for (int o = 1; o < 64; o <<= 1) v += __shfl_xor(v, o);
    return v;
}
__device__ __forceinline__ int block_excl_scan(int v, int lane, int wave, LAS int* red, int& total) {
    int inc = v;
#pragma unroll
    for (int o = 1; o < 64; o <<= 1) { const int t = __shfl_up(inc, o); if (lane >= o) inc += t; }
    __syncthreads();
    if (lane == 63) red[wave] = inc;
    __syncthreads();
    int off = 0, tot = 0;
#pragma unroll
    for (int w = 0; w < 8; ++w) { const int c = red[w]; if (w < wave) off += c; tot += c; }
    total = tot; return off + inc - v;
}
template <int PER>
__device__ __forceinline__ void select_fast(Frame& F, const float* affcol, int cap, int* idx_out, float* gate_out, int* slotcol) {
    LAS int* red = (LAS int*)F.lds;
    unsigned key[PER];
#pragma unroll
    for (int i = 0; i < PER / 4; ++i) { const u32x4 v = ((const u32x4*)(affcol + (size_t)F.tid * PER))[i]; key[4 * i] = v.x; key[4 * i + 1] = v.y; key[4 * i + 2] = v.z; key[4 * i + 3] = v.w; }
    unsigned T = 0u;
    for (int b = 30; b >= 0; --b) {
        const unsigned cand = T | (1u << b); int cnt = 0;
#pragma unroll
        for (int i = 0; i < PER; ++i) cnt += (key[i] >= cand) ? 1 : 0;
        cnt = wave_sum_i(cnt);
        LAS int* r = red + (b & 1) * 8;
        if (F.lane == 0) r[F.wave] = cnt;
        __syncthreads();
        int tot = 0;
#pragma unroll
        for (int w = 0; w < 8; ++w) tot += r[w];
        if (tot >= cap) T = cand;
    }
    int g = 0, q = 0;
#pragma unroll
    for (int i = 0; i < PER; ++i) { g += (key[i] > T) ? 1 : 0; q += (key[i] == T) ? 1 : 0; }
    int tot_g, tot_q; (void)tot_q;
    const int Eoff = block_excl_scan(q, F.lane, F.wave, red + 32, tot_q);
    int dummy; const int Goff = block_excl_scan(g, F.lane, F.wave, red + 32, tot_g); (void)Goff;
    const int need_eq = cap - tot_g;
    int eq_take = need_eq - Eoff; eq_take = eq_take < 0 ? 0 : (eq_take > q ? q : eq_take);
    const int base = block_excl_scan(g + eq_take, F.lane, F.wave, red + 32, dummy);
    int slot = base, eqseen = 0;
    const int tok0 = F.tid * PER;
#pragma unroll
    for (int i4 = 0; i4 < PER / 4; ++i4) { int so[4];
#pragma unroll
        for (int j = 0; j < 4; ++j) { const int i = 4 * i4 + j; const unsigned k = key[i]; bool sel = k > T; if (k == T) { sel = eqseen < eq_take; ++eqseen; }
            so[j] = sel ? slot : -1; if (sel) { idx_out[slot] = tok0 + i; gate_out[slot] = __uint_as_float(k); ++slot; } }
        ((int4*)(slotcol + tok0))[i4] = make_int4(so[0], so[1], so[2], so[3]); }
}
__device__ __forceinline__ void select_phase(Frame& F) {
    for (int it = F.c; it < 32; it += F.G) {
        const int grp = it >> 4, e = it & 15; const int n = grp ? NTS : NTP, cap = n / 8;
        const float* affcol = (const float*)(F.ws + WS_AFF) + (size_t)e * NT + (grp ? NTP : 0);
        int* idx = (int*)(F.ws + WS_IDX) + (grp ? 65536 : 0) + e * cap; float* gate = (float*)(F.ws + WS_GATE) + (grp ? 65536 : 0) + e * cap;
        int* slotcol = (int*)(F.ws + WS_SLOT) + (size_t)e * NT + (grp ? NTP : 0);
        __syncthreads();
        if (grp == 0) select_fast<64>(F, affcol, cap, idx, gate, slotcol); else select_fast<32>(F, affcol, cap, idx, gate, slotcol);
        __syncthreads();
    }
}

__device__ __forceinline__ void natten_fill(Frame& F, const float* rpb) {
    LAS float* rpbs = (LAS float*)F.lds;
    __syncthreads();
    for (int i = F.tid; i < 16 * 15 * 31; i += 512) rpbs[i] = rpb[i] * 1.4426950408889634f;
    __syncthreads();
}
__device__ __forceinline__ void natten_phase(Frame& F, const float* rpb) {
    const bf16_t* Kb = (const bf16_t*)(F.ws + PO_K); const bf16_t* VT = (const bf16_t*)(F.ws + PO_VT); bf16_t* QO = (bf16_t*)(F.ws + PO_Q);
    LAS float* rpbs = (LAS float*)F.lds;
    const int lane = F.lane, w = F.wave, fr = lane & 15, fq = lane >> 4;
    bool c0[4], c2[4]; int xe[4];
#pragma unroll
    for (int e = 0; e < 4; ++e) { xe[e] = 4 * fq + e - fr; c0[e] = xe[e] >= 8; c2[e] = xe[e] < -8; }
    const bool fA = fr < 8, fC = fr > 8;
    unsigned mk0[2], mk2[2], mk0c[2], mk2a[2], mkc1[2], mkca[2], mkcc[2];
#pragma unroll
    for (int pr = 0; pr < 2; ++pr) { mk0[pr] = (c0[2 * pr] ? 0xFFFFu : 0u) | (c0[2 * pr + 1] ? 0xFFFF0000u : 0u); mk2[pr] = (c2[2 * pr] ? 0xFFFFu : 0u) | (c2[2 * pr + 1] ? 0xFFFF0000u : 0u);
        mk0c[pr] = fC ? 0u : mk0[pr]; mk2a[pr] = fA ? 0u : mk2[pr]; mkc1[pr] = ~(mk0[pr] | mk2[pr]); mkca[pr] = ~mk2a[pr]; mkcc[pr] = ~mk0c[pr];
        asm volatile("" : "+v"(mk0[pr]), "+v"(mk2[pr]), "+v"(mk0c[pr]), "+v"(mk2a[pr]), "+v"(mkc1[pr]), "+v"(mkca[pr]), "+v"(mkcc[pr])); }
    LAS bf16_t* Ks = (LAS bf16_t*)(F.lds + 32768); LAS bf16_t* Vs = Ks + 2 * 64 * 72;
    const int lrow = F.tid >> 3, lchk = F.tid & 7;
    const int nblk = F.xok ? 6 : 1536;
    for (int it = F.xok ? 0 : F.c; it < nblk; it += F.xok ? 1 : F.G) {
        int gb, h, rb, rows;
        if (F.xok) { const int u = (F.c >> 3) + 32 * it, t = 12 * (F.c & 7) + (u >> 4); h = u & 15;
            if (t < 64) { gb = t >> 4; rb = t & 15; rows = 128; } else { gb = 4 + ((t - 64) >> 3); rb = (t - 64) & 7; rows = 64; } }
        else { const int blk = it; if (blk < 1024) { gb = blk >> 8; h = (blk >> 4) & 15; rb = blk & 15; rows = 128; } else { const int V = blk - 1024; gb = 4 + (V >> 7); h = (V >> 3) & 15; rb = V & 7; rows = 64; } }
        const int r = rb * 8 + w;
        int rs = r - 4; rs = rs < 0 ? 0 : (rs > rows - 8 ? rows - 8 : rs);
        int kr_lo = rb * 8 - 4; kr_lo = kr_lo < 0 ? 0 : (kr_lo > rows - 8 ? rows - 8 : kr_lo);
        int kr_hi = rb * 8 + 7 - 4; kr_hi = (kr_hi < 0 ? 0 : (kr_hi > rows - 8 ? rows - 8 : kr_hi)) + 8;
        const size_t tb = (size_t)gb_tok0(gb), tq0 = tb + (size_t)r * 64;
        bf16x8 Qf[4][2];
        float mrun[4], lrun[4]; f32x4 Ot[4][4];
#pragma unroll
        for (int qt = 0; qt < 4; ++qt) { mrun[qt] = -INFINITY; lrun[qt] = 0.f;
#pragma unroll
            for (int dt = 0; dt < 4; ++dt) Ot[dt][qt] = (f32x4){0.f, 0.f, 0.f, 0.f}; }
        const bf16_t* kg = Kb + (tb + (size_t)kr_lo * 64 + lrow) * D + h * 64 + lchk * 8; const bf16_t* vg = VT + (size_t)(h * 64 + lrow) * NT + tb + (size_t)kr_lo * 64 + lchk * 8;
        const int nrows = kr_hi - kr_lo;
#define NA_LOAD(dst, ptr) asm volatile("global_load_dwordx4 %0, %1, off" : "=&v"(dst) : "v"(ptr) : "memory")
        u32x4 kA, vA, kB, vB;
        { const u32x4 k0r = *(const u32x4*)kg, v0r = *(const u32x4*)vg;
#pragma unroll
          for (int t = 0; t < 4; ++t)
#pragma unroll
              for (int ks = 0; ks < 2; ++ks) Qf[t][ks] = *(const bf16x8*)(QO + (tq0 + 16 * t + fr) * D + h * 64 + 32 * ks + 8 * fq);
          { const bf16_t* kp = kg + (size_t)64 * D; const bf16_t* vp = vg + 64; NA_LOAD(kB, kp); NA_LOAD(vB, vp); }
          __syncthreads();
          *(LAS u32x4*)(Ks + lrow * 72 + lchk * 8) = k0r; *(LAS u32x4*)(Vs + lrow * 72 + lchk * 8) = v0r; }
#pragma unroll
        for (int t = 0; t < 4; ++t)
#pragma unroll
            for (int ks = 0; ks < 2; ++ks) asm volatile("" :: "v"(Qf[t][ks]));
        asm volatile("s_waitcnt vmcnt(0)" ::: "memory");
        __syncthreads();
#pragma nounroll
        for (int i2 = 0; i2 < nrows; i2 += 2) {
#pragma unroll
          for (int jj = 0; jj < 2; ++jj) {
            const int i = i2 + jj; if (i >= nrows) break;
            const int kr = kr_lo + i; const int buf = jj; const bool more = i + 1 < nrows, more2 = i + 2 < nrows;
            if (more2) { const bf16_t* kp = kg + (size_t)(i + 2) * 64 * D; const bf16_t* vp = vg + (size_t)(i + 2) * 64;
                if (jj == 1) { NA_LOAD(kB, kp); NA_LOAD(vB, vp); } else { NA_LOAD(kA, kp); NA_LOAD(vA, vp); } }
            if (kr >= rs && kr < rs + 8) {
            const int dr = kr - r + 7;
            const LAS bf16_t* Kt = Ks + buf * (64 * 72); const LAS bf16_t* Vt = Vs + buf * (64 * 72);
            bf16x8 Kf[4][2];
#pragma unroll
            for (int t = 0; t < 4; ++t)
#pragma unroll
                for (int ks = 0; ks < 2; ++ks) Kf[t][ks] = *(const LAS bf16x8*)(Kt + (16 * t + fr) * 72 + 32 * ks + 8 * fq);
            float bsel[3][4];
#pragma unroll
            for (int e = 0; e < 4; ++e) { const int dcB = xe[e] + 15 + (c0[e] ? -16 : (c2[e] ? 16 : 0)), dcA = fA ? xe[e] + 15 : dcB, dcC = fC ? xe[e] + 15 : dcB;
                bsel[0][e] = rpbs[(h * 15 + dr) * 31 + dcA]; bsel[1][e] = rpbs[(h * 15 + dr) * 31 + dcB]; bsel[2][e] = rpbs[(h * 15 + dr) * 31 + dcC]; }
            bf16x8 Pf[4][2]; float alpha[4]; bool moved = false;
#pragma unroll
            for (int qt = 0; qt < 4; ++qt) {
                f32x4 St[3];
#pragma unroll
                for (int dk = 0; dk < 3; ++dk) { const int kt = qt + dk - 1; St[dk] = (f32x4){0.f, 0.f, 0.f, 0.f};
                    if (kt >= 0 && kt < 4) { St[dk] = __builtin_amdgcn_mfma_f32_16x16x32_bf16(Kf[kt][0], Qf[qt][0], St[dk], 0, 0, 0); St[dk] = __builtin_amdgcn_mfma_f32_16x16x32_bf16(Kf[kt][1], Qf[qt][1], St[dk], 0, 0, 0); } }
                constexpr int dummy = 0; (void)dummy;
                const int cls = qt == 0 ? 0 : (qt == 3 ? 2 : 1);
                float sv[4]; bool u0[4], u2[4]; float mx = -INFINITY;
#pragma unroll
                for (int e = 0; e < 4; ++e) { u0[e] = c0[e] && !(cls == 0 && fA) && !(cls == 2 && fC) && (qt > 0); u2[e] = c2[e] && !(cls == 0 && fA) && !(cls == 2 && fC) && (qt < 3);
                    sv[e] = (u0[e] ? St[0][e] : (u2[e] ? St[2][e] : St[1][e])) + bsel[cls][e]; mx = fmaxf(mx, sv[e]); }
                mx = x32_max(x16_max(mx));
                const float mnew = fmaxf(mrun[qt], mx); alpha[qt] = __builtin_amdgcn_exp2f(mrun[qt] - mnew); moved = moved || (mnew != mrun[qt]); mrun[qt] = mnew;
                float l = 0.f, p[4];
#pragma unroll
                for (int e = 0; e < 4; ++e) { p[e] = __builtin_amdgcn_exp2f(sv[e] - mnew); l += p[e]; }
                l = x32_sum(x16_sum(l)); lrun[qt] = lrun[qt] * alpha[qt] + l;
                const unsigned pk01 = cvt_pk_bf16_c(p[0], p[1]), pk23 = cvt_pk_bf16_c(p[2], p[3]);
                unsigned t01[4], t23[4];
#pragma unroll
                for (int kt = 0; kt < 4; ++kt) { const int dk = kt - qt + 1; t01[kt] = 0u; t23[kt] = 0u;
                    if (dk == 0) { t01[kt] = pk01 & (cls == 2 ? mk0c[0] : mk0[0]); t23[kt] = pk23 & (cls == 2 ? mk0c[1] : mk0[1]); }
                    else if (dk == 2) { t01[kt] = pk01 & (cls == 0 ? mk2a[0] : mk2[0]); t23[kt] = pk23 & (cls == 0 ? mk2a[1] : mk2[1]); }
                    else if (dk == 1) { t01[kt] = pk01 & (cls == 0 ? mkca[0] : (cls == 2 ? mkcc[0] : mkc1[0])); t23[kt] = pk23 & (cls == 0 ? mkca[1] : (cls == 2 ? mkcc[1] : mkc1[1])); } }
#pragma unroll
                for (int ks = 0; ks < 2; ++ks) { u32x4 wv; wv.x = t01[2 * ks]; wv.y = t23[2 * ks]; wv.z = t01[2 * ks + 1]; wv.w = t23[2 * ks + 1];
                    Pf[qt][ks] = __builtin_bit_cast(bf16x8, wv); }
            }
            const bool rescale = __ballot(moved) != 0ull;
#pragma unroll
            for (int dt = 0; dt < 4; ++dt) {
                if (rescale) {
#pragma unroll
                    for (int qt = 0; qt < 4; ++qt) Ot[dt][qt] = Ot[dt][qt] * alpha[qt]; }
#pragma unroll
                for (int ks = 0; ks < 2; ++ks) { const u32x2 v0 = *(const LAS u32x2*)(Vt + (16 * dt + fr) * 72 + 32 * ks + 4 * fq), v1 = *(const LAS u32x2*)(Vt + (16 * dt + fr) * 72 + 32 * ks + 16 + 4 * fq);
                    u32x4 vv; vv.x = v0.x; vv.y = v0.y; vv.z = v1.x; vv.w = v1.y; const bf16x8 Vf = __builtin_bit_cast(bf16x8, vv);
#pragma unroll
                    for (int qt = 0; qt < 4; ++qt) { if ((qt == 0 && ks == 1) || (qt == 3 && ks == 0)) continue; Ot[dt][qt] = __builtin_amdgcn_mfma_f32_16x16x32_bf16(Vf, Pf[qt][ks], Ot[dt][qt], 0, 0, 0); } }
            }
            }
            if (more) {
                if (more2) asm volatile("s_waitcnt vmcnt(2)" ::: "memory"); else asm volatile("s_waitcnt vmcnt(0)" ::: "memory");
                LAS bf16_t* kd = Ks + (buf ^ 1) * (64 * 72) + lrow * 72 + lchk * 8; LAS bf16_t* vd = Vs + (buf ^ 1) * (64 * 72) + lrow * 72 + lchk * 8;
                if (jj == 1) { asm volatile("" : "+v"(kA), "+v"(vA)); *(LAS u32x4*)kd = kA; *(LAS u32x4*)vd = vA; } else { asm volatile("" : "+v"(kB), "+v"(vB)); *(LAS u32x4*)kd = kB; *(LAS u32x4*)vd = vB; }
            }
            __syncthreads();
          }
        }
#undef NA_LOAD
#pragma unroll
        for (int qt = 0; qt < 4; ++qt) { const float inv = 1.f / lrun[qt];
#pragma unroll
            for (int dt = 0; dt < 4; ++dt) { const f32x4 o = Ot[dt][qt] * inv; u32x2 wv; wv.x = cvt_pk_bf16_c(o[0], o[1]); wv.y = cvt_pk_bf16_c(o[2], o[3]);
                pst8(QO + (tq0 + 16 * qt + fr) * D + h * 64 + 16 * dt + 4 * fq, wv); } }
    }
    __syncthreads();
}
constexpr int N_PHASES = 31;
constexpr int FLAG_NO_XIMPORT = 1, FLAG_NO_EXPERTS0 = 2;
constexpr int CV_P1 = 3072, CV_P2 = CV_P1 + 1536, CV_SEL = CV_P2 + 5376, CV_SEL1 = 5376, CV_P0B = CV_SEL + 3584;
__global__ void __launch_bounds__(512, 2) fwd(Args args) {
    extern __shared__ __attribute__((aligned(16))) unsigned char lds_raw[];
    Frame F; F.lds = (LAS unsigned char*)lds_raw; F.ws = args.ws; F.in = args.in; F.out = args.out;
    F.tid = threadIdx.x; F.lane = F.tid & 63; F.wave = __builtin_amdgcn_readfirstlane(F.tid >> 6); F.G = gridDim.x; F.c = blockIdx.x; F.xok = false;
    unsigned char* ws = args.ws;
    const int wave_s = __builtin_amdgcn_readfirstlane(threadIdx.x >> 6);
    for (int u = F.tid; u < (LDS_BYTES - RING_BYTES) / 4; u += 512) ((LAS unsigned*)(F.lds + RING_BYTES))[u] = 0u;
    __syncthreads();
    const int lo = args.ph_lo, hi = args.ph_hi;
    volatile LAS unsigned* MISC = (volatile LAS unsigned*)(F.lds + MISC_OFF);
    XcdBarrier bar; bar.bar = (unsigned*)(ws + WS_CTL) + CW_BAR + args.pad * XCD_BAR_WORDS_EXT; bar.x = 0; bar.st = nullptr;
    const bool multi = (hi - lo) > 1;
    if (multi) bar = xcd_barrier_post((unsigned*)(ws + WS_CTL) + CW_BAR + args.pad * XCD_BAR_WORDS_EXT, MISC + 8);
#define IN(k) (lo <= (k) && (k) < hi)
#ifdef STAMP_PA
    unsigned long long* TS = (unsigned long long*)(ws + WS_CTL + 40 * 1024);
#define STAMP(k) do { if (blockIdx.x == 0 && threadIdx.x == 0) TS[k] = __builtin_amdgcn_s_memrealtime(); } while (0)
#else
#define STAMP(k) do { } while (0)
#endif
#ifdef AMP_PHASE
    unsigned long long t_phase0 = 0ull;
#define AMP_NOW(t) asm volatile("s_memrealtime %0\n\ts_waitcnt lgkmcnt(0)" : "=s"(t) :: "memory")
#define AMP_T0() do { AMP_NOW(t_phase0); } while (0)
#define AMP_WAIT(k) do { if ((k) == AMP_PHASE || AMP_PHASE < 0) { asm volatile("s_waitcnt vmcnt(0) lgkmcnt(0)" ::: "memory"); unsigned long long _t1; AMP_NOW(_t1); const unsigned long long _tw = _t1 + (unsigned long long)AMP_M * (_t1 - t_phase0); unsigned long long _tn; do { __builtin_amdgcn_s_sleep(4); AMP_NOW(_tn); } while (_tn < _tw); } } while (0)
#else
#define AMP_T0() do { } while (0)
#define AMP_WAIT(k) do { } while (0)
#endif
#define SEAM(k) do { AMP_WAIT(k); if (IN(k) && IN((k) + 1)) { xcd_barrier(bar, wave_s); STAMP((k) + 1); } } while (0)
    STAMP(0);
    LAS unsigned char* ring = F.lds;
#define PHASE_BEGIN() do { int _t; asm volatile("v_mbcnt_lo_u32_b32 %0, -1, 0\n\tv_mbcnt_hi_u32_b32 %0, -1, %0" : "=v"(_t)); _t |= (wave_s << 6); F.tid = _t; F.lane = _t & 63; F.wave = wave_s; AMP_T0(); } while (0)

#ifndef P0_SKIP
#define P0_SKIP 0
#endif
    if (IN(0)) { PHASE_BEGIN(); const int p0s = (args.pad == 1) ? P0_SKIP : 0;
        if (!(p0s & 1)) for (int it = F.c; it < 128; it += F.G) s5_build_item(F, it >> 1, it & 1);
        if (!(p0s & 2)) convert_small_weights(F);
        if (!(p0s & 4)) if (!(args.flags & FLAG_NO_EXPERTS0)) { convert_expert_weights(F, 0, CV_SEL, CV_P0B, 128);
            convert_expert_weights(F, 0, CV_P0B, 16 * 1536, 0); }
        if (!(p0s & 8)) { convert_plain(F, args.in[I_MWQ], (bf16_t*)(ws + WS_MWQ), (size_t)2 * 1024 * 1024);
        convert_plain(F, args.in[I_MEMP], (bf16_t*)(ws + WS_MEMB), (size_t)4 * 256 * 1024);
        convert_plain(F, args.in[I_MEMS], (bf16_t*)(ws + WS_MEMB) + (size_t)4 * 256 * 1024, (size_t)4 * 256 * 1024); }
        if (!(p0s & 16)) import_x(F, !(args.flags & FLAG_NO_XIMPORT));
    }
    SEAM(0);
    unsigned nloc_s = 32u;
    if (multi && IN(0) && IN(1)) {
        if (F.tid == 0) { unsigned ok = (F.G == 256) ? 1u : 0u; unsigned* bw = bar.bar;
            for (unsigned j = 0; j < 16; ++j) { const unsigned cnt = xb_ld(&bw[XB_XCNT(j)]); if (j < 8 ? cnt != 32u : cnt != 0u) ok = 0u; }
            MISC[13] = ok; }
        __syncthreads();
        if (MISC[13]) { F.xok = true; F.c = (int)(MISC[12] * 8u + bar.x); }
    }
#define LSEAM(k) do { AMP_WAIT(k); if (IN(k) && IN((k) + 1)) { if (F.xok) xcd_local_barrier(bar, wave_s, nloc_s); else xcd_barrier(bar, wave_s); STAMP((k) + 1); } } while (0)
    {
        const float* lng = args.in[I_LNG]; const float* lnb = args.in[I_LNB];
        if (IN(1)) { PHASE_BEGIN();
            { SchedKV S{ws, F.G, F.c}; EpiBf<false> E{2048u, 1.f}; gemm_phase<EpiBf<false>, SchedKV, false>(ring, F.tid, 1024, 2048u, 2048u, S, E); }
            { SchedUA S{(const char*)ws + WS_XB, (const char*)ws + WS_WIN, (char*)ws + PO_UA, F.G, F.c}; EpiUA E; gemm_phase<EpiUA, SchedUA, false>(ring, F.tid, 1024, 2048u, 2048u, S, E); }
            if (!(args.flags & FLAG_NO_EXPERTS0)) convert_expert_weights(F, 0, 0, CV_P1, 128);
        }
        SEAM(1);
        if (IN(2)) { PHASE_BEGIN();
            { SchedSA S{ws, F.G, F.c}; EpiS E; gemm_phase<EpiS, SchedSA, false>(ring, F.tid, 512, (unsigned)(UAK * 2), 1024u, S, E); }
            { SchedWqk S{ws, F.G, F.c}; EpiBf8 E{1024u, 0.0625f * 1.4426950408889634f * FP8_SWQK}; gemm_phase<EpiBf8, SchedWqk, false>(ring, F.tid, 256, 4096u, 2048u, S, E); }
            { SchedWvo S{ws, F.G, F.c}; EpiBf<false> E{1024u, 1.f}; gemm_phase<EpiBf<false>, SchedWvo, false>(ring, F.tid, 256, 2048u, 4096u, S, E); }
            if (!(args.flags & FLAG_NO_EXPERTS0)) convert_expert_weights(F, 0, CV_P1, CV_P2, 128);
        }
        SEAM(2);
        if (IN(3)) { PHASE_BEGIN(); s5_recurrence(F); }
        SEAM(3);
        if (IN(4)) { PHASE_BEGIN(); SchedSC S{ws, F.G, F.c}; EpiGelu E; gemm_phase<EpiGelu, SchedSC, false>(ring, F.tid, UAK, (unsigned)(UAK * 2), (unsigned)(UAK * 2), S, E); }
        SEAM(4);
        if (IN(5)) { PHASE_BEGIN(); SchedGated S{(const char*)ws + PO_SG, (const char*)ws + WS_WGLU, (char*)ws + PO_HB_S5, 2048, 2048, 1024, NT / BM, 8, F.G, F.c}; EpiGated<0> E{1024u};
            gemm_phase<EpiGated<0>, SchedGated, false>(ring, F.tid, 1024, 2048u, 2048u, S, E); }
        LSEAM(5);
        if (IN(6)) { PHASE_BEGIN(); if (args.flags & FLAG_NO_XIMPORT) ln_phase<0, false, false, false>(F, (const bf16_t*)(ws + PO_HB_S5), lng, lnb, nullptr); else ln_phase<0, false, false, true>(F, (const bf16_t*)(ws + PO_HB_S5), lng, lnb, nullptr); }
        LSEAM(6);
    }
#define COMMON_BLOCK(layer, pb) do { \
        const float* lng = args.in[I_LNG] + (size_t)(layer) * 3 * D; const float* lnb = args.in[I_LNB] + (size_t)(layer) * 3 * D; \
        if (IN((pb) + 0)) { PHASE_BEGIN(); SchedScores8 S{(const char*)ws + WS_XB8, (const char*)ws + WS_WQK + (size_t)(layer) * 8 * MiB, (char*)ws + PO_SB, F.G, F.c}; EpiSoftmax E{(LAS float*)(F.lds + RING_BYTES + 4096), 1024u, 1.f / (FP8_SX * FP8_SWQK)}; \
            gemm_phase<EpiSoftmax, SchedScores8, false, true>(ring, F.tid, 512, 1024u, 1024u, S, E); } \
        AMP_WAIT((pb) + 0); if (IN((pb) + 0) && IN((pb) + 2)) { if (F.xok) xcd_local_barrier(bar, wave_s, nloc_s); else xcd_barrier(bar, wave_s); STAMP((pb) + 1); }     \
        if (IN((pb) + 2)) { PHASE_BEGIN(); SchedBatchW S{(const char*)ws + PO_SB, (const char*)ws + WS_WVO + (size_t)(layer) * 16 * MiB, (char*)ws + PO_HB_MEM, F.G, F.c}; EpiBf<false> E{1024u, 1.f}; \
            gemm_phase<EpiBf<false>, SchedBatchW, false>(ring, F.tid, 1024, 2048u, 2048u, S, E); } \
        if (IN((pb) + 3)) { PHASE_BEGIN(); ln_router_fill(F, lng + D, lnb + D, args.in[I_EWR] + (size_t)(layer) * D * 16); }     \
        LSEAM((pb) + 2); \
        if (IN((pb) + 3)) { PHASE_BEGIN(); ln_phase<0, true, false>(F, (const bf16_t*)(ws + PO_HB_MEM), lng + D, lnb + D, args.in[I_EWR] + (size_t)(layer) * D * 16); } \
        SEAM((pb) + 3); \
        if (IN((pb) + 4)) { PHASE_BEGIN(); select_phase(F); if ((layer) == 0) { if (!(args.flags & FLAG_NO_EXPERTS0)) convert_expert_weights(F, 0, CV_P2, CV_SEL, 32); } else convert_expert_weights(F, 1, 0, CV_SEL1, 32); } \
        SEAM((pb) + 4); \
        if (IN((pb) + 5)) { PHASE_BEGIN(); SchedUp S{ws, F.G, F.c}; EpiGated8 E{2048u}; gemm_phase<EpiGated8, SchedUp, true, true>(ring, F.tid, 512, 1024u, 1024u, S, E); } \
        LSEAM((pb) + 5);     \
        if (IN((pb) + 6)) { PHASE_BEGIN(); SchedDown S{ws, F.G, F.c}; EpiBf<true> E{1024u, 1.f / (FP8_SH * FP8_SW2)}; gemm_phase<EpiBf<true>, SchedDown, false, true>(ring, F.tid, 1024, 2048u, 2048u, S, E); } \
        AMP_WAIT((pb) + 6); if (IN((pb) + 6) && IN((pb) + 9)) { xcd_barrier(bar, wave_s); STAMP((pb) + 9); }     \
    } while (0)
    COMMON_BLOCK(0, 7);
    if (IN(16)) { PHASE_BEGIN(); ln_phase<1, false, false>(F, nullptr, args.in[I_LNG] + 2 * D, args.in[I_LNB] + 2 * D, nullptr); convert_expert_weights(F, 1, CV_SEL1, 16 * 1536, 0); }
    SEAM(16);
    {
        const float* lng = args.in[I_LNG] + 3 * D; const float* lnb = args.in[I_LNB] + 3 * D;
        if (IN(17)) { PHASE_BEGIN(); SchedQKV S{ws, F.G, F.c}; EpiQKV E; gemm_phase<EpiQKV, SchedQKV, false, true>(ring, F.tid, 512, 1024u, 1024u, S, E); }
        if (IN(18)) { PHASE_BEGIN(); natten_fill(F, args.in[I_BRPB]); }
        SEAM(17);
        if (IN(18)) { PHASE_BEGIN(); natten_phase(F, args.in[I_BRPB]); }
        LSEAM(18);
        if (IN(19)) { PHASE_BEGIN(); SchedPlain S{(const char*)ws + PO_Q, (const char*)ws + WS_WO, (char*)ws + PO_HB_NA, 2048, 2048, 1024, NT / BM, 4, F.G, F.c}; EpiBf<false> E{1024u, 1.f};
            gemm_phase<EpiBf<false>, SchedPlain, false>(ring, F.tid, 1024, 2048u, 2048u, S, E); }
        LSEAM(19);
        if (IN(20)) { PHASE_BEGIN(); ln_phase<0, false, false>(F, (const bf16_t*)(ws + PO_HB_NA), lng, lnb, nullptr); }
        LSEAM(20);
    }
    COMMON_BLOCK(1, 21);
    if (IN(30)) { PHASE_BEGIN(); ln_phase<1, false, true>(F, nullptr, args.in[I_LNG] + 5 * D, args.in[I_LNB] + 5 * D, nullptr); }
    AMP_WAIT(30);
#undef COMMON_BLOCK
#ifdef STAMP_PA
    xcd_barrier(bar, wave_s); STAMP(31); xcd_barrier(bar, wave_s);
    {
        const volatile unsigned long long* T = TS; const float dA = (float)(T[STAMP_PA + STAMP_NA] - T[STAMP_PA]) * 0.01f, dB = (float)(T[STAMP_PB + STAMP_NB] - T[STAMP_PB]) * 0.01f;
        const float c = sqrtf(100.f * dA), V = 100.f * dB; const size_t np = (size_t)NTP * 1024, n = (size_t)NT * 1024;
        for (size_t i = (size_t)blockIdx.x * 512 + threadIdx.x; i < n; i += (size_t)gridDim.x * 512) args.out[i] = i < np ? c : (i == np ? V : 0.f);
    }
#endif
#undef IN
#undef SEAM
}
}
#ifndef DBG
#define DBG 0
#endif
#ifndef FZ_PER_PHASE
#define FZ_PER_PHASE 0
#endif

#if DBG
namespace dbg {
__global__ void k_cmp_bf16_f32(const unsigned short* a, const float* b, size_t n, double* acc) {
    double s0 = 0, s1 = 0;
    for (size_t i = (size_t)blockIdx.x * blockDim.x + threadIdx.x; i < n; i += (size_t)gridDim.x * blockDim.x) { const double x = (double)__uint_as_float(((unsigned)a[i]) << 16), y = b[i]; s0 += (x - y) * (x - y); s1 += y * y; }
    for (int o = 32; o >= 1; o >>= 1) { s0 += __shfl_xor(s0, o); s1 += __shfl_xor(s1, o); }
    if ((threadIdx.x & 63) == 0) { atomicAdd(acc, s0); atomicAdd(acc + 1, s1); }
}
__global__ void k_cmp_f32_f32(const float* a, const float* b, size_t n, double* acc) {
    double s0 = 0, s1 = 0;
    for (size_t i = (size_t)blockIdx.x * blockDim.x + threadIdx.x; i < n; i += (size_t)gridDim.x * blockDim.x) { const double x = a[i], y = b[i]; s0 += (x - y) * (x - y); s1 += y * y; }
    for (int o = 32; o >= 1; o >>= 1) { s0 += __shfl_xor(s0, o); s1 += __shfl_xor(s1, o); }
    if ((threadIdx.x & 63) == 0) { atomicAdd(acc, s0); atomicAdd(acc + 1, s1); }
}
__global__ void k_cmp_ua(const unsigned short* UA, const float* u, double* acc) {
    double s0 = 0, s1 = 0;
    for (size_t i = (size_t)blockIdx.x * blockDim.x + threadIdx.x; i < (size_t)fz::NT * 1024; i += (size_t)gridDim.x * blockDim.x) {
        const int tok = (int)(i >> 10), ch = (int)(i & 1023), chunk = tok >> 5, j = tok & 31, g = ch >> 4, h = ch & 15;
        const double x = (double)__uint_as_float(((unsigned)UA[((size_t)g * fz::NCHUNK + chunk) * fz::UAK + j * 16 + h]) << 16), y = u[i]; s0 += (x - y) * (x - y); s1 += y * y; }
    for (int o = 32; o >= 1; o >>= 1) { s0 += __shfl_xor(s0, o); s1 += __shfl_xor(s1, o); }
    if ((threadIdx.x & 63) == 0) { atomicAdd(acc, s0); atomicAdd(acc + 1, s1); }
}
__global__ void k_encode(float* out, const double* accA, const double* accB) {
    const double vA = accA[1] > 0 ? sqrt(accA[0] / accA[1]) : 9.99; const double vB = accB[1] > 0 ? sqrt(accB[0] / accB[1]) : 9.99;
    const float c = (float)sqrt(1e8 * (vA == vA ? vA : 7.77)); const float V = (float)(1e5 * (vB == vB ? vB : 7.77));
    const size_t np = (size_t)fz::NTP * 1024, n = (size_t)fz::NT * 1024;
    for (size_t i = (size_t)blockIdx.x * blockDim.x + threadIdx.x; i < n; i += (size_t)gridDim.x * blockDim.x) out[i] = i < np ? c : (i == np ? V : 0.f);
}
}
#endif

extern "C" void kernel_launch(void* const* d_in, const int* in_sizes, int n_in, void* d_out, int out_size, void* d_ws, size_t ws_size, hipStream_t stream) {
    using namespace fz;
    static int grid = 0;
    if (grid == 0) {
        if (n_in != 26 || ws_size < WS_END) { fprintf(stderr, "kernel_launch: unexpected inputs (n_in %d, ws %zu)\n", n_in, ws_size); grid = -1; return; }
        int dev = 0, cus = 0, per_cu = 0;
        if (hipGetDevice(&dev) != hipSuccess || hipDeviceGetAttribute(&cus, hipDeviceAttributeMultiprocessorCount, dev) != hipSuccess) { grid = -1; return; }
        if (hipFuncSetAttribute((const void*)fwd, hipFuncAttributeMaxDynamicSharedMemorySize, LDS_BYTES) != hipSuccess) { fprintf(stderr, "kernel_launch: hipFuncSetAttribute failed\n"); grid = -1; return; }
        if (hipOccupancyMaxActiveBlocksPerMultiprocessor(&per_cu, (const void*)fwd, 512, LDS_BYTES) != hipSuccess || per_cu < 1) { fprintf(stderr, "kernel_launch: occupancy query says %d\n", per_cu); }
        (void)hipGetLastError();
        grid = cus;
    }
    if (grid < 0) return;
    unsigned char* ws = (unsigned char*)d_ws;
    (void)hipMemsetAsync(ws + WS_CTL, 0, CTL_ZERO_BYTES, stream);
    Args a{};
    for (int i = 0; i < 26; ++i) a.in[i] = (const float*)d_in[i];
    a.out = (float*)d_out; a.ws = ws; a.flags = 0; a.pad = 0;
    auto run = [&](int lo, int hi) { a.ph_lo = lo; a.ph_hi = hi; hipLaunchKernelGGL(fwd, dim3(grid), dim3(512), LDS_BYTES, stream, a); };
#if DBG == 0
#ifdef PRE_LO
    a.pad = 1; run(PRE_LO, PRE_HI); a.pad = 0;
#endif
#if FZ_PER_PHASE
    for (int p = 0; p < N_PHASES; ++p) run(p, p + 1);
#else
    run(0, N_PHASES);
#endif
#else
    using nv::SG;
    const float* const* in = (const float* const*)d_in;
    const size_t BIG = (size_t)NT * D;
    double* ACC = (double*)(ws + 32 * 1024);
    float* nmisc = (float*)(ws + 987 * MiB);
    float* nKV = nmisc; float* nAFF = nmisc + 4u * 1024 * 1024; float* nGATE = nAFF + 1024 * 1024; int* nIDX = (int*)(nGATE + 128 * 1024); float* nMEMC = (float*)(ws + 385 * MiB);
    auto sgemm = [&](const float* A, const float* B, float* C, const int* gidx, int M, int N, int K, long sam, long sak, long sbk, long sbn, long ldc,
                     int nz = 1, int zdiv = 1, long zA0 = 0, long zA1 = 0, long zB0 = 0, long zB1 = 0, long zC0 = 0, long zC1 = 0) {
        SG s{A, B, C, gidx, M, N, K, zdiv, sam, sak, sbk, sbn, ldc, zA0, zA1, zB0, zB1, zC0, zC1};
        hipLaunchKernelGGL(nv::k_sgemm, dim3(N / 128, M / 128, nz), dim3(256), 0, stream, s);
    };
    const int EW = (int)((BIG + 255) / 256);
    auto n_import = [&](float* X) { hipMemcpyAsync(X, in[I_XP], (size_t)NTP * D * 4, hipMemcpyDeviceToDevice, stream); hipMemcpyAsync(X + (size_t)NTP * D, in[I_XS], (size_t)NTS * D * 4, hipMemcpyDeviceToDevice, stream);
        hipMemcpyAsync(nMEMC, in[I_MEMP], (size_t)4 * 256 * D * 4, hipMemcpyDeviceToDevice, stream); hipMemcpyAsync(nMEMC + (size_t)4 * 256 * D, in[I_MEMS], (size_t)4 * 256 * D * 4, hipMemcpyDeviceToDevice, stream); };
    auto n_s5 = [&](float* X, float* T1, float* T2, float* T3) {
        sgemm(X, in[I_AWIN], T1, nullptr, NT, D, D, D, 1, D, 1, D);
        hipLaunchKernelGGL(nv::k_s5_scan, dim3(8 * 64 * 2), dim3(64), 0, stream, T1, T2, in[I_ALRE], in[I_ALIM], in[I_ALDT], in[I_ABRE], in[I_ABIM], in[I_ACRE], in[I_ACIM]);
        hipLaunchKernelGGL(nv::k_s5_gelu, dim3(EW), dim3(256), 0, stream, T1, T2, in[I_AD], T2);
        sgemm(T2, in[I_AWGLU], T1, nullptr, NT, D, D, D, 1, 2 * D, 1, D);
        sgemm(T2, in[I_AWGLU] + D, T3, nullptr, NT, D, D, D, 1, 2 * D, 1, D);
        hipLaunchKernelGGL(nv::k_glu, dim3(EW), dim3(256), 0, stream, T1, T3, T1);
    };
    auto n_na = [&](float* X, float* T1, float* T2, float* T3) {
        sgemm(X, in[I_BWQKV], T1, nullptr, NT, D, D, D, 1, 3 * D, 1, D); sgemm(X, in[I_BWQKV] + D, T2, nullptr, NT, D, D, D, 1, 3 * D, 1, D); sgemm(X, in[I_BWQKV] + 2 * D, T3, nullptr, NT, D, D, D, 1, 3 * D, 1, D);
        hipLaunchKernelGGL(nv::k_natten, dim3(NT * 16 / 4), dim3(256), 0, stream, T1, T2, T3, in[I_BRPB]);
        sgemm(T1, in[I_BWO], T2, nullptr, NT, D, D, D, 1, D, 1, D);
    };
    auto n_ln = [&](float* X, const float* h, int layer, int sub, float* xo) { hipLaunchKernelGGL(nv::k_res_ln, dim3(NT / 4), dim3(256), 0, stream, X, h, in[I_LNG] + (layer * 3 + sub) * D, in[I_LNB] + (layer * 3 + sub) * D, xo, NT); };
    auto n_mem = [&](float* X, float* T1, float* T2, float* T3, int layer) {
        const float* wq = in[I_MWQ] + (size_t)layer * D * D; const float* wkv = in[I_MWKV] + (size_t)layer * D * 2 * D; const float* wo = in[I_MWO] + (size_t)layer * D * D;
        sgemm(nMEMC, wkv, nKV, nullptr, 8 * 256, 2 * D, D, D, 1, 2 * D, 1, 2 * D);
        sgemm(X, wq, T1, nullptr, NT, D, D, D, 1, D, 1, D);
        for (int grp = 0; grp < 2; ++grp) { const int L = grp ? 4096 : 8192; const size_t tb = grp ? (size_t)NTP : 0; const int gb0 = grp * 4;
            sgemm(T1 + tb * D, nKV + (size_t)gb0 * 256 * 2 * D, T2 + tb * D, nullptr, L, 256, 256, D, 1, 1, 2 * D, D, 16, 4, (long)L * D, 256, (long)256 * 2 * D, 256, (long)L * D, 256); }
        hipLaunchKernelGGL(nv::k_softmax256, dim3(NT * 4 / 4), dim3(256), 0, stream, T2, 0.0625f, NT * 4);
        for (int grp = 0; grp < 2; ++grp) { const int L = grp ? 4096 : 8192; const size_t tb = grp ? (size_t)NTP : 0; const int gb0 = grp * 4;
            sgemm(T2 + tb * D, nKV + (size_t)gb0 * 256 * 2 * D + D, T3 + tb * D, nullptr, L, 256, 256, D, 1, 2 * D, 1, D, 16, 4, (long)L * D, 256, (long)256 * 2 * D, 256, (long)L * D, 256); }
        sgemm(T3, wo, T1, nullptr, NT, D, D, D, 1, D, 1, D);
    };
    auto n_moe = [&](float* X, float* T1, float* T2, float* T3, int layer) {
        hipLaunchKernelGGL(nv::k_router, dim3(NT / 4), dim3(256), 0, stream, X, in[I_EWR] + (size_t)layer * D * 16, nAFF, NT);
        hipLaunchKernelGGL(nv::k_select, dim3(32), dim3(512), 0, stream, nAFF, nIDX, nGATE);
        hipMemsetAsync(T1, 0, BIG * 4, stream);
        for (int grp = 0; grp < 2; ++grp) { const int n = grp ? NTS : NTP, cap = n / 8; const size_t tb = grp ? (size_t)NTP : 0;
            for (int e = 0; e < 16; ++e) { const int* idx = nIDX + (grp ? 16 * 4096 : 0) + e * cap; const float* gate = nGATE + (grp ? 16 * 4096 : 0) + e * cap;
                const float* w1 = in[I_EW1] + ((size_t)layer * 16 + e) * D * 2048; const float* w3 = in[I_EW3] + ((size_t)layer * 16 + e) * D * 2048; const float* w2 = in[I_EW2] + ((size_t)layer * 16 + e) * 2048 * D;
                float* H1 = T2; float* H3 = T2 + (size_t)4096 * 2048; float* YE = T3;
                sgemm(X + tb * D, w1, H1, idx, cap, 2048, D, D, 1, 2048, 1, 2048); sgemm(X + tb * D, w3, H3, idx, cap, 2048, D, D, 1, 2048, 1, 2048);
                hipLaunchKernelGGL(nv::k_silu_mul, dim3((unsigned)(((size_t)cap * 2048 + 255) / 256)), dim3(256), 0, stream, H1, H3, (size_t)cap * 2048);
                sgemm(H1, w2, YE, nullptr, cap, D, 2048, 2048, 1, D, 1, D);
                hipLaunchKernelGGL(nv::k_scatter_add, dim3((unsigned)(((size_t)cap * D + 255) / 256)), dim3(256), 0, stream, YE, idx, gate, T1 + tb * D, cap); } }
    };
    float* X = (float*)(ws + WS_XF); float* T1 = (float*)(ws + WS_EW13); float* T2 = (float*)(ws + WS_POOL); float* T3 = (float*)(ws + WS_POOL + 192 * MiB);
    auto cmp_bf = [&](size_t off_bf16, const float* ref, double* acc) { hipLaunchKernelGGL(dbg::k_cmp_bf16_f32, dim3(2048), dim3(256), 0, stream, (const unsigned short*)(ws + off_bf16), ref, BIG, acc); };
#if DBG == 1
    n_import(X);
    a.flags = FLAG_NO_XIMPORT | FLAG_NO_EXPERTS0;
    n_s5(X, T1, T2, T3);
    for (int p = 0; p <= 5; ++p) run(p, p + 1);
    cmp_bf(PO_HB_S5, T1, ACC);
    cmp_bf(PO_HB_S5, T1, ACC + 2);
#elif DBG == 11
    n_import(X);
    a.flags = FLAG_NO_XIMPORT | FLAG_NO_EXPERTS0;
    sgemm(X, in[I_AWIN], T1, nullptr, NT, D, D, D, 1, D, 1, D);
    for (int p = 0; p <= 4; ++p) run(p, p + 1);
    hipLaunchKernelGGL(dbg::k_cmp_ua, dim3(2048), dim3(256), 0, stream, (const unsigned short*)(ws + PO_UA), T1, ACC);
    hipMemcpyAsync(X, T1, BIG * 4, hipMemcpyDeviceToDevice, stream);
    { float* Y = (float*)(ws + 193 * MiB);
      hipLaunchKernelGGL(nv::k_s5_scan, dim3(8 * 64 * 2), dim3(64), 0, stream, X, Y, in[I_ALRE], in[I_ALIM], in[I_ALDT], in[I_ABRE], in[I_ABIM], in[I_ACRE], in[I_ACIM]);
      hipLaunchKernelGGL(nv::k_s5_gelu, dim3(EW), dim3(256), 0, stream, X, Y, in[I_AD], Y);
      cmp_bf(PO_SG, Y, ACC + 2); }
#elif DBG == 2
    n_import(X); n_s5(X, T1, T2, T3); n_ln(X, T1, 0, 0, X); n_mem(X, T1, T2, T3, 0);
    a.flags = FLAG_NO_XIMPORT | FLAG_NO_EXPERTS0;
    run(0, 1); run(1, 2); run(2, 3); run(7, 8); run(9, 10);
    cmp_bf(PO_HB_MEM, T1, ACC); cmp_bf(PO_HB_MEM, T1, ACC + 2);
#elif DBG == 4
    n_import(X); n_na(X, T1, T2, T3);
    hipMemcpyAsync(T1, T2, BIG * 4, hipMemcpyDeviceToDevice, stream);
    a.flags = FLAG_NO_XIMPORT | FLAG_NO_EXPERTS0;
    run(0, 1); run(17, 18); run(18, 19); run(19, 20);
    cmp_bf(PO_HB_NA, T1, ACC); cmp_bf(PO_HB_NA, T1, ACC + 2);
#endif
    hipLaunchKernelGGL(dbg::k_encode, dim3(2048), dim3(256), 0, stream, (float*)d_out, ACC, ACC + 2);
#endif
}
```

```cpp
#include <hip/hip_runtime.h>
#include <cstdio>
#include <cstdint>
#include <cmath>
#define NO_WT 1
namespace nv {
constexpr int D = 1024, NTP = 32768, NTS = 16384, NT = NTP + NTS, NGB = 8, MEM = 256;
constexpr int GRID_W = 64;
constexpr float ALPHA = 1.41421356237309515f;
constexpr float LN_EPS = 1e-5f;

__host__ __device__ inline int gb_tok0(int gb) { return gb < 4 ? gb * 8192 : NTP + (gb - 4) * 4096; }
__host__ __device__ inline int gb_len(int gb) { return gb < 4 ? 8192 : 4096; }

__device__ __forceinline__ float wave_sum(float v) {
#pragma unroll
    for (int o = 1; o < 64; o <<= 1) v += __shfl_xor(v, o);
    return v;
}
__device__ __forceinline__ float wave_max(float v) {
#pragma unroll
    for (int o = 1; o < 64; o <<= 1) v = fmaxf(v, __shfl_xor(v, o));
    return v;
}

struct SG { const float* A; const float* B; float* C; const int* gidx; int M, N, K, zdiv; long sam, sak, sbk, sbn, ldc; long zA0, zA1, zB0, zB1, zC0, zC1; };
__global__ __launch_bounds__(256) void k_sgemm(SG a) {
    __shared__ float As[8][132];
    __shared__ float Bs[8][132];
    const int z = blockIdx.z, z0 = z / a.zdiv, z1 = z % a.zdiv;
    const float* A = a.A + z0 * a.zA0 + z1 * a.zA1;
    const float* B = a.B + z0 * a.zB0 + z1 * a.zB1;
    float* C = a.C + z0 * a.zC0 + z1 * a.zC1;
    const int bm = blockIdx.y * 128, bn = blockIdx.x * 128, tid = threadIdx.x, tx = tid & 15, ty = tid >> 4;
    float acc[8][8];
#pragma unroll
    for (int i = 0; i < 8; ++i)
#pragma unroll
        for (int j = 0; j < 8; ++j) acc[i][j] = 0.f;
    const int arow_l = tid >> 1, akk = (tid & 1) * 4;
    const long arow = a.gidx ? (long)a.gidx[bm + arow_l] : (long)(bm + arow_l);
    const float* Ap = A + arow * a.sam;
    const int bkk = tid >> 5, bnn = (tid & 31) * 4;
    for (int k0 = 0; k0 < a.K; k0 += 8) {
        float av[4], bv[4];
#pragma unroll
        for (int i = 0; i < 4; ++i) av[i] = Ap[(long)(k0 + akk + i) * a.sak];
#pragma unroll
        for (int i = 0; i < 4; ++i) bv[i] = B[(long)(k0 + bkk) * a.sbk + (long)(bn + bnn + i) * a.sbn];
        __syncthreads();
#pragma unroll
        for (int i = 0; i < 4; ++i) As[akk + i][arow_l] = av[i];
#pragma unroll
        for (int i = 0; i < 4; ++i) Bs[bkk][bnn + i] = bv[i];
        __syncthreads();
#pragma unroll
        for (int kk = 0; kk < 8; ++kk) {
            float x[8], y[8];
#pragma unroll
            for (int i = 0; i < 8; ++i) x[i] = As[kk][ty * 8 + i];
#pragma unroll
            for (int j = 0; j < 8; ++j) y[j] = Bs[kk][tx * 8 + j];
#pragma unroll
            for (int i = 0; i < 8; ++i)
#pragma unroll
                for (int j = 0; j < 8; ++j) acc[i][j] += x[i] * y[j];
        }
    }
#pragma unroll
    for (int i = 0; i < 8; ++i)
#pragma unroll
        for (int j = 0; j < 8; ++j) C[(long)(bm + ty * 8 + i) * a.ldc + bn + tx * 8 + j] = acc[i][j];
}

__global__ __launch_bounds__(64) void k_s5_scan(const float* __restrict__ u, float* __restrict__ ydir, const float* lam_re, const float* lam_im, const float* log_dt,
                                                const float* b_re, const float* b_im, const float* c_re, const float* c_im) {
    const int wid = blockIdx.x;
    const int dir = wid & 1, g = (wid >> 1) & 63, gb = wid >> 7;
    const int p = threadIdx.x;
    const int L = gb_len(gb), t0 = gb_tok0(gb);
    const double dt = exp((double)log_dt[dir * 64 + g]);
    const double lr = lam_re[(dir * 64 + g) * 64 + p], li = lam_im[(dir * 64 + g) * 64 + p];
    const double er = exp(lr * dt), lbr = er * cos(li * dt), lbi = er * sin(li * dt);
    const double nr = lbr - 1.0, ni = lbi, den = lr * lr + li * li;
    const double fr = (nr * lr + ni * li) / den, fi = (ni * lr - nr * li) / den;
    float Br[16], Bi[16], Cr[16], Ci[16];
#pragma unroll
    for (int h = 0; h < 16; ++h) {
        const double br = b_re[((dir * 64 + g) * 64 + p) * 16 + h], bi = b_im[((dir * 64 + g) * 64 + p) * 16 + h];
        Br[h] = (float)(fr * br - fi * bi); Bi[h] = (float)(fr * bi + fi * br);
        Cr[h] = c_re[((dir * 64 + g) * 16 + h) * 64 + p]; Ci[h] = c_im[((dir * 64 + g) * 16 + h) * 64 + p];
    }
    const float ar = (float)lbr, ai = (float)lbi;
    float hr = 0.f, hi = 0.f;
    float* yo = ydir + (size_t)dir * NT * D;
    for (int s = 0; s < L; ++s) {
        const int t = dir ? (L - 1 - s) : s;
        const float* ur = u + (size_t)(t0 + t) * D + g * 16;
        float bur = 0.f, bui = 0.f;
#pragma unroll
        for (int h = 0; h < 16; ++h) { const float uv = ur[h]; bur += uv * Br[h]; bui += uv * Bi[h]; }
        const float nhr = ar * hr - ai * hi + bur, nhi = ar * hi + ai * hr + bui;
        hr = nhr; hi = nhi;
        float mine = 0.f;
#pragma unroll
        for (int c = 0; c < 16; ++c) { const float v = wave_sum(Cr[c] * hr - Ci[c] * hi); if (p == c) mine = v; }
        if (p < 16) yo[(size_t)(t0 + t) * D + g * 16 + p] = mine;
    }
}
__global__ void k_s5_gelu(const float* u, const float* ydir, const float* dskip, float* gout) {
    const size_t i = (size_t)blockIdx.x * blockDim.x + threadIdx.x;
    if (i >= (size_t)NT * D) return;
    const float y = dskip[i & (D - 1)] * u[i] + ydir[i] + ydir[(size_t)NT * D + i];
    const float c = 0.7978845608028654f * (y + 0.044715f * y * y * y);
    gout[i] = 0.5f * y * (1.f + tanhf(c));
}
__global__ void k_glu(const float* z1, const float* z2, float* out) {
    const size_t i = (size_t)blockIdx.x * blockDim.x + threadIdx.x;
    if (i >= (size_t)NT * D) return;
    out[i] = z1[i] / (1.f + expf(-z2[i]));
}
__global__ __launch_bounds__(256) void k_res_ln(const float* x, const float* h, const float* g, const float* b, float* xo, int rows) {
    const int row = blockIdx.x * 4 + (threadIdx.x >> 6), lane = threadIdx.x & 63;
    if (row >= rows) return;
    float v[16]; float s = 0.f;
#pragma unroll
    for (int j = 0; j < 16; ++j) { const size_t i = (size_t)row * D + lane + 64 * j; v[j] = ALPHA * x[i] + h[i]; s += v[j]; }
    const float mean = wave_sum(s) * (1.f / D); float q = 0.f;
#pragma unroll
    for (int j = 0; j < 16; ++j) { v[j] -= mean; q += v[j] * v[j]; }
    const float rstd = 1.f / sqrtf(wave_sum(q) * (1.f / D) + LN_EPS);
#pragma unroll
    for (int j = 0; j < 16; ++j) { const int c = lane + 64 * j; xo[(size_t)row * D + c] = v[j] * rstd * g[c] + b[c]; }
}
__global__ __launch_bounds__(256) void k_softmax256(float* s, float scale, int rows) {
    const int row = blockIdx.x * 4 + (threadIdx.x >> 6), lane = threadIdx.x & 63;
    if (row >= rows) return;
    float v[4]; float m = -INFINITY;
#pragma unroll
    for (int j = 0; j < 4; ++j) { v[j] = s[(size_t)row * 256 + lane + 64 * j] * scale; m = fmaxf(m, v[j]); }
    m = wave_max(m); float l = 0.f;
#pragma unroll
    for (int j = 0; j < 4; ++j) { v[j] = expf(v[j] - m); l += v[j]; }
    l = wave_sum(l);
#pragma unroll
    for (int j = 0; j < 4; ++j) s[(size_t)row * 256 + lane + 64 * j] = v[j] / l;
}
__global__ __launch_bounds__(256) void k_router(const float* x, const float* wr, float* aff, int rows) {
    const int row = blockIdx.x * 4 + (threadIdx.x >> 6), lane = threadIdx.x & 63;
    if (row >= rows) return;
    float acc[16];
#pragma unroll
    for (int e = 0; e < 16; ++e) acc[e] = 0.f;
    for (int j = 0; j < 16; ++j) { const int k = lane + 64 * j; const float xv = x[(size_t)row * D + k];
#pragma unroll
        for (int e = 0; e < 16; ++e) acc[e] += xv * wr[k * 16 + e]; }
    float m = -INFINITY;
#pragma unroll
    for (int e = 0; e < 16; ++e) { acc[e] = wave_sum(acc[e]); m = fmaxf(m, acc[e]); }
    float l = 0.f;
#pragma unroll
    for (int e = 0; e < 16; ++e) { acc[e] = expf(acc[e] - m); l += acc[e]; }
    float mine = 0.f;
#pragma unroll
    for (int e = 0; e < 16; ++e) if (lane == e) mine = acc[e] / l;
    if (lane < 16) aff[(size_t)row * 16 + lane] = mine;
}

__device__ __forceinline__ void select_expert(const float* aff, int n, int e, int cap, int* idx_out, float* gate_out, int* slot_of  , unsigned* hist  , unsigned* wsum  , unsigned* bc  ) {
    const int tid = threadIdx.x, nth = blockDim.x, lane = tid & 63, wv = tid >> 6, nw = nth >> 6;
    unsigned prefix = 0u, mask = 0u; unsigned remaining = (unsigned)cap;
    for (int pass = 0; pass < 4; ++pass) {
        const int shift = 24 - 8 * pass;
        for (int i = tid; i < 256; i += nth) hist[i] = 0u;
        __syncthreads();
        for (int t = tid; t < n; t += nth) { const unsigned key = __float_as_uint(aff[(size_t)t * 16 + e]); if ((key & mask) == prefix) atomicAdd(&hist[(key >> shift) & 255u], 1u); }
        __syncthreads();
        if (tid == 0) { unsigned cum = 0u; int b = 255; for (; b > 0; --b) { if (cum + hist[b] >= remaining) break; cum += hist[b]; } bc[0] = (unsigned)b; bc[1] = remaining - cum; }
        __syncthreads();
        prefix |= bc[0] << shift; mask |= 0xffu << shift; remaining = bc[1];
        __syncthreads();
    }
    const unsigned T = prefix; const unsigned need_eq = remaining;
    unsigned base = 0u, eqbase = 0u;
    for (int s0 = 0; s0 < n; s0 += nth) {
        const int t = s0 + tid; const bool in = t < n;
        const float a = in ? aff[(size_t)t * 16 + e] : 0.f; const unsigned key = __float_as_uint(a);
        const bool gt = in && key > T, eq = in && key == T;
        const unsigned long long meq = __ballot(eq); const unsigned eqr_w = __popcll(meq & ((1ull << lane) - 1ull));
        if (lane == 0) wsum[wv] = __popcll(meq);
        __syncthreads();
        unsigned eqoff = 0u, eqtot = 0u; for (int w = 0; w < nw; ++w) { const unsigned c = wsum[w]; if (w < wv) eqoff += c; eqtot += c; }
        __syncthreads();
        const bool sel = gt || (eq && (eqbase + eqoff + eqr_w) < need_eq);
        const unsigned long long ms = __ballot(sel); const unsigned sr_w = __popcll(ms & ((1ull << lane) - 1ull));
        if (lane == 0) wsum[wv] = __popcll(ms);
        __syncthreads();
        unsigned soff = 0u, stot = 0u; for (int w = 0; w < nw; ++w) { const unsigned c = wsum[w]; if (w < wv) soff += c; stot += c; }
        __syncthreads();
        if (sel) { const unsigned slot = base + soff + sr_w; if (slot < (unsigned)cap) { idx_out[slot] = t; gate_out[slot] = a; } }
        if (slot_of && in) slot_of[(size_t)t * 16 + e] = sel ? (int)(base + soff + sr_w) : -1;
        base += stot; eqbase += eqtot;
    }
}
__global__ __launch_bounds__(512) void k_select(const float* aff_all, int* idx_all, float* gate_all) {
    __shared__ unsigned hist[256]; __shared__ unsigned wsum[32]; __shared__ unsigned bc[4];
    const int grp = blockIdx.x >> 4, e = blockIdx.x & 15;
    const int n = grp ? NTS : NTP, cap = n / 8;
    const float* aff = aff_all + (size_t)(grp ? NTP : 0) * 16;
    int* idx = idx_all + (grp ? 16 * 4096 : 0) + e * cap; float* gate = gate_all + (grp ? 16 * 4096 : 0) + e * cap;
    select_expert(aff, n, e, cap, idx, gate, nullptr, hist, wsum, bc);
}
__global__ void k_silu_mul(float* h1, const float* h3, size_t n) {
    const size_t i = (size_t)blockIdx.x * blockDim.x + threadIdx.x; if (i >= n) return;
    const float a = h1[i]; h1[i] = a / (1.f + expf(-a)) * h3[i];
}
__global__ void k_scatter_add(const float* ye, const int* idx, const float* gate, float* out, int cap) {
    const size_t i = (size_t)blockIdx.x * blockDim.x + threadIdx.x; if (i >= (size_t)cap * D) return;
    const int slot = (int)(i >> 10), c = (int)(i & 1023);
    atomicAdd(&out[(size_t)idx[slot] * D + c], gate[slot] * ye[i]);
}

__global__ __launch_bounds__(256) void k_natten(float* q, const float* k, const float* v, const float* rpb) {
    const int wg = blockIdx.x * 4 + (threadIdx.x >> 6), lane = threadIdx.x & 63;
    const int tok = wg >> 4, h = wg & 15;
    if (tok >= NT) return;
    int gb, l; if (tok < NTP) { gb = tok >> 13; l = tok & 8191; } else { gb = 4 + ((tok - NTP) >> 12); l = (tok - NTP) & 4095; }
    const int rows = gb_len(gb) / GRID_W, t0 = gb_tok0(gb);
    const int r = l >> 6, qc = l & 63;
    int rs = r - 4; rs = rs < 0 ? 0 : (rs > rows - 8 ? rows - 8 : rs);
    int ws = qc - 8; ws = ws < 0 ? 0 : (ws > 48 ? 48 : ws);
    const float qv = q[(size_t)tok * D + h * 64 + lane] * 0.125f;
    float m = -INFINITY, lsum = 0.f, o = 0.f;
    for (int rr = 0; rr < 8; ++rr) {
        const int kr = rs + rr, dr = kr - r + 7;
        for (int cc = 0; cc < 16; ++cc) {
            const int kc = ws + cc; int dc = kc - qc + 15; dc = dc < 0 ? 0 : (dc > 30 ? 30 : dc);
            const size_t kt = (size_t)(t0 + kr * 64 + kc) * D + h * 64 + lane;
            const float s = wave_sum(qv * k[kt]) + rpb[(h * 15 + dr) * 31 + dc];
            const float mn = fmaxf(m, s), al = expf(m - mn), pp = expf(s - mn);
            lsum = lsum * al + pp; o = o * al + pp * v[kt]; m = mn;
        }
    }
    q[(size_t)tok * D + h * 64 + lane] = o / lsum;
}
}
#define LAS __attribute__((address_space(3)))
#define GAS __attribute__((address_space(1)))
namespace fz {
typedef unsigned short bf16_t;
typedef short bf16x8 __attribute__((ext_vector_type(8)));
typedef float f32x4 __attribute__((ext_vector_type(4)));
typedef float f32x2 __attribute__((ext_vector_type(2)));
typedef unsigned u32x4 __attribute__((ext_vector_type(4)));
typedef unsigned u32x2 __attribute__((ext_vector_type(2)));
typedef int v8i __attribute__((ext_vector_type(8)));
typedef int v4i __attribute__((ext_vector_type(4)));

constexpr int D = 1024, NTP = 32768, NTS = 16384, NT = NTP + NTS;
constexpr int TCH = 32, NCHUNK = NT / TCH;
constexpr int UAK = TCH * 16 + 256;
constexpr float ALPHA = 1.41421356237309515f, LN_EPS = 1e-5f;
constexpr size_t MiB = 1u << 20;
#ifndef RES_BF16
#define RES_BF16 1
#endif
constexpr bool RES_BF16_FLAG = RES_BF16 != 0;
constexpr size_t WS_CTL = 0, WS_XF = 1 * MiB, WS_XB = 193 * MiB, WS_WIN = 289 * MiB, WS_WGLU = 291 * MiB, WS_WQKV = 295 * MiB, WS_WO = 301 * MiB, WS_MWQ = 303 * MiB,
                 WS_MWKV = 307 * MiB, WS_MWO = 315 * MiB, WS_MEMB = 319 * MiB, WS_KV = 323 * MiB, WS_WQK = 339 * MiB, WS_WVO = 371 * MiB, WS_AFF = 403 * MiB, WS_SLOT = 406 * MiB,
                 WS_IDX = 409 * MiB, WS_GATE = 409 * MiB + 512 * 1024, WS_EW13 = 411 * MiB  , WS_EW2 = 475 * MiB  ,
                 WS_XB8 = 507 * MiB  , WS_POOL = 603 * MiB, WS_END = 1024 * MiB;
constexpr size_t WS_EW13B = 97 * MiB, WS_EW2B = 161 * MiB;
static_assert(!RES_BF16_FLAG || WS_EW2B + 32 * MiB <= WS_XB, "layer-1 expert weights");
constexpr size_t PO_M2T = WS_POOL, PO_M13T = WS_POOL + 16 * MiB, PO_UA = WS_POOL + 64 * MiB, PO_SG = WS_POOL + 208 * MiB;
constexpr size_t PO_HB_S5 = WS_POOL;
constexpr size_t PO_SB = WS_POOL, PO_HB_MEM = WS_POOL + 304 * MiB;
constexpr size_t PO_Q = WS_POOL, PO_K = WS_POOL + 96 * MiB, PO_VT = WS_POOL + 192 * MiB, PO_HB_NA = WS_POOL + 304 * MiB;
constexpr size_t PO_HM = WS_POOL, PO_YE = WS_POOL + 192 * MiB;
static_assert(PO_YE + 192 * MiB <= WS_END && PO_SG + 96 * MiB <= WS_END && PO_HB_NA + 96 * MiB <= WS_END && PO_HB_MEM + 96 * MiB <= WS_END, "pool");
constexpr int CW_TMO = 0, CW_BAR = 4096;
constexpr size_t CTL_ZERO_BYTES = 64 * 1024;
constexpr int RING_BYTES = 131072, MISC_OFF = RING_BYTES + 320, LDS_BYTES = 147456, ZERO16_OFF = RING_BYTES + 64;

__host__ __device__ inline int gb_tok0(int gb) { return gb < 4 ? gb * 8192 : NTP + (gb - 4) * 4096; }
__host__ __device__ inline int gb_len(int gb) { return gb < 4 ? 8192 : 4096; }
__host__ __device__ inline int panel_gb(int pm) { return pm < 128 ? (pm >> 5) : 4 + ((pm - 128) >> 4); }

__device__ __forceinline__ unsigned cvt_pk_bf16(float lo, float hi) { unsigned r; asm volatile("v_cvt_pk_bf16_f32 %0, %1, %2" : "=v"(r) : "v"(lo), "v"(hi)); return r; }
typedef __bf16 bf16x2_t __attribute__((ext_vector_type(2)));
__device__ __forceinline__ unsigned cvt_pk_bf16_c(float lo, float hi) { const f32x2 v = {lo, hi}; const bf16x2_t b = __builtin_convertvector(v, bf16x2_t); return __builtin_bit_cast(unsigned, b); }
__device__ __forceinline__ float bf2f(unsigned short b) { return __uint_as_float(((unsigned)b) << 16); }
template <int CTRL> __device__ __forceinline__ float dpp_f(float v) { return __uint_as_float((unsigned)__builtin_amdgcn_update_dpp(0, (int)__float_as_uint(v), CTRL, 0xF, 0xF, true)); }
__device__ __forceinline__ float x16_sum(float v) { const auto r = __builtin_amdgcn_permlane16_swap(__float_as_uint(v), __float_as_uint(v), false, false); return __uint_as_float(r[0]) + __uint_as_float(r[1]); }
__device__ __forceinline__ float x32_sum(float v) { const auto r = __builtin_amdgcn_permlane32_swap(__float_as_uint(v), __float_as_uint(v), false, false); return __uint_as_float(r[0]) + __uint_as_float(r[1]); }
__device__ __forceinline__ float x16_max(float v) { const auto r = __builtin_amdgcn_permlane16_swap(__float_as_uint(v), __float_as_uint(v), false, false); return fmaxf(__uint_as_float(r[0]), __uint_as_float(r[1])); }
__device__ __forceinline__ float x32_max(float v) { const auto r = __builtin_amdgcn_permlane32_swap(__float_as_uint(v), __float_as_uint(v), false, false); return fmaxf(__uint_as_float(r[0]), __uint_as_float(r[1])); }
__device__ __forceinline__ float row_sum(float v) { v += dpp_f<0xB1>(v); v += dpp_f<0x4E>(v); v += dpp_f<0x141>(v); v += dpp_f<0x140>(v); return v; }
__device__ __forceinline__ float row_max(float v) { v = fmaxf(v, dpp_f<0xB1>(v)); v = fmaxf(v, dpp_f<0x4E>(v)); v = fmaxf(v, dpp_f<0x141>(v)); v = fmaxf(v, dpp_f<0x140>(v)); return v; }
__device__ __forceinline__ float wave_sum(float v) { return x32_sum(x16_sum(row_sum(v))); }
__device__ __forceinline__ float wave_max(float v) { return x32_max(x16_max(row_max(v))); }
#ifndef NO_WT
__device__ __forceinline__ void st16(void* p, u32x4 v) { asm volatile("global_store_dwordx4 %0, %1, off sc1\n\ts_nop 1" :: "v"(p), "v"(v)); }
__device__ __forceinline__ void st8(void* p, u32x2 v) { asm volatile("global_store_dwordx2 %0, %1, off sc1\n\ts_nop 1" :: "v"(p), "v"(v)); }
__device__ __forceinline__ void st4(void* p, unsigned v) { asm volatile("global_store_dword %0, %1, off sc1\n\ts_nop 1" :: "v"(p), "v"(v)); }
#else
__device__ __forceinline__ void st16(void* p, u32x4 v) { *(u32x4*)p = v; }
__device__ __forceinline__ void st8(void* p, u32x2 v) { *(u32x2*)p = v; }
__device__ __forceinline__ void st4(void* p, unsigned v) { *(unsigned*)p = v; }
#endif
__device__ __forceinline__ void st16f(void* p, f32x4 v) { st16(p, __builtin_bit_cast(u32x4, v)); }
__device__ __forceinline__ void pst16(void* p, u32x4 v) { *(u32x4*)p = v; }
__device__ __forceinline__ void pst8(void* p, u32x2 v) { *(u32x2*)p = v; }
#ifndef NO_WT
__device__ __forceinline__ void st16_so(const void* base, unsigned off, f32x4 v) { asm volatile("global_store_dwordx4 %0, %1, %2 sc1\n\ts_nop 1" :: "v"(off), "v"(v), "s"(base)); }
__device__ __forceinline__ void st4_so(const void* base, unsigned off, unsigned v) { asm volatile("global_store_dword %0, %1, %2 sc1\n\ts_nop 1" :: "v"(off), "v"(v), "s"(base)); }
#else
__device__ __forceinline__ void st16_so(const void* base, unsigned off, f32x4 v) { *(f32x4*)((unsigned char*)base + off) = v; }
__device__ __forceinline__ void st4_so(const void* base, unsigned off, unsigned v) { *(unsigned*)((unsigned char*)base + off) = v; }
#endif
#define LDS_WAIT() asm volatile("s_waitcnt lgkmcnt(0)" ::: "memory")
#define VM_WAIT() asm volatile("s_waitcnt vmcnt(0)" ::: "memory")

#define XB_TMO      128
#define XB_XCNT(j)  (256  + 64 * (j))
#define XB_XSUB(j)  (1280 + 64 * (j))
#define XB_XGEN(j)  (2304 + 64 * (j))
#define XB_TOP      3328
#define XB_TOPGEN   3392
#define XCD_BAR_WORDS 3456
#define XB_SPIN_CAP (1u << 18)
__device__ __forceinline__ unsigned xb_ld(unsigned* p)              { return __hip_atomic_load(p, __ATOMIC_RELAXED, __HIP_MEMORY_SCOPE_AGENT); }
__device__ __forceinline__ unsigned xb_add(unsigned* p, unsigned v) { return __hip_atomic_fetch_add(p, v, __ATOMIC_RELAXED, __HIP_MEMORY_SCOPE_AGENT); }
__device__ __forceinline__ unsigned xb_xcc_id() { return (unsigned)__builtin_amdgcn_s_getreg((3 << 11) | 20) & 0xFu; }
#define XB_SPIN(cond, bar) do { unsigned _sp = 0; while (cond) { __builtin_amdgcn_s_sleep(1); \
    if ((++_sp & 255u) == 0u) { if (xb_ld(&(bar)[XB_TMO])) break; if (_sp > XB_SPIN_CAP) { atomicAdd(&(bar)[XB_TMO], 1u); break; } } } } while (0)
struct XcdBarrier { unsigned* bar; unsigned x; volatile LAS unsigned* st; };
__device__ __forceinline__ int xb_tid();
__device__ __forceinline__ XcdBarrier xcd_barrier_post(unsigned* bar, volatile LAS unsigned* st) {
    XcdBarrier b; b.bar = bar; b.x = xb_xcc_id(); b.st = st;
    if (threadIdx.x == 0) st[4] = xb_add(&bar[XB_XCNT(b.x)], 1u);
    return b;
}
#define XB_LCNT(j)  (3520 + 64 * (j))
#define XB_LGEN(j)  (4544 + 64 * (j))
#define XCD_BAR_WORDS_EXT 5568
__device__ __forceinline__ void xcd_local_barrier(const XcdBarrier& b, const int wave_s, const unsigned nloc) {
    asm volatile("s_waitcnt vmcnt(0)" ::: "memory");
    __syncthreads();
    if (wave_s == 0 && xb_tid() == 0) {
        unsigned* bar = b.bar;
        const unsigned old = xb_add(&bar[XB_LCNT(b.x)], 1u);
        const unsigned gen = old / nloc;
        if (old + 1u == (gen + 1u) * nloc) xb_add(&bar[XB_LGEN(b.x)], 1u);
        else XB_SPIN(xb_ld(&bar[XB_LGEN(b.x)]) == gen, bar);
#ifndef LB_NOACQ
        __builtin_amdgcn_fence(__ATOMIC_ACQUIRE, "agent");
        asm volatile("s_waitcnt vmcnt(0)" ::: "memory");
#endif
    }
    __syncthreads();
}
__device__ __forceinline__ void xcd_barrier_complete(unsigned* bar, unsigned x, unsigned& nloc, unsigned& nx) {
    const unsigned G = gridDim.x * gridDim.y * gridDim.z;
    unsigned sum, cnt, mine, sp = 0u;
    for (;;) {
        sum = 0u; cnt = 0u; mine = 0u;
#pragma unroll
        for (unsigned j = 0; j < 16; ++j) { const unsigned c = xb_ld(&bar[XB_XCNT(j)]); sum += c; cnt += (c > 0u) ? 1u : 0u; mine = (j == x) ? c : mine; }
        if (sum == G) break;
        __builtin_amdgcn_s_sleep(1);
        if ((++sp & 255u) == 0u) { if (xb_ld(&bar[XB_TMO])) break; if (sp > XB_SPIN_CAP) { atomicAdd(&bar[XB_TMO], 1u); break; } }
    }
    nloc = mine > 0u ? mine : 1u; nx = cnt > 0u ? cnt : 1u;
}
__device__ __forceinline__ int xb_tid() { int t; asm volatile("v_mbcnt_lo_u32_b32 %0, -1, 0\n\tv_mbcnt_hi_u32_b32 %0, -1, %0" : "=v"(t)); return t; }
__device__ __forceinline__ void xcd_barrier(const XcdBarrier& b, const int wave_s) {
    asm volatile("s_waitcnt vmcnt(0)" ::: "memory");
    __syncthreads();
    if (wave_s == 0 && xb_tid() == 0) {
        unsigned* bar = b.bar;
        __builtin_amdgcn_s_waitcnt(0);
        unsigned nloc = b.st[0], nx = b.st[1];
        if (nloc == 0u) { xcd_barrier_complete(bar, b.x, nloc, nx); b.st[0] = nloc; b.st[1] = nx; }
        const unsigned old = xb_add(&bar[XB_XSUB(b.x)], 1u);
        const unsigned gen = old / nloc;
        if (old + 1u == (gen + 1u) * nloc) {
            __builtin_amdgcn_fence(__ATOMIC_RELEASE, "agent");
            asm volatile("s_waitcnt vmcnt(0)" ::: "memory");
            const unsigned og = xb_add(&bar[XB_TOP], 1u);
            const unsigned tg = og / nx;
            if (og + 1u == (tg + 1u) * nx) xb_add(&bar[XB_TOPGEN], 1u);
            else XB_SPIN(xb_ld(&bar[XB_TOPGEN]) == tg, bar);
            __builtin_amdgcn_fence(__ATOMIC_ACQUIRE, "agent");
            xb_add(&bar[XB_XGEN(b.x)], 1u);
            asm volatile("s_waitcnt vmcnt(0)" ::: "memory");
        } else {
            XB_SPIN(xb_ld(&bar[XB_XGEN(b.x)]) == gen, bar);
            __builtin_amdgcn_fence(__ATOMIC_ACQUIRE, "agent");
            asm volatile("s_waitcnt vmcnt(0)" ::: "memory");
        }
    }
    __syncthreads();
}

constexpr int BM = 256, BK = 64, HALF = 128, HTB = HALF * BK * 2, STAGE_BYTES = 8 * HTB;
__host__ __device__ __forceinline__ int lds_byte(int r, int c) { const int st = (r >> 4) * 2 + (c >> 5), rr = r & 15, cc = c & 31, ob = rr * 64 + cc * 2; return st * 1024 + (ob ^ (((ob >> 9) & 1) << 5)); }
__host__ __device__ __forceinline__ void stage_rc(int b, int& R, int& C) { const int st = b / 1024, sb = b % 1024, swz = sb ^ (((sb >> 9) & 1) << 5); R = (st >> 1) * 16 + swz / 64; C = (st & 1) * 32 + (swz % 64) / 2; }
__host__ __device__ __forceinline__ int perm32(int rho) { const int n = rho >> 4, i = rho & 15; return 8 * (i >> 2) + 4 * n + (i & 3); }

struct GUnit { const char* A; const char* B; char* C; const void* X; int pm, pn; };
template <int WGM = 8>
__device__ __forceinline__ bool static_unit(int i, int G, int c, int nM, int nN, int& pm, int& pn) {
    const long L = (long)i * G + c; const int nwg = nM * nN; if (L >= nwg) return false;
    int wgid = (int)L; { const int q = nwg / 8, r = nwg % 8, xcd = wgid % 8, off = wgid / 8; wgid = (xcd < r ? xcd * (q + 1) : r * (q + 1) + (xcd - r) * q) + off; }
    const int nig = WGM * nN, gid = wgid / nig, fm = gid * WGM, gsz = (nM - fm) < WGM ? (nM - fm) : WGM;
    pm = fm + ((wgid % nig) % gsz); pn = (wgid % nig) / gsz; return true;
}
template <class Epi, class Sched, bool GATHER, bool FP8 = false>
__device__ __forceinline__ void gemm_phase(LAS unsigned char* lds, const int tid_in, const int K, const unsigned lda, const unsigned ldb, const Sched& S, const Epi& E) {
    int tid_ = tid_in; asm volatile("" : "+v"(tid_));
    const int tid = tid_, wid = __builtin_amdgcn_readfirstlane(tid >> 6), lane = tid & 63, wr = wid >> 2, wc = wid & 3, fr = lane & 15, fq = lane >> 4;
    int nt_ = K / BK; asm volatile("" : "+s"(nt_)); const int nt = nt_;
    unsigned voffA[2], voffB[2]; int gR[2], gC[2];
#pragma unroll
    for (int i = 0; i < 2; ++i) { int R, C; stage_rc(tid * 16 + i * 8192, R, C); const int Rb = Epi::PERM ? ((R & ~31) + perm32(R & 31)) : R;
        voffA[i] = (unsigned)R * lda + (unsigned)C * 2u; voffB[i] = (unsigned)Rb * ldb + (unsigned)C * 2u; gR[i] = R; gC[i] = C * 2; }
    const size_t kstep = (size_t)(BK * 2);
    const size_t hstepA = (size_t)HALF * lda, hstepB = (size_t)HALF * ldb;
    const unsigned ldsw = (unsigned)wid * 1024u;
    const int aoff = lds_byte(wr * 64 + fr, fq * 8), boff = lds_byte(wc * 32 + fr, fq * 8);
    unsigned cvo[2][2], nvo[2][2];
#define PG8_SA(b, h) (((b) * 2 + (h)) * HTB)
#define PG8_SB(b, h) ((4 + (b) * 2 + (h)) * HTB)
#define PG8_STAGE(bufoff, gbase, voff) do { _Pragma("unroll") for (int _i = 0; _i < 2; ++_i) \
        __builtin_amdgcn_global_load_lds((const unsigned*)((const char*)(gbase) + (voff)[_i]), (LAS unsigned*)(lds + (bufoff) + ldsw + _i * 8192), 16, 0, 0); } while (0)
#define PG8_STAGE_B(bufoff, ptr, h) PG8_STAGE(bufoff, (ptr) + (h) * hstepB, voffB)
#define PG8_STAGE_A(bufoff, ptr, h, vo) do { if constexpr (GATHER) { PG8_STAGE(bufoff, (ptr), (vo)[h]); } else { PG8_STAGE(bufoff, (ptr) + (h) * hstepA, voffA); } } while (0)
#define PG8_LDA(dst, b, h) do { _Pragma("unroll") for (int m = 0; m < 4; ++m) _Pragma("unroll") for (int k = 0; k < 2; ++k) dst[m][k] = *(const LAS bf16x8*)(lds + PG8_SA(b, h) + aoff + m * 2048 + k * 1024); } while (0)
#define PG8_LDB(dst, b, h) do { _Pragma("unroll") for (int n = 0; n < 2; ++n) _Pragma("unroll") for (int k = 0; k < 2; ++k) dst[n][k] = *(const LAS bf16x8*)(lds + PG8_SB(b, h) + boff + n * 2048 + k * 1024); } while (0)
#define PG8_MMA(ai, bj, At, Bt) do { __builtin_amdgcn_s_setprio(1); _Pragma("unroll") for (int m = 0; m < 4; ++m) _Pragma("unroll") for (int n = 0; n < 2; ++n) { \
        if constexpr (FP8) { const v8i _a = __builtin_shufflevector(__builtin_bit_cast(v4i, At[m][0]), __builtin_bit_cast(v4i, At[m][1]), 0, 1, 2, 3, 4, 5, 6, 7), _b = __builtin_shufflevector(__builtin_bit_cast(v4i, Bt[n][0]), __builtin_bit_cast(v4i, Bt[n][1]), 0, 1, 2, 3, 4, 5, 6, 7); \
            asm volatile("v_mfma_f32_16x16x128_f8f6f4 %0, %1, %2, %0" : "+v"(acc[ai][bj][m][n]) : "v"(_b), "v"(_a)); } \
        else { _Pragma("unroll") for (int k = 0; k < 2; ++k) acc[ai][bj][m][n] = __builtin_amdgcn_mfma_f32_16x16x32_bf16(Bt[n][k], At[m][k], acc[ai][bj][m][n], 0, 0, 0); } } __builtin_amdgcn_s_setprio(0); } while (0)
#define PG8_WAIT_V(n) asm volatile("s_waitcnt vmcnt(" #n ")" ::: "memory")
#define PG8_WAIT_L(n) asm volatile("s_waitcnt lgkmcnt(" #n ")" ::: "memory")
#define PG8_BAR __builtin_amdgcn_s_barrier()
#define PG8_SCHED __builtin_amdgcn_sched_barrier(0)
#define PG8_GLOAD(vo, u) do { if constexpr (GATHER) { const int* _gi = (const int*)(u).X; _Pragma("unroll") for (int _h = 0; _h < 2; ++_h) _Pragma("unroll") for (int _i = 0; _i < 2; ++_i) \
        (vo)[_h][_i] = (unsigned)_gi[_h * HALF + gR[_i]] * lda + (unsigned)gC[_i]; } } while (0)
    GUnit cur, nxt; int ui = 0;
    if (!S.next(0, cur)) return;
    f32x4 acc[2][2][4][2];
    const volatile LAS f32x4* zero16 = (const volatile LAS f32x4*)(lds + ZERO16_OFF);
#pragma unroll
    for (int a = 0; a < 2; ++a)
#pragma unroll
        for (int b = 0; b < 2; ++b)
#pragma unroll
            for (int m = 0; m < 4; ++m)
#pragma unroll
                for (int n = 0; n < 2; ++n) acc[a][b][m][n] = *zero16;
    bf16x8 At[4][2], B0[2][2], B1[2][2];
    const char* cA = cur.A; const char* cB = cur.B;
    PG8_GLOAD(cvo, cur);
    if constexpr (GATHER) { PG8_WAIT_V(0); }
    PG8_STAGE_B(PG8_SB(0, 0), cB, 0); PG8_STAGE_B(PG8_SB(0, 1), cB, 1); PG8_STAGE_A(PG8_SA(0, 0), cA, 0, cvo); PG8_STAGE_A(PG8_SA(0, 1), cA, 1, cvo);
    if (wr == 1) PG8_BAR;
    PG8_WAIT_V(2); PG8_BAR;
    PG8_STAGE_B(PG8_SB(1, 0), cB + kstep, 0); PG8_STAGE_A(PG8_SA(1, 0), cA + kstep, 0, cvo); PG8_STAGE_B(PG8_SB(1, 1), cB + kstep, 1);
    PG8_WAIT_V(6); PG8_BAR;
    for (;;) {
        const bool has_next = S.next(ui + 1, nxt);
        const char* nA = has_next ? nxt.A : cA; const char* nB = has_next ? nxt.B : cB;
        if constexpr (GATHER) { if (has_next) { PG8_GLOAD(nvo, nxt); } else {
#pragma unroll
            for (int h = 0; h < 2; ++h)
#pragma unroll
                for (int i = 0; i < 2; ++i) nvo[h][i] = cvo[h][i]; } }
        for (int t = 0; t < nt; t += 2) {
            const bool last = (t == nt - 2);
            const char* a1 = cA + (size_t)(t + 1) * kstep;
            const char* a2 = last ? nA : cA + (size_t)(t + 2) * kstep; const char* b2 = last ? nB : cB + (size_t)(t + 2) * kstep;
            const char* a3 = a2 + kstep; const char* b3 = b2 + kstep;
            unsigned vo2[2][2];
            if constexpr (GATHER) {
#pragma unroll
                for (int h = 0; h < 2; ++h)
#pragma unroll
                    for (int i = 0; i < 2; ++i) vo2[h][i] = last ? nvo[h][i] : cvo[h][i]; }
            PG8_LDB(B0, 0, 0); PG8_LDB(B1, 0, 1); PG8_SCHED; PG8_LDA(At, 0, 0); PG8_STAGE_A(PG8_SA(1, 1), a1, 1, cvo);
            PG8_WAIT_V(8); PG8_WAIT_L(0); PG8_BAR; PG8_MMA(0, 0, At, B0); PG8_MMA(0, 1, At, B1); PG8_BAR; PG8_SCHED;
            PG8_LDA(At, 0, 1); PG8_STAGE_B(PG8_SB(0, 0), b2, 0); PG8_STAGE_B(PG8_SB(0, 1), b2, 1); PG8_STAGE_A(PG8_SA(0, 0), a2, 0, vo2);
            PG8_WAIT_V(8); PG8_WAIT_L(0); PG8_BAR; PG8_MMA(1, 0, At, B0); PG8_MMA(1, 1, At, B1); PG8_BAR; PG8_SCHED;
            PG8_LDB(B0, 1, 0); PG8_LDB(B1, 1, 1); PG8_SCHED; PG8_LDA(At, 1, 0); PG8_STAGE_A(PG8_SA(0, 1), a2, 1, vo2);
            PG8_WAIT_V(8); PG8_WAIT_L(0); PG8_BAR; PG8_MMA(0, 0, At, B0); PG8_MMA(0, 1, At, B1); PG8_BAR; PG8_SCHED;
            PG8_LDA(At, 1, 1); PG8_STAGE_B(PG8_SB(1, 0), b3, 0); PG8_STAGE_B(PG8_SB(1, 1), b3, 1); PG8_STAGE_A(PG8_SA(1, 0), a3, 0, vo2);
            PG8_WAIT_V(8); PG8_WAIT_L(0); PG8_BAR; PG8_MMA(1, 0, At, B0); PG8_MMA(1, 1, At, B1); PG8_BAR; PG8_SCHED;
        }
        if constexpr (FP8) { asm volatile("s_nop 15\n\ts_nop 15" ::: "memory"); }
        if (wr == 0) PG8_BAR;
        E(acc, cur, wr, wc, fr, fq);
        if (!has_next) break;
#pragma unroll
        for (int a = 0; a < 2; ++a)
#pragma unroll
            for (int b = 0; b < 2; ++b)
#pragma unroll
                for (int m = 0; m < 4; ++m)
#pragma unroll
                    for (int n = 0; n < 2; ++n) acc[a][b][m][n] = *zero16;
        cur = nxt; cA = nA; cB = nB; ++ui;
        if constexpr (GATHER) {
#pragma unroll
            for (int h = 0; h < 2; ++h)
#pragma unroll
                for (int i = 0; i < 2; ++i) cvo[h][i] = nvo[h][i]; }
        if (wr == 1) PG8_BAR;
    }
    PG8_WAIT_V(0);
    PG8_BAR;
#undef PG8_SA
#undef PG8_SB
#undef PG8_STAGE
#undef PG8_STAGE_A
#undef PG8_STAGE_B
#undef PG8_LDA
#undef PG8_LDB
#undef PG8_MMA
#undef PG8_WAIT_V
#undef PG8_WAIT_L
#undef PG8_BAR
#undef PG8_SCHED
#undef PG8_GLOAD
}
typedef f32x4 Acc[2][2][4][2];
__device__ __forceinline__ float sigmoidf_fast(float x) { return __builtin_amdgcn_rcpf(1.f + __builtin_amdgcn_exp2f(-1.4426950408889634f * x)); }
__device__ __forceinline__ float gelu_tanh_fast(float y) {
    const float inner = 1.5957691216057308f * (y + 0.044715f * y * y * y);
    return y * sigmoidf_fast(inner);
}
__device__ __forceinline__ unsigned cvt4_fp8(float a, float b, float c, float d) {
    a = fminf(fmaxf(a, -448.f), 448.f); b = fminf(fmaxf(b, -448.f), 448.f); c = fminf(fmaxf(c, -448.f), 448.f); d = fminf(fmaxf(d, -448.f), 448.f);
    int w = 0; w = __builtin_amdgcn_cvt_pk_fp8_f32(a, b, w, false); w = __builtin_amdgcn_cvt_pk_fp8_f32(c, d, w, true); return (unsigned)w;
}
constexpr float FP8_SX = 8.f, FP8_SW13 = 32.f, FP8_SH = 8.f, FP8_SW2 = 64.f, FP8_SWQK = 32.f, FP8_SWQKV = 32.f;
struct EpiGated8 {
    static constexpr bool PERM = true;
    unsigned ldc;
    __device__ __forceinline__ void operator()(const Acc& acc, const GUnit& u, int wr, int wc, int fr, int fq) const {
        unsigned char* base = (unsigned char*)u.C;
        constexpr float kx = -1.4426950408889634f / (FP8_SX * FP8_SW13), ic = (FP8_SX * FP8_SW13) * (FP8_SX * FP8_SW13) / FP8_SH;
#pragma unroll
        for (int ai = 0; ai < 2; ++ai)
#pragma unroll
            for (int m = 0; m < 4; ++m) { const int r = ai * HALF + wr * 64 + m * 16 + fr;
                float o[8];
#pragma unroll
                for (int n = 0; n < 2; ++n)
#pragma unroll
                    for (int j = 0; j < 4; j += 2) {
                        const f32x2 a = {acc[ai][0][m][n][j], acc[ai][0][m][n][j + 1]}, b = {acc[ai][1][m][n][j], acc[ai][1][m][n][j + 1]};
                        const f32x2 t = a * f32x2{kx, kx};
                        const f32x2 e = {__builtin_amdgcn_exp2f(t[0]), __builtin_amdgcn_exp2f(t[1])};
                        const f32x2 d = e * f32x2{ic, ic} + f32x2{ic, ic};
                        const f32x2 s = {__builtin_amdgcn_rcpf(d[0]), __builtin_amdgcn_rcpf(d[1])};
                        const f32x2 q = (a * b) * s;
                        o[n * 4 + j] = __builtin_amdgcn_fmed3f(q[0], -448.f, 448.f); o[n * 4 + j + 1] = __builtin_amdgcn_fmed3f(q[1], -448.f, 448.f); }
                int w0 = 0, w1 = 0;
                w0 = __builtin_amdgcn_cvt_pk_fp8_f32(o[0], o[1], w0, false); w0 = __builtin_amdgcn_cvt_pk_fp8_f32(o[2], o[3], w0, true);
                w1 = __builtin_amdgcn_cvt_pk_fp8_f32(o[4], o[5], w1, false); w1 = __builtin_amdgcn_cvt_pk_fp8_f32(o[6], o[7], w1, true);
                u32x2 w; w.x = (unsigned)w0; w.y = (unsigned)w1;
                st8(base + (size_t)r * ldc + wc * 32 + 8 * fq, w); }
    }
};
struct EpiBf8 {
    static constexpr bool PERM = true;
    unsigned ldc; float scale;
    __device__ __forceinline__ void operator()(const Acc& acc, const GUnit& u, int wr, int wc, int fr, int fq) const {
        unsigned char* base = (unsigned char*)u.C;
#pragma unroll
        for (int ai = 0; ai < 2; ++ai)
#pragma unroll
            for (int m = 0; m < 4; ++m) { const int r = ai * HALF + wr * 64 + m * 16 + fr; unsigned char* rowp = base + (size_t)r * ldc + wc * 32 + 8 * fq;
#pragma unroll
                for (int bj = 0; bj < 2; ++bj) { const f32x4 v0 = acc[ai][bj][m][0] * scale, v1 = acc[ai][bj][m][1] * scale;
                    u32x2 w; w.x = cvt4_fp8(v0[0], v0[1], v0[2], v0[3]); w.y = cvt4_fp8(v1[0], v1[1], v1[2], v1[3]); st8(rowp + bj * HALF, w); } }
    }
};
template <bool ROWSCALE> struct EpiBf {
    static constexpr bool PERM = true;
    unsigned ldc; float scale;
    __device__ __forceinline__ void operator()(const Acc& acc, const GUnit& u, int wr, int wc, int fr, int fq) const {
        bf16_t* base = (bf16_t*)u.C; const float* rs = (const float*)u.X;
#pragma unroll
        for (int ai = 0; ai < 2; ++ai)
#pragma unroll
            for (int m = 0; m < 4; ++m) { const int r = ai * HALF + wr * 64 + m * 16 + fr; float s = scale; if (ROWSCALE) s *= rs[r];
                bf16_t* rowp = base + (size_t)r * ldc + wc * 32 + 8 * fq;
#pragma unroll
                for (int bj = 0; bj < 2; ++bj) { const f32x4 v0 = acc[ai][bj][m][0] * s, v1 = acc[ai][bj][m][1] * s;
                    u32x4 w; w.x = cvt_pk_bf16(v0[0], v0[1]); w.y = cvt_pk_bf16(v0[2], v0[3]); w.z = cvt_pk_bf16(v1[0], v1[1]); w.w = cvt_pk_bf16(v1[2], v1[3]);
                    st16(rowp + bj * HALF, w); } }
    }
};
template <int MODE> struct EpiGated {
    static constexpr bool PERM = true;
    unsigned ldc;
    __device__ __forceinline__ void operator()(const Acc& acc, const GUnit& u, int wr, int wc, int fr, int fq) const {
        bf16_t* base = (bf16_t*)u.C;
#pragma unroll
        for (int ai = 0; ai < 2; ++ai)
#pragma unroll
            for (int m = 0; m < 4; ++m) { const int r = ai * HALF + wr * 64 + m * 16 + fr;
                float o[8];
#pragma unroll
                for (int n = 0; n < 2; ++n)
#pragma unroll
                    for (int j = 0; j < 4; ++j) { const float a = acc[ai][0][m][n][j], b = acc[ai][1][m][n][j];
                        o[n * 4 + j] = (MODE == 0) ? a * sigmoidf_fast(b) : a * sigmoidf_fast(a) * b; }
                u32x4 w; w.x = cvt_pk_bf16(o[0], o[1]); w.y = cvt_pk_bf16(o[2], o[3]); w.z = cvt_pk_bf16(o[4], o[5]); w.w = cvt_pk_bf16(o[6], o[7]);
                st16(base + (size_t)r * ldc + wc * 32 + 8 * fq, w); }
    }
};
struct EpiUA {
    static constexpr bool PERM = true;
    __device__ __forceinline__ void operator()(const Acc& acc, const GUnit& u, int wr, int wc, int fr, int fq) const {
        bf16_t* UA = (bf16_t*)u.C;
#pragma unroll
        for (int ai = 0; ai < 2; ++ai)
#pragma unroll
            for (int m = 0; m < 4; ++m) { const int tok = u.pm * BM + ai * HALF + wr * 64 + m * 16 + fr; const int chunk = tok >> 5, j = tok & 31;
#pragma unroll
                for (int bj = 0; bj < 2; ++bj) { const int ch = u.pn * BM + bj * HALF + wc * 32 + 8 * fq, g = ch >> 4, h0 = ch & 15;
                    const f32x4 v0 = acc[ai][bj][m][0], v1 = acc[ai][bj][m][1];
                    u32x4 w; w.x = cvt_pk_bf16(v0[0], v0[1]); w.y = cvt_pk_bf16(v0[2], v0[3]); w.z = cvt_pk_bf16(v1[0], v1[1]); w.w = cvt_pk_bf16(v1[2], v1[3]);
                    st16(UA + ((size_t)g * NCHUNK + chunk) * UAK + j * 16 + h0, w); } }
    }
};
struct EpiS {
    static constexpr bool PERM = false;
    __device__ __forceinline__ void operator()(const Acc& acc, const GUnit& u, int wr, int wc, int fr, int fq) const {
        float* Sg = (float*)u.C;
#pragma unroll
        for (int ai = 0; ai < 2; ++ai)
#pragma unroll
            for (int m = 0; m < 4; ++m) { const int chunk = u.pm * BM + ai * HALF + wr * 64 + m * 16 + fr; float* rowp = Sg + (size_t)chunk * 256 + wc * 32 + 4 * fq;
#pragma unroll
                for (int bj = 0; bj < 2; ++bj)
#pragma unroll
                    for (int n = 0; n < 2; ++n) st16f(rowp + bj * HALF + n * 16, acc[ai][bj][m][n]); }
    }
};
struct EpiGelu {
    static constexpr bool PERM = true;
    __device__ __forceinline__ void operator()(const Acc& acc, const GUnit& u, int wr, int wc, int fr, int fq) const {
        bf16_t* Gg = (bf16_t*)u.C;
#pragma unroll
        for (int ai = 0; ai < 2; ++ai)
#pragma unroll
            for (int m = 0; m < 4; ++m) { const int chunk = u.pm * BM + ai * HALF + wr * 64 + m * 16 + fr;
#pragma unroll
                for (int bj = 0; bj < 2; ++bj) { const int n0 = u.pn * BM + bj * HALF + wc * 32 + 8 * fq, i = n0 >> 4, c0 = n0 & 15;
                    const f32x4 v0 = acc[ai][bj][m][0], v1 = acc[ai][bj][m][1];
                    u32x4 w; w.x = cvt_pk_bf16(gelu_tanh_fast(v0[0]), gelu_tanh_fast(v0[1])); w.y = cvt_pk_bf16(gelu_tanh_fast(v0[2]), gelu_tanh_fast(v0[3]));
                    w.z = cvt_pk_bf16(gelu_tanh_fast(v1[0]), gelu_tanh_fast(v1[1])); w.w = cvt_pk_bf16(gelu_tanh_fast(v1[2]), gelu_tanh_fast(v1[3]));
                    st16(Gg + ((size_t)chunk * TCH + i) * D + c0, w); } }
    }
};

struct EpiSoftmax {
    static constexpr bool PERM = true;
    LAS float* red; unsigned ldc; float scale;
    __device__ __forceinline__ void operator()(Acc& acc, const GUnit& u, int wr, int wc, int fr, int fq) const {
        bf16_t* base = (bf16_t*)u.C;
#pragma unroll
        for (int ai = 0; ai < 2; ++ai)
#pragma unroll
            for (int m = 0; m < 4; ++m) { float mx = -INFINITY;
#pragma unroll
                for (int bj = 0; bj < 2; ++bj)
#pragma unroll
                    for (int n = 0; n < 2; ++n) { const f32x4 v = acc[ai][bj][m][n]; mx = fmaxf(mx, fmaxf(fmaxf(v[0], v[1]), fmaxf(v[2], v[3]))); }
                mx *= scale; mx = x32_max(x16_max(mx));
                if (fq == 0) red[(ai * HALF + wr * 64 + m * 16 + fr) * 4 + wc] = mx; }
        asm volatile("s_waitcnt lgkmcnt(0)" ::: "memory"); __builtin_amdgcn_s_barrier(); asm volatile("" ::: "memory");
#pragma unroll
        for (int ai = 0; ai < 2; ++ai)
#pragma unroll
            for (int m = 0; m < 4; ++m) { const int r = ai * HALF + wr * 64 + m * 16 + fr; const f32x4 mm = *(const LAS f32x4*)(red + r * 4); const float M = fmaxf(fmaxf(mm[0], mm[1]), fmaxf(mm[2], mm[3]));
                float s = 0.f;
#pragma unroll
                for (int bj = 0; bj < 2; ++bj)
#pragma unroll
                    for (int n = 0; n < 2; ++n) { f32x4 v = acc[ai][bj][m][n];
#pragma unroll
                        for (int j = 0; j < 4; ++j) { v[j] = __builtin_amdgcn_exp2f(__builtin_fmaf(v[j], scale, -M)); s += v[j]; }
                        acc[ai][bj][m][n] = v; }
                s = x32_sum(x16_sum(s));
                if (fq == 0) red[1024 + r * 4 + wc] = s; }
        asm volatile("s_waitcnt lgkmcnt(0)" ::: "memory"); __builtin_amdgcn_s_barrier(); asm volatile("" ::: "memory");
#pragma unroll
        for (int ai = 0; ai < 2; ++ai)
#pragma unroll
            for (int m = 0; m < 4; ++m) { const int r = ai * HALF + wr * 64 + m * 16 + fr; const f32x4 ss = *(const LAS f32x4*)(red + 1024 + r * 4); const float inv = __builtin_amdgcn_rcpf((ss[0] + ss[1]) + (ss[2] + ss[3]));
                bf16_t* rowp = base + (size_t)r * ldc + wc * 32 + 8 * fq;
#pragma unroll
                for (int bj = 0; bj < 2; ++bj) { const f32x4 v0 = acc[ai][bj][m][0] * inv, v1 = acc[ai][bj][m][1] * inv;
                    u32x4 w; w.x = cvt_pk_bf16(v0[0], v0[1]); w.y = cvt_pk_bf16(v0[2], v0[3]); w.z = cvt_pk_bf16(v1[0], v1[1]); w.w = cvt_pk_bf16(v1[2], v1[3]);
                    st16(rowp + bj * HALF, w); } }
    }
};

struct Ctx { unsigned char* ws; int G, c; };
struct SchedPlain { const char* A; const char* B; char* C; size_t lda, ldb, ldc; int nM, nN, G, c;
    __device__ __forceinline__ bool next(int i, GUnit& u) const { int pm, pn; if (!static_unit(i, G, c, nM, nN, pm, pn)) return false;
        u.A = A + (size_t)pm * BM * lda; u.B = B + (size_t)pn * BM * ldb; u.C = C + ((size_t)pm * BM * ldc + (size_t)pn * BM) * 2; u.X = nullptr; u.pm = pm; u.pn = pn; return true; } };
struct SchedGated { const char* A; const char* B; char* C; size_t lda, ldb, ldc; int nM, nN, G, c;
    __device__ __forceinline__ bool next(int i, GUnit& u) const { int pm, pn; if (!static_unit(i, G, c, nM, nN, pm, pn)) return false;
        u.A = A + (size_t)pm * BM * lda; u.B = B + (size_t)pn * BM * ldb; u.C = C + ((size_t)pm * BM * ldc + (size_t)pn * HALF) * 2; u.X = nullptr; u.pm = pm; u.pn = pn; return true; } };
struct SchedUA { const char* A; const char* B; char* UA; int G, c;
    __device__ __forceinline__ bool next(int i, GUnit& u) const { int pm, pn; if (!static_unit(i, G, c, NT / BM, D / BM, pm, pn)) return false;
        u.A = A + (size_t)pm * BM * (D * 2); u.B = B + (size_t)pn * BM * (D * 2); u.C = UA; u.X = nullptr; u.pm = pm; u.pn = pn; return true; } };
struct SchedKV { unsigned char* ws; int G, c;
    __device__ __forceinline__ bool next(int i, GUnit& u) const { const int L = i * G + c; if (L >= 128) return false; const int layer = L >> 6, r = L & 63, pm = r >> 3, pn = r & 7;
        u.A = (const char*)ws + WS_MEMB + (size_t)pm * BM * 2048; u.B = (const char*)ws + WS_MWKV + (size_t)layer * 4 * MiB + (size_t)pn * BM * 2048;
        u.C = (char*)ws + WS_KV + (size_t)layer * 8 * MiB + ((size_t)pm * BM * 2048 + pn * BM) * 2; u.X = nullptr; u.pm = pm; u.pn = pn; return true; } };
struct SchedSA { unsigned char* ws; int G, c;
    __device__ __forceinline__ bool next(int i, GUnit& u) const { const int L = i * G + c; if (L >= 64 * 6) return false; const int g = L / 6, pm = L % 6;
        u.A = (const char*)ws + PO_UA + ((size_t)g * NCHUNK + (size_t)pm * BM) * (UAK * 2); u.B = (const char*)ws + PO_M2T + (size_t)g * 256 * 512 * 2;
        u.C = (char*)ws + PO_SG + (size_t)g * NCHUNK * 256 * 4; u.X = nullptr; u.pm = pm; u.pn = 0; return true; } };
struct SchedSC { unsigned char* ws; int G, c;
    __device__ __forceinline__ bool next(int i, GUnit& u) const { const int L = i * G + c; if (L >= 64 * 12) return false; const int g = L / 12, r = L % 12, pm = r >> 1, pn = r & 1;
        u.A = (const char*)ws + PO_UA + ((size_t)g * NCHUNK + (size_t)pm * BM) * (UAK * 2); u.B = (const char*)ws + PO_M13T + ((size_t)g * 512 + pn * BM) * UAK * 2;
        u.C = (char*)ws + PO_SG + (size_t)g * 16 * 2; u.X = nullptr; u.pm = pm; u.pn = pn; return true; } };
struct SchedWqk { unsigned char* ws; int G, c;
    __device__ __forceinline__ bool next(int i, GUnit& u) const { const int L = i * G + c; if (L >= 256) return false; const int pn = L & 3, h = (L >> 2) & 3, gb = (L >> 4) & 7, layer = L >> 7;
        u.A = (const char*)ws + WS_KV + (size_t)layer * 8 * MiB + ((size_t)gb * 256 * 2048 + h * 256) * 2; u.B = (const char*)ws + WS_MWQ + (size_t)layer * 2 * MiB + ((size_t)pn * BM * 1024 + h * 256) * 2;
        u.C = (char*)ws + WS_WQK + ((size_t)(layer * 8 + gb) * 1024 * 1024 + (size_t)h * 256 * 1024 + pn * BM); u.X = nullptr; u.pm = 0; u.pn = pn; return true; } };
struct SchedWvo { unsigned char* ws; int G, c;
    __device__ __forceinline__ bool next(int i, GUnit& u) const { const int L = i * G + c; if (L >= 256) return false; const int pm = L & 3, h = (L >> 2) & 3, gb = (L >> 4) & 7, layer = L >> 7;
        u.A = (const char*)ws + WS_MWO + (size_t)layer * 2 * MiB + ((size_t)pm * BM * 1024 + h * 256) * 2; u.B = (const char*)ws + WS_KV + (size_t)layer * 8 * MiB + ((size_t)gb * 256 * 2048 + 1024 + h * 256) * 2;
        u.C = (char*)ws + WS_WVO + ((size_t)(layer * 8 + gb) * 1024 * 1024 + (size_t)pm * BM * 1024 + h * 256) * 2; u.X = nullptr; u.pm = pm; u.pn = 0; return true; } };
struct SchedScores8 { const char* A; const char* Bl; char* C; int G, c;
    __device__ __forceinline__ bool next(int i, GUnit& u) const { int pm, pn; if (!static_unit(i, G, c, NT / BM, 4, pm, pn)) return false; const int gb = panel_gb(pm);
        u.A = A + (size_t)pm * BM * 1024; u.B = Bl + ((size_t)gb * 1024 + pn * BM) * 1024; u.C = C + ((size_t)pm * BM * 1024 + pn * BM) * 2; u.X = nullptr; u.pm = pm; u.pn = pn; return true; } };
struct SchedBatchW { const char* A; const char* Bl; char* C; int G, c;
    __device__ __forceinline__ bool next(int i, GUnit& u) const { int pm, pn; if (!static_unit(i, G, c, NT / BM, 4, pm, pn)) return false; const int gb = panel_gb(pm);
        u.A = A + (size_t)pm * BM * 2048; u.B = Bl + ((size_t)gb * 1024 + pn * BM) * 2048; u.C = C + ((size_t)pm * BM * 1024 + pn * BM) * 2; u.X = nullptr; u.pm = pm; u.pn = pn; return true; } };
struct Args { const float* in[26]; float* out; unsigned char* ws; int ph_lo, ph_hi, flags, pad; };
struct Frame {
    LAS unsigned char* lds; unsigned char* ws; const float* const* in; float* out;
    int tid, lane, wave, G, c;
    bool xok;
};
enum { I_XP = 0, I_XS, I_MEMP, I_MEMS, I_AWIN, I_ALRE, I_ALIM, I_ALDT, I_ABRE, I_ABIM, I_ACRE, I_ACIM, I_AD, I_AWGLU, I_BWQKV, I_BRPB, I_BWO, I_MWQ, I_MWKV, I_MWO, I_EWR, I_EW1, I_EW3, I_EW2, I_LNG, I_LNB };

__device__ __forceinline__ int rowmap(int mode, int n) {
    if (mode == 0) return n;
    if (mode == 1) { const int z = n >> 10, nn = n & 1023; return ((nn >> 7) << 8) + (z << 7) + (nn & 127); }
    return ((n >> 7) << 8) + ((mode == 3) ? 128 : 0) + (n & 127);
}
__device__ __forceinline__ void transpose_item(const float* W, int K, int N, bf16_t* WT, int mode, LAS float* scr, int item, int lane) {
    const int nblk = N / 32, kb = item / nblk, nb = item % nblk, k0 = 64 * kb, n0 = 32 * nb;
#pragma unroll 8
    for (int i = 0; i < 32; ++i) { const int kk = 2 * i + (lane >> 5); scr[kk * 33 + (lane & 31)] = W[(size_t)(k0 + kk) * N + n0 + (lane & 31)]; }
    LDS_WAIT(); asm volatile("" ::: "memory");
    const int c = lane & 7;
#pragma unroll
    for (int j = 0; j < 4; ++j) { const int n = (lane >> 3) + 8 * j; const LAS float* s = scr + (8 * c) * 33 + n;
        u32x4 o; o.x = cvt_pk_bf16(s[0 * 33], s[1 * 33]); o.y = cvt_pk_bf16(s[2 * 33], s[3 * 33]); o.z = cvt_pk_bf16(s[4 * 33], s[5 * 33]); o.w = cvt_pk_bf16(s[6 * 33], s[7 * 33]);
        *(u32x4*)(WT + (size_t)rowmap(mode, n0 + n) * K + k0 + 8 * c) = o; }
    LDS_WAIT(); asm volatile("" ::: "memory");
}
__device__ __forceinline__ void t8_load(f32x4 (&v)[16], const float* W, int N, int item, int lane) {
    const int nblk = N / 32, kb = item / nblk, nb = item % nblk, k0 = 128 * kb, n0 = 32 * nb, q = lane >> 3, c = lane & 7;
#pragma unroll
    for (int i = 0; i < 16; ++i) v[i] = *(const f32x4*)(W + (size_t)(k0 + 16 * q + i) * N + n0 + 4 * c);
}
__device__ __forceinline__ void t8_finish(const f32x4 (&v)[16], int K, int N, unsigned char* WT, int mode, float scale, LAS unsigned char* scr, int item, int lane) {
    const int nblk = N / 32, kb = item / nblk, nb = item % nblk, k0 = 128 * kb, n0 = 32 * nb, q = lane >> 3, c = lane & 7;
#pragma unroll
    for (int j = 0; j < 4; ++j) { u32x4 o;
        o.x = cvt4_fp8(v[0][j] * scale, v[1][j] * scale, v[2][j] * scale, v[3][j] * scale); o.y = cvt4_fp8(v[4][j] * scale, v[5][j] * scale, v[6][j] * scale, v[7][j] * scale);
        o.z = cvt4_fp8(v[8][j] * scale, v[9][j] * scale, v[10][j] * scale, v[11][j] * scale); o.w = cvt4_fp8(v[12][j] * scale, v[13][j] * scale, v[14][j] * scale, v[15][j] * scale);
        *(LAS u32x4*)(scr + (4 * c + j) * 144 + 16 * q) = o; }
    LDS_WAIT(); asm volatile("" ::: "memory");
#pragma unroll
    for (int j = 0; j < 4; ++j) { const int n = (lane >> 3) + 8 * j; const u32x4 o = *(const LAS u32x4*)(scr + n * 144 + 16 * c);
        pst16(WT + (size_t)rowmap(mode, n0 + n) * K + k0 + 16 * c, o); }
    LDS_WAIT(); asm volatile("" ::: "memory");
}
__device__ __forceinline__ void transpose_item8(const float* W, int K, int N, unsigned char* WT, int mode, float scale, LAS unsigned char* scr, int item, int lane) {
    f32x4 v[16]; t8_load(v, W, N, item, lane); t8_finish(v, K, N, WT, mode, scale, scr, item, lane);
}
__device__ __forceinline__ void transpose_item16(const float* W, int K, int N, bf16_t* WT, int mode, LAS unsigned char* scr, int item, int lane) {
    const int nblk = N / 32, kb = item / nblk, nb = item % nblk, k0 = 128 * kb, n0 = 32 * nb, q = lane >> 3, c = lane & 7;
    f32x4 v[16];
#pragma unroll
    for (int i = 0; i < 16; ++i) v[i] = *(const f32x4*)(W + (size_t)(k0 + 16 * q + i) * N + n0 + 4 * c);
#pragma unroll
    for (int j = 0; j < 4; ++j) { u32x4 o0, o1;
        o0.x = cvt_pk_bf16(v[0][j], v[1][j]); o0.y = cvt_pk_bf16(v[2][j], v[3][j]); o0.z = cvt_pk_bf16(v[4][j], v[5][j]); o0.w = cvt_pk_bf16(v[6][j], v[7][j]);
        o1.x = cvt_pk_bf16(v[8][j], v[9][j]); o1.y = cvt_pk_bf16(v[10][j], v[11][j]); o1.z = cvt_pk_bf16(v[12][j], v[13][j]); o1.w = cvt_pk_bf16(v[14][j], v[15][j]);
        *(LAS u32x4*)(scr + (4 * c + j) * 272 + 32 * q) = o0; *(LAS u32x4*)(scr + (4 * c + j) * 272 + 32 * q + 16) = o1; }
    LDS_WAIT(); asm volatile("" ::: "memory");
#pragma unroll
    for (int j = 0; j < 8; ++j) { const int n = (lane >> 4) + 4 * j, ch = lane & 15; const u32x4 o = *(const LAS u32x4*)(scr + n * 272 + 16 * ch);
        *(u32x4*)(WT + (size_t)rowmap(mode, n0 + n) * K + k0 + 8 * ch) = o; }
    LDS_WAIT(); asm volatile("" ::: "memory");
}
__device__ __forceinline__ void convert_small_weights(Frame& F) {
    LAS unsigned char* scr = F.lds + F.wave * 16384;
    const int gw = F.c * 8 + F.wave, NGW = F.G * 8;
    for (int it = gw; it < 3328; it += NGW) {
        int r = it;
        if (r < 256) { transpose_item16(F.in[I_AWIN], 1024, 1024, (bf16_t*)(F.ws + WS_WIN), 0, scr, r, F.lane); continue; } r -= 256;
        if (r < 512) { transpose_item16(F.in[I_AWGLU], 1024, 2048, (bf16_t*)(F.ws + WS_WGLU), 1, scr, r, F.lane); continue; } r -= 512;
        if (r < 768) { transpose_item8(F.in[I_BWQKV], 1024, 3072, F.ws + WS_WQKV, 0, FP8_SWQKV, scr, r, F.lane); continue; } r -= 768;
        if (r < 256) { transpose_item16(F.in[I_BWO], 1024, 1024, (bf16_t*)(F.ws + WS_WO), 0, scr, r, F.lane); continue; } r -= 256;
        if (r < 1024) { const int l = r >> 9; transpose_item16(F.in[I_MWKV] + (size_t)l * 1024 * 2048, 1024, 2048, (bf16_t*)(F.ws + WS_MWKV + (size_t)l * 4 * MiB), 0, scr, r & 511, F.lane); continue; } r -= 1024;
        { const int l = r >> 8; transpose_item16(F.in[I_MWO] + (size_t)l * 1024 * 1024, 1024, 1024, (bf16_t*)(F.ws + WS_MWO + (size_t)l * 2 * MiB), 0, scr, r & 255, F.lane); }
    }
}
__device__ __forceinline__ void convert_expert_weights(Frame& F, int layer, int lo = 0, int hi = 16 * 1536, int wg0 = 0, int gw_in = -1, int ngw_in = 0) {
    if (F.G <= wg0) wg0 = 0;
    if (F.c < wg0) return;
    LAS unsigned char* scr = F.lds + F.wave * 16384;
    const int gw = gw_in >= 0 ? gw_in : (F.c - wg0) * 8 + F.wave, NGW = gw_in >= 0 ? ngw_in : (F.G - wg0) * 8;
#define CVX_DECODE(it_) const int _e = (it_) / 1536; int _r = (it_) % 1536; const size_t _wofs = ((size_t)layer * 16 + _e) * 1024 * 2048; \
        const int _w = _r >> 9; _r &= 511; const float* _W = (_w == 0 ? F.in[I_EW1] : (_w == 1 ? F.in[I_EW3] : F.in[I_EW2])) + _wofs; const int _N = _w == 2 ? 1024 : 2048, _K = _w == 2 ? 2048 : 1024;
#define CVX_LOAD(v_, it_) do { CVX_DECODE(it_); (void)_K; t8_load(v_, _W, _N, _r, F.lane); } while (0)
#define CVX_FINISH(v_, it_) do { CVX_DECODE(it_); unsigned char* _WT = _w == 2 ? F.ws + (layer ? WS_EW2B : WS_EW2) + (size_t)_e * 2 * MiB : F.ws + (layer ? WS_EW13B : WS_EW13) + (size_t)_e * 4 * MiB; \
        t8_finish(v_, _K, _N, _WT, _w == 0 ? 2 : (_w == 1 ? 3 : 0), _w == 2 ? FP8_SW2 : FP8_SW13, scr, _r, F.lane); } while (0)
    f32x4 va[16], vb[16];
    int it = lo + gw;
    if (it < hi) CVX_LOAD(va, it);
    while (it < hi) {
        const int it1 = it + NGW, it2 = it1 + NGW;
        if (it1 < hi) CVX_LOAD(vb, it1);
        CVX_FINISH(va, it);
        if (it1 < hi) { if (it2 < hi) CVX_LOAD(va, it2); CVX_FINISH(vb, it1); }
        it = it2;
    }
#undef CVX_DECODE
#undef CVX_LOAD
#undef CVX_FINISH
}
__device__ __forceinline__ void convert_plain(Frame& F, const float* src, bf16_t* dst, size_t n) {
    const size_t n4 = n / 4;
    for (size_t i = (size_t)F.c * 512 + F.tid; i < n4; i += (size_t)F.G * 512) { const f32x4 v = ((const f32x4*)src)[i]; u32x2 w; w.x = cvt_pk_bf16(v[0], v[1]); w.y = cvt_pk_bf16(v[2], v[3]); ((u32x2*)dst)[i] = w; }
}
__device__ __forceinline__ void import_x(Frame& F, bool copy_f32) {
    const size_t n4 = (size_t)NT * D / 4, np4 = (size_t)NTP * D / 4, st = (size_t)F.G * 512;
    f32x4* XF = (f32x4*)(F.ws + WS_XF); u32x2* XB = (u32x2*)(F.ws + WS_XB);
    for (size_t i0 = (size_t)F.c * 512 + F.tid; i0 < n4; i0 += st * 8) {
        f32x4 v[8];
#pragma unroll
        for (int u = 0; u < 8; ++u) { const size_t i = i0 + st * u;
            if (i < n4) { if (copy_f32) { v[u] = (i < np4) ? ((const f32x4*)F.in[I_XP])[i] : ((const f32x4*)F.in[I_XS])[i - np4]; } else v[u] = XF[i]; } }
#pragma unroll
        for (int u = 0; u < 8; ++u) { const size_t i = i0 + st * u;
            if (i < n4) { u32x2 w; w.x = cvt_pk_bf16(v[u][0], v[u][1]); w.y = cvt_pk_bf16(v[u][2], v[u][3]); XB[i] = w; } }
    }
}

__device__ __forceinline__ void s5_lam(const float* lre, const float* lim, const float* ldt, int dir, int g, int p, double& dt, double& lr, double& li) {
    dt = exp((double)ldt[dir * 64 + g]); lr = (double)lre[(dir * 64 + g) * 64 + p]; li = (double)lim[(dir * 64 + g) * 64 + p];
}
__device__ __forceinline__ void s5_fill_bc(Frame& F, int g, int dir, const LAS double* LBd, LAS float* Bbr, LAS float* Bbi, LAS float* Cr, LAS float* Ci) {
    for (int idx = F.tid; idx < 1024; idx += 512) {
        const int p = idx >> 4, h = idx & 15; const double fr = LBd[p * 4 + 2], fi = LBd[p * 4 + 3];
        const double br = F.in[I_ABRE][((dir * 64 + g) * 64 + p) * 16 + h], bi = F.in[I_ABIM][((dir * 64 + g) * 64 + p) * 16 + h];
        Bbr[idx] = (float)(fr * br - fi * bi); Bbi[idx] = (float)(fr * bi + fi * br);
        Cr[idx] = F.in[I_ACRE][(dir * 64 + g) * 1024 + idx]; Ci[idx] = F.in[I_ACIM][(dir * 64 + g) * 1024 + idx];
    }
}
__device__ __forceinline__ void s5_build_item(Frame& F, int g, int dir) {
    LAS float* LPr = (LAS float*)F.lds; LAS float* LPi = LPr + 33 * 64;
    LAS float* Bbr = LPi + 33 * 64; LAS float* Bbi = Bbr + 1024; LAS float* Cr = Bbi + 1024; LAS float* Ci = Cr + 1024;
    LAS float* B2r = Ci + 1024; LAS float* B2i = B2r + 1024; LAS float* C2r = B2i + 1024; LAS float* C2i = C2r + 1024;
    LAS float* KD = C2i + 1024;
    bf16_t* M2T = (bf16_t*)(F.ws + PO_M2T) + (size_t)g * 256 * 512; bf16_t* M13T = (bf16_t*)(F.ws + PO_M13T) + (size_t)g * 512 * UAK;
    LAS double* LB = (LAS double*)(KD + 32 * 256);
    __syncthreads();
    if (F.tid < 128) { const int dd = F.tid >> 6, p = F.tid & 63;
        if (dd == 0 || dir == 0) { double dt, lr, li; s5_lam(F.in[I_ALRE], F.in[I_ALIM], F.in[I_ALDT], dd == 0 ? dir : 1, g, p, dt, lr, li);
            const double er = exp(lr * dt), lbr = er * cos(li * dt), lbi = er * sin(li * dt), nr = lbr - 1.0, ni = lbi, den = lr * lr + li * li;
            LB[(dd * 64 + p) * 4 + 0] = lbr; LB[(dd * 64 + p) * 4 + 1] = lbi; LB[(dd * 64 + p) * 4 + 2] = (nr * lr + ni * li) / den; LB[(dd * 64 + p) * 4 + 3] = (ni * lr - nr * li) / den; } }
    __syncthreads();
    for (int idx = F.tid; idx < 33 * 64; idx += 512) { const int e = idx >> 6, p = idx & 63; double br = LB[p * 4], bi = LB[p * 4 + 1], rr = 1.0, ri = 0.0;
        for (int b = e; b != 0; b >>= 1) { if (b & 1) { const double t = rr * br - ri * bi; ri = rr * bi + ri * br; rr = t; } const double t2 = br * br - bi * bi; bi = 2.0 * br * bi; br = t2; }
        LPr[idx] = (float)rr; LPi[idx] = (float)ri; }
    s5_fill_bc(F, g, dir, LB, Bbr, Bbi, Cr, Ci);
    if (dir == 0) s5_fill_bc(F, g, 1, LB + 256, B2r, B2i, C2r, C2i);
    __syncthreads();
    {
        const int k = F.tid, j = k >> 4, h = k & 15, e = dir == 0 ? (TCH - 1 - j) : j;
        for (int p = 0; p < 64; ++p) { const float lr = LPr[e * 64 + p], li = LPi[e * 64 + p], br = Bbr[p * 16 + h], bi = Bbi[p * 16 + h];
            const float xr = lr * br - li * bi, xi = lr * bi + li * br;
            M2T[(size_t)(dir * 128 + p) * 512 + k] = (bf16_t)(cvt_pk_bf16(xr, 0.f) & 0xffffu); M2T[(size_t)(dir * 128 + 64 + p) * 512 + k] = (bf16_t)(cvt_pk_bf16(xi, 0.f) & 0xffffu); }
    }
    {
        const int p = F.tid & 63, q8 = F.tid >> 6;
        for (int ic = q8; ic < 512; ic += 8) { const int i = ic >> 4, c = ic & 15, e = dir == 0 ? (i + 1) : (TCH - i);
            const float cr = Cr[c * 64 + p], ci = Ci[c * 64 + p], lr = LPr[e * 64 + p], li = LPi[e * 64 + p];
            const float vr = cr * lr - ci * li, vi = cr * li + ci * lr;
            M13T[(size_t)ic * UAK + 512 + dir * 128 + p] = (bf16_t)(cvt_pk_bf16(vr, 0.f) & 0xffffu); M13T[(size_t)ic * UAK + 512 + dir * 128 + 64 + p] = (bf16_t)(cvt_pk_bf16(-vi, 0.f) & 0xffffu); }
    }
    {
        const int ch = F.tid & 255, c = ch >> 4, h = ch & 15, par = F.tid >> 8;
        if (dir == 0 && par == 0) {
            float s = (c == h) ? F.in[I_AD][g * 16 + c] : 0.f;
            for (int p = 0; p < 64; ++p) s += Cr[c * 64 + p] * Bbr[p * 16 + h] - Ci[c * 64 + p] * Bbi[p * 16 + h] + C2r[c * 64 + p] * B2r[p * 16 + h] - C2i[c * 64 + p] * B2i[p * 16 + h];
            KD[ch] = s;
        }
#pragma nounroll
        for (int hp = 0; hp < 64; hp += 32) {
            float cbr[32], cbi[32];
#pragma unroll
            for (int p = 0; p < 32; ++p) { const float cr = Cr[c * 64 + hp + p], ci = Ci[c * 64 + hp + p], br = Bbr[(hp + p) * 16 + h], bi = Bbi[(hp + p) * 16 + h]; cbr[p] = cr * br - ci * bi; cbi[p] = cr * bi + ci * br; }
#pragma nounroll
            for (int d = 1 + par; d < TCH; d += 2) {
                float s0 = 0.f, s1 = 0.f;
#pragma unroll
                for (int p = 0; p < 32; p += 4) { const f32x4 lr = *(const LAS f32x4*)(LPr + d * 64 + hp + p), li = *(const LAS f32x4*)(LPi + d * 64 + hp + p);
                    s0 += cbr[p] * lr[0]; s1 -= cbi[p] * li[0]; s0 += cbr[p + 1] * lr[1]; s1 -= cbi[p + 1] * li[1]; s0 += cbr[p + 2] * lr[2]; s1 -= cbi[p + 2] * li[2]; s0 += cbr[p + 3] * lr[3]; s1 -= cbi[p + 3] * li[3]; }
                if (hp == 0) KD[d * 256 + ch] = s0 + s1; else KD[d * 256 + ch] += s0 + s1;
            }
        }
        __syncthreads();
        for (int idx = F.tid; idx < 512 * 64; idx += 512) { const int hf = idx & 1, j = (idx >> 1) & 31, ic = idx >> 6, i = ic >> 4, cc = ic & 15;
            const bool mine = dir == 0 ? (j <= i) : (j > i);
            if (mine) { const int d = dir == 0 ? (i - j) : (j - i); const f32x4 v0 = *(const LAS f32x4*)(KD + d * 256 + cc * 16 + hf * 8), v1 = *(const LAS f32x4*)(KD + d * 256 + cc * 16 + hf * 8 + 4);
                u32x4 v; v.x = cvt_pk_bf16(v0[0], v0[1]); v.y = cvt_pk_bf16(v0[2], v0[3]); v.z = cvt_pk_bf16(v1[0], v1[1]); v.w = cvt_pk_bf16(v1[2], v1[3]); *(u32x4*)(M13T + (size_t)ic * UAK + j * 16 + hf * 8) = v; } }
    }
    __syncthreads();
}

__device__ __forceinline__ void s5_recurrence(Frame& F) {
    const float* S = (const float*)(F.ws + PO_SG); bf16_t* UA = (bf16_t*)(F.ws + PO_UA);
    for (int base = F.c * 256; base < 65536; base += F.G * 256) {
        if (F.tid >= 256) continue;
        const int flat = base + F.tid, p = flat & 63, dir = (flat >> 6) & 1, g = (flat >> 7) & 63, gb = flat >> 13;
        double dt, lr, li; s5_lam(F.in[I_ALRE], F.in[I_ALIM], F.in[I_ALDT], dir, g, p, dt, lr, li);
        const double er = exp(lr * dt * TCH); const float ar = (float)(er * cos(li * dt * TCH)), ai = (float)(er * sin(li * dt * TCH));
        const int nc = gb < 4 ? 256 : 128, chunk0 = gb < 4 ? gb * 256 : 1024 + (gb - 4) * 128;
        float hr = 0.f, hi = 0.f;
        for (int s0 = 0; s0 < nc; s0 += 8) {
            float sr[8], si[8];
#pragma unroll
            for (int k = 0; k < 8; ++k) { const int cc = dir == 0 ? (s0 + k) : (nc - 1 - s0 - k); const size_t o = ((size_t)g * NCHUNK + (chunk0 + cc)) * 256 + dir * 128 + p; sr[k] = S[o]; si[k] = S[o + 64]; }
#pragma unroll
            for (int k = 0; k < 8; ++k) { const int cc = dir == 0 ? (s0 + k) : (nc - 1 - s0 - k); const size_t o = ((size_t)g * NCHUNK + (chunk0 + cc)) * UAK + 512 + dir * 128 + p;
                UA[o] = (bf16_t)(cvt_pk_bf16(hr, 0.f) & 0xffffu); UA[o + 64] = (bf16_t)(cvt_pk_bf16(hi, 0.f) & 0xffffu);
                const float nr = ar * hr - ai * hi + sr[k], ni = ar * hi + ai * hr + si[k]; hr = nr; hi = ni; }
        }
    }
}

__device__ __forceinline__ void add_bf16x4(f32x4& v, const u32x2 w) { v[0] += __uint_as_float(w.x << 16); v[1] += __uint_as_float(w.x & 0xffff0000u); v[2] += __uint_as_float(w.y << 16); v[3] += __uint_as_float(w.y & 0xffff0000u); }
constexpr int WRS = 1028;
__device__ __forceinline__ void ln_router_fill(Frame& F, const float* gam, const float* bet, const float* wrouter) {
    LAS float* wrT = (LAS float*)F.lds; LAS float* gsh = wrT + 16 * WRS; LAS float* bsh = gsh + 1024;
    __syncthreads();
    for (int i = F.tid; i < 16384; i += 512) { const int k = i >> 4, e = i & 15; wrT[e * WRS + k] = wrouter[i]; }
    for (int i = F.tid; i < 1024; i += 512) { gsh[i] = gam[i]; bsh[i] = bet[i]; }
    __syncthreads();
}
#ifndef RES_BF16
#define RES_BF16 1
#endif
template <int MODE, bool ROUTER, bool FINAL, bool SRCIN = false>
__device__ __forceinline__ void ln_phase(Frame& F, const bf16_t* HB, const float* gam, const float* bet, const float* wrouter) {
    float* XF = (float*)(F.ws + WS_XF);
    LAS float* wrT = (LAS float*)F.lds;
    LAS float* gsh = wrT + 16 * WRS; LAS float* bsh = gsh + 1024;
    f32x4 gv[4], bv[4];
    if (!ROUTER) {
#pragma unroll
        for (int j = 0; j < 4; ++j) { gv[j] = *(const f32x4*)(gam + F.lane * 4 + 256 * j); bv[j] = *(const f32x4*)(bet + F.lane * 4 + 256 * j); } }
    const unsigned char* wsb = F.ws; int ln = F.lane; unsigned lb4 = (unsigned)ln * 16u, lb2 = (unsigned)ln * 8u, lb1 = (unsigned)ln * 4u;
    const unsigned hb_off = (unsigned)((const unsigned char*)HB - wsb);
    const int nq = F.xok ? 6 : (NT / 4 + F.G * 8 - 1) / (F.G * 8);
    constexpr bool X32 = SRCIN || !RES_BF16;
    f32x4 xr32[4][4]; u32x2 xr16[4][4], hwr[4][4];
#define LN_ISSUE(row0_) do { const int _r0 = (row0_); \
        const unsigned char* xbase = SRCIN ? (_r0 < NTP ? (const unsigned char*)F.in[I_XP] : (const unsigned char*)F.in[I_XS] - (size_t)NTP * 4096) : wsb + WS_XF;      \
        if (X32) { _Pragma("unroll") for (int r = 0; r < 4; ++r) { const unsigned ro = (unsigned)(_r0 + r) * 4096u + lb4; _Pragma("unroll") for (int j = 0; j < 4; ++j) xr32[r][j] = *(const f32x4*)(xbase + ro + 1024u * j); } } \
        else { _Pragma("unroll") for (int r = 0; r < 4; ++r) { const unsigned ro = (unsigned)(_r0 + r) * 2048u + lb2; _Pragma("unroll") for (int j = 0; j < 4; ++j) xr16[r][j] = *(const u32x2*)(xbase + ro + 512u * j); } } \
        if (MODE == 0) { _Pragma("unroll") for (int r = 0; r < 4; ++r) { const unsigned ro = hb_off + (unsigned)(_r0 + r) * 2048u + lb2; _Pragma("unroll") for (int j = 0; j < 4; ++j) hwr[r][j] = *(const u32x2*)(wsb + ro + 512u * j); } } \
    } while (0)
#define LN_Q(qi_) (F.xok ? ((F.c & 7) * 1536 + (F.c >> 3) * 48 + F.wave * 6 + (qi_)) : (F.c * 8 + F.wave + (qi_) * F.G * 8))
    u32x4 sln = {~0u, ~0u, ~0u, ~0u};
    if (MODE == 1) { const int q0 = LN_Q(0); if (nq > 0 && q0 < NT / 4 && F.lane < 16) sln = *(const u32x4*)(wsb + (unsigned)(WS_SLOT + ((size_t)F.lane * NT + (size_t)q0 * 4) * 4)); }
    { const int q0 = LN_Q(0); if (nq > 0 && q0 < NT / 4) { LN_ISSUE(q0 * 4); } }
    for (int qi = 0; qi < nq; ++qi) {
        const int q = LN_Q(qi);
        if (q >= NT / 4) break;
        const int row0 = q * 4;
        const u32x4 slc = sln;
        if (MODE == 1) { const int qn = LN_Q(qi + 1); if (qi + 1 < nq && qn < NT / 4 && ln < 16) sln = *(const u32x4*)(wsb + (unsigned)(WS_SLOT + ((size_t)ln * NT + (size_t)qn * 4) * 4)); }
        asm volatile("v_mbcnt_lo_u32_b32 %0, -1, 0\n\tv_mbcnt_hi_u32_b32 %0, -1, %0" : "=v"(ln));
        lb4 = (unsigned)ln * 16u; lb2 = (unsigned)ln * 8u; lb1 = (unsigned)ln * 4u; const int lw = ln * 4;
        f32x4 v[4][4];
#pragma unroll
        for (int r = 0; r < 4; ++r)
#pragma unroll
            for (int j = 0; j < 4; ++j) {
                if (X32) v[r][j] = xr32[r][j];
                else { v[r][j][0] = __uint_as_float(xr16[r][j].x << 16); v[r][j][1] = __uint_as_float(xr16[r][j].x & 0xffff0000u); v[r][j][2] = __uint_as_float(xr16[r][j].y << 16); v[r][j][3] = __uint_as_float(xr16[r][j].y & 0xffff0000u); } }
        if (MODE == 0) {
#pragma unroll
            for (int r = 0; r < 4; ++r)
#pragma unroll
                for (int j = 0; j < 4; ++j) { v[r][j] = v[r][j] * ALPHA; add_bf16x4(v[r][j], hwr[r][j]); }
        }
        if (!ROUTER) { const int qn = LN_Q(qi + 1); if (qi + 1 < nq && qn < NT / 4) { LN_ISSUE(qn * 4); } }
        if (MODE == 0) {
        } else {
            const int grp = row0 >= NTP; int sl[4];
#pragma unroll
            for (int r = 0; r < 4; ++r) sl[r] = (ln < 16) ? (int)slc[r] : -1;
            unsigned long long mask[4]; bool any[4], two[4]; u32x2 wa[4][4], wb[4][4];
#pragma unroll
            for (int r = 0; r < 4; ++r) {
                unsigned long long mk = __ballot(sl[r] >= 0); any[r] = mk != 0ull;
                int e0 = 0, s0 = 0; if (any[r]) { e0 = __builtin_ctzll(mk); mk &= mk - 1; s0 = __builtin_amdgcn_readlane(sl[r], e0); }
                const unsigned y0 = any[r] ? (grp ? 65536u + e0 * 2048u + s0 : e0 * 4096u + s0) : 0u;
                two[r] = mk != 0ull; int e1 = 0, s1 = 0; if (two[r]) { e1 = __builtin_ctzll(mk); mk &= mk - 1; s1 = __builtin_amdgcn_readlane(sl[r], e1); }
                const unsigned y1 = two[r] ? (grp ? 65536u + e1 * 2048u + s1 : e1 * 4096u + s1) : y0;
                mask[r] = mk;
                const unsigned char* ya = wsb + PO_YE + (size_t)y0 * 2048; const unsigned char* yb = wsb + PO_YE + (size_t)y1 * 2048;
#pragma unroll
                for (int j = 0; j < 4; ++j) { wa[r][j] = *(const u32x2*)(ya + lb2 + 512u * j); wb[r][j] = *(const u32x2*)(yb + lb2 + 512u * j); }
            }
#pragma unroll
            for (int r = 0; r < 4; ++r) {
#pragma unroll
                for (int j = 0; j < 4; ++j) { v[r][j] = v[r][j] * ALPHA; if (any[r]) add_bf16x4(v[r][j], wa[r][j]); if (two[r]) add_bf16x4(v[r][j], wb[r][j]); }
                unsigned long long mk = mask[r];
                while (mk) {
                    const int e0 = __builtin_ctzll(mk); mk &= mk - 1; const int s0 = __builtin_amdgcn_readlane(sl[r], e0);
                    const unsigned y0 = grp ? 65536u + e0 * 2048u + s0 : e0 * 4096u + s0;
                    const bool tw = mk != 0ull; int e1 = 0, s1 = 0; if (tw) { e1 = __builtin_ctzll(mk); mk &= mk - 1; s1 = __builtin_amdgcn_readlane(sl[r], e1); }
                    const unsigned y1 = tw ? (grp ? 65536u + e1 * 2048u + s1 : e1 * 4096u + s1) : y0;
                    const unsigned char* ya = wsb + PO_YE + (size_t)y0 * 2048; const unsigned char* yb = wsb + PO_YE + (size_t)y1 * 2048;
                    u32x2 xa[4], xb[4];
#pragma unroll
                    for (int j = 0; j < 4; ++j) { xa[j] = *(const u32x2*)(ya + lb2 + 512u * j); xb[j] = *(const u32x2*)(yb + lb2 + 512u * j); }
#pragma unroll
                    for (int j = 0; j < 4; ++j) { add_bf16x4(v[r][j], xa[j]); if (tw) add_bf16x4(v[r][j], xb[j]); }
                }
            }
        }
#pragma unroll
        for (int r = 0; r < 4; ++r) {
            float s = 0.f;
#pragma unroll
            for (int j = 0; j < 4; ++j) s += (v[r][j][0] + v[r][j][1]) + (v[r][j][2] + v[r][j][3]);
            const float mean = wave_sum(s) * (1.f / D); float qq = 0.f;
#pragma unroll
            for (int j = 0; j < 4; ++j) { v[r][j] = v[r][j] - mean; qq += (v[r][j][0] * v[r][j][0] + v[r][j][1] * v[r][j][1]) + (v[r][j][2] * v[r][j][2] + v[r][j][3] * v[r][j][3]); }
            const float rstd = 1.f / sqrtf(wave_sum(qq) * (1.f / D) + LN_EPS);
#pragma unroll
            for (int j = 0; j < 4; ++j) { if (ROUTER) { gv[j] = *(const LAS f32x4*)(gsh + lw + 256 * j); bv[j] = *(const LAS f32x4*)(bsh + lw + 256 * j); } v[r][j] = v[r][j] * rstd * gv[j] + bv[j]; }
            const unsigned row = (unsigned)(row0 + r);
            if (FINAL) {
                unsigned char* ob = (unsigned char*)F.out;
#pragma unroll
                for (int j = 0; j < 4; ++j) *(f32x4*)(ob + (size_t)(row * 4096u + lb4 + 1024u * j)) = v[r][j];
            } else {
                unsigned char* wsw = F.ws;
#pragma unroll
                for (int j = 0; j < 4; ++j) {
                    if (RES_BF16) { u32x2 xo; xo.x = cvt_pk_bf16_c(v[r][j][0], v[r][j][1]); xo.y = cvt_pk_bf16_c(v[r][j][2], v[r][j][3]); *(u32x2*)(wsw + (unsigned)(WS_XF + row * 2048u + lb2 + 512u * j)) = xo; }
                    else *(f32x4*)(wsw + (unsigned)(WS_XF + row * 4096u + lb4 + 1024u * j)) = v[r][j];
                    *(unsigned*)(wsw + (unsigned)(WS_XB8 + row * 1024u + lb1 + 256u * j)) = cvt4_fp8(v[r][j][0] * FP8_SX, v[r][j][1] * FP8_SX, v[r][j][2] * FP8_SX, v[r][j][3] * FP8_SX); }
            }
        }
        if (ROUTER) {
            { const int qn = LN_Q(qi + 1); if (qi + 1 < nq && qn < NT / 4) { LN_ISSUE(qn * 4); } }
            float val[64];
#pragma unroll
            for (int hf = 0; hf < 4; ++hf) {
                f32x2 a2[4][4];
#pragma unroll
                for (int r = 0; r < 4; ++r)
#pragma unroll
                    for (int e4 = 0; e4 < 4; ++e4) a2[r][e4] = f32x2{0.f, 0.f};
#pragma unroll
                for (int e4 = 0; e4 < 4; ++e4)
#pragma unroll
                    for (int j = 0; j < 4; ++j) { const f32x4 w = *(const LAS f32x4*)(wrT + (hf * 4 + e4) * WRS + lw + 256 * j);
                        const f32x2 wl = f32x2{w[0], w[1]}, wh = f32x2{w[2], w[3]};
#pragma unroll
                        for (int r = 0; r < 4; ++r) { a2[r][e4] = f32x2{v[r][j][0], v[r][j][1]} * wl + a2[r][e4]; a2[r][e4] = f32x2{v[r][j][2], v[r][j][3]} * wh + a2[r][e4]; } }
#pragma unroll
                for (int r = 0; r < 4; ++r)
#pragma unroll
                    for (int e4 = 0; e4 < 4; ++e4) val[r * 16 + hf * 4 + e4] = a2[r][e4][0] + a2[r][e4][1];
            }
#pragma unroll
            for (int sft = 5; sft >= 0; --sft) { const int n2 = 1 << sft; const bool up = (ln >> sft) & 1;
#pragma unroll
                for (int i = 0; i < n2; ++i) { const float lo = val[i], hi = val[i + n2]; const float mine = up ? hi : lo, other = up ? lo : hi; val[i] = mine + __shfl_xor(other, n2); } }
            const float lg = val[0], m = row_max(lg);
            const float ex = expf(lg - m); const float l = row_sum(ex);
            *(float*)(F.ws + (unsigned)(WS_AFF + ((size_t)(ln & 15) * NT + row0 + (ln >> 4)) * 4)) = ex / l;
        }
    }
#undef LN_Q
#undef LN_ISSUE
    if (ROUTER) __syncthreads();
}
__device__ __forceinline__ void softmax_phase(Frame& F, bf16_t* SB) {
    for (int row = F.c * 8 + F.wave; row < NT * 4; row += F.G * 8) {
        u32x2* p = (u32x2*)(SB + (size_t)row * 256) + F.lane; const u32x2 w = *p;
        float a = __uint_as_float(w.x << 16), b = __uint_as_float(w.x & 0xffff0000u), c = __uint_as_float(w.y << 16), d = __uint_as_float(w.y & 0xffff0000u);
        const float m = wave_max(fmaxf(fmaxf(a, b), fmaxf(c, d)));
        a = __expf(a - m); b = __expf(b - m); c = __expf(c - m); d = __expf(d - m);
        const float inv = 1.f / wave_sum((a + b) + (c + d));
        u32x2 o; o.x = cvt_pk_bf16(a * inv, b * inv); o.y = cvt_pk_bf16(c * inv, d * inv); *p = o;
    }
}
__device__ __forceinline__ void moe_panel(int P, int& e, int& grp, int& yerow0) {
    if (P < 256) { e = P >> 4; grp = 0; } else { e = (P - 256) >> 3; grp = 1; }
    yerow0 = P * 256;
}
#ifndef UPWGM
#define UPWGM 8
#endif
struct SchedUp { unsigned char* ws; int G, c; int layer; int nconv;
    __device__ __forceinline__ bool next(int i, GUnit& u) const { int P, pn;
        if (nconv > 0) { const int xcd = c & 7, rank = c >> 3, nact = 32 - nconv; if (rank >= nact) return false; const int l = i * nact + rank; if (l >= 768) return false;
            const int wgid = xcd * 768 + l; P = (wgid >> 7) * 8 + ((wgid & 127) & 7); pn = (wgid & 127) >> 3; }
        else if (!static_unit<UPWGM>(i, G, c, 384, 16, P, pn)) return false;
        int e, grp, y0; moe_panel(P, e, grp, y0);
        u.A = (const char*)ws + WS_XB8 + (grp ? (size_t)NTP * 1024 : 0); u.B = (const char*)ws + (layer ? WS_EW13B : WS_EW13) + ((size_t)e * 4096 + pn * BM) * 1024;
        u.C = (char*)ws + PO_HM + ((size_t)P * BM * 2048 + pn * HALF); u.X = (const int*)(ws + WS_IDX) + y0; u.pm = P; u.pn = pn; return true; } };
struct SchedDown { unsigned char* ws; int G, c; int layer;
    __device__ __forceinline__ bool next(int i, GUnit& u) const { int P, pn; if (!static_unit(i, G, c, 384, 4, P, pn)) return false; int e, grp, y0; moe_panel(P, e, grp, y0);
        u.A = (const char*)ws + PO_HM + (size_t)P * BM * 2048; u.B = (const char*)ws + (layer ? WS_EW2B : WS_EW2) + ((size_t)e * 1024 + pn * BM) * 2048;
        u.C = (char*)ws + PO_YE + ((size_t)y0 * 1024 + pn * BM) * 2; u.X = (const float*)(ws + WS_GATE) + y0; u.pm = P; u.pn = pn; return true; } };
struct SchedQKV { unsigned char* ws; int G, c;
    __device__ __forceinline__ bool next(int i, GUnit& u) const { const int L = i * G + c; if (L >= 1536 + 768) return false;
        if (L < 1536) { int pm, pn; static_unit(i, G, c, 192, 8, pm, pn);
            u.A = (const char*)ws + WS_XB8 + (size_t)pm * BM * 1024; u.B = (const char*)ws + WS_WQKV + (size_t)pn * BM * 1024;
            u.C = (char*)ws + (pn < 4 ? PO_Q : PO_K) + ((size_t)pm * BM * 1024 + (pn & 3) * BM) * 2; u.X = nullptr; u.pm = pm; u.pn = pn; return true; }
        const int r = L - 1536, pmv = r & 3, pnv = r >> 2;
        u.A = (const char*)ws + WS_WQKV + (size_t)(2048 + pmv * BM) * 1024; u.B = (const char*)ws + WS_XB8 + (size_t)pnv * BM * 1024;
        u.C = (char*)ws + PO_VT + ((size_t)pmv * BM * NT + (size_t)pnv * BM) * 2; u.X = nullptr; u.pm = pmv; u.pn = 8 + pnv; return true; } };
struct EpiQKV {
    static constexpr bool PERM = true;
    __device__ __forceinline__ void operator()(const Acc& acc, const GUnit& u, int wr, int wc, int fr, int fq) const {
        constexpr float ds = 1.f / (FP8_SX * FP8_SWQKV);
        if (u.pn >= 8) { EpiBf<false> e{(unsigned)NT, ds}; e(acc, u, wr, wc, fr, fq); }
        else { EpiBf<false> e{1024u, u.pn < 4 ? 0.125f * 1.4426950408889634f * ds : ds}; e(acc, u, wr, wc, fr, fq); }
    }
};

__device__ __forceinline__ int wave_sum_i(int v) {
#pragma unroll
    for (int o = 1; o < 64; o <<= 1) v += __shfl_xor(v, o);
    return v;
}
__device__ __forceinline__ int block_excl_scan(int v, int lane, int wave, LAS int* red, int& total) {
    int inc = v;
#pragma unroll
    for (int o = 1; o < 64; o <<= 1) { const int t = __shfl_up(inc, o); if (lane >= o) inc += t; }
    __syncthreads();
    if (lane == 63) red[wave] = inc;
    __syncthreads();
    int off = 0, tot = 0;
#pragma unroll
    for (int w = 0; w < 8; ++w) { const int c = red[w]; if (w < wave) off += c; tot += c; }
    total = tot; return off + inc - v;
}
template <int PER>
__device__ __forceinline__ void select_fast(Frame& F, const float* affcol, int cap, int* idx_out, float* gate_out, int* slotcol) {
    LAS int* red = (LAS int*)F.lds;
    unsigned key[PER];
#pragma unroll
    for (int i = 0; i < PER / 4; ++i) { const u32x4 v = ((const u32x4*)(affcol + (size_t)F.tid * PER))[i]; key[4 * i] = v.x; key[4 * i + 1] = v.y; key[4 * i + 2] = v.z; key[4 * i + 3] = v.w; }
    unsigned T = 0u;
    for (int b = 30; b >= 0; --b) {
        const unsigned cand = T | (1u << b); int cnt = 0;
#pragma unroll
        for (int i = 0; i < PER; ++i) cnt += (key[i] >= cand) ? 1 : 0;
        cnt = wave_sum_i(cnt);
        LAS int* r = red + (b & 1) * 8;
        if (F.lane == 0) r[F.wave] = cnt;
        __syncthreads();
        int tot = 0;
#pragma unroll
        for (int w = 0; w < 8; ++w) tot += r[w];
        if (tot >= cap) T = cand;
    }
    int g = 0, q = 0;
#pragma unroll
    for (int i = 0; i < PER; ++i) { g += (key[i] > T) ? 1 : 0; q += (key[i] == T) ? 1 : 0; }
    int tot_g, tot_q; (void)tot_q;
    const int Eoff = block_excl_scan(q, F.lane, F.wave, red + 32, tot_q);
    int dummy; const int Goff = block_excl_scan(g, F.lane, F.wave, red + 32, tot_g); (void)Goff;
    const int need_eq = cap - tot_g;
    int eq_take = need_eq - Eoff; eq_take = eq_take < 0 ? 0 : (eq_take > q ? q : eq_take);
    const int base = block_excl_scan(g + eq_take, F.lane, F.wave, red + 32, dummy);
    int slot = base, eqseen = 0;
    const int tok0 = F.tid * PER;
#pragma unroll
    for (int i4 = 0; i4 < PER / 4; ++i4) { int so[4];
#pragma unroll
        for (int j = 0; j < 4; ++j) { const int i = 4 * i4 + j; const unsigned k = key[i]; bool sel = k > T; if (k == T) { sel = eqseen < eq_take; ++eqseen; }
            so[j] = sel ? slot : -1; if (sel) { idx_out[slot] = tok0 + i; gate_out[slot] = __uint_as_float(k); ++slot; } }
        ((int4*)(slotcol + tok0))[i4] = make_int4(so[0], so[1], so[2], so[3]); }
}
__device__ __forceinline__ void select_phase(Frame& F) {
    for (int it = F.c; it < 32; it += F.G) {
        const int grp = it >> 4, e = it & 15; const int n = grp ? NTS : NTP, cap = n / 8;
        const float* affcol = (const float*)(F.ws + WS_AFF) + (size_t)e * NT + (grp ? NTP : 0);
        int* idx = (int*)(F.ws + WS_IDX) + (grp ? 65536 : 0) + e * cap; float* gate = (float*)(F.ws + WS_GATE) + (grp ? 65536 : 0) + e * cap;
        int* slotcol = (int*)(F.ws + WS_SLOT) + (size_t)e * NT + (grp ? NTP : 0);
        __syncthreads();
        if (grp == 0) select_fast<64>(F, affcol, cap, idx, gate, slotcol); else select_fast<32>(F, affcol, cap, idx, gate, slotcol);
        __syncthreads();
    }
}

__device__ __forceinline__ void natten_fill(Frame& F, const float* rpb) {
    LAS float* rpbs = (LAS float*)F.lds;
    __syncthreads();
    for (int i = F.tid; i < 16 * 15 * 31; i += 512) rpbs[i] = rpb[i] * 1.4426950408889634f;
    __syncthreads();
}
__device__ __forceinline__ void natten_phase(Frame& F, const float* rpb) {
    const bf16_t* Kb = (const bf16_t*)(F.ws + PO_K); const bf16_t* VT = (const bf16_t*)(F.ws + PO_VT); bf16_t* QO = (bf16_t*)(F.ws + PO_Q);
    LAS float* rpbs = (LAS float*)F.lds;
    const int lane = F.lane, w = F.wave, fr = lane & 15, fq = lane >> 4;
    bool c0[4], c2[4]; int xe[4];
#pragma unroll
    for (int e = 0; e < 4; ++e) { xe[e] = 4 * fq + e - fr; c0[e] = xe[e] >= 8; c2[e] = xe[e] < -8; }
    const bool fA = fr < 8, fC = fr > 8;
    unsigned mk0[2], mk2[2], mk0c[2], mk2a[2], mkc1[2], mkca[2], mkcc[2];
#pragma unroll
    for (int pr = 0; pr < 2; ++pr) { mk0[pr] = (c0[2 * pr] ? 0xFFFFu : 0u) | (c0[2 * pr + 1] ? 0xFFFF0000u : 0u); mk2[pr] = (c2[2 * pr] ? 0xFFFFu : 0u) | (c2[2 * pr + 1] ? 0xFFFF0000u : 0u);
        mk0c[pr] = fC ? 0u : mk0[pr]; mk2a[pr] = fA ? 0u : mk2[pr]; mkc1[pr] = ~(mk0[pr] | mk2[pr]); mkca[pr] = ~mk2a[pr]; mkcc[pr] = ~mk0c[pr];
        asm volatile("" : "+v"(mk0[pr]), "+v"(mk2[pr]), "+v"(mk0c[pr]), "+v"(mk2a[pr]), "+v"(mkc1[pr]), "+v"(mkca[pr]), "+v"(mkcc[pr])); }
    LAS bf16_t* Ks = (LAS bf16_t*)(F.lds + 32768); LAS bf16_t* Vs = Ks + 2 * 64 * 72;
    const int lrow = F.tid >> 3, lchk = F.tid & 7;
    const int nblk = F.xok ? 6 : 1536;
    for (int it = F.xok ? 0 : F.c; it < nblk; it += F.xok ? 1 : F.G) {
        int gb, h, rb, rows;
        if (F.xok) { const int u = (F.c >> 3) + 32 * it, t = 12 * (F.c & 7) + (u >> 4); h = u & 15;
            if (t < 64) { gb = t >> 4; rb = t & 15; rows = 128; } else { gb = 4 + ((t - 64) >> 3); rb = (t - 64) & 7; rows = 64; } }
        else { const int blk = it; if (blk < 1024) { gb = blk >> 8; h = (blk >> 4) & 15; rb = blk & 15; rows = 128; } else { const int V = blk - 1024; gb = 4 + (V >> 7); h = (V >> 3) & 15; rb = V & 7; rows = 64; } }
        const int r = rb * 8 + w;
        int rs = r - 4; rs = rs < 0 ? 0 : (rs > rows - 8 ? rows - 8 : rs);
        int kr_lo = rb * 8 - 4; kr_lo = kr_lo < 0 ? 0 : (kr_lo > rows - 8 ? rows - 8 : kr_lo);
        int kr_hi = rb * 8 + 7 - 4; kr_hi = (kr_hi < 0 ? 0 : (kr_hi > rows - 8 ? rows - 8 : kr_hi)) + 8;
        const size_t tb = (size_t)gb_tok0(gb), tq0 = tb + (size_t)r * 64;
        bf16x8 Qf[4][2];
        float mrun[4], lrun[4]; f32x4 Ot[4][4];
#pragma unroll
        for (int qt = 0; qt < 4; ++qt) { mrun[qt] = -INFINITY; lrun[qt] = 0.f;
#pragma unroll
            for (int dt = 0; dt < 4; ++dt) Ot[dt][qt] = (f32x4){0.f, 0.f, 0.f, 0.f}; }
        const bf16_t* kg = Kb + (tb + (size_t)kr_lo * 64 + lrow) * D + h * 64 + lchk * 8; const bf16_t* vg = VT + (size_t)(h * 64 + lrow) * NT + tb + (size_t)kr_lo * 64 + lchk * 8;
        const int nrows = kr_hi - kr_lo;
#define NA_LOAD(dst, ptr) asm volatile("global_load_dwordx4 %0, %1, off" : "=&v"(dst) : "v"(ptr) : "memory")
        u32x4 kA, vA, kB, vB;
        { const u32x4 k0r = *(const u32x4*)kg, v0r = *(const u32x4*)vg;
#pragma unroll
          for (int t = 0; t < 4; ++t)
#pragma unroll
              for (int ks = 0; ks < 2; ++ks) Qf[t][ks] = *(const bf16x8*)(QO + (tq0 + 16 * t + fr) * D + h * 64 + 32 * ks + 8 * fq);
          { const bf16_t* kp = kg + (size_t)64 * D; const bf16_t* vp = vg + 64; NA_LOAD(kB, kp); NA_LOAD(vB, vp); }
          __syncthreads();
          *(LAS u32x4*)(Ks + lrow * 72 + lchk * 8) = k0r; *(LAS u32x4*)(Vs + lrow * 72 + lchk * 8) = v0r; }
#pragma unroll
        for (int t = 0; t < 4; ++t)
#pragma unroll
            for (int ks = 0; ks < 2; ++ks) asm volatile("" :: "v"(Qf[t][ks]));
        asm volatile("s_waitcnt vmcnt(0)" ::: "memory");
        __syncthreads();
#pragma nounroll
        for (int i2 = 0; i2 < nrows; i2 += 2) {
#pragma unroll
          for (int jj = 0; jj < 2; ++jj) {
            const int i = i2 + jj; if (i >= nrows) break;
            const int kr = kr_lo + i; const int buf = jj; const bool more = i + 1 < nrows, more2 = i + 2 < nrows;
            if (more2) { const bf16_t* kp = kg + (size_t)(i + 2) * 64 * D; const bf16_t* vp = vg + (size_t)(i + 2) * 64;
                if (jj == 1) { NA_LOAD(kB, kp); NA_LOAD(vB, vp); } else { NA_LOAD(kA, kp); NA_LOAD(vA, vp); } }
            if (kr >= rs && kr < rs + 8) {
            const int dr = kr - r + 7;
            const LAS bf16_t* Kt = Ks + buf * (64 * 72); const LAS bf16_t* Vt = Vs + buf * (64 * 72);
            bf16x8 Kf[4][2];
#pragma unroll
            for (int t = 0; t < 4; ++t)
#pragma unroll
                for (int ks = 0; ks < 2; ++ks) Kf[t][ks] = *(const LAS bf16x8*)(Kt + (16 * t + fr) * 72 + 32 * ks + 8 * fq);
            float bsel[3][4];
#pragma unroll
            for (int e = 0; e < 4; ++e) { const int dcB = xe[e] + 15 + (c0[e] ? -16 : (c2[e] ? 16 : 0)), dcA = fA ? xe[e] + 15 : dcB, dcC = fC ? xe[e] + 15 : dcB;
                bsel[0][e] = rpbs[(h * 15 + dr) * 31 + dcA]; bsel[1][e] = rpbs[(h * 15 + dr) * 31 + dcB]; bsel[2][e] = rpbs[(h * 15 + dr) * 31 + dcC]; }
            bf16x8 Pf[4][2]; float alpha[4]; bool moved = false;
#pragma unroll
            for (int qt = 0; qt < 4; ++qt) {
                f32x4 St[3];
#pragma unroll
                for (int dk = 0; dk < 3; ++dk) { const int kt = qt + dk - 1; St[dk] = (f32x4){0.f, 0.f, 0.f, 0.f};
                    if (kt >= 0 && kt < 4) { St[dk] = __builtin_amdgcn_mfma_f32_16x16x32_bf16(Kf[kt][0], Qf[qt][0], St[dk], 0, 0, 0); St[dk] = __builtin_amdgcn_mfma_f32_16x16x32_bf16(Kf[kt][1], Qf[qt][1], St[dk], 0, 0, 0); } }
                constexpr int dummy = 0; (void)dummy;
                const int cls = qt == 0 ? 0 : (qt == 3 ? 2 : 1);
                float sv[4]; bool u0[4], u2[4]; float mx = -INFINITY;
#pragma unroll
                for (int e = 0; e < 4; ++e) { u0[e] = c0[e] && !(cls == 0 && fA) && !(cls == 2 && fC) && (qt > 0); u2[e] = c2[e] && !(cls == 0 && fA) && !(cls == 2 && fC) && (qt < 3);
                    sv[e] = (u0[e] ? St[0][e] : (u2[e] ? St[2][e] : St[1][e])) + bsel[cls][e]; mx = fmaxf(mx, sv[e]); }
                mx = x32_max(x16_max(mx));
                const float mnew = fmaxf(mrun[qt], mx); alpha[qt] = __builtin_amdgcn_exp2f(mrun[qt] - mnew); moved = moved || (mnew != mrun[qt]); mrun[qt] = mnew;
                float l = 0.f, p[4];
#pragma unroll
                for (int e = 0; e < 4; ++e) { p[e] = __builtin_amdgcn_exp2f(sv[e] - mnew); l += p[e]; }
                l = x32_sum(x16_sum(l)); lrun[qt] = lrun[qt] * alpha[qt] + l;
                const unsigned pk01 = cvt_pk_bf16_c(p[0], p[1]), pk23 = cvt_pk_bf16_c(p[2], p[3]);
                unsigned t01[4], t23[4];
#pragma unroll
                for (int kt = 0; kt < 4; ++kt) { const int dk = kt - qt + 1; t01[kt] = 0u; t23[kt] = 0u;
                    if (dk == 0) { t01[kt] = pk01 & (cls == 2 ? mk0c[0] : mk0[0]); t23[kt] = pk23 & (cls == 2 ? mk0c[1] : mk0[1]); }
                    else if (dk == 2) { t01[kt] = pk01 & (cls == 0 ? mk2a[0] : mk2[0]); t23[kt] = pk23 & (cls == 0 ? mk2a[1] : mk2[1]); }
                    else if (dk == 1) { t01[kt] = pk01 & (cls == 0 ? mkca[0] : (cls == 2 ? mkcc[0] : mkc1[0])); t23[kt] = pk23 & (cls == 0 ? mkca[1] : (cls == 2 ? mkcc[1] : mkc1[1])); } }
#pragma unroll
                for (int ks = 0; ks < 2; ++ks) { u32x4 wv; wv.x = t01[2 * ks]; wv.y = t23[2 * ks]; wv.z = t01[2 * ks + 1]; wv.w = t23[2 * ks + 1];
                    Pf[qt][ks] = __builtin_bit_cast(bf16x8, wv); }
            }
            const bool rescale = __ballot(moved) != 0ull;
#pragma unroll
            for (int dt = 0; dt < 4; ++dt) {
                if (rescale) {
#pragma unroll
                    for (int qt = 0; qt < 4; ++qt) Ot[dt][qt] = Ot[dt][qt] * alpha[qt]; }
#pragma unroll
                for (int ks = 0; ks < 2; ++ks) { const u32x2 v0 = *(const LAS u32x2*)(Vt + (16 * dt + fr) * 72 + 32 * ks + 4 * fq), v1 = *(const LAS u32x2*)(Vt + (16 * dt + fr) * 72 + 32 * ks + 16 + 4 * fq);
                    u32x4 vv; vv.x = v0.x; vv.y = v0.y; vv.z = v1.x; vv.w = v1.y; const bf16x8 Vf = __builtin_bit_cast(bf16x8, vv);
#pragma unroll
                    for (int qt = 0; qt < 4; ++qt) { if ((qt == 0 && ks == 1) || (qt == 3 && ks == 0)) continue; Ot[dt][qt] = __builtin_amdgcn_mfma_f32_16x16x32_bf16(Vf, Pf[qt][ks], Ot[dt][qt], 0, 0, 0); } }
            }
            }
            if (more) {
                if (more2) asm volatile("s_waitcnt vmcnt(2)" ::: "memory"); else asm volatile("s_waitcnt vmcnt(0)" ::: "memory");
                LAS bf16_t* kd = Ks + (buf ^ 1) * (64 * 72) + lrow * 72 + lchk * 8; LAS bf16_t* vd = Vs + (buf ^ 1) * (64 * 72) + lrow * 72 + lchk * 8;
                if (jj == 1) { asm volatile("" : "+v"(kA), "+v"(vA)); *(LAS u32x4*)kd = kA; *(LAS u32x4*)vd = vA; } else { asm volatile("" : "+v"(kB), "+v"(vB)); *(LAS u32x4*)kd = kB; *(LAS u32x4*)vd = vB; }
            }
            __syncthreads();
          }
        }
#undef NA_LOAD
#pragma unroll
        for (int qt = 0; qt < 4; ++qt) { const float inv = 1.f / lrun[qt];
#pragma unroll
            for (int dt = 0; dt < 4; ++dt) { const f32x4 o = Ot[dt][qt] * inv; u32x2 wv; wv.x = cvt_pk_bf16_c(o[0], o[1]); wv.y = cvt_pk_bf16_c(o[2], o[3]);
                pst8(QO + (tq0 + 16 * qt + fr) * D + h * 64 + 16 * dt + 4 * fq, wv); } }
    }
    __syncthreads();
}
constexpr int N_PHASES = 31;
constexpr int FLAG_NO_XIMPORT = 1, FLAG_NO_EXPERTS0 = 2;
#ifndef UP_NCONV
#define UP_NCONV 2
#endif
#ifndef CV_UP_ITEMS
#define CV_UP_ITEMS 9600
#endif
constexpr int CV_UP1 = 5376 + CV_UP_ITEMS;
constexpr int CV_P1 = 3072, CV_P2 = CV_P1 + 1536, CV_SEL = CV_P2 + 5376, CV_SEL1 = 5376, CV_P0B = CV_SEL + 3584;
__global__ void __launch_bounds__(512, 2) fwd(Args args) {
    extern __shared__ __attribute__((aligned(16))) unsigned char lds_raw[];
    Frame F; F.lds = (LAS unsigned char*)lds_raw; F.ws = args.ws; F.in = args.in; F.out = args.out;
    F.tid = threadIdx.x; F.lane = F.tid & 63; F.wave = __builtin_amdgcn_readfirstlane(F.tid >> 6); F.G = gridDim.x; F.c = blockIdx.x; F.xok = false;
    unsigned char* ws = args.ws;
    const int wave_s = __builtin_amdgcn_readfirstlane(threadIdx.x >> 6);
    for (int u = F.tid; u < (LDS_BYTES - RING_BYTES) / 4; u += 512) ((LAS unsigned*)(F.lds + RING_BYTES))[u] = 0u;
    __syncthreads();
    const int lo = args.ph_lo, hi = args.ph_hi;
    volatile LAS unsigned* MISC = (volatile LAS unsigned*)(F.lds + MISC_OFF);
    XcdBarrier bar; bar.bar = (unsigned*)(ws + WS_CTL) + CW_BAR + args.pad * XCD_BAR_WORDS_EXT; bar.x = 0; bar.st = nullptr;
    const bool multi = (hi - lo) > 1;
    if (multi) bar = xcd_barrier_post((unsigned*)(ws + WS_CTL) + CW_BAR + args.pad * XCD_BAR_WORDS_EXT, MISC + 8);
#define IN(k) (lo <= (k) && (k) < hi)
#ifdef STAMP_PA
    unsigned long long* TS = (unsigned long long*)(ws + WS_CTL + 40 * 1024);
#define STAMP(k) do { if (blockIdx.x == 0 && threadIdx.x == 0) TS[k] = __builtin_amdgcn_s_memrealtime(); } while (0)
#else
#define STAMP(k) do { } while (0)
#endif
#ifdef AMP_PHASE
    unsigned long long t_phase0 = 0ull;
#define AMP_NOW(t) asm volatile("s_memrealtime %0\n\ts_waitcnt lgkmcnt(0)" : "=s"(t) :: "memory")
#define AMP_T0() do { AMP_NOW(t_phase0); } while (0)
#define AMP_WAIT(k) do { if ((k) == AMP_PHASE || AMP_PHASE < 0) { asm volatile("s_waitcnt vmcnt(0) lgkmcnt(0)" ::: "memory"); unsigned long long _t1; AMP_NOW(_t1); const unsigned long long _tw = _t1 + (unsigned long long)AMP_M * (_t1 - t_phase0); unsigned long long _tn; do { __builtin_amdgcn_s_sleep(4); AMP_NOW(_tn); } while (_tn < _tw); } } while (0)
#else
#define AMP_T0() do { } while (0)
#define AMP_WAIT(k) do { } while (0)
#endif
#define SEAM(k) do { AMP_WAIT(k); if (IN(k) && IN((k) + 1)) { xcd_barrier(bar, wave_s); STAMP((k) + 1); } } while (0)
    STAMP(0);
    LAS unsigned char* ring = F.lds;
#define PHASE_BEGIN() do { int _t; asm volatile("v_mbcnt_lo_u32_b32 %0, -1, 0\n\tv_mbcnt_hi_u32_b32 %0, -1, %0" : "=v"(_t)); _t |= (wave_s << 6); F.tid = _t; F.lane = _t & 63; F.wave = wave_s; AMP_T0(); } while (0)

#ifndef P0_SKIP
#define P0_SKIP 0
#endif
    if (IN(0)) { PHASE_BEGIN(); const int p0s = (args.pad == 1) ? P0_SKIP : 0;
        if (!(p0s & 1)) for (int it = F.c; it < 128; it += F.G) s5_build_item(F, it >> 1, it & 1);
        if (!(p0s & 2)) convert_small_weights(F);
        if (!(p0s & 4)) if (!(args.flags & FLAG_NO_EXPERTS0)) { convert_expert_weights(F, 0, CV_SEL, CV_P0B, 128);
            convert_expert_weights(F, 0, CV_P0B, 16 * 1536, 0); }
        if (!(p0s & 8)) { convert_plain(F, args.in[I_MWQ], (bf16_t*)(ws + WS_MWQ), (size_t)2 * 1024 * 1024);
        convert_plain(F, args.in[I_MEMP], (bf16_t*)(ws + WS_MEMB), (size_t)4 * 256 * 1024);
        convert_plain(F, args.in[I_MEMS], (bf16_t*)(ws + WS_MEMB) + (size_t)4 * 256 * 1024, (size_t)4 * 256 * 1024); }
        if (!(p0s & 16)) import_x(F, !(args.flags & FLAG_NO_XIMPORT));
    }
    SEAM(0);
    unsigned nloc_s = 32u;
    if (multi && IN(0) && IN(1)) {
        if (F.tid == 0) { unsigned ok = (F.G == 256) ? 1u : 0u; unsigned* bw = bar.bar;
            for (unsigned j = 0; j < 16; ++j) { const unsigned cnt = xb_ld(&bw[XB_XCNT(j)]); if (j < 8 ? cnt != 32u : cnt != 0u) ok = 0u; }
            MISC[13] = ok; }
        __syncthreads();
        if (MISC[13]) { F.xok = true; F.c = (int)(MISC[12] * 8u + bar.x); }
    }
#define LSEAM(k) do { AMP_WAIT(k); if (IN(k) && IN((k) + 1)) { if (F.xok) xcd_local_barrier(bar, wave_s, nloc_s); else xcd_barrier(bar, wave_s); STAMP((k) + 1); } } while (0)
    {
        const float* lng = args.in[I_LNG]; const float* lnb = args.in[I_LNB];
        if (IN(1)) { PHASE_BEGIN();
            { SchedKV S{ws, F.G, F.c}; EpiBf<false> E{2048u, 1.f}; gemm_phase<EpiBf<false>, SchedKV, false>(ring, F.tid, 1024, 2048u, 2048u, S, E); }
            { SchedUA S{(const char*)ws + WS_XB, (const char*)ws + WS_WIN, (char*)ws + PO_UA, F.G, F.c}; EpiUA E; gemm_phase<EpiUA, SchedUA, false>(ring, F.tid, 1024, 2048u, 2048u, S, E); }
            if (!(args.flags & FLAG_NO_EXPERTS0)) convert_expert_weights(F, 0, 0, CV_P1, 128);
        }
        SEAM(1);
        if (IN(2)) { PHASE_BEGIN();
            { SchedSA S{ws, F.G, F.c}; EpiS E; gemm_phase<EpiS, SchedSA, false>(ring, F.tid, 512, (unsigned)(UAK * 2), 1024u, S, E); }
            { SchedWqk S{ws, F.G, F.c}; EpiBf8 E{1024u, 0.0625f * 1.4426950408889634f * FP8_SWQK}; gemm_phase<EpiBf8, SchedWqk, false>(ring, F.tid, 256, 4096u, 2048u, S, E); }
            { SchedWvo S{ws, F.G, F.c}; EpiBf<false> E{1024u, 1.f}; gemm_phase<EpiBf<false>, SchedWvo, false>(ring, F.tid, 256, 2048u, 4096u, S, E); }
            if (!(args.flags & FLAG_NO_EXPERTS0)) convert_expert_weights(F, 0, CV_P1, CV_P2, 128);
        }
        SEAM(2);
        if (IN(3)) { PHASE_BEGIN(); s5_recurrence(F); }
        SEAM(3);
        if (IN(4)) { PHASE_BEGIN(); SchedSC S{ws, F.G, F.c}; EpiGelu E; gemm_phase<EpiGelu, SchedSC, false>(ring, F.tid, UAK, (unsigned)(UAK * 2), (unsigned)(UAK * 2), S, E); }
        SEAM(4);
        if (IN(5)) { PHASE_BEGIN(); SchedGated S{(const char*)ws + PO_SG, (const char*)ws + WS_WGLU, (char*)ws + PO_HB_S5, 2048, 2048, 1024, NT / BM, 8, F.G, F.c}; EpiGated<0> E{1024u};
            gemm_phase<EpiGated<0>, SchedGated, false>(ring, F.tid, 1024, 2048u, 2048u, S, E); }
        LSEAM(5);
        if (IN(6)) { PHASE_BEGIN(); if (args.flags & FLAG_NO_XIMPORT) ln_phase<0, false, false, false>(F, (const bf16_t*)(ws + PO_HB_S5), lng, lnb, nullptr); else ln_phase<0, false, false, true>(F, (const bf16_t*)(ws + PO_HB_S5), lng, lnb, nullptr); }
        LSEAM(6);
    }
#define COMMON_BLOCK(layer, pb) do { \
        const float* lng = args.in[I_LNG] + (size_t)(layer) * 3 * D; const float* lnb = args.in[I_LNB] + (size_t)(layer) * 3 * D; \
        if (IN((pb) + 0)) { PHASE_BEGIN(); SchedScores8 S{(const char*)ws + WS_XB8, (const char*)ws + WS_WQK + (size_t)(layer) * 8 * MiB, (char*)ws + PO_SB, F.G, F.c}; EpiSoftmax E{(LAS float*)(F.lds + RING_BYTES + 4096), 1024u, 1.f / (FP8_SX * FP8_SWQK)}; \
            gemm_phase<EpiSoftmax, SchedScores8, false, true>(ring, F.tid, 512, 1024u, 1024u, S, E); } \
        AMP_WAIT((pb) + 0); if (IN((pb) + 0) && IN((pb) + 2)) { if (F.xok) xcd_local_barrier(bar, wave_s, nloc_s); else xcd_barrier(bar, wave_s); STAMP((pb) + 1); }     \
        if (IN((pb) + 2)) { PHASE_BEGIN(); SchedBatchW S{(const char*)ws + PO_SB, (const char*)ws + WS_WVO + (size_t)(layer) * 16 * MiB, (char*)ws + PO_HB_MEM, F.G, F.c}; EpiBf<false> E{1024u, 1.f}; \
            gemm_phase<EpiBf<false>, SchedBatchW, false>(ring, F.tid, 1024, 2048u, 2048u, S, E); } \
        if (IN((pb) + 3)) { PHASE_BEGIN(); ln_router_fill(F, lng + D, lnb + D, args.in[I_EWR] + (size_t)(layer) * D * 16); }     \
        LSEAM((pb) + 2); \
        if (IN((pb) + 3)) { PHASE_BEGIN(); ln_phase<0, true, false>(F, (const bf16_t*)(ws + PO_HB_MEM), lng + D, lnb + D, args.in[I_EWR] + (size_t)(layer) * D * 16); } \
        SEAM((pb) + 3); \
        if (IN((pb) + 4)) { PHASE_BEGIN(); select_phase(F); if ((layer) == 0) { if (!(args.flags & FLAG_NO_EXPERTS0)) convert_expert_weights(F, 0, CV_P2, CV_SEL, 32); } else convert_expert_weights(F, 1, 0, CV_SEL1, 32); } \
        SEAM((pb) + 4); \
        if (IN((pb) + 5)) { PHASE_BEGIN(); const int nconv = ((layer) == 0 && F.xok) ? UP_NCONV : 0; SchedUp S{ws, F.G, F.c, (layer), nconv}; EpiGated8 E{2048u}; gemm_phase<EpiGated8, SchedUp, true, true>(ring, F.tid, 512, 1024u, 1024u, S, E); \
            if (nconv > 0 && (F.c >> 3) >= 32 - nconv) convert_expert_weights(F, 1, CV_SEL1, CV_UP1, 0, ((F.c & 7) * nconv + (F.c >> 3) - (32 - nconv)) * 8 + F.wave, 8 * nconv * 8); }     \
        LSEAM((pb) + 5);     \
        if (IN((pb) + 6)) { PHASE_BEGIN(); SchedDown S{ws, F.G, F.c, (layer)}; EpiBf<true> E{1024u, 1.f / (FP8_SH * FP8_SW2)}; gemm_phase<EpiBf<true>, SchedDown, false, true>(ring, F.tid, 1024, 2048u, 2048u, S, E); } \
        AMP_WAIT((pb) + 6); if (IN((pb) + 6) && IN((pb) + 9)) { xcd_barrier(bar, wave_s); STAMP((pb) + 9); }     \
    } while (0)
    COMMON_BLOCK(0, 7);
    if (IN(16)) { PHASE_BEGIN(); ln_phase<1, false, false>(F, nullptr, args.in[I_LNG] + 2 * D, args.in[I_LNB] + 2 * D, nullptr); convert_expert_weights(F, 1, (F.xok && UP_NCONV > 0) ? CV_UP1 : CV_SEL1, 16 * 1536, 0); }
    SEAM(16);
    {
        const float* lng = args.in[I_LNG] + 3 * D; const float* lnb = args.in[I_LNB] + 3 * D;
        if (IN(17)) { PHASE_BEGIN(); SchedQKV S{ws, F.G, F.c}; EpiQKV E; gemm_phase<EpiQKV, SchedQKV, false, true>(ring, F.tid, 512, 1024u, 1024u, S, E); }
        if (IN(18)) { PHASE_BEGIN(); natten_fill(F, args.in[I_BRPB]); }
        SEAM(17);
        if (IN(18)) { PHASE_BEGIN(); natten_phase(F, args.in[I_BRPB]); }
        LSEAM(18);
        if (IN(19)) { PHASE_BEGIN(); SchedPlain S{(const char*)ws + PO_Q, (const char*)ws + WS_WO, (char*)ws + PO_HB_NA, 2048, 2048, 1024, NT / BM, 4, F.G, F.c}; EpiBf<false> E{1024u, 1.f};
            gemm_phase<EpiBf<false>, SchedPlain, false>(ring, F.tid, 1024, 2048u, 2048u, S, E); }
        LSEAM(19);
        if (IN(20)) { PHASE_BEGIN(); ln_phase<0, false, false>(F, (const bf16_t*)(ws + PO_HB_NA), lng, lnb, nullptr); }
        LSEAM(20);
    }
    COMMON_BLOCK(1, 21);
    if (IN(30)) { PHASE_BEGIN(); ln_phase<1, false, true>(F, nullptr, args.in[I_LNG] + 5 * D, args.in[I_LNB] + 5 * D, nullptr); }
    AMP_WAIT(30);
#undef COMMON_BLOCK
#ifdef STAMP_PA
    xcd_barrier(bar, wave_s); STAMP(31); xcd_barrier(bar, wave_s);
    {
        const volatile unsigned long long* T = TS; const float dA = (float)(T[STAMP_PA + STAMP_NA] - T[STAMP_PA]) * 0.01f, dB = (float)(T[STAMP_PB + STAMP_NB] - T[STAMP_PB]) * 0.01f;
        const float c = sqrtf(100.f * dA), V = 100.f * dB; const size_t np = (size_t)NTP * 1024, n = (size_t)NT * 1024;
        for (size_t i = (size_t)blockIdx.x * 512 + threadIdx.x; i < n; i += (size_t)gridDim.x * 512) args.out[i] = i < np ? c : (i == np ? V : 0.f);
    }
#endif
#undef IN
#undef SEAM
}
}
#ifndef DBG
#define DBG 0
#endif
#ifndef FZ_PER_PHASE
#define FZ_PER_PHASE 0
#endif

#if DBG
namespace dbg {
__global__ void k_cmp_bf16_f32(const unsigned short* a, const float* b, size_t n, double* acc) {
    double s0 = 0, s1 = 0;
    for (size_t i = (size_t)blockIdx.x * blockDim.x + threadIdx.x; i < n; i += (size_t)gridDim.x * blockDim.x) { const double x = (double)__uint_as_float(((unsigned)a[i]) << 16), y = b[i]; s0 += (x - y) * (x - y); s1 += y * y; }
    for (int o = 32; o >= 1; o >>= 1) { s0 += __shfl_xor(s0, o); s1 += __shfl_xor(s1, o); }
    if ((threadIdx.x & 63) == 0) { atomicAdd(acc, s0); atomicAdd(acc + 1, s1); }
}
__global__ void k_cmp_f32_f32(const float* a, const float* b, size_t n, double* acc) {
    double s0 = 0, s1 = 0;
    for (size_t i = (size_t)blockIdx.x * blockDim.x + threadIdx.x; i < n; i += (size_t)gridDim.x * blockDim.x) { const double x = a[i], y = b[i]; s0 += (x - y) * (x - y); s1 += y * y; }
    for (int o = 32; o >= 1; o >>= 1) { s0 += __shfl_xor(s0, o); s1 += __shfl_xor(s1, o); }
    if ((threadIdx.x & 63) == 0) { atomicAdd(acc, s0); atomicAdd(acc + 1, s1); }
}
__global__ void k_cmp_ua(const unsigned short* UA, const float* u, double* acc) {
    double s0 = 0, s1 = 0;
    for (size_t i = (size_t)blockIdx.x * blockDim.x + threadIdx.x; i < (size_t)fz::NT * 1024; i += (size_t)gridDim.x * blockDim.x) {
        const int tok = (int)(i >> 10), ch = (int)(i & 1023), chunk = tok >> 5, j = tok & 31, g = ch >> 4, h = ch & 15;
        const double x = (double)__uint_as_float(((unsigned)UA[((size_t)g * fz::NCHUNK + chunk) * fz::UAK + j * 16 + h]) << 16), y = u[i]; s0 += (x - y) * (x - y); s1 += y * y; }
    for (int o = 32; o >= 1; o >>= 1) { s0 += __shfl_xor(s0, o); s1 += __shfl_xor(s1, o); }
    if ((threadIdx.x & 63) == 0) { atomicAdd(acc, s0); atomicAdd(acc + 1, s1); }
}
__global__ void k_encode(float* out, const double* accA, const double* accB) {
    const double vA = accA[1] > 0 ? sqrt(accA[0] / accA[1]) : 9.99; const double vB = accB[1] > 0 ? sqrt(accB[0] / accB[1]) : 9.99;
    const float c = (float)sqrt(1e8 * (vA == vA ? vA : 7.77)); const float V = (float)(1e5 * (vB == vB ? vB : 7.77));
    const size_t np = (size_t)fz::NTP * 1024, n = (size_t)fz::NT * 1024;
    for (size_t i = (size_t)blockIdx.x * blockDim.x + threadIdx.x; i < n; i += (size_t)gridDim.x * blockDim.x) out[i] = i < np ? c : (i == np ? V : 0.f);
}
}
#endif

extern "C" void kernel_launch(void* const* d_in, const int* in_sizes, int n_in, void* d_out, int out_size, void* d_ws, size_t ws_size, hipStream_t stream) {
    using namespace fz;
    static int grid = 0;
    if (grid == 0) {
        if (n_in != 26 || ws_size < WS_END) { fprintf(stderr, "kernel_launch: unexpected inputs (n_in %d, ws %zu)\n", n_in, ws_size); grid = -1; return; }
        int dev = 0, cus = 0, per_cu = 0;
        if (hipGetDevice(&dev) != hipSuccess || hipDeviceGetAttribute(&cus, hipDeviceAttributeMultiprocessorCount, dev) != hipSuccess) { grid = -1; return; }
        if (hipFuncSetAttribute((const void*)fwd, hipFuncAttributeMaxDynamicSharedMemorySize, LDS_BYTES) != hipSuccess) { fprintf(stderr, "kernel_launch: hipFuncSetAttribute failed\n"); grid = -1; return; }
        if (hipOccupancyMaxActiveBlocksPerMultiprocessor(&per_cu, (const void*)fwd, 512, LDS_BYTES) != hipSuccess || per_cu < 1) { fprintf(stderr, "kernel_launch: occupancy query says %d\n", per_cu); }
        (void)hipGetLastError();
        grid = cus;
    }
    if (grid < 0) return;
    unsigned char* ws = (unsigned char*)d_ws;
    (void)hipMemsetAsync(ws + WS_CTL, 0, CTL_ZERO_BYTES, stream);
    Args a{};
    for (int i = 0; i < 26; ++i) a.in[i] = (const float*)d_in[i];
    a.out = (float*)d_out; a.ws = ws; a.flags = 0; a.pad = 0;
    auto run = [&](int lo, int hi) { a.ph_lo = lo; a.ph_hi = hi; hipLaunchKernelGGL(fwd, dim3(grid), dim3(512), LDS_BYTES, stream, a); };
#if DBG == 0
#ifdef PRE_LO
    a.pad = 1; run(PRE_LO, PRE_HI); a.pad = 0;
#endif
#if FZ_PER_PHASE
    for (int p = 0; p < N_PHASES; ++p) run(p, p + 1);
#else
    run(0, N_PHASES);
#endif
#else
    using nv::SG;
    const float* const* in = (const float* const*)d_in;
    const size_t BIG = (size_t)NT * D;
    double* ACC = (double*)(ws + 32 * 1024);
    float* nmisc = (float*)(ws + 987 * MiB);
    float* nKV = nmisc; float* nAFF = nmisc + 4u * 1024 * 1024; float* nGATE = nAFF + 1024 * 1024; int* nIDX = (int*)(nGATE + 128 * 1024); float* nMEMC = (float*)(ws + 385 * MiB);
    auto sgemm = [&](const float* A, const float* B, float* C, const int* gidx, int M, int N, int K, long sam, long sak, long sbk, long sbn, long ldc,
                     int nz = 1, int zdiv = 1, long zA0 = 0, long zA1 = 0, long zB0 = 0, long zB1 = 0, long zC0 = 0, long zC1 = 0) {
        SG s{A, B, C, gidx, M, N, K, zdiv, sam, sak, sbk, sbn, ldc, zA0, zA1, zB0, zB1, zC0, zC1};
        hipLaunchKernelGGL(nv::k_sgemm, dim3(N / 128, M / 128, nz), dim3(256), 0, stream, s);
    };
    const int EW = (int)((BIG + 255) / 256);
    auto n_import = [&](float* X) { hipMemcpyAsync(X, in[I_XP], (size_t)NTP * D * 4, hipMemcpyDeviceToDevice, stream); hipMemcpyAsync(X + (size_t)NTP * D, in[I_XS], (size_t)NTS * D * 4, hipMemcpyDeviceToDevice, stream);
        hipMemcpyAsync(nMEMC, in[I_MEMP], (size_t)4 * 256 * D * 4, hipMemcpyDeviceToDevice, stream); hipMemcpyAsync(nMEMC + (size_t)4 * 256 * D, in[I_MEMS], (size_t)4 * 256 * D * 4, hipMemcpyDeviceToDevice, stream); };
    auto n_s5 = [&](float* X, float* T1, float* T2, float* T3) {
        sgemm(X, in[I_AWIN], T1, nullptr, NT, D, D, D, 1, D, 1, D);
        hipLaunchKernelGGL(nv::k_s5_scan, dim3(8 * 64 * 2), dim3(64), 0, stream, T1, T2, in[I_ALRE], in[I_ALIM], in[I_ALDT], in[I_ABRE], in[I_ABIM], in[I_ACRE], in[I_ACIM]);
        hipLaunchKernelGGL(nv::k_s5_gelu, dim3(EW), dim3(256), 0, stream, T1, T2, in[I_AD], T2);
        sgemm(T2, in[I_AWGLU], T1, nullptr, NT, D, D, D, 1, 2 * D, 1, D);
        sgemm(T2, in[I_AWGLU] + D, T3, nullptr, NT, D, D, D, 1, 2 * D, 1, D);
        hipLaunchKernelGGL(nv::k_glu, dim3(EW), dim3(256), 0, stream, T1, T3, T1);
    };
    auto n_na = [&](float* X, float* T1, float* T2, float* T3) {
        sgemm(X, in[I_BWQKV], T1, nullptr, NT, D, D, D, 1, 3 * D, 1, D); sgemm(X, in[I_BWQKV] + D, T2, nullptr, NT, D, D, D, 1, 3 * D, 1, D); sgemm(X, in[I_BWQKV] + 2 * D, T3, nullptr, NT, D, D, D, 1, 3 * D, 1, D);
        hipLaunchKernelGGL(nv::k_natten, dim3(NT * 16 / 4), dim3(256), 0, stream, T1, T2, T3, in[I_BRPB]);
        sgemm(T1, in[I_BWO], T2, nullptr, NT, D, D, D, 1, D, 1, D);
    };
    auto n_ln = [&](float* X, const float* h, int layer, int sub, float* xo) { hipLaunchKernelGGL(nv::k_res_ln, dim3(NT / 4), dim3(256), 0, stream, X, h, in[I_LNG] + (layer * 3 + sub) * D, in[I_LNB] + (layer * 3 + sub) * D, xo, NT); };
    auto n_mem = [&](float* X, float* T1, float* T2, float* T3, int layer) {
        const float* wq = in[I_MWQ] + (size_t)layer * D * D; const float* wkv = in[I_MWKV] + (size_t)layer * D * 2 * D; const float* wo = in[I_MWO] + (size_t)layer * D * D;
        sgemm(nMEMC, wkv, nKV, nullptr, 8 * 256, 2 * D, D, D, 1, 2 * D, 1, 2 * D);
        sgemm(X, wq, T1, nullptr, NT, D, D, D, 1, D, 1, D);
        for (int grp = 0; grp < 2; ++grp) { const int L = grp ? 4096 : 8192; const size_t tb = grp ? (size_t)NTP : 0; const int gb0 = grp * 4;
            sgemm(T1 + tb * D, nKV + (size_t)gb0 * 256 * 2 * D, T2 + tb * D, nullptr, L, 256, 256, D, 1, 1, 2 * D, D, 16, 4, (long)L * D, 256, (long)256 * 2 * D, 256, (long)L * D, 256); }
        hipLaunchKernelGGL(nv::k_softmax256, dim3(NT * 4 / 4), dim3(256), 0, stream, T2, 0.0625f, NT * 4);
        for (int grp = 0; grp < 2; ++grp) { const int L = grp ? 4096 : 8192; const size_t tb = grp ? (size_t)NTP : 0; const int gb0 = grp * 4;
            sgemm(T2 + tb * D, nKV + (size_t)gb0 * 256 * 2 * D + D, T3 + tb * D, nullptr, L, 256, 256, D, 1, 2 * D, 1, D, 16, 4, (long)L * D, 256, (long)256 * 2 * D, 256, (long)L * D, 256); }
        sgemm(T3, wo, T1, nullptr, NT, D, D, D, 1, D, 1, D);
    };
    auto n_moe = [&](float* X, float* T1, float* T2, float* T3, int layer) {
        hipLaunchKernelGGL(nv::k_router, dim3(NT / 4), dim3(256), 0, stream, X, in[I_EWR] + (size_t)layer * D * 16, nAFF, NT);
        hipLaunchKernelGGL(nv::k_select, dim3(32), dim3(512), 0, stream, nAFF, nIDX, nGATE);
        hipMemsetAsync(T1, 0, BIG * 4, stream);
        for (int grp = 0; grp < 2; ++grp) { const int n = grp ? NTS : NTP, cap = n / 8; const size_t tb = grp ? (size_t)NTP : 0;
            for (int e = 0; e < 16; ++e) { const int* idx = nIDX + (grp ? 16 * 4096 : 0) + e * cap; const float* gate = nGATE + (grp ? 16 * 4096 : 0) + e * cap;
                const float* w1 = in[I_EW1] + ((size_t)layer * 16 + e) * D * 2048; const float* w3 = in[I_EW3] + ((size_t)layer * 16 + e) * D * 2048; const float* w2 = in[I_EW2] + ((size_t)layer * 16 + e) * 2048 * D;
                float* H1 = T2; float* H3 = T2 + (size_t)4096 * 2048; float* YE = T3;
                sgemm(X + tb * D, w1, H1, idx, cap, 2048, D, D, 1, 2048, 1, 2048); sgemm(X + tb * D, w3, H3, idx, cap, 2048, D, D, 1, 2048, 1, 2048);
                hipLaunchKernelGGL(nv::k_silu_mul, dim3((unsigned)(((size_t)cap * 2048 + 255) / 256)), dim3(256), 0, stream, H1, H3, (size_t)cap * 2048);
                sgemm(H1, w2, YE, nullptr, cap, D, 2048, 2048, 1, D, 1, D);
                hipLaunchKernelGGL(nv::k_scatter_add, dim3((unsigned)(((size_t)cap * D + 255) / 256)), dim3(256), 0, stream, YE, idx, gate, T1 + tb * D, cap); } }
    };
    float* X = (float*)(ws + WS_XF); float* T1 = (float*)(ws + WS_EW13); float* T2 = (float*)(ws + WS_POOL); float* T3 = (float*)(ws + WS_POOL + 192 * MiB);
    auto cmp_bf = [&](size_t off_bf16, const float* ref, double* acc) { hipLaunchKernelGGL(dbg::k_cmp_bf16_f32, dim3(2048), dim3(256), 0, stream, (const unsigned short*)(ws + off_bf16), ref, BIG, acc); };
#if DBG == 1
    n_import(X);
    a.flags = FLAG_NO_XIMPORT | FLAG_NO_EXPERTS0;
    n_s5(X, T1, T2, T3);
    for (int p = 0; p <= 5; ++p) run(p, p + 1);
    cmp_bf(PO_HB_S5, T1, ACC);
    cmp_bf(PO_HB_S5, T1, ACC + 2);
#elif DBG == 11
    n_import(X);
    a.flags = FLAG_NO_XIMPORT | FLAG_NO_EXPERTS0;
    sgemm(X, in[I_AWIN], T1, nullptr, NT, D, D, D, 1, D, 1, D);
    for (int p = 0; p <= 4; ++p) run(p, p + 1);
    hipLaunchKernelGGL(dbg::k_cmp_ua, dim3(2048), dim3(256), 0, stream, (const unsigned short*)(ws + PO_UA), T1, ACC);
    hipMemcpyAsync(X, T1, BIG * 4, hipMemcpyDeviceToDevice, stream);
    { float* Y = (float*)(ws + 193 * MiB);
      hipLaunchKernelGGL(nv::k_s5_scan, dim3(8 * 64 * 2), dim3(64), 0, stream, X, Y, in[I_ALRE], in[I_ALIM], in[I_ALDT], in[I_ABRE], in[I_ABIM], in[I_ACRE], in[I_ACIM]);
      hipLaunchKernelGGL(nv::k_s5_gelu, dim3(EW), dim3(256), 0, stream, X, Y, in[I_AD], Y);
      cmp_bf(PO_SG, Y, ACC + 2); }
#elif DBG == 2
    n_import(X); n_s5(X, T1, T2, T3); n_ln(X, T1, 0, 0, X); n_mem(X, T1, T2, T3, 0);
    a.flags = FLAG_NO_XIMPORT | FLAG_NO_EXPERTS0;
    run(0, 1); run(1, 2); run(2, 3); run(7, 8); run(9, 10);
    cmp_bf(PO_HB_MEM, T1, ACC); cmp_bf(PO_HB_MEM, T1, ACC + 2);
#elif DBG == 4
    n_import(X); n_na(X, T1, T2, T3);
    hipMemcpyAsync(T1, T2, BIG * 4, hipMemcpyDeviceToDevice, stream);
    a.flags = FLAG_NO_XIMPORT | FLAG_NO_EXPERTS0;
    run(0, 1); run(17, 18); run(18, 19); run(19, 20);
    cmp_bf(PO_HB_NA, T1, ACC); cmp_bf(PO_HB_NA, T1, ACC + 2);
#endif
    hipLaunchKernelGGL(dbg::k_encode, dim3(2048), dim3(256), 0, stream, (float*)d_out, ACC, ACC + 2);
#endif
}
```

```cpp
#include <hip/hip_runtime.h>
#include <cstdio>
#include <cstdint>
#include <cmath>
#define NO_WT 1
namespace nv {
constexpr int D = 1024, NTP = 32768, NTS = 16384, NT = NTP + NTS, NGB = 8, MEM = 256;
constexpr int GRID_W = 64;
constexpr float ALPHA = 1.41421356237309515f;
constexpr float LN_EPS = 1e-5f;

__host__ __device__ inline int gb_tok0(int gb) { return gb < 4 ? gb * 8192 : NTP + (gb - 4) * 4096; }
__host__ __device__ inline int gb_len(int gb) { return gb < 4 ? 8192 : 4096; }

__device__ __forceinline__ float wave_sum(float v) {
#pragma unroll
    for (int o = 1; o < 64; o <<= 1) v += __shfl_xor(v, o);
    return v;
}
__device__ __forceinline__ float wave_max(float v) {
#pragma unroll
    for (int o = 1; o < 64; o <<= 1) v = fmaxf(v, __shfl_xor(v, o));
    return v;
}

struct SG { const float* A; const float* B; float* C; const int* gidx; int M, N, K, zdiv; long sam, sak, sbk, sbn, ldc; long zA0, zA1, zB0, zB1, zC0, zC1; };
__global__ __launch_bounds__(256) void k_sgemm(SG a) {
    __shared__ float As[8][132];
    __shared__ float Bs[8][132];
    const int z = blockIdx.z, z0 = z / a.zdiv, z1 = z % a.zdiv;
    const float* A = a.A + z0 * a.zA0 + z1 * a.zA1;
    const float* B = a.B + z0 * a.zB0 + z1 * a.zB1;
    float* C = a.C + z0 * a.zC0 + z1 * a.zC1;
    const int bm = blockIdx.y * 128, bn = blockIdx.x * 128, tid = threadIdx.x, tx = tid & 15, ty = tid >> 4;
    float acc[8][8];
#pragma unroll
    for (int i = 0; i < 8; ++i)
#pragma unroll
        for (int j = 0; j < 8; ++j) acc[i][j] = 0.f;
    const int arow_l = tid >> 1, akk = (tid & 1) * 4;
    const long arow = a.gidx ? (long)a.gidx[bm + arow_l] : (long)(bm + arow_l);
    const float* Ap = A + arow * a.sam;
    const int bkk = tid >> 5, bnn = (tid & 31) * 4;
    for (int k0 = 0; k0 < a.K; k0 += 8) {
        float av[4], bv[4];
#pragma unroll
        for (int i = 0; i < 4; ++i) av[i] = Ap[(long)(k0 + akk + i) * a.sak];
#pragma unroll
        for (int i = 0; i < 4; ++i) bv[i] = B[(long)(k0 + bkk) * a.sbk + (long)(bn + bnn + i) * a.sbn];
        __syncthreads();
#pragma unroll
        for (int i = 0; i < 4; ++i) As[akk + i][arow_l] = av[i];
#pragma unroll
        for (int i = 0; i < 4; ++i) Bs[bkk][bnn + i] = bv[i];
        __syncthreads();
#pragma unroll
        for (int kk = 0; kk < 8; ++kk) {
            float x[8], y[8];
#pragma unroll
            for (int i = 0; i < 8; ++i) x[i] = As[kk][ty * 8 + i];
#pragma unroll
            for (int j = 0; j < 8; ++j) y[j] = Bs[kk][tx * 8 + j];
#pragma unroll
            for (int i = 0; i < 8; ++i)
#pragma unroll
                for (int j = 0; j < 8; ++j) acc[i][j] += x[i] * y[j];
        }
    }
#pragma unroll
    for (int i = 0; i < 8; ++i)
#pragma unroll
        for (int j = 0; j < 8; ++j) C[(long)(bm + ty * 8 + i) * a.ldc + bn + tx * 8 + j] = acc[i][j];
}

__global__ __launch_bounds__(64) void k_s5_scan(const float* __restrict__ u, float* __restrict__ ydir, const float* lam_re, const float* lam_im, const float* log_dt,
                                                const float* b_re, const float* b_im, const float* c_re, const float* c_im) {
    const int wid = blockIdx.x;
    const int dir = wid & 1, g = (wid >> 1) & 63, gb = wid >> 7;
    const int p = threadIdx.x;
    const int L = gb_len(gb), t0 = gb_tok0(gb);
    const double dt = exp((double)log_dt[dir * 64 + g]);
    const double lr = lam_re[(dir * 64 + g) * 64 + p], li = lam_im[(dir * 64 + g) * 64 + p];
    const double er = exp(lr * dt), lbr = er * cos(li * dt), lbi = er * sin(li * dt);
    const double nr = lbr - 1.0, ni = lbi, den = lr * lr + li * li;
    const double fr = (nr * lr + ni * li) / den, fi = (ni * lr - nr * li) / den;
    float Br[16], Bi[16], Cr[16], Ci[16];
#pragma unroll
    for (int h = 0; h < 16; ++h) {
        const double br = b_re[((dir * 64 + g) * 64 + p) * 16 + h], bi = b_im[((dir * 64 + g) * 64 + p) * 16 + h];
        Br[h] = (float)(fr * br - fi * bi); Bi[h] = (float)(fr * bi + fi * br);
        Cr[h] = c_re[((dir * 64 + g) * 16 + h) * 64 + p]; Ci[h] = c_im[((dir * 64 + g) * 16 + h) * 64 + p];
    }
    const float ar = (float)lbr, ai = (float)lbi;
    float hr = 0.f, hi = 0.f;
    float* yo = ydir + (size_t)dir * NT * D;
    for (int s = 0; s < L; ++s) {
        const int t = dir ? (L - 1 - s) : s;
        const float* ur = u + (size_t)(t0 + t) * D + g * 16;
        float bur = 0.f, bui = 0.f;
#pragma unroll
        for (int h = 0; h < 16; ++h) { const float uv = ur[h]; bur += uv * Br[h]; bui += uv * Bi[h]; }
        const float nhr = ar * hr - ai * hi + bur, nhi = ar * hi + ai * hr + bui;
        hr = nhr; hi = nhi;
        float mine = 0.f;
#pragma unroll
        for (int c = 0; c < 16; ++c) { const float v = wave_sum(Cr[c] * hr - Ci[c] * hi); if (p == c) mine = v; }
        if (p < 16) yo[(size_t)(t0 + t) * D + g * 16 + p] = mine;
    }
}
__global__ void k_s5_gelu(const float* u, const float* ydir, const float* dskip, float* gout) {
    const size_t i = (size_t)blockIdx.x * blockDim.x + threadIdx.x;
    if (i >= (size_t)NT * D) return;
    const float y = dskip[i & (D - 1)] * u[i] + ydir[i] + ydir[(size_t)NT * D + i];
    const float c = 0.7978845608028654f * (y + 0.044715f * y * y * y);
    gout[i] = 0.5f * y * (1.f + tanhf(c));
}
__global__ void k_glu(const float* z1, const float* z2, float* out) {
    const size_t i = (size_t)blockIdx.x * blockDim.x + threadIdx.x;
    if (i >= (size_t)NT * D) return;
    out[i] = z1[i] / (1.f + expf(-z2[i]));
}
__global__ __launch_bounds__(256) void k_res_ln(const float* x, const float* h, const float* g, const float* b, float* xo, int rows) {
    const int row = blockIdx.x * 4 + (threadIdx.x >> 6), lane = threadIdx.x & 63;
    if (row >= rows) return;
    float v[16]; float s = 0.f;
#pragma unroll
    for (int j = 0; j < 16; ++j) { const size_t i = (size_t)row * D + lane + 64 * j; v[j] = ALPHA * x[i] + h[i]; s += v[j]; }
    const float mean = wave_sum(s) * (1.f / D); float q = 0.f;
#pragma unroll
    for (int j = 0; j < 16; ++j) { v[j] -= mean; q += v[j] * v[j]; }
    const float rstd = 1.f / sqrtf(wave_sum(q) * (1.f / D) + LN_EPS);
#pragma unroll
    for (int j = 0; j < 16; ++j) { const int c = lane + 64 * j; xo[(size_t)row * D + c] = v[j] * rstd * g[c] + b[c]; }
}
__global__ __launch_bounds__(256) void k_softmax256(float* s, float scale, int rows) {
    const int row = blockIdx.x * 4 + (threadIdx.x >> 6), lane = threadIdx.x & 63;
    if (row >= rows) return;
    float v[4]; float m = -INFINITY;
#pragma unroll
    for (int j = 0; j < 4; ++j) { v[j] = s[(size_t)row * 256 + lane + 64 * j] * scale; m = fmaxf(m, v[j]); }
    m = wave_max(m); float l = 0.f;
#pragma unroll
    for (int j = 0; j < 4; ++j) { v[j] = expf(v[j] - m); l += v[j]; }
    l = wave_sum(l);
#pragma unroll
    for (int j = 0; j < 4; ++j) s[(size_t)row * 256 + lane + 64 * j] = v[j] / l;
}
__global__ __launch_bounds__(256) void k_router(const float* x, const float* wr, float* aff, int rows) {
    const int row = blockIdx.x * 4 + (threadIdx.x >> 6), lane = threadIdx.x & 63;
    if (row >= rows) return;
    float acc[16];
#pragma unroll
    for (int e = 0; e < 16; ++e) acc[e] = 0.f;
    for (int j = 0; j < 16; ++j) { const int k = lane + 64 * j; const float xv = x[(size_t)row * D + k];
#pragma unroll
        for (int e = 0; e < 16; ++e) acc[e] += xv * wr[k * 16 + e]; }
    float m = -INFINITY;
#pragma unroll
    for (int e = 0; e < 16; ++e) { acc[e] = wave_sum(acc[e]); m = fmaxf(m, acc[e]); }
    float l = 0.f;
#pragma unroll
    for (int e = 0; e < 16; ++e) { acc[e] = expf(acc[e] - m); l += acc[e]; }
    float mine = 0.f;
#pragma unroll
    for (int e = 0; e < 16; ++e) if (lane == e) mine = acc[e] / l;
    if (lane < 16) aff[(size_t)row * 16 + lane] = mine;
}

__device__ __forceinline__ void select_expert(const float* aff, int n, int e, int cap, int* idx_out, float* gate_out, int* slot_of  , unsigned* hist  , unsigned* wsum  , unsigned* bc  ) {
    const int tid = threadIdx.x, nth = blockDim.x, lane = tid & 63, wv = tid >> 6, nw = nth >> 6;
    unsigned prefix = 0u, mask = 0u; unsigned remaining = (unsigned)cap;
    for (int pass = 0; pass < 4; ++pass) {
        const int shift = 24 - 8 * pass;
        for (int i = tid; i < 256; i += nth) hist[i] = 0u;
        __syncthreads();
        for (int t = tid; t < n; t += nth) { const unsigned key = __float_as_uint(aff[(size_t)t * 16 + e]); if ((key & mask) == prefix) atomicAdd(&hist[(key >> shift) & 255u], 1u); }
        __syncthreads();
        if (tid == 0) { unsigned cum = 0u; int b = 255; for (; b > 0; --b) { if (cum + hist[b] >= remaining) break; cum += hist[b]; } bc[0] = (unsigned)b; bc[1] = remaining - cum; }
        __syncthreads();
        prefix |= bc[0] << shift; mask |= 0xffu << shift; remaining = bc[1];
        __syncthreads();
    }
    const unsigned T = prefix; const unsigned need_eq = remaining;
    unsigned base = 0u, eqbase = 0u;
    for (int s0 = 0; s0 < n; s0 += nth) {
        const int t = s0 + tid; const bool in = t < n;
        const float a = in ? aff[(size_t)t * 16 + e] : 0.f; const unsigned key = __float_as_uint(a);
        const bool gt = in && key > T, eq = in && key == T;
        const unsigned long long meq = __ballot(eq); const unsigned eqr_w = __popcll(meq & ((1ull << lane) - 1ull));
        if (lane == 0) wsum[wv] = __popcll(meq);
        __syncthreads();
        unsigned eqoff = 0u, eqtot = 0u; for (int w = 0; w < nw; ++w) { const unsigned c = wsum[w]; if (w < wv) eqoff += c; eqtot += c; }
        __syncthreads();
        const bool sel = gt || (eq && (eqbase + eqoff + eqr_w) < need_eq);
        const unsigned long long ms = __ballot(sel); const unsigned sr_w = __popcll(ms & ((1ull << lane) - 1ull));
        if (lane == 0) wsum[wv] = __popcll(ms);
        __syncthreads();
        unsigned soff = 0u, stot = 0u; for (int w = 0; w < nw; ++w) { const unsigned c = wsum[w]; if (w < wv) soff += c; stot += c; }
        __syncthreads();
        if (sel) { const unsigned slot = base + soff + sr_w; if (slot < (unsigned)cap) { idx_out[slot] = t; gate_out[slot] = a; } }
        if (slot_of && in) slot_of[(size_t)t * 16 + e] = sel ? (int)(base + soff + sr_w) : -1;
        base += stot; eqbase += eqtot;
    }
}
__global__ __launch_bounds__(512) void k_select(const float* aff_all, int* idx_all, float* gate_all) {
    __shared__ unsigned hist[256]; __shared__ unsigned wsum[32]; __shared__ unsigned bc[4];
    const int grp = blockIdx.x >> 4, e = blockIdx.x & 15;
    const int n = grp ? NTS : NTP, cap = n / 8;
    const float* aff = aff_all + (size_t)(grp ? NTP : 0) * 16;
    int* idx = idx_all + (grp ? 16 * 4096 : 0) + e * cap; float* gate = gate_all + (grp ? 16 * 4096 : 0) + e * cap;
    select_expert(aff, n, e, cap, idx, gate, nullptr, hist, wsum, bc);
}
__global__ void k_silu_mul(float* h1, const float* h3, size_t n) {
    const size_t i = (size_t)blockIdx.x * blockDim.x + threadIdx.x; if (i >= n) return;
    const float a = h1[i]; h1[i] = a / (1.f + expf(-a)) * h3[i];
}
__global__ void k_scatter_add(const float* ye, const int* idx, const float* gate, float* out, int cap) {
    const size_t i = (size_t)blockIdx.x * blockDim.x + threadIdx.x; if (i >= (size_t)cap * D) return;
    const int slot = (int)(i >> 10), c = (int)(i & 1023);
    atomicAdd(&out[(size_t)idx[slot] * D + c], gate[slot] * ye[i]);
}

__global__ __launch_bounds__(256) void k_natten(float* q, const float* k, const float* v, const float* rpb) {
    const int wg = blockIdx.x * 4 + (threadIdx.x >> 6), lane = threadIdx.x & 63;
    const int tok = wg >> 4, h = wg & 15;
    if (tok >= NT) return;
    int gb, l; if (tok < NTP) { gb = tok >> 13; l = tok & 8191; } else { gb = 4 + ((tok - NTP) >> 12); l = (tok - NTP) & 4095; }
    const int rows = gb_len(gb) / GRID_W, t0 = gb_tok0(gb);
    const int r = l >> 6, qc = l & 63;
    int rs = r - 4; rs = rs < 0 ? 0 : (rs > rows - 8 ? rows - 8 : rs);
    int ws = qc - 8; ws = ws < 0 ? 0 : (ws > 48 ? 48 : ws);
    const float qv = q[(size_t)tok * D + h * 64 + lane] * 0.125f;
    float m = -INFINITY, lsum = 0.f, o = 0.f;
    for (int rr = 0; rr < 8; ++rr) {
        const int kr = rs + rr, dr = kr - r + 7;
        for (int cc = 0; cc < 16; ++cc) {
            const int kc = ws + cc; int dc = kc - qc + 15; dc = dc < 0 ? 0 : (dc > 30 ? 30 : dc);
            const size_t kt = (size_t)(t0 + kr * 64 + kc) * D + h * 64 + lane;
            const float s = wave_sum(qv * k[kt]) + rpb[(h * 15 + dr) * 31 + dc];
            const float mn = fmaxf(m, s), al = expf(m - mn), pp = expf(s - mn);
            lsum = lsum * al + pp; o = o * al + pp * v[kt]; m = mn;
        }
    }
    q[(size_t)tok * D + h * 64 + lane] = o / lsum;
}
}
#define LAS __attribute__((address_space(3)))
#define GAS __attribute__((address_space(1)))
namespace fz {
typedef unsigned short bf16_t;
typedef short bf16x8 __attribute__((ext_vector_type(8)));
typedef float f32x4 __attribute__((ext_vector_type(4)));
typedef float f32x2 __attribute__((ext_vector_type(2)));
typedef unsigned u32x4 __attribute__((ext_vector_type(4)));
typedef unsigned u32x2 __attribute__((ext_vector_type(2)));
typedef int v8i __attribute__((ext_vector_type(8)));
typedef int v4i __attribute__((ext_vector_type(4)));

constexpr int D = 1024, NTP = 32768, NTS = 16384, NT = NTP + NTS;
constexpr int TCH = 32, NCHUNK = NT / TCH;
constexpr int UAK = TCH * 16 + 256;
constexpr float ALPHA = 1.41421356237309515f, LN_EPS = 1e-5f;
constexpr size_t MiB = 1u << 20;
#ifndef RES_BF16
#define RES_BF16 1
#endif
constexpr bool RES_BF16_FLAG = RES_BF16 != 0;
constexpr size_t WS_CTL = 0, WS_XF = 1 * MiB, WS_XB = 193 * MiB, WS_WIN = 289 * MiB, WS_WGLU = 291 * MiB, WS_WQKV = 295 * MiB, WS_WO = 301 * MiB, WS_MWQ = 303 * MiB,
                 WS_MWKV = 307 * MiB, WS_MWO = 315 * MiB, WS_MEMB = 319 * MiB, WS_KV = 323 * MiB, WS_WQK = 339 * MiB, WS_WVO = 371 * MiB, WS_AFF = 403 * MiB, WS_SLOT = 406 * MiB,
                 WS_IDX = 409 * MiB, WS_GATE = 409 * MiB + 512 * 1024, WS_EW13 = 411 * MiB  , WS_EW2 = 475 * MiB  ,
                 WS_XB8 = 507 * MiB  , WS_POOL = 603 * MiB, WS_END = 1024 * MiB;
constexpr size_t WS_EW13B = 97 * MiB, WS_EW2B = 161 * MiB;
static_assert(!RES_BF16_FLAG || WS_EW2B + 32 * MiB <= WS_XB, "layer-1 expert weights");
constexpr size_t PO_M2T = WS_POOL, PO_M13T = WS_POOL + 16 * MiB, PO_UA = WS_POOL + 64 * MiB, PO_SG = WS_POOL + 208 * MiB;
constexpr size_t PO_HB_S5 = WS_POOL;
constexpr size_t PO_SB = WS_POOL, PO_HB_MEM = WS_POOL + 304 * MiB;
constexpr size_t PO_Q = WS_POOL, PO_K = WS_POOL + 96 * MiB, PO_VT = WS_POOL + 192 * MiB, PO_HB_NA = WS_POOL + 304 * MiB;
constexpr size_t PO_HM = WS_POOL, PO_YE = WS_POOL + 192 * MiB;
static_assert(PO_YE + 192 * MiB <= WS_END && PO_SG + 96 * MiB <= WS_END && PO_HB_NA + 96 * MiB <= WS_END && PO_HB_MEM + 96 * MiB <= WS_END, "pool");
constexpr int CW_TMO = 0, CW_BAR = 4096;
constexpr size_t CTL_ZERO_BYTES = 64 * 1024;
constexpr int RING_BYTES = 131072, MISC_OFF = RING_BYTES + 320, LDS_BYTES = 163840, ZERO16_OFF = RING_BYTES + 64;

__host__ __device__ inline int gb_tok0(int gb) { return gb < 4 ? gb * 8192 : NTP + (gb - 4) * 4096; }
__host__ __device__ inline int gb_len(int gb) { return gb < 4 ? 8192 : 4096; }
__host__ __device__ inline int panel_gb(int pm) { return pm < 128 ? (pm >> 5) : 4 + ((pm - 128) >> 4); }

__device__ __forceinline__ unsigned cvt_pk_bf16(float lo, float hi) { unsigned r; asm volatile("v_cvt_pk_bf16_f32 %0, %1, %2" : "=v"(r) : "v"(lo), "v"(hi)); return r; }
typedef __bf16 bf16x2_t __attribute__((ext_vector_type(2)));
__device__ __forceinline__ unsigned cvt_pk_bf16_c(float lo, float hi) { const f32x2 v = {lo, hi}; const bf16x2_t b = __builtin_convertvector(v, bf16x2_t); return __builtin_bit_cast(unsigned, b); }
__device__ __forceinline__ float bf2f(unsigned short b) { return __uint_as_float(((unsigned)b) << 16); }
template <int CTRL> __device__ __forceinline__ float dpp_f(float v) { return __uint_as_float((unsigned)__builtin_amdgcn_update_dpp(0, (int)__float_as_uint(v), CTRL, 0xF, 0xF, true)); }
__device__ __forceinline__ float x16_sum(float v) { const auto r = __builtin_amdgcn_permlane16_swap(__float_as_uint(v), __float_as_uint(v), false, false); return __uint_as_float(r[0]) + __uint_as_float(r[1]); }
__device__ __forceinline__ float x32_sum(float v) { const auto r = __builtin_amdgcn_permlane32_swap(__float_as_uint(v), __float_as_uint(v), false, false); return __uint_as_float(r[0]) + __uint_as_float(r[1]); }
__device__ __forceinline__ float x16_max(float v) { const auto r = __builtin_amdgcn_permlane16_swap(__float_as_uint(v), __float_as_uint(v), false, false); return fmaxf(__uint_as_float(r[0]), __uint_as_float(r[1])); }
__device__ __forceinline__ float x32_max(float v) { const auto r = __builtin_amdgcn_permlane32_swap(__float_as_uint(v), __float_as_uint(v), false, false); return fmaxf(__uint_as_float(r[0]), __uint_as_float(r[1])); }
__device__ __forceinline__ float row_sum(float v) { v += dpp_f<0xB1>(v); v += dpp_f<0x4E>(v); v += dpp_f<0x141>(v); v += dpp_f<0x140>(v); return v; }
__device__ __forceinline__ float row_max(float v) { v = fmaxf(v, dpp_f<0xB1>(v)); v = fmaxf(v, dpp_f<0x4E>(v)); v = fmaxf(v, dpp_f<0x141>(v)); v = fmaxf(v, dpp_f<0x140>(v)); return v; }
__device__ __forceinline__ float wave_sum(float v) { return x32_sum(x16_sum(row_sum(v))); }
__device__ __forceinline__ float wave_max(float v) { return x32_max(x16_max(row_max(v))); }
#ifndef NO_WT
__device__ __forceinline__ void st16(void* p, u32x4 v) { asm volatile("global_store_dwordx4 %0, %1, off sc1\n\ts_nop 1" :: "v"(p), "v"(v)); }
__device__ __forceinline__ void st8(void* p, u32x2 v) { asm volatile("global_store_dwordx2 %0, %1, off sc1\n\ts_nop 1" :: "v"(p), "v"(v)); }
__device__ __forceinline__ void st4(void* p, unsigned v) { asm volatile("global_store_dword %0, %1, off sc1\n\ts_nop 1" :: "v"(p), "v"(v)); }
#else
__device__ __forceinline__ void st16(void* p, u32x4 v) { *(u32x4*)p = v; }
__device__ __forceinline__ void st8(void* p, u32x2 v) { *(u32x2*)p = v; }
__device__ __forceinline__ void st4(void* p, unsigned v) { *(unsigned*)p = v; }
#endif
__device__ __forceinline__ void st16f(void* p, f32x4 v) { st16(p, __builtin_bit_cast(u32x4, v)); }
__device__ __forceinline__ void pst16(void* p, u32x4 v) { *(u32x4*)p = v; }
__device__ __forceinline__ void pst8(void* p, u32x2 v) { *(u32x2*)p = v; }
#ifndef NO_WT
__device__ __forceinline__ void st16_so(const void* base, unsigned off, f32x4 v) { asm volatile("global_store_dwordx4 %0, %1, %2 sc1\n\ts_nop 1" :: "v"(off), "v"(v), "s"(base)); }
__device__ __forceinline__ void st4_so(const void* base, unsigned off, unsigned v) { asm volatile("global_store_dword %0, %1, %2 sc1\n\ts_nop 1" :: "v"(off), "v"(v), "s"(base)); }
#else
__device__ __forceinline__ void st16_so(const void* base, unsigned off, f32x4 v) { *(f32x4*)((unsigned char*)base + off) = v; }
__device__ __forceinline__ void st4_so(const void* base, unsigned off, unsigned v) { *(unsigned*)((unsigned char*)base + off) = v; }
#endif
#define LDS_WAIT() asm volatile("s_waitcnt lgkmcnt(0)" ::: "memory")
#define VM_WAIT() asm volatile("s_waitcnt vmcnt(0)" ::: "memory")

#define XB_TMO      128
#define XB_XCNT(j)  (256  + 64 * (j))
#define XB_XSUB(j)  (1280 + 64 * (j))
#define XB_XGEN(j)  (2304 + 64 * (j))
#define XB_TOP      3328
#define XB_TOPGEN   3392
#define XCD_BAR_WORDS 3456
#define XB_SPIN_CAP (1u << 18)
__device__ __forceinline__ unsigned xb_ld(unsigned* p)              { return __hip_atomic_load(p, __ATOMIC_RELAXED, __HIP_MEMORY_SCOPE_AGENT); }
__device__ __forceinline__ unsigned xb_add(unsigned* p, unsigned v) { return __hip_atomic_fetch_add(p, v, __ATOMIC_RELAXED, __HIP_MEMORY_SCOPE_AGENT); }
__device__ __forceinline__ unsigned xb_xcc_id() { return (unsigned)__builtin_amdgcn_s_getreg((3 << 11) | 20) & 0xFu; }
#define XB_SPIN(cond, bar) do { unsigned _sp = 0; while (cond) { __builtin_amdgcn_s_sleep(1); \
    if ((++_sp & 255u) == 0u) { if (xb_ld(&(bar)[XB_TMO])) break; if (_sp > XB_SPIN_CAP) { atomicAdd(&(bar)[XB_TMO], 1u); break; } } } } while (0)
struct XcdBarrier { unsigned* bar; unsigned x; volatile LAS unsigned* st; };
__device__ __forceinline__ int xb_tid();
__device__ __forceinline__ XcdBarrier xcd_barrier_post(unsigned* bar, volatile LAS unsigned* st) {
    XcdBarrier b; b.bar = bar; b.x = xb_xcc_id(); b.st = st;
    if (threadIdx.x == 0) st[4] = xb_add(&bar[XB_XCNT(b.x)], 1u);
    return b;
}
#define XB_LCNT(j)  (3520 + 64 * (j))
#define XB_LGEN(j)  (4544 + 64 * (j))
#define XCD_BAR_WORDS_EXT 5568
__device__ __forceinline__ void xcd_local_barrier(const XcdBarrier& b, const int wave_s, const unsigned nloc) {
    asm volatile("s_waitcnt vmcnt(0)" ::: "memory");
    __syncthreads();
    if (wave_s == 0 && xb_tid() == 0) {
        unsigned* bar = b.bar;
        const unsigned old = xb_add(&bar[XB_LCNT(b.x)], 1u);
        const unsigned gen = old / nloc;
        if (old + 1u == (gen + 1u) * nloc) xb_add(&bar[XB_LGEN(b.x)], 1u);
        else XB_SPIN(xb_ld(&bar[XB_LGEN(b.x)]) == gen, bar);
#ifndef LB_NOACQ
        __builtin_amdgcn_fence(__ATOMIC_ACQUIRE, "agent");
        asm volatile("s_waitcnt vmcnt(0)" ::: "memory");
#endif
    }
    __syncthreads();
}
__device__ __forceinline__ void xcd_barrier_complete(unsigned* bar, unsigned x, unsigned& nloc, unsigned& nx) {
    const unsigned G = gridDim.x * gridDim.y * gridDim.z;
    unsigned sum, cnt, mine, sp = 0u;
    for (;;) {
        sum = 0u; cnt = 0u; mine = 0u;
#pragma unroll
        for (unsigned j = 0; j < 16; ++j) { const unsigned c = xb_ld(&bar[XB_XCNT(j)]); sum += c; cnt += (c > 0u) ? 1u : 0u; mine = (j == x) ? c : mine; }
        if (sum == G) break;
        __builtin_amdgcn_s_sleep(1);
        if ((++sp & 255u) == 0u) { if (xb_ld(&bar[XB_TMO])) break; if (sp > XB_SPIN_CAP) { atomicAdd(&bar[XB_TMO], 1u); break; } }
    }
    nloc = mine > 0u ? mine : 1u; nx = cnt > 0u ? cnt : 1u;
}
__device__ __forceinline__ int xb_tid() { int t; asm volatile("v_mbcnt_lo_u32_b32 %0, -1, 0\n\tv_mbcnt_hi_u32_b32 %0, -1, %0" : "=v"(t)); return t; }
__device__ __forceinline__ void xcd_barrier(const XcdBarrier& b, const int wave_s) {
    asm volatile("s_waitcnt vmcnt(0)" ::: "memory");
    __syncthreads();
    if (wave_s == 0 && xb_tid() == 0) {
        unsigned* bar = b.bar;
        __builtin_amdgcn_s_waitcnt(0);
        unsigned nloc = b.st[0], nx = b.st[1];
        if (nloc == 0u) { xcd_barrier_complete(bar, b.x, nloc, nx); b.st[0] = nloc; b.st[1] = nx; }
        const unsigned old = xb_add(&bar[XB_XSUB(b.x)], 1u);
        const unsigned gen = old / nloc;
        if (old + 1u == (gen + 1u) * nloc) {
            __builtin_amdgcn_fence(__ATOMIC_RELEASE, "agent");
            asm volatile("s_waitcnt vmcnt(0)" ::: "memory");
            const unsigned og = xb_add(&bar[XB_TOP], 1u);
            const unsigned tg = og / nx;
            if (og + 1u == (tg + 1u) * nx) xb_add(&bar[XB_TOPGEN], 1u);
            else XB_SPIN(xb_ld(&bar[XB_TOPGEN]) == tg, bar);
            __builtin_amdgcn_fence(__ATOMIC_ACQUIRE, "agent");
            xb_add(&bar[XB_XGEN(b.x)], 1u);
            asm volatile("s_waitcnt vmcnt(0)" ::: "memory");
        } else {
            XB_SPIN(xb_ld(&bar[XB_XGEN(b.x)]) == gen, bar);
            __builtin_amdgcn_fence(__ATOMIC_ACQUIRE, "agent");
            asm volatile("s_waitcnt vmcnt(0)" ::: "memory");
        }
    }
    __syncthreads();
}

constexpr int BM = 256, BK = 64, HALF = 128, HTB = HALF * BK * 2, STAGE_BYTES = 8 * HTB;
__host__ __device__ __forceinline__ int lds_byte(int r, int c) { const int st = (r >> 4) * 2 + (c >> 5), rr = r & 15, cc = c & 31, ob = rr * 64 + cc * 2; return st * 1024 + (ob ^ (((ob >> 9) & 1) << 5)); }
__host__ __device__ __forceinline__ void stage_rc(int b, int& R, int& C) { const int st = b / 1024, sb = b % 1024, swz = sb ^ (((sb >> 9) & 1) << 5); R = (st >> 1) * 16 + swz / 64; C = (st & 1) * 32 + (swz % 64) / 2; }
__host__ __device__ __forceinline__ int perm32(int rho) { const int n = rho >> 4, i = rho & 15; return 8 * (i >> 2) + 4 * n + (i & 3); }

struct GUnit { const char* A; const char* B; char* C; const void* X; int pm, pn; };
template <int WGM = 8>
__device__ __forceinline__ bool static_unit(int i, int G, int c, int nM, int nN, int& pm, int& pn) {
    const long L = (long)i * G + c; const int nwg = nM * nN; if (L >= nwg) return false;
    int wgid = (int)L; { const int q = nwg / 8, r = nwg % 8, xcd = wgid % 8, off = wgid / 8; wgid = (xcd < r ? xcd * (q + 1) : r * (q + 1) + (xcd - r) * q) + off; }
    const int nig = WGM * nN, gid = wgid / nig, fm = gid * WGM, gsz = (nM - fm) < WGM ? (nM - fm) : WGM;
    pm = fm + ((wgid % nig) % gsz); pn = (wgid % nig) / gsz; return true;
}
template <class Epi, class Sched, bool GATHER, bool FP8 = false>
__device__ __forceinline__ void gemm_phase(LAS unsigned char* lds, const int tid_in, const int K, const unsigned lda, const unsigned ldb, const Sched& S, const Epi& E) {
    int tid_ = tid_in; asm volatile("" : "+v"(tid_));
    const int tid = tid_, wid = __builtin_amdgcn_readfirstlane(tid >> 6), lane = tid & 63, wr = wid >> 2, wc = wid & 3, fr = lane & 15, fq = lane >> 4;
    int nt_ = K / BK; asm volatile("" : "+s"(nt_)); const int nt = nt_;
    unsigned voffA[2], voffB[2]; int gR[2], gC[2];
#pragma unroll
    for (int i = 0; i < 2; ++i) { int R, C; stage_rc(tid * 16 + i * 8192, R, C); const int Rb = Epi::PERM ? ((R & ~31) + perm32(R & 31)) : R;
        voffA[i] = (unsigned)R * lda + (unsigned)C * 2u; voffB[i] = (unsigned)Rb * ldb + (unsigned)C * 2u; gR[i] = R; gC[i] = C * 2; }
    const size_t kstep = (size_t)(BK * 2);
    const size_t hstepA = (size_t)HALF * lda, hstepB = (size_t)HALF * ldb;
    const unsigned ldsw = (unsigned)wid * 1024u;
    const int aoff = lds_byte(wr * 64 + fr, fq * 8), boff = lds_byte(wc * 32 + fr, fq * 8);
    unsigned cvo[2][2], nvo[2][2];
#define PG8_SA(b, h) (((b) * 2 + (h)) * HTB)
#define PG8_SB(b, h) ((4 + (b) * 2 + (h)) * HTB)
#define PG8_STAGE(bufoff, gbase, voff) do { _Pragma("unroll") for (int _i = 0; _i < 2; ++_i) \
        __builtin_amdgcn_global_load_lds((const unsigned*)((const char*)(gbase) + (voff)[_i]), (LAS unsigned*)(lds + (bufoff) + ldsw + _i * 8192), 16, 0, 0); } while (0)
#define PG8_STAGE_B(bufoff, ptr, h) PG8_STAGE(bufoff, (ptr) + (h) * hstepB, voffB)
#define PG8_STAGE_A(bufoff, ptr, h, vo) do { if constexpr (GATHER) { PG8_STAGE(bufoff, (ptr), (vo)[h]); } else { PG8_STAGE(bufoff, (ptr) + (h) * hstepA, voffA); } } while (0)
#define PG8_LDA(dst, b, h) do { _Pragma("unroll") for (int m = 0; m < 4; ++m) _Pragma("unroll") for (int k = 0; k < 2; ++k) dst[m][k] = *(const LAS bf16x8*)(lds + PG8_SA(b, h) + aoff + m * 2048 + k * 1024); } while (0)
#define PG8_LDB(dst, b, h) do { _Pragma("unroll") for (int n = 0; n < 2; ++n) _Pragma("unroll") for (int k = 0; k < 2; ++k) dst[n][k] = *(const LAS bf16x8*)(lds + PG8_SB(b, h) + boff + n * 2048 + k * 1024); } while (0)
#define PG8_MMA(ai, bj, At, Bt) do { __builtin_amdgcn_s_setprio(1); _Pragma("unroll") for (int m = 0; m < 4; ++m) _Pragma("unroll") for (int n = 0; n < 2; ++n) { \
        if constexpr (FP8) { const v8i _a = __builtin_shufflevector(__builtin_bit_cast(v4i, At[m][0]), __builtin_bit_cast(v4i, At[m][1]), 0, 1, 2, 3, 4, 5, 6, 7), _b = __builtin_shufflevector(__builtin_bit_cast(v4i, Bt[n][0]), __builtin_bit_cast(v4i, Bt[n][1]), 0, 1, 2, 3, 4, 5, 6, 7); \
            asm volatile("v_mfma_f32_16x16x128_f8f6f4 %0, %1, %2, %0" : "+v"(acc[ai][bj][m][n]) : "v"(_b), "v"(_a)); } \
        else { _Pragma("unroll") for (int k = 0; k < 2; ++k) acc[ai][bj][m][n] = __builtin_amdgcn_mfma_f32_16x16x32_bf16(Bt[n][k], At[m][k], acc[ai][bj][m][n], 0, 0, 0); } } __builtin_amdgcn_s_setprio(0); } while (0)
#define PG8_WAIT_V(n) asm volatile("s_waitcnt vmcnt(" #n ")" ::: "memory")
#define PG8_WAIT_L(n) asm volatile("s_waitcnt lgkmcnt(" #n ")" ::: "memory")
#define PG8_BAR __builtin_amdgcn_s_barrier()
#define PG8_SCHED __builtin_amdgcn_sched_barrier(0)
#define PG8_GLOAD(vo, u) do { if constexpr (GATHER) { const int* _gi = (const int*)(u).X; _Pragma("unroll") for (int _h = 0; _h < 2; ++_h) _Pragma("unroll") for (int _i = 0; _i < 2; ++_i) \
        (vo)[_h][_i] = (unsigned)_gi[_h * HALF + gR[_i]] * lda + (unsigned)gC[_i]; } } while (0)
    GUnit cur, nxt; int ui = 0;
    if (!S.next(0, cur)) return;
    f32x4 acc[2][2][4][2];
    const volatile LAS f32x4* zero16 = (const volatile LAS f32x4*)(lds + ZERO16_OFF);
#pragma unroll
    for (int a = 0; a < 2; ++a)
#pragma unroll
        for (int b = 0; b < 2; ++b)
#pragma unroll
            for (int m = 0; m < 4; ++m)
#pragma unroll
                for (int n = 0; n < 2; ++n) acc[a][b][m][n] = *zero16;
    bf16x8 At[4][2], B0[2][2], B1[2][2];
    const char* cA = cur.A; const char* cB = cur.B;
    PG8_GLOAD(cvo, cur);
    if constexpr (GATHER) { PG8_WAIT_V(0); }
    PG8_STAGE_B(PG8_SB(0, 0), cB, 0); PG8_STAGE_B(PG8_SB(0, 1), cB, 1); PG8_STAGE_A(PG8_SA(0, 0), cA, 0, cvo); PG8_STAGE_A(PG8_SA(0, 1), cA, 1, cvo);
    if (wr == 1) PG8_BAR;
    PG8_WAIT_V(2); PG8_BAR;
    PG8_STAGE_B(PG8_SB(1, 0), cB + kstep, 0); PG8_STAGE_A(PG8_SA(1, 0), cA + kstep, 0, cvo); PG8_STAGE_B(PG8_SB(1, 1), cB + kstep, 1);
    PG8_WAIT_V(6); PG8_BAR;
    for (;;) {
        const bool has_next = S.next(ui + 1, nxt);
        const char* nA = has_next ? nxt.A : cA; const char* nB = has_next ? nxt.B : cB;
        if constexpr (GATHER) { if (has_next) { PG8_GLOAD(nvo, nxt); } else {
#pragma unroll
            for (int h = 0; h < 2; ++h)
#pragma unroll
                for (int i = 0; i < 2; ++i) nvo[h][i] = cvo[h][i]; } }
        for (int t = 0; t < nt; t += 2) {
            const bool last = (t == nt - 2);
            const char* a1 = cA + (size_t)(t + 1) * kstep;
            const char* a2 = last ? nA : cA + (size_t)(t + 2) * kstep; const char* b2 = last ? nB : cB + (size_t)(t + 2) * kstep;
            const char* a3 = a2 + kstep; const char* b3 = b2 + kstep;
            unsigned vo2[2][2];
            if constexpr (GATHER) {
#pragma unroll
                for (int h = 0; h < 2; ++h)
#pragma unroll
                    for (int i = 0; i < 2; ++i) vo2[h][i] = last ? nvo[h][i] : cvo[h][i]; }
            PG8_LDB(B0, 0, 0); PG8_LDB(B1, 0, 1); PG8_SCHED; PG8_LDA(At, 0, 0); PG8_STAGE_A(PG8_SA(1, 1), a1, 1, cvo);
            PG8_WAIT_V(8); PG8_WAIT_L(0); PG8_BAR; PG8_MMA(0, 0, At, B0); PG8_MMA(0, 1, At, B1); PG8_BAR; PG8_SCHED;
            PG8_LDA(At, 0, 1); PG8_STAGE_B(PG8_SB(0, 0), b2, 0); PG8_STAGE_B(PG8_SB(0, 1), b2, 1); PG8_STAGE_A(PG8_SA(0, 0), a2, 0, vo2);
            PG8_WAIT_V(8); PG8_WAIT_L(0); PG8_BAR; PG8_MMA(1, 0, At, B0); PG8_MMA(1, 1, At, B1); PG8_BAR; PG8_SCHED;
            PG8_LDB(B0, 1, 0); PG8_LDB(B1, 1, 1); PG8_SCHED; PG8_LDA(At, 1, 0); PG8_STAGE_A(PG8_SA(0, 1), a2, 1, vo2);
            PG8_WAIT_V(8); PG8_WAIT_L(0); PG8_BAR; PG8_MMA(0, 0, At, B0); PG8_MMA(0, 1, At, B1); PG8_BAR; PG8_SCHED;
            PG8_LDA(At, 1, 1); PG8_STAGE_B(PG8_SB(1, 0), b3, 0); PG8_STAGE_B(PG8_SB(1, 1), b3, 1); PG8_STAGE_A(PG8_SA(1, 0), a3, 0, vo2);
            PG8_WAIT_V(8); PG8_WAIT_L(0); PG8_BAR; PG8_MMA(1, 0, At, B0); PG8_MMA(1, 1, At, B1); PG8_BAR; PG8_SCHED;
        }
        if constexpr (FP8) { asm volatile("s_nop 15\n\ts_nop 15" ::: "memory"); }
        if (wr == 0) PG8_BAR;
        E(acc, cur, wr, wc, fr, fq);
        if (!has_next) break;
#pragma unroll
        for (int a = 0; a < 2; ++a)
#pragma unroll
            for (int b = 0; b < 2; ++b)
#pragma unroll
                for (int m = 0; m < 4; ++m)
#pragma unroll
                    for (int n = 0; n < 2; ++n) acc[a][b][m][n] = *zero16;
        cur = nxt; cA = nA; cB = nB; ++ui;
        if constexpr (GATHER) {
#pragma unroll
            for (int h = 0; h < 2; ++h)
#pragma unroll
                for (int i = 0; i < 2; ++i) cvo[h][i] = nvo[h][i]; }
        if (wr == 1) PG8_BAR;
    }
    PG8_WAIT_V(0);
    PG8_BAR;
#undef PG8_SA
#undef PG8_SB
#undef PG8_STAGE
#undef PG8_STAGE_A
#undef PG8_STAGE_B
#undef PG8_LDA
#undef PG8_LDB
#undef PG8_MMA
#undef PG8_WAIT_V
#undef PG8_WAIT_L
#undef PG8_BAR
#undef PG8_SCHED
#undef PG8_GLOAD
}
typedef f32x4 Acc[2][2][4][2];
__device__ __forceinline__ float sigmoidf_fast(float x) { return __builtin_amdgcn_rcpf(1.f + __builtin_amdgcn_exp2f(-1.4426950408889634f * x)); }
__device__ __forceinline__ float gelu_tanh_fast(float y) {
    const float inner = 1.5957691216057308f * (y + 0.044715f * y * y * y);
    return y * sigmoidf_fast(inner);
}
__device__ __forceinline__ unsigned cvt4_fp8(float a, float b, float c, float d) {
    a = fminf(fmaxf(a, -448.f), 448.f); b = fminf(fmaxf(b, -448.f), 448.f); c = fminf(fmaxf(c, -448.f), 448.f); d = fminf(fmaxf(d, -448.f), 448.f);
    int w = 0; w = __builtin_amdgcn_cvt_pk_fp8_f32(a, b, w, false); w = __builtin_amdgcn_cvt_pk_fp8_f32(c, d, w, true); return (unsigned)w;
}
constexpr float FP8_SX = 8.f, FP8_SW13 = 32.f, FP8_SH = 8.f, FP8_SW2 = 64.f, FP8_SWQK = 32.f, FP8_SWQKV = 32.f;
struct EpiGated8 {
    static constexpr bool PERM = true;
    unsigned ldc;
    __device__ __forceinline__ void operator()(const Acc& acc, const GUnit& u, int wr, int wc, int fr, int fq) const {
        unsigned char* base = (unsigned char*)u.C;
        constexpr float kx = -1.4426950408889634f / (FP8_SX * FP8_SW13), ic = (FP8_SX * FP8_SW13) * (FP8_SX * FP8_SW13) / FP8_SH;
#pragma unroll
        for (int ai = 0; ai < 2; ++ai)
#pragma unroll
            for (int m = 0; m < 4; ++m) { const int r = ai * HALF + wr * 64 + m * 16 + fr;
                float o[8];
#pragma unroll
                for (int n = 0; n < 2; ++n)
#pragma unroll
                    for (int j = 0; j < 4; j += 2) {
                        const f32x2 a = {acc[ai][0][m][n][j], acc[ai][0][m][n][j + 1]}, b = {acc[ai][1][m][n][j], acc[ai][1][m][n][j + 1]};
                        const f32x2 t = a * f32x2{kx, kx};
                        const f32x2 e = {__builtin_amdgcn_exp2f(t[0]), __builtin_amdgcn_exp2f(t[1])};
                        const f32x2 d = e * f32x2{ic, ic} + f32x2{ic, ic};
                        const f32x2 s = {__builtin_amdgcn_rcpf(d[0]), __builtin_amdgcn_rcpf(d[1])};
                        const f32x2 q = (a * b) * s;
                        o[n * 4 + j] = __builtin_amdgcn_fmed3f(q[0], -448.f, 448.f); o[n * 4 + j + 1] = __builtin_amdgcn_fmed3f(q[1], -448.f, 448.f); }
                int w0 = 0, w1 = 0;
                w0 = __builtin_amdgcn_cvt_pk_fp8_f32(o[0], o[1], w0, false); w0 = __builtin_amdgcn_cvt_pk_fp8_f32(o[2], o[3], w0, true);
                w1 = __builtin_amdgcn_cvt_pk_fp8_f32(o[4], o[5], w1, false); w1 = __builtin_amdgcn_cvt_pk_fp8_f32(o[6], o[7], w1, true);
                u32x2 w; w.x = (unsigned)w0; w.y = (unsigned)w1;
                st8(base + (size_t)r * ldc + wc * 32 + 8 * fq, w); }
    }
};
struct EpiBf8 {
    static constexpr bool PERM = true;
    unsigned ldc; float scale;
    __device__ __forceinline__ void operator()(const Acc& acc, const GUnit& u, int wr, int wc, int fr, int fq) const {
        unsigned char* base = (unsigned char*)u.C;
#pragma unroll
        for (int ai = 0; ai < 2; ++ai)
#pragma unroll
            for (int m = 0; m < 4; ++m) { const int r = ai * HALF + wr * 64 + m * 16 + fr; unsigned char* rowp = base + (size_t)r * ldc + wc * 32 + 8 * fq;
#pragma unroll
                for (int bj = 0; bj < 2; ++bj) { const f32x4 v0 = acc[ai][bj][m][0] * scale, v1 = acc[ai][bj][m][1] * scale;
                    u32x2 w; w.x = cvt4_fp8(v0[0], v0[1], v0[2], v0[3]); w.y = cvt4_fp8(v1[0], v1[1], v1[2], v1[3]); st8(rowp + bj * HALF, w); } }
    }
};
template <bool ROWSCALE> struct EpiBf {
    static constexpr bool PERM = true;
    unsigned ldc; float scale;
    __device__ __forceinline__ void operator()(const Acc& acc, const GUnit& u, int wr, int wc, int fr, int fq) const {
        bf16_t* base = (bf16_t*)u.C; const float* rs = (const float*)u.X;
#pragma unroll
        for (int ai = 0; ai < 2; ++ai)
#pragma unroll
            for (int m = 0; m < 4; ++m) { const int r = ai * HALF + wr * 64 + m * 16 + fr; float s = scale; if (ROWSCALE) s *= rs[r];
                bf16_t* rowp = base + (size_t)r * ldc + wc * 32 + 8 * fq;
#pragma unroll
                for (int bj = 0; bj < 2; ++bj) { const f32x4 v0 = acc[ai][bj][m][0] * s, v1 = acc[ai][bj][m][1] * s;
                    u32x4 w; w.x = cvt_pk_bf16(v0[0], v0[1]); w.y = cvt_pk_bf16(v0[2], v0[3]); w.z = cvt_pk_bf16(v1[0], v1[1]); w.w = cvt_pk_bf16(v1[2], v1[3]);
                    st16(rowp + bj * HALF, w); } }
    }
};
template <int MODE> struct EpiGated {
    static constexpr bool PERM = true;
    unsigned ldc;
    __device__ __forceinline__ void operator()(const Acc& acc, const GUnit& u, int wr, int wc, int fr, int fq) const {
        bf16_t* base = (bf16_t*)u.C;
#pragma unroll
        for (int ai = 0; ai < 2; ++ai)
#pragma unroll
            for (int m = 0; m < 4; ++m) { const int r = ai * HALF + wr * 64 + m * 16 + fr;
                float o[8];
#pragma unroll
                for (int n = 0; n < 2; ++n)
#pragma unroll
                    for (int j = 0; j < 4; ++j) { const float a = acc[ai][0][m][n][j], b = acc[ai][1][m][n][j];
                        o[n * 4 + j] = (MODE == 0) ? a * sigmoidf_fast(b) : a * sigmoidf_fast(a) * b; }
                u32x4 w; w.x = cvt_pk_bf16(o[0], o[1]); w.y = cvt_pk_bf16(o[2], o[3]); w.z = cvt_pk_bf16(o[4], o[5]); w.w = cvt_pk_bf16(o[6], o[7]);
                st16(base + (size_t)r * ldc + wc * 32 + 8 * fq, w); }
    }
};
struct EpiUA {
    static constexpr bool PERM = true;
    __device__ __forceinline__ void operator()(const Acc& acc, const GUnit& u, int wr, int wc, int fr, int fq) const {
        bf16_t* UA = (bf16_t*)u.C;
#pragma unroll
        for (int ai = 0; ai < 2; ++ai)
#pragma unroll
            for (int m = 0; m < 4; ++m) { const int tok = u.pm * BM + ai * HALF + wr * 64 + m * 16 + fr; const int chunk = tok >> 5, j = tok & 31;
#pragma unroll
                for (int bj = 0; bj < 2; ++bj) { const int ch = u.pn * BM + bj * HALF + wc * 32 + 8 * fq, g = ch >> 4, h0 = ch & 15;
                    const f32x4 v0 = acc[ai][bj][m][0], v1 = acc[ai][bj][m][1];
                    u32x4 w; w.x = cvt_pk_bf16(v0[0], v0[1]); w.y = cvt_pk_bf16(v0[2], v0[3]); w.z = cvt_pk_bf16(v1[0], v1[1]); w.w = cvt_pk_bf16(v1[2], v1[3]);
                    st16(UA + ((size_t)g * NCHUNK + chunk) * UAK + j * 16 + h0, w); } }
    }
};
struct EpiS {
    static constexpr bool PERM = false;
    __device__ __forceinline__ void operator()(const Acc& acc, const GUnit& u, int wr, int wc, int fr, int fq) const {
        float* Sg = (float*)u.C;
#pragma unroll
        for (int ai = 0; ai < 2; ++ai)
#pragma unroll
            for (int m = 0; m < 4; ++m) { const int chunk = u.pm * BM + ai * HALF + wr * 64 + m * 16 + fr; float* rowp = Sg + (size_t)chunk * 256 + wc * 32 + 4 * fq;
#pragma unroll
                for (int bj = 0; bj < 2; ++bj)
#pragma unroll
                    for (int n = 0; n < 2; ++n) st16f(rowp + bj * HALF + n * 16, acc[ai][bj][m][n]); }
    }
};
struct EpiGelu {
    static constexpr bool PERM = true;
    __device__ __forceinline__ void operator()(const Acc& acc, const GUnit& u, int wr, int wc, int fr, int fq) const {
        bf16_t* Gg = (bf16_t*)u.C;
#pragma unroll
        for (int ai = 0; ai < 2; ++ai)
#pragma unroll
            for (int m = 0; m < 4; ++m) { const int chunk = u.pm * BM + ai * HALF + wr * 64 + m * 16 + fr;
#pragma unroll
                for (int bj = 0; bj < 2; ++bj) { const int n0 = u.pn * BM + bj * HALF + wc * 32 + 8 * fq, i = n0 >> 4, c0 = n0 & 15;
                    const f32x4 v0 = acc[ai][bj][m][0], v1 = acc[ai][bj][m][1];
                    u32x4 w; w.x = cvt_pk_bf16(gelu_tanh_fast(v0[0]), gelu_tanh_fast(v0[1])); w.y = cvt_pk_bf16(gelu_tanh_fast(v0[2]), gelu_tanh_fast(v0[3]));
                    w.z = cvt_pk_bf16(gelu_tanh_fast(v1[0]), gelu_tanh_fast(v1[1])); w.w = cvt_pk_bf16(gelu_tanh_fast(v1[2]), gelu_tanh_fast(v1[3]));
                    st16(Gg + ((size_t)chunk * TCH + i) * D + c0, w); } }
    }
};

struct EpiSoftmax {
    static constexpr bool PERM = true;
    LAS float* red; unsigned ldc; float scale;
    __device__ __forceinline__ void operator()(Acc& acc, const GUnit& u, int wr, int wc, int fr, int fq) const {
        bf16_t* base = (bf16_t*)u.C;
#pragma unroll
        for (int ai = 0; ai < 2; ++ai)
#pragma unroll
            for (int m = 0; m < 4; ++m) { float mx = -INFINITY;
#pragma unroll
                for (int bj = 0; bj < 2; ++bj)
#pragma unroll
                    for (int n = 0; n < 2; ++n) { const f32x4 v = acc[ai][bj][m][n]; mx = fmaxf(mx, fmaxf(fmaxf(v[0], v[1]), fmaxf(v[2], v[3]))); }
                mx *= scale; mx = x32_max(x16_max(mx));
                if (fq == 0) red[(ai * HALF + wr * 64 + m * 16 + fr) * 4 + wc] = mx; }
        asm volatile("s_waitcnt lgkmcnt(0)" ::: "memory"); __builtin_amdgcn_s_barrier(); asm volatile("" ::: "memory");
#pragma unroll
        for (int ai = 0; ai < 2; ++ai)
#pragma unroll
            for (int m = 0; m < 4; ++m) { const int r = ai * HALF + wr * 64 + m * 16 + fr; const f32x4 mm = *(const LAS f32x4*)(red + r * 4); const float M = fmaxf(fmaxf(mm[0], mm[1]), fmaxf(mm[2], mm[3]));
                float s = 0.f;
#pragma unroll
                for (int bj = 0; bj < 2; ++bj)
#pragma unroll
                    for (int n = 0; n < 2; ++n) { f32x4 v = acc[ai][bj][m][n];
#pragma unroll
                        for (int j = 0; j < 4; ++j) { v[j] = __builtin_amdgcn_exp2f(__builtin_fmaf(v[j], scale, -M)); s += v[j]; }
                        acc[ai][bj][m][n] = v; }
                s = x32_sum(x16_sum(s));
                if (fq == 0) red[1024 + r * 4 + wc] = s; }
        asm volatile("s_waitcnt lgkmcnt(0)" ::: "memory"); __builtin_amdgcn_s_barrier(); asm volatile("" ::: "memory");
#pragma unroll
        for (int ai = 0; ai < 2; ++ai)
#pragma unroll
            for (int m = 0; m < 4; ++m) { const int r = ai * HALF + wr * 64 + m * 16 + fr; const f32x4 ss = *(const LAS f32x4*)(red + 1024 + r * 4); const float inv = __builtin_amdgcn_rcpf((ss[0] + ss[1]) + (ss[2] + ss[3]));
                bf16_t* rowp = base + (size_t)r * ldc + wc * 32 + 8 * fq;
#pragma unroll
                for (int bj = 0; bj < 2; ++bj) { const f32x4 v0 = acc[ai][bj][m][0] * inv, v1 = acc[ai][bj][m][1] * inv;
                    u32x4 w; w.x = cvt_pk_bf16(v0[0], v0[1]); w.y = cvt_pk_bf16(v0[2], v0[3]); w.z = cvt_pk_bf16(v1[0], v1[1]); w.w = cvt_pk_bf16(v1[2], v1[3]);
                    st16(rowp + bj * HALF, w); } }
    }
};

struct Ctx { unsigned char* ws; int G, c; };
struct SchedPlain { const char* A; const char* B; char* C; size_t lda, ldb, ldc; int nM, nN, G, c;
    __device__ __forceinline__ bool next(int i, GUnit& u) const { int pm, pn; if (!static_unit(i, G, c, nM, nN, pm, pn)) return false;
        u.A = A + (size_t)pm * BM * lda; u.B = B + (size_t)pn * BM * ldb; u.C = C + ((size_t)pm * BM * ldc + (size_t)pn * BM) * 2; u.X = nullptr; u.pm = pm; u.pn = pn; return true; } };
struct SchedGated { const char* A; const char* B; char* C; size_t lda, ldb, ldc; int nM, nN, G, c;
    __device__ __forceinline__ bool next(int i, GUnit& u) const { int pm, pn; if (!static_unit(i, G, c, nM, nN, pm, pn)) return false;
        u.A = A + (size_t)pm * BM * lda; u.B = B + (size_t)pn * BM * ldb; u.C = C + ((size_t)pm * BM * ldc + (size_t)pn * HALF) * 2; u.X = nullptr; u.pm = pm; u.pn = pn; return true; } };
struct SchedUA { const char* A; const char* B; char* UA; int G, c;
    __device__ __forceinline__ bool next(int i, GUnit& u) const { int pm, pn; if (!static_unit(i, G, c, NT / BM, D / BM, pm, pn)) return false;
        u.A = A + (size_t)pm * BM * (D * 2); u.B = B + (size_t)pn * BM * (D * 2); u.C = UA; u.X = nullptr; u.pm = pm; u.pn = pn; return true; } };
struct SchedKV { unsigned char* ws; int G, c;
    __device__ __forceinline__ bool next(int i, GUnit& u) const { const int L = i * G + c; if (L >= 128) return false; const int layer = L >> 6, r = L & 63, pm = r >> 3, pn = r & 7;
        u.A = (const char*)ws + WS_MEMB + (size_t)pm * BM * 2048; u.B = (const char*)ws + WS_MWKV + (size_t)layer * 4 * MiB + (size_t)pn * BM * 2048;
        u.C = (char*)ws + WS_KV + (size_t)layer * 8 * MiB + ((size_t)pm * BM * 2048 + pn * BM) * 2; u.X = nullptr; u.pm = pm; u.pn = pn; return true; } };
struct SchedSA { unsigned char* ws; int G, c;
    __device__ __forceinline__ bool next(int i, GUnit& u) const { const int L = i * G + c; if (L >= 64 * 6) return false; const int g = L / 6, pm = L % 6;
        u.A = (const char*)ws + PO_UA + ((size_t)g * NCHUNK + (size_t)pm * BM) * (UAK * 2); u.B = (const char*)ws + PO_M2T + (size_t)g * 256 * 512 * 2;
        u.C = (char*)ws + PO_SG + (size_t)g * NCHUNK * 256 * 4; u.X = nullptr; u.pm = pm; u.pn = 0; return true; } };
struct SchedSC { unsigned char* ws; int G, c;
    __device__ __forceinline__ bool next(int i, GUnit& u) const { const int L = i * G + c; if (L >= 64 * 12) return false; const int g = L / 12, r = L % 12, pm = r >> 1, pn = r & 1;
        u.A = (const char*)ws + PO_UA + ((size_t)g * NCHUNK + (size_t)pm * BM) * (UAK * 2); u.B = (const char*)ws + PO_M13T + ((size_t)g * 512 + pn * BM) * UAK * 2;
        u.C = (char*)ws + PO_SG + (size_t)g * 16 * 2; u.X = nullptr; u.pm = pm; u.pn = pn; return true; } };
struct SchedWqk { unsigned char* ws; int G, c;
    __device__ __forceinline__ bool next(int i, GUnit& u) const { const int L = i * G + c; if (L >= 256) return false; const int pn = L & 3, h = (L >> 2) & 3, gb = (L >> 4) & 7, layer = L >> 7;
        u.A = (const char*)ws + WS_KV + (size_t)layer * 8 * MiB + ((size_t)gb * 256 * 2048 + h * 256) * 2; u.B = (const char*)ws + WS_MWQ + (size_t)layer * 2 * MiB + ((size_t)pn * BM * 1024 + h * 256) * 2;
        u.C = (char*)ws + WS_WQK + ((size_t)(layer * 8 + gb) * 1024 * 1024 + (size_t)h * 256 * 1024 + pn * BM); u.X = nullptr; u.pm = 0; u.pn = pn; return true; } };
struct SchedWvo { unsigned char* ws; int G, c;
    __device__ __forceinline__ bool next(int i, GUnit& u) const { const int L = i * G + c; if (L >= 256) return false; const int pm = L & 3, h = (L >> 2) & 3, gb = (L >> 4) & 7, layer = L >> 7;
        u.A = (const char*)ws + WS_MWO + (size_t)layer * 2 * MiB + ((size_t)pm * BM * 1024 + h * 256) * 2; u.B = (const char*)ws + WS_KV + (size_t)layer * 8 * MiB + ((size_t)gb * 256 * 2048 + 1024 + h * 256) * 2;
        u.C = (char*)ws + WS_WVO + ((size_t)(layer * 8 + gb) * 1024 * 1024 + (size_t)pm * BM * 1024 + h * 256) * 2; u.X = nullptr; u.pm = pm; u.pn = 0; return true; } };
struct SchedScores8 { const char* A; const char* Bl; char* C; int G, c;
    __device__ __forceinline__ bool next(int i, GUnit& u) const { int pm, pn; if (!static_unit(i, G, c, NT / BM, 4, pm, pn)) return false; const int gb = panel_gb(pm);
        u.A = A + (size_t)pm * BM * 1024; u.B = Bl + ((size_t)gb * 1024 + pn * BM) * 1024; u.C = C + ((size_t)pm * BM * 1024 + pn * BM) * 2; u.X = nullptr; u.pm = pm; u.pn = pn; return true; } };
struct SchedBatchW { const char* A; const char* Bl; char* C; int G, c;
    __device__ __forceinline__ bool next(int i, GUnit& u) const { int pm, pn; if (!static_unit(i, G, c, NT / BM, 4, pm, pn)) return false; const int gb = panel_gb(pm);
        u.A = A + (size_t)pm * BM * 2048; u.B = Bl + ((size_t)gb * 1024 + pn * BM) * 2048; u.C = C + ((size_t)pm * BM * 1024 + pn * BM) * 2; u.X = nullptr; u.pm = pm; u.pn = pn; return true; } };
struct Args { const float* in[26]; float* out; unsigned char* ws; int ph_lo, ph_hi, flags, pad; };
struct Frame {
    LAS unsigned char* lds; unsigned char* ws; const float* const* in; float* out;
    int tid, lane, wave, G, c;
    bool xok;
};
enum { I_XP = 0, I_XS, I_MEMP, I_MEMS, I_AWIN, I_ALRE, I_ALIM, I_ALDT, I_ABRE, I_ABIM, I_ACRE, I_ACIM, I_AD, I_AWGLU, I_BWQKV, I_BRPB, I_BWO, I_MWQ, I_MWKV, I_MWO, I_EWR, I_EW1, I_EW3, I_EW2, I_LNG, I_LNB };

__device__ __forceinline__ int rowmap(int mode, int n) {
    if (mode == 0) return n;
    if (mode == 1) { const int z = n >> 10, nn = n & 1023; return ((nn >> 7) << 8) + (z << 7) + (nn & 127); }
    return ((n >> 7) << 8) + ((mode == 3) ? 128 : 0) + (n & 127);
}
__device__ __forceinline__ void transpose_item(const float* W, int K, int N, bf16_t* WT, int mode, LAS float* scr, int item, int lane) {
    const int nblk = N / 32, kb = item / nblk, nb = item % nblk, k0 = 64 * kb, n0 = 32 * nb;
#pragma unroll 8
    for (int i = 0; i < 32; ++i) { const int kk = 2 * i + (lane >> 5); scr[kk * 33 + (lane & 31)] = W[(size_t)(k0 + kk) * N + n0 + (lane & 31)]; }
    LDS_WAIT(); asm volatile("" ::: "memory");
    const int c = lane & 7;
#pragma unroll
    for (int j = 0; j < 4; ++j) { const int n = (lane >> 3) + 8 * j; const LAS float* s = scr + (8 * c) * 33 + n;
        u32x4 o; o.x = cvt_pk_bf16(s[0 * 33], s[1 * 33]); o.y = cvt_pk_bf16(s[2 * 33], s[3 * 33]); o.z = cvt_pk_bf16(s[4 * 33], s[5 * 33]); o.w = cvt_pk_bf16(s[6 * 33], s[7 * 33]);
        *(u32x4*)(WT + (size_t)rowmap(mode, n0 + n) * K + k0 + 8 * c) = o; }
    LDS_WAIT(); asm volatile("" ::: "memory");
}
__device__ __forceinline__ void t8_load(f32x4 (&v)[16], const float* W, int N, int item, int lane) {
    const int nblk = N / 32, kb = item / nblk, nb = item % nblk, k0 = 128 * kb, n0 = 32 * nb, q = lane >> 3, c = lane & 7;
#pragma unroll
    for (int i = 0; i < 16; ++i) v[i] = *(const f32x4*)(W + (size_t)(k0 + 16 * q + i) * N + n0 + 4 * c);
}
__device__ __forceinline__ void t8_finish(const f32x4 (&v)[16], int K, int N, unsigned char* WT, int mode, float scale, LAS unsigned char* scr, int item, int lane) {
    const int nblk = N / 32, kb = item / nblk, nb = item % nblk, k0 = 128 * kb, n0 = 32 * nb, q = lane >> 3, c = lane & 7;
#pragma unroll
    for (int j = 0; j < 4; ++j) { u32x4 o;
        o.x = cvt4_fp8(v[0][j] * scale, v[1][j] * scale, v[2][j] * scale, v[3][j] * scale); o.y = cvt4_fp8(v[4][j] * scale, v[5][j] * scale, v[6][j] * scale, v[7][j] * scale);
        o.z = cvt4_fp8(v[8][j] * scale, v[9][j] * scale, v[10][j] * scale, v[11][j] * scale); o.w = cvt4_fp8(v[12][j] * scale, v[13][j] * scale, v[14][j] * scale, v[15][j] * scale);
        *(LAS u32x4*)(scr + (4 * c + j) * 144 + 16 * q) = o; }
    LDS_WAIT(); asm volatile("" ::: "memory");
#pragma unroll
    for (int j = 0; j < 4; ++j) { const int n = (lane >> 3) + 8 * j; const u32x4 o = *(const LAS u32x4*)(scr + n * 144 + 16 * c);
        pst16(WT + (size_t)rowmap(mode, n0 + n) * K + k0 + 16 * c, o); }
    LDS_WAIT(); asm volatile("" ::: "memory");
}
__device__ __forceinline__ void transpose_item8(const float* W, int K, int N, unsigned char* WT, int mode, float scale, LAS unsigned char* scr, int item, int lane) {
    f32x4 v[16]; t8_load(v, W, N, item, lane); t8_finish(v, K, N, WT, mode, scale, scr, item, lane);
}
__device__ __forceinline__ void transpose_item16(const float* W, int K, int N, bf16_t* WT, int mode, LAS unsigned char* scr, int item, int lane) {
    const int nblk = N / 32, kb = item / nblk, nb = item % nblk, k0 = 128 * kb, n0 = 32 * nb, q = lane >> 3, c = lane & 7;
    f32x4 v[16];
#pragma unroll
    for (int i = 0; i < 16; ++i) v[i] = *(const f32x4*)(W + (size_t)(k0 + 16 * q + i) * N + n0 + 4 * c);
#pragma unroll
    for (int j = 0; j < 4; ++j) { u32x4 o0, o1;
        o0.x = cvt_pk_bf16(v[0][j], v[1][j]); o0.y = cvt_pk_bf16(v[2][j], v[3][j]); o0.z = cvt_pk_bf16(v[4][j], v[5][j]); o0.w = cvt_pk_bf16(v[6][j], v[7][j]);
        o1.x = cvt_pk_bf16(v[8][j], v[9][j]); o1.y = cvt_pk_bf16(v[10][j], v[11][j]); o1.z = cvt_pk_bf16(v[12][j], v[13][j]); o1.w = cvt_pk_bf16(v[14][j], v[15][j]);
        *(LAS u32x4*)(scr + (4 * c + j) * 272 + 32 * q) = o0; *(LAS u32x4*)(scr + (4 * c + j) * 272 + 32 * q + 16) = o1; }
    LDS_WAIT(); asm volatile("" ::: "memory");
#pragma unroll
    for (int j = 0; j < 8; ++j) { const int n = (lane >> 4) + 4 * j, ch = lane & 15; const u32x4 o = *(const LAS u32x4*)(scr + n * 272 + 16 * ch);
        *(u32x4*)(WT + (size_t)rowmap(mode, n0 + n) * K + k0 + 8 * ch) = o; }
    LDS_WAIT(); asm volatile("" ::: "memory");
}
__device__ __forceinline__ void convert_small_weights(Frame& F) {
    LAS unsigned char* scr = F.lds + F.wave * 16384;
    const int gw = F.c * 8 + F.wave, NGW = F.G * 8;
    for (int it = gw; it < 3328; it += NGW) {
        int r = it;
        if (r < 256) { transpose_item16(F.in[I_AWIN], 1024, 1024, (bf16_t*)(F.ws + WS_WIN), 0, scr, r, F.lane); continue; } r -= 256;
        if (r < 512) { transpose_item16(F.in[I_AWGLU], 1024, 2048, (bf16_t*)(F.ws + WS_WGLU), 1, scr, r, F.lane); continue; } r -= 512;
        if (r < 768) { transpose_item8(F.in[I_BWQKV], 1024, 3072, F.ws + WS_WQKV, 0, FP8_SWQKV, scr, r, F.lane); continue; } r -= 768;
        if (r < 256) { transpose_item16(F.in[I_BWO], 1024, 1024, (bf16_t*)(F.ws + WS_WO), 0, scr, r, F.lane); continue; } r -= 256;
        if (r < 1024) { const int l = r >> 9; transpose_item16(F.in[I_MWKV] + (size_t)l * 1024 * 2048, 1024, 2048, (bf16_t*)(F.ws + WS_MWKV + (size_t)l * 4 * MiB), 0, scr, r & 511, F.lane); continue; } r -= 1024;
        { const int l = r >> 8; transpose_item16(F.in[I_MWO] + (size_t)l * 1024 * 1024, 1024, 1024, (bf16_t*)(F.ws + WS_MWO + (size_t)l * 2 * MiB), 0, scr, r & 255, F.lane); }
    }
}
__device__ __forceinline__ void convert_expert_weights(Frame& F, int layer, int lo = 0, int hi = 16 * 1536, int wg0 = 0, int gw_in = -1, int ngw_in = 0) {
    if (F.G <= wg0) wg0 = 0;
    if (F.c < wg0) return;
    LAS unsigned char* scr = F.lds + F.wave * 16384;
    const int gw = gw_in >= 0 ? gw_in : (F.c - wg0) * 8 + F.wave, NGW = gw_in >= 0 ? ngw_in : (F.G - wg0) * 8;
#define CVX_DECODE(it_) const int _e = (it_) / 1536; int _r = (it_) % 1536; const size_t _wofs = ((size_t)layer * 16 + _e) * 1024 * 2048; \
        const int _w = _r >> 9; _r &= 511; const float* _W = (_w == 0 ? F.in[I_EW1] : (_w == 1 ? F.in[I_EW3] : F.in[I_EW2])) + _wofs; const int _N = _w == 2 ? 1024 : 2048, _K = _w == 2 ? 2048 : 1024;
#define CVX_LOAD(v_, it_) do { CVX_DECODE(it_); (void)_K; t8_load(v_, _W, _N, _r, F.lane); } while (0)
#define CVX_FINISH(v_, it_) do { CVX_DECODE(it_); unsigned char* _WT = _w == 2 ? F.ws + (layer ? WS_EW2B : WS_EW2) + (size_t)_e * 2 * MiB : F.ws + (layer ? WS_EW13B : WS_EW13) + (size_t)_e * 4 * MiB; \
        t8_finish(v_, _K, _N, _WT, _w == 0 ? 2 : (_w == 1 ? 3 : 0), _w == 2 ? FP8_SW2 : FP8_SW13, scr, _r, F.lane); } while (0)
    f32x4 va[16], vb[16];
    int it = lo + gw;
    if (it < hi) CVX_LOAD(va, it);
    while (it < hi) {
        const int it1 = it + NGW, it2 = it1 + NGW;
        if (it1 < hi) CVX_LOAD(vb, it1);
        CVX_FINISH(va, it);
        if (it1 < hi) { if (it2 < hi) CVX_LOAD(va, it2); CVX_FINISH(vb, it1); }
        it = it2;
    }
#undef CVX_DECODE
#undef CVX_LOAD
#undef CVX_FINISH
}
__device__ __forceinline__ void convert_plain(Frame& F, const float* src, bf16_t* dst, size_t n) {
    const size_t n4 = n / 4;
    for (size_t i = (size_t)F.c * 512 + F.tid; i < n4; i += (size_t)F.G * 512) { const f32x4 v = ((const f32x4*)src)[i]; u32x2 w; w.x = cvt_pk_bf16(v[0], v[1]); w.y = cvt_pk_bf16(v[2], v[3]); ((u32x2*)dst)[i] = w; }
}
__device__ __forceinline__ void import_x(Frame& F, bool copy_f32) {
    const size_t n4 = (size_t)NT * D / 4, np4 = (size_t)NTP * D / 4, st = (size_t)F.G * 512;
    f32x4* XF = (f32x4*)(F.ws + WS_XF); u32x2* XB = (u32x2*)(F.ws + WS_XB);
    for (size_t i0 = (size_t)F.c * 512 + F.tid; i0 < n4; i0 += st * 8) {
        f32x4 v[8];
#pragma unroll
        for (int u = 0; u < 8; ++u) { const size_t i = i0 + st * u;
            if (i < n4) { if (copy_f32) { v[u] = (i < np4) ? ((const f32x4*)F.in[I_XP])[i] : ((const f32x4*)F.in[I_XS])[i - np4]; } else v[u] = XF[i]; } }
#pragma unroll
        for (int u = 0; u < 8; ++u) { const size_t i = i0 + st * u;
            if (i < n4) { u32x2 w; w.x = cvt_pk_bf16(v[u][0], v[u][1]); w.y = cvt_pk_bf16(v[u][2], v[u][3]); XB[i] = w; } }
    }
}

__device__ __forceinline__ void s5_lam(const float* lre, const float* lim, const float* ldt, int dir, int g, int p, double& dt, double& lr, double& li) {
    dt = exp((double)ldt[dir * 64 + g]); lr = (double)lre[(dir * 64 + g) * 64 + p]; li = (double)lim[(dir * 64 + g) * 64 + p];
}
__device__ __forceinline__ void s5_fill_bc(Frame& F, int g, int dir, const LAS double* LBd, LAS float* Bbr, LAS float* Bbi, LAS float* Cr, LAS float* Ci) {
    for (int idx = F.tid; idx < 1024; idx += 512) {
        const int p = idx >> 4, h = idx & 15; const double fr = LBd[p * 4 + 2], fi = LBd[p * 4 + 3];
        const double br = F.in[I_ABRE][((dir * 64 + g) * 64 + p) * 16 + h], bi = F.in[I_ABIM][((dir * 64 + g) * 64 + p) * 16 + h];
        Bbr[idx] = (float)(fr * br - fi * bi); Bbi[idx] = (float)(fr * bi + fi * br);
        Cr[idx] = F.in[I_ACRE][(dir * 64 + g) * 1024 + idx]; Ci[idx] = F.in[I_ACIM][(dir * 64 + g) * 1024 + idx];
    }
}
__device__ __forceinline__ void s5_build_item(Frame& F, int g, int dir) {
    LAS float* LPr = (LAS float*)F.lds; LAS float* LPi = LPr + 33 * 64;
    LAS float* Bbr = LPi + 33 * 64; LAS float* Bbi = Bbr + 1024; LAS float* Cr = Bbi + 1024; LAS float* Ci = Cr + 1024;
    LAS float* B2r = Ci + 1024; LAS float* B2i = B2r + 1024; LAS float* C2r = B2i + 1024; LAS float* C2i = C2r + 1024;
    LAS float* KD = C2i + 1024;
    bf16_t* M2T = (bf16_t*)(F.ws + PO_M2T) + (size_t)g * 256 * 512; bf16_t* M13T = (bf16_t*)(F.ws + PO_M13T) + (size_t)g * 512 * UAK;
    LAS double* LB = (LAS double*)(KD + 32 * 256);
    __syncthreads();
    if (F.tid < 128) { const int dd = F.tid >> 6, p = F.tid & 63;
        if (dd == 0 || dir == 0) { double dt, lr, li; s5_lam(F.in[I_ALRE], F.in[I_ALIM], F.in[I_ALDT], dd == 0 ? dir : 1, g, p, dt, lr, li);
            const double er = exp(lr * dt), lbr = er * cos(li * dt), lbi = er * sin(li * dt), nr = lbr - 1.0, ni = lbi, den = lr * lr + li * li;
            LB[(dd * 64 + p) * 4 + 0] = lbr; LB[(dd * 64 + p) * 4 + 1] = lbi; LB[(dd * 64 + p) * 4 + 2] = (nr * lr + ni * li) / den; LB[(dd * 64 + p) * 4 + 3] = (ni * lr - nr * li) / den; } }
    __syncthreads();
    for (int idx = F.tid; idx < 33 * 64; idx += 512) { const int e = idx >> 6, p = idx & 63; double br = LB[p * 4], bi = LB[p * 4 + 1], rr = 1.0, ri = 0.0;
        for (int b = e; b != 0; b >>= 1) { if (b & 1) { const double t = rr * br - ri * bi; ri = rr * bi + ri * br; rr = t; } const double t2 = br * br - bi * bi; bi = 2.0 * br * bi; br = t2; }
        LPr[idx] = (float)rr; LPi[idx] = (float)ri; }
    s5_fill_bc(F, g, dir, LB, Bbr, Bbi, Cr, Ci);
    if (dir == 0) s5_fill_bc(F, g, 1, LB + 256, B2r, B2i, C2r, C2i);
    __syncthreads();
    {
        const int k = F.tid, j = k >> 4, h = k & 15, e = dir == 0 ? (TCH - 1 - j) : j;
        for (int p = 0; p < 64; ++p) { const float lr = LPr[e * 64 + p], li = LPi[e * 64 + p], br = Bbr[p * 16 + h], bi = Bbi[p * 16 + h];
            const float xr = lr * br - li * bi, xi = lr * bi + li * br;
            M2T[(size_t)(dir * 128 + p) * 512 + k] = (bf16_t)(cvt_pk_bf16(xr, 0.f) & 0xffffu); M2T[(size_t)(dir * 128 + 64 + p) * 512 + k] = (bf16_t)(cvt_pk_bf16(xi, 0.f) & 0xffffu); }
    }
    {
        const int p = F.tid & 63, q8 = F.tid >> 6;
        for (int ic = q8; ic < 512; ic += 8) { const int i = ic >> 4, c = ic & 15, e = dir == 0 ? (i + 1) : (TCH - i);
            const float cr = Cr[c * 64 + p], ci = Ci[c * 64 + p], lr = LPr[e * 64 + p], li = LPi[e * 64 + p];
            const float vr = cr * lr - ci * li, vi = cr * li + ci * lr;
            M13T[(size_t)ic * UAK + 512 + dir * 128 + p] = (bf16_t)(cvt_pk_bf16(vr, 0.f) & 0xffffu); M13T[(size_t)ic * UAK + 512 + dir * 128 + 64 + p] = (bf16_t)(cvt_pk_bf16(-vi, 0.f) & 0xffffu); }
    }
    {
        const int ch = F.tid & 255, c = ch >> 4, h = ch & 15, par = F.tid >> 8;
        if (dir == 0 && par == 0) {
            float s = (c == h) ? F.in[I_AD][g * 16 + c] : 0.f;
            for (int p = 0; p < 64; ++p) s += Cr[c * 64 + p] * Bbr[p * 16 + h] - Ci[c * 64 + p] * Bbi[p * 16 + h] + C2r[c * 64 + p] * B2r[p * 16 + h] - C2i[c * 64 + p] * B2i[p * 16 + h];
            KD[ch] = s;
        }
#pragma nounroll
        for (int hp = 0; hp < 64; hp += 32) {
            float cbr[32], cbi[32];
#pragma unroll
            for (int p = 0; p < 32; ++p) { const float cr = Cr[c * 64 + hp + p], ci = Ci[c * 64 + hp + p], br = Bbr[(hp + p) * 16 + h], bi = Bbi[(hp + p) * 16 + h]; cbr[p] = cr * br - ci * bi; cbi[p] = cr * bi + ci * br; }
#pragma nounroll
            for (int d = 1 + par; d < TCH; d += 2) {
                float s0 = 0.f, s1 = 0.f;
#pragma unroll
                for (int p = 0; p < 32; p += 4) { const f32x4 lr = *(const LAS f32x4*)(LPr + d * 64 + hp + p), li = *(const LAS f32x4*)(LPi + d * 64 + hp + p);
                    s0 += cbr[p] * lr[0]; s1 -= cbi[p] * li[0]; s0 += cbr[p + 1] * lr[1]; s1 -= cbi[p + 1] * li[1]; s0 += cbr[p + 2] * lr[2]; s1 -= cbi[p + 2] * li[2]; s0 += cbr[p + 3] * lr[3]; s1 -= cbi[p + 3] * li[3]; }
                if (hp == 0) KD[d * 256 + ch] = s0 + s1; else KD[d * 256 + ch] += s0 + s1;
            }
        }
        __syncthreads();
        for (int idx = F.tid; idx < 512 * 64; idx += 512) { const int hf = idx & 1, j = (idx >> 1) & 31, ic = idx >> 6, i = ic >> 4, cc = ic & 15;
            const bool mine = dir == 0 ? (j <= i) : (j > i);
            if (mine) { const int d = dir == 0 ? (i - j) : (j - i); const f32x4 v0 = *(const LAS f32x4*)(KD + d * 256 + cc * 16 + hf * 8), v1 = *(const LAS f32x4*)(KD + d * 256 + cc * 16 + hf * 8 + 4);
                u32x4 v; v.x = cvt_pk_bf16(v0[0], v0[1]); v.y = cvt_pk_bf16(v0[2], v0[3]); v.z = cvt_pk_bf16(v1[0], v1[1]); v.w = cvt_pk_bf16(v1[2], v1[3]); *(u32x4*)(M13T + (size_t)ic * UAK + j * 16 + hf * 8) = v; } }
    }
    __syncthreads();
}

__device__ __forceinline__ void s5_recurrence(Frame& F) {
    const float* S = (const float*)(F.ws + PO_SG); bf16_t* UA = (bf16_t*)(F.ws + PO_UA);
    for (int base = F.c * 256; base < 65536; base += F.G * 256) {
        if (F.tid >= 256) continue;
        const int flat = base + F.tid, p = flat & 63, dir = (flat >> 6) & 1, g = (flat >> 7) & 63, gb = flat >> 13;
        double dt, lr, li; s5_lam(F.in[I_ALRE], F.in[I_ALIM], F.in[I_ALDT], dir, g, p, dt, lr, li);
        const double er = exp(lr * dt * TCH); const float ar = (float)(er * cos(li * dt * TCH)), ai = (float)(er * sin(li * dt * TCH));
        const int nc = gb < 4 ? 256 : 128, chunk0 = gb < 4 ? gb * 256 : 1024 + (gb - 4) * 128;
        float hr = 0.f, hi = 0.f;
        for (int s0 = 0; s0 < nc; s0 += 8) {
            float sr[8], si[8];
#pragma unroll
            for (int k = 0; k < 8; ++k) { const int cc = dir == 0 ? (s0 + k) : (nc - 1 - s0 - k); const size_t o = ((size_t)g * NCHUNK + (chunk0 + cc)) * 256 + dir * 128 + p; sr[k] = S[o]; si[k] = S[o + 64]; }
#pragma unroll
            for (int k = 0; k < 8; ++k) { const int cc = dir == 0 ? (s0 + k) : (nc - 1 - s0 - k); const size_t o = ((size_t)g * NCHUNK + (chunk0 + cc)) * UAK + 512 + dir * 128 + p;
                UA[o] = (bf16_t)(cvt_pk_bf16(hr, 0.f) & 0xffffu); UA[o + 64] = (bf16_t)(cvt_pk_bf16(hi, 0.f) & 0xffffu);
                const float nr = ar * hr - ai * hi + sr[k], ni = ar * hi + ai * hr + si[k]; hr = nr; hi = ni; }
        }
    }
}

__device__ __forceinline__ void add_bf16x4(f32x4& v, const u32x2 w) { v[0] += __uint_as_float(w.x << 16); v[1] += __uint_as_float(w.x & 0xffff0000u); v[2] += __uint_as_float(w.y << 16); v[3] += __uint_as_float(w.y & 0xffff0000u); }
constexpr int WRS = 1028;
__device__ __forceinline__ void ln_router_fill(Frame& F, const float* gam, const float* bet, const float* wrouter) {
    LAS float* wrT = (LAS float*)F.lds; LAS float* gsh = wrT + 16 * WRS; LAS float* bsh = gsh + 1024;
    __syncthreads();
    for (int i = F.tid; i < 16384; i += 512) { const int k = i >> 4, e = i & 15; wrT[e * WRS + k] = wrouter[i]; }
    for (int i = F.tid; i < 1024; i += 512) { gsh[i] = gam[i]; bsh[i] = bet[i]; }
    __syncthreads();
}
#ifndef RES_BF16
#define RES_BF16 1
#endif
template <int MODE, bool ROUTER, bool FINAL, bool SRCIN = false>
__device__ __forceinline__ void ln_phase(Frame& F, const bf16_t* HB, const float* gam, const float* bet, const float* wrouter) {
    float* XF = (float*)(F.ws + WS_XF);
    LAS float* wrT = (LAS float*)F.lds;
    LAS float* gsh = wrT + 16 * WRS; LAS float* bsh = gsh + 1024;
    f32x4 gv[4], bv[4];
    if (!ROUTER) {
#pragma unroll
        for (int j = 0; j < 4; ++j) { gv[j] = *(const f32x4*)(gam + F.lane * 4 + 256 * j); bv[j] = *(const f32x4*)(bet + F.lane * 4 + 256 * j); } }
    const unsigned char* wsb = F.ws; int ln = F.lane; unsigned lb4 = (unsigned)ln * 16u, lb2 = (unsigned)ln * 8u, lb1 = (unsigned)ln * 4u;
    const unsigned hb_off = (unsigned)((const unsigned char*)HB - wsb);
    const int nq = F.xok ? 6 : (NT / 4 + F.G * 8 - 1) / (F.G * 8);
    constexpr bool X32 = SRCIN || !RES_BF16;
    f32x4 xr32[4][4]; u32x2 xr16[4][4], hwr[4][4];
#define LN_ISSUE(row0_) do { const int _r0 = (row0_); \
        const unsigned char* xbase = SRCIN ? (_r0 < NTP ? (const unsigned char*)F.in[I_XP] : (const unsigned char*)F.in[I_XS] - (size_t)NTP * 4096) : wsb + WS_XF;      \
        if (X32) { _Pragma("unroll") for (int r = 0; r < 4; ++r) { const unsigned ro = (unsigned)(_r0 + r) * 4096u + lb4; _Pragma("unroll") for (int j = 0; j < 4; ++j) xr32[r][j] = *(const f32x4*)(xbase + ro + 1024u * j); } } \
        else { _Pragma("unroll") for (int r = 0; r < 4; ++r) { const unsigned ro = (unsigned)(_r0 + r) * 2048u + lb2; _Pragma("unroll") for (int j = 0; j < 4; ++j) xr16[r][j] = *(const u32x2*)(xbase + ro + 512u * j); } } \
        if (MODE == 0) { _Pragma("unroll") for (int r = 0; r < 4; ++r) { const unsigned ro = hb_off + (unsigned)(_r0 + r) * 2048u + lb2; _Pragma("unroll") for (int j = 0; j < 4; ++j) hwr[r][j] = *(const u32x2*)(wsb + ro + 512u * j); } } \
    } while (0)
#define LN_Q(qi_) (F.xok ? ((F.c & 7) * 1536 + (F.c >> 3) * 48 + F.wave * 6 + (qi_)) : (F.c * 8 + F.wave + (qi_) * F.G * 8))
    u32x4 sln = {~0u, ~0u, ~0u, ~0u};
    if (MODE == 1) { const int q0 = LN_Q(0); if (nq > 0 && q0 < NT / 4 && F.lane < 16) sln = *(const u32x4*)(wsb + (unsigned)(WS_SLOT + ((size_t)F.lane * NT + (size_t)q0 * 4) * 4)); }
    { const int q0 = LN_Q(0); if (nq > 0 && q0 < NT / 4) { LN_ISSUE(q0 * 4); } }
    for (int qi = 0; qi < nq; ++qi) {
        const int q = LN_Q(qi);
        if (q >= NT / 4) break;
        const int row0 = q * 4;
        const u32x4 slc = sln;
        if (MODE == 1) { const int qn = LN_Q(qi + 1); if (qi + 1 < nq && qn < NT / 4 && ln < 16) sln = *(const u32x4*)(wsb + (unsigned)(WS_SLOT + ((size_t)ln * NT + (size_t)qn * 4) * 4)); }
        asm volatile("v_mbcnt_lo_u32_b32 %0, -1, 0\n\tv_mbcnt_hi_u32_b32 %0, -1, %0" : "=v"(ln));
        lb4 = (unsigned)ln * 16u; lb2 = (unsigned)ln * 8u; lb1 = (unsigned)ln * 4u; const int lw = ln * 4;
        f32x4 v[4][4];
#pragma unroll
        for (int r = 0; r < 4; ++r)
#pragma unroll
            for (int j = 0; j < 4; ++j) {
                if (X32) v[r][j] = xr32[r][j];
                else { v[r][j][0] = __uint_as_float(xr16[r][j].x << 16); v[r][j][1] = __uint_as_float(xr16[r][j].x & 0xffff0000u); v[r][j][2] = __uint_as_float(xr16[r][j].y << 16); v[r][j][3] = __uint_as_float(xr16[r][j].y & 0xffff0000u); } }
        if (MODE == 0) {
#pragma unroll
            for (int r = 0; r < 4; ++r)
#pragma unroll
                for (int j = 0; j < 4; ++j) { v[r][j] = v[r][j] * ALPHA; add_bf16x4(v[r][j], hwr[r][j]); }
        }
        if (!ROUTER) { const int qn = LN_Q(qi + 1); if (qi + 1 < nq && qn < NT / 4) { LN_ISSUE(qn * 4); } }
        if (MODE == 0) {
        } else {
            const int grp = row0 >= NTP; int sl[4];
#pragma unroll
            for (int r = 0; r < 4; ++r) sl[r] = (ln < 16) ? (int)slc[r] : -1;
            unsigned long long mask[4]; bool any[4], two[4]; u32x2 wa[4][4], wb[4][4];
#pragma unroll
            for (int r = 0; r < 4; ++r) {
                unsigned long long mk = __ballot(sl[r] >= 0); any[r] = mk != 0ull;
                int e0 = 0, s0 = 0; if (any[r]) { e0 = __builtin_ctzll(mk); mk &= mk - 1; s0 = __builtin_amdgcn_readlane(sl[r], e0); }
                const unsigned y0 = any[r] ? (grp ? 65536u + e0 * 2048u + s0 : e0 * 4096u + s0) : 0u;
                two[r] = mk != 0ull; int e1 = 0, s1 = 0; if (two[r]) { e1 = __builtin_ctzll(mk); mk &= mk - 1; s1 = __builtin_amdgcn_readlane(sl[r], e1); }
                const unsigned y1 = two[r] ? (grp ? 65536u + e1 * 2048u + s1 : e1 * 4096u + s1) : y0;
                mask[r] = mk;
                const unsigned char* ya = wsb + PO_YE + (size_t)y0 * 2048; const unsigned char* yb = wsb + PO_YE + (size_t)y1 * 2048;
#pragma unroll
                for (int j = 0; j < 4; ++j) { wa[r][j] = *(const u32x2*)(ya + lb2 + 512u * j); wb[r][j] = *(const u32x2*)(yb + lb2 + 512u * j); }
            }
#pragma unroll
            for (int r = 0; r < 4; ++r) {
#pragma unroll
                for (int j = 0; j < 4; ++j) { v[r][j] = v[r][j] * ALPHA; if (any[r]) add_bf16x4(v[r][j], wa[r][j]); if (two[r]) add_bf16x4(v[r][j], wb[r][j]); }
                unsigned long long mk = mask[r];
                while (mk) {
                    const int e0 = __builtin_ctzll(mk); mk &= mk - 1; const int s0 = __builtin_amdgcn_readlane(sl[r], e0);
                    const unsigned y0 = grp ? 65536u + e0 * 2048u + s0 : e0 * 4096u + s0;
                    const bool tw = mk != 0ull; int e1 = 0, s1 = 0; if (tw) { e1 = __builtin_ctzll(mk); mk &= mk - 1; s1 = __builtin_amdgcn_readlane(sl[r], e1); }
                    const unsigned y1 = tw ? (grp ? 65536u + e1 * 2048u + s1 : e1 * 4096u + s1) : y0;
                    const unsigned char* ya = wsb + PO_YE + (size_t)y0 * 2048; const unsigned char* yb = wsb + PO_YE + (size_t)y1 * 2048;
                    u32x2 xa[4], xb[4];
#pragma unroll
                    for (int j = 0; j < 4; ++j) { xa[j] = *(const u32x2*)(ya + lb2 + 512u * j); xb[j] = *(const u32x2*)(yb + lb2 + 512u * j); }
#pragma unroll
                    for (int j = 0; j < 4; ++j) { add_bf16x4(v[r][j], xa[j]); if (tw) add_bf16x4(v[r][j], xb[j]); }
                }
            }
        }
#pragma unroll
        for (int r = 0; r < 4; ++r) {
            float s = 0.f;
#pragma unroll
            for (int j = 0; j < 4; ++j) s += (v[r][j][0] + v[r][j][1]) + (v[r][j][2] + v[r][j][3]);
            const float mean = wave_sum(s) * (1.f / D); float qq = 0.f;
#pragma unroll
            for (int j = 0; j < 4; ++j) { v[r][j] = v[r][j] - mean; qq += (v[r][j][0] * v[r][j][0] + v[r][j][1] * v[r][j][1]) + (v[r][j][2] * v[r][j][2] + v[r][j][3] * v[r][j][3]); }
            const float rstd = 1.f / sqrtf(wave_sum(qq) * (1.f / D) + LN_EPS);
#pragma unroll
            for (int j = 0; j < 4; ++j) { if (ROUTER) { gv[j] = *(const LAS f32x4*)(gsh + lw + 256 * j); bv[j] = *(const LAS f32x4*)(bsh + lw + 256 * j); } v[r][j] = v[r][j] * rstd * gv[j] + bv[j]; }
            const unsigned row = (unsigned)(row0 + r);
            if (FINAL) {
                unsigned char* ob = (unsigned char*)F.out;
#pragma unroll
                for (int j = 0; j < 4; ++j) *(f32x4*)(ob + (size_t)(row * 4096u + lb4 + 1024u * j)) = v[r][j];
            } else {
                unsigned char* wsw = F.ws;
#pragma unroll
                for (int j = 0; j < 4; ++j) {
                    if (RES_BF16) { u32x2 xo; xo.x = cvt_pk_bf16_c(v[r][j][0], v[r][j][1]); xo.y = cvt_pk_bf16_c(v[r][j][2], v[r][j][3]); *(u32x2*)(wsw + (unsigned)(WS_XF + row * 2048u + lb2 + 512u * j)) = xo; }
                    else *(f32x4*)(wsw + (unsigned)(WS_XF + row * 4096u + lb4 + 1024u * j)) = v[r][j];
                    *(unsigned*)(wsw + (unsigned)(WS_XB8 + row * 1024u + lb1 + 256u * j)) = cvt4_fp8(v[r][j][0] * FP8_SX, v[r][j][1] * FP8_SX, v[r][j][2] * FP8_SX, v[r][j][3] * FP8_SX); }
            }
        }
        if (ROUTER) {
            { const int qn = LN_Q(qi + 1); if (qi + 1 < nq && qn < NT / 4) { LN_ISSUE(qn * 4); } }
            float val[64];
#pragma unroll
            for (int hf = 0; hf < 4; ++hf) {
                f32x2 a2[4][4];
#pragma unroll
                for (int r = 0; r < 4; ++r)
#pragma unroll
                    for (int e4 = 0; e4 < 4; ++e4) a2[r][e4] = f32x2{0.f, 0.f};
#pragma unroll
                for (int e4 = 0; e4 < 4; ++e4)
#pragma unroll
                    for (int j = 0; j < 4; ++j) { const f32x4 w = *(const LAS f32x4*)(wrT + (hf * 4 + e4) * WRS + lw + 256 * j);
                        const f32x2 wl = f32x2{w[0], w[1]}, wh = f32x2{w[2], w[3]};
#pragma unroll
                        for (int r = 0; r < 4; ++r) { a2[r][e4] = f32x2{v[r][j][0], v[r][j][1]} * wl + a2[r][e4]; a2[r][e4] = f32x2{v[r][j][2], v[r][j][3]} * wh + a2[r][e4]; } }
#pragma unroll
                for (int r = 0; r < 4; ++r)
#pragma unroll
                    for (int e4 = 0; e4 < 4; ++e4) val[r * 16 + hf * 4 + e4] = a2[r][e4][0] + a2[r][e4][1];
            }
#pragma unroll
            for (int sft = 5; sft >= 0; --sft) { const int n2 = 1 << sft; const bool up = (ln >> sft) & 1;
#pragma unroll
                for (int i = 0; i < n2; ++i) { const float lo = val[i], hi = val[i + n2]; const float mine = up ? hi : lo, other = up ? lo : hi; val[i] = mine + __shfl_xor(other, n2); } }
            const float lg = val[0], m = row_max(lg);
            const float ex = expf(lg - m); const float l = row_sum(ex);
            *(float*)(F.ws + (unsigned)(WS_AFF + ((size_t)(ln & 15) * NT + row0 + (ln >> 4)) * 4)) = ex / l;
        }
    }
#undef LN_Q
#undef LN_ISSUE
    if (ROUTER) __syncthreads();
}
__device__ __forceinline__ void softmax_phase(Frame& F, bf16_t* SB) {
    for (int row = F.c * 8 + F.wave; row < NT * 4; row += F.G * 8) {
        u32x2* p = (u32x2*)(SB + (size_t)row * 256) + F.lane; const u32x2 w = *p;
        float a = __uint_as_float(w.x << 16), b = __uint_as_float(w.x & 0xffff0000u), c = __uint_as_float(w.y << 16), d = __uint_as_float(w.y & 0xffff0000u);
        const float m = wave_max(fmaxf(fmaxf(a, b), fmaxf(c, d)));
        a = __expf(a - m); b = __expf(b - m); c = __expf(c - m); d = __expf(d - m);
        const float inv = 1.f / wave_sum((a + b) + (c + d));
        u32x2 o; o.x = cvt_pk_bf16(a * inv, b * inv); o.y = cvt_pk_bf16(c * inv, d * inv); *p = o;
    }
}
__device__ __forceinline__ void moe_panel(int P, int& e, int& grp, int& yerow0) {
    if (P < 256) { e = P >> 4; grp = 0; } else { e = (P - 256) >> 3; grp = 1; }
    yerow0 = P * 256;
}
#ifndef UPWGM
#define UPWGM 8
#endif
struct SchedUp { unsigned char* ws; int G, c; int layer; int nconv;
    __device__ __forceinline__ bool next(int i, GUnit& u) const { int P, pn;
        if (nconv > 0) { const int xcd = c & 7, rank = c >> 3, nact = 32 - nconv, nfull = 768 / nact, rem = 768 - nfull * nact, per = (rem + nconv - 1) / nconv; int l;
            if (rank < nact) { if (i >= nfull) return false; l = i * nact + rank; }
            else { if (i >= per) return false; l = nfull * nact + (rank - nact) * per + i; if (l >= 768) return false; }
            const int wgid = xcd * 768 + l; P = (wgid >> 7) * 8 + ((wgid & 127) & 7); pn = (wgid & 127) >> 3; }
        else if (!static_unit<UPWGM>(i, G, c, 384, 16, P, pn)) return false;
        int e, grp, y0; moe_panel(P, e, grp, y0);
        u.A = (const char*)ws + WS_XB8 + (grp ? (size_t)NTP * 1024 : 0); u.B = (const char*)ws + (layer ? WS_EW13B : WS_EW13) + ((size_t)e * 4096 + pn * BM) * 1024;
        u.C = (char*)ws + PO_HM + ((size_t)P * BM * 2048 + pn * HALF); u.X = (const int*)(ws + WS_IDX) + y0; u.pm = P; u.pn = pn; return true; } };
struct SchedDown { unsigned char* ws; int G, c; int layer;
    __device__ __forceinline__ bool next(int i, GUnit& u) const { int P, pn; if (!static_unit(i, G, c, 384, 4, P, pn)) return false; int e, grp, y0; moe_panel(P, e, grp, y0);
        u.A = (const char*)ws + PO_HM + (size_t)P * BM * 2048; u.B = (const char*)ws + (layer ? WS_EW2B : WS_EW2) + ((size_t)e * 1024 + pn * BM) * 2048;
        u.C = (char*)ws + PO_YE + ((size_t)y0 * 1024 + pn * BM) * 2; u.X = (const float*)(ws + WS_GATE) + y0; u.pm = P; u.pn = pn; return true; } };
struct SchedQKV { unsigned char* ws; int G, c;
    __device__ __forceinline__ bool next(int i, GUnit& u) const { const int L = i * G + c; if (L >= 1536 + 768) return false;
        if (L < 1536) { int pm, pn; static_unit(i, G, c, 192, 8, pm, pn);
            u.A = (const char*)ws + WS_XB8 + (size_t)pm * BM * 1024; u.B = (const char*)ws + WS_WQKV + (size_t)pn * BM * 1024;
            u.C = (char*)ws + (pn < 4 ? PO_Q : PO_K) + ((size_t)pm * BM * 1024 + (pn & 3) * BM) * 2; u.X = nullptr; u.pm = pm; u.pn = pn; return true; }
        const int r = L - 1536, pmv = r & 3, pnv = r >> 2;
        u.A = (const char*)ws + WS_WQKV + (size_t)(2048 + pmv * BM) * 1024; u.B = (const char*)ws + WS_XB8 + (size_t)pnv * BM * 1024;
        u.C = (char*)ws + PO_VT + ((size_t)pmv * BM * NT + (size_t)pnv * BM) * 2; u.X = nullptr; u.pm = pmv; u.pn = 8 + pnv; return true; } };
struct EpiQKV {
    static constexpr bool PERM = true;
    __device__ __forceinline__ void operator()(const Acc& acc, const GUnit& u, int wr, int wc, int fr, int fq) const {
        constexpr float ds = 1.f / (FP8_SX * FP8_SWQKV);
        if (u.pn >= 8) { EpiBf<false> e{(unsigned)NT, ds}; e(acc, u, wr, wc, fr, fq); }
        else { EpiBf<false> e{1024u, u.pn < 4 ? 0.125f * 1.4426950408889634f * ds : ds}; e(acc, u, wr, wc, fr, fq); }
    }
};

__device__ __forceinline__ int wave_sum_i(int v) {
#pragma unroll
    for (int o = 1; o < 64; o <<= 1) v += __shfl_xor(v, o);
    return v;
}
__device__ __forceinline__ int block_excl_scan(int v, int lane, int wave, LAS int* red, int& total) {
    int inc = v;
#pragma unroll
    for (int o = 1; o < 64; o <<= 1) { const int t = __shfl_up(inc, o); if (lane >= o) inc += t; }
    __syncthreads();
    if (lane == 63) red[wave] = inc;
    __syncthreads();
    int off = 0, tot = 0;
#pragma unroll
    for (int w = 0; w < 8; ++w) { const int c = red[w]; if (w < wave) off += c; tot += c; }
    total = tot; return off + inc - v;
}
template <int PER>
__device__ __forceinline__ void select_fast(Frame& F, const float* affcol, int cap, int* idx_out, float* gate_out, int* slotcol) {
    LAS int* red = (LAS int*)F.lds;
    unsigned key[PER];
#pragma unroll
    for (int i = 0; i < PER / 4; ++i) { const u32x4 v = ((const u32x4*)(affcol + (size_t)F.tid * PER))[i]; key[4 * i] = v.x; key[4 * i + 1] = v.y; key[4 * i + 2] = v.z; key[4 * i + 3] = v.w; }
    unsigned T = 0u;
    for (int b = 30; b >= 0; --b) {
        const unsigned cand = T | (1u << b); int cnt = 0;
#pragma unroll
        for (int i = 0; i < PER; ++i) cnt += (key[i] >= cand) ? 1 : 0;
        cnt = wave_sum_i(cnt);
        LAS int* r = red + (b & 1) * 8;
        if (F.lane == 0) r[F.wave] = cnt;
        __syncthreads();
        int tot = 0;
#pragma unroll
        for (int w = 0; w < 8; ++w) tot += r[w];
        if (tot >= cap) T = cand;
    }
    int g = 0, q = 0;
#pragma unroll
    for (int i = 0; i < PER; ++i) { g += (key[i] > T) ? 1 : 0; q += (key[i] == T) ? 1 : 0; }
    int tot_g, tot_q; (void)tot_q;
    const int Eoff = block_excl_scan(q, F.lane, F.wave, red + 32, tot_q);
    int dummy; const int Goff = block_excl_scan(g, F.lane, F.wave, red + 32, tot_g); (void)Goff;
    const int need_eq = cap - tot_g;
    int eq_take = need_eq - Eoff; eq_take = eq_take < 0 ? 0 : (eq_take > q ? q : eq_take);
    const int base = block_excl_scan(g + eq_take, F.lane, F.wave, red + 32, dummy);
    int slot = base, eqseen = 0;
    const int tok0 = F.tid * PER;
#pragma unroll
    for (int i4 = 0; i4 < PER / 4; ++i4) { int so[4];
#pragma unroll
        for (int j = 0; j < 4; ++j) { const int i = 4 * i4 + j; const unsigned k = key[i]; bool sel = k > T; if (k == T) { sel = eqseen < eq_take; ++eqseen; }
            so[j] = sel ? slot : -1; if (sel) { idx_out[slot] = tok0 + i; gate_out[slot] = __uint_as_float(k); ++slot; } }
        ((int4*)(slotcol + tok0))[i4] = make_int4(so[0], so[1], so[2], so[3]); }
}
__device__ __forceinline__ void select_phase(Frame& F) {
    for (int it = F.c; it < 32; it += F.G) {
        const int grp = it >> 4, e = it & 15; const int n = grp ? NTS : NTP, cap = n / 8;
        const float* affcol = (const float*)(F.ws + WS_AFF) + (size_t)e * NT + (grp ? NTP : 0);
        int* idx = (int*)(F.ws + WS_IDX) + (grp ? 65536 : 0) + e * cap; float* gate = (float*)(F.ws + WS_GATE) + (grp ? 65536 : 0) + e * cap;
        int* slotcol = (int*)(F.ws + WS_SLOT) + (size_t)e * NT + (grp ? NTP : 0);
        __syncthreads();
        if (grp == 0) select_fast<64>(F, affcol, cap, idx, gate, slotcol); else select_fast<32>(F, affcol, cap, idx, gate, slotcol);
        __syncthreads();
    }
}

constexpr int NA_SLOT = 16384, NA_SLOT8_OFF = 147456, NA_RPB_OFF = RING_BYTES + 4096;
__device__ __forceinline__ void natten_phase(Frame& F, const float* rpb) {
    const bf16_t* Kb = (const bf16_t*)(F.ws + PO_K); const bf16_t* VT = (const bf16_t*)(F.ws + PO_VT); bf16_t* QO = (bf16_t*)(F.ws + PO_Q);
    LAS float* rpbh = (LAS float*)(F.lds + NA_RPB_OFF);
    const int lane = F.lane, w = F.wave, fr = lane & 15, fq = lane >> 4;
    bool c0[4], c2[4]; int xe[4];
#pragma unroll
    for (int e = 0; e < 4; ++e) { xe[e] = 4 * fq + e - fr; c0[e] = xe[e] >= 8; c2[e] = xe[e] < -8; }
    const bool fA = fr < 8, fC = fr > 8;
    unsigned mk0[2], mk2[2], mk0c[2], mk2a[2], mkc1[2], mkca[2], mkcc[2];
#pragma unroll
    for (int pr = 0; pr < 2; ++pr) { mk0[pr] = (c0[2 * pr] ? 0xFFFFu : 0u) | (c0[2 * pr + 1] ? 0xFFFF0000u : 0u); mk2[pr] = (c2[2 * pr] ? 0xFFFFu : 0u) | (c2[2 * pr + 1] ? 0xFFFF0000u : 0u);
        mk0c[pr] = fC ? 0u : mk0[pr]; mk2a[pr] = fA ? 0u : mk2[pr]; mkc1[pr] = ~(mk0[pr] | mk2[pr]); mkca[pr] = ~mk2a[pr]; mkcc[pr] = ~mk0c[pr];
        asm volatile("" : "+v"(mk0[pr]), "+v"(mk2[pr]), "+v"(mk0c[pr]), "+v"(mk2a[pr]), "+v"(mkc1[pr]), "+v"(mkca[pr]), "+v"(mkcc[pr])); }
    const int lrow = F.tid >> 3, lchk = F.tid & 7;
    const int gchk = lchk ^ ((lrow >> 1) & 7);
    const unsigned stg = (unsigned)F.tid * 16u;
    const int swz = (fr >> 1) & 7;
    unsigned kofs[2], vofs0[2], vofs1[2];
#pragma unroll
    for (int ks = 0; ks < 2; ++ks) { kofs[ks] = (unsigned)(fr * 128 + (((4 * ks + fq) ^ swz) << 4));
        vofs0[ks] = (unsigned)(8192 + fr * 128 + (((4 * ks + (fq >> 1)) ^ swz) << 4) + (fq & 1) * 8); vofs1[ks] = (unsigned)(8192 + fr * 128 + (((4 * ks + (fq >> 1) + 2) ^ swz) << 4) + (fq & 1) * 8); }
    const int nblk = F.xok ? 6 : 1536;
    for (int it = F.xok ? 0 : F.c; it < nblk; it += F.xok ? 1 : F.G) {
        int gb, h, rb, rows;
        if (F.xok) { const int u = (F.c >> 3) + 32 * it, t = 12 * (F.c & 7) + (u >> 4); h = u & 15;
            if (t < 64) { gb = t >> 4; rb = t & 15; rows = 128; } else { gb = 4 + ((t - 64) >> 3); rb = (t - 64) & 7; rows = 64; } }
        else { const int blk = it; if (blk < 1024) { gb = blk >> 8; h = (blk >> 4) & 15; rb = blk & 15; rows = 128; } else { const int V = blk - 1024; gb = 4 + (V >> 7); h = (V >> 3) & 15; rb = V & 7; rows = 64; } }
        const int r = rb * 8 + w;
        int rs = r - 4; rs = rs < 0 ? 0 : (rs > rows - 8 ? rows - 8 : rs);
        int kr_lo = rb * 8 - 4; kr_lo = kr_lo < 0 ? 0 : (kr_lo > rows - 8 ? rows - 8 : kr_lo);
        int kr_hi = rb * 8 + 7 - 4; kr_hi = (kr_hi < 0 ? 0 : (kr_hi > rows - 8 ? rows - 8 : kr_hi)) + 8;
        const size_t tb = (size_t)gb_tok0(gb), tq0 = tb + (size_t)r * 64;
        bf16x8 Qf[4][2];
        float mrun[4], lrun[4]; f32x4 Ot[4][4];
        const bf16_t* kg = Kb + (tb + (size_t)kr_lo * 64 + lrow) * D + h * 64 + gchk * 8; const bf16_t* vg = VT + (size_t)(h * 64 + lrow) * NT + tb + (size_t)kr_lo * 64 + gchk * 8;
        const int nrows = kr_hi - kr_lo;
#define NA_LOAD(dst, ptr) asm volatile("global_load_dwordx4 %0, %1, off" : "=&v"(dst) : "v"(ptr) : "memory")
        {
#pragma unroll
          for (int j = 0; j < 8; ++j) { __builtin_amdgcn_global_load_lds((const unsigned*)(kg + (size_t)j * 64 * D), (LAS unsigned*)(F.lds + j * NA_SLOT + w * 1024), 16, 0, 0);
              __builtin_amdgcn_global_load_lds((const unsigned*)(vg + (size_t)j * 64), (LAS unsigned*)(F.lds + j * NA_SLOT + 8192 + w * 1024), 16, 0, 0); }
#pragma unroll
          for (int t = 0; t < 4; ++t)
#pragma unroll
              for (int ks = 0; ks < 2; ++ks) Qf[t][ks] = *(const bf16x8*)(QO + (tq0 + 16 * t + fr) * D + h * 64 + 32 * ks + 8 * fq);
          const float rv = F.tid < 465 ? rpb[h * 465 + F.tid] * 1.4426950408889634f : 0.f;
          if (F.tid < 465) rpbh[F.tid] = rv; }
#pragma unroll
        for (int qt = 0; qt < 4; ++qt) { mrun[qt] = -INFINITY; lrun[qt] = 0.f;
#pragma unroll
            for (int dt = 0; dt < 4; ++dt) Ot[dt][qt] = (f32x4){0.f, 0.f, 0.f, 0.f}; }
#pragma unroll
        for (int t = 0; t < 4; ++t)
#pragma unroll
            for (int ks = 0; ks < 2; ++ks) asm volatile("" :: "v"(Qf[t][ks]));
        asm volatile("s_waitcnt vmcnt(0)" ::: "memory");
        __syncthreads();
        int slot = rs - kr_lo;
#pragma nounroll
        for (int i = 0; i < 8; ++i) {
            const bool more = i + 8 < nrows;
            if (more) {
                const int ws_ = i == 0 ? 8 : i - 1; const unsigned wb = (unsigned)(ws_ * NA_SLOT + (ws_ == 8 ? NA_SLOT8_OFF - 8 * NA_SLOT : 0));
                __builtin_amdgcn_global_load_lds((const unsigned*)(kg + (size_t)(i + 8) * 64 * D), (LAS unsigned*)(F.lds + wb + w * 1024), 16, 0, 0);
                __builtin_amdgcn_global_load_lds((const unsigned*)(vg + (size_t)(i + 8) * 64), (LAS unsigned*)(F.lds + wb + 8192 + w * 1024), 16, 0, 0); }
            {
            const int dr = rs + i - r + 7;
            const unsigned sb = (unsigned)(slot * NA_SLOT + (slot == 8 ? NA_SLOT8_OFF - 8 * NA_SLOT : 0));
            const LAS unsigned char* Sl = F.lds + sb;
            bf16x8 Kf[4][2];
#pragma unroll
            for (int t = 0; t < 4; ++t)
#pragma unroll
                for (int ks = 0; ks < 2; ++ks) Kf[t][ks] = *(const LAS bf16x8*)(Sl + kofs[ks] + t * 2048);
            float bsel[3][4];
#pragma unroll
            for (int e = 0; e < 4; ++e) { const int dcB = xe[e] + 15 + (c0[e] ? -16 : (c2[e] ? 16 : 0)), dcA = fA ? xe[e] + 15 : dcB, dcC = fC ? xe[e] + 15 : dcB;
                bsel[0][e] = rpbh[dr * 31 + dcA]; bsel[1][e] = rpbh[dr * 31 + dcB]; bsel[2][e] = rpbh[dr * 31 + dcC]; }
            bf16x8 Pf[4][2]; float alpha[4]; bool moved = false;
#pragma unroll
            for (int qt = 0; qt < 4; ++qt) {
                f32x4 St[3];
#pragma unroll
                for (int dk = 0; dk < 3; ++dk) { const int kt = qt + dk - 1; St[dk] = (f32x4){0.f, 0.f, 0.f, 0.f};
                    if (kt >= 0 && kt < 4) { St[dk] = __builtin_amdgcn_mfma_f32_16x16x32_bf16(Kf[kt][0], Qf[qt][0], St[dk], 0, 0, 0); St[dk] = __builtin_amdgcn_mfma_f32_16x16x32_bf16(Kf[kt][1], Qf[qt][1], St[dk], 0, 0, 0); } }
                constexpr int dummy = 0; (void)dummy;
                const int cls = qt == 0 ? 0 : (qt == 3 ? 2 : 1);
                float sv[4]; bool u0[4], u2[4]; float mx = -INFINITY;
#pragma unroll
                for (int e = 0; e < 4; ++e) { u0[e] = c0[e] && !(cls == 0 && fA) && !(cls == 2 && fC) && (qt > 0); u2[e] = c2[e] && !(cls == 0 && fA) && !(cls == 2 && fC) && (qt < 3);
                    sv[e] = (u0[e] ? St[0][e] : (u2[e] ? St[2][e] : St[1][e])) + bsel[cls][e]; mx = fmaxf(mx, sv[e]); }
                mx = x32_max(x16_max(mx));
                const float mnew = fmaxf(mrun[qt], mx); alpha[qt] = __builtin_amdgcn_exp2f(mrun[qt] - mnew); moved = moved || (mnew != mrun[qt]); mrun[qt] = mnew;
                float l = 0.f, p[4];
#pragma unroll
                for (int e = 0; e < 4; ++e) { p[e] = __builtin_amdgcn_exp2f(sv[e] - mnew); l += p[e]; }
                l = x32_sum(x16_sum(l)); lrun[qt] = lrun[qt] * alpha[qt] + l;
                const unsigned pk01 = cvt_pk_bf16_c(p[0], p[1]), pk23 = cvt_pk_bf16_c(p[2], p[3]);
                unsigned t01[4], t23[4];
#pragma unroll
                for (int kt = 0; kt < 4; ++kt) { const int dk = kt - qt + 1; t01[kt] = 0u; t23[kt] = 0u;
                    if (dk == 0) { t01[kt] = pk01 & (cls == 2 ? mk0c[0] : mk0[0]); t23[kt] = pk23 & (cls == 2 ? mk0c[1] : mk0[1]); }
                    else if (dk == 2) { t01[kt] = pk01 & (cls == 0 ? mk2a[0] : mk2[0]); t23[kt] = pk23 & (cls == 0 ? mk2a[1] : mk2[1]); }
                    else if (dk == 1) { t01[kt] = pk01 & (cls == 0 ? mkca[0] : (cls == 2 ? mkcc[0] : mkc1[0])); t23[kt] = pk23 & (cls == 0 ? mkca[1] : (cls == 2 ? mkcc[1] : mkc1[1])); } }
#pragma unroll
                for (int ks = 0; ks < 2; ++ks) { u32x4 wv; wv.x = t01[2 * ks]; wv.y = t23[2 * ks]; wv.z = t01[2 * ks + 1]; wv.w = t23[2 * ks + 1];
                    Pf[qt][ks] = __builtin_bit_cast(bf16x8, wv); }
            }
            const bool rescale = __ballot(moved) != 0ull;
#pragma unroll
            for (int dt = 0; dt < 4; ++dt) {
                if (rescale) {
#pragma unroll
                    for (int qt = 0; qt < 4; ++qt) Ot[dt][qt] = Ot[dt][qt] * alpha[qt]; }
#pragma unroll
                for (int ks = 0; ks < 2; ++ks) { const u32x2 v0 = *(const LAS u32x2*)(Sl + vofs0[ks] + dt * 2048), v1 = *(const LAS u32x2*)(Sl + vofs1[ks] + dt * 2048);
                    u32x4 vv; vv.x = v0.x; vv.y = v0.y; vv.z = v1.x; vv.w = v1.y; const bf16x8 Vf = __builtin_bit_cast(bf16x8, vv);
#pragma unroll
                    for (int qt = 0; qt < 4; ++qt) { if ((qt == 0 && ks == 1) || (qt == 3 && ks == 0)) continue; Ot[dt][qt] = __builtin_amdgcn_mfma_f32_16x16x32_bf16(Vf, Pf[qt][ks], Ot[dt][qt], 0, 0, 0); } }
            }
            }
            if (more) asm volatile("s_waitcnt vmcnt(0)" ::: "memory");
            slot = slot == 8 ? 0 : slot + 1;
            __syncthreads();
        }
#undef NA_LOAD
#pragma unroll
        for (int qt = 0; qt < 4; ++qt) { const float inv = 1.f / lrun[qt];
#pragma unroll
            for (int dt = 0; dt < 4; ++dt) { const f32x4 o = Ot[dt][qt] * inv; u32x2 wv; wv.x = cvt_pk_bf16_c(o[0], o[1]); wv.y = cvt_pk_bf16_c(o[2], o[3]);
                pst8(QO + (tq0 + 16 * qt + fr) * D + h * 64 + 16 * dt + 4 * fq, wv); } }
    }
    __syncthreads();
}
constexpr int N_PHASES = 31;
constexpr int FLAG_NO_XIMPORT = 1, FLAG_NO_EXPERTS0 = 2;
#ifndef UP_NCONV
#define UP_NCONV 4
#endif
#ifndef CV_UP_ITEMS
#define CV_UP_ITEMS 16896
#endif
constexpr int CV_UP1 = 5376 + CV_UP_ITEMS;
constexpr int CV_P1 = 3072, CV_P2 = CV_P1 + 1536, CV_SEL = CV_P2 + 5376, CV_SEL1 = 5376, CV_P0B = CV_SEL + 3584;
__global__ void __launch_bounds__(512, 2) fwd(Args args) {
    extern __shared__ __attribute__((aligned(16))) unsigned char lds_raw[];
    Frame F; F.lds = (LAS unsigned char*)lds_raw; F.ws = args.ws; F.in = args.in; F.out = args.out;
    F.tid = threadIdx.x; F.lane = F.tid & 63; F.wave = __builtin_amdgcn_readfirstlane(F.tid >> 6); F.G = gridDim.x; F.c = blockIdx.x; F.xok = false;
    unsigned char* ws = args.ws;
    const int wave_s = __builtin_amdgcn_readfirstlane(threadIdx.x >> 6);
    for (int u = F.tid; u < (LDS_BYTES - RING_BYTES) / 4; u += 512) ((LAS unsigned*)(F.lds + RING_BYTES))[u] = 0u;
    __syncthreads();
    const int lo = args.ph_lo, hi = args.ph_hi;
    volatile LAS unsigned* MISC = (volatile LAS unsigned*)(F.lds + MISC_OFF);
    XcdBarrier bar; bar.bar = (unsigned*)(ws + WS_CTL) + CW_BAR + args.pad * XCD_BAR_WORDS_EXT; bar.x = 0; bar.st = nullptr;
    const bool multi = (hi - lo) > 1;
    if (multi) bar = xcd_barrier_post((unsigned*)(ws + WS_CTL) + CW_BAR + args.pad * XCD_BAR_WORDS_EXT, MISC + 8);
#define IN(k) (lo <= (k) && (k) < hi)
#ifdef STAMP_PA
    unsigned long long* TS = (unsigned long long*)(ws + WS_CTL + 40 * 1024);
#define STAMP(k) do { if (blockIdx.x == 0 && threadIdx.x == 0) TS[k] = __builtin_amdgcn_s_memrealtime(); } while (0)
#else
#define STAMP(k) do { } while (0)
#endif
#ifdef AMP_PHASE
    unsigned long long t_phase0 = 0ull;
#define AMP_NOW(t) asm volatile("s_memrealtime %0\n\ts_waitcnt lgkmcnt(0)" : "=s"(t) :: "memory")
#define AMP_T0() do { AMP_NOW(t_phase0); } while (0)
#define AMP_WAIT(k) do { if ((k) == AMP_PHASE || AMP_PHASE < 0) { asm volatile("s_waitcnt vmcnt(0) lgkmcnt(0)" ::: "memory"); unsigned long long _t1; AMP_NOW(_t1); const unsigned long long _tw = _t1 + (unsigned long long)AMP_M * (_t1 - t_phase0); unsigned long long _tn; do { __builtin_amdgcn_s_sleep(4); AMP_NOW(_tn); } while (_tn < _tw); } } while (0)
#else
#define AMP_T0() do { } while (0)
#define AMP_WAIT(k) do { } while (0)
#endif
#define SEAM(k) do { AMP_WAIT(k); if (IN(k) && IN((k) + 1)) { xcd_barrier(bar, wave_s); STAMP((k) + 1); } } while (0)
    STAMP(0);
    LAS unsigned char* ring = F.lds;
#define PHASE_BEGIN() do { int _t; asm volatile("v_mbcnt_lo_u32_b32 %0, -1, 0\n\tv_mbcnt_hi_u32_b32 %0, -1, %0" : "=v"(_t)); _t |= (wave_s << 6); F.tid = _t; F.lane = _t & 63; F.wave = wave_s; AMP_T0(); } while (0)

#ifndef P0_SKIP
#define P0_SKIP 0
#endif
    if (IN(0)) { PHASE_BEGIN(); const int p0s = (args.pad == 1) ? P0_SKIP : 0;
        if (!(p0s & 1)) for (int it = F.c; it < 128; it += F.G) s5_build_item(F, it >> 1, it & 1);
        if (!(p0s & 2)) convert_small_weights(F);
        if (!(p0s & 4)) if (!(args.flags & FLAG_NO_EXPERTS0)) { convert_expert_weights(F, 0, CV_SEL, CV_P0B, 128);
            convert_expert_weights(F, 0, CV_P0B, 16 * 1536, 0); }
        if (!(p0s & 8)) { convert_plain(F, args.in[I_MWQ], (bf16_t*)(ws + WS_MWQ), (size_t)2 * 1024 * 1024);
        convert_plain(F, args.in[I_MEMP], (bf16_t*)(ws + WS_MEMB), (size_t)4 * 256 * 1024);
        convert_plain(F, args.in[I_MEMS], (bf16_t*)(ws + WS_MEMB) + (size_t)4 * 256 * 1024, (size_t)4 * 256 * 1024); }
        if (!(p0s & 16)) import_x(F, !(args.flags & FLAG_NO_XIMPORT));
    }
    SEAM(0);
    unsigned nloc_s = 32u;
    if (multi && IN(0) && IN(1)) {
        if (F.tid == 0) { unsigned ok = (F.G == 256) ? 1u : 0u; unsigned* bw = bar.bar;
            for (unsigned j = 0; j < 16; ++j) { const unsigned cnt = xb_ld(&bw[XB_XCNT(j)]); if (j < 8 ? cnt != 32u : cnt != 0u) ok = 0u; }
#ifdef FORCE_NOXOK
            ok = 0u;
#endif
            MISC[13] = ok; }
        __syncthreads();
        if (MISC[13]) { F.xok = true; F.c = (int)(MISC[12] * 8u + bar.x); }
    }
#define LSEAM(k) do { AMP_WAIT(k); if (IN(k) && IN((k) + 1)) { if (F.xok) xcd_local_barrier(bar, wave_s, nloc_s); else xcd_barrier(bar, wave_s); STAMP((k) + 1); } } while (0)
    {
        const float* lng = args.in[I_LNG]; const float* lnb = args.in[I_LNB];
        if (IN(1)) { PHASE_BEGIN();
            { SchedKV S{ws, F.G, F.c}; EpiBf<false> E{2048u, 1.f}; gemm_phase<EpiBf<false>, SchedKV, false>(ring, F.tid, 1024, 2048u, 2048u, S, E); }
            { SchedUA S{(const char*)ws + WS_XB, (const char*)ws + WS_WIN, (char*)ws + PO_UA, F.G, F.c}; EpiUA E; gemm_phase<EpiUA, SchedUA, false>(ring, F.tid, 1024, 2048u, 2048u, S, E); }
            if (!(args.flags & FLAG_NO_EXPERTS0)) convert_expert_weights(F, 0, 0, CV_P1, 128);
        }
        SEAM(1);
        if (IN(2)) { PHASE_BEGIN();
            { SchedSA S{ws, F.G, F.c}; EpiS E; gemm_phase<EpiS, SchedSA, false>(ring, F.tid, 512, (unsigned)(UAK * 2), 1024u, S, E); }
            { SchedWqk S{ws, F.G, F.c}; EpiBf8 E{1024u, 0.0625f * 1.4426950408889634f * FP8_SWQK}; gemm_phase<EpiBf8, SchedWqk, false>(ring, F.tid, 256, 4096u, 2048u, S, E); }
            { SchedWvo S{ws, F.G, F.c}; EpiBf<false> E{1024u, 1.f}; gemm_phase<EpiBf<false>, SchedWvo, false>(ring, F.tid, 256, 2048u, 4096u, S, E); }
            if (!(args.flags & FLAG_NO_EXPERTS0)) convert_expert_weights(F, 0, CV_P1, CV_P2, 128);
        }
        SEAM(2);
        if (IN(3)) { PHASE_BEGIN(); s5_recurrence(F); }
        SEAM(3);
        if (IN(4)) { PHASE_BEGIN(); SchedSC S{ws, F.G, F.c}; EpiGelu E; gemm_phase<EpiGelu, SchedSC, false>(ring, F.tid, UAK, (unsigned)(UAK * 2), (unsigned)(UAK * 2), S, E); }
        SEAM(4);
        if (IN(5)) { PHASE_BEGIN(); SchedGated S{(const char*)ws + PO_SG, (const char*)ws + WS_WGLU, (char*)ws + PO_HB_S5, 2048, 2048, 1024, NT / BM, 8, F.G, F.c}; EpiGated<0> E{1024u};
            gemm_phase<EpiGated<0>, SchedGated, false>(ring, F.tid, 1024, 2048u, 2048u, S, E); }
        LSEAM(5);
        if (IN(6)) { PHASE_BEGIN(); if (args.flags & FLAG_NO_XIMPORT) ln_phase<0, false, false, false>(F, (const bf16_t*)(ws + PO_HB_S5), lng, lnb, nullptr); else ln_phase<0, false, false, true>(F, (const bf16_t*)(ws + PO_HB_S5), lng, lnb, nullptr); }
        LSEAM(6);
    }
#define COMMON_BLOCK(layer, pb) do { \
        const float* lng = args.in[I_LNG] + (size_t)(layer) * 3 * D; const float* lnb = args.in[I_LNB] + (size_t)(layer) * 3 * D; \
        if (IN((pb) + 0)) { PHASE_BEGIN(); SchedScores8 S{(const char*)ws + WS_XB8, (const char*)ws + WS_WQK + (size_t)(layer) * 8 * MiB, (char*)ws + PO_SB, F.G, F.c}; EpiSoftmax E{(LAS float*)(F.lds + RING_BYTES + 4096), 1024u, 1.f / (FP8_SX * FP8_SWQK)}; \
            gemm_phase<EpiSoftmax, SchedScores8, false, true>(ring, F.tid, 512, 1024u, 1024u, S, E); } \
        AMP_WAIT((pb) + 0); if (IN((pb) + 0) && IN((pb) + 2)) { if (F.xok) xcd_local_barrier(bar, wave_s, nloc_s); else xcd_barrier(bar, wave_s); STAMP((pb) + 1); }     \
        if (IN((pb) + 2)) { PHASE_BEGIN(); SchedBatchW S{(const char*)ws + PO_SB, (const char*)ws + WS_WVO + (size_t)(layer) * 16 * MiB, (char*)ws + PO_HB_MEM, F.G, F.c}; EpiBf<false> E{1024u, 1.f}; \
            gemm_phase<EpiBf<false>, SchedBatchW, false>(ring, F.tid, 1024, 2048u, 2048u, S, E); } \
        if (IN((pb) + 3)) { PHASE_BEGIN(); ln_router_fill(F, lng + D, lnb + D, args.in[I_EWR] + (size_t)(layer) * D * 16); }     \
        LSEAM((pb) + 2); \
        if (IN((pb) + 3)) { PHASE_BEGIN(); ln_phase<0, true, false>(F, (const bf16_t*)(ws + PO_HB_MEM), lng + D, lnb + D, args.in[I_EWR] + (size_t)(layer) * D * 16); } \
        SEAM((pb) + 3); \
        if (IN((pb) + 4)) { PHASE_BEGIN(); select_phase(F); if ((layer) == 0) { if (!(args.flags & FLAG_NO_EXPERTS0)) convert_expert_weights(F, 0, CV_P2, CV_SEL, 32); } else convert_expert_weights(F, 1, 0, CV_SEL1, 32); } \
        SEAM((pb) + 4); \
        if (IN((pb) + 5)) { PHASE_BEGIN(); const int nconv = ((layer) == 0 && F.xok) ? UP_NCONV : 0; SchedUp S{ws, F.G, F.c, (layer), nconv}; EpiGated8 E{2048u}; gemm_phase<EpiGated8, SchedUp, true, true>(ring, F.tid, 512, 1024u, 1024u, S, E); \
            if (nconv > 0 && (F.c >> 3) >= 32 - nconv) convert_expert_weights(F, 1, CV_SEL1, CV_UP1, 0, ((F.c & 7) * nconv + (F.c >> 3) - (32 - nconv)) * 8 + F.wave, 8 * nconv * 8); }     \
        LSEAM((pb) + 5);     \
        if (IN((pb) + 6)) { PHASE_BEGIN(); SchedDown S{ws, F.G, F.c, (layer)}; EpiBf<true> E{1024u, 1.f / (FP8_SH * FP8_SW2)}; gemm_phase<EpiBf<true>, SchedDown, false, true>(ring, F.tid, 1024, 2048u, 2048u, S, E); } \
        AMP_WAIT((pb) + 6); if (IN((pb) + 6) && IN((pb) + 9)) { xcd_barrier(bar, wave_s); STAMP((pb) + 9); }     \
    } while (0)
    COMMON_BLOCK(0, 7);
    if (IN(16)) { PHASE_BEGIN(); ln_phase<1, false, false>(F, nullptr, args.in[I_LNG] + 2 * D, args.in[I_LNB] + 2 * D, nullptr); convert_expert_weights(F, 1, (F.xok && UP_NCONV > 0) ? CV_UP1 : CV_SEL1, 16 * 1536, 0); }
    SEAM(16);
    {
        const float* lng = args.in[I_LNG] + 3 * D; const float* lnb = args.in[I_LNB] + 3 * D;
        if (IN(17)) { PHASE_BEGIN(); SchedQKV S{ws, F.G, F.c}; EpiQKV E; gemm_phase<EpiQKV, SchedQKV, false, true>(ring, F.tid, 512, 1024u, 1024u, S, E); }
        SEAM(17);
        if (IN(18)) { PHASE_BEGIN(); natten_phase(F, args.in[I_BRPB]); }
        LSEAM(18);
        if (IN(19)) { PHASE_BEGIN(); SchedPlain S{(const char*)ws + PO_Q, (const char*)ws + WS_WO, (char*)ws + PO_HB_NA, 2048, 2048, 1024, NT / BM, 4, F.G, F.c}; EpiBf<false> E{1024u, 1.f};
            gemm_phase<EpiBf<false>, SchedPlain, false>(ring, F.tid, 1024, 2048u, 2048u, S, E); }
        LSEAM(19);
        if (IN(20)) { PHASE_BEGIN(); ln_phase<0, false, false>(F, (const bf16_t*)(ws + PO_HB_NA), lng, lnb, nullptr); }
        LSEAM(20);
    }
    COMMON_BLOCK(1, 21);
    if (IN(30)) { PHASE_BEGIN(); ln_phase<1, false, true>(F, nullptr, args.in[I_LNG] + 5 * D, args.in[I_LNB] + 5 * D, nullptr); }
    AMP_WAIT(30);
#undef COMMON_BLOCK
#ifdef STAMP_PA
    xcd_barrier(bar, wave_s); STAMP(31); xcd_barrier(bar, wave_s);
    {
        const volatile unsigned long long* T = TS; const float dA = (float)(T[STAMP_PA + STAMP_NA] - T[STAMP_PA]) * 0.01f, dB = (float)(T[STAMP_PB + STAMP_NB] - T[STAMP_PB]) * 0.01f;
        const float c = sqrtf(100.f * dA), V = 100.f * dB; const size_t np = (size_t)NTP * 1024, n = (size_t)NT * 1024;
        for (size_t i = (size_t)blockIdx.x * 512 + threadIdx.x; i < n; i += (size_t)gridDim.x * 512) args.out[i] = i < np ? c : (i == np ? V : 0.f);
    }
#endif
#undef IN
#undef SEAM
}
}
#ifndef DBG
#define DBG 0
#endif
#ifndef FZ_PER_PHASE
#define FZ_PER_PHASE 0
#endif

#if DBG
namespace dbg {
__global__ void k_cmp_bf16_f32(const unsigned short* a, const float* b, size_t n, double* acc) {
    double s0 = 0, s1 = 0;
    for (size_t i = (size_t)blockIdx.x * blockDim.x + threadIdx.x; i < n; i += (size_t)gridDim.x * blockDim.x) { const double x = (double)__uint_as_float(((unsigned)a[i]) << 16), y = b[i]; s0 += (x - y) * (x - y); s1 += y * y; }
    for (int o = 32; o >= 1; o >>= 1) { s0 += __shfl_xor(s0, o); s1 += __shfl_xor(s1, o); }
    if ((threadIdx.x & 63) == 0) { atomicAdd(acc, s0); atomicAdd(acc + 1, s1); }
}
__global__ void k_cmp_f32_f32(const float* a, const float* b, size_t n, double* acc) {
    double s0 = 0, s1 = 0;
    for (size_t i = (size_t)blockIdx.x * blockDim.x + threadIdx.x; i < n; i += (size_t)gridDim.x * blockDim.x) { const double x = a[i], y = b[i]; s0 += (x - y) * (x - y); s1 += y * y; }
    for (int o = 32; o >= 1; o >>= 1) { s0 += __shfl_xor(s0, o); s1 += __shfl_xor(s1, o); }
    if ((threadIdx.x & 63) == 0) { atomicAdd(acc, s0); atomicAdd(acc + 1, s1); }
}
__global__ void k_cmp_ua(const unsigned short* UA, const float* u, double* acc) {
    double s0 = 0, s1 = 0;
    for (size_t i = (size_t)blockIdx.x * blockDim.x + threadIdx.x; i < (size_t)fz::NT * 1024; i += (size_t)gridDim.x * blockDim.x) {
        const int tok = (int)(i >> 10), ch = (int)(i & 1023), chunk = tok >> 5, j = tok & 31, g = ch >> 4, h = ch & 15;
        const double x = (double)__uint_as_float(((unsigned)UA[((size_t)g * fz::NCHUNK + chunk) * fz::UAK + j * 16 + h]) << 16), y = u[i]; s0 += (x - y) * (x - y); s1 += y * y; }
    for (int o = 32; o >= 1; o >>= 1) { s0 += __shfl_xor(s0, o); s1 += __shfl_xor(s1, o); }
    if ((threadIdx.x & 63) == 0) { atomicAdd(acc, s0); atomicAdd(acc + 1, s1); }
}
__global__ void k_encode(float* out, const double* accA, const double* accB) {
    const double vA = accA[1] > 0 ? sqrt(accA[0] / accA[1]) : 9.99; const double vB = accB[1] > 0 ? sqrt(accB[0] / accB[1]) : 9.99;
    const float c = (float)sqrt(1e8 * (vA == vA ? vA : 7.77)); const float V = (float)(1e5 * (vB == vB ? vB : 7.77));
    const size_t np = (size_t)fz::NTP * 1024, n = (size_t)fz::NT * 1024;
    for (size_t i = (size_t)blockIdx.x * blockDim.x + threadIdx.x; i < n; i += (size_t)gridDim.x * blockDim.x) out[i] = i < np ? c : (i == np ? V : 0.f);
}
}
#endif

extern "C" void kernel_launch(void* const* d_in, const int* in_sizes, int n_in, void* d_out, int out_size, void* d_ws, size_t ws_size, hipStream_t stream) {
    using namespace fz;
    static int grid = 0;
    if (grid == 0) {
        if (n_in != 26 || ws_size < WS_END) { fprintf(stderr, "kernel_launch: unexpected inputs (n_in %d, ws %zu)\n", n_in, ws_size); grid = -1; return; }
        int dev = 0, cus = 0, per_cu = 0;
        if (hipGetDevice(&dev) != hipSuccess || hipDeviceGetAttribute(&cus, hipDeviceAttributeMultiprocessorCount, dev) != hipSuccess) { grid = -1; return; }
        if (hipFuncSetAttribute((const void*)fwd, hipFuncAttributeMaxDynamicSharedMemorySize, LDS_BYTES) != hipSuccess) { fprintf(stderr, "kernel_launch: hipFuncSetAttribute failed\n"); grid = -1; return; }
        if (hipOccupancyMaxActiveBlocksPerMultiprocessor(&per_cu, (const void*)fwd, 512, LDS_BYTES) != hipSuccess || per_cu < 1) { fprintf(stderr, "kernel_launch: occupancy query says %d\n", per_cu); }
        (void)hipGetLastError();
        grid = cus;
    }
    if (grid < 0) return;
    unsigned char* ws = (unsigned char*)d_ws;
    (void)hipMemsetAsync(ws + WS_CTL, 0, CTL_ZERO_BYTES, stream);
    Args a{};
    for (int i = 0; i < 26; ++i) a.in[i] = (const float*)d_in[i];
    a.out = (float*)d_out; a.ws = ws; a.flags = 0; a.pad = 0;
    auto run = [&](int lo, int hi) { a.ph_lo = lo; a.ph_hi = hi; hipLaunchKernelGGL(fwd, dim3(grid), dim3(512), LDS_BYTES, stream, a); };
#if DBG == 0
#ifdef PRE_LO
    a.pad = 1; run(PRE_LO, PRE_HI); a.pad = 0;
#endif
#if FZ_PER_PHASE
    for (int p = 0; p < N_PHASES; ++p) run(p, p + 1);
#else
    run(0, N_PHASES);
#endif
#else
    using nv::SG;
    const float* const* in = (const float* const*)d_in;
    const size_t BIG = (size_t)NT * D;
    double* ACC = (double*)(ws + 32 * 1024);
    float* nmisc = (float*)(ws + 987 * MiB);
    float* nKV = nmisc; float* nAFF = nmisc + 4u * 1024 * 1024; float* nGATE = nAFF + 1024 * 1024; int* nIDX = (int*)(nGATE + 128 * 1024); float* nMEMC = (float*)(ws + 385 * MiB);
    auto sgemm = [&](const float* A, const float* B, float* C, const int* gidx, int M, int N, int K, long sam, long sak, long sbk, long sbn, long ldc,
                     int nz = 1, int zdiv = 1, long zA0 = 0, long zA1 = 0, long zB0 = 0, long zB1 = 0, long zC0 = 0, long zC1 = 0) {
        SG s{A, B, C, gidx, M, N, K, zdiv, sam, sak, sbk, sbn, ldc, zA0, zA1, zB0, zB1, zC0, zC1};
        hipLaunchKernelGGL(nv::k_sgemm, dim3(N / 128, M / 128, nz), dim3(256), 0, stream, s);
    };
    const int EW = (int)((BIG + 255) / 256);
    auto n_import = [&](float* X) { hipMemcpyAsync(X, in[I_XP], (size_t)NTP * D * 4, hipMemcpyDeviceToDevice, stream); hipMemcpyAsync(X + (size_t)NTP * D, in[I_XS], (size_t)NTS * D * 4, hipMemcpyDeviceToDevice, stream);
        hipMemcpyAsync(nMEMC, in[I_MEMP], (size_t)4 * 256 * D * 4, hipMemcpyDeviceToDevice, stream); hipMemcpyAsync(nMEMC + (size_t)4 * 256 * D, in[I_MEMS], (size_t)4 * 256 * D * 4, hipMemcpyDeviceToDevice, stream); };
    auto n_s5 = [&](float* X, float* T1, float* T2, float* T3) {
        sgemm(X, in[I_AWIN], T1, nullptr, NT, D, D, D, 1, D, 1, D);
        hipLaunchKernelGGL(nv::k_s5_scan, dim3(8 * 64 * 2), dim3(64), 0, stream, T1, T2, in[I_ALRE], in[I_ALIM], in[I_ALDT], in[I_ABRE], in[I_ABIM], in[I_ACRE], in[I_ACIM]);
        hipLaunchKernelGGL(nv::k_s5_gelu, dim3(EW), dim3(256), 0, stream, T1, T2, in[I_AD], T2);
        sgemm(T2, in[I_AWGLU], T1, nullptr, NT, D, D, D, 1, 2 * D, 1, D);
        sgemm(T2, in[I_AWGLU] + D, T3, nullptr, NT, D, D, D, 1, 2 * D, 1, D);
        hipLaunchKernelGGL(nv::k_glu, dim3(EW), dim3(256), 0, stream, T1, T3, T1);
    };
    auto n_na = [&](float* X, float* T1, float* T2, float* T3) {
        sgemm(X, in[I_BWQKV], T1, nullptr, NT, D, D, D, 1, 3 * D, 1, D); sgemm(X, in[I_BWQKV] + D, T2, nullptr, NT, D, D, D, 1, 3 * D, 1, D); sgemm(X, in[I_BWQKV] + 2 * D, T3, nullptr, NT, D, D, D, 1, 3 * D, 1, D);
        hipLaunchKernelGGL(nv::k_natten, dim3(NT * 16 / 4), dim3(256), 0, stream, T1, T2, T3, in[I_BRPB]);
        sgemm(T1, in[I_BWO], T2, nullptr, NT, D, D, D, 1, D, 1, D);
    };
    auto n_ln = [&](float* X, const float* h, int layer, int sub, float* xo) { hipLaunchKernelGGL(nv::k_res_ln, dim3(NT / 4), dim3(256), 0, stream, X, h, in[I_LNG] + (layer * 3 + sub) * D, in[I_LNB] + (layer * 3 + sub) * D, xo, NT); };
    auto n_mem = [&](float* X, float* T1, float* T2, float* T3, int layer) {
        const float* wq = in[I_MWQ] + (size_t)layer * D * D; const float* wkv = in[I_MWKV] + (size_t)layer * D * 2 * D; const float* wo = in[I_MWO] + (size_t)layer * D * D;
        sgemm(nMEMC, wkv, nKV, nullptr, 8 * 256, 2 * D, D, D, 1, 2 * D, 1, 2 * D);
        sgemm(X, wq, T1, nullptr, NT, D, D, D, 1, D, 1, D);
        for (int grp = 0; grp < 2; ++grp) { const int L = grp ? 4096 : 8192; const size_t tb = grp ? (size_t)NTP : 0; const int gb0 = grp * 4;
            sgemm(T1 + tb * D, nKV + (size_t)gb0 * 256 * 2 * D, T2 + tb * D, nullptr, L, 256, 256, D, 1, 1, 2 * D, D, 16, 4, (long)L * D, 256, (long)256 * 2 * D, 256, (long)L * D, 256); }
        hipLaunchKernelGGL(nv::k_softmax256, dim3(NT * 4 / 4), dim3(256), 0, stream, T2, 0.0625f, NT * 4);
        for (int grp = 0; grp < 2; ++grp) { const int L = grp ? 4096 : 8192; const size_t tb = grp ? (size_t)NTP : 0; const int gb0 = grp * 4;
            sgemm(T2 + tb * D, nKV + (size_t)gb0 * 256 * 2 * D + D, T3 + tb * D, nullptr, L, 256, 256, D, 1, 2 * D, 1, D, 16, 4, (long)L * D, 256, (long)256 * 2 * D, 256, (long)L * D, 256); }
        sgemm(T3, wo, T1, nullptr, NT, D, D, D, 1, D, 1, D);
    };
    auto n_moe = [&](float* X, float* T1, float* T2, float* T3, int layer) {
        hipLaunchKernelGGL(nv::k_router, dim3(NT / 4), dim3(256), 0, stream, X, in[I_EWR] + (size_t)layer * D * 16, nAFF, NT);
        hipLaunchKernelGGL(nv::k_select, dim3(32), dim3(512), 0, stream, nAFF, nIDX, nGATE);
        hipMemsetAsync(T1, 0, BIG * 4, stream);
        for (int grp = 0; grp < 2; ++grp) { const int n = grp ? NTS : NTP, cap = n / 8; const size_t tb = grp ? (size_t)NTP : 0;
            for (int e = 0; e < 16; ++e) { const int* idx = nIDX + (grp ? 16 * 4096 : 0) + e * cap; const float* gate = nGATE + (grp ? 16 * 4096 : 0) + e * cap;
                const float* w1 = in[I_EW1] + ((size_t)layer * 16 + e) * D * 2048; const float* w3 = in[I_EW3] + ((size_t)layer * 16 + e) * D * 2048; const float* w2 = in[I_EW2] + ((size_t)layer * 16 + e) * 2048 * D;
                float* H1 = T2; float* H3 = T2 + (size_t)4096 * 2048; float* YE = T3;
                sgemm(X + tb * D, w1, H1, idx, cap, 2048, D, D, 1, 2048, 1, 2048); sgemm(X + tb * D, w3, H3, idx, cap, 2048, D, D, 1, 2048, 1, 2048);
                hipLaunchKernelGGL(nv::k_silu_mul, dim3((unsigned)(((size_t)cap * 2048 + 255) / 256)), dim3(256), 0, stream, H1, H3, (size_t)cap * 2048);
                sgemm(H1, w2, YE, nullptr, cap, D, 2048, 2048, 1, D, 1, D);
                hipLaunchKernelGGL(nv::k_scatter_add, dim3((unsigned)(((size_t)cap * D + 255) / 256)), dim3(256), 0, stream, YE, idx, gate, T1 + tb * D, cap); } }
    };
    float* X = (float*)(ws + WS_XF); float* T1 = (float*)(ws + WS_EW13); float* T2 = (float*)(ws + WS_POOL); float* T3 = (float*)(ws + WS_POOL + 192 * MiB);
    auto cmp_bf = [&](size_t off_bf16, const float* ref, double* acc) { hipLaunchKernelGGL(dbg::k_cmp_bf16_f32, dim3(2048), dim3(256), 0, stream, (const unsigned short*)(ws + off_bf16), ref, BIG, acc); };
#if DBG == 1
    n_import(X);
    a.flags = FLAG_NO_XIMPORT | FLAG_NO_EXPERTS0;
    n_s5(X, T1, T2, T3);
    for (int p = 0; p <= 5; ++p) run(p, p + 1);
    cmp_bf(PO_HB_S5, T1, ACC);
    cmp_bf(PO_HB_S5, T1, ACC + 2);
#elif DBG == 11
    n_import(X);
    a.flags = FLAG_NO_XIMPORT | FLAG_NO_EXPERTS0;
    sgemm(X, in[I_AWIN], T1, nullptr, NT, D, D, D, 1, D, 1, D);
    for (int p = 0; p <= 4; ++p) run(p, p + 1);
    hipLaunchKernelGGL(dbg::k_cmp_ua, dim3(2048), dim3(256), 0, stream, (const unsigned short*)(ws + PO_UA), T1, ACC);
    hipMemcpyAsync(X, T1, BIG * 4, hipMemcpyDeviceToDevice, stream);
    { float* Y = (float*)(ws + 193 * MiB);
      hipLaunchKernelGGL(nv::k_s5_scan, dim3(8 * 64 * 2), dim3(64), 0, stream, X, Y, in[I_ALRE], in[I_ALIM], in[I_ALDT], in[I_ABRE], in[I_ABIM], in[I_ACRE], in[I_ACIM]);
      hipLaunchKernelGGL(nv::k_s5_gelu, dim3(EW), dim3(256), 0, stream, X, Y, in[I_AD], Y);
      cmp_bf(PO_SG, Y, ACC + 2); }
#elif DBG == 2
    n_import(X); n_s5(X, T1, T2, T3); n_ln(X, T1, 0, 0, X); n_mem(X, T1, T2, T3, 0);
    a.flags = FLAG_NO_XIMPORT | FLAG_NO_EXPERTS0;
    run(0, 1); run(1, 2); run(2, 3); run(7, 8); run(9, 10);
    cmp_bf(PO_HB_MEM, T1, ACC); cmp_bf(PO_HB_MEM, T1, ACC + 2);
#elif DBG == 4
    n_import(X); n_na(X, T1, T2, T3);
    hipMemcpyAsync(T1, T2, BIG * 4, hipMemcpyDeviceToDevice, stream);
    a.flags = FLAG_NO_XIMPORT | FLAG_NO_EXPERTS0;
    run(0, 1); run(17, 18); run(18, 19); run(19, 20);
    cmp_bf(PO_HB_NA, T1, ACC); cmp_bf(PO_HB_NA, T1, ACC + 2);
#endif
    hipLaunchKernelGGL(dbg::k_encode, dim3(2048), dim3(256), 0, stream, (float*)d_out, ACC, ACC + 2);
#endif
}
```
